# Optimizing an MI355X kernel written in HIP

```python
import math
import jax, jax.numpy as jnp
from jax import lax
import numpy as np

D_MODEL = 1024
BATCH = 8
SEQ = 4096
DEPTH = 1

HEAD_DIM = 64
DIFF_HEADS = 4
DIFF_VDIM = 2 * HEAD_DIM
DIFF_WIDTH = DIFF_HEADS * DIFF_VDIM
DIL_HEADS = 4
DIL_WIDTH = DIL_HEADS * HEAD_DIM
DIL_WINDOWS = (128, 512, 2048)
DIL_DILATIONS = (1, 4, 16)
DIL_NKEYS = DIL_WINDOWS[0] // DIL_DILATIONS[0] + 1
MEM_HEADS = 4
MEM_WIDTH = MEM_HEADS * HEAD_DIM
N_MEM = 256
D_MIX = DIFF_WIDTH + DIL_WIDTH + MEM_WIDTH
C_DIFF_Q = 0
C_DIFF_K = C_DIFF_Q + DIFF_WIDTH
C_DIFF_V = C_DIFF_K + DIFF_WIDTH
C_DIL_Q = C_DIFF_V + DIFF_WIDTH
C_DIL_K = C_DIL_Q + DIL_WIDTH
C_DIL_V = C_DIL_K + DIL_WIDTH
C_MEM_Q = C_DIL_V + DIL_WIDTH
D_IN = C_MEM_Q + MEM_WIDTH
Q_BLOCK = 128
DIL_Q_BLOCK = 64
N_EXPERTS = 32
TOP_K = 4
D_FF = D_MODEL
SWIGLU_ALPHA = 1.702
SWIGLU_LIMIT = 7.0
MOE_BLOCK = 256
NORM_EPS = 1e-5

kernel_name = "hymba_diff_dilated_mem_moe_block"


def rms_norm(x, g):
    xf = x.astype(jnp.float32)
    y = xf * lax.rsqrt(jnp.mean(xf * xf, axis=-1, keepdims=True) + NORM_EPS)
    return (y * g.astype(jnp.float32)).astype(x.dtype)


def alibi_slopes():
    n = DIFF_HEADS + DIL_HEADS
    s = 2.0 ** (-8.0 * (jnp.arange(n, dtype=jnp.float32) + 1.0) / n)
    return s[0::2], s[1::2]


def dilated_distances():
    r = jnp.array(DIL_DILATIONS, dtype=jnp.int32)
    return jnp.arange(DIL_NKEYS, dtype=jnp.int32)[None, :] * r[:, None]


def split_heads(t, n_heads, d):
    b, s, _ = t.shape
    return t.reshape(b, s, n_heads, d).transpose(0, 2, 1, 3)


def merge_heads(t):
    b, h, s, d = t.shape
    return t.transpose(0, 2, 1, 3).reshape(b, s, h * d)


def diff_attention(q1, q2, k1, k2, v, slopes, lam):
    b, h, s, dh = q1.shape
    scale = dh ** -0.5
    kpos = jnp.arange(s)

    def block(i):
        start = i * Q_BLOCK
        qb1 = lax.dynamic_slice_in_dim(q1, start, Q_BLOCK, axis=2)
        qb2 = lax.dynamic_slice_in_dim(q2, start, Q_BLOCK, axis=2)
        qpos = start + jnp.arange(Q_BLOCK)
        dist = qpos[:, None] - kpos[None, :]
        causal = dist >= 0
        bias = -slopes[:, None, None] * dist.astype(jnp.float32)

        def probs(qb, k):
            sc = jnp.einsum('bhqd,bhkd->bhqk', qb, k).astype(jnp.float32) * scale + bias
            return jax.nn.softmax(jnp.where(causal, sc, -jnp.inf), axis=-1)

        a = probs(qb1, k1) - lam * probs(qb2, k2)
        return jnp.einsum('bhqk,bhkd->bhqd', a.astype(v.dtype), v)

    o = lax.map(block, jnp.arange(s // Q_BLOCK))
    return o.transpose(1, 2, 0, 3, 4).reshape(b, h, s, v.shape[-1])


def dilated_attention(q, k, v, slopes):
    b, h, s, dh = q.shape
    scale = dh ** -0.5
    dist = dilated_distances()
    bias = -slopes[:, None, None, None] * dist.astype(jnp.float32)

    def block(i):
        start = i * DIL_Q_BLOCK
        qb = lax.dynamic_slice_in_dim(q, start, DIL_Q_BLOCK, axis=2)
        qpos = start + jnp.arange(DIL_Q_BLOCK)
        kidx = qpos[:, None, None] - dist[None]
        valid = kidx >= 0
        kidx = jnp.maximum(kidx, 0)
        kg = jnp.take(k, kidx, axis=2, mode='clip')
        vg = jnp.take(v, kidx, axis=2, mode='clip')
        sc = jnp.einsum('bhqd,bhqnkd->bhqnk', qb, kg).astype(jnp.float32) * scale + bias
        sc = jnp.where(valid, sc, -jnp.inf)
        m = jnp.max(sc, axis=-1, keepdims=True)
        p = jnp.exp(sc - m)
        denom = jnp.sum(p, axis=-1)
        o = jnp.einsum('bhqnk,bhqnkd->bhqnd', p.astype(v.dtype), vg).astype(jnp.float32) / denom[..., None]
        w = jax.nn.softmax(m[..., 0] + jnp.log(denom), axis=-1)
        return jnp.einsum('bhqn,bhqnd->bhqd', w, o)

    o = lax.map(block, jnp.arange(s // DIL_Q_BLOCK))
    return o.transpose(1, 2, 0, 3, 4).reshape(b, h, s, dh)


def memory_attention(q, mk, mv):
    scale = q.shape[-1] ** -0.5
    sc = jnp.einsum('bhsd,bhmd->bhsm', q, mk).astype(jnp.float32) * scale
    a = jax.nn.softmax(sc, axis=-1)
    return jnp.einsum('bhsm,bhmd->bhsd', a.astype(mv.dtype), mv)


def moe_ffn(h, w_router, b_router, w_gu, b_gu, w_dn, b_dn):
    b, s, d = h.shape
    t = b * s
    xf = h.reshape(t, d)
    logits = (xf @ w_router + b_router).astype(jnp.float32)
    top_v, top_e = lax.top_k(logits, TOP_K)
    gates = jax.nn.softmax(top_v, axis=-1)
    n_assign = t * TOP_K
    e_flat = top_e.reshape(-1)
    g_flat = gates.reshape(-1)
    tok_flat = jnp.arange(n_assign, dtype=jnp.int32) // TOP_K
    order = jnp.argsort(e_flat, stable=True)
    e_sorted = e_flat[order]
    counts = jnp.bincount(e_flat, length=N_EXPERTS)
    padded = (counts + MOE_BLOCK - 1) // MOE_BLOCK * MOE_BLOCK
    pad_end = jnp.cumsum(padded)
    pad_start = pad_end - padded
    start = jnp.cumsum(counts) - counts
    rank = jnp.arange(n_assign, dtype=jnp.int32) - start[e_sorted]
    dest = pad_start[e_sorted] + rank
    n_blocks = -(-n_assign // MOE_BLOCK) + N_EXPERTS
    n_rows = n_blocks * MOE_BLOCK
    row_tok = jnp.zeros((n_rows,), jnp.int32).at[dest].set(tok_flat[order])
    row_gate = jnp.zeros((n_rows,), jnp.float32).at[dest].set(g_flat[order])
    block_expert = jnp.minimum(
        jnp.searchsorted(pad_end, jnp.arange(n_blocks) * MOE_BLOCK, side='right'), N_EXPERTS - 1)
    xb = xf[row_tok].reshape(n_blocks, MOE_BLOCK, d)

    def expert_block(args):
        xe, e = args
        gu = xe @ w_gu[e] + b_gu[e]
        gate = jnp.minimum(gu[..., 0::2], SWIGLU_LIMIT)
        up = jnp.clip(gu[..., 1::2], -SWIGLU_LIMIT, SWIGLU_LIMIT)
        act = (up + 1.0) * (gate * jax.nn.sigmoid(gate * SWIGLU_ALPHA))
        return act @ w_dn[e] + b_dn[e]

    yb = lax.map(expert_block, (xb, block_expert))
    out = jnp.zeros((t, d), jnp.float32).at[row_tok].add(
        yb.reshape(n_rows, d).astype(jnp.float32) * row_gate[:, None])
    return out.reshape(b, s, d).astype(h.dtype)


def setup_inputs(seed: int = 0) -> dict:
    key = jax.random.key(seed)
    ks = jax.random.split(key, 18)
    f32 = jnp.float32

    def nrm(k, shape, scale):
        return jax.random.normal(k, shape, f32) * scale

    return {
        "x": nrm(ks[0], (BATCH, SEQ, D_MODEL), 1.0),
        "mem": nrm(ks[1], (BATCH, N_MEM, D_MODEL), 1.0),
        "attn_norm_g": 1.0 + nrm(ks[2], (DEPTH, D_MODEL), 0.02),
        "mem_norm_g": 1.0 + nrm(ks[3], (DEPTH, D_MODEL), 0.02),
        "w_in": nrm(ks[4], (DEPTH, D_MODEL, D_IN), D_MODEL ** -0.5),
        "diff_lambda_qk": nrm(ks[5], (DEPTH, 4, HEAD_DIM), 0.1),
        "diff_subln_g": 1.0 + nrm(ks[6], (DEPTH, DIFF_VDIM), 0.02),
        "w_mem_kv": nrm(ks[7], (DEPTH, D_MODEL, 2 * MEM_WIDTH), D_MODEL ** -0.5),
        "w_out": nrm(ks[8], (DEPTH, D_MIX, D_MODEL), D_MIX ** -0.5),
        "ffn_norm_g": 1.0 + nrm(ks[9], (DEPTH, D_MODEL), 0.02),
        "w_router": nrm(ks[10], (DEPTH, D_MODEL, N_EXPERTS), D_MODEL ** -0.5),
        "b_router": nrm(ks[11], (DEPTH, N_EXPERTS), 0.01),
        "w_gate_up": nrm(ks[12], (DEPTH, N_EXPERTS, D_MODEL, 2 * D_FF), D_MODEL ** -0.5),
        "b_gate_up": nrm(ks[13], (DEPTH, N_EXPERTS, 2 * D_FF), 0.01),
        "w_down": nrm(ks[14], (DEPTH, N_EXPERTS, D_FF, D_MODEL), D_FF ** -0.5),
        "b_down": nrm(ks[15], (DEPTH, N_EXPERTS, D_MODEL), 0.01),
        "final_norm_g": 1.0 + nrm(ks[16], (D_MODEL,), 0.02),
    }


def reference(x, mem, attn_norm_g, mem_norm_g, w_in, diff_lambda_qk, diff_subln_g, w_mem_kv,
              w_out, ffn_norm_g, w_router, b_router, w_gate_up, b_gate_up, w_down, b_down,
              final_norm_g):
    b, s, _ = x.shape
    diff_slopes, dil_slopes = alibi_slopes()
    for l in range(DEPTH):
        h = rms_norm(x, attn_norm_g[l])
        p = h @ w_in[l]

        lam_init = 0.8 - 0.6 * math.exp(-0.3 * l)
        lv = diff_lambda_qk[l].astype(jnp.float32)
        lam = jnp.exp(jnp.sum(lv[0] * lv[1])) - jnp.exp(jnp.sum(lv[2] * lv[3])) + lam_init
        dq = p[..., C_DIFF_Q:C_DIFF_K].reshape(b, s, DIFF_HEADS, 2, HEAD_DIM).transpose(0, 2, 3, 1, 4)
        dk = p[..., C_DIFF_K:C_DIFF_V].reshape(b, s, DIFF_HEADS, 2, HEAD_DIM).transpose(0, 2, 3, 1, 4)
        dv = split_heads(p[..., C_DIFF_V:C_DIL_Q], DIFF_HEADS, DIFF_VDIM)
        o_diff = diff_attention(dq[:, :, 0], dq[:, :, 1], dk[:, :, 0], dk[:, :, 1], dv, diff_slopes, lam)
        o_diff = rms_norm(o_diff, diff_subln_g[l]) * (1.0 - lam_init)
        o_diff = merge_heads(o_diff.astype(x.dtype))

        lq = split_heads(p[..., C_DIL_Q:C_DIL_K], DIL_HEADS, HEAD_DIM)
        lk = split_heads(p[..., C_DIL_K:C_DIL_V], DIL_HEADS, HEAD_DIM)
        lvv = split_heads(p[..., C_DIL_V:C_MEM_Q], DIL_HEADS, HEAD_DIM)
        o_dil = merge_heads(dilated_attention(lq, lk, lvv, dil_slopes).astype(x.dtype))

        mq = split_heads(p[..., C_MEM_Q:D_IN], MEM_HEADS, HEAD_DIM)
        mkv = rms_norm(mem, mem_norm_g[l]) @ w_mem_kv[l]
        mk = split_heads(mkv[..., :MEM_WIDTH], MEM_HEADS, HEAD_DIM)
        mv = split_heads(mkv[..., MEM_WIDTH:], MEM_HEADS, HEAD_DIM)
        o_mem = merge_heads(memory_attention(mq, mk, mv).astype(x.dtype))

        mix = jnp.concatenate([o_diff, o_dil, o_mem], axis=-1)
        x = x + mix @ w_out[l]

        x = x + moe_ffn(rms_norm(x, ffn_norm_g[l]), w_router[l], b_router[l],
                        w_gate_up[l], b_gate_up[l], w_down[l], b_down[l])
    return rms_norm(x, final_norm_g)
```

```cpp
#include <hip/hip_runtime.h>
#include <hip/hip_bf16.h>
#include <cstdint>
#include <cstdio>
#include <cmath>

constexpr int D = 1024, BATCH = 8, SEQ = 4096, T = BATCH * SEQ, DIN = 2560, NMEM = 256, NE = 32, DFF = 1024;
constexpr int C_DQ = 0, C_DK = 512, C_DV = 1024, C_LQ = 1536, C_LK = 1792, C_LV = 2048, C_MQ = 2304;
constexpr float EPS = 1e-5f;
constexpr int LCAP = T;
constexpr float QSCALE = 0.125f * 1.4426950408889634f;
constexpr float LOG2E = 1.4426950408889634f;
namespace pg8 {
#define PG8_LAS __attribute__((address_space(3)))
typedef unsigned short bf16_t;
typedef short bf16x8 __attribute__((ext_vector_type(8)));
typedef float f32x4 __attribute__((ext_vector_type(4)));
typedef unsigned u32x4 __attribute__((ext_vector_type(4)));
typedef unsigned u32x2 __attribute__((ext_vector_type(2)));
constexpr int BM = 256, BK = 64, HALF = 128, HTB = HALF * BK * 2  , STAGE_BYTES = 8 * HTB, NXCD = 8, WGM = 8;

__host__ __device__ __forceinline__ int lds_byte(int r, int c) { const int st = (r >> 4) * 2 + (c >> 5), rr = r & 15, cc = c & 31, ob = rr * 64 + cc * 2; return st * 1024 + (ob ^ (((ob >> 9) & 1) << 5)); }
__host__ __device__ __forceinline__ void stage_rc(int b, int& R, int& C) { const int st = b / 1024, sb = b % 1024, swz = sb ^ (((sb >> 9) & 1) << 5); R = (st >> 1) * 16 + swz / 64; C = (st & 1) * 32 + (swz % 64) / 2; }
__host__ __device__ __forceinline__ int perm32(int rho) { const int n = rho >> 4, i = rho & 15; return 8 * (i >> 2) + 4 * n + (i & 3); }

struct Unit { size_t aoff, boff; int pm, pn, e, valid, mt; };
struct Gemm { const bf16_t* A; const bf16_t* Bt; int K; };

struct StaticOrder {
    int nM, nN, nwg, G, c, K;
    __device__ void init(int M, int N, int K_, int G_, int c_) { nM = M / BM; nN = N / BM; nwg = nM * nN; G = G_; c = c_; K = K_; }
    __device__ bool next(int i, Unit& u) const {
        const long L = (long)i * G + c; if (L >= nwg) return false;
        int wgid = (int)L; { const int q = nwg / NXCD, r = nwg % NXCD, xcd = wgid % NXCD, off = wgid / NXCD; wgid = (xcd < r ? xcd * (q + 1) : r * (q + 1) + (xcd - r) * q) + off; }
        const int nig = WGM * nN, gid = wgid / nig, fm = gid * WGM, gsz = (nM - fm) < WGM ? (nM - fm) : WGM;
        u.pm = fm + ((wgid % nig) % gsz); u.pn = (wgid % nig) / gsz; u.e = 0; u.valid = 256; u.mt = 0;
        u.aoff = (size_t)u.pm * (size_t)(BM * K * 2); u.boff = (size_t)u.pn * (size_t)(BM * K * 2); return true;
    }
    __device__ __forceinline__ const unsigned* id_src(const Unit&, int) const { return nullptr; }
};

__device__ __forceinline__ unsigned cvt_pk_bf16(float lo, float hi) { unsigned r; asm volatile("v_cvt_pk_bf16_f32 %0, %1, %2" : "=v"(r) : "v"(lo), "v"(hi)); return r; }

template <class Epi, class Sched, bool ALIGN_EPI, bool GATHER, bool IDS>
__device__ __forceinline__ void gemm_phase(PG8_LAS unsigned char* lds, PG8_LAS unsigned* idb, const Gemm g, const Sched& S, const Epi& E) {
    const int tid = threadIdx.x, wid = __builtin_amdgcn_readfirstlane(tid >> 6), lane = tid & 63, wr = wid >> 2, wc = wid & 3, fr = lane & 15, fq = lane >> 4;
    const int K = g.K, nt = K / BK;
    unsigned voffA[2], voffB[2]; int RA[2], CA[2];
#pragma unroll
    for (int i = 0; i < 2; ++i) { int R, C; stage_rc(tid * 16 + i * 8192, R, C); const int Rb = (R & ~31) + perm32(R & 31); RA[i] = R; CA[i] = C;
        voffA[i] = (unsigned)(R * K + C) * 2u; voffB[i] = (unsigned)(Rb * K + C) * 2u; }
    const size_t kstep = (size_t)(BK * 2);
    const size_t hstep = (size_t)HALF * K * 2;
    const unsigned ldsw = (unsigned)wid * 1024u;
    const int aoff = lds_byte(wr * 64 + fr, fq * 8), boff = lds_byte(wc * 32 + fr, fq * 8);
#define PG8_SA(b, h) (((b) * 2 + (h)) * HTB)
#define PG8_SB(b, h) ((4 + (b) * 2 + (h)) * HTB)
#define PG8_STAGE(bufoff, gbase, voff) do { _Pragma("unroll") for (int _i = 0; _i < 2; ++_i) \
        __builtin_amdgcn_global_load_lds((const unsigned*)((const char*)(gbase) + (voff)[_i]), (PG8_LAS unsigned*)(lds + (bufoff) + ldsw + _i * 8192), 16, 0, 0); } while (0)
#define PG8_STAGE_A(bufoff, pbase, gbase, h, gv) do { if constexpr (GATHER) { PG8_STAGE(bufoff, gbase, gv[h]); } else { PG8_STAGE(bufoff, (pbase) + (h) * hstep, voffA); } } while (0)
#define PG8_LDA(dst, b, h) do { _Pragma("unroll") for (int m = 0; m < 4; ++m) _Pragma("unroll") for (int k = 0; k < 2; ++k) dst[m][k] = *(const PG8_LAS bf16x8*)(lds + PG8_SA(b, h) + aoff + m * 2048 + k * 1024); } while (0)
#define PG8_LDB(dst, b, h) do { _Pragma("unroll") for (int n = 0; n < 2; ++n) _Pragma("unroll") for (int k = 0; k < 2; ++k) dst[n][k] = *(const PG8_LAS bf16x8*)(lds + PG8_SB(b, h) + boff + n * 2048 + k * 1024); } while (0)
#define PG8_MMA(ai, bj, At, Bt) do { __builtin_amdgcn_s_setprio(1); _Pragma("unroll") for (int m = 0; m < 4; ++m) _Pragma("unroll") for (int n = 0; n < 2; ++n) _Pragma("unroll") for (int k = 0; k < 2; ++k) \
        acc[ai][bj][m][n] = __builtin_amdgcn_mfma_f32_16x16x32_bf16(Bt[n][k], At[m][k], acc[ai][bj][m][n], 0, 0, 0); __builtin_amdgcn_s_setprio(0); } while (0)
#define PG8_WAIT_V(n) asm volatile("s_waitcnt vmcnt(" #n ")" ::: "memory")
#define PG8_WAIT_L(n) asm volatile("s_waitcnt lgkmcnt(" #n ")" ::: "memory")
#define PG8_BAR __builtin_amdgcn_s_barrier()
#define PG8_SCHED __builtin_amdgcn_sched_barrier(0)
#define PG8_IDS_DMA(u, s) do { if (wid < 4) __builtin_amdgcn_global_load_lds(S.id_src(u, tid), (PG8_LAS unsigned*)(idb + (s) * 256 + wid * 64), 4, 0, 0); } while (0)
#define PG8_GV(dst, s) do { _Pragma("unroll") for (int _h = 0; _h < 2; ++_h) _Pragma("unroll") for (int _i = 0; _i < 2; ++_i) \
        dst[_h][_i] = (idb[(s) * 256 + _h * 128 + RA[_i]] >> 2) * (unsigned)(K * 2) + (unsigned)(CA[_i] * 2); } while (0)
    Unit cur, nxt; int ui = 0, us = 0;
    if (!S.next(0, cur)) return;
    f32x4 acc[2][2][4][2];
#pragma unroll
    for (int a = 0; a < 2; ++a)
#pragma unroll
        for (int b = 0; b < 2; ++b)
#pragma unroll
            for (int m = 0; m < 4; ++m)
#pragma unroll
                for (int n = 0; n < 2; ++n) acc[a][b][m][n] = (f32x4){0.f, 0.f, 0.f, 0.f};
    bf16x8 At[4][2], B0[2][2], B1[2][2];
    unsigned cv[2][2] = {{0u, 0u}, {0u, 0u}}, nv[2][2] = {{0u, 0u}, {0u, 0u}};
    const char* A0 = (const char*)g.A;
    const char* cA = A0 + (GATHER ? (size_t)0 : cur.aoff); const char* cB = (const char*)g.Bt + cur.boff;
    if constexpr (IDS) {
        PG8_IDS_DMA(cur, 0); PG8_WAIT_V(0); PG8_BAR;
        if constexpr (GATHER) { PG8_GV(cv, 0); }
    }
    PG8_STAGE(PG8_SB(0, 0), cB, voffB); PG8_STAGE(PG8_SB(0, 1), cB + hstep, voffB); PG8_STAGE_A(PG8_SA(0, 0), cA, A0, 0, cv); PG8_STAGE_A(PG8_SA(0, 1), cA, A0, 1, cv);
    if (wr == 1) PG8_BAR;
    PG8_WAIT_V(2); PG8_BAR;
    PG8_STAGE(PG8_SB(1, 0), cB + kstep, voffB); PG8_STAGE_A(PG8_SA(1, 0), cA + kstep, A0 + kstep, 0, cv); PG8_STAGE(PG8_SB(1, 1), cB + hstep + kstep, voffB);
    PG8_WAIT_V(6); PG8_BAR;
    for (;;) {
        const bool has_next = S.next(ui + 1, nxt);
        const int ns = (us == 2) ? 0 : us + 1;
        if constexpr (IDS) { if (has_next) PG8_IDS_DMA(nxt, ns); }
        const char* nA = has_next ? A0 + (GATHER ? (size_t)0 : nxt.aoff) : cA; const char* nB = has_next ? (const char*)g.Bt + nxt.boff : cB;
        for (int t = 0; t < nt; t += 2) {
            const bool last = (t == nt - 2);
            const char* a1 = cA + (size_t)(t + 1) * kstep;
            const char* a2 = last ? nA : cA + (size_t)(t + 2) * kstep; const char* b2 = last ? nB : cB + (size_t)(t + 2) * kstep;
            const char* a3 = a2 + kstep; const char* b3 = b2 + kstep;
            unsigned ov[2][2];
            if constexpr (GATHER) {
                if (last && has_next) { PG8_GV(nv, ns); }
#pragma unroll
                for (int h = 0; h < 2; ++h)
#pragma unroll
                    for (int i = 0; i < 2; ++i) ov[h][i] = (last && has_next) ? nv[h][i] : cv[h][i];
            }
            PG8_LDB(B0, 0, 0); PG8_LDB(B1, 0, 1); PG8_SCHED; PG8_LDA(At, 0, 0); PG8_STAGE_A(PG8_SA(1, 1), a1, a1, 1, cv);
            PG8_WAIT_V(8); PG8_WAIT_L(0); PG8_BAR; PG8_MMA(0, 0, At, B0); PG8_MMA(0, 1, At, B1); PG8_BAR; PG8_SCHED;
            PG8_LDA(At, 0, 1); PG8_STAGE(PG8_SB(0, 0), b2, voffB); PG8_STAGE(PG8_SB(0, 1), b2 + hstep, voffB); PG8_STAGE_A(PG8_SA(0, 0), a2, a2, 0, ov);
            PG8_WAIT_V(8); PG8_WAIT_L(0); PG8_BAR; PG8_MMA(1, 0, At, B0); PG8_MMA(1, 1, At, B1); PG8_BAR; PG8_SCHED;
            PG8_LDB(B0, 1, 0); PG8_LDB(B1, 1, 1); PG8_SCHED; PG8_LDA(At, 1, 0); PG8_STAGE_A(PG8_SA(0, 1), a2, a2, 1, ov);
            PG8_WAIT_V(8); PG8_WAIT_L(0); PG8_BAR; PG8_MMA(0, 0, At, B0); PG8_MMA(0, 1, At, B1); PG8_BAR; PG8_SCHED;
            PG8_LDA(At, 1, 1); PG8_STAGE(PG8_SB(1, 0), b3, voffB); PG8_STAGE(PG8_SB(1, 1), b3 + hstep, voffB); PG8_STAGE_A(PG8_SA(1, 0), a3, a3, 0, ov);
            PG8_WAIT_V(8); PG8_WAIT_L(0); PG8_BAR; PG8_MMA(1, 0, At, B0); PG8_MMA(1, 1, At, B1); PG8_BAR; PG8_SCHED;
        }
        if constexpr (ALIGN_EPI) { if (wr == 0) PG8_BAR; }
        E(acc, cur, wr, wc, fr, fq, (const PG8_LAS unsigned*)(idb + us * 256));
        if (!has_next) break;
#pragma unroll
        for (int a = 0; a < 2; ++a)
#pragma unroll
            for (int b = 0; b < 2; ++b)
#pragma unroll
                for (int m = 0; m < 4; ++m)
#pragma unroll
                    for (int n = 0; n < 2; ++n) acc[a][b][m][n] = (f32x4){0.f, 0.f, 0.f, 0.f};
        cur = nxt; cA = nA; cB = nB; ++ui; us = ns;
        if constexpr (GATHER) {
#pragma unroll
            for (int h = 0; h < 2; ++h)
#pragma unroll
                for (int i = 0; i < 2; ++i) cv[h][i] = nv[h][i];
        }
        if constexpr (ALIGN_EPI) { if (wr == 1) PG8_BAR; }
    }
    PG8_WAIT_V(0);
    if constexpr (!ALIGN_EPI) { if (wr == 0) PG8_BAR; }
    PG8_BAR;
#undef PG8_SA
#undef PG8_SB
#undef PG8_STAGE
#undef PG8_STAGE_A
#undef PG8_LDA
#undef PG8_LDB
#undef PG8_MMA
#undef PG8_WAIT_V
#undef PG8_WAIT_L
#undef PG8_BAR
#undef PG8_SCHED
#undef PG8_IDS_DMA
#undef PG8_GV
}
}
namespace attn_body {
using bf16=__hip_bfloat16;
using bf16x8=__attribute__((ext_vector_type(8)))short;
using s16x4=__attribute__((ext_vector_type(4)))short;
using f32x16=__attribute__((ext_vector_type(16)))float;
using u32x4=__attribute__((ext_vector_type(4)))unsigned;
constexpr int D=64;
constexpr int NW=8,QBLK=32,QB=QBLK*NW,KVBLK=64;
struct UnitP { const bf16* Q; const bf16* K; const bf16* V; bf16* O; long qp, kp, op; int q0, t0, NT; float slope2; float* lse; int lse_stride; };
__device__ __forceinline__ int crow(int r,int hi){return (r&3)+8*(r>>2)+4*hi;}
#define SBAR() __builtin_amdgcn_sched_barrier(0)
template<bool CAUSAL,bool WINDOW> __device__ __forceinline__ void cmask(f32x16&p0,f32x16&p1,int jb,int qrel,int hi){
  const float NEG=-INFINITY; int kb=64*jb+4*hi;
  #pragma unroll
  for(int r=0;r<16;++r){int kv=kb+(r&3)+8*(r>>2);
    if(CAUSAL){ if(kv>qrel)p0[r]=NEG; if(kv+32>qrel)p1[r]=NEG; }
    if(WINDOW){ if(kv<qrel-128)p0[r]=NEG; if(kv+32<qrel-128)p1[r]=NEG; } }
}
template<bool ALIBI> __device__ __forceinline__ void alibi_keys(f32x16&p0,f32x16&p1,float slope2,float nb){
  const float nb1=ALIBI?__builtin_fmaf(slope2,32.f,nb):nb;
  #pragma unroll
  for(int r=0;r<16;++r){ if(ALIBI){ p0[r]=__builtin_fmaf(slope2,(float)((r&3)+8*(r>>2)),p0[r]); p1[r]=__builtin_fmaf(slope2,(float)((r&3)+8*(r>>2)),p1[r]); } p0[r]+=nb; p1[r]+=nb1; }
}

constexpr int NSLOT=3, SLOTB=8192;
constexpr int LDS_K=0, LDS_V=NSLOT*SLOTB, LDS_WS=2*NSLOT*SLOTB, LDS_OST=LDS_WS+NW*64*4, LDS_BYTES=LDS_OST+NW*4096;
__device__ __forceinline__ void glds16(const void*gsrc,unsigned lds_dst){unsigned keep;
  asm volatile("s_mov_b32 %0, m0\n\ts_mov_b32 m0, %2\n\ts_nop 0\n\tglobal_load_lds_dwordx4 %1, off\n\ts_mov_b32 m0, %0":"=&s"(keep):"v"(gsrc),"s"(lds_dst):"memory");}
__device__ __forceinline__ float max3f(float a,float b,float c){float r;asm("v_max3_f32 %0, %1, %2, %3":"=v"(r):"v"(a),"v"(b),"v"(c));return r;}
__device__ __forceinline__ float max2f(float a,float b){float r;asm("v_max_f32_e32 %0, %1, %2":"=v"(r):"v"(a),"v"(b));return r;}
__device__ __forceinline__ float fadd_s(float a,float b){float r;asm("v_add_f32_e32 %0, %1, %2":"=v"(r):"v"(a),"v"(b));return r;}
__device__ __forceinline__ float fsub_s(float a,float b){float r;asm("v_sub_f32_e32 %0, %1, %2":"=v"(r):"v"(a),"v"(b));return r;}
typedef float f32x2_t __attribute__((ext_vector_type(2))); typedef __bf16 bf16x2_t __attribute__((ext_vector_type(2)));
__device__ __forceinline__ unsigned cvtpk_s(float lo,float hi){f32x2_t v={lo,hi};bf16x2_t b=__builtin_convertvector(v,bf16x2_t);return __builtin_bit_cast(unsigned,b);}
#define WAIT_BAR(N) asm volatile("s_waitcnt vmcnt(" #N ") lgkmcnt(0)\n\ts_barrier":::"memory")

__device__ __forceinline__ void qkt(f32x16&p0,f32x16&p1,const char*Kslot,const bf16x8*qr,int r32,int hi){
  const char*kb=Kslot+hi*1024+r32*16;
  #pragma unroll
  for(int d0=0;d0<4;++d0){
    const bf16x8 b0=*reinterpret_cast<const bf16x8*>(kb+d0*2048);
    const bf16x8 b1=*reinterpret_cast<const bf16x8*>(kb+d0*2048+512);
    if(d0==0){p0=__builtin_amdgcn_mfma_f32_32x32x16_bf16(b0,qr[0],f32x16{},0,0,0);p1=__builtin_amdgcn_mfma_f32_32x32x16_bf16(b1,qr[0],f32x16{},0,0,0);}
    else{p0=__builtin_amdgcn_mfma_f32_32x32x16_bf16(b0,qr[d0],p0,0,0,0);p1=__builtin_amdgcn_mfma_f32_32x32x16_bf16(b1,qr[d0],p1,0,0,0);}}
}
typedef __attribute__((address_space(3))) const char* lds_cptr;
typedef short v4i16_t __attribute__((ext_vector_type(4)));
__device__ __forceinline__ void kload8(bf16x8*kf,lds_cptr kp){
  kf[0]=*(const __attribute__((address_space(3))) bf16x8*)(kp);      kf[1]=*(const __attribute__((address_space(3))) bf16x8*)(kp+512);
  kf[2]=*(const __attribute__((address_space(3))) bf16x8*)(kp+2048); kf[3]=*(const __attribute__((address_space(3))) bf16x8*)(kp+2560);
  kf[4]=*(const __attribute__((address_space(3))) bf16x8*)(kp+4096); kf[5]=*(const __attribute__((address_space(3))) bf16x8*)(kp+4608);
  kf[6]=*(const __attribute__((address_space(3))) bf16x8*)(kp+6144); kf[7]=*(const __attribute__((address_space(3))) bf16x8*)(kp+6656);
}
__device__ __forceinline__ void kload2(bf16x8*kf,lds_cptr kp,int j){ kf[2*j]=*(const __attribute__((address_space(3))) bf16x8*)(kp+j*2048); kf[2*j+1]=*(const __attribute__((address_space(3))) bf16x8*)(kp+j*2048+512); }
__device__ __forceinline__ s16x4 vtr(lds_cptr p){ return __builtin_bit_cast(s16x4,__builtin_amdgcn_ds_read_tr16_b64_v4i16((__attribute__((address_space(3))) v4i16_t*)p)); }
__device__ __forceinline__ float rowmax(const f32x16&p0,const f32x16&p1){
  float a=max3f(p0[0],p0[1],p1[0]),b=max3f(p0[2],p0[3],p1[1]);a=max3f(a,p1[2],p1[3]);
  #pragma unroll
  for(int r=4;r<16;r+=4){a=max3f(a,p0[r],p0[r+1]);b=max3f(b,p0[r+2],p0[r+3]);a=max3f(a,p1[r],p1[r+1]);b=max3f(b,p1[r+2],p1[r+3]);}
  const float m=max2f(a,b);
  auto rr=__builtin_amdgcn_permlane32_swap(__float_as_uint(m),__float_as_uint(m),false,false);
  return max2f(__uint_as_float(rr[0]),__uint_as_float(rr[1]));
}
__device__ __forceinline__ void pv(f32x16*o,int vb,bf16x8 pa0,bf16x8 pa1,bf16x8 pa2,bf16x8 pa3){
  #pragma unroll
  for(int d0=0;d0<2;++d0){s16x4 lo[4],hi[4];
    #pragma unroll
    for(int ks=0;ks<4;++ks){
      asm volatile("ds_read_b64_tr_b16 %0,%1 offset:%c2":"=&v"(lo[ks]):"v"(vb),"i"(d0*4096+ks*1024):"memory");
      asm volatile("ds_read_b64_tr_b16 %0,%1 offset:%c2":"=&v"(hi[ks]):"v"(vb),"i"(d0*4096+ks*1024+512):"memory");}
    asm volatile("s_waitcnt lgkmcnt(0)":::"memory");SBAR();
    #define PK(k) (bf16x8){lo[k][0],lo[k][1],lo[k][2],lo[k][3],hi[k][0],hi[k][1],hi[k][2],hi[k][3]}
    o[d0]=__builtin_amdgcn_mfma_f32_32x32x16_bf16(pa0,PK(0),o[d0],0,0,0);
    o[d0]=__builtin_amdgcn_mfma_f32_32x32x16_bf16(pa1,PK(1),o[d0],0,0,0);
    o[d0]=__builtin_amdgcn_mfma_f32_32x32x16_bf16(pa2,PK(2),o[d0],0,0,0);
    o[d0]=__builtin_amdgcn_mfma_f32_32x32x16_bf16(pa3,PK(3),o[d0],0,0,0);
    #undef PK
  }
}

#ifndef ATTN_STORE16
#define ATTN_STORE16(p,v) (*(u32x4*)(p)=(v))
#endif
template<int THRL,bool CAUSAL,bool WINDOW,bool ALIBI,bool LSE> __device__ __forceinline__ void attn_unit(const UnitP&U,char*shm){
  int tid=threadIdx.x; asm volatile("":"+v"(tid));
  const int lane=tid&63,r32=lane&31,hi=lane>>5; const int wid=__builtin_amdgcn_readfirstlane(tid>>6);
  const int q0=U.q0; const long qp=U.qp,kp=U.kp,op=U.op; const float slope2=U.slope2;
  const bf16*Qw=U.Q+(long)(q0+wid*QBLK)*qp;
  const bf16*Kh=U.K+(long)U.t0*KVBLK*kp,*Vh=U.V+(long)U.t0*KVBLK*kp;
  const unsigned lds0=(unsigned)(uintptr_t)shm;
  float*wsf=(float*)(shm+LDS_WS)+wid*64;
  const bf16*ksrc=Kh+(long)lane*kp+wid*8;
  const bf16*vsrc=Vh+(long)(16*(wid&3)+(lane>>2))*kp+(wid>>2)*32+(lane&3)*8;
  const unsigned kdst=lds0+LDS_K+wid*1024, vdst=lds0+LDS_V+wid*1024;
  #define DMA_K(t,slot) glds16(ksrc+(long)(t)*KVBLK*kp,(unsigned)__builtin_amdgcn_readfirstlane(kdst+(slot)))
  #define DMA_V(t,slot) glds16(vsrc+(long)(t)*KVBLK*kp,(unsigned)__builtin_amdgcn_readfirstlane(vdst+(slot)))
  const int vb0=(int)(lds0+LDS_V)+((lane>>4)&1)*32+(lane&3)*8+(4*hi+((lane&15)>>2))*64;
  const char*Kbase=shm+LDS_K; bf16x8 kf[8];
  const lds_cptr shm3=(lds_cptr)shm; const lds_cptr kp0=shm3+LDS_K+hi*1024+r32*16; const lds_cptr vp0=shm3+LDS_V+((lane>>4)&1)*32+(lane&3)*8+(4*hi+((lane&15)>>2))*64;
  const int NT=U.NT;
  DMA_K(0,0);DMA_V(0,0);DMA_K(1,SLOTB);
  bf16x8 qr[4];
  #pragma unroll
  for(int d0=0;d0<4;++d0)qr[d0]=*reinterpret_cast<const bf16x8*>(&Qw[(long)r32*qp+d0*16+hi*8]);
  float mhat=0.f,l_reg=0.f;f32x16 o[2];o[0]=f32x16{};o[1]=f32x16{};
  const int qrel=wid*QBLK+r32;
  #define CMASK(P0,P1,t) do{int jb_=(t)-(NT-4); if(WINDOW||(CAUSAL&&jb_>=0))cmask<CAUSAL,WINDOW>(P0,P1,jb_,qrel,hi);}while(0)
  #define NB(t) (ALIBI?__builtin_fmaf(slope2,(float)(64*((t)-(NT-4))+4*hi-qrel),-mhat):-mhat)
  bool resc=false;
  #define START(P0,P1) do{ const float rm=rowmax(P0,P1); resc=false; \
    { const float dl=(rm==-INFINITY)?0.f:rm; mhat=fadd_s(mhat,dl); \
      _Pragma("unroll") for(int r=0;r<16;++r){P0[r]=fsub_s(P0[r],dl);P1[r]=fsub_s(P1[r],dl);} } \
    _Pragma("unroll") for(int r=0;r<16;++r)P0[r]=__builtin_amdgcn_exp2f(P0[r]); }while(0)
  #define RESC() do{ if(resc){ asm volatile("s_waitcnt lgkmcnt(0)":::"memory"); \
      _Pragma("unroll") for(int d_=0;d_<2;++d_) _Pragma("unroll") for(int r=0;r<16;++r)o[d_][r]*=wsf[crow(r,hi)]; } }while(0)
  f32x16 pA0,pA1,pB0,pB1;
  int sl_prev=0,sl_cur=0,sl_next=SLOTB;
  #define ROT() do{sl_prev=sl_cur;sl_cur=sl_next;sl_next=(sl_next==(NSLOT-1)*SLOTB)?0:sl_next+SLOTB;}while(0)
  DMA_K(2,2*SLOTB);
  WAIT_BAR(3);
  qkt(pA0,pA1,Kbase,qr,r32,hi);asm volatile("s_nop 15\n\ts_nop 7":"+v"(pA0),"+v"(pA1));alibi_keys<ALIBI>(pA0,pA1,slope2,NB(0));CMASK(pA0,pA1,0);
  START(pA0,pA1);
  _Pragma("unroll") for(int r=0;r<16;++r)pA1[r]=__builtin_amdgcn_exp2f(pA1[r]);
  WAIT_BAR(0);
  DMA_K(3,0);DMA_V(1,SLOTB);
  ROT();
  kload8(kf,kp0+sl_cur);
  WAIT_BAR(2);
  s16x4 vlo[8],vhi[8]; u32x4 pw0,pw1,pw2,pw3;
  #define PKW(P,B) cvtpk_s(P[B],P[B+1])
  #define PAF(k) __builtin_bit_cast(bf16x8,pw##k)
  #define VFR(i) (bf16x8){vlo[i][0],vlo[i][1],vlo[i][2],vlo[i][3],vhi[i][0],vhi[i][1],vhi[i][2],vhi[i][3]}
  #define PIN(x) asm volatile("":"+v"(x))
  #define MX3(a,b,c) __builtin_fmaxf(__builtin_fmaxf((a),(b)),(c))
  #define GAPA(MF,A0,A1,A2,A3,W0,W1,PW) do{ MF; sacc+=A0; sacc+=A1; sacc+=A2; sacc+=A3; PIN(sacc); W0; W1; PIN(PW); SBAR(); }while(0)
  #define EX(v) __builtin_amdgcn_exp2f(v)
  #define GAPB(MF,X,B) do{ MF; X[B]=EX(X[B]); X[B+1]=EX(X[B+1]); X[B+2]=EX(X[B+2]); X[B+3]=EX(X[B+3]); PIN(X); SBAR(); }while(0)
  #define VRD(i) do{ vlo[i]=vtr(vp_+(((i)>>2)*4096+((i)&3)*1024)); vhi[i]=vtr(vp_+(((i)>>2)*4096+((i)&3)*1024+512)); }while(0)
  #define KRD(G,j) do{ if(G){ kload2(kf,kp0+sl_next,j); SBAR(); } }while(0)
  #define STEP(C0,C1,P0,P1,t,GK,GV,GL) do{ SBAR(); \
    const lds_cptr vp_=vp0+sl_prev; \
    VRD(0); SBAR(); float sacc=(P0[0]+P0[1]); \
    GAPA(C0=__builtin_amdgcn_mfma_f32_32x32x16_bf16(kf[0],qr[0],f32x16{},0,0,0), P0[2],P0[3],P0[4],P0[5],     pw0[0]=PKW(P0,0), pw0[1]=PKW(P0,2), pw0); \
    VRD(4); SBAR(); GAPA(C1=__builtin_amdgcn_mfma_f32_32x32x16_bf16(kf[1],qr[0],f32x16{},0,0,0), P0[6],P0[7],P0[8],P0[9],     pw0[2]=PKW(P0,4), pw0[3]=PKW(P0,6), pw0); \
    VRD(1); SBAR(); GAPA(C0=__builtin_amdgcn_mfma_f32_32x32x16_bf16(kf[2],qr[1],C0,0,0,0),   P0[10],P0[11],P0[12],P0[13], pw1[0]=PKW(P0,8), pw1[1]=PKW(P0,10), pw1); \
    VRD(5); SBAR(); GAPA(C1=__builtin_amdgcn_mfma_f32_32x32x16_bf16(kf[3],qr[1],C1,0,0,0),   P0[14],P0[15],P1[0],P1[1],   pw1[2]=PKW(P0,12),pw1[3]=PKW(P0,14), pw1); \
    VRD(2); SBAR(); GAPA(C0=__builtin_amdgcn_mfma_f32_32x32x16_bf16(kf[4],qr[2],C0,0,0,0),   P1[2],P1[3],P1[4],P1[5],     pw2[0]=PKW(P1,0), pw2[1]=PKW(P1,2), pw2); \
    VRD(6); SBAR(); GAPA(C1=__builtin_amdgcn_mfma_f32_32x32x16_bf16(kf[5],qr[2],C1,0,0,0),   P1[6],P1[7],P1[8],P1[9],     pw2[2]=PKW(P1,4), pw2[3]=PKW(P1,6), pw2); \
    VRD(3); SBAR(); GAPA(C0=__builtin_amdgcn_mfma_f32_32x32x16_bf16(kf[6],qr[3],C0,0,0,0),   P1[10],P1[11],P1[12],P1[13], pw3[0]=PKW(P1,8), pw3[1]=PKW(P1,10), pw3); \
    VRD(7); SBAR(); GAPA(C1=__builtin_amdgcn_mfma_f32_32x32x16_bf16(kf[7],qr[3],C1,0,0,0),   P1[14],P1[15],0.f,0.f,       pw3[2]=PKW(P1,12),pw3[3]=PKW(P1,14), pw3); \
    l_reg+=sacc; \
    if(GK){DMA_K((t)+3,sl_cur);} if(GV){DMA_V((t)+1,sl_next);} \
    alibi_keys<ALIBI>(C0,C1,slope2,NB(t)); CMASK(C0,C1,t); \
    { float a=MX3(C0[0],C0[1],C1[0]),b=MX3(C0[2],C0[3],C1[1]); a=MX3(a,C1[2],C1[3]); \
      _Pragma("unroll") for(int r=4;r<16;r+=4){a=MX3(a,C0[r],C0[r+1]);b=MX3(b,C0[r+2],C0[r+3]);a=MX3(a,C1[r],C1[r+1]);b=MX3(b,C1[r+2],C1[r+3]);} \
      float rm=__builtin_fmaxf(a,b); { auto rr=__builtin_amdgcn_permlane32_swap(__float_as_uint(rm),__float_as_uint(rm),false,false); rm=__builtin_fmaxf(__uint_as_float(rr[0]),__uint_as_float(rr[1])); } \
      resc=false; \
      if(__builtin_expect(__any(rm>(float)THRL),0)){ const float dl=__builtin_fmaxf(rm,0.f); mhat+=dl; \
        _Pragma("unroll") for(int r=0;r<16;++r){C0[r]-=dl;C1[r]-=dl;} \
        const float f=__builtin_amdgcn_exp2f(-dl); l_reg*=f; if(hi==0)wsf[r32]=f; resc=true; } } \
    SBAR(); \
    GAPB(o[0]=__builtin_amdgcn_mfma_f32_32x32x16_bf16(PAF(0),VFR(0),o[0],0,0,0), C0,0); \
    GAPB(o[1]=__builtin_amdgcn_mfma_f32_32x32x16_bf16(PAF(0),VFR(4),o[1],0,0,0), C0,4); \
    KRD(GL,0); GAPB(o[0]=__builtin_amdgcn_mfma_f32_32x32x16_bf16(PAF(1),VFR(1),o[0],0,0,0), C0,8); \
    KRD(GL,1); GAPB(o[1]=__builtin_amdgcn_mfma_f32_32x32x16_bf16(PAF(1),VFR(5),o[1],0,0,0), C0,12); \
    KRD(GL,2); GAPB(o[0]=__builtin_amdgcn_mfma_f32_32x32x16_bf16(PAF(2),VFR(2),o[0],0,0,0), C1,0); \
    KRD(GL,3); GAPB(o[1]=__builtin_amdgcn_mfma_f32_32x32x16_bf16(PAF(2),VFR(6),o[1],0,0,0), C1,4); \
    GAPB(o[0]=__builtin_amdgcn_mfma_f32_32x32x16_bf16(PAF(3),VFR(3),o[0],0,0,0), C1,8); \
    GAPB(o[1]=__builtin_amdgcn_mfma_f32_32x32x16_bf16(PAF(3),VFR(7),o[1],0,0,0), C1,12); \
    }while(0)
  int t=1;
  #undef CMASK
  #define CMASK(P0,P1,t) do{}while(0)
  for(;t+5<NT;t+=2){
    STEP(pB0,pB1,pA0,pA1,t,true,true,true);     WAIT_BAR(2); RESC(); ROT();
    STEP(pA0,pA1,pB0,pB1,t+1,true,true,true);   WAIT_BAR(2); RESC(); ROT();
  }
  #undef CMASK
  #define CMASK(P0,P1,t) do{int jb_=(t)-(NT-4); if(WINDOW||(CAUSAL&&jb_>=0))cmask<CAUSAL,WINDOW>(P0,P1,jb_,qrel,hi);}while(0)
  #define ENDW(tt) do{ if((tt)+3<NT){WAIT_BAR(2);} else if((tt)+2<NT){WAIT_BAR(1);} else {WAIT_BAR(0);} }while(0)
  for(;t+1<NT;t+=2){
    STEP(pB0,pB1,pA0,pA1,t,(t+3<NT),(t+1<NT),(t+1<NT));       ENDW(t);   RESC(); ROT();
    STEP(pA0,pA1,pB0,pB1,t+1,(t+4<NT),(t+2<NT),(t+2<NT));     ENDW(t+1); RESC(); ROT();
  }
  STEP(pB0,pB1,pA0,pA1,NT-1,false,false,false); RESC();
  { float sacc=pB0[0]+pB0[1]; _Pragma("unroll") for(int r=2;r<16;++r)sacc+=pB0[r]; _Pragma("unroll") for(int r=0;r<16;++r)sacc+=pB1[r]; l_reg+=sacc;
    pw0=(u32x4){PKW(pB0,0),PKW(pB0,2),PKW(pB0,4),PKW(pB0,6)};pw1=(u32x4){PKW(pB0,8),PKW(pB0,10),PKW(pB0,12),PKW(pB0,14)};pw2=(u32x4){PKW(pB1,0),PKW(pB1,2),PKW(pB1,4),PKW(pB1,6)};pw3=(u32x4){PKW(pB1,8),PKW(pB1,10),PKW(pB1,12),PKW(pB1,14)};
    SBAR(); pv(o,vb0+sl_cur,PAF(0),PAF(1),PAF(2),PAF(3)); }
  #undef PKW
  #undef PAF
  #undef VFR
  #undef PIN
  #undef MX3
  #undef GAPA
  #undef GAPB
  #undef EX
  #undef VRD
  #undef KRD
  #undef STEP
  #undef ENDW
  {auto rr=__builtin_amdgcn_permlane32_swap(__float_as_uint(l_reg),__float_as_uint(l_reg),false,false);l_reg=__uint_as_float(rr[0])+__uint_as_float(rr[1]);}
  if(LSE){ if(hi==0)U.lse[(long)(q0+wid*QBLK+r32)*U.lse_stride]=mhat+__builtin_amdgcn_logf(l_reg); }
  if(hi==0)wsf[32+r32]=l_reg;asm volatile("s_waitcnt lgkmcnt(0)":::"memory");
  float rli[16];
  #pragma unroll
  for(int r=0;r<16;++r)rli[r]=__builtin_amdgcn_rcpf(wsf[32+crow(r,hi)]);
  bf16*Ow=U.O+(long)(q0+wid*QBLK)*op;
  { bf16*stg=(bf16*)(shm+LDS_OST)+wid*2048;
    #pragma unroll
    for(int r=0;r<16;++r){const int orow=crow(r,hi);
      #pragma unroll
      for(int d0=0;d0<2;++d0)stg[orow*64+d0*32+r32]=__float2bfloat16(o[d0][r]*rli[r]);}
    asm volatile("s_waitcnt lgkmcnt(0)":::"memory");
    #pragma unroll
    for(int i=0;i<4;++i){const int row=i*8+(lane>>3),ch=lane&7; const u32x4 v=*(const u32x4*)(stg+row*64+ch*8); ATTN_STORE16(Ow+(long)row*op+ch*8,v);} }
  asm volatile("s_waitcnt lgkmcnt(0)\n\ts_barrier":::"memory");
  #undef DMA_K
  #undef DMA_V
  #undef CMASK
  #undef START
  #undef RESC
  #undef ROT
  #undef NB
}
constexpr int ATTN_LDS_BYTES=LDS_BYTES;
#undef SBAR
#undef WAIT_BAR
}
constexpr size_t MiB = 1u << 20;
constexpr size_t WS_CTL = 0, CTL_ZERO_BYTES = 1 * MiB;
constexpr size_t WS_LIST = 1 * MiB;
constexpr size_t WS_RGATE = 5 * MiB;
constexpr size_t WS_RSTD1 = 5 * MiB + 512 * 1024, WS_RSTD2 = WS_RSTD1 + 128 * 1024, WS_WRG = WS_RSTD2 + 128 * 1024;
constexpr size_t WS_LSE = 6 * MiB;
constexpr size_t WS_MKV = 8 * MiB;
constexpr size_t WS_WIN = 10 * MiB, WS_WOUT = 15 * MiB, WS_WGU = 17 * MiB, WS_WDN = 145 * MiB;
constexpr size_t WS_XB = 209 * MiB;
constexpr size_t WS_P = 273 * MiB, WS_OD = 433 * MiB, WS_ODIL = 497 * MiB;
constexpr size_t WS_ACT = 273 * MiB;
constexpr size_t WS_MIX = 545 * MiB, WS_X1B = 609 * MiB, WS_YB = 673 * MiB, WS_END = 929 * MiB;
constexpr int CW_TMO = 0, CW_CODE = 1;
constexpr int CW_CNT = 64;
constexpr int CW_BAR = 4096;

constexpr int RING_OFF = 0, RING_BYTES = 131072;
constexpr int LDSCTL_OFF = RING_BYTES;
constexpr int IDB_OFF = LDSCTL_OFF;
constexpr int TBL_OFF = IDB_OFF + 3072;
constexpr int LCNT_OFF = TBL_OFF + 2304;
constexpr int MISC_OFF = LCNT_OFF + 256;
constexpr int STG_OFF = MISC_OFF + 128;
constexpr int LDS_BYTES = 147456;
static_assert(STG_OFF + 512 * 12 <= LDS_BYTES, "LDS map");
constexpr int NWAVES = 8;

#define GAS __attribute__((address_space(1)))
#define LAS __attribute__((address_space(3)))
typedef unsigned short bf16;
typedef unsigned v4u __attribute__((ext_vector_type(4)));
typedef unsigned v2u __attribute__((ext_vector_type(2)));
typedef float f32x4 __attribute__((ext_vector_type(4)));
typedef float f32x16 __attribute__((ext_vector_type(16)));
typedef short bf16x8 __attribute__((ext_vector_type(8)));
typedef GAS unsigned gu32;
#define RLX_AGENT __ATOMIC_RELAXED, __HIP_MEMORY_SCOPE_AGENT
#define LDS_WAIT() asm volatile("s_waitcnt lgkmcnt(0)" ::: "memory")
#define VM_WAIT() asm volatile("s_waitcnt vmcnt(0)" ::: "memory")
__device__ __forceinline__ unsigned f2bf(float f) { unsigned u = __builtin_bit_cast(unsigned, f); return (u + 0x7fffu + ((u >> 16) & 1u)) >> 16; }
__device__ __forceinline__ unsigned pk2(float lo, float hi) { return f2bf(lo) | (f2bf(hi) << 16); }
__device__ __forceinline__ float bf2f(unsigned short b) { return __builtin_bit_cast(float, (unsigned)b << 16); }
__device__ __forceinline__ float bflo(unsigned w) { return __builtin_bit_cast(float, w << 16); }
__device__ __forceinline__ float bfhi(unsigned w) { return __builtin_bit_cast(float, w & 0xffff0000u); }
__device__ __forceinline__ float wave_sum(float v) {
#pragma unroll
    for (int o = 1; o < 64; o <<= 1) v += __shfl_xor(v, o);
    return v;
}

#define XB_TMO      128
#define XB_XCNT(j)  (256  + 64 * (j))
#define XB_XSUB(j)  (1280 + 64 * (j))
#define XB_XGEN(j)  (2304 + 64 * (j))
#define XB_TOP      3328
#define XB_TOPGEN   3392
#define XCD_BAR_WORDS 3456
#define XB_SPIN_CAP (1u << 20)
__device__ __forceinline__ unsigned xb_ld(unsigned* p)              { return __hip_atomic_load(p, __ATOMIC_RELAXED, __HIP_MEMORY_SCOPE_AGENT); }
__device__ __forceinline__ unsigned xb_add(unsigned* p, unsigned v) { return __hip_atomic_fetch_add(p, v, __ATOMIC_RELAXED, __HIP_MEMORY_SCOPE_AGENT); }
__device__ __forceinline__ unsigned xb_xcc_id() { return (unsigned)__builtin_amdgcn_s_getreg((3 << 11) | 20) & 0xFu; }
#define XB_SPIN(cond, bar) do { unsigned _sp = 0; while (cond) { __builtin_amdgcn_s_sleep(1); \
    if ((++_sp & 255u) == 0u) { if (xb_ld(&(bar)[XB_TMO])) break; if (_sp > XB_SPIN_CAP) { atomicAdd(&(bar)[XB_TMO], 1u); break; } } } } while (0)
struct XcdBarrier { unsigned* bar; unsigned x; volatile LAS unsigned* st; };
__device__ __forceinline__ XcdBarrier xcd_barrier_post(unsigned* bar, volatile LAS unsigned* st) {
    XcdBarrier b; b.bar = bar; b.x = xb_xcc_id(); b.st = st;
    if (threadIdx.x == 0) (void)xb_add(&bar[XB_XCNT(b.x)], 1u);
    return b;
}
__device__ __forceinline__ void xcd_barrier_complete(unsigned* bar, unsigned x, unsigned& nloc, unsigned& nx) {
    const unsigned G = gridDim.x * gridDim.y * gridDim.z;
    unsigned sum, cnt, mine, sp = 0u;
    for (;;) {
        sum = 0u; cnt = 0u; mine = 0u;
#pragma unroll
        for (unsigned j = 0; j < 16; ++j) { const unsigned c = xb_ld(&bar[XB_XCNT(j)]); sum += c; cnt += (c > 0u) ? 1u : 0u; mine = (j == x) ? c : mine; }
        if (sum == G) break;
        __builtin_amdgcn_s_sleep(1);
        if ((++sp & 255u) == 0u) { if (xb_ld(&bar[XB_TMO])) break; if (sp > XB_SPIN_CAP) { atomicAdd(&bar[XB_TMO], 1u); break; } }
    }
    nloc = mine > 0u ? mine : 1u; nx = cnt > 0u ? cnt : 1u;
}
__device__ __forceinline__ void xcd_barrier(const XcdBarrier& b) {
    asm volatile("s_waitcnt vmcnt(0)" ::: "memory");
    __syncthreads();
    if (threadIdx.x == 0) {
        unsigned* bar = b.bar;
        __builtin_amdgcn_s_waitcnt(0);
        unsigned nloc = b.st[0], nx = b.st[1];
        if (nloc == 0u) { xcd_barrier_complete(bar, b.x, nloc, nx); b.st[0] = nloc; b.st[1] = nx; }
        const unsigned old = xb_add(&bar[XB_XSUB(b.x)], 1u);
        const unsigned gen = old / nloc;
        if (old + 1u == (gen + 1u) * nloc) {
            __builtin_amdgcn_fence(__ATOMIC_RELEASE, "agent");
            asm volatile("s_waitcnt vmcnt(0)" ::: "memory");
            const unsigned og = xb_add(&bar[XB_TOP], 1u);
            const unsigned tg = og / nx;
            if (og + 1u == (tg + 1u) * nx) xb_add(&bar[XB_TOPGEN], 1u);
            else XB_SPIN(xb_ld(&bar[XB_TOPGEN]) == tg, bar);
            __builtin_amdgcn_fence(__ATOMIC_ACQUIRE, "agent");
            xb_add(&bar[XB_XGEN(b.x)], 1u);
            asm volatile("s_waitcnt vmcnt(0)" ::: "memory");
        } else {
            XB_SPIN(xb_ld(&bar[XB_XGEN(b.x)]) == gen, bar);
            __builtin_amdgcn_fence(__ATOMIC_ACQUIRE, "agent");
            asm volatile("s_waitcnt vmcnt(0)" ::: "memory");
        }
    }
    __syncthreads();
}

struct Frame {
    LAS unsigned char* lds;
    volatile LAS unsigned* MISC;
    gu32* ctl;
    int tid, lane, wave;
    int vcu, G;
    const float *x, *mem, *g_attn, *g_mem, *w_in, *lamqk, *subg, *w_mkv, *w_out, *g_ffn, *w_r, *b_r, *w_gu, *b_gu, *w_dn, *b_dn, *g_fin;
    float* out; unsigned char* ws;
};

template <class RowMap>
__device__ __forceinline__ void p0_transpose_item(const float* W, int K, int N, bf16* WT, const float* gk, LAS float* scr, int item, int lane, RowMap rowmap) {
    const int nblk = N / 32, kb = item / nblk, nb = item % nblk, k0 = 64 * kb, n0 = 32 * nb;
#pragma unroll 8
    for (int i = 0; i < 32; ++i) { const int kk = 2 * i + (lane >> 5); float v = W[(size_t)(k0 + kk) * N + n0 + (lane & 31)]; if (gk) v *= gk[k0 + kk]; scr[kk * 33 + (lane & 31)] = v; }
    LDS_WAIT(); asm volatile("" ::: "memory");
    const int c = lane & 7;
#pragma unroll
    for (int j = 0; j < 4; ++j) { const int n = (lane >> 3) + 8 * j; const LAS float* s = scr + (8 * c) * 33 + n;
        v4u o; o.x = pk2(s[0 * 33], s[1 * 33]); o.y = pk2(s[2 * 33], s[3 * 33]); o.z = pk2(s[4 * 33], s[5 * 33]); o.w = pk2(s[6 * 33], s[7 * 33]);
        *(GAS v4u*)(WT + (size_t)rowmap(n0 + n) * K + k0 + 8 * c) = o; }
    LDS_WAIT(); asm volatile("" ::: "memory");
}
struct RowId { __device__ __forceinline__ int operator()(int n) const { return n; } };
struct RowGU { __device__ __forceinline__ int operator()(int n) const { const int f = n >> 1, u = n & 1; return ((f >> 7) << 8) + (u << 7) + (f & 127); } };

__device__ __forceinline__ void p0_x_row(Frame& F, const float* xrow, bf16* orow, float* rstd_out) {
    const GAS f32x4* xr = (const GAS f32x4*)xrow + F.lane;
    f32x4 v[4]; float s = 0.f;
#pragma unroll
    for (int j = 0; j < 4; ++j) { v[j] = xr[64 * j]; s += (v[j].x * v[j].x + v[j].y * v[j].y) + (v[j].z * v[j].z + v[j].w * v[j].w); }
    const float rstd = 1.f / sqrtf(wave_sum(s) * (1.f / D) + EPS);
    GAS unsigned long long* o8 = (GAS unsigned long long*)orow + F.lane;
#pragma unroll
    for (int j = 0; j < 4; ++j) o8[64 * j] = (unsigned long long)pk2(v[j].x, v[j].y) | ((unsigned long long)pk2(v[j].z, v[j].w) << 32);
    if (F.lane == 0) *rstd_out = rstd;
}
__device__ __forceinline__ void p0_mkv_tile(Frame& F, int tile, bf16* mkv) {
    const int mt = tile >> 4, nt = tile & 15, m0 = 32 * mt, n0 = 32 * nt, r = F.lane & 31, h = F.lane >> 5;
    f32x16 acc = {}; float ss = 0.f;
    const float* mrow = F.mem + (size_t)(m0 + r) * D + 8 * h;
    const float* wcol = F.w_mkv + (size_t)(8 * h) * 512 + n0 + r;
    const float* gp = F.g_mem + 8 * h;
    for (int k0 = 0; k0 < D; k0 += 16) {
        const f32x4 a0 = *(const f32x4*)(mrow + k0), a1 = *(const f32x4*)(mrow + k0 + 4);
        const f32x4 g0 = *(const f32x4*)(gp + k0), g1 = *(const f32x4*)(gp + k0 + 4);
        ss += (a0.x * a0.x + a0.y * a0.y) + (a0.z * a0.z + a0.w * a0.w) + (a1.x * a1.x + a1.y * a1.y) + (a1.z * a1.z + a1.w * a1.w);
        v4u bw; bw.x = pk2(a0.x * g0.x, a0.y * g0.y); bw.y = pk2(a0.z * g0.z, a0.w * g0.w); bw.z = pk2(a1.x * g1.x, a1.y * g1.y); bw.w = pk2(a1.z * g1.z, a1.w * g1.w);
        float wv[8];
#pragma unroll
        for (int j = 0; j < 8; ++j) wv[j] = wcol[(size_t)(k0 + j) * 512];
        v4u aw; aw.x = pk2(wv[0], wv[1]); aw.y = pk2(wv[2], wv[3]); aw.z = pk2(wv[4], wv[5]); aw.w = pk2(wv[6], wv[7]);
        acc = __builtin_amdgcn_mfma_f32_32x32x16_bf16(__builtin_bit_cast(bf16x8, aw), __builtin_bit_cast(bf16x8, bw), acc, 0, 0, 0);
    }
    ss += __shfl_xor(ss, 32);
    const float rstd = 1.f / sqrtf(ss * (1.f / D) + EPS);
    bf16* orow = mkv + (size_t)(m0 + r) * 512 + n0 + 4 * h;
#pragma unroll
    for (int q = 0; q < 4; ++q) { v2u o; o.x = pk2(acc[4 * q] * rstd, acc[4 * q + 1] * rstd); o.y = pk2(acc[4 * q + 2] * rstd, acc[4 * q + 3] * rstd); *(GAS v2u*)(orow + 8 * q) = o; }
}
__device__ __forceinline__ void p0_prologue(Frame& F) {
    LAS float* scr = (LAS float*)(F.lds + RING_OFF + F.wave * 16384);
    const int gw = F.vcu * NWAVES + F.wave, NGW = F.G * NWAVES;
    bf16* win_t = (bf16*)(F.ws + WS_WIN); bf16* wout_t = (bf16*)(F.ws + WS_WOUT); bf16* wgu_t = (bf16*)(F.ws + WS_WGU); bf16* wdn_t = (bf16*)(F.ws + WS_WDN);
    constexpr int I_IN = (D / 64) * (DIN / 32), I_OUT = (D / 64) * (D / 32), I_GU1 = (D / 64) * (2 * DFF / 32), I_DN1 = (DFF / 64) * (D / 32);
    constexpr int NITEMS = I_IN + I_OUT + NE * I_GU1 + NE * I_DN1;
    for (int it = gw; it < NITEMS; it += NGW) {
        int r = it;
        if (r < I_IN) { p0_transpose_item(F.w_in, D, DIN, win_t, F.g_attn, scr, r, F.lane, RowId()); continue; } r -= I_IN;
        if (r < I_OUT) { p0_transpose_item(F.w_out, D, D, wout_t, nullptr, scr, r, F.lane, RowId()); continue; } r -= I_OUT;
        if (r < NE * I_GU1) { const int e = r / I_GU1; p0_transpose_item(F.w_gu + (size_t)e * D * 2 * DFF, D, 2 * DFF, wgu_t + (size_t)e * 2 * DFF * D, F.g_ffn, scr, r % I_GU1, F.lane, RowGU()); continue; } r -= NE * I_GU1;
        { const int e = r / I_DN1; p0_transpose_item(F.w_dn + (size_t)e * DFF * D, DFF, D, wdn_t + (size_t)e * D * DFF, nullptr, scr, r % I_DN1, F.lane, RowId()); }
    }
    bf16* xb = (bf16*)(F.ws + WS_XB); float* rstd1 = (float*)(F.ws + WS_RSTD1);
    for (int m = gw; m < T; m += NGW) p0_x_row(F, F.x + (size_t)m * D, xb + (size_t)m * D, rstd1 + m);
    bf16* mkv = (bf16*)(F.ws + WS_MKV);
    for (int t = gw; t < (BATCH * NMEM / 32) * (512 / 32); t += NGW) p0_mkv_tile(F, t, mkv);
    float* wrg = (float*)(F.ws + WS_WRG);
    for (int i = gw * 64 + F.lane; i < D * NE; i += NGW * 64) wrg[i] = F.w_r[i] * F.g_ffn[i >> 5];
}

struct EpiInProj {
    bf16* O; const float* rstd;
    __device__ __forceinline__ void operator()(const pg8::f32x4 (&acc)[2][2][4][2], const pg8::Unit& u, int wr, int wc, int fr, int fq, const LAS unsigned*) const {
        const int row0 = u.pm * 256 + wr * 64 + fr, col0 = u.pn * 256 + wc * 32 + 8 * fq;
        const float sc = (u.pn <= 1 || u.pn == 6 || u.pn == 9) ? QSCALE : 1.f;
        float rsv[2][4];
#pragma unroll
        for (int ai = 0; ai < 2; ++ai)
#pragma unroll
            for (int m = 0; m < 4; ++m) rsv[ai][m] = rstd[row0 + ai * 128 + m * 16];
#pragma unroll
        for (int ai = 0; ai < 2; ++ai)
#pragma unroll
            for (int m = 0; m < 4; ++m) { const int row = row0 + ai * 128 + m * 16; const float rs = rsv[ai][m] * sc; bf16* rowp = O + (size_t)row * DIN + col0;
#pragma unroll
                for (int bj = 0; bj < 2; ++bj) { const pg8::f32x4 v0 = acc[ai][bj][m][0] * rs, v1 = acc[ai][bj][m][1] * rs;
                    v4u w; w.x = pg8::cvt_pk_bf16(v0[0], v0[1]); w.y = pg8::cvt_pk_bf16(v0[2], v0[3]); w.z = pg8::cvt_pk_bf16(v1[0], v1[1]); w.w = pg8::cvt_pk_bf16(v1[2], v1[3]);
                    *(v4u*)(rowp + bj * 128) = w; } }
    }
};
__device__ __forceinline__ void attn_phase(Frame& F, char* shm) {
    using namespace attn_body;
    const int v = F.vcu;
    const attn_body::bf16* P = (const attn_body::bf16*)(F.ws + WS_P);
    attn_body::bf16* OD = (attn_body::bf16*)(F.ws + WS_OD);
    attn_body::bf16* mix = (attn_body::bf16*)(F.ws + WS_MIX);
    float lam;
    { const float a = F.lamqk[F.lane] * F.lamqk[64 + F.lane], c = F.lamqk[128 + F.lane] * F.lamqk[192 + F.lane];
      lam = __expf(wave_sum(a)) - __expf(wave_sum(c)) + 0.2f; }
#if !defined(ATT_ONLY) || ATT_ONLY==1
    if (v < BATCH * 4 * 8) {
        const int bh = v >> 3, s = v & 7, b = bh >> 2, h = bh & 3;
        const attn_body::bf16* Pb = P + (size_t)b * SEQ * DIN;
        const float slope = exp2f(-(float)(2 * h + 1)) * LOG2E;
        for (int i2 = 0; i2 < 2; ++i2) {
            const int qb = i2 ? 15 - s : s;
            for (int pass = 0; pass < 4; ++pass) {
                const int j = pass >> 1, vh = pass & 1;
                UnitP U; U.Q = Pb + C_DQ + h * 128 + j * 64; U.K = Pb + C_DK + h * 128 + j * 64; U.V = Pb + C_DV + h * 128 + vh * 64;
                U.O = OD + (size_t)b * SEQ * 1024 + h * 256 + j * 128 + vh * 64; U.qp = DIN; U.kp = DIN; U.op = 1024;
                U.q0 = qb * 256; U.t0 = 0; U.NT = 4 * qb + 4; U.slope2 = slope; U.lse = nullptr; U.lse_stride = 0;
                attn_unit<8, true, false, true, false>(U, shm);
            }
            asm volatile("s_waitcnt vmcnt(0)" ::: "memory");
            const int row = (b * SEQ + qb * 256 + F.wave * 32 + (F.lane >> 1)), vh = F.lane & 1;
            const v4u* o1 = (const v4u*)(OD + (size_t)row * 1024 + h * 256 + vh * 64);
            const v4u* o2 = (const v4u*)(OD + (size_t)row * 1024 + h * 256 + 128 + vh * 64);
            float d[64]; float ss = 0.f;
#pragma unroll
            for (int c = 0; c < 8; ++c) { const v4u a = o1[c], bq = o2[c];
                const unsigned aw[4] = {a.x, a.y, a.z, a.w}, bw[4] = {bq.x, bq.y, bq.z, bq.w};
#pragma unroll
                for (int q = 0; q < 4; ++q) { const float x0 = bflo(aw[q]) - lam * bflo(bw[q]), x1 = bfhi(aw[q]) - lam * bfhi(bw[q]); d[8 * c + 2 * q] = x0; d[8 * c + 2 * q + 1] = x1; ss += x0 * x0 + x1 * x1; } }
            ss += __shfl_xor(ss, 1);
            const float rstd = 0.8f / sqrtf(ss * (1.f / 128.f) + EPS);
            const float* gp = F.subg + vh * 64;
            v4u* mo = (v4u*)(mix + (size_t)row * 1024 + h * 128 + vh * 64);
#pragma unroll
            for (int c = 0; c < 8; ++c) { v4u o; o.x = pk2(d[8 * c] * rstd * gp[8 * c], d[8 * c + 1] * rstd * gp[8 * c + 1]); o.y = pk2(d[8 * c + 2] * rstd * gp[8 * c + 2], d[8 * c + 3] * rstd * gp[8 * c + 3]);
                o.z = pk2(d[8 * c + 4] * rstd * gp[8 * c + 4], d[8 * c + 5] * rstd * gp[8 * c + 5]); o.w = pk2(d[8 * c + 6] * rstd * gp[8 * c + 6], d[8 * c + 7] * rstd * gp[8 * c + 7]); mo[c] = o; }
        }
    }
#endif
#if !defined(ATT_ONLY) || ATT_ONLY==2
    attn_body::bf16* ODIL = (attn_body::bf16*)(F.ws + WS_ODIL); float* LSEb = (float*)(F.ws + WS_LSE);
    for (int i = 0; i < 6; ++i) {
        const int du = v * 6 + i; if (du >= BATCH * 4 * 48) break;
        const int bh = du / 48, idx = du % 48, n = idx >> 4, w = idx & 15, b = bh >> 2, h = bh & 3;
        const int r = (n == 0) ? 1 : (n == 1 ? 4 : 16), c = (n == 0) ? 0 : (n == 1 ? (w >> 2) : w), blk = (n == 0) ? w : (n == 1 ? (w & 3) : 0);
        const attn_body::bf16* Pb = P + ((size_t)b * SEQ + c) * DIN;
        UnitP U; U.Q = Pb + C_LQ + h * 64; U.K = Pb + C_LK + h * 64; U.V = Pb + C_LV + h * 64; U.qp = (long)r * DIN; U.kp = (long)r * DIN;
        U.O = ODIL + (size_t)n * T * 256 + ((size_t)b * SEQ + c) * 256 + h * 64; U.op = (long)r * 256;
        U.q0 = blk * 256; U.t0 = (blk == 0) ? 0 : 4 * blk - 2; U.NT = 4 * blk + 4 - U.t0;
        U.slope2 = exp2f(-(float)(2 * h + 2)) * (float)r * LOG2E;
        U.lse = LSEb + (size_t)n * T * 4 + ((size_t)b * SEQ + c) * 4 + h; U.lse_stride = r * 4;
        attn_unit<8, true, true, true, true>(U, shm);
    }
#endif
#if !defined(ATT_ONLY) || ATT_ONLY==3
    const attn_body::bf16* MKV = (const attn_body::bf16*)(F.ws + WS_MKV);
    for (int i = 0; i < 2; ++i) {
        const int mu = v * 2 + i; if (mu >= BATCH * 4 * 16) break;
        const int bh = mu >> 4, qb = mu & 15, b = bh >> 2, h = bh & 3;
        UnitP U; U.Q = P + (size_t)b * SEQ * DIN + C_MQ + h * 64; U.qp = DIN; U.K = MKV + (size_t)b * NMEM * 512 + h * 64; U.V = U.K + 256; U.kp = 512;
        U.O = mix + (size_t)b * SEQ * 1024 + 768 + h * 64; U.op = 1024; U.q0 = qb * 256; U.t0 = 0; U.NT = 4; U.slope2 = 0.f; U.lse = nullptr; U.lse_stride = 0;
        attn_unit<8, false, false, false, false>(U, shm);
    }
#endif
}
__device__ __forceinline__ void dil_combine_phase(Frame& F) {
    const int gw = F.vcu * NWAVES + F.wave, NGW = F.G * NWAVES;
    const bf16* ODIL = (const bf16*)(F.ws + WS_ODIL); const float* LSEb = (const float*)(F.ws + WS_LSE); bf16* mix = (bf16*)(F.ws + WS_MIX);
    const int h = F.lane >> 4, d4 = (F.lane & 15) * 4;
    for (int row = gw; row < T; row += NGW) {
        float l[3], m = -INFINITY;
#pragma unroll
        for (int n = 0; n < 3; ++n) { l[n] = LSEb[(size_t)n * T * 4 + (size_t)row * 4 + h]; m = fmaxf(m, l[n]); }
        float wn[3], den = 0.f;
#pragma unroll
        for (int n = 0; n < 3; ++n) { wn[n] = exp2f(l[n] - m); den += wn[n]; }
        const float inv = 1.f / den; float o[4] = {0.f, 0.f, 0.f, 0.f};
#pragma unroll
        for (int n = 0; n < 3; ++n) { const v2u q = *(const v2u*)(ODIL + (size_t)n * T * 256 + (size_t)row * 256 + h * 64 + d4); const float wq = wn[n] * inv;
            o[0] += wq * bflo(q.x); o[1] += wq * bfhi(q.x); o[2] += wq * bflo(q.y); o[3] += wq * bfhi(q.y); }
        v2u ov; ov.x = pk2(o[0], o[1]); ov.y = pk2(o[2], o[3]);
        *(v2u*)(mix + (size_t)row * 1024 + 512 + h * 64 + d4) = ov;
    }
}
struct EpiOutProj {
    const float* X; float* O; bf16* XB;
    __device__ __forceinline__ void operator()(const pg8::f32x4 (&acc)[2][2][4][2], const pg8::Unit& u, int wr, int wc, int fr, int fq, const LAS unsigned*) const {
        const int row0 = u.pm * 256 + wr * 64 + fr, col0 = u.pn * 256 + wc * 32 + 8 * fq;
#pragma unroll
        for (int ai = 0; ai < 2; ++ai) {
            pg8::f32x4 xv[4][2][2];
#pragma unroll
            for (int m = 0; m < 4; ++m)
#pragma unroll
                for (int bj = 0; bj < 2; ++bj)
#pragma unroll
                    for (int n = 0; n < 2; ++n) xv[m][bj][n] = *(const pg8::f32x4*)(X + (size_t)(row0 + ai * 128 + m * 16) * D + col0 + bj * 128 + 4 * n);
#pragma unroll
            for (int m = 0; m < 4; ++m) { const size_t ro = (size_t)(row0 + ai * 128 + m * 16) * D + col0;
#pragma unroll
                for (int bj = 0; bj < 2; ++bj) { const pg8::f32x4 v0 = xv[m][bj][0] + acc[ai][bj][m][0], v1 = xv[m][bj][1] + acc[ai][bj][m][1];
                    *(pg8::f32x4*)(O + ro + bj * 128) = v0; *(pg8::f32x4*)(O + ro + bj * 128 + 4) = v1;
                    v4u w; w.x = pg8::cvt_pk_bf16(v0[0], v0[1]); w.y = pg8::cvt_pk_bf16(v0[2], v0[3]); w.z = pg8::cvt_pk_bf16(v1[0], v1[1]); w.w = pg8::cvt_pk_bf16(v1[2], v1[3]);
                    *(v4u*)(XB + ro + bj * 128) = w; } }
        }
    }
};

__device__ __forceinline__ void route_phase(Frame& F) {
    LAS float* wl = (LAS float*)(F.lds + RING_OFF);
    LAS unsigned* lcnt = (LAS unsigned*)(F.lds + LCNT_OFF);
    LAS unsigned* stg = (LAS unsigned*)(F.lds + STG_OFF);
    const float* wrg = (const float*)(F.ws + WS_WRG);
    for (int i = F.tid; i < D * 8; i += NWAVES * 64) { const int c = i >> 3, q = i & 7; const f32x4 w = *(const f32x4*)(wrg + c * 32 + q * 4);
        *(LAS f32x4*)((LAS char*)wl + c * 128 + (((q + (c >> 1)) & 7) << 4)) = w; }
    if (F.tid < 64) lcnt[F.tid] = 0u;
    __syncthreads();
    const float* x1 = F.out; float* rstd2 = (float*)(F.ws + WS_RSTD2);
    const int lane = F.lane, half = lane >> 5, el = lane & 31;
    const float bre = F.b_r[el];
    for (int it = 0; it < 8; ++it) {
        const int tl = F.wave * 16 + 2 * it, tokA = F.vcu * 128 + tl;
        const float* xa = x1 + (size_t)tokA * D; const float* xb = xa + D;
        float xA[16], xB[16]; float ssA = 0.f, ssB = 0.f;
#pragma unroll
        for (int jj = 0; jj < 16; ++jj) { xA[jj] = xa[lane + 64 * jj]; xB[jj] = xb[lane + 64 * jj]; }
#pragma unroll
        for (int jj = 0; jj < 16; ++jj) { ssA += xA[jj] * xA[jj]; ssB += xB[jj] * xB[jj]; }
        float vals[64];
#pragma unroll
        for (int e = 0; e < 64; ++e) vals[e] = 0.f;
#pragma unroll
        for (int jj = 0; jj < 16; ++jj) { const int c = lane + 64 * jj; const LAS char* rowp = (const LAS char*)wl + c * 128; const int rot = c >> 1;
#pragma unroll
            for (int q = 0; q < 8; ++q) { const f32x4 w = *(const LAS f32x4*)(rowp + (((q + rot) & 7) << 4));
                vals[4 * q] += xA[jj] * w.x; vals[4 * q + 1] += xA[jj] * w.y; vals[4 * q + 2] += xA[jj] * w.z; vals[4 * q + 3] += xA[jj] * w.w;
                vals[32 + 4 * q] += xB[jj] * w.x; vals[32 + 4 * q + 1] += xB[jj] * w.y; vals[32 + 4 * q + 2] += xB[jj] * w.z; vals[32 + 4 * q + 3] += xB[jj] * w.w; } }
        ssA = wave_sum(ssA); ssB = wave_sum(ssB);
        const float rA = 1.f / sqrtf(ssA * (1.f / D) + EPS), rB = 1.f / sqrtf(ssB * (1.f / D) + EPS);
#define RS_STEP(o, n) do { const bool up_ = (lane & (o)) != 0; _Pragma("unroll") for (int i_ = 0; i_ < (n) / 2; ++i_) { \
            const float mine_ = up_ ? vals[i_ + (n) / 2] : vals[i_], oth_ = up_ ? vals[i_] : vals[i_ + (n) / 2]; vals[i_] = mine_ + __shfl_xor(oth_, (o)); } } while (0)
        RS_STEP(32, 64); RS_STEP(16, 32); RS_STEP(8, 16); RS_STEP(4, 8); RS_STEP(2, 4); RS_STEP(1, 2);
#undef RS_STEP
        float lg = vals[0] * (half ? rB : rA) + bre;
        int te[4]; float tv[4];
#pragma unroll
        for (int k = 0; k < 4; ++k) {
            float bv = lg; int bi = el;
#pragma unroll
            for (int o = 16; o > 0; o >>= 1) { const float ov = __shfl_xor(bv, o); const int oi = __shfl_xor(bi, o); if (ov > bv || (ov == bv && oi < bi)) { bv = ov; bi = oi; } }
            te[k] = bi; tv[k] = bv; if (el == bi) lg = -INFINITY;
        }
        float gk[4], den = 0.f;
#pragma unroll
        for (int k = 0; k < 4; ++k) { gk[k] = __expf(tv[k] - tv[0]); den += gk[k]; }
        const float inv = 1.f / den;
        if (el < 4) {
            const int e = (el == 0) ? te[0] : (el == 1) ? te[1] : (el == 2) ? te[2] : te[3];
            const float g = ((el == 0) ? gk[0] : (el == 1) ? gk[1] : (el == 2) ? gk[2] : gk[3]) * inv;
            const unsigned rank = __hip_atomic_fetch_add(lcnt + e, 1u, __ATOMIC_RELAXED, __HIP_MEMORY_SCOPE_WORKGROUP);
            const int slot = (tl + half) * 4 + el;
            stg[slot * 3] = (unsigned)((tokA + half) * 4 + el); stg[slot * 3 + 1] = ((unsigned)e << 16) | rank; stg[slot * 3 + 2] = __builtin_bit_cast(unsigned, g);
        }
        if (el == 0) rstd2[tokA + half] = half ? rB : rA;
    }
    __syncthreads();
    if (F.tid < 32) { const unsigned n = lcnt[F.tid]; lcnt[32 + F.tid] = n ? __hip_atomic_fetch_add((unsigned*)(F.ctl + CW_CNT) + F.tid, n, __ATOMIC_RELAXED, __HIP_MEMORY_SCOPE_AGENT) : 0u; }
    __syncthreads();
    { unsigned* list = (unsigned*)(F.ws + WS_LIST); float* rgate = (float*)(F.ws + WS_RGATE);
      const unsigned ent = stg[F.tid * 3], er = stg[F.tid * 3 + 1], gb = stg[F.tid * 3 + 2]; const unsigned e = er >> 16, rank = er & 0xffffu;
      list[(size_t)e * LCAP + lcnt[32 + e] + rank] = ent; rgate[ent] = __builtin_bit_cast(float, gb); }
    __syncthreads();
}

__device__ __forceinline__ int moe_build_table(Frame& F) {
    LAS unsigned* tbl = (LAS unsigned*)(F.lds + TBL_OFF); LAS unsigned* lcnt = (LAS unsigned*)(F.lds + LCNT_OFF);
    if (F.wave == 0) {
        const int e = F.lane & 31;
        const unsigned cnt = __hip_atomic_load((unsigned*)(F.ctl + CW_CNT) + e, __ATOMIC_RELAXED, __HIP_MEMORY_SCOPE_AGENT);
        const unsigned nt = (cnt + 255u) >> 8; unsigned incl = nt;
#pragma unroll
        for (int o = 1; o < 32; o <<= 1) { const unsigned t = __shfl_up(incl, o); if ((F.lane & 31) >= o) incl += t; }
        if (F.lane < 32) { lcnt[e] = cnt; const unsigned start = incl - nt; for (unsigned j = 0; j < nt; ++j) tbl[start + j] = ((unsigned)e << 16) | j; if (F.lane == 31) F.MISC[16] = incl; }
    }
    __syncthreads();
    return (int)F.MISC[16];
}
struct MoeOrder {
    const LAS unsigned* tbl; const LAS unsigned* lcnt; const unsigned* list; int NMT, G, c, NPN, MPER, K; size_t bexp; bool a_tiles;
    __device__ __forceinline__ bool next(int i, pg8::Unit& u) const {
        const int L = i * G + c, blk = L >> 5, w = L & 31, g = blk * MPER + w / NPN, pn = w % NPN;
        if (g >= NMT) return false;
        const unsigned t = tbl[g]; const int e = (int)(t >> 16), mt = (int)(t & 0xffffu); const int cnt = (int)lcnt[e];
        u.pm = g; u.pn = pn; u.e = e; u.mt = mt; u.valid = min(256, cnt - mt * 256);
        u.aoff = a_tiles ? (size_t)g * (size_t)(256 * K * 2) : (size_t)0; u.boff = (size_t)e * bexp + (size_t)pn * (size_t)(256 * K * 2);
        return true;
    }
    __device__ __forceinline__ const unsigned* id_src(const pg8::Unit& u, int row) const { return list + (size_t)u.e * LCAP + u.mt * 256 + min(row, u.valid - 1); }
};
struct EpiGU {
    bf16* ACT; const float* rstd2; const float* bgu;
    __device__ __forceinline__ void operator()(const pg8::f32x4 (&acc)[2][2][4][2], const pg8::Unit& u, int wr, int wc, int fr, int fq, const LAS unsigned* ids) const {
        const int r0 = wr * 64 + fr, f0 = u.pn * 128 + wc * 32 + 8 * fq;
        float rs[2][4];
#pragma unroll
        for (int ai = 0; ai < 2; ++ai)
#pragma unroll
            for (int m = 0; m < 4; ++m) rs[ai][m] = rstd2[ids[r0 + ai * 128 + m * 16] >> 2];
        const float* bp = bgu + (size_t)u.e * 2048 + 2 * f0;
        const pg8::f32x4 b0 = *(const pg8::f32x4*)bp, b1 = *(const pg8::f32x4*)(bp + 4), b2 = *(const pg8::f32x4*)(bp + 8), b3 = *(const pg8::f32x4*)(bp + 12);
        const float gb[8] = {b0[0], b0[2], b1[0], b1[2], b2[0], b2[2], b3[0], b3[2]}, ub[8] = {b0[1], b0[3], b1[1], b1[3], b2[1], b2[3], b3[1], b3[3]};
#pragma unroll
        for (int ai = 0; ai < 2; ++ai)
#pragma unroll
            for (int m = 0; m < 4; ++m) { const int r = r0 + ai * 128 + m * 16; const float s = rs[ai][m]; float a[8];
#pragma unroll
                for (int n = 0; n < 2; ++n)
#pragma unroll
                    for (int j = 0; j < 4; ++j) { float gate = acc[ai][0][m][n][j] * s + gb[4 * n + j], up = acc[ai][1][m][n][j] * s + ub[4 * n + j];
                        gate = fminf(gate, 7.f); up = fminf(fmaxf(up, -7.f), 7.f);
                        a[4 * n + j] = (up + 1.f) * gate * __builtin_amdgcn_rcpf(1.f + __builtin_amdgcn_exp2f(-1.702f * LOG2E * gate)); }
                v4u w; w.x = pg8::cvt_pk_bf16(a[0], a[1]); w.y = pg8::cvt_pk_bf16(a[2], a[3]); w.z = pg8::cvt_pk_bf16(a[4], a[5]); w.w = pg8::cvt_pk_bf16(a[6], a[7]);
                *(v4u*)(ACT + (size_t)(u.pm * 256 + r) * DFF + f0) = w; }
    }
};
struct EpiDown {
    bf16* YB; const float* rgate; const float* bdn;
    __device__ __forceinline__ void operator()(const pg8::f32x4 (&acc)[2][2][4][2], const pg8::Unit& u, int wr, int wc, int fr, int fq, const LAS unsigned* ids) const {
        const int r0 = wr * 64 + fr, col0 = u.pn * 256 + wc * 32 + 8 * fq;
        unsigned en[2][4]; float gt[2][4];
#pragma unroll
        for (int ai = 0; ai < 2; ++ai)
#pragma unroll
            for (int m = 0; m < 4; ++m) { en[ai][m] = ids[r0 + ai * 128 + m * 16]; gt[ai][m] = rgate[en[ai][m]]; }
        pg8::f32x4 bv[2][2];
#pragma unroll
        for (int bj = 0; bj < 2; ++bj)
#pragma unroll
            for (int n = 0; n < 2; ++n) bv[bj][n] = *(const pg8::f32x4*)(bdn + (size_t)u.e * D + col0 + bj * 128 + 4 * n);
#pragma unroll
        for (int ai = 0; ai < 2; ++ai)
#pragma unroll
            for (int m = 0; m < 4; ++m) { const int r = r0 + ai * 128 + m * 16; if (r < u.valid) { const float g = gt[ai][m]; bf16* yp = YB + (size_t)en[ai][m] * D + col0;
#pragma unroll
                for (int bj = 0; bj < 2; ++bj) { const pg8::f32x4 v0 = (acc[ai][bj][m][0] + bv[bj][0]) * g, v1 = (acc[ai][bj][m][1] + bv[bj][1]) * g;
                    v4u w; w.x = pg8::cvt_pk_bf16(v0[0], v0[1]); w.y = pg8::cvt_pk_bf16(v0[2], v0[3]); w.z = pg8::cvt_pk_bf16(v1[0], v1[1]); w.w = pg8::cvt_pk_bf16(v1[2], v1[3]);
                    *(v4u*)(yp + bj * 128) = w; } } }
    }
};
__device__ __forceinline__ void final_phase(Frame& F) {
    const int gw = F.vcu * NWAVES + F.wave, NGW = F.G * NWAVES;
    const bf16* YB = (const bf16*)(F.ws + WS_YB);
    for (int t = gw; t < T; t += NGW) {
        float v[16]; float ss = 0.f;
#pragma unroll
        for (int jj = 0; jj < 2; ++jj) { const int c = 512 * jj + 8 * F.lane;
            const f32x4 a = *(const f32x4*)(F.out + (size_t)t * D + c), b = *(const f32x4*)(F.out + (size_t)t * D + c + 4);
            float* vv = v + 8 * jj; vv[0] = a.x; vv[1] = a.y; vv[2] = a.z; vv[3] = a.w; vv[4] = b.x; vv[5] = b.y; vv[6] = b.z; vv[7] = b.w;
#pragma unroll
            for (int k = 0; k < 4; ++k) { const v4u y = *(const v4u*)(YB + ((size_t)t * 4 + k) * D + c);
                vv[0] += bflo(y.x); vv[1] += bfhi(y.x); vv[2] += bflo(y.y); vv[3] += bfhi(y.y); vv[4] += bflo(y.z); vv[5] += bfhi(y.z); vv[6] += bflo(y.w); vv[7] += bfhi(y.w); } }
#pragma unroll
        for (int i = 0; i < 16; ++i) ss += v[i] * v[i];
        const float rstd = 1.f / sqrtf(wave_sum(ss) * (1.f / D) + EPS);
#pragma unroll
        for (int jj = 0; jj < 2; ++jj) { const int c = 512 * jj + 8 * F.lane; const f32x4 g0 = *(const f32x4*)(F.g_fin + c), g1 = *(const f32x4*)(F.g_fin + c + 4); const float* vv = v + 8 * jj;
            f32x4 o0, o1; o0.x = vv[0] * rstd * g0.x; o0.y = vv[1] * rstd * g0.y; o0.z = vv[2] * rstd * g0.z; o0.w = vv[3] * rstd * g0.w;
            o1.x = vv[4] * rstd * g1.x; o1.y = vv[5] * rstd * g1.y; o1.z = vv[6] * rstd * g1.z; o1.w = vv[7] * rstd * g1.w;
            *(f32x4*)(F.out + (size_t)t * D + c) = o0; *(f32x4*)(F.out + (size_t)t * D + c + 4) = o1; }
    }
}
struct Args { const float* in[17]; float* out; unsigned char* ws; int ph_lo, ph_hi, use_bar, pad; };
__global__ void __launch_bounds__(NWAVES * 64, 2) mk_fwd(Args args) {
    extern __shared__ __attribute__((aligned(16))) unsigned char lds[];
    Frame F;
    F.lds = (LAS unsigned char*)lds;
    F.MISC = (volatile LAS unsigned*)(F.lds + MISC_OFF);
    F.tid = threadIdx.x; F.lane = F.tid & 63; F.wave = __builtin_amdgcn_readfirstlane(F.tid >> 6);
    F.G = gridDim.x; { const int bx = blockIdx.x; F.vcu = (F.G % 8 == 0) ? (bx % 8) * (F.G / 8) + bx / 8 : bx; }
    F.ws = args.ws; F.out = args.out; F.ctl = (gu32*)(args.ws + WS_CTL);
    F.x = args.in[0]; F.mem = args.in[1]; F.g_attn = args.in[2]; F.g_mem = args.in[3]; F.w_in = args.in[4]; F.lamqk = args.in[5]; F.subg = args.in[6]; F.w_mkv = args.in[7];
    F.w_out = args.in[8]; F.g_ffn = args.in[9]; F.w_r = args.in[10]; F.b_r = args.in[11]; F.w_gu = args.in[12]; F.b_gu = args.in[13]; F.w_dn = args.in[14]; F.b_dn = args.in[15]; F.g_fin = args.in[16];
    for (int u = F.tid; u < (LDS_BYTES - LDSCTL_OFF) / 4; u += NWAVES * 64) ((LAS unsigned*)(F.lds + LDSCTL_OFF))[u] = 0u;
    __syncthreads();
    XcdBarrier bar; bar.bar = (unsigned*)(F.ctl + CW_BAR); bar.x = 0; bar.st = nullptr;
    if (args.use_bar) bar = xcd_barrier_post((unsigned*)(F.ctl + CW_BAR), F.MISC + 8);
    const int lo = args.ph_lo, hi = args.ph_hi;
#define IN(k) (lo <= (k) && (k) < hi)
#define SEAM(k) do { if (IN(k) && IN((k) + 1)) xcd_barrier(bar); } while (0)
    if (IN(0)) { p0_prologue(F); } SEAM(0);
    if (IN(1)) {
        pg8::Gemm g{(const bf16*)(F.ws + WS_XB), (const bf16*)(F.ws + WS_WIN), D}; pg8::StaticOrder S; S.init(T, DIN, D, F.G, (int)blockIdx.x);
        EpiInProj E{(bf16*)(F.ws + WS_P), (const float*)(F.ws + WS_RSTD1)};
        pg8::gemm_phase<EpiInProj, pg8::StaticOrder, true, false, false>(F.lds + RING_OFF, (LAS unsigned*)(F.lds + IDB_OFF), g, S, E);
    } SEAM(1);
    if (IN(2)) { attn_phase(F, (char*)lds + RING_OFF); } SEAM(2);
    if (IN(3)) { dil_combine_phase(F); } SEAM(3);
    if (IN(4)) {
        pg8::Gemm g{(const bf16*)(F.ws + WS_MIX), (const bf16*)(F.ws + WS_WOUT), D}; pg8::StaticOrder S; S.init(T, D, D, F.G, (int)blockIdx.x);
        EpiOutProj E{F.x, F.out, (bf16*)(F.ws + WS_X1B)};
        pg8::gemm_phase<EpiOutProj, pg8::StaticOrder, true, false, false>(F.lds + RING_OFF, (LAS unsigned*)(F.lds + IDB_OFF), g, S, E);
    } SEAM(4);
    if (IN(5)) { route_phase(F); } SEAM(5);
    if (IN(6)) {
        const int nmt = moe_build_table(F);
        pg8::Gemm g{(const bf16*)(F.ws + WS_X1B), (const bf16*)(F.ws + WS_WGU), D};
        MoeOrder S{(const LAS unsigned*)(F.lds + TBL_OFF), (const LAS unsigned*)(F.lds + LCNT_OFF), (const unsigned*)(F.ws + WS_LIST), nmt, F.G, F.vcu, 8, 4, D, (size_t)2 * DFF * D * 2, false};
        EpiGU E{(bf16*)(F.ws + WS_ACT), (const float*)(F.ws + WS_RSTD2), F.b_gu};
        pg8::gemm_phase<EpiGU, MoeOrder, true, true, true>(F.lds + RING_OFF, (LAS unsigned*)(F.lds + IDB_OFF), g, S, E);
    } SEAM(6);
    if (IN(7)) {
        const int nmt = moe_build_table(F);
        pg8::Gemm g{(const bf16*)(F.ws + WS_ACT), (const bf16*)(F.ws + WS_WDN), DFF};
        MoeOrder S{(const LAS unsigned*)(F.lds + TBL_OFF), (const LAS unsigned*)(F.lds + LCNT_OFF), (const unsigned*)(F.ws + WS_LIST), nmt, F.G, F.vcu, 4, 8, DFF, (size_t)D * DFF * 2, true};
        EpiDown E{(bf16*)(F.ws + WS_YB), (const float*)(F.ws + WS_RGATE), F.b_dn};
        pg8::gemm_phase<EpiDown, MoeOrder, true, false, true>(F.lds + RING_OFF, (LAS unsigned*)(F.lds + IDB_OFF), g, S, E);
    } SEAM(7);
    if (IN(8)) { final_phase(F); }
#undef IN
#undef SEAM
}

static void launch_phases(const Args& base, int lo, int hi, int use_bar, int grid, hipStream_t stream) {
    Args a = base; a.ph_lo = lo; a.ph_hi = hi; a.use_bar = use_bar;
    hipLaunchKernelGGL(mk_fwd, dim3(grid), dim3(NWAVES * 64), LDS_BYTES, stream, a);
}
extern "C" void kernel_launch(void* const* d_in, const int* in_sizes, int n_in, void* d_out, int out_size, void* d_ws, size_t ws_size, hipStream_t stream) {
    static int grid = 0;
    if (grid == 0) {
        if (n_in != 17 || in_sizes[0] != T * D || out_size != T * D || ws_size < (size_t)1000 * MiB) { fprintf(stderr, "kernel_launch: unexpected shapes / workspace (%d inputs, ws %zu)\n", n_in, ws_size); grid = -1; return; }
        int dev = 0, cus = 0, per_cu = 0;
        if (hipGetDevice(&dev) != hipSuccess || hipDeviceGetAttribute(&cus, hipDeviceAttributeMultiprocessorCount, dev) != hipSuccess) { grid = -1; return; }
        if (hipFuncSetAttribute((const void*)mk_fwd, hipFuncAttributeMaxDynamicSharedMemorySize, LDS_BYTES) != hipSuccess) { fprintf(stderr, "kernel_launch: hipFuncSetAttribute failed\n"); grid = -1; return; }
        if (hipOccupancyMaxActiveBlocksPerMultiprocessor(&per_cu, (const void*)mk_fwd, NWAVES * 64, LDS_BYTES) != hipSuccess || per_cu < 1) { fprintf(stderr, "kernel_launch: occupancy query says %d blocks per CU\n", per_cu); per_cu = 1; }
        (void)hipGetLastError();
        grid = cus;
        if (grid != 256) { fprintf(stderr, "kernel_launch: built for a 256-CU device (got %d)\n", cus); grid = -1; return; }
    }
    if (grid < 0) return;
    (void)hipMemsetAsync((char*)d_ws + WS_CTL, 0, CTL_ZERO_BYTES, stream);
    Args a{};
    for (int i = 0; i < 17; ++i) a.in[i] = (const float*)d_in[i];
    a.out = (float*)d_out; a.ws = (unsigned char*)d_ws;
    launch_phases(a, 0, 9, 1, grid, stream);
}
```

```cpp
#include <hip/hip_runtime.h>
#include <hip/hip_bf16.h>
#include <cstdint>
#include <cstdio>
#include <cmath>

constexpr int D = 1024, BATCH = 8, SEQ = 4096, T = BATCH * SEQ, DIN = 2560, NMEM = 256, NE = 32, DFF = 1024;
constexpr int C_DQ = 0, C_DK = 512, C_DV = 1024, C_LQ = 1536, C_LK = 1792, C_LV = 2048, C_MQ = 2304;
constexpr float EPS = 1e-5f;
constexpr int LCAP = T;
constexpr float QSCALE = 0.125f * 1.4426950408889634f;
constexpr float LOG2E = 1.4426950408889634f;
namespace pg8 {
#define PG8_LAS __attribute__((address_space(3)))
typedef unsigned short bf16_t;
typedef short bf16x8 __attribute__((ext_vector_type(8)));
typedef float f32x4 __attribute__((ext_vector_type(4)));
typedef unsigned u32x4 __attribute__((ext_vector_type(4)));
typedef unsigned u32x2 __attribute__((ext_vector_type(2)));
constexpr int BM = 256, BK = 64, HALF = 128, HTB = HALF * BK * 2  , STAGE_BYTES = 8 * HTB, NXCD = 8, WGM = 8;

__host__ __device__ __forceinline__ int lds_byte(int r, int c) { const int st = (r >> 4) * 2 + (c >> 5), rr = r & 15, cc = c & 31, ob = rr * 64 + cc * 2; return st * 1024 + (ob ^ (((ob >> 9) & 1) << 5)); }
__host__ __device__ __forceinline__ void stage_rc(int b, int& R, int& C) { const int st = b / 1024, sb = b % 1024, swz = sb ^ (((sb >> 9) & 1) << 5); R = (st >> 1) * 16 + swz / 64; C = (st & 1) * 32 + (swz % 64) / 2; }
__host__ __device__ __forceinline__ int perm32(int rho) { const int n = rho >> 4, i = rho & 15; return 8 * (i >> 2) + 4 * n + (i & 3); }

struct Unit { size_t aoff, boff; int pm, pn, e, valid, mt; };
struct Gemm { const bf16_t* A; const bf16_t* Bt; int K; };

struct StaticOrder {
    int nM, nN, nwg, G, c, K;
    __device__ void init(int M, int N, int K_, int G_, int c_) { nM = M / BM; nN = N / BM; nwg = nM * nN; G = G_; c = c_; K = K_; }
    __device__ bool next(int i, Unit& u) const {
        const long L = (long)i * G + c; if (L >= nwg) return false;
        int wgid = (int)L; { const int q = nwg / NXCD, r = nwg % NXCD, xcd = wgid % NXCD, off = wgid / NXCD; wgid = (xcd < r ? xcd * (q + 1) : r * (q + 1) + (xcd - r) * q) + off; }
        const int nig = WGM * nN, gid = wgid / nig, fm = gid * WGM, gsz = (nM - fm) < WGM ? (nM - fm) : WGM;
        u.pm = fm + ((wgid % nig) % gsz); u.pn = (wgid % nig) / gsz; u.e = 0; u.valid = 256; u.mt = 0;
        u.aoff = (size_t)u.pm * (size_t)(BM * K * 2); u.boff = (size_t)u.pn * (size_t)(BM * K * 2); return true;
    }
    __device__ __forceinline__ const unsigned* id_src(const Unit&, int) const { return nullptr; }
};

__device__ __forceinline__ unsigned cvt_pk_bf16(float lo, float hi) { unsigned r; asm volatile("v_cvt_pk_bf16_f32 %0, %1, %2" : "=v"(r) : "v"(lo), "v"(hi)); return r; }

template <class Epi, class Sched, bool ALIGN_EPI, bool GATHER, bool IDS>
__device__ __forceinline__ void gemm_phase(PG8_LAS unsigned char* lds, PG8_LAS unsigned* idb, const Gemm g, const Sched& S, const Epi& E) {
    const int tid = threadIdx.x, wid = __builtin_amdgcn_readfirstlane(tid >> 6), lane = tid & 63, wr = wid >> 2, wc = wid & 3, fr = lane & 15, fq = lane >> 4;
    const int K = g.K, nt = K / BK;
    unsigned voffA[2], voffB[2]; int RA[2], CA[2];
#pragma unroll
    for (int i = 0; i < 2; ++i) { int R, C; stage_rc(tid * 16 + i * 8192, R, C); const int Rb = (R & ~31) + perm32(R & 31); RA[i] = R; CA[i] = C;
        voffA[i] = (unsigned)(R * K + C) * 2u; voffB[i] = (unsigned)(Rb * K + C) * 2u; }
    const size_t kstep = (size_t)(BK * 2);
    const size_t hstep = (size_t)HALF * K * 2;
    const unsigned ldsw = (unsigned)wid * 1024u;
    const int aoff = lds_byte(wr * 64 + fr, fq * 8), boff = lds_byte(wc * 32 + fr, fq * 8);
#define PG8_SA(b, h) (((b) * 2 + (h)) * HTB)
#define PG8_SB(b, h) ((4 + (b) * 2 + (h)) * HTB)
#define PG8_STAGE(bufoff, gbase, voff) do { _Pragma("unroll") for (int _i = 0; _i < 2; ++_i) \
        __builtin_amdgcn_global_load_lds((const unsigned*)((const char*)(gbase) + (voff)[_i]), (PG8_LAS unsigned*)(lds + (bufoff) + ldsw + _i * 8192), 16, 0, 0); } while (0)
#define PG8_STAGE_A(bufoff, pbase, gbase, h, gv) do { if constexpr (GATHER) { PG8_STAGE(bufoff, gbase, gv[h]); } else { PG8_STAGE(bufoff, (pbase) + (h) * hstep, voffA); } } while (0)
#define PG8_LDA(dst, b, h) do { _Pragma("unroll") for (int m = 0; m < 4; ++m) _Pragma("unroll") for (int k = 0; k < 2; ++k) dst[m][k] = *(const PG8_LAS bf16x8*)(lds + PG8_SA(b, h) + aoff + m * 2048 + k * 1024); } while (0)
#define PG8_LDB(dst, b, h) do { _Pragma("unroll") for (int n = 0; n < 2; ++n) _Pragma("unroll") for (int k = 0; k < 2; ++k) dst[n][k] = *(const PG8_LAS bf16x8*)(lds + PG8_SB(b, h) + boff + n * 2048 + k * 1024); } while (0)
#define PG8_MMA(ai, bj, At, Bt) do { __builtin_amdgcn_s_setprio(1); _Pragma("unroll") for (int m = 0; m < 4; ++m) _Pragma("unroll") for (int n = 0; n < 2; ++n) _Pragma("unroll") for (int k = 0; k < 2; ++k) \
        acc[ai][bj][m][n] = __builtin_amdgcn_mfma_f32_16x16x32_bf16(Bt[n][k], At[m][k], acc[ai][bj][m][n], 0, 0, 0); __builtin_amdgcn_s_setprio(0); } while (0)
#define PG8_WAIT_V(n) asm volatile("s_waitcnt vmcnt(" #n ")" ::: "memory")
#define PG8_WAIT_L(n) asm volatile("s_waitcnt lgkmcnt(" #n ")" ::: "memory")
#define PG8_BAR __builtin_amdgcn_s_barrier()
#define PG8_SCHED __builtin_amdgcn_sched_barrier(0)
#define PG8_IDS_DMA(u, s) do { if (wid < 4) __builtin_amdgcn_global_load_lds(S.id_src(u, tid), (PG8_LAS unsigned*)(idb + (s) * 256 + wid * 64), 4, 0, 0); } while (0)
#define PG8_GV(dst, s) do { _Pragma("unroll") for (int _h = 0; _h < 2; ++_h) _Pragma("unroll") for (int _i = 0; _i < 2; ++_i) \
        dst[_h][_i] = (idb[(s) * 256 + _h * 128 + RA[_i]] >> 2) * (unsigned)(K * 2) + (unsigned)(CA[_i] * 2); } while (0)
    Unit cur, nxt; int ui = 0, us = 0;
    if (!S.next(0, cur)) return;
    f32x4 acc[2][2][4][2];
#pragma unroll
    for (int a = 0; a < 2; ++a)
#pragma unroll
        for (int b = 0; b < 2; ++b)
#pragma unroll
            for (int m = 0; m < 4; ++m)
#pragma unroll
                for (int n = 0; n < 2; ++n) acc[a][b][m][n] = (f32x4){0.f, 0.f, 0.f, 0.f};
    bf16x8 At[4][2], B0[2][2], B1[2][2];
    unsigned cv[2][2] = {{0u, 0u}, {0u, 0u}}, nv[2][2] = {{0u, 0u}, {0u, 0u}};
    const char* A0 = (const char*)g.A;
    const char* cA = A0 + (GATHER ? (size_t)0 : cur.aoff); const char* cB = (const char*)g.Bt + cur.boff;
    if constexpr (IDS) {
        PG8_IDS_DMA(cur, 0); PG8_WAIT_V(0); PG8_BAR;
        if constexpr (GATHER) { PG8_GV(cv, 0); }
    }
    PG8_STAGE(PG8_SB(0, 0), cB, voffB); PG8_STAGE(PG8_SB(0, 1), cB + hstep, voffB); PG8_STAGE_A(PG8_SA(0, 0), cA, A0, 0, cv); PG8_STAGE_A(PG8_SA(0, 1), cA, A0, 1, cv);
    if (wr == 1) PG8_BAR;
    PG8_WAIT_V(2); PG8_BAR;
    PG8_STAGE(PG8_SB(1, 0), cB + kstep, voffB); PG8_STAGE_A(PG8_SA(1, 0), cA + kstep, A0 + kstep, 0, cv); PG8_STAGE(PG8_SB(1, 1), cB + hstep + kstep, voffB);
    PG8_WAIT_V(6); PG8_BAR;
    for (;;) {
        const bool has_next = S.next(ui + 1, nxt);
        const int ns = (us == 2) ? 0 : us + 1;
        if constexpr (IDS) { if (has_next) PG8_IDS_DMA(nxt, ns); }
        const char* nA = has_next ? A0 + (GATHER ? (size_t)0 : nxt.aoff) : cA; const char* nB = has_next ? (const char*)g.Bt + nxt.boff : cB;
        for (int t = 0; t < nt; t += 2) {
            const bool last = (t == nt - 2);
            const char* a1 = cA + (size_t)(t + 1) * kstep;
            const char* a2 = last ? nA : cA + (size_t)(t + 2) * kstep; const char* b2 = last ? nB : cB + (size_t)(t + 2) * kstep;
            const char* a3 = a2 + kstep; const char* b3 = b2 + kstep;
            unsigned ov[2][2];
            if constexpr (GATHER) {
                if (last && has_next) { PG8_GV(nv, ns); }
#pragma unroll
                for (int h = 0; h < 2; ++h)
#pragma unroll
                    for (int i = 0; i < 2; ++i) ov[h][i] = (last && has_next) ? nv[h][i] : cv[h][i];
            }
            PG8_LDB(B0, 0, 0); PG8_LDB(B1, 0, 1); PG8_SCHED; PG8_LDA(At, 0, 0); PG8_STAGE_A(PG8_SA(1, 1), a1, a1, 1, cv);
            PG8_WAIT_V(8); PG8_WAIT_L(0); PG8_BAR; PG8_MMA(0, 0, At, B0); PG8_MMA(0, 1, At, B1); PG8_BAR; PG8_SCHED;
            PG8_LDA(At, 0, 1); PG8_STAGE(PG8_SB(0, 0), b2, voffB); PG8_STAGE(PG8_SB(0, 1), b2 + hstep, voffB); PG8_STAGE_A(PG8_SA(0, 0), a2, a2, 0, ov);
            PG8_WAIT_V(8); PG8_WAIT_L(0); PG8_BAR; PG8_MMA(1, 0, At, B0); PG8_MMA(1, 1, At, B1); PG8_BAR; PG8_SCHED;
            PG8_LDB(B0, 1, 0); PG8_LDB(B1, 1, 1); PG8_SCHED; PG8_LDA(At, 1, 0); PG8_STAGE_A(PG8_SA(0, 1), a2, a2, 1, ov);
            PG8_WAIT_V(8); PG8_WAIT_L(0); PG8_BAR; PG8_MMA(0, 0, At, B0); PG8_MMA(0, 1, At, B1); PG8_BAR; PG8_SCHED;
            PG8_LDA(At, 1, 1); PG8_STAGE(PG8_SB(1, 0), b3, voffB); PG8_STAGE(PG8_SB(1, 1), b3 + hstep, voffB); PG8_STAGE_A(PG8_SA(1, 0), a3, a3, 0, ov);
            PG8_WAIT_V(8); PG8_WAIT_L(0); PG8_BAR; PG8_MMA(1, 0, At, B0); PG8_MMA(1, 1, At, B1); PG8_BAR; PG8_SCHED;
        }
        if constexpr (ALIGN_EPI) { if (wr == 0) PG8_BAR; }
        E(acc, cur, wr, wc, fr, fq, (const PG8_LAS unsigned*)(idb + us * 256));
        if (!has_next) break;
#pragma unroll
        for (int a = 0; a < 2; ++a)
#pragma unroll
            for (int b = 0; b < 2; ++b)
#pragma unroll
                for (int m = 0; m < 4; ++m)
#pragma unroll
                    for (int n = 0; n < 2; ++n) acc[a][b][m][n] = (f32x4){0.f, 0.f, 0.f, 0.f};
        cur = nxt; cA = nA; cB = nB; ++ui; us = ns;
        if constexpr (GATHER) {
#pragma unroll
            for (int h = 0; h < 2; ++h)
#pragma unroll
                for (int i = 0; i < 2; ++i) cv[h][i] = nv[h][i];
        }
        if constexpr (ALIGN_EPI) { if (wr == 1) PG8_BAR; }
    }
    PG8_WAIT_V(0);
    if constexpr (!ALIGN_EPI) { if (wr == 0) PG8_BAR; }
    PG8_BAR;
#undef PG8_SA
#undef PG8_SB
#undef PG8_STAGE
#undef PG8_STAGE_A
#undef PG8_LDA
#undef PG8_LDB
#undef PG8_MMA
#undef PG8_WAIT_V
#undef PG8_WAIT_L
#undef PG8_BAR
#undef PG8_SCHED
#undef PG8_IDS_DMA
#undef PG8_GV
}
}
namespace attn_body {
using bf16=__hip_bfloat16;
using bf16x8=__attribute__((ext_vector_type(8)))short;
using s16x4=__attribute__((ext_vector_type(4)))short;
using f32x16=__attribute__((ext_vector_type(16)))float;
using u32x4=__attribute__((ext_vector_type(4)))unsigned;
constexpr int D=64;
constexpr int NW=8,QBLK=32,QB=QBLK*NW,KVBLK=64;
struct UnitP { const bf16* Q; const bf16* K; const bf16* V; bf16* O; long qp, kp, op; int q0, t0, NT; float slope2; float* lse; int lse_stride; };
__device__ __forceinline__ int crow(int r,int hi){return (r&3)+8*(r>>2)+4*hi;}
#define SBAR() __builtin_amdgcn_sched_barrier(0)
template<bool CAUSAL,bool WINDOW> __device__ __forceinline__ void cmask(f32x16&p0,f32x16&p1,int jb,int qrel,int hi){
  const float NEG=-INFINITY; int kb=64*jb+4*hi;
  #pragma unroll
  for(int r=0;r<16;++r){int kv=kb+(r&3)+8*(r>>2);
    if(CAUSAL){ if(kv>qrel)p0[r]=NEG; if(kv+32>qrel)p1[r]=NEG; }
    if(WINDOW){ if(kv<qrel-128)p0[r]=NEG; if(kv+32<qrel-128)p1[r]=NEG; } }
}
__device__ __forceinline__ unsigned bfr(float x){ typedef float f2_ __attribute__((ext_vector_type(2))); typedef __bf16 b2_ __attribute__((ext_vector_type(2))); f2_ v={x,0.f}; b2_ b=__builtin_convertvector(v,b2_); return __builtin_bit_cast(unsigned,b)&0xffffu; }
__device__ __forceinline__ float bfv(unsigned b){ return __builtin_bit_cast(float,b<<16); }

constexpr int NSLOT=3, SLOTB=8192;
constexpr int LDS_K=0, LDS_V=NSLOT*SLOTB, LDS_WS=2*NSLOT*SLOTB, LDS_OST=LDS_WS+NW*64*4, LDS_BYTES=LDS_OST+NW*4096;
__device__ __forceinline__ void glds16(const void*gsrc,unsigned lds_dst){unsigned keep;
  asm volatile("s_mov_b32 %0, m0\n\ts_mov_b32 m0, %2\n\ts_nop 0\n\tglobal_load_lds_dwordx4 %1, off\n\ts_mov_b32 m0, %0":"=&s"(keep):"v"(gsrc),"s"(lds_dst):"memory");}
__device__ __forceinline__ float max3f(float a,float b,float c){float r;asm("v_max3_f32 %0, %1, %2, %3":"=v"(r):"v"(a),"v"(b),"v"(c));return r;}
__device__ __forceinline__ float max2f(float a,float b){float r;asm("v_max_f32_e32 %0, %1, %2":"=v"(r):"v"(a),"v"(b));return r;}
__device__ __forceinline__ float fadd_s(float a,float b){float r;asm("v_add_f32_e32 %0, %1, %2":"=v"(r):"v"(a),"v"(b));return r;}
__device__ __forceinline__ float fsub_s(float a,float b){float r;asm("v_sub_f32_e32 %0, %1, %2":"=v"(r):"v"(a),"v"(b));return r;}
typedef float f32x2_t __attribute__((ext_vector_type(2))); typedef __bf16 bf16x2_t __attribute__((ext_vector_type(2)));
__device__ __forceinline__ unsigned cvtpk_s(float lo,float hi){f32x2_t v={lo,hi};bf16x2_t b=__builtin_convertvector(v,bf16x2_t);return __builtin_bit_cast(unsigned,b);}
#define WAIT_BAR(N) asm volatile("s_waitcnt vmcnt(" #N ") lgkmcnt(0)\n\ts_barrier":::"memory")

__device__ __forceinline__ void qkt(f32x16&p0,f32x16&p1,const char*Kslot,const bf16x8*qr,bf16x8 kx0,bf16x8 kx1,bf16x8 qx,int r32,int hi){
  const char*kb=Kslot+hi*1024+r32*16;
  #pragma unroll
  for(int d0=0;d0<4;++d0){
    const bf16x8 b0=*reinterpret_cast<const bf16x8*>(kb+d0*2048);
    const bf16x8 b1=*reinterpret_cast<const bf16x8*>(kb+d0*2048+512);
    if(d0==0){p0=__builtin_amdgcn_mfma_f32_32x32x16_bf16(b0,qr[0],f32x16{},0,0,0);p1=__builtin_amdgcn_mfma_f32_32x32x16_bf16(b1,qr[0],f32x16{},0,0,0);}
    else{p0=__builtin_amdgcn_mfma_f32_32x32x16_bf16(b0,qr[d0],p0,0,0,0);p1=__builtin_amdgcn_mfma_f32_32x32x16_bf16(b1,qr[d0],p1,0,0,0);}}
  p0=__builtin_amdgcn_mfma_f32_32x32x16_bf16(kx0,qx,p0,0,0,0);p1=__builtin_amdgcn_mfma_f32_32x32x16_bf16(kx1,qx,p1,0,0,0);
}
typedef __attribute__((address_space(3))) const char* lds_cptr;
typedef short v4i16_t __attribute__((ext_vector_type(4)));
__device__ __forceinline__ void kload8(bf16x8*kf,lds_cptr kp){
  kf[0]=*(const __attribute__((address_space(3))) bf16x8*)(kp);      kf[1]=*(const __attribute__((address_space(3))) bf16x8*)(kp+512);
  kf[2]=*(const __attribute__((address_space(3))) bf16x8*)(kp+2048); kf[3]=*(const __attribute__((address_space(3))) bf16x8*)(kp+2560);
  kf[4]=*(const __attribute__((address_space(3))) bf16x8*)(kp+4096); kf[5]=*(const __attribute__((address_space(3))) bf16x8*)(kp+4608);
  kf[6]=*(const __attribute__((address_space(3))) bf16x8*)(kp+6144); kf[7]=*(const __attribute__((address_space(3))) bf16x8*)(kp+6656);
}
__device__ __forceinline__ void kload2(bf16x8*kf,lds_cptr kp,int j){ kf[2*j]=*(const __attribute__((address_space(3))) bf16x8*)(kp+j*2048); kf[2*j+1]=*(const __attribute__((address_space(3))) bf16x8*)(kp+j*2048+512); }
__device__ __forceinline__ s16x4 vtr(lds_cptr p){ return __builtin_bit_cast(s16x4,__builtin_amdgcn_ds_read_tr16_b64_v4i16((__attribute__((address_space(3))) v4i16_t*)p)); }
__device__ __forceinline__ float rowmax(const f32x16&p0,const f32x16&p1){
  float a=max3f(p0[0],p0[1],p1[0]),b=max3f(p0[2],p0[3],p1[1]);a=max3f(a,p1[2],p1[3]);
  #pragma unroll
  for(int r=4;r<16;r+=4){a=max3f(a,p0[r],p0[r+1]);b=max3f(b,p0[r+2],p0[r+3]);a=max3f(a,p1[r],p1[r+1]);b=max3f(b,p1[r+2],p1[r+3]);}
  const float m=max2f(a,b);
  auto rr=__builtin_amdgcn_permlane32_swap(__float_as_uint(m),__float_as_uint(m),false,false);
  return max2f(__uint_as_float(rr[0]),__uint_as_float(rr[1]));
}
__device__ __forceinline__ void pv(f32x16*o,int vb,bf16x8 pa0,bf16x8 pa1,bf16x8 pa2,bf16x8 pa3){
  #pragma unroll
  for(int d0=0;d0<2;++d0){s16x4 lo[4],hi[4];
    #pragma unroll
    for(int ks=0;ks<4;++ks){
      asm volatile("ds_read_b64_tr_b16 %0,%1 offset:%c2":"=&v"(lo[ks]):"v"(vb),"i"(d0*4096+ks*1024):"memory");
      asm volatile("ds_read_b64_tr_b16 %0,%1 offset:%c2":"=&v"(hi[ks]):"v"(vb),"i"(d0*4096+ks*1024+512):"memory");}
    asm volatile("s_waitcnt lgkmcnt(0)":::"memory");SBAR();
    #define PK(k) (bf16x8){lo[k][0],lo[k][1],lo[k][2],lo[k][3],hi[k][0],hi[k][1],hi[k][2],hi[k][3]}
    o[d0]=__builtin_amdgcn_mfma_f32_32x32x16_bf16(pa0,PK(0),o[d0],0,0,0);
    o[d0]=__builtin_amdgcn_mfma_f32_32x32x16_bf16(pa1,PK(1),o[d0],0,0,0);
    o[d0]=__builtin_amdgcn_mfma_f32_32x32x16_bf16(pa2,PK(2),o[d0],0,0,0);
    o[d0]=__builtin_amdgcn_mfma_f32_32x32x16_bf16(pa3,PK(3),o[d0],0,0,0);
    #undef PK
  }
}

#ifndef ATTN_STORE16
#define ATTN_STORE16(p,v) (*(u32x4*)(p)=(v))
#endif
template<int THRL,bool CAUSAL,bool WINDOW,bool ALIBI,bool LSE> __device__ __forceinline__ void attn_unit(const UnitP&U,char*shm){
  int tid=threadIdx.x; asm volatile("":"+v"(tid));
  const int lane=tid&63,r32=lane&31,hi=lane>>5; const int wid=__builtin_amdgcn_readfirstlane(tid>>6);
  const int q0=U.q0; const long qp=U.qp,kp=U.kp,op=U.op; const float slope2=U.slope2;
  const bf16*Qw=U.Q+(long)(q0+wid*QBLK)*qp;
  const bf16*Kh=U.K+(long)U.t0*KVBLK*kp,*Vh=U.V+(long)U.t0*KVBLK*kp;
  const unsigned lds0=(unsigned)(uintptr_t)shm;
  float*wsf=(float*)(shm+LDS_WS)+wid*64;
  const bf16*ksrc=Kh+(long)lane*kp+wid*8;
  const bf16*vsrc=Vh+(long)(16*(wid&3)+(lane>>2))*kp+(wid>>2)*32+(lane&3)*8;
  const unsigned kdst=lds0+LDS_K+wid*1024, vdst=lds0+LDS_V+wid*1024;
  #define DMA_K(t,slot) glds16(ksrc+(long)(t)*KVBLK*kp,(unsigned)__builtin_amdgcn_readfirstlane(kdst+(slot)))
  #define DMA_V(t,slot) glds16(vsrc+(long)(t)*KVBLK*kp,(unsigned)__builtin_amdgcn_readfirstlane(vdst+(slot)))
  const int vb0=(int)(lds0+LDS_V)+((lane>>4)&1)*32+(lane&3)*8+(4*hi+((lane&15)>>2))*64;
  const char*Kbase=shm+LDS_K; bf16x8 kf[8];
  const lds_cptr shm3=(lds_cptr)shm; const lds_cptr kp0=shm3+LDS_K+hi*1024+r32*16; const lds_cptr vp0=shm3+LDS_V+((lane>>4)&1)*32+(lane&3)*8+(4*hi+((lane&15)>>2))*64;
  const int NT=U.NT;
  DMA_K(0,0);DMA_V(0,0);DMA_K(1,SLOTB);
  bf16x8 qr[4];
  #pragma unroll
  for(int d0=0;d0<4;++d0)qr[d0]=*reinterpret_cast<const bf16x8*>(&Qw[(long)r32*qp+d0*16+hi*8]);
  float mhat=0.f,l_reg=0.f;f32x16 o[2];o[0]=f32x16{};o[1]=f32x16{};
  const int qrel=wid*QBLK+r32;
  #define CMASK(P0,P1,t) do{int jb_=(t)-(NT-4); if(WINDOW||(CAUSAL&&jb_>=0))cmask<CAUSAL,WINDOW>(P0,P1,jb_,qrel,hi);}while(0)
  bf16x8 kx0,kx1,qx;
  { const float k0_=ALIBI?slope2*(float)r32:0.f, k1_=ALIBI?slope2*(float)(r32+32):0.f; const unsigned h0=bfr(k0_),l0=bfr(k0_-bfv(h0)),h1=bfr(k1_),l1=bfr(k1_-bfv(h1));
    u32x4 a={0x3f803f80u,0x3f80u|(h0<<16),l0,0u}, b={0x3f803f80u,0x3f80u|(h1<<16),l1,0u}; if(hi){a=u32x4{0u,0u,0u,0u};b=a;} kx0=__builtin_bit_cast(bf16x8,a); kx1=__builtin_bit_cast(bf16x8,b); }
  #define QX_SET(t) do{ const float nb_=ALIBI?__builtin_fmaf(slope2,(float)(64*((t)-(NT-4))-qrel),-mhat):-mhat; const unsigned a_=bfr(nb_); const float r1_=nb_-bfv(a_); const unsigned b_=bfr(r1_); const unsigned c_=bfr(r1_-bfv(b_)); \
    u32x4 q_={a_|(b_<<16),c_|0x3f800000u,0x3f80u,0u}; if(hi)q_=u32x4{0u,0u,0u,0u}; qx=__builtin_bit_cast(bf16x8,q_); asm volatile("":"+v"(qx)); }while(0)
  bool resc=false;
  #define START(P0,P1) do{ const float rm=rowmax(P0,P1); resc=false; \
    { const float dl=(rm==-INFINITY)?0.f:rm; mhat=fadd_s(mhat,dl); \
      _Pragma("unroll") for(int r=0;r<16;++r){P0[r]=fsub_s(P0[r],dl);P1[r]=fsub_s(P1[r],dl);} } \
    _Pragma("unroll") for(int r=0;r<16;++r)P0[r]=__builtin_amdgcn_exp2f(P0[r]); }while(0)
  #define RESC() do{ if(resc){ asm volatile("s_waitcnt lgkmcnt(0)":::"memory"); \
      _Pragma("unroll") for(int d_=0;d_<2;++d_) _Pragma("unroll") for(int r=0;r<16;++r)o[d_][r]*=wsf[crow(r,hi)]; } }while(0)
  f32x16 pA0,pA1,pB0,pB1;
  int sl_prev=0,sl_cur=0,sl_next=SLOTB;
  #define ROT() do{sl_prev=sl_cur;sl_cur=sl_next;sl_next=(sl_next==(NSLOT-1)*SLOTB)?0:sl_next+SLOTB;}while(0)
  DMA_K(2,2*SLOTB);
  WAIT_BAR(3);
  QX_SET(0);
  qkt(pA0,pA1,Kbase,qr,kx0,kx1,qx,r32,hi);asm volatile("s_nop 15\n\ts_nop 7":"+v"(pA0),"+v"(pA1));CMASK(pA0,pA1,0);
  START(pA0,pA1);
  _Pragma("unroll") for(int r=0;r<16;++r)pA1[r]=__builtin_amdgcn_exp2f(pA1[r]);
  WAIT_BAR(0);
  DMA_K(3,0);DMA_V(1,SLOTB);
  ROT();
  kload8(kf,kp0+sl_cur);
  WAIT_BAR(2);
  s16x4 vlo[8],vhi[8]; u32x4 pw0,pw1,pw2,pw3;
  #define PKW(P,B) cvtpk_s(P[B],P[B+1])
  #define PAF(k) __builtin_bit_cast(bf16x8,pw##k)
  #define VFR(i) (bf16x8){vlo[i][0],vlo[i][1],vlo[i][2],vlo[i][3],vhi[i][0],vhi[i][1],vhi[i][2],vhi[i][3]}
  #define PIN(x) asm volatile("":"+v"(x))
  #define MX3(a,b,c) __builtin_fmaxf(__builtin_fmaxf((a),(b)),(c))
  #define GAPA(MF,A0,A1,A2,A3,W0,W1,PW) do{ MF; sacc+=A0; sacc+=A1; sacc+=A2; sacc+=A3; PIN(sacc); W0; W1; PIN(PW); SBAR(); }while(0)
  #define EX(v) __builtin_amdgcn_exp2f(v)
  #define GAPB(MF,X,B) do{ MF; X[B]=EX(X[B]); X[B+1]=EX(X[B+1]); X[B+2]=EX(X[B+2]); X[B+3]=EX(X[B+3]); PIN(X); SBAR(); }while(0)
  #define VRD(i) do{ vlo[i]=vtr(vp_+(((i)>>2)*4096+((i)&3)*1024)); vhi[i]=vtr(vp_+(((i)>>2)*4096+((i)&3)*1024+512)); }while(0)
  #define KRD(G,j) do{ if(G){ kload2(kf,kp0+sl_next,j); SBAR(); } }while(0)
  #define STEP(C0,C1,P0,P1,t,GK,GV,GL) do{ SBAR(); QX_SET(t); SBAR(); \
    const lds_cptr vp_=vp0+sl_prev; \
    VRD(0); SBAR(); float sacc=(P0[0]+P0[1]); \
    GAPA(C0=__builtin_amdgcn_mfma_f32_32x32x16_bf16(kf[0],qr[0],f32x16{},0,0,0), P0[2],P0[3],P0[4],P0[5],     pw0[0]=PKW(P0,0), pw0[1]=PKW(P0,2), pw0); \
    VRD(4); SBAR(); GAPA(C1=__builtin_amdgcn_mfma_f32_32x32x16_bf16(kf[1],qr[0],f32x16{},0,0,0), P0[6],P0[7],P0[8],P0[9],     pw0[2]=PKW(P0,4), pw0[3]=PKW(P0,6), pw0); \
    VRD(1); SBAR(); GAPA(C0=__builtin_amdgcn_mfma_f32_32x32x16_bf16(kf[2],qr[1],C0,0,0,0),   P0[10],P0[11],P0[12],P0[13], pw1[0]=PKW(P0,8), pw1[1]=PKW(P0,10), pw1); \
    VRD(5); SBAR(); GAPA(C1=__builtin_amdgcn_mfma_f32_32x32x16_bf16(kf[3],qr[1],C1,0,0,0),   P0[14],P0[15],P1[0],P1[1],   pw1[2]=PKW(P0,12),pw1[3]=PKW(P0,14), pw1); \
    VRD(2); SBAR(); GAPA(C0=__builtin_amdgcn_mfma_f32_32x32x16_bf16(kf[4],qr[2],C0,0,0,0),   P1[2],P1[3],P1[4],P1[5],     pw2[0]=PKW(P1,0), pw2[1]=PKW(P1,2), pw2); \
    VRD(6); SBAR(); GAPA(C1=__builtin_amdgcn_mfma_f32_32x32x16_bf16(kf[5],qr[2],C1,0,0,0),   P1[6],P1[7],P1[8],P1[9],     pw2[2]=PKW(P1,4), pw2[3]=PKW(P1,6), pw2); \
    VRD(3); SBAR(); GAPA(C0=__builtin_amdgcn_mfma_f32_32x32x16_bf16(kf[6],qr[3],C0,0,0,0),   P1[10],P1[11],P1[12],P1[13], pw3[0]=PKW(P1,8), pw3[1]=PKW(P1,10), pw3); \
    VRD(7); SBAR(); GAPA(C1=__builtin_amdgcn_mfma_f32_32x32x16_bf16(kf[7],qr[3],C1,0,0,0),   P1[14],P1[15],0.f,0.f,       pw3[2]=PKW(P1,12),pw3[3]=PKW(P1,14), pw3); \
    C0=__builtin_amdgcn_mfma_f32_32x32x16_bf16(kx0,qx,C0,0,0,0); C1=__builtin_amdgcn_mfma_f32_32x32x16_bf16(kx1,qx,C1,0,0,0); SBAR(); \
    l_reg+=sacc; \
    if(GK){DMA_K((t)+3,sl_cur);} if(GV){DMA_V((t)+1,sl_next);} \
    CMASK(C0,C1,t); \
    { float a=MX3(C0[0],C0[1],C1[0]),b=MX3(C0[2],C0[3],C1[1]); a=MX3(a,C1[2],C1[3]); \
      _Pragma("unroll") for(int r=4;r<16;r+=4){a=MX3(a,C0[r],C0[r+1]);b=MX3(b,C0[r+2],C0[r+3]);a=MX3(a,C1[r],C1[r+1]);b=MX3(b,C1[r+2],C1[r+3]);} \
      float rm=__builtin_fmaxf(a,b); { auto rr=__builtin_amdgcn_permlane32_swap(__float_as_uint(rm),__float_as_uint(rm),false,false); rm=__builtin_fmaxf(__uint_as_float(rr[0]),__uint_as_float(rr[1])); } \
      resc=false; \
      if(__builtin_expect(__any(rm>(float)THRL),0)){ const float dl=__builtin_fmaxf(rm,0.f); mhat+=dl; \
        _Pragma("unroll") for(int r=0;r<16;++r){C0[r]-=dl;C1[r]-=dl;} \
        const float f=__builtin_amdgcn_exp2f(-dl); l_reg*=f; if(hi==0)wsf[r32]=f; resc=true; } } \
    SBAR(); \
    GAPB(o[0]=__builtin_amdgcn_mfma_f32_32x32x16_bf16(PAF(0),VFR(0),o[0],0,0,0), C0,0); \
    GAPB(o[1]=__builtin_amdgcn_mfma_f32_32x32x16_bf16(PAF(0),VFR(4),o[1],0,0,0), C0,4); \
    KRD(GL,0); GAPB(o[0]=__builtin_amdgcn_mfma_f32_32x32x16_bf16(PAF(1),VFR(1),o[0],0,0,0), C0,8); \
    KRD(GL,1); GAPB(o[1]=__builtin_amdgcn_mfma_f32_32x32x16_bf16(PAF(1),VFR(5),o[1],0,0,0), C0,12); \
    KRD(GL,2); GAPB(o[0]=__builtin_amdgcn_mfma_f32_32x32x16_bf16(PAF(2),VFR(2),o[0],0,0,0), C1,0); \
    KRD(GL,3); GAPB(o[1]=__builtin_amdgcn_mfma_f32_32x32x16_bf16(PAF(2),VFR(6),o[1],0,0,0), C1,4); \
    GAPB(o[0]=__builtin_amdgcn_mfma_f32_32x32x16_bf16(PAF(3),VFR(3),o[0],0,0,0), C1,8); \
    GAPB(o[1]=__builtin_amdgcn_mfma_f32_32x32x16_bf16(PAF(3),VFR(7),o[1],0,0,0), C1,12); \
    }while(0)
  int t=1;
  #undef CMASK
  #define CMASK(P0,P1,t) do{}while(0)
  for(;t+5<NT;t+=2){
    STEP(pB0,pB1,pA0,pA1,t,true,true,true);     WAIT_BAR(2); RESC(); ROT();
    STEP(pA0,pA1,pB0,pB1,t+1,true,true,true);   WAIT_BAR(2); RESC(); ROT();
  }
  #undef CMASK
  #define CMASK(P0,P1,t) do{int jb_=(t)-(NT-4); if(WINDOW||(CAUSAL&&jb_>=0))cmask<CAUSAL,WINDOW>(P0,P1,jb_,qrel,hi);}while(0)
  #define ENDW(tt) do{ if((tt)+3<NT){WAIT_BAR(2);} else if((tt)+2<NT){WAIT_BAR(1);} else {WAIT_BAR(0);} }while(0)
  for(;t+1<NT;t+=2){
    STEP(pB0,pB1,pA0,pA1,t,(t+3<NT),(t+1<NT),(t+1<NT));       ENDW(t);   RESC(); ROT();
    STEP(pA0,pA1,pB0,pB1,t+1,(t+4<NT),(t+2<NT),(t+2<NT));     ENDW(t+1); RESC(); ROT();
  }
  STEP(pB0,pB1,pA0,pA1,NT-1,false,false,false); RESC();
  { float sacc=pB0[0]+pB0[1]; _Pragma("unroll") for(int r=2;r<16;++r)sacc+=pB0[r]; _Pragma("unroll") for(int r=0;r<16;++r)sacc+=pB1[r]; l_reg+=sacc;
    pw0=(u32x4){PKW(pB0,0),PKW(pB0,2),PKW(pB0,4),PKW(pB0,6)};pw1=(u32x4){PKW(pB0,8),PKW(pB0,10),PKW(pB0,12),PKW(pB0,14)};pw2=(u32x4){PKW(pB1,0),PKW(pB1,2),PKW(pB1,4),PKW(pB1,6)};pw3=(u32x4){PKW(pB1,8),PKW(pB1,10),PKW(pB1,12),PKW(pB1,14)};
    SBAR(); pv(o,vb0+sl_cur,PAF(0),PAF(1),PAF(2),PAF(3)); }
  #undef PKW
  #undef PAF
  #undef VFR
  #undef PIN
  #undef MX3
  #undef GAPA
  #undef GAPB
  #undef EX
  #undef VRD
  #undef KRD
  #undef STEP
  #undef ENDW
  {auto rr=__builtin_amdgcn_permlane32_swap(__float_as_uint(l_reg),__float_as_uint(l_reg),false,false);l_reg=__uint_as_float(rr[0])+__uint_as_float(rr[1]);}
  if(LSE){ if(hi==0)U.lse[(long)(q0+wid*QBLK+r32)*U.lse_stride]=mhat+__builtin_amdgcn_logf(l_reg); }
  if(hi==0)wsf[32+r32]=l_reg;asm volatile("s_waitcnt lgkmcnt(0)":::"memory");
  float rli[16];
  #pragma unroll
  for(int r=0;r<16;++r)rli[r]=__builtin_amdgcn_rcpf(wsf[32+crow(r,hi)]);
  bf16*Ow=U.O+(long)(q0+wid*QBLK)*op;
  { bf16*stg=(bf16*)(shm+LDS_OST)+wid*2048;
    #pragma unroll
    for(int r=0;r<16;++r){const int orow=crow(r,hi);
      #pragma unroll
      for(int d0=0;d0<2;++d0)stg[orow*64+d0*32+r32]=__float2bfloat16(o[d0][r]*rli[r]);}
    asm volatile("s_waitcnt lgkmcnt(0)":::"memory");
    #pragma unroll
    for(int i=0;i<4;++i){const int row=i*8+(lane>>3),ch=lane&7; const u32x4 v=*(const u32x4*)(stg+row*64+ch*8); ATTN_STORE16(Ow+(long)row*op+ch*8,v);} }
  asm volatile("s_waitcnt lgkmcnt(0)\n\ts_barrier":::"memory");
  #undef DMA_K
  #undef DMA_V
  #undef CMASK
  #undef START
  #undef RESC
  #undef ROT
  #undef QX_SET
}
constexpr int ATTN_LDS_BYTES=LDS_BYTES;
#undef SBAR
#undef WAIT_BAR
}
constexpr size_t MiB = 1u << 20;
constexpr size_t WS_CTL = 0, CTL_ZERO_BYTES = 1 * MiB;
constexpr size_t WS_LIST = 1 * MiB;
constexpr size_t WS_RGATE = 5 * MiB;
constexpr size_t WS_RSTD1 = 5 * MiB + 512 * 1024, WS_RSTD2 = WS_RSTD1 + 128 * 1024, WS_WRG = WS_RSTD2 + 128 * 1024;
constexpr size_t WS_WRT = 7 * MiB + 512 * 1024;
constexpr size_t WS_LSE = 6 * MiB;
constexpr size_t WS_MKV = 8 * MiB;
constexpr size_t WS_WIN = 10 * MiB, WS_WOUT = 15 * MiB, WS_WGU = 17 * MiB, WS_WDN = 145 * MiB;
constexpr size_t WS_XB = 209 * MiB;
constexpr size_t WS_P = 273 * MiB, WS_OD = 433 * MiB, WS_ODIL = 497 * MiB;
constexpr size_t WS_ACT = 273 * MiB;
constexpr size_t WS_MIX = 545 * MiB, WS_X1B = 609 * MiB, WS_YB = 673 * MiB, WS_Y = 929 * MiB, WS_END = 993 * MiB;
constexpr int CW_TMO = 0, CW_CODE = 1;
constexpr int CW_CNT = 64;
constexpr int CW_BAR = 4096;

constexpr int RING_OFF = 0, RING_BYTES = 131072;
constexpr int LDSCTL_OFF = RING_BYTES;
constexpr int IDB_OFF = LDSCTL_OFF;
constexpr int TBL_OFF = IDB_OFF + 3072;
constexpr int LCNT_OFF = TBL_OFF + 2304;
constexpr int MISC_OFF = LCNT_OFF + 256;
constexpr int STG_OFF = MISC_OFF + 128;
constexpr int LDS_BYTES = 147456;
static_assert(STG_OFF + 512 * 12 <= LDS_BYTES, "LDS map");
constexpr int NWAVES = 8;

#define GAS __attribute__((address_space(1)))
#define LAS __attribute__((address_space(3)))
typedef unsigned short bf16;
typedef unsigned v4u __attribute__((ext_vector_type(4)));
typedef unsigned v2u __attribute__((ext_vector_type(2)));
typedef float f32x4 __attribute__((ext_vector_type(4)));
typedef float f32x16 __attribute__((ext_vector_type(16)));
typedef short bf16x8 __attribute__((ext_vector_type(8)));
typedef GAS unsigned gu32;
#define RLX_AGENT __ATOMIC_RELAXED, __HIP_MEMORY_SCOPE_AGENT
#define LDS_WAIT() asm volatile("s_waitcnt lgkmcnt(0)" ::: "memory")
#define VM_WAIT() asm volatile("s_waitcnt vmcnt(0)" ::: "memory")
__device__ __forceinline__ unsigned f2bf(float f) { unsigned u = __builtin_bit_cast(unsigned, f); return (u + 0x7fffu + ((u >> 16) & 1u)) >> 16; }
__device__ __forceinline__ unsigned pk2(float lo, float hi) { return f2bf(lo) | (f2bf(hi) << 16); }
__device__ __forceinline__ float bf2f(unsigned short b) { return __builtin_bit_cast(float, (unsigned)b << 16); }
__device__ __forceinline__ float bflo(unsigned w) { return __builtin_bit_cast(float, w << 16); }
__device__ __forceinline__ float bfhi(unsigned w) { return __builtin_bit_cast(float, w & 0xffff0000u); }
__device__ __forceinline__ float wave_sum(float v) {
#pragma unroll
    for (int o = 1; o < 64; o <<= 1) v += __shfl_xor(v, o);
    return v;
}

#define XB_TMO      128
#define XB_XCNT(j)  (256  + 64 * (j))
#define XB_XSUB(j)  (1280 + 64 * (j))
#define XB_XGEN(j)  (2304 + 64 * (j))
#define XB_TOP      3328
#define XB_TOPGEN   3392
#define XCD_BAR_WORDS 3456
#define XB_SPIN_CAP (1u << 20)
__device__ __forceinline__ unsigned xb_ld(unsigned* p)              { return __hip_atomic_load(p, __ATOMIC_RELAXED, __HIP_MEMORY_SCOPE_AGENT); }
__device__ __forceinline__ unsigned xb_add(unsigned* p, unsigned v) { return __hip_atomic_fetch_add(p, v, __ATOMIC_RELAXED, __HIP_MEMORY_SCOPE_AGENT); }
__device__ __forceinline__ unsigned xb_xcc_id() { return (unsigned)__builtin_amdgcn_s_getreg((3 << 11) | 20) & 0xFu; }
#define XB_SPIN(cond, bar) do { unsigned _sp = 0; while (cond) { __builtin_amdgcn_s_sleep(1); \
    if ((++_sp & 255u) == 0u) { if (xb_ld(&(bar)[XB_TMO])) break; if (_sp > XB_SPIN_CAP) { atomicAdd(&(bar)[XB_TMO], 1u); break; } } } } while (0)
struct XcdBarrier { unsigned* bar; unsigned x; volatile LAS unsigned* st; };
__device__ __forceinline__ XcdBarrier xcd_barrier_post(unsigned* bar, volatile LAS unsigned* st) {
    XcdBarrier b; b.bar = bar; b.x = xb_xcc_id(); b.st = st;
    if (threadIdx.x == 0) (void)xb_add(&bar[XB_XCNT(b.x)], 1u);
    return b;
}
__device__ __forceinline__ void xcd_barrier_complete(unsigned* bar, unsigned x, unsigned& nloc, unsigned& nx) {
    const unsigned G = gridDim.x * gridDim.y * gridDim.z;
    unsigned sum, cnt, mine, sp = 0u;
    for (;;) {
        sum = 0u; cnt = 0u; mine = 0u;
#pragma unroll
        for (unsigned j = 0; j < 16; ++j) { const unsigned c = xb_ld(&bar[XB_XCNT(j)]); sum += c; cnt += (c > 0u) ? 1u : 0u; mine = (j == x) ? c : mine; }
        if (sum == G) break;
        __builtin_amdgcn_s_sleep(1);
        if ((++sp & 255u) == 0u) { if (xb_ld(&bar[XB_TMO])) break; if (sp > XB_SPIN_CAP) { atomicAdd(&bar[XB_TMO], 1u); break; } }
    }
    nloc = mine > 0u ? mine : 1u; nx = cnt > 0u ? cnt : 1u;
}
__device__ __forceinline__ void xcd_barrier(const XcdBarrier& b) {
    asm volatile("s_waitcnt vmcnt(0)" ::: "memory");
    __syncthreads();
    if (threadIdx.x == 0) {
        unsigned* bar = b.bar;
        __builtin_amdgcn_s_waitcnt(0);
        unsigned nloc = b.st[0], nx = b.st[1];
        if (nloc == 0u) { xcd_barrier_complete(bar, b.x, nloc, nx); b.st[0] = nloc; b.st[1] = nx; }
        const unsigned old = xb_add(&bar[XB_XSUB(b.x)], 1u);
        const unsigned gen = old / nloc;
        if (old + 1u == (gen + 1u) * nloc) {
            __builtin_amdgcn_fence(__ATOMIC_RELEASE, "agent");
            asm volatile("s_waitcnt vmcnt(0)" ::: "memory");
            const unsigned og = xb_add(&bar[XB_TOP], 1u);
            const unsigned tg = og / nx;
            if (og + 1u == (tg + 1u) * nx) xb_add(&bar[XB_TOPGEN], 1u);
            else XB_SPIN(xb_ld(&bar[XB_TOPGEN]) == tg, bar);
            __builtin_amdgcn_fence(__ATOMIC_ACQUIRE, "agent");
            xb_add(&bar[XB_XGEN(b.x)], 1u);
            asm volatile("s_waitcnt vmcnt(0)" ::: "memory");
        } else {
            XB_SPIN(xb_ld(&bar[XB_XGEN(b.x)]) == gen, bar);
            __builtin_amdgcn_fence(__ATOMIC_ACQUIRE, "agent");
            asm volatile("s_waitcnt vmcnt(0)" ::: "memory");
        }
    }
    __syncthreads();
}

struct Frame {
    LAS unsigned char* lds;
    volatile LAS unsigned* MISC;
    gu32* ctl;
    int tid, lane, wave;
    int vcu, G;
    const float *x, *mem, *g_attn, *g_mem, *w_in, *lamqk, *subg, *w_mkv, *w_out, *g_ffn, *w_r, *b_r, *w_gu, *b_gu, *w_dn, *b_dn, *g_fin;
    float* out; unsigned char* ws;
};

#define P0_LOAD(dst, itm) do { const int m_ = (itm) / ipm, r_ = (itm) % ipm, kb_ = r_ / nblk, nb_ = r_ % nblk; \
        const float* src_ = W + (size_t)m_ * K * N + (size_t)(64 * kb_ + (lane >> 5)) * N + 32 * nb_ + (lane & 31); \
        _Pragma("unroll") for (int i_ = 0; i_ < 32; ++i_) dst[i_] = src_[(size_t)(2 * i_) * N]; } while (0)
template <class RowMap>
__device__ __forceinline__ void p0_transpose_all(const float* W, int K, int N, int nmat, bf16* WT, const float* gk, LAS float* scr, int gw, int NGW, int lane, RowMap rowmap) {
    const int nblk = N / 32, ipm = (K / 64) * nblk, total = nmat * ipm;
    int it = gw; if (it >= total) return;
    float v[32], w[32];
    P0_LOAD(v, it);
    for (;;) {
        const int nx = it + NGW; const bool more = nx < total;
        if (more) P0_LOAD(w, nx);
        const int m = it / ipm, r = it % ipm, k0 = 64 * (r / nblk), n0 = 32 * (r % nblk);
        if (gk) {
#pragma unroll
            for (int i = 0; i < 32; ++i) v[i] *= gk[k0 + 2 * i + (lane >> 5)];
        }
#pragma unroll
        for (int i = 0; i < 32; ++i) scr[(2 * i + (lane >> 5)) * 33 + (lane & 31)] = v[i];
        LDS_WAIT(); asm volatile("" ::: "memory");
        const int c = lane & 7; bf16* wt = WT + (size_t)m * N * K;
#pragma unroll
        for (int j = 0; j < 4; ++j) { const int n = (lane >> 3) + 8 * j; const LAS float* s = scr + (8 * c) * 33 + n;
            v4u o; o.x = pk2(s[0 * 33], s[1 * 33]); o.y = pk2(s[2 * 33], s[3 * 33]); o.z = pk2(s[4 * 33], s[5 * 33]); o.w = pk2(s[6 * 33], s[7 * 33]);
            *(GAS v4u*)(wt + (size_t)rowmap(n0 + n) * K + k0 + 8 * c) = o; }
        LDS_WAIT(); asm volatile("" ::: "memory");
        if (!more) break;
#pragma unroll
        for (int i = 0; i < 32; ++i) v[i] = w[i];
        it = nx;
    }
}
#undef P0_LOAD
struct RowId { __device__ __forceinline__ int operator()(int n) const { return n; } };
struct RowGU { __device__ __forceinline__ int operator()(int n) const { const int f = n >> 1, u = n & 1; return ((f >> 7) << 8) + (u << 7) + (f & 127); } };

__device__ __forceinline__ void p0_x_rows2(Frame& F, const float* xrow, bf16* orow, float* rstd_out) {
    const GAS f32x4* xr = (const GAS f32x4*)xrow + F.lane;
    f32x4 v[8]; float s0 = 0.f, s1 = 0.f;
#pragma unroll
    for (int j = 0; j < 8; ++j) v[j] = xr[64 * j];
#pragma unroll
    for (int j = 0; j < 4; ++j) { s0 += (v[j].x * v[j].x + v[j].y * v[j].y) + (v[j].z * v[j].z + v[j].w * v[j].w); s1 += (v[4 + j].x * v[4 + j].x + v[4 + j].y * v[4 + j].y) + (v[4 + j].z * v[4 + j].z + v[4 + j].w * v[4 + j].w); }
    s0 = wave_sum(s0); s1 = wave_sum(s1);
    GAS unsigned long long* o8 = (GAS unsigned long long*)orow + F.lane;
#pragma unroll
    for (int j = 0; j < 8; ++j) o8[64 * j] = (unsigned long long)pk2(v[j].x, v[j].y) | ((unsigned long long)pk2(v[j].z, v[j].w) << 32);
    if (F.lane == 0) { rstd_out[0] = 1.f / sqrtf(s0 * (1.f / D) + EPS); rstd_out[1] = 1.f / sqrtf(s1 * (1.f / D) + EPS); }
}
__device__ __forceinline__ void p0_mkv_tile(Frame& F, int tile, bf16* mkv) {
    const int mt = tile >> 4, nt = tile & 15, m0 = 32 * mt, n0 = 32 * nt, r = F.lane & 31, h = F.lane >> 5;
    f32x16 acc = {}; float ss = 0.f;
    const float* mrow = F.mem + (size_t)(m0 + r) * D + 8 * h;
    const float* wcol = F.w_mkv + (size_t)(8 * h) * 512 + n0 + r;
    const float* gp = F.g_mem + 8 * h;
    for (int k0 = 0; k0 < D; k0 += 16) {
        const f32x4 a0 = *(const f32x4*)(mrow + k0), a1 = *(const f32x4*)(mrow + k0 + 4);
        const f32x4 g0 = *(const f32x4*)(gp + k0), g1 = *(const f32x4*)(gp + k0 + 4);
        ss += (a0.x * a0.x + a0.y * a0.y) + (a0.z * a0.z + a0.w * a0.w) + (a1.x * a1.x + a1.y * a1.y) + (a1.z * a1.z + a1.w * a1.w);
        v4u bw; bw.x = pk2(a0.x * g0.x, a0.y * g0.y); bw.y = pk2(a0.z * g0.z, a0.w * g0.w); bw.z = pk2(a1.x * g1.x, a1.y * g1.y); bw.w = pk2(a1.z * g1.z, a1.w * g1.w);
        float wv[8];
#pragma unroll
        for (int j = 0; j < 8; ++j) wv[j] = wcol[(size_t)(k0 + j) * 512];
        v4u aw; aw.x = pk2(wv[0], wv[1]); aw.y = pk2(wv[2], wv[3]); aw.z = pk2(wv[4], wv[5]); aw.w = pk2(wv[6], wv[7]);
        acc = __builtin_amdgcn_mfma_f32_32x32x16_bf16(__builtin_bit_cast(bf16x8, aw), __builtin_bit_cast(bf16x8, bw), acc, 0, 0, 0);
    }
    ss += __shfl_xor(ss, 32);
    const float rstd = 1.f / sqrtf(ss * (1.f / D) + EPS);
    bf16* orow = mkv + (size_t)(m0 + r) * 512 + n0 + 4 * h;
#pragma unroll
    for (int q = 0; q < 4; ++q) { v2u o; o.x = pk2(acc[4 * q] * rstd, acc[4 * q + 1] * rstd); o.y = pk2(acc[4 * q + 2] * rstd, acc[4 * q + 3] * rstd); *(GAS v2u*)(orow + 8 * q) = o; }
}
__device__ __forceinline__ void p0_prologue(Frame& F) {
    LAS float* scr = (LAS float*)(F.lds + RING_OFF + F.wave * 16384);
    const int gw = F.vcu * NWAVES + F.wave, NGW = F.G * NWAVES;
    bf16* win_t = (bf16*)(F.ws + WS_WIN); bf16* wout_t = (bf16*)(F.ws + WS_WOUT); bf16* wgu_t = (bf16*)(F.ws + WS_WGU); bf16* wdn_t = (bf16*)(F.ws + WS_WDN);
    p0_transpose_all(F.w_gu, D, 2 * DFF, NE, wgu_t, F.g_ffn, scr, gw, NGW, F.lane, RowGU());
    p0_transpose_all(F.w_dn, DFF, D, NE, wdn_t, nullptr, scr, gw, NGW, F.lane, RowId());
    p0_transpose_all(F.w_in, D, DIN, 1, win_t, F.g_attn, scr, gw, NGW, F.lane, RowId());
    p0_transpose_all(F.w_out, D, D, 1, wout_t, nullptr, scr, gw, NGW, F.lane, RowId());
    bf16* xb = (bf16*)(F.ws + WS_XB); float* rstd1 = (float*)(F.ws + WS_RSTD1);
    for (int m = 2 * gw; m < T; m += 2 * NGW) p0_x_rows2(F, F.x + (size_t)m * D, xb + (size_t)m * D, rstd1 + m);
    bf16* mkv = (bf16*)(F.ws + WS_MKV);
    for (int t = gw; t < (BATCH * NMEM / 32) * (512 / 32); t += NGW) p0_mkv_tile(F, t, mkv);
    bf16* wrt = (bf16*)(F.ws + WS_WRT);
    for (int i = gw * 64 + F.lane; i < D * NE; i += NGW * 64) { const int e = i >> 10, k = i & 1023; const float w = F.w_r[k * NE + e] * F.g_ffn[k]; const unsigned hb = f2bf(w); wrt[i] = (bf16)hb; wrt[D * NE + i] = (bf16)f2bf(w - bf2f((bf16)hb)); }
}

struct EpiInProj {
    bf16* O; const float* rstd;
    __device__ __forceinline__ void operator()(const pg8::f32x4 (&acc)[2][2][4][2], const pg8::Unit& u, int wr, int wc, int fr, int fq, const LAS unsigned*) const {
        const int row0 = u.pm * 256 + wr * 64 + fr, col0 = u.pn * 256 + wc * 32 + 8 * fq;
        const float sc = (u.pn <= 1 || u.pn == 6 || u.pn == 9) ? QSCALE : 1.f;
        float rsv[2][4];
#pragma unroll
        for (int ai = 0; ai < 2; ++ai)
#pragma unroll
            for (int m = 0; m < 4; ++m) rsv[ai][m] = rstd[row0 + ai * 128 + m * 16];
#pragma unroll
        for (int ai = 0; ai < 2; ++ai)
#pragma unroll
            for (int m = 0; m < 4; ++m) { const int row = row0 + ai * 128 + m * 16; const float rs = rsv[ai][m] * sc; bf16* rowp = O + (size_t)row * DIN + col0;
#pragma unroll
                for (int bj = 0; bj < 2; ++bj) { const pg8::f32x4 v0 = acc[ai][bj][m][0] * rs, v1 = acc[ai][bj][m][1] * rs;
                    v4u w; w.x = pg8::cvt_pk_bf16(v0[0], v0[1]); w.y = pg8::cvt_pk_bf16(v0[2], v0[3]); w.z = pg8::cvt_pk_bf16(v1[0], v1[1]); w.w = pg8::cvt_pk_bf16(v1[2], v1[3]);
                    *(v4u*)(rowp + bj * 128) = w; } }
    }
};
__device__ __forceinline__ void attn_phase(Frame& F, char* shm, int gmask = 7) {
    using namespace attn_body;
    const int v = F.vcu;
    const attn_body::bf16* P = (const attn_body::bf16*)(F.ws + WS_P);
    attn_body::bf16* OD = (attn_body::bf16*)(F.ws + WS_OD);
    attn_body::bf16* mix = (attn_body::bf16*)(F.ws + WS_MIX);
    float lam;
    { const float a = F.lamqk[F.lane] * F.lamqk[64 + F.lane], c = F.lamqk[128 + F.lane] * F.lamqk[192 + F.lane];
      lam = __expf(wave_sum(a)) - __expf(wave_sum(c)) + 0.2f; }
#if !defined(ATT_ONLY) || ATT_ONLY==1
    if ((gmask & 1) && v < BATCH * 4 * 8) {
        const int bh = v >> 3, s = v & 7, b = bh >> 2, h = bh & 3;
        const attn_body::bf16* Pb = P + (size_t)b * SEQ * DIN;
        const float slope = exp2f(-(float)(2 * h + 1)) * LOG2E;
        for (int i2 = 0; i2 < 2; ++i2) {
            const int qb = i2 ? 15 - s : s;
            for (int pass = 0; pass < 4; ++pass) {
                const int j = pass >> 1, vh = pass & 1;
                UnitP U; U.Q = Pb + C_DQ + h * 128 + j * 64; U.K = Pb + C_DK + h * 128 + j * 64; U.V = Pb + C_DV + h * 128 + vh * 64;
                U.O = OD + (size_t)b * SEQ * 1024 + h * 256 + j * 128 + vh * 64; U.qp = DIN; U.kp = DIN; U.op = 1024;
                U.q0 = qb * 256; U.t0 = 0; U.NT = 4 * qb + 4; U.slope2 = slope; U.lse = nullptr; U.lse_stride = 0;
                attn_unit<8, true, false, true, false>(U, shm);
            }
            asm volatile("s_waitcnt vmcnt(0)" ::: "memory");
            const int row = (b * SEQ + qb * 256 + F.wave * 32 + (F.lane >> 1)), vh = F.lane & 1;
            const v4u* o1 = (const v4u*)(OD + (size_t)row * 1024 + h * 256 + vh * 64);
            const v4u* o2 = (const v4u*)(OD + (size_t)row * 1024 + h * 256 + 128 + vh * 64);
            float d[64]; float ss = 0.f;
#pragma unroll
            for (int c = 0; c < 8; ++c) { const v4u a = o1[c], bq = o2[c];
                const unsigned aw[4] = {a.x, a.y, a.z, a.w}, bw[4] = {bq.x, bq.y, bq.z, bq.w};
#pragma unroll
                for (int q = 0; q < 4; ++q) { const float x0 = bflo(aw[q]) - lam * bflo(bw[q]), x1 = bfhi(aw[q]) - lam * bfhi(bw[q]); d[8 * c + 2 * q] = x0; d[8 * c + 2 * q + 1] = x1; ss += x0 * x0 + x1 * x1; } }
            ss += __shfl_xor(ss, 1);
            const float rstd = 0.8f / sqrtf(ss * (1.f / 128.f) + EPS);
            const float* gp = F.subg + vh * 64;
            v4u* mo = (v4u*)(mix + (size_t)row * 1024 + h * 128 + vh * 64);
#pragma unroll
            for (int c = 0; c < 8; ++c) { v4u o; o.x = pk2(d[8 * c] * rstd * gp[8 * c], d[8 * c + 1] * rstd * gp[8 * c + 1]); o.y = pk2(d[8 * c + 2] * rstd * gp[8 * c + 2], d[8 * c + 3] * rstd * gp[8 * c + 3]);
                o.z = pk2(d[8 * c + 4] * rstd * gp[8 * c + 4], d[8 * c + 5] * rstd * gp[8 * c + 5]); o.w = pk2(d[8 * c + 6] * rstd * gp[8 * c + 6], d[8 * c + 7] * rstd * gp[8 * c + 7]); mo[c] = o; }
        }
    }
#endif
#if !defined(ATT_ONLY) || ATT_ONLY==2
    attn_body::bf16* ODIL = (attn_body::bf16*)(F.ws + WS_ODIL); float* LSEb = (float*)(F.ws + WS_LSE);
    for (int i = 0; i < 6; ++i) {
        const int du = v * 6 + i; if (!(gmask & 2) || du >= BATCH * 4 * 48) break;
        const int bh = du / 48, idx = du % 48, n = idx >> 4, w = idx & 15, b = bh >> 2, h = bh & 3;
        const int r = (n == 0) ? 1 : (n == 1 ? 4 : 16), c = (n == 0) ? 0 : (n == 1 ? (w >> 2) : w), blk = (n == 0) ? w : (n == 1 ? (w & 3) : 0);
        const attn_body::bf16* Pb = P + ((size_t)b * SEQ + c) * DIN;
        UnitP U; U.Q = Pb + C_LQ + h * 64; U.K = Pb + C_LK + h * 64; U.V = Pb + C_LV + h * 64; U.qp = (long)r * DIN; U.kp = (long)r * DIN;
        U.O = ODIL + (size_t)n * T * 256 + ((size_t)b * SEQ + c) * 256 + h * 64; U.op = (long)r * 256;
        U.q0 = blk * 256; U.t0 = (blk == 0) ? 0 : 4 * blk - 2; U.NT = 4 * blk + 4 - U.t0;
        U.slope2 = exp2f(-(float)(2 * h + 2)) * (float)r * LOG2E;
        U.lse = LSEb + (size_t)n * T * 4 + ((size_t)b * SEQ + c) * 4 + h; U.lse_stride = r * 4;
        attn_unit<8, true, true, true, true>(U, shm);
    }
#endif
#if !defined(ATT_ONLY) || ATT_ONLY==3
    const attn_body::bf16* MKV = (const attn_body::bf16*)(F.ws + WS_MKV);
    for (int i = 0; i < 2; ++i) {
        const int mu = v * 2 + i; if (!(gmask & 4) || mu >= BATCH * 4 * 16) break;
        const int bh = mu >> 4, qb = mu & 15, b = bh >> 2, h = bh & 3;
        UnitP U; U.Q = P + (size_t)b * SEQ * DIN + C_MQ + h * 64; U.qp = DIN; U.K = MKV + (size_t)b * NMEM * 512 + h * 64; U.V = U.K + 256; U.kp = 512;
        U.O = mix + (size_t)b * SEQ * 1024 + 768 + h * 64; U.op = 1024; U.q0 = qb * 256; U.t0 = 0; U.NT = 4; U.slope2 = 0.f; U.lse = nullptr; U.lse_stride = 0;
        attn_unit<8, false, false, false, false>(U, shm);
    }
#endif
}
__device__ __forceinline__ void dil_combine_phase(Frame& F) {
    const int gw = F.vcu * NWAVES + F.wave, NGW = F.G * NWAVES;
    const bf16* ODIL = (const bf16*)(F.ws + WS_ODIL); const float* LSEb = (const float*)(F.ws + WS_LSE); bf16* mix = (bf16*)(F.ws + WS_MIX);
    const int h = F.lane >> 4, d4 = (F.lane & 15) * 4;
    for (int row0 = 4 * gw; row0 < T; row0 += 4 * NGW) {
        float l[4][3]; v2u q[4][3];
#pragma unroll
        for (int i = 0; i < 4; ++i)
#pragma unroll
            for (int n = 0; n < 3; ++n) { l[i][n] = LSEb[(size_t)n * T * 4 + (size_t)(row0 + i) * 4 + h]; q[i][n] = *(const v2u*)(ODIL + (size_t)n * T * 256 + (size_t)(row0 + i) * 256 + h * 64 + d4); }
#pragma unroll
        for (int i = 0; i < 4; ++i) {
            const float m = fmaxf(fmaxf(l[i][0], l[i][1]), l[i][2]);
            float wn[3], den = 0.f;
#pragma unroll
            for (int n = 0; n < 3; ++n) { wn[n] = exp2f(l[i][n] - m); den += wn[n]; }
            const float inv = 1.f / den; float o[4] = {0.f, 0.f, 0.f, 0.f};
#pragma unroll
            for (int n = 0; n < 3; ++n) { const float wq = wn[n] * inv; o[0] += wq * bflo(q[i][n].x); o[1] += wq * bfhi(q[i][n].x); o[2] += wq * bflo(q[i][n].y); o[3] += wq * bfhi(q[i][n].y); }
            v2u ov; ov.x = pk2(o[0], o[1]); ov.y = pk2(o[2], o[3]);
            *(v2u*)(mix + (size_t)(row0 + i) * 1024 + 512 + h * 64 + d4) = ov;
        }
    }
}
struct EpiY {
    bf16* Y;
    __device__ __forceinline__ void operator()(const pg8::f32x4 (&acc)[2][2][4][2], const pg8::Unit& u, int wr, int wc, int fr, int fq, const LAS unsigned*) const {
        const int row0 = u.pm * 256 + wr * 64 + fr, col0 = u.pn * 256 + wc * 32 + 8 * fq;
#pragma unroll
        for (int ai = 0; ai < 2; ++ai)
#pragma unroll
            for (int m = 0; m < 4; ++m) { bf16* rowp = Y + (size_t)(row0 + ai * 128 + m * 16) * D + col0;
#pragma unroll
                for (int bj = 0; bj < 2; ++bj) { const pg8::f32x4 v0 = acc[ai][bj][m][0], v1 = acc[ai][bj][m][1];
                    v4u w; w.x = pg8::cvt_pk_bf16(v0[0], v0[1]); w.y = pg8::cvt_pk_bf16(v0[2], v0[3]); w.z = pg8::cvt_pk_bf16(v1[0], v1[1]); w.w = pg8::cvt_pk_bf16(v1[2], v1[3]);
                    *(v4u*)(rowp + bj * 128) = w; } }
    }
};

__device__ __forceinline__ void route_phase(Frame& F) {
    LAS float* xch = (LAS float*)(F.lds + RING_OFF);
    LAS unsigned* lcnt = (LAS unsigned*)(F.lds + LCNT_OFF);
    LAS unsigned* stg = (LAS unsigned*)(F.lds + STG_OFF);
    if (F.tid < 64) lcnt[F.tid] = 0u;
    const int lane = F.lane, tl = lane & 31, h = lane >> 5, tg = F.wave & 3, kh = F.wave >> 2;
    { const v4u* wsrc = (const v4u*)(F.ws + WS_WRT); LAS char* wl = (LAS char*)(F.lds + RING_OFF);
      for (int i = F.tid; i < 2 * 32 * 128; i += NWAVES * 64) { const int hl = i >> 12, e = (i >> 7) & 31, c = i & 127; *(LAS v4u*)(wl + hl * 65536 + e * 2048 + ((c ^ (e & 15)) << 4)) = wsrc[i]; } }
    __syncthreads();
    const int tok = F.vcu * 128 + tg * 32 + tl;
    const float* xr = F.x + (size_t)tok * D + kh * 512 + 8 * h;
    const bf16* yr = (const bf16*)(F.ws + WS_Y) + (size_t)tok * D + kh * 512 + 8 * h;
    bf16* x1r = (bf16*)(F.ws + WS_X1B) + (size_t)tok * D + kh * 512 + 8 * h;
    const LAS char* wrow = (const LAS char*)(F.lds + RING_OFF) + tl * 2048;
    f32x16 acc = {}; float ss = 0.f;
    f32x4 xa[2][8]; v4u ya[2][4];
#define RT_LOAD(buf, g) do { _Pragma("unroll") for (int q_ = 0; q_ < 4; ++q_) { xa[buf][2 * q_] = *(const f32x4*)(xr + 64 * (g) + 16 * q_); xa[buf][2 * q_ + 1] = *(const f32x4*)(xr + 64 * (g) + 16 * q_ + 4); \
        ya[buf][q_] = *(const v4u*)(yr + 64 * (g) + 16 * q_); } } while (0)
#define RT_COMP(buf, g) do { _Pragma("unroll") for (int q_ = 0; q_ < 4; ++q_) { const int c_ = (kh * 512 + 64 * (g) + 16 * q_) / 8 + h; \
        const v4u wh = *(const LAS v4u*)(wrow + ((c_ ^ (tl & 15)) << 4)), wl2 = *(const LAS v4u*)(wrow + 65536 + ((c_ ^ (tl & 15)) << 4)); \
        const f32x4 a0 = xa[buf][2 * q_], a1 = xa[buf][2 * q_ + 1]; const v4u yv = ya[buf][q_]; \
        const float x1[8] = {a0.x + bflo(yv.x), a0.y + bfhi(yv.x), a0.z + bflo(yv.y), a0.w + bfhi(yv.y), a1.x + bflo(yv.z), a1.y + bfhi(yv.z), a1.z + bflo(yv.w), a1.w + bfhi(yv.w)}; \
        unsigned hw[4], lw[4]; \
        _Pragma("unroll") for (int p_ = 0; p_ < 4; ++p_) { const float u_ = x1[2 * p_], r_ = x1[2 * p_ + 1]; ss += u_ * u_ + r_ * r_; const unsigned hb = pk2(u_, r_); hw[p_] = hb; lw[p_] = pk2(u_ - bflo(hb), r_ - bfhi(hb)); } \
        const v4u xh = (v4u){hw[0], hw[1], hw[2], hw[3]}, xl = (v4u){lw[0], lw[1], lw[2], lw[3]}; \
        *(v4u*)(x1r + 64 * (g) + 16 * q_) = xh; \
        acc = __builtin_amdgcn_mfma_f32_32x32x16_bf16(__builtin_bit_cast(bf16x8, wh), __builtin_bit_cast(bf16x8, xh), acc, 0, 0, 0); \
        acc = __builtin_amdgcn_mfma_f32_32x32x16_bf16(__builtin_bit_cast(bf16x8, wh), __builtin_bit_cast(bf16x8, xl), acc, 0, 0, 0); \
        acc = __builtin_amdgcn_mfma_f32_32x32x16_bf16(__builtin_bit_cast(bf16x8, wl2), __builtin_bit_cast(bf16x8, xh), acc, 0, 0, 0); } } while (0)
    RT_LOAD(0, 0);
#pragma unroll
    for (int g = 0; g < 8; g += 2) {
        RT_LOAD(1, g + 1); RT_COMP(0, g);
        if (g + 2 < 8) RT_LOAD(0, g + 2);
        RT_COMP(1, g + 1);
    }
#undef RT_LOAD
#undef RT_COMP
    __syncthreads();
    if (kh == 1) { LAS float* d = xch + (tg * 64 + lane) * 17;
#pragma unroll
        for (int i = 0; i < 16; ++i) d[i] = acc[i];
        d[16] = ss; }
    __syncthreads();
    if (kh == 0) {
        const LAS float* d = xch + (tg * 64 + lane) * 17;
#pragma unroll
        for (int i = 0; i < 16; ++i) acc[i] += d[i];
        ss += d[16]; ss += __shfl_xor(ss, 32);
        const float rstd = 1.f / sqrtf(ss * (1.f / D) + EPS);
        float lg[16];
#pragma unroll
        for (int i = 0; i < 16; ++i) lg[i] = acc[i] * rstd + F.b_r[4 * h + (i & 3) + 8 * (i >> 2)];
        float cv[8]; int ce[8];
#pragma unroll
        for (int k = 0; k < 4; ++k) { float bv = -INFINITY; int bi = 0;
#pragma unroll
            for (int i = 0; i < 16; ++i) { if (lg[i] > bv) { bv = lg[i]; bi = i; } }
            cv[k] = bv; ce[k] = 4 * h + (bi & 3) + 8 * (bi >> 2);
#pragma unroll
            for (int i = 0; i < 16; ++i) if (i == bi) lg[i] = -INFINITY; }
#pragma unroll
        for (int k = 0; k < 4; ++k) { cv[4 + k] = __shfl_xor(cv[k], 32); ce[4 + k] = __shfl_xor(ce[k], 32); }
        float tv[4]; int te[4];
#pragma unroll
        for (int k = 0; k < 4; ++k) { float bv = -INFINITY; int be = 64, bi = 0;
#pragma unroll
            for (int i = 0; i < 8; ++i) { if (cv[i] > bv || (cv[i] == bv && ce[i] < be)) { bv = cv[i]; be = ce[i]; bi = i; } }
            tv[k] = bv; te[k] = be;
#pragma unroll
            for (int i = 0; i < 8; ++i) if (i == bi) cv[i] = -INFINITY; }
        float gk[4], den = 0.f;
#pragma unroll
        for (int k = 0; k < 4; ++k) { gk[k] = __expf(tv[k] - tv[0]); den += gk[k]; }
        const float inv = 1.f / den;
        if (h == 0) {
#pragma unroll
            for (int k = 0; k < 4; ++k) {
                const unsigned rank = __hip_atomic_fetch_add(lcnt + te[k], 1u, __ATOMIC_RELAXED, __HIP_MEMORY_SCOPE_WORKGROUP);
                const int slot = (tg * 32 + tl) * 4 + k;
                stg[slot * 3] = (unsigned)(tok * 4 + k); stg[slot * 3 + 1] = ((unsigned)te[k] << 16) | rank; stg[slot * 3 + 2] = __builtin_bit_cast(unsigned, gk[k] * inv);
            }
            ((float*)(F.ws + WS_RSTD2))[tok] = rstd;
        }
    }
    __syncthreads();
    if (F.tid < 32) { const unsigned n = lcnt[F.tid]; lcnt[32 + F.tid] = n ? __hip_atomic_fetch_add((unsigned*)(F.ctl + CW_CNT) + F.tid, n, __ATOMIC_RELAXED, __HIP_MEMORY_SCOPE_AGENT) : 0u; }
    __syncthreads();
    { unsigned* list = (unsigned*)(F.ws + WS_LIST); float* rgate = (float*)(F.ws + WS_RGATE);
      const unsigned ent = stg[F.tid * 3], er = stg[F.tid * 3 + 1], gb = stg[F.tid * 3 + 2]; const unsigned e = er >> 16, rank = er & 0xffffu;
      list[(size_t)e * LCAP + lcnt[32 + e] + rank] = ent; rgate[ent] = __builtin_bit_cast(float, gb); }
    __syncthreads();
}

__device__ __forceinline__ int moe_build_table(Frame& F) {
    LAS unsigned* tbl = (LAS unsigned*)(F.lds + TBL_OFF); LAS unsigned* lcnt = (LAS unsigned*)(F.lds + LCNT_OFF);
    if (F.wave == 0) {
        const int e = F.lane & 31;
        const unsigned cnt = __hip_atomic_load((unsigned*)(F.ctl + CW_CNT) + e, __ATOMIC_RELAXED, __HIP_MEMORY_SCOPE_AGENT);
        const unsigned nt = (cnt + 255u) >> 8; unsigned incl = nt;
#pragma unroll
        for (int o = 1; o < 32; o <<= 1) { const unsigned t = __shfl_up(incl, o); if ((F.lane & 31) >= o) incl += t; }
        if (F.lane < 32) { lcnt[e] = cnt; const unsigned start = incl - nt; for (unsigned j = 0; j < nt; ++j) tbl[start + j] = ((unsigned)e << 16) | j; if (F.lane == 31) F.MISC[16] = incl; }
    }
    __syncthreads();
    return (int)F.MISC[16];
}
struct MoeOrder {
    const LAS unsigned* tbl; const LAS unsigned* lcnt; const unsigned* list; int NMT, G, c, NPN, MPER, K; size_t bexp; bool a_tiles;
    __device__ __forceinline__ bool next(int i, pg8::Unit& u) const {
        const int L = i * G + c, blk = L >> 5, w = L & 31, g = blk * MPER + w / NPN, pn = w % NPN;
        if (g >= NMT) return false;
        const unsigned t = tbl[g]; const int e = (int)(t >> 16), mt = (int)(t & 0xffffu); const int cnt = (int)lcnt[e];
        u.pm = g; u.pn = pn; u.e = e; u.mt = mt; u.valid = min(256, cnt - mt * 256);
        u.aoff = a_tiles ? (size_t)g * (size_t)(256 * K * 2) : (size_t)0; u.boff = (size_t)e * bexp + (size_t)pn * (size_t)(256 * K * 2);
        return true;
    }
    __device__ __forceinline__ const unsigned* id_src(const pg8::Unit& u, int row) const { return list + (size_t)u.e * LCAP + u.mt * 256 + min(row, u.valid - 1); }
};
struct EpiGU {
    bf16* ACT; const float* rstd2; const float* bgu;
    __device__ __forceinline__ void operator()(const pg8::f32x4 (&acc)[2][2][4][2], const pg8::Unit& u, int wr, int wc, int fr, int fq, const LAS unsigned* ids) const {
        const int r0 = wr * 64 + fr, f0 = u.pn * 128 + wc * 32 + 8 * fq;
        float rs[2][4];
#pragma unroll
        for (int ai = 0; ai < 2; ++ai)
#pragma unroll
            for (int m = 0; m < 4; ++m) rs[ai][m] = rstd2[ids[r0 + ai * 128 + m * 16] >> 2];
        const float* bp = bgu + (size_t)u.e * 2048 + 2 * f0;
        const pg8::f32x4 b0 = *(const pg8::f32x4*)bp, b1 = *(const pg8::f32x4*)(bp + 4), b2 = *(const pg8::f32x4*)(bp + 8), b3 = *(const pg8::f32x4*)(bp + 12);
        const float gb[8] = {b0[0], b0[2], b1[0], b1[2], b2[0], b2[2], b3[0], b3[2]}, ub[8] = {b0[1], b0[3], b1[1], b1[3], b2[1], b2[3], b3[1], b3[3]};
#pragma unroll
        for (int ai = 0; ai < 2; ++ai)
#pragma unroll
            for (int m = 0; m < 4; ++m) { const int r = r0 + ai * 128 + m * 16; const float s = rs[ai][m]; float a[8];
#pragma unroll
                for (int n = 0; n < 2; ++n)
#pragma unroll
                    for (int j = 0; j < 4; ++j) { float gate = acc[ai][0][m][n][j] * s + gb[4 * n + j], up = acc[ai][1][m][n][j] * s + ub[4 * n + j];
                        gate = fminf(gate, 7.f); up = fminf(fmaxf(up, -7.f), 7.f);
                        a[4 * n + j] = (up + 1.f) * gate * __builtin_amdgcn_rcpf(1.f + __builtin_amdgcn_exp2f(-1.702f * LOG2E * gate)); }
                v4u w; w.x = pg8::cvt_pk_bf16(a[0], a[1]); w.y = pg8::cvt_pk_bf16(a[2], a[3]); w.z = pg8::cvt_pk_bf16(a[4], a[5]); w.w = pg8::cvt_pk_bf16(a[6], a[7]);
                *(v4u*)(ACT + (size_t)(u.pm * 256 + r) * DFF + f0) = w; }
    }
};
struct EpiDown {
    bf16* YB; const float* rgate; const float* bdn;
    __device__ __forceinline__ void operator()(const pg8::f32x4 (&acc)[2][2][4][2], const pg8::Unit& u, int wr, int wc, int fr, int fq, const LAS unsigned* ids) const {
        const int r0 = wr * 64 + fr, col0 = u.pn * 256 + wc * 32 + 8 * fq;
        unsigned en[2][4]; float gt[2][4];
#pragma unroll
        for (int ai = 0; ai < 2; ++ai)
#pragma unroll
            for (int m = 0; m < 4; ++m) { en[ai][m] = ids[r0 + ai * 128 + m * 16]; gt[ai][m] = rgate[en[ai][m]]; }
        pg8::f32x4 bv[2][2];
#pragma unroll
        for (int bj = 0; bj < 2; ++bj)
#pragma unroll
            for (int n = 0; n < 2; ++n) bv[bj][n] = *(const pg8::f32x4*)(bdn + (size_t)u.e * D + col0 + bj * 128 + 4 * n);
#pragma unroll
        for (int ai = 0; ai < 2; ++ai)
#pragma unroll
            for (int m = 0; m < 4; ++m) { const int r = r0 + ai * 128 + m * 16; if (r < u.valid) { const float g = gt[ai][m]; bf16* yp = YB + (size_t)en[ai][m] * D + col0;
#pragma unroll
                for (int bj = 0; bj < 2; ++bj) { const pg8::f32x4 v0 = (acc[ai][bj][m][0] + bv[bj][0]) * g, v1 = (acc[ai][bj][m][1] + bv[bj][1]) * g;
                    v4u w; w.x = pg8::cvt_pk_bf16(v0[0], v0[1]); w.y = pg8::cvt_pk_bf16(v0[2], v0[3]); w.z = pg8::cvt_pk_bf16(v1[0], v1[1]); w.w = pg8::cvt_pk_bf16(v1[2], v1[3]);
                    *(v4u*)(yp + bj * 128) = w; } } }
    }
};
__device__ __forceinline__ void final_phase(Frame& F) {
    const int gw = F.vcu * NWAVES + F.wave, NGW = F.G * NWAVES;
    const bf16* YB = (const bf16*)(F.ws + WS_YB);
    for (int t = gw; t < T; t += NGW) {
        float v[16]; float ss = 0.f;
#pragma unroll
        for (int jj = 0; jj < 2; ++jj) { const int c = 512 * jj + 8 * F.lane;
            const f32x4 a = *(const f32x4*)(F.x + (size_t)t * D + c), b = *(const f32x4*)(F.x + (size_t)t * D + c + 4);
            const v4u y0 = *(const v4u*)((const bf16*)(F.ws + WS_Y) + (size_t)t * D + c);
            float* vv = v + 8 * jj; vv[0] = a.x + bflo(y0.x); vv[1] = a.y + bfhi(y0.x); vv[2] = a.z + bflo(y0.y); vv[3] = a.w + bfhi(y0.y); vv[4] = b.x + bflo(y0.z); vv[5] = b.y + bfhi(y0.z); vv[6] = b.z + bflo(y0.w); vv[7] = b.w + bfhi(y0.w);
#pragma unroll
            for (int k = 0; k < 4; ++k) { const v4u y = *(const v4u*)(YB + ((size_t)t * 4 + k) * D + c);
                vv[0] += bflo(y.x); vv[1] += bfhi(y.x); vv[2] += bflo(y.y); vv[3] += bfhi(y.y); vv[4] += bflo(y.z); vv[5] += bfhi(y.z); vv[6] += bflo(y.w); vv[7] += bfhi(y.w); } }
#pragma unroll
        for (int i = 0; i < 16; ++i) ss += v[i] * v[i];
        const float rstd = 1.f / sqrtf(wave_sum(ss) * (1.f / D) + EPS);
#pragma unroll
        for (int jj = 0; jj < 2; ++jj) { const int c = 512 * jj + 8 * F.lane; const f32x4 g0 = *(const f32x4*)(F.g_fin + c), g1 = *(const f32x4*)(F.g_fin + c + 4); const float* vv = v + 8 * jj;
            f32x4 o0, o1; o0.x = vv[0] * rstd * g0.x; o0.y = vv[1] * rstd * g0.y; o0.z = vv[2] * rstd * g0.z; o0.w = vv[3] * rstd * g0.w;
            o1.x = vv[4] * rstd * g1.x; o1.y = vv[5] * rstd * g1.y; o1.z = vv[6] * rstd * g1.z; o1.w = vv[7] * rstd * g1.w;
            *(f32x4*)(F.out + (size_t)t * D + c) = o0; *(f32x4*)(F.out + (size_t)t * D + c + 4) = o1; }
    }
}
struct Args { const float* in[17]; float* out; unsigned char* ws; int ph_lo, ph_hi, use_bar, pad; };
__global__ void __launch_bounds__(NWAVES * 64, 2) mk_fwd(Args args) {
    extern __shared__ __attribute__((aligned(16))) unsigned char lds[];
    Frame F;
    F.lds = (LAS unsigned char*)lds;
    F.MISC = (volatile LAS unsigned*)(F.lds + MISC_OFF);
    F.tid = threadIdx.x; F.lane = F.tid & 63; F.wave = __builtin_amdgcn_readfirstlane(F.tid >> 6);
    F.G = gridDim.x; { const int bx = blockIdx.x; F.vcu = (F.G % 8 == 0) ? (bx % 8) * (F.G / 8) + bx / 8 : bx; }
    F.ws = args.ws; F.out = args.out; F.ctl = (gu32*)(args.ws + WS_CTL);
    F.x = args.in[0]; F.mem = args.in[1]; F.g_attn = args.in[2]; F.g_mem = args.in[3]; F.w_in = args.in[4]; F.lamqk = args.in[5]; F.subg = args.in[6]; F.w_mkv = args.in[7];
    F.w_out = args.in[8]; F.g_ffn = args.in[9]; F.w_r = args.in[10]; F.b_r = args.in[11]; F.w_gu = args.in[12]; F.b_gu = args.in[13]; F.w_dn = args.in[14]; F.b_dn = args.in[15]; F.g_fin = args.in[16];
    for (int u = F.tid; u < (LDS_BYTES - LDSCTL_OFF) / 4; u += NWAVES * 64) ((LAS unsigned*)(F.lds + LDSCTL_OFF))[u] = 0u;
    __syncthreads();
    XcdBarrier bar; bar.bar = (unsigned*)(F.ctl + CW_BAR); bar.x = 0; bar.st = nullptr;
    if (args.use_bar) bar = xcd_barrier_post((unsigned*)(F.ctl + CW_BAR), F.MISC + 8);
    const int lo = args.ph_lo, hi = args.ph_hi;
#define IN(k) (lo <= (k) && (k) < hi)
#define SEAM(k) do { if (IN(k) && IN((k) + 1)) xcd_barrier(bar); } while (0)
    if (IN(0)) { p0_prologue(F); } SEAM(0);
    if (IN(1)) {
        pg8::Gemm g{(const bf16*)(F.ws + WS_XB), (const bf16*)(F.ws + WS_WIN), D}; pg8::StaticOrder S; S.init(T, DIN, D, F.G, (int)blockIdx.x);
        EpiInProj E{(bf16*)(F.ws + WS_P), (const float*)(F.ws + WS_RSTD1)};
        pg8::gemm_phase<EpiInProj, pg8::StaticOrder, true, false, false>(F.lds + RING_OFF, (LAS unsigned*)(F.lds + IDB_OFF), g, S, E);
    } SEAM(1);
    if (IN(2)) { attn_phase(F, (char*)lds + RING_OFF); } SEAM(2);
    if (IN(3)) { dil_combine_phase(F); } SEAM(3);
    if (IN(4)) {
        pg8::Gemm g{(const bf16*)(F.ws + WS_MIX), (const bf16*)(F.ws + WS_WOUT), D}; pg8::StaticOrder S; S.init(T, D, D, F.G, (int)blockIdx.x);
        EpiY E{(bf16*)(F.ws + WS_Y)};
        pg8::gemm_phase<EpiY, pg8::StaticOrder, true, false, false>(F.lds + RING_OFF, (LAS unsigned*)(F.lds + IDB_OFF), g, S, E);
    } SEAM(4);
    if (IN(5)) { route_phase(F); } SEAM(5);
    if (IN(6)) {
        const int nmt = moe_build_table(F);
        pg8::Gemm g{(const bf16*)(F.ws + WS_X1B), (const bf16*)(F.ws + WS_WGU), D};
        MoeOrder S{(const LAS unsigned*)(F.lds + TBL_OFF), (const LAS unsigned*)(F.lds + LCNT_OFF), (const unsigned*)(F.ws + WS_LIST), nmt, F.G, F.vcu, 8, 4, D, (size_t)2 * DFF * D * 2, false};
        EpiGU E{(bf16*)(F.ws + WS_ACT), (const float*)(F.ws + WS_RSTD2), F.b_gu};
        pg8::gemm_phase<EpiGU, MoeOrder, true, true, true>(F.lds + RING_OFF, (LAS unsigned*)(F.lds + IDB_OFF), g, S, E);
    } SEAM(6);
    if (IN(7)) {
        const int nmt = moe_build_table(F);
        pg8::Gemm g{(const bf16*)(F.ws + WS_ACT), (const bf16*)(F.ws + WS_WDN), DFF};
        MoeOrder S{(const LAS unsigned*)(F.lds + TBL_OFF), (const LAS unsigned*)(F.lds + LCNT_OFF), (const unsigned*)(F.ws + WS_LIST), nmt, F.G, F.vcu, 4, 8, DFF, (size_t)D * DFF * 2, true};
        EpiDown E{(bf16*)(F.ws + WS_YB), (const float*)(F.ws + WS_RGATE), F.b_dn};
        pg8::gemm_phase<EpiDown, MoeOrder, true, false, true>(F.lds + RING_OFF, (LAS unsigned*)(F.lds + IDB_OFF), g, S, E);
    } SEAM(7);
    if (IN(8)) { final_phase(F); }
#undef IN
#undef SEAM
}

static void launch_phases(const Args& base, int lo, int hi, int use_bar, int grid, hipStream_t stream) {
    Args a = base; a.ph_lo = lo; a.ph_hi = hi; a.use_bar = use_bar;
    hipLaunchKernelGGL(mk_fwd, dim3(grid), dim3(NWAVES * 64), LDS_BYTES, stream, a);
}
extern "C" void kernel_launch(void* const* d_in, const int* in_sizes, int n_in, void* d_out, int out_size, void* d_ws, size_t ws_size, hipStream_t stream) {
    static int grid = 0;
    if (grid == 0) {
        if (n_in != 17 || in_sizes[0] != T * D || out_size != T * D || ws_size < (size_t)1000 * MiB) { fprintf(stderr, "kernel_launch: unexpected shapes / workspace (%d inputs, ws %zu)\n", n_in, ws_size); grid = -1; return; }
        int dev = 0, cus = 0, per_cu = 0;
        if (hipGetDevice(&dev) != hipSuccess || hipDeviceGetAttribute(&cus, hipDeviceAttributeMultiprocessorCount, dev) != hipSuccess) { grid = -1; return; }
        if (hipFuncSetAttribute((const void*)mk_fwd, hipFuncAttributeMaxDynamicSharedMemorySize, LDS_BYTES) != hipSuccess) { fprintf(stderr, "kernel_launch: hipFuncSetAttribute failed\n"); grid = -1; return; }
        if (hipOccupancyMaxActiveBlocksPerMultiprocessor(&per_cu, (const void*)mk_fwd, NWAVES * 64, LDS_BYTES) != hipSuccess || per_cu < 1) { fprintf(stderr, "kernel_launch: occupancy query says %d blocks per CU\n", per_cu); per_cu = 1; }
        (void)hipGetLastError();
        grid = cus;
        if (grid != 256) { fprintf(stderr, "kernel_launch: built for a 256-CU device (got %d)\n", cus); grid = -1; return; }
    }
    if (grid < 0) return;
    (void)hipMemsetAsync((char*)d_ws + WS_CTL, 0, CTL_ZERO_BYTES, stream);
    Args a{};
    for (int i = 0; i < 17; ++i) a.in[i] = (const float*)d_in[i];
    a.out = (float*)d_out; a.ws = (unsigned char*)d_ws;
    launch_phases(a, 0, 9, 1, grid, stream);
}
```

```cpp
#include <hip/hip_runtime.h>
#include <hip/hip_bf16.h>
#include <cstdint>
#include <cstdio>
#include <cmath>

constexpr int D = 1024, BATCH = 8, SEQ = 4096, T = BATCH * SEQ, DIN = 2560, NMEM = 256, NE = 32, DFF = 1024;
constexpr int C_DQ = 0, C_DK = 512, C_DV = 1024, C_LQ = 1536, C_LK = 1792, C_LV = 2048, C_MQ = 2304;
constexpr float EPS = 1e-5f;
constexpr int LCAP = T;
constexpr float QSCALE = 0.125f * 1.4426950408889634f;
constexpr float LOG2E = 1.4426950408889634f;
namespace pg8 {
#define PG8_LAS __attribute__((address_space(3)))
typedef unsigned short bf16_t;
typedef short bf16x8 __attribute__((ext_vector_type(8)));
typedef float f32x4 __attribute__((ext_vector_type(4)));
typedef unsigned u32x4 __attribute__((ext_vector_type(4)));
typedef unsigned u32x2 __attribute__((ext_vector_type(2)));
constexpr int BM = 256, BK = 64, HALF = 128, HTB = HALF * BK * 2  , STAGE_BYTES = 8 * HTB, NXCD = 8, WGM = 8;

__host__ __device__ __forceinline__ int lds_byte(int r, int c) { const int st = (r >> 4) * 2 + (c >> 5), rr = r & 15, cc = c & 31, ob = rr * 64 + cc * 2; return st * 1024 + (ob ^ (((ob >> 9) & 1) << 5)); }
__host__ __device__ __forceinline__ void stage_rc(int b, int& R, int& C) { const int st = b / 1024, sb = b % 1024, swz = sb ^ (((sb >> 9) & 1) << 5); R = (st >> 1) * 16 + swz / 64; C = (st & 1) * 32 + (swz % 64) / 2; }
__host__ __device__ __forceinline__ int perm32(int rho) { const int n = rho >> 4, i = rho & 15; return 8 * (i >> 2) + 4 * n + (i & 3); }

struct Unit { size_t aoff, boff; int pm, pn, e, valid, mt; };
struct Gemm { const void* A; const void* Bt; int RB; };
typedef int v8i __attribute__((ext_vector_type(8)));

struct StaticOrder {
    int nM, nN, nwg, G, c, RB;
    __device__ void init(int M, int N, int RB_, int G_, int c_) { nM = M / BM; nN = N / BM; nwg = nM * nN; G = G_; c = c_; RB = RB_; }
    __device__ bool next(int i, Unit& u) const {
        const long L = (long)i * G + c; if (L >= nwg) return false;
        int wgid = (int)L; { const int q = nwg / NXCD, r = nwg % NXCD, xcd = wgid % NXCD, off = wgid / NXCD; wgid = (xcd < r ? xcd * (q + 1) : r * (q + 1) + (xcd - r) * q) + off; }
        const int nig = WGM * nN, gid = wgid / nig, fm = gid * WGM, gsz = (nM - fm) < WGM ? (nM - fm) : WGM;
        u.pm = fm + ((wgid % nig) % gsz); u.pn = (wgid % nig) / gsz; u.e = 0; u.valid = 256; u.mt = 0;
        u.aoff = (size_t)u.pm * (size_t)(BM * RB); u.boff = (size_t)u.pn * (size_t)(BM * RB); return true;
    }
    __device__ __forceinline__ const unsigned* id_src(const Unit&, int) const { return nullptr; }
};

__device__ __forceinline__ unsigned cvt_pk_bf16(float lo, float hi) { unsigned r; asm volatile("v_cvt_pk_bf16_f32 %0, %1, %2" : "=v"(r) : "v"(lo), "v"(hi)); return r; }

template <class Epi, class Sched, bool ALIGN_EPI, bool GATHER, bool IDS, bool FP8 = false, bool LINEAR = false>
__device__ __forceinline__ void gemm_phase(PG8_LAS unsigned char* lds, PG8_LAS unsigned* idb, const Gemm g, const Sched& S, const Epi& E) {
    const int tid = threadIdx.x, wid = __builtin_amdgcn_readfirstlane(tid >> 6), lane = tid & 63, wr = wid >> 2, wc = wid & 3, fr = lane & 15, fq = lane >> 4;
    const int RB = g.RB; int nt = RB / (BK * 2); asm volatile("" : "+s"(nt));
    unsigned voffA[2], voffB[2]; int RA[2], CA[2];
#pragma unroll
    for (int i = 0; i < 2; ++i) { int R, C; stage_rc(tid * 16 + i * 8192, R, C); const int Rb = (R & ~31) + perm32(R & 31); RA[i] = R; CA[i] = C;
        voffA[i] = (unsigned)(R * RB + C * 2); voffB[i] = (unsigned)(Rb * RB + C * 2); }
    const size_t kstep = (size_t)(BK * 2);
    const size_t hstep = (size_t)HALF * RB;
    const unsigned ldsw = (unsigned)wid * 1024u;
    const int aoff = lds_byte(wr * 64 + fr, fq * 8), boff = lds_byte(wc * 32 + fr, fq * 8);
    const int aoff8a = lds_byte(wr * 64 + fr, 16 * fq), boff8a = lds_byte(wc * 32 + fr, 16 * fq);
#define PG8_SA(b, h) (((b) * 2 + (h)) * HTB)
#define PG8_SB(b, h) ((4 + (b) * 2 + (h)) * HTB)
#define PG8_STAGE(bufoff, gbase, voff) do { _Pragma("unroll") for (int _i = 0; _i < 2; ++_i) \
        __builtin_amdgcn_global_load_lds((const unsigned*)((const char*)(gbase) + (voff)[_i]), (PG8_LAS unsigned*)(lds + (bufoff) + ldsw + _i * 8192), 16, 0, 0); } while (0)
#define PG8_STAGE_A(bufoff, pbase, gbase, h, gv) do { if constexpr (GATHER) { PG8_STAGE(bufoff, gbase, gv[h]); } else { PG8_STAGE(bufoff, (pbase) + (h) * hstep, voffA); } } while (0)
#define PG8_LD32(p0_, p1_) __builtin_bit_cast(v8i, __builtin_shufflevector(*(const PG8_LAS u32x4*)(p0_), *(const PG8_LAS u32x4*)(p1_), 0, 1, 2, 3, 4, 5, 6, 7))
#define PG8_LDA(dst, b, h) do { if constexpr (FP8) { _Pragma("unroll") for (int m = 0; m < 4; ++m) dst##8[m] = PG8_LD32(lds + PG8_SA(b, h) + aoff8a + m * 2048, lds + PG8_SA(b, h) + aoff8a + m * 2048 + 16); } \
        else { _Pragma("unroll") for (int m = 0; m < 4; ++m) _Pragma("unroll") for (int k = 0; k < 2; ++k) dst[m][k] = *(const PG8_LAS bf16x8*)(lds + PG8_SA(b, h) + aoff + m * 2048 + k * 1024); } } while (0)
#define PG8_LDB(dst, b, h) do { if constexpr (FP8) { _Pragma("unroll") for (int n = 0; n < 2; ++n) dst##8[n] = PG8_LD32(lds + PG8_SB(b, h) + boff8a + n * 2048, lds + PG8_SB(b, h) + boff8a + n * 2048 + 16); } \
        else { _Pragma("unroll") for (int n = 0; n < 2; ++n) _Pragma("unroll") for (int k = 0; k < 2; ++k) dst[n][k] = *(const PG8_LAS bf16x8*)(lds + PG8_SB(b, h) + boff + n * 2048 + k * 1024); } } while (0)
#define PG8_MMA(ai, bj, At, Bt) do { __builtin_amdgcn_s_setprio(1); if constexpr (FP8) { _Pragma("unroll") for (int m = 0; m < 4; ++m) _Pragma("unroll") for (int n = 0; n < 2; ++n) \
        acc[ai][bj][m][n] = __builtin_amdgcn_mfma_scale_f32_16x16x128_f8f6f4(Bt##8[n], At##8[m], acc[ai][bj][m][n], 0, 0, 0, 0x7f7f7f7f, 0, 0x7f7f7f7f); } \
        else { _Pragma("unroll") for (int m = 0; m < 4; ++m) _Pragma("unroll") for (int n = 0; n < 2; ++n) _Pragma("unroll") for (int k = 0; k < 2; ++k) \
        acc[ai][bj][m][n] = __builtin_amdgcn_mfma_f32_16x16x32_bf16(Bt[n][k], At[m][k], acc[ai][bj][m][n], 0, 0, 0); } __builtin_amdgcn_s_setprio(0); } while (0)
#define PG8_WAIT_V(n) asm volatile("s_waitcnt vmcnt(" #n ")" ::: "memory")
#define PG8_WAIT_L(n) asm volatile("s_waitcnt lgkmcnt(" #n ")" ::: "memory")
#define PG8_BAR __builtin_amdgcn_s_barrier()
#define PG8_SCHED __builtin_amdgcn_sched_barrier(0)
#define PG8_IDS_DMA(u, s) do { if (wid < 4) __builtin_amdgcn_global_load_lds(S.id_src(u, tid), (PG8_LAS unsigned*)(idb + (s) * 256 + wid * 64), 4, 0, 0); } while (0)
#define PG8_GV(dst, s, un) do { _Pragma("unroll") for (int _h = 0; _h < 2; ++_h) _Pragma("unroll") for (int _i = 0; _i < 2; ++_i) \
        dst[_h][_i] = (LINEAR ? (unsigned)((un).pm * 256 + _h * 128 + RA[_i]) : (idb[(s) * 256 + _h * 128 + RA[_i]] >> 2)) * (unsigned)RB + (unsigned)(CA[_i] * 2); } while (0)
    Unit cur, nxt; int ui = 0, us = 0;
    if (!S.next(0, cur)) return;
    f32x4 acc[2][2][4][2];
#pragma unroll
    for (int a = 0; a < 2; ++a)
#pragma unroll
        for (int b = 0; b < 2; ++b)
#pragma unroll
            for (int m = 0; m < 4; ++m)
#pragma unroll
                for (int n = 0; n < 2; ++n) acc[a][b][m][n] = (f32x4){0.f, 0.f, 0.f, 0.f};
    bf16x8 At[4][2], B0[2][2], B1[2][2]; v8i At8[4], B08[2], B18[2];
    unsigned cv[2][2] = {{0u, 0u}, {0u, 0u}};
    const char* A0 = (const char*)g.A;
    const char* cA = A0 + (GATHER ? (size_t)0 : cur.aoff); const char* cB = (const char*)g.Bt + cur.boff;
    if constexpr (IDS) {
        PG8_IDS_DMA(cur, 0); PG8_WAIT_V(0); PG8_BAR;
    }
    if constexpr (GATHER) { PG8_GV(cv, 0, cur); }
    PG8_STAGE(PG8_SB(0, 0), cB, voffB); PG8_STAGE(PG8_SB(0, 1), cB + hstep, voffB); PG8_STAGE_A(PG8_SA(0, 0), cA, A0, 0, cv); PG8_STAGE_A(PG8_SA(0, 1), cA, A0, 1, cv);
    if (wr == 1) PG8_BAR;
    PG8_WAIT_V(2); PG8_BAR;
    PG8_STAGE(PG8_SB(1, 0), cB + kstep, voffB); PG8_STAGE_A(PG8_SA(1, 0), cA + kstep, A0 + kstep, 0, cv); PG8_STAGE(PG8_SB(1, 1), cB + hstep + kstep, voffB);
    PG8_WAIT_V(6); PG8_BAR;
    for (;;) {
        const bool has_next = S.next(ui + 1, nxt);
        const int ns = (us == 2) ? 0 : us + 1;
        if constexpr (IDS) { if (has_next) PG8_IDS_DMA(nxt, ns); }
        const char* nA = has_next ? A0 + (GATHER ? (size_t)0 : nxt.aoff) : cA; const char* nB = has_next ? (const char*)g.Bt + nxt.boff : cB;
#pragma nounroll
        for (int t = 0; t < nt; t += 2) {
            int lastv = (t == nt - 2) ? 1 : 0; asm volatile("" : "+v"(lastv)); const bool last = __builtin_amdgcn_readfirstlane(lastv) != 0;
            const char* a1 = cA + (size_t)(t + 1) * kstep;
            const char* a2 = last ? nA : cA + (size_t)(t + 2) * kstep; const char* b2 = last ? nB : cB + (size_t)(t + 2) * kstep;
            const char* a3 = a2 + kstep; const char* b3 = b2 + kstep;
            PG8_LDB(B0, 0, 0); PG8_LDB(B1, 0, 1); PG8_SCHED; PG8_LDA(At, 0, 0); PG8_STAGE_A(PG8_SA(1, 1), a1, a1, 1, cv);
            if constexpr (GATHER) { if (last && has_next) { PG8_GV(cv, ns, nxt); } }
            PG8_WAIT_V(8); PG8_WAIT_L(0); PG8_BAR; PG8_MMA(0, 0, At, B0); PG8_MMA(0, 1, At, B1); PG8_BAR; PG8_SCHED;
            PG8_LDA(At, 0, 1); PG8_STAGE(PG8_SB(0, 0), b2, voffB); PG8_STAGE(PG8_SB(0, 1), b2 + hstep, voffB); PG8_STAGE_A(PG8_SA(0, 0), a2, a2, 0, cv);
            PG8_WAIT_V(8); PG8_WAIT_L(0); PG8_BAR; PG8_MMA(1, 0, At, B0); PG8_MMA(1, 1, At, B1); PG8_BAR; PG8_SCHED;
            PG8_LDB(B0, 1, 0); PG8_LDB(B1, 1, 1); PG8_SCHED; PG8_LDA(At, 1, 0); PG8_STAGE_A(PG8_SA(0, 1), a2, a2, 1, cv);
            PG8_WAIT_V(8); PG8_WAIT_L(0); PG8_BAR; PG8_MMA(0, 0, At, B0); PG8_MMA(0, 1, At, B1); PG8_BAR; PG8_SCHED;
            PG8_LDA(At, 1, 1); PG8_STAGE(PG8_SB(1, 0), b3, voffB); PG8_STAGE(PG8_SB(1, 1), b3 + hstep, voffB); PG8_STAGE_A(PG8_SA(1, 0), a3, a3, 0, cv);
            PG8_WAIT_V(8); PG8_WAIT_L(0); PG8_BAR; PG8_MMA(1, 0, At, B0); PG8_MMA(1, 1, At, B1); PG8_BAR; PG8_SCHED;
        }
        if constexpr (ALIGN_EPI) { if (wr == 0) PG8_BAR; }
        PG8_SCHED;
        E(acc, cur, wr, wc, fr, fq, (const PG8_LAS unsigned*)(idb + us * 256));
        PG8_SCHED;
        if (!has_next) break;
#pragma unroll
        for (int a = 0; a < 2; ++a)
#pragma unroll
            for (int b = 0; b < 2; ++b)
#pragma unroll
                for (int m = 0; m < 4; ++m)
#pragma unroll
                    for (int n = 0; n < 2; ++n) acc[a][b][m][n] = (f32x4){0.f, 0.f, 0.f, 0.f};
        cur = nxt; cA = nA; cB = nB; ++ui; us = ns;
        if constexpr (ALIGN_EPI) { if (wr == 1) PG8_BAR; }
    }
    PG8_WAIT_V(0);
    if constexpr (!ALIGN_EPI) { if (wr == 0) PG8_BAR; }
    PG8_BAR;
#undef PG8_SA
#undef PG8_SB
#undef PG8_STAGE
#undef PG8_STAGE_A
#undef PG8_LDA
#undef PG8_LDB
#undef PG8_MMA
#undef PG8_LD32
#undef PG8_WAIT_V
#undef PG8_WAIT_L
#undef PG8_BAR
#undef PG8_SCHED
#undef PG8_IDS_DMA
#undef PG8_GV
}
}
namespace attn_body {
using bf16=__hip_bfloat16;
using bf16x8=__attribute__((ext_vector_type(8)))short;
using s16x4=__attribute__((ext_vector_type(4)))short;
using f32x16=__attribute__((ext_vector_type(16)))float;
using u32x4=__attribute__((ext_vector_type(4)))unsigned;
constexpr int D=64;
constexpr int NW=8,QBLK=32,QB=QBLK*NW,KVBLK=64;
struct UnitP { const bf16* Q; const bf16* K; const bf16* V; bf16* O; long qp, kp, op; int q0, t0, NT; float slope2; float* lse; int lse_stride; };
__device__ __forceinline__ int crow(int r,int hi){return (r&3)+8*(r>>2)+4*hi;}
#define SBAR() __builtin_amdgcn_sched_barrier(0)
template<bool CAUSAL,bool WINDOW> __device__ __forceinline__ void cmask(f32x16&p0,f32x16&p1,int jb,int qrel,int hi){
  const float NEG=-INFINITY; int kb=64*jb+4*hi;
  #pragma unroll
  for(int r=0;r<16;++r){int kv=kb+(r&3)+8*(r>>2);
    if(CAUSAL){ if(kv>qrel)p0[r]=NEG; if(kv+32>qrel)p1[r]=NEG; }
    if(WINDOW){ if(kv<qrel-128)p0[r]=NEG; if(kv+32<qrel-128)p1[r]=NEG; } }
}
__device__ __forceinline__ unsigned bfr(float x){ typedef float f2_ __attribute__((ext_vector_type(2))); typedef __bf16 b2_ __attribute__((ext_vector_type(2))); f2_ v={x,0.f}; b2_ b=__builtin_convertvector(v,b2_); return __builtin_bit_cast(unsigned,b)&0xffffu; }
__device__ __forceinline__ float bfv(unsigned b){ return __builtin_bit_cast(float,b<<16); }

constexpr int NSLOT=3, SLOTB=8192;
constexpr int LDS_K=0, LDS_V=NSLOT*SLOTB, LDS_WS=2*NSLOT*SLOTB, LDS_OST=LDS_WS+NW*64*4, LDS_BYTES=LDS_OST+NW*4096;
__device__ __forceinline__ void glds16(const void*gsrc,unsigned lds_dst){unsigned keep;
  asm volatile("s_mov_b32 %0, m0\n\ts_mov_b32 m0, %2\n\ts_nop 0\n\tglobal_load_lds_dwordx4 %1, off\n\ts_mov_b32 m0, %0":"=&s"(keep):"v"(gsrc),"s"(lds_dst):"memory");}
__device__ __forceinline__ float max3f(float a,float b,float c){float r;asm("v_max3_f32 %0, %1, %2, %3":"=v"(r):"v"(a),"v"(b),"v"(c));return r;}
__device__ __forceinline__ float max2f(float a,float b){float r;asm("v_max_f32_e32 %0, %1, %2":"=v"(r):"v"(a),"v"(b));return r;}
__device__ __forceinline__ float fadd_s(float a,float b){float r;asm("v_add_f32_e32 %0, %1, %2":"=v"(r):"v"(a),"v"(b));return r;}
__device__ __forceinline__ float fsub_s(float a,float b){float r;asm("v_sub_f32_e32 %0, %1, %2":"=v"(r):"v"(a),"v"(b));return r;}
typedef float f32x2_t __attribute__((ext_vector_type(2))); typedef __bf16 bf16x2_t __attribute__((ext_vector_type(2)));
__device__ __forceinline__ unsigned cvtpk_s(float lo,float hi){f32x2_t v={lo,hi};bf16x2_t b=__builtin_convertvector(v,bf16x2_t);return __builtin_bit_cast(unsigned,b);}
#define WAIT_BAR(N) asm volatile("s_waitcnt vmcnt(" #N ") lgkmcnt(0)\n\ts_barrier":::"memory")

__device__ __forceinline__ void qkt(f32x16&p0,f32x16&p1,const char*Kslot,const bf16x8*qr,bf16x8 kx0,bf16x8 kx1,bf16x8 qx,int r32,int hi){
  const char*kb=Kslot+hi*1024+r32*16;
  #pragma unroll
  for(int d0=0;d0<4;++d0){
    const bf16x8 b0=*reinterpret_cast<const bf16x8*>(kb+d0*2048);
    const bf16x8 b1=*reinterpret_cast<const bf16x8*>(kb+d0*2048+512);
    if(d0==0){p0=__builtin_amdgcn_mfma_f32_32x32x16_bf16(b0,qr[0],f32x16{},0,0,0);p1=__builtin_amdgcn_mfma_f32_32x32x16_bf16(b1,qr[0],f32x16{},0,0,0);}
    else{p0=__builtin_amdgcn_mfma_f32_32x32x16_bf16(b0,qr[d0],p0,0,0,0);p1=__builtin_amdgcn_mfma_f32_32x32x16_bf16(b1,qr[d0],p1,0,0,0);}}
  p0=__builtin_amdgcn_mfma_f32_32x32x16_bf16(kx0,qx,p0,0,0,0);p1=__builtin_amdgcn_mfma_f32_32x32x16_bf16(kx1,qx,p1,0,0,0);
}
typedef __attribute__((address_space(3))) const char* lds_cptr;
typedef short v4i16_t __attribute__((ext_vector_type(4)));
__device__ __forceinline__ void kload8(bf16x8*kf,lds_cptr kp){
  kf[0]=*(const __attribute__((address_space(3))) bf16x8*)(kp);      kf[1]=*(const __attribute__((address_space(3))) bf16x8*)(kp+512);
  kf[2]=*(const __attribute__((address_space(3))) bf16x8*)(kp+2048); kf[3]=*(const __attribute__((address_space(3))) bf16x8*)(kp+2560);
  kf[4]=*(const __attribute__((address_space(3))) bf16x8*)(kp+4096); kf[5]=*(const __attribute__((address_space(3))) bf16x8*)(kp+4608);
  kf[6]=*(const __attribute__((address_space(3))) bf16x8*)(kp+6144); kf[7]=*(const __attribute__((address_space(3))) bf16x8*)(kp+6656);
}
__device__ __forceinline__ void kload2(bf16x8*kf,lds_cptr kp,int j){ kf[2*j]=*(const __attribute__((address_space(3))) bf16x8*)(kp+j*2048); kf[2*j+1]=*(const __attribute__((address_space(3))) bf16x8*)(kp+j*2048+512); }
__device__ __forceinline__ s16x4 vtr(lds_cptr p){ return __builtin_bit_cast(s16x4,__builtin_amdgcn_ds_read_tr16_b64_v4i16((__attribute__((address_space(3))) v4i16_t*)p)); }
__device__ __forceinline__ float rowmax(const f32x16&p0,const f32x16&p1){
  float a=max3f(p0[0],p0[1],p1[0]),b=max3f(p0[2],p0[3],p1[1]);a=max3f(a,p1[2],p1[3]);
  #pragma unroll
  for(int r=4;r<16;r+=4){a=max3f(a,p0[r],p0[r+1]);b=max3f(b,p0[r+2],p0[r+3]);a=max3f(a,p1[r],p1[r+1]);b=max3f(b,p1[r+2],p1[r+3]);}
  const float m=max2f(a,b);
  auto rr=__builtin_amdgcn_permlane32_swap(__float_as_uint(m),__float_as_uint(m),false,false);
  return max2f(__uint_as_float(rr[0]),__uint_as_float(rr[1]));
}
__device__ __forceinline__ void pv(f32x16*o,int vb,bf16x8 pa0,bf16x8 pa1,bf16x8 pa2,bf16x8 pa3){
  #pragma unroll
  for(int d0=0;d0<2;++d0){s16x4 lo[4],hi[4];
    #pragma unroll
    for(int ks=0;ks<4;++ks){
      asm volatile("ds_read_b64_tr_b16 %0,%1 offset:%c2":"=&v"(lo[ks]):"v"(vb),"i"(d0*4096+ks*1024):"memory");
      asm volatile("ds_read_b64_tr_b16 %0,%1 offset:%c2":"=&v"(hi[ks]):"v"(vb),"i"(d0*4096+ks*1024+512):"memory");}
    asm volatile("s_waitcnt lgkmcnt(0)":::"memory");SBAR();
    #define PK(k) (bf16x8){lo[k][0],lo[k][1],lo[k][2],lo[k][3],hi[k][0],hi[k][1],hi[k][2],hi[k][3]}
    o[d0]=__builtin_amdgcn_mfma_f32_32x32x16_bf16(pa0,PK(0),o[d0],0,0,0);
    o[d0]=__builtin_amdgcn_mfma_f32_32x32x16_bf16(pa1,PK(1),o[d0],0,0,0);
    o[d0]=__builtin_amdgcn_mfma_f32_32x32x16_bf16(pa2,PK(2),o[d0],0,0,0);
    o[d0]=__builtin_amdgcn_mfma_f32_32x32x16_bf16(pa3,PK(3),o[d0],0,0,0);
    #undef PK
  }
}

#ifndef ATTN_STORE16
#define ATTN_STORE16(p,v) (*(u32x4*)(p)=(v))
#endif
template<int THRL,bool CAUSAL,bool WINDOW,bool ALIBI,bool LSE> __device__ __forceinline__ void attn_unit(const UnitP&U,char*shm){
  int tid=threadIdx.x; asm volatile("":"+v"(tid));
  const int lane=tid&63,r32=lane&31,hi=lane>>5; const int wid=__builtin_amdgcn_readfirstlane(tid>>6);
  const int q0=U.q0; const long qp=U.qp,kp=U.kp,op=U.op; const float slope2=U.slope2;
  const bf16*Qw=U.Q+(long)(q0+wid*QBLK)*qp;
  const bf16*Kh=U.K+(long)U.t0*KVBLK*kp,*Vh=U.V+(long)U.t0*KVBLK*kp;
  const unsigned lds0=(unsigned)(uintptr_t)shm;
  float*wsf=(float*)(shm+LDS_WS)+wid*64;
  const bf16*ksrc=Kh+(long)lane*kp+wid*8;
  const bf16*vsrc=Vh+(long)(16*(wid&3)+(lane>>2))*kp+(wid>>2)*32+(lane&3)*8;
  const unsigned kdst=lds0+LDS_K+wid*1024, vdst=lds0+LDS_V+wid*1024;
  #define DMA_K(t,slot) glds16(ksrc+(long)(t)*KVBLK*kp,(unsigned)__builtin_amdgcn_readfirstlane(kdst+(slot)))
  #define DMA_V(t,slot) glds16(vsrc+(long)(t)*KVBLK*kp,(unsigned)__builtin_amdgcn_readfirstlane(vdst+(slot)))
  const int vb0=(int)(lds0+LDS_V)+((lane>>4)&1)*32+(lane&3)*8+(4*hi+((lane&15)>>2))*64;
  const char*Kbase=shm+LDS_K; bf16x8 kf[8];
  const lds_cptr shm3=(lds_cptr)shm; const lds_cptr kp0=shm3+LDS_K+hi*1024+r32*16; const lds_cptr vp0=shm3+LDS_V+((lane>>4)&1)*32+(lane&3)*8+(4*hi+((lane&15)>>2))*64;
  const int NT=U.NT;
  DMA_K(0,0);DMA_V(0,0);DMA_K(1,SLOTB);
  bf16x8 qr[4];
  #pragma unroll
  for(int d0=0;d0<4;++d0)qr[d0]=*reinterpret_cast<const bf16x8*>(&Qw[(long)r32*qp+d0*16+hi*8]);
  float mhat=0.f,l_reg=0.f;f32x16 o[2];o[0]=f32x16{};o[1]=f32x16{};
  const int qrel=wid*QBLK+r32;
  #define CMASK(P0,P1,t) do{int jb_=(t)-(NT-4); if(WINDOW||(CAUSAL&&jb_>=0))cmask<CAUSAL,WINDOW>(P0,P1,jb_,qrel,hi);}while(0)
  bf16x8 kx0,kx1,qx;
  { const float k0_=ALIBI?slope2*(float)r32:0.f, k1_=ALIBI?slope2*(float)(r32+32):0.f; const unsigned h0=bfr(k0_),l0=bfr(k0_-bfv(h0)),h1=bfr(k1_),l1=bfr(k1_-bfv(h1));
    u32x4 a={0x3f803f80u,0x3f80u|(h0<<16),l0,0u}, b={0x3f803f80u,0x3f80u|(h1<<16),l1,0u}; if(hi){a=u32x4{0u,0u,0u,0u};b=a;} kx0=__builtin_bit_cast(bf16x8,a); kx1=__builtin_bit_cast(bf16x8,b); }
  #define QX_SET(t) do{ const float nb_=ALIBI?__builtin_fmaf(slope2,(float)(64*((t)-(NT-4))-qrel),-mhat):-mhat; const unsigned a_=bfr(nb_); const float r1_=nb_-bfv(a_); const unsigned b_=bfr(r1_); const unsigned c_=bfr(r1_-bfv(b_)); \
    u32x4 q_={a_|(b_<<16),c_|0x3f800000u,0x3f80u,0u}; if(hi)q_=u32x4{0u,0u,0u,0u}; qx=__builtin_bit_cast(bf16x8,q_); asm volatile("":"+v"(qx)); }while(0)
  bool resc=false;
  #define START(P0,P1) do{ const float rm=rowmax(P0,P1); resc=false; \
    { const float dl=(rm==-INFINITY)?0.f:rm; mhat=fadd_s(mhat,dl); \
      _Pragma("unroll") for(int r=0;r<16;++r){P0[r]=fsub_s(P0[r],dl);P1[r]=fsub_s(P1[r],dl);} } \
    _Pragma("unroll") for(int r=0;r<16;++r)P0[r]=__builtin_amdgcn_exp2f(P0[r]); }while(0)
  #define RESC() do{ if(resc){ asm volatile("s_waitcnt lgkmcnt(0)":::"memory"); \
      _Pragma("unroll") for(int d_=0;d_<2;++d_) _Pragma("unroll") for(int r=0;r<16;++r)o[d_][r]*=wsf[crow(r,hi)]; } }while(0)
  f32x16 pA0,pA1,pB0,pB1;
  int sl_prev=0,sl_cur=0,sl_next=SLOTB;
  #define ROT() do{sl_prev=sl_cur;sl_cur=sl_next;sl_next=(sl_next==(NSLOT-1)*SLOTB)?0:sl_next+SLOTB;}while(0)
  DMA_K(2,2*SLOTB);
  WAIT_BAR(3);
  QX_SET(0);
  qkt(pA0,pA1,Kbase,qr,kx0,kx1,qx,r32,hi);asm volatile("s_nop 15\n\ts_nop 7":"+v"(pA0),"+v"(pA1));CMASK(pA0,pA1,0);
  START(pA0,pA1);
  _Pragma("unroll") for(int r=0;r<16;++r)pA1[r]=__builtin_amdgcn_exp2f(pA1[r]);
  WAIT_BAR(0);
  DMA_K(3,0);DMA_V(1,SLOTB);
  ROT();
  kload8(kf,kp0+sl_cur);
  WAIT_BAR(2);
  s16x4 vlo[8],vhi[8]; u32x4 pw0,pw1,pw2,pw3;
  #define PKW(P,B) cvtpk_s(P[B],P[B+1])
  #define PAF(k) __builtin_bit_cast(bf16x8,pw##k)
  #define VFR(i) (bf16x8){vlo[i][0],vlo[i][1],vlo[i][2],vlo[i][3],vhi[i][0],vhi[i][1],vhi[i][2],vhi[i][3]}
  #define PIN(x) asm volatile("":"+v"(x))
  #define MX3(a,b,c) __builtin_fmaxf(__builtin_fmaxf((a),(b)),(c))
  #define GAPA(MF,A0,A1,A2,A3,W0,W1,PW) do{ MF; sacc+=A0; sacc+=A1; sacc+=A2; sacc+=A3; PIN(sacc); W0; W1; PIN(PW); SBAR(); }while(0)
  #define EX(v) __builtin_amdgcn_exp2f(v)
  #define GAPB(MF,X,B) do{ MF; X[B]=EX(X[B]); X[B+1]=EX(X[B+1]); X[B+2]=EX(X[B+2]); X[B+3]=EX(X[B+3]); PIN(X); SBAR(); }while(0)
  #define VRD(i) do{ vlo[i]=vtr(vp_+(((i)>>2)*4096+((i)&3)*1024)); vhi[i]=vtr(vp_+(((i)>>2)*4096+((i)&3)*1024+512)); }while(0)
  #define KRD(G,j) do{ if(G){ kload2(kf,kp0+sl_next,j); SBAR(); } }while(0)
  #define STEP(C0,C1,P0,P1,t,GK,GV,GL) do{ SBAR(); QX_SET(t); SBAR(); \
    const lds_cptr vp_=vp0+sl_prev; \
    VRD(0); SBAR(); float sacc=(P0[0]+P0[1]); \
    GAPA(C0=__builtin_amdgcn_mfma_f32_32x32x16_bf16(kf[0],qr[0],f32x16{},0,0,0), P0[2],P0[3],P0[4],P0[5],     pw0[0]=PKW(P0,0), pw0[1]=PKW(P0,2), pw0); \
    VRD(4); SBAR(); GAPA(C1=__builtin_amdgcn_mfma_f32_32x32x16_bf16(kf[1],qr[0],f32x16{},0,0,0), P0[6],P0[7],P0[8],P0[9],     pw0[2]=PKW(P0,4), pw0[3]=PKW(P0,6), pw0); \
    VRD(1); SBAR(); GAPA(C0=__builtin_amdgcn_mfma_f32_32x32x16_bf16(kf[2],qr[1],C0,0,0,0),   P0[10],P0[11],P0[12],P0[13], pw1[0]=PKW(P0,8), pw1[1]=PKW(P0,10), pw1); \
    VRD(5); SBAR(); GAPA(C1=__builtin_amdgcn_mfma_f32_32x32x16_bf16(kf[3],qr[1],C1,0,0,0),   P0[14],P0[15],P1[0],P1[1],   pw1[2]=PKW(P0,12),pw1[3]=PKW(P0,14), pw1); \
    VRD(2); SBAR(); GAPA(C0=__builtin_amdgcn_mfma_f32_32x32x16_bf16(kf[4],qr[2],C0,0,0,0),   P1[2],P1[3],P1[4],P1[5],     pw2[0]=PKW(P1,0), pw2[1]=PKW(P1,2), pw2); \
    VRD(6); SBAR(); GAPA(C1=__builtin_amdgcn_mfma_f32_32x32x16_bf16(kf[5],qr[2],C1,0,0,0),   P1[6],P1[7],P1[8],P1[9],     pw2[2]=PKW(P1,4), pw2[3]=PKW(P1,6), pw2); \
    VRD(3); SBAR(); GAPA(C0=__builtin_amdgcn_mfma_f32_32x32x16_bf16(kf[6],qr[3],C0,0,0,0),   P1[10],P1[11],P1[12],P1[13], pw3[0]=PKW(P1,8), pw3[1]=PKW(P1,10), pw3); \
    VRD(7); SBAR(); GAPA(C1=__builtin_amdgcn_mfma_f32_32x32x16_bf16(kf[7],qr[3],C1,0,0,0),   P1[14],P1[15],0.f,0.f,       pw3[2]=PKW(P1,12),pw3[3]=PKW(P1,14), pw3); \
    C0=__builtin_amdgcn_mfma_f32_32x32x16_bf16(kx0,qx,C0,0,0,0); C1=__builtin_amdgcn_mfma_f32_32x32x16_bf16(kx1,qx,C1,0,0,0); SBAR(); \
    l_reg+=sacc; \
    if(GK){DMA_K((t)+3,sl_cur);} if(GV){DMA_V((t)+1,sl_next);} \
    CMASK(C0,C1,t); \
    { float a=MX3(C0[0],C0[1],C1[0]),b=MX3(C0[2],C0[3],C1[1]); a=MX3(a,C1[2],C1[3]); \
      _Pragma("unroll") for(int r=4;r<16;r+=4){a=MX3(a,C0[r],C0[r+1]);b=MX3(b,C0[r+2],C0[r+3]);a=MX3(a,C1[r],C1[r+1]);b=MX3(b,C1[r+2],C1[r+3]);} \
      float rm=__builtin_fmaxf(a,b); { auto rr=__builtin_amdgcn_permlane32_swap(__float_as_uint(rm),__float_as_uint(rm),false,false); rm=__builtin_fmaxf(__uint_as_float(rr[0]),__uint_as_float(rr[1])); } \
      resc=false; \
      if(__builtin_expect(__any(rm>(float)THRL),0)){ const float dl=__builtin_fmaxf(rm,0.f); mhat+=dl; \
        _Pragma("unroll") for(int r=0;r<16;++r){C0[r]-=dl;C1[r]-=dl;} \
        const float f=__builtin_amdgcn_exp2f(-dl); l_reg*=f; if(hi==0)wsf[r32]=f; resc=true; } } \
    SBAR(); \
    GAPB(o[0]=__builtin_amdgcn_mfma_f32_32x32x16_bf16(PAF(0),VFR(0),o[0],0,0,0), C0,0); \
    GAPB(o[1]=__builtin_amdgcn_mfma_f32_32x32x16_bf16(PAF(0),VFR(4),o[1],0,0,0), C0,4); \
    KRD(GL,0); GAPB(o[0]=__builtin_amdgcn_mfma_f32_32x32x16_bf16(PAF(1),VFR(1),o[0],0,0,0), C0,8); \
    KRD(GL,1); GAPB(o[1]=__builtin_amdgcn_mfma_f32_32x32x16_bf16(PAF(1),VFR(5),o[1],0,0,0), C0,12); \
    KRD(GL,2); GAPB(o[0]=__builtin_amdgcn_mfma_f32_32x32x16_bf16(PAF(2),VFR(2),o[0],0,0,0), C1,0); \
    KRD(GL,3); GAPB(o[1]=__builtin_amdgcn_mfma_f32_32x32x16_bf16(PAF(2),VFR(6),o[1],0,0,0), C1,4); \
    GAPB(o[0]=__builtin_amdgcn_mfma_f32_32x32x16_bf16(PAF(3),VFR(3),o[0],0,0,0), C1,8); \
    GAPB(o[1]=__builtin_amdgcn_mfma_f32_32x32x16_bf16(PAF(3),VFR(7),o[1],0,0,0), C1,12); \
    }while(0)
  int t=1;
  #undef CMASK
  #define CMASK(P0,P1,t) do{}while(0)
  for(;t+5<NT;t+=2){
    STEP(pB0,pB1,pA0,pA1,t,true,true,true);     WAIT_BAR(2); RESC(); ROT();
    STEP(pA0,pA1,pB0,pB1,t+1,true,true,true);   WAIT_BAR(2); RESC(); ROT();
  }
  #undef CMASK
  #define CMASK(P0,P1,t) do{int jb_=(t)-(NT-4); if(WINDOW||(CAUSAL&&jb_>=0))cmask<CAUSAL,WINDOW>(P0,P1,jb_,qrel,hi);}while(0)
  #define ENDW(tt) do{ if((tt)+3<NT){WAIT_BAR(2);} else if((tt)+2<NT){WAIT_BAR(1);} else {WAIT_BAR(0);} }while(0)
  for(;t+1<NT;t+=2){
    STEP(pB0,pB1,pA0,pA1,t,(t+3<NT),(t+1<NT),(t+1<NT));       ENDW(t);   RESC(); ROT();
    STEP(pA0,pA1,pB0,pB1,t+1,(t+4<NT),(t+2<NT),(t+2<NT));     ENDW(t+1); RESC(); ROT();
  }
  STEP(pB0,pB1,pA0,pA1,NT-1,false,false,false); RESC();
  { float sacc=pB0[0]+pB0[1]; _Pragma("unroll") for(int r=2;r<16;++r)sacc+=pB0[r]; _Pragma("unroll") for(int r=0;r<16;++r)sacc+=pB1[r]; l_reg+=sacc;
    pw0=(u32x4){PKW(pB0,0),PKW(pB0,2),PKW(pB0,4),PKW(pB0,6)};pw1=(u32x4){PKW(pB0,8),PKW(pB0,10),PKW(pB0,12),PKW(pB0,14)};pw2=(u32x4){PKW(pB1,0),PKW(pB1,2),PKW(pB1,4),PKW(pB1,6)};pw3=(u32x4){PKW(pB1,8),PKW(pB1,10),PKW(pB1,12),PKW(pB1,14)};
    SBAR(); pv(o,vb0+sl_cur,PAF(0),PAF(1),PAF(2),PAF(3)); }
  #undef PKW
  #undef PAF
  #undef VFR
  #undef PIN
  #undef MX3
  #undef GAPA
  #undef GAPB
  #undef EX
  #undef VRD
  #undef KRD
  #undef STEP
  #undef ENDW
  {auto rr=__builtin_amdgcn_permlane32_swap(__float_as_uint(l_reg),__float_as_uint(l_reg),false,false);l_reg=__uint_as_float(rr[0])+__uint_as_float(rr[1]);}
  if(LSE){ if(hi==0)U.lse[(long)(q0+wid*QBLK+r32)*U.lse_stride]=mhat+__builtin_amdgcn_logf(l_reg); }
  if(hi==0)wsf[32+r32]=l_reg;asm volatile("s_waitcnt lgkmcnt(0)":::"memory");
  float rli[16];
  #pragma unroll
  for(int r=0;r<16;++r)rli[r]=__builtin_amdgcn_rcpf(wsf[32+crow(r,hi)]);
  bf16*Ow=U.O+(long)(q0+wid*QBLK)*op;
  { bf16*stg=(bf16*)(shm+LDS_OST)+wid*2048;
    #pragma unroll
    for(int r=0;r<16;++r){const int orow=crow(r,hi);
      #pragma unroll
      for(int d0=0;d0<2;++d0)stg[orow*64+d0*32+r32]=__float2bfloat16(o[d0][r]*rli[r]);}
    asm volatile("s_waitcnt lgkmcnt(0)":::"memory");
    #pragma unroll
    for(int i=0;i<4;++i){const int row=i*8+(lane>>3),ch=lane&7; const u32x4 v=*(const u32x4*)(stg+row*64+ch*8); ATTN_STORE16(Ow+(long)row*op+ch*8,v);} }
  asm volatile("s_waitcnt lgkmcnt(0)\n\ts_barrier":::"memory");
  #undef DMA_K
  #undef DMA_V
  #undef CMASK
  #undef START
  #undef RESC
  #undef ROT
  #undef QX_SET
}
constexpr int ATTN_LDS_BYTES=LDS_BYTES;
#undef SBAR
#undef WAIT_BAR
}
constexpr size_t MiB = 1u << 20;
constexpr size_t WS_CTL = 0, CTL_ZERO_BYTES = 1 * MiB;
constexpr size_t WS_LIST = 1 * MiB;
constexpr size_t WS_RGATE = 5 * MiB;
constexpr size_t WS_RSTD1 = 5 * MiB + 512 * 1024, WS_RSTD2 = WS_RSTD1 + 128 * 1024, WS_WRG = WS_RSTD2 + 128 * 1024;
constexpr size_t WS_WRT = 7 * MiB + 512 * 1024;
constexpr size_t WS_LSE = 6 * MiB;
constexpr size_t WS_MKV = 8 * MiB;
constexpr size_t WS_WIN = 10 * MiB, WS_WOUT = 15 * MiB, WS_WGU = 17 * MiB, WS_WDN = 145 * MiB;
constexpr size_t WS_XB = 209 * MiB;
constexpr size_t WS_P = 273 * MiB, WS_OD = 433 * MiB, WS_ODIL = 497 * MiB;
constexpr size_t WS_ACT = 273 * MiB;
constexpr size_t WS_MIX = 545 * MiB, WS_X1B = 609 * MiB, WS_YB = 673 * MiB, WS_Y = 929 * MiB, WS_END = 993 * MiB;
constexpr int CW_TMO = 0, CW_CODE = 1;
constexpr int CW_CNT = 64;
constexpr int CW_BAR = 4096;

constexpr int RING_OFF = 0, RING_BYTES = 131072;
constexpr int LDSCTL_OFF = RING_BYTES;
constexpr int IDB_OFF = LDSCTL_OFF;
constexpr int TBL_OFF = IDB_OFF + 3072;
constexpr int LCNT_OFF = TBL_OFF + 2304;
constexpr int MISC_OFF = LCNT_OFF + 256;
constexpr int STG_OFF = MISC_OFF + 128;
constexpr int LDS_BYTES = 147456;
static_assert(STG_OFF + 512 * 12 <= LDS_BYTES, "LDS map");
constexpr int NWAVES = 8;

#define GAS __attribute__((address_space(1)))
#define LAS __attribute__((address_space(3)))
typedef unsigned short bf16;
typedef unsigned v4u __attribute__((ext_vector_type(4)));
typedef unsigned v2u __attribute__((ext_vector_type(2)));
typedef float f32x4 __attribute__((ext_vector_type(4)));
typedef float f32x16 __attribute__((ext_vector_type(16)));
typedef short bf16x8 __attribute__((ext_vector_type(8)));
typedef GAS unsigned gu32;
#define RLX_AGENT __ATOMIC_RELAXED, __HIP_MEMORY_SCOPE_AGENT
#define LDS_WAIT() asm volatile("s_waitcnt lgkmcnt(0)" ::: "memory")
#define VM_WAIT() asm volatile("s_waitcnt vmcnt(0)" ::: "memory")
__device__ __forceinline__ unsigned f2bf(float f) { unsigned u = __builtin_bit_cast(unsigned, f); return (u + 0x7fffu + ((u >> 16) & 1u)) >> 16; }
__device__ __forceinline__ unsigned pk2(float lo, float hi) { return f2bf(lo) | (f2bf(hi) << 16); }
__device__ __forceinline__ unsigned fp8x4(float a, float b, float c, float d) { int w = __builtin_amdgcn_cvt_pk_fp8_f32(a, b, 0, false); w = __builtin_amdgcn_cvt_pk_fp8_f32(c, d, w, true); return (unsigned)w; }
constexpr float WSCALE = 64.f, ASCALE = 8.f;
__device__ __forceinline__ float bf2f(unsigned short b) { return __builtin_bit_cast(float, (unsigned)b << 16); }
__device__ __forceinline__ float bflo(unsigned w) { return __builtin_bit_cast(float, w << 16); }
__device__ __forceinline__ float bfhi(unsigned w) { return __builtin_bit_cast(float, w & 0xffff0000u); }
__device__ __forceinline__ float wave_sum(float v) {
#pragma unroll
    for (int o = 1; o < 64; o <<= 1) v += __shfl_xor(v, o);
    return v;
}

#define XB_TMO      128
#define XB_XCNT(j)  (256  + 64 * (j))
#define XB_XSUB(j)  (1280 + 64 * (j))
#define XB_XGEN(j)  (2304 + 64 * (j))
#define XB_TOP      3328
#define XB_TOPGEN   3392
#define XCD_BAR_WORDS 3456
#define XB_SPIN_CAP (1u << 20)
__device__ __forceinline__ unsigned xb_ld(unsigned* p)              { return __hip_atomic_load(p, __ATOMIC_RELAXED, __HIP_MEMORY_SCOPE_AGENT); }
__device__ __forceinline__ unsigned xb_add(unsigned* p, unsigned v) { return __hip_atomic_fetch_add(p, v, __ATOMIC_RELAXED, __HIP_MEMORY_SCOPE_AGENT); }
__device__ __forceinline__ unsigned xb_xcc_id() { return (unsigned)__builtin_amdgcn_s_getreg((3 << 11) | 20) & 0xFu; }
#define XB_SPIN(cond, bar) do { unsigned _sp = 0; while (cond) { __builtin_amdgcn_s_sleep(1); \
    if ((++_sp & 255u) == 0u) { if (xb_ld(&(bar)[XB_TMO])) break; if (_sp > XB_SPIN_CAP) { atomicAdd(&(bar)[XB_TMO], 1u); break; } } } } while (0)
struct XcdBarrier { unsigned* bar; unsigned x; volatile LAS unsigned* st; };
__device__ __forceinline__ XcdBarrier xcd_barrier_post(unsigned* bar, volatile LAS unsigned* st) {
    XcdBarrier b; b.bar = bar; b.x = xb_xcc_id(); b.st = st;
    if (threadIdx.x == 0) (void)xb_add(&bar[XB_XCNT(b.x)], 1u);
    return b;
}
__device__ __forceinline__ void xcd_barrier_complete(unsigned* bar, unsigned x, unsigned& nloc, unsigned& nx) {
    const unsigned G = gridDim.x * gridDim.y * gridDim.z;
    unsigned sum, cnt, mine, sp = 0u;
    for (;;) {
        sum = 0u; cnt = 0u; mine = 0u;
#pragma unroll
        for (unsigned j = 0; j < 16; ++j) { const unsigned c = xb_ld(&bar[XB_XCNT(j)]); sum += c; cnt += (c > 0u) ? 1u : 0u; mine = (j == x) ? c : mine; }
        if (sum == G) break;
        __builtin_amdgcn_s_sleep(1);
        if ((++sp & 255u) == 0u) { if (xb_ld(&bar[XB_TMO])) break; if (sp > XB_SPIN_CAP) { atomicAdd(&bar[XB_TMO], 1u); break; } }
    }
    nloc = mine > 0u ? mine : 1u; nx = cnt > 0u ? cnt : 1u;
}
__device__ __forceinline__ void xcd_barrier(const XcdBarrier& b) {
    asm volatile("s_waitcnt vmcnt(0)" ::: "memory");
    __syncthreads();
    if (threadIdx.x == 0) {
        unsigned* bar = b.bar;
        __builtin_amdgcn_s_waitcnt(0);
        unsigned nloc = b.st[0], nx = b.st[1];
        if (nloc == 0u) { xcd_barrier_complete(bar, b.x, nloc, nx); b.st[0] = nloc; b.st[1] = nx; }
        const unsigned old = xb_add(&bar[XB_XSUB(b.x)], 1u);
        const unsigned gen = old / nloc;
        if (old + 1u == (gen + 1u) * nloc) {
            __builtin_amdgcn_fence(__ATOMIC_RELEASE, "agent");
            asm volatile("s_waitcnt vmcnt(0)" ::: "memory");
            const unsigned og = xb_add(&bar[XB_TOP], 1u);
            const unsigned tg = og / nx;
            if (og + 1u == (tg + 1u) * nx) xb_add(&bar[XB_TOPGEN], 1u);
            else XB_SPIN(xb_ld(&bar[XB_TOPGEN]) == tg, bar);
            __builtin_amdgcn_fence(__ATOMIC_ACQUIRE, "agent");
            xb_add(&bar[XB_XGEN(b.x)], 1u);
            asm volatile("s_waitcnt vmcnt(0)" ::: "memory");
        } else {
            XB_SPIN(xb_ld(&bar[XB_XGEN(b.x)]) == gen, bar);
            __builtin_amdgcn_fence(__ATOMIC_ACQUIRE, "agent");
            asm volatile("s_waitcnt vmcnt(0)" ::: "memory");
        }
    }
    __syncthreads();
}

struct Frame {
    LAS unsigned char* lds;
    volatile LAS unsigned* MISC;
    gu32* ctl;
    int tid, lane, wave;
    int vcu, G;
    const float *x, *mem, *g_attn, *g_mem, *w_in, *lamqk, *subg, *w_mkv, *w_out, *g_ffn, *w_r, *b_r, *w_gu, *b_gu, *w_dn, *b_dn, *g_fin;
    float* out; unsigned char* ws;
};

#define P0_LOAD(dst, itm) do { const int m_ = (itm) / ipm, r_ = (itm) % ipm, kb_ = r_ / nblk, nb_ = r_ % nblk; \
        const float* src_ = W + (size_t)m_ * K * N + (size_t)(64 * kb_ + (lane >> 5)) * N + 32 * nb_ + (lane & 31); \
        _Pragma("unroll") for (int i_ = 0; i_ < 32; ++i_) dst[i_] = src_[(size_t)(2 * i_) * N]; } while (0)
template <bool F8, class RowMap>
__device__ __forceinline__ void p0_transpose_all(const float* W, int K, int N, int nmat, void* WTv, const float* gk, float wscale, LAS float* scr, int gw, int NGW, int lane, RowMap rowmap) {
    const int nblk = N / 32, ipm = (K / 64) * nblk, total = nmat * ipm;
    int it = gw; if (it >= total) return;
    float v[32], w[32];
    P0_LOAD(v, it);
    for (;;) {
        const int nx = it + NGW; const bool more = nx < total;
        if (more) P0_LOAD(w, nx);
        const int m = it / ipm, r = it % ipm, k0 = 64 * (r / nblk), n0 = 32 * (r % nblk);
        if (gk) {
#pragma unroll
            for (int i = 0; i < 32; ++i) v[i] *= gk[k0 + 2 * i + (lane >> 5)] * wscale;
        } else if (F8) {
#pragma unroll
            for (int i = 0; i < 32; ++i) v[i] *= wscale;
        }
#pragma unroll
        for (int i = 0; i < 32; ++i) scr[(2 * i + (lane >> 5)) * 33 + (lane & 31)] = v[i];
        LDS_WAIT(); asm volatile("" ::: "memory");
        const int c = lane & 7;
#pragma unroll
        for (int j = 0; j < 4; ++j) { const int n = (lane >> 3) + 8 * j; const LAS float* s = scr + (8 * c) * 33 + n;
            if constexpr (F8) { unsigned char* wt = (unsigned char*)WTv + (size_t)m * N * K;
                v2u o; o.x = fp8x4(s[0 * 33], s[1 * 33], s[2 * 33], s[3 * 33]); o.y = fp8x4(s[4 * 33], s[5 * 33], s[6 * 33], s[7 * 33]);
                *(GAS v2u*)(wt + (size_t)rowmap(n0 + n) * K + k0 + 8 * c) = o; }
            else { bf16* wt = (bf16*)WTv + (size_t)m * N * K;
                v4u o; o.x = pk2(s[0 * 33], s[1 * 33]); o.y = pk2(s[2 * 33], s[3 * 33]); o.z = pk2(s[4 * 33], s[5 * 33]); o.w = pk2(s[6 * 33], s[7 * 33]);
                *(GAS v4u*)(wt + (size_t)rowmap(n0 + n) * K + k0 + 8 * c) = o; } }
        LDS_WAIT(); asm volatile("" ::: "memory");
        if (!more) break;
#pragma unroll
        for (int i = 0; i < 32; ++i) v[i] = w[i];
        it = nx;
    }
}
#undef P0_LOAD
struct RowId { __device__ __forceinline__ int operator()(int n) const { return n; } };
struct RowGU { __device__ __forceinline__ int operator()(int n) const { const int f = n >> 1, u = n & 1; return ((f >> 7) << 8) + (u << 7) + (f & 127); } };

__device__ __forceinline__ void p0_x_rows2(Frame& F, const float* xrow, bf16* orow, float* rstd_out) {
    const GAS f32x4* xr = (const GAS f32x4*)xrow + F.lane;
    f32x4 v[8]; float s0 = 0.f, s1 = 0.f;
#pragma unroll
    for (int j = 0; j < 8; ++j) v[j] = xr[64 * j];
#pragma unroll
    for (int j = 0; j < 4; ++j) { s0 += (v[j].x * v[j].x + v[j].y * v[j].y) + (v[j].z * v[j].z + v[j].w * v[j].w); s1 += (v[4 + j].x * v[4 + j].x + v[4 + j].y * v[4 + j].y) + (v[4 + j].z * v[4 + j].z + v[4 + j].w * v[4 + j].w); }
    s0 = wave_sum(s0); s1 = wave_sum(s1);
    GAS unsigned long long* o8 = (GAS unsigned long long*)orow + F.lane;
#pragma unroll
    for (int j = 0; j < 8; ++j) o8[64 * j] = (unsigned long long)pk2(v[j].x, v[j].y) | ((unsigned long long)pk2(v[j].z, v[j].w) << 32);
    if (F.lane == 0) { rstd_out[0] = 1.f / sqrtf(s0 * (1.f / D) + EPS); rstd_out[1] = 1.f / sqrtf(s1 * (1.f / D) + EPS); }
}
__device__ __forceinline__ void p0_mkv_tile(Frame& F, int tile, bf16* mkv) {
    const int mt = tile >> 4, nt = tile & 15, m0 = 32 * mt, n0 = 32 * nt, r = F.lane & 31, h = F.lane >> 5;
    f32x16 acc = {}; float ss = 0.f;
    const float* mrow = F.mem + (size_t)(m0 + r) * D + 8 * h;
    const float* wcol = F.w_mkv + (size_t)(8 * h) * 512 + n0 + r;
    const float* gp = F.g_mem + 8 * h;
    for (int k0 = 0; k0 < D; k0 += 16) {
        const f32x4 a0 = *(const f32x4*)(mrow + k0), a1 = *(const f32x4*)(mrow + k0 + 4);
        const f32x4 g0 = *(const f32x4*)(gp + k0), g1 = *(const f32x4*)(gp + k0 + 4);
        ss += (a0.x * a0.x + a0.y * a0.y) + (a0.z * a0.z + a0.w * a0.w) + (a1.x * a1.x + a1.y * a1.y) + (a1.z * a1.z + a1.w * a1.w);
        v4u bw; bw.x = pk2(a0.x * g0.x, a0.y * g0.y); bw.y = pk2(a0.z * g0.z, a0.w * g0.w); bw.z = pk2(a1.x * g1.x, a1.y * g1.y); bw.w = pk2(a1.z * g1.z, a1.w * g1.w);
        float wv[8];
#pragma unroll
        for (int j = 0; j < 8; ++j) wv[j] = wcol[(size_t)(k0 + j) * 512];
        v4u aw; aw.x = pk2(wv[0], wv[1]); aw.y = pk2(wv[2], wv[3]); aw.z = pk2(wv[4], wv[5]); aw.w = pk2(wv[6], wv[7]);
        acc = __builtin_amdgcn_mfma_f32_32x32x16_bf16(__builtin_bit_cast(bf16x8, aw), __builtin_bit_cast(bf16x8, bw), acc, 0, 0, 0);
    }
    ss += __shfl_xor(ss, 32);
    const float rstd = 1.f / sqrtf(ss * (1.f / D) + EPS);
    bf16* orow = mkv + (size_t)(m0 + r) * 512 + n0 + 4 * h;
#pragma unroll
    for (int q = 0; q < 4; ++q) { v2u o; o.x = pk2(acc[4 * q] * rstd, acc[4 * q + 1] * rstd); o.y = pk2(acc[4 * q + 2] * rstd, acc[4 * q + 3] * rstd); *(GAS v2u*)(orow + 8 * q) = o; }
}
__device__ __forceinline__ void p0_prologue(Frame& F) {
    LAS float* scr = (LAS float*)(F.lds + RING_OFF + F.wave * 16384);
    const int gw = F.vcu * NWAVES + F.wave, NGW = F.G * NWAVES;
    bf16* win_t = (bf16*)(F.ws + WS_WIN); bf16* wout_t = (bf16*)(F.ws + WS_WOUT); bf16* wgu_t = (bf16*)(F.ws + WS_WGU); bf16* wdn_t = (bf16*)(F.ws + WS_WDN);
    p0_transpose_all<true>(F.w_gu, D, 2 * DFF, NE, wgu_t, F.g_ffn, WSCALE, scr, gw, NGW, F.lane, RowGU());
    p0_transpose_all<true>(F.w_dn, DFF, D, NE, wdn_t, nullptr, WSCALE, scr, gw, NGW, F.lane, RowId());
    p0_transpose_all<false>(F.w_in, D, DIN, 1, win_t, F.g_attn, 1.f, scr, gw, NGW, F.lane, RowId());
    p0_transpose_all<false>(F.w_out, D, D, 1, wout_t, nullptr, 1.f, scr, gw, NGW, F.lane, RowId());
    bf16* xb = (bf16*)(F.ws + WS_XB); float* rstd1 = (float*)(F.ws + WS_RSTD1);
    for (int m = 2 * gw; m < T; m += 2 * NGW) p0_x_rows2(F, F.x + (size_t)m * D, xb + (size_t)m * D, rstd1 + m);
    bf16* mkv = (bf16*)(F.ws + WS_MKV);
    for (int t = gw; t < (BATCH * NMEM / 32) * (512 / 32); t += NGW) p0_mkv_tile(F, t, mkv);
    bf16* wrt = (bf16*)(F.ws + WS_WRT);
    for (int i = gw * 64 + F.lane; i < D * NE; i += NGW * 64) { const int e = i >> 10, k = i & 1023; const float w = F.w_r[k * NE + e] * F.g_ffn[k]; const unsigned hb = f2bf(w); wrt[i] = (bf16)hb; wrt[D * NE + i] = (bf16)f2bf(w - bf2f((bf16)hb)); }
}

struct EpiInProj {
    bf16* O; const float* rstd;
    __device__ __forceinline__ void operator()(const pg8::f32x4 (&acc)[2][2][4][2], const pg8::Unit& u, int wr, int wc, int fr, int fq, const LAS unsigned*) const {
        asm volatile("" : "+v"(fr), "+v"(fq));
        const int row0 = u.pm * 256 + wr * 64 + fr, col0 = u.pn * 256 + wc * 32 + 8 * fq;
        const float sc = (u.pn <= 1 || u.pn == 6 || u.pn == 9) ? QSCALE : 1.f;
        float rsv[2][4];
#pragma unroll
        for (int ai = 0; ai < 2; ++ai)
#pragma unroll
            for (int m = 0; m < 4; ++m) rsv[ai][m] = rstd[row0 + ai * 128 + m * 16];
#pragma unroll
        for (int ai = 0; ai < 2; ++ai)
#pragma unroll
            for (int m = 0; m < 4; ++m) { const int row = row0 + ai * 128 + m * 16; const float rs = rsv[ai][m] * sc; bf16* rowp = O + (size_t)row * DIN + col0;
#pragma unroll
                for (int bj = 0; bj < 2; ++bj) { const pg8::f32x4 v0 = acc[ai][bj][m][0] * rs, v1 = acc[ai][bj][m][1] * rs;
                    v4u w; w.x = pg8::cvt_pk_bf16(v0[0], v0[1]); w.y = pg8::cvt_pk_bf16(v0[2], v0[3]); w.z = pg8::cvt_pk_bf16(v1[0], v1[1]); w.w = pg8::cvt_pk_bf16(v1[2], v1[3]);
                    *(v4u*)(rowp + bj * 128) = w; } }
    }
};
__device__ __forceinline__ void attn_phase(Frame& F, char* shm, int gmask = 7) {
    using namespace attn_body;
    const int v = F.vcu;
    const attn_body::bf16* P = (const attn_body::bf16*)(F.ws + WS_P);
    attn_body::bf16* OD = (attn_body::bf16*)(F.ws + WS_OD);
    attn_body::bf16* mix = (attn_body::bf16*)(F.ws + WS_MIX);
    float lam;
    { const float a = F.lamqk[F.lane] * F.lamqk[64 + F.lane], c = F.lamqk[128 + F.lane] * F.lamqk[192 + F.lane];
      lam = __expf(wave_sum(a)) - __expf(wave_sum(c)) + 0.2f; }
#if !defined(ATT_ONLY) || ATT_ONLY==1
    if ((gmask & 1) && v < BATCH * 4 * 8) {
        const int bh = v >> 3, s = v & 7, b = bh >> 2, h = bh & 3;
        const attn_body::bf16* Pb = P + (size_t)b * SEQ * DIN;
        const float slope = exp2f(-(float)(2 * h + 1)) * LOG2E;
        for (int i2 = 0; i2 < 2; ++i2) {
            const int qb = i2 ? 15 - s : s;
            for (int pass = 0; pass < 4; ++pass) {
                const int j = pass >> 1, vh = pass & 1;
                UnitP U; U.Q = Pb + C_DQ + h * 128 + j * 64; U.K = Pb + C_DK + h * 128 + j * 64; U.V = Pb + C_DV + h * 128 + vh * 64;
                U.O = OD + (size_t)b * SEQ * 1024 + h * 256 + j * 128 + vh * 64; U.qp = DIN; U.kp = DIN; U.op = 1024;
                U.q0 = qb * 256; U.t0 = 0; U.NT = 4 * qb + 4; U.slope2 = slope; U.lse = nullptr; U.lse_stride = 0;
                attn_unit<8, true, false, true, false>(U, shm);
            }
            asm volatile("s_waitcnt vmcnt(0)" ::: "memory");
            const int row = (b * SEQ + qb * 256 + F.wave * 32 + (F.lane >> 1)), vh = F.lane & 1;
            const v4u* o1 = (const v4u*)(OD + (size_t)row * 1024 + h * 256 + vh * 64);
            const v4u* o2 = (const v4u*)(OD + (size_t)row * 1024 + h * 256 + 128 + vh * 64);
            float d[64]; float ss = 0.f;
#pragma unroll
            for (int c = 0; c < 8; ++c) { const v4u a = o1[c], bq = o2[c];
                const unsigned aw[4] = {a.x, a.y, a.z, a.w}, bw[4] = {bq.x, bq.y, bq.z, bq.w};
#pragma unroll
                for (int q = 0; q < 4; ++q) { const float x0 = bflo(aw[q]) - lam * bflo(bw[q]), x1 = bfhi(aw[q]) - lam * bfhi(bw[q]); d[8 * c + 2 * q] = x0; d[8 * c + 2 * q + 1] = x1; ss += x0 * x0 + x1 * x1; } }
            ss += __shfl_xor(ss, 1);
            const float rstd = 0.8f / sqrtf(ss * (1.f / 128.f) + EPS);
            const float* gp = F.subg + vh * 64;
            v4u* mo = (v4u*)(mix + (size_t)row * 1024 + h * 128 + vh * 64);
#pragma unroll
            for (int c = 0; c < 8; ++c) { v4u o; o.x = pk2(d[8 * c] * rstd * gp[8 * c], d[8 * c + 1] * rstd * gp[8 * c + 1]); o.y = pk2(d[8 * c + 2] * rstd * gp[8 * c + 2], d[8 * c + 3] * rstd * gp[8 * c + 3]);
                o.z = pk2(d[8 * c + 4] * rstd * gp[8 * c + 4], d[8 * c + 5] * rstd * gp[8 * c + 5]); o.w = pk2(d[8 * c + 6] * rstd * gp[8 * c + 6], d[8 * c + 7] * rstd * gp[8 * c + 7]); mo[c] = o; }
        }
    }
#endif
#if !defined(ATT_ONLY) || ATT_ONLY==2
    attn_body::bf16* ODIL = (attn_body::bf16*)(F.ws + WS_ODIL); float* LSEb = (float*)(F.ws + WS_LSE);
    for (int i = 0; i < 6; ++i) {
        const int du = v * 6 + i; if (!(gmask & 2) || du >= BATCH * 4 * 48) break;
        const int bh = du / 48, idx = du % 48, n = idx >> 4, w = idx & 15, b = bh >> 2, h = bh & 3;
        const int r = (n == 0) ? 1 : (n == 1 ? 4 : 16), c = (n == 0) ? 0 : (n == 1 ? (w >> 2) : w), blk = (n == 0) ? w : (n == 1 ? (w & 3) : 0);
        const attn_body::bf16* Pb = P + ((size_t)b * SEQ + c) * DIN;
        UnitP U; U.Q = Pb + C_LQ + h * 64; U.K = Pb + C_LK + h * 64; U.V = Pb + C_LV + h * 64; U.qp = (long)r * DIN; U.kp = (long)r * DIN;
        U.O = ODIL + (size_t)n * T * 256 + ((size_t)b * SEQ + c) * 256 + h * 64; U.op = (long)r * 256;
        U.q0 = blk * 256; U.t0 = (blk == 0) ? 0 : 4 * blk - 2; U.NT = 4 * blk + 4 - U.t0;
        U.slope2 = exp2f(-(float)(2 * h + 2)) * (float)r * LOG2E;
        U.lse = LSEb + (size_t)n * T * 4 + ((size_t)b * SEQ + c) * 4 + h; U.lse_stride = r * 4;
        attn_unit<8, true, true, true, true>(U, shm);
    }
#endif
#if !defined(ATT_ONLY) || ATT_ONLY==3
    const attn_body::bf16* MKV = (const attn_body::bf16*)(F.ws + WS_MKV);
    for (int i = 0; i < 2; ++i) {
        const int mu = v * 2 + i; if (!(gmask & 4) || mu >= BATCH * 4 * 16) break;
        const int bh = mu >> 4, qb = mu & 15, b = bh >> 2, h = bh & 3;
        UnitP U; U.Q = P + (size_t)b * SEQ * DIN + C_MQ + h * 64; U.qp = DIN; U.K = MKV + (size_t)b * NMEM * 512 + h * 64; U.V = U.K + 256; U.kp = 512;
        U.O = mix + (size_t)b * SEQ * 1024 + 768 + h * 64; U.op = 1024; U.q0 = qb * 256; U.t0 = 0; U.NT = 4; U.slope2 = 0.f; U.lse = nullptr; U.lse_stride = 0;
        attn_unit<8, false, false, false, false>(U, shm);
    }
#endif
}
__device__ __forceinline__ void dil_combine_phase(Frame& F) {
    const int gw = F.vcu * NWAVES + F.wave, NGW = F.G * NWAVES;
    const bf16* ODIL = (const bf16*)(F.ws + WS_ODIL); const float* LSEb = (const float*)(F.ws + WS_LSE); bf16* mix = (bf16*)(F.ws + WS_MIX);
    const int h = F.lane >> 4, d4 = (F.lane & 15) * 4;
    for (int row0 = 4 * gw; row0 < T; row0 += 4 * NGW) {
        float l[4][3]; v2u q[4][3];
#pragma unroll
        for (int i = 0; i < 4; ++i)
#pragma unroll
            for (int n = 0; n < 3; ++n) { l[i][n] = LSEb[(size_t)n * T * 4 + (size_t)(row0 + i) * 4 + h]; q[i][n] = *(const v2u*)(ODIL + (size_t)n * T * 256 + (size_t)(row0 + i) * 256 + h * 64 + d4); }
#pragma unroll
        for (int i = 0; i < 4; ++i) {
            const float m = fmaxf(fmaxf(l[i][0], l[i][1]), l[i][2]);
            float wn[3], den = 0.f;
#pragma unroll
            for (int n = 0; n < 3; ++n) { wn[n] = exp2f(l[i][n] - m); den += wn[n]; }
            const float inv = 1.f / den; float o[4] = {0.f, 0.f, 0.f, 0.f};
#pragma unroll
            for (int n = 0; n < 3; ++n) { const float wq = wn[n] * inv; o[0] += wq * bflo(q[i][n].x); o[1] += wq * bfhi(q[i][n].x); o[2] += wq * bflo(q[i][n].y); o[3] += wq * bfhi(q[i][n].y); }
            v2u ov; ov.x = pk2(o[0], o[1]); ov.y = pk2(o[2], o[3]);
            *(v2u*)(mix + (size_t)(row0 + i) * 1024 + 512 + h * 64 + d4) = ov;
        }
    }
}
struct EpiY {
    bf16* Y;
    __device__ __forceinline__ void operator()(const pg8::f32x4 (&acc)[2][2][4][2], const pg8::Unit& u, int wr, int wc, int fr, int fq, const LAS unsigned*) const {
        asm volatile("" : "+v"(fr), "+v"(fq));
        const int row0 = u.pm * 256 + wr * 64 + fr, col0 = u.pn * 256 + wc * 32 + 8 * fq;
#pragma unroll
        for (int ai = 0; ai < 2; ++ai)
#pragma unroll
            for (int m = 0; m < 4; ++m) { bf16* rowp = Y + (size_t)(row0 + ai * 128 + m * 16) * D + col0;
#pragma unroll
                for (int bj = 0; bj < 2; ++bj) { const pg8::f32x4 v0 = acc[ai][bj][m][0], v1 = acc[ai][bj][m][1];
                    v4u w; w.x = pg8::cvt_pk_bf16(v0[0], v0[1]); w.y = pg8::cvt_pk_bf16(v0[2], v0[3]); w.z = pg8::cvt_pk_bf16(v1[0], v1[1]); w.w = pg8::cvt_pk_bf16(v1[2], v1[3]);
                    *(v4u*)(rowp + bj * 128) = w; } }
    }
};

__device__ __forceinline__ void route_phase(Frame& F) {
    LAS float* xch = (LAS float*)(F.lds + RING_OFF);
    LAS unsigned* lcnt = (LAS unsigned*)(F.lds + LCNT_OFF);
    LAS unsigned* stg = (LAS unsigned*)(F.lds + STG_OFF);
    if (F.tid < 64) lcnt[F.tid] = 0u;
    const int lane = F.lane, tl = lane & 31, h = lane >> 5, tg = F.wave & 3, kh = F.wave >> 2;
    { const v4u* wsrc = (const v4u*)(F.ws + WS_WRT); LAS char* wl = (LAS char*)(F.lds + RING_OFF);
      for (int i = F.tid; i < 2 * 32 * 128; i += NWAVES * 64) { const int hl = i >> 12, e = (i >> 7) & 31, c = i & 127; *(LAS v4u*)(wl + hl * 65536 + e * 2048 + ((c ^ (e & 15)) << 4)) = wsrc[i]; } }
    __syncthreads();
    const int tok = F.vcu * 128 + tg * 32 + tl;
    const float* xr = F.x + (size_t)tok * D + kh * 512 + 8 * h;
    const bf16* yr = (const bf16*)(F.ws + WS_Y) + (size_t)tok * D + kh * 512 + 8 * h;
    unsigned char* x1r = (unsigned char*)(F.ws + WS_X1B) + (size_t)tok * D + kh * 512 + 8 * h;
    const LAS char* wrow = (const LAS char*)(F.lds + RING_OFF) + tl * 2048;
    f32x16 acc = {}; float ss = 0.f;
    f32x4 xa[2][8]; v4u ya[2][4];
#define RT_LOAD(buf, g) do { _Pragma("unroll") for (int q_ = 0; q_ < 4; ++q_) { xa[buf][2 * q_] = *(const f32x4*)(xr + 64 * (g) + 16 * q_); xa[buf][2 * q_ + 1] = *(const f32x4*)(xr + 64 * (g) + 16 * q_ + 4); \
        ya[buf][q_] = *(const v4u*)(yr + 64 * (g) + 16 * q_); } } while (0)
#define RT_COMP(buf, g) do { _Pragma("unroll") for (int q_ = 0; q_ < 4; ++q_) { const int c_ = (kh * 512 + 64 * (g) + 16 * q_) / 8 + h; \
        const v4u wh = *(const LAS v4u*)(wrow + ((c_ ^ (tl & 15)) << 4)), wl2 = *(const LAS v4u*)(wrow + 65536 + ((c_ ^ (tl & 15)) << 4)); \
        const f32x4 a0 = xa[buf][2 * q_], a1 = xa[buf][2 * q_ + 1]; const v4u yv = ya[buf][q_]; \
        const float x1[8] = {a0.x + bflo(yv.x), a0.y + bfhi(yv.x), a0.z + bflo(yv.y), a0.w + bfhi(yv.y), a1.x + bflo(yv.z), a1.y + bfhi(yv.z), a1.z + bflo(yv.w), a1.w + bfhi(yv.w)}; \
        unsigned hw[4], lw[4]; \
        _Pragma("unroll") for (int p_ = 0; p_ < 4; ++p_) { const float u_ = x1[2 * p_], r_ = x1[2 * p_ + 1]; ss += u_ * u_ + r_ * r_; const unsigned hb = pk2(u_, r_); hw[p_] = hb; lw[p_] = pk2(u_ - bflo(hb), r_ - bfhi(hb)); } \
        const v4u xh = (v4u){hw[0], hw[1], hw[2], hw[3]}, xl = (v4u){lw[0], lw[1], lw[2], lw[3]}; \
        { v2u o8_; o8_.x = fp8x4(x1[0], x1[1], x1[2], x1[3]); o8_.y = fp8x4(x1[4], x1[5], x1[6], x1[7]); *(v2u*)(x1r + 64 * (g) + 16 * q_) = o8_; } \
        acc = __builtin_amdgcn_mfma_f32_32x32x16_bf16(__builtin_bit_cast(bf16x8, wh), __builtin_bit_cast(bf16x8, xh), acc, 0, 0, 0); \
        acc = __builtin_amdgcn_mfma_f32_32x32x16_bf16(__builtin_bit_cast(bf16x8, wh), __builtin_bit_cast(bf16x8, xl), acc, 0, 0, 0); \
        acc = __builtin_amdgcn_mfma_f32_32x32x16_bf16(__builtin_bit_cast(bf16x8, wl2), __builtin_bit_cast(bf16x8, xh), acc, 0, 0, 0); } } while (0)
    RT_LOAD(0, 0);
#pragma unroll
    for (int g = 0; g < 8; g += 2) {
        RT_LOAD(1, g + 1); RT_COMP(0, g);
        if (g + 2 < 8) RT_LOAD(0, g + 2);
        RT_COMP(1, g + 1);
    }
#undef RT_LOAD
#undef RT_COMP
    __syncthreads();
    if (kh == 1) { LAS float* d = xch + (tg * 64 + lane) * 17;
#pragma unroll
        for (int i = 0; i < 16; ++i) d[i] = acc[i];
        d[16] = ss; }
    __syncthreads();
    if (kh == 0) {
        const LAS float* d = xch + (tg * 64 + lane) * 17;
#pragma unroll
        for (int i = 0; i < 16; ++i) acc[i] += d[i];
        ss += d[16]; ss += __shfl_xor(ss, 32);
        const float rstd = 1.f / sqrtf(ss * (1.f / D) + EPS);
        float lg[16];
#pragma unroll
        for (int i = 0; i < 16; ++i) lg[i] = acc[i] * rstd + F.b_r[4 * h + (i & 3) + 8 * (i >> 2)];
        float cv[8]; int ce[8];
#pragma unroll
        for (int k = 0; k < 4; ++k) { float bv = -INFINITY; int bi = 0;
#pragma unroll
            for (int i = 0; i < 16; ++i) { if (lg[i] > bv) { bv = lg[i]; bi = i; } }
            cv[k] = bv; ce[k] = 4 * h + (bi & 3) + 8 * (bi >> 2);
#pragma unroll
            for (int i = 0; i < 16; ++i) if (i == bi) lg[i] = -INFINITY; }
#pragma unroll
        for (int k = 0; k < 4; ++k) { cv[4 + k] = __shfl_xor(cv[k], 32); ce[4 + k] = __shfl_xor(ce[k], 32); }
        float tv[4]; int te[4];
#pragma unroll
        for (int k = 0; k < 4; ++k) { float bv = -INFINITY; int be = 64, bi = 0;
#pragma unroll
            for (int i = 0; i < 8; ++i) { if (cv[i] > bv || (cv[i] == bv && ce[i] < be)) { bv = cv[i]; be = ce[i]; bi = i; } }
            tv[k] = bv; te[k] = be;
#pragma unroll
            for (int i = 0; i < 8; ++i) if (i == bi) cv[i] = -INFINITY; }
        float gk[4], den = 0.f;
#pragma unroll
        for (int k = 0; k < 4; ++k) { gk[k] = __expf(tv[k] - tv[0]); den += gk[k]; }
        const float inv = 1.f / den;
        if (h == 0) {
#pragma unroll
            for (int k = 0; k < 4; ++k) {
                const unsigned rank = __hip_atomic_fetch_add(lcnt + te[k], 1u, __ATOMIC_RELAXED, __HIP_MEMORY_SCOPE_WORKGROUP);
                const int slot = (tg * 32 + tl) * 4 + k;
                stg[slot * 3] = (unsigned)(tok * 4 + k); stg[slot * 3 + 1] = ((unsigned)te[k] << 16) | rank; stg[slot * 3 + 2] = __builtin_bit_cast(unsigned, gk[k] * inv);
            }
            ((float*)(F.ws + WS_RSTD2))[tok] = rstd;
        }
    }
    __syncthreads();
    if (F.tid < 32) { const unsigned n = lcnt[F.tid]; lcnt[32 + F.tid] = n ? __hip_atomic_fetch_add((unsigned*)(F.ctl + CW_CNT) + F.tid, n, __ATOMIC_RELAXED, __HIP_MEMORY_SCOPE_AGENT) : 0u; }
    __syncthreads();
    { unsigned* list = (unsigned*)(F.ws + WS_LIST); float* rgate = (float*)(F.ws + WS_RGATE);
      const unsigned ent = stg[F.tid * 3], er = stg[F.tid * 3 + 1], gb = stg[F.tid * 3 + 2]; const unsigned e = er >> 16, rank = er & 0xffffu;
      list[(size_t)e * LCAP + lcnt[32 + e] + rank] = ent; rgate[ent] = __builtin_bit_cast(float, gb); }
    __syncthreads();
}

__device__ __forceinline__ int moe_build_table(Frame& F) {
    LAS unsigned* tbl = (LAS unsigned*)(F.lds + TBL_OFF); LAS unsigned* lcnt = (LAS unsigned*)(F.lds + LCNT_OFF);
    if (F.wave == 0) {
        const int e = F.lane & 31;
        const unsigned cnt = __hip_atomic_load((unsigned*)(F.ctl + CW_CNT) + e, __ATOMIC_RELAXED, __HIP_MEMORY_SCOPE_AGENT);
        const unsigned nt = (cnt + 255u) >> 8; unsigned incl = nt;
#pragma unroll
        for (int o = 1; o < 32; o <<= 1) { const unsigned t = __shfl_up(incl, o); if ((F.lane & 31) >= o) incl += t; }
        if (F.lane < 32) { lcnt[e] = cnt; const unsigned start = incl - nt; for (unsigned j = 0; j < nt; ++j) tbl[start + j] = ((unsigned)e << 16) | j; if (F.lane == 31) F.MISC[16] = incl; }
    }
    __syncthreads();
    return (int)F.MISC[16];
}
struct MoeOrder {
    const LAS unsigned* tbl; const LAS unsigned* lcnt; const unsigned* list; int NMT, G, c, NPN, MPER, RB; size_t bexp; bool a_tiles;
    __device__ __forceinline__ bool next(int i, pg8::Unit& u) const {
        const int L = i * G + c, blk = L >> 5, w = L & 31, g = blk * MPER + w / NPN, pn = w % NPN;
        if (g >= NMT) return false;
        const unsigned t = tbl[g]; const int e = (int)(t >> 16), mt = (int)(t & 0xffffu); const int cnt = (int)lcnt[e];
        u.pm = g; u.pn = pn; u.e = e; u.mt = mt; u.valid = min(256, cnt - mt * 256);
        u.aoff = a_tiles ? (size_t)g * (size_t)(256 * RB) : (size_t)0; u.boff = (size_t)e * bexp + (size_t)pn * (size_t)(256 * RB);
        return true;
    }
    __device__ __forceinline__ const unsigned* id_src(const pg8::Unit& u, int row) const { return list + (size_t)u.e * LCAP + u.mt * 256 + min(row, u.valid - 1); }
};
struct EpiGU {
    unsigned char* ACT; const float* rstd2; const float* bgu;
    __device__ __forceinline__ void operator()(const pg8::f32x4 (&acc)[2][2][4][2], const pg8::Unit& u, int wr, int wc, int fr, int fq, const LAS unsigned* ids) const {
        asm volatile("" : "+v"(fr), "+v"(fq));
        const int r0 = wr * 64 + fr, f0 = u.pn * 128 + wc * 32 + 8 * fq;
        float rs[2][4];
#pragma unroll
        for (int ai = 0; ai < 2; ++ai)
#pragma unroll
            for (int m = 0; m < 4; ++m) rs[ai][m] = rstd2[ids[r0 + ai * 128 + m * 16] >> 2] * (1.f / WSCALE);
        const float* bp = bgu + (size_t)u.e * 2048 + 2 * f0;
        const pg8::f32x4 b0 = *(const pg8::f32x4*)bp, b1 = *(const pg8::f32x4*)(bp + 4), b2 = *(const pg8::f32x4*)(bp + 8), b3 = *(const pg8::f32x4*)(bp + 12);
        const float gb[8] = {b0[0], b0[2], b1[0], b1[2], b2[0], b2[2], b3[0], b3[2]}, ub[8] = {b0[1], b0[3], b1[1], b1[3], b2[1], b2[3], b3[1], b3[3]};
#pragma unroll
        for (int ai = 0; ai < 2; ++ai)
#pragma unroll
            for (int m = 0; m < 4; ++m) { const int r = r0 + ai * 128 + m * 16; const float s = rs[ai][m]; float a[8];
#pragma unroll
                for (int n = 0; n < 2; ++n)
#pragma unroll
                    for (int j = 0; j < 4; ++j) { float gate = acc[ai][0][m][n][j] * s + gb[4 * n + j], up = acc[ai][1][m][n][j] * s + ub[4 * n + j];
                        gate = fminf(gate, 7.f); up = fminf(fmaxf(up, -7.f), 7.f);
                        a[4 * n + j] = ASCALE * (up + 1.f) * gate * __builtin_amdgcn_rcpf(1.f + __builtin_amdgcn_exp2f(-1.702f * LOG2E * gate)); }
                v2u w; w.x = fp8x4(a[0], a[1], a[2], a[3]); w.y = fp8x4(a[4], a[5], a[6], a[7]);
                *(v2u*)(ACT + (size_t)(u.pm * 256 + r) * DFF + f0) = w; }
    }
};
struct EpiDown {
    bf16* YB; const float* rgate; const float* bdn;
    __device__ __forceinline__ void operator()(const pg8::f32x4 (&acc)[2][2][4][2], const pg8::Unit& u, int wr, int wc, int fr, int fq, const LAS unsigned* ids) const {
        asm volatile("" : "+v"(fr), "+v"(fq));
        const int r0 = wr * 64 + fr, col0 = u.pn * 256 + wc * 32 + 8 * fq;
        float gt[2][4];
#pragma unroll
        for (int ai = 0; ai < 2; ++ai)
#pragma unroll
            for (int m = 0; m < 4; ++m) gt[ai][m] = rgate[ids[r0 + ai * 128 + m * 16]];
        pg8::f32x4 bv[2][2];
#pragma unroll
        for (int bj = 0; bj < 2; ++bj)
#pragma unroll
            for (int n = 0; n < 2; ++n) bv[bj][n] = *(const pg8::f32x4*)(bdn + (size_t)u.e * D + col0 + bj * 128 + 4 * n);
#pragma unroll
        for (int ai = 0; ai < 2; ++ai)
#pragma unroll
            for (int m = 0; m < 4; ++m) { const int r = r0 + ai * 128 + m * 16; if (r < u.valid) { const float g = gt[ai][m]; bf16* yp = YB + (size_t)ids[r] * D + col0;
#pragma unroll
                for (int bj = 0; bj < 2; ++bj) { const pg8::f32x4 v0 = (acc[ai][bj][m][0] * (1.f / (WSCALE * ASCALE)) + bv[bj][0]) * g, v1 = (acc[ai][bj][m][1] * (1.f / (WSCALE * ASCALE)) + bv[bj][1]) * g;
                    v4u w; w.x = pg8::cvt_pk_bf16(v0[0], v0[1]); w.y = pg8::cvt_pk_bf16(v0[2], v0[3]); w.z = pg8::cvt_pk_bf16(v1[0], v1[1]); w.w = pg8::cvt_pk_bf16(v1[2], v1[3]);
                    *(v4u*)(yp + bj * 128) = w; } } }
    }
};
__device__ __forceinline__ void final_phase(Frame& F) {
    const int gw = F.vcu * NWAVES + F.wave, NGW = F.G * NWAVES;
    const bf16* YB = (const bf16*)(F.ws + WS_YB);
    for (int t = gw; t < T; t += NGW) {
        float v[16]; float ss = 0.f;
#pragma unroll
        for (int jj = 0; jj < 2; ++jj) { const int c = 512 * jj + 8 * F.lane;
            const f32x4 a = *(const f32x4*)(F.x + (size_t)t * D + c), b = *(const f32x4*)(F.x + (size_t)t * D + c + 4);
            const v4u y0 = *(const v4u*)((const bf16*)(F.ws + WS_Y) + (size_t)t * D + c);
            float* vv = v + 8 * jj; vv[0] = a.x + bflo(y0.x); vv[1] = a.y + bfhi(y0.x); vv[2] = a.z + bflo(y0.y); vv[3] = a.w + bfhi(y0.y); vv[4] = b.x + bflo(y0.z); vv[5] = b.y + bfhi(y0.z); vv[6] = b.z + bflo(y0.w); vv[7] = b.w + bfhi(y0.w);
#pragma unroll
            for (int k = 0; k < 4; ++k) { const v4u y = *(const v4u*)(YB + ((size_t)t * 4 + k) * D + c);
                vv[0] += bflo(y.x); vv[1] += bfhi(y.x); vv[2] += bflo(y.y); vv[3] += bfhi(y.y); vv[4] += bflo(y.z); vv[5] += bfhi(y.z); vv[6] += bflo(y.w); vv[7] += bfhi(y.w); } }
#pragma unroll
        for (int i = 0; i < 16; ++i) ss += v[i] * v[i];
        const float rstd = 1.f / sqrtf(wave_sum(ss) * (1.f / D) + EPS);
#pragma unroll
        for (int jj = 0; jj < 2; ++jj) { const int c = 512 * jj + 8 * F.lane; const f32x4 g0 = *(const f32x4*)(F.g_fin + c), g1 = *(const f32x4*)(F.g_fin + c + 4); const float* vv = v + 8 * jj;
            f32x4 o0, o1; o0.x = vv[0] * rstd * g0.x; o0.y = vv[1] * rstd * g0.y; o0.z = vv[2] * rstd * g0.z; o0.w = vv[3] * rstd * g0.w;
            o1.x = vv[4] * rstd * g1.x; o1.y = vv[5] * rstd * g1.y; o1.z = vv[6] * rstd * g1.z; o1.w = vv[7] * rstd * g1.w;
            *(f32x4*)(F.out + (size_t)t * D + c) = o0; *(f32x4*)(F.out + (size_t)t * D + c + 4) = o1; }
    }
}
struct Args { const float* in[17]; float* out; unsigned char* ws; int ph_lo, ph_hi, use_bar, pad; };
__global__ void __launch_bounds__(NWAVES * 64, 2) mk_fwd(Args args) {
    extern __shared__ __attribute__((aligned(16))) unsigned char lds[];
    Frame F;
    F.lds = (LAS unsigned char*)lds;
    F.MISC = (volatile LAS unsigned*)(F.lds + MISC_OFF);
    F.tid = threadIdx.x; F.lane = F.tid & 63; F.wave = __builtin_amdgcn_readfirstlane(F.tid >> 6);
    F.G = gridDim.x; { const int bx = blockIdx.x; F.vcu = (F.G % 8 == 0) ? (bx % 8) * (F.G / 8) + bx / 8 : bx; }
    F.ws = args.ws; F.out = args.out; F.ctl = (gu32*)(args.ws + WS_CTL);
    F.x = args.in[0]; F.mem = args.in[1]; F.g_attn = args.in[2]; F.g_mem = args.in[3]; F.w_in = args.in[4]; F.lamqk = args.in[5]; F.subg = args.in[6]; F.w_mkv = args.in[7];
    F.w_out = args.in[8]; F.g_ffn = args.in[9]; F.w_r = args.in[10]; F.b_r = args.in[11]; F.w_gu = args.in[12]; F.b_gu = args.in[13]; F.w_dn = args.in[14]; F.b_dn = args.in[15]; F.g_fin = args.in[16];
    for (int u = F.tid; u < (LDS_BYTES - LDSCTL_OFF) / 4; u += NWAVES * 64) ((LAS unsigned*)(F.lds + LDSCTL_OFF))[u] = 0u;
    __syncthreads();
    XcdBarrier bar; bar.bar = (unsigned*)(F.ctl + CW_BAR); bar.x = 0; bar.st = nullptr;
    if (args.use_bar) bar = xcd_barrier_post((unsigned*)(F.ctl + CW_BAR), F.MISC + 8);
    const int lo = args.ph_lo, hi = args.ph_hi;
#define IN(k) (lo <= (k) && (k) < hi)
#define SEAM(k) do { if (IN(k) && IN((k) + 1)) xcd_barrier(bar); } while (0)
    if (IN(0)) { p0_prologue(F); } SEAM(0);
    if (IN(1)) {
        pg8::Gemm g{(const void*)(F.ws + WS_XB), (const void*)(F.ws + WS_WIN), 2 * D}; pg8::StaticOrder S; S.init(T, DIN, 2 * D, F.G, (int)blockIdx.x);
        EpiInProj E{(bf16*)(F.ws + WS_P), (const float*)(F.ws + WS_RSTD1)};
        pg8::gemm_phase<EpiInProj, pg8::StaticOrder, true, false, false>(F.lds + RING_OFF, (LAS unsigned*)(F.lds + IDB_OFF), g, S, E);
    } SEAM(1);
    if (IN(2)) { attn_phase(F, (char*)lds + RING_OFF); } SEAM(2);
    if (IN(3)) { dil_combine_phase(F); } SEAM(3);
    if (IN(4)) {
        pg8::Gemm g{(const void*)(F.ws + WS_MIX), (const void*)(F.ws + WS_WOUT), 2 * D}; pg8::StaticOrder S; S.init(T, D, 2 * D, F.G, (int)blockIdx.x);
        EpiY E{(bf16*)(F.ws + WS_Y)};
        pg8::gemm_phase<EpiY, pg8::StaticOrder, true, false, false>(F.lds + RING_OFF, (LAS unsigned*)(F.lds + IDB_OFF), g, S, E);
    } SEAM(4);
    if (IN(5)) { route_phase(F); } SEAM(5);
    if (IN(6)) {
        const int nmt = moe_build_table(F);
        pg8::Gemm g{(const void*)(F.ws + WS_X1B), (const void*)(F.ws + WS_WGU), D};
        MoeOrder S{(const LAS unsigned*)(F.lds + TBL_OFF), (const LAS unsigned*)(F.lds + LCNT_OFF), (const unsigned*)(F.ws + WS_LIST), nmt, F.G, F.vcu, 8, 4, D, (size_t)2 * DFF * D, false};
        EpiGU E{(unsigned char*)(F.ws + WS_ACT), (const float*)(F.ws + WS_RSTD2), F.b_gu};
        pg8::gemm_phase<EpiGU, MoeOrder, true, true, true, true>(F.lds + RING_OFF, (LAS unsigned*)(F.lds + IDB_OFF), g, S, E);
    } SEAM(6);
    if (IN(7)) {
        const int nmt = moe_build_table(F);
        pg8::Gemm g{(const void*)(F.ws + WS_ACT), (const void*)(F.ws + WS_WDN), DFF};
        MoeOrder S{(const LAS unsigned*)(F.lds + TBL_OFF), (const LAS unsigned*)(F.lds + LCNT_OFF), (const unsigned*)(F.ws + WS_LIST), nmt, F.G, F.vcu, 4, 8, DFF, (size_t)D * DFF, true};
        EpiDown E{(bf16*)(F.ws + WS_YB), (const float*)(F.ws + WS_RGATE), F.b_dn};
        pg8::gemm_phase<EpiDown, MoeOrder, true, true, true, true, true>(F.lds + RING_OFF, (LAS unsigned*)(F.lds + IDB_OFF), g, S, E);
    } SEAM(7);
    if (IN(8)) { final_phase(F); }
#undef IN
#undef SEAM
}

static void launch_phases(const Args& base, int lo, int hi, int use_bar, int grid, hipStream_t stream) {
    Args a = base; a.ph_lo = lo; a.ph_hi = hi; a.use_bar = use_bar;
    hipLaunchKernelGGL(mk_fwd, dim3(grid), dim3(NWAVES * 64), LDS_BYTES, stream, a);
}
extern "C" void kernel_launch(void* const* d_in, const int* in_sizes, int n_in, void* d_out, int out_size, void* d_ws, size_t ws_size, hipStream_t stream) {
    static int grid = 0;
    if (grid == 0) {
        if (n_in != 17 || in_sizes[0] != T * D || out_size != T * D || ws_size < (size_t)1000 * MiB) { fprintf(stderr, "kernel_launch: unexpected shapes / workspace (%d inputs, ws %zu)\n", n_in, ws_size); grid = -1; return; }
        int dev = 0, cus = 0, per_cu = 0;
        if (hipGetDevice(&dev) != hipSuccess || hipDeviceGetAttribute(&cus, hipDeviceAttributeMultiprocessorCount, dev) != hipSuccess) { grid = -1; return; }
        if (hipFuncSetAttribute((const void*)mk_fwd, hipFuncAttributeMaxDynamicSharedMemorySize, LDS_BYTES) != hipSuccess) { fprintf(stderr, "kernel_launch: hipFuncSetAttribute failed\n"); grid = -1; return; }
        if (hipOccupancyMaxActiveBlocksPerMultiprocessor(&per_cu, (const void*)mk_fwd, NWAVES * 64, LDS_BYTES) != hipSuccess || per_cu < 1) { fprintf(stderr, "kernel_launch: occupancy query says %d blocks per CU\n", per_cu); per_cu = 1; }
        (void)hipGetLastError();
        grid = cus;
        if (grid != 256) { fprintf(stderr, "kernel_launch: built for a 256-CU device (got %d)\n", cus); grid = -1; return; }
    }
    if (grid < 0) return;
    (void)hipMemsetAsync((char*)d_ws + WS_CTL, 0, CTL_ZERO_BYTES, stream);
    Args a{};
    for (int i = 0; i < 17; ++i) a.in[i] = (const float*)d_in[i];
    a.out = (float*)d_out; a.ws = (unsigned char*)d_ws;
    launch_phases(a, 0, 9, 1, grid, stream);
}
```

```cpp
#include <hip/hip_runtime.h>
#include <hip/hip_bf16.h>
#include <cstdint>
#include <cstdio>
#include <cmath>

constexpr int D = 1024, BATCH = 8, SEQ = 4096, T = BATCH * SEQ, DIN = 2560, NMEM = 256, NE = 32, DFF = 1024;
constexpr int C_DQ = 0, C_DK = 512, C_DV = 1024, C_LQ = 1536, C_LK = 1792, C_LV = 2048, C_MQ = 2304;
constexpr float EPS = 1e-5f;
constexpr int LCAP = T;
constexpr float QSCALE = 0.125f * 1.4426950408889634f;
constexpr float LOG2E = 1.4426950408889634f;
namespace pg8 {
#define PG8_LAS __attribute__((address_space(3)))
typedef unsigned short bf16_t;
typedef short bf16x8 __attribute__((ext_vector_type(8)));
typedef float f32x4 __attribute__((ext_vector_type(4)));
typedef unsigned u32x4 __attribute__((ext_vector_type(4)));
typedef unsigned u32x2 __attribute__((ext_vector_type(2)));
constexpr int BM = 256, BK = 64, HALF = 128, HTB = HALF * BK * 2  , STAGE_BYTES = 8 * HTB, NXCD = 8, WGM = 8;

__host__ __device__ __forceinline__ int lds_byte(int r, int c) { const int st = (r >> 4) * 2 + (c >> 5), rr = r & 15, cc = c & 31, ob = rr * 64 + cc * 2; return st * 1024 + (ob ^ (((ob >> 9) & 1) << 5)); }
__host__ __device__ __forceinline__ void stage_rc(int b, int& R, int& C) { const int st = b / 1024, sb = b % 1024, swz = sb ^ (((sb >> 9) & 1) << 5); R = (st >> 1) * 16 + swz / 64; C = (st & 1) * 32 + (swz % 64) / 2; }
__host__ __device__ __forceinline__ int perm32(int rho) { const int n = rho >> 4, i = rho & 15; return 8 * (i >> 2) + 4 * n + (i & 3); }

struct Unit { size_t aoff, boff; int pm, pn, e, valid, mt; };
struct Gemm { const void* A; const void* Bt; int RB; };
typedef int v8i __attribute__((ext_vector_type(8)));

struct StaticOrder {
    int nM, nN, nwg, G, c, RB;
    __device__ void init(int M, int N, int RB_, int G_, int c_) { nM = M / BM; nN = N / BM; nwg = nM * nN; G = G_; c = c_; RB = RB_; }
    __device__ bool next(int i, Unit& u) const {
        const long L = (long)i * G + c; if (L >= nwg) return false;
        int wgid = (int)L; { const int q = nwg / NXCD, r = nwg % NXCD, xcd = wgid % NXCD, off = wgid / NXCD; wgid = (xcd < r ? xcd * (q + 1) : r * (q + 1) + (xcd - r) * q) + off; }
        const int nig = WGM * nN, gid = wgid / nig, fm = gid * WGM, gsz = (nM - fm) < WGM ? (nM - fm) : WGM;
        u.pm = fm + ((wgid % nig) % gsz); u.pn = (wgid % nig) / gsz; u.e = 0; u.valid = 256; u.mt = 0;
        u.aoff = (size_t)u.pm * (size_t)(BM * RB); u.boff = (size_t)u.pn * (size_t)(BM * RB); return true;
    }
    __device__ __forceinline__ const unsigned* id_src(const Unit&, int) const { return nullptr; }
};

__device__ __forceinline__ unsigned cvt_pk_bf16(float lo, float hi) { unsigned r; asm volatile("v_cvt_pk_bf16_f32 %0, %1, %2" : "=v"(r) : "v"(lo), "v"(hi)); return r; }

template <class Epi, class Sched, bool ALIGN_EPI, bool GATHER, bool IDS, bool FP8 = false, bool LINEAR = false>
__device__ __forceinline__ void gemm_phase(PG8_LAS unsigned char* lds, PG8_LAS unsigned* idb, const Gemm g, const Sched& S, const Epi& E) {
    const int tid = threadIdx.x, wid = __builtin_amdgcn_readfirstlane(tid >> 6), lane = tid & 63, wr = wid >> 2, wc = wid & 3, fr = lane & 15, fq = lane >> 4;
    const int RB = g.RB; int nt = RB / (BK * 2); asm volatile("" : "+s"(nt));
    unsigned voffA[2], voffB[2]; int RA[2], CA[2];
#pragma unroll
    for (int i = 0; i < 2; ++i) { int R, C; stage_rc(tid * 16 + i * 8192, R, C); const int Rb = (R & ~31) + perm32(R & 31); RA[i] = R; CA[i] = C;
        voffA[i] = (unsigned)(R * RB + C * 2); voffB[i] = (unsigned)(Rb * RB + C * 2); }
    const size_t kstep = (size_t)(BK * 2);
    const size_t hstep = (size_t)HALF * RB;
    const unsigned ldsw = (unsigned)wid * 1024u;
    const int aoff = lds_byte(wr * 64 + fr, fq * 8), boff = lds_byte(wc * 32 + fr, fq * 8);
    const int aoff8a = lds_byte(wr * 64 + fr, 16 * fq), boff8a = lds_byte(wc * 32 + fr, 16 * fq);
#define PG8_SA(b, h) (((b) * 2 + (h)) * HTB)
#define PG8_SB(b, h) ((4 + (b) * 2 + (h)) * HTB)
#define PG8_STAGE(bufoff, gbase, voff) do { _Pragma("unroll") for (int _i = 0; _i < 2; ++_i) \
        __builtin_amdgcn_global_load_lds((const unsigned*)((const char*)(gbase) + (voff)[_i]), (PG8_LAS unsigned*)(lds + (bufoff) + ldsw + _i * 8192), 16, 0, 0); } while (0)
#define PG8_STAGE_A(bufoff, pbase, gbase, h, gv) do { if constexpr (GATHER) { PG8_STAGE(bufoff, gbase, gv[h]); } else { PG8_STAGE(bufoff, (pbase) + (h) * hstep, voffA); } } while (0)
#define PG8_LD32(p0_, p1_) __builtin_bit_cast(v8i, __builtin_shufflevector(*(const PG8_LAS u32x4*)(p0_), *(const PG8_LAS u32x4*)(p1_), 0, 1, 2, 3, 4, 5, 6, 7))
#define PG8_LDA(dst, b, h) do { if constexpr (FP8) { _Pragma("unroll") for (int m = 0; m < 4; ++m) dst##8[m] = PG8_LD32(lds + PG8_SA(b, h) + aoff8a + m * 2048, lds + PG8_SA(b, h) + aoff8a + m * 2048 + 16); } \
        else { _Pragma("unroll") for (int m = 0; m < 4; ++m) _Pragma("unroll") for (int k = 0; k < 2; ++k) dst[m][k] = *(const PG8_LAS bf16x8*)(lds + PG8_SA(b, h) + aoff + m * 2048 + k * 1024); } } while (0)
#define PG8_LDB(dst, b, h) do { if constexpr (FP8) { _Pragma("unroll") for (int n = 0; n < 2; ++n) dst##8[n] = PG8_LD32(lds + PG8_SB(b, h) + boff8a + n * 2048, lds + PG8_SB(b, h) + boff8a + n * 2048 + 16); } \
        else { _Pragma("unroll") for (int n = 0; n < 2; ++n) _Pragma("unroll") for (int k = 0; k < 2; ++k) dst[n][k] = *(const PG8_LAS bf16x8*)(lds + PG8_SB(b, h) + boff + n * 2048 + k * 1024); } } while (0)
#define PG8_MMA(ai, bj, At, Bt) do { __builtin_amdgcn_s_setprio(1); if constexpr (FP8) { _Pragma("unroll") for (int m = 0; m < 4; ++m) _Pragma("unroll") for (int n = 0; n < 2; ++n) \
        acc[ai][bj][m][n] = __builtin_amdgcn_mfma_scale_f32_16x16x128_f8f6f4(Bt##8[n], At##8[m], acc[ai][bj][m][n], 0, 0, 0, 0x7f7f7f7f, 0, 0x7f7f7f7f); } \
        else { _Pragma("unroll") for (int m = 0; m < 4; ++m) _Pragma("unroll") for (int n = 0; n < 2; ++n) _Pragma("unroll") for (int k = 0; k < 2; ++k) \
        acc[ai][bj][m][n] = __builtin_amdgcn_mfma_f32_16x16x32_bf16(Bt[n][k], At[m][k], acc[ai][bj][m][n], 0, 0, 0); } __builtin_amdgcn_s_setprio(0); } while (0)
#define PG8_WAIT_V(n) asm volatile("s_waitcnt vmcnt(" #n ")" ::: "memory")
#define PG8_WAIT_L(n) asm volatile("s_waitcnt lgkmcnt(" #n ")" ::: "memory")
#define PG8_BAR __builtin_amdgcn_s_barrier()
#define PG8_SCHED __builtin_amdgcn_sched_barrier(0)
#define PG8_IDS_DMA(u, s) do { if (wid < 4) __builtin_amdgcn_global_load_lds(S.id_src(u, tid), (PG8_LAS unsigned*)(idb + (s) * 256 + wid * 64), 4, 0, 0); } while (0)
#define PG8_GV(dst, s, un) do { _Pragma("unroll") for (int _h = 0; _h < 2; ++_h) _Pragma("unroll") for (int _i = 0; _i < 2; ++_i) \
        dst[_h][_i] = (LINEAR ? (unsigned)((un).pm * 256 + _h * 128 + RA[_i]) : (idb[(s) * 256 + _h * 128 + RA[_i]] >> 2)) * (unsigned)RB + (unsigned)(CA[_i] * 2); } while (0)
    Unit cur, nxt; int ui = 0, us = 0;
    if (!S.next(0, cur)) return;
    f32x4 acc[2][2][4][2];
#pragma unroll
    for (int a = 0; a < 2; ++a)
#pragma unroll
        for (int b = 0; b < 2; ++b)
#pragma unroll
            for (int m = 0; m < 4; ++m)
#pragma unroll
                for (int n = 0; n < 2; ++n) acc[a][b][m][n] = (f32x4){0.f, 0.f, 0.f, 0.f};
    bf16x8 At[4][2], B0[2][2], B1[2][2]; v8i At8[4], B08[2], B18[2];
    unsigned cv[2][2] = {{0u, 0u}, {0u, 0u}};
    const char* A0 = (const char*)g.A;
    const char* cA = A0 + (GATHER ? (size_t)0 : cur.aoff); const char* cB = (const char*)g.Bt + cur.boff;
    if constexpr (IDS) {
        PG8_IDS_DMA(cur, 0); PG8_WAIT_V(0); PG8_BAR;
    }
    if constexpr (GATHER) { PG8_GV(cv, 0, cur); }
    PG8_STAGE(PG8_SB(0, 0), cB, voffB); PG8_STAGE(PG8_SB(0, 1), cB + hstep, voffB); PG8_STAGE_A(PG8_SA(0, 0), cA, A0, 0, cv); PG8_STAGE_A(PG8_SA(0, 1), cA, A0, 1, cv);
    if (wr == 1) PG8_BAR;
    PG8_WAIT_V(2); PG8_BAR;
    PG8_STAGE(PG8_SB(1, 0), cB + kstep, voffB); PG8_STAGE_A(PG8_SA(1, 0), cA + kstep, A0 + kstep, 0, cv); PG8_STAGE(PG8_SB(1, 1), cB + hstep + kstep, voffB);
    PG8_WAIT_V(6); PG8_BAR;
    for (;;) {
        const bool has_next = S.next(ui + 1, nxt);
        const int ns = (us == 2) ? 0 : us + 1;
        if constexpr (IDS) { if (has_next) PG8_IDS_DMA(nxt, ns); }
        const char* nA = has_next ? A0 + (GATHER ? (size_t)0 : nxt.aoff) : cA; const char* nB = has_next ? (const char*)g.Bt + nxt.boff : cB;
#pragma nounroll
        for (int t = 0; t < nt; t += 2) {
            int lastv = (t == nt - 2) ? 1 : 0; asm volatile("" : "+v"(lastv)); const bool last = __builtin_amdgcn_readfirstlane(lastv) != 0;
            const char* a1 = cA + (size_t)(t + 1) * kstep;
            const char* a2 = last ? nA : cA + (size_t)(t + 2) * kstep; const char* b2 = last ? nB : cB + (size_t)(t + 2) * kstep;
            const char* a3 = a2 + kstep; const char* b3 = b2 + kstep;
            PG8_LDB(B0, 0, 0); PG8_LDB(B1, 0, 1); PG8_SCHED; PG8_LDA(At, 0, 0); PG8_STAGE_A(PG8_SA(1, 1), a1, a1, 1, cv);
            if constexpr (GATHER) { if (last && has_next) { PG8_GV(cv, ns, nxt); } }
            PG8_WAIT_V(8); PG8_WAIT_L(0); PG8_BAR; PG8_MMA(0, 0, At, B0); PG8_MMA(0, 1, At, B1); PG8_BAR; PG8_SCHED;
            PG8_LDA(At, 0, 1); PG8_STAGE(PG8_SB(0, 0), b2, voffB); PG8_STAGE(PG8_SB(0, 1), b2 + hstep, voffB); PG8_STAGE_A(PG8_SA(0, 0), a2, a2, 0, cv);
            PG8_WAIT_V(8); PG8_WAIT_L(0); PG8_BAR; PG8_MMA(1, 0, At, B0); PG8_MMA(1, 1, At, B1); PG8_BAR; PG8_SCHED;
            PG8_LDB(B0, 1, 0); PG8_LDB(B1, 1, 1); PG8_SCHED; PG8_LDA(At, 1, 0); PG8_STAGE_A(PG8_SA(0, 1), a2, a2, 1, cv);
            PG8_WAIT_V(8); PG8_WAIT_L(0); PG8_BAR; PG8_MMA(0, 0, At, B0); PG8_MMA(0, 1, At, B1); PG8_BAR; PG8_SCHED;
            PG8_LDA(At, 1, 1); PG8_STAGE(PG8_SB(1, 0), b3, voffB); PG8_STAGE(PG8_SB(1, 1), b3 + hstep, voffB); PG8_STAGE_A(PG8_SA(1, 0), a3, a3, 0, cv);
            PG8_WAIT_V(8); PG8_WAIT_L(0); PG8_BAR; PG8_MMA(1, 0, At, B0); PG8_MMA(1, 1, At, B1); PG8_BAR; PG8_SCHED;
        }
        if constexpr (ALIGN_EPI) { if (wr == 0) PG8_BAR; }
        PG8_SCHED;
        E(acc, cur, wr, wc, fr, fq, (const PG8_LAS unsigned*)(idb + us * 256));
        PG8_SCHED;
        if (!has_next) break;
#pragma unroll
        for (int a = 0; a < 2; ++a)
#pragma unroll
            for (int b = 0; b < 2; ++b)
#pragma unroll
                for (int m = 0; m < 4; ++m)
#pragma unroll
                    for (int n = 0; n < 2; ++n) acc[a][b][m][n] = (f32x4){0.f, 0.f, 0.f, 0.f};
        cur = nxt; cA = nA; cB = nB; ++ui; us = ns;
        if constexpr (ALIGN_EPI) { if (wr == 1) PG8_BAR; }
    }
    PG8_WAIT_V(0);
    if constexpr (!ALIGN_EPI) { if (wr == 0) PG8_BAR; }
    PG8_BAR;
#undef PG8_SA
#undef PG8_SB
#undef PG8_STAGE
#undef PG8_STAGE_A
#undef PG8_LDA
#undef PG8_LDB
#undef PG8_MMA
#undef PG8_LD32
#undef PG8_WAIT_V
#undef PG8_WAIT_L
#undef PG8_BAR
#undef PG8_SCHED
#undef PG8_IDS_DMA
#undef PG8_GV
}
}
namespace attn_body {
using bf16=__hip_bfloat16;
using bf16x8=__attribute__((ext_vector_type(8)))short;
using s16x4=__attribute__((ext_vector_type(4)))short;
using f32x16=__attribute__((ext_vector_type(16)))float;
using u32x4=__attribute__((ext_vector_type(4)))unsigned;
constexpr int D=64;
constexpr int NW=8,QBLK=32,QB=QBLK*NW,KVBLK=64;
struct UnitP { const bf16* Q; const bf16* K; const bf16* V; bf16* O; long qp, kp, op; int q0, t0, NT; float slope2; float* lse; int lse_stride; };
__device__ __forceinline__ int crow(int r,int hi){return (r&3)+8*(r>>2)+4*hi;}
#define SBAR() __builtin_amdgcn_sched_barrier(0)
template<bool CAUSAL,bool WINDOW> __device__ __forceinline__ void cmask(f32x16&p0,f32x16&p1,int jb,int qrel,int hi){
  const float NEG=-INFINITY; int kb=64*jb+4*hi;
  #pragma unroll
  for(int r=0;r<16;++r){int kv=kb+(r&3)+8*(r>>2);
    if(CAUSAL){ if(kv>qrel)p0[r]=NEG; if(kv+32>qrel)p1[r]=NEG; }
    if(WINDOW){ if(kv<qrel-128)p0[r]=NEG; if(kv+32<qrel-128)p1[r]=NEG; } }
}
__device__ __forceinline__ unsigned bfr(float x){ typedef float f2_ __attribute__((ext_vector_type(2))); typedef __bf16 b2_ __attribute__((ext_vector_type(2))); f2_ v={x,0.f}; b2_ b=__builtin_convertvector(v,b2_); return __builtin_bit_cast(unsigned,b)&0xffffu; }
__device__ __forceinline__ float bfv(unsigned b){ return __builtin_bit_cast(float,b<<16); }

constexpr int NSLOT=3, SLOTB=8192;
constexpr int LDS_K=0, LDS_V=NSLOT*SLOTB, LDS_WS=2*NSLOT*SLOTB, LDS_OST=LDS_WS+NW*64*4, LDS_BYTES=LDS_OST+NW*4096;
__device__ __forceinline__ void glds16(const void*gsrc,unsigned lds_dst){unsigned keep;
  asm volatile("s_mov_b32 %0, m0\n\ts_mov_b32 m0, %2\n\ts_nop 0\n\tglobal_load_lds_dwordx4 %1, off\n\ts_mov_b32 m0, %0":"=&s"(keep):"v"(gsrc),"s"(lds_dst):"memory");}
__device__ __forceinline__ float max3f(float a,float b,float c){float r;asm("v_max3_f32 %0, %1, %2, %3":"=v"(r):"v"(a),"v"(b),"v"(c));return r;}
__device__ __forceinline__ float max2f(float a,float b){float r;asm("v_max_f32_e32 %0, %1, %2":"=v"(r):"v"(a),"v"(b));return r;}
__device__ __forceinline__ float fadd_s(float a,float b){float r;asm("v_add_f32_e32 %0, %1, %2":"=v"(r):"v"(a),"v"(b));return r;}
__device__ __forceinline__ float fsub_s(float a,float b){float r;asm("v_sub_f32_e32 %0, %1, %2":"=v"(r):"v"(a),"v"(b));return r;}
typedef float f32x2_t __attribute__((ext_vector_type(2))); typedef __bf16 bf16x2_t __attribute__((ext_vector_type(2)));
__device__ __forceinline__ unsigned cvtpk_s(float lo,float hi){f32x2_t v={lo,hi};bf16x2_t b=__builtin_convertvector(v,bf16x2_t);return __builtin_bit_cast(unsigned,b);}
#define WAIT_BAR(N) asm volatile("s_waitcnt vmcnt(" #N ") lgkmcnt(0)\n\ts_barrier":::"memory")

__device__ __forceinline__ void qkt(f32x16&p0,f32x16&p1,const char*Kslot,const bf16x8*qr,bf16x8 kx0,bf16x8 kx1,bf16x8 qx,int r32,int hi){
  const char*kb=Kslot+hi*1024+r32*16;
  #pragma unroll
  for(int d0=0;d0<4;++d0){
    const bf16x8 b0=*reinterpret_cast<const bf16x8*>(kb+d0*2048);
    const bf16x8 b1=*reinterpret_cast<const bf16x8*>(kb+d0*2048+512);
    if(d0==0){p0=__builtin_amdgcn_mfma_f32_32x32x16_bf16(b0,qr[0],f32x16{},0,0,0);p1=__builtin_amdgcn_mfma_f32_32x32x16_bf16(b1,qr[0],f32x16{},0,0,0);}
    else{p0=__builtin_amdgcn_mfma_f32_32x32x16_bf16(b0,qr[d0],p0,0,0,0);p1=__builtin_amdgcn_mfma_f32_32x32x16_bf16(b1,qr[d0],p1,0,0,0);}}
  p0=__builtin_amdgcn_mfma_f32_32x32x16_bf16(kx0,qx,p0,0,0,0);p1=__builtin_amdgcn_mfma_f32_32x32x16_bf16(kx1,qx,p1,0,0,0);
}
typedef __attribute__((address_space(3))) const char* lds_cptr;
typedef short v4i16_t __attribute__((ext_vector_type(4)));
__device__ __forceinline__ void kload8(bf16x8*kf,lds_cptr kp){
  kf[0]=*(const __attribute__((address_space(3))) bf16x8*)(kp);      kf[1]=*(const __attribute__((address_space(3))) bf16x8*)(kp+512);
  kf[2]=*(const __attribute__((address_space(3))) bf16x8*)(kp+2048); kf[3]=*(const __attribute__((address_space(3))) bf16x8*)(kp+2560);
  kf[4]=*(const __attribute__((address_space(3))) bf16x8*)(kp+4096); kf[5]=*(const __attribute__((address_space(3))) bf16x8*)(kp+4608);
  kf[6]=*(const __attribute__((address_space(3))) bf16x8*)(kp+6144); kf[7]=*(const __attribute__((address_space(3))) bf16x8*)(kp+6656);
}
__device__ __forceinline__ void kload2(bf16x8*kf,lds_cptr kp,int j){ kf[2*j]=*(const __attribute__((address_space(3))) bf16x8*)(kp+j*2048); kf[2*j+1]=*(const __attribute__((address_space(3))) bf16x8*)(kp+j*2048+512); }
__device__ __forceinline__ s16x4 vtr(lds_cptr p){ return __builtin_bit_cast(s16x4,__builtin_amdgcn_ds_read_tr16_b64_v4i16((__attribute__((address_space(3))) v4i16_t*)p)); }
__device__ __forceinline__ float rowmax(const f32x16&p0,const f32x16&p1){
  float a=max3f(p0[0],p0[1],p1[0]),b=max3f(p0[2],p0[3],p1[1]);a=max3f(a,p1[2],p1[3]);
  #pragma unroll
  for(int r=4;r<16;r+=4){a=max3f(a,p0[r],p0[r+1]);b=max3f(b,p0[r+2],p0[r+3]);a=max3f(a,p1[r],p1[r+1]);b=max3f(b,p1[r+2],p1[r+3]);}
  const float m=max2f(a,b);
  auto rr=__builtin_amdgcn_permlane32_swap(__float_as_uint(m),__float_as_uint(m),false,false);
  return max2f(__uint_as_float(rr[0]),__uint_as_float(rr[1]));
}
__device__ __forceinline__ void pv(f32x16*o,int vb,bf16x8 pa0,bf16x8 pa1,bf16x8 pa2,bf16x8 pa3){
  #pragma unroll
  for(int d0=0;d0<2;++d0){s16x4 lo[4],hi[4];
    #pragma unroll
    for(int ks=0;ks<4;++ks){
      asm volatile("ds_read_b64_tr_b16 %0,%1 offset:%c2":"=&v"(lo[ks]):"v"(vb),"i"(d0*4096+ks*1024):"memory");
      asm volatile("ds_read_b64_tr_b16 %0,%1 offset:%c2":"=&v"(hi[ks]):"v"(vb),"i"(d0*4096+ks*1024+512):"memory");}
    asm volatile("s_waitcnt lgkmcnt(0)":::"memory");SBAR();
    #define PK(k) (bf16x8){lo[k][0],lo[k][1],lo[k][2],lo[k][3],hi[k][0],hi[k][1],hi[k][2],hi[k][3]}
    o[d0]=__builtin_amdgcn_mfma_f32_32x32x16_bf16(pa0,PK(0),o[d0],0,0,0);
    o[d0]=__builtin_amdgcn_mfma_f32_32x32x16_bf16(pa1,PK(1),o[d0],0,0,0);
    o[d0]=__builtin_amdgcn_mfma_f32_32x32x16_bf16(pa2,PK(2),o[d0],0,0,0);
    o[d0]=__builtin_amdgcn_mfma_f32_32x32x16_bf16(pa3,PK(3),o[d0],0,0,0);
    #undef PK
  }
}

#ifndef ATTN_STORE16
#define ATTN_STORE16(p,v) (*(u32x4*)(p)=(v))
#endif
template<int THRL,bool CAUSAL,bool WINDOW,bool ALIBI,bool LSE> __device__ __forceinline__ void attn_unit(const UnitP&U,char*shm){
  int tid=threadIdx.x; asm volatile("":"+v"(tid));
  const int lane=tid&63,r32=lane&31,hi=lane>>5; const int wid=__builtin_amdgcn_readfirstlane(tid>>6);
  const int q0=U.q0; const long qp=U.qp,kp=U.kp,op=U.op; const float slope2=U.slope2;
  const bf16*Qw=U.Q+(long)(q0+wid*QBLK)*qp;
  const bf16*Kh=U.K+(long)U.t0*KVBLK*kp,*Vh=U.V+(long)U.t0*KVBLK*kp;
  const unsigned lds0=(unsigned)(uintptr_t)shm;
  float*wsf=(float*)(shm+LDS_WS)+wid*64;
  const bf16*ksrc=Kh+(long)lane*kp+wid*8;
  const bf16*vsrc=Vh+(long)(16*(wid&3)+(lane>>2))*kp+(wid>>2)*32+(lane&3)*8;
  const unsigned kdst=lds0+LDS_K+wid*1024, vdst=lds0+LDS_V+wid*1024;
  #define DMA_K(t,slot) glds16(ksrc+(long)(t)*KVBLK*kp,(unsigned)__builtin_amdgcn_readfirstlane(kdst+(slot)))
  #define DMA_V(t,slot) glds16(vsrc+(long)(t)*KVBLK*kp,(unsigned)__builtin_amdgcn_readfirstlane(vdst+(slot)))
  const int vb0=(int)(lds0+LDS_V)+((lane>>4)&1)*32+(lane&3)*8+(4*hi+((lane&15)>>2))*64;
  const char*Kbase=shm+LDS_K; bf16x8 kf[8];
  const lds_cptr shm3=(lds_cptr)shm; const lds_cptr kp0=shm3+LDS_K+hi*1024+r32*16; const lds_cptr vp0=shm3+LDS_V+((lane>>4)&1)*32+(lane&3)*8+(4*hi+((lane&15)>>2))*64;
  const int NT=U.NT;
  DMA_K(0,0);DMA_V(0,0);DMA_K(1,SLOTB);
  bf16x8 qr[4];
  #pragma unroll
  for(int d0=0;d0<4;++d0)qr[d0]=*reinterpret_cast<const bf16x8*>(&Qw[(long)r32*qp+d0*16+hi*8]);
  float mhat=0.f,l_reg=0.f;f32x16 o[2];o[0]=f32x16{};o[1]=f32x16{};
  const int qrel=wid*QBLK+r32;
  #define CMASK(P0,P1,t) do{int jb_=(t)-(NT-4); if(WINDOW||(CAUSAL&&jb_>=0))cmask<CAUSAL,WINDOW>(P0,P1,jb_,qrel,hi);}while(0)
  bf16x8 kx0,kx1,qx;
  { const float k0_=ALIBI?slope2*(float)r32:0.f, k1_=ALIBI?slope2*(float)(r32+32):0.f; const unsigned h0=bfr(k0_),l0=bfr(k0_-bfv(h0)),h1=bfr(k1_),l1=bfr(k1_-bfv(h1));
    u32x4 a={0x3f803f80u,0x3f80u|(h0<<16),l0,0u}, b={0x3f803f80u,0x3f80u|(h1<<16),l1,0u}; if(hi){a=u32x4{0u,0u,0u,0u};b=a;} kx0=__builtin_bit_cast(bf16x8,a); kx1=__builtin_bit_cast(bf16x8,b); }
  #define QX_SET(t) do{ const float nb_=ALIBI?__builtin_fmaf(slope2,(float)(64*((t)-(NT-4))-qrel),-mhat):-mhat; const unsigned a_=bfr(nb_); const float r1_=nb_-bfv(a_); const unsigned b_=bfr(r1_); const unsigned c_=bfr(r1_-bfv(b_)); \
    u32x4 q_={a_|(b_<<16),c_|0x3f800000u,0x3f80u,0u}; if(hi)q_=u32x4{0u,0u,0u,0u}; qx=__builtin_bit_cast(bf16x8,q_); asm volatile("":"+v"(qx)); }while(0)
  bool resc=false;
  #define START(P0,P1) do{ const float rm=rowmax(P0,P1); resc=false; \
    { const float dl=(rm==-INFINITY)?0.f:rm; mhat=fadd_s(mhat,dl); \
      _Pragma("unroll") for(int r=0;r<16;++r){P0[r]=fsub_s(P0[r],dl);P1[r]=fsub_s(P1[r],dl);} } \
    _Pragma("unroll") for(int r=0;r<16;++r)P0[r]=__builtin_amdgcn_exp2f(P0[r]); }while(0)
  #define RESC() do{ if(resc){ asm volatile("s_waitcnt lgkmcnt(0)":::"memory"); \
      _Pragma("unroll") for(int d_=0;d_<2;++d_) _Pragma("unroll") for(int r=0;r<16;++r)o[d_][r]*=wsf[crow(r,hi)]; } }while(0)
  f32x16 pA0,pA1,pB0,pB1;
  int sl_prev=0,sl_cur=0,sl_next=SLOTB;
  #define ROT() do{sl_prev=sl_cur;sl_cur=sl_next;sl_next=(sl_next==(NSLOT-1)*SLOTB)?0:sl_next+SLOTB;}while(0)
  DMA_K(2,2*SLOTB);
  WAIT_BAR(3);
  QX_SET(0);
  qkt(pA0,pA1,Kbase,qr,kx0,kx1,qx,r32,hi);asm volatile("s_nop 15\n\ts_nop 7":"+v"(pA0),"+v"(pA1));CMASK(pA0,pA1,0);
  START(pA0,pA1);
  _Pragma("unroll") for(int r=0;r<16;++r)pA1[r]=__builtin_amdgcn_exp2f(pA1[r]);
  WAIT_BAR(0);
  DMA_K(3,0);DMA_V(1,SLOTB);
  ROT();
  kload8(kf,kp0+sl_cur);
  WAIT_BAR(2);
  s16x4 vlo[8],vhi[8]; u32x4 pw0,pw1,pw2,pw3;
  #define PKW(P,B) cvtpk_s(P[B],P[B+1])
  #define PAF(k) __builtin_bit_cast(bf16x8,pw##k)
  #define VFR(i) (bf16x8){vlo[i][0],vlo[i][1],vlo[i][2],vlo[i][3],vhi[i][0],vhi[i][1],vhi[i][2],vhi[i][3]}
  #define PIN(x) asm volatile("":"+v"(x))
  #define MX3(a,b,c) __builtin_fmaxf(__builtin_fmaxf((a),(b)),(c))
  #define GAPA(MF,A0,A1,A2,A3,W0,W1,PW) do{ MF; sacc+=A0; sacc+=A1; sacc+=A2; sacc+=A3; PIN(sacc); W0; W1; PIN(PW); SBAR(); }while(0)
  #define EX(v) __builtin_amdgcn_exp2f(v)
  #define GAPB(MF,X,B) do{ MF; X[B]=EX(X[B]); X[B+1]=EX(X[B+1]); X[B+2]=EX(X[B+2]); X[B+3]=EX(X[B+3]); PIN(X); SBAR(); }while(0)
  #define VRD(i) do{ vlo[i]=vtr(vp_+(((i)>>2)*4096+((i)&3)*1024)); vhi[i]=vtr(vp_+(((i)>>2)*4096+((i)&3)*1024+512)); }while(0)
  #define KRD(G,j) do{ if(G){ kload2(kf,kp0+sl_next,j); SBAR(); } }while(0)
  #define STEP(C0,C1,P0,P1,t,GK,GV,GL) do{ SBAR(); QX_SET(t); SBAR(); \
    const lds_cptr vp_=vp0+sl_prev; \
    VRD(0); SBAR(); float sacc=(P0[0]+P0[1]); \
    GAPA(C0=__builtin_amdgcn_mfma_f32_32x32x16_bf16(kf[0],qr[0],f32x16{},0,0,0), P0[2],P0[3],P0[4],P0[5],     pw0[0]=PKW(P0,0), pw0[1]=PKW(P0,2), pw0); \
    VRD(4); SBAR(); GAPA(C1=__builtin_amdgcn_mfma_f32_32x32x16_bf16(kf[1],qr[0],f32x16{},0,0,0), P0[6],P0[7],P0[8],P0[9],     pw0[2]=PKW(P0,4), pw0[3]=PKW(P0,6), pw0); \
    VRD(1); SBAR(); GAPA(C0=__builtin_amdgcn_mfma_f32_32x32x16_bf16(kf[2],qr[1],C0,0,0,0),   P0[10],P0[11],P0[12],P0[13], pw1[0]=PKW(P0,8), pw1[1]=PKW(P0,10), pw1); \
    VRD(5); SBAR(); GAPA(C1=__builtin_amdgcn_mfma_f32_32x32x16_bf16(kf[3],qr[1],C1,0,0,0),   P0[14],P0[15],P1[0],P1[1],   pw1[2]=PKW(P0,12),pw1[3]=PKW(P0,14), pw1); \
    VRD(2); SBAR(); GAPA(C0=__builtin_amdgcn_mfma_f32_32x32x16_bf16(kf[4],qr[2],C0,0,0,0),   P1[2],P1[3],P1[4],P1[5],     pw2[0]=PKW(P1,0), pw2[1]=PKW(P1,2), pw2); \
    VRD(6); SBAR(); GAPA(C1=__builtin_amdgcn_mfma_f32_32x32x16_bf16(kf[5],qr[2],C1,0,0,0),   P1[6],P1[7],P1[8],P1[9],     pw2[2]=PKW(P1,4), pw2[3]=PKW(P1,6), pw2); \
    VRD(3); SBAR(); GAPA(C0=__builtin_amdgcn_mfma_f32_32x32x16_bf16(kf[6],qr[3],C0,0,0,0),   P1[10],P1[11],P1[12],P1[13], pw3[0]=PKW(P1,8), pw3[1]=PKW(P1,10), pw3); \
    VRD(7); SBAR(); GAPA(C1=__builtin_amdgcn_mfma_f32_32x32x16_bf16(kf[7],qr[3],C1,0,0,0),   P1[14],P1[15],0.f,0.f,       pw3[2]=PKW(P1,12),pw3[3]=PKW(P1,14), pw3); \
    C0=__builtin_amdgcn_mfma_f32_32x32x16_bf16(kx0,qx,C0,0,0,0); C1=__builtin_amdgcn_mfma_f32_32x32x16_bf16(kx1,qx,C1,0,0,0); SBAR(); \
    l_reg+=sacc; \
    if(GK){DMA_K((t)+3,sl_cur);} if(GV){DMA_V((t)+1,sl_next);} \
    CMASK(C0,C1,t); \
    { float a=MX3(C0[0],C0[1],C1[0]),b=MX3(C0[2],C0[3],C1[1]); a=MX3(a,C1[2],C1[3]); \
      _Pragma("unroll") for(int r=4;r<16;r+=4){a=MX3(a,C0[r],C0[r+1]);b=MX3(b,C0[r+2],C0[r+3]);a=MX3(a,C1[r],C1[r+1]);b=MX3(b,C1[r+2],C1[r+3]);} \
      float rm=__builtin_fmaxf(a,b); { auto rr=__builtin_amdgcn_permlane32_swap(__float_as_uint(rm),__float_as_uint(rm),false,false); rm=__builtin_fmaxf(__uint_as_float(rr[0]),__uint_as_float(rr[1])); } \
      resc=false; \
      if(__builtin_expect(__any(rm>(float)THRL),0)){ const float dl=__builtin_fmaxf(rm,0.f); mhat+=dl; \
        _Pragma("unroll") for(int r=0;r<16;++r){C0[r]-=dl;C1[r]-=dl;} \
        const float f=__builtin_amdgcn_exp2f(-dl); l_reg*=f; if(hi==0)wsf[r32]=f; resc=true; } } \
    SBAR(); \
    GAPB(o[0]=__builtin_amdgcn_mfma_f32_32x32x16_bf16(PAF(0),VFR(0),o[0],0,0,0), C0,0); \
    GAPB(o[1]=__builtin_amdgcn_mfma_f32_32x32x16_bf16(PAF(0),VFR(4),o[1],0,0,0), C0,4); \
    KRD(GL,0); GAPB(o[0]=__builtin_amdgcn_mfma_f32_32x32x16_bf16(PAF(1),VFR(1),o[0],0,0,0), C0,8); \
    KRD(GL,1); GAPB(o[1]=__builtin_amdgcn_mfma_f32_32x32x16_bf16(PAF(1),VFR(5),o[1],0,0,0), C0,12); \
    KRD(GL,2); GAPB(o[0]=__builtin_amdgcn_mfma_f32_32x32x16_bf16(PAF(2),VFR(2),o[0],0,0,0), C1,0); \
    KRD(GL,3); GAPB(o[1]=__builtin_amdgcn_mfma_f32_32x32x16_bf16(PAF(2),VFR(6),o[1],0,0,0), C1,4); \
    GAPB(o[0]=__builtin_amdgcn_mfma_f32_32x32x16_bf16(PAF(3),VFR(3),o[0],0,0,0), C1,8); \
    GAPB(o[1]=__builtin_amdgcn_mfma_f32_32x32x16_bf16(PAF(3),VFR(7),o[1],0,0,0), C1,12); \
    }while(0)
  int t=1;
  #undef CMASK
  #define CMASK(P0,P1,t) do{}while(0)
  for(;t+5<NT;t+=2){
    STEP(pB0,pB1,pA0,pA1,t,true,true,true);     WAIT_BAR(2); RESC(); ROT();
    STEP(pA0,pA1,pB0,pB1,t+1,true,true,true);   WAIT_BAR(2); RESC(); ROT();
  }
  #undef CMASK
  #define CMASK(P0,P1,t) do{int jb_=(t)-(NT-4); if(WINDOW||(CAUSAL&&jb_>=0))cmask<CAUSAL,WINDOW>(P0,P1,jb_,qrel,hi);}while(0)
  #define ENDW(tt) do{ if((tt)+3<NT){WAIT_BAR(2);} else if((tt)+2<NT){WAIT_BAR(1);} else {WAIT_BAR(0);} }while(0)
  for(;t+1<NT;t+=2){
    STEP(pB0,pB1,pA0,pA1,t,(t+3<NT),(t+1<NT),(t+1<NT));       ENDW(t);   RESC(); ROT();
    STEP(pA0,pA1,pB0,pB1,t+1,(t+4<NT),(t+2<NT),(t+2<NT));     ENDW(t+1); RESC(); ROT();
  }
  STEP(pB0,pB1,pA0,pA1,NT-1,false,false,false); RESC();
  { float sacc=pB0[0]+pB0[1]; _Pragma("unroll") for(int r=2;r<16;++r)sacc+=pB0[r]; _Pragma("unroll") for(int r=0;r<16;++r)sacc+=pB1[r]; l_reg+=sacc;
    pw0=(u32x4){PKW(pB0,0),PKW(pB0,2),PKW(pB0,4),PKW(pB0,6)};pw1=(u32x4){PKW(pB0,8),PKW(pB0,10),PKW(pB0,12),PKW(pB0,14)};pw2=(u32x4){PKW(pB1,0),PKW(pB1,2),PKW(pB1,4),PKW(pB1,6)};pw3=(u32x4){PKW(pB1,8),PKW(pB1,10),PKW(pB1,12),PKW(pB1,14)};
    SBAR(); pv(o,vb0+sl_cur,PAF(0),PAF(1),PAF(2),PAF(3)); }
  #undef PKW
  #undef PAF
  #undef VFR
  #undef PIN
  #undef MX3
  #undef GAPA
  #undef GAPB
  #undef EX
  #undef VRD
  #undef KRD
  #undef STEP
  #undef ENDW
  {auto rr=__builtin_amdgcn_permlane32_swap(__float_as_uint(l_reg),__float_as_uint(l_reg),false,false);l_reg=__uint_as_float(rr[0])+__uint_as_float(rr[1]);}
  if(LSE){ if(hi==0)U.lse[(long)(q0+wid*QBLK+r32)*U.lse_stride]=mhat+__builtin_amdgcn_logf(l_reg); }
  if(hi==0)wsf[32+r32]=l_reg;asm volatile("s_waitcnt lgkmcnt(0)":::"memory");
  float rli[16];
  #pragma unroll
  for(int r=0;r<16;++r)rli[r]=__builtin_amdgcn_rcpf(wsf[32+crow(r,hi)]);
  bf16*Ow=U.O+(long)(q0+wid*QBLK)*op;
  { bf16*stg=(bf16*)(shm+LDS_OST)+wid*2048;
    #pragma unroll
    for(int r=0;r<16;++r){const int orow=crow(r,hi);
      #pragma unroll
      for(int d0=0;d0<2;++d0)stg[orow*64+d0*32+r32]=__float2bfloat16(o[d0][r]*rli[r]);}
    asm volatile("s_waitcnt lgkmcnt(0)":::"memory");
    #pragma unroll
    for(int i=0;i<4;++i){const int row=i*8+(lane>>3),ch=lane&7; const u32x4 v=*(const u32x4*)(stg+row*64+ch*8); ATTN_STORE16(Ow+(long)row*op+ch*8,v);} }
  asm volatile("s_waitcnt lgkmcnt(0)\n\ts_barrier":::"memory");
  #undef DMA_K
  #undef DMA_V
  #undef CMASK
  #undef START
  #undef RESC
  #undef ROT
  #undef QX_SET
}
constexpr int ATTN_LDS_BYTES=LDS_BYTES;
#undef SBAR
#undef WAIT_BAR
}
constexpr size_t MiB = 1u << 20;
constexpr size_t WS_CTL = 0, CTL_ZERO_BYTES = 1 * MiB;
constexpr size_t WS_LIST = 1 * MiB;
constexpr size_t WS_RGATE = 5 * MiB;
constexpr size_t WS_RSTD1 = 5 * MiB + 512 * 1024, WS_RSTD2 = WS_RSTD1 + 128 * 1024, WS_WRG = WS_RSTD2 + 128 * 1024;
constexpr size_t WS_WRT = 7 * MiB + 512 * 1024;
constexpr size_t WS_LSE = 6 * MiB;
constexpr size_t WS_MKV = 8 * MiB;
constexpr size_t WS_WIN = 10 * MiB, WS_WOUT = 15 * MiB, WS_WGU = 17 * MiB, WS_WDN = 145 * MiB;
constexpr size_t WS_XB = 209 * MiB;
constexpr size_t WS_P = 273 * MiB, WS_OD = 433 * MiB, WS_ODIL = 497 * MiB;
constexpr size_t WS_ACT = 273 * MiB;
constexpr size_t WS_MIX = 545 * MiB, WS_X1B = 609 * MiB, WS_YB = 673 * MiB, WS_Y = 929 * MiB, WS_END = 993 * MiB;
constexpr int CW_TMO = 0, CW_CODE = 1;
constexpr int CW_CNT = 64;
constexpr int CW_NRM = 256;
constexpr int CW_Q = 1024;
constexpr int CW_BAR = 4096;

constexpr int RING_OFF = 0, RING_BYTES = 131072;
constexpr int LDSCTL_OFF = RING_BYTES;
constexpr int IDB_OFF = LDSCTL_OFF;
constexpr int TBL_OFF = IDB_OFF + 3072;
constexpr int LCNT_OFF = TBL_OFF + 2304;
constexpr int MISC_OFF = LCNT_OFF + 256;
constexpr int STG_OFF = MISC_OFF + 128;
constexpr int LDS_BYTES = 147456;
static_assert(STG_OFF + 512 * 12 <= LDS_BYTES, "LDS map");
constexpr int NWAVES = 8;

#define GAS __attribute__((address_space(1)))
#define LAS __attribute__((address_space(3)))
typedef unsigned short bf16;
typedef unsigned v4u __attribute__((ext_vector_type(4)));
typedef unsigned v2u __attribute__((ext_vector_type(2)));
typedef float f32x4 __attribute__((ext_vector_type(4)));
typedef float f32x16 __attribute__((ext_vector_type(16)));
typedef short bf16x8 __attribute__((ext_vector_type(8)));
typedef GAS unsigned gu32;
#define RLX_AGENT __ATOMIC_RELAXED, __HIP_MEMORY_SCOPE_AGENT
#define LDS_WAIT() asm volatile("s_waitcnt lgkmcnt(0)" ::: "memory")
#define VM_WAIT() asm volatile("s_waitcnt vmcnt(0)" ::: "memory")
__device__ __forceinline__ unsigned f2bf(float f) { unsigned u = __builtin_bit_cast(unsigned, f); return (u + 0x7fffu + ((u >> 16) & 1u)) >> 16; }
__device__ __forceinline__ unsigned pk2(float lo, float hi) { return f2bf(lo) | (f2bf(hi) << 16); }
__device__ __forceinline__ unsigned fp8x4(float a, float b, float c, float d) { int w = __builtin_amdgcn_cvt_pk_fp8_f32(a, b, 0, false); w = __builtin_amdgcn_cvt_pk_fp8_f32(c, d, w, true); return (unsigned)w; }
constexpr float WSCALE = 64.f, ASCALE = 8.f;
__device__ __forceinline__ float bf2f(unsigned short b) { return __builtin_bit_cast(float, (unsigned)b << 16); }
__device__ __forceinline__ float bflo(unsigned w) { return __builtin_bit_cast(float, w << 16); }
__device__ __forceinline__ float bfhi(unsigned w) { return __builtin_bit_cast(float, w & 0xffff0000u); }
__device__ __forceinline__ float wave_sum(float v) {
#pragma unroll
    for (int o = 1; o < 64; o <<= 1) v += __shfl_xor(v, o);
    return v;
}

#define XB_TMO      128
#define XB_XCNT(j)  (256  + 64 * (j))
#define XB_XSUB(j)  (1280 + 64 * (j))
#define XB_XGEN(j)  (2304 + 64 * (j))
#define XB_TOP      3328
#define XB_TOPGEN   3392
#define XCD_BAR_WORDS 3456
#define XB_SPIN_CAP (1u << 20)
__device__ __forceinline__ unsigned xb_ld(unsigned* p)              { return __hip_atomic_load(p, __ATOMIC_RELAXED, __HIP_MEMORY_SCOPE_AGENT); }
__device__ __forceinline__ unsigned xb_add(unsigned* p, unsigned v) { return __hip_atomic_fetch_add(p, v, __ATOMIC_RELAXED, __HIP_MEMORY_SCOPE_AGENT); }
__device__ __forceinline__ unsigned xb_xcc_id() { return (unsigned)__builtin_amdgcn_s_getreg((3 << 11) | 20) & 0xFu; }
#define XB_SPIN(cond, bar) do { unsigned _sp = 0; while (cond) { __builtin_amdgcn_s_sleep(1); \
    if ((++_sp & 255u) == 0u) { if (xb_ld(&(bar)[XB_TMO])) break; if (_sp > XB_SPIN_CAP) { atomicAdd(&(bar)[XB_TMO], 1u); break; } } } } while (0)
struct XcdBarrier { unsigned* bar; unsigned x; volatile LAS unsigned* st; };
__device__ __forceinline__ XcdBarrier xcd_barrier_post(unsigned* bar, volatile LAS unsigned* st) {
    XcdBarrier b; b.bar = bar; b.x = xb_xcc_id(); b.st = st;
    if (threadIdx.x == 0) (void)xb_add(&bar[XB_XCNT(b.x)], 1u);
    return b;
}
__device__ __forceinline__ void xcd_barrier_complete(unsigned* bar, unsigned x, unsigned& nloc, unsigned& nx) {
    const unsigned G = gridDim.x * gridDim.y * gridDim.z;
    unsigned sum, cnt, mine, sp = 0u;
    for (;;) {
        sum = 0u; cnt = 0u; mine = 0u;
#pragma unroll
        for (unsigned j = 0; j < 16; ++j) { const unsigned c = xb_ld(&bar[XB_XCNT(j)]); sum += c; cnt += (c > 0u) ? 1u : 0u; mine = (j == x) ? c : mine; }
        if (sum == G) break;
        __builtin_amdgcn_s_sleep(1);
        if ((++sp & 255u) == 0u) { if (xb_ld(&bar[XB_TMO])) break; if (sp > XB_SPIN_CAP) { atomicAdd(&bar[XB_TMO], 1u); break; } }
    }
    nloc = mine > 0u ? mine : 1u; nx = cnt > 0u ? cnt : 1u;
}
__device__ __forceinline__ void xcd_barrier(const XcdBarrier& b) {
    asm volatile("s_waitcnt vmcnt(0)" ::: "memory");
    __syncthreads();
    if (threadIdx.x == 0) {
        unsigned* bar = b.bar;
        __builtin_amdgcn_s_waitcnt(0);
        unsigned nloc = b.st[0], nx = b.st[1];
        if (nloc == 0u) { xcd_barrier_complete(bar, b.x, nloc, nx); b.st[0] = nloc; b.st[1] = nx; }
        const unsigned old = xb_add(&bar[XB_XSUB(b.x)], 1u);
        const unsigned gen = old / nloc;
        if (old + 1u == (gen + 1u) * nloc) {
            __builtin_amdgcn_fence(__ATOMIC_RELEASE, "agent");
            asm volatile("s_waitcnt vmcnt(0)" ::: "memory");
            const unsigned og = xb_add(&bar[XB_TOP], 1u);
            const unsigned tg = og / nx;
            if (og + 1u == (tg + 1u) * nx) xb_add(&bar[XB_TOPGEN], 1u);
            else XB_SPIN(xb_ld(&bar[XB_TOPGEN]) == tg, bar);
            __builtin_amdgcn_fence(__ATOMIC_ACQUIRE, "agent");
            xb_add(&bar[XB_XGEN(b.x)], 1u);
            asm volatile("s_waitcnt vmcnt(0)" ::: "memory");
        } else {
            XB_SPIN(xb_ld(&bar[XB_XGEN(b.x)]) == gen, bar);
            __builtin_amdgcn_fence(__ATOMIC_ACQUIRE, "agent");
            asm volatile("s_waitcnt vmcnt(0)" ::: "memory");
        }
    }
    __syncthreads();
}

struct Frame {
    LAS unsigned char* lds;
    volatile LAS unsigned* MISC;
    gu32* ctl;
    int tid, lane, wave;
    int vcu, G;
    const float *x, *mem, *g_attn, *g_mem, *w_in, *lamqk, *subg, *w_mkv, *w_out, *g_ffn, *w_r, *b_r, *w_gu, *b_gu, *w_dn, *b_dn, *g_fin;
    float* out; unsigned char* ws;
};

#define P0_LOAD(dst, itm) do { const int m_ = (itm) / ipm, r_ = (itm) % ipm, kb_ = r_ / nblk, nb_ = r_ % nblk; \
        const float* src_ = W + (size_t)m_ * K * N + (size_t)(64 * kb_ + (lane >> 5)) * N + 32 * nb_ + (lane & 31); \
        _Pragma("unroll") for (int i_ = 0; i_ < 32; ++i_) dst[i_] = src_[(size_t)(2 * i_) * N]; } while (0)
template <bool F8, class RowMap>
__device__ __forceinline__ void p0_transpose_all(const float* W, int K, int N, int nmat, void* WTv, const float* gk, float wscale, LAS float* scr, int gw, int NGW, int lane, RowMap rowmap) {
    const int nblk = N / 32, ipm = (K / 64) * nblk, total = nmat * ipm;
    int it = gw; if (it >= total) return;
    float v[32], w[32];
    P0_LOAD(v, it);
    for (;;) {
        const int nx = it + NGW; const bool more = nx < total;
        if (more) P0_LOAD(w, nx);
        const int m = it / ipm, r = it % ipm, k0 = 64 * (r / nblk), n0 = 32 * (r % nblk);
        if (gk) {
#pragma unroll
            for (int i = 0; i < 32; ++i) v[i] *= gk[k0 + 2 * i + (lane >> 5)] * wscale;
        } else if (F8) {
#pragma unroll
            for (int i = 0; i < 32; ++i) v[i] *= wscale;
        }
#pragma unroll
        for (int i = 0; i < 32; ++i) scr[(2 * i + (lane >> 5)) * 33 + (lane & 31)] = v[i];
        LDS_WAIT(); asm volatile("" ::: "memory");
        const int c = lane & 7;
#pragma unroll
        for (int j = 0; j < 4; ++j) { const int n = (lane >> 3) + 8 * j; const LAS float* s = scr + (8 * c) * 33 + n;
            if constexpr (F8) { unsigned char* wt = (unsigned char*)WTv + (size_t)m * N * K;
                v2u o; o.x = fp8x4(s[0 * 33], s[1 * 33], s[2 * 33], s[3 * 33]); o.y = fp8x4(s[4 * 33], s[5 * 33], s[6 * 33], s[7 * 33]);
                *(GAS v2u*)(wt + (size_t)rowmap(n0 + n) * K + k0 + 8 * c) = o; }
            else { bf16* wt = (bf16*)WTv + (size_t)m * N * K;
                v4u o; o.x = pk2(s[0 * 33], s[1 * 33]); o.y = pk2(s[2 * 33], s[3 * 33]); o.z = pk2(s[4 * 33], s[5 * 33]); o.w = pk2(s[6 * 33], s[7 * 33]);
                *(GAS v4u*)(wt + (size_t)rowmap(n0 + n) * K + k0 + 8 * c) = o; } }
        LDS_WAIT(); asm volatile("" ::: "memory");
        if (!more) break;
#pragma unroll
        for (int i = 0; i < 32; ++i) v[i] = w[i];
        it = nx;
    }
}
#undef P0_LOAD
struct RowId { __device__ __forceinline__ int operator()(int n) const { return n; } };
struct RowGU { __device__ __forceinline__ int operator()(int n) const { const int f = n >> 1, u = n & 1; return ((f >> 7) << 8) + (u << 7) + (f & 127); } };

__device__ __forceinline__ void p0_x_rows2(Frame& F, const float* xrow, bf16* orow, float* rstd_out) {
    const GAS f32x4* xr = (const GAS f32x4*)xrow + F.lane;
    f32x4 v[8]; float s0 = 0.f, s1 = 0.f;
#pragma unroll
    for (int j = 0; j < 8; ++j) v[j] = xr[64 * j];
#pragma unroll
    for (int j = 0; j < 4; ++j) { s0 += (v[j].x * v[j].x + v[j].y * v[j].y) + (v[j].z * v[j].z + v[j].w * v[j].w); s1 += (v[4 + j].x * v[4 + j].x + v[4 + j].y * v[4 + j].y) + (v[4 + j].z * v[4 + j].z + v[4 + j].w * v[4 + j].w); }
    s0 = wave_sum(s0); s1 = wave_sum(s1);
    GAS unsigned long long* o8 = (GAS unsigned long long*)orow + F.lane;
#pragma unroll
    for (int j = 0; j < 8; ++j) o8[64 * j] = (unsigned long long)pk2(v[j].x, v[j].y) | ((unsigned long long)pk2(v[j].z, v[j].w) << 32);
    if (F.lane == 0) { rstd_out[0] = 1.f / sqrtf(s0 * (1.f / D) + EPS); rstd_out[1] = 1.f / sqrtf(s1 * (1.f / D) + EPS); }
}
__device__ __forceinline__ void p0_mkv_tile(Frame& F, int tile, bf16* mkv) {
    const int mt = tile >> 4, nt = tile & 15, m0 = 32 * mt, n0 = 32 * nt, r = F.lane & 31, h = F.lane >> 5;
    f32x16 acc = {}; float ss = 0.f;
    const float* mrow = F.mem + (size_t)(m0 + r) * D + 8 * h;
    const float* wcol = F.w_mkv + (size_t)(8 * h) * 512 + n0 + r;
    const float* gp = F.g_mem + 8 * h;
    for (int k0 = 0; k0 < D; k0 += 16) {
        const f32x4 a0 = *(const f32x4*)(mrow + k0), a1 = *(const f32x4*)(mrow + k0 + 4);
        const f32x4 g0 = *(const f32x4*)(gp + k0), g1 = *(const f32x4*)(gp + k0 + 4);
        ss += (a0.x * a0.x + a0.y * a0.y) + (a0.z * a0.z + a0.w * a0.w) + (a1.x * a1.x + a1.y * a1.y) + (a1.z * a1.z + a1.w * a1.w);
        v4u bw; bw.x = pk2(a0.x * g0.x, a0.y * g0.y); bw.y = pk2(a0.z * g0.z, a0.w * g0.w); bw.z = pk2(a1.x * g1.x, a1.y * g1.y); bw.w = pk2(a1.z * g1.z, a1.w * g1.w);
        float wv[8];
#pragma unroll
        for (int j = 0; j < 8; ++j) wv[j] = wcol[(size_t)(k0 + j) * 512];
        v4u aw; aw.x = pk2(wv[0], wv[1]); aw.y = pk2(wv[2], wv[3]); aw.z = pk2(wv[4], wv[5]); aw.w = pk2(wv[6], wv[7]);
        acc = __builtin_amdgcn_mfma_f32_32x32x16_bf16(__builtin_bit_cast(bf16x8, aw), __builtin_bit_cast(bf16x8, bw), acc, 0, 0, 0);
    }
    ss += __shfl_xor(ss, 32);
    const float rstd = 1.f / sqrtf(ss * (1.f / D) + EPS);
    bf16* orow = mkv + (size_t)(m0 + r) * 512 + n0 + 4 * h;
#pragma unroll
    for (int q = 0; q < 4; ++q) { v2u o; o.x = pk2(acc[4 * q] * rstd, acc[4 * q + 1] * rstd); o.y = pk2(acc[4 * q + 2] * rstd, acc[4 * q + 3] * rstd); *(GAS v2u*)(orow + 8 * q) = o; }
}
__device__ __forceinline__ void p0_prologue(Frame& F) {
    LAS float* scr = (LAS float*)(F.lds + RING_OFF + F.wave * 16384);
    const int gw = F.vcu * NWAVES + F.wave, NGW = F.G * NWAVES;
    bf16* win_t = (bf16*)(F.ws + WS_WIN); bf16* wout_t = (bf16*)(F.ws + WS_WOUT); bf16* wgu_t = (bf16*)(F.ws + WS_WGU); bf16* wdn_t = (bf16*)(F.ws + WS_WDN);
    p0_transpose_all<true>(F.w_gu, D, 2 * DFF, NE, wgu_t, F.g_ffn, WSCALE, scr, gw, NGW, F.lane, RowGU());
    p0_transpose_all<true>(F.w_dn, DFF, D, NE, wdn_t, nullptr, WSCALE, scr, gw, NGW, F.lane, RowId());
    p0_transpose_all<false>(F.w_in, D, DIN, 1, win_t, F.g_attn, 1.f, scr, gw, NGW, F.lane, RowId());
    p0_transpose_all<false>(F.w_out, D, D, 1, wout_t, nullptr, 1.f, scr, gw, NGW, F.lane, RowId());
    bf16* xb = (bf16*)(F.ws + WS_XB); float* rstd1 = (float*)(F.ws + WS_RSTD1);
    for (int m = 2 * gw; m < T; m += 2 * NGW) p0_x_rows2(F, F.x + (size_t)m * D, xb + (size_t)m * D, rstd1 + m);
    bf16* mkv = (bf16*)(F.ws + WS_MKV);
    for (int t = gw; t < (BATCH * NMEM / 32) * (512 / 32); t += NGW) p0_mkv_tile(F, t, mkv);
    bf16* wrt = (bf16*)(F.ws + WS_WRT);
    for (int i = gw * 64 + F.lane; i < D * NE; i += NGW * 64) { const int e = i >> 10, k = i & 1023; const float w = F.w_r[k * NE + e] * F.g_ffn[k]; const unsigned hb = f2bf(w); wrt[i] = (bf16)hb; wrt[D * NE + i] = (bf16)f2bf(w - bf2f((bf16)hb)); }
}

struct EpiInProj {
    bf16* O; const float* rstd; unsigned* nrm;
    __device__ __forceinline__ void operator()(const pg8::f32x4 (&acc)[2][2][4][2], const pg8::Unit& u, int wr, int wc, int fr, int fq, const LAS unsigned*) const {
        asm volatile("" : "+v"(fr), "+v"(fq));
        const int row0 = u.pm * 256 + wr * 64 + fr, col0 = u.pn * 256 + wc * 32 + 8 * fq;
        const float sc = (u.pn <= 1 || u.pn == 6 || u.pn == 9) ? QSCALE : 1.f;
        float rsv[2][4];
#pragma unroll
        for (int ai = 0; ai < 2; ++ai)
#pragma unroll
            for (int m = 0; m < 4; ++m) rsv[ai][m] = rstd[row0 + ai * 128 + m * 16];
#pragma unroll
        for (int ai = 0; ai < 2; ++ai)
#pragma unroll
            for (int m = 0; m < 4; ++m) { const int row = row0 + ai * 128 + m * 16; const float rs = rsv[ai][m] * sc; bf16* rowp = O + (size_t)row * DIN + col0;
#pragma unroll
                for (int bj = 0; bj < 2; ++bj) { const pg8::f32x4 v0 = acc[ai][bj][m][0] * rs, v1 = acc[ai][bj][m][1] * rs;
                    v4u w; w.x = pg8::cvt_pk_bf16(v0[0], v0[1]); w.y = pg8::cvt_pk_bf16(v0[2], v0[3]); w.z = pg8::cvt_pk_bf16(v1[0], v1[1]); w.w = pg8::cvt_pk_bf16(v1[2], v1[3]);
                    *(v4u*)(rowp + bj * 128) = w; } }
        if (u.pn < 4) {
#pragma unroll
            for (int bj = 0; bj < 2; ++bj) { float mx = 0.f;
#pragma unroll
                for (int ai = 0; ai < 2; ++ai)
#pragma unroll
                    for (int m = 0; m < 4; ++m) { const float rs = rsv[ai][m] * sc; const pg8::f32x4 v0 = acc[ai][bj][m][0] * rs, v1 = acc[ai][bj][m][1] * rs;
                        float s = (v0[0] * v0[0] + v0[1] * v0[1]) + (v0[2] * v0[2] + v0[3] * v0[3]) + (v1[0] * v1[0] + v1[1] * v1[1]) + (v1[2] * v1[2] + v1[3] * v1[3]);
                        s += __shfl_xor(s, 16); s += __shfl_xor(s, 32); mx = fmaxf(mx, s); }
#pragma unroll
                for (int o = 1; o < 16; o <<= 1) mx = fmaxf(mx, __shfl_xor(mx, o));
                if ((fr | fq) == 0) atomicMax(nrm + (((u.pm >> 4) * 4 + u.pn) * 4 + 2 * bj + (wc >> 1)) * 2 + (wc & 1), __builtin_bit_cast(unsigned, mx)); }
        }
    }
};
__device__ __forceinline__ void attn_phase(Frame& F, char* shm, int qoff = 0, int gmask = 7) {
    using namespace attn_body;
    const attn_body::bf16* P = (const attn_body::bf16*)(F.ws + WS_P);
    attn_body::bf16* OD = (attn_body::bf16*)(F.ws + WS_OD);
    attn_body::bf16* mix = (attn_body::bf16*)(F.ws + WS_MIX);
    attn_body::bf16* ODIL = (attn_body::bf16*)(F.ws + WS_ODIL); float* LSEb = (float*)(F.ws + WS_LSE);
    const attn_body::bf16* MKV = (const attn_body::bf16*)(F.ws + WS_MKV);
    const float* nrm = (const float*)(F.ctl + CW_NRM);
    float lam;
    { const float a = F.lamqk[F.lane] * F.lamqk[64 + F.lane], c = F.lamqk[128 + F.lane] * F.lamqk[192 + F.lane];
      lam = __expf(wave_sum(a)) - __expf(wave_sum(c)) + 0.2f; }
    const int grp = (int)blockIdx.x & 7, b = grp;
    unsigned* qctr = (unsigned*)(F.ctl + CW_Q + qoff) + 64 * grp;
    const attn_body::bf16* Pb = P + (size_t)b * SEQ * DIN;
    for (;;) {
        if (F.tid == 0) F.MISC[20] = __hip_atomic_fetch_add(qctr, 1u, __ATOMIC_RELAXED, __HIP_MEMORY_SCOPE_AGENT);
        __syncthreads();
        const int un = (int)F.MISC[20];
        __syncthreads();
        if (un >= 320) break;
        if (un < 64) {
            if (!(gmask & 1)) continue;
            const int qb = 15 - (un >> 2), h = 3 - (un & 3);
            const float slope2 = exp2f(-(float)(2 * h + 1)) * LOG2E;
            for (int pass = 0; pass < 4; ++pass) {
                const int j = pass >> 1, vh = pass & 1;
                const int ni = ((b * 4 + (h >> 1)) * 4 + 2 * (h & 1) + j) * 2;
                const float R = sqrtf((nrm[ni] + nrm[ni + 1]) * (nrm[ni + 16] + nrm[ni + 17])) * 1.01f;
                const float kfirst = (float)(qb * 256) - (2.f * R + 160.f) / slope2;
                int t0 = kfirst > 0.f ? (int)(kfirst * (1.f / 64.f)) : 0; t0 = min(t0, 4 * qb); t0 &= ~1;
                UnitP U; U.Q = Pb + C_DQ + h * 128 + j * 64; U.K = Pb + C_DK + h * 128 + j * 64; U.V = Pb + C_DV + h * 128 + vh * 64;
                U.O = OD + (size_t)b * SEQ * 1024 + h * 256 + j * 128 + vh * 64; U.qp = DIN; U.kp = DIN; U.op = 1024;
                U.q0 = qb * 256; U.t0 = t0; U.NT = 4 * qb + 4 - t0; U.slope2 = slope2; U.lse = nullptr; U.lse_stride = 0;
                attn_unit<8, true, false, true, false>(U, shm);
            }
            asm volatile("s_waitcnt vmcnt(0)" ::: "memory");
            const int row = (b * SEQ + qb * 256 + F.wave * 32 + (F.lane >> 1)), vh = F.lane & 1;
            const v4u* o1 = (const v4u*)(OD + (size_t)row * 1024 + h * 256 + vh * 64);
            const v4u* o2 = (const v4u*)(OD + (size_t)row * 1024 + h * 256 + 128 + vh * 64);
            float d[64]; float ss = 0.f;
#pragma unroll
            for (int c = 0; c < 8; ++c) { const v4u a = o1[c], bq = o2[c];
                const unsigned aw[4] = {a.x, a.y, a.z, a.w}, bw[4] = {bq.x, bq.y, bq.z, bq.w};
#pragma unroll
                for (int q = 0; q < 4; ++q) { const float x0 = bflo(aw[q]) - lam * bflo(bw[q]), x1 = bfhi(aw[q]) - lam * bfhi(bw[q]); d[8 * c + 2 * q] = x0; d[8 * c + 2 * q + 1] = x1; ss += x0 * x0 + x1 * x1; } }
            ss += __shfl_xor(ss, 1);
            const float rstd = 0.8f / sqrtf(ss * (1.f / 128.f) + EPS);
            const float* gp = F.subg + vh * 64;
            v4u* mo = (v4u*)(mix + (size_t)row * 1024 + h * 128 + vh * 64);
#pragma unroll
            for (int c = 0; c < 8; ++c) { v4u o; o.x = pk2(d[8 * c] * rstd * gp[8 * c], d[8 * c + 1] * rstd * gp[8 * c + 1]); o.y = pk2(d[8 * c + 2] * rstd * gp[8 * c + 2], d[8 * c + 3] * rstd * gp[8 * c + 3]);
                o.z = pk2(d[8 * c + 4] * rstd * gp[8 * c + 4], d[8 * c + 5] * rstd * gp[8 * c + 5]); o.w = pk2(d[8 * c + 6] * rstd * gp[8 * c + 6], d[8 * c + 7] * rstd * gp[8 * c + 7]); mo[c] = o; }
        } else if (un < 256) {
            if (!(gmask & 2)) continue;
            const int du = un - 64, h = du / 48, idx = du % 48, n = idx >> 4, w = idx & 15;
            const int r = (n == 0) ? 1 : (n == 1 ? 4 : 16), c = (n == 0) ? 0 : (n == 1 ? (w >> 2) : w), blk = (n == 0) ? w : (n == 1 ? (w & 3) : 0);
            const attn_body::bf16* Pc = Pb + (size_t)c * DIN;
            UnitP U; U.Q = Pc + C_LQ + h * 64; U.K = Pc + C_LK + h * 64; U.V = Pc + C_LV + h * 64; U.qp = (long)r * DIN; U.kp = (long)r * DIN;
            U.O = ODIL + (size_t)n * T * 256 + ((size_t)b * SEQ + c) * 256 + h * 64; U.op = (long)r * 256;
            U.q0 = blk * 256; U.t0 = (blk == 0) ? 0 : 4 * blk - 2; U.NT = 4 * blk + 4 - U.t0;
            U.slope2 = exp2f(-(float)(2 * h + 2)) * (float)r * LOG2E;
            U.lse = LSEb + (size_t)n * T * 4 + ((size_t)b * SEQ + c) * 4 + h; U.lse_stride = r * 4;
            attn_unit<8, true, true, true, true>(U, shm);
        } else {
            if (!(gmask & 4)) continue;
            const int mu = un - 256, h = mu >> 4, qb = mu & 15;
            UnitP U; U.Q = Pb + C_MQ + h * 64; U.qp = DIN; U.K = MKV + (size_t)b * NMEM * 512 + h * 64; U.V = U.K + 256; U.kp = 512;
            U.O = mix + (size_t)b * SEQ * 1024 + 768 + h * 64; U.op = 1024; U.q0 = qb * 256; U.t0 = 0; U.NT = 4; U.slope2 = 0.f; U.lse = nullptr; U.lse_stride = 0;
            attn_unit<8, false, false, false, false>(U, shm);
        }
    }
}
__device__ __forceinline__ void dil_combine_phase(Frame& F) {
    const int gw = F.vcu * NWAVES + F.wave, NGW = F.G * NWAVES;
    const bf16* ODIL = (const bf16*)(F.ws + WS_ODIL); const float* LSEb = (const float*)(F.ws + WS_LSE); bf16* mix = (bf16*)(F.ws + WS_MIX);
    const int h = F.lane >> 4, d4 = (F.lane & 15) * 4;
    for (int row0 = 4 * gw; row0 < T; row0 += 4 * NGW) {
        float l[4][3]; v2u q[4][3];
#pragma unroll
        for (int i = 0; i < 4; ++i)
#pragma unroll
            for (int n = 0; n < 3; ++n) { l[i][n] = LSEb[(size_t)n * T * 4 + (size_t)(row0 + i) * 4 + h]; q[i][n] = *(const v2u*)(ODIL + (size_t)n * T * 256 + (size_t)(row0 + i) * 256 + h * 64 + d4); }
#pragma unroll
        for (int i = 0; i < 4; ++i) {
            const float m = fmaxf(fmaxf(l[i][0], l[i][1]), l[i][2]);
            float wn[3], den = 0.f;
#pragma unroll
            for (int n = 0; n < 3; ++n) { wn[n] = exp2f(l[i][n] - m); den += wn[n]; }
            const float inv = 1.f / den; float o[4] = {0.f, 0.f, 0.f, 0.f};
#pragma unroll
            for (int n = 0; n < 3; ++n) { const float wq = wn[n] * inv; o[0] += wq * bflo(q[i][n].x); o[1] += wq * bfhi(q[i][n].x); o[2] += wq * bflo(q[i][n].y); o[3] += wq * bfhi(q[i][n].y); }
            v2u ov; ov.x = pk2(o[0], o[1]); ov.y = pk2(o[2], o[3]);
            *(v2u*)(mix + (size_t)(row0 + i) * 1024 + 512 + h * 64 + d4) = ov;
        }
    }
}
struct EpiY {
    bf16* Y;
    __device__ __forceinline__ void operator()(const pg8::f32x4 (&acc)[2][2][4][2], const pg8::Unit& u, int wr, int wc, int fr, int fq, const LAS unsigned*) const {
        asm volatile("" : "+v"(fr), "+v"(fq));
        const int row0 = u.pm * 256 + wr * 64 + fr, col0 = u.pn * 256 + wc * 32 + 8 * fq;
#pragma unroll
        for (int ai = 0; ai < 2; ++ai)
#pragma unroll
            for (int m = 0; m < 4; ++m) { bf16* rowp = Y + (size_t)(row0 + ai * 128 + m * 16) * D + col0;
#pragma unroll
                for (int bj = 0; bj < 2; ++bj) { const pg8::f32x4 v0 = acc[ai][bj][m][0], v1 = acc[ai][bj][m][1];
                    v4u w; w.x = pg8::cvt_pk_bf16(v0[0], v0[1]); w.y = pg8::cvt_pk_bf16(v0[2], v0[3]); w.z = pg8::cvt_pk_bf16(v1[0], v1[1]); w.w = pg8::cvt_pk_bf16(v1[2], v1[3]);
                    *(v4u*)(rowp + bj * 128) = w; } }
    }
};

__device__ __forceinline__ void route_phase(Frame& F) {
    LAS float* xch = (LAS float*)(F.lds + RING_OFF);
    LAS unsigned* lcnt = (LAS unsigned*)(F.lds + LCNT_OFF);
    LAS unsigned* stg = (LAS unsigned*)(F.lds + STG_OFF);
    if (F.tid < 64) lcnt[F.tid] = 0u;
    const int lane = F.lane, tl = lane & 31, h = lane >> 5, tg = F.wave & 3, kh = F.wave >> 2;
    { const v4u* wsrc = (const v4u*)(F.ws + WS_WRT); LAS char* wl = (LAS char*)(F.lds + RING_OFF);
      for (int i = F.tid; i < 2 * 32 * 128; i += NWAVES * 64) { const int hl = i >> 12, e = (i >> 7) & 31, c = i & 127; *(LAS v4u*)(wl + hl * 65536 + e * 2048 + ((c ^ (e & 15)) << 4)) = wsrc[i]; } }
    __syncthreads();
    const int tok = F.vcu * 128 + tg * 32 + tl;
    const float* xr = F.x + (size_t)tok * D + kh * 512 + 8 * h;
    const bf16* yr = (const bf16*)(F.ws + WS_Y) + (size_t)tok * D + kh * 512 + 8 * h;
    unsigned char* x1r = (unsigned char*)(F.ws + WS_X1B) + (size_t)tok * D + kh * 512 + 8 * h;
    const LAS char* wrow = (const LAS char*)(F.lds + RING_OFF) + tl * 2048;
    f32x16 acc = {}; float ss = 0.f;
    f32x4 xa[2][8]; v4u ya[2][4];
#define RT_LOAD(buf, g) do { _Pragma("unroll") for (int q_ = 0; q_ < 4; ++q_) { xa[buf][2 * q_] = *(const f32x4*)(xr + 64 * (g) + 16 * q_); xa[buf][2 * q_ + 1] = *(const f32x4*)(xr + 64 * (g) + 16 * q_ + 4); \
        ya[buf][q_] = *(const v4u*)(yr + 64 * (g) + 16 * q_); } } while (0)
#define RT_COMP(buf, g) do { _Pragma("unroll") for (int q_ = 0; q_ < 4; ++q_) { const int c_ = (kh * 512 + 64 * (g) + 16 * q_) / 8 + h; \
        const v4u wh = *(const LAS v4u*)(wrow + ((c_ ^ (tl & 15)) << 4)), wl2 = *(const LAS v4u*)(wrow + 65536 + ((c_ ^ (tl & 15)) << 4)); \
        const f32x4 a0 = xa[buf][2 * q_], a1 = xa[buf][2 * q_ + 1]; const v4u yv = ya[buf][q_]; \
        const float x1[8] = {a0.x + bflo(yv.x), a0.y + bfhi(yv.x), a0.z + bflo(yv.y), a0.w + bfhi(yv.y), a1.x + bflo(yv.z), a1.y + bfhi(yv.z), a1.z + bflo(yv.w), a1.w + bfhi(yv.w)}; \
        unsigned hw[4], lw[4]; \
        _Pragma("unroll") for (int p_ = 0; p_ < 4; ++p_) { const float u_ = x1[2 * p_], r_ = x1[2 * p_ + 1]; ss += u_ * u_ + r_ * r_; const unsigned hb = pk2(u_, r_); hw[p_] = hb; lw[p_] = pk2(u_ - bflo(hb), r_ - bfhi(hb)); } \
        const v4u xh = (v4u){hw[0], hw[1], hw[2], hw[3]}, xl = (v4u){lw[0], lw[1], lw[2], lw[3]}; \
        { v2u o8_; o8_.x = fp8x4(x1[0], x1[1], x1[2], x1[3]); o8_.y = fp8x4(x1[4], x1[5], x1[6], x1[7]); *(v2u*)(x1r + 64 * (g) + 16 * q_) = o8_; } \
        acc = __builtin_amdgcn_mfma_f32_32x32x16_bf16(__builtin_bit_cast(bf16x8, wh), __builtin_bit_cast(bf16x8, xh), acc, 0, 0, 0); \
        acc = __builtin_amdgcn_mfma_f32_32x32x16_bf16(__builtin_bit_cast(bf16x8, wh), __builtin_bit_cast(bf16x8, xl), acc, 0, 0, 0); \
        acc = __builtin_amdgcn_mfma_f32_32x32x16_bf16(__builtin_bit_cast(bf16x8, wl2), __builtin_bit_cast(bf16x8, xh), acc, 0, 0, 0); } } while (0)
    RT_LOAD(0, 0);
#pragma unroll
    for (int g = 0; g < 8; g += 2) {
        RT_LOAD(1, g + 1); RT_COMP(0, g);
        if (g + 2 < 8) RT_LOAD(0, g + 2);
        RT_COMP(1, g + 1);
    }
#undef RT_LOAD
#undef RT_COMP
    __syncthreads();
    if (kh == 1) { LAS float* d = xch + (tg * 64 + lane) * 17;
#pragma unroll
        for (int i = 0; i < 16; ++i) d[i] = acc[i];
        d[16] = ss; }
    __syncthreads();
    if (kh == 0) {
        const LAS float* d = xch + (tg * 64 + lane) * 17;
#pragma unroll
        for (int i = 0; i < 16; ++i) acc[i] += d[i];
        ss += d[16]; ss += __shfl_xor(ss, 32);
        const float rstd = 1.f / sqrtf(ss * (1.f / D) + EPS);
        float lg[16];
#pragma unroll
        for (int i = 0; i < 16; ++i) lg[i] = acc[i] * rstd + F.b_r[4 * h + (i & 3) + 8 * (i >> 2)];
        float cv[8]; int ce[8];
#pragma unroll
        for (int k = 0; k < 4; ++k) { float bv = -INFINITY; int bi = 0;
#pragma unroll
            for (int i = 0; i < 16; ++i) { if (lg[i] > bv) { bv = lg[i]; bi = i; } }
            cv[k] = bv; ce[k] = 4 * h + (bi & 3) + 8 * (bi >> 2);
#pragma unroll
            for (int i = 0; i < 16; ++i) if (i == bi) lg[i] = -INFINITY; }
#pragma unroll
        for (int k = 0; k < 4; ++k) { cv[4 + k] = __shfl_xor(cv[k], 32); ce[4 + k] = __shfl_xor(ce[k], 32); }
        float tv[4]; int te[4];
#pragma unroll
        for (int k = 0; k < 4; ++k) { float bv = -INFINITY; int be = 64, bi = 0;
#pragma unroll
            for (int i = 0; i < 8; ++i) { if (cv[i] > bv || (cv[i] == bv && ce[i] < be)) { bv = cv[i]; be = ce[i]; bi = i; } }
            tv[k] = bv; te[k] = be;
#pragma unroll
            for (int i = 0; i < 8; ++i) if (i == bi) cv[i] = -INFINITY; }
        float gk[4], den = 0.f;
#pragma unroll
        for (int k = 0; k < 4; ++k) { gk[k] = __expf(tv[k] - tv[0]); den += gk[k]; }
        const float inv = 1.f / den;
        if (h == 0) {
#pragma unroll
            for (int k = 0; k < 4; ++k) {
                const unsigned rank = __hip_atomic_fetch_add(lcnt + te[k], 1u, __ATOMIC_RELAXED, __HIP_MEMORY_SCOPE_WORKGROUP);
                const int slot = (tg * 32 + tl) * 4 + k;
                stg[slot * 3] = (unsigned)(tok * 4 + k); stg[slot * 3 + 1] = ((unsigned)te[k] << 16) | rank; stg[slot * 3 + 2] = __builtin_bit_cast(unsigned, gk[k] * inv);
            }
            ((float*)(F.ws + WS_RSTD2))[tok] = rstd;
        }
    }
    __syncthreads();
    if (F.tid < 32) { const unsigned n = lcnt[F.tid]; lcnt[32 + F.tid] = n ? __hip_atomic_fetch_add((unsigned*)(F.ctl + CW_CNT) + F.tid, n, __ATOMIC_RELAXED, __HIP_MEMORY_SCOPE_AGENT) : 0u; }
    __syncthreads();
    { unsigned* list = (unsigned*)(F.ws + WS_LIST); float* rgate = (float*)(F.ws + WS_RGATE);
      const unsigned ent = stg[F.tid * 3], er = stg[F.tid * 3 + 1], gb = stg[F.tid * 3 + 2]; const unsigned e = er >> 16, rank = er & 0xffffu;
      list[(size_t)e * LCAP + lcnt[32 + e] + rank] = ent; rgate[ent] = __builtin_bit_cast(float, gb); }
    __syncthreads();
}

__device__ __forceinline__ int moe_build_table(Frame& F) {
    LAS unsigned* tbl = (LAS unsigned*)(F.lds + TBL_OFF); LAS unsigned* lcnt = (LAS unsigned*)(F.lds + LCNT_OFF);
    if (F.wave == 0) {
        const int e = F.lane & 31;
        const unsigned cnt = __hip_atomic_load((unsigned*)(F.ctl + CW_CNT) + e, __ATOMIC_RELAXED, __HIP_MEMORY_SCOPE_AGENT);
        const unsigned nt = (cnt + 255u) >> 8; unsigned incl = nt;
#pragma unroll
        for (int o = 1; o < 32; o <<= 1) { const unsigned t = __shfl_up(incl, o); if ((F.lane & 31) >= o) incl += t; }
        if (F.lane < 32) { lcnt[e] = cnt; const unsigned start = incl - nt; for (unsigned j = 0; j < nt; ++j) tbl[start + j] = ((unsigned)e << 16) | j; if (F.lane == 31) F.MISC[16] = incl; }
    }
    __syncthreads();
    return (int)F.MISC[16];
}
struct MoeOrder {
    const LAS unsigned* tbl; const LAS unsigned* lcnt; const unsigned* list; int NMT, G, c, NPN, MPER, RB; size_t bexp; bool a_tiles;
    __device__ __forceinline__ bool next(int i, pg8::Unit& u) const {
        const int L = i * G + c, blk = L >> 5, w = L & 31, g = blk * MPER + w / NPN, pn = w % NPN;
        if (g >= NMT) return false;
        const unsigned t = tbl[g]; const int e = (int)(t >> 16), mt = (int)(t & 0xffffu); const int cnt = (int)lcnt[e];
        u.pm = g; u.pn = pn; u.e = e; u.mt = mt; u.valid = min(256, cnt - mt * 256);
        u.aoff = a_tiles ? (size_t)g * (size_t)(256 * RB) : (size_t)0; u.boff = (size_t)e * bexp + (size_t)pn * (size_t)(256 * RB);
        return true;
    }
    __device__ __forceinline__ const unsigned* id_src(const pg8::Unit& u, int row) const { return list + (size_t)u.e * LCAP + u.mt * 256 + min(row, u.valid - 1); }
};
struct EpiGU {
    unsigned char* ACT; const float* rstd2; const float* bgu;
    __device__ __forceinline__ void operator()(const pg8::f32x4 (&acc)[2][2][4][2], const pg8::Unit& u, int wr, int wc, int fr, int fq, const LAS unsigned* ids) const {
        asm volatile("" : "+v"(fr), "+v"(fq));
        const int r0 = wr * 64 + fr, f0 = u.pn * 128 + wc * 32 + 8 * fq;
        float rs[2][4];
#pragma unroll
        for (int ai = 0; ai < 2; ++ai)
#pragma unroll
            for (int m = 0; m < 4; ++m) rs[ai][m] = rstd2[ids[r0 + ai * 128 + m * 16] >> 2] * (1.f / WSCALE);
        const float* bp = bgu + (size_t)u.e * 2048 + 2 * f0;
        const pg8::f32x4 b0 = *(const pg8::f32x4*)bp, b1 = *(const pg8::f32x4*)(bp + 4), b2 = *(const pg8::f32x4*)(bp + 8), b3 = *(const pg8::f32x4*)(bp + 12);
        const float gb[8] = {b0[0], b0[2], b1[0], b1[2], b2[0], b2[2], b3[0], b3[2]}, ub[8] = {b0[1], b0[3], b1[1], b1[3], b2[1], b2[3], b3[1], b3[3]};
#pragma unroll
        for (int ai = 0; ai < 2; ++ai)
#pragma unroll
            for (int m = 0; m < 4; ++m) { const int r = r0 + ai * 128 + m * 16; const float s = rs[ai][m]; float a[8];
#pragma unroll
                for (int n = 0; n < 2; ++n)
#pragma unroll
                    for (int j = 0; j < 4; ++j) { float gate = acc[ai][0][m][n][j] * s + gb[4 * n + j], up = acc[ai][1][m][n][j] * s + ub[4 * n + j];
                        gate = fminf(gate, 7.f); up = fminf(fmaxf(up, -7.f), 7.f);
                        a[4 * n + j] = ASCALE * (up + 1.f) * gate * __builtin_amdgcn_rcpf(1.f + __builtin_amdgcn_exp2f(-1.702f * LOG2E * gate)); }
                v2u w; w.x = fp8x4(a[0], a[1], a[2], a[3]); w.y = fp8x4(a[4], a[5], a[6], a[7]);
                *(v2u*)(ACT + (size_t)(u.pm * 256 + r) * DFF + f0) = w; }
    }
};
struct EpiDown {
    bf16* YB; const float* rgate; const float* bdn;
    __device__ __forceinline__ void operator()(const pg8::f32x4 (&acc)[2][2][4][2], const pg8::Unit& u, int wr, int wc, int fr, int fq, const LAS unsigned* ids) const {
        asm volatile("" : "+v"(fr), "+v"(fq));
        const int r0 = wr * 64 + fr, col0 = u.pn * 256 + wc * 32 + 8 * fq;
        float gt[2][4];
#pragma unroll
        for (int ai = 0; ai < 2; ++ai)
#pragma unroll
            for (int m = 0; m < 4; ++m) gt[ai][m] = rgate[ids[r0 + ai * 128 + m * 16]];
        pg8::f32x4 bv[2][2];
#pragma unroll
        for (int bj = 0; bj < 2; ++bj)
#pragma unroll
            for (int n = 0; n < 2; ++n) bv[bj][n] = *(const pg8::f32x4*)(bdn + (size_t)u.e * D + col0 + bj * 128 + 4 * n);
#pragma unroll
        for (int ai = 0; ai < 2; ++ai)
#pragma unroll
            for (int m = 0; m < 4; ++m) { const int r = r0 + ai * 128 + m * 16; if (r < u.valid) { const float g = gt[ai][m]; bf16* yp = YB + (size_t)ids[r] * D + col0;
#pragma unroll
                for (int bj = 0; bj < 2; ++bj) { const pg8::f32x4 v0 = (acc[ai][bj][m][0] * (1.f / (WSCALE * ASCALE)) + bv[bj][0]) * g, v1 = (acc[ai][bj][m][1] * (1.f / (WSCALE * ASCALE)) + bv[bj][1]) * g;
                    v4u w; w.x = pg8::cvt_pk_bf16(v0[0], v0[1]); w.y = pg8::cvt_pk_bf16(v0[2], v0[3]); w.z = pg8::cvt_pk_bf16(v1[0], v1[1]); w.w = pg8::cvt_pk_bf16(v1[2], v1[3]);
                    *(v4u*)(yp + bj * 128) = w; } } }
    }
};
__device__ __forceinline__ void final_phase(Frame& F) {
    const int gw = F.vcu * NWAVES + F.wave, NGW = F.G * NWAVES;
    const bf16* YB = (const bf16*)(F.ws + WS_YB);
    for (int t = gw; t < T; t += NGW) {
        float v[16]; float ss = 0.f;
#pragma unroll
        for (int jj = 0; jj < 2; ++jj) { const int c = 512 * jj + 8 * F.lane;
            const f32x4 a = *(const f32x4*)(F.x + (size_t)t * D + c), b = *(const f32x4*)(F.x + (size_t)t * D + c + 4);
            const v4u y0 = *(const v4u*)((const bf16*)(F.ws + WS_Y) + (size_t)t * D + c);
            float* vv = v + 8 * jj; vv[0] = a.x + bflo(y0.x); vv[1] = a.y + bfhi(y0.x); vv[2] = a.z + bflo(y0.y); vv[3] = a.w + bfhi(y0.y); vv[4] = b.x + bflo(y0.z); vv[5] = b.y + bfhi(y0.z); vv[6] = b.z + bflo(y0.w); vv[7] = b.w + bfhi(y0.w);
#pragma unroll
            for (int k = 0; k < 4; ++k) { const v4u y = *(const v4u*)(YB + ((size_t)t * 4 + k) * D + c);
                vv[0] += bflo(y.x); vv[1] += bfhi(y.x); vv[2] += bflo(y.y); vv[3] += bfhi(y.y); vv[4] += bflo(y.z); vv[5] += bfhi(y.z); vv[6] += bflo(y.w); vv[7] += bfhi(y.w); } }
#pragma unroll
        for (int i = 0; i < 16; ++i) ss += v[i] * v[i];
        const float rstd = 1.f / sqrtf(wave_sum(ss) * (1.f / D) + EPS);
#pragma unroll
        for (int jj = 0; jj < 2; ++jj) { const int c = 512 * jj + 8 * F.lane; const f32x4 g0 = *(const f32x4*)(F.g_fin + c), g1 = *(const f32x4*)(F.g_fin + c + 4); const float* vv = v + 8 * jj;
            f32x4 o0, o1; o0.x = vv[0] * rstd * g0.x; o0.y = vv[1] * rstd * g0.y; o0.z = vv[2] * rstd * g0.z; o0.w = vv[3] * rstd * g0.w;
            o1.x = vv[4] * rstd * g1.x; o1.y = vv[5] * rstd * g1.y; o1.z = vv[6] * rstd * g1.z; o1.w = vv[7] * rstd * g1.w;
            *(f32x4*)(F.out + (size_t)t * D + c) = o0; *(f32x4*)(F.out + (size_t)t * D + c + 4) = o1; }
    }
}
struct Args { const float* in[17]; float* out; unsigned char* ws; int ph_lo, ph_hi, use_bar, pad; };
__global__ void __launch_bounds__(NWAVES * 64, 2) mk_fwd(Args args) {
    extern __shared__ __attribute__((aligned(16))) unsigned char lds[];
    Frame F;
    F.lds = (LAS unsigned char*)lds;
    F.MISC = (volatile LAS unsigned*)(F.lds + MISC_OFF);
    F.tid = threadIdx.x; F.lane = F.tid & 63; F.wave = __builtin_amdgcn_readfirstlane(F.tid >> 6);
    F.G = gridDim.x; { const int bx = blockIdx.x; F.vcu = (F.G % 8 == 0) ? (bx % 8) * (F.G / 8) + bx / 8 : bx; }
    F.ws = args.ws; F.out = args.out; F.ctl = (gu32*)(args.ws + WS_CTL);
    F.x = args.in[0]; F.mem = args.in[1]; F.g_attn = args.in[2]; F.g_mem = args.in[3]; F.w_in = args.in[4]; F.lamqk = args.in[5]; F.subg = args.in[6]; F.w_mkv = args.in[7];
    F.w_out = args.in[8]; F.g_ffn = args.in[9]; F.w_r = args.in[10]; F.b_r = args.in[11]; F.w_gu = args.in[12]; F.b_gu = args.in[13]; F.w_dn = args.in[14]; F.b_dn = args.in[15]; F.g_fin = args.in[16];
    for (int u = F.tid; u < (LDS_BYTES - LDSCTL_OFF) / 4; u += NWAVES * 64) ((LAS unsigned*)(F.lds + LDSCTL_OFF))[u] = 0u;
    __syncthreads();
    XcdBarrier bar; bar.bar = (unsigned*)(F.ctl + CW_BAR); bar.x = 0; bar.st = nullptr;
    if (args.use_bar) bar = xcd_barrier_post((unsigned*)(F.ctl + CW_BAR), F.MISC + 8);
    const int lo = args.ph_lo, hi = args.ph_hi;
#define IN(k) (lo <= (k) && (k) < hi)
#define SEAM(k) do { if (IN(k) && IN((k) + 1)) xcd_barrier(bar); } while (0)
    if (IN(0)) { p0_prologue(F); } SEAM(0);
    if (IN(1)) {
        pg8::Gemm g{(const void*)(F.ws + WS_XB), (const void*)(F.ws + WS_WIN), 2 * D}; pg8::StaticOrder S; S.init(T, DIN, 2 * D, F.G, (int)blockIdx.x);
        EpiInProj E{(bf16*)(F.ws + WS_P), (const float*)(F.ws + WS_RSTD1), (unsigned*)(F.ctl + CW_NRM)};
        pg8::gemm_phase<EpiInProj, pg8::StaticOrder, true, false, false>(F.lds + RING_OFF, (LAS unsigned*)(F.lds + IDB_OFF), g, S, E);
    } SEAM(1);
    if (IN(2)) { attn_phase(F, (char*)lds + RING_OFF); } SEAM(2);
    if (IN(3)) { dil_combine_phase(F); } SEAM(3);
    if (IN(4)) {
        pg8::Gemm g{(const void*)(F.ws + WS_MIX), (const void*)(F.ws + WS_WOUT), 2 * D}; pg8::StaticOrder S; S.init(T, D, 2 * D, F.G, (int)blockIdx.x);
        EpiY E{(bf16*)(F.ws + WS_Y)};
        pg8::gemm_phase<EpiY, pg8::StaticOrder, true, false, false>(F.lds + RING_OFF, (LAS unsigned*)(F.lds + IDB_OFF), g, S, E);
    } SEAM(4);
    if (IN(5)) { route_phase(F); } SEAM(5);
    if (IN(6)) {
        const int nmt = moe_build_table(F);
        pg8::Gemm g{(const void*)(F.ws + WS_X1B), (const void*)(F.ws + WS_WGU), D};
        MoeOrder S{(const LAS unsigned*)(F.lds + TBL_OFF), (const LAS unsigned*)(F.lds + LCNT_OFF), (const unsigned*)(F.ws + WS_LIST), nmt, F.G, F.vcu, 8, 4, D, (size_t)2 * DFF * D, false};
        EpiGU E{(unsigned char*)(F.ws + WS_ACT), (const float*)(F.ws + WS_RSTD2), F.b_gu};
        pg8::gemm_phase<EpiGU, MoeOrder, true, true, true, true>(F.lds + RING_OFF, (LAS unsigned*)(F.lds + IDB_OFF), g, S, E);
    } SEAM(6);
    if (IN(7)) {
        const int nmt = moe_build_table(F);
        pg8::Gemm g{(const void*)(F.ws + WS_ACT), (const void*)(F.ws + WS_WDN), DFF};
        MoeOrder S{(const LAS unsigned*)(F.lds + TBL_OFF), (const LAS unsigned*)(F.lds + LCNT_OFF), (const unsigned*)(F.ws + WS_LIST), nmt, F.G, F.vcu, 4, 8, DFF, (size_t)D * DFF, true};
        EpiDown E{(bf16*)(F.ws + WS_YB), (const float*)(F.ws + WS_RGATE), F.b_dn};
        pg8::gemm_phase<EpiDown, MoeOrder, true, true, true, true, true>(F.lds + RING_OFF, (LAS unsigned*)(F.lds + IDB_OFF), g, S, E);
    } SEAM(7);
    if (IN(8)) { final_phase(F); }
#undef IN
#undef SEAM
}

static void launch_phases(const Args& base, int lo, int hi, int use_bar, int grid, hipStream_t stream) {
    Args a = base; a.ph_lo = lo; a.ph_hi = hi; a.use_bar = use_bar;
    hipLaunchKernelGGL(mk_fwd, dim3(grid), dim3(NWAVES * 64), LDS_BYTES, stream, a);
}
extern "C" void kernel_launch(void* const* d_in, const int* in_sizes, int n_in, void* d_out, int out_size, void* d_ws, size_t ws_size, hipStream_t stream) {
    static int grid = 0;
    if (grid == 0) {
        if (n_in != 17 || in_sizes[0] != T * D || out_size != T * D || ws_size < (size_t)1000 * MiB) { fprintf(stderr, "kernel_launch: unexpected shapes / workspace (%d inputs, ws %zu)\n", n_in, ws_size); grid = -1; return; }
        int dev = 0, cus = 0, per_cu = 0;
        if (hipGetDevice(&dev) != hipSuccess || hipDeviceGetAttribute(&cus, hipDeviceAttributeMultiprocessorCount, dev) != hipSuccess) { grid = -1; return; }
        if (hipFuncSetAttribute((const void*)mk_fwd, hipFuncAttributeMaxDynamicSharedMemorySize, LDS_BYTES) != hipSuccess) { fprintf(stderr, "kernel_launch: hipFuncSetAttribute failed\n"); grid = -1; return; }
        if (hipOccupancyMaxActiveBlocksPerMultiprocessor(&per_cu, (const void*)mk_fwd, NWAVES * 64, LDS_BYTES) != hipSuccess || per_cu < 1) { fprintf(stderr, "kernel_launch: occupancy query says %d blocks per CU\n", per_cu); per_cu = 1; }
        (void)hipGetLastError();
        grid = cus;
        if (grid != 256) { fprintf(stderr, "kernel_launch: built for a 256-CU device (got %d)\n", cus); grid = -1; return; }
    }
    if (grid < 0) return;
    (void)hipMemsetAsync((char*)d_ws + WS_CTL, 0, CTL_ZERO_BYTES, stream);
    Args a{};
    for (int i = 0; i < 17; ++i) a.in[i] = (const float*)d_in[i];
    a.out = (float*)d_out; a.ws = (unsigned char*)d_ws;
    launch_phases(a, 0, 9, 1, grid, stream);
}
```

```cpp
#include <hip/hip_runtime.h>
#include <hip/hip_bf16.h>
#include <cstdint>
#include <cstdio>
#include <cmath>

constexpr int D = 1024, BATCH = 8, SEQ = 4096, T = BATCH * SEQ, DIN = 2560, NMEM = 256, NE = 32, DFF = 1024;
constexpr int C_DQ = 0, C_DK = 512, C_DV = 1024, C_LQ = 1536, C_LK = 1792, C_LV = 2048, C_MQ = 2304;
constexpr float EPS = 1e-5f;
constexpr int LCAP = T;
constexpr float QSCALE = 0.125f * 1.4426950408889634f;
constexpr float LOG2E = 1.4426950408889634f;
namespace pg8 {
#define PG8_LAS __attribute__((address_space(3)))
typedef unsigned short bf16_t;
typedef short bf16x8 __attribute__((ext_vector_type(8)));
typedef float f32x4 __attribute__((ext_vector_type(4)));
typedef unsigned u32x4 __attribute__((ext_vector_type(4)));
typedef unsigned u32x2 __attribute__((ext_vector_type(2)));
constexpr int BM = 256, BK = 64, HALF = 128, HTB = HALF * BK * 2  , STAGE_BYTES = 8 * HTB, NXCD = 8, WGM = 8;

__host__ __device__ __forceinline__ int lds_byte(int r, int c) { const int st = (r >> 4) * 2 + (c >> 5), rr = r & 15, cc = c & 31, ob = rr * 64 + cc * 2; return st * 1024 + (ob ^ (((ob >> 9) & 1) << 5)); }
__host__ __device__ __forceinline__ void stage_rc(int b, int& R, int& C) { const int st = b / 1024, sb = b % 1024, swz = sb ^ (((sb >> 9) & 1) << 5); R = (st >> 1) * 16 + swz / 64; C = (st & 1) * 32 + (swz % 64) / 2; }
__host__ __device__ __forceinline__ int perm32(int rho) { const int n = rho >> 4, i = rho & 15; return 8 * (i >> 2) + 4 * n + (i & 3); }

struct Unit { size_t aoff, boff; int pm, pn, e, valid, mt; };
struct Gemm { const void* A; const void* Bt; int RB; };
typedef int v8i __attribute__((ext_vector_type(8)));

struct StaticOrder {
    int nM, nN, nwg, G, c, RB;
    __device__ void init(int M, int N, int RB_, int G_, int c_) { nM = M / BM; nN = N / BM; nwg = nM * nN; G = G_; c = c_; RB = RB_; }
    __device__ bool next(int i, Unit& u) const {
        const long L = (long)i * G + c; if (L >= nwg) return false;
        int wgid = (int)L; { const int q = nwg / NXCD, r = nwg % NXCD, xcd = wgid % NXCD, off = wgid / NXCD; wgid = (xcd < r ? xcd * (q + 1) : r * (q + 1) + (xcd - r) * q) + off; }
        const int nig = WGM * nN, gid = wgid / nig, fm = gid * WGM, gsz = (nM - fm) < WGM ? (nM - fm) : WGM;
        u.pm = fm + ((wgid % nig) % gsz); u.pn = (wgid % nig) / gsz; u.e = 0; u.valid = 256; u.mt = 0;
        u.aoff = (size_t)u.pm * (size_t)(BM * RB); u.boff = (size_t)u.pn * (size_t)(BM * RB); return true;
    }
    __device__ __forceinline__ const unsigned* id_src(const Unit&, int) const { return nullptr; }
};

__device__ __forceinline__ unsigned cvt_pk_bf16(float lo, float hi) { unsigned r; asm volatile("v_cvt_pk_bf16_f32 %0, %1, %2" : "=v"(r) : "v"(lo), "v"(hi)); return r; }

template <class Epi, class Sched, bool ALIGN_EPI, bool GATHER, bool IDS, bool FP8 = false, bool LINEAR = false>
__device__ __forceinline__ void gemm_phase(PG8_LAS unsigned char* lds, PG8_LAS unsigned* idb, const Gemm g, const Sched& S, const Epi& E) {
    const int tid = threadIdx.x, wid = __builtin_amdgcn_readfirstlane(tid >> 6), lane = tid & 63, wr = wid >> 2, wc = wid & 3, fr = lane & 15, fq = lane >> 4;
    const int RB = g.RB; int nt = RB / (BK * 2); asm volatile("" : "+s"(nt));
    unsigned voffA[2], voffB[2]; int RA[2], CA[2];
#pragma unroll
    for (int i = 0; i < 2; ++i) { int R, C; stage_rc(tid * 16 + i * 8192, R, C); const int Rb = (R & ~31) + perm32(R & 31); RA[i] = R; CA[i] = C;
        voffA[i] = (unsigned)(R * RB + C * 2); voffB[i] = (unsigned)(Rb * RB + C * 2); }
    const size_t kstep = (size_t)(BK * 2);
    const size_t hstep = (size_t)HALF * RB;
    const unsigned ldsw = (unsigned)wid * 1024u;
    const int aoff = lds_byte(wr * 64 + fr, fq * 8), boff = lds_byte(wc * 32 + fr, fq * 8);
#define PG8_SA(b, h) (((b) * 2 + (h)) * HTB)
#define PG8_SB(b, h) ((4 + (b) * 2 + (h)) * HTB)
#define PG8_STAGE(bufoff, gbase, voff) do { _Pragma("unroll") for (int _i = 0; _i < 2; ++_i) \
        __builtin_amdgcn_global_load_lds((const unsigned*)((const char*)(gbase) + (voff)[_i]), (PG8_LAS unsigned*)(lds + (bufoff) + ldsw + _i * 8192), 16, 0, 0); } while (0)
#define PG8_STAGE_A(bufoff, pbase, gbase, h, gv) do { if constexpr (GATHER) { PG8_STAGE(bufoff, gbase, gv[h]); } else { PG8_STAGE(bufoff, (pbase) + (h) * hstep, voffA); } } while (0)
#define PG8_LD32(p0_, p1_) __builtin_bit_cast(v8i, __builtin_shufflevector(*(const PG8_LAS u32x4*)(p0_), *(const PG8_LAS u32x4*)(p1_), 0, 1, 2, 3, 4, 5, 6, 7))
#define PG8_LDA(dst, b, h) do { if constexpr (FP8) { _Pragma("unroll") for (int m = 0; m < 4; ++m) dst##8[m] = PG8_LD32(lds + PG8_SA(b, h) + aoff + m * 2048, lds + PG8_SA(b, h) + aoff + m * 2048 + 1024); } \
        else { _Pragma("unroll") for (int m = 0; m < 4; ++m) _Pragma("unroll") for (int k = 0; k < 2; ++k) dst[m][k] = *(const PG8_LAS bf16x8*)(lds + PG8_SA(b, h) + aoff + m * 2048 + k * 1024); } } while (0)
#define PG8_LDB(dst, b, h) do { if constexpr (FP8) { _Pragma("unroll") for (int n = 0; n < 2; ++n) dst##8[n] = PG8_LD32(lds + PG8_SB(b, h) + boff + n * 2048, lds + PG8_SB(b, h) + boff + n * 2048 + 1024); } \
        else { _Pragma("unroll") for (int n = 0; n < 2; ++n) _Pragma("unroll") for (int k = 0; k < 2; ++k) dst[n][k] = *(const PG8_LAS bf16x8*)(lds + PG8_SB(b, h) + boff + n * 2048 + k * 1024); } } while (0)
#define PG8_MMA(ai, bj, At, Bt) do { __builtin_amdgcn_s_setprio(1); if constexpr (FP8) { _Pragma("unroll") for (int m = 0; m < 4; ++m) _Pragma("unroll") for (int n = 0; n < 2; ++n) \
        acc[ai][bj][m][n] = __builtin_amdgcn_mfma_scale_f32_16x16x128_f8f6f4(Bt##8[n], At##8[m], acc[ai][bj][m][n], 0, 0, 0, 0x7f7f7f7f, 0, 0x7f7f7f7f); } \
        else { _Pragma("unroll") for (int m = 0; m < 4; ++m) _Pragma("unroll") for (int n = 0; n < 2; ++n) _Pragma("unroll") for (int k = 0; k < 2; ++k) \
        acc[ai][bj][m][n] = __builtin_amdgcn_mfma_f32_16x16x32_bf16(Bt[n][k], At[m][k], acc[ai][bj][m][n], 0, 0, 0); } __builtin_amdgcn_s_setprio(0); } while (0)
#define PG8_WAIT_V(n) asm volatile("s_waitcnt vmcnt(" #n ")" ::: "memory")
#define PG8_WAIT_L(n) asm volatile("s_waitcnt lgkmcnt(" #n ")" ::: "memory")
#define PG8_BAR __builtin_amdgcn_s_barrier()
#define PG8_SCHED __builtin_amdgcn_sched_barrier(0)
#define PG8_IDS_DMA(u, s) do { if (wid < 4) __builtin_amdgcn_global_load_lds(S.id_src(u, tid), (PG8_LAS unsigned*)(idb + (s) * 256 + wid * 64), 4, 0, 0); } while (0)
#define PG8_GV(dst, s, un) do { _Pragma("unroll") for (int _h = 0; _h < 2; ++_h) _Pragma("unroll") for (int _i = 0; _i < 2; ++_i) \
        dst[_h][_i] = (LINEAR ? (unsigned)((un).pm * 256 + _h * 128 + RA[_i]) : (idb[(s) * 256 + _h * 128 + RA[_i]] >> 2)) * (unsigned)RB + (unsigned)(CA[_i] * 2); } while (0)
    Unit cur, nxt; int ui = 0, us = 0;
    if (!S.next(0, cur)) return;
    f32x4 acc[2][2][4][2];
#pragma unroll
    for (int a = 0; a < 2; ++a)
#pragma unroll
        for (int b = 0; b < 2; ++b)
#pragma unroll
            for (int m = 0; m < 4; ++m)
#pragma unroll
                for (int n = 0; n < 2; ++n) acc[a][b][m][n] = (f32x4){0.f, 0.f, 0.f, 0.f};
    bf16x8 At[4][2], B0[2][2], B1[2][2]; v8i At8[4], B08[2], B18[2];
    unsigned cv[2][2] = {{0u, 0u}, {0u, 0u}};
    const char* A0 = (const char*)g.A;
    const char* cA = A0 + (GATHER ? (size_t)0 : cur.aoff); const char* cB = (const char*)g.Bt + cur.boff;
    if constexpr (IDS) {
        PG8_IDS_DMA(cur, 0); PG8_WAIT_V(0); PG8_BAR;
    }
    if constexpr (GATHER) { PG8_GV(cv, 0, cur); }
    PG8_STAGE(PG8_SB(0, 0), cB, voffB); PG8_STAGE(PG8_SB(0, 1), cB + hstep, voffB); PG8_STAGE_A(PG8_SA(0, 0), cA, A0, 0, cv); PG8_STAGE_A(PG8_SA(0, 1), cA, A0, 1, cv);
    if (wr == 1) PG8_BAR;
    PG8_WAIT_V(2); PG8_BAR;
    PG8_STAGE(PG8_SB(1, 0), cB + kstep, voffB); PG8_STAGE_A(PG8_SA(1, 0), cA + kstep, A0 + kstep, 0, cv); PG8_STAGE(PG8_SB(1, 1), cB + hstep + kstep, voffB);
    PG8_WAIT_V(6); PG8_BAR;
    for (;;) {
        const bool has_next = S.next(ui + 1, nxt);
        const int ns = (us == 2) ? 0 : us + 1;
        if constexpr (IDS) { if (has_next) PG8_IDS_DMA(nxt, ns); }
        const char* nA = has_next ? A0 + (GATHER ? (size_t)0 : nxt.aoff) : cA; const char* nB = has_next ? (const char*)g.Bt + nxt.boff : cB;
#pragma nounroll
        for (int t = 0; t < nt; t += 2) {
            int lastv = (t == nt - 2) ? 1 : 0; asm volatile("" : "+v"(lastv)); const bool last = __builtin_amdgcn_readfirstlane(lastv) != 0;
            const char* a1 = cA + (size_t)(t + 1) * kstep;
            const char* a2 = last ? nA : cA + (size_t)(t + 2) * kstep; const char* b2 = last ? nB : cB + (size_t)(t + 2) * kstep;
            const char* a3 = a2 + kstep; const char* b3 = b2 + kstep;
            PG8_LDB(B0, 0, 0); PG8_LDB(B1, 0, 1); PG8_SCHED; PG8_LDA(At, 0, 0); PG8_STAGE_A(PG8_SA(1, 1), a1, a1, 1, cv);
            if constexpr (GATHER) { if (last && has_next) { PG8_GV(cv, ns, nxt); } }
            PG8_WAIT_V(8); PG8_WAIT_L(0); PG8_BAR; PG8_MMA(0, 0, At, B0); PG8_MMA(0, 1, At, B1); PG8_BAR; PG8_SCHED;
            PG8_LDA(At, 0, 1); PG8_STAGE(PG8_SB(0, 0), b2, voffB); PG8_STAGE(PG8_SB(0, 1), b2 + hstep, voffB); PG8_STAGE_A(PG8_SA(0, 0), a2, a2, 0, cv);
            PG8_WAIT_V(8); PG8_WAIT_L(0); PG8_BAR; PG8_MMA(1, 0, At, B0); PG8_MMA(1, 1, At, B1); PG8_BAR; PG8_SCHED;
            PG8_LDB(B0, 1, 0); PG8_LDB(B1, 1, 1); PG8_SCHED; PG8_LDA(At, 1, 0); PG8_STAGE_A(PG8_SA(0, 1), a2, a2, 1, cv);
            PG8_WAIT_V(8); PG8_WAIT_L(0); PG8_BAR; PG8_MMA(0, 0, At, B0); PG8_MMA(0, 1, At, B1); PG8_BAR; PG8_SCHED;
            PG8_LDA(At, 1, 1); PG8_STAGE(PG8_SB(1, 0), b3, voffB); PG8_STAGE(PG8_SB(1, 1), b3 + hstep, voffB); PG8_STAGE_A(PG8_SA(1, 0), a3, a3, 0, cv);
            PG8_WAIT_V(8); PG8_WAIT_L(0); PG8_BAR; PG8_MMA(1, 0, At, B0); PG8_MMA(1, 1, At, B1); PG8_BAR; PG8_SCHED;
        }
        if constexpr (ALIGN_EPI) { if (wr == 0) PG8_BAR; }
        PG8_SCHED;
        E(acc, cur, wr, wc, fr, fq, (const PG8_LAS unsigned*)(idb + us * 256));
        PG8_SCHED;
        if (!has_next) break;
#pragma unroll
        for (int a = 0; a < 2; ++a)
#pragma unroll
            for (int b = 0; b < 2; ++b)
#pragma unroll
                for (int m = 0; m < 4; ++m)
#pragma unroll
                    for (int n = 0; n < 2; ++n) acc[a][b][m][n] = (f32x4){0.f, 0.f, 0.f, 0.f};
        cur = nxt; cA = nA; cB = nB; ++ui; us = ns;
        if constexpr (ALIGN_EPI) { if (wr == 1) PG8_BAR; }
    }
    PG8_WAIT_V(0);
    if constexpr (!ALIGN_EPI) { if (wr == 0) PG8_BAR; }
    PG8_BAR;
#undef PG8_SA
#undef PG8_SB
#undef PG8_STAGE
#undef PG8_STAGE_A
#undef PG8_LDA
#undef PG8_LDB
#undef PG8_MMA
#undef PG8_LD32
#undef PG8_WAIT_V
#undef PG8_WAIT_L
#undef PG8_BAR
#undef PG8_SCHED
#undef PG8_IDS_DMA
#undef PG8_GV
}
}
namespace attn_body {
using bf16=__hip_bfloat16;
using bf16x8=__attribute__((ext_vector_type(8)))short;
using s16x4=__attribute__((ext_vector_type(4)))short;
using f32x16=__attribute__((ext_vector_type(16)))float;
using u32x4=__attribute__((ext_vector_type(4)))unsigned;
constexpr int D=64;
constexpr int NW=8,QBLK=32,QB=QBLK*NW,KVBLK=64;
struct UnitP { const bf16* Q; const bf16* K; const bf16* V; bf16* O; long qp, kp, op; int q0, t0, NT; float slope2; float* lse; int lse_stride; };
__device__ __forceinline__ int crow(int r,int hi){return (r&3)+8*(r>>2)+4*hi;}
#define SBAR() __builtin_amdgcn_sched_barrier(0)
template<bool CAUSAL,bool WINDOW> __device__ __forceinline__ void cmask(f32x16&p0,f32x16&p1,int jb,int qrel,int hi){
  const float NEG=-INFINITY; int kb=64*jb+4*hi;
  #pragma unroll
  for(int r=0;r<16;++r){int kv=kb+(r&3)+8*(r>>2);
    if(CAUSAL){ if(kv>qrel)p0[r]=NEG; if(kv+32>qrel)p1[r]=NEG; }
    if(WINDOW){ if(kv<qrel-128)p0[r]=NEG; if(kv+32<qrel-128)p1[r]=NEG; } }
}
__device__ __forceinline__ unsigned bfr(float x){ typedef float f2_ __attribute__((ext_vector_type(2))); typedef __bf16 b2_ __attribute__((ext_vector_type(2))); f2_ v={x,0.f}; b2_ b=__builtin_convertvector(v,b2_); return __builtin_bit_cast(unsigned,b)&0xffffu; }
__device__ __forceinline__ float bfv(unsigned b){ return __builtin_bit_cast(float,b<<16); }

constexpr int NSLOT=3, SLOTB=8192;
constexpr int LDS_K=0, LDS_V=NSLOT*SLOTB, LDS_WS=2*NSLOT*SLOTB, LDS_OST=LDS_WS+NW*64*4, LDS_BYTES=LDS_OST+NW*4096;
__device__ __forceinline__ void glds16(const void*gsrc,unsigned lds_dst){unsigned keep;
  asm volatile("s_mov_b32 %0, m0\n\ts_mov_b32 m0, %2\n\ts_nop 0\n\tglobal_load_lds_dwordx4 %1, off\n\ts_mov_b32 m0, %0":"=&s"(keep):"v"(gsrc),"s"(lds_dst):"memory");}
__device__ __forceinline__ float max3f(float a,float b,float c){float r;asm("v_max3_f32 %0, %1, %2, %3":"=v"(r):"v"(a),"v"(b),"v"(c));return r;}
__device__ __forceinline__ float max2f(float a,float b){float r;asm("v_max_f32_e32 %0, %1, %2":"=v"(r):"v"(a),"v"(b));return r;}
__device__ __forceinline__ float fadd_s(float a,float b){float r;asm("v_add_f32_e32 %0, %1, %2":"=v"(r):"v"(a),"v"(b));return r;}
__device__ __forceinline__ float fsub_s(float a,float b){float r;asm("v_sub_f32_e32 %0, %1, %2":"=v"(r):"v"(a),"v"(b));return r;}
typedef float f32x2_t __attribute__((ext_vector_type(2))); typedef __bf16 bf16x2_t __attribute__((ext_vector_type(2)));
__device__ __forceinline__ unsigned cvtpk_s(float lo,float hi){f32x2_t v={lo,hi};bf16x2_t b=__builtin_convertvector(v,bf16x2_t);return __builtin_bit_cast(unsigned,b);}
#define WAIT_BAR(N) asm volatile("s_waitcnt vmcnt(" #N ") lgkmcnt(0)\n\ts_barrier":::"memory")

__device__ __forceinline__ void qkt(f32x16&p0,f32x16&p1,const char*Kslot,const bf16x8*qr,bf16x8 kx0,bf16x8 kx1,bf16x8 qx,int r32,int hi){
  const char*kb=Kslot+hi*1024+r32*16;
  #pragma unroll
  for(int d0=0;d0<4;++d0){
    const bf16x8 b0=*reinterpret_cast<const bf16x8*>(kb+d0*2048);
    const bf16x8 b1=*reinterpret_cast<const bf16x8*>(kb+d0*2048+512);
    if(d0==0){p0=__builtin_amdgcn_mfma_f32_32x32x16_bf16(b0,qr[0],f32x16{},0,0,0);p1=__builtin_amdgcn_mfma_f32_32x32x16_bf16(b1,qr[0],f32x16{},0,0,0);}
    else{p0=__builtin_amdgcn_mfma_f32_32x32x16_bf16(b0,qr[d0],p0,0,0,0);p1=__builtin_amdgcn_mfma_f32_32x32x16_bf16(b1,qr[d0],p1,0,0,0);}}
  p0=__builtin_amdgcn_mfma_f32_32x32x16_bf16(kx0,qx,p0,0,0,0);p1=__builtin_amdgcn_mfma_f32_32x32x16_bf16(kx1,qx,p1,0,0,0);
}
typedef __attribute__((address_space(3))) const char* lds_cptr;
typedef short v4i16_t __attribute__((ext_vector_type(4)));
__device__ __forceinline__ void kload8(bf16x8*kf,lds_cptr kp){
  kf[0]=*(const __attribute__((address_space(3))) bf16x8*)(kp);      kf[1]=*(const __attribute__((address_space(3))) bf16x8*)(kp+512);
  kf[2]=*(const __attribute__((address_space(3))) bf16x8*)(kp+2048); kf[3]=*(const __attribute__((address_space(3))) bf16x8*)(kp+2560);
  kf[4]=*(const __attribute__((address_space(3))) bf16x8*)(kp+4096); kf[5]=*(const __attribute__((address_space(3))) bf16x8*)(kp+4608);
  kf[6]=*(const __attribute__((address_space(3))) bf16x8*)(kp+6144); kf[7]=*(const __attribute__((address_space(3))) bf16x8*)(kp+6656);
}
__device__ __forceinline__ void kload2(bf16x8*kf,lds_cptr kp,int j){ kf[2*j]=*(const __attribute__((address_space(3))) bf16x8*)(kp+j*2048); kf[2*j+1]=*(const __attribute__((address_space(3))) bf16x8*)(kp+j*2048+512); }
__device__ __forceinline__ s16x4 vtr(lds_cptr p){ return __builtin_bit_cast(s16x4,__builtin_amdgcn_ds_read_tr16_b64_v4i16((__attribute__((address_space(3))) v4i16_t*)p)); }
__device__ __forceinline__ float rowmax(const f32x16&p0,const f32x16&p1){
  float a=max3f(p0[0],p0[1],p1[0]),b=max3f(p0[2],p0[3],p1[1]);a=max3f(a,p1[2],p1[3]);
  #pragma unroll
  for(int r=4;r<16;r+=4){a=max3f(a,p0[r],p0[r+1]);b=max3f(b,p0[r+2],p0[r+3]);a=max3f(a,p1[r],p1[r+1]);b=max3f(b,p1[r+2],p1[r+3]);}
  const float m=max2f(a,b);
  auto rr=__builtin_amdgcn_permlane32_swap(__float_as_uint(m),__float_as_uint(m),false,false);
  return max2f(__uint_as_float(rr[0]),__uint_as_float(rr[1]));
}
__device__ __forceinline__ void pv(f32x16*o,int vb,bf16x8 pa0,bf16x8 pa1,bf16x8 pa2,bf16x8 pa3){
  #pragma unroll
  for(int d0=0;d0<2;++d0){s16x4 lo[4],hi[4];
    #pragma unroll
    for(int ks=0;ks<4;++ks){
      asm volatile("ds_read_b64_tr_b16 %0,%1 offset:%c2":"=&v"(lo[ks]):"v"(vb),"i"(d0*4096+ks*1024):"memory");
      asm volatile("ds_read_b64_tr_b16 %0,%1 offset:%c2":"=&v"(hi[ks]):"v"(vb),"i"(d0*4096+ks*1024+512):"memory");}
    asm volatile("s_waitcnt lgkmcnt(0)":::"memory");SBAR();
    #define PK(k) (bf16x8){lo[k][0],lo[k][1],lo[k][2],lo[k][3],hi[k][0],hi[k][1],hi[k][2],hi[k][3]}
    o[d0]=__builtin_amdgcn_mfma_f32_32x32x16_bf16(pa0,PK(0),o[d0],0,0,0);
    o[d0]=__builtin_amdgcn_mfma_f32_32x32x16_bf16(pa1,PK(1),o[d0],0,0,0);
    o[d0]=__builtin_amdgcn_mfma_f32_32x32x16_bf16(pa2,PK(2),o[d0],0,0,0);
    o[d0]=__builtin_amdgcn_mfma_f32_32x32x16_bf16(pa3,PK(3),o[d0],0,0,0);
    #undef PK
  }
}

#ifndef ATTN_STORE16
#define ATTN_STORE16(p,v) (*(u32x4*)(p)=(v))
#endif
template<int THRL,bool CAUSAL,bool WINDOW,bool ALIBI,bool LSE> __device__ __forceinline__ void attn_unit(const UnitP&U,char*shm){
  int tid=threadIdx.x; asm volatile("":"+v"(tid));
  const int lane=tid&63,r32=lane&31,hi=lane>>5; const int wid=__builtin_amdgcn_readfirstlane(tid>>6);
  const int q0=U.q0; const long qp=U.qp,kp=U.kp,op=U.op; const float slope2=U.slope2;
  const bf16*Qw=U.Q+(long)(q0+wid*QBLK)*qp;
  const bf16*Kh=U.K+(long)U.t0*KVBLK*kp,*Vh=U.V+(long)U.t0*KVBLK*kp;
  const unsigned lds0=(unsigned)(uintptr_t)shm;
  float*wsf=(float*)(shm+LDS_WS)+wid*64;
  const bf16*ksrc=Kh+(long)lane*kp+wid*8;
  const bf16*vsrc=Vh+(long)(16*(wid&3)+(lane>>2))*kp+(wid>>2)*32+(lane&3)*8;
  const unsigned kdst=lds0+LDS_K+wid*1024, vdst=lds0+LDS_V+wid*1024;
  #define DMA_K(t,slot) glds16(ksrc+(long)(t)*KVBLK*kp,(unsigned)__builtin_amdgcn_readfirstlane(kdst+(slot)))
  #define DMA_V(t,slot) glds16(vsrc+(long)(t)*KVBLK*kp,(unsigned)__builtin_amdgcn_readfirstlane(vdst+(slot)))
  const int vb0=(int)(lds0+LDS_V)+((lane>>4)&1)*32+(lane&3)*8+(4*hi+((lane&15)>>2))*64;
  const char*Kbase=shm+LDS_K; bf16x8 kf[8];
  const lds_cptr shm3=(lds_cptr)shm; const lds_cptr kp0=shm3+LDS_K+hi*1024+r32*16; const lds_cptr vp0=shm3+LDS_V+((lane>>4)&1)*32+(lane&3)*8+(4*hi+((lane&15)>>2))*64;
  const int NT=U.NT;
  DMA_K(0,0);DMA_V(0,0);DMA_K(1,SLOTB);
  bf16x8 qr[4];
  #pragma unroll
  for(int d0=0;d0<4;++d0)qr[d0]=*reinterpret_cast<const bf16x8*>(&Qw[(long)r32*qp+d0*16+hi*8]);
  float mhat=0.f,l_reg=0.f;f32x16 o[2];o[0]=f32x16{};o[1]=f32x16{};
  const int qrel=wid*QBLK+r32;
  #define CMASK(P0,P1,t) do{int jb_=(t)-(NT-4); if(WINDOW||(CAUSAL&&jb_>=0))cmask<CAUSAL,WINDOW>(P0,P1,jb_,qrel,hi);}while(0)
  bf16x8 kx0,kx1,qx;
  { const float k0_=ALIBI?slope2*(float)r32:0.f, k1_=ALIBI?slope2*(float)(r32+32):0.f; const unsigned h0=bfr(k0_),l0=bfr(k0_-bfv(h0)),h1=bfr(k1_),l1=bfr(k1_-bfv(h1));
    u32x4 a={0x3f803f80u,0x3f80u|(h0<<16),l0,0u}, b={0x3f803f80u,0x3f80u|(h1<<16),l1,0u}; if(hi){a=u32x4{0u,0u,0u,0u};b=a;} kx0=__builtin_bit_cast(bf16x8,a); kx1=__builtin_bit_cast(bf16x8,b); }
  #define QX_SET(t) do{ const float nb_=ALIBI?__builtin_fmaf(slope2,(float)(64*((t)-(NT-4))-qrel),-mhat):-mhat; const unsigned a_=bfr(nb_); const float r1_=nb_-bfv(a_); const unsigned b_=bfr(r1_); const unsigned c_=bfr(r1_-bfv(b_)); \
    u32x4 q_={a_|(b_<<16),c_|0x3f800000u,0x3f80u,0u}; if(hi)q_=u32x4{0u,0u,0u,0u}; qx=__builtin_bit_cast(bf16x8,q_); asm volatile("":"+v"(qx)); }while(0)
  bool resc=false;
  #define START(P0,P1) do{ const float rm=rowmax(P0,P1); resc=false; \
    { const float dl=(rm==-INFINITY)?0.f:rm; mhat=fadd_s(mhat,dl); \
      _Pragma("unroll") for(int r=0;r<16;++r){P0[r]=fsub_s(P0[r],dl);P1[r]=fsub_s(P1[r],dl);} } \
    _Pragma("unroll") for(int r=0;r<16;++r)P0[r]=__builtin_amdgcn_exp2f(P0[r]); }while(0)
  #define RESC() do{ if(resc){ asm volatile("s_waitcnt lgkmcnt(0)":::"memory"); \
      _Pragma("unroll") for(int d_=0;d_<2;++d_) _Pragma("unroll") for(int r=0;r<16;++r)o[d_][r]*=wsf[crow(r,hi)]; } }while(0)
  f32x16 pA0,pA1,pB0,pB1;
  int sl_prev=0,sl_cur=0,sl_next=SLOTB;
  #define ROT() do{sl_prev=sl_cur;sl_cur=sl_next;sl_next=(sl_next==(NSLOT-1)*SLOTB)?0:sl_next+SLOTB;}while(0)
  DMA_K(2,2*SLOTB);
  WAIT_BAR(3);
  QX_SET(0);
  qkt(pA0,pA1,Kbase,qr,kx0,kx1,qx,r32,hi);asm volatile("s_nop 15\n\ts_nop 7":"+v"(pA0),"+v"(pA1));CMASK(pA0,pA1,0);
  START(pA0,pA1);
  _Pragma("unroll") for(int r=0;r<16;++r)pA1[r]=__builtin_amdgcn_exp2f(pA1[r]);
  WAIT_BAR(0);
  DMA_K(3,0);DMA_V(1,SLOTB);
  ROT();
  kload8(kf,kp0+sl_cur);
  WAIT_BAR(2);
  s16x4 vlo[8],vhi[8]; u32x4 pw0,pw1,pw2,pw3;
  #define PKW(P,B) cvtpk_s(P[B],P[B+1])
  #define PAF(k) __builtin_bit_cast(bf16x8,pw##k)
  #define VFR(i) (bf16x8){vlo[i][0],vlo[i][1],vlo[i][2],vlo[i][3],vhi[i][0],vhi[i][1],vhi[i][2],vhi[i][3]}
  #define PIN(x) asm volatile("":"+v"(x))
  #define MX3(a,b,c) __builtin_fmaxf(__builtin_fmaxf((a),(b)),(c))
  #define GAPA(MF,A0,A1,A2,A3,W0,W1,PW) do{ MF; sacc+=A0; sacc+=A1; sacc+=A2; sacc+=A3; PIN(sacc); W0; W1; PIN(PW); SBAR(); }while(0)
  #define EX(v) __builtin_amdgcn_exp2f(v)
  #define GAPB(MF,X,B) do{ MF; X[B]=EX(X[B]); X[B+1]=EX(X[B+1]); X[B+2]=EX(X[B+2]); X[B+3]=EX(X[B+3]); PIN(X); SBAR(); }while(0)
  #define VRD(i) do{ vlo[i]=vtr(vp_+(((i)>>2)*4096+((i)&3)*1024)); vhi[i]=vtr(vp_+(((i)>>2)*4096+((i)&3)*1024+512)); }while(0)
  #define KRD(G,j) do{ if(G){ kload2(kf,kp0+sl_next,j); SBAR(); } }while(0)
  #define STEP(C0,C1,P0,P1,t,GK,GV,GL) do{ SBAR(); QX_SET(t); SBAR(); \
    const lds_cptr vp_=vp0+sl_prev; \
    VRD(0); SBAR(); float sacc=(P0[0]+P0[1]); \
    GAPA(C0=__builtin_amdgcn_mfma_f32_32x32x16_bf16(kf[0],qr[0],f32x16{},0,0,0), P0[2],P0[3],P0[4],P0[5],     pw0[0]=PKW(P0,0), pw0[1]=PKW(P0,2), pw0); \
    VRD(4); SBAR(); GAPA(C1=__builtin_amdgcn_mfma_f32_32x32x16_bf16(kf[1],qr[0],f32x16{},0,0,0), P0[6],P0[7],P0[8],P0[9],     pw0[2]=PKW(P0,4), pw0[3]=PKW(P0,6), pw0); \
    VRD(1); SBAR(); GAPA(C0=__builtin_amdgcn_mfma_f32_32x32x16_bf16(kf[2],qr[1],C0,0,0,0),   P0[10],P0[11],P0[12],P0[13], pw1[0]=PKW(P0,8), pw1[1]=PKW(P0,10), pw1); \
    VRD(5); SBAR(); GAPA(C1=__builtin_amdgcn_mfma_f32_32x32x16_bf16(kf[3],qr[1],C1,0,0,0),   P0[14],P0[15],P1[0],P1[1],   pw1[2]=PKW(P0,12),pw1[3]=PKW(P0,14), pw1); \
    VRD(2); SBAR(); GAPA(C0=__builtin_amdgcn_mfma_f32_32x32x16_bf16(kf[4],qr[2],C0,0,0,0),   P1[2],P1[3],P1[4],P1[5],     pw2[0]=PKW(P1,0), pw2[1]=PKW(P1,2), pw2); \
    VRD(6); SBAR(); GAPA(C1=__builtin_amdgcn_mfma_f32_32x32x16_bf16(kf[5],qr[2],C1,0,0,0),   P1[6],P1[7],P1[8],P1[9],     pw2[2]=PKW(P1,4), pw2[3]=PKW(P1,6), pw2); \
    VRD(3); SBAR(); GAPA(C0=__builtin_amdgcn_mfma_f32_32x32x16_bf16(kf[6],qr[3],C0,0,0,0),   P1[10],P1[11],P1[12],P1[13], pw3[0]=PKW(P1,8), pw3[1]=PKW(P1,10), pw3); \
    VRD(7); SBAR(); GAPA(C1=__builtin_amdgcn_mfma_f32_32x32x16_bf16(kf[7],qr[3],C1,0,0,0),   P1[14],P1[15],0.f,0.f,       pw3[2]=PKW(P1,12),pw3[3]=PKW(P1,14), pw3); \
    C0=__builtin_amdgcn_mfma_f32_32x32x16_bf16(kx0,qx,C0,0,0,0); C1=__builtin_amdgcn_mfma_f32_32x32x16_bf16(kx1,qx,C1,0,0,0); SBAR(); \
    l_reg+=sacc; \
    if(GK){DMA_K((t)+3,sl_cur);} if(GV){DMA_V((t)+1,sl_next);} \
    CMASK(C0,C1,t); \
    { float a=MX3(C0[0],C0[1],C1[0]),b=MX3(C0[2],C0[3],C1[1]); a=MX3(a,C1[2],C1[3]); \
      _Pragma("unroll") for(int r=4;r<16;r+=4){a=MX3(a,C0[r],C0[r+1]);b=MX3(b,C0[r+2],C0[r+3]);a=MX3(a,C1[r],C1[r+1]);b=MX3(b,C1[r+2],C1[r+3]);} \
      float rm=__builtin_fmaxf(a,b); { auto rr=__builtin_amdgcn_permlane32_swap(__float_as_uint(rm),__float_as_uint(rm),false,false); rm=__builtin_fmaxf(__uint_as_float(rr[0]),__uint_as_float(rr[1])); } \
      resc=false; \
      if(__builtin_expect(__any(rm>(float)THRL),0)){ const float dl=__builtin_fmaxf(rm,0.f); mhat+=dl; \
        _Pragma("unroll") for(int r=0;r<16;++r){C0[r]-=dl;C1[r]-=dl;} \
        const float f=__builtin_amdgcn_exp2f(-dl); l_reg*=f; if(hi==0)wsf[r32]=f; resc=true; } } \
    SBAR(); \
    GAPB(o[0]=__builtin_amdgcn_mfma_f32_32x32x16_bf16(PAF(0),VFR(0),o[0],0,0,0), C0,0); \
    GAPB(o[1]=__builtin_amdgcn_mfma_f32_32x32x16_bf16(PAF(0),VFR(4),o[1],0,0,0), C0,4); \
    KRD(GL,0); GAPB(o[0]=__builtin_amdgcn_mfma_f32_32x32x16_bf16(PAF(1),VFR(1),o[0],0,0,0), C0,8); \
    KRD(GL,1); GAPB(o[1]=__builtin_amdgcn_mfma_f32_32x32x16_bf16(PAF(1),VFR(5),o[1],0,0,0), C0,12); \
    KRD(GL,2); GAPB(o[0]=__builtin_amdgcn_mfma_f32_32x32x16_bf16(PAF(2),VFR(2),o[0],0,0,0), C1,0); \
    KRD(GL,3); GAPB(o[1]=__builtin_amdgcn_mfma_f32_32x32x16_bf16(PAF(2),VFR(6),o[1],0,0,0), C1,4); \
    GAPB(o[0]=__builtin_amdgcn_mfma_f32_32x32x16_bf16(PAF(3),VFR(3),o[0],0,0,0), C1,8); \
    GAPB(o[1]=__builtin_amdgcn_mfma_f32_32x32x16_bf16(PAF(3),VFR(7),o[1],0,0,0), C1,12); \
    }while(0)
  int t=1;
  #undef CMASK
  #define CMASK(P0,P1,t) do{}while(0)
  for(;t+5<NT;t+=2){
    STEP(pB0,pB1,pA0,pA1,t,true,true,true);     WAIT_BAR(2); RESC(); ROT();
    STEP(pA0,pA1,pB0,pB1,t+1,true,true,true);   WAIT_BAR(2); RESC(); ROT();
  }
  #undef CMASK
  #define CMASK(P0,P1,t) do{int jb_=(t)-(NT-4); if(WINDOW||(CAUSAL&&jb_>=0))cmask<CAUSAL,WINDOW>(P0,P1,jb_,qrel,hi);}while(0)
  #define ENDW(tt) do{ if((tt)+3<NT){WAIT_BAR(2);} else if((tt)+2<NT){WAIT_BAR(1);} else {WAIT_BAR(0);} }while(0)
  for(;t+1<NT;t+=2){
    STEP(pB0,pB1,pA0,pA1,t,(t+3<NT),(t+1<NT),(t+1<NT));       ENDW(t);   RESC(); ROT();
    STEP(pA0,pA1,pB0,pB1,t+1,(t+4<NT),(t+2<NT),(t+2<NT));     ENDW(t+1); RESC(); ROT();
  }
  STEP(pB0,pB1,pA0,pA1,NT-1,false,false,false); RESC();
  { float sacc=pB0[0]+pB0[1]; _Pragma("unroll") for(int r=2;r<16;++r)sacc+=pB0[r]; _Pragma("unroll") for(int r=0;r<16;++r)sacc+=pB1[r]; l_reg+=sacc;
    pw0=(u32x4){PKW(pB0,0),PKW(pB0,2),PKW(pB0,4),PKW(pB0,6)};pw1=(u32x4){PKW(pB0,8),PKW(pB0,10),PKW(pB0,12),PKW(pB0,14)};pw2=(u32x4){PKW(pB1,0),PKW(pB1,2),PKW(pB1,4),PKW(pB1,6)};pw3=(u32x4){PKW(pB1,8),PKW(pB1,10),PKW(pB1,12),PKW(pB1,14)};
    SBAR(); pv(o,vb0+sl_cur,PAF(0),PAF(1),PAF(2),PAF(3)); }
  #undef PKW
  #undef PAF
  #undef VFR
  #undef PIN
  #undef MX3
  #undef GAPA
  #undef GAPB
  #undef EX
  #undef VRD
  #undef KRD
  #undef STEP
  #undef ENDW
  {auto rr=__builtin_amdgcn_permlane32_swap(__float_as_uint(l_reg),__float_as_uint(l_reg),false,false);l_reg=__uint_as_float(rr[0])+__uint_as_float(rr[1]);}
  if(LSE){ if(hi==0)U.lse[(long)(q0+wid*QBLK+r32)*U.lse_stride]=mhat+__builtin_amdgcn_logf(l_reg); }
  if(hi==0)wsf[32+r32]=l_reg;asm volatile("s_waitcnt lgkmcnt(0)":::"memory");
  float rli[16];
  #pragma unroll
  for(int r=0;r<16;++r)rli[r]=__builtin_amdgcn_rcpf(wsf[32+crow(r,hi)]);
  bf16*Ow=U.O+(long)(q0+wid*QBLK)*op;
  { bf16*stg=(bf16*)(shm+LDS_OST)+wid*2048;
    #pragma unroll
    for(int r=0;r<16;++r){const int orow=crow(r,hi);
      #pragma unroll
      for(int d0=0;d0<2;++d0)stg[orow*64+d0*32+r32]=__float2bfloat16(o[d0][r]*rli[r]);}
    asm volatile("s_waitcnt lgkmcnt(0)":::"memory");
    #pragma unroll
    for(int i=0;i<4;++i){const int row=i*8+(lane>>3),ch=lane&7; const u32x4 v=*(const u32x4*)(stg+row*64+ch*8); ATTN_STORE16(Ow+(long)row*op+ch*8,v);} }
  asm volatile("s_waitcnt lgkmcnt(0)\n\ts_barrier":::"memory");
  #undef DMA_K
  #undef DMA_V
  #undef CMASK
  #undef START
  #undef RESC
  #undef ROT
  #undef QX_SET
}
constexpr int ATTN_LDS_BYTES=LDS_BYTES;
#undef SBAR
#undef WAIT_BAR
}
constexpr size_t MiB = 1u << 20;
constexpr size_t WS_CTL = 0, CTL_ZERO_BYTES = 1 * MiB;
constexpr size_t WS_LIST = 1 * MiB;
constexpr size_t WS_RGATE = 5 * MiB;
constexpr size_t WS_RSTD1 = 5 * MiB + 512 * 1024, WS_RSTD2 = WS_RSTD1 + 128 * 1024, WS_WRG = WS_RSTD2 + 128 * 1024;
constexpr size_t WS_WRT = 7 * MiB + 512 * 1024;
constexpr size_t WS_LSE = 6 * MiB;
constexpr size_t WS_MKV = 8 * MiB;
constexpr size_t WS_WIN = 10 * MiB, WS_WOUT = 15 * MiB, WS_WGU = 17 * MiB, WS_WDN = 145 * MiB;
constexpr size_t WS_XB = 209 * MiB;
constexpr size_t WS_P = 273 * MiB, WS_OD = 433 * MiB, WS_ODIL = 497 * MiB;
constexpr size_t WS_ACT = 273 * MiB;
constexpr size_t WS_MIX = 545 * MiB, WS_X1B = 609 * MiB, WS_YB = 673 * MiB, WS_Y = 929 * MiB, WS_END = 993 * MiB;
constexpr int CW_TMO = 0, CW_CODE = 1;
constexpr int CW_CNT = 64;
constexpr int CW_NRM = 256;
constexpr int CW_Q = 1024;
constexpr int CW_BAR = 4096;

constexpr int RING_OFF = 0, RING_BYTES = 131072;
constexpr int LDSCTL_OFF = RING_BYTES;
constexpr int IDB_OFF = LDSCTL_OFF;
constexpr int TBL_OFF = IDB_OFF + 3072;
constexpr int LCNT_OFF = TBL_OFF + 2304;
constexpr int MISC_OFF = LCNT_OFF + 256;
constexpr int STG_OFF = MISC_OFF + 128;
constexpr int LDS_BYTES = 147456;
static_assert(STG_OFF + 512 * 12 <= LDS_BYTES, "LDS map");
constexpr int NWAVES = 8;

#define GAS __attribute__((address_space(1)))
#define LAS __attribute__((address_space(3)))
typedef unsigned short bf16;
typedef unsigned v4u __attribute__((ext_vector_type(4)));
typedef unsigned v2u __attribute__((ext_vector_type(2)));
typedef float f32x4 __attribute__((ext_vector_type(4)));
typedef float f32x16 __attribute__((ext_vector_type(16)));
typedef short bf16x8 __attribute__((ext_vector_type(8)));
typedef GAS unsigned gu32;
#define RLX_AGENT __ATOMIC_RELAXED, __HIP_MEMORY_SCOPE_AGENT
#define LDS_WAIT() asm volatile("s_waitcnt lgkmcnt(0)" ::: "memory")
#define VM_WAIT() asm volatile("s_waitcnt vmcnt(0)" ::: "memory")
__device__ __forceinline__ unsigned f2bf(float f) { unsigned u = __builtin_bit_cast(unsigned, f); return (u + 0x7fffu + ((u >> 16) & 1u)) >> 16; }
__device__ __forceinline__ unsigned pk2(float lo, float hi) { return f2bf(lo) | (f2bf(hi) << 16); }
__device__ __forceinline__ unsigned fp8x4(float a, float b, float c, float d) { int w = __builtin_amdgcn_cvt_pk_fp8_f32(a, b, 0, false); w = __builtin_amdgcn_cvt_pk_fp8_f32(c, d, w, true); return (unsigned)w; }
constexpr float WSCALE = 64.f, ASCALE = 8.f;
__device__ __forceinline__ float bf2f(unsigned short b) { return __builtin_bit_cast(float, (unsigned)b << 16); }
__device__ __forceinline__ float bflo(unsigned w) { return __builtin_bit_cast(float, w << 16); }
__device__ __forceinline__ float bfhi(unsigned w) { return __builtin_bit_cast(float, w & 0xffff0000u); }
__device__ __forceinline__ float wave_sum(float v) {
#pragma unroll
    for (int o = 1; o < 64; o <<= 1) v += __shfl_xor(v, o);
    return v;
}

#define XB_TMO      128
#define XB_XCNT(j)  (256  + 64 * (j))
#define XB_XSUB(j)  (1280 + 64 * (j))
#define XB_XGEN(j)  (2304 + 64 * (j))
#define XB_TOP      3328
#define XB_TOPGEN   3392
#define XCD_BAR_WORDS 3456
#define XB_SPIN_CAP (1u << 20)
__device__ __forceinline__ unsigned xb_ld(unsigned* p)              { return __hip_atomic_load(p, __ATOMIC_RELAXED, __HIP_MEMORY_SCOPE_AGENT); }
__device__ __forceinline__ unsigned xb_add(unsigned* p, unsigned v) { return __hip_atomic_fetch_add(p, v, __ATOMIC_RELAXED, __HIP_MEMORY_SCOPE_AGENT); }
__device__ __forceinline__ unsigned xb_xcc_id() { return (unsigned)__builtin_amdgcn_s_getreg((3 << 11) | 20) & 0xFu; }
#define XB_SPIN(cond, bar) do { unsigned _sp = 0; while (cond) { __builtin_amdgcn_s_sleep(1); \
    if ((++_sp & 255u) == 0u) { if (xb_ld(&(bar)[XB_TMO])) break; if (_sp > XB_SPIN_CAP) { atomicAdd(&(bar)[XB_TMO], 1u); break; } } } } while (0)
struct XcdBarrier { unsigned* bar; unsigned x; volatile LAS unsigned* st; };
__device__ __forceinline__ XcdBarrier xcd_barrier_post(unsigned* bar, volatile LAS unsigned* st) {
    XcdBarrier b; b.bar = bar; b.x = xb_xcc_id(); b.st = st;
    if (threadIdx.x == 0) (void)xb_add(&bar[XB_XCNT(b.x)], 1u);
    return b;
}
__device__ __forceinline__ void xcd_barrier_complete(unsigned* bar, unsigned x, unsigned& nloc, unsigned& nx) {
    const unsigned G = gridDim.x * gridDim.y * gridDim.z;
    unsigned sum, cnt, mine, sp = 0u;
    for (;;) {
        sum = 0u; cnt = 0u; mine = 0u;
#pragma unroll
        for (unsigned j = 0; j < 16; ++j) { const unsigned c = xb_ld(&bar[XB_XCNT(j)]); sum += c; cnt += (c > 0u) ? 1u : 0u; mine = (j == x) ? c : mine; }
        if (sum == G) break;
        __builtin_amdgcn_s_sleep(1);
        if ((++sp & 255u) == 0u) { if (xb_ld(&bar[XB_TMO])) break; if (sp > XB_SPIN_CAP) { atomicAdd(&bar[XB_TMO], 1u); break; } }
    }
    nloc = mine > 0u ? mine : 1u; nx = cnt > 0u ? cnt : 1u;
}
__device__ __forceinline__ void xcd_barrier(const XcdBarrier& b) {
    asm volatile("s_waitcnt vmcnt(0)" ::: "memory");
    __syncthreads();
    if (threadIdx.x == 0) {
        unsigned* bar = b.bar;
        __builtin_amdgcn_s_waitcnt(0);
        unsigned nloc = b.st[0], nx = b.st[1];
        if (nloc == 0u) { xcd_barrier_complete(bar, b.x, nloc, nx); b.st[0] = nloc; b.st[1] = nx; }
        const unsigned old = xb_add(&bar[XB_XSUB(b.x)], 1u);
        const unsigned gen = old / nloc;
        if (old + 1u == (gen + 1u) * nloc) {
            __builtin_amdgcn_fence(__ATOMIC_RELEASE, "agent");
            asm volatile("s_waitcnt vmcnt(0)" ::: "memory");
            const unsigned og = xb_add(&bar[XB_TOP], 1u);
            const unsigned tg = og / nx;
            if (og + 1u == (tg + 1u) * nx) xb_add(&bar[XB_TOPGEN], 1u);
            else XB_SPIN(xb_ld(&bar[XB_TOPGEN]) == tg, bar);
            __builtin_amdgcn_fence(__ATOMIC_ACQUIRE, "agent");
            xb_add(&bar[XB_XGEN(b.x)], 1u);
            asm volatile("s_waitcnt vmcnt(0)" ::: "memory");
        } else {
            XB_SPIN(xb_ld(&bar[XB_XGEN(b.x)]) == gen, bar);
            __builtin_amdgcn_fence(__ATOMIC_ACQUIRE, "agent");
            asm volatile("s_waitcnt vmcnt(0)" ::: "memory");
        }
    }
    __syncthreads();
}

struct Frame {
    LAS unsigned char* lds;
    volatile LAS unsigned* MISC;
    gu32* ctl;
    int tid, lane, wave;
    int vcu, G;
    const float *x, *mem, *g_attn, *g_mem, *w_in, *lamqk, *subg, *w_mkv, *w_out, *g_ffn, *w_r, *b_r, *w_gu, *b_gu, *w_dn, *b_dn, *g_fin;
    float* out; unsigned char* ws;
};

#define P0_LOAD(dst, itm) do { const int m_ = (itm) / ipm, r_ = (itm) % ipm, kb_ = r_ / nblk, nb_ = r_ % nblk; \
        const float* src_ = W + (size_t)m_ * K * N + (size_t)(64 * kb_ + (lane >> 5)) * N + 32 * nb_ + (lane & 31); \
        _Pragma("unroll") for (int i_ = 0; i_ < 32; ++i_) dst[i_] = src_[(size_t)(2 * i_) * N]; } while (0)
template <bool F8, class RowMap>
__device__ __forceinline__ void p0_transpose_all(const float* W, int K, int N, int nmat, void* WTv, const float* gk, float wscale, LAS float* scr, int gw, int NGW, int lane, RowMap rowmap) {
    asm volatile("" : "+v"(lane));
    const int nblk = N / 32, ipm = (K / 64) * nblk, total = nmat * ipm;
    int it = gw; if (it >= total) return;
    float v[32], w[32];
    P0_LOAD(v, it);
    for (;;) {
        const int nx = it + NGW; const bool more = nx < total;
        if (more) P0_LOAD(w, nx);
        const int m = it / ipm, r = it % ipm, k0 = 64 * (r / nblk), n0 = 32 * (r % nblk);
        if (gk) {
#pragma unroll
            for (int i = 0; i < 32; ++i) v[i] *= gk[k0 + 2 * i + (lane >> 5)] * wscale;
        } else if (F8) {
#pragma unroll
            for (int i = 0; i < 32; ++i) v[i] *= wscale;
        }
#pragma unroll
        for (int i = 0; i < 32; ++i) scr[(2 * i + (lane >> 5)) * 33 + (lane & 31)] = v[i];
        LDS_WAIT(); asm volatile("" ::: "memory");
        const int c = lane & 7;
#pragma unroll
        for (int j = 0; j < 4; ++j) { const int n = (lane >> 3) + 8 * j; const LAS float* s = scr + (8 * c) * 33 + n;
            if constexpr (F8) { unsigned char* wt = (unsigned char*)WTv + (size_t)m * N * K;
                v2u o; o.x = fp8x4(s[0 * 33], s[1 * 33], s[2 * 33], s[3 * 33]); o.y = fp8x4(s[4 * 33], s[5 * 33], s[6 * 33], s[7 * 33]);
                *(GAS v2u*)(wt + (size_t)rowmap(n0 + n) * K + k0 + 8 * c) = o; }
            else { bf16* wt = (bf16*)WTv + (size_t)m * N * K;
                v4u o; o.x = pk2(s[0 * 33], s[1 * 33]); o.y = pk2(s[2 * 33], s[3 * 33]); o.z = pk2(s[4 * 33], s[5 * 33]); o.w = pk2(s[6 * 33], s[7 * 33]);
                *(GAS v4u*)(wt + (size_t)rowmap(n0 + n) * K + k0 + 8 * c) = o; } }
        LDS_WAIT(); asm volatile("" ::: "memory");
        if (!more) break;
#pragma unroll
        for (int i = 0; i < 32; ++i) v[i] = w[i];
        it = nx;
    }
}
#undef P0_LOAD
struct RowId { __device__ __forceinline__ int operator()(int n) const { return n; } };
struct RowGU { __device__ __forceinline__ int operator()(int n) const { const int f = n >> 1, u = n & 1; return ((f >> 7) << 8) + (u << 7) + (f & 127); } };

__device__ __forceinline__ void p0_x_rows2(Frame& F, const float* xrow, bf16* orow, float* rstd_out) {
    const GAS f32x4* xr = (const GAS f32x4*)xrow + F.lane;
    f32x4 v[8]; float s0 = 0.f, s1 = 0.f;
#pragma unroll
    for (int j = 0; j < 8; ++j) v[j] = xr[64 * j];
#pragma unroll
    for (int j = 0; j < 4; ++j) { s0 += (v[j].x * v[j].x + v[j].y * v[j].y) + (v[j].z * v[j].z + v[j].w * v[j].w); s1 += (v[4 + j].x * v[4 + j].x + v[4 + j].y * v[4 + j].y) + (v[4 + j].z * v[4 + j].z + v[4 + j].w * v[4 + j].w); }
    s0 = wave_sum(s0); s1 = wave_sum(s1);
    GAS unsigned long long* o8 = (GAS unsigned long long*)orow + F.lane;
#pragma unroll
    for (int j = 0; j < 8; ++j) o8[64 * j] = (unsigned long long)pk2(v[j].x, v[j].y) | ((unsigned long long)pk2(v[j].z, v[j].w) << 32);
    if (F.lane == 0) { rstd_out[0] = 1.f / sqrtf(s0 * (1.f / D) + EPS); rstd_out[1] = 1.f / sqrtf(s1 * (1.f / D) + EPS); }
}
__device__ __forceinline__ void p0_mkv_tile(Frame& F, int tile, bf16* mkv) {
    const int mt = tile >> 4, nt = tile & 15, m0 = 32 * mt, n0 = 32 * nt, r = F.lane & 31, h = F.lane >> 5;
    f32x16 acc = {}; float ss = 0.f;
    const float* mrow = F.mem + (size_t)(m0 + r) * D + 8 * h;
    const float* wcol = F.w_mkv + (size_t)(8 * h) * 512 + n0 + r;
    const float* gp = F.g_mem + 8 * h;
    for (int k0 = 0; k0 < D; k0 += 16) {
        const f32x4 a0 = *(const f32x4*)(mrow + k0), a1 = *(const f32x4*)(mrow + k0 + 4);
        const f32x4 g0 = *(const f32x4*)(gp + k0), g1 = *(const f32x4*)(gp + k0 + 4);
        ss += (a0.x * a0.x + a0.y * a0.y) + (a0.z * a0.z + a0.w * a0.w) + (a1.x * a1.x + a1.y * a1.y) + (a1.z * a1.z + a1.w * a1.w);
        v4u bw; bw.x = pk2(a0.x * g0.x, a0.y * g0.y); bw.y = pk2(a0.z * g0.z, a0.w * g0.w); bw.z = pk2(a1.x * g1.x, a1.y * g1.y); bw.w = pk2(a1.z * g1.z, a1.w * g1.w);
        float wv[8];
#pragma unroll
        for (int j = 0; j < 8; ++j) wv[j] = wcol[(size_t)(k0 + j) * 512];
        v4u aw; aw.x = pk2(wv[0], wv[1]); aw.y = pk2(wv[2], wv[3]); aw.z = pk2(wv[4], wv[5]); aw.w = pk2(wv[6], wv[7]);
        acc = __builtin_amdgcn_mfma_f32_32x32x16_bf16(__builtin_bit_cast(bf16x8, aw), __builtin_bit_cast(bf16x8, bw), acc, 0, 0, 0);
    }
    ss += __shfl_xor(ss, 32);
    const float rstd = 1.f / sqrtf(ss * (1.f / D) + EPS);
    bf16* orow = mkv + (size_t)(m0 + r) * 512 + n0 + 4 * h;
#pragma unroll
    for (int q = 0; q < 4; ++q) { v2u o; o.x = pk2(acc[4 * q] * rstd, acc[4 * q + 1] * rstd); o.y = pk2(acc[4 * q + 2] * rstd, acc[4 * q + 3] * rstd); *(GAS v2u*)(orow + 8 * q) = o; }
}
__device__ __forceinline__ void p0_prologue(Frame& F) {
    LAS float* scr = (LAS float*)(F.lds + RING_OFF + F.wave * 16384);
    const int gw = F.vcu * NWAVES + F.wave, NGW = F.G * NWAVES;
    bf16* win_t = (bf16*)(F.ws + WS_WIN); bf16* wout_t = (bf16*)(F.ws + WS_WOUT);
    p0_transpose_all<false>(F.w_in, D, DIN, 1, win_t, F.g_attn, 1.f, scr, gw, NGW, F.lane, RowId());
    p0_transpose_all<false>(F.w_out, D, D, 1, wout_t, nullptr, 1.f, scr, gw, NGW, F.lane, RowId());
    bf16* xb = (bf16*)(F.ws + WS_XB); float* rstd1 = (float*)(F.ws + WS_RSTD1);
    for (int m = 2 * gw; m < T; m += 2 * NGW) p0_x_rows2(F, F.x + (size_t)m * D, xb + (size_t)m * D, rstd1 + m);
    bf16* mkv = (bf16*)(F.ws + WS_MKV);
    for (int t = gw; t < (BATCH * NMEM / 32) * (512 / 32); t += NGW) p0_mkv_tile(F, t, mkv);
    bf16* wrt = (bf16*)(F.ws + WS_WRT);
    for (int i = gw * 64 + F.lane; i < D * NE; i += NGW * 64) { const int e = i >> 10, k = i & 1023; const float w = F.w_r[k * NE + e] * F.g_ffn[k]; const unsigned hb = f2bf(w); wrt[i] = (bf16)hb; wrt[D * NE + i] = (bf16)f2bf(w - bf2f((bf16)hb)); }
}

constexpr int NCONV = 8, NCONV_ALL = 8 * NCONV;
__device__ __forceinline__ void p0b_unit(Frame& F, int c) {
    LAS float* scr = (LAS float*)(F.lds + RING_OFF + F.wave * 16384);
    p0_transpose_all<true>(F.w_gu, D, 2 * DFF, NE, (void*)(F.ws + WS_WGU), F.g_ffn, WSCALE, scr, c * NWAVES + F.wave, NCONV_ALL * NWAVES, F.lane, RowGU());
    p0_transpose_all<true>(F.w_dn, DFF, D, NE, (void*)(F.ws + WS_WDN), nullptr, WSCALE, scr, c * NWAVES + F.wave, NCONV_ALL * NWAVES, F.lane, RowId());
    __syncthreads();
}

struct EpiInProj {
    bf16* O; const float* rstd; unsigned* nrm;
    __device__ __forceinline__ void operator()(const pg8::f32x4 (&acc)[2][2][4][2], const pg8::Unit& u, int wr, int wc, int fr, int fq, const LAS unsigned*) const {
        asm volatile("" : "+v"(fr), "+v"(fq));
        const int row0 = u.pm * 256 + wr * 64 + fr, col0 = u.pn * 256 + wc * 32 + 8 * fq;
        const float sc = (u.pn <= 1 || u.pn == 6 || u.pn == 9) ? QSCALE : 1.f;
        float rsv[2][4];
#pragma unroll
        for (int ai = 0; ai < 2; ++ai)
#pragma unroll
            for (int m = 0; m < 4; ++m) rsv[ai][m] = rstd[row0 + ai * 128 + m * 16];
#pragma unroll
        for (int ai = 0; ai < 2; ++ai)
#pragma unroll
            for (int m = 0; m < 4; ++m) { const int row = row0 + ai * 128 + m * 16; const float rs = rsv[ai][m] * sc; bf16* rowp = O + (size_t)row * DIN + col0;
#pragma unroll
                for (int bj = 0; bj < 2; ++bj) { const pg8::f32x4 v0 = acc[ai][bj][m][0] * rs, v1 = acc[ai][bj][m][1] * rs;
                    v4u w; w.x = pg8::cvt_pk_bf16(v0[0], v0[1]); w.y = pg8::cvt_pk_bf16(v0[2], v0[3]); w.z = pg8::cvt_pk_bf16(v1[0], v1[1]); w.w = pg8::cvt_pk_bf16(v1[2], v1[3]);
                    *(v4u*)(rowp + bj * 128) = w; } }
        if (u.pn < 4) {
#pragma unroll
            for (int bj = 0; bj < 2; ++bj) { float mx = 0.f;
#pragma unroll
                for (int ai = 0; ai < 2; ++ai)
#pragma unroll
                    for (int m = 0; m < 4; ++m) { const float rs = rsv[ai][m] * sc; const pg8::f32x4 v0 = acc[ai][bj][m][0] * rs, v1 = acc[ai][bj][m][1] * rs;
                        float s = (v0[0] * v0[0] + v0[1] * v0[1]) + (v0[2] * v0[2] + v0[3] * v0[3]) + (v1[0] * v1[0] + v1[1] * v1[1]) + (v1[2] * v1[2] + v1[3] * v1[3]);
                        s += __shfl_xor(s, 16); s += __shfl_xor(s, 32); mx = fmaxf(mx, s); }
#pragma unroll
                for (int o = 1; o < 16; o <<= 1) mx = fmaxf(mx, __shfl_xor(mx, o));
                if ((fr | fq) == 0) atomicMax(nrm + (((u.pm >> 4) * 4 + u.pn) * 4 + 2 * bj + (wc >> 1)) * 2 + (wc & 1), __builtin_bit_cast(unsigned, mx)); }
        }
    }
};
__device__ __forceinline__ void attn_phase(Frame& F, char* shm, int qoff = 0, int gmask = 7) {
    using namespace attn_body;
    const attn_body::bf16* P = (const attn_body::bf16*)(F.ws + WS_P);
    attn_body::bf16* OD = (attn_body::bf16*)(F.ws + WS_OD);
    attn_body::bf16* mix = (attn_body::bf16*)(F.ws + WS_MIX);
    attn_body::bf16* ODIL = (attn_body::bf16*)(F.ws + WS_ODIL); float* LSEb = (float*)(F.ws + WS_LSE);
    const attn_body::bf16* MKV = (const attn_body::bf16*)(F.ws + WS_MKV);
    const float* nrm = (const float*)(F.ctl + CW_NRM);
    const int grp = (int)blockIdx.x & 7, b = grp;
    unsigned* qctr = (unsigned*)(F.ctl + CW_Q + qoff) + 64 * grp;
    const attn_body::bf16* Pb = P + (size_t)b * SEQ * DIN;
    for (;;) {
        if (F.tid == 0) F.MISC[20] = __hip_atomic_fetch_add(qctr, 1u, __ATOMIC_RELAXED, __HIP_MEMORY_SCOPE_AGENT);
        __syncthreads();
        int un = (int)F.MISC[20];
        __syncthreads();
        if (un < NCONV) { if (gmask == 7) p0b_unit(F, grp * NCONV + un); continue; }
        un -= NCONV;
        if (un >= 512) break;
        if (un < 256) {
            if (!(gmask & 1)) continue;
            const int qb = 15 - (un >> 4), h = 3 - ((un >> 2) & 3), pass = un & 3, j = pass >> 1, vh = pass & 1;
            const float slope2 = exp2f(-(float)(2 * h + 1)) * LOG2E;
            const int ni = ((b * 4 + (h >> 1)) * 4 + 2 * (h & 1) + j) * 2;
            const float R = sqrtf((nrm[ni] + nrm[ni + 1]) * (nrm[ni + 16] + nrm[ni + 17])) * 1.01f;
            const float kfirst = (float)(qb * 256) - (2.f * R + 160.f) / slope2;
            int t0 = kfirst > 0.f ? (int)(kfirst * (1.f / 64.f)) : 0; t0 = min(t0, 4 * qb); t0 &= ~1;
            UnitP U; U.Q = Pb + C_DQ + h * 128 + j * 64; U.K = Pb + C_DK + h * 128 + j * 64; U.V = Pb + C_DV + h * 128 + vh * 64;
            U.O = OD + (size_t)b * SEQ * 1024 + h * 256 + j * 128 + vh * 64; U.qp = DIN; U.kp = DIN; U.op = 1024;
            U.q0 = qb * 256; U.t0 = t0; U.NT = 4 * qb + 4 - t0; U.slope2 = slope2; U.lse = nullptr; U.lse_stride = 0;
            attn_unit<32, true, false, true, false>(U, shm);
        } else if (un < 448) {
            if (!(gmask & 2)) continue;
            const int du = un - 256, h = du / 48, idx = du % 48, n = idx >> 4, w = idx & 15;
            const int r = (n == 0) ? 1 : (n == 1 ? 4 : 16), c = (n == 0) ? 0 : (n == 1 ? (w >> 2) : w), blk = (n == 0) ? w : (n == 1 ? (w & 3) : 0);
            const attn_body::bf16* Pc = Pb + (size_t)c * DIN;
            UnitP U; U.Q = Pc + C_LQ + h * 64; U.K = Pc + C_LK + h * 64; U.V = Pc + C_LV + h * 64; U.qp = (long)r * DIN; U.kp = (long)r * DIN;
            U.O = ODIL + (size_t)n * T * 256 + ((size_t)b * SEQ + c) * 256 + h * 64; U.op = (long)r * 256;
            U.q0 = blk * 256; U.t0 = (blk == 0) ? 0 : 4 * blk - 2; U.NT = 4 * blk + 4 - U.t0;
            U.slope2 = exp2f(-(float)(2 * h + 2)) * (float)r * LOG2E;
            U.lse = LSEb + (size_t)n * T * 4 + ((size_t)b * SEQ + c) * 4 + h; U.lse_stride = r * 4;
            attn_unit<32, true, true, true, true>(U, shm);
        } else {
            if (!(gmask & 4)) continue;
            const int mu = un - 448, h = mu >> 4, qb = mu & 15;
            UnitP U; U.Q = Pb + C_MQ + h * 64; U.qp = DIN; U.K = MKV + (size_t)b * NMEM * 512 + h * 64; U.V = U.K + 256; U.kp = 512;
            U.O = mix + (size_t)b * SEQ * 1024 + 768 + h * 64; U.op = 1024; U.q0 = qb * 256; U.t0 = 0; U.NT = 4; U.slope2 = 0.f; U.lse = nullptr; U.lse_stride = 0;
            attn_unit<8, false, false, false, false>(U, shm);
        }
    }
}
__device__ __forceinline__ void dil_combine_phase(Frame& F) {
    const int gw = F.vcu * NWAVES + F.wave, NGW = F.G * NWAVES;
    const bf16* OD = (const bf16*)(F.ws + WS_OD); const bf16* ODIL = (const bf16*)(F.ws + WS_ODIL); const float* LSEb = (const float*)(F.ws + WS_LSE); bf16* mix = (bf16*)(F.ws + WS_MIX);
    const int h = F.lane >> 4, pt = F.lane & 15, d4 = pt * 4;
    float lam;
    { const float a = F.lamqk[F.lane] * F.lamqk[64 + F.lane], c = F.lamqk[128 + F.lane] * F.lamqk[192 + F.lane];
      lam = __expf(wave_sum(a)) - __expf(wave_sum(c)) + 0.2f; }
    float gsub[8];
#pragma unroll
    for (int i = 0; i < 8; ++i) gsub[i] = F.subg[pt * 8 + i] * 0.8f;
    for (int row0 = 4 * gw; row0 < T; row0 += 4 * NGW) {
        float l[4][3]; v2u q[4][3]; v4u o1[4], o2[4];
#pragma unroll
        for (int i = 0; i < 4; ++i) {
            o1[i] = *(const v4u*)(OD + (size_t)(row0 + i) * 1024 + h * 256 + pt * 8); o2[i] = *(const v4u*)(OD + (size_t)(row0 + i) * 1024 + h * 256 + 128 + pt * 8);
#pragma unroll
            for (int n = 0; n < 3; ++n) { l[i][n] = LSEb[(size_t)n * T * 4 + (size_t)(row0 + i) * 4 + h]; q[i][n] = *(const v2u*)(ODIL + (size_t)n * T * 256 + (size_t)(row0 + i) * 256 + h * 64 + d4); } }
#pragma unroll
        for (int i = 0; i < 4; ++i) {
            const unsigned aw[4] = {o1[i].x, o1[i].y, o1[i].z, o1[i].w}, bw[4] = {o2[i].x, o2[i].y, o2[i].z, o2[i].w};
            float d[8], ss = 0.f;
#pragma unroll
            for (int c = 0; c < 4; ++c) { d[2 * c] = bflo(aw[c]) - lam * bflo(bw[c]); d[2 * c + 1] = bfhi(aw[c]) - lam * bfhi(bw[c]); ss += d[2 * c] * d[2 * c] + d[2 * c + 1] * d[2 * c + 1]; }
#pragma unroll
            for (int o = 1; o < 16; o <<= 1) ss += __shfl_xor(ss, o);
            const float rstd = 1.f / sqrtf(ss * (1.f / 128.f) + EPS);
            v4u od; od.x = pk2(d[0] * rstd * gsub[0], d[1] * rstd * gsub[1]); od.y = pk2(d[2] * rstd * gsub[2], d[3] * rstd * gsub[3]); od.z = pk2(d[4] * rstd * gsub[4], d[5] * rstd * gsub[5]); od.w = pk2(d[6] * rstd * gsub[6], d[7] * rstd * gsub[7]);
            *(v4u*)(mix + (size_t)(row0 + i) * 1024 + h * 128 + pt * 8) = od;
            const float m = fmaxf(fmaxf(l[i][0], l[i][1]), l[i][2]);
            float wn[3], den = 0.f;
#pragma unroll
            for (int n = 0; n < 3; ++n) { wn[n] = exp2f(l[i][n] - m); den += wn[n]; }
            const float inv = 1.f / den; float o[4] = {0.f, 0.f, 0.f, 0.f};
#pragma unroll
            for (int n = 0; n < 3; ++n) { const float wq = wn[n] * inv; o[0] += wq * bflo(q[i][n].x); o[1] += wq * bfhi(q[i][n].x); o[2] += wq * bflo(q[i][n].y); o[3] += wq * bfhi(q[i][n].y); }
            v2u ov; ov.x = pk2(o[0], o[1]); ov.y = pk2(o[2], o[3]);
            *(v2u*)(mix + (size_t)(row0 + i) * 1024 + 512 + h * 64 + d4) = ov;
        }
    }
}
struct EpiY {
    bf16* Y;
    __device__ __forceinline__ void operator()(const pg8::f32x4 (&acc)[2][2][4][2], const pg8::Unit& u, int wr, int wc, int fr, int fq, const LAS unsigned*) const {
        asm volatile("" : "+v"(fr), "+v"(fq));
        const int row0 = u.pm * 256 + wr * 64 + fr, col0 = u.pn * 256 + wc * 32 + 8 * fq;
#pragma unroll
        for (int ai = 0; ai < 2; ++ai)
#pragma unroll
            for (int m = 0; m < 4; ++m) { bf16* rowp = Y + (size_t)(row0 + ai * 128 + m * 16) * D + col0;
#pragma unroll
                for (int bj = 0; bj < 2; ++bj) { const pg8::f32x4 v0 = acc[ai][bj][m][0], v1 = acc[ai][bj][m][1];
                    v4u w; w.x = pg8::cvt_pk_bf16(v0[0], v0[1]); w.y = pg8::cvt_pk_bf16(v0[2], v0[3]); w.z = pg8::cvt_pk_bf16(v1[0], v1[1]); w.w = pg8::cvt_pk_bf16(v1[2], v1[3]);
                    *(v4u*)(rowp + bj * 128) = w; } }
    }
};

__device__ __forceinline__ void route_phase(Frame& F) {
    LAS float* xch = (LAS float*)(F.lds + RING_OFF);
    LAS unsigned* lcnt = (LAS unsigned*)(F.lds + LCNT_OFF);
    LAS unsigned* stg = (LAS unsigned*)(F.lds + STG_OFF);
    if (F.tid < 64) lcnt[F.tid] = 0u;
    const int lane = F.lane, tl = lane & 31, h = lane >> 5, tg = F.wave & 3, kh = F.wave >> 2;
    { const v4u* wsrc = (const v4u*)(F.ws + WS_WRT); LAS char* wl = (LAS char*)(F.lds + RING_OFF);
      for (int i = F.tid; i < 2 * 32 * 128; i += NWAVES * 64) { const int hl = i >> 12, e = (i >> 7) & 31, c = i & 127; *(LAS v4u*)(wl + hl * 65536 + e * 2048 + ((c ^ (e & 15)) << 4)) = wsrc[i]; } }
    __syncthreads();
    const int tok = F.vcu * 128 + tg * 32 + tl;
    const float* xr = F.x + (size_t)tok * D + kh * 512 + 8 * h;
    const bf16* yr = (const bf16*)(F.ws + WS_Y) + (size_t)tok * D + kh * 512 + 8 * h;
    unsigned char* x1r = (unsigned char*)(F.ws + WS_X1B) + (size_t)tok * D + kh * 512 + 8 * h;
    const LAS char* wrow = (const LAS char*)(F.lds + RING_OFF) + tl * 2048;
    f32x16 acc = {}; float ss = 0.f;
    f32x4 xa[2][8]; v4u ya[2][4];
#define RT_LOAD(buf, g) do { _Pragma("unroll") for (int q_ = 0; q_ < 4; ++q_) { xa[buf][2 * q_] = *(const f32x4*)(xr + 64 * (g) + 16 * q_); xa[buf][2 * q_ + 1] = *(const f32x4*)(xr + 64 * (g) + 16 * q_ + 4); \
        ya[buf][q_] = *(const v4u*)(yr + 64 * (g) + 16 * q_); } } while (0)
#define RT_COMP(buf, g) do { _Pragma("unroll") for (int q_ = 0; q_ < 4; ++q_) { const int c_ = (kh * 512 + 64 * (g) + 16 * q_) / 8 + h; \
        const v4u wh = *(const LAS v4u*)(wrow + ((c_ ^ (tl & 15)) << 4)), wl2 = *(const LAS v4u*)(wrow + 65536 + ((c_ ^ (tl & 15)) << 4)); \
        const f32x4 a0 = xa[buf][2 * q_], a1 = xa[buf][2 * q_ + 1]; const v4u yv = ya[buf][q_]; \
        const float x1[8] = {a0.x + bflo(yv.x), a0.y + bfhi(yv.x), a0.z + bflo(yv.y), a0.w + bfhi(yv.y), a1.x + bflo(yv.z), a1.y + bfhi(yv.z), a1.z + bflo(yv.w), a1.w + bfhi(yv.w)}; \
        unsigned hw[4], lw[4]; \
        _Pragma("unroll") for (int p_ = 0; p_ < 4; ++p_) { const float u_ = x1[2 * p_], r_ = x1[2 * p_ + 1]; ss += u_ * u_ + r_ * r_; const unsigned hb = pk2(u_, r_); hw[p_] = hb; lw[p_] = pk2(u_ - bflo(hb), r_ - bfhi(hb)); } \
        const v4u xh = (v4u){hw[0], hw[1], hw[2], hw[3]}, xl = (v4u){lw[0], lw[1], lw[2], lw[3]}; \
        { v2u o8_; o8_.x = fp8x4(x1[0], x1[1], x1[2], x1[3]); o8_.y = fp8x4(x1[4], x1[5], x1[6], x1[7]); *(v2u*)(x1r + 64 * (g) + 16 * q_) = o8_; } \
        acc = __builtin_amdgcn_mfma_f32_32x32x16_bf16(__builtin_bit_cast(bf16x8, wh), __builtin_bit_cast(bf16x8, xh), acc, 0, 0, 0); \
        acc = __builtin_amdgcn_mfma_f32_32x32x16_bf16(__builtin_bit_cast(bf16x8, wh), __builtin_bit_cast(bf16x8, xl), acc, 0, 0, 0); \
        acc = __builtin_amdgcn_mfma_f32_32x32x16_bf16(__builtin_bit_cast(bf16x8, wl2), __builtin_bit_cast(bf16x8, xh), acc, 0, 0, 0); } } while (0)
    RT_LOAD(0, 0);
#pragma unroll
    for (int g = 0; g < 8; g += 2) {
        RT_LOAD(1, g + 1); RT_COMP(0, g);
        if (g + 2 < 8) RT_LOAD(0, g + 2);
        RT_COMP(1, g + 1);
    }
#undef RT_LOAD
#undef RT_COMP
    __syncthreads();
    if (kh == 1) { LAS float* d = xch + (tg * 64 + lane) * 17;
#pragma unroll
        for (int i = 0; i < 16; ++i) d[i] = acc[i];
        d[16] = ss; }
    __syncthreads();
    if (kh == 0) {
        const LAS float* d = xch + (tg * 64 + lane) * 17;
#pragma unroll
        for (int i = 0; i < 16; ++i) acc[i] += d[i];
        ss += d[16]; ss += __shfl_xor(ss, 32);
        const float rstd = 1.f / sqrtf(ss * (1.f / D) + EPS);
        float lg[16];
#pragma unroll
        for (int i = 0; i < 16; ++i) lg[i] = acc[i] * rstd + F.b_r[4 * h + (i & 3) + 8 * (i >> 2)];
        float cv[8]; int ce[8];
#pragma unroll
        for (int k = 0; k < 4; ++k) { float bv = -INFINITY; int bi = 0;
#pragma unroll
            for (int i = 0; i < 16; ++i) { if (lg[i] > bv) { bv = lg[i]; bi = i; } }
            cv[k] = bv; ce[k] = 4 * h + (bi & 3) + 8 * (bi >> 2);
#pragma unroll
            for (int i = 0; i < 16; ++i) if (i == bi) lg[i] = -INFINITY; }
#pragma unroll
        for (int k = 0; k < 4; ++k) { cv[4 + k] = __shfl_xor(cv[k], 32); ce[4 + k] = __shfl_xor(ce[k], 32); }
        float tv[4]; int te[4];
#pragma unroll
        for (int k = 0; k < 4; ++k) { float bv = -INFINITY; int be = 64, bi = 0;
#pragma unroll
            for (int i = 0; i < 8; ++i) { if (cv[i] > bv || (cv[i] == bv && ce[i] < be)) { bv = cv[i]; be = ce[i]; bi = i; } }
            tv[k] = bv; te[k] = be;
#pragma unroll
            for (int i = 0; i < 8; ++i) if (i == bi) cv[i] = -INFINITY; }
        float gk[4], den = 0.f;
#pragma unroll
        for (int k = 0; k < 4; ++k) { gk[k] = __expf(tv[k] - tv[0]); den += gk[k]; }
        const float inv = 1.f / den;
        if (h == 0) {
#pragma unroll
            for (int k = 0; k < 4; ++k) {
                const unsigned rank = __hip_atomic_fetch_add(lcnt + te[k], 1u, __ATOMIC_RELAXED, __HIP_MEMORY_SCOPE_WORKGROUP);
                const int slot = (tg * 32 + tl) * 4 + k;
                stg[slot * 3] = (unsigned)(tok * 4 + k); stg[slot * 3 + 1] = ((unsigned)te[k] << 16) | rank; stg[slot * 3 + 2] = __builtin_bit_cast(unsigned, gk[k] * inv);
            }
            ((float*)(F.ws + WS_RSTD2))[tok] = rstd;
        }
    }
    __syncthreads();
    if (F.tid < 32) { const unsigned n = lcnt[F.tid]; lcnt[32 + F.tid] = n ? __hip_atomic_fetch_add((unsigned*)(F.ctl + CW_CNT) + F.tid, n, __ATOMIC_RELAXED, __HIP_MEMORY_SCOPE_AGENT) : 0u; }
    __syncthreads();
    { unsigned* list = (unsigned*)(F.ws + WS_LIST); float* rgate = (float*)(F.ws + WS_RGATE);
      const unsigned ent = stg[F.tid * 3], er = stg[F.tid * 3 + 1], gb = stg[F.tid * 3 + 2]; const unsigned e = er >> 16, rank = er & 0xffffu;
      list[(size_t)e * LCAP + lcnt[32 + e] + rank] = ent; rgate[ent] = __builtin_bit_cast(float, gb); }
    __syncthreads();
}

__device__ __forceinline__ int moe_build_table(Frame& F) {
    LAS unsigned* tbl = (LAS unsigned*)(F.lds + TBL_OFF); LAS unsigned* lcnt = (LAS unsigned*)(F.lds + LCNT_OFF);
    if (F.wave == 0) {
        const int e = F.lane & 31;
        const unsigned cnt = __hip_atomic_load((unsigned*)(F.ctl + CW_CNT) + e, __ATOMIC_RELAXED, __HIP_MEMORY_SCOPE_AGENT);
        const unsigned nt = (cnt + 255u) >> 8; unsigned incl = nt;
#pragma unroll
        for (int o = 1; o < 32; o <<= 1) { const unsigned t = __shfl_up(incl, o); if ((F.lane & 31) >= o) incl += t; }
        if (F.lane < 32) { lcnt[e] = cnt; const unsigned start = incl - nt; for (unsigned j = 0; j < nt; ++j) tbl[start + j] = ((unsigned)e << 16) | j; if (F.lane == 31) F.MISC[16] = incl; }
    }
    __syncthreads();
    return (int)F.MISC[16];
}
struct MoeOrder {
    const LAS unsigned* tbl; const LAS unsigned* lcnt; const unsigned* list; int NMT, G, c, NPN, MPER, RB; size_t bexp; bool a_tiles;
    __device__ __forceinline__ bool next(int i, pg8::Unit& u) const {
        const int L = i * G + c, blk = L >> 5, w = L & 31, g = blk * MPER + w / NPN, pn = w % NPN;
        if (g >= NMT) return false;
        const unsigned t = tbl[g]; const int e = (int)(t >> 16), mt = (int)(t & 0xffffu); const int cnt = (int)lcnt[e];
        u.pm = g; u.pn = pn; u.e = e; u.mt = mt; u.valid = min(256, cnt - mt * 256);
        u.aoff = a_tiles ? (size_t)g * (size_t)(256 * RB) : (size_t)0; u.boff = (size_t)e * bexp + (size_t)pn * (size_t)(256 * RB);
        return true;
    }
    __device__ __forceinline__ const unsigned* id_src(const pg8::Unit& u, int row) const { return list + (size_t)u.e * LCAP + u.mt * 256 + min(row, u.valid - 1); }
};
struct EpiGU {
    unsigned char* ACT; const float* rstd2; const float* bgu;
    __device__ __forceinline__ void operator()(const pg8::f32x4 (&acc)[2][2][4][2], const pg8::Unit& u, int wr, int wc, int fr, int fq, const LAS unsigned* ids) const {
        asm volatile("" : "+v"(fr), "+v"(fq));
        const int r0 = wr * 64 + fr, f0 = u.pn * 128 + wc * 32 + 8 * fq;
        float rs[2][4];
#pragma unroll
        for (int ai = 0; ai < 2; ++ai)
#pragma unroll
            for (int m = 0; m < 4; ++m) rs[ai][m] = rstd2[ids[r0 + ai * 128 + m * 16] >> 2] * (1.f / WSCALE);
        const float* bp = bgu + (size_t)u.e * 2048 + 2 * f0;
        const pg8::f32x4 b0 = *(const pg8::f32x4*)bp, b1 = *(const pg8::f32x4*)(bp + 4), b2 = *(const pg8::f32x4*)(bp + 8), b3 = *(const pg8::f32x4*)(bp + 12);
        const float gb[8] = {b0[0], b0[2], b1[0], b1[2], b2[0], b2[2], b3[0], b3[2]}, ub[8] = {b0[1], b0[3], b1[1], b1[3], b2[1], b2[3], b3[1], b3[3]};
#pragma unroll
        for (int ai = 0; ai < 2; ++ai)
#pragma unroll
            for (int m = 0; m < 4; ++m) { const int r = r0 + ai * 128 + m * 16; const float s = rs[ai][m]; float a[8];
#pragma unroll
                for (int n = 0; n < 2; ++n)
#pragma unroll
                    for (int j = 0; j < 4; ++j) { float gate = acc[ai][0][m][n][j] * s + gb[4 * n + j], up = acc[ai][1][m][n][j] * s + ub[4 * n + j];
                        gate = fminf(gate, 7.f); up = fminf(fmaxf(up, -7.f), 7.f);
                        a[4 * n + j] = ASCALE * (up + 1.f) * gate * __builtin_amdgcn_rcpf(1.f + __builtin_amdgcn_exp2f(-1.702f * LOG2E * gate)); }
                v2u w; w.x = fp8x4(a[0], a[1], a[2], a[3]); w.y = fp8x4(a[4], a[5], a[6], a[7]);
                *(v2u*)(ACT + (size_t)(u.pm * 256 + r) * DFF + f0) = w; }
    }
};
struct EpiDown {
    bf16* YB; const float* rgate; const float* bdn;
    __device__ __forceinline__ void operator()(const pg8::f32x4 (&acc)[2][2][4][2], const pg8::Unit& u, int wr, int wc, int fr, int fq, const LAS unsigned* ids) const {
        asm volatile("" : "+v"(fr), "+v"(fq));
        const int r0 = wr * 64 + fr, col0 = u.pn * 256 + wc * 32 + 8 * fq;
        float gt[2][4];
#pragma unroll
        for (int ai = 0; ai < 2; ++ai)
#pragma unroll
            for (int m = 0; m < 4; ++m) gt[ai][m] = rgate[ids[r0 + ai * 128 + m * 16]];
        pg8::f32x4 bv[2][2];
#pragma unroll
        for (int bj = 0; bj < 2; ++bj)
#pragma unroll
            for (int n = 0; n < 2; ++n) bv[bj][n] = *(const pg8::f32x4*)(bdn + (size_t)u.e * D + col0 + bj * 128 + 4 * n);
#pragma unroll
        for (int ai = 0; ai < 2; ++ai)
#pragma unroll
            for (int m = 0; m < 4; ++m) { const int r = r0 + ai * 128 + m * 16; if (r < u.valid) { const float g = gt[ai][m]; bf16* yp = YB + (size_t)ids[r] * D + col0;
#pragma unroll
                for (int bj = 0; bj < 2; ++bj) { const pg8::f32x4 v0 = (acc[ai][bj][m][0] * (1.f / (WSCALE * ASCALE)) + bv[bj][0]) * g, v1 = (acc[ai][bj][m][1] * (1.f / (WSCALE * ASCALE)) + bv[bj][1]) * g;
                    v4u w; w.x = pg8::cvt_pk_bf16(v0[0], v0[1]); w.y = pg8::cvt_pk_bf16(v0[2], v0[3]); w.z = pg8::cvt_pk_bf16(v1[0], v1[1]); w.w = pg8::cvt_pk_bf16(v1[2], v1[3]);
                    *(v4u*)(yp + bj * 128) = w; } } }
    }
};
__device__ __forceinline__ void final_phase(Frame& F) {
    const int gw = F.vcu * NWAVES + F.wave, NGW = F.G * NWAVES;
    const bf16* YB = (const bf16*)(F.ws + WS_YB);
    for (int t = gw; t < T; t += NGW) {
        float v[16]; float ss = 0.f;
#pragma unroll
        for (int jj = 0; jj < 2; ++jj) { const int c = 512 * jj + 8 * F.lane;
            const f32x4 a = *(const f32x4*)(F.x + (size_t)t * D + c), b = *(const f32x4*)(F.x + (size_t)t * D + c + 4);
            const v4u y0 = *(const v4u*)((const bf16*)(F.ws + WS_Y) + (size_t)t * D + c);
            float* vv = v + 8 * jj; vv[0] = a.x + bflo(y0.x); vv[1] = a.y + bfhi(y0.x); vv[2] = a.z + bflo(y0.y); vv[3] = a.w + bfhi(y0.y); vv[4] = b.x + bflo(y0.z); vv[5] = b.y + bfhi(y0.z); vv[6] = b.z + bflo(y0.w); vv[7] = b.w + bfhi(y0.w);
#pragma unroll
            for (int k = 0; k < 4; ++k) { const v4u y = *(const v4u*)(YB + ((size_t)t * 4 + k) * D + c);
                vv[0] += bflo(y.x); vv[1] += bfhi(y.x); vv[2] += bflo(y.y); vv[3] += bfhi(y.y); vv[4] += bflo(y.z); vv[5] += bfhi(y.z); vv[6] += bflo(y.w); vv[7] += bfhi(y.w); } }
#pragma unroll
        for (int i = 0; i < 16; ++i) ss += v[i] * v[i];
        const float rstd = 1.f / sqrtf(wave_sum(ss) * (1.f / D) + EPS);
#pragma unroll
        for (int jj = 0; jj < 2; ++jj) { const int c = 512 * jj + 8 * F.lane; const f32x4 g0 = *(const f32x4*)(F.g_fin + c), g1 = *(const f32x4*)(F.g_fin + c + 4); const float* vv = v + 8 * jj;
            f32x4 o0, o1; o0.x = vv[0] * rstd * g0.x; o0.y = vv[1] * rstd * g0.y; o0.z = vv[2] * rstd * g0.z; o0.w = vv[3] * rstd * g0.w;
            o1.x = vv[4] * rstd * g1.x; o1.y = vv[5] * rstd * g1.y; o1.z = vv[6] * rstd * g1.z; o1.w = vv[7] * rstd * g1.w;
            *(f32x4*)(F.out + (size_t)t * D + c) = o0; *(f32x4*)(F.out + (size_t)t * D + c + 4) = o1; }
    }
}
struct Args { const float* in[17]; float* out; unsigned char* ws; int ph_lo, ph_hi, use_bar, pad; };
__global__ void __launch_bounds__(NWAVES * 64, 2) mk_fwd(Args args) {
    extern __shared__ __attribute__((aligned(16))) unsigned char lds[];
    Frame F;
    F.lds = (LAS unsigned char*)lds;
    F.MISC = (volatile LAS unsigned*)(F.lds + MISC_OFF);
    F.tid = threadIdx.x; F.lane = F.tid & 63; F.wave = __builtin_amdgcn_readfirstlane(F.tid >> 6);
    F.G = gridDim.x; { const int bx = blockIdx.x; F.vcu = (F.G % 8 == 0) ? (bx % 8) * (F.G / 8) + bx / 8 : bx; }
    F.ws = args.ws; F.out = args.out; F.ctl = (gu32*)(args.ws + WS_CTL);
    F.x = args.in[0]; F.mem = args.in[1]; F.g_attn = args.in[2]; F.g_mem = args.in[3]; F.w_in = args.in[4]; F.lamqk = args.in[5]; F.subg = args.in[6]; F.w_mkv = args.in[7];
    F.w_out = args.in[8]; F.g_ffn = args.in[9]; F.w_r = args.in[10]; F.b_r = args.in[11]; F.w_gu = args.in[12]; F.b_gu = args.in[13]; F.w_dn = args.in[14]; F.b_dn = args.in[15]; F.g_fin = args.in[16];
    for (int u = F.tid; u < (LDS_BYTES - LDSCTL_OFF) / 4; u += NWAVES * 64) ((LAS unsigned*)(F.lds + LDSCTL_OFF))[u] = 0u;
    __syncthreads();
    XcdBarrier bar; bar.bar = (unsigned*)(F.ctl + CW_BAR); bar.x = 0; bar.st = nullptr;
    if (args.use_bar) bar = xcd_barrier_post((unsigned*)(F.ctl + CW_BAR), F.MISC + 8);
    const int lo = args.ph_lo, hi = args.ph_hi;
#define IN(k) (lo <= (k) && (k) < hi)
#define SEAM(k) do { if (IN(k) && IN((k) + 1)) xcd_barrier(bar); } while (0)
    if (IN(0)) { p0_prologue(F); } SEAM(0);
    if (IN(1)) {
        pg8::Gemm g{(const void*)(F.ws + WS_XB), (const void*)(F.ws + WS_WIN), 2 * D}; pg8::StaticOrder S; S.init(T, DIN, 2 * D, F.G, (int)blockIdx.x);
        EpiInProj E{(bf16*)(F.ws + WS_P), (const float*)(F.ws + WS_RSTD1), (unsigned*)(F.ctl + CW_NRM)};
        pg8::gemm_phase<EpiInProj, pg8::StaticOrder, true, false, false>(F.lds + RING_OFF, (LAS unsigned*)(F.lds + IDB_OFF), g, S, E);
    } SEAM(1);
    if (IN(2)) { attn_phase(F, (char*)lds + RING_OFF); } SEAM(2);
    if (IN(3)) { dil_combine_phase(F); } SEAM(3);
    if (IN(4)) {
        pg8::Gemm g{(const void*)(F.ws + WS_MIX), (const void*)(F.ws + WS_WOUT), 2 * D}; pg8::StaticOrder S; S.init(T, D, 2 * D, F.G, (int)blockIdx.x);
        EpiY E{(bf16*)(F.ws + WS_Y)};
        pg8::gemm_phase<EpiY, pg8::StaticOrder, true, false, false>(F.lds + RING_OFF, (LAS unsigned*)(F.lds + IDB_OFF), g, S, E);
    } SEAM(4);
    if (IN(5)) { route_phase(F); } SEAM(5);
    if (IN(6)) {
        const int nmt = moe_build_table(F);
        pg8::Gemm g{(const void*)(F.ws + WS_X1B), (const void*)(F.ws + WS_WGU), D};
        MoeOrder S{(const LAS unsigned*)(F.lds + TBL_OFF), (const LAS unsigned*)(F.lds + LCNT_OFF), (const unsigned*)(F.ws + WS_LIST), nmt, F.G, F.vcu, 8, 4, D, (size_t)2 * DFF * D, false};
        EpiGU E{(unsigned char*)(F.ws + WS_ACT), (const float*)(F.ws + WS_RSTD2), F.b_gu};
        pg8::gemm_phase<EpiGU, MoeOrder, true, true, true, true>(F.lds + RING_OFF, (LAS unsigned*)(F.lds + IDB_OFF), g, S, E);
    } SEAM(6);
    if (IN(7)) {
        const int nmt = moe_build_table(F);
        pg8::Gemm g{(const void*)(F.ws + WS_ACT), (const void*)(F.ws + WS_WDN), DFF};
        MoeOrder S{(const LAS unsigned*)(F.lds + TBL_OFF), (const LAS unsigned*)(F.lds + LCNT_OFF), (const unsigned*)(F.ws + WS_LIST), nmt, F.G, F.vcu, 4, 8, DFF, (size_t)D * DFF, true};
        EpiDown E{(bf16*)(F.ws + WS_YB), (const float*)(F.ws + WS_RGATE), F.b_dn};
        pg8::gemm_phase<EpiDown, MoeOrder, true, true, true, true, true>(F.lds + RING_OFF, (LAS unsigned*)(F.lds + IDB_OFF), g, S, E);
    } SEAM(7);
    if (IN(8)) { final_phase(F); }
#undef IN
#undef SEAM
}

static void launch_phases(const Args& base, int lo, int hi, int use_bar, int grid, hipStream_t stream) {
    Args a = base; a.ph_lo = lo; a.ph_hi = hi; a.use_bar = use_bar;
    hipLaunchKernelGGL(mk_fwd, dim3(grid), dim3(NWAVES * 64), LDS_BYTES, stream, a);
}
extern "C" void kernel_launch(void* const* d_in, const int* in_sizes, int n_in, void* d_out, int out_size, void* d_ws, size_t ws_size, hipStream_t stream) {
    static int grid = 0;
    if (grid == 0) {
        if (n_in != 17 || in_sizes[0] != T * D || out_size != T * D || ws_size < (size_t)1000 * MiB) { fprintf(stderr, "kernel_launch: unexpected shapes / workspace (%d inputs, ws %zu)\n", n_in, ws_size); grid = -1; return; }
        int dev = 0, cus = 0, per_cu = 0;
        if (hipGetDevice(&dev) != hipSuccess || hipDeviceGetAttribute(&cus, hipDeviceAttributeMultiprocessorCount, dev) != hipSuccess) { grid = -1; return; }
        if (hipFuncSetAttribute((const void*)mk_fwd, hipFuncAttributeMaxDynamicSharedMemorySize, LDS_BYTES) != hipSuccess) { fprintf(stderr, "kernel_launch: hipFuncSetAttribute failed\n"); grid = -1; return; }
        if (hipOccupancyMaxActiveBlocksPerMultiprocessor(&per_cu, (const void*)mk_fwd, NWAVES * 64, LDS_BYTES) != hipSuccess || per_cu < 1) { fprintf(stderr, "kernel_launch: occupancy query says %d blocks per CU\n", per_cu); per_cu = 1; }
        (void)hipGetLastError();
        grid = cus;
        if (grid != 256) { fprintf(stderr, "kernel_launch: built for a 256-CU device (got %d)\n", cus); grid = -1; return; }
    }
    if (grid < 0) return;
    (void)hipMemsetAsync((char*)d_ws + WS_CTL, 0, CTL_ZERO_BYTES, stream);
    Args a{};
    for (int i = 0; i < 17; ++i) a.in[i] = (const float*)d_in[i];
    a.out = (float*)d_out; a.ws = (unsigned char*)d_ws;
    launch_phases(a, 0, 9, 1, grid, stream);
}
```

```cpp
#include <hip/hip_runtime.h>
#include <hip/hip_bf16.h>
#include <cstdint>
#include <cstdio>
#include <cmath>

constexpr int D = 1024, BATCH = 8, SEQ = 4096, T = BATCH * SEQ, DIN = 2560, NMEM = 256, NE = 32, DFF = 1024;
constexpr int C_DQ = 0, C_DK = 512, C_DV = 1024, C_LQ = 1536, C_LK = 1792, C_LV = 2048, C_MQ = 2304;
constexpr float EPS = 1e-5f;
constexpr int LCAP = T;
constexpr float QSCALE = 0.125f * 1.4426950408889634f;
constexpr float LOG2E = 1.4426950408889634f;
namespace pg8 {
#define PG8_LAS __attribute__((address_space(3)))
typedef unsigned short bf16_t;
typedef short bf16x8 __attribute__((ext_vector_type(8)));
typedef float f32x4 __attribute__((ext_vector_type(4)));
typedef unsigned u32x4 __attribute__((ext_vector_type(4)));
typedef unsigned u32x2 __attribute__((ext_vector_type(2)));
constexpr int BM = 256, BK = 64, HALF = 128, HTB = HALF * BK * 2  , STAGE_BYTES = 8 * HTB, NXCD = 8, WGM = 8;

__host__ __device__ __forceinline__ int lds_byte(int r, int c) { const int st = (r >> 4) * 2 + (c >> 5), rr = r & 15, cc = c & 31, ob = rr * 64 + cc * 2; return st * 1024 + (ob ^ (((ob >> 9) & 1) << 5)); }
__host__ __device__ __forceinline__ void stage_rc(int b, int& R, int& C) { const int st = b / 1024, sb = b % 1024, swz = sb ^ (((sb >> 9) & 1) << 5); R = (st >> 1) * 16 + swz / 64; C = (st & 1) * 32 + (swz % 64) / 2; }
__host__ __device__ __forceinline__ int perm32(int rho) { const int n = rho >> 4, i = rho & 15; return 8 * (i >> 2) + 4 * n + (i & 3); }

struct Unit { size_t aoff, boff; int pm, pn, e, valid, mt; };
struct Gemm { const void* A; const void* Bt; int RB; };
typedef int v8i __attribute__((ext_vector_type(8)));

struct StaticOrder {
    int nM, nN, nwg, G, c, RB; const unsigned* sc;
    __device__ void init(int M, int N, int RB_, int G_, int c_, const unsigned* sc_ = nullptr) { nM = M / BM; nN = N / BM; nwg = nM * nN; G = G_; c = c_; RB = RB_; sc = sc_; }
    __device__ bool next(int i, Unit& u) const {
        const long L = (long)i * G + c; if (L >= nwg) return false;
        int wgid = (int)L; { const int q = nwg / NXCD, r = nwg % NXCD, xcd = wgid % NXCD, off = wgid / NXCD; wgid = (xcd < r ? xcd * (q + 1) : r * (q + 1) + (xcd - r) * q) + off; }
        const int nig = WGM * nN, gid = wgid / nig, fm = gid * WGM, gsz = (nM - fm) < WGM ? (nM - fm) : WGM;
        u.pm = fm + ((wgid % nig) % gsz); u.pn = (wgid % nig) / gsz; u.e = 0; u.valid = 256; u.mt = 0;
        u.aoff = (size_t)u.pm * (size_t)(BM * RB); u.boff = (size_t)u.pn * (size_t)(BM * RB); return true;
    }
    __device__ __forceinline__ const unsigned* id_src(const Unit& u, int row) const { return sc + u.pm * 256 + row; }
    __device__ __forceinline__ const unsigned* sc_src(const Unit& u, int row) const { return sc + u.pm * 256 + row; }
    __device__ __forceinline__ const unsigned* bias_src(const Unit& u, int row) const { return sc + u.pm * 256 + row; }
};

__device__ __forceinline__ unsigned cvt_pk_bf16(float lo, float hi) { unsigned r; asm volatile("v_cvt_pk_bf16_f32 %0, %1, %2" : "=v"(r) : "v"(lo), "v"(hi)); return r; }

template <class Epi, class Sched, bool ALIGN_EPI, bool GATHER, bool IDS, bool FP8 = false, bool LINEAR = false>
__device__ __forceinline__ void gemm_phase(PG8_LAS unsigned char* lds, PG8_LAS unsigned* idb, const Gemm g, const Sched& S, const Epi& E) {
    const int tid = threadIdx.x, wid = __builtin_amdgcn_readfirstlane(tid >> 6), lane = tid & 63, wr = wid >> 2, wc = wid & 3, fr = lane & 15, fq = lane >> 4;
    const int RB = g.RB; int nt = RB / (BK * 2); asm volatile("" : "+s"(nt));
    unsigned voffA[2], voffB[2]; int RA[2], CA[2];
#pragma unroll
    for (int i = 0; i < 2; ++i) { int R, C; stage_rc(tid * 16 + i * 8192, R, C); const int Rb = (R & ~31) + perm32(R & 31); RA[i] = R; CA[i] = C;
        voffA[i] = (unsigned)(R * RB + C * 2); voffB[i] = (unsigned)(Rb * RB + C * 2); }
    const size_t kstep = (size_t)(BK * 2);
    const size_t hstep = (size_t)HALF * RB;
    const unsigned ldsw = (unsigned)wid * 1024u;
    const int aoff = lds_byte(wr * 64 + fr, fq * 8), boff = lds_byte(wc * 32 + fr, fq * 8);
#define PG8_SA(b, h) (((b) * 2 + (h)) * HTB)
#define PG8_SB(b, h) ((4 + (b) * 2 + (h)) * HTB)
#define PG8_STAGE(bufoff, gbase, voff) do { _Pragma("unroll") for (int _i = 0; _i < 2; ++_i) \
        __builtin_amdgcn_global_load_lds((const unsigned*)((const char*)(gbase) + (voff)[_i]), (PG8_LAS unsigned*)(lds + (bufoff) + ldsw + _i * 8192), 16, 0, 0); } while (0)
#define PG8_STAGE_A(bufoff, pbase, gbase, h, gv) do { if constexpr (GATHER) { PG8_STAGE(bufoff, gbase, gv[h]); } else { PG8_STAGE(bufoff, (pbase) + (h) * hstep, voffA); } } while (0)
#define PG8_LD32(p0_, p1_) __builtin_bit_cast(v8i, __builtin_shufflevector(*(const PG8_LAS u32x4*)(p0_), *(const PG8_LAS u32x4*)(p1_), 0, 1, 2, 3, 4, 5, 6, 7))
#define PG8_LDA(dst, b, h) do { if constexpr (FP8) { _Pragma("unroll") for (int m = 0; m < 4; ++m) dst##8[m] = PG8_LD32(lds + PG8_SA(b, h) + aoff + m * 2048, lds + PG8_SA(b, h) + aoff + m * 2048 + 1024); } \
        else { _Pragma("unroll") for (int m = 0; m < 4; ++m) _Pragma("unroll") for (int k = 0; k < 2; ++k) dst[m][k] = *(const PG8_LAS bf16x8*)(lds + PG8_SA(b, h) + aoff + m * 2048 + k * 1024); } } while (0)
#define PG8_LDB(dst, b, h) do { if constexpr (FP8) { _Pragma("unroll") for (int n = 0; n < 2; ++n) dst##8[n] = PG8_LD32(lds + PG8_SB(b, h) + boff + n * 2048, lds + PG8_SB(b, h) + boff + n * 2048 + 1024); } \
        else { _Pragma("unroll") for (int n = 0; n < 2; ++n) _Pragma("unroll") for (int k = 0; k < 2; ++k) dst[n][k] = *(const PG8_LAS bf16x8*)(lds + PG8_SB(b, h) + boff + n * 2048 + k * 1024); } } while (0)
#define PG8_MMA(ai, bj, At, Bt) do { __builtin_amdgcn_s_setprio(1); if constexpr (FP8) { _Pragma("unroll") for (int m = 0; m < 4; ++m) _Pragma("unroll") for (int n = 0; n < 2; ++n) \
        acc[ai][bj][m][n] = __builtin_amdgcn_mfma_scale_f32_16x16x128_f8f6f4(Bt##8[n], At##8[m], acc[ai][bj][m][n], 0, 0, 0, 0x7f7f7f7f, 0, 0x7f7f7f7f); } \
        else { _Pragma("unroll") for (int m = 0; m < 4; ++m) _Pragma("unroll") for (int n = 0; n < 2; ++n) _Pragma("unroll") for (int k = 0; k < 2; ++k) \
        acc[ai][bj][m][n] = __builtin_amdgcn_mfma_f32_16x16x32_bf16(Bt[n][k], At[m][k], acc[ai][bj][m][n], 0, 0, 0); } __builtin_amdgcn_s_setprio(0); } while (0)
#define PG8_WAIT_V(n) asm volatile("s_waitcnt vmcnt(" #n ")" ::: "memory")
#define PG8_WAIT_L(n) asm volatile("s_waitcnt lgkmcnt(" #n ")" ::: "memory")
#define PG8_BAR __builtin_amdgcn_s_barrier()
#define PG8_SCHED __builtin_amdgcn_sched_barrier(0)
#define PG8_IDS_DMA(u, s) do { if (wid < 4) { __builtin_amdgcn_global_load_lds(S.id_src(u, tid), (PG8_LAS unsigned*)(idb + (s) * 768 + wid * 64), 4, 0, 0); \
        __builtin_amdgcn_global_load_lds(S.sc_src(u, tid), (PG8_LAS unsigned*)(idb + (s) * 768 + 256 + wid * 64), 4, 0, 0); \
        __builtin_amdgcn_global_load_lds(S.bias_src(u, tid), (PG8_LAS unsigned*)(idb + (s) * 768 + 512 + wid * 64), 4, 0, 0); } } while (0)
#define PG8_GV(dst, s, un) do { _Pragma("unroll") for (int _h = 0; _h < 2; ++_h) _Pragma("unroll") for (int _i = 0; _i < 2; ++_i) \
        dst[_h][_i] = (LINEAR ? (unsigned)((un).pm * 256 + _h * 128 + RA[_i]) : (idb[(s) * 768 + _h * 128 + RA[_i]] >> 2)) * (unsigned)RB + (unsigned)(CA[_i] * 2); } while (0)
    Unit cur, nxt; int ui = 0, us = 0;
    if (!S.next(0, cur)) return;
    f32x4 acc[2][2][4][2];
#pragma unroll
    for (int a = 0; a < 2; ++a)
#pragma unroll
        for (int b = 0; b < 2; ++b)
#pragma unroll
            for (int m = 0; m < 4; ++m)
#pragma unroll
                for (int n = 0; n < 2; ++n) acc[a][b][m][n] = (f32x4){0.f, 0.f, 0.f, 0.f};
    bf16x8 At[4][2], B0[2][2], B1[2][2]; v8i At8[4], B08[2], B18[2];
    unsigned cv[2][2] = {{0u, 0u}, {0u, 0u}};
    const char* A0 = (const char*)g.A;
    const char* cA = A0 + (GATHER ? (size_t)0 : cur.aoff); const char* cB = (const char*)g.Bt + cur.boff;
    if constexpr (IDS) {
        PG8_IDS_DMA(cur, 0); PG8_WAIT_V(0); PG8_BAR;
    }
    if constexpr (GATHER) { PG8_GV(cv, 0, cur); }
    PG8_STAGE(PG8_SB(0, 0), cB, voffB); PG8_STAGE(PG8_SB(0, 1), cB + hstep, voffB); PG8_STAGE_A(PG8_SA(0, 0), cA, A0, 0, cv); PG8_STAGE_A(PG8_SA(0, 1), cA, A0, 1, cv);
    if (wr == 1) PG8_BAR;
    PG8_WAIT_V(2); PG8_BAR;
    PG8_STAGE(PG8_SB(1, 0), cB + kstep, voffB); PG8_STAGE_A(PG8_SA(1, 0), cA + kstep, A0 + kstep, 0, cv); PG8_STAGE(PG8_SB(1, 1), cB + hstep + kstep, voffB);
    PG8_WAIT_V(6); PG8_BAR;
    for (;;) {
        const bool has_next = S.next(ui + 1, nxt);
        const int ns = (us == 2) ? 0 : us + 1;
        if constexpr (IDS) { if (has_next) PG8_IDS_DMA(nxt, ns); }
        const char* nA = has_next ? A0 + (GATHER ? (size_t)0 : nxt.aoff) : cA; const char* nB = has_next ? (const char*)g.Bt + nxt.boff : cB;
#pragma nounroll
        for (int t = 0; t < nt; t += 2) {
            int lastv = (t == nt - 2) ? 1 : 0; asm volatile("" : "+v"(lastv)); const bool last = __builtin_amdgcn_readfirstlane(lastv) != 0;
            const char* a1 = cA + (size_t)(t + 1) * kstep;
            const char* a2 = last ? nA : cA + (size_t)(t + 2) * kstep; const char* b2 = last ? nB : cB + (size_t)(t + 2) * kstep;
            const char* a3 = a2 + kstep; const char* b3 = b2 + kstep;
            PG8_LDB(B0, 0, 0); PG8_LDB(B1, 0, 1); PG8_SCHED; PG8_LDA(At, 0, 0); PG8_STAGE_A(PG8_SA(1, 1), a1, a1, 1, cv);
            if constexpr (GATHER) { if (last && has_next) { PG8_GV(cv, ns, nxt); } }
            PG8_WAIT_V(8); PG8_WAIT_L(0); PG8_BAR; PG8_MMA(0, 0, At, B0); PG8_MMA(0, 1, At, B1); PG8_BAR; PG8_SCHED;
            PG8_LDA(At, 0, 1); PG8_STAGE(PG8_SB(0, 0), b2, voffB); PG8_STAGE(PG8_SB(0, 1), b2 + hstep, voffB); PG8_STAGE_A(PG8_SA(0, 0), a2, a2, 0, cv);
            PG8_WAIT_V(8); PG8_WAIT_L(0); PG8_BAR; PG8_MMA(1, 0, At, B0); PG8_MMA(1, 1, At, B1); PG8_BAR; PG8_SCHED;
            PG8_LDB(B0, 1, 0); PG8_LDB(B1, 1, 1); PG8_SCHED; PG8_LDA(At, 1, 0); PG8_STAGE_A(PG8_SA(0, 1), a2, a2, 1, cv);
            PG8_WAIT_V(8); PG8_WAIT_L(0); PG8_BAR; PG8_MMA(0, 0, At, B0); PG8_MMA(0, 1, At, B1); PG8_BAR; PG8_SCHED;
            PG8_LDA(At, 1, 1); PG8_STAGE(PG8_SB(1, 0), b3, voffB); PG8_STAGE(PG8_SB(1, 1), b3 + hstep, voffB); PG8_STAGE_A(PG8_SA(1, 0), a3, a3, 0, cv);
            PG8_WAIT_V(8); PG8_WAIT_L(0); PG8_BAR; PG8_MMA(1, 0, At, B0); PG8_MMA(1, 1, At, B1); PG8_BAR; PG8_SCHED;
        }
        if constexpr (ALIGN_EPI) { if (wr == 0) PG8_BAR; }
        PG8_SCHED;
        E(acc, cur, wr, wc, fr, fq, (const PG8_LAS unsigned*)(idb + us * 768));
        PG8_SCHED;
        if (!has_next) break;
#pragma unroll
        for (int a = 0; a < 2; ++a)
#pragma unroll
            for (int b = 0; b < 2; ++b)
#pragma unroll
                for (int m = 0; m < 4; ++m)
#pragma unroll
                    for (int n = 0; n < 2; ++n) acc[a][b][m][n] = (f32x4){0.f, 0.f, 0.f, 0.f};
        cur = nxt; cA = nA; cB = nB; ++ui; us = ns;
        if constexpr (ALIGN_EPI) { if (wr == 1) PG8_BAR; }
    }
    PG8_WAIT_V(0);
    if constexpr (!ALIGN_EPI) { if (wr == 0) PG8_BAR; }
    PG8_BAR;
#undef PG8_SA
#undef PG8_SB
#undef PG8_STAGE
#undef PG8_STAGE_A
#undef PG8_LDA
#undef PG8_LDB
#undef PG8_MMA
#undef PG8_LD32
#undef PG8_WAIT_V
#undef PG8_WAIT_L
#undef PG8_BAR
#undef PG8_SCHED
#undef PG8_IDS_DMA
#undef PG8_GV
}
}
namespace attn_body {
using bf16=__hip_bfloat16;
using bf16x8=__attribute__((ext_vector_type(8)))short;
using s16x4=__attribute__((ext_vector_type(4)))short;
using f32x16=__attribute__((ext_vector_type(16)))float;
using u32x4=__attribute__((ext_vector_type(4)))unsigned;
constexpr int D=64;
constexpr int NW=8,QBLK=32,QB=QBLK*NW,KVBLK=64;
struct UnitP { const bf16* Q; const bf16* K; const bf16* V; bf16* O; long qp, kp, op; int q0, t0, NT; float slope2; float* lse; int lse_stride; };
__device__ __forceinline__ int crow(int r,int hi){return (r&3)+8*(r>>2)+4*hi;}
#define SBAR() __builtin_amdgcn_sched_barrier(0)
template<bool CAUSAL,bool WINDOW> __device__ __forceinline__ void cmask(f32x16&p0,f32x16&p1,int jb,int qrel,int hi){
  const float NEG=-INFINITY; int kb=64*jb+4*hi;
  #pragma unroll
  for(int r=0;r<16;++r){int kv=kb+(r&3)+8*(r>>2);
    if(CAUSAL){ if(kv>qrel)p0[r]=NEG; if(kv+32>qrel)p1[r]=NEG; }
    if(WINDOW){ if(kv<qrel-128)p0[r]=NEG; if(kv+32<qrel-128)p1[r]=NEG; } }
}
__device__ __forceinline__ unsigned bfr(float x){ typedef float f2_ __attribute__((ext_vector_type(2))); typedef __bf16 b2_ __attribute__((ext_vector_type(2))); f2_ v={x,0.f}; b2_ b=__builtin_convertvector(v,b2_); return __builtin_bit_cast(unsigned,b)&0xffffu; }
__device__ __forceinline__ float bfv(unsigned b){ return __builtin_bit_cast(float,b<<16); }

constexpr int NSLOT=3, SLOTB=8192;
constexpr int LDS_K=0, LDS_V=NSLOT*SLOTB, LDS_WS=2*NSLOT*SLOTB, LDS_OST=LDS_WS+NW*64*4, LDS_BYTES=LDS_OST+NW*4096;
__device__ __forceinline__ void glds16(const void*gsrc,unsigned lds_dst){unsigned keep;
  asm volatile("s_mov_b32 %0, m0\n\ts_mov_b32 m0, %2\n\ts_nop 0\n\tglobal_load_lds_dwordx4 %1, off\n\ts_mov_b32 m0, %0":"=&s"(keep):"v"(gsrc),"s"(lds_dst):"memory");}
__device__ __forceinline__ float max3f(float a,float b,float c){float r;asm("v_max3_f32 %0, %1, %2, %3":"=v"(r):"v"(a),"v"(b),"v"(c));return r;}
__device__ __forceinline__ float max2f(float a,float b){float r;asm("v_max_f32_e32 %0, %1, %2":"=v"(r):"v"(a),"v"(b));return r;}
__device__ __forceinline__ float fadd_s(float a,float b){float r;asm("v_add_f32_e32 %0, %1, %2":"=v"(r):"v"(a),"v"(b));return r;}
__device__ __forceinline__ float fsub_s(float a,float b){float r;asm("v_sub_f32_e32 %0, %1, %2":"=v"(r):"v"(a),"v"(b));return r;}
typedef float f32x2_t __attribute__((ext_vector_type(2))); typedef __bf16 bf16x2_t __attribute__((ext_vector_type(2)));
__device__ __forceinline__ unsigned cvtpk_s(float lo,float hi){f32x2_t v={lo,hi};bf16x2_t b=__builtin_convertvector(v,bf16x2_t);return __builtin_bit_cast(unsigned,b);}
#define WAIT_BAR(N) asm volatile("s_waitcnt vmcnt(" #N ") lgkmcnt(0)\n\ts_barrier":::"memory")

__device__ __forceinline__ void qkt(f32x16&p0,f32x16&p1,const char*Kslot,const bf16x8*qr,bf16x8 kx0,bf16x8 kx1,bf16x8 qx,int r32,int hi){
  const char*kb=Kslot+hi*1024+r32*16;
  #pragma unroll
  for(int d0=0;d0<4;++d0){
    const bf16x8 b0=*reinterpret_cast<const bf16x8*>(kb+d0*2048);
    const bf16x8 b1=*reinterpret_cast<const bf16x8*>(kb+d0*2048+512);
    if(d0==0){p0=__builtin_amdgcn_mfma_f32_32x32x16_bf16(b0,qr[0],f32x16{},0,0,0);p1=__builtin_amdgcn_mfma_f32_32x32x16_bf16(b1,qr[0],f32x16{},0,0,0);}
    else{p0=__builtin_amdgcn_mfma_f32_32x32x16_bf16(b0,qr[d0],p0,0,0,0);p1=__builtin_amdgcn_mfma_f32_32x32x16_bf16(b1,qr[d0],p1,0,0,0);}}
  p0=__builtin_amdgcn_mfma_f32_32x32x16_bf16(kx0,qx,p0,0,0,0);p1=__builtin_amdgcn_mfma_f32_32x32x16_bf16(kx1,qx,p1,0,0,0);
}
typedef __attribute__((address_space(3))) const char* lds_cptr;
typedef short v4i16_t __attribute__((ext_vector_type(4)));
__device__ __forceinline__ void kload8(bf16x8*kf,lds_cptr kp){
  kf[0]=*(const __attribute__((address_space(3))) bf16x8*)(kp);      kf[1]=*(const __attribute__((address_space(3))) bf16x8*)(kp+512);
  kf[2]=*(const __attribute__((address_space(3))) bf16x8*)(kp+2048); kf[3]=*(const __attribute__((address_space(3))) bf16x8*)(kp+2560);
  kf[4]=*(const __attribute__((address_space(3))) bf16x8*)(kp+4096); kf[5]=*(const __attribute__((address_space(3))) bf16x8*)(kp+4608);
  kf[6]=*(const __attribute__((address_space(3))) bf16x8*)(kp+6144); kf[7]=*(const __attribute__((address_space(3))) bf16x8*)(kp+6656);
}
__device__ __forceinline__ void kload2(bf16x8*kf,lds_cptr kp,int j){ kf[2*j]=*(const __attribute__((address_space(3))) bf16x8*)(kp+j*2048); kf[2*j+1]=*(const __attribute__((address_space(3))) bf16x8*)(kp+j*2048+512); }
__device__ __forceinline__ s16x4 vtr(lds_cptr p){ return __builtin_bit_cast(s16x4,__builtin_amdgcn_ds_read_tr16_b64_v4i16((__attribute__((address_space(3))) v4i16_t*)p)); }
__device__ __forceinline__ float rowmax(const f32x16&p0,const f32x16&p1){
  float a=max3f(p0[0],p0[1],p1[0]),b=max3f(p0[2],p0[3],p1[1]);a=max3f(a,p1[2],p1[3]);
  #pragma unroll
  for(int r=4;r<16;r+=4){a=max3f(a,p0[r],p0[r+1]);b=max3f(b,p0[r+2],p0[r+3]);a=max3f(a,p1[r],p1[r+1]);b=max3f(b,p1[r+2],p1[r+3]);}
  const float m=max2f(a,b);
  auto rr=__builtin_amdgcn_permlane32_swap(__float_as_uint(m),__float_as_uint(m),false,false);
  return max2f(__uint_as_float(rr[0]),__uint_as_float(rr[1]));
}
__device__ __forceinline__ void pv(f32x16*o,int vb,bf16x8 pa0,bf16x8 pa1,bf16x8 pa2,bf16x8 pa3){
  #pragma unroll
  for(int d0=0;d0<2;++d0){s16x4 lo[4],hi[4];
    #pragma unroll
    for(int ks=0;ks<4;++ks){
      asm volatile("ds_read_b64_tr_b16 %0,%1 offset:%c2":"=&v"(lo[ks]):"v"(vb),"i"(d0*4096+ks*1024):"memory");
      asm volatile("ds_read_b64_tr_b16 %0,%1 offset:%c2":"=&v"(hi[ks]):"v"(vb),"i"(d0*4096+ks*1024+512):"memory");}
    asm volatile("s_waitcnt lgkmcnt(0)":::"memory");SBAR();
    #define PK(k) (bf16x8){lo[k][0],lo[k][1],lo[k][2],lo[k][3],hi[k][0],hi[k][1],hi[k][2],hi[k][3]}
    o[d0]=__builtin_amdgcn_mfma_f32_32x32x16_bf16(pa0,PK(0),o[d0],0,0,0);
    o[d0]=__builtin_amdgcn_mfma_f32_32x32x16_bf16(pa1,PK(1),o[d0],0,0,0);
    o[d0]=__builtin_amdgcn_mfma_f32_32x32x16_bf16(pa2,PK(2),o[d0],0,0,0);
    o[d0]=__builtin_amdgcn_mfma_f32_32x32x16_bf16(pa3,PK(3),o[d0],0,0,0);
    #undef PK
  }
}

#ifndef ATTN_STORE16
#define ATTN_STORE16(p,v) (*(u32x4*)(p)=(v))
#endif
template<int THRL,bool CAUSAL,bool WINDOW,bool ALIBI,bool LSE> __device__ __forceinline__ void attn_unit(const UnitP&U,char*shm){
  int tid=threadIdx.x; asm volatile("":"+v"(tid));
  const int lane=tid&63,r32=lane&31,hi=lane>>5; const int wid=__builtin_amdgcn_readfirstlane(tid>>6);
  const int q0=U.q0; const long qp=U.qp,kp=U.kp,op=U.op; const float slope2=U.slope2;
  const bf16*Qw=U.Q+(long)(q0+wid*QBLK)*qp;
  const bf16*Kh=U.K+(long)U.t0*KVBLK*kp,*Vh=U.V+(long)U.t0*KVBLK*kp;
  const unsigned lds0=(unsigned)(uintptr_t)shm;
  float*wsf=(float*)(shm+LDS_WS)+wid*64;
  const bf16*ksrc=Kh+(long)lane*kp+wid*8;
  const bf16*vsrc=Vh+(long)(16*(wid&3)+(lane>>2))*kp+(wid>>2)*32+(lane&3)*8;
  const unsigned kdst=lds0+LDS_K+wid*1024, vdst=lds0+LDS_V+wid*1024;
  #define DMA_K(t,slot) glds16(ksrc+(long)(t)*KVBLK*kp,(unsigned)__builtin_amdgcn_readfirstlane(kdst+(slot)))
  #define DMA_V(t,slot) glds16(vsrc+(long)(t)*KVBLK*kp,(unsigned)__builtin_amdgcn_readfirstlane(vdst+(slot)))
  const int vb0=(int)(lds0+LDS_V)+((lane>>4)&1)*32+(lane&3)*8+(4*hi+((lane&15)>>2))*64;
  const char*Kbase=shm+LDS_K; bf16x8 kf[8];
  const lds_cptr shm3=(lds_cptr)shm; const lds_cptr kp0=shm3+LDS_K+hi*1024+r32*16; const lds_cptr vp0=shm3+LDS_V+((lane>>4)&1)*32+(lane&3)*8+(4*hi+((lane&15)>>2))*64;
  const int NT=U.NT;
  DMA_K(0,0);DMA_V(0,0);DMA_K(1,SLOTB);
  bf16x8 qr[4];
  #pragma unroll
  for(int d0=0;d0<4;++d0)qr[d0]=*reinterpret_cast<const bf16x8*>(&Qw[(long)r32*qp+d0*16+hi*8]);
  float mhat=0.f,l_reg=0.f;f32x16 o[2];o[0]=f32x16{};o[1]=f32x16{};
  const int qrel=wid*QBLK+r32;
  #define CMASK(P0,P1,t) do{int jb_=(t)-(NT-4); if(WINDOW||(CAUSAL&&jb_>=0))cmask<CAUSAL,WINDOW>(P0,P1,jb_,qrel,hi);}while(0)
  bf16x8 kx0,kx1,qx;
  { const float k0_=ALIBI?slope2*(float)r32:0.f, k1_=ALIBI?slope2*(float)(r32+32):0.f; const unsigned h0=bfr(k0_),l0=bfr(k0_-bfv(h0)),h1=bfr(k1_),l1=bfr(k1_-bfv(h1));
    u32x4 a={0x3f803f80u,0x3f80u|(h0<<16),l0,0u}, b={0x3f803f80u,0x3f80u|(h1<<16),l1,0u}; if(hi){a=u32x4{0u,0u,0u,0u};b=a;} kx0=__builtin_bit_cast(bf16x8,a); kx1=__builtin_bit_cast(bf16x8,b); }
  #define QX_SET(t) do{ const float nb_=ALIBI?__builtin_fmaf(slope2,(float)(64*((t)-(NT-4))-qrel),-mhat):-mhat; const unsigned a_=bfr(nb_); const float r1_=nb_-bfv(a_); const unsigned b_=bfr(r1_); const unsigned c_=bfr(r1_-bfv(b_)); \
    u32x4 q_={a_|(b_<<16),c_|0x3f800000u,0x3f80u,0u}; if(hi)q_=u32x4{0u,0u,0u,0u}; qx=__builtin_bit_cast(bf16x8,q_); asm volatile("":"+v"(qx)); }while(0)
  bool resc=false;
  #define START(P0,P1) do{ const float rm=rowmax(P0,P1); resc=false; \
    { const float dl=(rm==-INFINITY)?0.f:rm; mhat=fadd_s(mhat,dl); \
      _Pragma("unroll") for(int r=0;r<16;++r){P0[r]=fsub_s(P0[r],dl);P1[r]=fsub_s(P1[r],dl);} } \
    _Pragma("unroll") for(int r=0;r<16;++r)P0[r]=__builtin_amdgcn_exp2f(P0[r]); }while(0)
  #define RESC() do{ if(resc){ asm volatile("s_waitcnt lgkmcnt(0)":::"memory"); \
      _Pragma("unroll") for(int d_=0;d_<2;++d_) _Pragma("unroll") for(int r=0;r<16;++r)o[d_][r]*=wsf[crow(r,hi)]; } }while(0)
  f32x16 pA0,pA1,pB0,pB1;
  int sl_prev=0,sl_cur=0,sl_next=SLOTB;
  #define ROT() do{sl_prev=sl_cur;sl_cur=sl_next;sl_next=(sl_next==(NSLOT-1)*SLOTB)?0:sl_next+SLOTB;}while(0)
  DMA_K(2,2*SLOTB);
  WAIT_BAR(3);
  QX_SET(0);
  qkt(pA0,pA1,Kbase,qr,kx0,kx1,qx,r32,hi);asm volatile("s_nop 15\n\ts_nop 7":"+v"(pA0),"+v"(pA1));CMASK(pA0,pA1,0);
  START(pA0,pA1);
  _Pragma("unroll") for(int r=0;r<16;++r)pA1[r]=__builtin_amdgcn_exp2f(pA1[r]);
  WAIT_BAR(0);
  DMA_K(3,0);DMA_V(1,SLOTB);
  ROT();
  kload8(kf,kp0+sl_cur);
  WAIT_BAR(2);
  s16x4 vlo[8],vhi[8]; u32x4 pw0,pw1,pw2,pw3;
  #define PKW(P,B) cvtpk_s(P[B],P[B+1])
  #define PAF(k) __builtin_bit_cast(bf16x8,pw##k)
  #define VFR(i) (bf16x8){vlo[i][0],vlo[i][1],vlo[i][2],vlo[i][3],vhi[i][0],vhi[i][1],vhi[i][2],vhi[i][3]}
  #define PIN(x) asm volatile("":"+v"(x))
  #define MX3(a,b,c) __builtin_fmaxf(__builtin_fmaxf((a),(b)),(c))
  #define GAPA(MF,A0,A1,A2,A3,W0,W1,PW) do{ MF; sacc+=A0; sacc+=A1; sacc+=A2; sacc+=A3; PIN(sacc); W0; W1; PIN(PW); SBAR(); }while(0)
  #define EX(v) __builtin_amdgcn_exp2f(v)
  #define GAPB(MF,X,B) do{ MF; X[B]=EX(X[B]); X[B+1]=EX(X[B+1]); X[B+2]=EX(X[B+2]); X[B+3]=EX(X[B+3]); PIN(X); SBAR(); }while(0)
  #define VRD(i) do{ vlo[i]=vtr(vp_+(((i)>>2)*4096+((i)&3)*1024)); vhi[i]=vtr(vp_+(((i)>>2)*4096+((i)&3)*1024+512)); }while(0)
  #define KRD(G,j) do{ if(G){ kload2(kf,kp0+sl_next,j); SBAR(); } }while(0)
  #define STEP(C0,C1,P0,P1,t,GK,GV,GL) do{ SBAR(); QX_SET(t); SBAR(); \
    const lds_cptr vp_=vp0+sl_prev; \
    VRD(0); SBAR(); float sacc=(P0[0]+P0[1]); \
    GAPA(C0=__builtin_amdgcn_mfma_f32_32x32x16_bf16(kf[0],qr[0],f32x16{},0,0,0), P0[2],P0[3],P0[4],P0[5],     pw0[0]=PKW(P0,0), pw0[1]=PKW(P0,2), pw0); \
    VRD(4); SBAR(); GAPA(C1=__builtin_amdgcn_mfma_f32_32x32x16_bf16(kf[1],qr[0],f32x16{},0,0,0), P0[6],P0[7],P0[8],P0[9],     pw0[2]=PKW(P0,4), pw0[3]=PKW(P0,6), pw0); \
    VRD(1); SBAR(); GAPA(C0=__builtin_amdgcn_mfma_f32_32x32x16_bf16(kf[2],qr[1],C0,0,0,0),   P0[10],P0[11],P0[12],P0[13], pw1[0]=PKW(P0,8), pw1[1]=PKW(P0,10), pw1); \
    VRD(5); SBAR(); GAPA(C1=__builtin_amdgcn_mfma_f32_32x32x16_bf16(kf[3],qr[1],C1,0,0,0),   P0[14],P0[15],P1[0],P1[1],   pw1[2]=PKW(P0,12),pw1[3]=PKW(P0,14), pw1); \
    VRD(2); SBAR(); GAPA(C0=__builtin_amdgcn_mfma_f32_32x32x16_bf16(kf[4],qr[2],C0,0,0,0),   P1[2],P1[3],P1[4],P1[5],     pw2[0]=PKW(P1,0), pw2[1]=PKW(P1,2), pw2); \
    VRD(6); SBAR(); GAPA(C1=__builtin_amdgcn_mfma_f32_32x32x16_bf16(kf[5],qr[2],C1,0,0,0),   P1[6],P1[7],P1[8],P1[9],     pw2[2]=PKW(P1,4), pw2[3]=PKW(P1,6), pw2); \
    VRD(3); SBAR(); GAPA(C0=__builtin_amdgcn_mfma_f32_32x32x16_bf16(kf[6],qr[3],C0,0,0,0),   P1[10],P1[11],P1[12],P1[13], pw3[0]=PKW(P1,8), pw3[1]=PKW(P1,10), pw3); \
    VRD(7); SBAR(); GAPA(C1=__builtin_amdgcn_mfma_f32_32x32x16_bf16(kf[7],qr[3],C1,0,0,0),   P1[14],P1[15],0.f,0.f,       pw3[2]=PKW(P1,12),pw3[3]=PKW(P1,14), pw3); \
    C0=__builtin_amdgcn_mfma_f32_32x32x16_bf16(kx0,qx,C0,0,0,0); C1=__builtin_amdgcn_mfma_f32_32x32x16_bf16(kx1,qx,C1,0,0,0); SBAR(); \
    l_reg+=sacc; \
    if(GK){DMA_K((t)+3,sl_cur);} if(GV){DMA_V((t)+1,sl_next);} \
    CMASK(C0,C1,t); \
    { float a=MX3(C0[0],C0[1],C1[0]),b=MX3(C0[2],C0[3],C1[1]); a=MX3(a,C1[2],C1[3]); \
      _Pragma("unroll") for(int r=4;r<16;r+=4){a=MX3(a,C0[r],C0[r+1]);b=MX3(b,C0[r+2],C0[r+3]);a=MX3(a,C1[r],C1[r+1]);b=MX3(b,C1[r+2],C1[r+3]);} \
      float rm=__builtin_fmaxf(a,b); { auto rr=__builtin_amdgcn_permlane32_swap(__float_as_uint(rm),__float_as_uint(rm),false,false); rm=__builtin_fmaxf(__uint_as_float(rr[0]),__uint_as_float(rr[1])); } \
      resc=false; \
      if(__builtin_expect(__any(rm>(float)THRL),0)){ const float dl=__builtin_fmaxf(rm,0.f); mhat+=dl; \
        _Pragma("unroll") for(int r=0;r<16;++r){C0[r]-=dl;C1[r]-=dl;} \
        const float f=__builtin_amdgcn_exp2f(-dl); l_reg*=f; if(hi==0)wsf[r32]=f; resc=true; } } \
    SBAR(); \
    GAPB(o[0]=__builtin_amdgcn_mfma_f32_32x32x16_bf16(PAF(0),VFR(0),o[0],0,0,0), C0,0); \
    GAPB(o[1]=__builtin_amdgcn_mfma_f32_32x32x16_bf16(PAF(0),VFR(4),o[1],0,0,0), C0,4); \
    KRD(GL,0); GAPB(o[0]=__builtin_amdgcn_mfma_f32_32x32x16_bf16(PAF(1),VFR(1),o[0],0,0,0), C0,8); \
    KRD(GL,1); GAPB(o[1]=__builtin_amdgcn_mfma_f32_32x32x16_bf16(PAF(1),VFR(5),o[1],0,0,0), C0,12); \
    KRD(GL,2); GAPB(o[0]=__builtin_amdgcn_mfma_f32_32x32x16_bf16(PAF(2),VFR(2),o[0],0,0,0), C1,0); \
    KRD(GL,3); GAPB(o[1]=__builtin_amdgcn_mfma_f32_32x32x16_bf16(PAF(2),VFR(6),o[1],0,0,0), C1,4); \
    GAPB(o[0]=__builtin_amdgcn_mfma_f32_32x32x16_bf16(PAF(3),VFR(3),o[0],0,0,0), C1,8); \
    GAPB(o[1]=__builtin_amdgcn_mfma_f32_32x32x16_bf16(PAF(3),VFR(7),o[1],0,0,0), C1,12); \
    }while(0)
  int t=1;
  #undef CMASK
  #define CMASK(P0,P1,t) do{}while(0)
  for(;t+5<NT;t+=2){
    STEP(pB0,pB1,pA0,pA1,t,true,true,true);     WAIT_BAR(2); RESC(); ROT();
    STEP(pA0,pA1,pB0,pB1,t+1,true,true,true);   WAIT_BAR(2); RESC(); ROT();
  }
  #undef CMASK
  #define CMASK(P0,P1,t) do{int jb_=(t)-(NT-4); if(WINDOW||(CAUSAL&&jb_>=0))cmask<CAUSAL,WINDOW>(P0,P1,jb_,qrel,hi);}while(0)
  #define ENDW(tt) do{ if((tt)+3<NT){WAIT_BAR(2);} else if((tt)+2<NT){WAIT_BAR(1);} else {WAIT_BAR(0);} }while(0)
  for(;t+1<NT;t+=2){
    STEP(pB0,pB1,pA0,pA1,t,(t+3<NT),(t+1<NT),(t+1<NT));       ENDW(t);   RESC(); ROT();
    STEP(pA0,pA1,pB0,pB1,t+1,(t+4<NT),(t+2<NT),(t+2<NT));     ENDW(t+1); RESC(); ROT();
  }
  STEP(pB0,pB1,pA0,pA1,NT-1,false,false,false); RESC();
  { float sacc=pB0[0]+pB0[1]; _Pragma("unroll") for(int r=2;r<16;++r)sacc+=pB0[r]; _Pragma("unroll") for(int r=0;r<16;++r)sacc+=pB1[r]; l_reg+=sacc;
    pw0=(u32x4){PKW(pB0,0),PKW(pB0,2),PKW(pB0,4),PKW(pB0,6)};pw1=(u32x4){PKW(pB0,8),PKW(pB0,10),PKW(pB0,12),PKW(pB0,14)};pw2=(u32x4){PKW(pB1,0),PKW(pB1,2),PKW(pB1,4),PKW(pB1,6)};pw3=(u32x4){PKW(pB1,8),PKW(pB1,10),PKW(pB1,12),PKW(pB1,14)};
    SBAR(); pv(o,vb0+sl_cur,PAF(0),PAF(1),PAF(2),PAF(3)); }
  #undef PKW
  #undef PAF
  #undef VFR
  #undef PIN
  #undef MX3
  #undef GAPA
  #undef GAPB
  #undef EX
  #undef VRD
  #undef KRD
  #undef STEP
  #undef ENDW
  {auto rr=__builtin_amdgcn_permlane32_swap(__float_as_uint(l_reg),__float_as_uint(l_reg),false,false);l_reg=__uint_as_float(rr[0])+__uint_as_float(rr[1]);}
  if(LSE){ if(hi==0)U.lse[(long)(q0+wid*QBLK+r32)*U.lse_stride]=mhat+__builtin_amdgcn_logf(l_reg); }
  if(hi==0)wsf[32+r32]=l_reg;asm volatile("s_waitcnt lgkmcnt(0)":::"memory");
  float rli[16];
  #pragma unroll
  for(int r=0;r<16;++r)rli[r]=__builtin_amdgcn_rcpf(wsf[32+crow(r,hi)]);
  bf16*Ow=U.O+(long)(q0+wid*QBLK)*op;
  { bf16*stg=(bf16*)(shm+LDS_OST)+wid*2048;
    #pragma unroll
    for(int r=0;r<16;++r){const int orow=crow(r,hi);
      #pragma unroll
      for(int d0=0;d0<2;++d0)stg[orow*64+d0*32+r32]=__float2bfloat16(o[d0][r]*rli[r]);}
    asm volatile("s_waitcnt lgkmcnt(0)":::"memory");
    #pragma unroll
    for(int i=0;i<4;++i){const int row=i*8+(lane>>3),ch=lane&7; const u32x4 v=*(const u32x4*)(stg+row*64+ch*8); ATTN_STORE16(Ow+(long)row*op+ch*8,v);} }
  asm volatile("s_waitcnt lgkmcnt(0)\n\ts_barrier":::"memory");
  #undef DMA_K
  #undef DMA_V
  #undef CMASK
  #undef START
  #undef RESC
  #undef ROT
  #undef QX_SET
}
constexpr int ATTN_LDS_BYTES=LDS_BYTES;
#undef SBAR
#undef WAIT_BAR
}
constexpr size_t MiB = 1u << 20;
constexpr size_t WS_CTL = 0, CTL_ZERO_BYTES = 1 * MiB;
constexpr size_t WS_LIST = 1 * MiB;
constexpr size_t WS_RGATE = 5 * MiB;
constexpr size_t WS_RSTD1 = 5 * MiB + 512 * 1024, WS_RSTD2 = WS_RSTD1 + 128 * 1024, WS_WRG = WS_RSTD2 + 128 * 1024;
constexpr size_t WS_WRT = 7 * MiB + 512 * 1024;
constexpr size_t WS_LSE = 6 * MiB;
constexpr size_t WS_MKV = 8 * MiB;
constexpr size_t WS_WIN = 10 * MiB, WS_WOUT = 15 * MiB, WS_WGU = 17 * MiB, WS_WDN = 145 * MiB;
constexpr size_t WS_XB = 209 * MiB;
constexpr size_t WS_LRSTD = 209 * MiB, WS_LGATE = 213 * MiB;
constexpr size_t WS_P = 273 * MiB, WS_OD = 433 * MiB, WS_ODIL = 497 * MiB;
constexpr size_t WS_ACT = 273 * MiB;
constexpr size_t WS_MIX = 545 * MiB, WS_X1B = 609 * MiB, WS_YB = 673 * MiB, WS_Y = 929 * MiB, WS_END = 993 * MiB;
constexpr int CW_TMO = 0, CW_CODE = 1;
constexpr int CW_CNT = 64;
constexpr int CW_NRM = 256;
constexpr int CW_Q = 1024;
constexpr int CW_BAR = 4096;

constexpr int RING_OFF = 0, RING_BYTES = 131072;
constexpr int LDSCTL_OFF = RING_BYTES;
constexpr int IDB_OFF = LDSCTL_OFF;
constexpr int TBL_OFF = IDB_OFF + 9216;
constexpr int LCNT_OFF = TBL_OFF + 2304;
constexpr int MISC_OFF = LCNT_OFF + 256;
constexpr int STG_OFF = IDB_OFF;
constexpr int LDS_BYTES = 147456;
static_assert(MISC_OFF + 128 <= LDS_BYTES && 512 * 16 <= 9216, "LDS map");
constexpr int NWAVES = 8;

#define GAS __attribute__((address_space(1)))
#define LAS __attribute__((address_space(3)))
typedef unsigned short bf16;
typedef unsigned v4u __attribute__((ext_vector_type(4)));
typedef unsigned v2u __attribute__((ext_vector_type(2)));
typedef float f32x4 __attribute__((ext_vector_type(4)));
typedef float f32x16 __attribute__((ext_vector_type(16)));
typedef short bf16x8 __attribute__((ext_vector_type(8)));
typedef GAS unsigned gu32;
#define RLX_AGENT __ATOMIC_RELAXED, __HIP_MEMORY_SCOPE_AGENT
#define LDS_WAIT() asm volatile("s_waitcnt lgkmcnt(0)" ::: "memory")
#define VM_WAIT() asm volatile("s_waitcnt vmcnt(0)" ::: "memory")
__device__ __forceinline__ unsigned f2bf(float f) { unsigned u = __builtin_bit_cast(unsigned, f); return (u + 0x7fffu + ((u >> 16) & 1u)) >> 16; }
__device__ __forceinline__ unsigned pk2(float lo, float hi) { return f2bf(lo) | (f2bf(hi) << 16); }
__device__ __forceinline__ unsigned fp8x4(float a, float b, float c, float d) { int w = __builtin_amdgcn_cvt_pk_fp8_f32(a, b, 0, false); w = __builtin_amdgcn_cvt_pk_fp8_f32(c, d, w, true); return (unsigned)w; }
constexpr float WSCALE = 64.f, ASCALE = 8.f;
__device__ __forceinline__ float bf2f(unsigned short b) { return __builtin_bit_cast(float, (unsigned)b << 16); }
__device__ __forceinline__ float bflo(unsigned w) { return __builtin_bit_cast(float, w << 16); }
__device__ __forceinline__ float bfhi(unsigned w) { return __builtin_bit_cast(float, w & 0xffff0000u); }
__device__ __forceinline__ float wave_sum(float v) {
#pragma unroll
    for (int o = 1; o < 64; o <<= 1) v += __shfl_xor(v, o);
    return v;
}

#define XB_TMO      128
#define XB_XCNT(j)  (256  + 64 * (j))
#define XB_XSUB(j)  (1280 + 64 * (j))
#define XB_XGEN(j)  (2304 + 64 * (j))
#define XB_TOP      3328
#define XB_TOPGEN   3392
#define XCD_BAR_WORDS 3456
#define XB_SPIN_CAP (1u << 20)
__device__ __forceinline__ unsigned xb_ld(unsigned* p)              { return __hip_atomic_load(p, __ATOMIC_RELAXED, __HIP_MEMORY_SCOPE_AGENT); }
__device__ __forceinline__ unsigned xb_add(unsigned* p, unsigned v) { return __hip_atomic_fetch_add(p, v, __ATOMIC_RELAXED, __HIP_MEMORY_SCOPE_AGENT); }
__device__ __forceinline__ unsigned xb_xcc_id() { return (unsigned)__builtin_amdgcn_s_getreg((3 << 11) | 20) & 0xFu; }
#define XB_SPIN(cond, bar) do { unsigned _sp = 0; while (cond) { __builtin_amdgcn_s_sleep(1); \
    if ((++_sp & 255u) == 0u) { if (xb_ld(&(bar)[XB_TMO])) break; if (_sp > XB_SPIN_CAP) { atomicAdd(&(bar)[XB_TMO], 1u); break; } } } } while (0)
struct XcdBarrier { unsigned* bar; unsigned x; volatile LAS unsigned* st; };
__device__ __forceinline__ XcdBarrier xcd_barrier_post(unsigned* bar, volatile LAS unsigned* st) {
    XcdBarrier b; b.bar = bar; b.x = xb_xcc_id(); b.st = st;
    if (threadIdx.x == 0) (void)xb_add(&bar[XB_XCNT(b.x)], 1u);
    return b;
}
__device__ __forceinline__ void xcd_barrier_complete(unsigned* bar, unsigned x, unsigned& nloc, unsigned& nx) {
    const unsigned G = gridDim.x * gridDim.y * gridDim.z;
    unsigned sum, cnt, mine, sp = 0u;
    for (;;) {
        sum = 0u; cnt = 0u; mine = 0u;
#pragma unroll
        for (unsigned j = 0; j < 16; ++j) { const unsigned c = xb_ld(&bar[XB_XCNT(j)]); sum += c; cnt += (c > 0u) ? 1u : 0u; mine = (j == x) ? c : mine; }
        if (sum == G) break;
        __builtin_amdgcn_s_sleep(1);
        if ((++sp & 255u) == 0u) { if (xb_ld(&bar[XB_TMO])) break; if (sp > XB_SPIN_CAP) { atomicAdd(&bar[XB_TMO], 1u); break; } }
    }
    nloc = mine > 0u ? mine : 1u; nx = cnt > 0u ? cnt : 1u;
}
__device__ __forceinline__ void xcd_barrier(const XcdBarrier& b) {
    asm volatile("s_waitcnt vmcnt(0)" ::: "memory");
    __syncthreads();
    if (threadIdx.x == 0) {
        unsigned* bar = b.bar;
        __builtin_amdgcn_s_waitcnt(0);
        unsigned nloc = b.st[0], nx = b.st[1];
        if (nloc == 0u) { xcd_barrier_complete(bar, b.x, nloc, nx); b.st[0] = nloc; b.st[1] = nx; }
        const unsigned old = xb_add(&bar[XB_XSUB(b.x)], 1u);
        const unsigned gen = old / nloc;
        if (old + 1u == (gen + 1u) * nloc) {
            __builtin_amdgcn_fence(__ATOMIC_RELEASE, "agent");
            asm volatile("s_waitcnt vmcnt(0)" ::: "memory");
            const unsigned og = xb_add(&bar[XB_TOP], 1u);
            const unsigned tg = og / nx;
            if (og + 1u == (tg + 1u) * nx) xb_add(&bar[XB_TOPGEN], 1u);
            else XB_SPIN(xb_ld(&bar[XB_TOPGEN]) == tg, bar);
            __builtin_amdgcn_fence(__ATOMIC_ACQUIRE, "agent");
            xb_add(&bar[XB_XGEN(b.x)], 1u);
            asm volatile("s_waitcnt vmcnt(0)" ::: "memory");
        } else {
            XB_SPIN(xb_ld(&bar[XB_XGEN(b.x)]) == gen, bar);
            __builtin_amdgcn_fence(__ATOMIC_ACQUIRE, "agent");
            asm volatile("s_waitcnt vmcnt(0)" ::: "memory");
        }
    }
    __syncthreads();
}

struct Frame {
    LAS unsigned char* lds;
    volatile LAS unsigned* MISC;
    gu32* ctl;
    int tid, lane, wave;
    int vcu, G;
    const float *x, *mem, *g_attn, *g_mem, *w_in, *lamqk, *subg, *w_mkv, *w_out, *g_ffn, *w_r, *b_r, *w_gu, *b_gu, *w_dn, *b_dn, *g_fin;
    float* out; unsigned char* ws;
};

#define P0_LOAD(dst, itm) do { const int m_ = (itm) / ipm, r_ = (itm) % ipm, kb_ = r_ / nblk, nb_ = r_ % nblk; \
        const float* src_ = W + (size_t)m_ * K * N + (size_t)(64 * kb_ + (lane >> 5)) * N + 32 * nb_ + (lane & 31); \
        _Pragma("unroll") for (int i_ = 0; i_ < 32; ++i_) dst[i_] = src_[(size_t)(2 * i_) * N]; } while (0)
template <bool F8, class RowMap>
__device__ __forceinline__ void p0_transpose_all(const float* W, int K, int N, int nmat, void* WTv, const float* gk, float wscale, LAS float* scr, int gw, int NGW, int lane, RowMap rowmap) {
    asm volatile("" : "+v"(lane));
    const int nblk = N / 32, ipm = (K / 64) * nblk, total = nmat * ipm;
    int it = gw; if (it >= total) return;
    float v[32], w[32];
    P0_LOAD(v, it);
    for (;;) {
        const int nx = it + NGW; const bool more = nx < total;
        if (more) P0_LOAD(w, nx);
        const int m = it / ipm, r = it % ipm, k0 = 64 * (r / nblk), n0 = 32 * (r % nblk);
        if (gk) {
#pragma unroll
            for (int i = 0; i < 32; ++i) v[i] *= gk[k0 + 2 * i + (lane >> 5)] * wscale;
        } else if (F8) {
#pragma unroll
            for (int i = 0; i < 32; ++i) v[i] *= wscale;
        }
#pragma unroll
        for (int i = 0; i < 32; ++i) scr[(2 * i + (lane >> 5)) * 33 + (lane & 31)] = v[i];
        LDS_WAIT(); asm volatile("" ::: "memory");
        const int c = lane & 7;
#pragma unroll
        for (int j = 0; j < 4; ++j) { const int n = (lane >> 3) + 8 * j; const LAS float* s = scr + (8 * c) * 33 + n;
            if constexpr (F8) { unsigned char* wt = (unsigned char*)WTv + (size_t)m * N * K;
                v2u o; o.x = fp8x4(s[0 * 33], s[1 * 33], s[2 * 33], s[3 * 33]); o.y = fp8x4(s[4 * 33], s[5 * 33], s[6 * 33], s[7 * 33]);
                *(GAS v2u*)(wt + (size_t)rowmap(n0 + n) * K + k0 + 8 * c) = o; }
            else { bf16* wt = (bf16*)WTv + (size_t)m * N * K;
                v4u o; o.x = pk2(s[0 * 33], s[1 * 33]); o.y = pk2(s[2 * 33], s[3 * 33]); o.z = pk2(s[4 * 33], s[5 * 33]); o.w = pk2(s[6 * 33], s[7 * 33]);
                *(GAS v4u*)(wt + (size_t)rowmap(n0 + n) * K + k0 + 8 * c) = o; } }
        LDS_WAIT(); asm volatile("" ::: "memory");
        if (!more) break;
#pragma unroll
        for (int i = 0; i < 32; ++i) v[i] = w[i];
        it = nx;
    }
}
#undef P0_LOAD
struct RowId { __device__ __forceinline__ int operator()(int n) const { return n; } };
struct RowGU { __device__ __forceinline__ int operator()(int n) const { const int f = n >> 1, u = n & 1; return ((f >> 7) << 8) + (u << 7) + (f & 127); } };

__device__ __forceinline__ void p0_x_rows2(Frame& F, const float* xrow, bf16* orow, float* rstd_out) {
    const GAS f32x4* xr = (const GAS f32x4*)xrow + F.lane;
    f32x4 v[8]; float s0 = 0.f, s1 = 0.f;
#pragma unroll
    for (int j = 0; j < 8; ++j) v[j] = xr[64 * j];
#pragma unroll
    for (int j = 0; j < 4; ++j) { s0 += (v[j].x * v[j].x + v[j].y * v[j].y) + (v[j].z * v[j].z + v[j].w * v[j].w); s1 += (v[4 + j].x * v[4 + j].x + v[4 + j].y * v[4 + j].y) + (v[4 + j].z * v[4 + j].z + v[4 + j].w * v[4 + j].w); }
    s0 = wave_sum(s0); s1 = wave_sum(s1);
    GAS unsigned long long* o8 = (GAS unsigned long long*)orow + F.lane;
#pragma unroll
    for (int j = 0; j < 8; ++j) o8[64 * j] = (unsigned long long)pk2(v[j].x, v[j].y) | ((unsigned long long)pk2(v[j].z, v[j].w) << 32);
    if (F.lane == 0) { rstd_out[0] = 1.f / sqrtf(s0 * (1.f / D) + EPS); rstd_out[1] = 1.f / sqrtf(s1 * (1.f / D) + EPS); }
}
__device__ __forceinline__ void p0_mkv_tile(Frame& F, int tile, bf16* mkv) {
    const int mt = tile >> 4, nt = tile & 15, m0 = 32 * mt, n0 = 32 * nt, r = F.lane & 31, h = F.lane >> 5;
    f32x16 acc = {}; float ss = 0.f;
    const float* mrow = F.mem + (size_t)(m0 + r) * D + 8 * h;
    const float* wcol = F.w_mkv + (size_t)(8 * h) * 512 + n0 + r;
    const float* gp = F.g_mem + 8 * h;
    for (int k0 = 0; k0 < D; k0 += 16) {
        const f32x4 a0 = *(const f32x4*)(mrow + k0), a1 = *(const f32x4*)(mrow + k0 + 4);
        const f32x4 g0 = *(const f32x4*)(gp + k0), g1 = *(const f32x4*)(gp + k0 + 4);
        ss += (a0.x * a0.x + a0.y * a0.y) + (a0.z * a0.z + a0.w * a0.w) + (a1.x * a1.x + a1.y * a1.y) + (a1.z * a1.z + a1.w * a1.w);
        v4u bw; bw.x = pk2(a0.x * g0.x, a0.y * g0.y); bw.y = pk2(a0.z * g0.z, a0.w * g0.w); bw.z = pk2(a1.x * g1.x, a1.y * g1.y); bw.w = pk2(a1.z * g1.z, a1.w * g1.w);
        float wv[8];
#pragma unroll
        for (int j = 0; j < 8; ++j) wv[j] = wcol[(size_t)(k0 + j) * 512];
        v4u aw; aw.x = pk2(wv[0], wv[1]); aw.y = pk2(wv[2], wv[3]); aw.z = pk2(wv[4], wv[5]); aw.w = pk2(wv[6], wv[7]);
        acc = __builtin_amdgcn_mfma_f32_32x32x16_bf16(__builtin_bit_cast(bf16x8, aw), __builtin_bit_cast(bf16x8, bw), acc, 0, 0, 0);
    }
    ss += __shfl_xor(ss, 32);
    const float rstd = 1.f / sqrtf(ss * (1.f / D) + EPS);
    bf16* orow = mkv + (size_t)(m0 + r) * 512 + n0 + 4 * h;
#pragma unroll
    for (int q = 0; q < 4; ++q) { v2u o; o.x = pk2(acc[4 * q] * rstd, acc[4 * q + 1] * rstd); o.y = pk2(acc[4 * q + 2] * rstd, acc[4 * q + 3] * rstd); *(GAS v2u*)(orow + 8 * q) = o; }
}
__device__ __forceinline__ void p0_prologue(Frame& F) {
    LAS float* scr = (LAS float*)(F.lds + RING_OFF + F.wave * 16384);
    const int gw = F.vcu * NWAVES + F.wave, NGW = F.G * NWAVES;
    bf16* win_t = (bf16*)(F.ws + WS_WIN); bf16* wout_t = (bf16*)(F.ws + WS_WOUT);
    if (F.wave < 4 && F.G == 256) p0_mkv_tile(F, F.wave * 256 + F.vcu, (bf16*)(F.ws + WS_MKV));
    p0_transpose_all<false>(F.w_in, D, DIN, 1, win_t, F.g_attn, 1.f, scr, gw, NGW, F.lane, RowId());
    p0_transpose_all<false>(F.w_out, D, D, 1, wout_t, nullptr, 1.f, scr, gw, NGW, F.lane, RowId());
    bf16* xb = (bf16*)(F.ws + WS_XB); float* rstd1 = (float*)(F.ws + WS_RSTD1);
    for (int m = 2 * gw; m < T; m += 2 * NGW) p0_x_rows2(F, F.x + (size_t)m * D, xb + (size_t)m * D, rstd1 + m);
    bf16* wrt = (bf16*)(F.ws + WS_WRT);
    for (int i = gw * 64 + F.lane; i < D * NE; i += NGW * 64) { const int e = i >> 10, k = i & 1023; const float w = F.w_r[k * NE + e] * F.g_ffn[k]; const unsigned hb = f2bf(w); wrt[i] = (bf16)hb; wrt[D * NE + i] = (bf16)f2bf(w - bf2f((bf16)hb)); }
}

constexpr int NCONV = 8, NCONV_ALL = 8 * NCONV;
__device__ __forceinline__ void p0b_unit(Frame& F, int c) {
    LAS float* scr = (LAS float*)(F.lds + RING_OFF + F.wave * 16384);
    p0_transpose_all<true>(F.w_gu, D, 2 * DFF, NE, (void*)(F.ws + WS_WGU), F.g_ffn, WSCALE, scr, c * NWAVES + F.wave, NCONV_ALL * NWAVES, F.lane, RowGU());
    p0_transpose_all<true>(F.w_dn, DFF, D, NE, (void*)(F.ws + WS_WDN), nullptr, WSCALE, scr, c * NWAVES + F.wave, NCONV_ALL * NWAVES, F.lane, RowId());
    __syncthreads();
}

struct EpiInProj {
    bf16* O; const float* rstd; unsigned* nrm;
    __device__ __forceinline__ void operator()(const pg8::f32x4 (&acc)[2][2][4][2], const pg8::Unit& u, int wr, int wc, int fr, int fq, const LAS unsigned* ids) const {
        asm volatile("" : "+v"(fr), "+v"(fq));
        const int row0 = u.pm * 256 + wr * 64 + fr, col0 = u.pn * 256 + wc * 32 + 8 * fq;
        const float sc = (u.pn <= 1 || u.pn == 6 || u.pn == 9) ? QSCALE : 1.f;
        const LAS float* scl = (const LAS float*)(ids + 256);
        float rsv[2][4];
#pragma unroll
        for (int ai = 0; ai < 2; ++ai)
#pragma unroll
            for (int m = 0; m < 4; ++m) rsv[ai][m] = scl[wr * 64 + fr + ai * 128 + m * 16];
#pragma unroll
        for (int ai = 0; ai < 2; ++ai)
#pragma unroll
            for (int m = 0; m < 4; ++m) { const int row = row0 + ai * 128 + m * 16; const float rs = rsv[ai][m] * sc; bf16* rowp = O + (size_t)row * DIN + col0;
#pragma unroll
                for (int bj = 0; bj < 2; ++bj) { const pg8::f32x4 v0 = acc[ai][bj][m][0] * rs, v1 = acc[ai][bj][m][1] * rs;
                    v4u w; w.x = pg8::cvt_pk_bf16(v0[0], v0[1]); w.y = pg8::cvt_pk_bf16(v0[2], v0[3]); w.z = pg8::cvt_pk_bf16(v1[0], v1[1]); w.w = pg8::cvt_pk_bf16(v1[2], v1[3]);
                    *(v4u*)(rowp + bj * 128) = w; } }
        if (u.pn < 4) {
#pragma unroll
            for (int bj = 0; bj < 2; ++bj) { float mx = 0.f;
#pragma unroll
                for (int ai = 0; ai < 2; ++ai)
#pragma unroll
                    for (int m = 0; m < 4; ++m) { const float rs = rsv[ai][m] * sc; const pg8::f32x4 v0 = acc[ai][bj][m][0] * rs, v1 = acc[ai][bj][m][1] * rs;
                        float s = (v0[0] * v0[0] + v0[1] * v0[1]) + (v0[2] * v0[2] + v0[3] * v0[3]) + (v1[0] * v1[0] + v1[1] * v1[1]) + (v1[2] * v1[2] + v1[3] * v1[3]);
                        s += __shfl_xor(s, 16); s += __shfl_xor(s, 32); mx = fmaxf(mx, s); }
#pragma unroll
                for (int o = 1; o < 16; o <<= 1) mx = fmaxf(mx, __shfl_xor(mx, o));
                if ((fr | fq) == 0) atomicMax(nrm + (((u.pm >> 4) * 4 + u.pn) * 4 + 2 * bj + (wc >> 1)) * 2 + (wc & 1), __builtin_bit_cast(unsigned, mx)); }
        }
    }
};
__device__ __forceinline__ void attn_phase(Frame& F, char* shm, int qoff = 0, int gmask = 7) {
    using namespace attn_body;
    const attn_body::bf16* P = (const attn_body::bf16*)(F.ws + WS_P);
    attn_body::bf16* OD = (attn_body::bf16*)(F.ws + WS_OD);
    attn_body::bf16* mix = (attn_body::bf16*)(F.ws + WS_MIX);
    attn_body::bf16* ODIL = (attn_body::bf16*)(F.ws + WS_ODIL); float* LSEb = (float*)(F.ws + WS_LSE);
    const attn_body::bf16* MKV = (const attn_body::bf16*)(F.ws + WS_MKV);
    const float* nrm = (const float*)(F.ctl + CW_NRM);
    const int grp = (int)blockIdx.x & 7, b = grp;
    unsigned* qctr = (unsigned*)(F.ctl + CW_Q + qoff) + 64 * grp;
    const attn_body::bf16* Pb = P + (size_t)b * SEQ * DIN;
    unsigned nxt_tok = 0u;
    if (F.tid == 0) nxt_tok = __hip_atomic_fetch_add(qctr, 1u, __ATOMIC_RELAXED, __HIP_MEMORY_SCOPE_AGENT);
    for (;;) {
        if (F.tid == 0) F.MISC[20] = nxt_tok;
        __syncthreads();
        int un = (int)F.MISC[20];
        __syncthreads();
        if (F.tid == 0 && un < NCONV + 512) nxt_tok = __hip_atomic_fetch_add(qctr, 1u, __ATOMIC_RELAXED, __HIP_MEMORY_SCOPE_AGENT);
        if (un < NCONV) { if (gmask == 7) p0b_unit(F, grp * NCONV + un); continue; }
        un -= NCONV;
        if (un >= 512) break;
        if (un < 256) {
            if (!(gmask & 1)) continue;
            const int qb = 15 - (un >> 4), h = 3 - ((un >> 2) & 3), pass = un & 3, j = pass >> 1, vh = pass & 1;
            const float slope2 = exp2f(-(float)(2 * h + 1)) * LOG2E;
            const int ni = ((b * 4 + (h >> 1)) * 4 + 2 * (h & 1) + j) * 2;
            const float R = sqrtf((nrm[ni] + nrm[ni + 1]) * (nrm[ni + 16] + nrm[ni + 17])) * 1.01f;
            const float kfirst = (float)(qb * 256) - (2.f * R + 160.f) / slope2;
            int t0 = kfirst > 0.f ? (int)(kfirst * (1.f / 64.f)) : 0; t0 = min(t0, 4 * qb); t0 &= ~1;
            UnitP U; U.Q = Pb + C_DQ + h * 128 + j * 64; U.K = Pb + C_DK + h * 128 + j * 64; U.V = Pb + C_DV + h * 128 + vh * 64;
            U.O = OD + (size_t)b * SEQ * 1024 + h * 256 + j * 128 + vh * 64; U.qp = DIN; U.kp = DIN; U.op = 1024;
            U.q0 = qb * 256; U.t0 = t0; U.NT = 4 * qb + 4 - t0; U.slope2 = slope2; U.lse = nullptr; U.lse_stride = 0;
            attn_unit<32, true, false, true, false>(U, shm);
        } else if (un < 448) {
            if (!(gmask & 2)) continue;
            const int du = un - 256, h = du / 48, idx = du % 48, n = idx >> 4, w = idx & 15;
            const int r = (n == 0) ? 1 : (n == 1 ? 4 : 16), c = (n == 0) ? 0 : (n == 1 ? (w >> 2) : w), blk = (n == 0) ? w : (n == 1 ? (w & 3) : 0);
            const attn_body::bf16* Pc = Pb + (size_t)c * DIN;
            UnitP U; U.Q = Pc + C_LQ + h * 64; U.K = Pc + C_LK + h * 64; U.V = Pc + C_LV + h * 64; U.qp = (long)r * DIN; U.kp = (long)r * DIN;
            U.O = ODIL + (size_t)n * T * 256 + ((size_t)b * SEQ + c) * 256 + h * 64; U.op = (long)r * 256;
            U.q0 = blk * 256; U.t0 = (blk == 0) ? 0 : 4 * blk - 2; U.NT = 4 * blk + 4 - U.t0;
            U.slope2 = exp2f(-(float)(2 * h + 2)) * (float)r * LOG2E;
            U.lse = LSEb + (size_t)n * T * 4 + ((size_t)b * SEQ + c) * 4 + h; U.lse_stride = r * 4;
            attn_unit<32, true, true, true, true>(U, shm);
        } else {
            if (!(gmask & 4)) continue;
            const int mu = un - 448, h = mu >> 4, qb = mu & 15;
            UnitP U; U.Q = Pb + C_MQ + h * 64; U.qp = DIN; U.K = MKV + (size_t)b * NMEM * 512 + h * 64; U.V = U.K + 256; U.kp = 512;
            U.O = mix + (size_t)b * SEQ * 1024 + 768 + h * 64; U.op = 1024; U.q0 = qb * 256; U.t0 = 0; U.NT = 4; U.slope2 = 0.f; U.lse = nullptr; U.lse_stride = 0;
            attn_unit<8, false, false, false, false>(U, shm);
        }
    }
}
__device__ __forceinline__ void dil_combine_phase(Frame& F) {
    const int gw = F.vcu * NWAVES + F.wave, NGW = F.G * NWAVES;
    const bf16* OD = (const bf16*)(F.ws + WS_OD); const bf16* ODIL = (const bf16*)(F.ws + WS_ODIL); const float* LSEb = (const float*)(F.ws + WS_LSE); bf16* mix = (bf16*)(F.ws + WS_MIX);
    const int h = F.lane >> 4, pt = F.lane & 15, d4 = pt * 4;
    float lam;
    { const float a = F.lamqk[F.lane] * F.lamqk[64 + F.lane], c = F.lamqk[128 + F.lane] * F.lamqk[192 + F.lane];
      lam = __expf(wave_sum(a)) - __expf(wave_sum(c)) + 0.2f; }
    float gsub[8];
#pragma unroll
    for (int i = 0; i < 8; ++i) gsub[i] = F.subg[pt * 8 + i] * 0.8f;
    for (int row0 = 4 * gw; row0 < T; row0 += 4 * NGW) {
        float l[4][3]; v2u q[4][3]; v4u o1[4], o2[4];
#pragma unroll
        for (int i = 0; i < 4; ++i) {
            o1[i] = *(const v4u*)(OD + (size_t)(row0 + i) * 1024 + h * 256 + pt * 8); o2[i] = *(const v4u*)(OD + (size_t)(row0 + i) * 1024 + h * 256 + 128 + pt * 8);
#pragma unroll
            for (int n = 0; n < 3; ++n) { l[i][n] = LSEb[(size_t)n * T * 4 + (size_t)(row0 + i) * 4 + h]; q[i][n] = *(const v2u*)(ODIL + (size_t)n * T * 256 + (size_t)(row0 + i) * 256 + h * 64 + d4); } }
#pragma unroll
        for (int i = 0; i < 4; ++i) {
            const unsigned aw[4] = {o1[i].x, o1[i].y, o1[i].z, o1[i].w}, bw[4] = {o2[i].x, o2[i].y, o2[i].z, o2[i].w};
            float d[8], ss = 0.f;
#pragma unroll
            for (int c = 0; c < 4; ++c) { d[2 * c] = bflo(aw[c]) - lam * bflo(bw[c]); d[2 * c + 1] = bfhi(aw[c]) - lam * bfhi(bw[c]); ss += d[2 * c] * d[2 * c] + d[2 * c + 1] * d[2 * c + 1]; }
#pragma unroll
            for (int o = 1; o < 16; o <<= 1) ss += __shfl_xor(ss, o);
            const float rstd = 1.f / sqrtf(ss * (1.f / 128.f) + EPS);
            v4u od; od.x = pk2(d[0] * rstd * gsub[0], d[1] * rstd * gsub[1]); od.y = pk2(d[2] * rstd * gsub[2], d[3] * rstd * gsub[3]); od.z = pk2(d[4] * rstd * gsub[4], d[5] * rstd * gsub[5]); od.w = pk2(d[6] * rstd * gsub[6], d[7] * rstd * gsub[7]);
            *(v4u*)(mix + (size_t)(row0 + i) * 1024 + h * 128 + pt * 8) = od;
            const float m = fmaxf(fmaxf(l[i][0], l[i][1]), l[i][2]);
            float wn[3], den = 0.f;
#pragma unroll
            for (int n = 0; n < 3; ++n) { wn[n] = exp2f(l[i][n] - m); den += wn[n]; }
            const float inv = 1.f / den; float o[4] = {0.f, 0.f, 0.f, 0.f};
#pragma unroll
            for (int n = 0; n < 3; ++n) { const float wq = wn[n] * inv; o[0] += wq * bflo(q[i][n].x); o[1] += wq * bfhi(q[i][n].x); o[2] += wq * bflo(q[i][n].y); o[3] += wq * bfhi(q[i][n].y); }
            v2u ov; ov.x = pk2(o[0], o[1]); ov.y = pk2(o[2], o[3]);
            *(v2u*)(mix + (size_t)(row0 + i) * 1024 + 512 + h * 64 + d4) = ov;
        }
    }
}
struct EpiY {
    bf16* Y;
    __device__ __forceinline__ void operator()(const pg8::f32x4 (&acc)[2][2][4][2], const pg8::Unit& u, int wr, int wc, int fr, int fq, const LAS unsigned*) const {
        asm volatile("" : "+v"(fr), "+v"(fq));
        const int row0 = u.pm * 256 + wr * 64 + fr, col0 = u.pn * 256 + wc * 32 + 8 * fq;
#pragma unroll
        for (int ai = 0; ai < 2; ++ai)
#pragma unroll
            for (int m = 0; m < 4; ++m) { bf16* rowp = Y + (size_t)(row0 + ai * 128 + m * 16) * D + col0;
#pragma unroll
                for (int bj = 0; bj < 2; ++bj) { const pg8::f32x4 v0 = acc[ai][bj][m][0], v1 = acc[ai][bj][m][1];
                    v4u w; w.x = pg8::cvt_pk_bf16(v0[0], v0[1]); w.y = pg8::cvt_pk_bf16(v0[2], v0[3]); w.z = pg8::cvt_pk_bf16(v1[0], v1[1]); w.w = pg8::cvt_pk_bf16(v1[2], v1[3]);
                    *(v4u*)(rowp + bj * 128) = w; } }
    }
};

__device__ __forceinline__ void route_phase(Frame& F) {
    LAS float* xch = (LAS float*)(F.lds + RING_OFF);
    LAS unsigned* lcnt = (LAS unsigned*)(F.lds + LCNT_OFF);
    LAS unsigned* stg = (LAS unsigned*)(F.lds + STG_OFF);
    if (F.tid < 64) lcnt[F.tid] = 0u;
    const int lane = F.lane, tl = lane & 31, h = lane >> 5, tg = F.wave & 3, kh = F.wave >> 2;
    { const v4u* wsrc = (const v4u*)(F.ws + WS_WRT); LAS char* wl = (LAS char*)(F.lds + RING_OFF);
      for (int i = F.tid; i < 2 * 32 * 128; i += NWAVES * 64) { const int hl = i >> 12, e = (i >> 7) & 31, c = i & 127; *(LAS v4u*)(wl + hl * 65536 + e * 2048 + ((c ^ (e & 15)) << 4)) = wsrc[i]; } }
    __syncthreads();
    const int tok = F.vcu * 128 + tg * 32 + tl;
    const float* xr = F.x + (size_t)tok * D + kh * 512 + 8 * h;
    const bf16* yr = (const bf16*)(F.ws + WS_Y) + (size_t)tok * D + kh * 512 + 8 * h;
    unsigned char* x1r = (unsigned char*)(F.ws + WS_X1B) + (size_t)tok * D + kh * 512 + 8 * h;
    const LAS char* wrow = (const LAS char*)(F.lds + RING_OFF) + tl * 2048;
    f32x16 acc = {}; float ss = 0.f;
    f32x4 xa[2][8]; v4u ya[2][4];
#define RT_LOAD(buf, g) do { _Pragma("unroll") for (int q_ = 0; q_ < 4; ++q_) { xa[buf][2 * q_] = *(const f32x4*)(xr + 64 * (g) + 16 * q_); xa[buf][2 * q_ + 1] = *(const f32x4*)(xr + 64 * (g) + 16 * q_ + 4); \
        ya[buf][q_] = *(const v4u*)(yr + 64 * (g) + 16 * q_); } } while (0)
#define RT_COMP(buf, g) do { _Pragma("unroll") for (int q_ = 0; q_ < 4; ++q_) { const int c_ = (kh * 512 + 64 * (g) + 16 * q_) / 8 + h; \
        const v4u wh = *(const LAS v4u*)(wrow + ((c_ ^ (tl & 15)) << 4)), wl2 = *(const LAS v4u*)(wrow + 65536 + ((c_ ^ (tl & 15)) << 4)); \
        const f32x4 a0 = xa[buf][2 * q_], a1 = xa[buf][2 * q_ + 1]; const v4u yv = ya[buf][q_]; \
        const float x1[8] = {a0.x + bflo(yv.x), a0.y + bfhi(yv.x), a0.z + bflo(yv.y), a0.w + bfhi(yv.y), a1.x + bflo(yv.z), a1.y + bfhi(yv.z), a1.z + bflo(yv.w), a1.w + bfhi(yv.w)}; \
        unsigned hw[4], lw[4]; \
        _Pragma("unroll") for (int p_ = 0; p_ < 4; ++p_) { const float u_ = x1[2 * p_], r_ = x1[2 * p_ + 1]; ss += u_ * u_ + r_ * r_; const unsigned hb = pk2(u_, r_); hw[p_] = hb; lw[p_] = pk2(u_ - bflo(hb), r_ - bfhi(hb)); } \
        const v4u xh = (v4u){hw[0], hw[1], hw[2], hw[3]}, xl = (v4u){lw[0], lw[1], lw[2], lw[3]}; \
        { v2u o8_; o8_.x = fp8x4(x1[0], x1[1], x1[2], x1[3]); o8_.y = fp8x4(x1[4], x1[5], x1[6], x1[7]); *(v2u*)(x1r + 64 * (g) + 16 * q_) = o8_; } \
        acc = __builtin_amdgcn_mfma_f32_32x32x16_bf16(__builtin_bit_cast(bf16x8, wh), __builtin_bit_cast(bf16x8, xh), acc, 0, 0, 0); \
        acc = __builtin_amdgcn_mfma_f32_32x32x16_bf16(__builtin_bit_cast(bf16x8, wh), __builtin_bit_cast(bf16x8, xl), acc, 0, 0, 0); \
        acc = __builtin_amdgcn_mfma_f32_32x32x16_bf16(__builtin_bit_cast(bf16x8, wl2), __builtin_bit_cast(bf16x8, xh), acc, 0, 0, 0); } } while (0)
    RT_LOAD(0, 0);
#pragma unroll
    for (int g = 0; g < 8; g += 2) {
        RT_LOAD(1, g + 1); RT_COMP(0, g);
        if (g + 2 < 8) RT_LOAD(0, g + 2);
        RT_COMP(1, g + 1);
    }
#undef RT_LOAD
#undef RT_COMP
    __syncthreads();
    if (kh == 1) { LAS float* d = xch + (tg * 64 + lane) * 17;
#pragma unroll
        for (int i = 0; i < 16; ++i) d[i] = acc[i];
        d[16] = ss; }
    __syncthreads();
    if (kh == 0) {
        const LAS float* d = xch + (tg * 64 + lane) * 17;
#pragma unroll
        for (int i = 0; i < 16; ++i) acc[i] += d[i];
        ss += d[16]; ss += __shfl_xor(ss, 32);
        const float rstd = 1.f / sqrtf(ss * (1.f / D) + EPS);
        float lg[16];
#pragma unroll
        for (int i = 0; i < 16; ++i) lg[i] = acc[i] * rstd + F.b_r[4 * h + (i & 3) + 8 * (i >> 2)];
        float cv[8]; int ce[8];
#pragma unroll
        for (int k = 0; k < 4; ++k) { float bv = -INFINITY; int bi = 0;
#pragma unroll
            for (int i = 0; i < 16; ++i) { if (lg[i] > bv) { bv = lg[i]; bi = i; } }
            cv[k] = bv; ce[k] = 4 * h + (bi & 3) + 8 * (bi >> 2);
#pragma unroll
            for (int i = 0; i < 16; ++i) if (i == bi) lg[i] = -INFINITY; }
#pragma unroll
        for (int k = 0; k < 4; ++k) { cv[4 + k] = __shfl_xor(cv[k], 32); ce[4 + k] = __shfl_xor(ce[k], 32); }
        float tv[4]; int te[4];
#pragma unroll
        for (int k = 0; k < 4; ++k) { float bv = -INFINITY; int be = 64, bi = 0;
#pragma unroll
            for (int i = 0; i < 8; ++i) { if (cv[i] > bv || (cv[i] == bv && ce[i] < be)) { bv = cv[i]; be = ce[i]; bi = i; } }
            tv[k] = bv; te[k] = be;
#pragma unroll
            for (int i = 0; i < 8; ++i) if (i == bi) cv[i] = -INFINITY; }
        float gk[4], den = 0.f;
#pragma unroll
        for (int k = 0; k < 4; ++k) { gk[k] = __expf(tv[k] - tv[0]); den += gk[k]; }
        const float inv = 1.f / den;
        if (h == 0) {
#pragma unroll
            for (int k = 0; k < 4; ++k) {
                const unsigned rank = __hip_atomic_fetch_add(lcnt + te[k], 1u, __ATOMIC_RELAXED, __HIP_MEMORY_SCOPE_WORKGROUP);
                const int slot = (tg * 32 + tl) * 4 + k;
                stg[slot * 4] = (unsigned)(tok * 4 + k); stg[slot * 4 + 1] = ((unsigned)te[k] << 16) | rank; stg[slot * 4 + 2] = __builtin_bit_cast(unsigned, gk[k] * inv); stg[slot * 4 + 3] = __builtin_bit_cast(unsigned, rstd);
            }
        }
    }
    __syncthreads();
    if (F.tid < 32) { const unsigned n = lcnt[F.tid]; lcnt[32 + F.tid] = n ? __hip_atomic_fetch_add((unsigned*)(F.ctl + CW_CNT) + F.tid, n, __ATOMIC_RELAXED, __HIP_MEMORY_SCOPE_AGENT) : 0u; }
    __syncthreads();
    { unsigned* list = (unsigned*)(F.ws + WS_LIST); unsigned* lgate = (unsigned*)(F.ws + WS_LGATE); unsigned* lrstd = (unsigned*)(F.ws + WS_LRSTD);
      const unsigned ent = stg[F.tid * 4], er = stg[F.tid * 4 + 1], gb = stg[F.tid * 4 + 2], rb = stg[F.tid * 4 + 3]; const unsigned e = er >> 16, rank = er & 0xffffu;
      const size_t at = (size_t)e * LCAP + lcnt[32 + e] + rank; list[at] = ent; lgate[at] = gb; lrstd[at] = rb; }
    __syncthreads();
}

__device__ __forceinline__ int moe_build_table(Frame& F) {
    LAS unsigned* tbl = (LAS unsigned*)(F.lds + TBL_OFF); LAS unsigned* lcnt = (LAS unsigned*)(F.lds + LCNT_OFF);
    if (F.wave == 0) {
        const int e = F.lane & 31;
        const unsigned cnt = __hip_atomic_load((unsigned*)(F.ctl + CW_CNT) + e, __ATOMIC_RELAXED, __HIP_MEMORY_SCOPE_AGENT);
        const unsigned nt = (cnt + 255u) >> 8; unsigned incl = nt;
#pragma unroll
        for (int o = 1; o < 32; o <<= 1) { const unsigned t = __shfl_up(incl, o); if ((F.lane & 31) >= o) incl += t; }
        if (F.lane < 32) { lcnt[e] = cnt; const unsigned start = incl - nt; for (unsigned j = 0; j < nt; ++j) tbl[start + j] = ((unsigned)e << 16) | j; if (F.lane == 31) F.MISC[16] = incl; }
    }
    __syncthreads();
    return (int)F.MISC[16];
}
struct MoeOrder {
    const LAS unsigned* tbl; const LAS unsigned* lcnt; const unsigned* list; int NMT, G, c, NPN, MPER, RB; size_t bexp; bool a_tiles; const unsigned* lsc; const unsigned* bias; int bexp_f;
    __device__ __forceinline__ bool next(int i, pg8::Unit& u) const {
        const int L = i * G + c, blk = L >> 5, w = L & 31, g = blk * MPER + w / NPN, pn = w % NPN;
        if (g >= NMT) return false;
        const unsigned t = tbl[g]; const int e = (int)(t >> 16), mt = (int)(t & 0xffffu); const int cnt = (int)lcnt[e];
        u.pm = g; u.pn = pn; u.e = e; u.mt = mt; u.valid = min(256, cnt - mt * 256);
        u.aoff = a_tiles ? (size_t)g * (size_t)(256 * RB) : (size_t)0; u.boff = (size_t)e * bexp + (size_t)pn * (size_t)(256 * RB);
        return true;
    }
    __device__ __forceinline__ const unsigned* id_src(const pg8::Unit& u, int row) const { return list + (size_t)u.e * LCAP + u.mt * 256 + min(row, u.valid - 1); }
    __device__ __forceinline__ const unsigned* sc_src(const pg8::Unit& u, int row) const { return lsc + (size_t)u.e * LCAP + u.mt * 256 + min(row, u.valid - 1); }
    __device__ __forceinline__ const unsigned* bias_src(const pg8::Unit& u, int col) const { return bias + (size_t)u.e * bexp_f + u.pn * 256 + col; }
};
struct EpiGU {
    unsigned char* ACT;
    __device__ __forceinline__ void operator()(const pg8::f32x4 (&acc)[2][2][4][2], const pg8::Unit& u, int wr, int wc, int fr, int fq, const LAS unsigned* ids) const {
        asm volatile("" : "+v"(fr), "+v"(fq));
        const int r0 = wr * 64 + fr, f0 = u.pn * 128 + wc * 32 + 8 * fq;
        const LAS float* scl = (const LAS float*)(ids + 256); const LAS float* bl = (const LAS float*)(ids + 512) + 2 * (wc * 32 + 8 * fq);
        float rs[2][4];
#pragma unroll
        for (int ai = 0; ai < 2; ++ai)
#pragma unroll
            for (int m = 0; m < 4; ++m) rs[ai][m] = scl[r0 + ai * 128 + m * 16] * (1.f / WSCALE);
        const pg8::f32x4 b0 = *(const LAS pg8::f32x4*)bl, b1 = *(const LAS pg8::f32x4*)(bl + 4), b2 = *(const LAS pg8::f32x4*)(bl + 8), b3 = *(const LAS pg8::f32x4*)(bl + 12);
        const float gb[8] = {b0[0], b0[2], b1[0], b1[2], b2[0], b2[2], b3[0], b3[2]}, ub[8] = {b0[1], b0[3], b1[1], b1[3], b2[1], b2[3], b3[1], b3[3]};
#pragma unroll
        for (int ai = 0; ai < 2; ++ai)
#pragma unroll
            for (int m = 0; m < 4; ++m) { const int r = r0 + ai * 128 + m * 16; const float s = rs[ai][m]; float a[8];
#pragma unroll
                for (int n = 0; n < 2; ++n)
#pragma unroll
                    for (int j = 0; j < 4; ++j) { float gate = acc[ai][0][m][n][j] * s + gb[4 * n + j], up = acc[ai][1][m][n][j] * s + ub[4 * n + j];
                        gate = fminf(gate, 7.f); up = fminf(fmaxf(up, -7.f), 7.f);
                        a[4 * n + j] = ASCALE * (up + 1.f) * gate * __builtin_amdgcn_rcpf(1.f + __builtin_amdgcn_exp2f(-1.702f * LOG2E * gate)); }
                v2u w; w.x = fp8x4(a[0], a[1], a[2], a[3]); w.y = fp8x4(a[4], a[5], a[6], a[7]);
                *(v2u*)(ACT + (size_t)(u.pm * 256 + r) * DFF + f0) = w; }
    }
};
struct EpiDown {
    bf16* YB;
    __device__ __forceinline__ void operator()(const pg8::f32x4 (&acc)[2][2][4][2], const pg8::Unit& u, int wr, int wc, int fr, int fq, const LAS unsigned* ids) const {
        asm volatile("" : "+v"(fr), "+v"(fq));
        const int r0 = wr * 64 + fr, cl = wc * 32 + 8 * fq, col0 = u.pn * 256 + cl;
        const LAS float* scl = (const LAS float*)(ids + 256); const LAS float* bl = (const LAS float*)(ids + 512) + cl;
        pg8::f32x4 bv[2][2];
#pragma unroll
        for (int bj = 0; bj < 2; ++bj)
#pragma unroll
            for (int n = 0; n < 2; ++n) bv[bj][n] = *(const LAS pg8::f32x4*)(bl + bj * 128 + 4 * n);
#pragma unroll
        for (int ai = 0; ai < 2; ++ai)
#pragma unroll
            for (int m = 0; m < 4; ++m) { const int r = r0 + ai * 128 + m * 16; if (r < u.valid) { const float g = scl[r]; bf16* yp = YB + (size_t)ids[r] * D + col0;
#pragma unroll
                for (int bj = 0; bj < 2; ++bj) { const pg8::f32x4 v0 = (acc[ai][bj][m][0] * (1.f / (WSCALE * ASCALE)) + bv[bj][0]) * g, v1 = (acc[ai][bj][m][1] * (1.f / (WSCALE * ASCALE)) + bv[bj][1]) * g;
                    v4u w; w.x = pg8::cvt_pk_bf16(v0[0], v0[1]); w.y = pg8::cvt_pk_bf16(v0[2], v0[3]); w.z = pg8::cvt_pk_bf16(v1[0], v1[1]); w.w = pg8::cvt_pk_bf16(v1[2], v1[3]);
                    *(v4u*)(yp + bj * 128) = w; } } }
    }
};
__device__ __forceinline__ void final_phase(Frame& F) {
    const int gw = F.vcu * NWAVES + F.wave, NGW = F.G * NWAVES;
    const bf16* YB = (const bf16*)(F.ws + WS_YB);
    for (int t = gw; t < T; t += NGW) {
        float v[16]; float ss = 0.f;
#pragma unroll
        for (int jj = 0; jj < 2; ++jj) { const int c = 512 * jj + 8 * F.lane;
            const f32x4 a = *(const f32x4*)(F.x + (size_t)t * D + c), b = *(const f32x4*)(F.x + (size_t)t * D + c + 4);
            const v4u y0 = *(const v4u*)((const bf16*)(F.ws + WS_Y) + (size_t)t * D + c);
            float* vv = v + 8 * jj; vv[0] = a.x + bflo(y0.x); vv[1] = a.y + bfhi(y0.x); vv[2] = a.z + bflo(y0.y); vv[3] = a.w + bfhi(y0.y); vv[4] = b.x + bflo(y0.z); vv[5] = b.y + bfhi(y0.z); vv[6] = b.z + bflo(y0.w); vv[7] = b.w + bfhi(y0.w);
#pragma unroll
            for (int k = 0; k < 4; ++k) { const v4u y = *(const v4u*)(YB + ((size_t)t * 4 + k) * D + c);
                vv[0] += bflo(y.x); vv[1] += bfhi(y.x); vv[2] += bflo(y.y); vv[3] += bfhi(y.y); vv[4] += bflo(y.z); vv[5] += bfhi(y.z); vv[6] += bflo(y.w); vv[7] += bfhi(y.w); } }
#pragma unroll
        for (int i = 0; i < 16; ++i) ss += v[i] * v[i];
        const float rstd = 1.f / sqrtf(wave_sum(ss) * (1.f / D) + EPS);
#pragma unroll
        for (int jj = 0; jj < 2; ++jj) { const int c = 512 * jj + 8 * F.lane; const f32x4 g0 = *(const f32x4*)(F.g_fin + c), g1 = *(const f32x4*)(F.g_fin + c + 4); const float* vv = v + 8 * jj;
            f32x4 o0, o1; o0.x = vv[0] * rstd * g0.x; o0.y = vv[1] * rstd * g0.y; o0.z = vv[2] * rstd * g0.z; o0.w = vv[3] * rstd * g0.w;
            o1.x = vv[4] * rstd * g1.x; o1.y = vv[5] * rstd * g1.y; o1.z = vv[6] * rstd * g1.z; o1.w = vv[7] * rstd * g1.w;
            *(f32x4*)(F.out + (size_t)t * D + c) = o0; *(f32x4*)(F.out + (size_t)t * D + c + 4) = o1; }
    }
}
struct Args { const float* in[17]; float* out; unsigned char* ws; int ph_lo, ph_hi, use_bar, pad; };
__global__ void __launch_bounds__(NWAVES * 64, 2) mk_fwd(Args args) {
    extern __shared__ __attribute__((aligned(16))) unsigned char lds[];
    Frame F;
    F.lds = (LAS unsigned char*)lds;
    F.MISC = (volatile LAS unsigned*)(F.lds + MISC_OFF);
    F.tid = threadIdx.x; F.lane = F.tid & 63; F.wave = __builtin_amdgcn_readfirstlane(F.tid >> 6);
    F.G = gridDim.x; { const int bx = blockIdx.x; F.vcu = (F.G % 8 == 0) ? (bx % 8) * (F.G / 8) + bx / 8 : bx; }
    F.ws = args.ws; F.out = args.out; F.ctl = (gu32*)(args.ws + WS_CTL);
    F.x = args.in[0]; F.mem = args.in[1]; F.g_attn = args.in[2]; F.g_mem = args.in[3]; F.w_in = args.in[4]; F.lamqk = args.in[5]; F.subg = args.in[6]; F.w_mkv = args.in[7];
    F.w_out = args.in[8]; F.g_ffn = args.in[9]; F.w_r = args.in[10]; F.b_r = args.in[11]; F.w_gu = args.in[12]; F.b_gu = args.in[13]; F.w_dn = args.in[14]; F.b_dn = args.in[15]; F.g_fin = args.in[16];
    for (int u = F.tid; u < (LDS_BYTES - LDSCTL_OFF) / 4; u += NWAVES * 64) ((LAS unsigned*)(F.lds + LDSCTL_OFF))[u] = 0u;
    __syncthreads();
    XcdBarrier bar; bar.bar = (unsigned*)(F.ctl + CW_BAR); bar.x = 0; bar.st = nullptr;
    if (args.use_bar) bar = xcd_barrier_post((unsigned*)(F.ctl + CW_BAR), F.MISC + 8);
    const int lo = args.ph_lo, hi = args.ph_hi;
#define IN(k) (lo <= (k) && (k) < hi)
#define SEAM(k) do { if (IN(k) && IN((k) + 1)) xcd_barrier(bar); } while (0)
    if (IN(0)) { p0_prologue(F); } SEAM(0);
    if (IN(1)) {
        pg8::Gemm g{(const void*)(F.ws + WS_XB), (const void*)(F.ws + WS_WIN), 2 * D}; pg8::StaticOrder S; S.init(T, DIN, 2 * D, F.G, (int)blockIdx.x, (const unsigned*)(F.ws + WS_RSTD1));
        EpiInProj E{(bf16*)(F.ws + WS_P), (const float*)(F.ws + WS_RSTD1), (unsigned*)(F.ctl + CW_NRM)};
        pg8::gemm_phase<EpiInProj, pg8::StaticOrder, true, false, true>(F.lds + RING_OFF, (LAS unsigned*)(F.lds + IDB_OFF), g, S, E);
    } SEAM(1);
    if (IN(2)) { attn_phase(F, (char*)lds + RING_OFF); } SEAM(2);
    if (IN(3)) { dil_combine_phase(F); } SEAM(3);
    if (IN(4)) {
        pg8::Gemm g{(const void*)(F.ws + WS_MIX), (const void*)(F.ws + WS_WOUT), 2 * D}; pg8::StaticOrder S; S.init(T, D, 2 * D, F.G, (int)blockIdx.x);
        EpiY E{(bf16*)(F.ws + WS_Y)};
        pg8::gemm_phase<EpiY, pg8::StaticOrder, true, false, false>(F.lds + RING_OFF, (LAS unsigned*)(F.lds + IDB_OFF), g, S, E);
    } SEAM(4);
    if (IN(5)) { route_phase(F); } SEAM(5);
    if (IN(6)) {
        const int nmt = moe_build_table(F);
        pg8::Gemm g{(const void*)(F.ws + WS_X1B), (const void*)(F.ws + WS_WGU), D};
        MoeOrder S{(const LAS unsigned*)(F.lds + TBL_OFF), (const LAS unsigned*)(F.lds + LCNT_OFF), (const unsigned*)(F.ws + WS_LIST), nmt, F.G, F.vcu, 8, 4, D, (size_t)2 * DFF * D, false, (const unsigned*)(F.ws + WS_LRSTD), (const unsigned*)F.b_gu, 2 * DFF};
        EpiGU E{(unsigned char*)(F.ws + WS_ACT)};
        pg8::gemm_phase<EpiGU, MoeOrder, true, true, true, true>(F.lds + RING_OFF, (LAS unsigned*)(F.lds + IDB_OFF), g, S, E);
    } SEAM(6);
    if (IN(7)) {
        const int nmt = moe_build_table(F);
        pg8::Gemm g{(const void*)(F.ws + WS_ACT), (const void*)(F.ws + WS_WDN), DFF};
        MoeOrder S{(const LAS unsigned*)(F.lds + TBL_OFF), (const LAS unsigned*)(F.lds + LCNT_OFF), (const unsigned*)(F.ws + WS_LIST), nmt, F.G, F.vcu, 4, 8, DFF, (size_t)D * DFF, true, (const unsigned*)(F.ws + WS_LGATE), (const unsigned*)F.b_dn, D};
        EpiDown E{(bf16*)(F.ws + WS_YB)};
        pg8::gemm_phase<EpiDown, MoeOrder, true, true, true, true, true>(F.lds + RING_OFF, (LAS unsigned*)(F.lds + IDB_OFF), g, S, E);
    } SEAM(7);
    if (IN(8)) { final_phase(F); }
#undef IN
#undef SEAM
}

static void launch_phases(const Args& base, int lo, int hi, int use_bar, int grid, hipStream_t stream) {
    Args a = base; a.ph_lo = lo; a.ph_hi = hi; a.use_bar = use_bar;
    hipLaunchKernelGGL(mk_fwd, dim3(grid), dim3(NWAVES * 64), LDS_BYTES, stream, a);
}
extern "C" void kernel_launch(void* const* d_in, const int* in_sizes, int n_in, void* d_out, int out_size, void* d_ws, size_t ws_size, hipStream_t stream) {
    static int grid = 0;
    if (grid == 0) {
        if (n_in != 17 || in_sizes[0] != T * D || out_size != T * D || ws_size < (size_t)1000 * MiB) { fprintf(stderr, "kernel_launch: unexpected shapes / workspace (%d inputs, ws %zu)\n", n_in, ws_size); grid = -1; return; }
        int dev = 0, cus = 0, per_cu = 0;
        if (hipGetDevice(&dev) != hipSuccess || hipDeviceGetAttribute(&cus, hipDeviceAttributeMultiprocessorCount, dev) != hipSuccess) { grid = -1; return; }
        if (hipFuncSetAttribute((const void*)mk_fwd, hipFuncAttributeMaxDynamicSharedMemorySize, LDS_BYTES) != hipSuccess) { fprintf(stderr, "kernel_launch: hipFuncSetAttribute failed\n"); grid = -1; return; }
        if (hipOccupancyMaxActiveBlocksPerMultiprocessor(&per_cu, (const void*)mk_fwd, NWAVES * 64, LDS_BYTES) != hipSuccess || per_cu < 1) { fprintf(stderr, "kernel_launch: occupancy query says %d blocks per CU\n", per_cu); per_cu = 1; }
        (void)hipGetLastError();
        grid = cus;
        if (grid != 256) { fprintf(stderr, "kernel_launch: built for a 256-CU device (got %d)\n", cus); grid = -1; return; }
    }
    if (grid < 0) return;
    (void)hipMemsetAsync((char*)d_ws + WS_CTL, 0, CTL_ZERO_BYTES, stream);
    Args a{};
    for (int i = 0; i < 17; ++i) a.in[i] = (const float*)d_in[i];
    a.out = (float*)d_out; a.ws = (unsigned char*)d_ws;
    launch_phases(a, 0, 9, 1, grid, stream);
}
```

```cpp
#include <hip/hip_runtime.h>
#include <hip/hip_bf16.h>
#include <cstdint>
#include <cstdio>
#include <cmath>

constexpr int D = 1024, BATCH = 8, SEQ = 4096, T = BATCH * SEQ, DIN = 2560, NMEM = 256, NE = 32, DFF = 1024;
constexpr int C_DQ = 0, C_DK = 512, C_DV = 1024, C_LQ = 1536, C_LK = 1792, C_LV = 2048, C_MQ = 2304;
constexpr float EPS = 1e-5f;
constexpr int LCAP = T;
constexpr float QSCALE = 0.125f * 1.4426950408889634f;
constexpr float LOG2E = 1.4426950408889634f;
namespace pg8 {
#define PG8_LAS __attribute__((address_space(3)))
typedef unsigned short bf16_t;
typedef short bf16x8 __attribute__((ext_vector_type(8)));
typedef float f32x4 __attribute__((ext_vector_type(4)));
typedef unsigned u32x4 __attribute__((ext_vector_type(4)));
typedef unsigned u32x2 __attribute__((ext_vector_type(2)));
constexpr int BM = 256, BK = 64, HALF = 128, HTB = HALF * BK * 2  , STAGE_BYTES = 8 * HTB, NXCD = 8, WGM = 8;

__host__ __device__ __forceinline__ int lds_byte(int r, int c) { const int st = (r >> 4) * 2 + (c >> 5), rr = r & 15, cc = c & 31, ob = rr * 64 + cc * 2; return st * 1024 + (ob ^ (((ob >> 9) & 1) << 5)); }
__host__ __device__ __forceinline__ void stage_rc(int b, int& R, int& C) { const int st = b / 1024, sb = b % 1024, swz = sb ^ (((sb >> 9) & 1) << 5); R = (st >> 1) * 16 + swz / 64; C = (st & 1) * 32 + (swz % 64) / 2; }
__host__ __device__ __forceinline__ int perm32(int rho) { const int n = rho >> 4, i = rho & 15; return 8 * (i >> 2) + 4 * n + (i & 3); }

struct Unit { size_t aoff, boff; int pm, pn, e, valid, mt; };
struct Gemm { const void* A; const void* Bt; int RB; };
typedef int v8i __attribute__((ext_vector_type(8)));

struct StaticOrder {
    int nM, nN, nwg, G, c, RB; const unsigned* sc;
    __device__ void init(int M, int N, int RB_, int G_, int c_, const unsigned* sc_ = nullptr) { nM = M / BM; nN = N / BM; nwg = nM * nN; G = G_; c = c_; RB = RB_; sc = sc_; }
    __device__ bool next(int i, Unit& u) const {
        const long L = (long)i * G + c; if (L >= nwg) return false;
        int wgid = (int)L; { const int q = nwg / NXCD, r = nwg % NXCD, xcd = wgid % NXCD, off = wgid / NXCD; wgid = (xcd < r ? xcd * (q + 1) : r * (q + 1) + (xcd - r) * q) + off; }
        const int nig = WGM * nN, gid = wgid / nig, fm = gid * WGM, gsz = (nM - fm) < WGM ? (nM - fm) : WGM;
        u.pm = fm + ((wgid % nig) % gsz); u.pn = (wgid % nig) / gsz; u.e = 0; u.valid = 256; u.mt = 0;
        u.aoff = (size_t)u.pm * (size_t)(BM * RB); u.boff = (size_t)u.pn * (size_t)(BM * RB); return true;
    }
    __device__ __forceinline__ const unsigned* id_src(const Unit& u, int row) const { return sc + u.pm * 256 + row; }
    __device__ __forceinline__ const unsigned* sc_src(const Unit& u, int row) const { return sc + u.pm * 256 + row; }
    __device__ __forceinline__ const unsigned* bias_src(const Unit& u, int row) const { return sc + u.pm * 256 + row; }
};

__device__ __forceinline__ unsigned cvt_pk_bf16(float lo, float hi) { unsigned r; asm volatile("v_cvt_pk_bf16_f32 %0, %1, %2" : "=v"(r) : "v"(lo), "v"(hi)); return r; }

template <class Epi, class Sched, bool ALIGN_EPI, bool GATHER, bool IDS, bool FP8 = false, bool LINEAR = false>
__device__ __forceinline__ void gemm_phase(PG8_LAS unsigned char* lds, PG8_LAS unsigned* idb, const Gemm g, const Sched& S, const Epi& E) {
    const int tid = threadIdx.x, wid = __builtin_amdgcn_readfirstlane(tid >> 6), lane = tid & 63, wr = wid >> 2, wc = wid & 3, fr = lane & 15, fq = lane >> 4;
    const int RB = g.RB; int nt = RB / (BK * 2); asm volatile("" : "+s"(nt));
    unsigned voffA[2], voffB[2]; int RA[2], CA[2];
#pragma unroll
    for (int i = 0; i < 2; ++i) { int R, C; stage_rc(tid * 16 + i * 8192, R, C); const int Rb = (R & ~31) + perm32(R & 31); RA[i] = R; CA[i] = C;
        voffA[i] = (unsigned)(R * RB + C * 2); voffB[i] = (unsigned)(Rb * RB + C * 2); }
    const size_t kstep = (size_t)(BK * 2);
    const size_t hstep = (size_t)HALF * RB;
    const unsigned ldsw = (unsigned)wid * 1024u;
    const int aoff = lds_byte(wr * 64 + fr, fq * 8), boff = lds_byte(wc * 32 + fr, fq * 8);
#define PG8_SA(b, h) (((b) * 2 + (h)) * HTB)
#define PG8_SB(b, h) ((4 + (b) * 2 + (h)) * HTB)
#define PG8_STAGE(bufoff, gbase, voff) do { _Pragma("unroll") for (int _i = 0; _i < 2; ++_i) \
        __builtin_amdgcn_global_load_lds((const unsigned*)((const char*)(gbase) + (voff)[_i]), (PG8_LAS unsigned*)(lds + (bufoff) + ldsw + _i * 8192), 16, 0, 0); } while (0)
#define PG8_STAGE_A(bufoff, pbase, gbase, h, gv) do { if constexpr (GATHER) { PG8_STAGE(bufoff, gbase, gv[h]); } else { PG8_STAGE(bufoff, (pbase) + (h) * hstep, voffA); } } while (0)
#define PG8_LD32(p0_, p1_) __builtin_bit_cast(v8i, __builtin_shufflevector(*(const PG8_LAS u32x4*)(p0_), *(const PG8_LAS u32x4*)(p1_), 0, 1, 2, 3, 4, 5, 6, 7))
#define PG8_LDA(dst, b, h) do { if constexpr (FP8) { _Pragma("unroll") for (int m = 0; m < 4; ++m) dst##8[m] = PG8_LD32(lds + PG8_SA(b, h) + aoff + m * 2048, lds + PG8_SA(b, h) + aoff + m * 2048 + 1024); } \
        else { _Pragma("unroll") for (int m = 0; m < 4; ++m) _Pragma("unroll") for (int k = 0; k < 2; ++k) dst[m][k] = *(const PG8_LAS bf16x8*)(lds + PG8_SA(b, h) + aoff + m * 2048 + k * 1024); } } while (0)
#define PG8_LDB(dst, b, h) do { if constexpr (FP8) { _Pragma("unroll") for (int n = 0; n < 2; ++n) dst##8[n] = PG8_LD32(lds + PG8_SB(b, h) + boff + n * 2048, lds + PG8_SB(b, h) + boff + n * 2048 + 1024); } \
        else { _Pragma("unroll") for (int n = 0; n < 2; ++n) _Pragma("unroll") for (int k = 0; k < 2; ++k) dst[n][k] = *(const PG8_LAS bf16x8*)(lds + PG8_SB(b, h) + boff + n * 2048 + k * 1024); } } while (0)
#define PG8_MMA(ai, bj, At, Bt) do { __builtin_amdgcn_s_setprio(1); if constexpr (FP8) { _Pragma("unroll") for (int m = 0; m < 4; ++m) _Pragma("unroll") for (int n = 0; n < 2; ++n) \
        acc[ai][bj][m][n] = __builtin_amdgcn_mfma_scale_f32_16x16x128_f8f6f4(Bt##8[n], At##8[m], acc[ai][bj][m][n], 0, 0, 0, 0x7f7f7f7f, 0, 0x7f7f7f7f); } \
        else { _Pragma("unroll") for (int m = 0; m < 4; ++m) _Pragma("unroll") for (int n = 0; n < 2; ++n) _Pragma("unroll") for (int k = 0; k < 2; ++k) \
        acc[ai][bj][m][n] = __builtin_amdgcn_mfma_f32_16x16x32_bf16(Bt[n][k], At[m][k], acc[ai][bj][m][n], 0, 0, 0); } __builtin_amdgcn_s_setprio(0); } while (0)
#define PG8_WAIT_V(n) asm volatile("s_waitcnt vmcnt(" #n ")" ::: "memory")
#define PG8_WAIT_L(n) asm volatile("s_waitcnt lgkmcnt(" #n ")" ::: "memory")
#define PG8_BAR __builtin_amdgcn_s_barrier()
#define PG8_SCHED __builtin_amdgcn_sched_barrier(0)
#define PG8_IDS_DMA(u, s) do { if (wid < 4) { __builtin_amdgcn_global_load_lds(S.id_src(u, tid), (PG8_LAS unsigned*)(idb + (s) * 768 + wid * 64), 4, 0, 0); \
        __builtin_amdgcn_global_load_lds(S.sc_src(u, tid), (PG8_LAS unsigned*)(idb + (s) * 768 + 256 + wid * 64), 4, 0, 0); \
        __builtin_amdgcn_global_load_lds(S.bias_src(u, tid), (PG8_LAS unsigned*)(idb + (s) * 768 + 512 + wid * 64), 4, 0, 0); } } while (0)
#define PG8_GV(dst, s, un) do { _Pragma("unroll") for (int _h = 0; _h < 2; ++_h) _Pragma("unroll") for (int _i = 0; _i < 2; ++_i) \
        dst[_h][_i] = (LINEAR ? (unsigned)((un).pm * 256 + _h * 128 + RA[_i]) : (idb[(s) * 768 + _h * 128 + RA[_i]] >> 2)) * (unsigned)RB + (unsigned)(CA[_i] * 2); } while (0)
    Unit cur, nxt; int ui = 0, us = 0;
    if (!S.next(0, cur)) return;
    f32x4 acc[2][2][4][2];
#pragma unroll
    for (int a = 0; a < 2; ++a)
#pragma unroll
        for (int b = 0; b < 2; ++b)
#pragma unroll
            for (int m = 0; m < 4; ++m)
#pragma unroll
                for (int n = 0; n < 2; ++n) acc[a][b][m][n] = (f32x4){0.f, 0.f, 0.f, 0.f};
    bf16x8 At[4][2], B0[2][2], B1[2][2]; v8i At8[4], B08[2], B18[2];
    unsigned cv[2][2] = {{0u, 0u}, {0u, 0u}};
    const char* A0 = (const char*)g.A;
    const char* cA = A0 + (GATHER ? (size_t)0 : cur.aoff); const char* cB = (const char*)g.Bt + cur.boff;
    if constexpr (IDS) {
        PG8_IDS_DMA(cur, 0); PG8_WAIT_V(0); PG8_BAR;
    }
    if constexpr (GATHER) { PG8_GV(cv, 0, cur); }
    PG8_STAGE(PG8_SB(0, 0), cB, voffB); PG8_STAGE(PG8_SB(0, 1), cB + hstep, voffB); PG8_STAGE_A(PG8_SA(0, 0), cA, A0, 0, cv); PG8_STAGE_A(PG8_SA(0, 1), cA, A0, 1, cv);
    if (wr == 1) PG8_BAR;
    PG8_WAIT_V(2); PG8_BAR;
    PG8_STAGE(PG8_SB(1, 0), cB + kstep, voffB); PG8_STAGE_A(PG8_SA(1, 0), cA + kstep, A0 + kstep, 0, cv); PG8_STAGE(PG8_SB(1, 1), cB + hstep + kstep, voffB);
    PG8_WAIT_V(6); PG8_BAR;
    for (;;) {
        const bool has_next = S.next(ui + 1, nxt);
        const int ns = (us == 2) ? 0 : us + 1;
        if constexpr (IDS) { if (has_next) PG8_IDS_DMA(nxt, ns); }
        const char* nA = has_next ? A0 + (GATHER ? (size_t)0 : nxt.aoff) : cA; const char* nB = has_next ? (const char*)g.Bt + nxt.boff : cB;
#pragma nounroll
        for (int t = 0; t < nt; t += 2) {
            int lastv = (t == nt - 2) ? 1 : 0; asm volatile("" : "+v"(lastv)); const bool last = __builtin_amdgcn_readfirstlane(lastv) != 0;
            const char* a1 = cA + (size_t)(t + 1) * kstep;
            const char* a2 = last ? nA : cA + (size_t)(t + 2) * kstep; const char* b2 = last ? nB : cB + (size_t)(t + 2) * kstep;
            const char* a3 = a2 + kstep; const char* b3 = b2 + kstep;
            PG8_LDB(B0, 0, 0); PG8_LDB(B1, 0, 1); PG8_SCHED; PG8_LDA(At, 0, 0); PG8_STAGE_A(PG8_SA(1, 1), a1, a1, 1, cv);
            if constexpr (GATHER) { if (last && has_next) { PG8_GV(cv, ns, nxt); } }
            PG8_WAIT_V(8); PG8_WAIT_L(0); PG8_BAR; PG8_MMA(0, 0, At, B0); PG8_MMA(0, 1, At, B1); PG8_BAR; PG8_SCHED;
            PG8_LDA(At, 0, 1); PG8_STAGE(PG8_SB(0, 0), b2, voffB); PG8_STAGE(PG8_SB(0, 1), b2 + hstep, voffB); PG8_STAGE_A(PG8_SA(0, 0), a2, a2, 0, cv);
            PG8_WAIT_V(8); PG8_WAIT_L(0); PG8_BAR; PG8_MMA(1, 0, At, B0); PG8_MMA(1, 1, At, B1); PG8_BAR; PG8_SCHED;
            PG8_LDB(B0, 1, 0); PG8_LDB(B1, 1, 1); PG8_SCHED; PG8_LDA(At, 1, 0); PG8_STAGE_A(PG8_SA(0, 1), a2, a2, 1, cv);
            PG8_WAIT_V(8); PG8_WAIT_L(0); PG8_BAR; PG8_MMA(0, 0, At, B0); PG8_MMA(0, 1, At, B1); PG8_BAR; PG8_SCHED;
            PG8_LDA(At, 1, 1); PG8_STAGE(PG8_SB(1, 0), b3, voffB); PG8_STAGE(PG8_SB(1, 1), b3 + hstep, voffB); PG8_STAGE_A(PG8_SA(1, 0), a3, a3, 0, cv);
            PG8_WAIT_V(8); PG8_WAIT_L(0); PG8_BAR; PG8_MMA(1, 0, At, B0); PG8_MMA(1, 1, At, B1); PG8_BAR; PG8_SCHED;
        }
        if constexpr (ALIGN_EPI) { if (wr == 0) PG8_BAR; }
        PG8_SCHED;
        E(acc, cur, wr, wc, fr, fq, (const PG8_LAS unsigned*)(idb + us * 768));
        PG8_SCHED;
        if (!has_next) break;
#pragma unroll
        for (int a = 0; a < 2; ++a)
#pragma unroll
            for (int b = 0; b < 2; ++b)
#pragma unroll
                for (int m = 0; m < 4; ++m)
#pragma unroll
                    for (int n = 0; n < 2; ++n) acc[a][b][m][n] = (f32x4){0.f, 0.f, 0.f, 0.f};
        cur = nxt; cA = nA; cB = nB; ++ui; us = ns;
        if constexpr (ALIGN_EPI) { if (wr == 1) PG8_BAR; }
    }
    PG8_WAIT_V(0);
    if constexpr (!ALIGN_EPI) { if (wr == 0) PG8_BAR; }
    PG8_BAR;
#undef PG8_SA
#undef PG8_SB
#undef PG8_STAGE
#undef PG8_STAGE_A
#undef PG8_LDA
#undef PG8_LDB
#undef PG8_MMA
#undef PG8_LD32
#undef PG8_WAIT_V
#undef PG8_WAIT_L
#undef PG8_BAR
#undef PG8_SCHED
#undef PG8_IDS_DMA
#undef PG8_GV
}
}
namespace attn_body {
using bf16=__hip_bfloat16;
using bf16x8=__attribute__((ext_vector_type(8)))short;
using s16x4=__attribute__((ext_vector_type(4)))short;
using f32x16=__attribute__((ext_vector_type(16)))float;
using u32x4=__attribute__((ext_vector_type(4)))unsigned;
constexpr int D=64;
constexpr int NW=8,QBLK=32,QB=QBLK*NW,KVBLK=64;
struct UnitP { const bf16* Q; const bf16* K; const bf16* V; bf16* O; long qp, kp, op; int q0, t0, NT; float slope2; float* lse; int lse_stride; };
__device__ __forceinline__ int crow(int r,int hi){return (r&3)+8*(r>>2)+4*hi;}
#define SBAR() __builtin_amdgcn_sched_barrier(0)
template<bool CAUSAL,bool WINDOW> __device__ __forceinline__ void cmask(f32x16&p0,f32x16&p1,int jb,int qrel,int hi){
  const float NEG=-INFINITY; int kb=64*jb+4*hi;
  #pragma unroll
  for(int r=0;r<16;++r){int kv=kb+(r&3)+8*(r>>2);
    if(CAUSAL){ if(kv>qrel)p0[r]=NEG; if(kv+32>qrel)p1[r]=NEG; }
    if(WINDOW){ if(kv<qrel-128)p0[r]=NEG; if(kv+32<qrel-128)p1[r]=NEG; } }
}
__device__ __forceinline__ unsigned bfr(float x){ typedef float f2_ __attribute__((ext_vector_type(2))); typedef __bf16 b2_ __attribute__((ext_vector_type(2))); f2_ v={x,0.f}; b2_ b=__builtin_convertvector(v,b2_); return __builtin_bit_cast(unsigned,b)&0xffffu; }
__device__ __forceinline__ float bfv(unsigned b){ return __builtin_bit_cast(float,b<<16); }

constexpr int NSLOT=3, SLOTB=8192;
constexpr int LDS_K=0, LDS_V=NSLOT*SLOTB, LDS_WS=2*NSLOT*SLOTB, LDS_OST=LDS_WS+NW*64*4, LDS_BYTES=LDS_OST+NW*4096;
__device__ __forceinline__ void glds16(const void*gsrc,unsigned lds_dst){unsigned keep;
  asm volatile("s_mov_b32 %0, m0\n\ts_mov_b32 m0, %2\n\ts_nop 0\n\tglobal_load_lds_dwordx4 %1, off\n\ts_mov_b32 m0, %0":"=&s"(keep):"v"(gsrc),"s"(lds_dst):"memory");}
__device__ __forceinline__ float max3f(float a,float b,float c){float r;asm("v_max3_f32 %0, %1, %2, %3":"=v"(r):"v"(a),"v"(b),"v"(c));return r;}
__device__ __forceinline__ float max2f(float a,float b){float r;asm("v_max_f32_e32 %0, %1, %2":"=v"(r):"v"(a),"v"(b));return r;}
__device__ __forceinline__ float fadd_s(float a,float b){float r;asm("v_add_f32_e32 %0, %1, %2":"=v"(r):"v"(a),"v"(b));return r;}
__device__ __forceinline__ float fsub_s(float a,float b){float r;asm("v_sub_f32_e32 %0, %1, %2":"=v"(r):"v"(a),"v"(b));return r;}
typedef float f32x2_t __attribute__((ext_vector_type(2))); typedef __bf16 bf16x2_t __attribute__((ext_vector_type(2)));
__device__ __forceinline__ unsigned cvtpk_s(float lo,float hi){f32x2_t v={lo,hi};bf16x2_t b=__builtin_convertvector(v,bf16x2_t);return __builtin_bit_cast(unsigned,b);}
#define WAIT_BAR(N) asm volatile("s_waitcnt vmcnt(" #N ") lgkmcnt(0)\n\ts_barrier":::"memory")

__device__ __forceinline__ void qkt(f32x16&p0,f32x16&p1,const char*Kslot,const bf16x8*qr,bf16x8 kx0,bf16x8 kx1,bf16x8 qx,int r32,int hi){
  const char*kb=Kslot+hi*1024+r32*16;
  #pragma unroll
  for(int d0=0;d0<4;++d0){
    const bf16x8 b0=*reinterpret_cast<const bf16x8*>(kb+d0*2048);
    const bf16x8 b1=*reinterpret_cast<const bf16x8*>(kb+d0*2048+512);
    if(d0==0){p0=__builtin_amdgcn_mfma_f32_32x32x16_bf16(b0,qr[0],f32x16{},0,0,0);p1=__builtin_amdgcn_mfma_f32_32x32x16_bf16(b1,qr[0],f32x16{},0,0,0);}
    else{p0=__builtin_amdgcn_mfma_f32_32x32x16_bf16(b0,qr[d0],p0,0,0,0);p1=__builtin_amdgcn_mfma_f32_32x32x16_bf16(b1,qr[d0],p1,0,0,0);}}
  p0=__builtin_amdgcn_mfma_f32_32x32x16_bf16(kx0,qx,p0,0,0,0);p1=__builtin_amdgcn_mfma_f32_32x32x16_bf16(kx1,qx,p1,0,0,0);
}
typedef __attribute__((address_space(3))) const char* lds_cptr;
typedef short v4i16_t __attribute__((ext_vector_type(4)));
__device__ __forceinline__ void kload8(bf16x8*kf,lds_cptr kp){
  kf[0]=*(const __attribute__((address_space(3))) bf16x8*)(kp);      kf[1]=*(const __attribute__((address_space(3))) bf16x8*)(kp+512);
  kf[2]=*(const __attribute__((address_space(3))) bf16x8*)(kp+2048); kf[3]=*(const __attribute__((address_space(3))) bf16x8*)(kp+2560);
  kf[4]=*(const __attribute__((address_space(3))) bf16x8*)(kp+4096); kf[5]=*(const __attribute__((address_space(3))) bf16x8*)(kp+4608);
  kf[6]=*(const __attribute__((address_space(3))) bf16x8*)(kp+6144); kf[7]=*(const __attribute__((address_space(3))) bf16x8*)(kp+6656);
}
__device__ __forceinline__ void kload2(bf16x8*kf,lds_cptr kp,int j){ kf[2*j]=*(const __attribute__((address_space(3))) bf16x8*)(kp+j*2048); kf[2*j+1]=*(const __attribute__((address_space(3))) bf16x8*)(kp+j*2048+512); }
__device__ __forceinline__ s16x4 vtr(lds_cptr p){ return __builtin_bit_cast(s16x4,__builtin_amdgcn_ds_read_tr16_b64_v4i16((__attribute__((address_space(3))) v4i16_t*)p)); }
__device__ __forceinline__ float rowmax(const f32x16&p0,const f32x16&p1){
  float a=max3f(p0[0],p0[1],p1[0]),b=max3f(p0[2],p0[3],p1[1]);a=max3f(a,p1[2],p1[3]);
  #pragma unroll
  for(int r=4;r<16;r+=4){a=max3f(a,p0[r],p0[r+1]);b=max3f(b,p0[r+2],p0[r+3]);a=max3f(a,p1[r],p1[r+1]);b=max3f(b,p1[r+2],p1[r+3]);}
  const float m=max2f(a,b);
  auto rr=__builtin_amdgcn_permlane32_swap(__float_as_uint(m),__float_as_uint(m),false,false);
  return max2f(__uint_as_float(rr[0]),__uint_as_float(rr[1]));
}
__device__ __forceinline__ void pv(f32x16*o,int vb,bf16x8 pa0,bf16x8 pa1,bf16x8 pa2,bf16x8 pa3){
  #pragma unroll
  for(int d0=0;d0<2;++d0){s16x4 lo[4],hi[4];
    #pragma unroll
    for(int ks=0;ks<4;++ks){
      asm volatile("ds_read_b64_tr_b16 %0,%1 offset:%c2":"=&v"(lo[ks]):"v"(vb),"i"(d0*4096+ks*1024):"memory");
      asm volatile("ds_read_b64_tr_b16 %0,%1 offset:%c2":"=&v"(hi[ks]):"v"(vb),"i"(d0*4096+ks*1024+512):"memory");}
    asm volatile("s_waitcnt lgkmcnt(0)":::"memory");SBAR();
    #define PK(k) (bf16x8){lo[k][0],lo[k][1],lo[k][2],lo[k][3],hi[k][0],hi[k][1],hi[k][2],hi[k][3]}
    o[d0]=__builtin_amdgcn_mfma_f32_32x32x16_bf16(pa0,PK(0),o[d0],0,0,0);
    o[d0]=__builtin_amdgcn_mfma_f32_32x32x16_bf16(pa1,PK(1),o[d0],0,0,0);
    o[d0]=__builtin_amdgcn_mfma_f32_32x32x16_bf16(pa2,PK(2),o[d0],0,0,0);
    o[d0]=__builtin_amdgcn_mfma_f32_32x32x16_bf16(pa3,PK(3),o[d0],0,0,0);
    #undef PK
  }
}

#ifndef ATTN_STORE16
#define ATTN_STORE16(p,v) (*(u32x4*)(p)=(v))
#endif
template<int THRL,bool CAUSAL,bool WINDOW,bool ALIBI,bool LSE> __device__ __forceinline__ void attn_unit(const UnitP&U,char*shm){
  int tid=threadIdx.x; asm volatile("":"+v"(tid));
  const int lane=tid&63,r32=lane&31,hi=lane>>5; const int wid=__builtin_amdgcn_readfirstlane(tid>>6);
  const int q0=U.q0; const long qp=U.qp,kp=U.kp,op=U.op; const float slope2=U.slope2;
  const bf16*Qw=U.Q+(long)(q0+wid*QBLK)*qp;
  const bf16*Kh=U.K+(long)U.t0*KVBLK*kp,*Vh=U.V+(long)U.t0*KVBLK*kp;
  const unsigned lds0=(unsigned)(uintptr_t)shm;
  float*wsf=(float*)(shm+LDS_WS)+wid*64;
  const bf16*ksrc=Kh+(long)lane*kp+wid*8;
  const bf16*vsrc=Vh+(long)(16*(wid&3)+(lane>>2))*kp+(wid>>2)*32+(lane&3)*8;
  const unsigned kdst=lds0+LDS_K+wid*1024, vdst=lds0+LDS_V+wid*1024;
  #define DMA_K(t,slot) glds16(ksrc+(long)(t)*KVBLK*kp,(unsigned)__builtin_amdgcn_readfirstlane(kdst+(slot)))
  #define DMA_V(t,slot) glds16(vsrc+(long)(t)*KVBLK*kp,(unsigned)__builtin_amdgcn_readfirstlane(vdst+(slot)))
  const int vb0=(int)(lds0+LDS_V)+((lane>>4)&1)*32+(lane&3)*8+(4*hi+((lane&15)>>2))*64;
  const char*Kbase=shm+LDS_K; bf16x8 kf[8];
  const lds_cptr shm3=(lds_cptr)shm; const lds_cptr kp0=shm3+LDS_K+hi*1024+r32*16; const lds_cptr vp0=shm3+LDS_V+((lane>>4)&1)*32+(lane&3)*8+(4*hi+((lane&15)>>2))*64;
  const int NT=U.NT;
  DMA_K(0,0);DMA_V(0,0);DMA_K(1,SLOTB);
  bf16x8 qr[4];
  #pragma unroll
  for(int d0=0;d0<4;++d0)qr[d0]=*reinterpret_cast<const bf16x8*>(&Qw[(long)r32*qp+d0*16+hi*8]);
  float mhat=0.f,l_reg=0.f;f32x16 o[2];o[0]=f32x16{};o[1]=f32x16{};
  const int qrel=wid*QBLK+r32;
  #define CMASK(P0,P1,t) do{int jb_=(t)-(NT-4); if(WINDOW||(CAUSAL&&jb_>=0))cmask<CAUSAL,WINDOW>(P0,P1,jb_,qrel,hi);}while(0)
  bf16x8 kx0,kx1,qx;
  { const float k0_=ALIBI?slope2*(float)r32:0.f, k1_=ALIBI?slope2*(float)(r32+32):0.f; const unsigned h0=bfr(k0_),l0=bfr(k0_-bfv(h0)),h1=bfr(k1_),l1=bfr(k1_-bfv(h1));
    u32x4 a={0x3f803f80u,0x3f80u|(h0<<16),l0,0u}, b={0x3f803f80u,0x3f80u|(h1<<16),l1,0u}; if(hi){a=u32x4{0u,0u,0u,0u};b=a;} kx0=__builtin_bit_cast(bf16x8,a); kx1=__builtin_bit_cast(bf16x8,b); }
  #define QX_SET(t) do{ const float nb_=ALIBI?__builtin_fmaf(slope2,(float)(64*((t)-(NT-4))-qrel),-mhat):-mhat; const unsigned a_=bfr(nb_); const float r1_=nb_-bfv(a_); const unsigned b_=bfr(r1_); const unsigned c_=bfr(r1_-bfv(b_)); \
    u32x4 q_={a_|(b_<<16),c_|0x3f800000u,0x3f80u,0u}; if(hi)q_=u32x4{0u,0u,0u,0u}; qx=__builtin_bit_cast(bf16x8,q_); asm volatile("":"+v"(qx)); }while(0)
  bool resc=false;
  #define START(P0,P1) do{ const float rm=rowmax(P0,P1); resc=false; \
    { const float dl=(rm==-INFINITY)?0.f:rm; mhat=fadd_s(mhat,dl); \
      _Pragma("unroll") for(int r=0;r<16;++r){P0[r]=fsub_s(P0[r],dl);P1[r]=fsub_s(P1[r],dl);} } \
    _Pragma("unroll") for(int r=0;r<16;++r)P0[r]=__builtin_amdgcn_exp2f(P0[r]); }while(0)
  #define RESC() do{ if(resc){ asm volatile("s_waitcnt lgkmcnt(0)":::"memory"); \
      _Pragma("unroll") for(int d_=0;d_<2;++d_) _Pragma("unroll") for(int r=0;r<16;++r)o[d_][r]*=wsf[crow(r,hi)]; } }while(0)
  f32x16 pA0,pA1,pB0,pB1;
  int sl_prev=0,sl_cur=0,sl_next=SLOTB;
  #define ROT() do{sl_prev=sl_cur;sl_cur=sl_next;sl_next=(sl_next==(NSLOT-1)*SLOTB)?0:sl_next+SLOTB;}while(0)
  DMA_K(2,2*SLOTB);
  WAIT_BAR(3);
  QX_SET(0);
  qkt(pA0,pA1,Kbase,qr,kx0,kx1,qx,r32,hi);asm volatile("s_nop 15\n\ts_nop 7":"+v"(pA0),"+v"(pA1));CMASK(pA0,pA1,0);
  START(pA0,pA1);
  _Pragma("unroll") for(int r=0;r<16;++r)pA1[r]=__builtin_amdgcn_exp2f(pA1[r]);
  WAIT_BAR(0);
  DMA_K(3,0);DMA_V(1,SLOTB);
  ROT();
  kload8(kf,kp0+sl_cur);
  WAIT_BAR(2);
  s16x4 vlo[8],vhi[8]; u32x4 pw0,pw1,pw2,pw3;
  #define PKW(P,B) cvtpk_s(P[B],P[B+1])
  #define PAF(k) __builtin_bit_cast(bf16x8,pw##k)
  #define VFR(i) (bf16x8){vlo[i][0],vlo[i][1],vlo[i][2],vlo[i][3],vhi[i][0],vhi[i][1],vhi[i][2],vhi[i][3]}
  #define PIN(x) asm volatile("":"+v"(x))
  #define MX3(a,b,c) __builtin_fmaxf(__builtin_fmaxf((a),(b)),(c))
  #define GAPA(MF,A0,A1,A2,A3,W0,W1,PW) do{ MF; sacc+=A0; sacc+=A1; sacc+=A2; sacc+=A3; PIN(sacc); W0; W1; PIN(PW); SBAR(); }while(0)
  #define EX(v) __builtin_amdgcn_exp2f(v)
  #define GAPB(MF,X,B) do{ MF; X[B]=EX(X[B]); X[B+1]=EX(X[B+1]); X[B+2]=EX(X[B+2]); X[B+3]=EX(X[B+3]); PIN(X); SBAR(); }while(0)
  #define VRD(i) do{ vlo[i]=vtr(vp_+(((i)>>2)*4096+((i)&3)*1024)); vhi[i]=vtr(vp_+(((i)>>2)*4096+((i)&3)*1024+512)); }while(0)
  #define KRD(G,j) do{ if(G){ kload2(kf,kp0+sl_next,j); SBAR(); } }while(0)
  #define STEP(C0,C1,P0,P1,t,GK,GV,GL) do{ SBAR(); QX_SET(t); SBAR(); \
    const lds_cptr vp_=vp0+sl_prev; \
    VRD(0); SBAR(); float sacc=(P0[0]+P0[1]); \
    GAPA(C0=__builtin_amdgcn_mfma_f32_32x32x16_bf16(kf[0],qr[0],f32x16{},0,0,0), P0[2],P0[3],P0[4],P0[5],     pw0[0]=PKW(P0,0), pw0[1]=PKW(P0,2), pw0); \
    VRD(4); SBAR(); GAPA(C1=__builtin_amdgcn_mfma_f32_32x32x16_bf16(kf[1],qr[0],f32x16{},0,0,0), P0[6],P0[7],P0[8],P0[9],     pw0[2]=PKW(P0,4), pw0[3]=PKW(P0,6), pw0); \
    VRD(1); SBAR(); GAPA(C0=__builtin_amdgcn_mfma_f32_32x32x16_bf16(kf[2],qr[1],C0,0,0,0),   P0[10],P0[11],P0[12],P0[13], pw1[0]=PKW(P0,8), pw1[1]=PKW(P0,10), pw1); \
    VRD(5); SBAR(); GAPA(C1=__builtin_amdgcn_mfma_f32_32x32x16_bf16(kf[3],qr[1],C1,0,0,0),   P0[14],P0[15],P1[0],P1[1],   pw1[2]=PKW(P0,12),pw1[3]=PKW(P0,14), pw1); \
    VRD(2); SBAR(); GAPA(C0=__builtin_amdgcn_mfma_f32_32x32x16_bf16(kf[4],qr[2],C0,0,0,0),   P1[2],P1[3],P1[4],P1[5],     pw2[0]=PKW(P1,0), pw2[1]=PKW(P1,2), pw2); \
    VRD(6); SBAR(); GAPA(C1=__builtin_amdgcn_mfma_f32_32x32x16_bf16(kf[5],qr[2],C1,0,0,0),   P1[6],P1[7],P1[8],P1[9],     pw2[2]=PKW(P1,4), pw2[3]=PKW(P1,6), pw2); \
    VRD(3); SBAR(); GAPA(C0=__builtin_amdgcn_mfma_f32_32x32x16_bf16(kf[6],qr[3],C0,0,0,0),   P1[10],P1[11],P1[12],P1[13], pw3[0]=PKW(P1,8), pw3[1]=PKW(P1,10), pw3); \
    VRD(7); SBAR(); GAPA(C1=__builtin_amdgcn_mfma_f32_32x32x16_bf16(kf[7],qr[3],C1,0,0,0),   P1[14],P1[15],0.f,0.f,       pw3[2]=PKW(P1,12),pw3[3]=PKW(P1,14), pw3); \
    C0=__builtin_amdgcn_mfma_f32_32x32x16_bf16(kx0,qx,C0,0,0,0); C1=__builtin_amdgcn_mfma_f32_32x32x16_bf16(kx1,qx,C1,0,0,0); SBAR(); \
    l_reg+=sacc; \
    if(GK){DMA_K((t)+3,sl_cur);} if(GV){DMA_V((t)+1,sl_next);} \
    CMASK(C0,C1,t); \
    { float a=MX3(C0[0],C0[1],C1[0]),b=MX3(C0[2],C0[3],C1[1]); a=MX3(a,C1[2],C1[3]); \
      _Pragma("unroll") for(int r=4;r<16;r+=4){a=MX3(a,C0[r],C0[r+1]);b=MX3(b,C0[r+2],C0[r+3]);a=MX3(a,C1[r],C1[r+1]);b=MX3(b,C1[r+2],C1[r+3]);} \
      float rm=__builtin_fmaxf(a,b); { auto rr=__builtin_amdgcn_permlane32_swap(__float_as_uint(rm),__float_as_uint(rm),false,false); rm=__builtin_fmaxf(__uint_as_float(rr[0]),__uint_as_float(rr[1])); } \
      resc=false; \
      if(__builtin_expect(__any(rm>(float)THRL),0)){ const float dl=__builtin_fmaxf(rm,0.f); mhat+=dl; \
        _Pragma("unroll") for(int r=0;r<16;++r){C0[r]-=dl;C1[r]-=dl;} \
        const float f=__builtin_amdgcn_exp2f(-dl); l_reg*=f; if(hi==0)wsf[r32]=f; resc=true; } } \
    SBAR(); \
    GAPB(o[0]=__builtin_amdgcn_mfma_f32_32x32x16_bf16(PAF(0),VFR(0),o[0],0,0,0), C0,0); \
    GAPB(o[1]=__builtin_amdgcn_mfma_f32_32x32x16_bf16(PAF(0),VFR(4),o[1],0,0,0), C0,4); \
    KRD(GL,0); GAPB(o[0]=__builtin_amdgcn_mfma_f32_32x32x16_bf16(PAF(1),VFR(1),o[0],0,0,0), C0,8); \
    KRD(GL,1); GAPB(o[1]=__builtin_amdgcn_mfma_f32_32x32x16_bf16(PAF(1),VFR(5),o[1],0,0,0), C0,12); \
    KRD(GL,2); GAPB(o[0]=__builtin_amdgcn_mfma_f32_32x32x16_bf16(PAF(2),VFR(2),o[0],0,0,0), C1,0); \
    KRD(GL,3); GAPB(o[1]=__builtin_amdgcn_mfma_f32_32x32x16_bf16(PAF(2),VFR(6),o[1],0,0,0), C1,4); \
    GAPB(o[0]=__builtin_amdgcn_mfma_f32_32x32x16_bf16(PAF(3),VFR(3),o[0],0,0,0), C1,8); \
    GAPB(o[1]=__builtin_amdgcn_mfma_f32_32x32x16_bf16(PAF(3),VFR(7),o[1],0,0,0), C1,12); \
    }while(0)
  int t=1;
  #undef CMASK
  #define CMASK(P0,P1,t) do{}while(0)
  for(;t+5<NT;t+=2){
    STEP(pB0,pB1,pA0,pA1,t,true,true,true);     WAIT_BAR(2); RESC(); ROT();
    STEP(pA0,pA1,pB0,pB1,t+1,true,true,true);   WAIT_BAR(2); RESC(); ROT();
  }
  #undef CMASK
  #define CMASK(P0,P1,t) do{int jb_=(t)-(NT-4); if(WINDOW||(CAUSAL&&jb_>=0))cmask<CAUSAL,WINDOW>(P0,P1,jb_,qrel,hi);}while(0)
  #define ENDW(tt) do{ if((tt)+3<NT){WAIT_BAR(2);} else if((tt)+2<NT){WAIT_BAR(1);} else {WAIT_BAR(0);} }while(0)
  for(;t+1<NT;t+=2){
    STEP(pB0,pB1,pA0,pA1,t,(t+3<NT),(t+1<NT),(t+1<NT));       ENDW(t);   RESC(); ROT();
    STEP(pA0,pA1,pB0,pB1,t+1,(t+4<NT),(t+2<NT),(t+2<NT));     ENDW(t+1); RESC(); ROT();
  }
  STEP(pB0,pB1,pA0,pA1,NT-1,false,false,false); RESC();
  { float sacc=pB0[0]+pB0[1]; _Pragma("unroll") for(int r=2;r<16;++r)sacc+=pB0[r]; _Pragma("unroll") for(int r=0;r<16;++r)sacc+=pB1[r]; l_reg+=sacc;
    pw0=(u32x4){PKW(pB0,0),PKW(pB0,2),PKW(pB0,4),PKW(pB0,6)};pw1=(u32x4){PKW(pB0,8),PKW(pB0,10),PKW(pB0,12),PKW(pB0,14)};pw2=(u32x4){PKW(pB1,0),PKW(pB1,2),PKW(pB1,4),PKW(pB1,6)};pw3=(u32x4){PKW(pB1,8),PKW(pB1,10),PKW(pB1,12),PKW(pB1,14)};
    SBAR(); pv(o,vb0+sl_cur,PAF(0),PAF(1),PAF(2),PAF(3)); }
  #undef PKW
  #undef PAF
  #undef VFR
  #undef PIN
  #undef MX3
  #undef GAPA
  #undef GAPB
  #undef EX
  #undef VRD
  #undef KRD
  #undef STEP
  #undef ENDW
  {auto rr=__builtin_amdgcn_permlane32_swap(__float_as_uint(l_reg),__float_as_uint(l_reg),false,false);l_reg=__uint_as_float(rr[0])+__uint_as_float(rr[1]);}
  if(LSE){ if(hi==0)U.lse[(long)(q0+wid*QBLK+r32)*U.lse_stride]=mhat+__builtin_amdgcn_logf(l_reg); }
  if(hi==0)wsf[32+r32]=l_reg;asm volatile("s_waitcnt lgkmcnt(0)":::"memory");
  float rli[16];
  #pragma unroll
  for(int r=0;r<16;++r)rli[r]=__builtin_amdgcn_rcpf(wsf[32+crow(r,hi)]);
  bf16*Ow=U.O+(long)(q0+wid*QBLK)*op;
  { bf16*stg=(bf16*)(shm+LDS_OST)+wid*2048;
    #pragma unroll
    for(int r=0;r<16;++r){const int orow=crow(r,hi);
      #pragma unroll
      for(int d0=0;d0<2;++d0)stg[orow*64+d0*32+r32]=__float2bfloat16(o[d0][r]*rli[r]);}
    asm volatile("s_waitcnt lgkmcnt(0)":::"memory");
    #pragma unroll
    for(int i=0;i<4;++i){const int row=i*8+(lane>>3),ch=lane&7; const u32x4 v=*(const u32x4*)(stg+row*64+ch*8); ATTN_STORE16(Ow+(long)row*op+ch*8,v);} }
  asm volatile("s_waitcnt lgkmcnt(0)\n\ts_barrier":::"memory");
  #undef DMA_K
  #undef DMA_V
  #undef CMASK
  #undef START
  #undef RESC
  #undef ROT
  #undef QX_SET
}
constexpr int ATTN_LDS_BYTES=LDS_BYTES;
#undef SBAR
#undef WAIT_BAR
}
constexpr size_t MiB = 1u << 20;
constexpr size_t WS_CTL = 0, CTL_ZERO_BYTES = 1 * MiB;
constexpr size_t WS_LIST = 1 * MiB;
constexpr size_t WS_RGATE = 5 * MiB;
constexpr size_t WS_RSTD1 = 5 * MiB + 512 * 1024, WS_RSTD2 = WS_RSTD1 + 128 * 1024, WS_WRG = WS_RSTD2 + 128 * 1024;
constexpr size_t WS_WRT = 7 * MiB + 512 * 1024;
constexpr size_t WS_LSE = 6 * MiB;
constexpr size_t WS_MKV = 8 * MiB;
constexpr size_t WS_WIN = 10 * MiB, WS_WOUT = 15 * MiB, WS_WGU = 17 * MiB, WS_WDN = 145 * MiB;
constexpr size_t WS_XB = 209 * MiB;
constexpr size_t WS_LRSTD = 209 * MiB, WS_LGATE = 213 * MiB;
constexpr size_t WS_P = 273 * MiB, WS_OD = 433 * MiB, WS_ODIL = 497 * MiB;
constexpr size_t WS_ACT = 273 * MiB;
constexpr size_t WS_MIX = 545 * MiB, WS_X1B = 609 * MiB, WS_YB = 673 * MiB, WS_X1H = 801 * MiB, WS_Y = 929 * MiB, WS_END = 993 * MiB;
constexpr int CW_TMO = 0, CW_CODE = 1;
constexpr int CW_CNT = 64;
constexpr int CW_NRM = 256;
constexpr int CW_Q = 1024;
constexpr int CW_BAR = 4096;

constexpr int RING_OFF = 0, RING_BYTES = 131072;
constexpr int LDSCTL_OFF = RING_BYTES;
constexpr int IDB_OFF = LDSCTL_OFF;
constexpr int TBL_OFF = IDB_OFF + 9216;
constexpr int LCNT_OFF = TBL_OFF + 2304;
constexpr int MISC_OFF = LCNT_OFF + 256;
constexpr int STG_OFF = IDB_OFF;
constexpr int LDS_BYTES = 147456;
static_assert(MISC_OFF + 128 <= LDS_BYTES && 512 * 16 <= 9216, "LDS map");
constexpr int NWAVES = 8;

#define GAS __attribute__((address_space(1)))
#define LAS __attribute__((address_space(3)))
typedef unsigned short bf16;
typedef unsigned v4u __attribute__((ext_vector_type(4)));
typedef unsigned v2u __attribute__((ext_vector_type(2)));
typedef float f32x4 __attribute__((ext_vector_type(4)));
typedef float f32x16 __attribute__((ext_vector_type(16)));
typedef short bf16x8 __attribute__((ext_vector_type(8)));
typedef GAS unsigned gu32;
#define RLX_AGENT __ATOMIC_RELAXED, __HIP_MEMORY_SCOPE_AGENT
#define LDS_WAIT() asm volatile("s_waitcnt lgkmcnt(0)" ::: "memory")
#define VM_WAIT() asm volatile("s_waitcnt vmcnt(0)" ::: "memory")
__device__ __forceinline__ unsigned f2bf(float f) { unsigned u = __builtin_bit_cast(unsigned, f); return (u + 0x7fffu + ((u >> 16) & 1u)) >> 16; }
__device__ __forceinline__ unsigned pk2(float lo, float hi) { return f2bf(lo) | (f2bf(hi) << 16); }
__device__ __forceinline__ unsigned fp8x4(float a, float b, float c, float d) { int w = __builtin_amdgcn_cvt_pk_fp8_f32(a, b, 0, false); w = __builtin_amdgcn_cvt_pk_fp8_f32(c, d, w, true); return (unsigned)w; }
constexpr float WSCALE = 64.f, ASCALE = 8.f, YSCALE = 64.f;
__device__ __forceinline__ float bf2f(unsigned short b) { return __builtin_bit_cast(float, (unsigned)b << 16); }
__device__ __forceinline__ float bflo(unsigned w) { return __builtin_bit_cast(float, w << 16); }
__device__ __forceinline__ float bfhi(unsigned w) { return __builtin_bit_cast(float, w & 0xffff0000u); }
__device__ __forceinline__ float wave_sum(float v) {
#pragma unroll
    for (int o = 1; o < 64; o <<= 1) v += __shfl_xor(v, o);
    return v;
}

#define XB_TMO      128
#define XB_XCNT(j)  (256  + 64 * (j))
#define XB_XSUB(j)  (1280 + 64 * (j))
#define XB_XGEN(j)  (2304 + 64 * (j))
#define XB_TOP      3328
#define XB_TOPGEN   3392
#define XCD_BAR_WORDS 3456
#define XB_SPIN_CAP (1u << 20)
__device__ __forceinline__ unsigned xb_ld(unsigned* p)              { return __hip_atomic_load(p, __ATOMIC_RELAXED, __HIP_MEMORY_SCOPE_AGENT); }
__device__ __forceinline__ unsigned xb_add(unsigned* p, unsigned v) { return __hip_atomic_fetch_add(p, v, __ATOMIC_RELAXED, __HIP_MEMORY_SCOPE_AGENT); }
__device__ __forceinline__ unsigned xb_xcc_id() { return (unsigned)__builtin_amdgcn_s_getreg((3 << 11) | 20) & 0xFu; }
#define XB_SPIN(cond, bar) do { unsigned _sp = 0; while (cond) { __builtin_amdgcn_s_sleep(1); \
    if ((++_sp & 255u) == 0u) { if (xb_ld(&(bar)[XB_TMO])) break; if (_sp > XB_SPIN_CAP) { atomicAdd(&(bar)[XB_TMO], 1u); break; } } } } while (0)
struct XcdBarrier { unsigned* bar; unsigned x; volatile LAS unsigned* st; };
__device__ __forceinline__ XcdBarrier xcd_barrier_post(unsigned* bar, volatile LAS unsigned* st) {
    XcdBarrier b; b.bar = bar; b.x = xb_xcc_id(); b.st = st;
    if (threadIdx.x == 0) (void)xb_add(&bar[XB_XCNT(b.x)], 1u);
    return b;
}
__device__ __forceinline__ void xcd_barrier_complete(unsigned* bar, unsigned x, unsigned& nloc, unsigned& nx) {
    const unsigned G = gridDim.x * gridDim.y * gridDim.z;
    unsigned sum, cnt, mine, sp = 0u;
    for (;;) {
        sum = 0u; cnt = 0u; mine = 0u;
#pragma unroll
        for (unsigned j = 0; j < 16; ++j) { const unsigned c = xb_ld(&bar[XB_XCNT(j)]); sum += c; cnt += (c > 0u) ? 1u : 0u; mine = (j == x) ? c : mine; }
        if (sum == G) break;
        __builtin_amdgcn_s_sleep(1);
        if ((++sp & 255u) == 0u) { if (xb_ld(&bar[XB_TMO])) break; if (sp > XB_SPIN_CAP) { atomicAdd(&bar[XB_TMO], 1u); break; } }
    }
    nloc = mine > 0u ? mine : 1u; nx = cnt > 0u ? cnt : 1u;
}
__device__ __forceinline__ void xcd_barrier(const XcdBarrier& b) {
    asm volatile("s_waitcnt vmcnt(0)" ::: "memory");
    __syncthreads();
    if (threadIdx.x == 0) {
        unsigned* bar = b.bar;
        __builtin_amdgcn_s_waitcnt(0);
        unsigned nloc = b.st[0], nx = b.st[1];
        if (nloc == 0u) { xcd_barrier_complete(bar, b.x, nloc, nx); b.st[0] = nloc; b.st[1] = nx; }
        const unsigned old = xb_add(&bar[XB_XSUB(b.x)], 1u);
        const unsigned gen = old / nloc;
        if (old + 1u == (gen + 1u) * nloc) {
            __builtin_amdgcn_fence(__ATOMIC_RELEASE, "agent");
            asm volatile("s_waitcnt vmcnt(0)" ::: "memory");
            const unsigned og = xb_add(&bar[XB_TOP], 1u);
            const unsigned tg = og / nx;
            if (og + 1u == (tg + 1u) * nx) xb_add(&bar[XB_TOPGEN], 1u);
            else XB_SPIN(xb_ld(&bar[XB_TOPGEN]) == tg, bar);
            __builtin_amdgcn_fence(__ATOMIC_ACQUIRE, "agent");
            xb_add(&bar[XB_XGEN(b.x)], 1u);
            asm volatile("s_waitcnt vmcnt(0)" ::: "memory");
        } else {
            XB_SPIN(xb_ld(&bar[XB_XGEN(b.x)]) == gen, bar);
            __builtin_amdgcn_fence(__ATOMIC_ACQUIRE, "agent");
            asm volatile("s_waitcnt vmcnt(0)" ::: "memory");
        }
    }
    __syncthreads();
}

struct Frame {
    LAS unsigned char* lds;
    volatile LAS unsigned* MISC;
    gu32* ctl;
    int tid, lane, wave;
    int vcu, G;
    const float *x, *mem, *g_attn, *g_mem, *w_in, *lamqk, *subg, *w_mkv, *w_out, *g_ffn, *w_r, *b_r, *w_gu, *b_gu, *w_dn, *b_dn, *g_fin;
    float* out; unsigned char* ws;
};

#define P0_LOAD(dst, itm) do { const int m_ = (itm) / ipm, r_ = (itm) % ipm, kb_ = r_ / nblk, nb_ = r_ % nblk; \
        const float* src_ = W + (size_t)m_ * K * N + (size_t)(64 * kb_ + (lane >> 5)) * N + 32 * nb_ + (lane & 31); \
        _Pragma("unroll") for (int i_ = 0; i_ < 32; ++i_) dst[i_] = src_[(size_t)(2 * i_) * N]; } while (0)
template <bool F8, class RowMap>
__device__ __forceinline__ void p0_transpose_all(const float* W, int K, int N, int nmat, void* WTv, const float* gk, float wscale, LAS float* scr, int gw, int NGW, int lane, RowMap rowmap) {
    asm volatile("" : "+v"(lane));
    const int nblk = N / 32, ipm = (K / 64) * nblk, total = nmat * ipm;
    int it = gw; if (it >= total) return;
    float v[32], w[32];
    P0_LOAD(v, it);
    for (;;) {
        const int nx = it + NGW; const bool more = nx < total;
        if (more) P0_LOAD(w, nx);
        const int m = it / ipm, r = it % ipm, k0 = 64 * (r / nblk), n0 = 32 * (r % nblk);
        if (gk) {
#pragma unroll
            for (int i = 0; i < 32; ++i) v[i] *= gk[k0 + 2 * i + (lane >> 5)] * wscale;
        } else if (F8) {
#pragma unroll
            for (int i = 0; i < 32; ++i) v[i] *= wscale;
        }
#pragma unroll
        for (int i = 0; i < 32; ++i) scr[(2 * i + (lane >> 5)) * 33 + (lane & 31)] = v[i];
        LDS_WAIT(); asm volatile("" ::: "memory");
        const int c = lane & 7;
#pragma unroll
        for (int j = 0; j < 4; ++j) { const int n = (lane >> 3) + 8 * j; const LAS float* s = scr + (8 * c) * 33 + n;
            if constexpr (F8) { unsigned char* wt = (unsigned char*)WTv + (size_t)m * N * K;
                v2u o; o.x = fp8x4(s[0 * 33], s[1 * 33], s[2 * 33], s[3 * 33]); o.y = fp8x4(s[4 * 33], s[5 * 33], s[6 * 33], s[7 * 33]);
                *(GAS v2u*)(wt + (size_t)rowmap(n0 + n) * K + k0 + 8 * c) = o; }
            else { bf16* wt = (bf16*)WTv + (size_t)m * N * K;
                v4u o; o.x = pk2(s[0 * 33], s[1 * 33]); o.y = pk2(s[2 * 33], s[3 * 33]); o.z = pk2(s[4 * 33], s[5 * 33]); o.w = pk2(s[6 * 33], s[7 * 33]);
                *(GAS v4u*)(wt + (size_t)rowmap(n0 + n) * K + k0 + 8 * c) = o; } }
        LDS_WAIT(); asm volatile("" ::: "memory");
        if (!more) break;
#pragma unroll
        for (int i = 0; i < 32; ++i) v[i] = w[i];
        it = nx;
    }
}
#undef P0_LOAD
struct RowId { __device__ __forceinline__ int operator()(int n) const { return n; } };
struct RowGU { __device__ __forceinline__ int operator()(int n) const { const int f = n >> 1, u = n & 1; return ((f >> 7) << 8) + (u << 7) + (f & 127); } };

__device__ __forceinline__ void p0_x_rows2(Frame& F, const float* xrow, bf16* orow, float* rstd_out) {
    const GAS f32x4* xr = (const GAS f32x4*)xrow + F.lane;
    f32x4 v[8]; float s0 = 0.f, s1 = 0.f;
#pragma unroll
    for (int j = 0; j < 8; ++j) v[j] = xr[64 * j];
#pragma unroll
    for (int j = 0; j < 4; ++j) { s0 += (v[j].x * v[j].x + v[j].y * v[j].y) + (v[j].z * v[j].z + v[j].w * v[j].w); s1 += (v[4 + j].x * v[4 + j].x + v[4 + j].y * v[4 + j].y) + (v[4 + j].z * v[4 + j].z + v[4 + j].w * v[4 + j].w); }
    s0 = wave_sum(s0); s1 = wave_sum(s1);
    GAS unsigned long long* o8 = (GAS unsigned long long*)orow + F.lane;
#pragma unroll
    for (int j = 0; j < 8; ++j) o8[64 * j] = (unsigned long long)pk2(v[j].x, v[j].y) | ((unsigned long long)pk2(v[j].z, v[j].w) << 32);
    if (F.lane == 0) { rstd_out[0] = 1.f / sqrtf(s0 * (1.f / D) + EPS); rstd_out[1] = 1.f / sqrtf(s1 * (1.f / D) + EPS); }
}
__device__ __forceinline__ void p0_mkv_tile(Frame& F, int tile, bf16* mkv) {
    const int mt = tile >> 4, nt = tile & 15, m0 = 32 * mt, n0 = 32 * nt, r = F.lane & 31, h = F.lane >> 5;
    f32x16 acc = {}; float ss = 0.f;
    const float* mrow = F.mem + (size_t)(m0 + r) * D + 8 * h;
    const float* wcol = F.w_mkv + (size_t)(8 * h) * 512 + n0 + r;
    const float* gp = F.g_mem + 8 * h;
    for (int k0 = 0; k0 < D; k0 += 16) {
        const f32x4 a0 = *(const f32x4*)(mrow + k0), a1 = *(const f32x4*)(mrow + k0 + 4);
        const f32x4 g0 = *(const f32x4*)(gp + k0), g1 = *(const f32x4*)(gp + k0 + 4);
        ss += (a0.x * a0.x + a0.y * a0.y) + (a0.z * a0.z + a0.w * a0.w) + (a1.x * a1.x + a1.y * a1.y) + (a1.z * a1.z + a1.w * a1.w);
        v4u bw; bw.x = pk2(a0.x * g0.x, a0.y * g0.y); bw.y = pk2(a0.z * g0.z, a0.w * g0.w); bw.z = pk2(a1.x * g1.x, a1.y * g1.y); bw.w = pk2(a1.z * g1.z, a1.w * g1.w);
        float wv[8];
#pragma unroll
        for (int j = 0; j < 8; ++j) wv[j] = wcol[(size_t)(k0 + j) * 512];
        v4u aw; aw.x = pk2(wv[0], wv[1]); aw.y = pk2(wv[2], wv[3]); aw.z = pk2(wv[4], wv[5]); aw.w = pk2(wv[6], wv[7]);
        acc = __builtin_amdgcn_mfma_f32_32x32x16_bf16(__builtin_bit_cast(bf16x8, aw), __builtin_bit_cast(bf16x8, bw), acc, 0, 0, 0);
    }
    ss += __shfl_xor(ss, 32);
    const float rstd = 1.f / sqrtf(ss * (1.f / D) + EPS);
    bf16* orow = mkv + (size_t)(m0 + r) * 512 + n0 + 4 * h;
#pragma unroll
    for (int q = 0; q < 4; ++q) { v2u o; o.x = pk2(acc[4 * q] * rstd, acc[4 * q + 1] * rstd); o.y = pk2(acc[4 * q + 2] * rstd, acc[4 * q + 3] * rstd); *(GAS v2u*)(orow + 8 * q) = o; }
}
__device__ __forceinline__ void p0_prologue(Frame& F) {
    LAS float* scr = (LAS float*)(F.lds + RING_OFF + F.wave * 16384);
    const int gw = F.vcu * NWAVES + F.wave, NGW = F.G * NWAVES;
    bf16* win_t = (bf16*)(F.ws + WS_WIN); bf16* wout_t = (bf16*)(F.ws + WS_WOUT);
    if (F.wave < 4 && F.G == 256) p0_mkv_tile(F, F.wave * 256 + F.vcu, (bf16*)(F.ws + WS_MKV));
    p0_transpose_all<false>(F.w_in, D, DIN, 1, win_t, F.g_attn, 1.f, scr, gw, NGW, F.lane, RowId());
    p0_transpose_all<false>(F.w_out, D, D, 1, wout_t, nullptr, 1.f, scr, gw, NGW, F.lane, RowId());
    bf16* xb = (bf16*)(F.ws + WS_XB); float* rstd1 = (float*)(F.ws + WS_RSTD1);
    for (int m = 2 * gw; m < T; m += 2 * NGW) p0_x_rows2(F, F.x + (size_t)m * D, xb + (size_t)m * D, rstd1 + m);
    bf16* wrt = (bf16*)(F.ws + WS_WRT);
    for (int i = gw * 64 + F.lane; i < D * NE; i += NGW * 64) { const int e = i >> 10, k = i & 1023; const float w = F.w_r[k * NE + e] * F.g_ffn[k]; const unsigned hb = f2bf(w); wrt[i] = (bf16)hb; wrt[D * NE + i] = (bf16)f2bf(w - bf2f((bf16)hb)); }
}

constexpr int NCONV = 8, NCONV_ALL = 8 * NCONV;
__device__ __forceinline__ void p0b_unit(Frame& F, int c) {
    LAS float* scr = (LAS float*)(F.lds + RING_OFF + F.wave * 16384);
    p0_transpose_all<true>(F.w_gu, D, 2 * DFF, NE, (void*)(F.ws + WS_WGU), F.g_ffn, WSCALE, scr, c * NWAVES + F.wave, NCONV_ALL * NWAVES, F.lane, RowGU());
    p0_transpose_all<true>(F.w_dn, DFF, D, NE, (void*)(F.ws + WS_WDN), nullptr, WSCALE, scr, c * NWAVES + F.wave, NCONV_ALL * NWAVES, F.lane, RowId());
    __syncthreads();
}

struct EpiInProj {
    bf16* O; const float* rstd; unsigned* nrm;
    __device__ __forceinline__ void operator()(const pg8::f32x4 (&acc)[2][2][4][2], const pg8::Unit& u, int wr, int wc, int fr, int fq, const LAS unsigned* ids) const {
        asm volatile("" : "+v"(fr), "+v"(fq));
        const int row0 = u.pm * 256 + wr * 64 + fr, col0 = u.pn * 256 + wc * 32 + 8 * fq;
        const float sc = (u.pn <= 1 || u.pn == 6 || u.pn == 9) ? QSCALE : 1.f;
        const LAS float* scl = (const LAS float*)(ids + 256);
        float rsv[2][4];
#pragma unroll
        for (int ai = 0; ai < 2; ++ai)
#pragma unroll
            for (int m = 0; m < 4; ++m) rsv[ai][m] = scl[wr * 64 + fr + ai * 128 + m * 16];
#pragma unroll
        for (int ai = 0; ai < 2; ++ai)
#pragma unroll
            for (int m = 0; m < 4; ++m) { const int row = row0 + ai * 128 + m * 16; const float rs = rsv[ai][m] * sc; bf16* rowp = O + (size_t)row * DIN + col0;
#pragma unroll
                for (int bj = 0; bj < 2; ++bj) { const pg8::f32x4 v0 = acc[ai][bj][m][0] * rs, v1 = acc[ai][bj][m][1] * rs;
                    v4u w; w.x = pg8::cvt_pk_bf16(v0[0], v0[1]); w.y = pg8::cvt_pk_bf16(v0[2], v0[3]); w.z = pg8::cvt_pk_bf16(v1[0], v1[1]); w.w = pg8::cvt_pk_bf16(v1[2], v1[3]);
                    *(v4u*)(rowp + bj * 128) = w; } }
        if (u.pn < 4) {
#pragma unroll
            for (int bj = 0; bj < 2; ++bj) { float mx = 0.f;
#pragma unroll
                for (int ai = 0; ai < 2; ++ai)
#pragma unroll
                    for (int m = 0; m < 4; ++m) { const float rs = rsv[ai][m] * sc; const pg8::f32x4 v0 = acc[ai][bj][m][0] * rs, v1 = acc[ai][bj][m][1] * rs;
                        float s = (v0[0] * v0[0] + v0[1] * v0[1]) + (v0[2] * v0[2] + v0[3] * v0[3]) + (v1[0] * v1[0] + v1[1] * v1[1]) + (v1[2] * v1[2] + v1[3] * v1[3]);
                        s += __shfl_xor(s, 16); s += __shfl_xor(s, 32); mx = fmaxf(mx, s); }
#pragma unroll
                for (int o = 1; o < 16; o <<= 1) mx = fmaxf(mx, __shfl_xor(mx, o));
                if ((fr | fq) == 0) atomicMax(nrm + (((u.pm >> 4) * 4 + u.pn) * 4 + 2 * bj + (wc >> 1)) * 2 + (wc & 1), __builtin_bit_cast(unsigned, mx)); }
        }
    }
};
__device__ __forceinline__ void attn_phase(Frame& F, char* shm, int qoff = 0, int gmask = 7) {
    using namespace attn_body;
    const attn_body::bf16* P = (const attn_body::bf16*)(F.ws + WS_P);
    attn_body::bf16* OD = (attn_body::bf16*)(F.ws + WS_OD);
    attn_body::bf16* mix = (attn_body::bf16*)(F.ws + WS_MIX);
    attn_body::bf16* ODIL = (attn_body::bf16*)(F.ws + WS_ODIL); float* LSEb = (float*)(F.ws + WS_LSE);
    const attn_body::bf16* MKV = (const attn_body::bf16*)(F.ws + WS_MKV);
    const float* nrm = (const float*)(F.ctl + CW_NRM);
    const int grp = (int)blockIdx.x & 7, b = grp;
    unsigned* qctr = (unsigned*)(F.ctl + CW_Q + qoff) + 64 * grp;
    const attn_body::bf16* Pb = P + (size_t)b * SEQ * DIN;
    unsigned nxt_tok = 0u;
    if (F.tid == 0) nxt_tok = __hip_atomic_fetch_add(qctr, 1u, __ATOMIC_RELAXED, __HIP_MEMORY_SCOPE_AGENT);
    for (;;) {
        if (F.tid == 0) F.MISC[20] = nxt_tok;
        __syncthreads();
        int un = (int)F.MISC[20];
        __syncthreads();
        if (F.tid == 0 && un < NCONV + 512) nxt_tok = __hip_atomic_fetch_add(qctr, 1u, __ATOMIC_RELAXED, __HIP_MEMORY_SCOPE_AGENT);
        if (un < NCONV) { if (gmask == 7) p0b_unit(F, grp * NCONV + un); continue; }
        un -= NCONV;
        if (un >= 512) break;
        if (un < 256) {
            if (!(gmask & 1)) continue;
            const int qb = 15 - (un >> 4), h = 3 - ((un >> 2) & 3), pass = un & 3, j = pass >> 1, vh = pass & 1;
            const float slope2 = exp2f(-(float)(2 * h + 1)) * LOG2E;
            const int ni = ((b * 4 + (h >> 1)) * 4 + 2 * (h & 1) + j) * 2;
            const float R = sqrtf((nrm[ni] + nrm[ni + 1]) * (nrm[ni + 16] + nrm[ni + 17])) * 1.01f;
            const float kfirst = (float)(qb * 256) - (2.f * R + 160.f) / slope2;
            int t0 = kfirst > 0.f ? (int)(kfirst * (1.f / 64.f)) : 0; t0 = min(t0, 4 * qb); t0 &= ~1;
            UnitP U; U.Q = Pb + C_DQ + h * 128 + j * 64; U.K = Pb + C_DK + h * 128 + j * 64; U.V = Pb + C_DV + h * 128 + vh * 64;
            U.O = OD + (size_t)b * SEQ * 1024 + h * 256 + j * 128 + vh * 64; U.qp = DIN; U.kp = DIN; U.op = 1024;
            U.q0 = qb * 256; U.t0 = t0; U.NT = 4 * qb + 4 - t0; U.slope2 = slope2; U.lse = nullptr; U.lse_stride = 0;
            attn_unit<32, true, false, true, false>(U, shm);
        } else if (un < 448) {
            if (!(gmask & 2)) continue;
            const int du = un - 256, h = du / 48, idx = du % 48, n = idx >> 4, w = idx & 15;
            const int r = (n == 0) ? 1 : (n == 1 ? 4 : 16), c = (n == 0) ? 0 : (n == 1 ? (w >> 2) : w), blk = (n == 0) ? w : (n == 1 ? (w & 3) : 0);
            const attn_body::bf16* Pc = Pb + (size_t)c * DIN;
            UnitP U; U.Q = Pc + C_LQ + h * 64; U.K = Pc + C_LK + h * 64; U.V = Pc + C_LV + h * 64; U.qp = (long)r * DIN; U.kp = (long)r * DIN;
            U.O = ODIL + (size_t)n * T * 256 + ((size_t)b * SEQ + c) * 256 + h * 64; U.op = (long)r * 256;
            U.q0 = blk * 256; U.t0 = (blk == 0) ? 0 : 4 * blk - 2; U.NT = 4 * blk + 4 - U.t0;
            U.slope2 = exp2f(-(float)(2 * h + 2)) * (float)r * LOG2E;
            U.lse = LSEb + (size_t)n * T * 4 + ((size_t)b * SEQ + c) * 4 + h; U.lse_stride = r * 4;
            attn_unit<32, true, true, true, true>(U, shm);
        } else {
            if (!(gmask & 4)) continue;
            const int mu = un - 448, h = mu >> 4, qb = mu & 15;
            UnitP U; U.Q = Pb + C_MQ + h * 64; U.qp = DIN; U.K = MKV + (size_t)b * NMEM * 512 + h * 64; U.V = U.K + 256; U.kp = 512;
            U.O = mix + (size_t)b * SEQ * 1024 + 768 + h * 64; U.op = 1024; U.q0 = qb * 256; U.t0 = 0; U.NT = 4; U.slope2 = 0.f; U.lse = nullptr; U.lse_stride = 0;
            attn_unit<8, false, false, false, false>(U, shm);
        }
    }
}
__device__ __forceinline__ void dil_combine_phase(Frame& F) {
    const int gw = F.vcu * NWAVES + F.wave, NGW = F.G * NWAVES;
    const bf16* OD = (const bf16*)(F.ws + WS_OD); const bf16* ODIL = (const bf16*)(F.ws + WS_ODIL); const float* LSEb = (const float*)(F.ws + WS_LSE); bf16* mix = (bf16*)(F.ws + WS_MIX);
    const int h = F.lane >> 4, pt = F.lane & 15, d4 = pt * 4;
    float lam;
    { const float a = F.lamqk[F.lane] * F.lamqk[64 + F.lane], c = F.lamqk[128 + F.lane] * F.lamqk[192 + F.lane];
      lam = __expf(wave_sum(a)) - __expf(wave_sum(c)) + 0.2f; }
    float gsub[8];
#pragma unroll
    for (int i = 0; i < 8; ++i) gsub[i] = F.subg[pt * 8 + i] * 0.8f;
    for (int row0 = 4 * gw; row0 < T; row0 += 4 * NGW) {
        float l[4][3]; v2u q[4][3]; v4u o1[4], o2[4];
#pragma unroll
        for (int i = 0; i < 4; ++i) {
            o1[i] = *(const v4u*)(OD + (size_t)(row0 + i) * 1024 + h * 256 + pt * 8); o2[i] = *(const v4u*)(OD + (size_t)(row0 + i) * 1024 + h * 256 + 128 + pt * 8);
#pragma unroll
            for (int n = 0; n < 3; ++n) { l[i][n] = LSEb[(size_t)n * T * 4 + (size_t)(row0 + i) * 4 + h]; q[i][n] = *(const v2u*)(ODIL + (size_t)n * T * 256 + (size_t)(row0 + i) * 256 + h * 64 + d4); } }
#pragma unroll
        for (int i = 0; i < 4; ++i) {
            const unsigned aw[4] = {o1[i].x, o1[i].y, o1[i].z, o1[i].w}, bw[4] = {o2[i].x, o2[i].y, o2[i].z, o2[i].w};
            float d[8], ss = 0.f;
#pragma unroll
            for (int c = 0; c < 4; ++c) { d[2 * c] = bflo(aw[c]) - lam * bflo(bw[c]); d[2 * c + 1] = bfhi(aw[c]) - lam * bfhi(bw[c]); ss += d[2 * c] * d[2 * c] + d[2 * c + 1] * d[2 * c + 1]; }
#pragma unroll
            for (int o = 1; o < 16; o <<= 1) ss += __shfl_xor(ss, o);
            const float rstd = 1.f / sqrtf(ss * (1.f / 128.f) + EPS);
            v4u od; od.x = pk2(d[0] * rstd * gsub[0], d[1] * rstd * gsub[1]); od.y = pk2(d[2] * rstd * gsub[2], d[3] * rstd * gsub[3]); od.z = pk2(d[4] * rstd * gsub[4], d[5] * rstd * gsub[5]); od.w = pk2(d[6] * rstd * gsub[6], d[7] * rstd * gsub[7]);
            *(v4u*)(mix + (size_t)(row0 + i) * 1024 + h * 128 + pt * 8) = od;
            const float m = fmaxf(fmaxf(l[i][0], l[i][1]), l[i][2]);
            float wn[3], den = 0.f;
#pragma unroll
            for (int n = 0; n < 3; ++n) { wn[n] = exp2f(l[i][n] - m); den += wn[n]; }
            const float inv = 1.f / den; float o[4] = {0.f, 0.f, 0.f, 0.f};
#pragma unroll
            for (int n = 0; n < 3; ++n) { const float wq = wn[n] * inv; o[0] += wq * bflo(q[i][n].x); o[1] += wq * bfhi(q[i][n].x); o[2] += wq * bflo(q[i][n].y); o[3] += wq * bfhi(q[i][n].y); }
            v2u ov; ov.x = pk2(o[0], o[1]); ov.y = pk2(o[2], o[3]);
            *(v2u*)(mix + (size_t)(row0 + i) * 1024 + 512 + h * 64 + d4) = ov;
        }
    }
}
struct EpiY {
    bf16* Y;
    __device__ __forceinline__ void operator()(const pg8::f32x4 (&acc)[2][2][4][2], const pg8::Unit& u, int wr, int wc, int fr, int fq, const LAS unsigned*) const {
        asm volatile("" : "+v"(fr), "+v"(fq));
        const int row0 = u.pm * 256 + wr * 64 + fr, col0 = u.pn * 256 + wc * 32 + 8 * fq;
#pragma unroll
        for (int ai = 0; ai < 2; ++ai)
#pragma unroll
            for (int m = 0; m < 4; ++m) { bf16* rowp = Y + (size_t)(row0 + ai * 128 + m * 16) * D + col0;
#pragma unroll
                for (int bj = 0; bj < 2; ++bj) { const pg8::f32x4 v0 = acc[ai][bj][m][0], v1 = acc[ai][bj][m][1];
                    v4u w; w.x = pg8::cvt_pk_bf16(v0[0], v0[1]); w.y = pg8::cvt_pk_bf16(v0[2], v0[3]); w.z = pg8::cvt_pk_bf16(v1[0], v1[1]); w.w = pg8::cvt_pk_bf16(v1[2], v1[3]);
                    *(v4u*)(rowp + bj * 128) = w; } }
    }
};

__device__ __forceinline__ void route_phase(Frame& F) {
    LAS float* xch = (LAS float*)(F.lds + RING_OFF);
    LAS unsigned* lcnt = (LAS unsigned*)(F.lds + LCNT_OFF);
    LAS unsigned* stg = (LAS unsigned*)(F.lds + STG_OFF);
    if (F.tid < 64) lcnt[F.tid] = 0u;
    const int lane = F.lane, tl = lane & 31, h = lane >> 5, tg = F.wave & 3, kh = F.wave >> 2;
    { const v4u* wsrc = (const v4u*)(F.ws + WS_WRT); LAS char* wl = (LAS char*)(F.lds + RING_OFF);
      for (int i = F.tid; i < 2 * 32 * 128; i += NWAVES * 64) { const int hl = i >> 12, e = (i >> 7) & 31, c = i & 127; *(LAS v4u*)(wl + hl * 65536 + e * 2048 + ((c ^ (e & 15)) << 4)) = wsrc[i]; } }
    __syncthreads();
    const int tok = F.vcu * 128 + tg * 32 + tl;
    const float* xr = F.x + (size_t)tok * D + kh * 512 + 8 * h;
    const bf16* yr = (const bf16*)(F.ws + WS_Y) + (size_t)tok * D + kh * 512 + 8 * h;
    unsigned char* x1r = (unsigned char*)(F.ws + WS_X1B) + (size_t)tok * D + kh * 512 + 8 * h;
    bf16* x1h = (bf16*)(F.ws + WS_X1H) + (size_t)tok * D + kh * 512 + 8 * h;
    const LAS char* wrow = (const LAS char*)(F.lds + RING_OFF) + tl * 2048;
    f32x16 acc = {}; float ss = 0.f;
    f32x4 xa[2][8]; v4u ya[2][4];
#define RT_LOAD(buf, g) do { _Pragma("unroll") for (int q_ = 0; q_ < 4; ++q_) { xa[buf][2 * q_] = *(const f32x4*)(xr + 64 * (g) + 16 * q_); xa[buf][2 * q_ + 1] = *(const f32x4*)(xr + 64 * (g) + 16 * q_ + 4); \
        ya[buf][q_] = *(const v4u*)(yr + 64 * (g) + 16 * q_); } } while (0)
#define RT_COMP(buf, g) do { _Pragma("unroll") for (int q_ = 0; q_ < 4; ++q_) { const int c_ = (kh * 512 + 64 * (g) + 16 * q_) / 8 + h; \
        const v4u wh = *(const LAS v4u*)(wrow + ((c_ ^ (tl & 15)) << 4)), wl2 = *(const LAS v4u*)(wrow + 65536 + ((c_ ^ (tl & 15)) << 4)); \
        const f32x4 a0 = xa[buf][2 * q_], a1 = xa[buf][2 * q_ + 1]; const v4u yv = ya[buf][q_]; \
        const float x1[8] = {a0.x + bflo(yv.x), a0.y + bfhi(yv.x), a0.z + bflo(yv.y), a0.w + bfhi(yv.y), a1.x + bflo(yv.z), a1.y + bfhi(yv.z), a1.z + bflo(yv.w), a1.w + bfhi(yv.w)}; \
        unsigned hw[4], lw[4]; \
        _Pragma("unroll") for (int p_ = 0; p_ < 4; ++p_) { const float u_ = x1[2 * p_], r_ = x1[2 * p_ + 1]; ss += u_ * u_ + r_ * r_; const unsigned hb = pk2(u_, r_); hw[p_] = hb; lw[p_] = pk2(u_ - bflo(hb), r_ - bfhi(hb)); } \
        const v4u xh = (v4u){hw[0], hw[1], hw[2], hw[3]}, xl = (v4u){lw[0], lw[1], lw[2], lw[3]}; \
        { v2u o8_; o8_.x = fp8x4(x1[0], x1[1], x1[2], x1[3]); o8_.y = fp8x4(x1[4], x1[5], x1[6], x1[7]); *(v2u*)(x1r + 64 * (g) + 16 * q_) = o8_; *(v4u*)(x1h + 64 * (g) + 16 * q_) = xh; } \
        acc = __builtin_amdgcn_mfma_f32_32x32x16_bf16(__builtin_bit_cast(bf16x8, wh), __builtin_bit_cast(bf16x8, xh), acc, 0, 0, 0); \
        acc = __builtin_amdgcn_mfma_f32_32x32x16_bf16(__builtin_bit_cast(bf16x8, wh), __builtin_bit_cast(bf16x8, xl), acc, 0, 0, 0); \
        acc = __builtin_amdgcn_mfma_f32_32x32x16_bf16(__builtin_bit_cast(bf16x8, wl2), __builtin_bit_cast(bf16x8, xh), acc, 0, 0, 0); } } while (0)
    RT_LOAD(0, 0);
#pragma unroll
    for (int g = 0; g < 8; g += 2) {
        RT_LOAD(1, g + 1); RT_COMP(0, g);
        if (g + 2 < 8) RT_LOAD(0, g + 2);
        RT_COMP(1, g + 1);
    }
#undef RT_LOAD
#undef RT_COMP
    __syncthreads();
    if (kh == 1) { LAS float* d = xch + (tg * 64 + lane) * 17;
#pragma unroll
        for (int i = 0; i < 16; ++i) d[i] = acc[i];
        d[16] = ss; }
    __syncthreads();
    if (kh == 0) {
        const LAS float* d = xch + (tg * 64 + lane) * 17;
#pragma unroll
        for (int i = 0; i < 16; ++i) acc[i] += d[i];
        ss += d[16]; ss += __shfl_xor(ss, 32);
        const float rstd = 1.f / sqrtf(ss * (1.f / D) + EPS);
        float lg[16];
#pragma unroll
        for (int i = 0; i < 16; ++i) lg[i] = acc[i] * rstd + F.b_r[4 * h + (i & 3) + 8 * (i >> 2)];
        float cv[8]; int ce[8];
#pragma unroll
        for (int k = 0; k < 4; ++k) { float bv = -INFINITY; int bi = 0;
#pragma unroll
            for (int i = 0; i < 16; ++i) { if (lg[i] > bv) { bv = lg[i]; bi = i; } }
            cv[k] = bv; ce[k] = 4 * h + (bi & 3) + 8 * (bi >> 2);
#pragma unroll
            for (int i = 0; i < 16; ++i) if (i == bi) lg[i] = -INFINITY; }
#pragma unroll
        for (int k = 0; k < 4; ++k) { cv[4 + k] = __shfl_xor(cv[k], 32); ce[4 + k] = __shfl_xor(ce[k], 32); }
        float tv[4]; int te[4];
#pragma unroll
        for (int k = 0; k < 4; ++k) { float bv = -INFINITY; int be = 64, bi = 0;
#pragma unroll
            for (int i = 0; i < 8; ++i) { if (cv[i] > bv || (cv[i] == bv && ce[i] < be)) { bv = cv[i]; be = ce[i]; bi = i; } }
            tv[k] = bv; te[k] = be;
#pragma unroll
            for (int i = 0; i < 8; ++i) if (i == bi) cv[i] = -INFINITY; }
        float gk[4], den = 0.f;
#pragma unroll
        for (int k = 0; k < 4; ++k) { gk[k] = __expf(tv[k] - tv[0]); den += gk[k]; }
        const float inv = 1.f / den;
        if (h == 0) {
#pragma unroll
            for (int k = 0; k < 4; ++k) {
                const unsigned rank = __hip_atomic_fetch_add(lcnt + te[k], 1u, __ATOMIC_RELAXED, __HIP_MEMORY_SCOPE_WORKGROUP);
                const int slot = (tg * 32 + tl) * 4 + k;
                stg[slot * 4] = (unsigned)(tok * 4 + k); stg[slot * 4 + 1] = ((unsigned)te[k] << 16) | rank; stg[slot * 4 + 2] = __builtin_bit_cast(unsigned, gk[k] * inv); stg[slot * 4 + 3] = __builtin_bit_cast(unsigned, rstd);
            }
        }
    }
    __syncthreads();
    if (F.tid < 32) { const unsigned n = lcnt[F.tid]; lcnt[32 + F.tid] = n ? __hip_atomic_fetch_add((unsigned*)(F.ctl + CW_CNT) + F.tid, n, __ATOMIC_RELAXED, __HIP_MEMORY_SCOPE_AGENT) : 0u; }
    __syncthreads();
    { unsigned* list = (unsigned*)(F.ws + WS_LIST); unsigned* lgate = (unsigned*)(F.ws + WS_LGATE); unsigned* lrstd = (unsigned*)(F.ws + WS_LRSTD);
      const unsigned ent = stg[F.tid * 4], er = stg[F.tid * 4 + 1], gb = stg[F.tid * 4 + 2], rb = stg[F.tid * 4 + 3]; const unsigned e = er >> 16, rank = er & 0xffffu;
      const size_t at = (size_t)e * LCAP + lcnt[32 + e] + rank; list[at] = ent; lgate[at] = gb; lrstd[at] = rb; }
    __syncthreads();
}

__device__ __forceinline__ int moe_build_table(Frame& F) {
    LAS unsigned* tbl = (LAS unsigned*)(F.lds + TBL_OFF); LAS unsigned* lcnt = (LAS unsigned*)(F.lds + LCNT_OFF);
    if (F.wave == 0) {
        const int e = F.lane & 31;
        const unsigned cnt = __hip_atomic_load((unsigned*)(F.ctl + CW_CNT) + e, __ATOMIC_RELAXED, __HIP_MEMORY_SCOPE_AGENT);
        const unsigned nt = (cnt + 255u) >> 8; unsigned incl = nt;
#pragma unroll
        for (int o = 1; o < 32; o <<= 1) { const unsigned t = __shfl_up(incl, o); if ((F.lane & 31) >= o) incl += t; }
        if (F.lane < 32) { lcnt[e] = cnt; const unsigned start = incl - nt; for (unsigned j = 0; j < nt; ++j) tbl[start + j] = ((unsigned)e << 16) | j; if (F.lane == 31) F.MISC[16] = incl; }
    }
    __syncthreads();
    return (int)F.MISC[16];
}
struct MoeOrder {
    const LAS unsigned* tbl; const LAS unsigned* lcnt; const unsigned* list; int NMT, G, c, NPN, MPER, RB; size_t bexp; bool a_tiles; const unsigned* lsc; const unsigned* bias; int bexp_f;
    __device__ __forceinline__ bool next(int i, pg8::Unit& u) const {
        const int L = i * G + c, blk = L >> 5, w = L & 31, g = blk * MPER + w / NPN, pn = w % NPN;
        if (g >= NMT) return false;
        const unsigned t = tbl[g]; const int e = (int)(t >> 16), mt = (int)(t & 0xffffu); const int cnt = (int)lcnt[e];
        u.pm = g; u.pn = pn; u.e = e; u.mt = mt; u.valid = min(256, cnt - mt * 256);
        u.aoff = a_tiles ? (size_t)g * (size_t)(256 * RB) : (size_t)0; u.boff = (size_t)e * bexp + (size_t)pn * (size_t)(256 * RB);
        return true;
    }
    __device__ __forceinline__ const unsigned* id_src(const pg8::Unit& u, int row) const { return list + (size_t)u.e * LCAP + u.mt * 256 + min(row, u.valid - 1); }
    __device__ __forceinline__ const unsigned* sc_src(const pg8::Unit& u, int row) const { return lsc + (size_t)u.e * LCAP + u.mt * 256 + min(row, u.valid - 1); }
    __device__ __forceinline__ const unsigned* bias_src(const pg8::Unit& u, int col) const { return bias + (size_t)u.e * bexp_f + u.pn * 256 + col; }
};
struct EpiGU {
    unsigned char* ACT;
    __device__ __forceinline__ void operator()(const pg8::f32x4 (&acc)[2][2][4][2], const pg8::Unit& u, int wr, int wc, int fr, int fq, const LAS unsigned* ids) const {
        asm volatile("" : "+v"(fr), "+v"(fq));
        const int r0 = wr * 64 + fr, f0 = u.pn * 128 + wc * 32 + 8 * fq;
        const LAS float* scl = (const LAS float*)(ids + 256); const LAS float* bl = (const LAS float*)(ids + 512) + 2 * (wc * 32 + 8 * fq);
        float rs[2][4];
#pragma unroll
        for (int ai = 0; ai < 2; ++ai)
#pragma unroll
            for (int m = 0; m < 4; ++m) rs[ai][m] = scl[r0 + ai * 128 + m * 16] * (1.f / WSCALE);
        const pg8::f32x4 b0 = *(const LAS pg8::f32x4*)bl, b1 = *(const LAS pg8::f32x4*)(bl + 4), b2 = *(const LAS pg8::f32x4*)(bl + 8), b3 = *(const LAS pg8::f32x4*)(bl + 12);
        const float gb[8] = {b0[0], b0[2], b1[0], b1[2], b2[0], b2[2], b3[0], b3[2]}, ub[8] = {b0[1], b0[3], b1[1], b1[3], b2[1], b2[3], b3[1], b3[3]};
#pragma unroll
        for (int ai = 0; ai < 2; ++ai)
#pragma unroll
            for (int m = 0; m < 4; ++m) { const int r = r0 + ai * 128 + m * 16; const float s = rs[ai][m]; float a[8];
#pragma unroll
                for (int n = 0; n < 2; ++n)
#pragma unroll
                    for (int j = 0; j < 4; ++j) { float gate = acc[ai][0][m][n][j] * s + gb[4 * n + j], up = acc[ai][1][m][n][j] * s + ub[4 * n + j];
                        gate = fminf(gate, 7.f); up = fminf(fmaxf(up, -7.f), 7.f);
                        a[4 * n + j] = ASCALE * (up + 1.f) * gate * __builtin_amdgcn_rcpf(1.f + __builtin_amdgcn_exp2f(-1.702f * LOG2E * gate)); }
                v2u w; w.x = fp8x4(a[0], a[1], a[2], a[3]); w.y = fp8x4(a[4], a[5], a[6], a[7]);
                *(v2u*)(ACT + (size_t)(u.pm * 256 + r) * DFF + f0) = w; }
    }
};
struct EpiDown {
    unsigned char* YB;
    __device__ __forceinline__ void operator()(const pg8::f32x4 (&acc)[2][2][4][2], const pg8::Unit& u, int wr, int wc, int fr, int fq, const LAS unsigned* ids) const {
        asm volatile("" : "+v"(fr), "+v"(fq));
        const int r0 = wr * 64 + fr, cl = wc * 32 + 8 * fq, col0 = u.pn * 256 + cl;
        const LAS float* scl = (const LAS float*)(ids + 256); const LAS float* bl = (const LAS float*)(ids + 512) + cl;
        pg8::f32x4 bv[2][2];
#pragma unroll
        for (int bj = 0; bj < 2; ++bj)
#pragma unroll
            for (int n = 0; n < 2; ++n) bv[bj][n] = *(const LAS pg8::f32x4*)(bl + bj * 128 + 4 * n);
#pragma unroll
        for (int ai = 0; ai < 2; ++ai)
#pragma unroll
            for (int m = 0; m < 4; ++m) { const int r = r0 + ai * 128 + m * 16; if (r < u.valid) { const float g = scl[r] * YSCALE; unsigned char* yp = YB + (size_t)ids[r] * D + col0;
#pragma unroll
                for (int bj = 0; bj < 2; ++bj) { const pg8::f32x4 v0 = (acc[ai][bj][m][0] * (1.f / (WSCALE * ASCALE)) + bv[bj][0]) * g, v1 = (acc[ai][bj][m][1] * (1.f / (WSCALE * ASCALE)) + bv[bj][1]) * g;
                    v2u w; w.x = fp8x4(v0[0], v0[1], v0[2], v0[3]); w.y = fp8x4(v1[0], v1[1], v1[2], v1[3]);
                    *(v2u*)(yp + bj * 128) = w; } } }
    }
};
__device__ __forceinline__ void final_phase(Frame& F) {
    const int gw = F.vcu * NWAVES + F.wave, NGW = F.G * NWAVES;
    const unsigned char* YB = (const unsigned char*)(F.ws + WS_YB); const bf16* X1 = (const bf16*)(F.ws + WS_X1H);
    const int c = 16 * F.lane;
    f32x4 gf[4];
#pragma unroll
    for (int q = 0; q < 4; ++q) gf[q] = *(const f32x4*)(F.g_fin + c + 4 * q);
    for (int t = gw; t < T; t += NGW) {
        const v4u xa = *(const v4u*)(X1 + (size_t)t * D + c), xb = *(const v4u*)(X1 + (size_t)t * D + c + 8);
        v4u y[4];
#pragma unroll
        for (int k = 0; k < 4; ++k) y[k] = *(const v4u*)(YB + ((size_t)t * 4 + k) * D + c);
        float v[16];
        { const unsigned xw[8] = {xa.x, xa.y, xa.z, xa.w, xb.x, xb.y, xb.z, xb.w};
#pragma unroll
          for (int q = 0; q < 8; ++q) { v[2 * q] = bflo(xw[q]); v[2 * q + 1] = bfhi(xw[q]); } }
#pragma unroll
        for (int k = 0; k < 4; ++k) { const unsigned yw[4] = {y[k].x, y[k].y, y[k].z, y[k].w};
#pragma unroll
            for (int q = 0; q < 4; ++q) { const auto lo = __builtin_amdgcn_cvt_pk_f32_fp8((int)yw[q], false), hi = __builtin_amdgcn_cvt_pk_f32_fp8((int)yw[q], true);
                v[4 * q] += lo[0] * (1.f / YSCALE); v[4 * q + 1] += lo[1] * (1.f / YSCALE); v[4 * q + 2] += hi[0] * (1.f / YSCALE); v[4 * q + 3] += hi[1] * (1.f / YSCALE); } }
        float ss = 0.f;
#pragma unroll
        for (int i = 0; i < 16; ++i) ss += v[i] * v[i];
        const float rstd = 1.f / sqrtf(wave_sum(ss) * (1.f / D) + EPS);
#pragma unroll
        for (int q = 0; q < 4; ++q) { f32x4 o; o.x = v[4 * q] * rstd * gf[q].x; o.y = v[4 * q + 1] * rstd * gf[q].y; o.z = v[4 * q + 2] * rstd * gf[q].z; o.w = v[4 * q + 3] * rstd * gf[q].w;
            *(f32x4*)(F.out + (size_t)t * D + c + 4 * q) = o; }
    }
}
struct Args { const float* in[17]; float* out; unsigned char* ws; int ph_lo, ph_hi, use_bar, pad; };
__global__ void __launch_bounds__(NWAVES * 64, 2) mk_fwd(Args args) {
    extern __shared__ __attribute__((aligned(16))) unsigned char lds[];
    Frame F;
    F.lds = (LAS unsigned char*)lds;
    F.MISC = (volatile LAS unsigned*)(F.lds + MISC_OFF);
    F.tid = threadIdx.x; F.lane = F.tid & 63; F.wave = __builtin_amdgcn_readfirstlane(F.tid >> 6);
    F.G = gridDim.x; { const int bx = blockIdx.x; F.vcu = (F.G % 8 == 0) ? (bx % 8) * (F.G / 8) + bx / 8 : bx; }
    F.ws = args.ws; F.out = args.out; F.ctl = (gu32*)(args.ws + WS_CTL);
    F.x = args.in[0]; F.mem = args.in[1]; F.g_attn = args.in[2]; F.g_mem = args.in[3]; F.w_in = args.in[4]; F.lamqk = args.in[5]; F.subg = args.in[6]; F.w_mkv = args.in[7];
    F.w_out = args.in[8]; F.g_ffn = args.in[9]; F.w_r = args.in[10]; F.b_r = args.in[11]; F.w_gu = args.in[12]; F.b_gu = args.in[13]; F.w_dn = args.in[14]; F.b_dn = args.in[15]; F.g_fin = args.in[16];
    for (int u = F.tid; u < (LDS_BYTES - LDSCTL_OFF) / 4; u += NWAVES * 64) ((LAS unsigned*)(F.lds + LDSCTL_OFF))[u] = 0u;
    __syncthreads();
    XcdBarrier bar; bar.bar = (unsigned*)(F.ctl + CW_BAR); bar.x = 0; bar.st = nullptr;
    if (args.use_bar) bar = xcd_barrier_post((unsigned*)(F.ctl + CW_BAR), F.MISC + 8);
    const int lo = args.ph_lo, hi = args.ph_hi;
#define IN(k) (lo <= (k) && (k) < hi)
#define SEAM(k) do { if (IN(k) && IN((k) + 1)) xcd_barrier(bar); } while (0)
    if (IN(0)) { p0_prologue(F); } SEAM(0);
    if (IN(1)) {
        pg8::Gemm g{(const void*)(F.ws + WS_XB), (const void*)(F.ws + WS_WIN), 2 * D}; pg8::StaticOrder S; S.init(T, DIN, 2 * D, F.G, (int)blockIdx.x, (const unsigned*)(F.ws + WS_RSTD1));
        EpiInProj E{(bf16*)(F.ws + WS_P), (const float*)(F.ws + WS_RSTD1), (unsigned*)(F.ctl + CW_NRM)};
        pg8::gemm_phase<EpiInProj, pg8::StaticOrder, true, false, true>(F.lds + RING_OFF, (LAS unsigned*)(F.lds + IDB_OFF), g, S, E);
    } SEAM(1);
    if (IN(2)) { attn_phase(F, (char*)lds + RING_OFF); } SEAM(2);
    if (IN(3)) { dil_combine_phase(F); } SEAM(3);
    if (IN(4)) {
        pg8::Gemm g{(const void*)(F.ws + WS_MIX), (const void*)(F.ws + WS_WOUT), 2 * D}; pg8::StaticOrder S; S.init(T, D, 2 * D, F.G, (int)blockIdx.x);
        EpiY E{(bf16*)(F.ws + WS_Y)};
        pg8::gemm_phase<EpiY, pg8::StaticOrder, true, false, false>(F.lds + RING_OFF, (LAS unsigned*)(F.lds + IDB_OFF), g, S, E);
    } SEAM(4);
    if (IN(5)) { route_phase(F); } SEAM(5);
    if (IN(6)) {
        const int nmt = moe_build_table(F);
        pg8::Gemm g{(const void*)(F.ws + WS_X1B), (const void*)(F.ws + WS_WGU), D};
        MoeOrder S{(const LAS unsigned*)(F.lds + TBL_OFF), (const LAS unsigned*)(F.lds + LCNT_OFF), (const unsigned*)(F.ws + WS_LIST), nmt, F.G, F.vcu, 8, 4, D, (size_t)2 * DFF * D, false, (const unsigned*)(F.ws + WS_LRSTD), (const unsigned*)F.b_gu, 2 * DFF};
        EpiGU E{(unsigned char*)(F.ws + WS_ACT)};
        pg8::gemm_phase<EpiGU, MoeOrder, true, true, true, true>(F.lds + RING_OFF, (LAS unsigned*)(F.lds + IDB_OFF), g, S, E);
    } SEAM(6);
    if (IN(7)) {
        const int nmt = moe_build_table(F);
        pg8::Gemm g{(const void*)(F.ws + WS_ACT), (const void*)(F.ws + WS_WDN), DFF};
        MoeOrder S{(const LAS unsigned*)(F.lds + TBL_OFF), (const LAS unsigned*)(F.lds + LCNT_OFF), (const unsigned*)(F.ws + WS_LIST), nmt, F.G, F.vcu, 4, 8, DFF, (size_t)D * DFF, true, (const unsigned*)(F.ws + WS_LGATE), (const unsigned*)F.b_dn, D};
        EpiDown E{(unsigned char*)(F.ws + WS_YB)};
        pg8::gemm_phase<EpiDown, MoeOrder, true, true, true, true, true>(F.lds + RING_OFF, (LAS unsigned*)(F.lds + IDB_OFF), g, S, E);
    } SEAM(7);
    if (IN(8)) { final_phase(F); }
#undef IN
#undef SEAM
}

static void launch_phases(const Args& base, int lo, int hi, int use_bar, int grid, hipStream_t stream) {
    Args a = base; a.ph_lo = lo; a.ph_hi = hi; a.use_bar = use_bar;
    hipLaunchKernelGGL(mk_fwd, dim3(grid), dim3(NWAVES * 64), LDS_BYTES, stream, a);
}
extern "C" void kernel_launch(void* const* d_in, const int* in_sizes, int n_in, void* d_out, int out_size, void* d_ws, size_t ws_size, hipStream_t stream) {
    static int grid = 0;
    if (grid == 0) {
        if (n_in != 17 || in_sizes[0] != T * D || out_size != T * D || ws_size < (size_t)1000 * MiB) { fprintf(stderr, "kernel_launch: unexpected shapes / workspace (%d inputs, ws %zu)\n", n_in, ws_size); grid = -1; return; }
        int dev = 0, cus = 0, per_cu = 0;
        if (hipGetDevice(&dev) != hipSuccess || hipDeviceGetAttribute(&cus, hipDeviceAttributeMultiprocessorCount, dev) != hipSuccess) { grid = -1; return; }
        if (hipFuncSetAttribute((const void*)mk_fwd, hipFuncAttributeMaxDynamicSharedMemorySize, LDS_BYTES) != hipSuccess) { fprintf(stderr, "kernel_launch: hipFuncSetAttribute failed\n"); grid = -1; return; }
        if (hipOccupancyMaxActiveBlocksPerMultiprocessor(&per_cu, (const void*)mk_fwd, NWAVES * 64, LDS_BYTES) != hipSuccess || per_cu < 1) { fprintf(stderr, "kernel_launch: occupancy query says %d blocks per CU\n", per_cu); per_cu = 1; }
        (void)hipGetLastError();
        grid = cus;
        if (grid != 256) { fprintf(stderr, "kernel_launch: built for a 256-CU device (got %d)\n", cus); grid = -1; return; }
    }
    if (grid < 0) return;
    (void)hipMemsetAsync((char*)d_ws + WS_CTL, 0, CTL_ZERO_BYTES, stream);
    Args a{};
    for (int i = 0; i < 17; ++i) a.in[i] = (const float*)d_in[i];
    a.out = (float*)d_out; a.ws = (unsigned char*)d_ws;
    launch_phases(a, 0, 9, 1, grid, stream);
}
```

```cpp
#include <hip/hip_runtime.h>
#include <hip/hip_bf16.h>
#include <cstdint>
#include <cstdio>
#include <cmath>

constexpr int D = 1024, BATCH = 8, SEQ = 4096, T = BATCH * SEQ, DIN = 2560, NMEM = 256, NE = 32, DFF = 1024;
constexpr int C_DQ = 0, C_DK = 512, C_DV = 1024, C_LQ = 1536, C_LK = 1792, C_LV = 2048, C_MQ = 2304;
constexpr float EPS = 1e-5f;
constexpr int LCAP = T;
constexpr float QSCALE = 0.125f * 1.4426950408889634f;
constexpr float LOG2E = 1.4426950408889634f;
namespace pg8 {
#define PG8_LAS __attribute__((address_space(3)))
typedef unsigned short bf16_t;
typedef short bf16x8 __attribute__((ext_vector_type(8)));
typedef float f32x4 __attribute__((ext_vector_type(4)));
typedef unsigned u32x4 __attribute__((ext_vector_type(4)));
typedef unsigned u32x2 __attribute__((ext_vector_type(2)));
constexpr int BM = 256, BK = 64, HALF = 128, HTB = HALF * BK * 2  , STAGE_BYTES = 8 * HTB, NXCD = 8, WGM = 8;

__host__ __device__ __forceinline__ int lds_byte(int r, int c) { const int st = (r >> 4) * 2 + (c >> 5), rr = r & 15, cc = c & 31, ob = rr * 64 + cc * 2; return st * 1024 + (ob ^ (((ob >> 9) & 1) << 5)); }
__host__ __device__ __forceinline__ void stage_rc(int b, int& R, int& C) { const int st = b / 1024, sb = b % 1024, swz = sb ^ (((sb >> 9) & 1) << 5); R = (st >> 1) * 16 + swz / 64; C = (st & 1) * 32 + (swz % 64) / 2; }
__host__ __device__ __forceinline__ int perm32(int rho) { const int n = rho >> 4, i = rho & 15; return 8 * (i >> 2) + 4 * n + (i & 3); }

struct Unit { size_t aoff, boff; int pm, pn, e, valid, mt; };
struct Gemm { const void* A; const void* Bt; int RB; };
typedef int v8i __attribute__((ext_vector_type(8)));

struct StaticOrder {
    int nM, nN, nwg, G, c, RB; const unsigned* sc;
    __device__ void init(int M, int N, int RB_, int G_, int c_, const unsigned* sc_ = nullptr) { nM = M / BM; nN = N / BM; nwg = nM * nN; G = G_; c = c_; RB = RB_; sc = sc_; }
    __device__ bool next(int i, Unit& u) const {
        const long L = (long)i * G + c; if (L >= nwg) return false;
        int wgid = (int)L; { const int q = nwg / NXCD, r = nwg % NXCD, xcd = wgid % NXCD, off = wgid / NXCD; wgid = (xcd < r ? xcd * (q + 1) : r * (q + 1) + (xcd - r) * q) + off; }
        const int nig = WGM * nN, gid = wgid / nig, fm = gid * WGM, gsz = (nM - fm) < WGM ? (nM - fm) : WGM;
        u.pm = fm + ((wgid % nig) % gsz); u.pn = (wgid % nig) / gsz; u.e = 0; u.valid = 256; u.mt = 0;
        u.aoff = (size_t)u.pm * (size_t)(BM * RB); u.boff = (size_t)u.pn * (size_t)(BM * RB); return true;
    }
    __device__ __forceinline__ const unsigned* id_src(const Unit& u, int row) const { return sc + u.pm * 256 + row; }
    __device__ __forceinline__ const unsigned* sc_src(const Unit& u, int row) const { return sc + u.pm * 256 + row; }
    __device__ __forceinline__ const unsigned* bias_src(const Unit& u, int row) const { return sc + u.pm * 256 + row; }
};

__device__ __forceinline__ unsigned cvt_pk_bf16(float lo, float hi) { unsigned r; asm volatile("v_cvt_pk_bf16_f32 %0, %1, %2" : "=v"(r) : "v"(lo), "v"(hi)); return r; }

template <class Epi, class Sched, bool ALIGN_EPI, bool GATHER, bool IDS, bool FP8 = false, bool LINEAR = false>
__device__ __forceinline__ void gemm_phase(PG8_LAS unsigned char* lds, PG8_LAS unsigned* idb, const Gemm g, const Sched& S, const Epi& E) {
    const int tid = threadIdx.x, wid = __builtin_amdgcn_readfirstlane(tid >> 6), lane = tid & 63, wr = wid >> 2, wc = wid & 3, fr = lane & 15, fq = lane >> 4;
    const int RB = g.RB; int nt = RB / (BK * 2); asm volatile("" : "+s"(nt));
    unsigned voffA[2], voffB[2]; int RA[2], CA[2];
#pragma unroll
    for (int i = 0; i < 2; ++i) { int R, C; stage_rc(tid * 16 + i * 8192, R, C); const int Rb = (R & ~31) + perm32(R & 31); RA[i] = R; CA[i] = C;
        voffA[i] = (unsigned)(R * RB + C * 2); voffB[i] = (unsigned)(Rb * RB + C * 2); }
    const size_t kstep = (size_t)(BK * 2);
    const size_t hstep = (size_t)HALF * RB;
    const unsigned ldsw = (unsigned)wid * 1024u;
    const int aoff = lds_byte(wr * 64 + fr, fq * 8), boff = lds_byte(wc * 32 + fr, fq * 8);
#define PG8_SA(b, h) (((b) * 2 + (h)) * HTB)
#define PG8_SB(b, h) ((4 + (b) * 2 + (h)) * HTB)
#define PG8_STAGE(bufoff, gbase, voff) do { _Pragma("unroll") for (int _i = 0; _i < 2; ++_i) \
        __builtin_amdgcn_global_load_lds((const unsigned*)((const char*)(gbase) + (voff)[_i]), (PG8_LAS unsigned*)(lds + (bufoff) + ldsw + _i * 8192), 16, 0, 0); } while (0)
#define PG8_STAGE_A(bufoff, pbase, gbase, h, gv) do { if constexpr (GATHER) { PG8_STAGE(bufoff, gbase, gv[h]); } else { PG8_STAGE(bufoff, (pbase) + (h) * hstep, voffA); } } while (0)
#define PG8_LD32(p0_, p1_) __builtin_bit_cast(v8i, __builtin_shufflevector(*(const PG8_LAS u32x4*)(p0_), *(const PG8_LAS u32x4*)(p1_), 0, 1, 2, 3, 4, 5, 6, 7))
#define PG8_LDA(dst, b, h) do { if constexpr (FP8) { _Pragma("unroll") for (int m = 0; m < 4; ++m) dst##8[m] = PG8_LD32(lds + PG8_SA(b, h) + aoff + m * 2048, lds + PG8_SA(b, h) + aoff + m * 2048 + 1024); } \
        else { _Pragma("unroll") for (int m = 0; m < 4; ++m) _Pragma("unroll") for (int k = 0; k < 2; ++k) dst[m][k] = *(const PG8_LAS bf16x8*)(lds + PG8_SA(b, h) + aoff + m * 2048 + k * 1024); } } while (0)
#define PG8_LDB(dst, b, h) do { if constexpr (FP8) { _Pragma("unroll") for (int n = 0; n < 2; ++n) dst##8[n] = PG8_LD32(lds + PG8_SB(b, h) + boff + n * 2048, lds + PG8_SB(b, h) + boff + n * 2048 + 1024); } \
        else { _Pragma("unroll") for (int n = 0; n < 2; ++n) _Pragma("unroll") for (int k = 0; k < 2; ++k) dst[n][k] = *(const PG8_LAS bf16x8*)(lds + PG8_SB(b, h) + boff + n * 2048 + k * 1024); } } while (0)
#define PG8_MMA(ai, bj, At, Bt) do { __builtin_amdgcn_s_setprio(1); if constexpr (FP8) { _Pragma("unroll") for (int m = 0; m < 4; ++m) _Pragma("unroll") for (int n = 0; n < 2; ++n) \
        acc[ai][bj][m][n] = __builtin_amdgcn_mfma_scale_f32_16x16x128_f8f6f4(Bt##8[n], At##8[m], acc[ai][bj][m][n], 0, 0, 0, 0x7f7f7f7f, 0, 0x7f7f7f7f); } \
        else { _Pragma("unroll") for (int m = 0; m < 4; ++m) _Pragma("unroll") for (int n = 0; n < 2; ++n) _Pragma("unroll") for (int k = 0; k < 2; ++k) \
        acc[ai][bj][m][n] = __builtin_amdgcn_mfma_f32_16x16x32_bf16(Bt[n][k], At[m][k], acc[ai][bj][m][n], 0, 0, 0); } __builtin_amdgcn_s_setprio(0); } while (0)
#define PG8_WAIT_V(n) asm volatile("s_waitcnt vmcnt(" #n ")" ::: "memory")
#define PG8_WAIT_L(n) asm volatile("s_waitcnt lgkmcnt(" #n ")" ::: "memory")
#define PG8_BAR __builtin_amdgcn_s_barrier()
#define PG8_SCHED __builtin_amdgcn_sched_barrier(0)
#define PG8_IDS_DMA(u, s) do { if (wid < 4) { __builtin_amdgcn_global_load_lds(S.id_src(u, tid), (PG8_LAS unsigned*)(idb + (s) * 768 + wid * 64), 4, 0, 0); \
        __builtin_amdgcn_global_load_lds(S.sc_src(u, tid), (PG8_LAS unsigned*)(idb + (s) * 768 + 256 + wid * 64), 4, 0, 0); \
        __builtin_amdgcn_global_load_lds(S.bias_src(u, tid), (PG8_LAS unsigned*)(idb + (s) * 768 + 512 + wid * 64), 4, 0, 0); } } while (0)
#define PG8_GV(dst, s, un) do { _Pragma("unroll") for (int _h = 0; _h < 2; ++_h) _Pragma("unroll") for (int _i = 0; _i < 2; ++_i) \
        dst[_h][_i] = (LINEAR ? (unsigned)((un).pm * 256 + _h * 128 + RA[_i]) : (idb[(s) * 768 + _h * 128 + RA[_i]] >> 2)) * (unsigned)RB + (unsigned)(CA[_i] * 2); } while (0)
    Unit cur, nxt; int ui = 0, us = 0;
    if (!S.next(0, cur)) return;
    f32x4 acc[2][2][4][2];
#pragma unroll
    for (int a = 0; a < 2; ++a)
#pragma unroll
        for (int b = 0; b < 2; ++b)
#pragma unroll
            for (int m = 0; m < 4; ++m)
#pragma unroll
                for (int n = 0; n < 2; ++n) acc[a][b][m][n] = (f32x4){0.f, 0.f, 0.f, 0.f};
    bf16x8 At[4][2], B0[2][2], B1[2][2]; v8i At8[4], B08[2], B18[2];
    unsigned cv[2][2] = {{0u, 0u}, {0u, 0u}};
    const char* A0 = (const char*)g.A;
    const char* cA = A0 + (GATHER ? (size_t)0 : cur.aoff); const char* cB = (const char*)g.Bt + cur.boff;
    if constexpr (IDS) {
        PG8_IDS_DMA(cur, 0); PG8_WAIT_V(0); PG8_BAR;
    }
    if constexpr (GATHER) { PG8_GV(cv, 0, cur); }
    PG8_STAGE(PG8_SB(0, 0), cB, voffB); PG8_STAGE(PG8_SB(0, 1), cB + hstep, voffB); PG8_STAGE_A(PG8_SA(0, 0), cA, A0, 0, cv); PG8_STAGE_A(PG8_SA(0, 1), cA, A0, 1, cv);
    if (wr == 1) PG8_BAR;
    PG8_WAIT_V(2); PG8_BAR;
    PG8_STAGE(PG8_SB(1, 0), cB + kstep, voffB); PG8_STAGE_A(PG8_SA(1, 0), cA + kstep, A0 + kstep, 0, cv); PG8_STAGE(PG8_SB(1, 1), cB + hstep + kstep, voffB);
    PG8_WAIT_V(6); PG8_BAR;
    for (;;) {
        const bool has_next = S.next(ui + 1, nxt);
        const int ns = (us == 2) ? 0 : us + 1;
        if constexpr (IDS) { if (has_next) PG8_IDS_DMA(nxt, ns); }
        const char* nA = has_next ? A0 + (GATHER ? (size_t)0 : nxt.aoff) : cA; const char* nB = has_next ? (const char*)g.Bt + nxt.boff : cB;
#pragma nounroll
        for (int t = 0; t < nt; t += 2) {
            int lastv = (t == nt - 2) ? 1 : 0; asm volatile("" : "+v"(lastv)); const bool last = __builtin_amdgcn_readfirstlane(lastv) != 0;
            const char* a1 = cA + (size_t)(t + 1) * kstep;
            const char* a2 = last ? nA : cA + (size_t)(t + 2) * kstep; const char* b2 = last ? nB : cB + (size_t)(t + 2) * kstep;
            const char* a3 = a2 + kstep; const char* b3 = b2 + kstep;
            PG8_LDB(B0, 0, 0); PG8_LDB(B1, 0, 1); PG8_SCHED; PG8_LDA(At, 0, 0); PG8_STAGE_A(PG8_SA(1, 1), a1, a1, 1, cv);
            if constexpr (GATHER) { if (last && has_next) { PG8_GV(cv, ns, nxt); } }
            PG8_WAIT_V(8); PG8_WAIT_L(0); PG8_BAR; PG8_MMA(0, 0, At, B0); PG8_MMA(0, 1, At, B1); PG8_BAR; PG8_SCHED;
            PG8_LDA(At, 0, 1); PG8_STAGE(PG8_SB(0, 0), b2, voffB); PG8_STAGE(PG8_SB(0, 1), b2 + hstep, voffB); PG8_STAGE_A(PG8_SA(0, 0), a2, a2, 0, cv);
            PG8_WAIT_V(8); PG8_WAIT_L(0); PG8_BAR; PG8_MMA(1, 0, At, B0); PG8_MMA(1, 1, At, B1); PG8_BAR; PG8_SCHED;
            PG8_LDB(B0, 1, 0); PG8_LDB(B1, 1, 1); PG8_SCHED; PG8_LDA(At, 1, 0); PG8_STAGE_A(PG8_SA(0, 1), a2, a2, 1, cv);
            PG8_WAIT_V(8); PG8_WAIT_L(0); PG8_BAR; PG8_MMA(0, 0, At, B0); PG8_MMA(0, 1, At, B1); PG8_BAR; PG8_SCHED;
            PG8_LDA(At, 1, 1); PG8_STAGE(PG8_SB(1, 0), b3, voffB); PG8_STAGE(PG8_SB(1, 1), b3 + hstep, voffB); PG8_STAGE_A(PG8_SA(1, 0), a3, a3, 0, cv);
            PG8_WAIT_V(8); PG8_WAIT_L(0); PG8_BAR; PG8_MMA(1, 0, At, B0); PG8_MMA(1, 1, At, B1); PG8_BAR; PG8_SCHED;
        }
        if constexpr (ALIGN_EPI) { if (wr == 0) PG8_BAR; }
        PG8_SCHED;
        E(acc, cur, wr, wc, fr, fq, (const PG8_LAS unsigned*)(idb + us * 768));
        PG8_SCHED;
        if (!has_next) break;
#pragma unroll
        for (int a = 0; a < 2; ++a)
#pragma unroll
            for (int b = 0; b < 2; ++b)
#pragma unroll
                for (int m = 0; m < 4; ++m)
#pragma unroll
                    for (int n = 0; n < 2; ++n) acc[a][b][m][n] = (f32x4){0.f, 0.f, 0.f, 0.f};
        cur = nxt; cA = nA; cB = nB; ++ui; us = ns;
        if constexpr (ALIGN_EPI) { if (wr == 1) PG8_BAR; }
    }
    PG8_WAIT_V(0);
    if constexpr (!ALIGN_EPI) { if (wr == 0) PG8_BAR; }
    PG8_BAR;
#undef PG8_SA
#undef PG8_SB
#undef PG8_STAGE
#undef PG8_STAGE_A
#undef PG8_LDA
#undef PG8_LDB
#undef PG8_MMA
#undef PG8_LD32
#undef PG8_WAIT_V
#undef PG8_WAIT_L
#undef PG8_BAR
#undef PG8_SCHED
#undef PG8_IDS_DMA
#undef PG8_GV
}
}
namespace attn_body {
using bf16=__hip_bfloat16;
using bf16x8=__attribute__((ext_vector_type(8)))short;
using s16x4=__attribute__((ext_vector_type(4)))short;
using f32x16=__attribute__((ext_vector_type(16)))float;
using u32x4=__attribute__((ext_vector_type(4)))unsigned;
constexpr int D=64;
constexpr int NW=8,QBLK=32,QB=QBLK*NW,KVBLK=64;
struct UnitP { const bf16* Q; const bf16* K; const bf16* V; bf16* O; long qp, kp, op; int q0, t0, NT; float slope2; float* lse; int lse_stride; };
__device__ __forceinline__ int crow(int r,int hi){return (r&3)+8*(r>>2)+4*hi;}
#define SBAR() __builtin_amdgcn_sched_barrier(0)
template<bool CAUSAL,bool WINDOW> __device__ __forceinline__ void cmask(f32x16&p0,f32x16&p1,int jb,int qrel,int hi){
  const float NEG=-INFINITY; int kb=64*jb+4*hi;
  #pragma unroll
  for(int r=0;r<16;++r){int kv=kb+(r&3)+8*(r>>2);
    if(CAUSAL){ if(kv>qrel)p0[r]=NEG; if(kv+32>qrel)p1[r]=NEG; }
    if(WINDOW){ if(kv<qrel-128)p0[r]=NEG; if(kv+32<qrel-128)p1[r]=NEG; } }
}
__device__ __forceinline__ unsigned bfr(float x){ typedef float f2_ __attribute__((ext_vector_type(2))); typedef __bf16 b2_ __attribute__((ext_vector_type(2))); f2_ v={x,0.f}; b2_ b=__builtin_convertvector(v,b2_); return __builtin_bit_cast(unsigned,b)&0xffffu; }
__device__ __forceinline__ float bfv(unsigned b){ return __builtin_bit_cast(float,b<<16); }

constexpr int NSLOT=3, SLOTB=8192;
constexpr int LDS_K=0, LDS_V=NSLOT*SLOTB;
template<int DV> struct Lds { static constexpr int SLOTV=SLOTB*(DV/64), WS=LDS_V+NSLOT*SLOTV, OST=WS+NW*64*4, OSTW=4096*(DV/64), BYTES=OST+NW*OSTW; };
__device__ __forceinline__ void glds16(const void*gsrc,unsigned lds_dst){unsigned keep;
  asm volatile("s_mov_b32 %0, m0\n\ts_mov_b32 m0, %2\n\ts_nop 0\n\tglobal_load_lds_dwordx4 %1, off\n\ts_mov_b32 m0, %0":"=&s"(keep):"v"(gsrc),"s"(lds_dst):"memory");}
__device__ __forceinline__ float max3f(float a,float b,float c){float r;asm("v_max3_f32 %0, %1, %2, %3":"=v"(r):"v"(a),"v"(b),"v"(c));return r;}
__device__ __forceinline__ float max2f(float a,float b){float r;asm("v_max_f32_e32 %0, %1, %2":"=v"(r):"v"(a),"v"(b));return r;}
__device__ __forceinline__ float fadd_s(float a,float b){float r;asm("v_add_f32_e32 %0, %1, %2":"=v"(r):"v"(a),"v"(b));return r;}
__device__ __forceinline__ float fsub_s(float a,float b){float r;asm("v_sub_f32_e32 %0, %1, %2":"=v"(r):"v"(a),"v"(b));return r;}
typedef float f32x2_t __attribute__((ext_vector_type(2))); typedef __bf16 bf16x2_t __attribute__((ext_vector_type(2)));
__device__ __forceinline__ unsigned cvtpk_s(float lo,float hi){f32x2_t v={lo,hi};bf16x2_t b=__builtin_convertvector(v,bf16x2_t);return __builtin_bit_cast(unsigned,b);}
#define WAIT_BAR(N) asm volatile("s_waitcnt vmcnt(" #N ") lgkmcnt(0)\n\ts_barrier":::"memory")

__device__ __forceinline__ void qkt(f32x16&p0,f32x16&p1,const char*Kslot,const bf16x8*qr,bf16x8 kx0,bf16x8 kx1,bf16x8 qx,int r32,int hi){
  const char*kb=Kslot+hi*1024+r32*16;
  #pragma unroll
  for(int d0=0;d0<4;++d0){
    const bf16x8 b0=*reinterpret_cast<const bf16x8*>(kb+d0*2048);
    const bf16x8 b1=*reinterpret_cast<const bf16x8*>(kb+d0*2048+512);
    if(d0==0){p0=__builtin_amdgcn_mfma_f32_32x32x16_bf16(b0,qr[0],f32x16{},0,0,0);p1=__builtin_amdgcn_mfma_f32_32x32x16_bf16(b1,qr[0],f32x16{},0,0,0);}
    else{p0=__builtin_amdgcn_mfma_f32_32x32x16_bf16(b0,qr[d0],p0,0,0,0);p1=__builtin_amdgcn_mfma_f32_32x32x16_bf16(b1,qr[d0],p1,0,0,0);}}
  p0=__builtin_amdgcn_mfma_f32_32x32x16_bf16(kx0,qx,p0,0,0,0);p1=__builtin_amdgcn_mfma_f32_32x32x16_bf16(kx1,qx,p1,0,0,0);
}
typedef __attribute__((address_space(3))) const char* lds_cptr;
typedef short v4i16_t __attribute__((ext_vector_type(4)));
__device__ __forceinline__ void kload8(bf16x8*kf,lds_cptr kp){
  kf[0]=*(const __attribute__((address_space(3))) bf16x8*)(kp);      kf[1]=*(const __attribute__((address_space(3))) bf16x8*)(kp+512);
  kf[2]=*(const __attribute__((address_space(3))) bf16x8*)(kp+2048); kf[3]=*(const __attribute__((address_space(3))) bf16x8*)(kp+2560);
  kf[4]=*(const __attribute__((address_space(3))) bf16x8*)(kp+4096); kf[5]=*(const __attribute__((address_space(3))) bf16x8*)(kp+4608);
  kf[6]=*(const __attribute__((address_space(3))) bf16x8*)(kp+6144); kf[7]=*(const __attribute__((address_space(3))) bf16x8*)(kp+6656);
}
__device__ __forceinline__ void kload2(bf16x8*kf,lds_cptr kp,int j){ kf[2*j]=*(const __attribute__((address_space(3))) bf16x8*)(kp+j*2048); kf[2*j+1]=*(const __attribute__((address_space(3))) bf16x8*)(kp+j*2048+512); }
__device__ __forceinline__ s16x4 vtr(lds_cptr p){ return __builtin_bit_cast(s16x4,__builtin_amdgcn_ds_read_tr16_b64_v4i16((__attribute__((address_space(3))) v4i16_t*)p)); }
__device__ __forceinline__ float rowmax(const f32x16&p0,const f32x16&p1){
  float a=max3f(p0[0],p0[1],p1[0]),b=max3f(p0[2],p0[3],p1[1]);a=max3f(a,p1[2],p1[3]);
  #pragma unroll
  for(int r=4;r<16;r+=4){a=max3f(a,p0[r],p0[r+1]);b=max3f(b,p0[r+2],p0[r+3]);a=max3f(a,p1[r],p1[r+1]);b=max3f(b,p1[r+2],p1[r+3]);}
  const float m=max2f(a,b);
  auto rr=__builtin_amdgcn_permlane32_swap(__float_as_uint(m),__float_as_uint(m),false,false);
  return max2f(__uint_as_float(rr[0]),__uint_as_float(rr[1]));
}
__device__ __forceinline__ void pv(f32x16*o,int vb,bf16x8 pa0,bf16x8 pa1,bf16x8 pa2,bf16x8 pa3){
  #pragma unroll
  for(int d0=0;d0<2;++d0){s16x4 lo[4],hi[4];
    #pragma unroll
    for(int ks=0;ks<4;++ks){
      asm volatile("ds_read_b64_tr_b16 %0,%1 offset:%c2":"=&v"(lo[ks]):"v"(vb),"i"(d0*4096+ks*1024):"memory");
      asm volatile("ds_read_b64_tr_b16 %0,%1 offset:%c2":"=&v"(hi[ks]):"v"(vb),"i"(d0*4096+ks*1024+512):"memory");}
    asm volatile("s_waitcnt lgkmcnt(0)":::"memory");SBAR();
    #define PK(k) (bf16x8){lo[k][0],lo[k][1],lo[k][2],lo[k][3],hi[k][0],hi[k][1],hi[k][2],hi[k][3]}
    o[d0]=__builtin_amdgcn_mfma_f32_32x32x16_bf16(pa0,PK(0),o[d0],0,0,0);
    o[d0]=__builtin_amdgcn_mfma_f32_32x32x16_bf16(pa1,PK(1),o[d0],0,0,0);
    o[d0]=__builtin_amdgcn_mfma_f32_32x32x16_bf16(pa2,PK(2),o[d0],0,0,0);
    o[d0]=__builtin_amdgcn_mfma_f32_32x32x16_bf16(pa3,PK(3),o[d0],0,0,0);
    #undef PK
  }
}

__device__ __forceinline__ void pv128(f32x16*o,int vb,bf16x8 pa0,bf16x8 pa1,bf16x8 pa2,bf16x8 pa3){
  #pragma unroll
  for(int d0=0;d0<4;++d0){s16x4 lo[4],hi[4];
    #pragma unroll
    for(int ks=0;ks<4;++ks){
      asm volatile("ds_read_b64_tr_b16 %0,%1 offset:%c2":"=&v"(lo[ks]):"v"(vb),"i"(d0*4096+ks*1024):"memory");
      asm volatile("ds_read_b64_tr_b16 %0,%1 offset:%c2":"=&v"(hi[ks]):"v"(vb),"i"(d0*4096+ks*1024+512):"memory");}
    asm volatile("s_waitcnt lgkmcnt(0)":::"memory");SBAR();
    #define PK(k) (bf16x8){lo[k][0],lo[k][1],lo[k][2],lo[k][3],hi[k][0],hi[k][1],hi[k][2],hi[k][3]}
    o[d0]=__builtin_amdgcn_mfma_f32_32x32x16_bf16(pa0,PK(0),o[d0],0,0,0);
    o[d0]=__builtin_amdgcn_mfma_f32_32x32x16_bf16(pa1,PK(1),o[d0],0,0,0);
    o[d0]=__builtin_amdgcn_mfma_f32_32x32x16_bf16(pa2,PK(2),o[d0],0,0,0);
    o[d0]=__builtin_amdgcn_mfma_f32_32x32x16_bf16(pa3,PK(3),o[d0],0,0,0);
    #undef PK
  }
}
#ifndef ATTN_STORE16
#define ATTN_STORE16(p,v) (*(u32x4*)(p)=(v))
#endif
template<int THRL,bool CAUSAL,bool WINDOW,bool ALIBI,bool LSE,int DV=64> __device__ __forceinline__ void attn_unit(const UnitP&U,char*shm){
  constexpr int LDS_WS=Lds<DV>::WS, LDS_OST=Lds<DV>::OST, VMUL=DV/64;
  int tid=threadIdx.x; asm volatile("":"+v"(tid));
  const int lane=tid&63,r32=lane&31,hi=lane>>5; const int wid=__builtin_amdgcn_readfirstlane(tid>>6);
  const int q0=U.q0; const long qp=U.qp,kp=U.kp,op=U.op; const float slope2=U.slope2;
  const bf16*Qw=U.Q+(long)(q0+wid*QBLK)*qp;
  const bf16*Kh=U.K+(long)U.t0*KVBLK*kp,*Vh=U.V+(long)U.t0*KVBLK*kp;
  const unsigned lds0=(unsigned)(uintptr_t)shm;
  float*wsf=(float*)(shm+LDS_WS)+wid*64;
  const bf16*ksrc=Kh+(long)lane*kp+wid*8;
  const bf16*vsrc=Vh+(long)(16*(wid&3)+(lane>>2))*kp+(wid>>2)*32+(lane&3)*8;
  const unsigned kdst=lds0+LDS_K+wid*1024, vdst=lds0+LDS_V+wid*1024;
  #define DMA_K(t,slot) glds16(ksrc+(long)(t)*KVBLK*kp,(unsigned)__builtin_amdgcn_readfirstlane(kdst+(slot)))
  #define DMA_V(t,slot) do{ glds16(vsrc+(long)(t)*KVBLK*kp,(unsigned)__builtin_amdgcn_readfirstlane(vdst+VMUL*(slot))); if constexpr(DV==128) glds16(vsrc+64+(long)(t)*KVBLK*kp,(unsigned)__builtin_amdgcn_readfirstlane(vdst+VMUL*(slot)+8192)); }while(0)
  const int vb0=(int)(lds0+LDS_V)+((lane>>4)&1)*32+(lane&3)*8+(4*hi+((lane&15)>>2))*64;
  const char*Kbase=shm+LDS_K; bf16x8 kf[8];
  const lds_cptr shm3=(lds_cptr)shm; const lds_cptr kp0=shm3+LDS_K+hi*1024+r32*16; const lds_cptr vp0=shm3+LDS_V+((lane>>4)&1)*32+(lane&3)*8+(4*hi+((lane&15)>>2))*64;
  const int NT=U.NT;
  DMA_K(0,0);DMA_V(0,0);DMA_K(1,SLOTB);
  bf16x8 qr[4];
  #pragma unroll
  for(int d0=0;d0<4;++d0)qr[d0]=*reinterpret_cast<const bf16x8*>(&Qw[(long)r32*qp+d0*16+hi*8]);
  float mhat=0.f,l_reg=0.f;f32x16 o[4];o[0]=f32x16{};o[1]=f32x16{};o[2]=f32x16{};o[3]=f32x16{};
  const int qrel=wid*QBLK+r32;
  #define CMASK(P0,P1,t) do{int jb_=(t)-(NT-4); if(WINDOW||(CAUSAL&&jb_>=0))cmask<CAUSAL,WINDOW>(P0,P1,jb_,qrel,hi);}while(0)
  bf16x8 kx0,kx1,qx;
  { const float k0_=ALIBI?slope2*(float)r32:0.f, k1_=ALIBI?slope2*(float)(r32+32):0.f; const unsigned h0=bfr(k0_),l0=bfr(k0_-bfv(h0)),h1=bfr(k1_),l1=bfr(k1_-bfv(h1));
    u32x4 a={0x3f803f80u,0x3f80u|(h0<<16),l0,0u}, b={0x3f803f80u,0x3f80u|(h1<<16),l1,0u}; if(hi){a=u32x4{0u,0u,0u,0u};b=a;} kx0=__builtin_bit_cast(bf16x8,a); kx1=__builtin_bit_cast(bf16x8,b); }
  #define QX_SET(t) do{ const float nb_=ALIBI?__builtin_fmaf(slope2,(float)(64*((t)-(NT-4))-qrel),-mhat):-mhat; const unsigned a_=bfr(nb_); const float r1_=nb_-bfv(a_); const unsigned b_=bfr(r1_); const unsigned c_=bfr(r1_-bfv(b_)); \
    u32x4 q_={a_|(b_<<16),c_|0x3f800000u,0x3f80u,0u}; if(hi)q_=u32x4{0u,0u,0u,0u}; qx=__builtin_bit_cast(bf16x8,q_); asm volatile("":"+v"(qx)); }while(0)
  bool resc=false;
  #define START(P0,P1) do{ const float rm=rowmax(P0,P1); resc=false; \
    { const float dl=(rm==-INFINITY)?0.f:rm; mhat=fadd_s(mhat,dl); \
      _Pragma("unroll") for(int r=0;r<16;++r){P0[r]=fsub_s(P0[r],dl);P1[r]=fsub_s(P1[r],dl);} } \
    _Pragma("unroll") for(int r=0;r<16;++r)P0[r]=__builtin_amdgcn_exp2f(P0[r]); }while(0)
  #define RESC() do{ if(resc){ asm volatile("s_waitcnt lgkmcnt(0)":::"memory"); \
      _Pragma("unroll") for(int d_=0;d_<2*VMUL;++d_) _Pragma("unroll") for(int r=0;r<16;++r)o[d_][r]*=wsf[crow(r,hi)]; } }while(0)
  f32x16 pA0,pA1,pB0,pB1;
  int sl_prev=0,sl_cur=0,sl_next=SLOTB;
  #define ROT() do{sl_prev=sl_cur;sl_cur=sl_next;sl_next=(sl_next==(NSLOT-1)*SLOTB)?0:sl_next+SLOTB;}while(0)
  DMA_K(2,2*SLOTB);
  if constexpr(DV==128){WAIT_BAR(4);}else{WAIT_BAR(3);}
  QX_SET(0);
  qkt(pA0,pA1,Kbase,qr,kx0,kx1,qx,r32,hi);asm volatile("s_nop 15\n\ts_nop 7":"+v"(pA0),"+v"(pA1));CMASK(pA0,pA1,0);
  START(pA0,pA1);
  _Pragma("unroll") for(int r=0;r<16;++r)pA1[r]=__builtin_amdgcn_exp2f(pA1[r]);
  WAIT_BAR(0);
  DMA_K(3,0);DMA_V(1,SLOTB);
  ROT();
  kload8(kf,kp0+sl_cur);
  if constexpr(DV==128){WAIT_BAR(3);}else{WAIT_BAR(2);}
  s16x4 vlo[8],vhi[8]; s16x4 vfl[4],vfh[4]; u32x4 pw0,pw1,pw2,pw3;
  #define PKW(P,B) cvtpk_s(P[B],P[B+1])
  #define PAF(k) __builtin_bit_cast(bf16x8,pw##k)
  #define VFR(i) (bf16x8){vlo[i][0],vlo[i][1],vlo[i][2],vlo[i][3],vhi[i][0],vhi[i][1],vhi[i][2],vhi[i][3]}
  #define PIN(x) asm volatile("":"+v"(x))
  #define MX3(a,b,c) __builtin_fmaxf(__builtin_fmaxf((a),(b)),(c))
  #define GAPA(MF,A0,A1,A2,A3,W0,W1,PW) do{ MF; sacc+=A0; sacc+=A1; sacc+=A2; sacc+=A3; PIN(sacc); W0; W1; PIN(PW); SBAR(); }while(0)
  #define EX(v) __builtin_amdgcn_exp2f(v)
  #define GAPB(MF,X,B) do{ MF; X[B]=EX(X[B]); X[B+1]=EX(X[B+1]); X[B+2]=EX(X[B+2]); X[B+3]=EX(X[B+3]); PIN(X); SBAR(); }while(0)
  #define VRD(i) do{ if constexpr(DV==64){ vlo[i]=vtr(vp_+(((i)>>2)*4096+((i)&3)*1024)); vhi[i]=vtr(vp_+(((i)>>2)*4096+((i)&3)*1024+512)); } }while(0)
  #define VRJ(f) do{ vfl[(f)&3]=vtr(vp_+(((f)&3)*4096+((f)>>2)*1024)); vfh[(f)&3]=vtr(vp_+(((f)&3)*4096+((f)>>2)*1024+512)); }while(0)
  #define VFJ(f) (bf16x8){vfl[(f)&3][0],vfl[(f)&3][1],vfl[(f)&3][2],vfl[(f)&3][3],vfh[(f)&3][0],vfh[(f)&3][1],vfh[(f)&3][2],vfh[(f)&3][3]}
  #define GAPJ(f,PA,X,B) do{ if((f)+3<16){VRJ((f)+3);} o[(f)&3]=__builtin_amdgcn_mfma_f32_32x32x16_bf16(PA,VFJ(f),o[(f)&3],0,0,0); X[B]=EX(X[B]); X[B+1]=EX(X[B+1]); PIN(X); SBAR(); }while(0)
  #define KRD(G,j) do{ if(G){ kload2(kf,kp0+sl_next,j); SBAR(); } }while(0)
  #define STEP(C0,C1,P0,P1,t,GK,GV,GL) do{ SBAR(); QX_SET(t); SBAR(); \
    const lds_cptr vp_=vp0+VMUL*sl_prev; \
    VRD(0); SBAR(); float sacc=(P0[0]+P0[1]); \
    GAPA(C0=__builtin_amdgcn_mfma_f32_32x32x16_bf16(kf[0],qr[0],f32x16{},0,0,0), P0[2],P0[3],P0[4],P0[5],     pw0[0]=PKW(P0,0), pw0[1]=PKW(P0,2), pw0); \
    VRD(4); SBAR(); GAPA(C1=__builtin_amdgcn_mfma_f32_32x32x16_bf16(kf[1],qr[0],f32x16{},0,0,0), P0[6],P0[7],P0[8],P0[9],     pw0[2]=PKW(P0,4), pw0[3]=PKW(P0,6), pw0); \
    VRD(1); SBAR(); GAPA(C0=__builtin_amdgcn_mfma_f32_32x32x16_bf16(kf[2],qr[1],C0,0,0,0),   P0[10],P0[11],P0[12],P0[13], pw1[0]=PKW(P0,8), pw1[1]=PKW(P0,10), pw1); \
    VRD(5); SBAR(); GAPA(C1=__builtin_amdgcn_mfma_f32_32x32x16_bf16(kf[3],qr[1],C1,0,0,0),   P0[14],P0[15],P1[0],P1[1],   pw1[2]=PKW(P0,12),pw1[3]=PKW(P0,14), pw1); \
    VRD(2); SBAR(); GAPA(C0=__builtin_amdgcn_mfma_f32_32x32x16_bf16(kf[4],qr[2],C0,0,0,0),   P1[2],P1[3],P1[4],P1[5],     pw2[0]=PKW(P1,0), pw2[1]=PKW(P1,2), pw2); \
    VRD(6); SBAR(); GAPA(C1=__builtin_amdgcn_mfma_f32_32x32x16_bf16(kf[5],qr[2],C1,0,0,0),   P1[6],P1[7],P1[8],P1[9],     pw2[2]=PKW(P1,4), pw2[3]=PKW(P1,6), pw2); \
    VRD(3); SBAR(); GAPA(C0=__builtin_amdgcn_mfma_f32_32x32x16_bf16(kf[6],qr[3],C0,0,0,0),   P1[10],P1[11],P1[12],P1[13], pw3[0]=PKW(P1,8), pw3[1]=PKW(P1,10), pw3); \
    VRD(7); SBAR(); GAPA(C1=__builtin_amdgcn_mfma_f32_32x32x16_bf16(kf[7],qr[3],C1,0,0,0),   P1[14],P1[15],0.f,0.f,       pw3[2]=PKW(P1,12),pw3[3]=PKW(P1,14), pw3); \
    C0=__builtin_amdgcn_mfma_f32_32x32x16_bf16(kx0,qx,C0,0,0,0); C1=__builtin_amdgcn_mfma_f32_32x32x16_bf16(kx1,qx,C1,0,0,0); if constexpr(DV==128){VRJ(0);VRJ(1);VRJ(2);} SBAR(); \
    l_reg+=sacc; \
    if(GK){DMA_K((t)+3,sl_cur);} if(GV){DMA_V((t)+1,sl_next);} \
    CMASK(C0,C1,t); \
    { float a=MX3(C0[0],C0[1],C1[0]),b=MX3(C0[2],C0[3],C1[1]); a=MX3(a,C1[2],C1[3]); \
      _Pragma("unroll") for(int r=4;r<16;r+=4){a=MX3(a,C0[r],C0[r+1]);b=MX3(b,C0[r+2],C0[r+3]);a=MX3(a,C1[r],C1[r+1]);b=MX3(b,C1[r+2],C1[r+3]);} \
      float rm=__builtin_fmaxf(a,b); { auto rr=__builtin_amdgcn_permlane32_swap(__float_as_uint(rm),__float_as_uint(rm),false,false); rm=__builtin_fmaxf(__uint_as_float(rr[0]),__uint_as_float(rr[1])); } \
      resc=false; \
      if(__builtin_expect(__any(rm>(float)THRL),0)){ const float dl=__builtin_fmaxf(rm,0.f); mhat+=dl; \
        _Pragma("unroll") for(int r=0;r<16;++r){C0[r]-=dl;C1[r]-=dl;} \
        const float f=__builtin_amdgcn_exp2f(-dl); l_reg*=f; if(hi==0)wsf[r32]=f; resc=true; } } \
    SBAR(); \
    if constexpr(DV==64){ \
    GAPB(o[0]=__builtin_amdgcn_mfma_f32_32x32x16_bf16(PAF(0),VFR(0),o[0],0,0,0), C0,0); \
    GAPB(o[1]=__builtin_amdgcn_mfma_f32_32x32x16_bf16(PAF(0),VFR(4),o[1],0,0,0), C0,4); \
    KRD(GL,0); GAPB(o[0]=__builtin_amdgcn_mfma_f32_32x32x16_bf16(PAF(1),VFR(1),o[0],0,0,0), C0,8); \
    KRD(GL,1); GAPB(o[1]=__builtin_amdgcn_mfma_f32_32x32x16_bf16(PAF(1),VFR(5),o[1],0,0,0), C0,12); \
    KRD(GL,2); GAPB(o[0]=__builtin_amdgcn_mfma_f32_32x32x16_bf16(PAF(2),VFR(2),o[0],0,0,0), C1,0); \
    KRD(GL,3); GAPB(o[1]=__builtin_amdgcn_mfma_f32_32x32x16_bf16(PAF(2),VFR(6),o[1],0,0,0), C1,4); \
    GAPB(o[0]=__builtin_amdgcn_mfma_f32_32x32x16_bf16(PAF(3),VFR(3),o[0],0,0,0), C1,8); \
    GAPB(o[1]=__builtin_amdgcn_mfma_f32_32x32x16_bf16(PAF(3),VFR(7),o[1],0,0,0), C1,12); \
    } else { \
    GAPJ(0,PAF(0),C0,0); GAPJ(1,PAF(0),C0,2); GAPJ(2,PAF(0),C0,4); GAPJ(3,PAF(0),C0,6); \
    KRD(GL,0); GAPJ(4,PAF(1),C0,8); GAPJ(5,PAF(1),C0,10); KRD(GL,1); GAPJ(6,PAF(1),C0,12); GAPJ(7,PAF(1),C0,14); \
    KRD(GL,2); GAPJ(8,PAF(2),C1,0); GAPJ(9,PAF(2),C1,2); KRD(GL,3); GAPJ(10,PAF(2),C1,4); GAPJ(11,PAF(2),C1,6); \
    GAPJ(12,PAF(3),C1,8); GAPJ(13,PAF(3),C1,10); GAPJ(14,PAF(3),C1,12); GAPJ(15,PAF(3),C1,14); \
    } \
    }while(0)
  int t=1;
  #undef CMASK
  #define CMASK(P0,P1,t) do{}while(0)
  for(;t+5<NT;t+=2){
    STEP(pB0,pB1,pA0,pA1,t,true,true,true);     if constexpr(DV==128){WAIT_BAR(3);}else{WAIT_BAR(2);} RESC(); ROT();
    STEP(pA0,pA1,pB0,pB1,t+1,true,true,true);   if constexpr(DV==128){WAIT_BAR(3);}else{WAIT_BAR(2);} RESC(); ROT();
  }
  #undef CMASK
  #define CMASK(P0,P1,t) do{int jb_=(t)-(NT-4); if(WINDOW||(CAUSAL&&jb_>=0))cmask<CAUSAL,WINDOW>(P0,P1,jb_,qrel,hi);}while(0)
  #define ENDW(tt) do{ if((tt)+3<NT){ if constexpr(DV==128){WAIT_BAR(3);}else{WAIT_BAR(2);} } else if((tt)+2<NT){ if constexpr(DV==128){WAIT_BAR(2);}else{WAIT_BAR(1);} } else {WAIT_BAR(0);} }while(0)
  for(;t+1<NT;t+=2){
    STEP(pB0,pB1,pA0,pA1,t,(t+3<NT),(t+1<NT),(t+1<NT));       ENDW(t);   RESC(); ROT();
    STEP(pA0,pA1,pB0,pB1,t+1,(t+4<NT),(t+2<NT),(t+2<NT));     ENDW(t+1); RESC(); ROT();
  }
  STEP(pB0,pB1,pA0,pA1,NT-1,false,false,false); RESC();
  { float sacc=pB0[0]+pB0[1]; _Pragma("unroll") for(int r=2;r<16;++r)sacc+=pB0[r]; _Pragma("unroll") for(int r=0;r<16;++r)sacc+=pB1[r]; l_reg+=sacc;
    pw0=(u32x4){PKW(pB0,0),PKW(pB0,2),PKW(pB0,4),PKW(pB0,6)};pw1=(u32x4){PKW(pB0,8),PKW(pB0,10),PKW(pB0,12),PKW(pB0,14)};pw2=(u32x4){PKW(pB1,0),PKW(pB1,2),PKW(pB1,4),PKW(pB1,6)};pw3=(u32x4){PKW(pB1,8),PKW(pB1,10),PKW(pB1,12),PKW(pB1,14)};
    SBAR(); if constexpr(DV==128){pv128(o,vb0+VMUL*sl_cur,PAF(0),PAF(1),PAF(2),PAF(3));}else{pv(o,vb0+sl_cur,PAF(0),PAF(1),PAF(2),PAF(3));} }
  #undef PKW
  #undef PAF
  #undef VFR
  #undef PIN
  #undef MX3
  #undef GAPA
  #undef GAPB
  #undef EX
  #undef VRD
  #undef VRJ
  #undef VFJ
  #undef GAPJ
  #undef KRD
  #undef STEP
  #undef ENDW
  {auto rr=__builtin_amdgcn_permlane32_swap(__float_as_uint(l_reg),__float_as_uint(l_reg),false,false);l_reg=__uint_as_float(rr[0])+__uint_as_float(rr[1]);}
  if(LSE){ if(hi==0)U.lse[(long)(q0+wid*QBLK+r32)*U.lse_stride]=mhat+__builtin_amdgcn_logf(l_reg); }
  if(hi==0)wsf[32+r32]=l_reg;asm volatile("s_waitcnt lgkmcnt(0)":::"memory");
  float rli[16];
  #pragma unroll
  for(int r=0;r<16;++r)rli[r]=__builtin_amdgcn_rcpf(wsf[32+crow(r,hi)]);
  bf16*Ow=U.O+(long)(q0+wid*QBLK)*op;
  { bf16*stg=(bf16*)(shm+LDS_OST)+wid*(2048*VMUL);
    #pragma unroll
    for(int r=0;r<16;++r){const int orow=crow(r,hi);
      #pragma unroll
      for(int d0=0;d0<2*VMUL;++d0)stg[orow*DV+d0*32+r32]=__float2bfloat16(o[d0][r]*rli[r]);}
    asm volatile("s_waitcnt lgkmcnt(0)":::"memory");
    if constexpr(DV==128){
      #pragma unroll
      for(int i=0;i<8;++i){const int row=i*4+(lane>>4),ch=lane&15; const u32x4 v=*(const u32x4*)(stg+row*128+ch*8); ATTN_STORE16(Ow+(long)row*op+ch*8,v);}
    } else {
      #pragma unroll
      for(int i=0;i<4;++i){const int row=i*8+(lane>>3),ch=lane&7; const u32x4 v=*(const u32x4*)(stg+row*64+ch*8); ATTN_STORE16(Ow+(long)row*op+ch*8,v);} } }
  asm volatile("s_waitcnt lgkmcnt(0)\n\ts_barrier":::"memory");
  #undef DMA_K
  #undef DMA_V
  #undef CMASK
  #undef START
  #undef RESC
  #undef ROT
  #undef QX_SET
}
constexpr int ATTN_LDS_BYTES=Lds<128>::BYTES;
#undef SBAR
#undef WAIT_BAR
}
constexpr size_t MiB = 1u << 20;
constexpr size_t WS_CTL = 0, CTL_ZERO_BYTES = 1 * MiB;
constexpr size_t WS_LIST = 1 * MiB;
constexpr size_t WS_RGATE = 5 * MiB;
constexpr size_t WS_RSTD1 = 5 * MiB + 512 * 1024, WS_RSTD2 = WS_RSTD1 + 128 * 1024, WS_WRG = WS_RSTD2 + 128 * 1024;
constexpr size_t WS_WRT = 7 * MiB + 512 * 1024;
constexpr size_t WS_LSE = 6 * MiB;
constexpr size_t WS_MKV = 8 * MiB;
constexpr size_t WS_WIN = 10 * MiB, WS_WOUT = 15 * MiB, WS_WGU = 17 * MiB, WS_WDN = 145 * MiB;
constexpr size_t WS_XB = 209 * MiB;
constexpr size_t WS_LRSTD = 209 * MiB, WS_LGATE = 213 * MiB;
constexpr size_t WS_P = 273 * MiB, WS_OD = 433 * MiB, WS_ODIL = 497 * MiB;
constexpr size_t WS_ACT = 273 * MiB;
constexpr size_t WS_MIX = 545 * MiB, WS_X1B = 609 * MiB, WS_YB = 673 * MiB, WS_X1H = 801 * MiB, WS_Y = 929 * MiB, WS_END = 993 * MiB;
constexpr int CW_TMO = 0, CW_CODE = 1;
constexpr int CW_CNT = 64;
constexpr int CW_NRM = 256;
constexpr int CW_Q = 1024;
constexpr int CW_BAR = 4096;

constexpr int RING_OFF = 0, RING_BYTES = 131072;
constexpr int LDSCTL_OFF = RING_BYTES;
constexpr int IDB_OFF = LDSCTL_OFF;
constexpr int TBL_OFF = IDB_OFF + 9216;
constexpr int LCNT_OFF = TBL_OFF + 2304;
constexpr int MISC_OFF = LCNT_OFF + 256;
constexpr int STG_OFF = IDB_OFF;
constexpr int LDS_BYTES = 147456;
static_assert(MISC_OFF + 128 <= LDS_BYTES && 512 * 16 <= 9216, "LDS map");
constexpr int NWAVES = 8;

#define GAS __attribute__((address_space(1)))
#define LAS __attribute__((address_space(3)))
typedef unsigned short bf16;
typedef unsigned v4u __attribute__((ext_vector_type(4)));
typedef unsigned v2u __attribute__((ext_vector_type(2)));
typedef float f32x4 __attribute__((ext_vector_type(4)));
typedef float f32x16 __attribute__((ext_vector_type(16)));
typedef short bf16x8 __attribute__((ext_vector_type(8)));
typedef GAS unsigned gu32;
#define RLX_AGENT __ATOMIC_RELAXED, __HIP_MEMORY_SCOPE_AGENT
#define LDS_WAIT() asm volatile("s_waitcnt lgkmcnt(0)" ::: "memory")
#define VM_WAIT() asm volatile("s_waitcnt vmcnt(0)" ::: "memory")
__device__ __forceinline__ unsigned f2bf(float f) { unsigned u = __builtin_bit_cast(unsigned, f); return (u + 0x7fffu + ((u >> 16) & 1u)) >> 16; }
__device__ __forceinline__ unsigned pk2(float lo, float hi) { return f2bf(lo) | (f2bf(hi) << 16); }
__device__ __forceinline__ unsigned fp8x4(float a, float b, float c, float d) { int w = __builtin_amdgcn_cvt_pk_fp8_f32(a, b, 0, false); w = __builtin_amdgcn_cvt_pk_fp8_f32(c, d, w, true); return (unsigned)w; }
constexpr float WSCALE = 64.f, ASCALE = 8.f, YSCALE = 64.f;
__device__ __forceinline__ float bf2f(unsigned short b) { return __builtin_bit_cast(float, (unsigned)b << 16); }
__device__ __forceinline__ float bflo(unsigned w) { return __builtin_bit_cast(float, w << 16); }
__device__ __forceinline__ float bfhi(unsigned w) { return __builtin_bit_cast(float, w & 0xffff0000u); }
__device__ __forceinline__ float wave_sum(float v) {
#pragma unroll
    for (int o = 1; o < 64; o <<= 1) v += __shfl_xor(v, o);
    return v;
}

#define XB_TMO      128
#define XB_XCNT(j)  (256  + 64 * (j))
#define XB_XSUB(j)  (1280 + 64 * (j))
#define XB_XGEN(j)  (2304 + 64 * (j))
#define XB_TOP      3328
#define XB_TOPGEN   3392
#define XCD_BAR_WORDS 3456
#define XB_SPIN_CAP (1u << 20)
__device__ __forceinline__ unsigned xb_ld(unsigned* p)              { return __hip_atomic_load(p, __ATOMIC_RELAXED, __HIP_MEMORY_SCOPE_AGENT); }
__device__ __forceinline__ unsigned xb_add(unsigned* p, unsigned v) { return __hip_atomic_fetch_add(p, v, __ATOMIC_RELAXED, __HIP_MEMORY_SCOPE_AGENT); }
__device__ __forceinline__ unsigned xb_xcc_id() { return (unsigned)__builtin_amdgcn_s_getreg((3 << 11) | 20) & 0xFu; }
#define XB_SPIN(cond, bar) do { unsigned _sp = 0; while (cond) { __builtin_amdgcn_s_sleep(1); \
    if ((++_sp & 255u) == 0u) { if (xb_ld(&(bar)[XB_TMO])) break; if (_sp > XB_SPIN_CAP) { atomicAdd(&(bar)[XB_TMO], 1u); break; } } } } while (0)
struct XcdBarrier { unsigned* bar; unsigned x; volatile LAS unsigned* st; };
__device__ __forceinline__ XcdBarrier xcd_barrier_post(unsigned* bar, volatile LAS unsigned* st) {
    XcdBarrier b; b.bar = bar; b.x = xb_xcc_id(); b.st = st;
    if (threadIdx.x == 0) (void)xb_add(&bar[XB_XCNT(b.x)], 1u);
    return b;
}
__device__ __forceinline__ void xcd_barrier_complete(unsigned* bar, unsigned x, unsigned& nloc, unsigned& nx) {
    const unsigned G = gridDim.x * gridDim.y * gridDim.z;
    unsigned sum, cnt, mine, sp = 0u;
    for (;;) {
        sum = 0u; cnt = 0u; mine = 0u;
#pragma unroll
        for (unsigned j = 0; j < 16; ++j) { const unsigned c = xb_ld(&bar[XB_XCNT(j)]); sum += c; cnt += (c > 0u) ? 1u : 0u; mine = (j == x) ? c : mine; }
        if (sum == G) break;
        __builtin_amdgcn_s_sleep(1);
        if ((++sp & 255u) == 0u) { if (xb_ld(&bar[XB_TMO])) break; if (sp > XB_SPIN_CAP) { atomicAdd(&bar[XB_TMO], 1u); break; } }
    }
    nloc = mine > 0u ? mine : 1u; nx = cnt > 0u ? cnt : 1u;
}
__device__ __forceinline__ void xcd_barrier(const XcdBarrier& b) {
    asm volatile("s_waitcnt vmcnt(0)" ::: "memory");
    __syncthreads();
    if (threadIdx.x == 0) {
        unsigned* bar = b.bar;
        __builtin_amdgcn_s_waitcnt(0);
        unsigned nloc = b.st[0], nx = b.st[1];
        if (nloc == 0u) { xcd_barrier_complete(bar, b.x, nloc, nx); b.st[0] = nloc; b.st[1] = nx; }
        const unsigned old = xb_add(&bar[XB_XSUB(b.x)], 1u);
        const unsigned gen = old / nloc;
        if (old + 1u == (gen + 1u) * nloc) {
            __builtin_amdgcn_fence(__ATOMIC_RELEASE, "agent");
            asm volatile("s_waitcnt vmcnt(0)" ::: "memory");
            const unsigned og = xb_add(&bar[XB_TOP], 1u);
            const unsigned tg = og / nx;
            if (og + 1u == (tg + 1u) * nx) xb_add(&bar[XB_TOPGEN], 1u);
            else XB_SPIN(xb_ld(&bar[XB_TOPGEN]) == tg, bar);
            __builtin_amdgcn_fence(__ATOMIC_ACQUIRE, "agent");
            xb_add(&bar[XB_XGEN(b.x)], 1u);
            asm volatile("s_waitcnt vmcnt(0)" ::: "memory");
        } else {
            XB_SPIN(xb_ld(&bar[XB_XGEN(b.x)]) == gen, bar);
            __builtin_amdgcn_fence(__ATOMIC_ACQUIRE, "agent");
            asm volatile("s_waitcnt vmcnt(0)" ::: "memory");
        }
    }
    __syncthreads();
}

struct Frame {
    LAS unsigned char* lds;
    volatile LAS unsigned* MISC;
    gu32* ctl;
    int tid, lane, wave;
    int vcu, G;
    const float *x, *mem, *g_attn, *g_mem, *w_in, *lamqk, *subg, *w_mkv, *w_out, *g_ffn, *w_r, *b_r, *w_gu, *b_gu, *w_dn, *b_dn, *g_fin;
    float* out; unsigned char* ws;
};

#define P0_LOAD(dst, itm) do { const int m_ = (itm) / ipm, r_ = (itm) % ipm, kb_ = r_ / nblk, nb_ = r_ % nblk; \
        const float* src_ = W + (size_t)m_ * K * N + (size_t)(64 * kb_ + (lane >> 5)) * N + 32 * nb_ + (lane & 31); \
        _Pragma("unroll") for (int i_ = 0; i_ < 32; ++i_) dst[i_] = src_[(size_t)(2 * i_) * N]; } while (0)
template <bool F8, class RowMap>
__device__ __forceinline__ void p0_transpose_all(const float* W, int K, int N, int nmat, void* WTv, const float* gk, float wscale, LAS float* scr, int gw, int NGW, int lane, RowMap rowmap) {
    asm volatile("" : "+v"(lane));
    const int nblk = N / 32, ipm = (K / 64) * nblk, total = nmat * ipm;
    int it = gw; if (it >= total) return;
    float v[32], w[32];
    P0_LOAD(v, it);
    for (;;) {
        const int nx = it + NGW; const bool more = nx < total;
        if (more) P0_LOAD(w, nx);
        const int m = it / ipm, r = it % ipm, k0 = 64 * (r / nblk), n0 = 32 * (r % nblk);
        if (gk) {
#pragma unroll
            for (int i = 0; i < 32; ++i) v[i] *= gk[k0 + 2 * i + (lane >> 5)] * wscale;
        } else if (F8) {
#pragma unroll
            for (int i = 0; i < 32; ++i) v[i] *= wscale;
        }
#pragma unroll
        for (int i = 0; i < 32; ++i) scr[(2 * i + (lane >> 5)) * 33 + (lane & 31)] = v[i];
        LDS_WAIT(); asm volatile("" ::: "memory");
        const int c = lane & 7;
#pragma unroll
        for (int j = 0; j < 4; ++j) { const int n = (lane >> 3) + 8 * j; const LAS float* s = scr + (8 * c) * 33 + n;
            if constexpr (F8) { unsigned char* wt = (unsigned char*)WTv + (size_t)m * N * K;
                v2u o; o.x = fp8x4(s[0 * 33], s[1 * 33], s[2 * 33], s[3 * 33]); o.y = fp8x4(s[4 * 33], s[5 * 33], s[6 * 33], s[7 * 33]);
                *(GAS v2u*)(wt + (size_t)rowmap(n0 + n) * K + k0 + 8 * c) = o; }
            else { bf16* wt = (bf16*)WTv + (size_t)m * N * K;
                v4u o; o.x = pk2(s[0 * 33], s[1 * 33]); o.y = pk2(s[2 * 33], s[3 * 33]); o.z = pk2(s[4 * 33], s[5 * 33]); o.w = pk2(s[6 * 33], s[7 * 33]);
                *(GAS v4u*)(wt + (size_t)rowmap(n0 + n) * K + k0 + 8 * c) = o; } }
        LDS_WAIT(); asm volatile("" ::: "memory");
        if (!more) break;
#pragma unroll
        for (int i = 0; i < 32; ++i) v[i] = w[i];
        it = nx;
    }
}
#undef P0_LOAD
struct RowId { __device__ __forceinline__ int operator()(int n) const { return n; } };
struct RowGU { __device__ __forceinline__ int operator()(int n) const { const int f = n >> 1, u = n & 1; return ((f >> 7) << 8) + (u << 7) + (f & 127); } };

__device__ __forceinline__ void p0_x_rows2(Frame& F, const float* xrow, bf16* orow, float* rstd_out) {
    const GAS f32x4* xr = (const GAS f32x4*)xrow + F.lane;
    f32x4 v[8]; float s0 = 0.f, s1 = 0.f;
#pragma unroll
    for (int j = 0; j < 8; ++j) v[j] = xr[64 * j];
#pragma unroll
    for (int j = 0; j < 4; ++j) { s0 += (v[j].x * v[j].x + v[j].y * v[j].y) + (v[j].z * v[j].z + v[j].w * v[j].w); s1 += (v[4 + j].x * v[4 + j].x + v[4 + j].y * v[4 + j].y) + (v[4 + j].z * v[4 + j].z + v[4 + j].w * v[4 + j].w); }
    s0 = wave_sum(s0); s1 = wave_sum(s1);
    GAS unsigned long long* o8 = (GAS unsigned long long*)orow + F.lane;
#pragma unroll
    for (int j = 0; j < 8; ++j) o8[64 * j] = (unsigned long long)pk2(v[j].x, v[j].y) | ((unsigned long long)pk2(v[j].z, v[j].w) << 32);
    if (F.lane == 0) { rstd_out[0] = 1.f / sqrtf(s0 * (1.f / D) + EPS); rstd_out[1] = 1.f / sqrtf(s1 * (1.f / D) + EPS); }
}
__device__ __forceinline__ void p0_mkv_tile(Frame& F, int tile, bf16* mkv) {
    const int mt = tile >> 4, nt = tile & 15, m0 = 32 * mt, n0 = 32 * nt, r = F.lane & 31, h = F.lane >> 5;
    f32x16 acc = {}; float ss = 0.f;
    const float* mrow = F.mem + (size_t)(m0 + r) * D + 8 * h;
    const float* wcol = F.w_mkv + (size_t)(8 * h) * 512 + n0 + r;
    const float* gp = F.g_mem + 8 * h;
    for (int k0 = 0; k0 < D; k0 += 16) {
        const f32x4 a0 = *(const f32x4*)(mrow + k0), a1 = *(const f32x4*)(mrow + k0 + 4);
        const f32x4 g0 = *(const f32x4*)(gp + k0), g1 = *(const f32x4*)(gp + k0 + 4);
        ss += (a0.x * a0.x + a0.y * a0.y) + (a0.z * a0.z + a0.w * a0.w) + (a1.x * a1.x + a1.y * a1.y) + (a1.z * a1.z + a1.w * a1.w);
        v4u bw; bw.x = pk2(a0.x * g0.x, a0.y * g0.y); bw.y = pk2(a0.z * g0.z, a0.w * g0.w); bw.z = pk2(a1.x * g1.x, a1.y * g1.y); bw.w = pk2(a1.z * g1.z, a1.w * g1.w);
        float wv[8];
#pragma unroll
        for (int j = 0; j < 8; ++j) wv[j] = wcol[(size_t)(k0 + j) * 512];
        v4u aw; aw.x = pk2(wv[0], wv[1]); aw.y = pk2(wv[2], wv[3]); aw.z = pk2(wv[4], wv[5]); aw.w = pk2(wv[6], wv[7]);
        acc = __builtin_amdgcn_mfma_f32_32x32x16_bf16(__builtin_bit_cast(bf16x8, aw), __builtin_bit_cast(bf16x8, bw), acc, 0, 0, 0);
    }
    ss += __shfl_xor(ss, 32);
    const float rstd = 1.f / sqrtf(ss * (1.f / D) + EPS);
    bf16* orow = mkv + (size_t)(m0 + r) * 512 + n0 + 4 * h;
#pragma unroll
    for (int q = 0; q < 4; ++q) { v2u o; o.x = pk2(acc[4 * q] * rstd, acc[4 * q + 1] * rstd); o.y = pk2(acc[4 * q + 2] * rstd, acc[4 * q + 3] * rstd); *(GAS v2u*)(orow + 8 * q) = o; }
}
__device__ __forceinline__ void p0_prologue(Frame& F) {
    LAS float* scr = (LAS float*)(F.lds + RING_OFF + F.wave * 16384);
    const int gw = F.vcu * NWAVES + F.wave, NGW = F.G * NWAVES;
    bf16* win_t = (bf16*)(F.ws + WS_WIN); bf16* wout_t = (bf16*)(F.ws + WS_WOUT);
    if (F.wave < 4 && F.G == 256) p0_mkv_tile(F, F.wave * 256 + F.vcu, (bf16*)(F.ws + WS_MKV));
    p0_transpose_all<false>(F.w_in, D, DIN, 1, win_t, F.g_attn, 1.f, scr, gw, NGW, F.lane, RowId());
    p0_transpose_all<false>(F.w_out, D, D, 1, wout_t, nullptr, 1.f, scr, gw, NGW, F.lane, RowId());
    bf16* xb = (bf16*)(F.ws + WS_XB); float* rstd1 = (float*)(F.ws + WS_RSTD1);
    for (int m = 2 * gw; m < T; m += 2 * NGW) p0_x_rows2(F, F.x + (size_t)m * D, xb + (size_t)m * D, rstd1 + m);
    bf16* wrt = (bf16*)(F.ws + WS_WRT);
    for (int i = gw * 64 + F.lane; i < D * NE; i += NGW * 64) { const int e = i >> 10, k = i & 1023; const float w = F.w_r[k * NE + e] * F.g_ffn[k]; const unsigned hb = f2bf(w); wrt[i] = (bf16)hb; wrt[D * NE + i] = (bf16)f2bf(w - bf2f((bf16)hb)); }
}

constexpr int NCONV = 8, NCONV_ALL = 8 * NCONV;
__device__ __forceinline__ void p0b_unit(Frame& F, int c) {
    LAS float* scr = (LAS float*)(F.lds + RING_OFF + F.wave * 16384);
    p0_transpose_all<true>(F.w_gu, D, 2 * DFF, NE, (void*)(F.ws + WS_WGU), F.g_ffn, WSCALE, scr, c * NWAVES + F.wave, NCONV_ALL * NWAVES, F.lane, RowGU());
    p0_transpose_all<true>(F.w_dn, DFF, D, NE, (void*)(F.ws + WS_WDN), nullptr, WSCALE, scr, c * NWAVES + F.wave, NCONV_ALL * NWAVES, F.lane, RowId());
    __syncthreads();
}

struct EpiInProj {
    bf16* O; const float* rstd; unsigned* nrm;
    __device__ __forceinline__ void operator()(const pg8::f32x4 (&acc)[2][2][4][2], const pg8::Unit& u, int wr, int wc, int fr, int fq, const LAS unsigned* ids) const {
        asm volatile("" : "+v"(fr), "+v"(fq));
        const int row0 = u.pm * 256 + wr * 64 + fr, col0 = u.pn * 256 + wc * 32 + 8 * fq;
        const float sc = (u.pn <= 1 || u.pn == 6 || u.pn == 9) ? QSCALE : 1.f;
        const LAS float* scl = (const LAS float*)(ids + 256);
        float rsv[2][4];
#pragma unroll
        for (int ai = 0; ai < 2; ++ai)
#pragma unroll
            for (int m = 0; m < 4; ++m) rsv[ai][m] = scl[wr * 64 + fr + ai * 128 + m * 16];
#pragma unroll
        for (int ai = 0; ai < 2; ++ai)
#pragma unroll
            for (int m = 0; m < 4; ++m) { const int row = row0 + ai * 128 + m * 16; const float rs = rsv[ai][m] * sc; bf16* rowp = O + (size_t)row * DIN + col0;
#pragma unroll
                for (int bj = 0; bj < 2; ++bj) { const pg8::f32x4 v0 = acc[ai][bj][m][0] * rs, v1 = acc[ai][bj][m][1] * rs;
                    v4u w; w.x = pg8::cvt_pk_bf16(v0[0], v0[1]); w.y = pg8::cvt_pk_bf16(v0[2], v0[3]); w.z = pg8::cvt_pk_bf16(v1[0], v1[1]); w.w = pg8::cvt_pk_bf16(v1[2], v1[3]);
                    *(v4u*)(rowp + bj * 128) = w; } }
        if (u.pn < 4) {
#pragma unroll
            for (int bj = 0; bj < 2; ++bj) { float mx = 0.f;
#pragma unroll
                for (int ai = 0; ai < 2; ++ai)
#pragma unroll
                    for (int m = 0; m < 4; ++m) { const float rs = rsv[ai][m] * sc; const pg8::f32x4 v0 = acc[ai][bj][m][0] * rs, v1 = acc[ai][bj][m][1] * rs;
                        float s = (v0[0] * v0[0] + v0[1] * v0[1]) + (v0[2] * v0[2] + v0[3] * v0[3]) + (v1[0] * v1[0] + v1[1] * v1[1]) + (v1[2] * v1[2] + v1[3] * v1[3]);
                        s += __shfl_xor(s, 16); s += __shfl_xor(s, 32); mx = fmaxf(mx, s); }
#pragma unroll
                for (int o = 1; o < 16; o <<= 1) mx = fmaxf(mx, __shfl_xor(mx, o));
                if ((fr | fq) == 0) atomicMax(nrm + (((u.pm >> 4) * 4 + u.pn) * 4 + 2 * bj + (wc >> 1)) * 2 + (wc & 1), __builtin_bit_cast(unsigned, mx)); }
        }
    }
};
__device__ __forceinline__ void attn_phase(Frame& F, char* shm, int qoff = 0, int gmask = 7) {
    using namespace attn_body;
    const attn_body::bf16* P = (const attn_body::bf16*)(F.ws + WS_P);
    attn_body::bf16* OD = (attn_body::bf16*)(F.ws + WS_OD);
    attn_body::bf16* mix = (attn_body::bf16*)(F.ws + WS_MIX);
    attn_body::bf16* ODIL = (attn_body::bf16*)(F.ws + WS_ODIL); float* LSEb = (float*)(F.ws + WS_LSE);
    const attn_body::bf16* MKV = (const attn_body::bf16*)(F.ws + WS_MKV);
    const float* nrm = (const float*)(F.ctl + CW_NRM);
    const int grp = (int)blockIdx.x & 7, b = grp;
    unsigned* qctr = (unsigned*)(F.ctl + CW_Q + qoff) + 64 * grp;
    const attn_body::bf16* Pb = P + (size_t)b * SEQ * DIN;
    unsigned nxt_tok = 0u;
    if (F.tid == 0) nxt_tok = __hip_atomic_fetch_add(qctr, 1u, __ATOMIC_RELAXED, __HIP_MEMORY_SCOPE_AGENT);
    for (;;) {
        if (F.tid == 0) F.MISC[20] = nxt_tok;
        __syncthreads();
        int un = (int)F.MISC[20];
        __syncthreads();
        if (F.tid == 0 && un < NCONV + 384) nxt_tok = __hip_atomic_fetch_add(qctr, 1u, __ATOMIC_RELAXED, __HIP_MEMORY_SCOPE_AGENT);
        if (un < NCONV) { if (gmask == 7) p0b_unit(F, grp * NCONV + un); continue; }
        un -= NCONV;
        if (un >= 384) break;
        if (un < 128) {
            if (!(gmask & 1)) continue;
            const int qb = 15 - (un >> 3), h = 3 - ((un >> 1) & 3), j = un & 1;
            const float slope2 = exp2f(-(float)(2 * h + 1)) * LOG2E;
            const int ni = ((b * 4 + (h >> 1)) * 4 + 2 * (h & 1) + j) * 2;
            const float R = sqrtf((nrm[ni] + nrm[ni + 1]) * (nrm[ni + 16] + nrm[ni + 17])) * 1.01f;
            const float kfirst = (float)(qb * 256) - (2.f * R + 160.f) / slope2;
            int t0 = kfirst > 0.f ? (int)(kfirst * (1.f / 64.f)) : 0; t0 = min(t0, 4 * qb); t0 &= ~1;
            UnitP U; U.Q = Pb + C_DQ + h * 128 + j * 64; U.K = Pb + C_DK + h * 128 + j * 64; U.V = Pb + C_DV + h * 128;
            U.O = OD + (size_t)b * SEQ * 1024 + h * 256 + j * 128; U.qp = DIN; U.kp = DIN; U.op = 1024;
            U.q0 = qb * 256; U.t0 = t0; U.NT = 4 * qb + 4 - t0; U.slope2 = slope2; U.lse = nullptr; U.lse_stride = 0;
            attn_unit<32, true, false, true, false, 128>(U, shm);
        } else if (un < 320) {
            if (!(gmask & 2)) continue;
            const int du = un - 128, h = du / 48, idx = du % 48, n = idx >> 4, w = idx & 15;
            const int r = (n == 0) ? 1 : (n == 1 ? 4 : 16), c = (n == 0) ? 0 : (n == 1 ? (w >> 2) : w), blk = (n == 0) ? w : (n == 1 ? (w & 3) : 0);
            const attn_body::bf16* Pc = Pb + (size_t)c * DIN;
            UnitP U; U.Q = Pc + C_LQ + h * 64; U.K = Pc + C_LK + h * 64; U.V = Pc + C_LV + h * 64; U.qp = (long)r * DIN; U.kp = (long)r * DIN;
            U.O = ODIL + (size_t)n * T * 256 + ((size_t)b * SEQ + c) * 256 + h * 64; U.op = (long)r * 256;
            U.q0 = blk * 256; U.t0 = (blk == 0) ? 0 : 4 * blk - 2; U.NT = 4 * blk + 4 - U.t0;
            U.slope2 = exp2f(-(float)(2 * h + 2)) * (float)r * LOG2E;
            U.lse = LSEb + (size_t)n * T * 4 + ((size_t)b * SEQ + c) * 4 + h; U.lse_stride = r * 4;
            attn_unit<32, true, true, true, true>(U, shm);
        } else {
            if (!(gmask & 4)) continue;
            const int mu = un - 320, h = mu >> 4, qb = mu & 15;
            UnitP U; U.Q = Pb + C_MQ + h * 64; U.qp = DIN; U.K = MKV + (size_t)b * NMEM * 512 + h * 64; U.V = U.K + 256; U.kp = 512;
            U.O = mix + (size_t)b * SEQ * 1024 + 768 + h * 64; U.op = 1024; U.q0 = qb * 256; U.t0 = 0; U.NT = 4; U.slope2 = 0.f; U.lse = nullptr; U.lse_stride = 0;
            attn_unit<8, false, false, false, false>(U, shm);
        }
    }
}
__device__ __forceinline__ void dil_combine_phase(Frame& F) {
    const int gw = F.vcu * NWAVES + F.wave, NGW = F.G * NWAVES;
    const bf16* OD = (const bf16*)(F.ws + WS_OD); const bf16* ODIL = (const bf16*)(F.ws + WS_ODIL); const float* LSEb = (const float*)(F.ws + WS_LSE); bf16* mix = (bf16*)(F.ws + WS_MIX);
    const int h = F.lane >> 4, pt = F.lane & 15, d4 = pt * 4;
    float lam;
    { const float a = F.lamqk[F.lane] * F.lamqk[64 + F.lane], c = F.lamqk[128 + F.lane] * F.lamqk[192 + F.lane];
      lam = __expf(wave_sum(a)) - __expf(wave_sum(c)) + 0.2f; }
    float gsub[8];
#pragma unroll
    for (int i = 0; i < 8; ++i) gsub[i] = F.subg[pt * 8 + i] * 0.8f;
    for (int row0 = 4 * gw; row0 < T; row0 += 4 * NGW) {
        float l[4][3]; v2u q[4][3]; v4u o1[4], o2[4];
#pragma unroll
        for (int i = 0; i < 4; ++i) {
            o1[i] = *(const v4u*)(OD + (size_t)(row0 + i) * 1024 + h * 256 + pt * 8); o2[i] = *(const v4u*)(OD + (size_t)(row0 + i) * 1024 + h * 256 + 128 + pt * 8);
#pragma unroll
            for (int n = 0; n < 3; ++n) { l[i][n] = LSEb[(size_t)n * T * 4 + (size_t)(row0 + i) * 4 + h]; q[i][n] = *(const v2u*)(ODIL + (size_t)n * T * 256 + (size_t)(row0 + i) * 256 + h * 64 + d4); } }
#pragma unroll
        for (int i = 0; i < 4; ++i) {
            const unsigned aw[4] = {o1[i].x, o1[i].y, o1[i].z, o1[i].w}, bw[4] = {o2[i].x, o2[i].y, o2[i].z, o2[i].w};
            float d[8], ss = 0.f;
#pragma unroll
            for (int c = 0; c < 4; ++c) { d[2 * c] = bflo(aw[c]) - lam * bflo(bw[c]); d[2 * c + 1] = bfhi(aw[c]) - lam * bfhi(bw[c]); ss += d[2 * c] * d[2 * c] + d[2 * c + 1] * d[2 * c + 1]; }
#pragma unroll
            for (int o = 1; o < 16; o <<= 1) ss += __shfl_xor(ss, o);
            const float rstd = 1.f / sqrtf(ss * (1.f / 128.f) + EPS);
            v4u od; od.x = pk2(d[0] * rstd * gsub[0], d[1] * rstd * gsub[1]); od.y = pk2(d[2] * rstd * gsub[2], d[3] * rstd * gsub[3]); od.z = pk2(d[4] * rstd * gsub[4], d[5] * rstd * gsub[5]); od.w = pk2(d[6] * rstd * gsub[6], d[7] * rstd * gsub[7]);
            *(v4u*)(mix + (size_t)(row0 + i) * 1024 + h * 128 + pt * 8) = od;
            const float m = fmaxf(fmaxf(l[i][0], l[i][1]), l[i][2]);
            float wn[3], den = 0.f;
#pragma unroll
            for (int n = 0; n < 3; ++n) { wn[n] = exp2f(l[i][n] - m); den += wn[n]; }
            const float inv = 1.f / den; float o[4] = {0.f, 0.f, 0.f, 0.f};
#pragma unroll
            for (int n = 0; n < 3; ++n) { const float wq = wn[n] * inv; o[0] += wq * bflo(q[i][n].x); o[1] += wq * bfhi(q[i][n].x); o[2] += wq * bflo(q[i][n].y); o[3] += wq * bfhi(q[i][n].y); }
            v2u ov; ov.x = pk2(o[0], o[1]); ov.y = pk2(o[2], o[3]);
            *(v2u*)(mix + (size_t)(row0 + i) * 1024 + 512 + h * 64 + d4) = ov;
        }
    }
}
struct EpiY {
    bf16* Y;
    __device__ __forceinline__ void operator()(const pg8::f32x4 (&acc)[2][2][4][2], const pg8::Unit& u, int wr, int wc, int fr, int fq, const LAS unsigned*) const {
        asm volatile("" : "+v"(fr), "+v"(fq));
        const int row0 = u.pm * 256 + wr * 64 + fr, col0 = u.pn * 256 + wc * 32 + 8 * fq;
#pragma unroll
        for (int ai = 0; ai < 2; ++ai)
#pragma unroll
            for (int m = 0; m < 4; ++m) { bf16* rowp = Y + (size_t)(row0 + ai * 128 + m * 16) * D + col0;
#pragma unroll
                for (int bj = 0; bj < 2; ++bj) { const pg8::f32x4 v0 = acc[ai][bj][m][0], v1 = acc[ai][bj][m][1];
                    v4u w; w.x = pg8::cvt_pk_bf16(v0[0], v0[1]); w.y = pg8::cvt_pk_bf16(v0[2], v0[3]); w.z = pg8::cvt_pk_bf16(v1[0], v1[1]); w.w = pg8::cvt_pk_bf16(v1[2], v1[3]);
                    *(v4u*)(rowp + bj * 128) = w; } }
    }
};

__device__ __forceinline__ void route_phase(Frame& F) {
    LAS float* xch = (LAS float*)(F.lds + RING_OFF);
    LAS unsigned* lcnt = (LAS unsigned*)(F.lds + LCNT_OFF);
    LAS unsigned* stg = (LAS unsigned*)(F.lds + STG_OFF);
    if (F.tid < 64) lcnt[F.tid] = 0u;
    const int lane = F.lane, tl = lane & 31, h = lane >> 5, tg = F.wave & 3, kh = F.wave >> 2;
    { const v4u* wsrc = (const v4u*)(F.ws + WS_WRT); LAS char* wl = (LAS char*)(F.lds + RING_OFF);
      for (int i = F.tid; i < 2 * 32 * 128; i += NWAVES * 64) { const int hl = i >> 12, e = (i >> 7) & 31, c = i & 127; *(LAS v4u*)(wl + hl * 65536 + e * 2048 + ((c ^ (e & 15)) << 4)) = wsrc[i]; } }
    __syncthreads();
    const int tok = F.vcu * 128 + tg * 32 + tl;
    const float* xr = F.x + (size_t)tok * D + kh * 512 + 8 * h;
    const bf16* yr = (const bf16*)(F.ws + WS_Y) + (size_t)tok * D + kh * 512 + 8 * h;
    unsigned char* x1r = (unsigned char*)(F.ws + WS_X1B) + (size_t)tok * D + kh * 512 + 8 * h;
    bf16* x1h = (bf16*)(F.ws + WS_X1H) + (size_t)tok * D + kh * 512 + 8 * h;
    const LAS char* wrow = (const LAS char*)(F.lds + RING_OFF) + tl * 2048;
    f32x16 acc = {}; float ss = 0.f;
    f32x4 xa[2][8]; v4u ya[2][4];
#define RT_LOAD(buf, g) do { _Pragma("unroll") for (int q_ = 0; q_ < 4; ++q_) { xa[buf][2 * q_] = *(const f32x4*)(xr + 64 * (g) + 16 * q_); xa[buf][2 * q_ + 1] = *(const f32x4*)(xr + 64 * (g) + 16 * q_ + 4); \
        ya[buf][q_] = *(const v4u*)(yr + 64 * (g) + 16 * q_); } } while (0)
#define RT_COMP(buf, g) do { _Pragma("unroll") for (int q_ = 0; q_ < 4; ++q_) { const int c_ = (kh * 512 + 64 * (g) + 16 * q_) / 8 + h; \
        const v4u wh = *(const LAS v4u*)(wrow + ((c_ ^ (tl & 15)) << 4)), wl2 = *(const LAS v4u*)(wrow + 65536 + ((c_ ^ (tl & 15)) << 4)); \
        const f32x4 a0 = xa[buf][2 * q_], a1 = xa[buf][2 * q_ + 1]; const v4u yv = ya[buf][q_]; \
        const float x1[8] = {a0.x + bflo(yv.x), a0.y + bfhi(yv.x), a0.z + bflo(yv.y), a0.w + bfhi(yv.y), a1.x + bflo(yv.z), a1.y + bfhi(yv.z), a1.z + bflo(yv.w), a1.w + bfhi(yv.w)}; \
        unsigned hw[4], lw[4]; \
        _Pragma("unroll") for (int p_ = 0; p_ < 4; ++p_) { const float u_ = x1[2 * p_], r_ = x1[2 * p_ + 1]; ss += u_ * u_ + r_ * r_; const unsigned hb = pk2(u_, r_); hw[p_] = hb; lw[p_] = pk2(u_ - bflo(hb), r_ - bfhi(hb)); } \
        const v4u xh = (v4u){hw[0], hw[1], hw[2], hw[3]}, xl = (v4u){lw[0], lw[1], lw[2], lw[3]}; \
        { v2u o8_; o8_.x = fp8x4(x1[0], x1[1], x1[2], x1[3]); o8_.y = fp8x4(x1[4], x1[5], x1[6], x1[7]); *(v2u*)(x1r + 64 * (g) + 16 * q_) = o8_; *(v4u*)(x1h + 64 * (g) + 16 * q_) = xh; } \
        acc = __builtin_amdgcn_mfma_f32_32x32x16_bf16(__builtin_bit_cast(bf16x8, wh), __builtin_bit_cast(bf16x8, xh), acc, 0, 0, 0); \
        acc = __builtin_amdgcn_mfma_f32_32x32x16_bf16(__builtin_bit_cast(bf16x8, wh), __builtin_bit_cast(bf16x8, xl), acc, 0, 0, 0); \
        acc = __builtin_amdgcn_mfma_f32_32x32x16_bf16(__builtin_bit_cast(bf16x8, wl2), __builtin_bit_cast(bf16x8, xh), acc, 0, 0, 0); } } while (0)
    RT_LOAD(0, 0);
#pragma unroll
    for (int g = 0; g < 8; g += 2) {
        RT_LOAD(1, g + 1); RT_COMP(0, g);
        if (g + 2 < 8) RT_LOAD(0, g + 2);
        RT_COMP(1, g + 1);
    }
#undef RT_LOAD
#undef RT_COMP
    __syncthreads();
    if (kh == 1) { LAS float* d = xch + (tg * 64 + lane) * 17;
#pragma unroll
        for (int i = 0; i < 16; ++i) d[i] = acc[i];
        d[16] = ss; }
    __syncthreads();
    if (kh == 0) {
        const LAS float* d = xch + (tg * 64 + lane) * 17;
#pragma unroll
        for (int i = 0; i < 16; ++i) acc[i] += d[i];
        ss += d[16]; ss += __shfl_xor(ss, 32);
        const float rstd = 1.f / sqrtf(ss * (1.f / D) + EPS);
        float lg[16];
#pragma unroll
        for (int i = 0; i < 16; ++i) lg[i] = acc[i] * rstd + F.b_r[4 * h + (i & 3) + 8 * (i >> 2)];
        float cv[8]; int ce[8];
#pragma unroll
        for (int k = 0; k < 4; ++k) { float bv = -INFINITY; int bi = 0;
#pragma unroll
            for (int i = 0; i < 16; ++i) { if (lg[i] > bv) { bv = lg[i]; bi = i; } }
            cv[k] = bv; ce[k] = 4 * h + (bi & 3) + 8 * (bi >> 2);
#pragma unroll
            for (int i = 0; i < 16; ++i) if (i == bi) lg[i] = -INFINITY; }
#pragma unroll
        for (int k = 0; k < 4; ++k) { cv[4 + k] = __shfl_xor(cv[k], 32); ce[4 + k] = __shfl_xor(ce[k], 32); }
        float tv[4]; int te[4];
#pragma unroll
        for (int k = 0; k < 4; ++k) { float bv = -INFINITY; int be = 64, bi = 0;
#pragma unroll
            for (int i = 0; i < 8; ++i) { if (cv[i] > bv || (cv[i] == bv && ce[i] < be)) { bv = cv[i]; be = ce[i]; bi = i; } }
            tv[k] = bv; te[k] = be;
#pragma unroll
            for (int i = 0; i < 8; ++i) if (i == bi) cv[i] = -INFINITY; }
        float gk[4], den = 0.f;
#pragma unroll
        for (int k = 0; k < 4; ++k) { gk[k] = __expf(tv[k] - tv[0]); den += gk[k]; }
        const float inv = 1.f / den;
        if (h == 0) {
#pragma unroll
            for (int k = 0; k < 4; ++k) {
                const unsigned rank = __hip_atomic_fetch_add(lcnt + te[k], 1u, __ATOMIC_RELAXED, __HIP_MEMORY_SCOPE_WORKGROUP);
                const int slot = (tg * 32 + tl) * 4 + k;
                stg[slot * 4] = (unsigned)(tok * 4 + k); stg[slot * 4 + 1] = ((unsigned)te[k] << 16) | rank; stg[slot * 4 + 2] = __builtin_bit_cast(unsigned, gk[k] * inv); stg[slot * 4 + 3] = __builtin_bit_cast(unsigned, rstd);
            }
        }
    }
    __syncthreads();
    if (F.tid < 32) { const unsigned n = lcnt[F.tid]; lcnt[32 + F.tid] = n ? __hip_atomic_fetch_add((unsigned*)(F.ctl + CW_CNT) + F.tid, n, __ATOMIC_RELAXED, __HIP_MEMORY_SCOPE_AGENT) : 0u; }
    __syncthreads();
    { unsigned* list = (unsigned*)(F.ws + WS_LIST); unsigned* lgate = (unsigned*)(F.ws + WS_LGATE); unsigned* lrstd = (unsigned*)(F.ws + WS_LRSTD);
      const unsigned ent = stg[F.tid * 4], er = stg[F.tid * 4 + 1], gb = stg[F.tid * 4 + 2], rb = stg[F.tid * 4 + 3]; const unsigned e = er >> 16, rank = er & 0xffffu;
      const size_t at = (size_t)e * LCAP + lcnt[32 + e] + rank; list[at] = ent; lgate[at] = gb; lrstd[at] = rb; }
    __syncthreads();
}

__device__ __forceinline__ int moe_build_table(Frame& F) {
    LAS unsigned* tbl = (LAS unsigned*)(F.lds + TBL_OFF); LAS unsigned* lcnt = (LAS unsigned*)(F.lds + LCNT_OFF);
    if (F.wave == 0) {
        const int e = F.lane & 31;
        const unsigned cnt = __hip_atomic_load((unsigned*)(F.ctl + CW_CNT) + e, __ATOMIC_RELAXED, __HIP_MEMORY_SCOPE_AGENT);
        const unsigned nt = (cnt + 255u) >> 8; unsigned incl = nt;
#pragma unroll
        for (int o = 1; o < 32; o <<= 1) { const unsigned t = __shfl_up(incl, o); if ((F.lane & 31) >= o) incl += t; }
        if (F.lane < 32) { lcnt[e] = cnt; const unsigned start = incl - nt; for (unsigned j = 0; j < nt; ++j) tbl[start + j] = ((unsigned)e << 16) | j; if (F.lane == 31) F.MISC[16] = incl; }
    }
    __syncthreads();
    return (int)F.MISC[16];
}
struct MoeOrder {
    const LAS unsigned* tbl; const LAS unsigned* lcnt; const unsigned* list; int NMT, G, c, NPN, MPER, RB; size_t bexp; bool a_tiles; const unsigned* lsc; const unsigned* bias; int bexp_f;
    __device__ __forceinline__ bool next(int i, pg8::Unit& u) const {
        const int L = i * G + c, blk = L >> 5, w = L & 31, g = blk * MPER + w / NPN, pn = w % NPN;
        if (g >= NMT) return false;
        const unsigned t = tbl[g]; const int e = (int)(t >> 16), mt = (int)(t & 0xffffu); const int cnt = (int)lcnt[e];
        u.pm = g; u.pn = pn; u.e = e; u.mt = mt; u.valid = min(256, cnt - mt * 256);
        u.aoff = a_tiles ? (size_t)g * (size_t)(256 * RB) : (size_t)0; u.boff = (size_t)e * bexp + (size_t)pn * (size_t)(256 * RB);
        return true;
    }
    __device__ __forceinline__ const unsigned* id_src(const pg8::Unit& u, int row) const { return list + (size_t)u.e * LCAP + u.mt * 256 + min(row, u.valid - 1); }
    __device__ __forceinline__ const unsigned* sc_src(const pg8::Unit& u, int row) const { return lsc + (size_t)u.e * LCAP + u.mt * 256 + min(row, u.valid - 1); }
    __device__ __forceinline__ const unsigned* bias_src(const pg8::Unit& u, int col) const { return bias + (size_t)u.e * bexp_f + u.pn * 256 + col; }
};
struct EpiGU {
    unsigned char* ACT;
    __device__ __forceinline__ void operator()(const pg8::f32x4 (&acc)[2][2][4][2], const pg8::Unit& u, int wr, int wc, int fr, int fq, const LAS unsigned* ids) const {
        asm volatile("" : "+v"(fr), "+v"(fq));
        const int r0 = wr * 64 + fr, f0 = u.pn * 128 + wc * 32 + 8 * fq;
        const LAS float* scl = (const LAS float*)(ids + 256); const LAS float* bl = (const LAS float*)(ids + 512) + 2 * (wc * 32 + 8 * fq);
        float rs[2][4];
#pragma unroll
        for (int ai = 0; ai < 2; ++ai)
#pragma unroll
            for (int m = 0; m < 4; ++m) rs[ai][m] = scl[r0 + ai * 128 + m * 16] * (1.f / WSCALE);
        const pg8::f32x4 b0 = *(const LAS pg8::f32x4*)bl, b1 = *(const LAS pg8::f32x4*)(bl + 4), b2 = *(const LAS pg8::f32x4*)(bl + 8), b3 = *(const LAS pg8::f32x4*)(bl + 12);
        const float gb[8] = {b0[0], b0[2], b1[0], b1[2], b2[0], b2[2], b3[0], b3[2]}, ub[8] = {b0[1], b0[3], b1[1], b1[3], b2[1], b2[3], b3[1], b3[3]};
#pragma unroll
        for (int ai = 0; ai < 2; ++ai)
#pragma unroll
            for (int m = 0; m < 4; ++m) { const int r = r0 + ai * 128 + m * 16; const float s = rs[ai][m]; float a[8];
#pragma unroll
                for (int n = 0; n < 2; ++n)
#pragma unroll
                    for (int j = 0; j < 4; ++j) { float gate = acc[ai][0][m][n][j] * s + gb[4 * n + j], up = acc[ai][1][m][n][j] * s + ub[4 * n + j];
                        gate = fminf(gate, 7.f); up = fminf(fmaxf(up, -7.f), 7.f);
                        a[4 * n + j] = ASCALE * (up + 1.f) * gate * __builtin_amdgcn_rcpf(1.f + __builtin_amdgcn_exp2f(-1.702f * LOG2E * gate)); }
                v2u w; w.x = fp8x4(a[0], a[1], a[2], a[3]); w.y = fp8x4(a[4], a[5], a[6], a[7]);
                *(v2u*)(ACT + (size_t)(u.pm * 256 + r) * DFF + f0) = w; }
    }
};
struct EpiDown {
    unsigned char* YB;
    __device__ __forceinline__ void operator()(const pg8::f32x4 (&acc)[2][2][4][2], const pg8::Unit& u, int wr, int wc, int fr, int fq, const LAS unsigned* ids) const {
        asm volatile("" : "+v"(fr), "+v"(fq));
        const int r0 = wr * 64 + fr, cl = wc * 32 + 8 * fq, col0 = u.pn * 256 + cl;
        const LAS float* scl = (const LAS float*)(ids + 256); const LAS float* bl = (const LAS float*)(ids + 512) + cl;
        pg8::f32x4 bv[2][2];
#pragma unroll
        for (int bj = 0; bj < 2; ++bj)
#pragma unroll
            for (int n = 0; n < 2; ++n) bv[bj][n] = *(const LAS pg8::f32x4*)(bl + bj * 128 + 4 * n);
#pragma unroll
        for (int ai = 0; ai < 2; ++ai)
#pragma unroll
            for (int m = 0; m < 4; ++m) { const int r = r0 + ai * 128 + m * 16; if (r < u.valid) { const float g = scl[r] * YSCALE; unsigned char* yp = YB + (size_t)ids[r] * D + col0;
#pragma unroll
                for (int bj = 0; bj < 2; ++bj) { const pg8::f32x4 v0 = (acc[ai][bj][m][0] * (1.f / (WSCALE * ASCALE)) + bv[bj][0]) * g, v1 = (acc[ai][bj][m][1] * (1.f / (WSCALE * ASCALE)) + bv[bj][1]) * g;
                    v2u w; w.x = fp8x4(v0[0], v0[1], v0[2], v0[3]); w.y = fp8x4(v1[0], v1[1], v1[2], v1[3]);
                    *(v2u*)(yp + bj * 128) = w; } } }
    }
};
__device__ __forceinline__ void final_phase(Frame& F) {
    const int gw = F.vcu * NWAVES + F.wave, NGW = F.G * NWAVES;
    const unsigned char* YB = (const unsigned char*)(F.ws + WS_YB); const bf16* X1 = (const bf16*)(F.ws + WS_X1H);
    const int c = 16 * F.lane;
    f32x4 gf[4];
#pragma unroll
    for (int q = 0; q < 4; ++q) gf[q] = *(const f32x4*)(F.g_fin + c + 4 * q);
    for (int t = gw; t < T; t += NGW) {
        const v4u xa = *(const v4u*)(X1 + (size_t)t * D + c), xb = *(const v4u*)(X1 + (size_t)t * D + c + 8);
        v4u y[4];
#pragma unroll
        for (int k = 0; k < 4; ++k) y[k] = *(const v4u*)(YB + ((size_t)t * 4 + k) * D + c);
        float v[16];
        { const unsigned xw[8] = {xa.x, xa.y, xa.z, xa.w, xb.x, xb.y, xb.z, xb.w};
#pragma unroll
          for (int q = 0; q < 8; ++q) { v[2 * q] = bflo(xw[q]); v[2 * q + 1] = bfhi(xw[q]); } }
#pragma unroll
        for (int k = 0; k < 4; ++k) { const unsigned yw[4] = {y[k].x, y[k].y, y[k].z, y[k].w};
#pragma unroll
            for (int q = 0; q < 4; ++q) { const auto lo = __builtin_amdgcn_cvt_pk_f32_fp8((int)yw[q], false), hi = __builtin_amdgcn_cvt_pk_f32_fp8((int)yw[q], true);
                v[4 * q] += lo[0] * (1.f / YSCALE); v[4 * q + 1] += lo[1] * (1.f / YSCALE); v[4 * q + 2] += hi[0] * (1.f / YSCALE); v[4 * q + 3] += hi[1] * (1.f / YSCALE); } }
        float ss = 0.f;
#pragma unroll
        for (int i = 0; i < 16; ++i) ss += v[i] * v[i];
        const float rstd = 1.f / sqrtf(wave_sum(ss) * (1.f / D) + EPS);
#pragma unroll
        for (int q = 0; q < 4; ++q) { f32x4 o; o.x = v[4 * q] * rstd * gf[q].x; o.y = v[4 * q + 1] * rstd * gf[q].y; o.z = v[4 * q + 2] * rstd * gf[q].z; o.w = v[4 * q + 3] * rstd * gf[q].w;
            *(f32x4*)(F.out + (size_t)t * D + c + 4 * q) = o; }
    }
}
struct Args { const float* in[17]; float* out; unsigned char* ws; int ph_lo, ph_hi, use_bar, pad; };
__global__ void __launch_bounds__(NWAVES * 64, 2) mk_fwd(Args args) {
    extern __shared__ __attribute__((aligned(16))) unsigned char lds[];
    Frame F;
    F.lds = (LAS unsigned char*)lds;
    F.MISC = (volatile LAS unsigned*)(F.lds + MISC_OFF);
    F.tid = threadIdx.x; F.lane = F.tid & 63; F.wave = __builtin_amdgcn_readfirstlane(F.tid >> 6);
    F.G = gridDim.x; { const int bx = blockIdx.x; F.vcu = (F.G % 8 == 0) ? (bx % 8) * (F.G / 8) + bx / 8 : bx; }
    F.ws = args.ws; F.out = args.out; F.ctl = (gu32*)(args.ws + WS_CTL);
    F.x = args.in[0]; F.mem = args.in[1]; F.g_attn = args.in[2]; F.g_mem = args.in[3]; F.w_in = args.in[4]; F.lamqk = args.in[5]; F.subg = args.in[6]; F.w_mkv = args.in[7];
    F.w_out = args.in[8]; F.g_ffn = args.in[9]; F.w_r = args.in[10]; F.b_r = args.in[11]; F.w_gu = args.in[12]; F.b_gu = args.in[13]; F.w_dn = args.in[14]; F.b_dn = args.in[15]; F.g_fin = args.in[16];
    for (int u = F.tid; u < (LDS_BYTES - LDSCTL_OFF) / 4; u += NWAVES * 64) ((LAS unsigned*)(F.lds + LDSCTL_OFF))[u] = 0u;
    __syncthreads();
    XcdBarrier bar; bar.bar = (unsigned*)(F.ctl + CW_BAR); bar.x = 0; bar.st = nullptr;
    if (args.use_bar) bar = xcd_barrier_post((unsigned*)(F.ctl + CW_BAR), F.MISC + 8);
    const int lo = args.ph_lo, hi = args.ph_hi;
#define IN(k) (lo <= (k) && (k) < hi)
#define SEAM(k) do { if (IN(k) && IN((k) + 1)) xcd_barrier(bar); } while (0)
    if (IN(0)) { p0_prologue(F); } SEAM(0);
    if (IN(1)) {
        pg8::Gemm g{(const void*)(F.ws + WS_XB), (const void*)(F.ws + WS_WIN), 2 * D}; pg8::StaticOrder S; S.init(T, DIN, 2 * D, F.G, (int)blockIdx.x, (const unsigned*)(F.ws + WS_RSTD1));
        EpiInProj E{(bf16*)(F.ws + WS_P), (const float*)(F.ws + WS_RSTD1), (unsigned*)(F.ctl + CW_NRM)};
        pg8::gemm_phase<EpiInProj, pg8::StaticOrder, true, false, true>(F.lds + RING_OFF, (LAS unsigned*)(F.lds + IDB_OFF), g, S, E);
    } SEAM(1);
    if (IN(2)) { attn_phase(F, (char*)lds + RING_OFF); } SEAM(2);
    if (IN(3)) { dil_combine_phase(F); } SEAM(3);
    if (IN(4)) {
        pg8::Gemm g{(const void*)(F.ws + WS_MIX), (const void*)(F.ws + WS_WOUT), 2 * D}; pg8::StaticOrder S; S.init(T, D, 2 * D, F.G, (int)blockIdx.x);
        EpiY E{(bf16*)(F.ws + WS_Y)};
        pg8::gemm_phase<EpiY, pg8::StaticOrder, true, false, false>(F.lds + RING_OFF, (LAS unsigned*)(F.lds + IDB_OFF), g, S, E);
    } SEAM(4);
    if (IN(5)) { route_phase(F); } SEAM(5);
    if (IN(6)) {
        const int nmt = moe_build_table(F);
        pg8::Gemm g{(const void*)(F.ws + WS_X1B), (const void*)(F.ws + WS_WGU), D};
        MoeOrder S{(const LAS unsigned*)(F.lds + TBL_OFF), (const LAS unsigned*)(F.lds + LCNT_OFF), (const unsigned*)(F.ws + WS_LIST), nmt, F.G, F.vcu, 8, 4, D, (size_t)2 * DFF * D, false, (const unsigned*)(F.ws + WS_LRSTD), (const unsigned*)F.b_gu, 2 * DFF};
        EpiGU E{(unsigned char*)(F.ws + WS_ACT)};
        pg8::gemm_phase<EpiGU, MoeOrder, true, true, true, true>(F.lds + RING_OFF, (LAS unsigned*)(F.lds + IDB_OFF), g, S, E);
    } SEAM(6);
    if (IN(7)) {
        const int nmt = moe_build_table(F);
        pg8::Gemm g{(const void*)(F.ws + WS_ACT), (const void*)(F.ws + WS_WDN), DFF};
        MoeOrder S{(const LAS unsigned*)(F.lds + TBL_OFF), (const LAS unsigned*)(F.lds + LCNT_OFF), (const unsigned*)(F.ws + WS_LIST), nmt, F.G, F.vcu, 4, 8, DFF, (size_t)D * DFF, true, (const unsigned*)(F.ws + WS_LGATE), (const unsigned*)F.b_dn, D};
        EpiDown E{(unsigned char*)(F.ws + WS_YB)};
        pg8::gemm_phase<EpiDown, MoeOrder, true, true, true, true, true>(F.lds + RING_OFF, (LAS unsigned*)(F.lds + IDB_OFF), g, S, E);
    } SEAM(7);
    if (IN(8)) { final_phase(F); }
#undef IN
#undef SEAM
}

static void launch_phases(const Args& base, int lo, int hi, int use_bar, int grid, hipStream_t stream) {
    Args a = base; a.ph_lo = lo; a.ph_hi = hi; a.use_bar = use_bar;
    hipLaunchKernelGGL(mk_fwd, dim3(grid), dim3(NWAVES * 64), LDS_BYTES, stream, a);
}
extern "C" void kernel_launch(void* const* d_in, const int* in_sizes, int n_in, void* d_out, int out_size, void* d_ws, size_t ws_size, hipStream_t stream) {
    static int grid = 0;
    if (grid == 0) {
        if (n_in != 17 || in_sizes[0] != T * D || out_size != T * D || ws_size < (size_t)1000 * MiB) { fprintf(stderr, "kernel_launch: unexpected shapes / workspace (%d inputs, ws %zu)\n", n_in, ws_size); grid = -1; return; }
        int dev = 0, cus = 0, per_cu = 0;
        if (hipGetDevice(&dev) != hipSuccess || hipDeviceGetAttribute(&cus, hipDeviceAttributeMultiprocessorCount, dev) != hipSuccess) { grid = -1; return; }
        if (hipFuncSetAttribute((const void*)mk_fwd, hipFuncAttributeMaxDynamicSharedMemorySize, LDS_BYTES) != hipSuccess) { fprintf(stderr, "kernel_launch: hipFuncSetAttribute failed\n"); grid = -1; return; }
        if (hipOccupancyMaxActiveBlocksPerMultiprocessor(&per_cu, (const void*)mk_fwd, NWAVES * 64, LDS_BYTES) != hipSuccess || per_cu < 1) { fprintf(stderr, "kernel_launch: occupancy query says %d blocks per CU\n", per_cu); per_cu = 1; }
        (void)hipGetLastError();
        grid = cus;
        if (grid != 256) { fprintf(stderr, "kernel_launch: built for a 256-CU device (got %d)\n", cus); grid = -1; return; }
    }
    if (grid < 0) return;
    (void)hipMemsetAsync((char*)d_ws + WS_CTL, 0, CTL_ZERO_BYTES, stream);
    Args a{};
    for (int i = 0; i < 17; ++i) a.in[i] = (const float*)d_in[i];
    a.out = (float*)d_out; a.ws = (unsigned char*)d_ws;
    launch_phases(a, 0, 9, 1, grid, stream);
}
```

```cpp
#include <hip/hip_runtime.h>
#include <hip/hip_bf16.h>
#include <cstdint>
#include <cstdio>
#include <cmath>

constexpr int D = 1024, BATCH = 8, SEQ = 4096, T = BATCH * SEQ, DIN = 2560, NMEM = 256, NE = 32, DFF = 1024;
constexpr int C_DQ = 0, C_DK = 512, C_DV = 1024, C_LQ = 1536, C_LK = 1792, C_LV = 2048, C_MQ = 2304;
constexpr float EPS = 1e-5f;
constexpr int LCAP = T;
constexpr float QSCALE = 0.125f * 1.4426950408889634f;
constexpr float LOG2E = 1.4426950408889634f;
namespace pg8 {
#define PG8_LAS __attribute__((address_space(3)))
typedef unsigned short bf16_t;
typedef short bf16x8 __attribute__((ext_vector_type(8)));
typedef float f32x4 __attribute__((ext_vector_type(4)));
typedef unsigned u32x4 __attribute__((ext_vector_type(4)));
typedef unsigned u32x2 __attribute__((ext_vector_type(2)));
constexpr int BM = 256, BK = 64, HALF = 128, HTB = HALF * BK * 2  , STAGE_BYTES = 8 * HTB, NXCD = 8, WGM = 8;

__host__ __device__ __forceinline__ int lds_byte(int r, int c) { const int st = (r >> 4) * 2 + (c >> 5), rr = r & 15, cc = c & 31, ob = rr * 64 + cc * 2; return st * 1024 + (ob ^ (((ob >> 9) & 1) << 5)); }
__host__ __device__ __forceinline__ void stage_rc(int b, int& R, int& C) { const int st = b / 1024, sb = b % 1024, swz = sb ^ (((sb >> 9) & 1) << 5); R = (st >> 1) * 16 + swz / 64; C = (st & 1) * 32 + (swz % 64) / 2; }
__host__ __device__ __forceinline__ int perm32(int rho) { const int n = rho >> 4, i = rho & 15; return 8 * (i >> 2) + 4 * n + (i & 3); }

struct Unit { size_t aoff, boff; int pm, pn, e, valid, mt; };
struct Gemm { const void* A; const void* Bt; int RB; };
typedef int v8i __attribute__((ext_vector_type(8)));

struct StaticOrder {
    int nM, nN, nwg, G, c, RB; const unsigned* sc;
    __device__ void init(int M, int N, int RB_, int G_, int c_, const unsigned* sc_ = nullptr) { nM = M / BM; nN = N / BM; nwg = nM * nN; G = G_; c = c_; RB = RB_; sc = sc_; }
    __device__ bool next(int i, Unit& u) const {
        const long L = (long)i * G + c; if (L >= nwg) return false;
        int wgid = (int)L; { const int q = nwg / NXCD, r = nwg % NXCD, xcd = wgid % NXCD, off = wgid / NXCD; wgid = (xcd < r ? xcd * (q + 1) : r * (q + 1) + (xcd - r) * q) + off; }
        const int nig = WGM * nN, gid = wgid / nig, fm = gid * WGM, gsz = (nM - fm) < WGM ? (nM - fm) : WGM;
        u.pm = fm + ((wgid % nig) % gsz); u.pn = (wgid % nig) / gsz; u.e = 0; u.valid = 256; u.mt = 0;
        u.aoff = (size_t)u.pm * (size_t)(BM * RB); u.boff = (size_t)u.pn * (size_t)(BM * RB); return true;
    }
    __device__ __forceinline__ const unsigned* id_src(const Unit& u, int row) const { return sc + u.pm * 256 + row; }
    __device__ __forceinline__ const unsigned* sc_src(const Unit& u, int row) const { return sc + u.pm * 256 + row; }
    __device__ __forceinline__ const unsigned* bias_src(const Unit& u, int row) const { return sc + u.pm * 256 + row; }
};

__device__ __forceinline__ unsigned cvt_pk_bf16(float lo, float hi) { unsigned r; asm volatile("v_cvt_pk_bf16_f32 %0, %1, %2" : "=v"(r) : "v"(lo), "v"(hi)); return r; }

template <class Epi, class Sched, bool ALIGN_EPI, bool GATHER, bool IDS, bool FP8 = false, bool LINEAR = false>
__device__ __forceinline__ void gemm_phase(PG8_LAS unsigned char* lds, PG8_LAS unsigned* idb, const Gemm g, const Sched& S, const Epi& E) {
    const int tid = threadIdx.x, wid = __builtin_amdgcn_readfirstlane(tid >> 6), lane = tid & 63, wr = wid >> 2, wc = wid & 3, fr = lane & 15, fq = lane >> 4;
    const int RB = g.RB; int nt = RB / (BK * 2); asm volatile("" : "+s"(nt));
    unsigned voffA[2], voffB[2]; int RA[2], CA[2];
#pragma unroll
    for (int i = 0; i < 2; ++i) { int R, C; stage_rc(tid * 16 + i * 8192, R, C); const int Rb = (R & ~31) + perm32(R & 31); RA[i] = R; CA[i] = C;
        voffA[i] = (unsigned)(R * RB + C * 2); voffB[i] = (unsigned)(Rb * RB + C * 2); }
    const size_t kstep = (size_t)(BK * 2);
    const size_t hstep = (size_t)HALF * RB;
    const unsigned ldsw = (unsigned)wid * 1024u;
    const int aoff = lds_byte(wr * 64 + fr, fq * 8), boff = lds_byte(wc * 32 + fr, fq * 8);
#define PG8_SA(b, h) (((b) * 2 + (h)) * HTB)
#define PG8_SB(b, h) ((4 + (b) * 2 + (h)) * HTB)
#define PG8_STAGE(bufoff, gbase, voff) do { _Pragma("unroll") for (int _i = 0; _i < 2; ++_i) \
        __builtin_amdgcn_global_load_lds((const unsigned*)((const char*)(gbase) + (voff)[_i]), (PG8_LAS unsigned*)(lds + (bufoff) + ldsw + _i * 8192), 16, 0, 0); } while (0)
#define PG8_STAGE_A(bufoff, pbase, gbase, h, gv) do { if constexpr (GATHER) { PG8_STAGE(bufoff, gbase, gv[h]); } else { PG8_STAGE(bufoff, (pbase) + (h) * hstep, voffA); } } while (0)
#define PG8_LD32(p0_, p1_) __builtin_bit_cast(v8i, __builtin_shufflevector(*(const PG8_LAS u32x4*)(p0_), *(const PG8_LAS u32x4*)(p1_), 0, 1, 2, 3, 4, 5, 6, 7))
#define PG8_LDA(dst, b, h) do { if constexpr (FP8) { _Pragma("unroll") for (int m = 0; m < 4; ++m) dst##8[m] = PG8_LD32(lds + PG8_SA(b, h) + aoff + m * 2048, lds + PG8_SA(b, h) + aoff + m * 2048 + 1024); } \
        else { _Pragma("unroll") for (int m = 0; m < 4; ++m) _Pragma("unroll") for (int k = 0; k < 2; ++k) dst[m][k] = *(const PG8_LAS bf16x8*)(lds + PG8_SA(b, h) + aoff + m * 2048 + k * 1024); } } while (0)
#define PG8_LDB(dst, b, h) do { if constexpr (FP8) { _Pragma("unroll") for (int n = 0; n < 2; ++n) dst##8[n] = PG8_LD32(lds + PG8_SB(b, h) + boff + n * 2048, lds + PG8_SB(b, h) + boff + n * 2048 + 1024); } \
        else { _Pragma("unroll") for (int n = 0; n < 2; ++n) _Pragma("unroll") for (int k = 0; k < 2; ++k) dst[n][k] = *(const PG8_LAS bf16x8*)(lds + PG8_SB(b, h) + boff + n * 2048 + k * 1024); } } while (0)
#define PG8_MMA(ai, bj, At, Bt) do { __builtin_amdgcn_s_setprio(1); if constexpr (FP8) { _Pragma("unroll") for (int m = 0; m < 4; ++m) _Pragma("unroll") for (int n = 0; n < 2; ++n) \
        acc[ai][bj][m][n] = __builtin_amdgcn_mfma_scale_f32_16x16x128_f8f6f4(Bt##8[n], At##8[m], acc[ai][bj][m][n], 0, 0, 0, sca_, 0, 0x7f7f7f7f); } \
        else { _Pragma("unroll") for (int m = 0; m < 4; ++m) _Pragma("unroll") for (int n = 0; n < 2; ++n) _Pragma("unroll") for (int k = 0; k < 2; ++k) \
        acc[ai][bj][m][n] = __builtin_amdgcn_mfma_f32_16x16x32_bf16(Bt[n][k], At[m][k], acc[ai][bj][m][n], 0, 0, 0); } __builtin_amdgcn_s_setprio(0); } while (0)
#define PG8_WAIT_V(n) asm volatile("s_waitcnt vmcnt(" #n ")" ::: "memory")
#define PG8_WAIT_L(n) asm volatile("s_waitcnt lgkmcnt(" #n ")" ::: "memory")
#define PG8_BAR __builtin_amdgcn_s_barrier()
#define PG8_SCHED __builtin_amdgcn_sched_barrier(0)
#define PG8_IDS_DMA(u, s) do { if (wid < 4) { __builtin_amdgcn_global_load_lds(S.id_src(u, tid), (PG8_LAS unsigned*)(idb + (s) * 768 + wid * 64), 4, 0, 0); \
        __builtin_amdgcn_global_load_lds(S.sc_src(u, tid), (PG8_LAS unsigned*)(idb + (s) * 768 + 256 + wid * 64), 4, 0, 0); \
        __builtin_amdgcn_global_load_lds(S.bias_src(u, tid), (PG8_LAS unsigned*)(idb + (s) * 768 + 512 + wid * 64), 4, 0, 0); } } while (0)
#define PG8_GV(dst, s, un) do { _Pragma("unroll") for (int _h = 0; _h < 2; ++_h) _Pragma("unroll") for (int _i = 0; _i < 2; ++_i) \
        dst[_h][_i] = (LINEAR ? (unsigned)((un).pm * 256 + _h * 128 + RA[_i]) : (idb[(s) * 768 + _h * 128 + RA[_i]] >> 2)) * (unsigned)RB + (unsigned)(CA[_i] * 2); } while (0)
    Unit cur, nxt; int ui = 0, us = 0;
    if (!S.next(0, cur)) return;
    f32x4 acc[2][2][4][2];
#pragma unroll
    for (int a = 0; a < 2; ++a)
#pragma unroll
        for (int b = 0; b < 2; ++b)
#pragma unroll
            for (int m = 0; m < 4; ++m)
#pragma unroll
                for (int n = 0; n < 2; ++n) acc[a][b][m][n] = (f32x4){0.f, 0.f, 0.f, 0.f};
    bf16x8 At[4][2], B0[2][2], B1[2][2]; v8i At8[4], B08[2], B18[2];
    unsigned cv[2][2] = {{0u, 0u}, {0u, 0u}};
    const char* A0 = (const char*)g.A;
    const char* cA = A0 + (GATHER ? (size_t)0 : cur.aoff); const char* cB = (const char*)g.Bt + cur.boff;
    if constexpr (IDS) {
        PG8_IDS_DMA(cur, 0); PG8_WAIT_V(0); PG8_BAR;
    }
    if constexpr (GATHER) { PG8_GV(cv, 0, cur); }
    PG8_STAGE(PG8_SB(0, 0), cB, voffB); PG8_STAGE(PG8_SB(0, 1), cB + hstep, voffB); PG8_STAGE_A(PG8_SA(0, 0), cA, A0, 0, cv); PG8_STAGE_A(PG8_SA(0, 1), cA, A0, 1, cv);
    if (wr == 1) PG8_BAR;
    PG8_WAIT_V(2); PG8_BAR;
    PG8_STAGE(PG8_SB(1, 0), cB + kstep, voffB); PG8_STAGE_A(PG8_SA(1, 0), cA + kstep, A0 + kstep, 0, cv); PG8_STAGE(PG8_SB(1, 1), cB + hstep + kstep, voffB);
    PG8_WAIT_V(6); PG8_BAR;
    for (;;) {
        const bool has_next = S.next(ui + 1, nxt);
        const int ns = (us == 2) ? 0 : us + 1;
        if constexpr (IDS) { if (has_next) PG8_IDS_DMA(nxt, ns); }
        const char* nA = has_next ? A0 + (GATHER ? (size_t)0 : nxt.aoff) : cA; const char* nB = has_next ? (const char*)g.Bt + nxt.boff : cB;
#ifdef PROBE_KTWICE
        for (int rep_ = 0; rep_ < (FP8 ? 2 : 1); ++rep_) { const int sca_ = rep_ ? 0 : 0x7f7f7f7f;
#else
        { const int sca_ = 0x7f7f7f7f;
#endif
#pragma nounroll
        for (int t = 0; t < nt; t += 2) {
            int lastv = (t == nt - 2) ? 1 : 0; asm volatile("" : "+v"(lastv)); const bool last = __builtin_amdgcn_readfirstlane(lastv) != 0;
            const char* a1 = cA + (size_t)(t + 1) * kstep;
            const char* a2 = last ? nA : cA + (size_t)(t + 2) * kstep; const char* b2 = last ? nB : cB + (size_t)(t + 2) * kstep;
            const char* a3 = a2 + kstep; const char* b3 = b2 + kstep;
            PG8_LDB(B0, 0, 0); PG8_LDB(B1, 0, 1); PG8_SCHED; PG8_LDA(At, 0, 0); PG8_STAGE_A(PG8_SA(1, 1), a1, a1, 1, cv);
            if constexpr (GATHER) { if (last && has_next) { PG8_GV(cv, ns, nxt); } }
            PG8_WAIT_V(8); PG8_WAIT_L(0); PG8_BAR; PG8_MMA(0, 0, At, B0); PG8_MMA(0, 1, At, B1); PG8_BAR; PG8_SCHED;
            PG8_LDA(At, 0, 1); PG8_STAGE(PG8_SB(0, 0), b2, voffB); PG8_STAGE(PG8_SB(0, 1), b2 + hstep, voffB); PG8_STAGE_A(PG8_SA(0, 0), a2, a2, 0, cv);
            PG8_WAIT_V(8); PG8_WAIT_L(0); PG8_BAR; PG8_MMA(1, 0, At, B0); PG8_MMA(1, 1, At, B1); PG8_BAR; PG8_SCHED;
            PG8_LDB(B0, 1, 0); PG8_LDB(B1, 1, 1); PG8_SCHED; PG8_LDA(At, 1, 0); PG8_STAGE_A(PG8_SA(0, 1), a2, a2, 1, cv);
            PG8_WAIT_V(8); PG8_WAIT_L(0); PG8_BAR; PG8_MMA(0, 0, At, B0); PG8_MMA(0, 1, At, B1); PG8_BAR; PG8_SCHED;
            PG8_LDA(At, 1, 1); PG8_STAGE(PG8_SB(1, 0), b3, voffB); PG8_STAGE(PG8_SB(1, 1), b3 + hstep, voffB); PG8_STAGE_A(PG8_SA(1, 0), a3, a3, 0, cv);
            PG8_WAIT_V(8); PG8_WAIT_L(0); PG8_BAR; PG8_MMA(1, 0, At, B0); PG8_MMA(1, 1, At, B1); PG8_BAR; PG8_SCHED;
        }
        }
        if constexpr (ALIGN_EPI) { if (wr == 0) PG8_BAR; }
        PG8_SCHED;
        E(acc, cur, wr, wc, fr, fq, (const PG8_LAS unsigned*)(idb + us * 768));
        PG8_SCHED;
#ifdef PROBE_EPI2
        if constexpr (FP8) { E(acc, cur, wr, wc, fr, fq, (const PG8_LAS unsigned*)(idb + us * 768)); PG8_SCHED; }
#endif
        if (!has_next) break;
#pragma unroll
        for (int a = 0; a < 2; ++a)
#pragma unroll
            for (int b = 0; b < 2; ++b)
#pragma unroll
                for (int m = 0; m < 4; ++m)
#pragma unroll
                    for (int n = 0; n < 2; ++n) acc[a][b][m][n] = (f32x4){0.f, 0.f, 0.f, 0.f};
        cur = nxt; cA = nA; cB = nB; ++ui; us = ns;
        if constexpr (ALIGN_EPI) { if (wr == 1) PG8_BAR; }
    }
    PG8_WAIT_V(0);
    if constexpr (!ALIGN_EPI) { if (wr == 0) PG8_BAR; }
    PG8_BAR;
#undef PG8_SA
#undef PG8_SB
#undef PG8_STAGE
#undef PG8_STAGE_A
#undef PG8_LDA
#undef PG8_LDB
#undef PG8_MMA
#undef PG8_LD32
#undef PG8_WAIT_V
#undef PG8_WAIT_L
#undef PG8_BAR
#undef PG8_SCHED
#undef PG8_IDS_DMA
#undef PG8_GV
}
}
namespace attn_body {
using bf16=__hip_bfloat16;
using bf16x8=__attribute__((ext_vector_type(8)))short;
using s16x4=__attribute__((ext_vector_type(4)))short;
using f32x16=__attribute__((ext_vector_type(16)))float;
using u32x4=__attribute__((ext_vector_type(4)))unsigned;
constexpr int D=64;
constexpr int NW=8,QBLK=32,QB=QBLK*NW,KVBLK=64;
struct UnitP { const bf16* Q; const bf16* K; const bf16* V; bf16* O; long qp, kp, op; int q0, t0, NT; float slope2; float* lse; int lse_stride; };
__device__ __forceinline__ int crow(int r,int hi){return (r&3)+8*(r>>2)+4*hi;}
#define SBAR() __builtin_amdgcn_sched_barrier(0)
template<bool CAUSAL,bool WINDOW> __device__ __forceinline__ void cmask(f32x16&p0,f32x16&p1,int jb,int qrel,int hi){
  const float NEG=-INFINITY; int kb=64*jb+4*hi;
  #pragma unroll
  for(int r=0;r<16;++r){int kv=kb+(r&3)+8*(r>>2);
    if(CAUSAL){ if(kv>qrel)p0[r]=NEG; if(kv+32>qrel)p1[r]=NEG; }
    if(WINDOW){ if(kv<qrel-128)p0[r]=NEG; if(kv+32<qrel-128)p1[r]=NEG; } }
}
__device__ __forceinline__ unsigned bfr(float x){ typedef float f2_ __attribute__((ext_vector_type(2))); typedef __bf16 b2_ __attribute__((ext_vector_type(2))); f2_ v={x,0.f}; b2_ b=__builtin_convertvector(v,b2_); return __builtin_bit_cast(unsigned,b)&0xffffu; }
__device__ __forceinline__ float bfv(unsigned b){ return __builtin_bit_cast(float,b<<16); }

constexpr int NSLOT=3, SLOTB=8192;
constexpr int LDS_K=0, LDS_V=NSLOT*SLOTB;
template<int DV> struct Lds { static constexpr int SLOTV=SLOTB*(DV/64), WS=LDS_V+NSLOT*SLOTV, OST=WS+NW*64*4, OSTW=4096*(DV/64), BYTES=OST+NW*OSTW; };
__device__ __forceinline__ void glds16(const void*gsrc,unsigned lds_dst){unsigned keep;
  asm volatile("s_mov_b32 %0, m0\n\ts_mov_b32 m0, %2\n\ts_nop 0\n\tglobal_load_lds_dwordx4 %1, off\n\ts_mov_b32 m0, %0":"=&s"(keep):"v"(gsrc),"s"(lds_dst):"memory");}
__device__ __forceinline__ float max3f(float a,float b,float c){float r;asm("v_max3_f32 %0, %1, %2, %3":"=v"(r):"v"(a),"v"(b),"v"(c));return r;}
__device__ __forceinline__ float max2f(float a,float b){float r;asm("v_max_f32_e32 %0, %1, %2":"=v"(r):"v"(a),"v"(b));return r;}
__device__ __forceinline__ float fadd_s(float a,float b){float r;asm("v_add_f32_e32 %0, %1, %2":"=v"(r):"v"(a),"v"(b));return r;}
__device__ __forceinline__ float fsub_s(float a,float b){float r;asm("v_sub_f32_e32 %0, %1, %2":"=v"(r):"v"(a),"v"(b));return r;}
typedef float f32x2_t __attribute__((ext_vector_type(2))); typedef __bf16 bf16x2_t __attribute__((ext_vector_type(2)));
__device__ __forceinline__ unsigned cvtpk_s(float lo,float hi){f32x2_t v={lo,hi};bf16x2_t b=__builtin_convertvector(v,bf16x2_t);return __builtin_bit_cast(unsigned,b);}
#define WAIT_BAR(N) asm volatile("s_waitcnt vmcnt(" #N ") lgkmcnt(0)\n\ts_barrier":::"memory")

__device__ __forceinline__ void qkt(f32x16&p0,f32x16&p1,const char*Kslot,const bf16x8*qr,bf16x8 kx0,bf16x8 kx1,bf16x8 qx,int r32,int hi){
  const char*kb=Kslot+hi*1024+r32*16;
  #pragma unroll
  for(int d0=0;d0<4;++d0){
    const bf16x8 b0=*reinterpret_cast<const bf16x8*>(kb+d0*2048);
    const bf16x8 b1=*reinterpret_cast<const bf16x8*>(kb+d0*2048+512);
    if(d0==0){p0=__builtin_amdgcn_mfma_f32_32x32x16_bf16(b0,qr[0],f32x16{},0,0,0);p1=__builtin_amdgcn_mfma_f32_32x32x16_bf16(b1,qr[0],f32x16{},0,0,0);}
    else{p0=__builtin_amdgcn_mfma_f32_32x32x16_bf16(b0,qr[d0],p0,0,0,0);p1=__builtin_amdgcn_mfma_f32_32x32x16_bf16(b1,qr[d0],p1,0,0,0);}}
  p0=__builtin_amdgcn_mfma_f32_32x32x16_bf16(kx0,qx,p0,0,0,0);p1=__builtin_amdgcn_mfma_f32_32x32x16_bf16(kx1,qx,p1,0,0,0);
}
typedef __attribute__((address_space(3))) const char* lds_cptr;
typedef short v4i16_t __attribute__((ext_vector_type(4)));
__device__ __forceinline__ void kload8(bf16x8*kf,lds_cptr kp){
  kf[0]=*(const __attribute__((address_space(3))) bf16x8*)(kp);      kf[1]=*(const __attribute__((address_space(3))) bf16x8*)(kp+512);
  kf[2]=*(const __attribute__((address_space(3))) bf16x8*)(kp+2048); kf[3]=*(const __attribute__((address_space(3))) bf16x8*)(kp+2560);
  kf[4]=*(const __attribute__((address_space(3))) bf16x8*)(kp+4096); kf[5]=*(const __attribute__((address_space(3))) bf16x8*)(kp+4608);
  kf[6]=*(const __attribute__((address_space(3))) bf16x8*)(kp+6144); kf[7]=*(const __attribute__((address_space(3))) bf16x8*)(kp+6656);
}
__device__ __forceinline__ void kload2(bf16x8*kf,lds_cptr kp,int j){ kf[2*j]=*(const __attribute__((address_space(3))) bf16x8*)(kp+j*2048); kf[2*j+1]=*(const __attribute__((address_space(3))) bf16x8*)(kp+j*2048+512); }
__device__ __forceinline__ s16x4 vtr(lds_cptr p){ return __builtin_bit_cast(s16x4,__builtin_amdgcn_ds_read_tr16_b64_v4i16((__attribute__((address_space(3))) v4i16_t*)p)); }
__device__ __forceinline__ float rowmax(const f32x16&p0,const f32x16&p1){
  float a=max3f(p0[0],p0[1],p1[0]),b=max3f(p0[2],p0[3],p1[1]);a=max3f(a,p1[2],p1[3]);
  #pragma unroll
  for(int r=4;r<16;r+=4){a=max3f(a,p0[r],p0[r+1]);b=max3f(b,p0[r+2],p0[r+3]);a=max3f(a,p1[r],p1[r+1]);b=max3f(b,p1[r+2],p1[r+3]);}
  const float m=max2f(a,b);
  auto rr=__builtin_amdgcn_permlane32_swap(__float_as_uint(m),__float_as_uint(m),false,false);
  return max2f(__uint_as_float(rr[0]),__uint_as_float(rr[1]));
}
__device__ __forceinline__ void pv(f32x16*o,int vb,bf16x8 pa0,bf16x8 pa1,bf16x8 pa2,bf16x8 pa3){
  #pragma unroll
  for(int d0=0;d0<2;++d0){s16x4 lo[4],hi[4];
    #pragma unroll
    for(int ks=0;ks<4;++ks){
      asm volatile("ds_read_b64_tr_b16 %0,%1 offset:%c2":"=&v"(lo[ks]):"v"(vb),"i"(d0*4096+ks*1024):"memory");
      asm volatile("ds_read_b64_tr_b16 %0,%1 offset:%c2":"=&v"(hi[ks]):"v"(vb),"i"(d0*4096+ks*1024+512):"memory");}
    asm volatile("s_waitcnt lgkmcnt(0)":::"memory");SBAR();
    #define PK(k) (bf16x8){lo[k][0],lo[k][1],lo[k][2],lo[k][3],hi[k][0],hi[k][1],hi[k][2],hi[k][3]}
    o[d0]=__builtin_amdgcn_mfma_f32_32x32x16_bf16(pa0,PK(0),o[d0],0,0,0);
    o[d0]=__builtin_amdgcn_mfma_f32_32x32x16_bf16(pa1,PK(1),o[d0],0,0,0);
    o[d0]=__builtin_amdgcn_mfma_f32_32x32x16_bf16(pa2,PK(2),o[d0],0,0,0);
    o[d0]=__builtin_amdgcn_mfma_f32_32x32x16_bf16(pa3,PK(3),o[d0],0,0,0);
    #undef PK
  }
}

__device__ __forceinline__ void pv128(f32x16*o,int vb,bf16x8 pa0,bf16x8 pa1,bf16x8 pa2,bf16x8 pa3){
  #pragma unroll
  for(int d0=0;d0<4;++d0){s16x4 lo[4],hi[4];
    #pragma unroll
    for(int ks=0;ks<4;++ks){
      asm volatile("ds_read_b64_tr_b16 %0,%1 offset:%c2":"=&v"(lo[ks]):"v"(vb),"i"(d0*4096+ks*1024):"memory");
      asm volatile("ds_read_b64_tr_b16 %0,%1 offset:%c2":"=&v"(hi[ks]):"v"(vb),"i"(d0*4096+ks*1024+512):"memory");}
    asm volatile("s_waitcnt lgkmcnt(0)":::"memory");SBAR();
    #define PK(k) (bf16x8){lo[k][0],lo[k][1],lo[k][2],lo[k][3],hi[k][0],hi[k][1],hi[k][2],hi[k][3]}
    o[d0]=__builtin_amdgcn_mfma_f32_32x32x16_bf16(pa0,PK(0),o[d0],0,0,0);
    o[d0]=__builtin_amdgcn_mfma_f32_32x32x16_bf16(pa1,PK(1),o[d0],0,0,0);
    o[d0]=__builtin_amdgcn_mfma_f32_32x32x16_bf16(pa2,PK(2),o[d0],0,0,0);
    o[d0]=__builtin_amdgcn_mfma_f32_32x32x16_bf16(pa3,PK(3),o[d0],0,0,0);
    #undef PK
  }
}
#ifndef ATTN_STORE16
#define ATTN_STORE16(p,v) (*(u32x4*)(p)=(v))
#endif
template<int THRL,bool CAUSAL,bool WINDOW,bool ALIBI,bool LSE,int DV=64> __device__ __forceinline__ void attn_unit(const UnitP&U,char*shm){
  constexpr int LDS_WS=Lds<DV>::WS, LDS_OST=Lds<DV>::OST, VMUL=DV/64;
  int tid=threadIdx.x; asm volatile("":"+v"(tid));
  const int lane=tid&63,r32=lane&31,hi=lane>>5; const int wid=__builtin_amdgcn_readfirstlane(tid>>6);
  const int q0=U.q0; const long qp=U.qp,kp=U.kp,op=U.op; const float slope2=U.slope2;
  const bf16*Qw=U.Q+(long)(q0+wid*QBLK)*qp;
  const bf16*Kh=U.K+(long)U.t0*KVBLK*kp,*Vh=U.V+(long)U.t0*KVBLK*kp;
  const unsigned lds0=(unsigned)(uintptr_t)shm;
  float*wsf=(float*)(shm+LDS_WS)+wid*64;
  const bf16*ksrc=Kh+(long)lane*kp+wid*8;
  const bf16*vsrc=Vh+(long)(16*(wid&3)+(lane>>2))*kp+(wid>>2)*32+(lane&3)*8;
  const unsigned kdst=lds0+LDS_K+wid*1024, vdst=lds0+LDS_V+wid*1024;
  #define DMA_K(t,slot) glds16(ksrc+(long)(t)*KVBLK*kp,(unsigned)__builtin_amdgcn_readfirstlane(kdst+(slot)))
  #define DMA_V(t,slot) do{ glds16(vsrc+(long)(t)*KVBLK*kp,(unsigned)__builtin_amdgcn_readfirstlane(vdst+VMUL*(slot))); if constexpr(DV==128) glds16(vsrc+64+(long)(t)*KVBLK*kp,(unsigned)__builtin_amdgcn_readfirstlane(vdst+VMUL*(slot)+8192)); }while(0)
  const int vb0=(int)(lds0+LDS_V)+((lane>>4)&1)*32+(lane&3)*8+(4*hi+((lane&15)>>2))*64;
  const char*Kbase=shm+LDS_K; bf16x8 kf[8];
  const lds_cptr shm3=(lds_cptr)shm; const lds_cptr kp0=shm3+LDS_K+hi*1024+r32*16; const lds_cptr vp0=shm3+LDS_V+((lane>>4)&1)*32+(lane&3)*8+(4*hi+((lane&15)>>2))*64;
  const int NT=U.NT;
  DMA_K(0,0);DMA_V(0,0);DMA_K(1,SLOTB);
  bf16x8 qr[4];
  #pragma unroll
  for(int d0=0;d0<4;++d0)qr[d0]=*reinterpret_cast<const bf16x8*>(&Qw[(long)r32*qp+d0*16+hi*8]);
  float mhat=0.f,l_reg=0.f;f32x16 o[4];o[0]=f32x16{};o[1]=f32x16{};o[2]=f32x16{};o[3]=f32x16{};
  const int qrel=wid*QBLK+r32;
  #define CMASK(P0,P1,t) do{int jb_=(t)-(NT-4); if(WINDOW||(CAUSAL&&jb_>=0))cmask<CAUSAL,WINDOW>(P0,P1,jb_,qrel,hi);}while(0)
  bf16x8 kx0,kx1,qx;
  { const float k0_=ALIBI?slope2*(float)r32:0.f, k1_=ALIBI?slope2*(float)(r32+32):0.f; const unsigned h0=bfr(k0_),l0=bfr(k0_-bfv(h0)),h1=bfr(k1_),l1=bfr(k1_-bfv(h1));
    u32x4 a={0x3f803f80u,0x3f80u|(h0<<16),l0,0u}, b={0x3f803f80u,0x3f80u|(h1<<16),l1,0u}; if(hi){a=u32x4{0u,0u,0u,0u};b=a;} kx0=__builtin_bit_cast(bf16x8,a); kx1=__builtin_bit_cast(bf16x8,b); }
  #define QX_SET(t) do{ const float nb_=ALIBI?__builtin_fmaf(slope2,(float)(64*((t)-(NT-4))-qrel),-mhat):-mhat; const unsigned a_=bfr(nb_); const float r1_=nb_-bfv(a_); const unsigned b_=bfr(r1_); const unsigned c_=bfr(r1_-bfv(b_)); \
    u32x4 q_={a_|(b_<<16),c_|0x3f800000u,0x3f80u,0u}; if(hi)q_=u32x4{0u,0u,0u,0u}; qx=__builtin_bit_cast(bf16x8,q_); asm volatile("":"+v"(qx)); }while(0)
  bool resc=false;
  #define START(P0,P1) do{ const float rm=rowmax(P0,P1); resc=false; \
    { const float dl=(rm==-INFINITY)?0.f:rm; mhat=fadd_s(mhat,dl); \
      _Pragma("unroll") for(int r=0;r<16;++r){P0[r]=fsub_s(P0[r],dl);P1[r]=fsub_s(P1[r],dl);} } \
    _Pragma("unroll") for(int r=0;r<16;++r)P0[r]=__builtin_amdgcn_exp2f(P0[r]); }while(0)
  #define RESC() do{ if(resc){ asm volatile("s_waitcnt lgkmcnt(0)":::"memory"); \
      _Pragma("unroll") for(int d_=0;d_<2*VMUL;++d_) _Pragma("unroll") for(int r=0;r<16;++r)o[d_][r]*=wsf[crow(r,hi)]; } }while(0)
  f32x16 pA0,pA1,pB0,pB1;
  int sl_prev=0,sl_cur=0,sl_next=SLOTB;
  #define ROT() do{sl_prev=sl_cur;sl_cur=sl_next;sl_next=(sl_next==(NSLOT-1)*SLOTB)?0:sl_next+SLOTB;}while(0)
  DMA_K(2,2*SLOTB);
  if constexpr(DV==128){WAIT_BAR(4);}else{WAIT_BAR(3);}
  QX_SET(0);
  qkt(pA0,pA1,Kbase,qr,kx0,kx1,qx,r32,hi);asm volatile("s_nop 15\n\ts_nop 7":"+v"(pA0),"+v"(pA1));CMASK(pA0,pA1,0);
  START(pA0,pA1);
  _Pragma("unroll") for(int r=0;r<16;++r)pA1[r]=__builtin_amdgcn_exp2f(pA1[r]);
  WAIT_BAR(0);
  DMA_K(3,0);DMA_V(1,SLOTB);
  ROT();
  kload8(kf,kp0+sl_cur);
  if constexpr(DV==128){WAIT_BAR(3);}else{WAIT_BAR(2);}
  s16x4 vlo[8],vhi[8]; s16x4 vfl[4],vfh[4]; u32x4 pw0,pw1,pw2,pw3;
  #define PKW(P,B) cvtpk_s(P[B],P[B+1])
  #define PAF(k) __builtin_bit_cast(bf16x8,pw##k)
  #define VFR(i) (bf16x8){vlo[i][0],vlo[i][1],vlo[i][2],vlo[i][3],vhi[i][0],vhi[i][1],vhi[i][2],vhi[i][3]}
  #define PIN(x) asm volatile("":"+v"(x))
  #define MX3(a,b,c) __builtin_fmaxf(__builtin_fmaxf((a),(b)),(c))
  #define GAPA(MF,A0,A1,A2,A3,W0,W1,PW) do{ MF; sacc+=A0; sacc+=A1; sacc+=A2; sacc+=A3; PIN(sacc); W0; W1; PIN(PW); SBAR(); }while(0)
  #define EX(v) __builtin_amdgcn_exp2f(v)
  #define GAPB(MF,X,B) do{ MF; X[B]=EX(X[B]); X[B+1]=EX(X[B+1]); X[B+2]=EX(X[B+2]); X[B+3]=EX(X[B+3]); PIN(X); SBAR(); }while(0)
  #define VRD(i) do{ if constexpr(DV==64){ vlo[i]=vtr(vp_+(((i)>>2)*4096+((i)&3)*1024)); vhi[i]=vtr(vp_+(((i)>>2)*4096+((i)&3)*1024+512)); } }while(0)
  #define VRJ(f) do{ vfl[(f)&3]=vtr(vp_+(((f)&3)*4096+((f)>>2)*1024)); vfh[(f)&3]=vtr(vp_+(((f)&3)*4096+((f)>>2)*1024+512)); }while(0)
  #define VFJ(f) (bf16x8){vfl[(f)&3][0],vfl[(f)&3][1],vfl[(f)&3][2],vfl[(f)&3][3],vfh[(f)&3][0],vfh[(f)&3][1],vfh[(f)&3][2],vfh[(f)&3][3]}
  #define GAPJ(f,PA,X,B) do{ if((f)+3<16){VRJ((f)+3);} o[(f)&3]=__builtin_amdgcn_mfma_f32_32x32x16_bf16(PA,VFJ(f),o[(f)&3],0,0,0); X[B]=EX(X[B]); X[B+1]=EX(X[B+1]); PIN(X); SBAR(); }while(0)
  #define KRD(G,j) do{ if(G){ kload2(kf,kp0+sl_next,j); SBAR(); } }while(0)
  #define STEP(C0,C1,P0,P1,t,GK,GV,GL) do{ SBAR(); QX_SET(t); SBAR(); \
    const lds_cptr vp_=vp0+VMUL*sl_prev; \
    VRD(0); SBAR(); float sacc=(P0[0]+P0[1]); \
    GAPA(C0=__builtin_amdgcn_mfma_f32_32x32x16_bf16(kf[0],qr[0],f32x16{},0,0,0), P0[2],P0[3],P0[4],P0[5],     pw0[0]=PKW(P0,0), pw0[1]=PKW(P0,2), pw0); \
    VRD(4); SBAR(); GAPA(C1=__builtin_amdgcn_mfma_f32_32x32x16_bf16(kf[1],qr[0],f32x16{},0,0,0), P0[6],P0[7],P0[8],P0[9],     pw0[2]=PKW(P0,4), pw0[3]=PKW(P0,6), pw0); \
    VRD(1); SBAR(); GAPA(C0=__builtin_amdgcn_mfma_f32_32x32x16_bf16(kf[2],qr[1],C0,0,0,0),   P0[10],P0[11],P0[12],P0[13], pw1[0]=PKW(P0,8), pw1[1]=PKW(P0,10), pw1); \
    VRD(5); SBAR(); GAPA(C1=__builtin_amdgcn_mfma_f32_32x32x16_bf16(kf[3],qr[1],C1,0,0,0),   P0[14],P0[15],P1[0],P1[1],   pw1[2]=PKW(P0,12),pw1[3]=PKW(P0,14), pw1); \
    VRD(2); SBAR(); GAPA(C0=__builtin_amdgcn_mfma_f32_32x32x16_bf16(kf[4],qr[2],C0,0,0,0),   P1[2],P1[3],P1[4],P1[5],     pw2[0]=PKW(P1,0), pw2[1]=PKW(P1,2), pw2); \
    VRD(6); SBAR(); GAPA(C1=__builtin_amdgcn_mfma_f32_32x32x16_bf16(kf[5],qr[2],C1,0,0,0),   P1[6],P1[7],P1[8],P1[9],     pw2[2]=PKW(P1,4), pw2[3]=PKW(P1,6), pw2); \
    VRD(3); SBAR(); GAPA(C0=__builtin_amdgcn_mfma_f32_32x32x16_bf16(kf[6],qr[3],C0,0,0,0),   P1[10],P1[11],P1[12],P1[13], pw3[0]=PKW(P1,8), pw3[1]=PKW(P1,10), pw3); \
    VRD(7); SBAR(); GAPA(C1=__builtin_amdgcn_mfma_f32_32x32x16_bf16(kf[7],qr[3],C1,0,0,0),   P1[14],P1[15],0.f,0.f,       pw3[2]=PKW(P1,12),pw3[3]=PKW(P1,14), pw3); \
    C0=__builtin_amdgcn_mfma_f32_32x32x16_bf16(kx0,qx,C0,0,0,0); C1=__builtin_amdgcn_mfma_f32_32x32x16_bf16(kx1,qx,C1,0,0,0); if constexpr(DV==128){VRJ(0);VRJ(1);VRJ(2);} SBAR(); \
    l_reg+=sacc; \
    if(GK){DMA_K((t)+3,sl_cur);} if(GV){DMA_V((t)+1,sl_next);} \
    CMASK(C0,C1,t); \
    { float a=MX3(C0[0],C0[1],C1[0]),b=MX3(C0[2],C0[3],C1[1]); a=MX3(a,C1[2],C1[3]); \
      _Pragma("unroll") for(int r=4;r<16;r+=4){a=MX3(a,C0[r],C0[r+1]);b=MX3(b,C0[r+2],C0[r+3]);a=MX3(a,C1[r],C1[r+1]);b=MX3(b,C1[r+2],C1[r+3]);} \
      float rm=__builtin_fmaxf(a,b); { auto rr=__builtin_amdgcn_permlane32_swap(__float_as_uint(rm),__float_as_uint(rm),false,false); rm=__builtin_fmaxf(__uint_as_float(rr[0]),__uint_as_float(rr[1])); } \
      resc=false; \
      if(__builtin_expect(__any(rm>(float)THRL),0)){ const float dl=__builtin_fmaxf(rm,0.f); mhat+=dl; \
        _Pragma("unroll") for(int r=0;r<16;++r){C0[r]-=dl;C1[r]-=dl;} \
        const float f=__builtin_amdgcn_exp2f(-dl); l_reg*=f; if(hi==0)wsf[r32]=f; resc=true; } } \
    SBAR(); \
    if constexpr(DV==64){ \
    GAPB(o[0]=__builtin_amdgcn_mfma_f32_32x32x16_bf16(PAF(0),VFR(0),o[0],0,0,0), C0,0); \
    GAPB(o[1]=__builtin_amdgcn_mfma_f32_32x32x16_bf16(PAF(0),VFR(4),o[1],0,0,0), C0,4); \
    KRD(GL,0); GAPB(o[0]=__builtin_amdgcn_mfma_f32_32x32x16_bf16(PAF(1),VFR(1),o[0],0,0,0), C0,8); \
    KRD(GL,1); GAPB(o[1]=__builtin_amdgcn_mfma_f32_32x32x16_bf16(PAF(1),VFR(5),o[1],0,0,0), C0,12); \
    KRD(GL,2); GAPB(o[0]=__builtin_amdgcn_mfma_f32_32x32x16_bf16(PAF(2),VFR(2),o[0],0,0,0), C1,0); \
    KRD(GL,3); GAPB(o[1]=__builtin_amdgcn_mfma_f32_32x32x16_bf16(PAF(2),VFR(6),o[1],0,0,0), C1,4); \
    GAPB(o[0]=__builtin_amdgcn_mfma_f32_32x32x16_bf16(PAF(3),VFR(3),o[0],0,0,0), C1,8); \
    GAPB(o[1]=__builtin_amdgcn_mfma_f32_32x32x16_bf16(PAF(3),VFR(7),o[1],0,0,0), C1,12); \
    } else { \
    GAPJ(0,PAF(0),C0,0); GAPJ(1,PAF(0),C0,2); GAPJ(2,PAF(0),C0,4); GAPJ(3,PAF(0),C0,6); \
    KRD(GL,0); GAPJ(4,PAF(1),C0,8); GAPJ(5,PAF(1),C0,10); KRD(GL,1); GAPJ(6,PAF(1),C0,12); GAPJ(7,PAF(1),C0,14); \
    KRD(GL,2); GAPJ(8,PAF(2),C1,0); GAPJ(9,PAF(2),C1,2); KRD(GL,3); GAPJ(10,PAF(2),C1,4); GAPJ(11,PAF(2),C1,6); \
    GAPJ(12,PAF(3),C1,8); GAPJ(13,PAF(3),C1,10); GAPJ(14,PAF(3),C1,12); GAPJ(15,PAF(3),C1,14); \
    } \
    }while(0)
  int t=1;
  #undef CMASK
  #define CMASK(P0,P1,t) do{}while(0)
  for(;t+5<NT;t+=2){
    STEP(pB0,pB1,pA0,pA1,t,true,true,true);     if constexpr(DV==128){WAIT_BAR(3);}else{WAIT_BAR(2);} RESC(); ROT();
    STEP(pA0,pA1,pB0,pB1,t+1,true,true,true);   if constexpr(DV==128){WAIT_BAR(3);}else{WAIT_BAR(2);} RESC(); ROT();
  }
  #undef CMASK
  #define CMASK(P0,P1,t) do{int jb_=(t)-(NT-4); if(WINDOW||(CAUSAL&&jb_>=0))cmask<CAUSAL,WINDOW>(P0,P1,jb_,qrel,hi);}while(0)
  #define ENDW(tt) do{ if((tt)+3<NT){ if constexpr(DV==128){WAIT_BAR(3);}else{WAIT_BAR(2);} } else if((tt)+2<NT){ if constexpr(DV==128){WAIT_BAR(2);}else{WAIT_BAR(1);} } else {WAIT_BAR(0);} }while(0)
  for(;t+1<NT;t+=2){
    STEP(pB0,pB1,pA0,pA1,t,(t+3<NT),(t+1<NT),(t+1<NT));       ENDW(t);   RESC(); ROT();
    STEP(pA0,pA1,pB0,pB1,t+1,(t+4<NT),(t+2<NT),(t+2<NT));     ENDW(t+1); RESC(); ROT();
  }
  STEP(pB0,pB1,pA0,pA1,NT-1,false,false,false); RESC();
  { float sacc=pB0[0]+pB0[1]; _Pragma("unroll") for(int r=2;r<16;++r)sacc+=pB0[r]; _Pragma("unroll") for(int r=0;r<16;++r)sacc+=pB1[r]; l_reg+=sacc;
    pw0=(u32x4){PKW(pB0,0),PKW(pB0,2),PKW(pB0,4),PKW(pB0,6)};pw1=(u32x4){PKW(pB0,8),PKW(pB0,10),PKW(pB0,12),PKW(pB0,14)};pw2=(u32x4){PKW(pB1,0),PKW(pB1,2),PKW(pB1,4),PKW(pB1,6)};pw3=(u32x4){PKW(pB1,8),PKW(pB1,10),PKW(pB1,12),PKW(pB1,14)};
    SBAR(); if constexpr(DV==128){pv128(o,vb0+VMUL*sl_cur,PAF(0),PAF(1),PAF(2),PAF(3));}else{pv(o,vb0+sl_cur,PAF(0),PAF(1),PAF(2),PAF(3));} }
  #undef PKW
  #undef PAF
  #undef VFR
  #undef PIN
  #undef MX3
  #undef GAPA
  #undef GAPB
  #undef EX
  #undef VRD
  #undef VRJ
  #undef VFJ
  #undef GAPJ
  #undef KRD
  #undef STEP
  #undef ENDW
  {auto rr=__builtin_amdgcn_permlane32_swap(__float_as_uint(l_reg),__float_as_uint(l_reg),false,false);l_reg=__uint_as_float(rr[0])+__uint_as_float(rr[1]);}
  if(LSE){ if(hi==0)U.lse[(long)(q0+wid*QBLK+r32)*U.lse_stride]=mhat+__builtin_amdgcn_logf(l_reg); }
  if(hi==0)wsf[32+r32]=l_reg;asm volatile("s_waitcnt lgkmcnt(0)":::"memory");
  float rli[16];
  #pragma unroll
  for(int r=0;r<16;++r)rli[r]=__builtin_amdgcn_rcpf(wsf[32+crow(r,hi)]);
  bf16*Ow=U.O+(long)(q0+wid*QBLK)*op;
  { bf16*stg=(bf16*)(shm+LDS_OST)+wid*(2048*VMUL);
    #pragma unroll
    for(int r=0;r<16;++r){const int orow=crow(r,hi);
      #pragma unroll
      for(int d0=0;d0<2*VMUL;++d0)stg[orow*DV+d0*32+r32]=__float2bfloat16(o[d0][r]*rli[r]);}
    asm volatile("s_waitcnt lgkmcnt(0)":::"memory");
    if constexpr(DV==128){
      #pragma unroll
      for(int i=0;i<8;++i){const int row=i*4+(lane>>4),ch=lane&15; const u32x4 v=*(const u32x4*)(stg+row*128+ch*8); ATTN_STORE16(Ow+(long)row*op+ch*8,v);}
    } else {
      #pragma unroll
      for(int i=0;i<4;++i){const int row=i*8+(lane>>3),ch=lane&7; const u32x4 v=*(const u32x4*)(stg+row*64+ch*8); ATTN_STORE16(Ow+(long)row*op+ch*8,v);} } }
  asm volatile("s_waitcnt lgkmcnt(0)\n\ts_barrier":::"memory");
  #undef DMA_K
  #undef DMA_V
  #undef CMASK
  #undef START
  #undef RESC
  #undef ROT
  #undef QX_SET
}
constexpr int ATTN_LDS_BYTES=Lds<128>::BYTES;
#undef SBAR
#undef WAIT_BAR
}
constexpr size_t MiB = 1u << 20;
constexpr size_t WS_CTL = 0, CTL_ZERO_BYTES = 1 * MiB;
constexpr size_t WS_LIST = 1 * MiB;
constexpr size_t WS_RGATE = 5 * MiB;
constexpr size_t WS_RSTD1 = 5 * MiB + 512 * 1024, WS_RSTD2 = WS_RSTD1 + 128 * 1024, WS_WRG = WS_RSTD2 + 128 * 1024;
constexpr size_t WS_WRT = 7 * MiB + 512 * 1024;
constexpr size_t WS_LSE = 6 * MiB;
constexpr size_t WS_MKV = 8 * MiB;
constexpr size_t WS_WIN = 10 * MiB, WS_WOUT = 15 * MiB, WS_WGU = 17 * MiB, WS_WDN = 145 * MiB;
constexpr size_t WS_XB = 209 * MiB;
constexpr size_t WS_LRSTD = 209 * MiB, WS_LGATE = 213 * MiB;
constexpr size_t WS_P = 273 * MiB, WS_OD = 433 * MiB, WS_ODIL = 497 * MiB;
constexpr size_t WS_ACT = 273 * MiB;
constexpr size_t WS_MIX = 545 * MiB, WS_X1B = 609 * MiB, WS_YB = 673 * MiB, WS_X1H = 801 * MiB, WS_Y = 929 * MiB, WS_END = 993 * MiB;
constexpr int CW_TMO = 0, CW_CODE = 1;
constexpr int CW_CNT = 64;
constexpr int CW_NRM = 256;
constexpr int CW_Q = 1024;
constexpr int CW_BAR = 4096;

constexpr int RING_OFF = 0, RING_BYTES = 131072;
constexpr int LDSCTL_OFF = RING_BYTES;
constexpr int IDB_OFF = LDSCTL_OFF;
constexpr int TBL_OFF = IDB_OFF + 9216;
constexpr int LCNT_OFF = TBL_OFF + 2304;
constexpr int MISC_OFF = LCNT_OFF + 256;
constexpr int STG_OFF = IDB_OFF;
constexpr int LDS_BYTES = 147456;
static_assert(MISC_OFF + 128 <= LDS_BYTES && 512 * 16 <= 9216, "LDS map");
constexpr int NWAVES = 8;

#define GAS __attribute__((address_space(1)))
#define LAS __attribute__((address_space(3)))
typedef unsigned short bf16;
typedef unsigned v4u __attribute__((ext_vector_type(4)));
typedef unsigned v2u __attribute__((ext_vector_type(2)));
typedef float f32x4 __attribute__((ext_vector_type(4)));
typedef float f32x16 __attribute__((ext_vector_type(16)));
typedef short bf16x8 __attribute__((ext_vector_type(8)));
typedef GAS unsigned gu32;
#define RLX_AGENT __ATOMIC_RELAXED, __HIP_MEMORY_SCOPE_AGENT
#define LDS_WAIT() asm volatile("s_waitcnt lgkmcnt(0)" ::: "memory")
#define VM_WAIT() asm volatile("s_waitcnt vmcnt(0)" ::: "memory")
__device__ __forceinline__ unsigned f2bf(float f) { unsigned u = __builtin_bit_cast(unsigned, f); return (u + 0x7fffu + ((u >> 16) & 1u)) >> 16; }
__device__ __forceinline__ unsigned pk2(float lo, float hi) { return f2bf(lo) | (f2bf(hi) << 16); }
__device__ __forceinline__ float sat8(float v) { return __builtin_amdgcn_fmed3f(v, -448.f, 448.f); }
__device__ __forceinline__ unsigned fp8x4(float a, float b, float c, float d) { int w = __builtin_amdgcn_cvt_pk_fp8_f32(sat8(a), sat8(b), 0, false); w = __builtin_amdgcn_cvt_pk_fp8_f32(sat8(c), sat8(d), w, true); return (unsigned)w; }
constexpr float WSCALE = 64.f, ASCALE = 8.f, YSCALE = 64.f;
__device__ __forceinline__ float bf2f(unsigned short b) { return __builtin_bit_cast(float, (unsigned)b << 16); }
__device__ __forceinline__ float bflo(unsigned w) { return __builtin_bit_cast(float, w << 16); }
__device__ __forceinline__ float bfhi(unsigned w) { return __builtin_bit_cast(float, w & 0xffff0000u); }
__device__ __forceinline__ float wave_sum(float v) {
#pragma unroll
    for (int o = 1; o < 64; o <<= 1) v += __shfl_xor(v, o);
    return v;
}

#define XB_TMO      128
#define XB_XCNT(j)  (256  + 64 * (j))
#define XB_XSUB(j)  (1280 + 64 * (j))
#define XB_XGEN(j)  (2304 + 64 * (j))
#define XB_TOP      3328
#define XB_TOPGEN   3392
#define XCD_BAR_WORDS 3456
#define XB_SPIN_CAP (1u << 20)
__device__ __forceinline__ unsigned xb_ld(unsigned* p)              { return __hip_atomic_load(p, __ATOMIC_RELAXED, __HIP_MEMORY_SCOPE_AGENT); }
__device__ __forceinline__ unsigned xb_add(unsigned* p, unsigned v) { return __hip_atomic_fetch_add(p, v, __ATOMIC_RELAXED, __HIP_MEMORY_SCOPE_AGENT); }
__device__ __forceinline__ unsigned xb_xcc_id() { return (unsigned)__builtin_amdgcn_s_getreg((3 << 11) | 20) & 0xFu; }
#define XB_SPIN(cond, bar) do { unsigned _sp = 0; while (cond) { __builtin_amdgcn_s_sleep(1); \
    if ((++_sp & 255u) == 0u) { if (xb_ld(&(bar)[XB_TMO])) break; if (_sp > XB_SPIN_CAP) { atomicAdd(&(bar)[XB_TMO], 1u); break; } } } } while (0)
struct XcdBarrier { unsigned* bar; unsigned x; volatile LAS unsigned* st; };
__device__ __forceinline__ XcdBarrier xcd_barrier_post(unsigned* bar, volatile LAS unsigned* st) {
    XcdBarrier b; b.bar = bar; b.x = xb_xcc_id(); b.st = st;
    if (threadIdx.x == 0) (void)xb_add(&bar[XB_XCNT(b.x)], 1u);
    return b;
}
__device__ __forceinline__ void xcd_barrier_complete(unsigned* bar, unsigned x, unsigned& nloc, unsigned& nx) {
    const unsigned G = gridDim.x * gridDim.y * gridDim.z;
    unsigned sum, cnt, mine, sp = 0u;
    for (;;) {
        sum = 0u; cnt = 0u; mine = 0u;
#pragma unroll
        for (unsigned j = 0; j < 16; ++j) { const unsigned c = xb_ld(&bar[XB_XCNT(j)]); sum += c; cnt += (c > 0u) ? 1u : 0u; mine = (j == x) ? c : mine; }
        if (sum == G) break;
        __builtin_amdgcn_s_sleep(1);
        if ((++sp & 255u) == 0u) { if (xb_ld(&bar[XB_TMO])) break; if (sp > XB_SPIN_CAP) { atomicAdd(&bar[XB_TMO], 1u); break; } }
    }
    nloc = mine > 0u ? mine : 1u; nx = cnt > 0u ? cnt : 1u;
}
__device__ __forceinline__ void xcd_barrier(const XcdBarrier& b) {
    asm volatile("s_waitcnt vmcnt(0)" ::: "memory");
    __syncthreads();
    if (threadIdx.x == 0) {
        unsigned* bar = b.bar;
        __builtin_amdgcn_s_waitcnt(0);
        unsigned nloc = b.st[0], nx = b.st[1];
        if (nloc == 0u) { xcd_barrier_complete(bar, b.x, nloc, nx); b.st[0] = nloc; b.st[1] = nx; }
        const unsigned old = xb_add(&bar[XB_XSUB(b.x)], 1u);
        const unsigned gen = old / nloc;
        if (old + 1u == (gen + 1u) * nloc) {
            __builtin_amdgcn_fence(__ATOMIC_RELEASE, "agent");
            asm volatile("s_waitcnt vmcnt(0)" ::: "memory");
            const unsigned og = xb_add(&bar[XB_TOP], 1u);
            const unsigned tg = og / nx;
            if (og + 1u == (tg + 1u) * nx) xb_add(&bar[XB_TOPGEN], 1u);
            else XB_SPIN(xb_ld(&bar[XB_TOPGEN]) == tg, bar);
            __builtin_amdgcn_fence(__ATOMIC_ACQUIRE, "agent");
            xb_add(&bar[XB_XGEN(b.x)], 1u);
            asm volatile("s_waitcnt vmcnt(0)" ::: "memory");
        } else {
            XB_SPIN(xb_ld(&bar[XB_XGEN(b.x)]) == gen, bar);
            __builtin_amdgcn_fence(__ATOMIC_ACQUIRE, "agent");
            asm volatile("s_waitcnt vmcnt(0)" ::: "memory");
        }
    }
    __syncthreads();
}

struct Frame {
    LAS unsigned char* lds;
    volatile LAS unsigned* MISC;
    gu32* ctl;
    int tid, lane, wave;
    int vcu, G;
    const float *x, *mem, *g_attn, *g_mem, *w_in, *lamqk, *subg, *w_mkv, *w_out, *g_ffn, *w_r, *b_r, *w_gu, *b_gu, *w_dn, *b_dn, *g_fin;
    float* out; unsigned char* ws;
};

#define P0_LOAD(dst, itm) do { const int m_ = (itm) / ipm, r_ = (itm) % ipm, kb_ = r_ / nblk, nb_ = r_ % nblk; \
        const float* src_ = W + (size_t)m_ * K * N + (size_t)(64 * kb_ + (lane >> 5)) * N + 32 * nb_ + (lane & 31); \
        _Pragma("unroll") for (int i_ = 0; i_ < 32; ++i_) dst[i_] = src_[(size_t)(2 * i_) * N]; } while (0)
template <bool F8, class RowMap>
__device__ __forceinline__ void p0_transpose_all(const float* W, int K, int N, int nmat, void* WTv, const float* gk, float wscale, LAS float* scr, int gw, int NGW, int lane, RowMap rowmap) {
    asm volatile("" : "+v"(lane));
    const int nblk = N / 32, ipm = (K / 64) * nblk, total = nmat * ipm;
    int it = gw; if (it >= total) return;
    float v[32], w[32];
    P0_LOAD(v, it);
    for (;;) {
        const int nx = it + NGW; const bool more = nx < total;
        if (more) P0_LOAD(w, nx);
        const int m = it / ipm, r = it % ipm, k0 = 64 * (r / nblk), n0 = 32 * (r % nblk);
        if (gk) {
#pragma unroll
            for (int i = 0; i < 32; ++i) v[i] *= gk[k0 + 2 * i + (lane >> 5)] * wscale;
        } else if (F8) {
#pragma unroll
            for (int i = 0; i < 32; ++i) v[i] *= wscale;
        }
#pragma unroll
        for (int i = 0; i < 32; ++i) scr[(2 * i + (lane >> 5)) * 33 + (lane & 31)] = v[i];
        LDS_WAIT(); asm volatile("" ::: "memory");
        const int c = lane & 7;
#pragma unroll
        for (int j = 0; j < 4; ++j) { const int n = (lane >> 3) + 8 * j; const LAS float* s = scr + (8 * c) * 33 + n;
            if constexpr (F8) { unsigned char* wt = (unsigned char*)WTv + (size_t)m * N * K;
                v2u o; o.x = fp8x4(s[0 * 33], s[1 * 33], s[2 * 33], s[3 * 33]); o.y = fp8x4(s[4 * 33], s[5 * 33], s[6 * 33], s[7 * 33]);
                *(GAS v2u*)(wt + (size_t)rowmap(n0 + n) * K + k0 + 8 * c) = o; }
            else { bf16* wt = (bf16*)WTv + (size_t)m * N * K;
                v4u o; o.x = pk2(s[0 * 33], s[1 * 33]); o.y = pk2(s[2 * 33], s[3 * 33]); o.z = pk2(s[4 * 33], s[5 * 33]); o.w = pk2(s[6 * 33], s[7 * 33]);
                *(GAS v4u*)(wt + (size_t)rowmap(n0 + n) * K + k0 + 8 * c) = o; } }
        LDS_WAIT(); asm volatile("" ::: "memory");
        if (!more) break;
#pragma unroll
        for (int i = 0; i < 32; ++i) v[i] = w[i];
        it = nx;
    }
}
#undef P0_LOAD
struct RowId { __device__ __forceinline__ int operator()(int n) const { return n; } };
struct RowGU { __device__ __forceinline__ int operator()(int n) const { const int f = n >> 1, u = n & 1; return ((f >> 7) << 8) + (u << 7) + (f & 127); } };

__device__ __forceinline__ void p0_x_rows2(Frame& F, const float* xrow, bf16* orow, float* rstd_out) {
    const GAS f32x4* xr = (const GAS f32x4*)xrow + F.lane;
    f32x4 v[8]; float s0 = 0.f, s1 = 0.f;
#pragma unroll
    for (int j = 0; j < 8; ++j) v[j] = xr[64 * j];
#pragma unroll
    for (int j = 0; j < 4; ++j) { s0 += (v[j].x * v[j].x + v[j].y * v[j].y) + (v[j].z * v[j].z + v[j].w * v[j].w); s1 += (v[4 + j].x * v[4 + j].x + v[4 + j].y * v[4 + j].y) + (v[4 + j].z * v[4 + j].z + v[4 + j].w * v[4 + j].w); }
    s0 = wave_sum(s0); s1 = wave_sum(s1);
    GAS unsigned long long* o8 = (GAS unsigned long long*)orow + F.lane;
#pragma unroll
    for (int j = 0; j < 8; ++j) o8[64 * j] = (unsigned long long)pk2(v[j].x, v[j].y) | ((unsigned long long)pk2(v[j].z, v[j].w) << 32);
    if (F.lane == 0) { rstd_out[0] = 1.f / sqrtf(s0 * (1.f / D) + EPS); rstd_out[1] = 1.f / sqrtf(s1 * (1.f / D) + EPS); }
}
__device__ __forceinline__ void p0_mkv_tile(Frame& F, int tile, bf16* mkv) {
    const int mt = tile >> 4, nt = tile & 15, m0 = 32 * mt, n0 = 32 * nt, r = F.lane & 31, h = F.lane >> 5;
    f32x16 acc = {}; float ss = 0.f;
    const float* mrow = F.mem + (size_t)(m0 + r) * D + 8 * h;
    const float* wcol = F.w_mkv + (size_t)(8 * h) * 512 + n0 + r;
    const float* gp = F.g_mem + 8 * h;
    for (int k0 = 0; k0 < D; k0 += 16) {
        const f32x4 a0 = *(const f32x4*)(mrow + k0), a1 = *(const f32x4*)(mrow + k0 + 4);
        const f32x4 g0 = *(const f32x4*)(gp + k0), g1 = *(const f32x4*)(gp + k0 + 4);
        ss += (a0.x * a0.x + a0.y * a0.y) + (a0.z * a0.z + a0.w * a0.w) + (a1.x * a1.x + a1.y * a1.y) + (a1.z * a1.z + a1.w * a1.w);
        v4u bw; bw.x = pk2(a0.x * g0.x, a0.y * g0.y); bw.y = pk2(a0.z * g0.z, a0.w * g0.w); bw.z = pk2(a1.x * g1.x, a1.y * g1.y); bw.w = pk2(a1.z * g1.z, a1.w * g1.w);
        float wv[8];
#pragma unroll
        for (int j = 0; j < 8; ++j) wv[j] = wcol[(size_t)(k0 + j) * 512];
        v4u aw; aw.x = pk2(wv[0], wv[1]); aw.y = pk2(wv[2], wv[3]); aw.z = pk2(wv[4], wv[5]); aw.w = pk2(wv[6], wv[7]);
        acc = __builtin_amdgcn_mfma_f32_32x32x16_bf16(__builtin_bit_cast(bf16x8, aw), __builtin_bit_cast(bf16x8, bw), acc, 0, 0, 0);
    }
    ss += __shfl_xor(ss, 32);
    const float rstd = 1.f / sqrtf(ss * (1.f / D) + EPS);
    bf16* orow = mkv + (size_t)(m0 + r) * 512 + n0 + 4 * h;
#pragma unroll
    for (int q = 0; q < 4; ++q) { v2u o; o.x = pk2(acc[4 * q] * rstd, acc[4 * q + 1] * rstd); o.y = pk2(acc[4 * q + 2] * rstd, acc[4 * q + 3] * rstd); *(GAS v2u*)(orow + 8 * q) = o; }
}
__device__ __forceinline__ void p0_prologue(Frame& F) {
    LAS float* scr = (LAS float*)(F.lds + RING_OFF + F.wave * 16384);
    const int gw = F.vcu * NWAVES + F.wave, NGW = F.G * NWAVES;
    bf16* win_t = (bf16*)(F.ws + WS_WIN); bf16* wout_t = (bf16*)(F.ws + WS_WOUT);
    if (F.wave < 4 && F.G == 256) p0_mkv_tile(F, F.wave * 256 + F.vcu, (bf16*)(F.ws + WS_MKV));
    p0_transpose_all<false>(F.w_in, D, DIN, 1, win_t, F.g_attn, 1.f, scr, gw, NGW, F.lane, RowId());
    p0_transpose_all<false>(F.w_out, D, D, 1, wout_t, nullptr, 1.f, scr, gw, NGW, F.lane, RowId());
    bf16* xb = (bf16*)(F.ws + WS_XB); float* rstd1 = (float*)(F.ws + WS_RSTD1);
    for (int m = 2 * gw; m < T; m += 2 * NGW) p0_x_rows2(F, F.x + (size_t)m * D, xb + (size_t)m * D, rstd1 + m);
    bf16* wrt = (bf16*)(F.ws + WS_WRT);
    for (int i = gw * 64 + F.lane; i < D * NE; i += NGW * 64) { const int e = i >> 10, k = i & 1023; const float w = F.w_r[k * NE + e] * F.g_ffn[k]; const unsigned hb = f2bf(w); wrt[i] = (bf16)hb; wrt[D * NE + i] = (bf16)f2bf(w - bf2f((bf16)hb)); }
}

constexpr int NCONV = 8, NCONV_ALL = 8 * NCONV;
__device__ __forceinline__ void p0b_unit(Frame& F, int c) {
    LAS float* scr = (LAS float*)(F.lds + RING_OFF + F.wave * 16384);
    p0_transpose_all<true>(F.w_gu, D, 2 * DFF, NE, (void*)(F.ws + WS_WGU), F.g_ffn, WSCALE, scr, c * NWAVES + F.wave, NCONV_ALL * NWAVES, F.lane, RowGU());
    p0_transpose_all<true>(F.w_dn, DFF, D, NE, (void*)(F.ws + WS_WDN), nullptr, WSCALE, scr, c * NWAVES + F.wave, NCONV_ALL * NWAVES, F.lane, RowId());
    __syncthreads();
}

struct EpiInProj {
    bf16* O; const float* rstd; unsigned* nrm;
    __device__ __forceinline__ void operator()(const pg8::f32x4 (&acc)[2][2][4][2], const pg8::Unit& u, int wr, int wc, int fr, int fq, const LAS unsigned* ids) const {
        asm volatile("" : "+v"(fr), "+v"(fq));
        const int row0 = u.pm * 256 + wr * 64 + fr, col0 = u.pn * 256 + wc * 32 + 8 * fq;
        const float sc = (u.pn <= 1 || u.pn == 6 || u.pn == 9) ? QSCALE : 1.f;
        const LAS float* scl = (const LAS float*)(ids + 256);
        float rsv[2][4];
#pragma unroll
        for (int ai = 0; ai < 2; ++ai)
#pragma unroll
            for (int m = 0; m < 4; ++m) rsv[ai][m] = scl[wr * 64 + fr + ai * 128 + m * 16];
#pragma unroll
        for (int ai = 0; ai < 2; ++ai)
#pragma unroll
            for (int m = 0; m < 4; ++m) { const int row = row0 + ai * 128 + m * 16; const float rs = rsv[ai][m] * sc; bf16* rowp = O + (size_t)row * DIN + col0;
#pragma unroll
                for (int bj = 0; bj < 2; ++bj) { const pg8::f32x4 v0 = acc[ai][bj][m][0] * rs, v1 = acc[ai][bj][m][1] * rs;
                    v4u w; w.x = pg8::cvt_pk_bf16(v0[0], v0[1]); w.y = pg8::cvt_pk_bf16(v0[2], v0[3]); w.z = pg8::cvt_pk_bf16(v1[0], v1[1]); w.w = pg8::cvt_pk_bf16(v1[2], v1[3]);
                    *(v4u*)(rowp + bj * 128) = w; } }
        if (u.pn < 4) {
#pragma unroll
            for (int bj = 0; bj < 2; ++bj) { float mx = 0.f;
#pragma unroll
                for (int ai = 0; ai < 2; ++ai)
#pragma unroll
                    for (int m = 0; m < 4; ++m) { const float rs = rsv[ai][m] * sc; const pg8::f32x4 v0 = acc[ai][bj][m][0] * rs, v1 = acc[ai][bj][m][1] * rs;
                        float s = (v0[0] * v0[0] + v0[1] * v0[1]) + (v0[2] * v0[2] + v0[3] * v0[3]) + (v1[0] * v1[0] + v1[1] * v1[1]) + (v1[2] * v1[2] + v1[3] * v1[3]);
                        s += __shfl_xor(s, 16); s += __shfl_xor(s, 32); mx = fmaxf(mx, s); }
#pragma unroll
                for (int o = 1; o < 16; o <<= 1) mx = fmaxf(mx, __shfl_xor(mx, o));
                if ((fr | fq) == 0) atomicMax(nrm + (((u.pm >> 4) * 4 + u.pn) * 4 + 2 * bj + (wc >> 1)) * 2 + (wc & 1), __builtin_bit_cast(unsigned, mx)); }
        }
    }
};
__device__ __forceinline__ void attn_phase(Frame& F, char* shm, int qoff = 0, int gmask = 7) {
    using namespace attn_body;
    const attn_body::bf16* P = (const attn_body::bf16*)(F.ws + WS_P);
    attn_body::bf16* OD = (attn_body::bf16*)(F.ws + WS_OD);
    attn_body::bf16* mix = (attn_body::bf16*)(F.ws + WS_MIX);
    attn_body::bf16* ODIL = (attn_body::bf16*)(F.ws + WS_ODIL); float* LSEb = (float*)(F.ws + WS_LSE);
    const attn_body::bf16* MKV = (const attn_body::bf16*)(F.ws + WS_MKV);
    const float* nrm = (const float*)(F.ctl + CW_NRM);
    const int grp = (int)blockIdx.x & 7, b = grp;
    unsigned* qctr = (unsigned*)(F.ctl + CW_Q + qoff) + 64 * grp;
    const attn_body::bf16* Pb = P + (size_t)b * SEQ * DIN;
    unsigned nxt_tok = 0u;
    if (F.tid == 0) nxt_tok = __hip_atomic_fetch_add(qctr, 1u, __ATOMIC_RELAXED, __HIP_MEMORY_SCOPE_AGENT);
    for (;;) {
        if (F.tid == 0) F.MISC[20] = nxt_tok;
        __syncthreads();
        int un = (int)F.MISC[20];
        __syncthreads();
        if (F.tid == 0 && un < NCONV + 384) nxt_tok = __hip_atomic_fetch_add(qctr, 1u, __ATOMIC_RELAXED, __HIP_MEMORY_SCOPE_AGENT);
        if (un < NCONV) { if (gmask == 7) p0b_unit(F, grp * NCONV + un); continue; }
        un -= NCONV;
        if (un >= 384) break;
        if (un < 128) {
            if (!(gmask & 1)) continue;
            const int qb = 15 - (un >> 3), h = 3 - ((un >> 1) & 3), j = un & 1;
            const float slope2 = exp2f(-(float)(2 * h + 1)) * LOG2E;
            const int ni = ((b * 4 + (h >> 1)) * 4 + 2 * (h & 1) + j) * 2;
            const float R = sqrtf((nrm[ni] + nrm[ni + 1]) * (nrm[ni + 16] + nrm[ni + 17])) * 1.01f;
            const float kfirst = (float)(qb * 256) - (2.f * R + 160.f) / slope2;
            int t0 = kfirst > 0.f ? (int)(kfirst * (1.f / 64.f)) : 0; t0 = min(t0, 4 * qb); t0 &= ~1;
            UnitP U; U.Q = Pb + C_DQ + h * 128 + j * 64; U.K = Pb + C_DK + h * 128 + j * 64; U.V = Pb + C_DV + h * 128;
            U.O = OD + (size_t)b * SEQ * 1024 + h * 256 + j * 128; U.qp = DIN; U.kp = DIN; U.op = 1024;
            U.q0 = qb * 256; U.t0 = t0; U.NT = 4 * qb + 4 - t0; U.slope2 = slope2; U.lse = nullptr; U.lse_stride = 0;
            attn_unit<32, true, false, true, false, 128>(U, shm);
        } else if (un < 320) {
            if (!(gmask & 2)) continue;
            const int du = un - 128, h = du / 48, idx = du % 48, n = idx >> 4, w = idx & 15;
            const int r = (n == 0) ? 1 : (n == 1 ? 4 : 16), c = (n == 0) ? 0 : (n == 1 ? (w >> 2) : w), blk = (n == 0) ? w : (n == 1 ? (w & 3) : 0);
            const attn_body::bf16* Pc = Pb + (size_t)c * DIN;
            UnitP U; U.Q = Pc + C_LQ + h * 64; U.K = Pc + C_LK + h * 64; U.V = Pc + C_LV + h * 64; U.qp = (long)r * DIN; U.kp = (long)r * DIN;
            U.O = ODIL + (size_t)n * T * 256 + ((size_t)b * SEQ + c) * 256 + h * 64; U.op = (long)r * 256;
            U.q0 = blk * 256; U.t0 = (blk == 0) ? 0 : 4 * blk - 2; U.NT = 4 * blk + 4 - U.t0;
            U.slope2 = exp2f(-(float)(2 * h + 2)) * (float)r * LOG2E;
            U.lse = LSEb + (size_t)n * T * 4 + ((size_t)b * SEQ + c) * 4 + h; U.lse_stride = r * 4;
            attn_unit<32, true, true, true, true>(U, shm);
        } else {
            if (!(gmask & 4)) continue;
            const int mu = un - 320, h = mu >> 4, qb = mu & 15;
            UnitP U; U.Q = Pb + C_MQ + h * 64; U.qp = DIN; U.K = MKV + (size_t)b * NMEM * 512 + h * 64; U.V = U.K + 256; U.kp = 512;
            U.O = mix + (size_t)b * SEQ * 1024 + 768 + h * 64; U.op = 1024; U.q0 = qb * 256; U.t0 = 0; U.NT = 4; U.slope2 = 0.f; U.lse = nullptr; U.lse_stride = 0;
            attn_unit<8, false, false, false, false>(U, shm);
        }
    }
}
__device__ __forceinline__ void dil_combine_phase(Frame& F) {
    const int gw = F.vcu * NWAVES + F.wave, NGW = F.G * NWAVES;
    const bf16* OD = (const bf16*)(F.ws + WS_OD); const bf16* ODIL = (const bf16*)(F.ws + WS_ODIL); const float* LSEb = (const float*)(F.ws + WS_LSE); bf16* mix = (bf16*)(F.ws + WS_MIX);
    const int h = F.lane >> 4, pt = F.lane & 15, d4 = pt * 4;
    float lam;
    { const float a = F.lamqk[F.lane] * F.lamqk[64 + F.lane], c = F.lamqk[128 + F.lane] * F.lamqk[192 + F.lane];
      lam = __expf(wave_sum(a)) - __expf(wave_sum(c)) + 0.2f; }
    float gsub[8];
#pragma unroll
    for (int i = 0; i < 8; ++i) gsub[i] = F.subg[pt * 8 + i] * 0.8f;
    for (int row0 = 4 * gw; row0 < T; row0 += 4 * NGW) {
        float l[4][3]; v2u q[4][3]; v4u o1[4], o2[4];
#pragma unroll
        for (int i = 0; i < 4; ++i) {
            o1[i] = *(const v4u*)(OD + (size_t)(row0 + i) * 1024 + h * 256 + pt * 8); o2[i] = *(const v4u*)(OD + (size_t)(row0 + i) * 1024 + h * 256 + 128 + pt * 8);
#pragma unroll
            for (int n = 0; n < 3; ++n) { l[i][n] = LSEb[(size_t)n * T * 4 + (size_t)(row0 + i) * 4 + h]; q[i][n] = *(const v2u*)(ODIL + (size_t)n * T * 256 + (size_t)(row0 + i) * 256 + h * 64 + d4); } }
#pragma unroll
        for (int i = 0; i < 4; ++i) {
            const unsigned aw[4] = {o1[i].x, o1[i].y, o1[i].z, o1[i].w}, bw[4] = {o2[i].x, o2[i].y, o2[i].z, o2[i].w};
            float d[8], ss = 0.f;
#pragma unroll
            for (int c = 0; c < 4; ++c) { d[2 * c] = bflo(aw[c]) - lam * bflo(bw[c]); d[2 * c + 1] = bfhi(aw[c]) - lam * bfhi(bw[c]); ss += d[2 * c] * d[2 * c] + d[2 * c + 1] * d[2 * c + 1]; }
#pragma unroll
            for (int o = 1; o < 16; o <<= 1) ss += __shfl_xor(ss, o);
            const float rstd = 1.f / sqrtf(ss * (1.f / 128.f) + EPS);
            v4u od; od.x = pk2(d[0] * rstd * gsub[0], d[1] * rstd * gsub[1]); od.y = pk2(d[2] * rstd * gsub[2], d[3] * rstd * gsub[3]); od.z = pk2(d[4] * rstd * gsub[4], d[5] * rstd * gsub[5]); od.w = pk2(d[6] * rstd * gsub[6], d[7] * rstd * gsub[7]);
            *(v4u*)(mix + (size_t)(row0 + i) * 1024 + h * 128 + pt * 8) = od;
            const float m = fmaxf(fmaxf(l[i][0], l[i][1]), l[i][2]);
            float wn[3], den = 0.f;
#pragma unroll
            for (int n = 0; n < 3; ++n) { wn[n] = exp2f(l[i][n] - m); den += wn[n]; }
            const float inv = 1.f / den; float o[4] = {0.f, 0.f, 0.f, 0.f};
#pragma unroll
            for (int n = 0; n < 3; ++n) { const float wq = wn[n] * inv; o[0] += wq * bflo(q[i][n].x); o[1] += wq * bfhi(q[i][n].x); o[2] += wq * bflo(q[i][n].y); o[3] += wq * bfhi(q[i][n].y); }
            v2u ov; ov.x = pk2(o[0], o[1]); ov.y = pk2(o[2], o[3]);
            *(v2u*)(mix + (size_t)(row0 + i) * 1024 + 512 + h * 64 + d4) = ov;
        }
    }
}
struct EpiY {
    bf16* Y;
    __device__ __forceinline__ void operator()(const pg8::f32x4 (&acc)[2][2][4][2], const pg8::Unit& u, int wr, int wc, int fr, int fq, const LAS unsigned*) const {
        asm volatile("" : "+v"(fr), "+v"(fq));
        const int row0 = u.pm * 256 + wr * 64 + fr, col0 = u.pn * 256 + wc * 32 + 8 * fq;
#pragma unroll
        for (int ai = 0; ai < 2; ++ai)
#pragma unroll
            for (int m = 0; m < 4; ++m) { bf16* rowp = Y + (size_t)(row0 + ai * 128 + m * 16) * D + col0;
#pragma unroll
                for (int bj = 0; bj < 2; ++bj) { const pg8::f32x4 v0 = acc[ai][bj][m][0], v1 = acc[ai][bj][m][1];
                    v4u w; w.x = pg8::cvt_pk_bf16(v0[0], v0[1]); w.y = pg8::cvt_pk_bf16(v0[2], v0[3]); w.z = pg8::cvt_pk_bf16(v1[0], v1[1]); w.w = pg8::cvt_pk_bf16(v1[2], v1[3]);
                    *(v4u*)(rowp + bj * 128) = w; } }
    }
};

__device__ __forceinline__ void route_phase(Frame& F) {
    LAS float* xch = (LAS float*)(F.lds + RING_OFF);
    LAS unsigned* lcnt = (LAS unsigned*)(F.lds + LCNT_OFF);
    LAS unsigned* stg = (LAS unsigned*)(F.lds + STG_OFF);
    if (F.tid < 64) lcnt[F.tid] = 0u;
    const int lane = F.lane, tl = lane & 31, h = lane >> 5, tg = F.wave & 3, kh = F.wave >> 2;
    { const v4u* wsrc = (const v4u*)(F.ws + WS_WRT); LAS char* wl = (LAS char*)(F.lds + RING_OFF);
      for (int i = F.tid; i < 2 * 32 * 128; i += NWAVES * 64) { const int hl = i >> 12, e = (i >> 7) & 31, c = i & 127; *(LAS v4u*)(wl + hl * 65536 + e * 2048 + ((c ^ (e & 15)) << 4)) = wsrc[i]; } }
    __syncthreads();
    const int tok = F.vcu * 128 + tg * 32 + tl;
    const float* xr = F.x + (size_t)tok * D + kh * 512 + 8 * h;
    const bf16* yr = (const bf16*)(F.ws + WS_Y) + (size_t)tok * D + kh * 512 + 8 * h;
    unsigned char* x1r = (unsigned char*)(F.ws + WS_X1B) + (size_t)tok * D + kh * 512 + 8 * h;
    bf16* x1h = (bf16*)(F.ws + WS_X1H) + (size_t)tok * D + kh * 512 + 8 * h;
    const LAS char* wrow = (const LAS char*)(F.lds + RING_OFF) + tl * 2048;
    f32x16 acc = {}; float ss = 0.f;
    f32x4 xa[2][8]; v4u ya[2][4];
#define RT_LOAD(buf, g) do { _Pragma("unroll") for (int q_ = 0; q_ < 4; ++q_) { xa[buf][2 * q_] = *(const f32x4*)(xr + 64 * (g) + 16 * q_); xa[buf][2 * q_ + 1] = *(const f32x4*)(xr + 64 * (g) + 16 * q_ + 4); \
        ya[buf][q_] = *(const v4u*)(yr + 64 * (g) + 16 * q_); } } while (0)
#define RT_COMP(buf, g) do { _Pragma("unroll") for (int q_ = 0; q_ < 4; ++q_) { const int c_ = (kh * 512 + 64 * (g) + 16 * q_) / 8 + h; \
        const v4u wh = *(const LAS v4u*)(wrow + ((c_ ^ (tl & 15)) << 4)), wl2 = *(const LAS v4u*)(wrow + 65536 + ((c_ ^ (tl & 15)) << 4)); \
        const f32x4 a0 = xa[buf][2 * q_], a1 = xa[buf][2 * q_ + 1]; const v4u yv = ya[buf][q_]; \
        const float x1[8] = {a0.x + bflo(yv.x), a0.y + bfhi(yv.x), a0.z + bflo(yv.y), a0.w + bfhi(yv.y), a1.x + bflo(yv.z), a1.y + bfhi(yv.z), a1.z + bflo(yv.w), a1.w + bfhi(yv.w)}; \
        unsigned hw[4], lw[4]; \
        _Pragma("unroll") for (int p_ = 0; p_ < 4; ++p_) { const float u_ = x1[2 * p_], r_ = x1[2 * p_ + 1]; ss += u_ * u_ + r_ * r_; const unsigned hb = pk2(u_, r_); hw[p_] = hb; lw[p_] = pk2(u_ - bflo(hb), r_ - bfhi(hb)); } \
        const v4u xh = (v4u){hw[0], hw[1], hw[2], hw[3]}, xl = (v4u){lw[0], lw[1], lw[2], lw[3]}; \
        { v2u o8_; o8_.x = fp8x4(x1[0], x1[1], x1[2], x1[3]); o8_.y = fp8x4(x1[4], x1[5], x1[6], x1[7]); *(v2u*)(x1r + 64 * (g) + 16 * q_) = o8_; *(v4u*)(x1h + 64 * (g) + 16 * q_) = xh; } \
        acc = __builtin_amdgcn_mfma_f32_32x32x16_bf16(__builtin_bit_cast(bf16x8, wh), __builtin_bit_cast(bf16x8, xh), acc, 0, 0, 0); \
        acc = __builtin_amdgcn_mfma_f32_32x32x16_bf16(__builtin_bit_cast(bf16x8, wh), __builtin_bit_cast(bf16x8, xl), acc, 0, 0, 0); \
        acc = __builtin_amdgcn_mfma_f32_32x32x16_bf16(__builtin_bit_cast(bf16x8, wl2), __builtin_bit_cast(bf16x8, xh), acc, 0, 0, 0); } } while (0)
    RT_LOAD(0, 0);
#pragma unroll
    for (int g = 0; g < 8; g += 2) {
        RT_LOAD(1, g + 1); RT_COMP(0, g);
        if (g + 2 < 8) RT_LOAD(0, g + 2);
        RT_COMP(1, g + 1);
    }
#undef RT_LOAD
#undef RT_COMP
    __syncthreads();
    if (kh == 1) { LAS float* d = xch + (tg * 64 + lane) * 17;
#pragma unroll
        for (int i = 0; i < 16; ++i) d[i] = acc[i];
        d[16] = ss; }
    __syncthreads();
    if (kh == 0) {
        const LAS float* d = xch + (tg * 64 + lane) * 17;
#pragma unroll
        for (int i = 0; i < 16; ++i) acc[i] += d[i];
        ss += d[16]; ss += __shfl_xor(ss, 32);
        const float rstd = 1.f / sqrtf(ss * (1.f / D) + EPS);
        float lg[16];
#pragma unroll
        for (int i = 0; i < 16; ++i) lg[i] = acc[i] * rstd + F.b_r[4 * h + (i & 3) + 8 * (i >> 2)];
        float cv[8]; int ce[8];
#pragma unroll
        for (int k = 0; k < 4; ++k) { float bv = -INFINITY; int bi = 0;
#pragma unroll
            for (int i = 0; i < 16; ++i) { if (lg[i] > bv) { bv = lg[i]; bi = i; } }
            cv[k] = bv; ce[k] = 4 * h + (bi & 3) + 8 * (bi >> 2);
#pragma unroll
            for (int i = 0; i < 16; ++i) if (i == bi) lg[i] = -INFINITY; }
#pragma unroll
        for (int k = 0; k < 4; ++k) { cv[4 + k] = __shfl_xor(cv[k], 32); ce[4 + k] = __shfl_xor(ce[k], 32); }
        float tv[4]; int te[4];
#pragma unroll
        for (int k = 0; k < 4; ++k) { float bv = -INFINITY; int be = 64, bi = 0;
#pragma unroll
            for (int i = 0; i < 8; ++i) { if (cv[i] > bv || (cv[i] == bv && ce[i] < be)) { bv = cv[i]; be = ce[i]; bi = i; } }
            tv[k] = bv; te[k] = be;
#pragma unroll
            for (int i = 0; i < 8; ++i) if (i == bi) cv[i] = -INFINITY; }
        float gk[4], den = 0.f;
#pragma unroll
        for (int k = 0; k < 4; ++k) { gk[k] = __expf(tv[k] - tv[0]); den += gk[k]; }
        const float inv = 1.f / den;
        if (h == 0) {
#pragma unroll
            for (int k = 0; k < 4; ++k) {
                const unsigned rank = __hip_atomic_fetch_add(lcnt + te[k], 1u, __ATOMIC_RELAXED, __HIP_MEMORY_SCOPE_WORKGROUP);
                const int slot = (tg * 32 + tl) * 4 + k;
                stg[slot * 4] = (unsigned)(tok * 4 + k); stg[slot * 4 + 1] = ((unsigned)te[k] << 16) | rank; stg[slot * 4 + 2] = __builtin_bit_cast(unsigned, gk[k] * inv); stg[slot * 4 + 3] = __builtin_bit_cast(unsigned, rstd);
            }
        }
    }
    __syncthreads();
    if (F.tid < 32) { const unsigned n = lcnt[F.tid]; lcnt[32 + F.tid] = n ? __hip_atomic_fetch_add((unsigned*)(F.ctl + CW_CNT) + F.tid, n, __ATOMIC_RELAXED, __HIP_MEMORY_SCOPE_AGENT) : 0u; }
    __syncthreads();
    { unsigned* list = (unsigned*)(F.ws + WS_LIST); unsigned* lgate = (unsigned*)(F.ws + WS_LGATE); unsigned* lrstd = (unsigned*)(F.ws + WS_LRSTD);
      const unsigned ent = stg[F.tid * 4], er = stg[F.tid * 4 + 1], gb = stg[F.tid * 4 + 2], rb = stg[F.tid * 4 + 3]; const unsigned e = er >> 16, rank = er & 0xffffu;
      const size_t at = (size_t)e * LCAP + lcnt[32 + e] + rank; list[at] = ent; lgate[at] = gb; lrstd[at] = rb; }
    __syncthreads();
}

__device__ __forceinline__ int moe_build_table(Frame& F) {
    LAS unsigned* tbl = (LAS unsigned*)(F.lds + TBL_OFF); LAS unsigned* lcnt = (LAS unsigned*)(F.lds + LCNT_OFF);
    if (F.wave == 0) {
        const int e = F.lane & 31;
        const unsigned cnt = __hip_atomic_load((unsigned*)(F.ctl + CW_CNT) + e, __ATOMIC_RELAXED, __HIP_MEMORY_SCOPE_AGENT);
        const unsigned nt = (cnt + 255u) >> 8; unsigned incl = nt;
#pragma unroll
        for (int o = 1; o < 32; o <<= 1) { const unsigned t = __shfl_up(incl, o); if ((F.lane & 31) >= o) incl += t; }
        if (F.lane < 32) { lcnt[e] = cnt; const unsigned start = incl - nt; for (unsigned j = 0; j < nt; ++j) tbl[start + j] = ((unsigned)e << 16) | j; if (F.lane == 31) F.MISC[16] = incl; }
    }
    __syncthreads();
    return (int)F.MISC[16];
}
struct MoeOrder {
    const LAS unsigned* tbl; const LAS unsigned* lcnt; const unsigned* list; int NMT, G, c, NPN, MPER, RB; size_t bexp; bool a_tiles; const unsigned* lsc; const unsigned* bias; int bexp_f;
    __device__ __forceinline__ bool next(int i, pg8::Unit& u) const {
        const int L = i * G + c, blk = L >> 5, w = L & 31, g = blk * MPER + w / NPN, pn = w % NPN;
        if (g >= NMT) return false;
        const unsigned t = tbl[g]; const int e = (int)(t >> 16), mt = (int)(t & 0xffffu); const int cnt = (int)lcnt[e];
        u.pm = g; u.pn = pn; u.e = e; u.mt = mt; u.valid = min(256, cnt - mt * 256);
        u.aoff = a_tiles ? (size_t)g * (size_t)(256 * RB) : (size_t)0; u.boff = (size_t)e * bexp + (size_t)pn * (size_t)(256 * RB);
        return true;
    }
    __device__ __forceinline__ const unsigned* id_src(const pg8::Unit& u, int row) const { return list + (size_t)u.e * LCAP + u.mt * 256 + min(row, u.valid - 1); }
    __device__ __forceinline__ const unsigned* sc_src(const pg8::Unit& u, int row) const { return lsc + (size_t)u.e * LCAP + u.mt * 256 + min(row, u.valid - 1); }
    __device__ __forceinline__ const unsigned* bias_src(const pg8::Unit& u, int col) const { return bias + (size_t)u.e * bexp_f + u.pn * 256 + col; }
};
struct EpiGU {
    unsigned char* ACT;
    __device__ __forceinline__ void operator()(const pg8::f32x4 (&acc)[2][2][4][2], const pg8::Unit& u, int wr, int wc, int fr, int fq, const LAS unsigned* ids) const {
        asm volatile("" : "+v"(fr), "+v"(fq));
        typedef float f2 __attribute__((ext_vector_type(2)));
        constexpr float CG = 1.702f * LOG2E, KA = ASCALE / CG;
        const int r0 = wr * 64 + fr, f0 = u.pn * 128 + wc * 32 + 8 * fq;
        const LAS float* scl = (const LAS float*)(ids + 256); const LAS float* bl = (const LAS float*)(ids + 512) + 2 * (wc * 32 + 8 * fq);
        float rs[2][4];
#pragma unroll
        for (int ai = 0; ai < 2; ++ai)
#pragma unroll
            for (int m = 0; m < 4; ++m) rs[ai][m] = scl[r0 + ai * 128 + m * 16] * (1.f / WSCALE);
        const pg8::f32x4 b0 = *(const LAS pg8::f32x4*)bl, b1 = *(const LAS pg8::f32x4*)(bl + 4), b2 = *(const LAS pg8::f32x4*)(bl + 8), b3 = *(const LAS pg8::f32x4*)(bl + 12);
        const f2 gb[4] = {f2{b0[0], b0[2]} * CG, f2{b1[0], b1[2]} * CG, f2{b2[0], b2[2]} * CG, f2{b3[0], b3[2]} * CG}, ub[4] = {f2{b0[1], b0[3]}, f2{b1[1], b1[3]}, f2{b2[1], b2[3]}, f2{b3[1], b3[3]}};
#pragma unroll
        for (int ai = 0; ai < 2; ++ai)
#pragma unroll
            for (int m = 0; m < 4; ++m) { const int r = r0 + ai * 128 + m * 16; const float s = rs[ai][m], sg = s * CG; f2 a[4];
#pragma unroll
                for (int q = 0; q < 4; ++q) { const int n = q >> 1, j = 2 * (q & 1);
                    f2 g = f2{acc[ai][0][m][n][j], acc[ai][0][m][n][j + 1]} * sg + gb[q], up = f2{acc[ai][1][m][n][j], acc[ai][1][m][n][j + 1]} * s + ub[q];
                    g.x = fminf(g.x, 7.f * CG); g.y = fminf(g.y, 7.f * CG); up.x = __builtin_amdgcn_fmed3f(up.x, -7.f, 7.f); up.y = __builtin_amdgcn_fmed3f(up.y, -7.f, 7.f);
                    f2 d = f2{__builtin_amdgcn_exp2f(-g.x), __builtin_amdgcn_exp2f(-g.y)} + 1.f;
                    const f2 rc = f2{__builtin_amdgcn_rcpf(d.x), __builtin_amdgcn_rcpf(d.y)};
                    a[q] = ((up * KA + KA) * g) * rc; }
                v2u w; w.x = (unsigned)__builtin_amdgcn_cvt_pk_fp8_f32(a[1].x, a[1].y, __builtin_amdgcn_cvt_pk_fp8_f32(a[0].x, a[0].y, 0, false), true);
                w.y = (unsigned)__builtin_amdgcn_cvt_pk_fp8_f32(a[3].x, a[3].y, __builtin_amdgcn_cvt_pk_fp8_f32(a[2].x, a[2].y, 0, false), true);
                *(v2u*)(ACT + (size_t)(u.pm * 256 + r) * DFF + f0) = w; }
    }
};
struct EpiDown {
    unsigned char* YB;
    __device__ __forceinline__ void operator()(const pg8::f32x4 (&acc)[2][2][4][2], const pg8::Unit& u, int wr, int wc, int fr, int fq, const LAS unsigned* ids) const {
        asm volatile("" : "+v"(fr), "+v"(fq));
        const int r0 = wr * 64 + fr, cl = wc * 32 + 8 * fq, col0 = u.pn * 256 + cl;
        const LAS float* scl = (const LAS float*)(ids + 256); const LAS float* bl = (const LAS float*)(ids + 512) + cl;
        pg8::f32x4 bv[2][2];
#pragma unroll
        for (int bj = 0; bj < 2; ++bj)
#pragma unroll
            for (int n = 0; n < 2; ++n) bv[bj][n] = *(const LAS pg8::f32x4*)(bl + bj * 128 + 4 * n);
#pragma unroll
        for (int ai = 0; ai < 2; ++ai)
#pragma unroll
            for (int m = 0; m < 4; ++m) { const int r = r0 + ai * 128 + m * 16; if (r < u.valid) { const float g = scl[r] * YSCALE; unsigned char* yp = YB + (size_t)ids[r] * D + col0;
#pragma unroll
                for (int bj = 0; bj < 2; ++bj) { const pg8::f32x4 v0 = (acc[ai][bj][m][0] * (1.f / (WSCALE * ASCALE)) + bv[bj][0]) * g, v1 = (acc[ai][bj][m][1] * (1.f / (WSCALE * ASCALE)) + bv[bj][1]) * g;
                    v2u w; w.x = fp8x4(v0[0], v0[1], v0[2], v0[3]); w.y = fp8x4(v1[0], v1[1], v1[2], v1[3]);
                    *(v2u*)(yp + bj * 128) = w; } } }
    }
};
__device__ __forceinline__ void final_phase(Frame& F) {
    const int gw = F.vcu * NWAVES + F.wave, NGW = F.G * NWAVES;
    const unsigned char* YB = (const unsigned char*)(F.ws + WS_YB); const bf16* X1 = (const bf16*)(F.ws + WS_X1H);
    const int c = 16 * F.lane;
    f32x4 gf[4];
#pragma unroll
    for (int q = 0; q < 4; ++q) gf[q] = *(const f32x4*)(F.g_fin + c + 4 * q);
    for (int t = gw; t < T; t += NGW) {
        const v4u xa = *(const v4u*)(X1 + (size_t)t * D + c), xb = *(const v4u*)(X1 + (size_t)t * D + c + 8);
        v4u y[4];
#pragma unroll
        for (int k = 0; k < 4; ++k) y[k] = *(const v4u*)(YB + ((size_t)t * 4 + k) * D + c);
        float v[16];
        { const unsigned xw[8] = {xa.x, xa.y, xa.z, xa.w, xb.x, xb.y, xb.z, xb.w};
#pragma unroll
          for (int q = 0; q < 8; ++q) { v[2 * q] = bflo(xw[q]); v[2 * q + 1] = bfhi(xw[q]); } }
#pragma unroll
        for (int k = 0; k < 4; ++k) { const unsigned yw[4] = {y[k].x, y[k].y, y[k].z, y[k].w};
#pragma unroll
            for (int q = 0; q < 4; ++q) { const auto lo = __builtin_amdgcn_cvt_pk_f32_fp8((int)yw[q], false), hi = __builtin_amdgcn_cvt_pk_f32_fp8((int)yw[q], true);
                v[4 * q] += lo[0] * (1.f / YSCALE); v[4 * q + 1] += lo[1] * (1.f / YSCALE); v[4 * q + 2] += hi[0] * (1.f / YSCALE); v[4 * q + 3] += hi[1] * (1.f / YSCALE); } }
        float ss = 0.f;
#pragma unroll
        for (int i = 0; i < 16; ++i) ss += v[i] * v[i];
        const float rstd = 1.f / sqrtf(wave_sum(ss) * (1.f / D) + EPS);
#pragma unroll
        for (int q = 0; q < 4; ++q) { f32x4 o; o.x = v[4 * q] * rstd * gf[q].x; o.y = v[4 * q + 1] * rstd * gf[q].y; o.z = v[4 * q + 2] * rstd * gf[q].z; o.w = v[4 * q + 3] * rstd * gf[q].w;
            *(f32x4*)(F.out + (size_t)t * D + c + 4 * q) = o; }
    }
}
struct Args { const float* in[17]; float* out; unsigned char* ws; int ph_lo, ph_hi, use_bar, pad; };
__global__ void __launch_bounds__(NWAVES * 64, 2) mk_fwd(Args args) {
    extern __shared__ __attribute__((aligned(16))) unsigned char lds[];
    Frame F;
    F.lds = (LAS unsigned char*)lds;
    F.MISC = (volatile LAS unsigned*)(F.lds + MISC_OFF);
    F.tid = threadIdx.x; F.lane = F.tid & 63; F.wave = __builtin_amdgcn_readfirstlane(F.tid >> 6);
    F.G = gridDim.x; { const int bx = blockIdx.x; F.vcu = (F.G % 8 == 0) ? (bx % 8) * (F.G / 8) + bx / 8 : bx; }
    F.ws = args.ws; F.out = args.out; F.ctl = (gu32*)(args.ws + WS_CTL);
    F.x = args.in[0]; F.mem = args.in[1]; F.g_attn = args.in[2]; F.g_mem = args.in[3]; F.w_in = args.in[4]; F.lamqk = args.in[5]; F.subg = args.in[6]; F.w_mkv = args.in[7];
    F.w_out = args.in[8]; F.g_ffn = args.in[9]; F.w_r = args.in[10]; F.b_r = args.in[11]; F.w_gu = args.in[12]; F.b_gu = args.in[13]; F.w_dn = args.in[14]; F.b_dn = args.in[15]; F.g_fin = args.in[16];
    for (int u = F.tid; u < (LDS_BYTES - LDSCTL_OFF) / 4; u += NWAVES * 64) ((LAS unsigned*)(F.lds + LDSCTL_OFF))[u] = 0u;
    __syncthreads();
    XcdBarrier bar; bar.bar = (unsigned*)(F.ctl + CW_BAR); bar.x = 0; bar.st = nullptr;
    if (args.use_bar) bar = xcd_barrier_post((unsigned*)(F.ctl + CW_BAR), F.MISC + 8);
    const int lo = args.ph_lo, hi = args.ph_hi;
#define IN(k) (lo <= (k) && (k) < hi)
#define SEAM(k) do { if (IN(k) && IN((k) + 1)) xcd_barrier(bar); } while (0)
    if (IN(0)) { p0_prologue(F); } SEAM(0);
    if (IN(1)) {
        pg8::Gemm g{(const void*)(F.ws + WS_XB), (const void*)(F.ws + WS_WIN), 2 * D}; pg8::StaticOrder S; S.init(T, DIN, 2 * D, F.G, (int)blockIdx.x, (const unsigned*)(F.ws + WS_RSTD1));
        EpiInProj E{(bf16*)(F.ws + WS_P), (const float*)(F.ws + WS_RSTD1), (unsigned*)(F.ctl + CW_NRM)};
        pg8::gemm_phase<EpiInProj, pg8::StaticOrder, true, false, true>(F.lds + RING_OFF, (LAS unsigned*)(F.lds + IDB_OFF), g, S, E);
    } SEAM(1);
    if (IN(2)) { attn_phase(F, (char*)lds + RING_OFF); } SEAM(2);
    if (IN(3)) { dil_combine_phase(F); } SEAM(3);
    if (IN(4)) {
        pg8::Gemm g{(const void*)(F.ws + WS_MIX), (const void*)(F.ws + WS_WOUT), 2 * D}; pg8::StaticOrder S; S.init(T, D, 2 * D, F.G, (int)blockIdx.x);
        EpiY E{(bf16*)(F.ws + WS_Y)};
        pg8::gemm_phase<EpiY, pg8::StaticOrder, true, false, false>(F.lds + RING_OFF, (LAS unsigned*)(F.lds + IDB_OFF), g, S, E);
    } SEAM(4);
    if (IN(5)) { route_phase(F); } SEAM(5);
    if (IN(6)) {
        const int nmt = moe_build_table(F);
        pg8::Gemm g{(const void*)(F.ws + WS_X1B), (const void*)(F.ws + WS_WGU), D};
        MoeOrder S{(const LAS unsigned*)(F.lds + TBL_OFF), (const LAS unsigned*)(F.lds + LCNT_OFF), (const unsigned*)(F.ws + WS_LIST), nmt, F.G, F.vcu, 8, 4, D, (size_t)2 * DFF * D, false, (const unsigned*)(F.ws + WS_LRSTD), (const unsigned*)F.b_gu, 2 * DFF};
        EpiGU E{(unsigned char*)(F.ws + WS_ACT)};
        pg8::gemm_phase<EpiGU, MoeOrder, true, true, true, true>(F.lds + RING_OFF, (LAS unsigned*)(F.lds + IDB_OFF), g, S, E);
    } SEAM(6);
    if (IN(7)) {
        const int nmt = moe_build_table(F);
        pg8::Gemm g{(const void*)(F.ws + WS_ACT), (const void*)(F.ws + WS_WDN), DFF};
        MoeOrder S{(const LAS unsigned*)(F.lds + TBL_OFF), (const LAS unsigned*)(F.lds + LCNT_OFF), (const unsigned*)(F.ws + WS_LIST), nmt, F.G, F.vcu, 4, 8, DFF, (size_t)D * DFF, true, (const unsigned*)(F.ws + WS_LGATE), (const unsigned*)F.b_dn, D};
        EpiDown E{(unsigned char*)(F.ws + WS_YB)};
        pg8::gemm_phase<EpiDown, MoeOrder, true, true, true, true, true>(F.lds + RING_OFF, (LAS unsigned*)(F.lds + IDB_OFF), g, S, E);
    } SEAM(7);
    if (IN(8)) { final_phase(F); }
#undef IN
#undef SEAM
}

static void launch_phases(const Args& base, int lo, int hi, int use_bar, int grid, hipStream_t stream) {
    Args a = base; a.ph_lo = lo; a.ph_hi = hi; a.use_bar = use_bar;
    hipLaunchKernelGGL(mk_fwd, dim3(grid), dim3(NWAVES * 64), LDS_BYTES, stream, a);
}
extern "C" void kernel_launch(void* const* d_in, const int* in_sizes, int n_in, void* d_out, int out_size, void* d_ws, size_t ws_size, hipStream_t stream) {
    static int grid = 0;
    if (grid == 0) {
        if (n_in != 17 || in_sizes[0] != T * D || out_size != T * D || ws_size < (size_t)1000 * MiB) { fprintf(stderr, "kernel_launch: unexpected shapes / workspace (%d inputs, ws %zu)\n", n_in, ws_size); grid = -1; return; }
        int dev = 0, cus = 0, per_cu = 0;
        if (hipGetDevice(&dev) != hipSuccess || hipDeviceGetAttribute(&cus, hipDeviceAttributeMultiprocessorCount, dev) != hipSuccess) { grid = -1; return; }
        if (hipFuncSetAttribute((const void*)mk_fwd, hipFuncAttributeMaxDynamicSharedMemorySize, LDS_BYTES) != hipSuccess) { fprintf(stderr, "kernel_launch: hipFuncSetAttribute failed\n"); grid = -1; return; }
        if (hipOccupancyMaxActiveBlocksPerMultiprocessor(&per_cu, (const void*)mk_fwd, NWAVES * 64, LDS_BYTES) != hipSuccess || per_cu < 1) { fprintf(stderr, "kernel_launch: occupancy query says %d blocks per CU\n", per_cu); per_cu = 1; }
        (void)hipGetLastError();
        grid = cus;
        if (grid != 256) { fprintf(stderr, "kernel_launch: built for a 256-CU device (got %d)\n", cus); grid = -1; return; }
    }
    if (grid < 0) return;
    (void)hipMemsetAsync((char*)d_ws + WS_CTL, 0, CTL_ZERO_BYTES, stream);
    Args a{};
    for (int i = 0; i < 17; ++i) a.in[i] = (const float*)d_in[i];
    a.out = (float*)d_out; a.ws = (unsigned char*)d_ws;
    launch_phases(a, 0, 9, 1, grid, stream);
}
```

```cpp
#include <hip/hip_runtime.h>
#include <hip/hip_bf16.h>
#include <cstdint>
#include <cstdio>
#include <cmath>

constexpr int D = 1024, BATCH = 8, SEQ = 4096, T = BATCH * SEQ, DIN = 2560, NMEM = 256, NE = 32, DFF = 1024;
constexpr int C_DQ = 0, C_DK = 512, C_DV = 1024, C_LQ = 1536, C_LK = 1792, C_LV = 2048, C_MQ = 2304;
constexpr float EPS = 1e-5f;
constexpr int LCAP = T;
constexpr float QSCALE = 0.125f * 1.4426950408889634f;
constexpr float LOG2E = 1.4426950408889634f;
namespace pg8 {
#define PG8_LAS __attribute__((address_space(3)))
typedef unsigned short bf16_t;
typedef short bf16x8 __attribute__((ext_vector_type(8)));
typedef float f32x4 __attribute__((ext_vector_type(4)));
typedef unsigned u32x4 __attribute__((ext_vector_type(4)));
typedef unsigned u32x2 __attribute__((ext_vector_type(2)));
constexpr int BM = 256, BK = 64, HALF = 128, HTB = HALF * BK * 2  , STAGE_BYTES = 8 * HTB, NXCD = 8, WGM = 8;

__host__ __device__ __forceinline__ int lds_byte(int r, int c) { const int st = (r >> 4) * 2 + (c >> 5), rr = r & 15, cc = c & 31, ob = rr * 64 + cc * 2; return st * 1024 + (ob ^ (((ob >> 9) & 1) << 5)); }
__host__ __device__ __forceinline__ void stage_rc(int b, int& R, int& C) { const int st = b / 1024, sb = b % 1024, swz = sb ^ (((sb >> 9) & 1) << 5); R = (st >> 1) * 16 + swz / 64; C = (st & 1) * 32 + (swz % 64) / 2; }
__host__ __device__ __forceinline__ int perm32(int rho) { const int n = rho >> 4, i = rho & 15; return 8 * (i >> 2) + 4 * n + (i & 3); }

struct Unit { size_t aoff, boff; int pm, pn, e, valid, mt; };
struct Gemm { const void* A; const void* Bt; int RB; };
typedef int v8i __attribute__((ext_vector_type(8)));

struct StaticOrder {
    int nM, nN, nwg, G, c, RB; const unsigned* sc;
    __device__ void init(int M, int N, int RB_, int G_, int c_, const unsigned* sc_ = nullptr) { nM = M / BM; nN = N / BM; nwg = nM * nN; G = G_; c = c_; RB = RB_; sc = sc_; }
    __device__ bool next(int i, Unit& u) const {
        const long L = (long)i * G + c; if (L >= nwg) return false;
        int wgid = (int)L; { const int q = nwg / NXCD, r = nwg % NXCD, xcd = wgid % NXCD, off = wgid / NXCD; wgid = (xcd < r ? xcd * (q + 1) : r * (q + 1) + (xcd - r) * q) + off; }
        const int nig = WGM * nN, gid = wgid / nig, fm = gid * WGM, gsz = (nM - fm) < WGM ? (nM - fm) : WGM;
        u.pm = fm + ((wgid % nig) % gsz); u.pn = (wgid % nig) / gsz; u.e = 0; u.valid = 256; u.mt = 0;
        u.aoff = (size_t)u.pm * (size_t)(BM * RB); u.boff = (size_t)u.pn * (size_t)(BM * RB); return true;
    }
    __device__ __forceinline__ const unsigned* id_src(const Unit& u, int row) const { return sc + u.pm * 256 + row; }
    __device__ __forceinline__ const unsigned* sc_src(const Unit& u, int row) const { return sc + u.pm * 256 + row; }
    __device__ __forceinline__ const unsigned* bias_src(const Unit& u, int row) const { return sc + u.pm * 256 + row; }
};

__device__ __forceinline__ unsigned cvt_pk_bf16(float lo, float hi) { unsigned r; asm volatile("v_cvt_pk_bf16_f32 %0, %1, %2" : "=v"(r) : "v"(lo), "v"(hi)); return r; }

template <class Epi, class Sched, bool ALIGN_EPI, bool GATHER, bool IDS, bool FP8 = false, bool LINEAR = false>
__device__ __forceinline__ void gemm_phase(PG8_LAS unsigned char* lds, PG8_LAS unsigned* idb, const Gemm g, const Sched& S, const Epi& E) {
    const int tid = threadIdx.x, wid = __builtin_amdgcn_readfirstlane(tid >> 6), lane = tid & 63, wr = wid >> 2, wc = wid & 3, fr = lane & 15, fq = lane >> 4;
    const int RB = g.RB; int nt = RB / (BK * 2); asm volatile("" : "+s"(nt));
    unsigned voffA[2], voffB[2]; int RA[2], CA[2];
#pragma unroll
    for (int i = 0; i < 2; ++i) { int R, C; stage_rc(tid * 16 + i * 8192, R, C); const int Rb = (R & ~31) + perm32(R & 31); RA[i] = R; CA[i] = C;
        voffA[i] = (unsigned)(R * RB + C * 2); voffB[i] = (unsigned)(Rb * RB + C * 2); }
    const size_t kstep = (size_t)(BK * 2);
    const size_t hstep = (size_t)HALF * RB;
    const unsigned ldsw = (unsigned)wid * 1024u;
    const int aoff = lds_byte(wr * 64 + fr, fq * 8), boff = lds_byte(wc * 32 + fr, fq * 8);
#define PG8_SA(b, h) (((b) * 2 + (h)) * HTB)
#define PG8_SB(b, h) ((4 + (b) * 2 + (h)) * HTB)
#define PG8_STAGE(bufoff, gbase, voff) do { _Pragma("unroll") for (int _i = 0; _i < 2; ++_i) \
        __builtin_amdgcn_global_load_lds((const unsigned*)((const char*)(gbase) + (voff)[_i]), (PG8_LAS unsigned*)(lds + (bufoff) + ldsw + _i * 8192), 16, 0, 0); } while (0)
#define PG8_STAGE_A(bufoff, pbase, gbase, h, gv) do { if constexpr (GATHER) { PG8_STAGE(bufoff, gbase, gv[h]); } else { PG8_STAGE(bufoff, (pbase) + (h) * hstep, voffA); } } while (0)
#define PG8_LD32(p0_, p1_) __builtin_bit_cast(v8i, __builtin_shufflevector(*(const PG8_LAS u32x4*)(p0_), *(const PG8_LAS u32x4*)(p1_), 0, 1, 2, 3, 4, 5, 6, 7))
#define PG8_LDA(dst, b, h) do { if constexpr (FP8) { _Pragma("unroll") for (int m = 0; m < 4; ++m) dst##8[m] = PG8_LD32(lds + PG8_SA(b, h) + aoff + m * 2048, lds + PG8_SA(b, h) + aoff + m * 2048 + 1024); } \
        else { _Pragma("unroll") for (int m = 0; m < 4; ++m) _Pragma("unroll") for (int k = 0; k < 2; ++k) dst[m][k] = *(const PG8_LAS bf16x8*)(lds + PG8_SA(b, h) + aoff + m * 2048 + k * 1024); } } while (0)
#define PG8_LDB(dst, b, h) do { if constexpr (FP8) { _Pragma("unroll") for (int n = 0; n < 2; ++n) dst##8[n] = PG8_LD32(lds + PG8_SB(b, h) + boff + n * 2048, lds + PG8_SB(b, h) + boff + n * 2048 + 1024); } \
        else { _Pragma("unroll") for (int n = 0; n < 2; ++n) _Pragma("unroll") for (int k = 0; k < 2; ++k) dst[n][k] = *(const PG8_LAS bf16x8*)(lds + PG8_SB(b, h) + boff + n * 2048 + k * 1024); } } while (0)
#define PG8_MMA(ai, bj, At, Bt) do { __builtin_amdgcn_s_setprio(1); if constexpr (FP8) { _Pragma("unroll") for (int m = 0; m < 4; ++m) _Pragma("unroll") for (int n = 0; n < 2; ++n) \
        acc[ai][bj][m][n] = __builtin_amdgcn_mfma_scale_f32_16x16x128_f8f6f4(Bt##8[n], At##8[m], acc[ai][bj][m][n], 0, 0, 0, sca_, 0, 0x7f7f7f7f); } \
        else { _Pragma("unroll") for (int m = 0; m < 4; ++m) _Pragma("unroll") for (int n = 0; n < 2; ++n) _Pragma("unroll") for (int k = 0; k < 2; ++k) \
        acc[ai][bj][m][n] = __builtin_amdgcn_mfma_f32_16x16x32_bf16(Bt[n][k], At[m][k], acc[ai][bj][m][n], 0, 0, 0); } __builtin_amdgcn_s_setprio(0); } while (0)
#define PG8_WAIT_V(n) asm volatile("s_waitcnt vmcnt(" #n ")" ::: "memory")
#define PG8_WAIT_L(n) asm volatile("s_waitcnt lgkmcnt(" #n ")" ::: "memory")
#define PG8_BAR __builtin_amdgcn_s_barrier()
#define PG8_SCHED __builtin_amdgcn_sched_barrier(0)
#define PG8_IDS_DMA(u, s) do { if (wid < 4) { __builtin_amdgcn_global_load_lds(S.id_src(u, tid), (PG8_LAS unsigned*)(idb + (s) * 768 + wid * 64), 4, 0, 0); \
        __builtin_amdgcn_global_load_lds(S.sc_src(u, tid), (PG8_LAS unsigned*)(idb + (s) * 768 + 256 + wid * 64), 4, 0, 0); \
        __builtin_amdgcn_global_load_lds(S.bias_src(u, tid), (PG8_LAS unsigned*)(idb + (s) * 768 + 512 + wid * 64), 4, 0, 0); } } while (0)
#define PG8_GV(dst, s, un) do { _Pragma("unroll") for (int _h = 0; _h < 2; ++_h) _Pragma("unroll") for (int _i = 0; _i < 2; ++_i) \
        dst[_h][_i] = (LINEAR ? (unsigned)((un).pm * 256 + _h * 128 + RA[_i]) : (idb[(s) * 768 + _h * 128 + RA[_i]] >> 2)) * (unsigned)RB + (unsigned)(CA[_i] * 2); } while (0)
    Unit cur, nxt; int ui = 0, us = 0;
    if (!S.next(0, cur)) return;
    f32x4 acc[2][2][4][2];
#pragma unroll
    for (int a = 0; a < 2; ++a)
#pragma unroll
        for (int b = 0; b < 2; ++b)
#pragma unroll
            for (int m = 0; m < 4; ++m)
#pragma unroll
                for (int n = 0; n < 2; ++n) acc[a][b][m][n] = (f32x4){0.f, 0.f, 0.f, 0.f};
    bf16x8 At[4][2], B0[2][2], B1[2][2]; v8i At8[4], B08[2], B18[2];
    unsigned cv[2][2] = {{0u, 0u}, {0u, 0u}};
    const char* A0 = (const char*)g.A;
    const char* cA = A0 + (GATHER ? (size_t)0 : cur.aoff); const char* cB = (const char*)g.Bt + cur.boff;
    if constexpr (IDS) {
        PG8_IDS_DMA(cur, 0); PG8_WAIT_V(0); PG8_BAR;
    }
    if constexpr (GATHER) { PG8_GV(cv, 0, cur); }
    PG8_STAGE(PG8_SB(0, 0), cB, voffB); PG8_STAGE(PG8_SB(0, 1), cB + hstep, voffB); PG8_STAGE_A(PG8_SA(0, 0), cA, A0, 0, cv); PG8_STAGE_A(PG8_SA(0, 1), cA, A0, 1, cv);
    if (wr == 1) PG8_BAR;
    PG8_WAIT_V(2); PG8_BAR;
    PG8_STAGE(PG8_SB(1, 0), cB + kstep, voffB); PG8_STAGE_A(PG8_SA(1, 0), cA + kstep, A0 + kstep, 0, cv); PG8_STAGE(PG8_SB(1, 1), cB + hstep + kstep, voffB);
    PG8_WAIT_V(6); PG8_BAR;
    for (;;) {
        const bool has_next = S.next(ui + 1, nxt);
        const int ns = (us == 2) ? 0 : us + 1;
        if constexpr (IDS) { if (has_next) PG8_IDS_DMA(nxt, ns); }
        const char* nA = has_next ? A0 + (GATHER ? (size_t)0 : nxt.aoff) : cA; const char* nB = has_next ? (const char*)g.Bt + nxt.boff : cB;
#ifdef PROBE_KTWICE
        for (int rep_ = 0; rep_ < (FP8 ? 2 : 1); ++rep_) { const int sca_ = rep_ ? 0 : 0x7f7f7f7f;
#else
        { const int sca_ = 0x7f7f7f7f;
#endif
#pragma nounroll
        for (int t = 0; t < nt; t += 2) {
            int lastv = (t == nt - 2) ? 1 : 0; asm volatile("" : "+v"(lastv)); const bool last = __builtin_amdgcn_readfirstlane(lastv) != 0;
            const char* a1 = cA + (size_t)(t + 1) * kstep;
            const char* a2 = last ? nA : cA + (size_t)(t + 2) * kstep; const char* b2 = last ? nB : cB + (size_t)(t + 2) * kstep;
            const char* a3 = a2 + kstep; const char* b3 = b2 + kstep;
            PG8_LDB(B0, 0, 0); PG8_LDB(B1, 0, 1); PG8_SCHED; PG8_LDA(At, 0, 0); PG8_STAGE_A(PG8_SA(1, 1), a1, a1, 1, cv);
            if constexpr (GATHER) { if (last && has_next) { PG8_GV(cv, ns, nxt); } }
            PG8_WAIT_V(8); PG8_WAIT_L(0); PG8_BAR; PG8_MMA(0, 0, At, B0); PG8_MMA(0, 1, At, B1); PG8_BAR; PG8_SCHED;
            PG8_LDA(At, 0, 1); PG8_STAGE(PG8_SB(0, 0), b2, voffB); PG8_STAGE(PG8_SB(0, 1), b2 + hstep, voffB); PG8_STAGE_A(PG8_SA(0, 0), a2, a2, 0, cv);
            PG8_WAIT_V(8); PG8_WAIT_L(0); PG8_BAR; PG8_MMA(1, 0, At, B0); PG8_MMA(1, 1, At, B1); PG8_BAR; PG8_SCHED;
            PG8_LDB(B0, 1, 0); PG8_LDB(B1, 1, 1); PG8_SCHED; PG8_LDA(At, 1, 0); PG8_STAGE_A(PG8_SA(0, 1), a2, a2, 1, cv);
            PG8_WAIT_V(8); PG8_WAIT_L(0); PG8_BAR; PG8_MMA(0, 0, At, B0); PG8_MMA(0, 1, At, B1); PG8_BAR; PG8_SCHED;
            PG8_LDA(At, 1, 1); PG8_STAGE(PG8_SB(1, 0), b3, voffB); PG8_STAGE(PG8_SB(1, 1), b3 + hstep, voffB); PG8_STAGE_A(PG8_SA(1, 0), a3, a3, 0, cv);
            PG8_WAIT_V(8); PG8_WAIT_L(0); PG8_BAR; PG8_MMA(1, 0, At, B0); PG8_MMA(1, 1, At, B1); PG8_BAR; PG8_SCHED;
        }
        }
        if constexpr (ALIGN_EPI) { if (wr == 0) PG8_BAR; }
        PG8_SCHED;
        E(acc, cur, wr, wc, fr, fq, (const PG8_LAS unsigned*)(idb + us * 768));
        PG8_SCHED;
#ifdef PROBE_EPI2
        if constexpr (FP8) { E(acc, cur, wr, wc, fr, fq, (const PG8_LAS unsigned*)(idb + us * 768)); PG8_SCHED; }
#endif
        if (!has_next) break;
#pragma unroll
        for (int a = 0; a < 2; ++a)
#pragma unroll
            for (int b = 0; b < 2; ++b)
#pragma unroll
                for (int m = 0; m < 4; ++m)
#pragma unroll
                    for (int n = 0; n < 2; ++n) acc[a][b][m][n] = (f32x4){0.f, 0.f, 0.f, 0.f};
        cur = nxt; cA = nA; cB = nB; ++ui; us = ns;
        if constexpr (ALIGN_EPI) { if (wr == 1) PG8_BAR; }
    }
    PG8_WAIT_V(0);
    if constexpr (!ALIGN_EPI) { if (wr == 0) PG8_BAR; }
    PG8_BAR;
#undef PG8_SA
#undef PG8_SB
#undef PG8_STAGE
#undef PG8_STAGE_A
#undef PG8_LDA
#undef PG8_LDB
#undef PG8_MMA
#undef PG8_LD32
#undef PG8_WAIT_V
#undef PG8_WAIT_L
#undef PG8_BAR
#undef PG8_SCHED
#undef PG8_IDS_DMA
#undef PG8_GV
}
}
namespace attn_body {
using bf16=__hip_bfloat16;
using bf16x8=__attribute__((ext_vector_type(8)))short;
using s16x4=__attribute__((ext_vector_type(4)))short;
using f32x16=__attribute__((ext_vector_type(16)))float;
using u32x4=__attribute__((ext_vector_type(4)))unsigned;
constexpr int D=64;
constexpr int NW=8,QBLK=32,QB=QBLK*NW,KVBLK=64;
struct UnitP { const bf16* Q; const bf16* K; const bf16* V; bf16* O; long qp, kp, op; int q0, t0, NT; float slope2; float* lse; int lse_stride; };
__device__ __forceinline__ int crow(int r,int hi){return (r&3)+8*(r>>2)+4*hi;}
#define SBAR() __builtin_amdgcn_sched_barrier(0)
template<bool CAUSAL,bool WINDOW> __device__ __forceinline__ void cmask(f32x16&p0,f32x16&p1,int jb,int qrel,int hi){
  const float NEG=-INFINITY; int kb=64*jb+4*hi;
  #pragma unroll
  for(int r=0;r<16;++r){int kv=kb+(r&3)+8*(r>>2);
    if(CAUSAL){ if(kv>qrel)p0[r]=NEG; if(kv+32>qrel)p1[r]=NEG; }
    if(WINDOW){ if(kv<qrel-128)p0[r]=NEG; if(kv+32<qrel-128)p1[r]=NEG; } }
}
__device__ __forceinline__ unsigned bfr(float x){ typedef float f2_ __attribute__((ext_vector_type(2))); typedef __bf16 b2_ __attribute__((ext_vector_type(2))); f2_ v={x,0.f}; b2_ b=__builtin_convertvector(v,b2_); return __builtin_bit_cast(unsigned,b)&0xffffu; }
__device__ __forceinline__ float bfv(unsigned b){ return __builtin_bit_cast(float,b<<16); }

constexpr int NSLOT=3, SLOTB=8192;
constexpr int LDS_K=0, LDS_V=NSLOT*SLOTB;
template<int DV> struct Lds { static constexpr int SLOTV=SLOTB*(DV/64), WS=LDS_V+NSLOT*SLOTV, OST=WS+NW*64*4, OSTW=4096*(DV/64), BYTES=OST+NW*OSTW; };
__device__ __forceinline__ void glds16(const void*gsrc,unsigned lds_dst){unsigned keep;
  asm volatile("s_mov_b32 %0, m0\n\ts_mov_b32 m0, %2\n\ts_nop 0\n\tglobal_load_lds_dwordx4 %1, off\n\ts_mov_b32 m0, %0":"=&s"(keep):"v"(gsrc),"s"(lds_dst):"memory");}
__device__ __forceinline__ float max3f(float a,float b,float c){float r;asm("v_max3_f32 %0, %1, %2, %3":"=v"(r):"v"(a),"v"(b),"v"(c));return r;}
__device__ __forceinline__ float max2f(float a,float b){float r;asm("v_max_f32_e32 %0, %1, %2":"=v"(r):"v"(a),"v"(b));return r;}
__device__ __forceinline__ float fadd_s(float a,float b){float r;asm("v_add_f32_e32 %0, %1, %2":"=v"(r):"v"(a),"v"(b));return r;}
__device__ __forceinline__ float fsub_s(float a,float b){float r;asm("v_sub_f32_e32 %0, %1, %2":"=v"(r):"v"(a),"v"(b));return r;}
typedef float f32x2_t __attribute__((ext_vector_type(2))); typedef __bf16 bf16x2_t __attribute__((ext_vector_type(2)));
__device__ __forceinline__ unsigned cvtpk_s(float lo,float hi){f32x2_t v={lo,hi};bf16x2_t b=__builtin_convertvector(v,bf16x2_t);return __builtin_bit_cast(unsigned,b);}
#define WAIT_BAR(N) asm volatile("s_waitcnt vmcnt(" #N ") lgkmcnt(0)\n\ts_barrier":::"memory")

__device__ __forceinline__ void qkt(f32x16&p0,f32x16&p1,const char*Kslot,const bf16x8*qr,bf16x8 kx0,bf16x8 kx1,bf16x8 qx,int r32,int hi){
  const char*kb=Kslot+hi*1024+r32*16;
  #pragma unroll
  for(int d0=0;d0<4;++d0){
    const bf16x8 b0=*reinterpret_cast<const bf16x8*>(kb+d0*2048);
    const bf16x8 b1=*reinterpret_cast<const bf16x8*>(kb+d0*2048+512);
    if(d0==0){p0=__builtin_amdgcn_mfma_f32_32x32x16_bf16(b0,qr[0],f32x16{},0,0,0);p1=__builtin_amdgcn_mfma_f32_32x32x16_bf16(b1,qr[0],f32x16{},0,0,0);}
    else{p0=__builtin_amdgcn_mfma_f32_32x32x16_bf16(b0,qr[d0],p0,0,0,0);p1=__builtin_amdgcn_mfma_f32_32x32x16_bf16(b1,qr[d0],p1,0,0,0);}}
  p0=__builtin_amdgcn_mfma_f32_32x32x16_bf16(kx0,qx,p0,0,0,0);p1=__builtin_amdgcn_mfma_f32_32x32x16_bf16(kx1,qx,p1,0,0,0);
}
typedef __attribute__((address_space(3))) const char* lds_cptr;
typedef short v4i16_t __attribute__((ext_vector_type(4)));
__device__ __forceinline__ void kload8(bf16x8*kf,lds_cptr kp){
  kf[0]=*(const __attribute__((address_space(3))) bf16x8*)(kp);      kf[1]=*(const __attribute__((address_space(3))) bf16x8*)(kp+512);
  kf[2]=*(const __attribute__((address_space(3))) bf16x8*)(kp+2048); kf[3]=*(const __attribute__((address_space(3))) bf16x8*)(kp+2560);
  kf[4]=*(const __attribute__((address_space(3))) bf16x8*)(kp+4096); kf[5]=*(const __attribute__((address_space(3))) bf16x8*)(kp+4608);
  kf[6]=*(const __attribute__((address_space(3))) bf16x8*)(kp+6144); kf[7]=*(const __attribute__((address_space(3))) bf16x8*)(kp+6656);
}
__device__ __forceinline__ void kload2(bf16x8*kf,lds_cptr kp,int j){ kf[2*j]=*(const __attribute__((address_space(3))) bf16x8*)(kp+j*2048); kf[2*j+1]=*(const __attribute__((address_space(3))) bf16x8*)(kp+j*2048+512); }
__device__ __forceinline__ s16x4 vtr(lds_cptr p){ return __builtin_bit_cast(s16x4,__builtin_amdgcn_ds_read_tr16_b64_v4i16((__attribute__((address_space(3))) v4i16_t*)p)); }
__device__ __forceinline__ float rowmax(const f32x16&p0,const f32x16&p1){
  float a=max3f(p0[0],p0[1],p1[0]),b=max3f(p0[2],p0[3],p1[1]);a=max3f(a,p1[2],p1[3]);
  #pragma unroll
  for(int r=4;r<16;r+=4){a=max3f(a,p0[r],p0[r+1]);b=max3f(b,p0[r+2],p0[r+3]);a=max3f(a,p1[r],p1[r+1]);b=max3f(b,p1[r+2],p1[r+3]);}
  const float m=max2f(a,b);
  auto rr=__builtin_amdgcn_permlane32_swap(__float_as_uint(m),__float_as_uint(m),false,false);
  return max2f(__uint_as_float(rr[0]),__uint_as_float(rr[1]));
}
__device__ __forceinline__ void pv(f32x16*o,int vb,bf16x8 pa0,bf16x8 pa1,bf16x8 pa2,bf16x8 pa3){
  #pragma unroll
  for(int d0=0;d0<2;++d0){s16x4 lo[4],hi[4];
    #pragma unroll
    for(int ks=0;ks<4;++ks){
      asm volatile("ds_read_b64_tr_b16 %0,%1 offset:%c2":"=&v"(lo[ks]):"v"(vb),"i"(d0*4096+ks*1024):"memory");
      asm volatile("ds_read_b64_tr_b16 %0,%1 offset:%c2":"=&v"(hi[ks]):"v"(vb),"i"(d0*4096+ks*1024+512):"memory");}
    asm volatile("s_waitcnt lgkmcnt(0)":::"memory");SBAR();
    #define PK(k) (bf16x8){lo[k][0],lo[k][1],lo[k][2],lo[k][3],hi[k][0],hi[k][1],hi[k][2],hi[k][3]}
    o[d0]=__builtin_amdgcn_mfma_f32_32x32x16_bf16(pa0,PK(0),o[d0],0,0,0);
    o[d0]=__builtin_amdgcn_mfma_f32_32x32x16_bf16(pa1,PK(1),o[d0],0,0,0);
    o[d0]=__builtin_amdgcn_mfma_f32_32x32x16_bf16(pa2,PK(2),o[d0],0,0,0);
    o[d0]=__builtin_amdgcn_mfma_f32_32x32x16_bf16(pa3,PK(3),o[d0],0,0,0);
    #undef PK
  }
}

__device__ __forceinline__ void pv128(f32x16*o,int vb,bf16x8 pa0,bf16x8 pa1,bf16x8 pa2,bf16x8 pa3){
  #pragma unroll
  for(int d0=0;d0<4;++d0){s16x4 lo[4],hi[4];
    #pragma unroll
    for(int ks=0;ks<4;++ks){
      asm volatile("ds_read_b64_tr_b16 %0,%1 offset:%c2":"=&v"(lo[ks]):"v"(vb),"i"(d0*4096+ks*1024):"memory");
      asm volatile("ds_read_b64_tr_b16 %0,%1 offset:%c2":"=&v"(hi[ks]):"v"(vb),"i"(d0*4096+ks*1024+512):"memory");}
    asm volatile("s_waitcnt lgkmcnt(0)":::"memory");SBAR();
    #define PK(k) (bf16x8){lo[k][0],lo[k][1],lo[k][2],lo[k][3],hi[k][0],hi[k][1],hi[k][2],hi[k][3]}
    o[d0]=__builtin_amdgcn_mfma_f32_32x32x16_bf16(pa0,PK(0),o[d0],0,0,0);
    o[d0]=__builtin_amdgcn_mfma_f32_32x32x16_bf16(pa1,PK(1),o[d0],0,0,0);
    o[d0]=__builtin_amdgcn_mfma_f32_32x32x16_bf16(pa2,PK(2),o[d0],0,0,0);
    o[d0]=__builtin_amdgcn_mfma_f32_32x32x16_bf16(pa3,PK(3),o[d0],0,0,0);
    #undef PK
  }
}
#ifndef ATTN_STORE16
#define ATTN_STORE16(p,v) (*(u32x4*)(p)=(v))
#endif
template<int THRL,bool CAUSAL,bool WINDOW,bool ALIBI,bool LSE,int DV=64> __device__ __forceinline__ void attn_unit(const UnitP&U,char*shm){
  constexpr int LDS_WS=Lds<DV>::WS, LDS_OST=Lds<DV>::OST, VMUL=DV/64;
  int tid=threadIdx.x; asm volatile("":"+v"(tid));
  const int lane=tid&63,r32=lane&31,hi=lane>>5; const int wid=__builtin_amdgcn_readfirstlane(tid>>6);
  const int q0=U.q0; const long qp=U.qp,kp=U.kp,op=U.op; const float slope2=U.slope2;
  const bf16*Qw=U.Q+(long)(q0+wid*QBLK)*qp;
  const bf16*Kh=U.K+(long)U.t0*KVBLK*kp,*Vh=U.V+(long)U.t0*KVBLK*kp;
  const unsigned lds0=(unsigned)(uintptr_t)shm;
  float*wsf=(float*)(shm+LDS_WS)+wid*64;
  const bf16*ksrc=Kh+(long)lane*kp+wid*8;
  const bf16*vsrc=Vh+(long)(16*(wid&3)+(lane>>2))*kp+(wid>>2)*32+(lane&3)*8;
  const unsigned kdst=lds0+LDS_K+wid*1024, vdst=lds0+LDS_V+wid*1024;
  #define DMA_K(t,slot) glds16(ksrc+(long)(t)*KVBLK*kp,(unsigned)__builtin_amdgcn_readfirstlane(kdst+(slot)))
  #define DMA_V(t,slot) do{ glds16(vsrc+(long)(t)*KVBLK*kp,(unsigned)__builtin_amdgcn_readfirstlane(vdst+VMUL*(slot))); if constexpr(DV==128) glds16(vsrc+64+(long)(t)*KVBLK*kp,(unsigned)__builtin_amdgcn_readfirstlane(vdst+VMUL*(slot)+8192)); }while(0)
  const int vb0=(int)(lds0+LDS_V)+((lane>>4)&1)*32+(lane&3)*8+(4*hi+((lane&15)>>2))*64;
  const char*Kbase=shm+LDS_K; bf16x8 kf[8];
  const lds_cptr shm3=(lds_cptr)shm; const lds_cptr kp0=shm3+LDS_K+hi*1024+r32*16; const lds_cptr vp0=shm3+LDS_V+((lane>>4)&1)*32+(lane&3)*8+(4*hi+((lane&15)>>2))*64;
  const int NT=U.NT;
  DMA_K(0,0);DMA_V(0,0);DMA_K(1,SLOTB);
  bf16x8 qr[4];
  #pragma unroll
  for(int d0=0;d0<4;++d0)qr[d0]=*reinterpret_cast<const bf16x8*>(&Qw[(long)r32*qp+d0*16+hi*8]);
  float mhat=0.f,l_reg=0.f;f32x16 o[4];o[0]=f32x16{};o[1]=f32x16{};o[2]=f32x16{};o[3]=f32x16{};
  const int qrel=wid*QBLK+r32;
  #define CMASK(P0,P1,t) do{int jb_=(t)-(NT-4); if(WINDOW||(CAUSAL&&jb_>=0))cmask<CAUSAL,WINDOW>(P0,P1,jb_,qrel,hi);}while(0)
  bf16x8 kx0,kx1,qx;
  { const float k0_=ALIBI?slope2*(float)r32:0.f, k1_=ALIBI?slope2*(float)(r32+32):0.f; const unsigned h0=bfr(k0_),l0=bfr(k0_-bfv(h0)),h1=bfr(k1_),l1=bfr(k1_-bfv(h1));
    u32x4 a={0x3f803f80u,0x3f80u|(h0<<16),l0,0u}, b={0x3f803f80u,0x3f80u|(h1<<16),l1,0u}; if(hi){a=u32x4{0u,0u,0u,0u};b=a;} kx0=__builtin_bit_cast(bf16x8,a); kx1=__builtin_bit_cast(bf16x8,b); }
  #define QX_SET(t) do{ const float nb_=ALIBI?__builtin_fmaf(slope2,(float)(64*((t)-(NT-4))-qrel),-mhat):-mhat; const unsigned a_=bfr(nb_); const float r1_=nb_-bfv(a_); const unsigned b_=bfr(r1_); const unsigned c_=bfr(r1_-bfv(b_)); \
    u32x4 q_={a_|(b_<<16),c_|0x3f800000u,0x3f80u,0u}; if(hi)q_=u32x4{0u,0u,0u,0u}; qx=__builtin_bit_cast(bf16x8,q_); asm volatile("":"+v"(qx)); }while(0)
  bool resc=false;
  #define START(P0,P1) do{ const float rm=rowmax(P0,P1); resc=false; \
    { const float dl=(rm==-INFINITY)?0.f:rm; mhat=fadd_s(mhat,dl); \
      _Pragma("unroll") for(int r=0;r<16;++r){P0[r]=fsub_s(P0[r],dl);P1[r]=fsub_s(P1[r],dl);} } \
    _Pragma("unroll") for(int r=0;r<16;++r)P0[r]=__builtin_amdgcn_exp2f(P0[r]); }while(0)
  #define RESC() do{ if(resc){ asm volatile("s_waitcnt lgkmcnt(0)":::"memory"); \
      _Pragma("unroll") for(int d_=0;d_<2*VMUL;++d_) _Pragma("unroll") for(int r=0;r<16;++r)o[d_][r]*=wsf[crow(r,hi)]; } }while(0)
  f32x16 pA0,pA1,pB0,pB1;
  int sl_prev=0,sl_cur=0,sl_next=SLOTB;
  #define ROT() do{sl_prev=sl_cur;sl_cur=sl_next;sl_next=(sl_next==(NSLOT-1)*SLOTB)?0:sl_next+SLOTB;}while(0)
  DMA_K(2,2*SLOTB);
  if constexpr(DV==128){WAIT_BAR(4);}else{WAIT_BAR(3);}
  QX_SET(0);
  qkt(pA0,pA1,Kbase,qr,kx0,kx1,qx,r32,hi);asm volatile("s_nop 15\n\ts_nop 7":"+v"(pA0),"+v"(pA1));CMASK(pA0,pA1,0);
  START(pA0,pA1);
  _Pragma("unroll") for(int r=0;r<16;++r)pA1[r]=__builtin_amdgcn_exp2f(pA1[r]);
  WAIT_BAR(0);
  DMA_K(3,0);DMA_V(1,SLOTB);
  ROT();
  kload8(kf,kp0+sl_cur);
  if constexpr(DV==128){WAIT_BAR(3);}else{WAIT_BAR(2);}
  s16x4 vlo[8],vhi[8]; s16x4 vfl[4],vfh[4]; u32x4 pw0,pw1,pw2,pw3;
  #define PKW(P,B) cvtpk_s(P[B],P[B+1])
  #define PAF(k) __builtin_bit_cast(bf16x8,pw##k)
  #define VFR(i) (bf16x8){vlo[i][0],vlo[i][1],vlo[i][2],vlo[i][3],vhi[i][0],vhi[i][1],vhi[i][2],vhi[i][3]}
  #define PIN(x) asm volatile("":"+v"(x))
  #define MX3(a,b,c) __builtin_fmaxf(__builtin_fmaxf((a),(b)),(c))
  #define GAPA(MF,A0,A1,A2,A3,W0,W1,PW) do{ MF; sacc+=A0; sacc+=A1; sacc+=A2; sacc+=A3; PIN(sacc); W0; W1; PIN(PW); SBAR(); }while(0)
  #define EX(v) __builtin_amdgcn_exp2f(v)
  #define GAPB(MF,X,B) do{ MF; X[B]=EX(X[B]); X[B+1]=EX(X[B+1]); X[B+2]=EX(X[B+2]); X[B+3]=EX(X[B+3]); PIN(X); SBAR(); }while(0)
  #define VRD(i) do{ if constexpr(DV==64){ vlo[i]=vtr(vp_+(((i)>>2)*4096+((i)&3)*1024)); vhi[i]=vtr(vp_+(((i)>>2)*4096+((i)&3)*1024+512)); } }while(0)
  #define VRJ(f) do{ vfl[(f)&3]=vtr(vp_+(((f)&3)*4096+((f)>>2)*1024)); vfh[(f)&3]=vtr(vp_+(((f)&3)*4096+((f)>>2)*1024+512)); }while(0)
  #define VFJ(f) (bf16x8){vfl[(f)&3][0],vfl[(f)&3][1],vfl[(f)&3][2],vfl[(f)&3][3],vfh[(f)&3][0],vfh[(f)&3][1],vfh[(f)&3][2],vfh[(f)&3][3]}
  #define GAPJ(f,PA,X,B) do{ if((f)+3<16){VRJ((f)+3);} o[(f)&3]=__builtin_amdgcn_mfma_f32_32x32x16_bf16(PA,VFJ(f),o[(f)&3],0,0,0); X[B]=EX(X[B]); X[B+1]=EX(X[B+1]); PIN(X); SBAR(); }while(0)
  #define KRD(G,j) do{ if(G){ kload2(kf,kp0+sl_next,j); SBAR(); } }while(0)
  #define STEP(C0,C1,P0,P1,t,GK,GV,GL) do{ SBAR(); QX_SET(t); SBAR(); \
    const lds_cptr vp_=vp0+VMUL*sl_prev; \
    VRD(0); SBAR(); float sacc=(P0[0]+P0[1]); \
    GAPA(C0=__builtin_amdgcn_mfma_f32_32x32x16_bf16(kf[0],qr[0],f32x16{},0,0,0), P0[2],P0[3],P0[4],P0[5],     pw0[0]=PKW(P0,0), pw0[1]=PKW(P0,2), pw0); \
    VRD(4); SBAR(); GAPA(C1=__builtin_amdgcn_mfma_f32_32x32x16_bf16(kf[1],qr[0],f32x16{},0,0,0), P0[6],P0[7],P0[8],P0[9],     pw0[2]=PKW(P0,4), pw0[3]=PKW(P0,6), pw0); \
    VRD(1); SBAR(); GAPA(C0=__builtin_amdgcn_mfma_f32_32x32x16_bf16(kf[2],qr[1],C0,0,0,0),   P0[10],P0[11],P0[12],P0[13], pw1[0]=PKW(P0,8), pw1[1]=PKW(P0,10), pw1); \
    VRD(5); SBAR(); GAPA(C1=__builtin_amdgcn_mfma_f32_32x32x16_bf16(kf[3],qr[1],C1,0,0,0),   P0[14],P0[15],P1[0],P1[1],   pw1[2]=PKW(P0,12),pw1[3]=PKW(P0,14), pw1); \
    VRD(2); SBAR(); GAPA(C0=__builtin_amdgcn_mfma_f32_32x32x16_bf16(kf[4],qr[2],C0,0,0,0),   P1[2],P1[3],P1[4],P1[5],     pw2[0]=PKW(P1,0), pw2[1]=PKW(P1,2), pw2); \
    VRD(6); SBAR(); GAPA(C1=__builtin_amdgcn_mfma_f32_32x32x16_bf16(kf[5],qr[2],C1,0,0,0),   P1[6],P1[7],P1[8],P1[9],     pw2[2]=PKW(P1,4), pw2[3]=PKW(P1,6), pw2); \
    VRD(3); SBAR(); GAPA(C0=__builtin_amdgcn_mfma_f32_32x32x16_bf16(kf[6],qr[3],C0,0,0,0),   P1[10],P1[11],P1[12],P1[13], pw3[0]=PKW(P1,8), pw3[1]=PKW(P1,10), pw3); \
    VRD(7); SBAR(); GAPA(C1=__builtin_amdgcn_mfma_f32_32x32x16_bf16(kf[7],qr[3],C1,0,0,0),   P1[14],P1[15],0.f,0.f,       pw3[2]=PKW(P1,12),pw3[3]=PKW(P1,14), pw3); \
    C0=__builtin_amdgcn_mfma_f32_32x32x16_bf16(kx0,qx,C0,0,0,0); C1=__builtin_amdgcn_mfma_f32_32x32x16_bf16(kx1,qx,C1,0,0,0); if constexpr(DV==128){VRJ(0);VRJ(1);VRJ(2);} SBAR(); \
    l_reg+=sacc; \
    if(GK){DMA_K((t)+3,sl_cur);} if(GV){DMA_V((t)+1,sl_next);} \
    CMASK(C0,C1,t); \
    { float a=MX3(C0[0],C0[1],C1[0]),b=MX3(C0[2],C0[3],C1[1]); a=MX3(a,C1[2],C1[3]); \
      _Pragma("unroll") for(int r=4;r<16;r+=4){a=MX3(a,C0[r],C0[r+1]);b=MX3(b,C0[r+2],C0[r+3]);a=MX3(a,C1[r],C1[r+1]);b=MX3(b,C1[r+2],C1[r+3]);} \
      float rm=__builtin_fmaxf(a,b); { auto rr=__builtin_amdgcn_permlane32_swap(__float_as_uint(rm),__float_as_uint(rm),false,false); rm=__builtin_fmaxf(__uint_as_float(rr[0]),__uint_as_float(rr[1])); } \
      resc=false; \
      if(__builtin_expect(__any(rm>(float)THRL),0)){ const float dl=__builtin_fmaxf(rm,0.f); mhat+=dl; \
        _Pragma("unroll") for(int r=0;r<16;++r){C0[r]-=dl;C1[r]-=dl;} \
        const float f=__builtin_amdgcn_exp2f(-dl); l_reg*=f; if(hi==0)wsf[r32]=f; resc=true; } } \
    SBAR(); \
    if constexpr(DV==64){ \
    GAPB(o[0]=__builtin_amdgcn_mfma_f32_32x32x16_bf16(PAF(0),VFR(0),o[0],0,0,0), C0,0); \
    GAPB(o[1]=__builtin_amdgcn_mfma_f32_32x32x16_bf16(PAF(0),VFR(4),o[1],0,0,0), C0,4); \
    KRD(GL,0); GAPB(o[0]=__builtin_amdgcn_mfma_f32_32x32x16_bf16(PAF(1),VFR(1),o[0],0,0,0), C0,8); \
    KRD(GL,1); GAPB(o[1]=__builtin_amdgcn_mfma_f32_32x32x16_bf16(PAF(1),VFR(5),o[1],0,0,0), C0,12); \
    KRD(GL,2); GAPB(o[0]=__builtin_amdgcn_mfma_f32_32x32x16_bf16(PAF(2),VFR(2),o[0],0,0,0), C1,0); \
    KRD(GL,3); GAPB(o[1]=__builtin_amdgcn_mfma_f32_32x32x16_bf16(PAF(2),VFR(6),o[1],0,0,0), C1,4); \
    GAPB(o[0]=__builtin_amdgcn_mfma_f32_32x32x16_bf16(PAF(3),VFR(3),o[0],0,0,0), C1,8); \
    GAPB(o[1]=__builtin_amdgcn_mfma_f32_32x32x16_bf16(PAF(3),VFR(7),o[1],0,0,0), C1,12); \
    } else { \
    GAPJ(0,PAF(0),C0,0); GAPJ(1,PAF(0),C0,2); GAPJ(2,PAF(0),C0,4); GAPJ(3,PAF(0),C0,6); \
    KRD(GL,0); GAPJ(4,PAF(1),C0,8); GAPJ(5,PAF(1),C0,10); KRD(GL,1); GAPJ(6,PAF(1),C0,12); GAPJ(7,PAF(1),C0,14); \
    KRD(GL,2); GAPJ(8,PAF(2),C1,0); GAPJ(9,PAF(2),C1,2); KRD(GL,3); GAPJ(10,PAF(2),C1,4); GAPJ(11,PAF(2),C1,6); \
    GAPJ(12,PAF(3),C1,8); GAPJ(13,PAF(3),C1,10); GAPJ(14,PAF(3),C1,12); GAPJ(15,PAF(3),C1,14); \
    } \
    }while(0)
  int t=1;
  #undef CMASK
  #define CMASK(P0,P1,t) do{}while(0)
  for(;t+5<NT;t+=2){
    STEP(pB0,pB1,pA0,pA1,t,true,true,true);     if constexpr(DV==128){WAIT_BAR(3);}else{WAIT_BAR(2);} RESC(); ROT();
    STEP(pA0,pA1,pB0,pB1,t+1,true,true,true);   if constexpr(DV==128){WAIT_BAR(3);}else{WAIT_BAR(2);} RESC(); ROT();
  }
  #undef CMASK
  #define CMASK(P0,P1,t) do{int jb_=(t)-(NT-4); if(WINDOW||(CAUSAL&&jb_>=0))cmask<CAUSAL,WINDOW>(P0,P1,jb_,qrel,hi);}while(0)
  #define ENDW(tt) do{ if((tt)+3<NT){ if constexpr(DV==128){WAIT_BAR(3);}else{WAIT_BAR(2);} } else if((tt)+2<NT){ if constexpr(DV==128){WAIT_BAR(2);}else{WAIT_BAR(1);} } else {WAIT_BAR(0);} }while(0)
  for(;t+1<NT;t+=2){
    STEP(pB0,pB1,pA0,pA1,t,(t+3<NT),(t+1<NT),(t+1<NT));       ENDW(t);   RESC(); ROT();
    STEP(pA0,pA1,pB0,pB1,t+1,(t+4<NT),(t+2<NT),(t+2<NT));     ENDW(t+1); RESC(); ROT();
  }
  STEP(pB0,pB1,pA0,pA1,NT-1,false,false,false); RESC();
  { float sacc=pB0[0]+pB0[1]; _Pragma("unroll") for(int r=2;r<16;++r)sacc+=pB0[r]; _Pragma("unroll") for(int r=0;r<16;++r)sacc+=pB1[r]; l_reg+=sacc;
    pw0=(u32x4){PKW(pB0,0),PKW(pB0,2),PKW(pB0,4),PKW(pB0,6)};pw1=(u32x4){PKW(pB0,8),PKW(pB0,10),PKW(pB0,12),PKW(pB0,14)};pw2=(u32x4){PKW(pB1,0),PKW(pB1,2),PKW(pB1,4),PKW(pB1,6)};pw3=(u32x4){PKW(pB1,8),PKW(pB1,10),PKW(pB1,12),PKW(pB1,14)};
    SBAR(); if constexpr(DV==128){pv128(o,vb0+VMUL*sl_cur,PAF(0),PAF(1),PAF(2),PAF(3));}else{pv(o,vb0+sl_cur,PAF(0),PAF(1),PAF(2),PAF(3));} }
  #undef PKW
  #undef PAF
  #undef VFR
  #undef PIN
  #undef MX3
  #undef GAPA
  #undef GAPB
  #undef EX
  #undef VRD
  #undef VRJ
  #undef VFJ
  #undef GAPJ
  #undef KRD
  #undef STEP
  #undef ENDW
  {auto rr=__builtin_amdgcn_permlane32_swap(__float_as_uint(l_reg),__float_as_uint(l_reg),false,false);l_reg=__uint_as_float(rr[0])+__uint_as_float(rr[1]);}
  if(LSE){ if(hi==0)U.lse[(long)(q0+wid*QBLK+r32)*U.lse_stride]=mhat+__builtin_amdgcn_logf(l_reg); }
  if(hi==0)wsf[32+r32]=l_reg;asm volatile("s_waitcnt lgkmcnt(0)":::"memory");
  float rli[16];
  #pragma unroll
  for(int r=0;r<16;++r)rli[r]=__builtin_amdgcn_rcpf(wsf[32+crow(r,hi)]);
  bf16*Ow=U.O+(long)(q0+wid*QBLK)*op;
  { bf16*stg=(bf16*)(shm+LDS_OST)+wid*(2048*VMUL);
    #pragma unroll
    for(int r=0;r<16;++r){const int orow=crow(r,hi);
      #pragma unroll
      for(int d0=0;d0<2*VMUL;++d0)stg[orow*DV+d0*32+r32]=__float2bfloat16(o[d0][r]*rli[r]);}
    asm volatile("s_waitcnt lgkmcnt(0)":::"memory");
    if constexpr(DV==128){
      #pragma unroll
      for(int i=0;i<8;++i){const int row=i*4+(lane>>4),ch=lane&15; const u32x4 v=*(const u32x4*)(stg+row*128+ch*8); ATTN_STORE16(Ow+(long)row*op+ch*8,v);}
    } else {
      #pragma unroll
      for(int i=0;i<4;++i){const int row=i*8+(lane>>3),ch=lane&7; const u32x4 v=*(const u32x4*)(stg+row*64+ch*8); ATTN_STORE16(Ow+(long)row*op+ch*8,v);} } }
  asm volatile("s_waitcnt lgkmcnt(0)\n\ts_barrier":::"memory");
  #undef DMA_K
  #undef DMA_V
  #undef CMASK
  #undef START
  #undef RESC
  #undef ROT
  #undef QX_SET
}
constexpr int ATTN_LDS_BYTES=Lds<128>::BYTES;
#undef SBAR
#undef WAIT_BAR
}
constexpr size_t MiB = 1u << 20;
constexpr size_t WS_CTL = 0, CTL_ZERO_BYTES = 1 * MiB;
constexpr size_t WS_LIST = 1 * MiB;
constexpr size_t WS_RGATE = 5 * MiB;
constexpr size_t WS_RSTD1 = 5 * MiB + 512 * 1024, WS_RSTD2 = WS_RSTD1 + 128 * 1024, WS_WRG = WS_RSTD2 + 128 * 1024;
constexpr size_t WS_WRT = 7 * MiB + 512 * 1024;
constexpr size_t WS_LSE = 6 * MiB;
constexpr size_t WS_MKV = 8 * MiB;
constexpr size_t WS_WIN = 10 * MiB, WS_WOUT = 15 * MiB, WS_WGU = 17 * MiB, WS_WDN = 145 * MiB;
constexpr size_t WS_XB = 209 * MiB;
constexpr size_t WS_LRSTD = 209 * MiB, WS_LGATE = 213 * MiB;
constexpr size_t WS_P = 273 * MiB, WS_OD = 433 * MiB, WS_ODIL = 497 * MiB;
constexpr size_t WS_ACT = 273 * MiB;
constexpr size_t WS_MIX = 545 * MiB, WS_X1B = 609 * MiB, WS_YB = 673 * MiB, WS_X1H = 801 * MiB, WS_Y = 929 * MiB, WS_END = 993 * MiB;
constexpr int CW_TMO = 0, CW_CODE = 1;
constexpr int CW_CNT = 64;
constexpr int CW_NRM = 256;
constexpr int CW_Q = 1024;
constexpr int CW_BAR = 4096;

constexpr int RING_OFF = 0, RING_BYTES = 131072;
constexpr int LDSCTL_OFF = RING_BYTES;
constexpr int IDB_OFF = LDSCTL_OFF;
constexpr int TBL_OFF = IDB_OFF + 9216;
constexpr int LCNT_OFF = TBL_OFF + 2304;
constexpr int MISC_OFF = LCNT_OFF + 256;
constexpr int STG_OFF = IDB_OFF;
constexpr int LDS_BYTES = 147456;
static_assert(MISC_OFF + 128 <= LDS_BYTES && 512 * 16 <= 9216, "LDS map");
constexpr int NWAVES = 8;

#define GAS __attribute__((address_space(1)))
#define LAS __attribute__((address_space(3)))
typedef unsigned short bf16;
typedef unsigned v4u __attribute__((ext_vector_type(4)));
typedef unsigned v2u __attribute__((ext_vector_type(2)));
typedef float f32x4 __attribute__((ext_vector_type(4)));
typedef float f32x16 __attribute__((ext_vector_type(16)));
typedef short bf16x8 __attribute__((ext_vector_type(8)));
typedef GAS unsigned gu32;
#define RLX_AGENT __ATOMIC_RELAXED, __HIP_MEMORY_SCOPE_AGENT
#define LDS_WAIT() asm volatile("s_waitcnt lgkmcnt(0)" ::: "memory")
#define VM_WAIT() asm volatile("s_waitcnt vmcnt(0)" ::: "memory")
__device__ __forceinline__ unsigned f2bf(float f) { unsigned u = __builtin_bit_cast(unsigned, f); return (u + 0x7fffu + ((u >> 16) & 1u)) >> 16; }
__device__ __forceinline__ unsigned pk2(float lo, float hi) { return f2bf(lo) | (f2bf(hi) << 16); }
__device__ __forceinline__ float sat8(float v) { return __builtin_amdgcn_fmed3f(v, -448.f, 448.f); }
__device__ __forceinline__ unsigned fp8x4(float a, float b, float c, float d) { int w = __builtin_amdgcn_cvt_pk_fp8_f32(sat8(a), sat8(b), 0, false); w = __builtin_amdgcn_cvt_pk_fp8_f32(sat8(c), sat8(d), w, true); return (unsigned)w; }
constexpr float WSCALE = 64.f, ASCALE = 8.f, YSCALE = 64.f;
__device__ __forceinline__ float bf2f(unsigned short b) { return __builtin_bit_cast(float, (unsigned)b << 16); }
__device__ __forceinline__ float bflo(unsigned w) { return __builtin_bit_cast(float, w << 16); }
__device__ __forceinline__ float bfhi(unsigned w) { return __builtin_bit_cast(float, w & 0xffff0000u); }
__device__ __forceinline__ float wave_sum(float v) {
#pragma unroll
    for (int o = 1; o < 64; o <<= 1) v += __shfl_xor(v, o);
    return v;
}

#define XB_TMO      128
#define XB_XCNT(j)  (256  + 64 * (j))
#define XB_XSUB(j)  (1280 + 64 * (j))
#define XB_XGEN(j)  (2304 + 64 * (j))
#define XB_TOP      3328
#define XB_TOPGEN   3392
#define XCD_BAR_WORDS 3456
#define XB_SPIN_CAP (1u << 20)
__device__ __forceinline__ unsigned xb_ld(unsigned* p)              { return __hip_atomic_load(p, __ATOMIC_RELAXED, __HIP_MEMORY_SCOPE_AGENT); }
__device__ __forceinline__ unsigned xb_add(unsigned* p, unsigned v) { return __hip_atomic_fetch_add(p, v, __ATOMIC_RELAXED, __HIP_MEMORY_SCOPE_AGENT); }
__device__ __forceinline__ unsigned xb_xcc_id() { return (unsigned)__builtin_amdgcn_s_getreg((3 << 11) | 20) & 0xFu; }
#define XB_SPIN(cond, bar) do { unsigned _sp = 0; while (cond) { __builtin_amdgcn_s_sleep(1); \
    if ((++_sp & 255u) == 0u) { if (xb_ld(&(bar)[XB_TMO])) break; if (_sp > XB_SPIN_CAP) { atomicAdd(&(bar)[XB_TMO], 1u); break; } } } } while (0)
struct XcdBarrier { unsigned* bar; unsigned x; volatile LAS unsigned* st; };
__device__ __forceinline__ XcdBarrier xcd_barrier_post(unsigned* bar, volatile LAS unsigned* st) {
    XcdBarrier b; b.bar = bar; b.x = xb_xcc_id(); b.st = st;
    if (threadIdx.x == 0) (void)xb_add(&bar[XB_XCNT(b.x)], 1u);
    return b;
}
__device__ __forceinline__ void xcd_barrier_complete(unsigned* bar, unsigned x, unsigned& nloc, unsigned& nx) {
    const unsigned G = gridDim.x * gridDim.y * gridDim.z;
    unsigned sum, cnt, mine, sp = 0u;
    for (;;) {
        sum = 0u; cnt = 0u; mine = 0u;
#pragma unroll
        for (unsigned j = 0; j < 16; ++j) { const unsigned c = xb_ld(&bar[XB_XCNT(j)]); sum += c; cnt += (c > 0u) ? 1u : 0u; mine = (j == x) ? c : mine; }
        if (sum == G) break;
        __builtin_amdgcn_s_sleep(1);
        if ((++sp & 255u) == 0u) { if (xb_ld(&bar[XB_TMO])) break; if (sp > XB_SPIN_CAP) { atomicAdd(&bar[XB_TMO], 1u); break; } }
    }
    nloc = mine > 0u ? mine : 1u; nx = cnt > 0u ? cnt : 1u;
}
__device__ __forceinline__ void xcd_barrier(const XcdBarrier& b) {
    asm volatile("s_waitcnt vmcnt(0)" ::: "memory");
    __syncthreads();
    if (threadIdx.x == 0) {
        unsigned* bar = b.bar;
        __builtin_amdgcn_s_waitcnt(0);
        unsigned nloc = b.st[0], nx = b.st[1];
        if (nloc == 0u) { xcd_barrier_complete(bar, b.x, nloc, nx); b.st[0] = nloc; b.st[1] = nx; }
        const unsigned old = xb_add(&bar[XB_XSUB(b.x)], 1u);
        const unsigned gen = old / nloc;
        if (old + 1u == (gen + 1u) * nloc) {
            __builtin_amdgcn_fence(__ATOMIC_RELEASE, "agent");
            asm volatile("s_waitcnt vmcnt(0)" ::: "memory");
            const unsigned og = xb_add(&bar[XB_TOP], 1u);
            const unsigned tg = og / nx;
            if (og + 1u == (tg + 1u) * nx) xb_add(&bar[XB_TOPGEN], 1u);
            else XB_SPIN(xb_ld(&bar[XB_TOPGEN]) == tg, bar);
            __builtin_amdgcn_fence(__ATOMIC_ACQUIRE, "agent");
            xb_add(&bar[XB_XGEN(b.x)], 1u);
            asm volatile("s_waitcnt vmcnt(0)" ::: "memory");
        } else {
            XB_SPIN(xb_ld(&bar[XB_XGEN(b.x)]) == gen, bar);
            __builtin_amdgcn_fence(__ATOMIC_ACQUIRE, "agent");
            asm volatile("s_waitcnt vmcnt(0)" ::: "memory");
        }
    }
    __syncthreads();
}

struct Frame {
    LAS unsigned char* lds;
    volatile LAS unsigned* MISC;
    gu32* ctl;
    int tid, lane, wave;
    int vcu, G;
    const float *x, *mem, *g_attn, *g_mem, *w_in, *lamqk, *subg, *w_mkv, *w_out, *g_ffn, *w_r, *b_r, *w_gu, *b_gu, *w_dn, *b_dn, *g_fin;
    float* out; unsigned char* ws;
};

#define P0_LOAD(dst, itm) do { const int m_ = (itm) / ipm, r_ = (itm) % ipm, kb_ = r_ / nblk, nb_ = r_ % nblk; \
        const float* src_ = W + (size_t)m_ * K * N + (size_t)(64 * kb_ + (lane >> 5)) * N + 32 * nb_ + (lane & 31); \
        _Pragma("unroll") for (int i_ = 0; i_ < 32; ++i_) dst[i_] = src_[(size_t)(2 * i_) * N]; } while (0)
template <bool F8, class RowMap>
__device__ __forceinline__ void p0_transpose_all(const float* W, int K, int N, int nmat, void* WTv, const float* gk, float wscale, LAS float* scr, int gw, int NGW, int lane, RowMap rowmap) {
    asm volatile("" : "+v"(lane));
    const int nblk = N / 32, ipm = (K / 64) * nblk, total = nmat * ipm;
    int it = gw; if (it >= total) return;
    float v[32], w[32];
    P0_LOAD(v, it);
    for (;;) {
        const int nx = it + NGW; const bool more = nx < total;
        if (more) P0_LOAD(w, nx);
        const int m = it / ipm, r = it % ipm, k0 = 64 * (r / nblk), n0 = 32 * (r % nblk);
        if (gk) {
#pragma unroll
            for (int i = 0; i < 32; ++i) v[i] *= gk[k0 + 2 * i + (lane >> 5)] * wscale;
        } else if (F8) {
#pragma unroll
            for (int i = 0; i < 32; ++i) v[i] *= wscale;
        }
#pragma unroll
        for (int i = 0; i < 32; ++i) scr[(2 * i + (lane >> 5)) * 33 + (lane & 31)] = v[i];
        LDS_WAIT(); asm volatile("" ::: "memory");
        const int c = lane & 7;
#pragma unroll
        for (int j = 0; j < 4; ++j) { const int n = (lane >> 3) + 8 * j; const LAS float* s = scr + (8 * c) * 33 + n;
            if constexpr (F8) { unsigned char* wt = (unsigned char*)WTv + (size_t)m * N * K;
                v2u o; o.x = fp8x4(s[0 * 33], s[1 * 33], s[2 * 33], s[3 * 33]); o.y = fp8x4(s[4 * 33], s[5 * 33], s[6 * 33], s[7 * 33]);
                *(GAS v2u*)(wt + (size_t)rowmap(n0 + n) * K + k0 + 8 * c) = o; }
            else { bf16* wt = (bf16*)WTv + (size_t)m * N * K;
                v4u o; o.x = pk2(s[0 * 33], s[1 * 33]); o.y = pk2(s[2 * 33], s[3 * 33]); o.z = pk2(s[4 * 33], s[5 * 33]); o.w = pk2(s[6 * 33], s[7 * 33]);
                *(GAS v4u*)(wt + (size_t)rowmap(n0 + n) * K + k0 + 8 * c) = o; } }
        LDS_WAIT(); asm volatile("" ::: "memory");
        if (!more) break;
#pragma unroll
        for (int i = 0; i < 32; ++i) v[i] = w[i];
        it = nx;
    }
}
#undef P0_LOAD
struct RowId { __device__ __forceinline__ int operator()(int n) const { return n; } };
struct RowGU { __device__ __forceinline__ int operator()(int n) const { const int f = n >> 1, u = n & 1; return ((f >> 7) << 8) + (u << 7) + (f & 127); } };

__device__ __forceinline__ void p0_x_rows4(Frame& F, const float* xrow, bf16* orow, float* rstd_out) {
    const GAS f32x4* xr = (const GAS f32x4*)xrow + F.lane;
    f32x4 v[16]; float s[4] = {0.f, 0.f, 0.f, 0.f};
#pragma unroll
    for (int j = 0; j < 16; ++j) v[j] = xr[64 * j];
#pragma unroll
    for (int j = 0; j < 16; ++j) s[j >> 2] += (v[j].x * v[j].x + v[j].y * v[j].y) + (v[j].z * v[j].z + v[j].w * v[j].w);
    GAS unsigned long long* o8 = (GAS unsigned long long*)orow + F.lane;
#pragma unroll
    for (int j = 0; j < 16; ++j) o8[64 * j] = (unsigned long long)pk2(v[j].x, v[j].y) | ((unsigned long long)pk2(v[j].z, v[j].w) << 32);
#pragma unroll
    for (int q = 0; q < 4; ++q) s[q] = wave_sum(s[q]);
    if (F.lane < 4) rstd_out[F.lane] = 1.f / sqrtf((F.lane == 0 ? s[0] : F.lane == 1 ? s[1] : F.lane == 2 ? s[2] : s[3]) * (1.f / D) + EPS);
}
__device__ __forceinline__ void p0_mkv_tile(Frame& F, int tile, bf16* mkv) {
    const int mt = tile >> 4, nt = tile & 15, m0 = 32 * mt, n0 = 32 * nt, r = F.lane & 31, h = F.lane >> 5, kh = F.wave >> 2, tw = F.wave & 3;
    f32x16 acc = {}; float ss = 0.f;
    const float* mrow = F.mem + (size_t)(m0 + r) * D + 8 * h + kh * 512;
    const float* wcol = F.w_mkv + (size_t)(8 * h + kh * 512) * 512 + n0 + r;
    const float* gp = F.g_mem + 8 * h + kh * 512;
#pragma unroll 2
    for (int k0 = 0; k0 < 512; k0 += 16) {
        const f32x4 a0 = *(const f32x4*)(mrow + k0), a1 = *(const f32x4*)(mrow + k0 + 4);
        const f32x4 g0 = *(const f32x4*)(gp + k0), g1 = *(const f32x4*)(gp + k0 + 4);
        float wv[8];
#pragma unroll
        for (int j = 0; j < 8; ++j) wv[j] = wcol[(size_t)(k0 + j) * 512];
        ss += (a0.x * a0.x + a0.y * a0.y) + (a0.z * a0.z + a0.w * a0.w) + (a1.x * a1.x + a1.y * a1.y) + (a1.z * a1.z + a1.w * a1.w);
        v4u bw; bw.x = pk2(a0.x * g0.x, a0.y * g0.y); bw.y = pk2(a0.z * g0.z, a0.w * g0.w); bw.z = pk2(a1.x * g1.x, a1.y * g1.y); bw.w = pk2(a1.z * g1.z, a1.w * g1.w);
        v4u aw; aw.x = pk2(wv[0], wv[1]); aw.y = pk2(wv[2], wv[3]); aw.z = pk2(wv[4], wv[5]); aw.w = pk2(wv[6], wv[7]);
        acc = __builtin_amdgcn_mfma_f32_32x32x16_bf16(__builtin_bit_cast(bf16x8, aw), __builtin_bit_cast(bf16x8, bw), acc, 0, 0, 0);
    }
    LAS float* xc = (LAS float*)(F.lds + RING_OFF + 8 * 16384 - 4 * 64 * 17 * 4) + (tw * 64 + F.lane) * 17;
    if (kh == 1) {
#pragma unroll
        for (int i = 0; i < 16; ++i) xc[i] = acc[i];
        xc[16] = ss; }
    __syncthreads();
    if (kh == 0) {
#pragma unroll
        for (int i = 0; i < 16; ++i) acc[i] += xc[i];
        ss += xc[16]; ss += __shfl_xor(ss, 32);
        const float rstd = 1.f / sqrtf(ss * (1.f / D) + EPS);
        bf16* orow = mkv + (size_t)(m0 + r) * 512 + n0 + 4 * h;
#pragma unroll
        for (int q = 0; q < 4; ++q) { v2u o; o.x = pk2(acc[4 * q] * rstd, acc[4 * q + 1] * rstd); o.y = pk2(acc[4 * q + 2] * rstd, acc[4 * q + 3] * rstd); *(GAS v2u*)(orow + 8 * q) = o; }
    }
    __syncthreads();
}
__device__ __forceinline__ void p0_prologue(Frame& F) {
    LAS float* scr = (LAS float*)(F.lds + RING_OFF + F.wave * 16384);
    const int gw = F.vcu * NWAVES + F.wave, NGW = F.G * NWAVES;
    bf16* win_t = (bf16*)(F.ws + WS_WIN); bf16* wout_t = (bf16*)(F.ws + WS_WOUT);
    p0_mkv_tile(F, (F.wave & 3) * 256 + F.vcu, (bf16*)(F.ws + WS_MKV));
    p0_transpose_all<false>(F.w_in, D, DIN, 1, win_t, F.g_attn, 1.f, scr, gw, NGW, F.lane, RowId());
    p0_transpose_all<false>(F.w_out, D, D, 1, wout_t, nullptr, 1.f, scr, gw, NGW, F.lane, RowId());
    bf16* xb = (bf16*)(F.ws + WS_XB); float* rstd1 = (float*)(F.ws + WS_RSTD1);
    for (int m = 4 * gw; m < T; m += 4 * NGW) p0_x_rows4(F, F.x + (size_t)m * D, xb + (size_t)m * D, rstd1 + m);
    bf16* wrt = (bf16*)(F.ws + WS_WRT);
    for (int i = gw * 64 + F.lane; i < D * NE; i += NGW * 64) { const int e = i >> 10, k = i & 1023; const float w = F.w_r[k * NE + e] * F.g_ffn[k]; const unsigned hb = f2bf(w); wrt[i] = (bf16)hb; wrt[D * NE + i] = (bf16)f2bf(w - bf2f((bf16)hb)); }
}

constexpr int NCONV = 8, NCONV_ALL = 8 * NCONV;
__device__ __forceinline__ void p0b_unit(Frame& F, int c) {
    LAS float* scr = (LAS float*)(F.lds + RING_OFF + F.wave * 16384);
    p0_transpose_all<true>(F.w_gu, D, 2 * DFF, NE, (void*)(F.ws + WS_WGU), F.g_ffn, WSCALE, scr, c * NWAVES + F.wave, NCONV_ALL * NWAVES, F.lane, RowGU());
    p0_transpose_all<true>(F.w_dn, DFF, D, NE, (void*)(F.ws + WS_WDN), nullptr, WSCALE, scr, c * NWAVES + F.wave, NCONV_ALL * NWAVES, F.lane, RowId());
    __syncthreads();
}

struct EpiInProj {
    bf16* O; const float* rstd; unsigned* nrm;
    __device__ __forceinline__ void operator()(const pg8::f32x4 (&acc)[2][2][4][2], const pg8::Unit& u, int wr, int wc, int fr, int fq, const LAS unsigned* ids) const {
        asm volatile("" : "+v"(fr), "+v"(fq));
        const int row0 = u.pm * 256 + wr * 64 + fr, col0 = u.pn * 256 + wc * 32 + 8 * fq;
        const float sc = (u.pn <= 1 || u.pn == 6 || u.pn == 9) ? QSCALE : 1.f;
        const LAS float* scl = (const LAS float*)(ids + 256);
        float rsv[2][4];
#pragma unroll
        for (int ai = 0; ai < 2; ++ai)
#pragma unroll
            for (int m = 0; m < 4; ++m) rsv[ai][m] = scl[wr * 64 + fr + ai * 128 + m * 16];
#pragma unroll
        for (int ai = 0; ai < 2; ++ai)
#pragma unroll
            for (int m = 0; m < 4; ++m) { const int row = row0 + ai * 128 + m * 16; const float rs = rsv[ai][m] * sc; bf16* rowp = O + (size_t)row * DIN + col0;
#pragma unroll
                for (int bj = 0; bj < 2; ++bj) { const pg8::f32x4 v0 = acc[ai][bj][m][0] * rs, v1 = acc[ai][bj][m][1] * rs;
                    v4u w; w.x = pg8::cvt_pk_bf16(v0[0], v0[1]); w.y = pg8::cvt_pk_bf16(v0[2], v0[3]); w.z = pg8::cvt_pk_bf16(v1[0], v1[1]); w.w = pg8::cvt_pk_bf16(v1[2], v1[3]);
                    *(v4u*)(rowp + bj * 128) = w; } }
        if (u.pn < 4) {
#pragma unroll
            for (int bj = 0; bj < 2; ++bj) { float mx = 0.f;
#pragma unroll
                for (int ai = 0; ai < 2; ++ai)
#pragma unroll
                    for (int m = 0; m < 4; ++m) { const float rs = rsv[ai][m] * sc; const pg8::f32x4 v0 = acc[ai][bj][m][0] * rs, v1 = acc[ai][bj][m][1] * rs;
                        float s = (v0[0] * v0[0] + v0[1] * v0[1]) + (v0[2] * v0[2] + v0[3] * v0[3]) + (v1[0] * v1[0] + v1[1] * v1[1]) + (v1[2] * v1[2] + v1[3] * v1[3]);
                        s += __shfl_xor(s, 16); s += __shfl_xor(s, 32); mx = fmaxf(mx, s); }
#pragma unroll
                for (int o = 1; o < 16; o <<= 1) mx = fmaxf(mx, __shfl_xor(mx, o));
                if ((fr | fq) == 0) atomicMax(nrm + (((u.pm >> 4) * 4 + u.pn) * 4 + 2 * bj + (wc >> 1)) * 2 + (wc & 1), __builtin_bit_cast(unsigned, mx)); }
        }
    }
};
__device__ __forceinline__ void attn_phase(Frame& F, char* shm, int qoff = 0, int gmask = 7) {
    using namespace attn_body;
    const attn_body::bf16* P = (const attn_body::bf16*)(F.ws + WS_P);
    attn_body::bf16* OD = (attn_body::bf16*)(F.ws + WS_OD);
    attn_body::bf16* mix = (attn_body::bf16*)(F.ws + WS_MIX);
    attn_body::bf16* ODIL = (attn_body::bf16*)(F.ws + WS_ODIL); float* LSEb = (float*)(F.ws + WS_LSE);
    const attn_body::bf16* MKV = (const attn_body::bf16*)(F.ws + WS_MKV);
    const float* nrm = (const float*)(F.ctl + CW_NRM);
    const int grp = (int)blockIdx.x & 7, b = grp;
    unsigned* qctr = (unsigned*)(F.ctl + CW_Q + qoff) + 64 * grp;
    const attn_body::bf16* Pb = P + (size_t)b * SEQ * DIN;
    unsigned nxt_tok = 0u;
    if (F.tid == 0) nxt_tok = __hip_atomic_fetch_add(qctr, 1u, __ATOMIC_RELAXED, __HIP_MEMORY_SCOPE_AGENT);
    for (;;) {
        if (F.tid == 0) F.MISC[20] = nxt_tok;
        __syncthreads();
        int un = (int)F.MISC[20];
        __syncthreads();
        if (F.tid == 0 && un < NCONV + 384) nxt_tok = __hip_atomic_fetch_add(qctr, 1u, __ATOMIC_RELAXED, __HIP_MEMORY_SCOPE_AGENT);
        if (un < NCONV) { if (gmask == 7) p0b_unit(F, grp * NCONV + un); continue; }
        un -= NCONV;
        if (un >= 384) break;
        if (un < 128) {
            if (!(gmask & 1)) continue;
            const int qb = 15 - (un >> 3), h = 3 - ((un >> 1) & 3), j = un & 1;
            const float slope2 = exp2f(-(float)(2 * h + 1)) * LOG2E;
            const int ni = ((b * 4 + (h >> 1)) * 4 + 2 * (h & 1) + j) * 2;
            const float R = sqrtf((nrm[ni] + nrm[ni + 1]) * (nrm[ni + 16] + nrm[ni + 17])) * 1.01f;
            const float kfirst = (float)(qb * 256) - (2.f * R + 160.f) / slope2;
            int t0 = kfirst > 0.f ? (int)(kfirst * (1.f / 64.f)) : 0; t0 = min(t0, 4 * qb); t0 &= ~1;
            UnitP U; U.Q = Pb + C_DQ + h * 128 + j * 64; U.K = Pb + C_DK + h * 128 + j * 64; U.V = Pb + C_DV + h * 128;
            U.O = OD + (size_t)b * SEQ * 1024 + h * 256 + j * 128; U.qp = DIN; U.kp = DIN; U.op = 1024;
            U.q0 = qb * 256; U.t0 = t0; U.NT = 4 * qb + 4 - t0; U.slope2 = slope2; U.lse = nullptr; U.lse_stride = 0;
            attn_unit<32, true, false, true, false, 128>(U, shm);
        } else if (un < 320) {
            if (!(gmask & 2)) continue;
            const int du = un - 128, h = du / 48, idx = du % 48, n = idx >> 4, w = idx & 15;
            const int r = (n == 0) ? 1 : (n == 1 ? 4 : 16), c = (n == 0) ? 0 : (n == 1 ? (w >> 2) : w), blk = (n == 0) ? w : (n == 1 ? (w & 3) : 0);
            const attn_body::bf16* Pc = Pb + (size_t)c * DIN;
            UnitP U; U.Q = Pc + C_LQ + h * 64; U.K = Pc + C_LK + h * 64; U.V = Pc + C_LV + h * 64; U.qp = (long)r * DIN; U.kp = (long)r * DIN;
            U.O = ODIL + (size_t)n * T * 256 + ((size_t)b * SEQ + c) * 256 + h * 64; U.op = (long)r * 256;
            U.q0 = blk * 256; U.t0 = (blk == 0) ? 0 : 4 * blk - 2; U.NT = 4 * blk + 4 - U.t0;
            U.slope2 = exp2f(-(float)(2 * h + 2)) * (float)r * LOG2E;
            U.lse = LSEb + (size_t)n * T * 4 + ((size_t)b * SEQ + c) * 4 + h; U.lse_stride = r * 4;
            attn_unit<32, true, true, true, true>(U, shm);
        } else {
            if (!(gmask & 4)) continue;
            const int mu = un - 320, h = mu >> 4, qb = mu & 15;
            UnitP U; U.Q = Pb + C_MQ + h * 64; U.qp = DIN; U.K = MKV + (size_t)b * NMEM * 512 + h * 64; U.V = U.K + 256; U.kp = 512;
            U.O = mix + (size_t)b * SEQ * 1024 + 768 + h * 64; U.op = 1024; U.q0 = qb * 256; U.t0 = 0; U.NT = 4; U.slope2 = 0.f; U.lse = nullptr; U.lse_stride = 0;
            attn_unit<8, false, false, false, false>(U, shm);
        }
    }
}
__device__ __forceinline__ void dil_combine_phase(Frame& F) {
    const int gw = F.vcu * NWAVES + F.wave, NGW = F.G * NWAVES;
    const bf16* OD = (const bf16*)(F.ws + WS_OD); const bf16* ODIL = (const bf16*)(F.ws + WS_ODIL); const float* LSEb = (const float*)(F.ws + WS_LSE); bf16* mix = (bf16*)(F.ws + WS_MIX);
    const int h = F.lane >> 4, pt = F.lane & 15, d4 = pt * 4;
    float lam;
    { const float a = F.lamqk[F.lane] * F.lamqk[64 + F.lane], c = F.lamqk[128 + F.lane] * F.lamqk[192 + F.lane];
      lam = __expf(wave_sum(a)) - __expf(wave_sum(c)) + 0.2f; }
    float gsub[8];
#pragma unroll
    for (int i = 0; i < 8; ++i) gsub[i] = F.subg[pt * 8 + i] * 0.8f;
    for (int row0 = 4 * gw; row0 < T; row0 += 4 * NGW) {
        float l[4][3]; v2u q[4][3]; v4u o1[4], o2[4];
#pragma unroll
        for (int i = 0; i < 4; ++i) {
            o1[i] = *(const v4u*)(OD + (size_t)(row0 + i) * 1024 + h * 256 + pt * 8); o2[i] = *(const v4u*)(OD + (size_t)(row0 + i) * 1024 + h * 256 + 128 + pt * 8);
#pragma unroll
            for (int n = 0; n < 3; ++n) { l[i][n] = LSEb[(size_t)n * T * 4 + (size_t)(row0 + i) * 4 + h]; q[i][n] = *(const v2u*)(ODIL + (size_t)n * T * 256 + (size_t)(row0 + i) * 256 + h * 64 + d4); } }
#pragma unroll
        for (int i = 0; i < 4; ++i) {
            const unsigned aw[4] = {o1[i].x, o1[i].y, o1[i].z, o1[i].w}, bw[4] = {o2[i].x, o2[i].y, o2[i].z, o2[i].w};
            float d[8], ss = 0.f;
#pragma unroll
            for (int c = 0; c < 4; ++c) { d[2 * c] = bflo(aw[c]) - lam * bflo(bw[c]); d[2 * c + 1] = bfhi(aw[c]) - lam * bfhi(bw[c]); ss += d[2 * c] * d[2 * c] + d[2 * c + 1] * d[2 * c + 1]; }
#pragma unroll
            for (int o = 1; o < 16; o <<= 1) ss += __shfl_xor(ss, o);
            const float rstd = 1.f / sqrtf(ss * (1.f / 128.f) + EPS);
            v4u od; od.x = pk2(d[0] * rstd * gsub[0], d[1] * rstd * gsub[1]); od.y = pk2(d[2] * rstd * gsub[2], d[3] * rstd * gsub[3]); od.z = pk2(d[4] * rstd * gsub[4], d[5] * rstd * gsub[5]); od.w = pk2(d[6] * rstd * gsub[6], d[7] * rstd * gsub[7]);
            *(v4u*)(mix + (size_t)(row0 + i) * 1024 + h * 128 + pt * 8) = od;
            const float m = fmaxf(fmaxf(l[i][0], l[i][1]), l[i][2]);
            float wn[3], den = 0.f;
#pragma unroll
            for (int n = 0; n < 3; ++n) { wn[n] = exp2f(l[i][n] - m); den += wn[n]; }
            const float inv = 1.f / den; float o[4] = {0.f, 0.f, 0.f, 0.f};
#pragma unroll
            for (int n = 0; n < 3; ++n) { const float wq = wn[n] * inv; o[0] += wq * bflo(q[i][n].x); o[1] += wq * bfhi(q[i][n].x); o[2] += wq * bflo(q[i][n].y); o[3] += wq * bfhi(q[i][n].y); }
            v2u ov; ov.x = pk2(o[0], o[1]); ov.y = pk2(o[2], o[3]);
            *(v2u*)(mix + (size_t)(row0 + i) * 1024 + 512 + h * 64 + d4) = ov;
        }
    }
}
struct EpiY {
    bf16* Y;
    __device__ __forceinline__ void operator()(const pg8::f32x4 (&acc)[2][2][4][2], const pg8::Unit& u, int wr, int wc, int fr, int fq, const LAS unsigned*) const {
        asm volatile("" : "+v"(fr), "+v"(fq));
        const int row0 = u.pm * 256 + wr * 64 + fr, col0 = u.pn * 256 + wc * 32 + 8 * fq;
#pragma unroll
        for (int ai = 0; ai < 2; ++ai)
#pragma unroll
            for (int m = 0; m < 4; ++m) { bf16* rowp = Y + (size_t)(row0 + ai * 128 + m * 16) * D + col0;
#pragma unroll
                for (int bj = 0; bj < 2; ++bj) { const pg8::f32x4 v0 = acc[ai][bj][m][0], v1 = acc[ai][bj][m][1];
                    v4u w; w.x = pg8::cvt_pk_bf16(v0[0], v0[1]); w.y = pg8::cvt_pk_bf16(v0[2], v0[3]); w.z = pg8::cvt_pk_bf16(v1[0], v1[1]); w.w = pg8::cvt_pk_bf16(v1[2], v1[3]);
                    *(v4u*)(rowp + bj * 128) = w; } }
    }
};

__device__ __forceinline__ void route_phase(Frame& F) {
    LAS char* XH = (LAS char*)(F.lds + RING_OFF); LAS char* XL = XH + 32768; LAS char* WH = XH + 65536; LAS char* WL = XH + 73728;
    LAS float* xch = (LAS float*)(XH + 81920);
    LAS float* ssl = (LAS float*)(XH + 81920 + 17408);
    LAS unsigned* lcnt = (LAS unsigned*)(F.lds + LCNT_OFF);
    LAS unsigned* stg = (LAS unsigned*)(F.lds + STG_OFF);
    if (F.tid < 64) lcnt[F.tid] = 0u;
    const int lane = F.lane, tl = lane & 31, h = lane >> 5, tg = F.wave & 3, kh = F.wave >> 2;
    const int srow = F.tid >> 5, k4 = (F.tid & 31) * 4, T0 = F.vcu * 128;
    const float* xg = F.x + (size_t)(T0 + srow) * D + k4;
    const bf16* yg = (const bf16*)(F.ws + WS_Y) + (size_t)(T0 + srow) * D + k4;
    unsigned char* x1q = (unsigned char*)(F.ws + WS_X1B) + (size_t)(T0 + srow) * D + k4;
    bf16* x1h = (bf16*)(F.ws + WS_X1H) + (size_t)(T0 + srow) * D + k4;
    const bf16* wsrc = (const bf16*)(F.ws + WS_WRT);
    f32x4 xv[8]; v2u yv[8]; v4u wv[2]; float ssr[8];
#pragma unroll
    for (int i = 0; i < 8; ++i) ssr[i] = 0.f;
#define RT_LOAD(kc) do { _Pragma("unroll") for (int i_ = 0; i_ < 8; ++i_) { xv[i_] = *(const f32x4*)(xg + (size_t)(16 * i_) * D + 128 * (kc)); yv[i_] = *(const v2u*)(yg + (size_t)(16 * i_) * D + 128 * (kc)); } \
        _Pragma("unroll") for (int j_ = 0; j_ < 2; ++j_) { const int idx_ = F.tid + 512 * j_; wv[j_] = *(const v4u*)(wsrc + (idx_ >> 9) * 32768 + ((idx_ >> 4) & 31) * 1024 + 128 * (kc) + (idx_ & 15) * 8); } } while (0)
    f32x16 acc = {};
    RT_LOAD(0);
    for (int kc = 0; kc < 8; ++kc) {
#pragma unroll
        for (int i = 0; i < 8; ++i) {
            const float x0 = xv[i].x + bflo(yv[i].x), x1 = xv[i].y + bfhi(yv[i].x), x2 = xv[i].z + bflo(yv[i].y), x3 = xv[i].w + bfhi(yv[i].y);
            ssr[i] += (x0 * x0 + x1 * x1) + (x2 * x2 + x3 * x3);
            const unsigned h0 = pk2(x0, x1), h1 = pk2(x2, x3), l0 = pk2(x0 - bflo(h0), x1 - bfhi(h0)), l1 = pk2(x2 - bflo(h1), x3 - bfhi(h1));
            *(unsigned*)(x1q + (size_t)(16 * i) * D + 128 * kc) = fp8x4(x0, x1, x2, x3);
            *(v2u*)(x1h + (size_t)(16 * i) * D + 128 * kc) = (v2u){h0, h1};
            const int row = srow + 16 * i, off = row * 256 + (((k4 >> 3) ^ (row & 15)) << 4) + (k4 & 4) * 2;
            *(LAS v2u*)(XH + off) = (v2u){h0, h1}; *(LAS v2u*)(XL + off) = (v2u){l0, l1};
        }
#pragma unroll
        for (int j = 0; j < 2; ++j) { const int idx = F.tid + 512 * j, e = (idx >> 4) & 31, c = idx & 15; *(LAS v4u*)(((idx >> 9) ? WL : WH) + e * 256 + ((c ^ (e & 15)) << 4)) = wv[j]; }
        __syncthreads();
        if (kc < 7) RT_LOAD(kc + 1);
#pragma unroll
        for (int s = 0; s < 4; ++s) { const int c16 = 2 * (4 * kh + s) + h, tr = tg * 32 + tl;
            const v4u xh = *(const LAS v4u*)(XH + tr * 256 + ((c16 ^ (tr & 15)) << 4)), xl = *(const LAS v4u*)(XL + tr * 256 + ((c16 ^ (tr & 15)) << 4));
            const v4u wh = *(const LAS v4u*)(WH + tl * 256 + ((c16 ^ (tl & 15)) << 4)), wl2 = *(const LAS v4u*)(WL + tl * 256 + ((c16 ^ (tl & 15)) << 4));
            acc = __builtin_amdgcn_mfma_f32_32x32x16_bf16(__builtin_bit_cast(bf16x8, wh), __builtin_bit_cast(bf16x8, xh), acc, 0, 0, 0);
            acc = __builtin_amdgcn_mfma_f32_32x32x16_bf16(__builtin_bit_cast(bf16x8, wh), __builtin_bit_cast(bf16x8, xl), acc, 0, 0, 0);
            acc = __builtin_amdgcn_mfma_f32_32x32x16_bf16(__builtin_bit_cast(bf16x8, wl2), __builtin_bit_cast(bf16x8, xh), acc, 0, 0, 0); }
        __syncthreads();
    }
#undef RT_LOAD
#pragma unroll
    for (int i = 0; i < 8; ++i) { float s = ssr[i];
#pragma unroll
        for (int o = 1; o < 32; o <<= 1) s += __shfl_xor(s, o);
        if ((F.tid & 31) == 0) ssl[srow + 16 * i] = s; }
    const int tok = T0 + tg * 32 + tl; float ss = 0.f;
    if (kh == 1) { LAS float* d = xch + (tg * 64 + lane) * 17;
#pragma unroll
        for (int i = 0; i < 16; ++i) d[i] = acc[i];
        d[16] = ss; }
    __syncthreads();
    if (kh == 0) {
        const LAS float* d = xch + (tg * 64 + lane) * 17;
#pragma unroll
        for (int i = 0; i < 16; ++i) acc[i] += d[i];
        ss = ssl[tg * 32 + tl];
        const float rstd = 1.f / sqrtf(ss * (1.f / D) + EPS);
        float lg[16];
#pragma unroll
        for (int i = 0; i < 16; ++i) lg[i] = acc[i] * rstd + F.b_r[4 * h + (i & 3) + 8 * (i >> 2)];
        float cv[8]; int ce[8];
#pragma unroll
        for (int k = 0; k < 4; ++k) { float bv = -INFINITY; int bi = 0;
#pragma unroll
            for (int i = 0; i < 16; ++i) { if (lg[i] > bv) { bv = lg[i]; bi = i; } }
            cv[k] = bv; ce[k] = 4 * h + (bi & 3) + 8 * (bi >> 2);
#pragma unroll
            for (int i = 0; i < 16; ++i) if (i == bi) lg[i] = -INFINITY; }
#pragma unroll
        for (int k = 0; k < 4; ++k) { cv[4 + k] = __shfl_xor(cv[k], 32); ce[4 + k] = __shfl_xor(ce[k], 32); }
        float tv[4]; int te[4];
#pragma unroll
        for (int k = 0; k < 4; ++k) { float bv = -INFINITY; int be = 64, bi = 0;
#pragma unroll
            for (int i = 0; i < 8; ++i) { if (cv[i] > bv || (cv[i] == bv && ce[i] < be)) { bv = cv[i]; be = ce[i]; bi = i; } }
            tv[k] = bv; te[k] = be;
#pragma unroll
            for (int i = 0; i < 8; ++i) if (i == bi) cv[i] = -INFINITY; }
        float gk[4], den = 0.f;
#pragma unroll
        for (int k = 0; k < 4; ++k) { gk[k] = __expf(tv[k] - tv[0]); den += gk[k]; }
        const float inv = 1.f / den;
        if (h == 0) {
#pragma unroll
            for (int k = 0; k < 4; ++k) {
                const unsigned rank = __hip_atomic_fetch_add(lcnt + te[k], 1u, __ATOMIC_RELAXED, __HIP_MEMORY_SCOPE_WORKGROUP);
                const int slot = (tg * 32 + tl) * 4 + k;
                stg[slot * 4] = (unsigned)(tok * 4 + k); stg[slot * 4 + 1] = ((unsigned)te[k] << 16) | rank; stg[slot * 4 + 2] = __builtin_bit_cast(unsigned, gk[k] * inv); stg[slot * 4 + 3] = __builtin_bit_cast(unsigned, rstd);
            }
        }
    }
    __syncthreads();
    if (F.tid < 32) { const unsigned n = lcnt[F.tid]; lcnt[32 + F.tid] = n ? __hip_atomic_fetch_add((unsigned*)(F.ctl + CW_CNT) + F.tid, n, __ATOMIC_RELAXED, __HIP_MEMORY_SCOPE_AGENT) : 0u; }
    __syncthreads();
    { unsigned* list = (unsigned*)(F.ws + WS_LIST); unsigned* lgate = (unsigned*)(F.ws + WS_LGATE); unsigned* lrstd = (unsigned*)(F.ws + WS_LRSTD);
      const unsigned ent = stg[F.tid * 4], er = stg[F.tid * 4 + 1], gb = stg[F.tid * 4 + 2], rb = stg[F.tid * 4 + 3]; const unsigned e = er >> 16, rank = er & 0xffffu;
      const size_t at = (size_t)e * LCAP + lcnt[32 + e] + rank; list[at] = ent; lgate[at] = gb; lrstd[at] = rb; }
    __syncthreads();
}

__device__ __forceinline__ int moe_build_table(Frame& F) {
    LAS unsigned* tbl = (LAS unsigned*)(F.lds + TBL_OFF); LAS unsigned* lcnt = (LAS unsigned*)(F.lds + LCNT_OFF);
    if (F.wave == 0) {
        const int e = F.lane & 31;
        const unsigned cnt = __hip_atomic_load((unsigned*)(F.ctl + CW_CNT) + e, __ATOMIC_RELAXED, __HIP_MEMORY_SCOPE_AGENT);
        const unsigned nt = (cnt + 255u) >> 8; unsigned incl = nt;
#pragma unroll
        for (int o = 1; o < 32; o <<= 1) { const unsigned t = __shfl_up(incl, o); if ((F.lane & 31) >= o) incl += t; }
        if (F.lane < 32) { lcnt[e] = cnt; const unsigned start = incl - nt; for (unsigned j = 0; j < nt; ++j) tbl[start + j] = ((unsigned)e << 16) | j; if (F.lane == 31) F.MISC[16] = incl; }
    }
    __syncthreads();
    return (int)F.MISC[16];
}
struct MoeOrder {
    const LAS unsigned* tbl; const LAS unsigned* lcnt; const unsigned* list; int NMT, G, c, NPN, MPER, RB; size_t bexp; bool a_tiles; const unsigned* lsc; const unsigned* bias; int bexp_f;
    __device__ __forceinline__ bool next(int i, pg8::Unit& u) const {
        const int L = i * G + c, blk = L >> 5, w = L & 31, g = blk * MPER + w / NPN, pn = w % NPN;
        if (g >= NMT) return false;
        const unsigned t = tbl[g]; const int e = (int)(t >> 16), mt = (int)(t & 0xffffu); const int cnt = (int)lcnt[e];
        u.pm = g; u.pn = pn; u.e = e; u.mt = mt; u.valid = min(256, cnt - mt * 256);
        u.aoff = a_tiles ? (size_t)g * (size_t)(256 * RB) : (size_t)0; u.boff = (size_t)e * bexp + (size_t)pn * (size_t)(256 * RB);
        return true;
    }
    __device__ __forceinline__ const unsigned* id_src(const pg8::Unit& u, int row) const { return list + (size_t)u.e * LCAP + u.mt * 256 + min(row, u.valid - 1); }
    __device__ __forceinline__ const unsigned* sc_src(const pg8::Unit& u, int row) const { return lsc + (size_t)u.e * LCAP + u.mt * 256 + min(row, u.valid - 1); }
    __device__ __forceinline__ const unsigned* bias_src(const pg8::Unit& u, int col) const { return bias + (size_t)u.e * bexp_f + u.pn * 256 + col; }
};
struct EpiGU {
    unsigned char* ACT;
    __device__ __forceinline__ void operator()(const pg8::f32x4 (&acc)[2][2][4][2], const pg8::Unit& u, int wr, int wc, int fr, int fq, const LAS unsigned* ids) const {
        asm volatile("" : "+v"(fr), "+v"(fq));
        typedef float f2 __attribute__((ext_vector_type(2)));
        constexpr float CG = 1.702f * LOG2E, KA = ASCALE / CG;
        const int r0 = wr * 64 + fr, f0 = u.pn * 128 + wc * 32 + 8 * fq;
        const LAS float* scl = (const LAS float*)(ids + 256); const LAS float* bl = (const LAS float*)(ids + 512) + 2 * (wc * 32 + 8 * fq);
        float rs[2][4];
#pragma unroll
        for (int ai = 0; ai < 2; ++ai)
#pragma unroll
            for (int m = 0; m < 4; ++m) rs[ai][m] = scl[r0 + ai * 128 + m * 16] * (1.f / WSCALE);
        const pg8::f32x4 b0 = *(const LAS pg8::f32x4*)bl, b1 = *(const LAS pg8::f32x4*)(bl + 4), b2 = *(const LAS pg8::f32x4*)(bl + 8), b3 = *(const LAS pg8::f32x4*)(bl + 12);
        const f2 gb[4] = {f2{b0[0], b0[2]} * CG, f2{b1[0], b1[2]} * CG, f2{b2[0], b2[2]} * CG, f2{b3[0], b3[2]} * CG}, ub[4] = {f2{b0[1], b0[3]}, f2{b1[1], b1[3]}, f2{b2[1], b2[3]}, f2{b3[1], b3[3]}};
#pragma unroll
        for (int ai = 0; ai < 2; ++ai)
#pragma unroll
            for (int m = 0; m < 4; ++m) { const int r = r0 + ai * 128 + m * 16; const float s = rs[ai][m], sg = s * CG; f2 a[4];
#pragma unroll
                for (int q = 0; q < 4; ++q) { const int n = q >> 1, j = 2 * (q & 1);
                    f2 g = f2{acc[ai][0][m][n][j], acc[ai][0][m][n][j + 1]} * sg + gb[q], up = f2{acc[ai][1][m][n][j], acc[ai][1][m][n][j + 1]} * s + ub[q];
                    g.x = fminf(g.x, 7.f * CG); g.y = fminf(g.y, 7.f * CG); up.x = __builtin_amdgcn_fmed3f(up.x, -7.f, 7.f); up.y = __builtin_amdgcn_fmed3f(up.y, -7.f, 7.f);
                    f2 d = f2{__builtin_amdgcn_exp2f(-g.x), __builtin_amdgcn_exp2f(-g.y)} + 1.f;
                    const f2 rc = f2{__builtin_amdgcn_rcpf(d.x), __builtin_amdgcn_rcpf(d.y)};
                    a[q] = ((up * KA + KA) * g) * rc; }
                v2u w; w.x = (unsigned)__builtin_amdgcn_cvt_pk_fp8_f32(a[1].x, a[1].y, __builtin_amdgcn_cvt_pk_fp8_f32(a[0].x, a[0].y, 0, false), true);
                w.y = (unsigned)__builtin_amdgcn_cvt_pk_fp8_f32(a[3].x, a[3].y, __builtin_amdgcn_cvt_pk_fp8_f32(a[2].x, a[2].y, 0, false), true);
                *(v2u*)(ACT + (size_t)(u.pm * 256 + r) * DFF + f0) = w; }
    }
};
struct EpiDown {
    unsigned char* YB;
    __device__ __forceinline__ void operator()(const pg8::f32x4 (&acc)[2][2][4][2], const pg8::Unit& u, int wr, int wc, int fr, int fq, const LAS unsigned* ids) const {
        asm volatile("" : "+v"(fr), "+v"(fq));
        const int r0 = wr * 64 + fr, cl = wc * 32 + 8 * fq, col0 = u.pn * 256 + cl;
        const LAS float* scl = (const LAS float*)(ids + 256); const LAS float* bl = (const LAS float*)(ids + 512) + cl;
        pg8::f32x4 bv[2][2];
#pragma unroll
        for (int bj = 0; bj < 2; ++bj)
#pragma unroll
            for (int n = 0; n < 2; ++n) bv[bj][n] = *(const LAS pg8::f32x4*)(bl + bj * 128 + 4 * n);
#pragma unroll
        for (int ai = 0; ai < 2; ++ai)
#pragma unroll
            for (int m = 0; m < 4; ++m) { const int r = r0 + ai * 128 + m * 16; if (r < u.valid) { const float g = scl[r] * YSCALE; unsigned char* yp = YB + (size_t)ids[r] * D + col0;
#pragma unroll
                for (int bj = 0; bj < 2; ++bj) { const pg8::f32x4 v0 = (acc[ai][bj][m][0] * (1.f / (WSCALE * ASCALE)) + bv[bj][0]) * g, v1 = (acc[ai][bj][m][1] * (1.f / (WSCALE * ASCALE)) + bv[bj][1]) * g;
                    v2u w; w.x = fp8x4(v0[0], v0[1], v0[2], v0[3]); w.y = fp8x4(v1[0], v1[1], v1[2], v1[3]);
                    *(v2u*)(yp + bj * 128) = w; } } }
    }
};
__device__ __forceinline__ void final_phase(Frame& F) {
    const int gw = F.vcu * NWAVES + F.wave, NGW = F.G * NWAVES;
    const unsigned char* YB = (const unsigned char*)(F.ws + WS_YB); const bf16* X1 = (const bf16*)(F.ws + WS_X1H);
    const int c = 16 * F.lane;
    f32x4 gf[4];
#pragma unroll
    for (int q = 0; q < 4; ++q) gf[q] = *(const f32x4*)(F.g_fin + c + 4 * q);
    for (int t = gw; t < T; t += NGW) {
        const v4u xa = *(const v4u*)(X1 + (size_t)t * D + c), xb = *(const v4u*)(X1 + (size_t)t * D + c + 8);
        v4u y[4];
#pragma unroll
        for (int k = 0; k < 4; ++k) y[k] = *(const v4u*)(YB + ((size_t)t * 4 + k) * D + c);
        float v[16];
        { const unsigned xw[8] = {xa.x, xa.y, xa.z, xa.w, xb.x, xb.y, xb.z, xb.w};
#pragma unroll
          for (int q = 0; q < 8; ++q) { v[2 * q] = bflo(xw[q]); v[2 * q + 1] = bfhi(xw[q]); } }
#pragma unroll
        for (int k = 0; k < 4; ++k) { const unsigned yw[4] = {y[k].x, y[k].y, y[k].z, y[k].w};
#pragma unroll
            for (int q = 0; q < 4; ++q) { const auto lo = __builtin_amdgcn_cvt_pk_f32_fp8((int)yw[q], false), hi = __builtin_amdgcn_cvt_pk_f32_fp8((int)yw[q], true);
                v[4 * q] += lo[0] * (1.f / YSCALE); v[4 * q + 1] += lo[1] * (1.f / YSCALE); v[4 * q + 2] += hi[0] * (1.f / YSCALE); v[4 * q + 3] += hi[1] * (1.f / YSCALE); } }
        float ss = 0.f;
#pragma unroll
        for (int i = 0; i < 16; ++i) ss += v[i] * v[i];
        const float rstd = 1.f / sqrtf(wave_sum(ss) * (1.f / D) + EPS);
#pragma unroll
        for (int q = 0; q < 4; ++q) { f32x4 o; o.x = v[4 * q] * rstd * gf[q].x; o.y = v[4 * q + 1] * rstd * gf[q].y; o.z = v[4 * q + 2] * rstd * gf[q].z; o.w = v[4 * q + 3] * rstd * gf[q].w;
            *(f32x4*)(F.out + (size_t)t * D + c + 4 * q) = o; }
    }
}
struct Args { const float* in[17]; float* out; unsigned char* ws; int ph_lo, ph_hi, use_bar, pad; };
__global__ void __launch_bounds__(NWAVES * 64, 2) mk_fwd(Args args) {
    extern __shared__ __attribute__((aligned(16))) unsigned char lds[];
    Frame F;
    F.lds = (LAS unsigned char*)lds;
    F.MISC = (volatile LAS unsigned*)(F.lds + MISC_OFF);
    F.tid = threadIdx.x; F.lane = F.tid & 63; F.wave = __builtin_amdgcn_readfirstlane(F.tid >> 6);
    F.G = gridDim.x; { const int bx = blockIdx.x; F.vcu = (F.G % 8 == 0) ? (bx % 8) * (F.G / 8) + bx / 8 : bx; }
    F.ws = args.ws; F.out = args.out; F.ctl = (gu32*)(args.ws + WS_CTL);
    F.x = args.in[0]; F.mem = args.in[1]; F.g_attn = args.in[2]; F.g_mem = args.in[3]; F.w_in = args.in[4]; F.lamqk = args.in[5]; F.subg = args.in[6]; F.w_mkv = args.in[7];
    F.w_out = args.in[8]; F.g_ffn = args.in[9]; F.w_r = args.in[10]; F.b_r = args.in[11]; F.w_gu = args.in[12]; F.b_gu = args.in[13]; F.w_dn = args.in[14]; F.b_dn = args.in[15]; F.g_fin = args.in[16];
    for (int u = F.tid; u < (LDS_BYTES - LDSCTL_OFF) / 4; u += NWAVES * 64) ((LAS unsigned*)(F.lds + LDSCTL_OFF))[u] = 0u;
    __syncthreads();
    XcdBarrier bar; bar.bar = (unsigned*)(F.ctl + CW_BAR); bar.x = 0; bar.st = nullptr;
    if (args.use_bar) bar = xcd_barrier_post((unsigned*)(F.ctl + CW_BAR), F.MISC + 8);
    const int lo = args.ph_lo, hi = args.ph_hi;
#define IN(k) (lo <= (k) && (k) < hi)
#define SEAM(k) do { if (IN(k) && IN((k) + 1)) xcd_barrier(bar); } while (0)
    if (IN(0)) { p0_prologue(F); } SEAM(0);
    if (IN(1)) {
        pg8::Gemm g{(const void*)(F.ws + WS_XB), (const void*)(F.ws + WS_WIN), 2 * D}; pg8::StaticOrder S; S.init(T, DIN, 2 * D, F.G, (int)blockIdx.x, (const unsigned*)(F.ws + WS_RSTD1));
        EpiInProj E{(bf16*)(F.ws + WS_P), (const float*)(F.ws + WS_RSTD1), (unsigned*)(F.ctl + CW_NRM)};
        pg8::gemm_phase<EpiInProj, pg8::StaticOrder, true, false, true>(F.lds + RING_OFF, (LAS unsigned*)(F.lds + IDB_OFF), g, S, E);
    } SEAM(1);
    if (IN(2)) { attn_phase(F, (char*)lds + RING_OFF); } SEAM(2);
    if (IN(3)) { dil_combine_phase(F); } SEAM(3);
    if (IN(4)) {
        pg8::Gemm g{(const void*)(F.ws + WS_MIX), (const void*)(F.ws + WS_WOUT), 2 * D}; pg8::StaticOrder S; S.init(T, D, 2 * D, F.G, (int)blockIdx.x);
        EpiY E{(bf16*)(F.ws + WS_Y)};
        pg8::gemm_phase<EpiY, pg8::StaticOrder, true, false, false>(F.lds + RING_OFF, (LAS unsigned*)(F.lds + IDB_OFF), g, S, E);
    } SEAM(4);
    if (IN(5)) { route_phase(F); } SEAM(5);
    if (IN(6)) {
        const int nmt = moe_build_table(F);
        pg8::Gemm g{(const void*)(F.ws + WS_X1B), (const void*)(F.ws + WS_WGU), D};
        MoeOrder S{(const LAS unsigned*)(F.lds + TBL_OFF), (const LAS unsigned*)(F.lds + LCNT_OFF), (const unsigned*)(F.ws + WS_LIST), nmt, F.G, F.vcu, 8, 4, D, (size_t)2 * DFF * D, false, (const unsigned*)(F.ws + WS_LRSTD), (const unsigned*)F.b_gu, 2 * DFF};
        EpiGU E{(unsigned char*)(F.ws + WS_ACT)};
        pg8::gemm_phase<EpiGU, MoeOrder, true, true, true, true>(F.lds + RING_OFF, (LAS unsigned*)(F.lds + IDB_OFF), g, S, E);
    } SEAM(6);
    if (IN(7)) {
        const int nmt = moe_build_table(F);
        pg8::Gemm g{(const void*)(F.ws + WS_ACT), (const void*)(F.ws + WS_WDN), DFF};
        MoeOrder S{(const LAS unsigned*)(F.lds + TBL_OFF), (const LAS unsigned*)(F.lds + LCNT_OFF), (const unsigned*)(F.ws + WS_LIST), nmt, F.G, F.vcu, 4, 8, DFF, (size_t)D * DFF, true, (const unsigned*)(F.ws + WS_LGATE), (const unsigned*)F.b_dn, D};
        EpiDown E{(unsigned char*)(F.ws + WS_YB)};
        pg8::gemm_phase<EpiDown, MoeOrder, true, true, true, true, true>(F.lds + RING_OFF, (LAS unsigned*)(F.lds + IDB_OFF), g, S, E);
    } SEAM(7);
    if (IN(8)) { final_phase(F); }
#undef IN
#undef SEAM
}

static void launch_phases(const Args& base, int lo, int hi, int use_bar, int grid, hipStream_t stream) {
    Args a = base; a.ph_lo = lo; a.ph_hi = hi; a.use_bar = use_bar;
    hipLaunchKernelGGL(mk_fwd, dim3(grid), dim3(NWAVES * 64), LDS_BYTES, stream, a);
}
extern "C" void kernel_launch(void* const* d_in, const int* in_sizes, int n_in, void* d_out, int out_size, void* d_ws, size_t ws_size, hipStream_t stream) {
    static int grid = 0;
    if (grid == 0) {
        if (n_in != 17 || in_sizes[0] != T * D || out_size != T * D || ws_size < (size_t)1000 * MiB) { fprintf(stderr, "kernel_launch: unexpected shapes / workspace (%d inputs, ws %zu)\n", n_in, ws_size); grid = -1; return; }
        int dev = 0, cus = 0, per_cu = 0;
        if (hipGetDevice(&dev) != hipSuccess || hipDeviceGetAttribute(&cus, hipDeviceAttributeMultiprocessorCount, dev) != hipSuccess) { grid = -1; return; }
        if (hipFuncSetAttribute((const void*)mk_fwd, hipFuncAttributeMaxDynamicSharedMemorySize, LDS_BYTES) != hipSuccess) { fprintf(stderr, "kernel_launch: hipFuncSetAttribute failed\n"); grid = -1; return; }
        if (hipOccupancyMaxActiveBlocksPerMultiprocessor(&per_cu, (const void*)mk_fwd, NWAVES * 64, LDS_BYTES) != hipSuccess || per_cu < 1) { fprintf(stderr, "kernel_launch: occupancy query says %d blocks per CU\n", per_cu); per_cu = 1; }
        (void)hipGetLastError();
        grid = cus;
        if (grid != 256) { fprintf(stderr, "kernel_launch: built for a 256-CU device (got %d)\n", cus); grid = -1; return; }
    }
    if (grid < 0) return;
    (void)hipMemsetAsync((char*)d_ws + WS_CTL, 0, CTL_ZERO_BYTES, stream);
    Args a{};
    for (int i = 0; i < 17; ++i) a.in[i] = (const float*)d_in[i];
    a.out = (float*)d_out; a.ws = (unsigned char*)d_ws;
    launch_phases(a, 0, 9, 1, grid, stream);
}
```

```cpp
#include <hip/hip_runtime.h>
#include <hip/hip_bf16.h>
#include <cstdint>
#include <cstdio>
#include <cmath>

constexpr int D = 1024, BATCH = 8, SEQ = 4096, T = BATCH * SEQ, DIN = 2560, NMEM = 256, NE = 32, DFF = 1024;
constexpr int C_DQ = 0, C_DK = 512, C_DV = 1024, C_LQ = 1536, C_LK = 1792, C_LV = 2048, C_MQ = 2304;
constexpr float EPS = 1e-5f;
constexpr int LCAP = T;
constexpr float QSCALE = 0.125f * 1.4426950408889634f;
constexpr float LOG2E = 1.4426950408889634f;
namespace pg8 {
#define PG8_LAS __attribute__((address_space(3)))
typedef unsigned short bf16_t;
typedef short bf16x8 __attribute__((ext_vector_type(8)));
typedef float f32x4 __attribute__((ext_vector_type(4)));
typedef unsigned u32x4 __attribute__((ext_vector_type(4)));
typedef unsigned u32x2 __attribute__((ext_vector_type(2)));
constexpr int BM = 256, BK = 64, HALF = 128, HTB = HALF * BK * 2  , STAGE_BYTES = 8 * HTB, NXCD = 8, WGM = 8;

__host__ __device__ __forceinline__ int lds_byte(int r, int c) { const int st = (r >> 4) * 2 + (c >> 5), rr = r & 15, cc = c & 31, ob = rr * 64 + cc * 2; return st * 1024 + (ob ^ (((ob >> 9) & 1) << 5)); }
__host__ __device__ __forceinline__ void stage_rc(int b, int& R, int& C) { const int st = b / 1024, sb = b % 1024, swz = sb ^ (((sb >> 9) & 1) << 5); R = (st >> 1) * 16 + swz / 64; C = (st & 1) * 32 + (swz % 64) / 2; }
__host__ __device__ __forceinline__ int perm32(int rho) { const int n = rho >> 4, i = rho & 15; return 8 * (i >> 2) + 4 * n + (i & 3); }

struct Unit { size_t aoff, boff; int pm, pn, e, valid, mt; };
struct Gemm { const void* A; const void* Bt; int RB; int akstep; };
typedef int v8i __attribute__((ext_vector_type(8)));

struct StaticOrder {
    int nM, nN, nwg, G, c, RB; const unsigned* sc;
    __device__ void init(int M, int N, int RB_, int G_, int c_, const unsigned* sc_ = nullptr) { nM = M / BM; nN = N / BM; nwg = nM * nN; G = G_; c = c_; RB = RB_; sc = sc_; }
    __device__ bool next(int i, Unit& u) const {
        const long L = (long)i * G + c; if (L >= nwg) return false;
        int wgid = (int)L; { const int q = nwg / NXCD, r = nwg % NXCD, xcd = wgid % NXCD, off = wgid / NXCD; wgid = (xcd < r ? xcd * (q + 1) : r * (q + 1) + (xcd - r) * q) + off; }
        const int nig = WGM * nN, gid = wgid / nig, fm = gid * WGM, gsz = (nM - fm) < WGM ? (nM - fm) : WGM;
        u.pm = fm + ((wgid % nig) % gsz); u.pn = (wgid % nig) / gsz; u.e = 0; u.valid = 256; u.mt = 0;
        u.aoff = (size_t)u.pm * (size_t)(BM * RB); u.boff = (size_t)u.pn * (size_t)(BM * RB); return true;
    }
    __device__ __forceinline__ const unsigned* id_src(const Unit& u, int row) const { return sc + u.pm * 256 + row; }
    __device__ __forceinline__ const unsigned* sc_src(const Unit& u, int row) const { return sc + u.pm * 256 + row; }
    __device__ __forceinline__ const unsigned* bias_src(const Unit& u, int row) const { return sc + u.pm * 256 + row; }
};

__device__ __forceinline__ unsigned cvt_pk_bf16(float lo, float hi) { typedef float f2_ __attribute__((ext_vector_type(2))); typedef __bf16 b2_ __attribute__((ext_vector_type(2))); f2_ v = {lo, hi}; b2_ b = __builtin_convertvector(v, b2_); return __builtin_bit_cast(unsigned, b); }

template <class Epi, class Sched, bool ALIGN_EPI, bool GATHER, bool IDS, bool FP8 = false, bool LINEAR = false>
__device__ __forceinline__ void gemm_phase(PG8_LAS unsigned char* lds, PG8_LAS unsigned* idb, const Gemm g, const Sched& S, const Epi& E) {
    const int tid = threadIdx.x, wid = __builtin_amdgcn_readfirstlane(tid >> 6), lane = tid & 63, wr = wid >> 2, wc = wid & 3, fr = lane & 15, fq = lane >> 4;
    const int RB = g.RB; int nt = RB / (BK * 2); asm volatile("" : "+s"(nt));
    unsigned voffA[2], voffB[2]; int RA[2], CA[2];
#pragma unroll
    for (int i = 0; i < 2; ++i) { int R, C; stage_rc(tid * 16 + i * 8192, R, C); const int Rb = (R & ~31) + perm32(R & 31); RA[i] = R; CA[i] = C;
        voffA[i] = (unsigned)(R * RB + C * 2); voffB[i] = (unsigned)(Rb * RB + C * 2); }
    const size_t kstep = (size_t)(BK * 2), akstep = (size_t)g.akstep;
    const size_t hstep = (size_t)HALF * RB;
    const unsigned ldsw = (unsigned)wid * 1024u;
    const int aoff = lds_byte(wr * 64 + fr, fq * 8), boff = lds_byte(wc * 32 + fr, fq * 8);
#define PG8_SA(b, h) (((b) * 2 + (h)) * HTB)
#define PG8_SB(b, h) ((4 + (b) * 2 + (h)) * HTB)
#define PG8_STAGE(bufoff, gbase, voff) do { _Pragma("unroll") for (int _i = 0; _i < 2; ++_i) \
        __builtin_amdgcn_global_load_lds((const unsigned*)((const char*)(gbase) + (voff)[_i]), (PG8_LAS unsigned*)(lds + (bufoff) + ldsw + _i * 8192), 16, 0, 0); } while (0)
#define PG8_STAGE_A(bufoff, pbase, gbase, h, gv) do { if constexpr (GATHER) { PG8_STAGE(bufoff, gbase, gv[h]); } else { PG8_STAGE(bufoff, (pbase) + (h) * hstep, voffA); } } while (0)
#define PG8_LD32(p0_, p1_) __builtin_bit_cast(v8i, __builtin_shufflevector(*(const PG8_LAS u32x4*)(p0_), *(const PG8_LAS u32x4*)(p1_), 0, 1, 2, 3, 4, 5, 6, 7))
#define PG8_LDA(dst, b, h) do { if constexpr (FP8) { _Pragma("unroll") for (int m = 0; m < 4; ++m) dst##8[m] = PG8_LD32(lds + PG8_SA(b, h) + aoff + m * 2048, lds + PG8_SA(b, h) + aoff + m * 2048 + 1024); } \
        else { _Pragma("unroll") for (int m = 0; m < 4; ++m) _Pragma("unroll") for (int k = 0; k < 2; ++k) dst[m][k] = *(const PG8_LAS bf16x8*)(lds + PG8_SA(b, h) + aoff + m * 2048 + k * 1024); } } while (0)
#define PG8_LDB(dst, b, h) do { if constexpr (FP8) { _Pragma("unroll") for (int n = 0; n < 2; ++n) dst##8[n] = PG8_LD32(lds + PG8_SB(b, h) + boff + n * 2048, lds + PG8_SB(b, h) + boff + n * 2048 + 1024); } \
        else { _Pragma("unroll") for (int n = 0; n < 2; ++n) _Pragma("unroll") for (int k = 0; k < 2; ++k) dst[n][k] = *(const PG8_LAS bf16x8*)(lds + PG8_SB(b, h) + boff + n * 2048 + k * 1024); } } while (0)
#define PG8_MMA(ai, bj, At, Bt) do { __builtin_amdgcn_s_setprio(1); if constexpr (FP8) { _Pragma("unroll") for (int m = 0; m < 4; ++m) _Pragma("unroll") for (int n = 0; n < 2; ++n) \
        acc[ai][bj][m][n] = __builtin_amdgcn_mfma_scale_f32_16x16x128_f8f6f4(Bt##8[n], At##8[m], acc[ai][bj][m][n], 0, 0, 0, sca_, 0, 0x7f7f7f7f); } \
        else { _Pragma("unroll") for (int m = 0; m < 4; ++m) _Pragma("unroll") for (int n = 0; n < 2; ++n) _Pragma("unroll") for (int k = 0; k < 2; ++k) \
        acc[ai][bj][m][n] = __builtin_amdgcn_mfma_f32_16x16x32_bf16(Bt[n][k], At[m][k], acc[ai][bj][m][n], 0, 0, 0); } __builtin_amdgcn_s_setprio(0); } while (0)
#define PG8_WAIT_V(n) asm volatile("s_waitcnt vmcnt(" #n ")" ::: "memory")
#define PG8_WAIT_L(n) asm volatile("s_waitcnt lgkmcnt(" #n ")" ::: "memory")
#define PG8_BAR __builtin_amdgcn_s_barrier()
#define PG8_SCHED __builtin_amdgcn_sched_barrier(0)
#define PG8_IDS_DMA(u, s) do { if (wid < 4) { __builtin_amdgcn_global_load_lds(S.id_src(u, tid), (PG8_LAS unsigned*)(idb + (s) * 768 + wid * 64), 4, 0, 0); \
        __builtin_amdgcn_global_load_lds(S.sc_src(u, tid), (PG8_LAS unsigned*)(idb + (s) * 768 + 256 + wid * 64), 4, 0, 0); \
        __builtin_amdgcn_global_load_lds(S.bias_src(u, tid), (PG8_LAS unsigned*)(idb + (s) * 768 + 512 + wid * 64), 4, 0, 0); } } while (0)
#define PG8_GV(dst, s, un) do { _Pragma("unroll") for (int _h = 0; _h < 2; ++_h) _Pragma("unroll") for (int _i = 0; _i < 2; ++_i) \
        dst[_h][_i] = (LINEAR ? (unsigned)((un).pm * 256 + _h * 128 + RA[_i]) : (idb[(s) * 768 + _h * 128 + RA[_i]] >> 2)) * (unsigned)RB + (unsigned)(CA[_i] * 2); } while (0)
    Unit cur, nxt; int ui = 0, us = 0;
    if (!S.next(0, cur)) return;
    f32x4 acc[2][2][4][2];
#pragma unroll
    for (int a = 0; a < 2; ++a)
#pragma unroll
        for (int b = 0; b < 2; ++b)
#pragma unroll
            for (int m = 0; m < 4; ++m)
#pragma unroll
                for (int n = 0; n < 2; ++n) acc[a][b][m][n] = (f32x4){0.f, 0.f, 0.f, 0.f};
    bf16x8 At[4][2], B0[2][2], B1[2][2]; v8i At8[4], B08[2], B18[2];
    unsigned cv[2][2] = {{0u, 0u}, {0u, 0u}};
    const char* A0 = (const char*)g.A;
    const char* cA = A0 + (GATHER ? (size_t)0 : cur.aoff); const char* cB = (const char*)g.Bt + cur.boff;
    if constexpr (IDS) {
        PG8_IDS_DMA(cur, 0); PG8_WAIT_V(0); PG8_BAR;
    }
    if constexpr (GATHER) { PG8_GV(cv, 0, cur); }
    PG8_STAGE(PG8_SB(0, 0), cB, voffB); PG8_STAGE(PG8_SB(0, 1), cB + hstep, voffB); PG8_STAGE_A(PG8_SA(0, 0), cA, A0, 0, cv); PG8_STAGE_A(PG8_SA(0, 1), cA, A0, 1, cv);
    if (wr == 1) PG8_BAR;
    PG8_WAIT_V(2); PG8_BAR;
    PG8_STAGE(PG8_SB(1, 0), cB + kstep, voffB); PG8_STAGE_A(PG8_SA(1, 0), cA + akstep, A0 + akstep, 0, cv); PG8_STAGE(PG8_SB(1, 1), cB + hstep + kstep, voffB);
    PG8_WAIT_V(6); PG8_BAR;
    for (;;) {
        const bool has_next = S.next(ui + 1, nxt);
        const int ns = (us == 2) ? 0 : us + 1;
        if constexpr (IDS) { if (has_next) PG8_IDS_DMA(nxt, ns); }
        const char* nA = has_next ? A0 + (GATHER ? (size_t)0 : nxt.aoff) : cA; const char* nB = has_next ? (const char*)g.Bt + nxt.boff : cB;
#ifdef PROBE_KTWICE
        for (int rep_ = 0; rep_ < (FP8 ? 2 : 1); ++rep_) { const int sca_ = rep_ ? 0 : 0x7f7f7f7f;
#else
        { const int sca_ = 0x7f7f7f7f;
#endif
#pragma nounroll
        for (int t = 0; t < nt; t += 2) {
            int lastv = (t == nt - 2) ? 1 : 0; asm volatile("" : "+v"(lastv)); const bool last = __builtin_amdgcn_readfirstlane(lastv) != 0;
            const char* a1 = cA + (size_t)(t + 1) * akstep;
            const char* a2 = last ? nA : cA + (size_t)(t + 2) * akstep; const char* b2 = last ? nB : cB + (size_t)(t + 2) * kstep;
            const char* a3 = a2 + akstep; const char* b3 = b2 + kstep;
            PG8_LDB(B0, 0, 0); PG8_LDB(B1, 0, 1); PG8_SCHED; PG8_LDA(At, 0, 0); PG8_STAGE_A(PG8_SA(1, 1), a1, a1, 1, cv);
            if constexpr (GATHER) { if (last && has_next) { PG8_GV(cv, ns, nxt); } }
            PG8_WAIT_V(8); PG8_WAIT_L(0); PG8_BAR; PG8_MMA(0, 0, At, B0); PG8_MMA(0, 1, At, B1); PG8_BAR; PG8_SCHED;
            PG8_LDA(At, 0, 1); PG8_STAGE(PG8_SB(0, 0), b2, voffB); PG8_STAGE(PG8_SB(0, 1), b2 + hstep, voffB); PG8_STAGE_A(PG8_SA(0, 0), a2, a2, 0, cv);
            PG8_WAIT_V(8); PG8_WAIT_L(0); PG8_BAR; PG8_MMA(1, 0, At, B0); PG8_MMA(1, 1, At, B1); PG8_BAR; PG8_SCHED;
            PG8_LDB(B0, 1, 0); PG8_LDB(B1, 1, 1); PG8_SCHED; PG8_LDA(At, 1, 0); PG8_STAGE_A(PG8_SA(0, 1), a2, a2, 1, cv);
            PG8_WAIT_V(8); PG8_WAIT_L(0); PG8_BAR; PG8_MMA(0, 0, At, B0); PG8_MMA(0, 1, At, B1); PG8_BAR; PG8_SCHED;
            PG8_LDA(At, 1, 1); PG8_STAGE(PG8_SB(1, 0), b3, voffB); PG8_STAGE(PG8_SB(1, 1), b3 + hstep, voffB); PG8_STAGE_A(PG8_SA(1, 0), a3, a3, 0, cv);
            PG8_WAIT_V(8); PG8_WAIT_L(0); PG8_BAR; PG8_MMA(1, 0, At, B0); PG8_MMA(1, 1, At, B1); PG8_BAR; PG8_SCHED;
        }
        }
        if constexpr (ALIGN_EPI) { if (wr == 0) PG8_BAR; }
        PG8_SCHED;
        E(acc, cur, wr, wc, fr, fq, (const PG8_LAS unsigned*)(idb + us * 768));
        PG8_SCHED;
#ifdef PROBE_EPI2
        if constexpr (FP8) { E(acc, cur, wr, wc, fr, fq, (const PG8_LAS unsigned*)(idb + us * 768)); PG8_SCHED; }
#endif
        if (!has_next) break;
#pragma unroll
        for (int a = 0; a < 2; ++a)
#pragma unroll
            for (int b = 0; b < 2; ++b)
#pragma unroll
                for (int m = 0; m < 4; ++m)
#pragma unroll
                    for (int n = 0; n < 2; ++n) acc[a][b][m][n] = (f32x4){0.f, 0.f, 0.f, 0.f};
        cur = nxt; cA = nA; cB = nB; ++ui; us = ns;
        if constexpr (ALIGN_EPI) { if (wr == 1) PG8_BAR; }
    }
    PG8_WAIT_V(0);
    if constexpr (!ALIGN_EPI) { if (wr == 0) PG8_BAR; }
    PG8_BAR;
#undef PG8_SA
#undef PG8_SB
#undef PG8_STAGE
#undef PG8_STAGE_A
#undef PG8_LDA
#undef PG8_LDB
#undef PG8_MMA
#undef PG8_LD32
#undef PG8_WAIT_V
#undef PG8_WAIT_L
#undef PG8_BAR
#undef PG8_SCHED
#undef PG8_IDS_DMA
#undef PG8_GV
}
}
namespace attn_body {
using bf16=__hip_bfloat16;
using bf16x8=__attribute__((ext_vector_type(8)))short;
using s16x4=__attribute__((ext_vector_type(4)))short;
using f32x16=__attribute__((ext_vector_type(16)))float;
using u32x4=__attribute__((ext_vector_type(4)))unsigned;
constexpr int D=64;
constexpr int NW=8,QBLK=32,QB=QBLK*NW,KVBLK=64;
struct UnitP { const bf16* Q; const bf16* K; const bf16* V; bf16* O; long qp, kp, op; int q0, t0, NT; float slope2; float* lse; int lse_stride; };
__device__ __forceinline__ int crow(int r,int hi){return (r&3)+8*(r>>2)+4*hi;}
#define SBAR() __builtin_amdgcn_sched_barrier(0)
template<bool CAUSAL,bool WINDOW> __device__ __forceinline__ void cmask(f32x16&p0,f32x16&p1,int jb,int qrel,int hi){
  const float NEG=-INFINITY; int kb=64*jb+4*hi;
  #pragma unroll
  for(int r=0;r<16;++r){int kv=kb+(r&3)+8*(r>>2);
    if(CAUSAL){ if(kv>qrel)p0[r]=NEG; if(kv+32>qrel)p1[r]=NEG; }
    if(WINDOW){ if(kv<qrel-128)p0[r]=NEG; if(kv+32<qrel-128)p1[r]=NEG; } }
}
__device__ __forceinline__ unsigned bfr(float x){ typedef float f2_ __attribute__((ext_vector_type(2))); typedef __bf16 b2_ __attribute__((ext_vector_type(2))); f2_ v={x,0.f}; b2_ b=__builtin_convertvector(v,b2_); return __builtin_bit_cast(unsigned,b)&0xffffu; }
__device__ __forceinline__ float bfv(unsigned b){ return __builtin_bit_cast(float,b<<16); }

constexpr int NSLOT=3, SLOTB=8192;
constexpr int LDS_K=0, LDS_V=NSLOT*SLOTB;
template<int DV> struct Lds { static constexpr int SLOTV=SLOTB*(DV/64), WS=LDS_V+NSLOT*SLOTV, OST=WS+NW*64*4, OSTW=4096*(DV/64), BYTES=OST+NW*OSTW; };
__device__ __forceinline__ void glds16(const void*gsrc,unsigned lds_dst){unsigned keep;
  asm volatile("s_mov_b32 %0, m0\n\ts_mov_b32 m0, %2\n\ts_nop 0\n\tglobal_load_lds_dwordx4 %1, off\n\ts_mov_b32 m0, %0":"=&s"(keep):"v"(gsrc),"s"(lds_dst):"memory");}
__device__ __forceinline__ float max3f(float a,float b,float c){float r;asm("v_max3_f32 %0, %1, %2, %3":"=v"(r):"v"(a),"v"(b),"v"(c));return r;}
__device__ __forceinline__ float max2f(float a,float b){float r;asm("v_max_f32_e32 %0, %1, %2":"=v"(r):"v"(a),"v"(b));return r;}
__device__ __forceinline__ float fadd_s(float a,float b){float r;asm("v_add_f32_e32 %0, %1, %2":"=v"(r):"v"(a),"v"(b));return r;}
__device__ __forceinline__ float fsub_s(float a,float b){float r;asm("v_sub_f32_e32 %0, %1, %2":"=v"(r):"v"(a),"v"(b));return r;}
typedef float f32x2_t __attribute__((ext_vector_type(2))); typedef __bf16 bf16x2_t __attribute__((ext_vector_type(2)));
__device__ __forceinline__ unsigned cvtpk_s(float lo,float hi){f32x2_t v={lo,hi};bf16x2_t b=__builtin_convertvector(v,bf16x2_t);return __builtin_bit_cast(unsigned,b);}
#define WAIT_BAR(N) asm volatile("s_waitcnt vmcnt(" #N ") lgkmcnt(0)\n\ts_barrier":::"memory")

__device__ __forceinline__ void qkt(f32x16&p0,f32x16&p1,const char*Kslot,const bf16x8*qr,bf16x8 kx0,bf16x8 kx1,bf16x8 qx,int r32,int hi){
  const char*kb=Kslot+hi*1024+r32*16;
  #pragma unroll
  for(int d0=0;d0<4;++d0){
    const bf16x8 b0=*reinterpret_cast<const bf16x8*>(kb+d0*2048);
    const bf16x8 b1=*reinterpret_cast<const bf16x8*>(kb+d0*2048+512);
    if(d0==0){p0=__builtin_amdgcn_mfma_f32_32x32x16_bf16(b0,qr[0],f32x16{},0,0,0);p1=__builtin_amdgcn_mfma_f32_32x32x16_bf16(b1,qr[0],f32x16{},0,0,0);}
    else{p0=__builtin_amdgcn_mfma_f32_32x32x16_bf16(b0,qr[d0],p0,0,0,0);p1=__builtin_amdgcn_mfma_f32_32x32x16_bf16(b1,qr[d0],p1,0,0,0);}}
  p0=__builtin_amdgcn_mfma_f32_32x32x16_bf16(kx0,qx,p0,0,0,0);p1=__builtin_amdgcn_mfma_f32_32x32x16_bf16(kx1,qx,p1,0,0,0);
}
typedef __attribute__((address_space(3))) const char* lds_cptr;
typedef short v4i16_t __attribute__((ext_vector_type(4)));
__device__ __forceinline__ void kload8(bf16x8*kf,lds_cptr kp){
  kf[0]=*(const __attribute__((address_space(3))) bf16x8*)(kp);      kf[1]=*(const __attribute__((address_space(3))) bf16x8*)(kp+512);
  kf[2]=*(const __attribute__((address_space(3))) bf16x8*)(kp+2048); kf[3]=*(const __attribute__((address_space(3))) bf16x8*)(kp+2560);
  kf[4]=*(const __attribute__((address_space(3))) bf16x8*)(kp+4096); kf[5]=*(const __attribute__((address_space(3))) bf16x8*)(kp+4608);
  kf[6]=*(const __attribute__((address_space(3))) bf16x8*)(kp+6144); kf[7]=*(const __attribute__((address_space(3))) bf16x8*)(kp+6656);
}
__device__ __forceinline__ void kload2(bf16x8*kf,lds_cptr kp,int j){ kf[2*j]=*(const __attribute__((address_space(3))) bf16x8*)(kp+j*2048); kf[2*j+1]=*(const __attribute__((address_space(3))) bf16x8*)(kp+j*2048+512); }
__device__ __forceinline__ s16x4 vtr(lds_cptr p){ return __builtin_bit_cast(s16x4,__builtin_amdgcn_ds_read_tr16_b64_v4i16((__attribute__((address_space(3))) v4i16_t*)p)); }
__device__ __forceinline__ float rowmax(const f32x16&p0,const f32x16&p1){
  float a=max3f(p0[0],p0[1],p1[0]),b=max3f(p0[2],p0[3],p1[1]);a=max3f(a,p1[2],p1[3]);
  #pragma unroll
  for(int r=4;r<16;r+=4){a=max3f(a,p0[r],p0[r+1]);b=max3f(b,p0[r+2],p0[r+3]);a=max3f(a,p1[r],p1[r+1]);b=max3f(b,p1[r+2],p1[r+3]);}
  const float m=max2f(a,b);
  auto rr=__builtin_amdgcn_permlane32_swap(__float_as_uint(m),__float_as_uint(m),false,false);
  return max2f(__uint_as_float(rr[0]),__uint_as_float(rr[1]));
}
__device__ __forceinline__ void pv(f32x16*o,int vb,bf16x8 pa0,bf16x8 pa1,bf16x8 pa2,bf16x8 pa3){
  #pragma unroll
  for(int d0=0;d0<2;++d0){s16x4 lo[4],hi[4];
    #pragma unroll
    for(int ks=0;ks<4;++ks){
      asm volatile("ds_read_b64_tr_b16 %0,%1 offset:%c2":"=&v"(lo[ks]):"v"(vb),"i"(d0*4096+ks*1024):"memory");
      asm volatile("ds_read_b64_tr_b16 %0,%1 offset:%c2":"=&v"(hi[ks]):"v"(vb),"i"(d0*4096+ks*1024+512):"memory");}
    asm volatile("s_waitcnt lgkmcnt(0)":::"memory");SBAR();
    #define PK(k) (bf16x8){lo[k][0],lo[k][1],lo[k][2],lo[k][3],hi[k][0],hi[k][1],hi[k][2],hi[k][3]}
    o[d0]=__builtin_amdgcn_mfma_f32_32x32x16_bf16(pa0,PK(0),o[d0],0,0,0);
    o[d0]=__builtin_amdgcn_mfma_f32_32x32x16_bf16(pa1,PK(1),o[d0],0,0,0);
    o[d0]=__builtin_amdgcn_mfma_f32_32x32x16_bf16(pa2,PK(2),o[d0],0,0,0);
    o[d0]=__builtin_amdgcn_mfma_f32_32x32x16_bf16(pa3,PK(3),o[d0],0,0,0);
    #undef PK
  }
}

__device__ __forceinline__ void pv128(f32x16*o,int vb,bf16x8 pa0,bf16x8 pa1,bf16x8 pa2,bf16x8 pa3){
  #pragma unroll
  for(int d0=0;d0<4;++d0){s16x4 lo[4],hi[4];
    #pragma unroll
    for(int ks=0;ks<4;++ks){
      asm volatile("ds_read_b64_tr_b16 %0,%1 offset:%c2":"=&v"(lo[ks]):"v"(vb),"i"(d0*4096+ks*1024):"memory");
      asm volatile("ds_read_b64_tr_b16 %0,%1 offset:%c2":"=&v"(hi[ks]):"v"(vb),"i"(d0*4096+ks*1024+512):"memory");}
    asm volatile("s_waitcnt lgkmcnt(0)":::"memory");SBAR();
    #define PK(k) (bf16x8){lo[k][0],lo[k][1],lo[k][2],lo[k][3],hi[k][0],hi[k][1],hi[k][2],hi[k][3]}
    o[d0]=__builtin_amdgcn_mfma_f32_32x32x16_bf16(pa0,PK(0),o[d0],0,0,0);
    o[d0]=__builtin_amdgcn_mfma_f32_32x32x16_bf16(pa1,PK(1),o[d0],0,0,0);
    o[d0]=__builtin_amdgcn_mfma_f32_32x32x16_bf16(pa2,PK(2),o[d0],0,0,0);
    o[d0]=__builtin_amdgcn_mfma_f32_32x32x16_bf16(pa3,PK(3),o[d0],0,0,0);
    #undef PK
  }
}
#ifndef ATTN_STORE16
#define ATTN_STORE16(p,v) (*(u32x4*)(p)=(v))
#endif
template<int THRL,bool CAUSAL,bool WINDOW,bool ALIBI,bool LSE,int DV=64> __device__ __forceinline__ void attn_unit(const UnitP&U,char*shm){
  constexpr int LDS_WS=Lds<DV>::WS, LDS_OST=Lds<DV>::OST, VMUL=DV/64;
  int tid=threadIdx.x; asm volatile("":"+v"(tid));
  const int lane=tid&63,r32=lane&31,hi=lane>>5; const int wid=__builtin_amdgcn_readfirstlane(tid>>6);
  const int q0=U.q0; const long qp=U.qp,kp=U.kp,op=U.op; const float slope2=U.slope2;
  const bf16*Qw=U.Q+(long)(q0+wid*QBLK)*qp;
  const bf16*Kh=U.K+(long)U.t0*KVBLK*kp,*Vh=U.V+(long)U.t0*KVBLK*kp;
  const unsigned lds0=(unsigned)(uintptr_t)shm;
  float*wsf=(float*)(shm+LDS_WS)+wid*64;
  const bf16*ksrc=Kh+(long)lane*kp+wid*8;
  const bf16*vsrc=Vh+(long)(16*(wid&3)+(lane>>2))*kp+(wid>>2)*32+(lane&3)*8;
  const unsigned kdst=lds0+LDS_K+wid*1024, vdst=lds0+LDS_V+wid*1024;
  #define DMA_K(t,slot) glds16(ksrc+(long)(t)*KVBLK*kp,(unsigned)__builtin_amdgcn_readfirstlane(kdst+(slot)))
  #define DMA_V(t,slot) do{ glds16(vsrc+(long)(t)*KVBLK*kp,(unsigned)__builtin_amdgcn_readfirstlane(vdst+VMUL*(slot))); if constexpr(DV==128) glds16(vsrc+64+(long)(t)*KVBLK*kp,(unsigned)__builtin_amdgcn_readfirstlane(vdst+VMUL*(slot)+8192)); }while(0)
  const int vb0=(int)(lds0+LDS_V)+((lane>>4)&1)*32+(lane&3)*8+(4*hi+((lane&15)>>2))*64;
  const char*Kbase=shm+LDS_K; bf16x8 kf[8];
  const lds_cptr shm3=(lds_cptr)shm; const lds_cptr kp0=shm3+LDS_K+hi*1024+r32*16; const lds_cptr vp0=shm3+LDS_V+((lane>>4)&1)*32+(lane&3)*8+(4*hi+((lane&15)>>2))*64;
  const int NT=U.NT;
  DMA_K(0,0);DMA_V(0,0);DMA_K(1,SLOTB);
  bf16x8 qr[4];
  #pragma unroll
  for(int d0=0;d0<4;++d0)qr[d0]=*reinterpret_cast<const bf16x8*>(&Qw[(long)r32*qp+d0*16+hi*8]);
  float mhat=0.f,l_reg=0.f;f32x16 o[4];o[0]=f32x16{};o[1]=f32x16{};o[2]=f32x16{};o[3]=f32x16{};
  const int qrel=wid*QBLK+r32;
  #define CMASK(P0,P1,t) do{int jb_=(t)-(NT-4); if(WINDOW||(CAUSAL&&jb_>=0))cmask<CAUSAL,WINDOW>(P0,P1,jb_,qrel,hi);}while(0)
  bf16x8 kx0,kx1,qx;
  { const float k0_=ALIBI?slope2*(float)r32:0.f, k1_=ALIBI?slope2*(float)(r32+32):0.f; const unsigned h0=bfr(k0_),l0=bfr(k0_-bfv(h0)),h1=bfr(k1_),l1=bfr(k1_-bfv(h1));
    u32x4 a={0x3f803f80u,0x3f80u|(h0<<16),l0,0u}, b={0x3f803f80u,0x3f80u|(h1<<16),l1,0u}; if(hi){a=u32x4{0u,0u,0u,0u};b=a;} kx0=__builtin_bit_cast(bf16x8,a); kx1=__builtin_bit_cast(bf16x8,b); }
  #define QX_SET(t) do{ const float nb_=ALIBI?__builtin_fmaf(slope2,(float)(64*((t)-(NT-4))-qrel),-mhat):-mhat; const unsigned a_=bfr(nb_); const float r1_=nb_-bfv(a_); const unsigned b_=bfr(r1_); const unsigned c_=bfr(r1_-bfv(b_)); \
    u32x4 q_={a_|(b_<<16),c_|0x3f800000u,0x3f80u,0u}; if(hi)q_=u32x4{0u,0u,0u,0u}; qx=__builtin_bit_cast(bf16x8,q_); asm volatile("":"+v"(qx)); }while(0)
  bool resc=false;
  #define START(P0,P1) do{ const float rm=rowmax(P0,P1); resc=false; \
    { const float dl=(rm==-INFINITY)?0.f:rm; mhat=fadd_s(mhat,dl); \
      _Pragma("unroll") for(int r=0;r<16;++r){P0[r]=fsub_s(P0[r],dl);P1[r]=fsub_s(P1[r],dl);} } \
    _Pragma("unroll") for(int r=0;r<16;++r)P0[r]=__builtin_amdgcn_exp2f(P0[r]); }while(0)
  #define RESC() do{ if(resc){ asm volatile("s_waitcnt lgkmcnt(0)":::"memory"); \
      _Pragma("unroll") for(int d_=0;d_<2*VMUL;++d_) _Pragma("unroll") for(int r=0;r<16;++r)o[d_][r]*=wsf[crow(r,hi)]; } }while(0)
  f32x16 pA0,pA1,pB0,pB1;
  int sl_prev=0,sl_cur=0,sl_next=SLOTB;
  #define ROT() do{sl_prev=sl_cur;sl_cur=sl_next;sl_next=(sl_next==(NSLOT-1)*SLOTB)?0:sl_next+SLOTB;}while(0)
  DMA_K(2,2*SLOTB);
  if constexpr(DV==128){WAIT_BAR(4);}else{WAIT_BAR(3);}
  QX_SET(0);
  qkt(pA0,pA1,Kbase,qr,kx0,kx1,qx,r32,hi);asm volatile("s_nop 15\n\ts_nop 7":"+v"(pA0),"+v"(pA1));CMASK(pA0,pA1,0);
  START(pA0,pA1);
  _Pragma("unroll") for(int r=0;r<16;++r)pA1[r]=__builtin_amdgcn_exp2f(pA1[r]);
  WAIT_BAR(0);
  DMA_K(3,0);DMA_V(1,SLOTB);
  ROT();
  kload8(kf,kp0+sl_cur);
  if constexpr(DV==128){WAIT_BAR(3);}else{WAIT_BAR(2);}
  s16x4 vlo[8],vhi[8]; s16x4 vfl[4],vfh[4]; u32x4 pw0,pw1,pw2,pw3;
  #define PKW(P,B) cvtpk_s(P[B],P[B+1])
  #define PAF(k) __builtin_bit_cast(bf16x8,pw##k)
  #define VFR(i) (bf16x8){vlo[i][0],vlo[i][1],vlo[i][2],vlo[i][3],vhi[i][0],vhi[i][1],vhi[i][2],vhi[i][3]}
  #define PIN(x) asm volatile("":"+v"(x))
  #define MX3(a,b,c) __builtin_fmaxf(__builtin_fmaxf((a),(b)),(c))
  #define GAPA(MF,A0,A1,A2,A3,W0,W1,PW) do{ MF; sacc+=A0; sacc+=A1; sacc+=A2; sacc+=A3; PIN(sacc); W0; W1; PIN(PW); SBAR(); }while(0)
  #define EX(v) __builtin_amdgcn_exp2f(v)
  #define GAPB(MF,X,B) do{ MF; X[B]=EX(X[B]); X[B+1]=EX(X[B+1]); X[B+2]=EX(X[B+2]); X[B+3]=EX(X[B+3]); PIN(X); SBAR(); }while(0)
  #define VRD(i) do{ if constexpr(DV==64){ vlo[i]=vtr(vp_+(((i)>>2)*4096+((i)&3)*1024)); vhi[i]=vtr(vp_+(((i)>>2)*4096+((i)&3)*1024+512)); } }while(0)
  #define VRJ(f) do{ vfl[(f)&3]=vtr(vp_+(((f)&3)*4096+((f)>>2)*1024)); vfh[(f)&3]=vtr(vp_+(((f)&3)*4096+((f)>>2)*1024+512)); }while(0)
  #define VFJ(f) (bf16x8){vfl[(f)&3][0],vfl[(f)&3][1],vfl[(f)&3][2],vfl[(f)&3][3],vfh[(f)&3][0],vfh[(f)&3][1],vfh[(f)&3][2],vfh[(f)&3][3]}
  #define GAPJ(f,PA,X,B) do{ if((f)+3<16){VRJ((f)+3);} o[(f)&3]=__builtin_amdgcn_mfma_f32_32x32x16_bf16(PA,VFJ(f),o[(f)&3],0,0,0); X[B]=EX(X[B]); X[B+1]=EX(X[B+1]); PIN(X); SBAR(); }while(0)
  #define KRD(G,j) do{ if(G){ kload2(kf,kp0+sl_next,j); SBAR(); } }while(0)
  #define STEP(C0,C1,P0,P1,t,GK,GV,GL) do{ SBAR(); QX_SET(t); SBAR(); \
    const lds_cptr vp_=vp0+VMUL*sl_prev; \
    VRD(0); SBAR(); float sacc=(P0[0]+P0[1]); \
    GAPA(C0=__builtin_amdgcn_mfma_f32_32x32x16_bf16(kf[0],qr[0],f32x16{},0,0,0), P0[2],P0[3],P0[4],P0[5],     pw0[0]=PKW(P0,0), pw0[1]=PKW(P0,2), pw0); \
    VRD(4); SBAR(); GAPA(C1=__builtin_amdgcn_mfma_f32_32x32x16_bf16(kf[1],qr[0],f32x16{},0,0,0), P0[6],P0[7],P0[8],P0[9],     pw0[2]=PKW(P0,4), pw0[3]=PKW(P0,6), pw0); \
    VRD(1); SBAR(); GAPA(C0=__builtin_amdgcn_mfma_f32_32x32x16_bf16(kf[2],qr[1],C0,0,0,0),   P0[10],P0[11],P0[12],P0[13], pw1[0]=PKW(P0,8), pw1[1]=PKW(P0,10), pw1); \
    VRD(5); SBAR(); GAPA(C1=__builtin_amdgcn_mfma_f32_32x32x16_bf16(kf[3],qr[1],C1,0,0,0),   P0[14],P0[15],P1[0],P1[1],   pw1[2]=PKW(P0,12),pw1[3]=PKW(P0,14), pw1); \
    VRD(2); SBAR(); GAPA(C0=__builtin_amdgcn_mfma_f32_32x32x16_bf16(kf[4],qr[2],C0,0,0,0),   P1[2],P1[3],P1[4],P1[5],     pw2[0]=PKW(P1,0), pw2[1]=PKW(P1,2), pw2); \
    VRD(6); SBAR(); GAPA(C1=__builtin_amdgcn_mfma_f32_32x32x16_bf16(kf[5],qr[2],C1,0,0,0),   P1[6],P1[7],P1[8],P1[9],     pw2[2]=PKW(P1,4), pw2[3]=PKW(P1,6), pw2); \
    VRD(3); SBAR(); GAPA(C0=__builtin_amdgcn_mfma_f32_32x32x16_bf16(kf[6],qr[3],C0,0,0,0),   P1[10],P1[11],P1[12],P1[13], pw3[0]=PKW(P1,8), pw3[1]=PKW(P1,10), pw3); \
    VRD(7); SBAR(); GAPA(C1=__builtin_amdgcn_mfma_f32_32x32x16_bf16(kf[7],qr[3],C1,0,0,0),   P1[14],P1[15],0.f,0.f,       pw3[2]=PKW(P1,12),pw3[3]=PKW(P1,14), pw3); \
    C0=__builtin_amdgcn_mfma_f32_32x32x16_bf16(kx0,qx,C0,0,0,0); C1=__builtin_amdgcn_mfma_f32_32x32x16_bf16(kx1,qx,C1,0,0,0); if constexpr(DV==128){VRJ(0);VRJ(1);VRJ(2);} SBAR(); \
    l_reg+=sacc; \
    if(GK){DMA_K((t)+3,sl_cur);} if(GV){DMA_V((t)+1,sl_next);} \
    CMASK(C0,C1,t); \
    { float a=MX3(C0[0],C0[1],C1[0]),b=MX3(C0[2],C0[3],C1[1]); a=MX3(a,C1[2],C1[3]); \
      _Pragma("unroll") for(int r=4;r<16;r+=4){a=MX3(a,C0[r],C0[r+1]);b=MX3(b,C0[r+2],C0[r+3]);a=MX3(a,C1[r],C1[r+1]);b=MX3(b,C1[r+2],C1[r+3]);} \
      float rm=__builtin_fmaxf(a,b); { auto rr=__builtin_amdgcn_permlane32_swap(__float_as_uint(rm),__float_as_uint(rm),false,false); rm=__builtin_fmaxf(__uint_as_float(rr[0]),__uint_as_float(rr[1])); } \
      resc=false; \
      if(__builtin_expect(__any(rm>(float)THRL),0)){ const float dl=__builtin_fmaxf(rm,0.f); mhat+=dl; \
        _Pragma("unroll") for(int r=0;r<16;++r){C0[r]-=dl;C1[r]-=dl;} \
        const float f=__builtin_amdgcn_exp2f(-dl); l_reg*=f; if(hi==0)wsf[r32]=f; resc=true; } } \
    SBAR(); \
    if constexpr(DV==64){ \
    GAPB(o[0]=__builtin_amdgcn_mfma_f32_32x32x16_bf16(PAF(0),VFR(0),o[0],0,0,0), C0,0); \
    GAPB(o[1]=__builtin_amdgcn_mfma_f32_32x32x16_bf16(PAF(0),VFR(4),o[1],0,0,0), C0,4); \
    KRD(GL,0); GAPB(o[0]=__builtin_amdgcn_mfma_f32_32x32x16_bf16(PAF(1),VFR(1),o[0],0,0,0), C0,8); \
    KRD(GL,1); GAPB(o[1]=__builtin_amdgcn_mfma_f32_32x32x16_bf16(PAF(1),VFR(5),o[1],0,0,0), C0,12); \
    KRD(GL,2); GAPB(o[0]=__builtin_amdgcn_mfma_f32_32x32x16_bf16(PAF(2),VFR(2),o[0],0,0,0), C1,0); \
    KRD(GL,3); GAPB(o[1]=__builtin_amdgcn_mfma_f32_32x32x16_bf16(PAF(2),VFR(6),o[1],0,0,0), C1,4); \
    GAPB(o[0]=__builtin_amdgcn_mfma_f32_32x32x16_bf16(PAF(3),VFR(3),o[0],0,0,0), C1,8); \
    GAPB(o[1]=__builtin_amdgcn_mfma_f32_32x32x16_bf16(PAF(3),VFR(7),o[1],0,0,0), C1,12); \
    } else { \
    GAPJ(0,PAF(0),C0,0); GAPJ(1,PAF(0),C0,2); GAPJ(2,PAF(0),C0,4); GAPJ(3,PAF(0),C0,6); \
    KRD(GL,0); GAPJ(4,PAF(1),C0,8); GAPJ(5,PAF(1),C0,10); KRD(GL,1); GAPJ(6,PAF(1),C0,12); GAPJ(7,PAF(1),C0,14); \
    KRD(GL,2); GAPJ(8,PAF(2),C1,0); GAPJ(9,PAF(2),C1,2); KRD(GL,3); GAPJ(10,PAF(2),C1,4); GAPJ(11,PAF(2),C1,6); \
    GAPJ(12,PAF(3),C1,8); GAPJ(13,PAF(3),C1,10); GAPJ(14,PAF(3),C1,12); GAPJ(15,PAF(3),C1,14); \
    } \
    }while(0)
  int t=1;
  #undef CMASK
  #define CMASK(P0,P1,t) do{}while(0)
  for(;t+5<NT;t+=2){
    STEP(pB0,pB1,pA0,pA1,t,true,true,true);     if constexpr(DV==128){WAIT_BAR(3);}else{WAIT_BAR(2);} RESC(); ROT();
    STEP(pA0,pA1,pB0,pB1,t+1,true,true,true);   if constexpr(DV==128){WAIT_BAR(3);}else{WAIT_BAR(2);} RESC(); ROT();
  }
  #undef CMASK
  #define CMASK(P0,P1,t) do{int jb_=(t)-(NT-4); if(WINDOW||(CAUSAL&&jb_>=0))cmask<CAUSAL,WINDOW>(P0,P1,jb_,qrel,hi);}while(0)
  #define ENDW(tt) do{ if((tt)+3<NT){ if constexpr(DV==128){WAIT_BAR(3);}else{WAIT_BAR(2);} } else if((tt)+2<NT){ if constexpr(DV==128){WAIT_BAR(2);}else{WAIT_BAR(1);} } else {WAIT_BAR(0);} }while(0)
  for(;t+1<NT;t+=2){
    STEP(pB0,pB1,pA0,pA1,t,(t+3<NT),(t+1<NT),(t+1<NT));       ENDW(t);   RESC(); ROT();
    STEP(pA0,pA1,pB0,pB1,t+1,(t+4<NT),(t+2<NT),(t+2<NT));     ENDW(t+1); RESC(); ROT();
  }
  STEP(pB0,pB1,pA0,pA1,NT-1,false,false,false); RESC();
  { float sacc=pB0[0]+pB0[1]; _Pragma("unroll") for(int r=2;r<16;++r)sacc+=pB0[r]; _Pragma("unroll") for(int r=0;r<16;++r)sacc+=pB1[r]; l_reg+=sacc;
    pw0=(u32x4){PKW(pB0,0),PKW(pB0,2),PKW(pB0,4),PKW(pB0,6)};pw1=(u32x4){PKW(pB0,8),PKW(pB0,10),PKW(pB0,12),PKW(pB0,14)};pw2=(u32x4){PKW(pB1,0),PKW(pB1,2),PKW(pB1,4),PKW(pB1,6)};pw3=(u32x4){PKW(pB1,8),PKW(pB1,10),PKW(pB1,12),PKW(pB1,14)};
    SBAR(); if constexpr(DV==128){pv128(o,vb0+VMUL*sl_cur,PAF(0),PAF(1),PAF(2),PAF(3));}else{pv(o,vb0+sl_cur,PAF(0),PAF(1),PAF(2),PAF(3));} }
  #undef PKW
  #undef PAF
  #undef VFR
  #undef PIN
  #undef MX3
  #undef GAPA
  #undef GAPB
  #undef EX
  #undef VRD
  #undef VRJ
  #undef VFJ
  #undef GAPJ
  #undef KRD
  #undef STEP
  #undef ENDW
  {auto rr=__builtin_amdgcn_permlane32_swap(__float_as_uint(l_reg),__float_as_uint(l_reg),false,false);l_reg=__uint_as_float(rr[0])+__uint_as_float(rr[1]);}
  if(LSE){ if(hi==0)U.lse[(long)(q0+wid*QBLK+r32)*U.lse_stride]=mhat+__builtin_amdgcn_logf(l_reg); }
  if(hi==0)wsf[32+r32]=l_reg;asm volatile("s_waitcnt lgkmcnt(0)":::"memory");
  float rli[16];
  #pragma unroll
  for(int r=0;r<16;++r)rli[r]=__builtin_amdgcn_rcpf(wsf[32+crow(r,hi)]);
  bf16*Ow=U.O+(long)(q0+wid*QBLK)*op;
  { bf16*stg=(bf16*)(shm+LDS_OST)+wid*(2048*VMUL);
    #pragma unroll
    for(int r=0;r<16;++r){const int orow=crow(r,hi);
      #pragma unroll
      for(int d0=0;d0<2*VMUL;++d0)stg[orow*DV+d0*32+r32]=__float2bfloat16(o[d0][r]*rli[r]);}
    asm volatile("s_waitcnt lgkmcnt(0)":::"memory");
    if constexpr(DV==128){
      #pragma unroll
      for(int i=0;i<8;++i){const int row=i*4+(lane>>4),ch=lane&15; const u32x4 v=*(const u32x4*)(stg+row*128+ch*8); ATTN_STORE16(Ow+(long)row*op+ch*8,v);}
    } else {
      #pragma unroll
      for(int i=0;i<4;++i){const int row=i*8+(lane>>3),ch=lane&7; const u32x4 v=*(const u32x4*)(stg+row*64+ch*8); ATTN_STORE16(Ow+(long)row*op+ch*8,v);} } }
  asm volatile("s_waitcnt lgkmcnt(0)\n\ts_barrier":::"memory");
  #undef DMA_K
  #undef DMA_V
  #undef CMASK
  #undef START
  #undef RESC
  #undef ROT
  #undef QX_SET
}
constexpr int ATTN_LDS_BYTES=Lds<128>::BYTES;
#undef SBAR
#undef WAIT_BAR
}
constexpr size_t MiB = 1u << 20;
constexpr size_t WS_CTL = 0, CTL_ZERO_BYTES = 1 * MiB;
constexpr size_t WS_LIST = 1 * MiB;
constexpr size_t WS_RGATE = 5 * MiB;
constexpr size_t WS_RSTD1 = 5 * MiB + 512 * 1024, WS_RSTD2 = WS_RSTD1 + 128 * 1024, WS_WRG = WS_RSTD2 + 128 * 1024;
constexpr size_t WS_WRT = 7 * MiB + 512 * 1024;
constexpr size_t WS_LSE = 6 * MiB;
constexpr size_t WS_MKV = 8 * MiB;
constexpr size_t WS_WIN = 10 * MiB, WS_WOUT = 15 * MiB, WS_WGU = 17 * MiB, WS_WDN = 145 * MiB;
constexpr size_t WS_XB = 209 * MiB;
constexpr size_t WS_LRSTD = 209 * MiB, WS_LGATE = 213 * MiB;
constexpr size_t WS_P = 273 * MiB, WS_OD = 433 * MiB, WS_ODIL = 497 * MiB;
constexpr size_t WS_ACT = 273 * MiB;
constexpr size_t WS_MIX = 545 * MiB, WS_X1B = 609 * MiB, WS_YB = 673 * MiB, WS_X1H = 801 * MiB, WS_Y = 929 * MiB, WS_END = 993 * MiB;
constexpr int CW_TMO = 0, CW_CODE = 1;
constexpr int CW_CNT = 64;
constexpr int CW_NRM = 256;
constexpr int CW_Q = 1024;
constexpr int CW_BAR = 4096;

constexpr int RING_OFF = 0, RING_BYTES = 131072;
constexpr int LDSCTL_OFF = RING_BYTES;
constexpr int IDB_OFF = LDSCTL_OFF;
constexpr int TBL_OFF = IDB_OFF + 9216;
constexpr int LCNT_OFF = TBL_OFF + 2304;
constexpr int MISC_OFF = LCNT_OFF + 256;
constexpr int STG_OFF = IDB_OFF;
constexpr int LDS_BYTES = 147456;
static_assert(MISC_OFF + 128 <= LDS_BYTES && 512 * 16 <= 9216, "LDS map");
constexpr int NWAVES = 8;

#define GAS __attribute__((address_space(1)))
#define LAS __attribute__((address_space(3)))
typedef unsigned short bf16;
typedef unsigned v4u __attribute__((ext_vector_type(4)));
typedef unsigned v2u __attribute__((ext_vector_type(2)));
typedef float f32x4 __attribute__((ext_vector_type(4)));
typedef float f32x16 __attribute__((ext_vector_type(16)));
typedef short bf16x8 __attribute__((ext_vector_type(8)));
typedef GAS unsigned gu32;
#define RLX_AGENT __ATOMIC_RELAXED, __HIP_MEMORY_SCOPE_AGENT
#define LDS_WAIT() asm volatile("s_waitcnt lgkmcnt(0)" ::: "memory")
#define VM_WAIT() asm volatile("s_waitcnt vmcnt(0)" ::: "memory")
__device__ __forceinline__ unsigned f2bf(float f) { unsigned u = __builtin_bit_cast(unsigned, f); return (u + 0x7fffu + ((u >> 16) & 1u)) >> 16; }
__device__ __forceinline__ unsigned pk2(float lo, float hi) { return f2bf(lo) | (f2bf(hi) << 16); }
__device__ __forceinline__ float sat8(float v) { return __builtin_amdgcn_fmed3f(v, -448.f, 448.f); }
__device__ __forceinline__ unsigned fp8x4(float a, float b, float c, float d) { int w = __builtin_amdgcn_cvt_pk_fp8_f32(sat8(a), sat8(b), 0, false); w = __builtin_amdgcn_cvt_pk_fp8_f32(sat8(c), sat8(d), w, true); return (unsigned)w; }
constexpr float WSCALE = 64.f, ASCALE = 8.f, YSCALE = 64.f;
__device__ __forceinline__ float bf2f(unsigned short b) { return __builtin_bit_cast(float, (unsigned)b << 16); }
__device__ __forceinline__ float bflo(unsigned w) { return __builtin_bit_cast(float, w << 16); }
__device__ __forceinline__ float bfhi(unsigned w) { return __builtin_bit_cast(float, w & 0xffff0000u); }
__device__ __forceinline__ float wave_sum(float v) {
#pragma unroll
    for (int o = 1; o < 64; o <<= 1) v += __shfl_xor(v, o);
    return v;
}

#define XB_TMO      128
#define XB_XCNT(j)  (256  + 64 * (j))
#define XB_XSUB(j)  (1280 + 64 * (j))
#define XB_XGEN(j)  (2304 + 64 * (j))
#define XB_TOP      3328
#define XB_TOPGEN   3392
#define XCD_BAR_WORDS 3456
#define XB_SPIN_CAP (1u << 20)
__device__ __forceinline__ unsigned xb_ld(unsigned* p)              { return __hip_atomic_load(p, __ATOMIC_RELAXED, __HIP_MEMORY_SCOPE_AGENT); }
__device__ __forceinline__ unsigned xb_add(unsigned* p, unsigned v) { return __hip_atomic_fetch_add(p, v, __ATOMIC_RELAXED, __HIP_MEMORY_SCOPE_AGENT); }
__device__ __forceinline__ unsigned xb_xcc_id() { return (unsigned)__builtin_amdgcn_s_getreg((3 << 11) | 20) & 0xFu; }
#define XB_SPIN(cond, bar) do { unsigned _sp = 0; while (cond) { __builtin_amdgcn_s_sleep(1); \
    if ((++_sp & 255u) == 0u) { if (xb_ld(&(bar)[XB_TMO])) break; if (_sp > XB_SPIN_CAP) { atomicAdd(&(bar)[XB_TMO], 1u); break; } } } } while (0)
struct XcdBarrier { unsigned* bar; unsigned x; volatile LAS unsigned* st; };
__device__ __forceinline__ XcdBarrier xcd_barrier_post(unsigned* bar, volatile LAS unsigned* st) {
    XcdBarrier b; b.bar = bar; b.x = xb_xcc_id(); b.st = st;
    if (threadIdx.x == 0) (void)xb_add(&bar[XB_XCNT(b.x)], 1u);
    return b;
}
__device__ __forceinline__ void xcd_barrier_complete(unsigned* bar, unsigned x, unsigned& nloc, unsigned& nx) {
    const unsigned G = gridDim.x * gridDim.y * gridDim.z;
    unsigned sum, cnt, mine, sp = 0u;
    for (;;) {
        sum = 0u; cnt = 0u; mine = 0u;
#pragma unroll
        for (unsigned j = 0; j < 16; ++j) { const unsigned c = xb_ld(&bar[XB_XCNT(j)]); sum += c; cnt += (c > 0u) ? 1u : 0u; mine = (j == x) ? c : mine; }
        if (sum == G) break;
        __builtin_amdgcn_s_sleep(1);
        if ((++sp & 255u) == 0u) { if (xb_ld(&bar[XB_TMO])) break; if (sp > XB_SPIN_CAP) { atomicAdd(&bar[XB_TMO], 1u); break; } }
    }
    nloc = mine > 0u ? mine : 1u; nx = cnt > 0u ? cnt : 1u;
}
__device__ __forceinline__ void xcd_barrier(const XcdBarrier& b) {
    asm volatile("s_waitcnt vmcnt(0)" ::: "memory");
    __syncthreads();
    if (threadIdx.x == 0) {
        unsigned* bar = b.bar;
        __builtin_amdgcn_s_waitcnt(0);
        unsigned nloc = b.st[0], nx = b.st[1];
        if (nloc == 0u) { xcd_barrier_complete(bar, b.x, nloc, nx); b.st[0] = nloc; b.st[1] = nx; }
        const unsigned old = xb_add(&bar[XB_XSUB(b.x)], 1u);
        const unsigned gen = old / nloc;
        if (old + 1u == (gen + 1u) * nloc) {
            __builtin_amdgcn_fence(__ATOMIC_RELEASE, "agent");
            asm volatile("s_waitcnt vmcnt(0)" ::: "memory");
            const unsigned og = xb_add(&bar[XB_TOP], 1u);
            const unsigned tg = og / nx;
            if (og + 1u == (tg + 1u) * nx) xb_add(&bar[XB_TOPGEN], 1u);
            else XB_SPIN(xb_ld(&bar[XB_TOPGEN]) == tg, bar);
            __builtin_amdgcn_fence(__ATOMIC_ACQUIRE, "agent");
            xb_add(&bar[XB_XGEN(b.x)], 1u);
            asm volatile("s_waitcnt vmcnt(0)" ::: "memory");
        } else {
            XB_SPIN(xb_ld(&bar[XB_XGEN(b.x)]) == gen, bar);
            __builtin_amdgcn_fence(__ATOMIC_ACQUIRE, "agent");
            asm volatile("s_waitcnt vmcnt(0)" ::: "memory");
        }
    }
    __syncthreads();
}

struct Frame {
    LAS unsigned char* lds;
    volatile LAS unsigned* MISC;
    gu32* ctl;
    int tid, lane, wave;
    int vcu, G;
    const float *x, *mem, *g_attn, *g_mem, *w_in, *lamqk, *subg, *w_mkv, *w_out, *g_ffn, *w_r, *b_r, *w_gu, *b_gu, *w_dn, *b_dn, *g_fin;
    float* out; unsigned char* ws;
};

#define P0_LOAD(dst, itm) do { const int m_ = (itm) / ipm, r_ = (itm) % ipm, kb_ = r_ / nblk, nb_ = r_ % nblk; \
        const float* src_ = W + (size_t)m_ * K * N + (size_t)(64 * kb_ + (lane >> 5)) * N + 32 * nb_ + (lane & 31); \
        _Pragma("unroll") for (int i_ = 0; i_ < 32; ++i_) dst[i_] = src_[(size_t)(2 * i_) * N]; } while (0)
template <bool F8, class RowMap>
__device__ __forceinline__ void p0_transpose_all(const float* W, int K, int N, int nmat, void* WTv, const float* gk, float wscale, LAS float* scr, int gw, int NGW, int lane, RowMap rowmap) {
    asm volatile("" : "+v"(lane));
    const int nblk = N / 32, ipm = (K / 64) * nblk, total = nmat * ipm;
    int it = gw; if (it >= total) return;
    float v[32], w[32];
    P0_LOAD(v, it);
    for (;;) {
        const int nx = it + NGW; const bool more = nx < total;
        if (more) P0_LOAD(w, nx);
        const int m = it / ipm, r = it % ipm, k0 = 64 * (r / nblk), n0 = 32 * (r % nblk);
        if (gk) {
#pragma unroll
            for (int i = 0; i < 32; ++i) v[i] *= gk[k0 + 2 * i + (lane >> 5)] * wscale;
        } else if (F8) {
#pragma unroll
            for (int i = 0; i < 32; ++i) v[i] *= wscale;
        }
#pragma unroll
        for (int i = 0; i < 32; ++i) scr[(2 * i + (lane >> 5)) * 33 + (lane & 31)] = v[i];
        LDS_WAIT(); asm volatile("" ::: "memory");
        const int c = lane & 7;
#pragma unroll
        for (int j = 0; j < 4; ++j) { const int n = (lane >> 3) + 8 * j; const LAS float* s = scr + (8 * c) * 33 + n;
            if constexpr (F8) { unsigned char* wt = (unsigned char*)WTv + (size_t)m * N * K;
                v2u o; o.x = fp8x4(s[0 * 33], s[1 * 33], s[2 * 33], s[3 * 33]); o.y = fp8x4(s[4 * 33], s[5 * 33], s[6 * 33], s[7 * 33]);
                *(GAS v2u*)(wt + (size_t)rowmap(n0 + n) * K + k0 + 8 * c) = o; }
            else { bf16* wt = (bf16*)WTv + (size_t)m * N * K;
                v4u o; o.x = pk2(s[0 * 33], s[1 * 33]); o.y = pk2(s[2 * 33], s[3 * 33]); o.z = pk2(s[4 * 33], s[5 * 33]); o.w = pk2(s[6 * 33], s[7 * 33]);
                *(GAS v4u*)(wt + (size_t)rowmap(n0 + n) * K + k0 + 8 * c) = o; } }
        LDS_WAIT(); asm volatile("" ::: "memory");
        if (!more) break;
#pragma unroll
        for (int i = 0; i < 32; ++i) v[i] = w[i];
        it = nx;
    }
}
#undef P0_LOAD
struct RowId { __device__ __forceinline__ int operator()(int n) const { return n; } };
struct RowGU { __device__ __forceinline__ int operator()(int n) const { const int f = n >> 1, u = n & 1; return ((f >> 7) << 8) + (u << 7) + (f & 127); } };

__device__ __forceinline__ void p0_x_rows4(Frame& F, const float* xrow, bf16* orow, float* rstd_out) {
    const GAS f32x4* xr = (const GAS f32x4*)xrow + F.lane;
    f32x4 v[16]; float s[4] = {0.f, 0.f, 0.f, 0.f};
#pragma unroll
    for (int j = 0; j < 16; ++j) v[j] = xr[64 * j];
#pragma unroll
    for (int j = 0; j < 16; ++j) s[j >> 2] += (v[j].x * v[j].x + v[j].y * v[j].y) + (v[j].z * v[j].z + v[j].w * v[j].w);
    GAS unsigned long long* o8 = (GAS unsigned long long*)orow + F.lane;
#pragma unroll
    for (int j = 0; j < 16; ++j) o8[64 * j] = (unsigned long long)pk2(v[j].x, v[j].y) | ((unsigned long long)pk2(v[j].z, v[j].w) << 32);
#pragma unroll
    for (int q = 0; q < 4; ++q) s[q] = wave_sum(s[q]);
    if (F.lane < 4) rstd_out[F.lane] = 1.f / sqrtf((F.lane == 0 ? s[0] : F.lane == 1 ? s[1] : F.lane == 2 ? s[2] : s[3]) * (1.f / D) + EPS);
}
__device__ __forceinline__ void p0_mkv_tile(Frame& F, int tile, bf16* mkv) {
    const int mt = tile >> 4, nt = tile & 15, m0 = 32 * mt, n0 = 32 * nt, r = F.lane & 31, h = F.lane >> 5, kh = F.wave >> 2, tw = F.wave & 3;
    f32x16 acc = {}; float ss = 0.f;
    const float* mrow = F.mem + (size_t)(m0 + r) * D + 8 * h + kh * 512;
    const float* wcol = F.w_mkv + (size_t)(8 * h + kh * 512) * 512 + n0 + r;
    const float* gp = F.g_mem + 8 * h + kh * 512;
#pragma unroll 2
    for (int k0 = 0; k0 < 512; k0 += 16) {
        const f32x4 a0 = *(const f32x4*)(mrow + k0), a1 = *(const f32x4*)(mrow + k0 + 4);
        const f32x4 g0 = *(const f32x4*)(gp + k0), g1 = *(const f32x4*)(gp + k0 + 4);
        float wv[8];
#pragma unroll
        for (int j = 0; j < 8; ++j) wv[j] = wcol[(size_t)(k0 + j) * 512];
        ss += (a0.x * a0.x + a0.y * a0.y) + (a0.z * a0.z + a0.w * a0.w) + (a1.x * a1.x + a1.y * a1.y) + (a1.z * a1.z + a1.w * a1.w);
        v4u bw; bw.x = pk2(a0.x * g0.x, a0.y * g0.y); bw.y = pk2(a0.z * g0.z, a0.w * g0.w); bw.z = pk2(a1.x * g1.x, a1.y * g1.y); bw.w = pk2(a1.z * g1.z, a1.w * g1.w);
        v4u aw; aw.x = pk2(wv[0], wv[1]); aw.y = pk2(wv[2], wv[3]); aw.z = pk2(wv[4], wv[5]); aw.w = pk2(wv[6], wv[7]);
        acc = __builtin_amdgcn_mfma_f32_32x32x16_bf16(__builtin_bit_cast(bf16x8, aw), __builtin_bit_cast(bf16x8, bw), acc, 0, 0, 0);
    }
    LAS float* xc = (LAS float*)(F.lds + RING_OFF + 8 * 16384 - 4 * 64 * 17 * 4) + (tw * 64 + F.lane) * 17;
    if (kh == 1) {
#pragma unroll
        for (int i = 0; i < 16; ++i) xc[i] = acc[i];
        xc[16] = ss; }
    __syncthreads();
    if (kh == 0) {
#pragma unroll
        for (int i = 0; i < 16; ++i) acc[i] += xc[i];
        ss += xc[16]; ss += __shfl_xor(ss, 32);
        const float rstd = 1.f / sqrtf(ss * (1.f / D) + EPS);
        bf16* orow = mkv + (size_t)(m0 + r) * 512 + n0 + 4 * h;
#pragma unroll
        for (int q = 0; q < 4; ++q) { v2u o; o.x = pk2(acc[4 * q] * rstd, acc[4 * q + 1] * rstd); o.y = pk2(acc[4 * q + 2] * rstd, acc[4 * q + 3] * rstd); *(GAS v2u*)(orow + 8 * q) = o; }
    }
    __syncthreads();
}
__device__ __forceinline__ void p0_prologue(Frame& F) {
    LAS float* scr = (LAS float*)(F.lds + RING_OFF + F.wave * 16384);
    const int gw = F.vcu * NWAVES + F.wave, NGW = F.G * NWAVES;
    bf16* win_t = (bf16*)(F.ws + WS_WIN); bf16* wout_t = (bf16*)(F.ws + WS_WOUT);
    p0_mkv_tile(F, (F.wave & 3) * 256 + F.vcu, (bf16*)(F.ws + WS_MKV));
    p0_transpose_all<false>(F.w_in, D, DIN, 1, win_t, F.g_attn, 1.f, scr, gw, NGW, F.lane, RowId());
    p0_transpose_all<false>(F.w_out, D, D, 1, wout_t, nullptr, 1.f, scr, gw, NGW, F.lane, RowId());
    bf16* xb = (bf16*)(F.ws + WS_XB); float* rstd1 = (float*)(F.ws + WS_RSTD1);
    for (int m = 4 * gw; m < T; m += 4 * NGW) p0_x_rows4(F, F.x + (size_t)m * D, xb + (size_t)m * D, rstd1 + m);
    bf16* wrt = (bf16*)(F.ws + WS_WRT);
    for (int i = gw * 64 + F.lane; i < D * NE; i += NGW * 64) { const int e = i >> 10, k = i & 1023; const float w = F.w_r[k * NE + e] * F.g_ffn[k]; const unsigned hb = f2bf(w); wrt[i] = (bf16)hb; wrt[D * NE + i] = (bf16)f2bf(w - bf2f((bf16)hb)); }
}

constexpr int NCONV = 8, NCONV_ALL = 8 * NCONV;
__device__ __forceinline__ void p0b_unit(Frame& F, int c) {
    LAS float* scr = (LAS float*)(F.lds + RING_OFF + F.wave * 16384);
    p0_transpose_all<true>(F.w_gu, D, 2 * DFF, NE, (void*)(F.ws + WS_WGU), F.g_ffn, WSCALE, scr, c * NWAVES + F.wave, NCONV_ALL * NWAVES, F.lane, RowGU());
    p0_transpose_all<true>(F.w_dn, DFF, D, NE, (void*)(F.ws + WS_WDN), nullptr, WSCALE, scr, c * NWAVES + F.wave, NCONV_ALL * NWAVES, F.lane, RowId());
    __syncthreads();
}

struct EpiInProj {
    bf16* O; const float* rstd; unsigned* nrm;
    __device__ __forceinline__ void operator()(const pg8::f32x4 (&acc)[2][2][4][2], const pg8::Unit& u, int wr, int wc, int fr, int fq, const LAS unsigned* ids) const {
        asm volatile("" : "+v"(fr), "+v"(fq));
        const int row0 = u.pm * 256 + wr * 64 + fr, col0 = u.pn * 256 + wc * 32 + 8 * fq;
        const float sc = (u.pn <= 1 || u.pn == 6 || u.pn == 9) ? QSCALE : 1.f;
        const LAS float* scl = (const LAS float*)(ids + 256);
        float rsv[2][4];
#pragma unroll
        for (int ai = 0; ai < 2; ++ai)
#pragma unroll
            for (int m = 0; m < 4; ++m) rsv[ai][m] = scl[wr * 64 + fr + ai * 128 + m * 16];
#pragma unroll
        for (int ai = 0; ai < 2; ++ai)
#pragma unroll
            for (int m = 0; m < 4; ++m) { const int row = row0 + ai * 128 + m * 16; const float rs = rsv[ai][m] * sc; bf16* rowp = O + (size_t)row * DIN + col0;
#pragma unroll
                for (int bj = 0; bj < 2; ++bj) { const pg8::f32x4 v0 = acc[ai][bj][m][0] * rs, v1 = acc[ai][bj][m][1] * rs;
                    v4u w; w.x = pg8::cvt_pk_bf16(v0[0], v0[1]); w.y = pg8::cvt_pk_bf16(v0[2], v0[3]); w.z = pg8::cvt_pk_bf16(v1[0], v1[1]); w.w = pg8::cvt_pk_bf16(v1[2], v1[3]);
                    *(v4u*)(rowp + bj * 128) = w; } }
        if (u.pn < 4) {
#pragma unroll
            for (int bj = 0; bj < 2; ++bj) { float mx = 0.f;
#pragma unroll
                for (int ai = 0; ai < 2; ++ai)
#pragma unroll
                    for (int m = 0; m < 4; ++m) { const float rs = rsv[ai][m] * sc; const pg8::f32x4 v0 = acc[ai][bj][m][0] * rs, v1 = acc[ai][bj][m][1] * rs;
                        float s = (v0[0] * v0[0] + v0[1] * v0[1]) + (v0[2] * v0[2] + v0[3] * v0[3]) + (v1[0] * v1[0] + v1[1] * v1[1]) + (v1[2] * v1[2] + v1[3] * v1[3]);
                        s += __shfl_xor(s, 16); s += __shfl_xor(s, 32); mx = fmaxf(mx, s); }
#pragma unroll
                for (int o = 1; o < 16; o <<= 1) mx = fmaxf(mx, __shfl_xor(mx, o));
                if ((fr | fq) == 0) atomicMax(nrm + (((u.pm >> 4) * 4 + u.pn) * 4 + 2 * bj + (wc >> 1)) * 2 + (wc & 1), __builtin_bit_cast(unsigned, mx)); }
        }
    }
};
__device__ __forceinline__ void attn_phase(Frame& F, char* shm, int qoff = 0, int gmask = 7) {
    using namespace attn_body;
    const attn_body::bf16* P = (const attn_body::bf16*)(F.ws + WS_P);
    attn_body::bf16* OD = (attn_body::bf16*)(F.ws + WS_OD);
    attn_body::bf16* mix = (attn_body::bf16*)(F.ws + WS_MIX);
    attn_body::bf16* ODIL = (attn_body::bf16*)(F.ws + WS_ODIL); float* LSEb = (float*)(F.ws + WS_LSE);
    const attn_body::bf16* MKV = (const attn_body::bf16*)(F.ws + WS_MKV);
    const float* nrm = (const float*)(F.ctl + CW_NRM);
    const int grp = (int)blockIdx.x & 7, b = grp;
    unsigned* qctr = (unsigned*)(F.ctl + CW_Q + qoff) + 64 * grp;
    const attn_body::bf16* Pb = P + (size_t)b * SEQ * DIN;
    unsigned nxt_tok = 0u;
    if (F.tid == 0) nxt_tok = __hip_atomic_fetch_add(qctr, 1u, __ATOMIC_RELAXED, __HIP_MEMORY_SCOPE_AGENT);
    for (;;) {
        if (F.tid == 0) F.MISC[20] = nxt_tok;
        __syncthreads();
        int un = (int)F.MISC[20];
        __syncthreads();
        if (F.tid == 0 && un < NCONV + 384) nxt_tok = __hip_atomic_fetch_add(qctr, 1u, __ATOMIC_RELAXED, __HIP_MEMORY_SCOPE_AGENT);
        if (un < NCONV) { if (gmask == 7) p0b_unit(F, grp * NCONV + un); continue; }
        un -= NCONV;
        if (un >= 384) break;
        if (un < 128) {
            if (!(gmask & 1)) continue;
            const int qb = 15 - (un >> 3), h = 3 - ((un >> 1) & 3), j = un & 1;
            const float slope2 = exp2f(-(float)(2 * h + 1)) * LOG2E;
            const int ni = ((b * 4 + (h >> 1)) * 4 + 2 * (h & 1) + j) * 2;
            const float R = sqrtf((nrm[ni] + nrm[ni + 1]) * (nrm[ni + 16] + nrm[ni + 17])) * 1.01f;
            const float kfirst = (float)(qb * 256) - (2.f * R + 160.f) / slope2;
            int t0 = kfirst > 0.f ? (int)(kfirst * (1.f / 64.f)) : 0; t0 = min(t0, 4 * qb); t0 &= ~1;
            UnitP U; U.Q = Pb + C_DQ + h * 128 + j * 64; U.K = Pb + C_DK + h * 128 + j * 64; U.V = Pb + C_DV + h * 128;
            U.O = OD + (size_t)b * SEQ * 1024 + h * 256 + j * 128; U.qp = DIN; U.kp = DIN; U.op = 1024;
            U.q0 = qb * 256; U.t0 = t0; U.NT = 4 * qb + 4 - t0; U.slope2 = slope2; U.lse = nullptr; U.lse_stride = 0;
            attn_unit<32, true, false, true, false, 128>(U, shm);
        } else if (un < 320) {
            if (!(gmask & 2)) continue;
            const int du = un - 128, h = du / 48, idx = du % 48, n = idx >> 4, w = idx & 15;
            const int r = (n == 0) ? 1 : (n == 1 ? 4 : 16), c = (n == 0) ? 0 : (n == 1 ? (w >> 2) : w), blk = (n == 0) ? w : (n == 1 ? (w & 3) : 0);
            const attn_body::bf16* Pc = Pb + (size_t)c * DIN;
            UnitP U; U.Q = Pc + C_LQ + h * 64; U.K = Pc + C_LK + h * 64; U.V = Pc + C_LV + h * 64; U.qp = (long)r * DIN; U.kp = (long)r * DIN;
            U.O = ODIL + (size_t)n * T * 256 + ((size_t)b * SEQ + c) * 256 + h * 64; U.op = (long)r * 256;
            U.q0 = blk * 256; U.t0 = (blk == 0) ? 0 : 4 * blk - 2; U.NT = 4 * blk + 4 - U.t0;
            U.slope2 = exp2f(-(float)(2 * h + 2)) * (float)r * LOG2E;
            U.lse = LSEb + (size_t)n * T * 4 + ((size_t)b * SEQ + c) * 4 + h; U.lse_stride = r * 4;
            attn_unit<32, true, true, true, true>(U, shm);
        } else {
            if (!(gmask & 4)) continue;
            const int mu = un - 320, h = mu >> 4, qb = mu & 15;
            UnitP U; U.Q = Pb + C_MQ + h * 64; U.qp = DIN; U.K = MKV + (size_t)b * NMEM * 512 + h * 64; U.V = U.K + 256; U.kp = 512;
            U.O = mix + (size_t)b * SEQ * 1024 + 768 + h * 64; U.op = 1024; U.q0 = qb * 256; U.t0 = 0; U.NT = 4; U.slope2 = 0.f; U.lse = nullptr; U.lse_stride = 0;
            attn_unit<8, false, false, false, false>(U, shm);
        }
    }
}
__device__ __forceinline__ void dil_combine_phase(Frame& F) {
    const int gw = F.vcu * NWAVES + F.wave, NGW = F.G * NWAVES;
    const bf16* OD = (const bf16*)(F.ws + WS_OD); const bf16* ODIL = (const bf16*)(F.ws + WS_ODIL); const float* LSEb = (const float*)(F.ws + WS_LSE); bf16* mix = (bf16*)(F.ws + WS_MIX);
    const int h = F.lane >> 4, pt = F.lane & 15, d4 = pt * 4;
    float lam;
    { const float a = F.lamqk[F.lane] * F.lamqk[64 + F.lane], c = F.lamqk[128 + F.lane] * F.lamqk[192 + F.lane];
      lam = __expf(wave_sum(a)) - __expf(wave_sum(c)) + 0.2f; }
    float gsub[8];
#pragma unroll
    for (int i = 0; i < 8; ++i) gsub[i] = F.subg[pt * 8 + i] * 0.8f;
    for (int row0 = 4 * gw; row0 < T; row0 += 4 * NGW) {
        float l[4][3]; v2u q[4][3]; v4u o1[4], o2[4];
#pragma unroll
        for (int i = 0; i < 4; ++i) {
            o1[i] = *(const v4u*)(OD + (size_t)(row0 + i) * 1024 + h * 256 + pt * 8); o2[i] = *(const v4u*)(OD + (size_t)(row0 + i) * 1024 + h * 256 + 128 + pt * 8);
#pragma unroll
            for (int n = 0; n < 3; ++n) { l[i][n] = LSEb[(size_t)n * T * 4 + (size_t)(row0 + i) * 4 + h]; q[i][n] = *(const v2u*)(ODIL + (size_t)n * T * 256 + (size_t)(row0 + i) * 256 + h * 64 + d4); } }
#pragma unroll
        for (int i = 0; i < 4; ++i) {
            const unsigned aw[4] = {o1[i].x, o1[i].y, o1[i].z, o1[i].w}, bw[4] = {o2[i].x, o2[i].y, o2[i].z, o2[i].w};
            float d[8], ss = 0.f;
#pragma unroll
            for (int c = 0; c < 4; ++c) { d[2 * c] = bflo(aw[c]) - lam * bflo(bw[c]); d[2 * c + 1] = bfhi(aw[c]) - lam * bfhi(bw[c]); ss += d[2 * c] * d[2 * c] + d[2 * c + 1] * d[2 * c + 1]; }
#pragma unroll
            for (int o = 1; o < 16; o <<= 1) ss += __shfl_xor(ss, o);
            const float rstd = 1.f / sqrtf(ss * (1.f / 128.f) + EPS);
            v4u od; od.x = pk2(d[0] * rstd * gsub[0], d[1] * rstd * gsub[1]); od.y = pk2(d[2] * rstd * gsub[2], d[3] * rstd * gsub[3]); od.z = pk2(d[4] * rstd * gsub[4], d[5] * rstd * gsub[5]); od.w = pk2(d[6] * rstd * gsub[6], d[7] * rstd * gsub[7]);
            *(v4u*)(mix + (size_t)(row0 + i) * 1024 + h * 128 + pt * 8) = od;
            const float m = fmaxf(fmaxf(l[i][0], l[i][1]), l[i][2]);
            float wn[3], den = 0.f;
#pragma unroll
            for (int n = 0; n < 3; ++n) { wn[n] = exp2f(l[i][n] - m); den += wn[n]; }
            const float inv = 1.f / den; float o[4] = {0.f, 0.f, 0.f, 0.f};
#pragma unroll
            for (int n = 0; n < 3; ++n) { const float wq = wn[n] * inv; o[0] += wq * bflo(q[i][n].x); o[1] += wq * bfhi(q[i][n].x); o[2] += wq * bflo(q[i][n].y); o[3] += wq * bfhi(q[i][n].y); }
            v2u ov; ov.x = pk2(o[0], o[1]); ov.y = pk2(o[2], o[3]);
            *(v2u*)(mix + (size_t)(row0 + i) * 1024 + 512 + h * 64 + d4) = ov;
        }
    }
}
struct EpiY {
    bf16* Y;
    __device__ __forceinline__ void operator()(const pg8::f32x4 (&acc)[2][2][4][2], const pg8::Unit& u, int wr, int wc, int fr, int fq, const LAS unsigned*) const {
        asm volatile("" : "+v"(fr), "+v"(fq));
        const int row0 = u.pm * 256 + wr * 64 + fr, col0 = u.pn * 256 + wc * 32 + 8 * fq;
#pragma unroll
        for (int ai = 0; ai < 2; ++ai)
#pragma unroll
            for (int m = 0; m < 4; ++m) { bf16* rowp = Y + (size_t)(row0 + ai * 128 + m * 16) * D + col0;
#pragma unroll
                for (int bj = 0; bj < 2; ++bj) { const pg8::f32x4 v0 = acc[ai][bj][m][0], v1 = acc[ai][bj][m][1];
                    v4u w; w.x = pg8::cvt_pk_bf16(v0[0], v0[1]); w.y = pg8::cvt_pk_bf16(v0[2], v0[3]); w.z = pg8::cvt_pk_bf16(v1[0], v1[1]); w.w = pg8::cvt_pk_bf16(v1[2], v1[3]);
                    *(v4u*)(rowp + bj * 128) = w; } }
    }
};

__device__ __forceinline__ void route_phase(Frame& F) {
    LAS char* XH = (LAS char*)(F.lds + RING_OFF); LAS char* XL = XH + 32768; LAS char* WH = XH + 65536; LAS char* WL = XH + 73728;
    LAS float* xch = (LAS float*)(XH + 81920);
    LAS float* ssl = (LAS float*)(XH + 81920 + 17408);
    LAS unsigned* lcnt = (LAS unsigned*)(F.lds + LCNT_OFF);
    LAS unsigned* stg = (LAS unsigned*)(F.lds + STG_OFF);
    if (F.tid < 64) lcnt[F.tid] = 0u;
    const int lane = F.lane, tl = lane & 31, h = lane >> 5, tg = F.wave & 3, kh = F.wave >> 2;
    const int srow = F.tid >> 5, k4 = (F.tid & 31) * 4, T0 = F.vcu * 128;
    const float* xg = F.x + (size_t)(T0 + srow) * D + k4;
    const bf16* yg = (const bf16*)(F.ws + WS_Y) + (size_t)(T0 + srow) * D + k4;
    unsigned char* x1q = (unsigned char*)(F.ws + WS_X1B) + (size_t)(T0 + srow) * D + k4;
    bf16* x1h = (bf16*)(F.ws + WS_X1H) + (size_t)(T0 + srow) * D + k4;
    const bf16* wsrc = (const bf16*)(F.ws + WS_WRT);
    f32x4 xv[8]; v2u yv[8]; v4u wv[2]; float ssr[8];
#pragma unroll
    for (int i = 0; i < 8; ++i) ssr[i] = 0.f;
#define RT_LOAD(kc) do { _Pragma("unroll") for (int i_ = 0; i_ < 8; ++i_) { xv[i_] = *(const f32x4*)(xg + (size_t)(16 * i_) * D + 128 * (kc)); yv[i_] = *(const v2u*)(yg + (size_t)(16 * i_) * D + 128 * (kc)); } \
        _Pragma("unroll") for (int j_ = 0; j_ < 2; ++j_) { const int idx_ = F.tid + 512 * j_; wv[j_] = *(const v4u*)(wsrc + (idx_ >> 9) * 32768 + ((idx_ >> 4) & 31) * 1024 + 128 * (kc) + (idx_ & 15) * 8); } } while (0)
    f32x16 acc = {};
    RT_LOAD(0);
    for (int kc = 0; kc < 8; ++kc) {
#pragma unroll
        for (int i = 0; i < 8; ++i) {
            const float x0 = xv[i].x + bflo(yv[i].x), x1 = xv[i].y + bfhi(yv[i].x), x2 = xv[i].z + bflo(yv[i].y), x3 = xv[i].w + bfhi(yv[i].y);
            ssr[i] += (x0 * x0 + x1 * x1) + (x2 * x2 + x3 * x3);
            const unsigned h0 = pk2(x0, x1), h1 = pk2(x2, x3), l0 = pk2(x0 - bflo(h0), x1 - bfhi(h0)), l1 = pk2(x2 - bflo(h1), x3 - bfhi(h1));
            *(unsigned*)(x1q + (size_t)(16 * i) * D + 128 * kc) = fp8x4(x0, x1, x2, x3);
            *(v2u*)(x1h + (size_t)(16 * i) * D + 128 * kc) = (v2u){h0, h1};
            const int row = srow + 16 * i, off = row * 256 + (((k4 >> 3) ^ (row & 15)) << 4) + (k4 & 4) * 2;
            *(LAS v2u*)(XH + off) = (v2u){h0, h1}; *(LAS v2u*)(XL + off) = (v2u){l0, l1};
        }
#pragma unroll
        for (int j = 0; j < 2; ++j) { const int idx = F.tid + 512 * j, e = (idx >> 4) & 31, c = idx & 15; *(LAS v4u*)(((idx >> 9) ? WL : WH) + e * 256 + ((c ^ (e & 15)) << 4)) = wv[j]; }
        __syncthreads();
        if (kc < 7) RT_LOAD(kc + 1);
#pragma unroll
        for (int s = 0; s < 4; ++s) { const int c16 = 2 * (4 * kh + s) + h, tr = tg * 32 + tl;
            const v4u xh = *(const LAS v4u*)(XH + tr * 256 + ((c16 ^ (tr & 15)) << 4)), xl = *(const LAS v4u*)(XL + tr * 256 + ((c16 ^ (tr & 15)) << 4));
            const v4u wh = *(const LAS v4u*)(WH + tl * 256 + ((c16 ^ (tl & 15)) << 4)), wl2 = *(const LAS v4u*)(WL + tl * 256 + ((c16 ^ (tl & 15)) << 4));
            acc = __builtin_amdgcn_mfma_f32_32x32x16_bf16(__builtin_bit_cast(bf16x8, wh), __builtin_bit_cast(bf16x8, xh), acc, 0, 0, 0);
            acc = __builtin_amdgcn_mfma_f32_32x32x16_bf16(__builtin_bit_cast(bf16x8, wh), __builtin_bit_cast(bf16x8, xl), acc, 0, 0, 0);
            acc = __builtin_amdgcn_mfma_f32_32x32x16_bf16(__builtin_bit_cast(bf16x8, wl2), __builtin_bit_cast(bf16x8, xh), acc, 0, 0, 0); }
        __syncthreads();
    }
#undef RT_LOAD
#pragma unroll
    for (int i = 0; i < 8; ++i) { float s = ssr[i];
#pragma unroll
        for (int o = 1; o < 32; o <<= 1) s += __shfl_xor(s, o);
        if ((F.tid & 31) == 0) ssl[srow + 16 * i] = s; }
    const int tok = T0 + tg * 32 + tl; float ss = 0.f;
    if (kh == 1) { LAS float* d = xch + (tg * 64 + lane) * 17;
#pragma unroll
        for (int i = 0; i < 16; ++i) d[i] = acc[i];
        d[16] = ss; }
    __syncthreads();
    if (kh == 0) {
        const LAS float* d = xch + (tg * 64 + lane) * 17;
#pragma unroll
        for (int i = 0; i < 16; ++i) acc[i] += d[i];
        ss = ssl[tg * 32 + tl];
        const float rstd = 1.f / sqrtf(ss * (1.f / D) + EPS);
        float lg[16];
#pragma unroll
        for (int i = 0; i < 16; ++i) lg[i] = acc[i] * rstd + F.b_r[4 * h + (i & 3) + 8 * (i >> 2)];
        float cv[8]; int ce[8];
#pragma unroll
        for (int k = 0; k < 4; ++k) { float bv = -INFINITY; int bi = 0;
#pragma unroll
            for (int i = 0; i < 16; ++i) { if (lg[i] > bv) { bv = lg[i]; bi = i; } }
            cv[k] = bv; ce[k] = 4 * h + (bi & 3) + 8 * (bi >> 2);
#pragma unroll
            for (int i = 0; i < 16; ++i) if (i == bi) lg[i] = -INFINITY; }
#pragma unroll
        for (int k = 0; k < 4; ++k) { cv[4 + k] = __shfl_xor(cv[k], 32); ce[4 + k] = __shfl_xor(ce[k], 32); }
        float tv[4]; int te[4];
#pragma unroll
        for (int k = 0; k < 4; ++k) { float bv = -INFINITY; int be = 64, bi = 0;
#pragma unroll
            for (int i = 0; i < 8; ++i) { if (cv[i] > bv || (cv[i] == bv && ce[i] < be)) { bv = cv[i]; be = ce[i]; bi = i; } }
            tv[k] = bv; te[k] = be;
#pragma unroll
            for (int i = 0; i < 8; ++i) if (i == bi) cv[i] = -INFINITY; }
        float gk[4], den = 0.f;
#pragma unroll
        for (int k = 0; k < 4; ++k) { gk[k] = __expf(tv[k] - tv[0]); den += gk[k]; }
        const float inv = 1.f / den;
        if (h == 0) {
#pragma unroll
            for (int k = 0; k < 4; ++k) {
                const unsigned rank = __hip_atomic_fetch_add(lcnt + te[k], 1u, __ATOMIC_RELAXED, __HIP_MEMORY_SCOPE_WORKGROUP);
                const int slot = (tg * 32 + tl) * 4 + k;
                stg[slot * 4] = (unsigned)(tok * 4 + k); stg[slot * 4 + 1] = ((unsigned)te[k] << 16) | rank; stg[slot * 4 + 2] = __builtin_bit_cast(unsigned, gk[k] * inv); stg[slot * 4 + 3] = __builtin_bit_cast(unsigned, rstd);
            }
        }
    }
    __syncthreads();
    if (F.tid < 32) { const unsigned n = lcnt[F.tid]; lcnt[32 + F.tid] = n ? __hip_atomic_fetch_add((unsigned*)(F.ctl + CW_CNT) + F.tid, n, __ATOMIC_RELAXED, __HIP_MEMORY_SCOPE_AGENT) : 0u; }
    __syncthreads();
    { unsigned* list = (unsigned*)(F.ws + WS_LIST); unsigned* lgate = (unsigned*)(F.ws + WS_LGATE); unsigned* lrstd = (unsigned*)(F.ws + WS_LRSTD);
      const unsigned ent = stg[F.tid * 4], er = stg[F.tid * 4 + 1], gb = stg[F.tid * 4 + 2], rb = stg[F.tid * 4 + 3]; const unsigned e = er >> 16, rank = er & 0xffffu;
      const size_t at = (size_t)e * LCAP + lcnt[32 + e] + rank; list[at] = ent; lgate[at] = gb; lrstd[at] = rb; }
    __syncthreads();
}

__device__ __forceinline__ int moe_build_table(Frame& F) {
    LAS unsigned* tbl = (LAS unsigned*)(F.lds + TBL_OFF); LAS unsigned* lcnt = (LAS unsigned*)(F.lds + LCNT_OFF);
    if (F.wave == 0) {
        const int e = F.lane & 31;
        const unsigned cnt = __hip_atomic_load((unsigned*)(F.ctl + CW_CNT) + e, __ATOMIC_RELAXED, __HIP_MEMORY_SCOPE_AGENT);
        const unsigned nt = (cnt + 255u) >> 8; unsigned incl = nt;
#pragma unroll
        for (int o = 1; o < 32; o <<= 1) { const unsigned t = __shfl_up(incl, o); if ((F.lane & 31) >= o) incl += t; }
        if (F.lane < 32) { lcnt[e] = cnt; const unsigned start = incl - nt; for (unsigned j = 0; j < nt; ++j) tbl[start + j] = ((unsigned)e << 16) | j; if (F.lane == 31) F.MISC[16] = incl; }
    }
    __syncthreads();
    return (int)F.MISC[16];
}
struct MoeOrder {
    const LAS unsigned* tbl; const LAS unsigned* lcnt; const unsigned* list; int NMT, G, c, NPN, MPER, RB; size_t bexp; bool a_tiles; const unsigned* lsc; const unsigned* bias; int bexp_f;
    __device__ __forceinline__ bool next(int i, pg8::Unit& u) const {
        const int L = i * G + c, blk = L >> 5, w = L & 31, g = blk * MPER + w / NPN, pn = w % NPN;
        if (g >= NMT) return false;
        const unsigned t = tbl[g]; const int e = (int)(t >> 16), mt = (int)(t & 0xffffu); const int cnt = (int)lcnt[e];
        u.pm = g; u.pn = pn; u.e = e; u.mt = mt; u.valid = min(256, cnt - mt * 256);
        u.aoff = a_tiles ? (size_t)g * (size_t)(256 * RB) : (size_t)0; u.boff = (size_t)e * bexp + (size_t)pn * (size_t)(256 * RB);
        return true;
    }
    __device__ __forceinline__ const unsigned* id_src(const pg8::Unit& u, int row) const { return list + (size_t)u.e * LCAP + u.mt * 256 + min(row, u.valid - 1); }
    __device__ __forceinline__ const unsigned* sc_src(const pg8::Unit& u, int row) const { return lsc + (size_t)u.e * LCAP + u.mt * 256 + min(row, u.valid - 1); }
    __device__ __forceinline__ const unsigned* bias_src(const pg8::Unit& u, int col) const { return bias + (size_t)u.e * bexp_f + u.pn * 256 + col; }
};
struct EpiGU {
    unsigned char* ACT;
    __device__ __forceinline__ void operator()(const pg8::f32x4 (&acc)[2][2][4][2], const pg8::Unit& u, int wr, int wc, int fr, int fq, const LAS unsigned* ids) const {
        asm volatile("" : "+v"(fr), "+v"(fq));
        typedef float f2 __attribute__((ext_vector_type(2)));
        constexpr float CG = 1.702f * LOG2E, KA = ASCALE / CG;
        const int r0 = wr * 64 + fr, f0 = u.pn * 128 + wc * 32 + 8 * fq;
        const LAS float* scl = (const LAS float*)(ids + 256); const LAS float* bl = (const LAS float*)(ids + 512) + 2 * (wc * 32 + 8 * fq);
        float rs[2][4];
#pragma unroll
        for (int ai = 0; ai < 2; ++ai)
#pragma unroll
            for (int m = 0; m < 4; ++m) rs[ai][m] = scl[r0 + ai * 128 + m * 16] * (1.f / WSCALE);
        const pg8::f32x4 b0 = *(const LAS pg8::f32x4*)bl, b1 = *(const LAS pg8::f32x4*)(bl + 4), b2 = *(const LAS pg8::f32x4*)(bl + 8), b3 = *(const LAS pg8::f32x4*)(bl + 12);
        const f2 gb[4] = {f2{b0[0], b0[2]} * CG, f2{b1[0], b1[2]} * CG, f2{b2[0], b2[2]} * CG, f2{b3[0], b3[2]} * CG}, ub[4] = {f2{b0[1], b0[3]}, f2{b1[1], b1[3]}, f2{b2[1], b2[3]}, f2{b3[1], b3[3]}};
#pragma unroll
        for (int ai = 0; ai < 2; ++ai)
#pragma unroll
            for (int m = 0; m < 4; ++m) { const int r = r0 + ai * 128 + m * 16; const float s = rs[ai][m], sg = s * CG; f2 a[4];
#pragma unroll
                for (int q = 0; q < 4; ++q) { const int n = q >> 1, j = 2 * (q & 1);
                    f2 g = f2{acc[ai][0][m][n][j], acc[ai][0][m][n][j + 1]} * sg + gb[q], up = f2{acc[ai][1][m][n][j], acc[ai][1][m][n][j + 1]} * s + ub[q];
                    g.x = fminf(g.x, 7.f * CG); g.y = fminf(g.y, 7.f * CG); up.x = __builtin_amdgcn_fmed3f(up.x, -7.f, 7.f); up.y = __builtin_amdgcn_fmed3f(up.y, -7.f, 7.f);
                    f2 d = f2{__builtin_amdgcn_exp2f(-g.x), __builtin_amdgcn_exp2f(-g.y)} + 1.f;
                    const f2 rc = f2{__builtin_amdgcn_rcpf(d.x), __builtin_amdgcn_rcpf(d.y)};
                    a[q] = ((up * KA + KA) * g) * rc; }
                v2u w; w.x = (unsigned)__builtin_amdgcn_cvt_pk_fp8_f32(a[1].x, a[1].y, __builtin_amdgcn_cvt_pk_fp8_f32(a[0].x, a[0].y, 0, false), true);
                w.y = (unsigned)__builtin_amdgcn_cvt_pk_fp8_f32(a[3].x, a[3].y, __builtin_amdgcn_cvt_pk_fp8_f32(a[2].x, a[2].y, 0, false), true);
                *(v2u*)(ACT + (size_t)(u.pm * 256 + r) * DFF + f0) = w; }
    }
};
struct EpiDown {
    unsigned char* YB;
    __device__ __forceinline__ void operator()(const pg8::f32x4 (&acc)[2][2][4][2], const pg8::Unit& u, int wr, int wc, int fr, int fq, const LAS unsigned* ids) const {
        asm volatile("" : "+v"(fr), "+v"(fq));
        const int r0 = wr * 64 + fr, cl = wc * 32 + 8 * fq, col0 = u.pn * 256 + cl;
        const LAS float* scl = (const LAS float*)(ids + 256); const LAS float* bl = (const LAS float*)(ids + 512) + cl;
        pg8::f32x4 bv[2][2];
#pragma unroll
        for (int bj = 0; bj < 2; ++bj)
#pragma unroll
            for (int n = 0; n < 2; ++n) bv[bj][n] = *(const LAS pg8::f32x4*)(bl + bj * 128 + 4 * n);
#pragma unroll
        for (int ai = 0; ai < 2; ++ai)
#pragma unroll
            for (int m = 0; m < 4; ++m) { const int r = r0 + ai * 128 + m * 16; if (r < u.valid) { const float g = scl[r] * YSCALE; unsigned char* yp = YB + (size_t)ids[r] * D + col0;
#pragma unroll
                for (int bj = 0; bj < 2; ++bj) { const pg8::f32x4 v0 = (acc[ai][bj][m][0] * (1.f / (WSCALE * ASCALE)) + bv[bj][0]) * g, v1 = (acc[ai][bj][m][1] * (1.f / (WSCALE * ASCALE)) + bv[bj][1]) * g;
                    v2u w; w.x = fp8x4(v0[0], v0[1], v0[2], v0[3]); w.y = fp8x4(v1[0], v1[1], v1[2], v1[3]);
                    *(v2u*)(yp + bj * 128) = w; } } }
    }
};
__device__ __forceinline__ void final_phase(Frame& F) {
    const int gw = F.vcu * NWAVES + F.wave, NGW = F.G * NWAVES;
    const unsigned char* YB = (const unsigned char*)(F.ws + WS_YB); const bf16* X1 = (const bf16*)(F.ws + WS_X1H);
    const int c = 16 * F.lane;
    f32x4 gf[4];
#pragma unroll
    for (int q = 0; q < 4; ++q) gf[q] = *(const f32x4*)(F.g_fin + c + 4 * q);
    for (int t = gw; t < T; t += NGW) {
        const v4u xa = *(const v4u*)(X1 + (size_t)t * D + c), xb = *(const v4u*)(X1 + (size_t)t * D + c + 8);
        v4u y[4];
#pragma unroll
        for (int k = 0; k < 4; ++k) y[k] = *(const v4u*)(YB + ((size_t)t * 4 + k) * D + c);
        float v[16];
        { const unsigned xw[8] = {xa.x, xa.y, xa.z, xa.w, xb.x, xb.y, xb.z, xb.w};
#pragma unroll
          for (int q = 0; q < 8; ++q) { v[2 * q] = bflo(xw[q]); v[2 * q + 1] = bfhi(xw[q]); } }
#pragma unroll
        for (int k = 0; k < 4; ++k) { const unsigned yw[4] = {y[k].x, y[k].y, y[k].z, y[k].w};
#pragma unroll
            for (int q = 0; q < 4; ++q) { const auto lo = __builtin_amdgcn_cvt_pk_f32_fp8((int)yw[q], false), hi = __builtin_amdgcn_cvt_pk_f32_fp8((int)yw[q], true);
                v[4 * q] += lo[0] * (1.f / YSCALE); v[4 * q + 1] += lo[1] * (1.f / YSCALE); v[4 * q + 2] += hi[0] * (1.f / YSCALE); v[4 * q + 3] += hi[1] * (1.f / YSCALE); } }
        float ss = 0.f;
#pragma unroll
        for (int i = 0; i < 16; ++i) ss += v[i] * v[i];
        const float rstd = 1.f / sqrtf(wave_sum(ss) * (1.f / D) + EPS);
#pragma unroll
        for (int q = 0; q < 4; ++q) { f32x4 o; o.x = v[4 * q] * rstd * gf[q].x; o.y = v[4 * q + 1] * rstd * gf[q].y; o.z = v[4 * q + 2] * rstd * gf[q].z; o.w = v[4 * q + 3] * rstd * gf[q].w;
            *(f32x4*)(F.out + (size_t)t * D + c + 4 * q) = o; }
    }
}
struct Args { const float* in[17]; float* out; unsigned char* ws; int ph_lo, ph_hi, use_bar, pad; };
__global__ void __launch_bounds__(NWAVES * 64, 2) mk_fwd(Args args) {
    extern __shared__ __attribute__((aligned(16))) unsigned char lds[];
    Frame F;
    F.lds = (LAS unsigned char*)lds;
    F.MISC = (volatile LAS unsigned*)(F.lds + MISC_OFF);
    F.tid = threadIdx.x; F.lane = F.tid & 63; F.wave = __builtin_amdgcn_readfirstlane(F.tid >> 6);
    F.G = gridDim.x; { const int bx = blockIdx.x; F.vcu = (F.G % 8 == 0) ? (bx % 8) * (F.G / 8) + bx / 8 : bx; }
    F.ws = args.ws; F.out = args.out; F.ctl = (gu32*)(args.ws + WS_CTL);
    F.x = args.in[0]; F.mem = args.in[1]; F.g_attn = args.in[2]; F.g_mem = args.in[3]; F.w_in = args.in[4]; F.lamqk = args.in[5]; F.subg = args.in[6]; F.w_mkv = args.in[7];
    F.w_out = args.in[8]; F.g_ffn = args.in[9]; F.w_r = args.in[10]; F.b_r = args.in[11]; F.w_gu = args.in[12]; F.b_gu = args.in[13]; F.w_dn = args.in[14]; F.b_dn = args.in[15]; F.g_fin = args.in[16];
    for (int u = F.tid; u < (LDS_BYTES - LDSCTL_OFF) / 4; u += NWAVES * 64) ((LAS unsigned*)(F.lds + LDSCTL_OFF))[u] = 0u;
    __syncthreads();
    XcdBarrier bar; bar.bar = (unsigned*)(F.ctl + CW_BAR); bar.x = 0; bar.st = nullptr;
    if (args.use_bar) bar = xcd_barrier_post((unsigned*)(F.ctl + CW_BAR), F.MISC + 8);
    const int lo = args.ph_lo, hi = args.ph_hi;
#define IN(k) (lo <= (k) && (k) < hi)
#define SEAM(k) do { if (IN(k) && IN((k) + 1)) xcd_barrier(bar); } while (0)
    if (IN(0)) { p0_prologue(F); } SEAM(0);
    if (IN(1)) {
        pg8::Gemm g{(const void*)(F.ws + WS_XB), (const void*)(F.ws + WS_WIN), 2 * D, 128}; pg8::StaticOrder S; S.init(T, DIN, 2 * D, F.G, (int)blockIdx.x, (const unsigned*)(F.ws + WS_RSTD1));
        EpiInProj E{(bf16*)(F.ws + WS_P), (const float*)(F.ws + WS_RSTD1), (unsigned*)(F.ctl + CW_NRM)};
        pg8::gemm_phase<EpiInProj, pg8::StaticOrder, true, false, true>(F.lds + RING_OFF, (LAS unsigned*)(F.lds + IDB_OFF), g, S, E);
    } SEAM(1);
    if (IN(2)) { attn_phase(F, (char*)lds + RING_OFF); } SEAM(2);
    if (IN(3)) { dil_combine_phase(F); } SEAM(3);
    if (IN(4)) {
        pg8::Gemm g{(const void*)(F.ws + WS_MIX), (const void*)(F.ws + WS_WOUT), 2 * D, 128}; pg8::StaticOrder S; S.init(T, D, 2 * D, F.G, (int)blockIdx.x);
        EpiY E{(bf16*)(F.ws + WS_Y)};
        pg8::gemm_phase<EpiY, pg8::StaticOrder, true, false, false>(F.lds + RING_OFF, (LAS unsigned*)(F.lds + IDB_OFF), g, S, E);
    } SEAM(4);
    if (IN(5)) { route_phase(F); } SEAM(5);
    if (IN(6)) {
        const int nmt = moe_build_table(F);
        pg8::Gemm g{(const void*)(F.ws + WS_X1B), (const void*)(F.ws + WS_WGU), D, 128};
        MoeOrder S{(const LAS unsigned*)(F.lds + TBL_OFF), (const LAS unsigned*)(F.lds + LCNT_OFF), (const unsigned*)(F.ws + WS_LIST), nmt, F.G, F.vcu, 8, 4, D, (size_t)2 * DFF * D, false, (const unsigned*)(F.ws + WS_LRSTD), (const unsigned*)F.b_gu, 2 * DFF};
        EpiGU E{(unsigned char*)(F.ws + WS_ACT)};
        pg8::gemm_phase<EpiGU, MoeOrder, true, true, true, true>(F.lds + RING_OFF, (LAS unsigned*)(F.lds + IDB_OFF), g, S, E);
    } SEAM(6);
    if (IN(7)) {
        const int nmt = moe_build_table(F);
        pg8::Gemm g{(const void*)(F.ws + WS_ACT), (const void*)(F.ws + WS_WDN), DFF, 128};
        MoeOrder S{(const LAS unsigned*)(F.lds + TBL_OFF), (const LAS unsigned*)(F.lds + LCNT_OFF), (const unsigned*)(F.ws + WS_LIST), nmt, F.G, F.vcu, 4, 8, DFF, (size_t)D * DFF, true, (const unsigned*)(F.ws + WS_LGATE), (const unsigned*)F.b_dn, D};
        EpiDown E{(unsigned char*)(F.ws + WS_YB)};
        pg8::gemm_phase<EpiDown, MoeOrder, true, true, true, true, true>(F.lds + RING_OFF, (LAS unsigned*)(F.lds + IDB_OFF), g, S, E);
    } SEAM(7);
    if (IN(8)) { final_phase(F); }
#undef IN
#undef SEAM
}

static void launch_phases(const Args& base, int lo, int hi, int use_bar, int grid, hipStream_t stream) {
    Args a = base; a.ph_lo = lo; a.ph_hi = hi; a.use_bar = use_bar;
    hipLaunchKernelGGL(mk_fwd, dim3(grid), dim3(NWAVES * 64), LDS_BYTES, stream, a);
}
extern "C" void kernel_launch(void* const* d_in, const int* in_sizes, int n_in, void* d_out, int out_size, void* d_ws, size_t ws_size, hipStream_t stream) {
    static int grid = 0;
    if (grid == 0) {
        if (n_in != 17 || in_sizes[0] != T * D || out_size != T * D || ws_size < (size_t)1000 * MiB) { fprintf(stderr, "kernel_launch: unexpected shapes / workspace (%d inputs, ws %zu)\n", n_in, ws_size); grid = -1; return; }
        int dev = 0, cus = 0, per_cu = 0;
        if (hipGetDevice(&dev) != hipSuccess || hipDeviceGetAttribute(&cus, hipDeviceAttributeMultiprocessorCount, dev) != hipSuccess) { grid = -1; return; }
        if (hipFuncSetAttribute((const void*)mk_fwd, hipFuncAttributeMaxDynamicSharedMemorySize, LDS_BYTES) != hipSuccess) { fprintf(stderr, "kernel_launch: hipFuncSetAttribute failed\n"); grid = -1; return; }
        if (hipOccupancyMaxActiveBlocksPerMultiprocessor(&per_cu, (const void*)mk_fwd, NWAVES * 64, LDS_BYTES) != hipSuccess || per_cu < 1) { fprintf(stderr, "kernel_launch: occupancy query says %d blocks per CU\n", per_cu); per_cu = 1; }
        (void)hipGetLastError();
        grid = cus;
        if (grid != 256) { fprintf(stderr, "kernel_launch: built for a 256-CU device (got %d)\n", cus); grid = -1; return; }
    }
    if (grid < 0) return;
    (void)hipMemsetAsync((char*)d_ws + WS_CTL, 0, CTL_ZERO_BYTES, stream);
    Args a{};
    for (int i = 0; i < 17; ++i) a.in[i] = (const float*)d_in[i];
    a.out = (float*)d_out; a.ws = (unsigned char*)d_ws;
    launch_phases(a, 0, 9, 1, grid, stream);
}
```

```cpp
#include <hip/hip_runtime.h>
#include <hip/hip_bf16.h>
#include <cstdint>
#include <cstdio>
#include <cmath>

constexpr int D = 1024, BATCH = 8, SEQ = 4096, T = BATCH * SEQ, DIN = 2560, NMEM = 256, NE = 32, DFF = 1024;
constexpr int C_DQ = 0, C_DK = 512, C_DV = 1024, C_LQ = 1536, C_LK = 1792, C_LV = 2048, C_MQ = 2304;
constexpr float EPS = 1e-5f;
constexpr int LCAP = T;
constexpr float QSCALE = 0.125f * 1.4426950408889634f;
constexpr float LOG2E = 1.4426950408889634f;
__device__ __forceinline__ int mk_lane() { int l = (int)__builtin_amdgcn_mbcnt_hi(~0u, __builtin_amdgcn_mbcnt_lo(~0u, 0u)); asm volatile("" : "+v"(l)); return l; }

namespace pg8 {
#define PG8_LAS __attribute__((address_space(3)))
typedef unsigned short bf16_t;
typedef short bf16x8 __attribute__((ext_vector_type(8)));
typedef float f32x4 __attribute__((ext_vector_type(4)));
typedef unsigned u32x4 __attribute__((ext_vector_type(4)));
typedef unsigned u32x2 __attribute__((ext_vector_type(2)));
constexpr int BM = 256, BK = 64, HALF = 128, HTB = HALF * BK * 2  , STAGE_BYTES = 8 * HTB, NXCD = 8, WGM = 8;

__host__ __device__ __forceinline__ int lds_byte(int r, int c) { const int st = (r >> 4) * 2 + (c >> 5), rr = r & 15, cc = c & 31, ob = rr * 64 + cc * 2; return st * 1024 + (ob ^ (((ob >> 9) & 1) << 5)); }
__host__ __device__ __forceinline__ void stage_rc(int b, int& R, int& C) { const int st = b / 1024, sb = b % 1024, swz = sb ^ (((sb >> 9) & 1) << 5); R = (st >> 1) * 16 + swz / 64; C = (st & 1) * 32 + (swz % 64) / 2; }
__host__ __device__ __forceinline__ int perm32(int rho) { const int n = rho >> 4, i = rho & 15; return 8 * (i >> 2) + 4 * n + (i & 3); }

struct Unit { size_t aoff, boff; int pm, pn, e, valid, mt; };
struct Gemm { const void* A; const void* Bt; int RB; int akstep; };
typedef int v8i __attribute__((ext_vector_type(8)));

struct StaticOrder {
    int nM, nN, nwg, G, c, RB; const unsigned* sc;
    __device__ void init(int M, int N, int RB_, int G_, int c_, const unsigned* sc_ = nullptr) { nM = M / BM; nN = N / BM; nwg = nM * nN; G = G_; c = c_; RB = RB_; sc = sc_; }
    __device__ bool next(int i, Unit& u) const {
        const long L = (long)i * G + c; if (L >= nwg) return false;
        int wgid = (int)L; { const int q = nwg / NXCD, r = nwg % NXCD, xcd = wgid % NXCD, off = wgid / NXCD; wgid = (xcd < r ? xcd * (q + 1) : r * (q + 1) + (xcd - r) * q) + off; }
        const int nig = WGM * nN, gid = wgid / nig, fm = gid * WGM, gsz = (nM - fm) < WGM ? (nM - fm) : WGM;
        u.pm = fm + ((wgid % nig) % gsz); u.pn = (wgid % nig) / gsz; u.e = 0; u.valid = 256; u.mt = 0;
        u.aoff = (size_t)u.pm * (size_t)(BM * RB); u.boff = (size_t)u.pn * (size_t)(BM * RB); return true;
    }
    __device__ __forceinline__ const unsigned* id_src(const Unit& u, int row) const { return sc + u.pm * 256 + row; }
    __device__ __forceinline__ const unsigned* sc_src(const Unit& u, int row) const { return sc + u.pm * 256 + row; }
    __device__ __forceinline__ const unsigned* bias_src(const Unit& u, int row) const { return sc + u.pm * 256 + row; }
};

__device__ __forceinline__ unsigned cvt_pk_bf16(float lo, float hi) { typedef float f2_ __attribute__((ext_vector_type(2))); typedef __bf16 b2_ __attribute__((ext_vector_type(2))); f2_ v = {lo, hi}; b2_ b = __builtin_convertvector(v, b2_); return __builtin_bit_cast(unsigned, b); }

template <class Epi, class Sched, bool ALIGN_EPI, bool GATHER, bool IDS, bool FP8 = false, bool LINEAR = false>
__device__ __forceinline__ void gemm_phase(PG8_LAS unsigned char* lds, PG8_LAS unsigned* idb, const Gemm g, const Sched& S, const Epi& E, const int tid) {
    const int wid = __builtin_amdgcn_readfirstlane(tid >> 6), lane = tid & 63, wr = wid >> 2, wc = wid & 3, fr = lane & 15, fq = lane >> 4;
    const int RB = g.RB; int nt = RB / (BK * 2); asm volatile("" : "+s"(nt));
    unsigned voffA[2], voffB[2]; int RA[2], CA[2];
#pragma unroll
    for (int i = 0; i < 2; ++i) { int R, C; stage_rc(tid * 16 + i * 8192, R, C); const int Rb = (R & ~31) + perm32(R & 31); RA[i] = R; CA[i] = C;
        voffA[i] = (unsigned)(R * RB + C * 2); voffB[i] = (unsigned)(Rb * RB + C * 2); }
    const size_t kstep = (size_t)(BK * 2), akstep = (size_t)g.akstep;
    const size_t hstep = (size_t)HALF * RB;
    const unsigned ldsw = (unsigned)wid * 1024u;
    const int aoff = lds_byte(wr * 64 + fr, fq * 8), boff = lds_byte(wc * 32 + fr, fq * 8);
#define PG8_SA(b, h) (((b) * 2 + (h)) * HTB)
#define PG8_SB(b, h) ((4 + (b) * 2 + (h)) * HTB)
#define PG8_STAGE(bufoff, gbase, voff) do { _Pragma("unroll") for (int _i = 0; _i < 2; ++_i) \
        __builtin_amdgcn_global_load_lds((const unsigned*)((const char*)(gbase) + (voff)[_i]), (PG8_LAS unsigned*)(lds + (bufoff) + ldsw + _i * 8192), 16, 0, 0); } while (0)
#define PG8_STAGE_A(bufoff, pbase, gbase, h, gv) do { if constexpr (GATHER) { PG8_STAGE(bufoff, gbase, gv[h]); } else { PG8_STAGE(bufoff, (pbase) + (h) * hstep, voffA); } } while (0)
#define PG8_LD32(p0_, p1_) __builtin_bit_cast(v8i, __builtin_shufflevector(*(const PG8_LAS u32x4*)(p0_), *(const PG8_LAS u32x4*)(p1_), 0, 1, 2, 3, 4, 5, 6, 7))
#define PG8_LDA(dst, b, h) do { if constexpr (FP8) { _Pragma("unroll") for (int m = 0; m < 4; ++m) dst##8[m] = PG8_LD32(lds + PG8_SA(b, h) + aoff + m * 2048, lds + PG8_SA(b, h) + aoff + m * 2048 + 1024); } \
        else { _Pragma("unroll") for (int m = 0; m < 4; ++m) _Pragma("unroll") for (int k = 0; k < 2; ++k) dst[m][k] = *(const PG8_LAS bf16x8*)(lds + PG8_SA(b, h) + aoff + m * 2048 + k * 1024); } } while (0)
#define PG8_LDB(dst, b, h) do { if constexpr (FP8) { _Pragma("unroll") for (int n = 0; n < 2; ++n) dst##8[n] = PG8_LD32(lds + PG8_SB(b, h) + boff + n * 2048, lds + PG8_SB(b, h) + boff + n * 2048 + 1024); } \
        else { _Pragma("unroll") for (int n = 0; n < 2; ++n) _Pragma("unroll") for (int k = 0; k < 2; ++k) dst[n][k] = *(const PG8_LAS bf16x8*)(lds + PG8_SB(b, h) + boff + n * 2048 + k * 1024); } } while (0)
#define PG8_MMA(ai, bj, At, Bt) do { __builtin_amdgcn_s_setprio(1); if constexpr (FP8) { _Pragma("unroll") for (int m = 0; m < 4; ++m) _Pragma("unroll") for (int n = 0; n < 2; ++n) \
        acc[ai][bj][m][n] = __builtin_amdgcn_mfma_scale_f32_16x16x128_f8f6f4(Bt##8[n], At##8[m], acc[ai][bj][m][n], 0, 0, 0, sca_, 0, 0x7f7f7f7f); } \
        else { _Pragma("unroll") for (int m = 0; m < 4; ++m) _Pragma("unroll") for (int n = 0; n < 2; ++n) _Pragma("unroll") for (int k = 0; k < 2; ++k) \
        acc[ai][bj][m][n] = __builtin_amdgcn_mfma_f32_16x16x32_bf16(Bt[n][k], At[m][k], acc[ai][bj][m][n], 0, 0, 0); } __builtin_amdgcn_s_setprio(0); } while (0)
#define PG8_WAIT_V(n) asm volatile("s_waitcnt vmcnt(" #n ")" ::: "memory")
#define PG8_WAIT_L(n) asm volatile("s_waitcnt lgkmcnt(" #n ")" ::: "memory")
#define PG8_BAR __builtin_amdgcn_s_barrier()
#define PG8_SCHED __builtin_amdgcn_sched_barrier(0)
#define PG8_IDS_DMA(u, s) do { if (wid < 4) { __builtin_amdgcn_global_load_lds(S.id_src(u, tid), (PG8_LAS unsigned*)(idb + (s) * 768 + wid * 64), 4, 0, 0); \
        __builtin_amdgcn_global_load_lds(S.sc_src(u, tid), (PG8_LAS unsigned*)(idb + (s) * 768 + 256 + wid * 64), 4, 0, 0); \
        __builtin_amdgcn_global_load_lds(S.bias_src(u, tid), (PG8_LAS unsigned*)(idb + (s) * 768 + 512 + wid * 64), 4, 0, 0); } } while (0)
#define PG8_GV(dst, s, un) do { _Pragma("unroll") for (int _h = 0; _h < 2; ++_h) _Pragma("unroll") for (int _i = 0; _i < 2; ++_i) \
        dst[_h][_i] = (LINEAR ? (unsigned)((un).pm * 256 + _h * 128 + RA[_i]) : (idb[(s) * 768 + _h * 128 + RA[_i]] >> 2)) * (unsigned)RB + (unsigned)(CA[_i] * 2); } while (0)
    Unit cur, nxt; int ui = 0, us = 0;
    if (!S.next(0, cur)) return;
    f32x4 acc[2][2][4][2];
#pragma unroll
    for (int a = 0; a < 2; ++a)
#pragma unroll
        for (int b = 0; b < 2; ++b)
#pragma unroll
            for (int m = 0; m < 4; ++m)
#pragma unroll
                for (int n = 0; n < 2; ++n) acc[a][b][m][n] = (f32x4){0.f, 0.f, 0.f, 0.f};
    bf16x8 At[4][2], B0[2][2], B1[2][2]; v8i At8[4], B08[2], B18[2];
    unsigned cv[2][2] = {{0u, 0u}, {0u, 0u}};
    const char* A0 = (const char*)g.A;
    const char* cA = A0 + (GATHER ? (size_t)0 : cur.aoff); const char* cB = (const char*)g.Bt + cur.boff;
    if constexpr (IDS) {
        PG8_IDS_DMA(cur, 0); PG8_WAIT_V(0); PG8_BAR;
    }
    if constexpr (GATHER) { PG8_GV(cv, 0, cur); }
    PG8_STAGE(PG8_SB(0, 0), cB, voffB); PG8_STAGE(PG8_SB(0, 1), cB + hstep, voffB); PG8_STAGE_A(PG8_SA(0, 0), cA, A0, 0, cv); PG8_STAGE_A(PG8_SA(0, 1), cA, A0, 1, cv);
    if (wr == 1) PG8_BAR;
    PG8_WAIT_V(2); PG8_BAR;
    PG8_STAGE(PG8_SB(1, 0), cB + kstep, voffB); PG8_STAGE_A(PG8_SA(1, 0), cA + akstep, A0 + akstep, 0, cv); PG8_STAGE(PG8_SB(1, 1), cB + hstep + kstep, voffB);
    PG8_WAIT_V(6); PG8_BAR;
    for (;;) {
        const bool has_next = S.next(ui + 1, nxt);
        const int ns = (us == 2) ? 0 : us + 1;
        if constexpr (IDS) { if (has_next) PG8_IDS_DMA(nxt, ns); }
        const char* nA = has_next ? A0 + (GATHER ? (size_t)0 : nxt.aoff) : cA; const char* nB = has_next ? (const char*)g.Bt + nxt.boff : cB;
#ifdef PROBE_KTWICE
        for (int rep_ = 0; rep_ < (FP8 ? 2 : 1); ++rep_) { const int sca_ = rep_ ? 0 : 0x7f7f7f7f;
#else
        { const int sca_ = 0x7f7f7f7f;
#endif
#pragma nounroll
        for (int t = 0; t < nt; t += 2) {
            int lastv = (t == nt - 2) ? 1 : 0; asm volatile("" : "+v"(lastv)); const bool last = __builtin_amdgcn_readfirstlane(lastv) != 0;
            const char* a1 = cA + (size_t)(t + 1) * akstep;
            const char* a2 = last ? nA : cA + (size_t)(t + 2) * akstep; const char* b2 = last ? nB : cB + (size_t)(t + 2) * kstep;
            const char* a3 = a2 + akstep; const char* b3 = b2 + kstep;
            PG8_LDB(B0, 0, 0); PG8_LDB(B1, 0, 1); PG8_SCHED; PG8_LDA(At, 0, 0); PG8_STAGE_A(PG8_SA(1, 1), a1, a1, 1, cv);
            if constexpr (GATHER) { if (last && has_next) { PG8_GV(cv, ns, nxt); } }
            PG8_WAIT_V(8); PG8_WAIT_L(0); PG8_BAR; PG8_MMA(0, 0, At, B0); PG8_MMA(0, 1, At, B1); PG8_BAR; PG8_SCHED;
            PG8_LDA(At, 0, 1); PG8_STAGE(PG8_SB(0, 0), b2, voffB); PG8_STAGE(PG8_SB(0, 1), b2 + hstep, voffB); PG8_STAGE_A(PG8_SA(0, 0), a2, a2, 0, cv);
            PG8_WAIT_V(8); PG8_WAIT_L(0); PG8_BAR; PG8_MMA(1, 0, At, B0); PG8_MMA(1, 1, At, B1); PG8_BAR; PG8_SCHED;
            PG8_LDB(B0, 1, 0); PG8_LDB(B1, 1, 1); PG8_SCHED; PG8_LDA(At, 1, 0); PG8_STAGE_A(PG8_SA(0, 1), a2, a2, 1, cv);
            PG8_WAIT_V(8); PG8_WAIT_L(0); PG8_BAR; PG8_MMA(0, 0, At, B0); PG8_MMA(0, 1, At, B1); PG8_BAR; PG8_SCHED;
            PG8_LDA(At, 1, 1); PG8_STAGE(PG8_SB(1, 0), b3, voffB); PG8_STAGE(PG8_SB(1, 1), b3 + hstep, voffB); PG8_STAGE_A(PG8_SA(1, 0), a3, a3, 0, cv);
            PG8_WAIT_V(8); PG8_WAIT_L(0); PG8_BAR; PG8_MMA(1, 0, At, B0); PG8_MMA(1, 1, At, B1); PG8_BAR; PG8_SCHED;
        }
        }
        if constexpr (ALIGN_EPI) { if (wr == 0) PG8_BAR; }
        PG8_SCHED;
        E(acc, cur, wr, wc, fr, fq, (const PG8_LAS unsigned*)(idb + us * 768));
        PG8_SCHED;
#ifdef PROBE_EPI2
        if constexpr (FP8) { E(acc, cur, wr, wc, fr, fq, (const PG8_LAS unsigned*)(idb + us * 768)); PG8_SCHED; }
#endif
        if (!has_next) break;
#pragma unroll
        for (int a = 0; a < 2; ++a)
#pragma unroll
            for (int b = 0; b < 2; ++b)
#pragma unroll
                for (int m = 0; m < 4; ++m)
#pragma unroll
                    for (int n = 0; n < 2; ++n) acc[a][b][m][n] = (f32x4){0.f, 0.f, 0.f, 0.f};
        cur = nxt; cA = nA; cB = nB; ++ui; us = ns;
        if constexpr (ALIGN_EPI) { if (wr == 1) PG8_BAR; }
    }
    PG8_WAIT_V(0);
    if constexpr (!ALIGN_EPI) { if (wr == 0) PG8_BAR; }
    PG8_BAR;
#undef PG8_SA
#undef PG8_SB
#undef PG8_STAGE
#undef PG8_STAGE_A
#undef PG8_LDA
#undef PG8_LDB
#undef PG8_MMA
#undef PG8_LD32
#undef PG8_WAIT_V
#undef PG8_WAIT_L
#undef PG8_BAR
#undef PG8_SCHED
#undef PG8_IDS_DMA
#undef PG8_GV
}
}
namespace attn_body {
using bf16=__hip_bfloat16;
using bf16x8=__attribute__((ext_vector_type(8)))short;
using s16x4=__attribute__((ext_vector_type(4)))short;
using f32x16=__attribute__((ext_vector_type(16)))float;
using u32x4=__attribute__((ext_vector_type(4)))unsigned;
constexpr int D=64;
constexpr int NW=8,QBLK=32,QB=QBLK*NW,KVBLK=64;
struct UnitP { const bf16* Q; const bf16* K; const bf16* V; bf16* O; long qp, kp, op; int q0, t0, NT; float slope2; float* lse; int lse_stride; };
__device__ __forceinline__ int crow(int r,int hi){return (r&3)+8*(r>>2)+4*hi;}
#define SBAR() __builtin_amdgcn_sched_barrier(0)
template<bool CAUSAL,bool WINDOW> __device__ __forceinline__ void cmask(f32x16&p0,f32x16&p1,int jb,int qrel,int hi){
  const float NEG=-INFINITY; int kb=64*jb+4*hi;
  #pragma unroll
  for(int r=0;r<16;++r){int kv=kb+(r&3)+8*(r>>2);
    if(CAUSAL){ if(kv>qrel)p0[r]=NEG; if(kv+32>qrel)p1[r]=NEG; }
    if(WINDOW){ if(kv<qrel-128)p0[r]=NEG; if(kv+32<qrel-128)p1[r]=NEG; } }
}
__device__ __forceinline__ unsigned bfr(float x){ typedef float f2_ __attribute__((ext_vector_type(2))); typedef __bf16 b2_ __attribute__((ext_vector_type(2))); f2_ v={x,0.f}; b2_ b=__builtin_convertvector(v,b2_); return __builtin_bit_cast(unsigned,b)&0xffffu; }
__device__ __forceinline__ float bfv(unsigned b){ return __builtin_bit_cast(float,b<<16); }

constexpr int NSLOT=3, SLOTB=8192;
constexpr int LDS_K=0, LDS_V=NSLOT*SLOTB;
template<int DV> struct Lds { static constexpr int SLOTV=SLOTB*(DV/64), WS=LDS_V+NSLOT*SLOTV, OST=WS+NW*64*4, OSTW=4096*(DV/64), BYTES=OST+NW*OSTW; };
__device__ __forceinline__ void glds16(const void*gsrc,unsigned lds_dst){unsigned keep;
  asm volatile("s_mov_b32 %0, m0\n\ts_mov_b32 m0, %2\n\ts_nop 0\n\tglobal_load_lds_dwordx4 %1, off\n\ts_mov_b32 m0, %0":"=&s"(keep):"v"(gsrc),"s"(lds_dst):"memory");}
__device__ __forceinline__ float max3f(float a,float b,float c){float r;asm("v_max3_f32 %0, %1, %2, %3":"=v"(r):"v"(a),"v"(b),"v"(c));return r;}
__device__ __forceinline__ float max2f(float a,float b){float r;asm("v_max_f32_e32 %0, %1, %2":"=v"(r):"v"(a),"v"(b));return r;}
__device__ __forceinline__ float fadd_s(float a,float b){float r;asm("v_add_f32_e32 %0, %1, %2":"=v"(r):"v"(a),"v"(b));return r;}
__device__ __forceinline__ float fsub_s(float a,float b){float r;asm("v_sub_f32_e32 %0, %1, %2":"=v"(r):"v"(a),"v"(b));return r;}
typedef float f32x2_t __attribute__((ext_vector_type(2))); typedef __bf16 bf16x2_t __attribute__((ext_vector_type(2)));
__device__ __forceinline__ unsigned cvtpk_s(float lo,float hi){f32x2_t v={lo,hi};bf16x2_t b=__builtin_convertvector(v,bf16x2_t);return __builtin_bit_cast(unsigned,b);}
#define WAIT_BAR(N) asm volatile("s_waitcnt vmcnt(" #N ") lgkmcnt(0)\n\ts_barrier":::"memory")

__device__ __forceinline__ void qkt(f32x16&p0,f32x16&p1,const char*Kslot,const bf16x8*qr,bf16x8 kx0,bf16x8 kx1,bf16x8 qx,int r32,int hi){
  const char*kb=Kslot+hi*1024+r32*16;
  #pragma unroll
  for(int d0=0;d0<4;++d0){
    const bf16x8 b0=*reinterpret_cast<const bf16x8*>(kb+d0*2048);
    const bf16x8 b1=*reinterpret_cast<const bf16x8*>(kb+d0*2048+512);
    if(d0==0){p0=__builtin_amdgcn_mfma_f32_32x32x16_bf16(b0,qr[0],f32x16{},0,0,0);p1=__builtin_amdgcn_mfma_f32_32x32x16_bf16(b1,qr[0],f32x16{},0,0,0);}
    else{p0=__builtin_amdgcn_mfma_f32_32x32x16_bf16(b0,qr[d0],p0,0,0,0);p1=__builtin_amdgcn_mfma_f32_32x32x16_bf16(b1,qr[d0],p1,0,0,0);}}
  p0=__builtin_amdgcn_mfma_f32_32x32x16_bf16(kx0,qx,p0,0,0,0);p1=__builtin_amdgcn_mfma_f32_32x32x16_bf16(kx1,qx,p1,0,0,0);
}
typedef __attribute__((address_space(3))) const char* lds_cptr;
typedef short v4i16_t __attribute__((ext_vector_type(4)));
__device__ __forceinline__ void kload8(bf16x8*kf,lds_cptr kp){
  kf[0]=*(const __attribute__((address_space(3))) bf16x8*)(kp);      kf[1]=*(const __attribute__((address_space(3))) bf16x8*)(kp+512);
  kf[2]=*(const __attribute__((address_space(3))) bf16x8*)(kp+2048); kf[3]=*(const __attribute__((address_space(3))) bf16x8*)(kp+2560);
  kf[4]=*(const __attribute__((address_space(3))) bf16x8*)(kp+4096); kf[5]=*(const __attribute__((address_space(3))) bf16x8*)(kp+4608);
  kf[6]=*(const __attribute__((address_space(3))) bf16x8*)(kp+6144); kf[7]=*(const __attribute__((address_space(3))) bf16x8*)(kp+6656);
}
__device__ __forceinline__ void kload2(bf16x8*kf,lds_cptr kp,int j){ kf[2*j]=*(const __attribute__((address_space(3))) bf16x8*)(kp+j*2048); kf[2*j+1]=*(const __attribute__((address_space(3))) bf16x8*)(kp+j*2048+512); }
__device__ __forceinline__ s16x4 vtr(lds_cptr p){ return __builtin_bit_cast(s16x4,__builtin_amdgcn_ds_read_tr16_b64_v4i16((__attribute__((address_space(3))) v4i16_t*)p)); }
__device__ __forceinline__ float rowmax(const f32x16&p0,const f32x16&p1){
  float a=max3f(p0[0],p0[1],p1[0]),b=max3f(p0[2],p0[3],p1[1]);a=max3f(a,p1[2],p1[3]);
  #pragma unroll
  for(int r=4;r<16;r+=4){a=max3f(a,p0[r],p0[r+1]);b=max3f(b,p0[r+2],p0[r+3]);a=max3f(a,p1[r],p1[r+1]);b=max3f(b,p1[r+2],p1[r+3]);}
  const float m=max2f(a,b);
  auto rr=__builtin_amdgcn_permlane32_swap(__float_as_uint(m),__float_as_uint(m),false,false);
  return max2f(__uint_as_float(rr[0]),__uint_as_float(rr[1]));
}
__device__ __forceinline__ void pv(f32x16*o,int vb,bf16x8 pa0,bf16x8 pa1,bf16x8 pa2,bf16x8 pa3){
  #pragma unroll
  for(int d0=0;d0<2;++d0){s16x4 lo[4],hi[4];
    #pragma unroll
    for(int ks=0;ks<4;++ks){
      asm volatile("ds_read_b64_tr_b16 %0,%1 offset:%c2":"=&v"(lo[ks]):"v"(vb),"i"(d0*4096+ks*1024):"memory");
      asm volatile("ds_read_b64_tr_b16 %0,%1 offset:%c2":"=&v"(hi[ks]):"v"(vb),"i"(d0*4096+ks*1024+512):"memory");}
    asm volatile("s_waitcnt lgkmcnt(0)":::"memory");SBAR();
    #define PK(k) (bf16x8){lo[k][0],lo[k][1],lo[k][2],lo[k][3],hi[k][0],hi[k][1],hi[k][2],hi[k][3]}
    o[d0]=__builtin_amdgcn_mfma_f32_32x32x16_bf16(pa0,PK(0),o[d0],0,0,0);
    o[d0]=__builtin_amdgcn_mfma_f32_32x32x16_bf16(pa1,PK(1),o[d0],0,0,0);
    o[d0]=__builtin_amdgcn_mfma_f32_32x32x16_bf16(pa2,PK(2),o[d0],0,0,0);
    o[d0]=__builtin_amdgcn_mfma_f32_32x32x16_bf16(pa3,PK(3),o[d0],0,0,0);
    #undef PK
  }
}

__device__ __forceinline__ void pv128(f32x16*o,int vb,bf16x8 pa0,bf16x8 pa1,bf16x8 pa2,bf16x8 pa3){
  #pragma unroll
  for(int d0=0;d0<4;++d0){s16x4 lo[4],hi[4];
    #pragma unroll
    for(int ks=0;ks<4;++ks){
      asm volatile("ds_read_b64_tr_b16 %0,%1 offset:%c2":"=&v"(lo[ks]):"v"(vb),"i"(d0*4096+ks*1024):"memory");
      asm volatile("ds_read_b64_tr_b16 %0,%1 offset:%c2":"=&v"(hi[ks]):"v"(vb),"i"(d0*4096+ks*1024+512):"memory");}
    asm volatile("s_waitcnt lgkmcnt(0)":::"memory");SBAR();
    #define PK(k) (bf16x8){lo[k][0],lo[k][1],lo[k][2],lo[k][3],hi[k][0],hi[k][1],hi[k][2],hi[k][3]}
    o[d0]=__builtin_amdgcn_mfma_f32_32x32x16_bf16(pa0,PK(0),o[d0],0,0,0);
    o[d0]=__builtin_amdgcn_mfma_f32_32x32x16_bf16(pa1,PK(1),o[d0],0,0,0);
    o[d0]=__builtin_amdgcn_mfma_f32_32x32x16_bf16(pa2,PK(2),o[d0],0,0,0);
    o[d0]=__builtin_amdgcn_mfma_f32_32x32x16_bf16(pa3,PK(3),o[d0],0,0,0);
    #undef PK
  }
}
#ifndef ATTN_STORE16
#define ATTN_STORE16(p,v) (*(u32x4*)(p)=(v))
#endif
template<int THRL,bool CAUSAL,bool WINDOW,bool ALIBI,bool LSE,int DV=64> __device__ __forceinline__ void attn_unit(const UnitP&U,char*shm){
  constexpr int LDS_WS=Lds<DV>::WS, LDS_OST=Lds<DV>::OST, VMUL=DV/64;
  int tid=threadIdx.x; asm volatile("":"+v"(tid));
  const int lane=tid&63,r32=lane&31,hi=lane>>5; const int wid=__builtin_amdgcn_readfirstlane(tid>>6);
  const int q0=U.q0; const long qp=U.qp,kp=U.kp,op=U.op; const float slope2=U.slope2;
  const bf16*Qw=U.Q+(long)(q0+wid*QBLK)*qp;
  const bf16*Kh=U.K+(long)U.t0*KVBLK*kp,*Vh=U.V+(long)U.t0*KVBLK*kp;
  const unsigned lds0=(unsigned)(uintptr_t)shm;
  float*wsf=(float*)(shm+LDS_WS)+wid*64;
  const bf16*ksrc=Kh+(long)lane*kp+wid*8;
  const bf16*vsrc=Vh+(long)(16*(wid&3)+(lane>>2))*kp+(wid>>2)*32+(lane&3)*8;
  const unsigned kdst=lds0+LDS_K+wid*1024, vdst=lds0+LDS_V+wid*1024;
  #define DMA_K(t,slot) glds16(ksrc+(long)(t)*KVBLK*kp,(unsigned)__builtin_amdgcn_readfirstlane(kdst+(slot)))
  #define DMA_V(t,slot) do{ glds16(vsrc+(long)(t)*KVBLK*kp,(unsigned)__builtin_amdgcn_readfirstlane(vdst+VMUL*(slot))); if constexpr(DV==128) glds16(vsrc+64+(long)(t)*KVBLK*kp,(unsigned)__builtin_amdgcn_readfirstlane(vdst+VMUL*(slot)+8192)); }while(0)
  const int vb0=(int)(lds0+LDS_V)+((lane>>4)&1)*32+(lane&3)*8+(4*hi+((lane&15)>>2))*64;
  const char*Kbase=shm+LDS_K; bf16x8 kf[8];
  const lds_cptr shm3=(lds_cptr)shm; const lds_cptr kp0=shm3+LDS_K+hi*1024+r32*16; const lds_cptr vp0=shm3+LDS_V+((lane>>4)&1)*32+(lane&3)*8+(4*hi+((lane&15)>>2))*64;
  const int NT=U.NT;
  DMA_K(0,0);DMA_V(0,0);DMA_K(1,SLOTB);
  bf16x8 qr[4];
  #pragma unroll
  for(int d0=0;d0<4;++d0)qr[d0]=*reinterpret_cast<const bf16x8*>(&Qw[(long)r32*qp+d0*16+hi*8]);
  float mhat=0.f,l_reg=0.f;f32x16 o[4];o[0]=f32x16{};o[1]=f32x16{};o[2]=f32x16{};o[3]=f32x16{};
  const int qrel=wid*QBLK+r32;
  #define CMASK(P0,P1,t) do{int jb_=(t)-(NT-4); if(WINDOW||(CAUSAL&&jb_>=0))cmask<CAUSAL,WINDOW>(P0,P1,jb_,qrel,hi);}while(0)
  bf16x8 kx0,kx1,qx;
  { const float k0_=ALIBI?slope2*(float)r32:0.f, k1_=ALIBI?slope2*(float)(r32+32):0.f; const unsigned h0=bfr(k0_),l0=bfr(k0_-bfv(h0)),h1=bfr(k1_),l1=bfr(k1_-bfv(h1));
    u32x4 a={0x3f803f80u,0x3f80u|(h0<<16),l0,0u}, b={0x3f803f80u,0x3f80u|(h1<<16),l1,0u}; if(hi){a=u32x4{0u,0u,0u,0u};b=a;} kx0=__builtin_bit_cast(bf16x8,a); kx1=__builtin_bit_cast(bf16x8,b); }
  #define QX_SET(t) do{ const float nb_=ALIBI?__builtin_fmaf(slope2,(float)(64*((t)-(NT-4))-qrel),-mhat):-mhat; const unsigned a_=bfr(nb_); const float r1_=nb_-bfv(a_); const unsigned b_=bfr(r1_); const unsigned c_=bfr(r1_-bfv(b_)); \
    u32x4 q_={a_|(b_<<16),c_|0x3f800000u,0x3f80u,0u}; if(hi)q_=u32x4{0u,0u,0u,0u}; qx=__builtin_bit_cast(bf16x8,q_); asm volatile("":"+v"(qx)); }while(0)
  bool resc=false;
  #define START(P0,P1) do{ const float rm=rowmax(P0,P1); resc=false; \
    { const float dl=(rm==-INFINITY)?0.f:rm; mhat=fadd_s(mhat,dl); \
      _Pragma("unroll") for(int r=0;r<16;++r){P0[r]=fsub_s(P0[r],dl);P1[r]=fsub_s(P1[r],dl);} } \
    _Pragma("unroll") for(int r=0;r<16;++r)P0[r]=__builtin_amdgcn_exp2f(P0[r]); }while(0)
  #define RESC() do{ if(resc){ asm volatile("s_waitcnt lgkmcnt(0)":::"memory"); \
      _Pragma("unroll") for(int d_=0;d_<2*VMUL;++d_) _Pragma("unroll") for(int r=0;r<16;++r)o[d_][r]*=wsf[crow(r,hi)]; } }while(0)
  f32x16 pA0,pA1,pB0,pB1;
  int sl_prev=0,sl_cur=0,sl_next=SLOTB;
  #define ROT() do{sl_prev=sl_cur;sl_cur=sl_next;sl_next=(sl_next==(NSLOT-1)*SLOTB)?0:sl_next+SLOTB;}while(0)
  DMA_K(2,2*SLOTB);
  if constexpr(DV==128){WAIT_BAR(4);}else{WAIT_BAR(3);}
  QX_SET(0);
  qkt(pA0,pA1,Kbase,qr,kx0,kx1,qx,r32,hi);asm volatile("s_nop 15\n\ts_nop 7":"+v"(pA0),"+v"(pA1));CMASK(pA0,pA1,0);
  START(pA0,pA1);
  _Pragma("unroll") for(int r=0;r<16;++r)pA1[r]=__builtin_amdgcn_exp2f(pA1[r]);
  WAIT_BAR(0);
  DMA_K(3,0);DMA_V(1,SLOTB);
  ROT();
  kload8(kf,kp0+sl_cur);
  if constexpr(DV==128){WAIT_BAR(3);}else{WAIT_BAR(2);}
  s16x4 vlo[8],vhi[8]; s16x4 vfl[4],vfh[4]; u32x4 pw0,pw1,pw2,pw3;
  #define PKW(P,B) cvtpk_s(P[B],P[B+1])
  #define PAF(k) __builtin_bit_cast(bf16x8,pw##k)
  #define VFR(i) (bf16x8){vlo[i][0],vlo[i][1],vlo[i][2],vlo[i][3],vhi[i][0],vhi[i][1],vhi[i][2],vhi[i][3]}
  #define PIN(x) asm volatile("":"+v"(x))
  #define MX3(a,b,c) __builtin_fmaxf(__builtin_fmaxf((a),(b)),(c))
  #define GAPA(MF,A0,A1,A2,A3,W0,W1,PW) do{ MF; sacc+=A0; sacc+=A1; sacc+=A2; sacc+=A3; PIN(sacc); W0; W1; PIN(PW); SBAR(); }while(0)
  #define EX(v) __builtin_amdgcn_exp2f(v)
  #define GAPB(MF,X,B) do{ MF; X[B]=EX(X[B]); X[B+1]=EX(X[B+1]); X[B+2]=EX(X[B+2]); X[B+3]=EX(X[B+3]); PIN(X); SBAR(); }while(0)
  #define VRD(i) do{ if constexpr(DV==64){ vlo[i]=vtr(vp_+(((i)>>2)*4096+((i)&3)*1024)); vhi[i]=vtr(vp_+(((i)>>2)*4096+((i)&3)*1024+512)); } }while(0)
  #define VRJ(f) do{ vfl[(f)&3]=vtr(vp_+(((f)&3)*4096+((f)>>2)*1024)); vfh[(f)&3]=vtr(vp_+(((f)&3)*4096+((f)>>2)*1024+512)); }while(0)
  #define VFJ(f) (bf16x8){vfl[(f)&3][0],vfl[(f)&3][1],vfl[(f)&3][2],vfl[(f)&3][3],vfh[(f)&3][0],vfh[(f)&3][1],vfh[(f)&3][2],vfh[(f)&3][3]}
  #define GAPJ(f,PA,X,B) do{ if((f)+3<16){VRJ((f)+3);} o[(f)&3]=__builtin_amdgcn_mfma_f32_32x32x16_bf16(PA,VFJ(f),o[(f)&3],0,0,0); X[B]=EX(X[B]); X[B+1]=EX(X[B+1]); PIN(X); SBAR(); }while(0)
  #define KRD(G,j) do{ if(G){ kload2(kf,kp0+sl_next,j); SBAR(); } }while(0)
  #define STEP(C0,C1,P0,P1,t,GK,GV,GL) do{ SBAR(); QX_SET(t); SBAR(); \
    const lds_cptr vp_=vp0+VMUL*sl_prev; \
    VRD(0); SBAR(); float sacc=(P0[0]+P0[1]); \
    GAPA(C0=__builtin_amdgcn_mfma_f32_32x32x16_bf16(kf[0],qr[0],f32x16{},0,0,0), P0[2],P0[3],P0[4],P0[5],     pw0[0]=PKW(P0,0), pw0[1]=PKW(P0,2), pw0); \
    VRD(4); SBAR(); GAPA(C1=__builtin_amdgcn_mfma_f32_32x32x16_bf16(kf[1],qr[0],f32x16{},0,0,0), P0[6],P0[7],P0[8],P0[9],     pw0[2]=PKW(P0,4), pw0[3]=PKW(P0,6), pw0); \
    VRD(1); SBAR(); GAPA(C0=__builtin_amdgcn_mfma_f32_32x32x16_bf16(kf[2],qr[1],C0,0,0,0),   P0[10],P0[11],P0[12],P0[13], pw1[0]=PKW(P0,8), pw1[1]=PKW(P0,10), pw1); \
    VRD(5); SBAR(); GAPA(C1=__builtin_amdgcn_mfma_f32_32x32x16_bf16(kf[3],qr[1],C1,0,0,0),   P0[14],P0[15],P1[0],P1[1],   pw1[2]=PKW(P0,12),pw1[3]=PKW(P0,14), pw1); \
    VRD(2); SBAR(); GAPA(C0=__builtin_amdgcn_mfma_f32_32x32x16_bf16(kf[4],qr[2],C0,0,0,0),   P1[2],P1[3],P1[4],P1[5],     pw2[0]=PKW(P1,0), pw2[1]=PKW(P1,2), pw2); \
    VRD(6); SBAR(); GAPA(C1=__builtin_amdgcn_mfma_f32_32x32x16_bf16(kf[5],qr[2],C1,0,0,0),   P1[6],P1[7],P1[8],P1[9],     pw2[2]=PKW(P1,4), pw2[3]=PKW(P1,6), pw2); \
    VRD(3); SBAR(); GAPA(C0=__builtin_amdgcn_mfma_f32_32x32x16_bf16(kf[6],qr[3],C0,0,0,0),   P1[10],P1[11],P1[12],P1[13], pw3[0]=PKW(P1,8), pw3[1]=PKW(P1,10), pw3); \
    VRD(7); SBAR(); GAPA(C1=__builtin_amdgcn_mfma_f32_32x32x16_bf16(kf[7],qr[3],C1,0,0,0),   P1[14],P1[15],0.f,0.f,       pw3[2]=PKW(P1,12),pw3[3]=PKW(P1,14), pw3); \
    C0=__builtin_amdgcn_mfma_f32_32x32x16_bf16(kx0,qx,C0,0,0,0); C1=__builtin_amdgcn_mfma_f32_32x32x16_bf16(kx1,qx,C1,0,0,0); if constexpr(DV==128){VRJ(0);VRJ(1);VRJ(2);} SBAR(); \
    l_reg+=sacc; \
    if(GK){DMA_K((t)+3,sl_cur);} if(GV){DMA_V((t)+1,sl_next);} \
    CMASK(C0,C1,t); \
    { float a=MX3(C0[0],C0[1],C1[0]),b=MX3(C0[2],C0[3],C1[1]); a=MX3(a,C1[2],C1[3]); \
      _Pragma("unroll") for(int r=4;r<16;r+=4){a=MX3(a,C0[r],C0[r+1]);b=MX3(b,C0[r+2],C0[r+3]);a=MX3(a,C1[r],C1[r+1]);b=MX3(b,C1[r+2],C1[r+3]);} \
      float rm=__builtin_fmaxf(a,b); { auto rr=__builtin_amdgcn_permlane32_swap(__float_as_uint(rm),__float_as_uint(rm),false,false); rm=__builtin_fmaxf(__uint_as_float(rr[0]),__uint_as_float(rr[1])); } \
      resc=false; \
      if(__builtin_expect(__any(rm>(float)THRL),0)){ const float dl=__builtin_fmaxf(rm,0.f); mhat+=dl; \
        _Pragma("unroll") for(int r=0;r<16;++r){C0[r]-=dl;C1[r]-=dl;} \
        const float f=__builtin_amdgcn_exp2f(-dl); l_reg*=f; if(hi==0)wsf[r32]=f; resc=true; } } \
    SBAR(); \
    if constexpr(DV==64){ \
    GAPB(o[0]=__builtin_amdgcn_mfma_f32_32x32x16_bf16(PAF(0),VFR(0),o[0],0,0,0), C0,0); \
    GAPB(o[1]=__builtin_amdgcn_mfma_f32_32x32x16_bf16(PAF(0),VFR(4),o[1],0,0,0), C0,4); \
    KRD(GL,0); GAPB(o[0]=__builtin_amdgcn_mfma_f32_32x32x16_bf16(PAF(1),VFR(1),o[0],0,0,0), C0,8); \
    KRD(GL,1); GAPB(o[1]=__builtin_amdgcn_mfma_f32_32x32x16_bf16(PAF(1),VFR(5),o[1],0,0,0), C0,12); \
    KRD(GL,2); GAPB(o[0]=__builtin_amdgcn_mfma_f32_32x32x16_bf16(PAF(2),VFR(2),o[0],0,0,0), C1,0); \
    KRD(GL,3); GAPB(o[1]=__builtin_amdgcn_mfma_f32_32x32x16_bf16(PAF(2),VFR(6),o[1],0,0,0), C1,4); \
    GAPB(o[0]=__builtin_amdgcn_mfma_f32_32x32x16_bf16(PAF(3),VFR(3),o[0],0,0,0), C1,8); \
    GAPB(o[1]=__builtin_amdgcn_mfma_f32_32x32x16_bf16(PAF(3),VFR(7),o[1],0,0,0), C1,12); \
    } else { \
    GAPJ(0,PAF(0),C0,0); GAPJ(1,PAF(0),C0,2); GAPJ(2,PAF(0),C0,4); GAPJ(3,PAF(0),C0,6); \
    KRD(GL,0); GAPJ(4,PAF(1),C0,8); GAPJ(5,PAF(1),C0,10); KRD(GL,1); GAPJ(6,PAF(1),C0,12); GAPJ(7,PAF(1),C0,14); \
    KRD(GL,2); GAPJ(8,PAF(2),C1,0); GAPJ(9,PAF(2),C1,2); KRD(GL,3); GAPJ(10,PAF(2),C1,4); GAPJ(11,PAF(2),C1,6); \
    GAPJ(12,PAF(3),C1,8); GAPJ(13,PAF(3),C1,10); GAPJ(14,PAF(3),C1,12); GAPJ(15,PAF(3),C1,14); \
    } \
    }while(0)
  int t=1;
  #undef CMASK
  #define CMASK(P0,P1,t) do{}while(0)
  for(;t+5<NT;t+=2){
    STEP(pB0,pB1,pA0,pA1,t,true,true,true);     if constexpr(DV==128){WAIT_BAR(3);}else{WAIT_BAR(2);} RESC(); ROT();
    STEP(pA0,pA1,pB0,pB1,t+1,true,true,true);   if constexpr(DV==128){WAIT_BAR(3);}else{WAIT_BAR(2);} RESC(); ROT();
  }
  #undef CMASK
  #define CMASK(P0,P1,t) do{int jb_=(t)-(NT-4); if(WINDOW||(CAUSAL&&jb_>=0))cmask<CAUSAL,WINDOW>(P0,P1,jb_,qrel,hi);}while(0)
  #define ENDW(tt) do{ if((tt)+3<NT){ if constexpr(DV==128){WAIT_BAR(3);}else{WAIT_BAR(2);} } else if((tt)+2<NT){ if constexpr(DV==128){WAIT_BAR(2);}else{WAIT_BAR(1);} } else {WAIT_BAR(0);} }while(0)
  for(;t+1<NT;t+=2){
    STEP(pB0,pB1,pA0,pA1,t,(t+3<NT),(t+1<NT),(t+1<NT));       ENDW(t);   RESC(); ROT();
    STEP(pA0,pA1,pB0,pB1,t+1,(t+4<NT),(t+2<NT),(t+2<NT));     ENDW(t+1); RESC(); ROT();
  }
  STEP(pB0,pB1,pA0,pA1,NT-1,false,false,false); RESC();
  { float sacc=pB0[0]+pB0[1]; _Pragma("unroll") for(int r=2;r<16;++r)sacc+=pB0[r]; _Pragma("unroll") for(int r=0;r<16;++r)sacc+=pB1[r]; l_reg+=sacc;
    pw0=(u32x4){PKW(pB0,0),PKW(pB0,2),PKW(pB0,4),PKW(pB0,6)};pw1=(u32x4){PKW(pB0,8),PKW(pB0,10),PKW(pB0,12),PKW(pB0,14)};pw2=(u32x4){PKW(pB1,0),PKW(pB1,2),PKW(pB1,4),PKW(pB1,6)};pw3=(u32x4){PKW(pB1,8),PKW(pB1,10),PKW(pB1,12),PKW(pB1,14)};
    SBAR(); if constexpr(DV==128){pv128(o,vb0+VMUL*sl_cur,PAF(0),PAF(1),PAF(2),PAF(3));}else{pv(o,vb0+sl_cur,PAF(0),PAF(1),PAF(2),PAF(3));} }
  #undef PKW
  #undef PAF
  #undef VFR
  #undef PIN
  #undef MX3
  #undef GAPA
  #undef GAPB
  #undef EX
  #undef VRD
  #undef VRJ
  #undef VFJ
  #undef GAPJ
  #undef KRD
  #undef STEP
  #undef ENDW
  {auto rr=__builtin_amdgcn_permlane32_swap(__float_as_uint(l_reg),__float_as_uint(l_reg),false,false);l_reg=__uint_as_float(rr[0])+__uint_as_float(rr[1]);}
  if(LSE){ if(hi==0)U.lse[(long)(q0+wid*QBLK+r32)*U.lse_stride]=mhat+__builtin_amdgcn_logf(l_reg); }
  if(hi==0)wsf[32+r32]=l_reg;asm volatile("s_waitcnt lgkmcnt(0)":::"memory");
  float rli[16];
  #pragma unroll
  for(int r=0;r<16;++r)rli[r]=__builtin_amdgcn_rcpf(wsf[32+crow(r,hi)]);
  bf16*Ow=U.O+(long)(q0+wid*QBLK)*op;
  { bf16*stg=(bf16*)(shm+LDS_OST)+wid*(2048*VMUL);
    #pragma unroll
    for(int r=0;r<16;++r){const int orow=crow(r,hi);
      #pragma unroll
      for(int d0=0;d0<2*VMUL;++d0)stg[orow*DV+d0*32+r32]=__float2bfloat16(o[d0][r]*rli[r]);}
    asm volatile("s_waitcnt lgkmcnt(0)":::"memory");
    if constexpr(DV==128){
      #pragma unroll
      for(int i=0;i<8;++i){const int row=i*4+(lane>>4),ch=lane&15; const u32x4 v=*(const u32x4*)(stg+row*128+ch*8); ATTN_STORE16(Ow+(long)row*op+ch*8,v);}
    } else {
      #pragma unroll
      for(int i=0;i<4;++i){const int row=i*8+(lane>>3),ch=lane&7; const u32x4 v=*(const u32x4*)(stg+row*64+ch*8); ATTN_STORE16(Ow+(long)row*op+ch*8,v);} } }
  asm volatile("s_waitcnt lgkmcnt(0)\n\ts_barrier":::"memory");
  #undef DMA_K
  #undef DMA_V
  #undef CMASK
  #undef START
  #undef RESC
  #undef ROT
  #undef QX_SET
}
constexpr int ATTN_LDS_BYTES=Lds<128>::BYTES;
#undef SBAR
#undef WAIT_BAR
}
constexpr size_t MiB = 1u << 20;
constexpr size_t WS_CTL = 0, CTL_ZERO_BYTES = 1 * MiB;
constexpr size_t WS_LIST = 1 * MiB;
constexpr size_t WS_RGATE = 5 * MiB;
constexpr size_t WS_RSTD1 = 5 * MiB + 512 * 1024, WS_RSTD2 = WS_RSTD1 + 128 * 1024, WS_WRG = WS_RSTD2 + 128 * 1024;
constexpr size_t WS_WRT = 7 * MiB + 512 * 1024;
constexpr size_t WS_LSE = 6 * MiB;
constexpr size_t WS_MKV = 8 * MiB;
constexpr size_t WS_WIN = 10 * MiB, WS_WOUT = 15 * MiB, WS_WGU = 17 * MiB, WS_WDN = 145 * MiB;
constexpr size_t WS_XB = 209 * MiB;
constexpr size_t WS_LRSTD = 865 * MiB, WS_LGATE = 869 * MiB;
constexpr size_t WS_P = 273 * MiB, WS_OD = 433 * MiB, WS_ODIL = 497 * MiB;
constexpr size_t WS_ACT = 273 * MiB;
constexpr size_t WS_MIX = 545 * MiB, WS_X1B = 609 * MiB, WS_YB = 673 * MiB, WS_X1H = 801 * MiB, WS_Y = 929 * MiB, WS_END = 993 * MiB;
constexpr int CW_TMO = 0, CW_CODE = 1;
constexpr int CW_CNT = 64;
constexpr int CW_NRM = 256;
constexpr int CW_Q = 1024;
constexpr int CW_BAR = 4096;

constexpr int RING_OFF = 0, RING_BYTES = 131072;
constexpr int LDSCTL_OFF = RING_BYTES;
constexpr int IDB_OFF = LDSCTL_OFF;
constexpr int TBL_OFF = IDB_OFF + 9216;
constexpr int LCNT_OFF = TBL_OFF + 2304;
constexpr int MISC_OFF = LCNT_OFF + 256;
constexpr int STG_OFF = IDB_OFF;
constexpr int LDS_BYTES = 147456;
static_assert(MISC_OFF + 128 <= LDS_BYTES && 512 * 16 <= 9216, "LDS map");
constexpr int NWAVES = 8;

#define GAS __attribute__((address_space(1)))
#define LAS __attribute__((address_space(3)))
typedef unsigned short bf16;
typedef unsigned v4u __attribute__((ext_vector_type(4)));
typedef unsigned v2u __attribute__((ext_vector_type(2)));
typedef float f32x4 __attribute__((ext_vector_type(4)));
typedef float f32x16 __attribute__((ext_vector_type(16)));
typedef short bf16x8 __attribute__((ext_vector_type(8)));
typedef GAS unsigned gu32;
#define RLX_AGENT __ATOMIC_RELAXED, __HIP_MEMORY_SCOPE_AGENT
#define LDS_WAIT() asm volatile("s_waitcnt lgkmcnt(0)" ::: "memory")
#define VM_WAIT() asm volatile("s_waitcnt vmcnt(0)" ::: "memory")
__device__ __forceinline__ unsigned f2bf(float f) { unsigned u = __builtin_bit_cast(unsigned, f); return (u + 0x7fffu + ((u >> 16) & 1u)) >> 16; }
__device__ __forceinline__ unsigned pk2(float lo, float hi) { return f2bf(lo) | (f2bf(hi) << 16); }
__device__ __forceinline__ float sat8(float v) { return __builtin_amdgcn_fmed3f(v, -448.f, 448.f); }
__device__ __forceinline__ unsigned fp8x4(float a, float b, float c, float d) { int w = __builtin_amdgcn_cvt_pk_fp8_f32(sat8(a), sat8(b), 0, false); w = __builtin_amdgcn_cvt_pk_fp8_f32(sat8(c), sat8(d), w, true); return (unsigned)w; }
constexpr float WSCALE = 64.f, ASCALE = 8.f, YSCALE = 64.f;
__device__ __forceinline__ float bf2f(unsigned short b) { return __builtin_bit_cast(float, (unsigned)b << 16); }
__device__ __forceinline__ float bflo(unsigned w) { return __builtin_bit_cast(float, w << 16); }
__device__ __forceinline__ float bfhi(unsigned w) { return __builtin_bit_cast(float, w & 0xffff0000u); }
__device__ __forceinline__ float wave_sum(float v) {
#pragma unroll
    for (int o = 1; o < 64; o <<= 1) v += __shfl_xor(v, o);
    return v;
}

#define XB_TMO      128
#define XB_XCNT(j)  (256  + 64 * (j))
#define XB_XSUB(j)  (1280 + 64 * (j))
#define XB_XGEN(j)  (2304 + 64 * (j))
#define XB_TOP      3328
#define XB_TOPGEN   3392
#define XCD_BAR_WORDS 3456
#define XB_SPIN_CAP (1u << 20)
__device__ __forceinline__ unsigned xb_ld(unsigned* p)              { return __hip_atomic_load(p, __ATOMIC_RELAXED, __HIP_MEMORY_SCOPE_AGENT); }
__device__ __forceinline__ unsigned xb_add(unsigned* p, unsigned v) { return __hip_atomic_fetch_add(p, v, __ATOMIC_RELAXED, __HIP_MEMORY_SCOPE_AGENT); }
__device__ __forceinline__ unsigned xb_xcc_id() { return (unsigned)__builtin_amdgcn_s_getreg((3 << 11) | 20) & 0xFu; }
#define XB_SPIN(cond, bar) do { unsigned _sp = 0; while (cond) { __builtin_amdgcn_s_sleep(1); \
    if ((++_sp & 255u) == 0u) { if (xb_ld(&(bar)[XB_TMO])) break; if (_sp > XB_SPIN_CAP) { atomicAdd(&(bar)[XB_TMO], 1u); break; } } } } while (0)
struct XcdBarrier { unsigned* bar; unsigned x; volatile LAS unsigned* st; };
__device__ __forceinline__ XcdBarrier xcd_barrier_post(unsigned* bar, volatile LAS unsigned* st, const bool lead) {
    XcdBarrier b; b.bar = bar; b.x = xb_xcc_id(); b.st = st;
    if (lead) (void)xb_add(&bar[XB_XCNT(b.x)], 1u);
    return b;
}
__device__ __forceinline__ void xcd_barrier_complete(unsigned* bar, unsigned x, unsigned& nloc, unsigned& nx) {
    const unsigned G = gridDim.x * gridDim.y * gridDim.z;
    unsigned sum, cnt, mine, sp = 0u;
    for (;;) {
        sum = 0u; cnt = 0u; mine = 0u;
#pragma unroll
        for (unsigned j = 0; j < 16; ++j) { const unsigned c = xb_ld(&bar[XB_XCNT(j)]); sum += c; cnt += (c > 0u) ? 1u : 0u; mine = (j == x) ? c : mine; }
        if (sum == G) break;
        __builtin_amdgcn_s_sleep(1);
        if ((++sp & 255u) == 0u) { if (xb_ld(&bar[XB_TMO])) break; if (sp > XB_SPIN_CAP) { atomicAdd(&bar[XB_TMO], 1u); break; } }
    }
    nloc = mine > 0u ? mine : 1u; nx = cnt > 0u ? cnt : 1u;
}
__device__ __forceinline__ void xcd_barrier(const XcdBarrier& b, const bool lead) {
    asm volatile("s_waitcnt vmcnt(0)" ::: "memory");
    __syncthreads();
    if (lead) {
        unsigned* bar = b.bar;
        __builtin_amdgcn_s_waitcnt(0);
        unsigned nloc = b.st[0], nx = b.st[1];
        if (nloc == 0u) { xcd_barrier_complete(bar, b.x, nloc, nx); b.st[0] = nloc; b.st[1] = nx; }
        const unsigned old = xb_add(&bar[XB_XSUB(b.x)], 1u);
        const unsigned gen = old / nloc;
        if (old + 1u == (gen + 1u) * nloc) {
            __builtin_amdgcn_fence(__ATOMIC_RELEASE, "agent");
            asm volatile("s_waitcnt vmcnt(0)" ::: "memory");
            const unsigned og = xb_add(&bar[XB_TOP], 1u);
            const unsigned tg = og / nx;
            if (og + 1u == (tg + 1u) * nx) xb_add(&bar[XB_TOPGEN], 1u);
            else XB_SPIN(xb_ld(&bar[XB_TOPGEN]) == tg, bar);
            __builtin_amdgcn_fence(__ATOMIC_ACQUIRE, "agent");
            xb_add(&bar[XB_XGEN(b.x)], 1u);
            asm volatile("s_waitcnt vmcnt(0)" ::: "memory");
        } else {
            XB_SPIN(xb_ld(&bar[XB_XGEN(b.x)]) == gen, bar);
            __builtin_amdgcn_fence(__ATOMIC_ACQUIRE, "agent");
            asm volatile("s_waitcnt vmcnt(0)" ::: "memory");
        }
    }
    __syncthreads();
}

struct Frame {
    LAS unsigned char* lds;
    volatile LAS unsigned* MISC;
    gu32* ctl;
    int tid, lane, wave;
    int vcu, G;
    const float *x, *mem, *g_attn, *g_mem, *w_in, *lamqk, *subg, *w_mkv, *w_out, *g_ffn, *w_r, *b_r, *w_gu, *b_gu, *w_dn, *b_dn, *g_fin;
    float* out; unsigned char* ws;
};

#define P0_LOAD(dst, itm) do { const int m_ = (itm) / ipm, r_ = (itm) % ipm, kb_ = r_ / nblk, nb_ = r_ % nblk; \
        const float* src_ = W + (size_t)m_ * K * N + (size_t)(64 * kb_ + (lane >> 5)) * N + 32 * nb_ + (lane & 31); \
        _Pragma("unroll") for (int i_ = 0; i_ < 32; ++i_) dst[i_] = src_[(size_t)(2 * i_) * N]; } while (0)
template <bool F8, bool GAIN, class RowMap>
__device__ __forceinline__ void p0_transpose_all(const float* W, int K, int N, int nmat, void* WTv, const float* gk, float wscale, LAS float* scr, int gw, int NGW, int lane, RowMap rowmap) {
    asm volatile("" : "+v"(lane));
    const int nblk = N / 32, ipm = (K / 64) * nblk, total = nmat * ipm;
    if (gw >= total) return;
    LAS float* gl = scr + 64 * 33;
    if constexpr (GAIN) { for (int i = lane; i < K; i += 64) gl[i] = gk[i] * wscale; LDS_WAIT(); asm volatile("" ::: "memory"); }
#define P0_PROC(v, itm) do { const int m = (itm) / ipm, r = (itm) % ipm, k0 = 64 * (r / nblk), n0 = 32 * (r % nblk); \
        if constexpr (GAIN) { _Pragma("unroll") for (int i = 0; i < 32; ++i) v[i] *= gl[k0 + 2 * i + (lane >> 5)]; } \
        else if (F8) { _Pragma("unroll") for (int i = 0; i < 32; ++i) v[i] *= wscale; } \
        _Pragma("unroll") for (int i = 0; i < 32; ++i) scr[(2 * i + (lane >> 5)) * 33 + (lane & 31)] = v[i]; \
        LDS_WAIT(); asm volatile("" ::: "memory"); \
        const int c = lane & 7; \
        _Pragma("unroll") for (int j = 0; j < 4; ++j) { const int n = (lane >> 3) + 8 * j; const LAS float* s = scr + (8 * c) * 33 + n; \
            if constexpr (F8) { unsigned char* wt = (unsigned char*)WTv + (size_t)m * N * K; \
                v2u o; o.x = fp8x4(s[0 * 33], s[1 * 33], s[2 * 33], s[3 * 33]); o.y = fp8x4(s[4 * 33], s[5 * 33], s[6 * 33], s[7 * 33]); \
                *(GAS v2u*)(wt + (size_t)rowmap(n0 + n) * K + k0 + 8 * c) = o; } \
            else { bf16* wt = (bf16*)WTv + (size_t)m * N * K; \
                v4u o; o.x = pk2(s[0 * 33], s[1 * 33]); o.y = pk2(s[2 * 33], s[3 * 33]); o.z = pk2(s[4 * 33], s[5 * 33]); o.w = pk2(s[6 * 33], s[7 * 33]); \
                *(GAS v4u*)(wt + (size_t)rowmap(n0 + n) * K + k0 + 8 * c) = o; } } \
        LDS_WAIT(); asm volatile("" ::: "memory"); } while (0)
    float va[32], vb[32], vc[32];
    int it = gw;
    P0_LOAD(va, it); if (it + NGW < total) P0_LOAD(vb, it + NGW);
    for (;;) {
        if (it + 2 * NGW < total) P0_LOAD(vc, it + 2 * NGW);
        P0_PROC(va, it); it += NGW; if (it >= total) break;
        if (it + 2 * NGW < total) P0_LOAD(va, it + 2 * NGW);
        P0_PROC(vb, it); it += NGW; if (it >= total) break;
        if (it + 2 * NGW < total) P0_LOAD(vb, it + 2 * NGW);
        P0_PROC(vc, it); it += NGW; if (it >= total) break;
    }
#undef P0_PROC
}
#undef P0_LOAD
struct RowId { __device__ __forceinline__ int operator()(int n) const { return n; } };
struct RowGU { __device__ __forceinline__ int operator()(int n) const { const int f = n >> 1, u = n & 1; return ((f >> 7) << 8) + (u << 7) + (f & 127); } };

__device__ __forceinline__ void p0_x_rows4(Frame& F, const float* xrow, bf16* orow, float* rstd_out) {
    const GAS f32x4* xr = (const GAS f32x4*)xrow + F.lane;
    f32x4 v[16]; float s[4] = {0.f, 0.f, 0.f, 0.f};
#pragma unroll
    for (int j = 0; j < 16; ++j) v[j] = xr[64 * j];
#pragma unroll
    for (int j = 0; j < 16; ++j) s[j >> 2] += (v[j].x * v[j].x + v[j].y * v[j].y) + (v[j].z * v[j].z + v[j].w * v[j].w);
    GAS unsigned long long* o8 = (GAS unsigned long long*)orow + F.lane;
#pragma unroll
    for (int j = 0; j < 16; ++j) o8[64 * j] = (unsigned long long)pk2(v[j].x, v[j].y) | ((unsigned long long)pk2(v[j].z, v[j].w) << 32);
#pragma unroll
    for (int q = 0; q < 4; ++q) s[q] = wave_sum(s[q]);
    if (F.lane < 4) rstd_out[F.lane] = 1.f / sqrtf((F.lane == 0 ? s[0] : F.lane == 1 ? s[1] : F.lane == 2 ? s[2] : s[3]) * (1.f / D) + EPS);
}
__device__ __forceinline__ void p0_mkv_tile(Frame& F, int tile, bf16* mkv, const float* xsrc, bf16* xdst, float* rstd_out, int xstep) {
    const int mt = tile >> 4, nt = tile & 15, m0 = 32 * mt, n0 = 32 * nt, r = F.lane & 31, h = F.lane >> 5, kh = F.wave >> 2, tw = F.wave & 3;
    f32x16 acc = {}; float ss = 0.f;
    LAS float* blk = (LAS float*)(F.lds + RING_OFF + F.wave * 12288);
    LAS float* gl = (LAS float*)(F.lds + RING_OFF + 98304);
    for (int i = F.tid; i < D; i += NWAVES * 64) gl[i] = F.g_mem[i];
    __syncthreads();
    const float* msrc = F.mem + (size_t)(m0 + (F.lane >> 4)) * D + kh * 512 + 4 * (F.lane & 15);
    const float* wcol = F.w_mkv + (size_t)(8 * h + kh * 512) * 512 + n0 + r;
    f32x4 ma[8], mb[8]; float wa[32], wb[32];
#define MKV_LD(M, W, kk_) do { _Pragma("unroll") for (int i_ = 0; i_ < 8; ++i_) M[i_] = *(const f32x4*)(msrc + (size_t)(4 * i_) * D + (kk_)); \
        _Pragma("unroll") for (int s_ = 0; s_ < 4; ++s_) _Pragma("unroll") for (int j_ = 0; j_ < 8; ++j_) W[8 * s_ + j_] = wcol[(size_t)((kk_) + 16 * s_ + j_) * 512]; } while (0)
#define MKV_MM(M, W, kk_) do { _Pragma("unroll") for (int i_ = 0; i_ < 8; ++i_) *(LAS f32x4*)(blk + (4 * i_ + (F.lane >> 4)) * 68 + 4 * (F.lane & 15)) = M[i_]; \
        LDS_WAIT(); asm volatile("" ::: "memory"); \
        _Pragma("unroll") for (int s_ = 0; s_ < 4; ++s_) { const LAS float* ap_ = blk + r * 68 + 16 * s_ + 8 * h; const LAS float* gq_ = gl + kh * 512 + (kk_) + 16 * s_ + 8 * h; \
            const f32x4 a0 = *(const LAS f32x4*)ap_, a1 = *(const LAS f32x4*)(ap_ + 4), g0 = *(const LAS f32x4*)gq_, g1 = *(const LAS f32x4*)(gq_ + 4); \
            ss += (a0.x * a0.x + a0.y * a0.y) + (a0.z * a0.z + a0.w * a0.w) + (a1.x * a1.x + a1.y * a1.y) + (a1.z * a1.z + a1.w * a1.w); \
            v4u bw_; bw_.x = pk2(a0.x * g0.x, a0.y * g0.y); bw_.y = pk2(a0.z * g0.z, a0.w * g0.w); bw_.z = pk2(a1.x * g1.x, a1.y * g1.y); bw_.w = pk2(a1.z * g1.z, a1.w * g1.w); \
            v4u aw_; aw_.x = pk2(W[8 * s_], W[8 * s_ + 1]); aw_.y = pk2(W[8 * s_ + 2], W[8 * s_ + 3]); aw_.z = pk2(W[8 * s_ + 4], W[8 * s_ + 5]); aw_.w = pk2(W[8 * s_ + 6], W[8 * s_ + 7]); \
            acc = __builtin_amdgcn_mfma_f32_32x32x16_bf16(__builtin_bit_cast(bf16x8, aw_), __builtin_bit_cast(bf16x8, bw_), acc, 0, 0, 0); } \
        LDS_WAIT(); asm volatile("" ::: "memory"); } while (0)
    f32x4 xv[8];
#define X_LD(m_) do { const GAS f32x4* xr_ = (const GAS f32x4*)(xsrc + (size_t)(m_) * D) + F.lane; _Pragma("unroll") for (int j_ = 0; j_ < 8; ++j_) xv[j_] = xr_[64 * j_]; } while (0)
#define X_PROC(m_) do { float s0_ = 0.f, s1_ = 0.f; \
        _Pragma("unroll") for (int j_ = 0; j_ < 4; ++j_) { s0_ += (xv[j_].x * xv[j_].x + xv[j_].y * xv[j_].y) + (xv[j_].z * xv[j_].z + xv[j_].w * xv[j_].w); \
            s1_ += (xv[4 + j_].x * xv[4 + j_].x + xv[4 + j_].y * xv[4 + j_].y) + (xv[4 + j_].z * xv[4 + j_].z + xv[4 + j_].w * xv[4 + j_].w); } \
        GAS unsigned long long* o8_ = (GAS unsigned long long*)(xdst + (size_t)(m_) * D) + F.lane; \
        _Pragma("unroll") for (int j_ = 0; j_ < 8; ++j_) o8_[64 * j_] = (unsigned long long)pk2(xv[j_].x, xv[j_].y) | ((unsigned long long)pk2(xv[j_].z, xv[j_].w) << 32); \
        s0_ = wave_sum(s0_); s1_ = wave_sum(s1_); \
        if (F.lane < 2) rstd_out[(m_) + F.lane] = 1.f / sqrtf((F.lane == 0 ? s0_ : s1_) * (1.f / D) + EPS); } while (0)
    MKV_LD(ma, wa, 0);
    int xm = 0;
#pragma nounroll
    for (int kk = 0; kk < 512; kk += 128) {
        X_LD(xm); __builtin_amdgcn_sched_barrier(0);
        MKV_LD(mb, wb, kk + 64); MKV_MM(ma, wa, kk); __builtin_amdgcn_sched_barrier(0);
        X_PROC(xm); X_LD(xm + 2); __builtin_amdgcn_sched_barrier(0);
        MKV_LD(ma, wa, min(kk + 128, 448)); MKV_MM(mb, wb, kk + 64); __builtin_amdgcn_sched_barrier(0);
        X_PROC(xm + 2); xm += xstep;
    }
#undef X_LD
#undef X_PROC
#undef MKV_LD
#undef MKV_MM
    LAS float* xc = (LAS float*)(F.lds + RING_OFF + 8 * 16384 - 4 * 64 * 17 * 4) + (tw * 64 + F.lane) * 17;
    if (kh == 1) {
#pragma unroll
        for (int i = 0; i < 16; ++i) xc[i] = acc[i];
        xc[16] = ss; }
    __syncthreads();
    if (kh == 0) {
#pragma unroll
        for (int i = 0; i < 16; ++i) acc[i] += xc[i];
        ss += xc[16]; ss += __shfl_xor(ss, 32);
        const float rstd = 1.f / sqrtf(ss * (1.f / D) + EPS);
        bf16* orow = mkv + (size_t)(m0 + r) * 512 + n0 + 4 * h;
#pragma unroll
        for (int q = 0; q < 4; ++q) { v2u o; o.x = pk2(acc[4 * q] * rstd, acc[4 * q + 1] * rstd); o.y = pk2(acc[4 * q + 2] * rstd, acc[4 * q + 3] * rstd); *(GAS v2u*)(orow + 8 * q) = o; }
    }
    __syncthreads();
}
__device__ __forceinline__ void p0_prologue(Frame& F) {
    LAS float* scr = (LAS float*)(F.lds + RING_OFF + F.wave * 16384);
    const int gw = F.vcu * NWAVES + F.wave, NGW = F.G * NWAVES;
    bf16* win_t = (bf16*)(F.ws + WS_WIN); bf16* wout_t = (bf16*)(F.ws + WS_WOUT);
    bf16* xb = (bf16*)(F.ws + WS_XB); float* rstd1 = (float*)(F.ws + WS_RSTD1);
    p0_mkv_tile(F, (F.wave & 3) * 256 + F.vcu, (bf16*)(F.ws + WS_MKV), F.x + (size_t)(4 * gw) * D, xb + (size_t)(4 * gw) * D, rstd1 + 4 * gw, 4 * NGW);
    bf16* wrt = (bf16*)(F.ws + WS_WRT);
    if (gw < 1280) p0_transpose_all<false, true>(F.w_in, D, DIN, 1, win_t, F.g_attn, 1.f, scr, gw, NGW, F.lane, RowId());
    else if (gw < 1792) p0_transpose_all<false, false>(F.w_out, D, D, 1, wout_t, nullptr, 1.f, scr, gw - 1280, NGW, F.lane, RowId());
    else for (int i = (gw - 1792) * 64 + F.lane; i < D * NE; i += 256 * 64) { const int e = i >> 10, k = i & 1023; const float w = F.w_r[k * NE + e] * F.g_ffn[k]; const unsigned hb = f2bf(w); wrt[i] = (bf16)hb; wrt[D * NE + i] = (bf16)f2bf(w - bf2f((bf16)hb)); }
}

constexpr int NCONV = 8, NCONV_ALL = 8 * NCONV;
__device__ __forceinline__ void p0b_unit(Frame& F, int c) {
    LAS float* scr = (LAS float*)(F.lds + RING_OFF + F.wave * 16384);
    p0_transpose_all<true, true>(F.w_gu, D, 2 * DFF, NE, (void*)(F.ws + WS_WGU), F.g_ffn, WSCALE, scr, c * NWAVES + F.wave, NCONV_ALL * NWAVES, F.lane, RowGU());
    p0_transpose_all<true, false>(F.w_dn, DFF, D, NE, (void*)(F.ws + WS_WDN), nullptr, WSCALE, scr, c * NWAVES + F.wave, NCONV_ALL * NWAVES, F.lane, RowId());
    __syncthreads();
}

struct EpiInProj {
    bf16* O; const float* rstd; unsigned* nrm;
    __device__ __forceinline__ void operator()(const pg8::f32x4 (&acc)[2][2][4][2], const pg8::Unit& u, int wr, int wc, int fr, int fq, const LAS unsigned* ids) const {
        asm volatile("" : "+v"(fr), "+v"(fq));
        const int row0 = u.pm * 256 + wr * 64 + fr, col0 = u.pn * 256 + wc * 32 + 8 * fq;
        const float sc = (u.pn <= 1 || u.pn == 6 || u.pn == 9) ? QSCALE : 1.f;
        const LAS float* scl = (const LAS float*)(ids + 256);
        float rsv[2][4];
#pragma unroll
        for (int ai = 0; ai < 2; ++ai)
#pragma unroll
            for (int m = 0; m < 4; ++m) rsv[ai][m] = scl[wr * 64 + fr + ai * 128 + m * 16];
#pragma unroll
        for (int ai = 0; ai < 2; ++ai)
#pragma unroll
            for (int m = 0; m < 4; ++m) { const int row = row0 + ai * 128 + m * 16; const float rs = rsv[ai][m] * sc; bf16* rowp = O + (size_t)row * DIN + col0;
#pragma unroll
                for (int bj = 0; bj < 2; ++bj) { const pg8::f32x4 v0 = acc[ai][bj][m][0] * rs, v1 = acc[ai][bj][m][1] * rs;
                    v4u w; w.x = pg8::cvt_pk_bf16(v0[0], v0[1]); w.y = pg8::cvt_pk_bf16(v0[2], v0[3]); w.z = pg8::cvt_pk_bf16(v1[0], v1[1]); w.w = pg8::cvt_pk_bf16(v1[2], v1[3]);
                    *(v4u*)(rowp + bj * 128) = w; } }
        if (u.pn < 4) {
#pragma unroll
            for (int bj = 0; bj < 2; ++bj) { float mx = 0.f;
#pragma unroll
                for (int ai = 0; ai < 2; ++ai)
#pragma unroll
                    for (int m = 0; m < 4; ++m) { const float rs = rsv[ai][m] * sc; const pg8::f32x4 v0 = acc[ai][bj][m][0] * rs, v1 = acc[ai][bj][m][1] * rs;
                        float s = (v0[0] * v0[0] + v0[1] * v0[1]) + (v0[2] * v0[2] + v0[3] * v0[3]) + (v1[0] * v1[0] + v1[1] * v1[1]) + (v1[2] * v1[2] + v1[3] * v1[3]);
                        s += __shfl_xor(s, 16); s += __shfl_xor(s, 32); mx = fmaxf(mx, s); }
#pragma unroll
                for (int o = 1; o < 16; o <<= 1) mx = fmaxf(mx, __shfl_xor(mx, o));
                if ((fr | fq) == 0) atomicMax(nrm + (((u.pm >> 4) * 4 + u.pn) * 4 + 2 * bj + (wc >> 1)) * 2 + (wc & 1), __builtin_bit_cast(unsigned, mx)); }
        }
    }
};
__device__ __forceinline__ void attn_phase(Frame& F, char* shm, int qoff = 0, int gmask = 7) {
    using namespace attn_body;
    const attn_body::bf16* P = (const attn_body::bf16*)(F.ws + WS_P);
    attn_body::bf16* OD = (attn_body::bf16*)(F.ws + WS_OD);
    attn_body::bf16* mix = (attn_body::bf16*)(F.ws + WS_MIX);
    attn_body::bf16* ODIL = (attn_body::bf16*)(F.ws + WS_ODIL); float* LSEb = (float*)(F.ws + WS_LSE);
    const attn_body::bf16* MKV = (const attn_body::bf16*)(F.ws + WS_MKV);
    const float* nrm = (const float*)(F.ctl + CW_NRM);
    const int grp = (int)blockIdx.x & 7, b = grp;
    unsigned* qctr = (unsigned*)(F.ctl + CW_Q + qoff) + 64 * grp;
    const attn_body::bf16* Pb = P + (size_t)b * SEQ * DIN;
#define ATTN_LEAD() ({ int t_ = (int)threadIdx.x; asm volatile("" : "+v"(t_)); t_ == 0; })
    unsigned nxt_tok = 0u;
    if (ATTN_LEAD()) nxt_tok = __hip_atomic_fetch_add(qctr, 1u, __ATOMIC_RELAXED, __HIP_MEMORY_SCOPE_AGENT);
    for (;;) {
        if (ATTN_LEAD()) F.MISC[20] = nxt_tok;
        __syncthreads();
        int un = (int)F.MISC[20];
        __syncthreads();
        if (ATTN_LEAD() && un < NCONV + 384) nxt_tok = __hip_atomic_fetch_add(qctr, 1u, __ATOMIC_RELAXED, __HIP_MEMORY_SCOPE_AGENT);
        if (un < NCONV) { if (gmask == 7) p0b_unit(F, grp * NCONV + un); continue; }
        un -= NCONV;
        if (un >= 384) break;
        if (un < 128) {
            if (!(gmask & 1)) continue;
            const int qb = 15 - (un >> 3), h = 3 - ((un >> 1) & 3), j = un & 1;
            const float slope2 = exp2f(-(float)(2 * h + 1)) * LOG2E;
            const int ni = ((b * 4 + (h >> 1)) * 4 + 2 * (h & 1) + j) * 2;
            const float R = sqrtf((nrm[ni] + nrm[ni + 1]) * (nrm[ni + 16] + nrm[ni + 17])) * 1.01f;
            const float kfirst = (float)(qb * 256) - (2.f * R + 160.f) / slope2;
            int t0 = kfirst > 0.f ? (int)(kfirst * (1.f / 64.f)) : 0; t0 = min(t0, 4 * qb); t0 &= ~1;
            UnitP U; U.Q = Pb + C_DQ + h * 128 + j * 64; U.K = Pb + C_DK + h * 128 + j * 64; U.V = Pb + C_DV + h * 128;
            U.O = OD + (size_t)b * SEQ * 1024 + h * 256 + j * 128; U.qp = DIN; U.kp = DIN; U.op = 1024;
            U.q0 = qb * 256; U.t0 = t0; U.NT = 4 * qb + 4 - t0; U.slope2 = slope2; U.lse = nullptr; U.lse_stride = 0;
            attn_unit<32, true, false, true, false, 128>(U, shm);
        } else if (un < 320) {
            if (!(gmask & 2)) continue;
            const int du = un - 128, h = du / 48, idx = du % 48, n = idx >> 4, w = idx & 15;
            const int r = (n == 0) ? 1 : (n == 1 ? 4 : 16), c = (n == 0) ? 0 : (n == 1 ? (w >> 2) : w), blk = (n == 0) ? w : (n == 1 ? (w & 3) : 0);
            const attn_body::bf16* Pc = Pb + (size_t)c * DIN;
            UnitP U; U.Q = Pc + C_LQ + h * 64; U.K = Pc + C_LK + h * 64; U.V = Pc + C_LV + h * 64; U.qp = (long)r * DIN; U.kp = (long)r * DIN;
            U.O = ODIL + (size_t)n * T * 256 + ((size_t)b * SEQ + c) * 256 + h * 64; U.op = (long)r * 256;
            U.q0 = blk * 256; U.t0 = (blk == 0) ? 0 : 4 * blk - 2; U.NT = 4 * blk + 4 - U.t0;
            U.slope2 = exp2f(-(float)(2 * h + 2)) * (float)r * LOG2E;
            U.lse = LSEb + (size_t)n * T * 4 + ((size_t)b * SEQ + c) * 4 + h; U.lse_stride = r * 4;
            attn_unit<32, true, true, true, true>(U, shm);
        } else {
            if (!(gmask & 4)) continue;
            const int mu = un - 320, h = mu >> 4, qb = mu & 15;
            UnitP U; U.Q = Pb + C_MQ + h * 64; U.qp = DIN; U.K = MKV + (size_t)b * NMEM * 512 + h * 64; U.V = U.K + 256; U.kp = 512;
            U.O = mix + (size_t)b * SEQ * 1024 + 768 + h * 64; U.op = 1024; U.q0 = qb * 256; U.t0 = 0; U.NT = 4; U.slope2 = 0.f; U.lse = nullptr; U.lse_stride = 0;
            attn_unit<8, false, false, false, false>(U, shm);
        }
    }
}
#undef ATTN_LEAD
__device__ __forceinline__ void dil_combine_phase(Frame& F) {
    const int gw = F.vcu * NWAVES + F.wave, NGW = F.G * NWAVES;
    const bf16* OD = (const bf16*)(F.ws + WS_OD); const bf16* ODIL = (const bf16*)(F.ws + WS_ODIL); const float* LSEb = (const float*)(F.ws + WS_LSE); bf16* mix = (bf16*)(F.ws + WS_MIX);
    const int h = F.lane >> 4, pt = F.lane & 15, d4 = pt * 4;
    float lam;
    { const float a = F.lamqk[F.lane] * F.lamqk[64 + F.lane], c = F.lamqk[128 + F.lane] * F.lamqk[192 + F.lane];
      lam = __expf(wave_sum(a)) - __expf(wave_sum(c)) + 0.2f; }
    float gsub[8];
#pragma unroll
    for (int i = 0; i < 8; ++i) gsub[i] = F.subg[pt * 8 + i] * 0.8f;
    for (int row0 = 4 * gw; row0 < T; row0 += 4 * NGW) {
        float l[4][3]; v2u q[4][3]; v4u o1[4], o2[4];
#pragma unroll
        for (int i = 0; i < 4; ++i) {
            o1[i] = *(const v4u*)(OD + (size_t)(row0 + i) * 1024 + h * 256 + pt * 8); o2[i] = *(const v4u*)(OD + (size_t)(row0 + i) * 1024 + h * 256 + 128 + pt * 8);
#pragma unroll
            for (int n = 0; n < 3; ++n) { l[i][n] = LSEb[(size_t)n * T * 4 + (size_t)(row0 + i) * 4 + h]; q[i][n] = *(const v2u*)(ODIL + (size_t)n * T * 256 + (size_t)(row0 + i) * 256 + h * 64 + d4); } }
#pragma unroll
        for (int i = 0; i < 4; ++i) {
            const unsigned aw[4] = {o1[i].x, o1[i].y, o1[i].z, o1[i].w}, bw[4] = {o2[i].x, o2[i].y, o2[i].z, o2[i].w};
            float d[8], ss = 0.f;
#pragma unroll
            for (int c = 0; c < 4; ++c) { d[2 * c] = bflo(aw[c]) - lam * bflo(bw[c]); d[2 * c + 1] = bfhi(aw[c]) - lam * bfhi(bw[c]); ss += d[2 * c] * d[2 * c] + d[2 * c + 1] * d[2 * c + 1]; }
#pragma unroll
            for (int o = 1; o < 16; o <<= 1) ss += __shfl_xor(ss, o);
            const float rstd = 1.f / sqrtf(ss * (1.f / 128.f) + EPS);
            v4u od; od.x = pk2(d[0] * rstd * gsub[0], d[1] * rstd * gsub[1]); od.y = pk2(d[2] * rstd * gsub[2], d[3] * rstd * gsub[3]); od.z = pk2(d[4] * rstd * gsub[4], d[5] * rstd * gsub[5]); od.w = pk2(d[6] * rstd * gsub[6], d[7] * rstd * gsub[7]);
            *(v4u*)(mix + (size_t)(row0 + i) * 1024 + h * 128 + pt * 8) = od;
            const float m = fmaxf(fmaxf(l[i][0], l[i][1]), l[i][2]);
            float wn[3], den = 0.f;
#pragma unroll
            for (int n = 0; n < 3; ++n) { wn[n] = exp2f(l[i][n] - m); den += wn[n]; }
            const float inv = 1.f / den; float o[4] = {0.f, 0.f, 0.f, 0.f};
#pragma unroll
            for (int n = 0; n < 3; ++n) { const float wq = wn[n] * inv; o[0] += wq * bflo(q[i][n].x); o[1] += wq * bfhi(q[i][n].x); o[2] += wq * bflo(q[i][n].y); o[3] += wq * bfhi(q[i][n].y); }
            v2u ov; ov.x = pk2(o[0], o[1]); ov.y = pk2(o[2], o[3]);
            *(v2u*)(mix + (size_t)(row0 + i) * 1024 + 512 + h * 64 + d4) = ov;
        }
    }
}
struct EpiY {
    bf16* Y;
    __device__ __forceinline__ void operator()(const pg8::f32x4 (&acc)[2][2][4][2], const pg8::Unit& u, int wr, int wc, int fr, int fq, const LAS unsigned*) const {
        asm volatile("" : "+v"(fr), "+v"(fq));
        const int row0 = u.pm * 256 + wr * 64 + fr, col0 = u.pn * 256 + wc * 32 + 8 * fq;
#pragma unroll
        for (int ai = 0; ai < 2; ++ai)
#pragma unroll
            for (int m = 0; m < 4; ++m) { bf16* rowp = Y + (size_t)(row0 + ai * 128 + m * 16) * D + col0;
#pragma unroll
                for (int bj = 0; bj < 2; ++bj) { const pg8::f32x4 v0 = acc[ai][bj][m][0], v1 = acc[ai][bj][m][1];
                    v4u w; w.x = pg8::cvt_pk_bf16(v0[0], v0[1]); w.y = pg8::cvt_pk_bf16(v0[2], v0[3]); w.z = pg8::cvt_pk_bf16(v1[0], v1[1]); w.w = pg8::cvt_pk_bf16(v1[2], v1[3]);
                    *(v4u*)(rowp + bj * 128) = w; } }
    }
};

__device__ __forceinline__ void route_phase(Frame& F) {
    LAS char* XH = (LAS char*)(F.lds + RING_OFF); LAS char* XL = XH + 32768; LAS char* WH = XH + 65536; LAS char* WL = XH + 73728;
    LAS float* xch = (LAS float*)(XH + 81920);
    LAS float* ssl = (LAS float*)(XH + 81920 + 17408);
    LAS unsigned* lcnt = (LAS unsigned*)(F.lds + LCNT_OFF);
    LAS unsigned* stg = (LAS unsigned*)(F.lds + STG_OFF);
    if (F.tid < 64) lcnt[F.tid] = 0u;
    const int lane = F.lane, tl = lane & 31, h = lane >> 5, tg = F.wave & 3, kh = F.wave >> 2;
    const int srow = F.tid >> 5, k4 = (F.tid & 31) * 4, T0 = F.vcu * 128;
    const bf16* xg = (const bf16*)(F.ws + WS_XB) + (size_t)(T0 + srow) * D + k4;
    const bf16* yg = (const bf16*)(F.ws + WS_Y) + (size_t)(T0 + srow) * D + k4;
    unsigned char* x1q = (unsigned char*)(F.ws + WS_X1B) + (size_t)(T0 + srow) * D + k4;
    bf16* x1h = (bf16*)(F.ws + WS_X1H) + (size_t)(T0 + srow) * D + k4;
    const bf16* wsrc = (const bf16*)(F.ws + WS_WRT);
    v2u xv[8]; v2u yv[8]; v4u wv[2]; float ssr[8];
#pragma unroll
    for (int i = 0; i < 8; ++i) ssr[i] = 0.f;
#define RT_LOAD(kc) do { _Pragma("unroll") for (int i_ = 0; i_ < 8; ++i_) { xv[i_] = *(const v2u*)(xg + (size_t)(16 * i_) * D + 128 * (kc)); yv[i_] = *(const v2u*)(yg + (size_t)(16 * i_) * D + 128 * (kc)); } \
        _Pragma("unroll") for (int j_ = 0; j_ < 2; ++j_) { const int idx_ = F.tid + 512 * j_; wv[j_] = *(const v4u*)(wsrc + (idx_ >> 9) * 32768 + ((idx_ >> 4) & 31) * 1024 + 128 * (kc) + (idx_ & 15) * 8); } } while (0)
    f32x16 acc = {};
    RT_LOAD(0);
    for (int kc = 0; kc < 8; ++kc) {
#pragma unroll
        for (int i = 0; i < 8; ++i) {
            const float x0 = bflo(xv[i].x) + bflo(yv[i].x), x1 = bfhi(xv[i].x) + bfhi(yv[i].x), x2 = bflo(xv[i].y) + bflo(yv[i].y), x3 = bfhi(xv[i].y) + bfhi(yv[i].y);
            ssr[i] += (x0 * x0 + x1 * x1) + (x2 * x2 + x3 * x3);
            const unsigned h0 = pk2(x0, x1), h1 = pk2(x2, x3), l0 = pk2(x0 - bflo(h0), x1 - bfhi(h0)), l1 = pk2(x2 - bflo(h1), x3 - bfhi(h1));
            *(unsigned*)(x1q + (size_t)(16 * i) * D + 128 * kc) = fp8x4(x0, x1, x2, x3);
            *(v2u*)(x1h + (size_t)(16 * i) * D + 128 * kc) = (v2u){h0, h1};
            const int row = srow + 16 * i, off = row * 256 + (((k4 >> 3) ^ (row & 15)) << 4) + (k4 & 4) * 2;
            *(LAS v2u*)(XH + off) = (v2u){h0, h1}; *(LAS v2u*)(XL + off) = (v2u){l0, l1};
        }
#pragma unroll
        for (int j = 0; j < 2; ++j) { const int idx = F.tid + 512 * j, e = (idx >> 4) & 31, c = idx & 15; *(LAS v4u*)(((idx >> 9) ? WL : WH) + e * 256 + ((c ^ (e & 15)) << 4)) = wv[j]; }
        __syncthreads();
        if (kc < 7) RT_LOAD(kc + 1);
#pragma unroll
        for (int s = 0; s < 4; ++s) { const int c16 = 2 * (4 * kh + s) + h, tr = tg * 32 + tl;
            const v4u xh = *(const LAS v4u*)(XH + tr * 256 + ((c16 ^ (tr & 15)) << 4)), xl = *(const LAS v4u*)(XL + tr * 256 + ((c16 ^ (tr & 15)) << 4));
            const v4u wh = *(const LAS v4u*)(WH + tl * 256 + ((c16 ^ (tl & 15)) << 4)), wl2 = *(const LAS v4u*)(WL + tl * 256 + ((c16 ^ (tl & 15)) << 4));
            acc = __builtin_amdgcn_mfma_f32_32x32x16_bf16(__builtin_bit_cast(bf16x8, wh), __builtin_bit_cast(bf16x8, xh), acc, 0, 0, 0);
            acc = __builtin_amdgcn_mfma_f32_32x32x16_bf16(__builtin_bit_cast(bf16x8, wh), __builtin_bit_cast(bf16x8, xl), acc, 0, 0, 0);
            acc = __builtin_amdgcn_mfma_f32_32x32x16_bf16(__builtin_bit_cast(bf16x8, wl2), __builtin_bit_cast(bf16x8, xh), acc, 0, 0, 0); }
        __syncthreads();
    }
#undef RT_LOAD
#pragma unroll
    for (int i = 0; i < 8; ++i) { float s = ssr[i];
#pragma unroll
        for (int o = 1; o < 32; o <<= 1) s += __shfl_xor(s, o);
        if ((F.tid & 31) == 0) ssl[srow + 16 * i] = s; }
    const int tok = T0 + tg * 32 + tl; float ss = 0.f;
    if (kh == 1) { LAS float* d = xch + (tg * 64 + lane) * 17;
#pragma unroll
        for (int i = 0; i < 16; ++i) d[i] = acc[i];
        d[16] = ss; }
    __syncthreads();
    if (kh == 0) {
        const LAS float* d = xch + (tg * 64 + lane) * 17;
#pragma unroll
        for (int i = 0; i < 16; ++i) acc[i] += d[i];
        ss = ssl[tg * 32 + tl];
        const float rstd = 1.f / sqrtf(ss * (1.f / D) + EPS);
        float lg[16];
#pragma unroll
        for (int i = 0; i < 16; ++i) lg[i] = acc[i] * rstd + F.b_r[4 * h + (i & 3) + 8 * (i >> 2)];
        float cv[8]; int ce[8];
#pragma unroll
        for (int k = 0; k < 4; ++k) { float bv = -INFINITY; int bi = 0;
#pragma unroll
            for (int i = 0; i < 16; ++i) { if (lg[i] > bv) { bv = lg[i]; bi = i; } }
            cv[k] = bv; ce[k] = 4 * h + (bi & 3) + 8 * (bi >> 2);
#pragma unroll
            for (int i = 0; i < 16; ++i) if (i == bi) lg[i] = -INFINITY; }
#pragma unroll
        for (int k = 0; k < 4; ++k) { cv[4 + k] = __shfl_xor(cv[k], 32); ce[4 + k] = __shfl_xor(ce[k], 32); }
        float tv[4]; int te[4];
#pragma unroll
        for (int k = 0; k < 4; ++k) { float bv = -INFINITY; int be = 64, bi = 0;
#pragma unroll
            for (int i = 0; i < 8; ++i) { if (cv[i] > bv || (cv[i] == bv && ce[i] < be)) { bv = cv[i]; be = ce[i]; bi = i; } }
            tv[k] = bv; te[k] = be;
#pragma unroll
            for (int i = 0; i < 8; ++i) if (i == bi) cv[i] = -INFINITY; }
        float gk[4], den = 0.f;
#pragma unroll
        for (int k = 0; k < 4; ++k) { gk[k] = __expf(tv[k] - tv[0]); den += gk[k]; }
        const float inv = 1.f / den;
        if (h == 0) {
#pragma unroll
            for (int k = 0; k < 4; ++k) {
                const unsigned rank = __hip_atomic_fetch_add(lcnt + te[k], 1u, __ATOMIC_RELAXED, __HIP_MEMORY_SCOPE_WORKGROUP);
                const int slot = (tg * 32 + tl) * 4 + k;
                stg[slot * 4] = (unsigned)(tok * 4 + k); stg[slot * 4 + 1] = ((unsigned)te[k] << 16) | rank; stg[slot * 4 + 2] = __builtin_bit_cast(unsigned, gk[k] * inv); stg[slot * 4 + 3] = __builtin_bit_cast(unsigned, rstd);
            }
        }
    }
    __syncthreads();
    if (F.tid < 32) { const unsigned n = lcnt[F.tid]; lcnt[32 + F.tid] = n ? __hip_atomic_fetch_add((unsigned*)(F.ctl + CW_CNT) + F.tid, n, __ATOMIC_RELAXED, __HIP_MEMORY_SCOPE_AGENT) : 0u; }
    __syncthreads();
    { unsigned* list = (unsigned*)(F.ws + WS_LIST); unsigned* lgate = (unsigned*)(F.ws + WS_LGATE); unsigned* lrstd = (unsigned*)(F.ws + WS_LRSTD);
      const unsigned ent = stg[F.tid * 4], er = stg[F.tid * 4 + 1], gb = stg[F.tid * 4 + 2], rb = stg[F.tid * 4 + 3]; const unsigned e = er >> 16, rank = er & 0xffffu;
      const size_t at = (size_t)e * LCAP + lcnt[32 + e] + rank; list[at] = ent; lgate[at] = gb; lrstd[at] = rb; }
    __syncthreads();
}

__device__ __forceinline__ int moe_build_table(Frame& F) {
    LAS unsigned* tbl = (LAS unsigned*)(F.lds + TBL_OFF); LAS unsigned* lcnt = (LAS unsigned*)(F.lds + LCNT_OFF);
    if (F.wave == 0) {
        const int e = F.lane & 31;
        const unsigned cnt = __hip_atomic_load((unsigned*)(F.ctl + CW_CNT) + e, __ATOMIC_RELAXED, __HIP_MEMORY_SCOPE_AGENT);
        const unsigned nt = (cnt + 255u) >> 8; unsigned incl = nt;
#pragma unroll
        for (int o = 1; o < 32; o <<= 1) { const unsigned t = __shfl_up(incl, o); if ((F.lane & 31) >= o) incl += t; }
        if (F.lane < 32) { lcnt[e] = cnt; const unsigned start = incl - nt; for (unsigned j = 0; j < nt; ++j) tbl[start + j] = ((unsigned)e << 16) | j; if (F.lane == 31) F.MISC[16] = incl; }
    }
    __syncthreads();
    return (int)F.MISC[16];
}
struct MoeOrder {
    const LAS unsigned* tbl; const LAS unsigned* lcnt; const unsigned* list; int NMT, G, c, NPN, MPER, RB; size_t bexp; bool a_tiles; const unsigned* lsc; const unsigned* bias; int bexp_f;
    __device__ __forceinline__ bool next(int i, pg8::Unit& u) const {
        const int L = i * G + c, blk = L >> 5, w = L & 31, g = (NPN == 8) ? blk * 4 + (w >> 3) : blk * 8 + (w >> 2), pn = (NPN == 8) ? (w & 7) : (w & 3);
        if (g >= NMT) return false;
        const unsigned t = tbl[g]; const int e = (int)(t >> 16), mt = (int)(t & 0xffffu); const int cnt = (int)lcnt[e];
        u.pm = g; u.pn = pn; u.e = e; u.mt = mt; u.valid = min(256, cnt - mt * 256);
        u.aoff = a_tiles ? (size_t)g * (size_t)(256 * RB) : (size_t)0; u.boff = (size_t)e * bexp + (size_t)pn * (size_t)(256 * RB);
        return true;
    }
    __device__ __forceinline__ const unsigned* id_src(const pg8::Unit& u, int row) const { return list + (size_t)u.e * LCAP + u.mt * 256 + min(row, u.valid - 1); }
    __device__ __forceinline__ const unsigned* sc_src(const pg8::Unit& u, int row) const { return lsc + (size_t)u.e * LCAP + u.mt * 256 + min(row, u.valid - 1); }
    __device__ __forceinline__ const unsigned* bias_src(const pg8::Unit& u, int col) const { return bias + (size_t)u.e * bexp_f + u.pn * 256 + col; }
};
struct EpiGU {
    unsigned char* ACT;
    __device__ __forceinline__ void operator()(const pg8::f32x4 (&acc)[2][2][4][2], const pg8::Unit& u, int wr, int wc, int fr, int fq, const LAS unsigned* ids) const {
        asm volatile("" : "+v"(fr), "+v"(fq));
        typedef float f2 __attribute__((ext_vector_type(2)));
        constexpr float CG = 1.702f * LOG2E, KA = ASCALE / CG;
        const int r0 = wr * 64 + fr, f0 = u.pn * 128 + wc * 32 + 8 * fq;
        const LAS float* scl = (const LAS float*)(ids + 256); const LAS float* bl = (const LAS float*)(ids + 512) + 2 * (wc * 32 + 8 * fq);
        float rs[2][4];
#pragma unroll
        for (int ai = 0; ai < 2; ++ai)
#pragma unroll
            for (int m = 0; m < 4; ++m) rs[ai][m] = scl[r0 + ai * 128 + m * 16] * (1.f / WSCALE);
        const pg8::f32x4 b0 = *(const LAS pg8::f32x4*)bl, b1 = *(const LAS pg8::f32x4*)(bl + 4), b2 = *(const LAS pg8::f32x4*)(bl + 8), b3 = *(const LAS pg8::f32x4*)(bl + 12);
        const f2 gb[4] = {f2{b0[0], b0[2]} * CG, f2{b1[0], b1[2]} * CG, f2{b2[0], b2[2]} * CG, f2{b3[0], b3[2]} * CG}, ub[4] = {f2{b0[1], b0[3]}, f2{b1[1], b1[3]}, f2{b2[1], b2[3]}, f2{b3[1], b3[3]}};
#pragma unroll
        for (int ai = 0; ai < 2; ++ai)
#pragma unroll
            for (int m = 0; m < 4; ++m) { const int r = r0 + ai * 128 + m * 16; const float s = rs[ai][m], sg = s * CG; f2 a[4];
#pragma unroll
                for (int q = 0; q < 4; ++q) { const int n = q >> 1, j = 2 * (q & 1);
                    f2 g = f2{acc[ai][0][m][n][j], acc[ai][0][m][n][j + 1]} * sg + gb[q], up = f2{acc[ai][1][m][n][j], acc[ai][1][m][n][j + 1]} * s + ub[q];
                    g.x = fminf(g.x, 7.f * CG); g.y = fminf(g.y, 7.f * CG); up.x = __builtin_amdgcn_fmed3f(up.x, -7.f, 7.f); up.y = __builtin_amdgcn_fmed3f(up.y, -7.f, 7.f);
                    f2 d = f2{__builtin_amdgcn_exp2f(-g.x), __builtin_amdgcn_exp2f(-g.y)} + 1.f;
                    const f2 rc = f2{__builtin_amdgcn_rcpf(d.x), __builtin_amdgcn_rcpf(d.y)};
                    a[q] = ((up * KA + KA) * g) * rc; }
                v2u w; w.x = (unsigned)__builtin_amdgcn_cvt_pk_fp8_f32(a[1].x, a[1].y, __builtin_amdgcn_cvt_pk_fp8_f32(a[0].x, a[0].y, 0, false), true);
                w.y = (unsigned)__builtin_amdgcn_cvt_pk_fp8_f32(a[3].x, a[3].y, __builtin_amdgcn_cvt_pk_fp8_f32(a[2].x, a[2].y, 0, false), true);
                *(v2u*)(ACT + (size_t)(u.pm * 256 + r) * DFF + f0) = w; }
    }
};
struct EpiDown {
    unsigned char* YB;
    __device__ __forceinline__ void operator()(const pg8::f32x4 (&acc)[2][2][4][2], const pg8::Unit& u, int wr, int wc, int fr, int fq, const LAS unsigned* ids) const {
        asm volatile("" : "+v"(fr), "+v"(fq));
        const int r0 = wr * 64 + fr, cl = wc * 32 + 8 * fq, col0 = u.pn * 256 + cl;
        const LAS float* scl = (const LAS float*)(ids + 256); const LAS float* bl = (const LAS float*)(ids + 512) + cl;
        pg8::f32x4 bv[2][2];
#pragma unroll
        for (int bj = 0; bj < 2; ++bj)
#pragma unroll
            for (int n = 0; n < 2; ++n) bv[bj][n] = *(const LAS pg8::f32x4*)(bl + bj * 128 + 4 * n);
#pragma unroll
        for (int ai = 0; ai < 2; ++ai)
#pragma unroll
            for (int m = 0; m < 4; ++m) { const int r = r0 + ai * 128 + m * 16; if (r < u.valid) { const float g = scl[r] * YSCALE; unsigned char* yp = YB + (size_t)ids[r] * D + col0;
#pragma unroll
                for (int bj = 0; bj < 2; ++bj) { const pg8::f32x4 v0 = (acc[ai][bj][m][0] * (1.f / (WSCALE * ASCALE)) + bv[bj][0]) * g, v1 = (acc[ai][bj][m][1] * (1.f / (WSCALE * ASCALE)) + bv[bj][1]) * g;
                    v2u w; w.x = fp8x4(v0[0], v0[1], v0[2], v0[3]); w.y = fp8x4(v1[0], v1[1], v1[2], v1[3]);
                    *(v2u*)(yp + bj * 128) = w; } } }
    }
};
__device__ __forceinline__ void final_phase(Frame& F) {
    const int gw = F.vcu * NWAVES + F.wave, NGW = F.G * NWAVES;
    const unsigned char* YB = (const unsigned char*)(F.ws + WS_YB); const bf16* X1 = (const bf16*)(F.ws + WS_X1H);
    const int c = 4 * F.lane;
    f32x4 gf[4];
#pragma unroll
    for (int q = 0; q < 4; ++q) gf[q] = *(const f32x4*)(F.g_fin + c + 256 * q);
    for (int t0 = 2 * gw; t0 < T; t0 += 2 * NGW) {
        v2u xa[2][4]; unsigned y[2][4][4];
#pragma unroll
        for (int u = 0; u < 2; ++u) {
#pragma unroll
            for (int q = 0; q < 4; ++q) xa[u][q] = *(const v2u*)(X1 + (size_t)(t0 + u) * D + c + 256 * q);
#pragma unroll
            for (int k = 0; k < 4; ++k)
#pragma unroll
                for (int q = 0; q < 4; ++q) y[u][k][q] = *(const unsigned*)(YB + ((size_t)(t0 + u) * 4 + k) * D + c + 256 * q); }
#pragma unroll
        for (int u = 0; u < 2; ++u) {
            float v[16];
#pragma unroll
            for (int q = 0; q < 4; ++q) { v[4 * q] = bflo(xa[u][q].x); v[4 * q + 1] = bfhi(xa[u][q].x); v[4 * q + 2] = bflo(xa[u][q].y); v[4 * q + 3] = bfhi(xa[u][q].y); }
#pragma unroll
            for (int k = 0; k < 4; ++k)
#pragma unroll
                for (int q = 0; q < 4; ++q) { const auto lo = __builtin_amdgcn_cvt_pk_f32_fp8((int)y[u][k][q], false), hi = __builtin_amdgcn_cvt_pk_f32_fp8((int)y[u][k][q], true);
                    v[4 * q] += lo[0] * (1.f / YSCALE); v[4 * q + 1] += lo[1] * (1.f / YSCALE); v[4 * q + 2] += hi[0] * (1.f / YSCALE); v[4 * q + 3] += hi[1] * (1.f / YSCALE); }
            float ss = 0.f;
#pragma unroll
            for (int i = 0; i < 16; ++i) ss += v[i] * v[i];
            const float rstd = 1.f / sqrtf(wave_sum(ss) * (1.f / D) + EPS);
#pragma unroll
            for (int q = 0; q < 4; ++q) { f32x4 o; o.x = v[4 * q] * rstd * gf[q].x; o.y = v[4 * q + 1] * rstd * gf[q].y; o.z = v[4 * q + 2] * rstd * gf[q].z; o.w = v[4 * q + 3] * rstd * gf[q].w;
                *(f32x4*)(F.out + (size_t)(t0 + u) * D + c + 256 * q) = o; }
        }
    }
}
struct Args { const float* in[17]; float* out; unsigned char* ws; int ph_lo, ph_hi, use_bar, pad; };
__global__ void __launch_bounds__(NWAVES * 64, 2) mk_fwd(Args args) {
    extern __shared__ __attribute__((aligned(16))) unsigned char lds[];
    Frame F;
    F.lds = (LAS unsigned char*)lds;
    F.MISC = (volatile LAS unsigned*)(F.lds + MISC_OFF);
    F.tid = threadIdx.x; F.lane = F.tid & 63; F.wave = __builtin_amdgcn_readfirstlane(F.tid >> 6);
    const bool lead = F.tid == 0;
#define FRESH() do { F.lane = mk_lane(); F.tid = F.wave * 64 + F.lane; } while (0)
    F.G = gridDim.x; { const int bx = blockIdx.x; F.vcu = (F.G % 8 == 0) ? (bx % 8) * (F.G / 8) + bx / 8 : bx; }
    F.ws = args.ws; F.out = args.out; F.ctl = (gu32*)(args.ws + WS_CTL);
    F.x = args.in[0]; F.mem = args.in[1]; F.g_attn = args.in[2]; F.g_mem = args.in[3]; F.w_in = args.in[4]; F.lamqk = args.in[5]; F.subg = args.in[6]; F.w_mkv = args.in[7];
    F.w_out = args.in[8]; F.g_ffn = args.in[9]; F.w_r = args.in[10]; F.b_r = args.in[11]; F.w_gu = args.in[12]; F.b_gu = args.in[13]; F.w_dn = args.in[14]; F.b_dn = args.in[15]; F.g_fin = args.in[16];
    for (int u = F.tid; u < (LDS_BYTES - LDSCTL_OFF) / 4; u += NWAVES * 64) ((LAS unsigned*)(F.lds + LDSCTL_OFF))[u] = 0u;
    __syncthreads();
    XcdBarrier bar; bar.bar = (unsigned*)(F.ctl + CW_BAR); bar.x = 0; bar.st = nullptr;
    if (args.use_bar) bar = xcd_barrier_post((unsigned*)(F.ctl + CW_BAR), F.MISC + 8, lead);
    const int lo = args.ph_lo, hi = args.ph_hi;
#define IN(k) (lo <= (k) && (k) < hi)
#define SEAM(k) do { if (IN(k) && IN((k) + 1)) xcd_barrier(bar, lead); } while (0)
    if (IN(0)) { p0_prologue(F); } SEAM(0);
    if (IN(1)) {
        pg8::Gemm g{(const void*)(F.ws + WS_XB), (const void*)(F.ws + WS_WIN), 2 * D, 128}; pg8::StaticOrder S; S.init(T, DIN, 2 * D, F.G, (int)blockIdx.x, (const unsigned*)(F.ws + WS_RSTD1));
        EpiInProj E{(bf16*)(F.ws + WS_P), (const float*)(F.ws + WS_RSTD1), (unsigned*)(F.ctl + CW_NRM)};
        pg8::gemm_phase<EpiInProj, pg8::StaticOrder, true, false, true>(F.lds + RING_OFF, (LAS unsigned*)(F.lds + IDB_OFF), g, S, E, F.tid);
    } SEAM(1);
    if (IN(2)) { attn_phase(F, (char*)lds + RING_OFF); } SEAM(2);
    if (IN(3)) { FRESH(); dil_combine_phase(F); } SEAM(3);
    if (IN(4)) { FRESH();
        pg8::Gemm g{(const void*)(F.ws + WS_MIX), (const void*)(F.ws + WS_WOUT), 2 * D, 128}; pg8::StaticOrder S; S.init(T, D, 2 * D, F.G, (int)blockIdx.x);
        EpiY E{(bf16*)(F.ws + WS_Y)};
        pg8::gemm_phase<EpiY, pg8::StaticOrder, true, false, false>(F.lds + RING_OFF, (LAS unsigned*)(F.lds + IDB_OFF), g, S, E, F.tid);
    } SEAM(4);
    if (IN(5)) { FRESH(); route_phase(F); } SEAM(5);
    if (IN(6)) { FRESH();
        const int nmt = moe_build_table(F);
        pg8::Gemm g{(const void*)(F.ws + WS_X1B), (const void*)(F.ws + WS_WGU), D, 128};
        MoeOrder S{(const LAS unsigned*)(F.lds + TBL_OFF), (const LAS unsigned*)(F.lds + LCNT_OFF), (const unsigned*)(F.ws + WS_LIST), nmt, F.G, F.vcu, 8, 4, D, (size_t)2 * DFF * D, false, (const unsigned*)(F.ws + WS_LRSTD), (const unsigned*)F.b_gu, 2 * DFF};
        EpiGU E{(unsigned char*)(F.ws + WS_ACT)};
        pg8::gemm_phase<EpiGU, MoeOrder, true, true, true, true>(F.lds + RING_OFF, (LAS unsigned*)(F.lds + IDB_OFF), g, S, E, F.tid);
    } SEAM(6);
    if (IN(7)) { FRESH();
        const int nmt = moe_build_table(F);
        pg8::Gemm g{(const void*)(F.ws + WS_ACT), (const void*)(F.ws + WS_WDN), DFF, 128};
        MoeOrder S{(const LAS unsigned*)(F.lds + TBL_OFF), (const LAS unsigned*)(F.lds + LCNT_OFF), (const unsigned*)(F.ws + WS_LIST), nmt, F.G, F.vcu, 4, 8, DFF, (size_t)D * DFF, true, (const unsigned*)(F.ws + WS_LGATE), (const unsigned*)F.b_dn, D};
        EpiDown E{(unsigned char*)(F.ws + WS_YB)};
        pg8::gemm_phase<EpiDown, MoeOrder, true, true, true, true, true>(F.lds + RING_OFF, (LAS unsigned*)(F.lds + IDB_OFF), g, S, E, F.tid);
    } SEAM(7);
    if (IN(8)) { FRESH(); final_phase(F); }
#undef IN
#undef FRESH
#undef SEAM
}

static void launch_phases(const Args& base, int lo, int hi, int use_bar, int grid, hipStream_t stream) {
    Args a = base; a.ph_lo = lo; a.ph_hi = hi; a.use_bar = use_bar;
    hipLaunchKernelGGL(mk_fwd, dim3(grid), dim3(NWAVES * 64), LDS_BYTES, stream, a);
}
extern "C" void kernel_launch(void* const* d_in, const int* in_sizes, int n_in, void* d_out, int out_size, void* d_ws, size_t ws_size, hipStream_t stream) {
    static int grid = 0;
    if (grid == 0) {
        if (n_in != 17 || in_sizes[0] != T * D || out_size != T * D || ws_size < (size_t)1000 * MiB) { fprintf(stderr, "kernel_launch: unexpected shapes / workspace (%d inputs, ws %zu)\n", n_in, ws_size); grid = -1; return; }
        int dev = 0, cus = 0, per_cu = 0;
        if (hipGetDevice(&dev) != hipSuccess || hipDeviceGetAttribute(&cus, hipDeviceAttributeMultiprocessorCount, dev) != hipSuccess) { grid = -1; return; }
        if (hipFuncSetAttribute((const void*)mk_fwd, hipFuncAttributeMaxDynamicSharedMemorySize, LDS_BYTES) != hipSuccess) { fprintf(stderr, "kernel_launch: hipFuncSetAttribute failed\n"); grid = -1; return; }
        if (hipOccupancyMaxActiveBlocksPerMultiprocessor(&per_cu, (const void*)mk_fwd, NWAVES * 64, LDS_BYTES) != hipSuccess || per_cu < 1) { fprintf(stderr, "kernel_launch: occupancy query says %d blocks per CU\n", per_cu); per_cu = 1; }
        (void)hipGetLastError();
        grid = cus;
        if (grid != 256) { fprintf(stderr, "kernel_launch: built for a 256-CU device (got %d)\n", cus); grid = -1; return; }
    }
    if (grid < 0) return;
    (void)hipMemsetAsync((char*)d_ws + WS_CTL, 0, CTL_ZERO_BYTES, stream);
    Args a{};
    for (int i = 0; i < 17; ++i) a.in[i] = (const float*)d_in[i];
    a.out = (float*)d_out; a.ws = (unsigned char*)d_ws;
    launch_phases(a, 0, 9, 1, grid, stream);
}
```

```cpp
#include <hip/hip_runtime.h>
#include <hip/hip_bf16.h>
#include <cstdint>
#include <cstdio>
#include <cmath>

constexpr int D = 1024, BATCH = 8, SEQ = 4096, T = BATCH * SEQ, DIN = 2560, NMEM = 256, NE = 32, DFF = 1024;
constexpr int C_DQ = 0, C_DK = 512, C_DV = 1024, C_LQ = 1536, C_LK = 1792, C_LV = 2048, C_MQ = 2304;
constexpr float EPS = 1e-5f;
constexpr int LCAP = T;
constexpr float QSCALE = 0.125f * 1.4426950408889634f;
constexpr float LOG2E = 1.4426950408889634f;
__device__ __forceinline__ int mk_lane() { int l = (int)__builtin_amdgcn_mbcnt_hi(~0u, __builtin_amdgcn_mbcnt_lo(~0u, 0u)); asm volatile("" : "+v"(l)); return l; }

namespace pg8 {
#define PG8_LAS __attribute__((address_space(3)))
typedef unsigned short bf16_t;
typedef short bf16x8 __attribute__((ext_vector_type(8)));
typedef float f32x4 __attribute__((ext_vector_type(4)));
typedef unsigned u32x4 __attribute__((ext_vector_type(4)));
typedef unsigned u32x2 __attribute__((ext_vector_type(2)));
constexpr int BM = 256, BK = 64, HALF = 128, HTB = HALF * BK * 2  , STAGE_BYTES = 8 * HTB, NXCD = 8, WGM = 8;

__host__ __device__ __forceinline__ int lds_byte(int r, int c) { const int st = (r >> 4) * 2 + (c >> 5), rr = r & 15, cc = c & 31, ob = rr * 64 + cc * 2; return st * 1024 + (ob ^ (((ob >> 9) & 1) << 5)); }
__host__ __device__ __forceinline__ void stage_rc(int b, int& R, int& C) { const int st = b / 1024, sb = b % 1024, swz = sb ^ (((sb >> 9) & 1) << 5); R = (st >> 1) * 16 + swz / 64; C = (st & 1) * 32 + (swz % 64) / 2; }
__host__ __device__ __forceinline__ int perm32(int rho) { const int n = rho >> 4, i = rho & 15; return 8 * (i >> 2) + 4 * n + (i & 3); }

struct Unit { size_t aoff, boff; int pm, pn, e, valid, mt; };
struct Gemm { const void* A; const void* Bt; int RB; int akstep; };
typedef int v8i __attribute__((ext_vector_type(8)));

struct StaticOrder {
    int nM, nN, nwg, G, c, RB; const unsigned* sc;
    __device__ void init(int M, int N, int RB_, int G_, int c_, const unsigned* sc_ = nullptr) { nM = M / BM; nN = N / BM; nwg = nM * nN; G = G_; c = c_; RB = RB_; sc = sc_; }
    __device__ bool next(int i, Unit& u) const {
        const long L = (long)i * G + c; if (L >= nwg) return false;
        int wgid = (int)L; { const int q = nwg / NXCD, r = nwg % NXCD, xcd = wgid % NXCD, off = wgid / NXCD; wgid = (xcd < r ? xcd * (q + 1) : r * (q + 1) + (xcd - r) * q) + off; }
        const int nig = WGM * nN, gid = wgid / nig, fm = gid * WGM, gsz = (nM - fm) < WGM ? (nM - fm) : WGM;
        u.pm = fm + ((wgid % nig) % gsz); u.pn = (wgid % nig) / gsz; u.e = 0; u.valid = 256; u.mt = 0;
        u.aoff = (size_t)u.pm * (size_t)(BM * RB); u.boff = (size_t)u.pn * (size_t)(BM * RB); return true;
    }
    __device__ __forceinline__ const unsigned* id_src(const Unit& u, int row) const { return sc + u.pm * 256 + row; }
    __device__ __forceinline__ const unsigned* sc_src(const Unit& u, int row) const { return sc + u.pm * 256 + row; }
    __device__ __forceinline__ const unsigned* bias_src(const Unit& u, int row) const { return sc + u.pm * 256 + row; }
};

__device__ __forceinline__ unsigned cvt_pk_bf16(float lo, float hi) { typedef float f2_ __attribute__((ext_vector_type(2))); typedef __bf16 b2_ __attribute__((ext_vector_type(2))); f2_ v = {lo, hi}; b2_ b = __builtin_convertvector(v, b2_); return __builtin_bit_cast(unsigned, b); }

template <class Epi, class Sched, bool ALIGN_EPI, bool GATHER, bool IDS, bool FP8 = false, bool LINEAR = false>
__device__ __forceinline__ void gemm_phase(PG8_LAS unsigned char* lds, PG8_LAS unsigned* idb, const Gemm g, const Sched& S, const Epi& E, const int tid) {
    const int wid = __builtin_amdgcn_readfirstlane(tid >> 6), lane = tid & 63, wr = wid >> 2, wc = wid & 3, fr = lane & 15, fq = lane >> 4;
    const int RB = g.RB; int nt = RB / (BK * 2); asm volatile("" : "+s"(nt));
    unsigned voffA[2], voffB[2]; int RA[2], CA[2];
#pragma unroll
    for (int i = 0; i < 2; ++i) { int R, C; stage_rc(tid * 16 + i * 8192, R, C); const int Rb = (R & ~31) + perm32(R & 31); RA[i] = R; CA[i] = C;
        voffA[i] = (unsigned)(R * RB + C * 2); voffB[i] = (unsigned)(Rb * RB + C * 2); }
    const size_t kstep = (size_t)(BK * 2), akstep = (size_t)g.akstep;
    const size_t hstep = (size_t)HALF * RB;
    const unsigned ldsw = (unsigned)wid * 1024u;
    const int aoff = lds_byte(wr * 64 + fr, fq * 8), boff = lds_byte(wc * 32 + fr, fq * 8);
#define PG8_SA(b, h) (((b) * 2 + (h)) * HTB)
#define PG8_SB(b, h) ((4 + (b) * 2 + (h)) * HTB)
#define PG8_STAGE(bufoff, gbase, voff) do { _Pragma("unroll") for (int _i = 0; _i < 2; ++_i) \
        __builtin_amdgcn_global_load_lds((const unsigned*)((const char*)(gbase) + (voff)[_i]), (PG8_LAS unsigned*)(lds + (bufoff) + ldsw + _i * 8192), 16, 0, 0); } while (0)
#define PG8_STAGE_A(bufoff, pbase, gbase, h, gv) do { if constexpr (GATHER) { PG8_STAGE(bufoff, gbase, gv[h]); } else { PG8_STAGE(bufoff, (pbase) + (h) * hstep, voffA); } } while (0)
#define PG8_LD32(p0_, p1_) __builtin_bit_cast(v8i, __builtin_shufflevector(*(const PG8_LAS u32x4*)(p0_), *(const PG8_LAS u32x4*)(p1_), 0, 1, 2, 3, 4, 5, 6, 7))
#define PG8_LDA(dst, b, h) do { if constexpr (FP8) { _Pragma("unroll") for (int m = 0; m < 4; ++m) dst##8[m] = PG8_LD32(lds + PG8_SA(b, h) + aoff + m * 2048, lds + PG8_SA(b, h) + aoff + m * 2048 + 1024); } \
        else { _Pragma("unroll") for (int m = 0; m < 4; ++m) _Pragma("unroll") for (int k = 0; k < 2; ++k) dst[m][k] = *(const PG8_LAS bf16x8*)(lds + PG8_SA(b, h) + aoff + m * 2048 + k * 1024); } } while (0)
#define PG8_LDB(dst, b, h) do { if constexpr (FP8) { _Pragma("unroll") for (int n = 0; n < 2; ++n) dst##8[n] = PG8_LD32(lds + PG8_SB(b, h) + boff + n * 2048, lds + PG8_SB(b, h) + boff + n * 2048 + 1024); } \
        else { _Pragma("unroll") for (int n = 0; n < 2; ++n) _Pragma("unroll") for (int k = 0; k < 2; ++k) dst[n][k] = *(const PG8_LAS bf16x8*)(lds + PG8_SB(b, h) + boff + n * 2048 + k * 1024); } } while (0)
#define PG8_MMA(ai, bj, At, Bt) do { __builtin_amdgcn_s_setprio(1); if constexpr (FP8) { _Pragma("unroll") for (int m = 0; m < 4; ++m) _Pragma("unroll") for (int n = 0; n < 2; ++n) \
        acc[ai][bj][m][n] = __builtin_amdgcn_mfma_scale_f32_16x16x128_f8f6f4(Bt##8[n], At##8[m], acc[ai][bj][m][n], 0, 0, 0, sca_, 0, 0x7f7f7f7f); } \
        else { _Pragma("unroll") for (int m = 0; m < 4; ++m) _Pragma("unroll") for (int n = 0; n < 2; ++n) _Pragma("unroll") for (int k = 0; k < 2; ++k) \
        acc[ai][bj][m][n] = __builtin_amdgcn_mfma_f32_16x16x32_bf16(Bt[n][k], At[m][k], acc[ai][bj][m][n], 0, 0, 0); } __builtin_amdgcn_s_setprio(0); } while (0)
#define PG8_WAIT_V(n) asm volatile("s_waitcnt vmcnt(" #n ")" ::: "memory")
#define PG8_WAIT_L(n) asm volatile("s_waitcnt lgkmcnt(" #n ")" ::: "memory")
#define PG8_BAR __builtin_amdgcn_s_barrier()
#define PG8_SCHED __builtin_amdgcn_sched_barrier(0)
#define PG8_IDS_DMA(u, s) do { if (wid < 4) { __builtin_amdgcn_global_load_lds(S.id_src(u, tid), (PG8_LAS unsigned*)(idb + (s) * 768 + wid * 64), 4, 0, 0); \
        __builtin_amdgcn_global_load_lds(S.sc_src(u, tid), (PG8_LAS unsigned*)(idb + (s) * 768 + 256 + wid * 64), 4, 0, 0); \
        __builtin_amdgcn_global_load_lds(S.bias_src(u, tid), (PG8_LAS unsigned*)(idb + (s) * 768 + 512 + wid * 64), 4, 0, 0); } } while (0)
#define PG8_GV(dst, s, un) do { _Pragma("unroll") for (int _h = 0; _h < 2; ++_h) _Pragma("unroll") for (int _i = 0; _i < 2; ++_i) \
        dst[_h][_i] = (LINEAR ? (unsigned)((un).pm * 256 + _h * 128 + RA[_i]) : (idb[(s) * 768 + _h * 128 + RA[_i]] >> 2)) * (unsigned)RB + (unsigned)(CA[_i] * 2); } while (0)
    Unit cur, nxt; int ui = 0, us = 0;
    if (!S.next(0, cur)) return;
    f32x4 acc[2][2][4][2];
#pragma unroll
    for (int a = 0; a < 2; ++a)
#pragma unroll
        for (int b = 0; b < 2; ++b)
#pragma unroll
            for (int m = 0; m < 4; ++m)
#pragma unroll
                for (int n = 0; n < 2; ++n) acc[a][b][m][n] = (f32x4){0.f, 0.f, 0.f, 0.f};
    bf16x8 At[4][2], B0[2][2], B1[2][2]; v8i At8[4], B08[2], B18[2];
    unsigned cv[2][2] = {{0u, 0u}, {0u, 0u}};
    const char* A0 = (const char*)g.A;
    const char* cA = A0 + (GATHER ? (size_t)0 : cur.aoff); const char* cB = (const char*)g.Bt + cur.boff;
    if constexpr (IDS) {
        PG8_IDS_DMA(cur, 0); PG8_WAIT_V(0); PG8_BAR;
    }
    if constexpr (GATHER) { PG8_GV(cv, 0, cur); }
    PG8_STAGE(PG8_SB(0, 0), cB, voffB); PG8_STAGE(PG8_SB(0, 1), cB + hstep, voffB); PG8_STAGE_A(PG8_SA(0, 0), cA, A0, 0, cv); PG8_STAGE_A(PG8_SA(0, 1), cA, A0, 1, cv);
    if (wr == 1) PG8_BAR;
    PG8_WAIT_V(2); PG8_BAR;
    PG8_STAGE(PG8_SB(1, 0), cB + kstep, voffB); PG8_STAGE_A(PG8_SA(1, 0), cA + akstep, A0 + akstep, 0, cv); PG8_STAGE(PG8_SB(1, 1), cB + hstep + kstep, voffB);
    PG8_WAIT_V(6); PG8_BAR;
    for (;;) {
        const bool has_next = S.next(ui + 1, nxt);
        const int ns = (us == 2) ? 0 : us + 1;
        if constexpr (IDS) { if (has_next) PG8_IDS_DMA(nxt, ns); }
        const char* nA = has_next ? A0 + (GATHER ? (size_t)0 : nxt.aoff) : cA; const char* nB = has_next ? (const char*)g.Bt + nxt.boff : cB;
#ifdef PROBE_KTWICE
        for (int rep_ = 0; rep_ < (FP8 ? 2 : 1); ++rep_) { const int sca_ = rep_ ? 0 : 0x7f7f7f7f;
#else
        { const int sca_ = 0x7f7f7f7f;
#endif
#pragma nounroll
        for (int t = 0; t < nt; t += 2) {
            int lastv = (t == nt - 2) ? 1 : 0; asm volatile("" : "+v"(lastv)); const bool last = __builtin_amdgcn_readfirstlane(lastv) != 0;
            const char* a1 = cA + (size_t)(t + 1) * akstep;
            const char* a2 = last ? nA : cA + (size_t)(t + 2) * akstep; const char* b2 = last ? nB : cB + (size_t)(t + 2) * kstep;
            const char* a3 = a2 + akstep; const char* b3 = b2 + kstep;
            PG8_LDB(B0, 0, 0); PG8_LDB(B1, 0, 1); PG8_SCHED; PG8_LDA(At, 0, 0); PG8_STAGE_A(PG8_SA(1, 1), a1, a1, 1, cv);
            if constexpr (GATHER) { if (last && has_next) { PG8_GV(cv, ns, nxt); } }
            PG8_WAIT_V(8); PG8_WAIT_L(0); PG8_BAR; PG8_MMA(0, 0, At, B0); PG8_MMA(0, 1, At, B1); PG8_BAR; PG8_SCHED;
            PG8_LDA(At, 0, 1); PG8_STAGE(PG8_SB(0, 0), b2, voffB); PG8_STAGE(PG8_SB(0, 1), b2 + hstep, voffB); PG8_STAGE_A(PG8_SA(0, 0), a2, a2, 0, cv);
            PG8_WAIT_V(8); PG8_WAIT_L(0); PG8_BAR; PG8_MMA(1, 0, At, B0); PG8_MMA(1, 1, At, B1); PG8_BAR; PG8_SCHED;
            PG8_LDB(B0, 1, 0); PG8_LDB(B1, 1, 1); PG8_SCHED; PG8_LDA(At, 1, 0); PG8_STAGE_A(PG8_SA(0, 1), a2, a2, 1, cv);
            PG8_WAIT_V(8); PG8_WAIT_L(0); PG8_BAR; PG8_MMA(0, 0, At, B0); PG8_MMA(0, 1, At, B1); PG8_BAR; PG8_SCHED;
            PG8_LDA(At, 1, 1); PG8_STAGE(PG8_SB(1, 0), b3, voffB); PG8_STAGE(PG8_SB(1, 1), b3 + hstep, voffB); PG8_STAGE_A(PG8_SA(1, 0), a3, a3, 0, cv);
            PG8_WAIT_V(8); PG8_WAIT_L(0); PG8_BAR; PG8_MMA(1, 0, At, B0); PG8_MMA(1, 1, At, B1); PG8_BAR; PG8_SCHED;
        }
        }
        if constexpr (ALIGN_EPI) { if (wr == 0) PG8_BAR; }
        PG8_SCHED;
        E(acc, cur, wr, wc, fr, fq, (const PG8_LAS unsigned*)(idb + us * 768));
        PG8_SCHED;
#ifdef PROBE_EPI2
        if constexpr (FP8) { E(acc, cur, wr, wc, fr, fq, (const PG8_LAS unsigned*)(idb + us * 768)); PG8_SCHED; }
#endif
        if (!has_next) break;
#pragma unroll
        for (int a = 0; a < 2; ++a)
#pragma unroll
            for (int b = 0; b < 2; ++b)
#pragma unroll
                for (int m = 0; m < 4; ++m)
#pragma unroll
                    for (int n = 0; n < 2; ++n) acc[a][b][m][n] = (f32x4){0.f, 0.f, 0.f, 0.f};
        cur = nxt; cA = nA; cB = nB; ++ui; us = ns;
        if constexpr (ALIGN_EPI) { if (wr == 1) PG8_BAR; }
    }
    PG8_WAIT_V(0);
    if constexpr (!ALIGN_EPI) { if (wr == 0) PG8_BAR; }
    PG8_BAR;
#undef PG8_SA
#undef PG8_SB
#undef PG8_STAGE
#undef PG8_STAGE_A
#undef PG8_LDA
#undef PG8_LDB
#undef PG8_MMA
#undef PG8_LD32
#undef PG8_WAIT_V
#undef PG8_WAIT_L
#undef PG8_BAR
#undef PG8_SCHED
#undef PG8_IDS_DMA
#undef PG8_GV
}
}
namespace attn_body {
using bf16=__hip_bfloat16;
using bf16x8=__attribute__((ext_vector_type(8)))short;
using s16x4=__attribute__((ext_vector_type(4)))short;
using f32x16=__attribute__((ext_vector_type(16)))float;
using u32x4=__attribute__((ext_vector_type(4)))unsigned;
constexpr int D=64;
constexpr int NW=8,QBLK=32,QB=QBLK*NW,KVBLK=64;
struct UnitP { const bf16* Q; const bf16* K; const bf16* V; bf16* O; long qp, kp, op; int q0, t0, NT; float slope2; float* lse; int lse_stride; };
__device__ __forceinline__ int crow(int r,int hi){return (r&3)+8*(r>>2)+4*hi;}
#define SBAR() __builtin_amdgcn_sched_barrier(0)
template<bool CAUSAL,bool WINDOW> __device__ __forceinline__ void cmask(f32x16&p0,f32x16&p1,int jb,int qrel,int hi){
  const float NEG=-INFINITY; int kb=64*jb+4*hi;
  #pragma unroll
  for(int r=0;r<16;++r){int kv=kb+(r&3)+8*(r>>2);
    if(CAUSAL){ if(kv>qrel)p0[r]=NEG; if(kv+32>qrel)p1[r]=NEG; }
    if(WINDOW){ if(kv<qrel-128)p0[r]=NEG; if(kv+32<qrel-128)p1[r]=NEG; } }
}
__device__ __forceinline__ unsigned bfr(float x){ typedef float f2_ __attribute__((ext_vector_type(2))); typedef __bf16 b2_ __attribute__((ext_vector_type(2))); f2_ v={x,0.f}; b2_ b=__builtin_convertvector(v,b2_); return __builtin_bit_cast(unsigned,b)&0xffffu; }
__device__ __forceinline__ float bfv(unsigned b){ return __builtin_bit_cast(float,b<<16); }

constexpr int NSLOT=3, SLOTB=8192;
constexpr int LDS_K=0, LDS_V=NSLOT*SLOTB;
template<int DV> struct Lds { static constexpr int SLOTV=SLOTB*(DV/64), WS=LDS_V+NSLOT*SLOTV, OST=WS+NW*64*4, OSTW=4096*(DV/64), BYTES=OST+NW*OSTW; };
__device__ __forceinline__ void glds16(const void*gsrc,unsigned lds_dst){unsigned keep;
  asm volatile("s_mov_b32 %0, m0\n\ts_mov_b32 m0, %2\n\ts_nop 0\n\tglobal_load_lds_dwordx4 %1, off\n\ts_mov_b32 m0, %0":"=&s"(keep):"v"(gsrc),"s"(lds_dst):"memory");}
__device__ __forceinline__ float max3f(float a,float b,float c){float r;asm("v_max3_f32 %0, %1, %2, %3":"=v"(r):"v"(a),"v"(b),"v"(c));return r;}
__device__ __forceinline__ float max2f(float a,float b){float r;asm("v_max_f32_e32 %0, %1, %2":"=v"(r):"v"(a),"v"(b));return r;}
__device__ __forceinline__ float fadd_s(float a,float b){float r;asm("v_add_f32_e32 %0, %1, %2":"=v"(r):"v"(a),"v"(b));return r;}
__device__ __forceinline__ float fsub_s(float a,float b){float r;asm("v_sub_f32_e32 %0, %1, %2":"=v"(r):"v"(a),"v"(b));return r;}
typedef float f32x2_t __attribute__((ext_vector_type(2))); typedef __bf16 bf16x2_t __attribute__((ext_vector_type(2)));
__device__ __forceinline__ unsigned cvtpk_s(float lo,float hi){f32x2_t v={lo,hi};bf16x2_t b=__builtin_convertvector(v,bf16x2_t);return __builtin_bit_cast(unsigned,b);}
#define WAIT_BAR(N) asm volatile("s_waitcnt vmcnt(" #N ") lgkmcnt(0)\n\ts_barrier":::"memory")

__device__ __forceinline__ void qkt(f32x16&p0,f32x16&p1,const char*Kslot,const bf16x8*qr,bf16x8 kx0,bf16x8 kx1,bf16x8 qx,int r32,int hi){
  const char*kb=Kslot+hi*1024+r32*16;
  #pragma unroll
  for(int d0=0;d0<4;++d0){
    const bf16x8 b0=*reinterpret_cast<const bf16x8*>(kb+d0*2048);
    const bf16x8 b1=*reinterpret_cast<const bf16x8*>(kb+d0*2048+512);
    if(d0==0){p0=__builtin_amdgcn_mfma_f32_32x32x16_bf16(b0,qr[0],f32x16{},0,0,0);p1=__builtin_amdgcn_mfma_f32_32x32x16_bf16(b1,qr[0],f32x16{},0,0,0);}
    else{p0=__builtin_amdgcn_mfma_f32_32x32x16_bf16(b0,qr[d0],p0,0,0,0);p1=__builtin_amdgcn_mfma_f32_32x32x16_bf16(b1,qr[d0],p1,0,0,0);}}
  p0=__builtin_amdgcn_mfma_f32_32x32x16_bf16(kx0,qx,p0,0,0,0);p1=__builtin_amdgcn_mfma_f32_32x32x16_bf16(kx1,qx,p1,0,0,0);
}
typedef __attribute__((address_space(3))) const char* lds_cptr;
typedef short v4i16_t __attribute__((ext_vector_type(4)));
__device__ __forceinline__ void kload8(bf16x8*kf,lds_cptr kp){
  kf[0]=*(const __attribute__((address_space(3))) bf16x8*)(kp);      kf[1]=*(const __attribute__((address_space(3))) bf16x8*)(kp+512);
  kf[2]=*(const __attribute__((address_space(3))) bf16x8*)(kp+2048); kf[3]=*(const __attribute__((address_space(3))) bf16x8*)(kp+2560);
  kf[4]=*(const __attribute__((address_space(3))) bf16x8*)(kp+4096); kf[5]=*(const __attribute__((address_space(3))) bf16x8*)(kp+4608);
  kf[6]=*(const __attribute__((address_space(3))) bf16x8*)(kp+6144); kf[7]=*(const __attribute__((address_space(3))) bf16x8*)(kp+6656);
}
__device__ __forceinline__ void kload2(bf16x8*kf,lds_cptr kp,int j){ kf[2*j]=*(const __attribute__((address_space(3))) bf16x8*)(kp+j*2048); kf[2*j+1]=*(const __attribute__((address_space(3))) bf16x8*)(kp+j*2048+512); }
__device__ __forceinline__ s16x4 vtr(lds_cptr p){ return __builtin_bit_cast(s16x4,__builtin_amdgcn_ds_read_tr16_b64_v4i16((__attribute__((address_space(3))) v4i16_t*)p)); }
__device__ __forceinline__ float rowmax(const f32x16&p0,const f32x16&p1){
  float a=max3f(p0[0],p0[1],p1[0]),b=max3f(p0[2],p0[3],p1[1]);a=max3f(a,p1[2],p1[3]);
  #pragma unroll
  for(int r=4;r<16;r+=4){a=max3f(a,p0[r],p0[r+1]);b=max3f(b,p0[r+2],p0[r+3]);a=max3f(a,p1[r],p1[r+1]);b=max3f(b,p1[r+2],p1[r+3]);}
  const float m=max2f(a,b);
  auto rr=__builtin_amdgcn_permlane32_swap(__float_as_uint(m),__float_as_uint(m),false,false);
  return max2f(__uint_as_float(rr[0]),__uint_as_float(rr[1]));
}
__device__ __forceinline__ void pv(f32x16*o,int vb,bf16x8 pa0,bf16x8 pa1,bf16x8 pa2,bf16x8 pa3){
  #pragma unroll
  for(int d0=0;d0<2;++d0){s16x4 lo[4],hi[4];
    #pragma unroll
    for(int ks=0;ks<4;++ks){
      asm volatile("ds_read_b64_tr_b16 %0,%1 offset:%c2":"=&v"(lo[ks]):"v"(vb),"i"(d0*4096+ks*1024):"memory");
      asm volatile("ds_read_b64_tr_b16 %0,%1 offset:%c2":"=&v"(hi[ks]):"v"(vb),"i"(d0*4096+ks*1024+512):"memory");}
    asm volatile("s_waitcnt lgkmcnt(0)":::"memory");SBAR();
    #define PK(k) (bf16x8){lo[k][0],lo[k][1],lo[k][2],lo[k][3],hi[k][0],hi[k][1],hi[k][2],hi[k][3]}
    o[d0]=__builtin_amdgcn_mfma_f32_32x32x16_bf16(pa0,PK(0),o[d0],0,0,0);
    o[d0]=__builtin_amdgcn_mfma_f32_32x32x16_bf16(pa1,PK(1),o[d0],0,0,0);
    o[d0]=__builtin_amdgcn_mfma_f32_32x32x16_bf16(pa2,PK(2),o[d0],0,0,0);
    o[d0]=__builtin_amdgcn_mfma_f32_32x32x16_bf16(pa3,PK(3),o[d0],0,0,0);
    #undef PK
  }
}

__device__ __forceinline__ void pv128(f32x16*o,int vb,bf16x8 pa0,bf16x8 pa1,bf16x8 pa2,bf16x8 pa3){
  #pragma unroll
  for(int d0=0;d0<4;++d0){s16x4 lo[4],hi[4];
    #pragma unroll
    for(int ks=0;ks<4;++ks){
      asm volatile("ds_read_b64_tr_b16 %0,%1 offset:%c2":"=&v"(lo[ks]):"v"(vb),"i"(d0*4096+ks*1024):"memory");
      asm volatile("ds_read_b64_tr_b16 %0,%1 offset:%c2":"=&v"(hi[ks]):"v"(vb),"i"(d0*4096+ks*1024+512):"memory");}
    asm volatile("s_waitcnt lgkmcnt(0)":::"memory");SBAR();
    #define PK(k) (bf16x8){lo[k][0],lo[k][1],lo[k][2],lo[k][3],hi[k][0],hi[k][1],hi[k][2],hi[k][3]}
    o[d0]=__builtin_amdgcn_mfma_f32_32x32x16_bf16(pa0,PK(0),o[d0],0,0,0);
    o[d0]=__builtin_amdgcn_mfma_f32_32x32x16_bf16(pa1,PK(1),o[d0],0,0,0);
    o[d0]=__builtin_amdgcn_mfma_f32_32x32x16_bf16(pa2,PK(2),o[d0],0,0,0);
    o[d0]=__builtin_amdgcn_mfma_f32_32x32x16_bf16(pa3,PK(3),o[d0],0,0,0);
    #undef PK
  }
}
#ifndef ATTN_STORE16
#define ATTN_STORE16(p,v) (*(u32x4*)(p)=(v))
#endif
template<int THRL,bool CAUSAL,bool WINDOW,bool ALIBI,bool LSE,int DV=64> __device__ __forceinline__ void attn_unit(const UnitP&U,char*shm){
  constexpr int LDS_WS=Lds<DV>::WS, LDS_OST=Lds<DV>::OST, VMUL=DV/64;
  int tid=threadIdx.x; asm volatile("":"+v"(tid));
  const int lane=tid&63,r32=lane&31,hi=lane>>5; const int wid=__builtin_amdgcn_readfirstlane(tid>>6);
  const int q0=U.q0; const long qp=U.qp,kp=U.kp,op=U.op; const float slope2=U.slope2;
  const bf16*Qw=U.Q+(long)(q0+wid*QBLK)*qp;
  const bf16*Kh=U.K+(long)U.t0*KVBLK*kp,*Vh=U.V+(long)U.t0*KVBLK*kp;
  const unsigned lds0=(unsigned)(uintptr_t)shm;
  float*wsf=(float*)(shm+LDS_WS)+wid*64;
  const bf16*ksrc=Kh+(long)lane*kp+wid*8;
  const bf16*vsrc=Vh+(long)(16*(wid&3)+(lane>>2))*kp+(wid>>2)*32+(lane&3)*8;
  const unsigned kdst=lds0+LDS_K+wid*1024, vdst=lds0+LDS_V+wid*1024;
  #define DMA_K(t,slot) glds16(ksrc+(long)(t)*KVBLK*kp,(unsigned)__builtin_amdgcn_readfirstlane(kdst+(slot)))
  #define DMA_V(t,slot) do{ glds16(vsrc+(long)(t)*KVBLK*kp,(unsigned)__builtin_amdgcn_readfirstlane(vdst+VMUL*(slot))); if constexpr(DV==128) glds16(vsrc+64+(long)(t)*KVBLK*kp,(unsigned)__builtin_amdgcn_readfirstlane(vdst+VMUL*(slot)+8192)); }while(0)
  const int vb0=(int)(lds0+LDS_V)+((lane>>4)&1)*32+(lane&3)*8+(4*hi+((lane&15)>>2))*64;
  const char*Kbase=shm+LDS_K; bf16x8 kf[8];
  const lds_cptr shm3=(lds_cptr)shm; const lds_cptr kp0=shm3+LDS_K+hi*1024+r32*16; const lds_cptr vp0=shm3+LDS_V+((lane>>4)&1)*32+(lane&3)*8+(4*hi+((lane&15)>>2))*64;
  const int NT=U.NT;
  DMA_K(0,0);DMA_V(0,0);DMA_K(1,SLOTB);
  bf16x8 qr[4];
  #pragma unroll
  for(int d0=0;d0<4;++d0)qr[d0]=*reinterpret_cast<const bf16x8*>(&Qw[(long)r32*qp+d0*16+hi*8]);
  float mhat=0.f,l_reg=0.f;f32x16 o[4];o[0]=f32x16{};o[1]=f32x16{};o[2]=f32x16{};o[3]=f32x16{};
  const int qrel=wid*QBLK+r32;
  #define CMASK(P0,P1,t) do{int jb_=(t)-(NT-4); if(WINDOW||(CAUSAL&&jb_>=0))cmask<CAUSAL,WINDOW>(P0,P1,jb_,qrel,hi);}while(0)
  bf16x8 kx0,kx1,qx;
  { const float k0_=ALIBI?slope2*(float)r32:0.f, k1_=ALIBI?slope2*(float)(r32+32):0.f; const unsigned h0=bfr(k0_),l0=bfr(k0_-bfv(h0)),h1=bfr(k1_),l1=bfr(k1_-bfv(h1));
    u32x4 a={0x3f803f80u,0x3f80u|(h0<<16),l0,0u}, b={0x3f803f80u,0x3f80u|(h1<<16),l1,0u}; if(hi){a=u32x4{0u,0u,0u,0u};b=a;} kx0=__builtin_bit_cast(bf16x8,a); kx1=__builtin_bit_cast(bf16x8,b); }
  #define QX_SET(t) do{ const float nb_=ALIBI?__builtin_fmaf(slope2,(float)(64*((t)-(NT-4))-qrel),-mhat):-mhat; const unsigned a_=bfr(nb_); const float r1_=nb_-bfv(a_); const unsigned b_=bfr(r1_); const unsigned c_=bfr(r1_-bfv(b_)); \
    u32x4 q_={a_|(b_<<16),c_|0x3f800000u,0x3f80u,0u}; if(hi)q_=u32x4{0u,0u,0u,0u}; qx=__builtin_bit_cast(bf16x8,q_); asm volatile("":"+v"(qx)); }while(0)
  bool resc=false;
  #define START(P0,P1) do{ const float rm=rowmax(P0,P1); resc=false; \
    { const float dl=(rm==-INFINITY)?0.f:rm; mhat=fadd_s(mhat,dl); \
      _Pragma("unroll") for(int r=0;r<16;++r){P0[r]=fsub_s(P0[r],dl);P1[r]=fsub_s(P1[r],dl);} } \
    _Pragma("unroll") for(int r=0;r<16;++r)P0[r]=__builtin_amdgcn_exp2f(P0[r]); }while(0)
  #define RESC() do{ if(resc){ asm volatile("s_waitcnt lgkmcnt(0)":::"memory"); \
      _Pragma("unroll") for(int d_=0;d_<2*VMUL;++d_) _Pragma("unroll") for(int r=0;r<16;++r)o[d_][r]*=wsf[crow(r,hi)]; } }while(0)
  f32x16 pA0,pA1,pB0,pB1;
  int sl_prev=0,sl_cur=0,sl_next=SLOTB;
  #define ROT() do{sl_prev=sl_cur;sl_cur=sl_next;sl_next=(sl_next==(NSLOT-1)*SLOTB)?0:sl_next+SLOTB;}while(0)
  DMA_K(2,2*SLOTB);
  if constexpr(DV==128){WAIT_BAR(4);}else{WAIT_BAR(3);}
  QX_SET(0);
  qkt(pA0,pA1,Kbase,qr,kx0,kx1,qx,r32,hi);asm volatile("s_nop 15\n\ts_nop 7":"+v"(pA0),"+v"(pA1));CMASK(pA0,pA1,0);
  START(pA0,pA1);
  _Pragma("unroll") for(int r=0;r<16;++r)pA1[r]=__builtin_amdgcn_exp2f(pA1[r]);
  WAIT_BAR(0);
  DMA_K(3,0);DMA_V(1,SLOTB);
  ROT();
  kload8(kf,kp0+sl_cur);
  if constexpr(DV==128){WAIT_BAR(3);}else{WAIT_BAR(2);}
  s16x4 vlo[8],vhi[8]; s16x4 vfl[4],vfh[4]; u32x4 pw0,pw1,pw2,pw3;
  #define PKW(P,B) cvtpk_s(P[B],P[B+1])
  #define PAF(k) __builtin_bit_cast(bf16x8,pw##k)
  #define VFR(i) (bf16x8){vlo[i][0],vlo[i][1],vlo[i][2],vlo[i][3],vhi[i][0],vhi[i][1],vhi[i][2],vhi[i][3]}
  #define PIN(x) asm volatile("":"+v"(x))
  #define MX3(a,b,c) __builtin_fmaxf(__builtin_fmaxf((a),(b)),(c))
  #define GAPA(MF,A0,A1,A2,A3,W0,W1,PW) do{ MF; sacc+=A0; sacc+=A1; sacc+=A2; sacc+=A3; PIN(sacc); W0; W1; PIN(PW); SBAR(); }while(0)
  #define EX(v) __builtin_amdgcn_exp2f(v)
  #define GAPB(MF,X,B) do{ MF; X[B]=EX(X[B]); X[B+1]=EX(X[B+1]); X[B+2]=EX(X[B+2]); X[B+3]=EX(X[B+3]); PIN(X); SBAR(); }while(0)
  #define VRD(i) do{ if constexpr(DV==64){ vlo[i]=vtr(vp_+(((i)>>2)*4096+((i)&3)*1024)); vhi[i]=vtr(vp_+(((i)>>2)*4096+((i)&3)*1024+512)); } }while(0)
  #define VRJ(f) do{ vfl[(f)&3]=vtr(vp_+(((f)&3)*4096+((f)>>2)*1024)); vfh[(f)&3]=vtr(vp_+(((f)&3)*4096+((f)>>2)*1024+512)); }while(0)
  #define VFJ(f) (bf16x8){vfl[(f)&3][0],vfl[(f)&3][1],vfl[(f)&3][2],vfl[(f)&3][3],vfh[(f)&3][0],vfh[(f)&3][1],vfh[(f)&3][2],vfh[(f)&3][3]}
  #define GAPJ(f,PA,X,B) do{ if((f)+3<16){VRJ((f)+3);} o[(f)&3]=__builtin_amdgcn_mfma_f32_32x32x16_bf16(PA,VFJ(f),o[(f)&3],0,0,0); X[B]=EX(X[B]); X[B+1]=EX(X[B+1]); PIN(X); SBAR(); }while(0)
  #define KRD(G,j) do{ if(G){ kload2(kf,kp0+sl_next,j); SBAR(); } }while(0)
  #define STEP(C0,C1,P0,P1,t,GK,GV,GL) do{ SBAR(); QX_SET(t); SBAR(); \
    const lds_cptr vp_=vp0+VMUL*sl_prev; \
    VRD(0); SBAR(); float sacc=(P0[0]+P0[1]); \
    GAPA(C0=__builtin_amdgcn_mfma_f32_32x32x16_bf16(kf[0],qr[0],f32x16{},0,0,0), P0[2],P0[3],P0[4],P0[5],     pw0[0]=PKW(P0,0), pw0[1]=PKW(P0,2), pw0); \
    VRD(4); SBAR(); GAPA(C1=__builtin_amdgcn_mfma_f32_32x32x16_bf16(kf[1],qr[0],f32x16{},0,0,0), P0[6],P0[7],P0[8],P0[9],     pw0[2]=PKW(P0,4), pw0[3]=PKW(P0,6), pw0); \
    VRD(1); SBAR(); GAPA(C0=__builtin_amdgcn_mfma_f32_32x32x16_bf16(kf[2],qr[1],C0,0,0,0),   P0[10],P0[11],P0[12],P0[13], pw1[0]=PKW(P0,8), pw1[1]=PKW(P0,10), pw1); \
    VRD(5); SBAR(); GAPA(C1=__builtin_amdgcn_mfma_f32_32x32x16_bf16(kf[3],qr[1],C1,0,0,0),   P0[14],P0[15],P1[0],P1[1],   pw1[2]=PKW(P0,12),pw1[3]=PKW(P0,14), pw1); \
    VRD(2); SBAR(); GAPA(C0=__builtin_amdgcn_mfma_f32_32x32x16_bf16(kf[4],qr[2],C0,0,0,0),   P1[2],P1[3],P1[4],P1[5],     pw2[0]=PKW(P1,0), pw2[1]=PKW(P1,2), pw2); \
    VRD(6); SBAR(); GAPA(C1=__builtin_amdgcn_mfma_f32_32x32x16_bf16(kf[5],qr[2],C1,0,0,0),   P1[6],P1[7],P1[8],P1[9],     pw2[2]=PKW(P1,4), pw2[3]=PKW(P1,6), pw2); \
    VRD(3); SBAR(); GAPA(C0=__builtin_amdgcn_mfma_f32_32x32x16_bf16(kf[6],qr[3],C0,0,0,0),   P1[10],P1[11],P1[12],P1[13], pw3[0]=PKW(P1,8), pw3[1]=PKW(P1,10), pw3); \
    VRD(7); SBAR(); GAPA(C1=__builtin_amdgcn_mfma_f32_32x32x16_bf16(kf[7],qr[3],C1,0,0,0),   P1[14],P1[15],0.f,0.f,       pw3[2]=PKW(P1,12),pw3[3]=PKW(P1,14), pw3); \
    C0=__builtin_amdgcn_mfma_f32_32x32x16_bf16(kx0,qx,C0,0,0,0); C1=__builtin_amdgcn_mfma_f32_32x32x16_bf16(kx1,qx,C1,0,0,0); if constexpr(DV==128){VRJ(0);VRJ(1);VRJ(2);} SBAR(); \
    l_reg+=sacc; \
    if(GK){DMA_K((t)+3,sl_cur);} if(GV){DMA_V((t)+1,sl_next);} \
    CMASK(C0,C1,t); \
    { float a=MX3(C0[0],C0[1],C1[0]),b=MX3(C0[2],C0[3],C1[1]); a=MX3(a,C1[2],C1[3]); \
      _Pragma("unroll") for(int r=4;r<16;r+=4){a=MX3(a,C0[r],C0[r+1]);b=MX3(b,C0[r+2],C0[r+3]);a=MX3(a,C1[r],C1[r+1]);b=MX3(b,C1[r+2],C1[r+3]);} \
      float rm=__builtin_fmaxf(a,b); { auto rr=__builtin_amdgcn_permlane32_swap(__float_as_uint(rm),__float_as_uint(rm),false,false); rm=__builtin_fmaxf(__uint_as_float(rr[0]),__uint_as_float(rr[1])); } \
      resc=false; \
      if(__builtin_expect(__any(rm>(float)THRL),0)){ const float dl=__builtin_fmaxf(rm,0.f); mhat+=dl; \
        _Pragma("unroll") for(int r=0;r<16;++r){C0[r]-=dl;C1[r]-=dl;} \
        const float f=__builtin_amdgcn_exp2f(-dl); l_reg*=f; if(hi==0)wsf[r32]=f; resc=true; } } \
    SBAR(); \
    if constexpr(DV==64){ \
    GAPB(o[0]=__builtin_amdgcn_mfma_f32_32x32x16_bf16(PAF(0),VFR(0),o[0],0,0,0), C0,0); \
    GAPB(o[1]=__builtin_amdgcn_mfma_f32_32x32x16_bf16(PAF(0),VFR(4),o[1],0,0,0), C0,4); \
    KRD(GL,0); GAPB(o[0]=__builtin_amdgcn_mfma_f32_32x32x16_bf16(PAF(1),VFR(1),o[0],0,0,0), C0,8); \
    KRD(GL,1); GAPB(o[1]=__builtin_amdgcn_mfma_f32_32x32x16_bf16(PAF(1),VFR(5),o[1],0,0,0), C0,12); \
    KRD(GL,2); GAPB(o[0]=__builtin_amdgcn_mfma_f32_32x32x16_bf16(PAF(2),VFR(2),o[0],0,0,0), C1,0); \
    KRD(GL,3); GAPB(o[1]=__builtin_amdgcn_mfma_f32_32x32x16_bf16(PAF(2),VFR(6),o[1],0,0,0), C1,4); \
    GAPB(o[0]=__builtin_amdgcn_mfma_f32_32x32x16_bf16(PAF(3),VFR(3),o[0],0,0,0), C1,8); \
    GAPB(o[1]=__builtin_amdgcn_mfma_f32_32x32x16_bf16(PAF(3),VFR(7),o[1],0,0,0), C1,12); \
    } else { \
    GAPJ(0,PAF(0),C0,0); GAPJ(1,PAF(0),C0,2); GAPJ(2,PAF(0),C0,4); GAPJ(3,PAF(0),C0,6); \
    KRD(GL,0); GAPJ(4,PAF(1),C0,8); GAPJ(5,PAF(1),C0,10); KRD(GL,1); GAPJ(6,PAF(1),C0,12); GAPJ(7,PAF(1),C0,14); \
    KRD(GL,2); GAPJ(8,PAF(2),C1,0); GAPJ(9,PAF(2),C1,2); KRD(GL,3); GAPJ(10,PAF(2),C1,4); GAPJ(11,PAF(2),C1,6); \
    GAPJ(12,PAF(3),C1,8); GAPJ(13,PAF(3),C1,10); GAPJ(14,PAF(3),C1,12); GAPJ(15,PAF(3),C1,14); \
    } \
    }while(0)
  int t=1;
  #undef CMASK
  #define CMASK(P0,P1,t) do{}while(0)
  for(;t+5<NT;t+=2){
    STEP(pB0,pB1,pA0,pA1,t,true,true,true);     if constexpr(DV==128){WAIT_BAR(3);}else{WAIT_BAR(2);} RESC(); ROT();
    STEP(pA0,pA1,pB0,pB1,t+1,true,true,true);   if constexpr(DV==128){WAIT_BAR(3);}else{WAIT_BAR(2);} RESC(); ROT();
  }
  #undef CMASK
  #define CMASK(P0,P1,t) do{int jb_=(t)-(NT-4); if(WINDOW||(CAUSAL&&jb_>=0))cmask<CAUSAL,WINDOW>(P0,P1,jb_,qrel,hi);}while(0)
  #define ENDW(tt) do{ if((tt)+3<NT){ if constexpr(DV==128){WAIT_BAR(3);}else{WAIT_BAR(2);} } else if((tt)+2<NT){ if constexpr(DV==128){WAIT_BAR(2);}else{WAIT_BAR(1);} } else {WAIT_BAR(0);} }while(0)
  for(;t+1<NT;t+=2){
    STEP(pB0,pB1,pA0,pA1,t,(t+3<NT),(t+1<NT),(t+1<NT));       ENDW(t);   RESC(); ROT();
    STEP(pA0,pA1,pB0,pB1,t+1,(t+4<NT),(t+2<NT),(t+2<NT));     ENDW(t+1); RESC(); ROT();
  }
  STEP(pB0,pB1,pA0,pA1,NT-1,false,false,false); RESC();
  { float sacc=pB0[0]+pB0[1]; _Pragma("unroll") for(int r=2;r<16;++r)sacc+=pB0[r]; _Pragma("unroll") for(int r=0;r<16;++r)sacc+=pB1[r]; l_reg+=sacc;
    pw0=(u32x4){PKW(pB0,0),PKW(pB0,2),PKW(pB0,4),PKW(pB0,6)};pw1=(u32x4){PKW(pB0,8),PKW(pB0,10),PKW(pB0,12),PKW(pB0,14)};pw2=(u32x4){PKW(pB1,0),PKW(pB1,2),PKW(pB1,4),PKW(pB1,6)};pw3=(u32x4){PKW(pB1,8),PKW(pB1,10),PKW(pB1,12),PKW(pB1,14)};
    SBAR(); if constexpr(DV==128){pv128(o,vb0+VMUL*sl_cur,PAF(0),PAF(1),PAF(2),PAF(3));}else{pv(o,vb0+sl_cur,PAF(0),PAF(1),PAF(2),PAF(3));} }
  #undef PKW
  #undef PAF
  #undef VFR
  #undef PIN
  #undef MX3
  #undef GAPA
  #undef GAPB
  #undef EX
  #undef VRD
  #undef VRJ
  #undef VFJ
  #undef GAPJ
  #undef KRD
  #undef STEP
  #undef ENDW
  {auto rr=__builtin_amdgcn_permlane32_swap(__float_as_uint(l_reg),__float_as_uint(l_reg),false,false);l_reg=__uint_as_float(rr[0])+__uint_as_float(rr[1]);}
  if(LSE){ if(hi==0)U.lse[(long)(q0+wid*QBLK+r32)*U.lse_stride]=mhat+__builtin_amdgcn_logf(l_reg); }
  if(hi==0)wsf[32+r32]=l_reg;asm volatile("s_waitcnt lgkmcnt(0)":::"memory");
  float rli[16];
  #pragma unroll
  for(int r=0;r<16;++r)rli[r]=__builtin_amdgcn_rcpf(wsf[32+crow(r,hi)]);
  bf16*Ow=U.O+(long)(q0+wid*QBLK)*op;
  { bf16*stg=(bf16*)(shm+LDS_OST)+wid*(2048*VMUL);
    #pragma unroll
    for(int r=0;r<16;++r){const int orow=crow(r,hi);
      #pragma unroll
      for(int d0=0;d0<2*VMUL;++d0)stg[orow*DV+d0*32+r32]=__float2bfloat16(o[d0][r]*rli[r]);}
    asm volatile("s_waitcnt lgkmcnt(0)":::"memory");
    if constexpr(DV==128){
      #pragma unroll
      for(int i=0;i<8;++i){const int row=i*4+(lane>>4),ch=lane&15; const u32x4 v=*(const u32x4*)(stg+row*128+ch*8); ATTN_STORE16(Ow+(long)row*op+ch*8,v);}
    } else {
      #pragma unroll
      for(int i=0;i<4;++i){const int row=i*8+(lane>>3),ch=lane&7; const u32x4 v=*(const u32x4*)(stg+row*64+ch*8); ATTN_STORE16(Ow+(long)row*op+ch*8,v);} } }
  asm volatile("s_waitcnt lgkmcnt(0)\n\ts_barrier":::"memory");
  #undef DMA_K
  #undef DMA_V
  #undef CMASK
  #undef START
  #undef RESC
  #undef ROT
  #undef QX_SET
}
constexpr int ATTN_LDS_BYTES=Lds<128>::BYTES;
#undef SBAR
#undef WAIT_BAR
}
constexpr size_t MiB = 1u << 20;
constexpr size_t WS_CTL = 0, CTL_ZERO_BYTES = 1 * MiB;
constexpr size_t WS_LIST = 1 * MiB;
constexpr size_t WS_RGATE = 5 * MiB;
constexpr size_t WS_RSTD1 = 5 * MiB + 512 * 1024, WS_RSTD2 = WS_RSTD1 + 128 * 1024, WS_WRG = WS_RSTD2 + 128 * 1024;
constexpr size_t WS_WRT = 7 * MiB + 512 * 1024;
constexpr size_t WS_LSE = 6 * MiB;
constexpr size_t WS_MKV = 8 * MiB;
constexpr size_t WS_WIN = 10 * MiB, WS_WOUT = 15 * MiB, WS_WGU = 17 * MiB, WS_WDN = 145 * MiB;
constexpr size_t WS_XB = 209 * MiB;
constexpr size_t WS_LRSTD = 865 * MiB, WS_LGATE = 869 * MiB;
constexpr size_t WS_P = 273 * MiB, WS_OD = 433 * MiB, WS_ODIL = 497 * MiB;
constexpr size_t WS_ACT = 273 * MiB;
constexpr size_t WS_OMEM = 873 * MiB;
constexpr size_t WS_MIX = 545 * MiB, WS_X1B = 609 * MiB, WS_YB = 673 * MiB, WS_X1H = 801 * MiB, WS_Y = 929 * MiB, WS_END = 993 * MiB;
constexpr int CW_TMO = 0, CW_CODE = 1;
constexpr int CW_CNT = 64;
constexpr int CW_NRM = 256;
constexpr int CW_Q = 1024;
constexpr int CW_BAR = 4096;

constexpr int RING_OFF = 0, RING_BYTES = 131072;
constexpr int LDSCTL_OFF = RING_BYTES;
constexpr int IDB_OFF = LDSCTL_OFF;
constexpr int TBL_OFF = IDB_OFF + 9216;
constexpr int LCNT_OFF = TBL_OFF + 2304;
constexpr int MISC_OFF = LCNT_OFF + 256;
constexpr int STG_OFF = IDB_OFF;
constexpr int LDS_BYTES = 147456;
static_assert(MISC_OFF + 128 <= LDS_BYTES && 512 * 16 <= 9216, "LDS map");
constexpr int NWAVES = 8;

#define GAS __attribute__((address_space(1)))
#define LAS __attribute__((address_space(3)))
typedef unsigned short bf16;
typedef unsigned v4u __attribute__((ext_vector_type(4)));
typedef unsigned v2u __attribute__((ext_vector_type(2)));
typedef float f32x4 __attribute__((ext_vector_type(4)));
typedef float f32x16 __attribute__((ext_vector_type(16)));
typedef short bf16x8 __attribute__((ext_vector_type(8)));
typedef GAS unsigned gu32;
#define RLX_AGENT __ATOMIC_RELAXED, __HIP_MEMORY_SCOPE_AGENT
#define LDS_WAIT() asm volatile("s_waitcnt lgkmcnt(0)" ::: "memory")
#define VM_WAIT() asm volatile("s_waitcnt vmcnt(0)" ::: "memory")
__device__ __forceinline__ unsigned f2bf(float f) { unsigned u = __builtin_bit_cast(unsigned, f); return (u + 0x7fffu + ((u >> 16) & 1u)) >> 16; }
__device__ __forceinline__ unsigned pk2(float lo, float hi) { return f2bf(lo) | (f2bf(hi) << 16); }
__device__ __forceinline__ float sat8(float v) { return __builtin_amdgcn_fmed3f(v, -448.f, 448.f); }
__device__ __forceinline__ unsigned fp8x4(float a, float b, float c, float d) { int w = __builtin_amdgcn_cvt_pk_fp8_f32(sat8(a), sat8(b), 0, false); w = __builtin_amdgcn_cvt_pk_fp8_f32(sat8(c), sat8(d), w, true); return (unsigned)w; }
constexpr float MSCALE = 16.f;
constexpr float WSCALE = 64.f, ASCALE = 8.f, YSCALE = 64.f;
__device__ __forceinline__ float bf2f(unsigned short b) { return __builtin_bit_cast(float, (unsigned)b << 16); }
__device__ __forceinline__ float bflo(unsigned w) { return __builtin_bit_cast(float, w << 16); }
__device__ __forceinline__ float bfhi(unsigned w) { return __builtin_bit_cast(float, w & 0xffff0000u); }
__device__ __forceinline__ float wave_sum(float v) {
#pragma unroll
    for (int o = 1; o < 64; o <<= 1) v += __shfl_xor(v, o);
    return v;
}

#define XB_TMO      128
#define XB_XCNT(j)  (256  + 64 * (j))
#define XB_XSUB(j)  (1280 + 64 * (j))
#define XB_XGEN(j)  (2304 + 64 * (j))
#define XB_TOP      3328
#define XB_TOPGEN   3392
#define XCD_BAR_WORDS 3456
#define XB_SPIN_CAP (1u << 20)
__device__ __forceinline__ unsigned xb_ld(unsigned* p)              { return __hip_atomic_load(p, __ATOMIC_RELAXED, __HIP_MEMORY_SCOPE_AGENT); }
__device__ __forceinline__ unsigned xb_add(unsigned* p, unsigned v) { return __hip_atomic_fetch_add(p, v, __ATOMIC_RELAXED, __HIP_MEMORY_SCOPE_AGENT); }
__device__ __forceinline__ unsigned xb_xcc_id() { return (unsigned)__builtin_amdgcn_s_getreg((3 << 11) | 20) & 0xFu; }
#define XB_SPIN(cond, bar) do { unsigned _sp = 0; while (cond) { __builtin_amdgcn_s_sleep(1); \
    if ((++_sp & 255u) == 0u) { if (xb_ld(&(bar)[XB_TMO])) break; if (_sp > XB_SPIN_CAP) { atomicAdd(&(bar)[XB_TMO], 1u); break; } } } } while (0)
struct XcdBarrier { unsigned* bar; unsigned x; volatile LAS unsigned* st; };
__device__ __forceinline__ XcdBarrier xcd_barrier_post(unsigned* bar, volatile LAS unsigned* st, const bool lead) {
    XcdBarrier b; b.bar = bar; b.x = xb_xcc_id(); b.st = st;
    if (lead) (void)xb_add(&bar[XB_XCNT(b.x)], 1u);
    return b;
}
__device__ __forceinline__ void xcd_barrier_complete(unsigned* bar, unsigned x, unsigned& nloc, unsigned& nx) {
    const unsigned G = gridDim.x * gridDim.y * gridDim.z;
    unsigned sum, cnt, mine, sp = 0u;
    for (;;) {
        sum = 0u; cnt = 0u; mine = 0u;
#pragma unroll
        for (unsigned j = 0; j < 16; ++j) { const unsigned c = xb_ld(&bar[XB_XCNT(j)]); sum += c; cnt += (c > 0u) ? 1u : 0u; mine = (j == x) ? c : mine; }
        if (sum == G) break;
        __builtin_amdgcn_s_sleep(1);
        if ((++sp & 255u) == 0u) { if (xb_ld(&bar[XB_TMO])) break; if (sp > XB_SPIN_CAP) { atomicAdd(&bar[XB_TMO], 1u); break; } }
    }
    nloc = mine > 0u ? mine : 1u; nx = cnt > 0u ? cnt : 1u;
}
__device__ __forceinline__ void xcd_barrier(const XcdBarrier& b, const bool lead) {
    asm volatile("s_waitcnt vmcnt(0)" ::: "memory");
    __syncthreads();
    if (lead) {
        unsigned* bar = b.bar;
        __builtin_amdgcn_s_waitcnt(0);
        unsigned nloc = b.st[0], nx = b.st[1];
        if (nloc == 0u) { xcd_barrier_complete(bar, b.x, nloc, nx); b.st[0] = nloc; b.st[1] = nx; }
        const unsigned old = xb_add(&bar[XB_XSUB(b.x)], 1u);
        const unsigned gen = old / nloc;
        if (old + 1u == (gen + 1u) * nloc) {
            __builtin_amdgcn_fence(__ATOMIC_RELEASE, "agent");
            asm volatile("s_waitcnt vmcnt(0)" ::: "memory");
            const unsigned og = xb_add(&bar[XB_TOP], 1u);
            const unsigned tg = og / nx;
            if (og + 1u == (tg + 1u) * nx) xb_add(&bar[XB_TOPGEN], 1u);
            else XB_SPIN(xb_ld(&bar[XB_TOPGEN]) == tg, bar);
            __builtin_amdgcn_fence(__ATOMIC_ACQUIRE, "agent");
            xb_add(&bar[XB_XGEN(b.x)], 1u);
            asm volatile("s_waitcnt vmcnt(0)" ::: "memory");
        } else {
            XB_SPIN(xb_ld(&bar[XB_XGEN(b.x)]) == gen, bar);
            __builtin_amdgcn_fence(__ATOMIC_ACQUIRE, "agent");
            asm volatile("s_waitcnt vmcnt(0)" ::: "memory");
        }
    }
    __syncthreads();
}

struct Frame {
    LAS unsigned char* lds;
    volatile LAS unsigned* MISC;
    gu32* ctl;
    int tid, lane, wave;
    int vcu, G;
    const float *x, *mem, *g_attn, *g_mem, *w_in, *lamqk, *subg, *w_mkv, *w_out, *g_ffn, *w_r, *b_r, *w_gu, *b_gu, *w_dn, *b_dn, *g_fin;
    float* out; unsigned char* ws;
};

#define P0_LOAD(dst, itm) do { const int m_ = (itm) / ipm, r_ = (itm) % ipm, kb_ = r_ / nblk, nb_ = r_ % nblk; \
        const float* src_ = W + (size_t)m_ * K * N + (size_t)(64 * kb_ + (lane >> 5)) * N + 32 * nb_ + (lane & 31); \
        _Pragma("unroll") for (int i_ = 0; i_ < 32; ++i_) dst[i_] = src_[(size_t)(2 * i_) * N]; } while (0)
template <bool F8, bool GAIN, class RowMap>
__device__ __forceinline__ void p0_transpose_all(const float* W, int K, int N, int nmat, void* WTv, const float* gk, float wscale, LAS float* scr, int gw, int NGW, int lane, RowMap rowmap) {
    asm volatile("" : "+v"(lane));
    const int nblk = N / 32, ipm = (K / 64) * nblk, total = nmat * ipm;
    if (gw >= total) return;
    LAS float* gl = scr + 64 * 33;
    if constexpr (GAIN) { for (int i = lane; i < K; i += 64) gl[i] = gk[i] * wscale; LDS_WAIT(); asm volatile("" ::: "memory"); }
#define P0_PROC(v, itm) do { const int m = (itm) / ipm, r = (itm) % ipm, k0 = 64 * (r / nblk), n0 = 32 * (r % nblk); \
        if constexpr (GAIN) { _Pragma("unroll") for (int i = 0; i < 32; ++i) v[i] *= gl[k0 + 2 * i + (lane >> 5)]; } \
        else if (F8) { _Pragma("unroll") for (int i = 0; i < 32; ++i) v[i] *= wscale; } \
        _Pragma("unroll") for (int i = 0; i < 32; ++i) scr[(2 * i + (lane >> 5)) * 33 + (lane & 31)] = v[i]; \
        LDS_WAIT(); asm volatile("" ::: "memory"); \
        const int c = lane & 7; \
        _Pragma("unroll") for (int j = 0; j < 4; ++j) { const int n = (lane >> 3) + 8 * j; const LAS float* s = scr + (8 * c) * 33 + n; \
            if constexpr (F8) { unsigned char* wt = (unsigned char*)WTv + (size_t)m * N * K; \
                v2u o; o.x = fp8x4(s[0 * 33], s[1 * 33], s[2 * 33], s[3 * 33]); o.y = fp8x4(s[4 * 33], s[5 * 33], s[6 * 33], s[7 * 33]); \
                *(GAS v2u*)(wt + (size_t)rowmap(n0 + n) * K + k0 + 8 * c) = o; } \
            else { bf16* wt = (bf16*)WTv + (size_t)m * N * K; \
                v4u o; o.x = pk2(s[0 * 33], s[1 * 33]); o.y = pk2(s[2 * 33], s[3 * 33]); o.z = pk2(s[4 * 33], s[5 * 33]); o.w = pk2(s[6 * 33], s[7 * 33]); \
                *(GAS v4u*)(wt + (size_t)rowmap(n0 + n) * K + k0 + 8 * c) = o; } } \
        LDS_WAIT(); asm volatile("" ::: "memory"); } while (0)
    float va[32], vb[32], vc[32];
    int it = gw;
    P0_LOAD(va, it); if (it + NGW < total) P0_LOAD(vb, it + NGW);
    for (;;) {
        if (it + 2 * NGW < total) P0_LOAD(vc, it + 2 * NGW);
        P0_PROC(va, it); it += NGW; if (it >= total) break;
        if (it + 2 * NGW < total) P0_LOAD(va, it + 2 * NGW);
        P0_PROC(vb, it); it += NGW; if (it >= total) break;
        if (it + 2 * NGW < total) P0_LOAD(vb, it + 2 * NGW);
        P0_PROC(vc, it); it += NGW; if (it >= total) break;
    }
#undef P0_PROC
}
#undef P0_LOAD
struct RowId { __device__ __forceinline__ int operator()(int n) const { return n; } };
struct RowGU { __device__ __forceinline__ int operator()(int n) const { const int f = n >> 1, u = n & 1; return ((f >> 7) << 8) + (u << 7) + (f & 127); } };

__device__ __forceinline__ void p0_x_rows4(Frame& F, const float* xrow, bf16* orow, float* rstd_out) {
    const GAS f32x4* xr = (const GAS f32x4*)xrow + F.lane;
    f32x4 v[16]; float s[4] = {0.f, 0.f, 0.f, 0.f};
#pragma unroll
    for (int j = 0; j < 16; ++j) v[j] = xr[64 * j];
#pragma unroll
    for (int j = 0; j < 16; ++j) s[j >> 2] += (v[j].x * v[j].x + v[j].y * v[j].y) + (v[j].z * v[j].z + v[j].w * v[j].w);
    GAS unsigned long long* o8 = (GAS unsigned long long*)orow + F.lane;
#pragma unroll
    for (int j = 0; j < 16; ++j) o8[64 * j] = (unsigned long long)pk2(v[j].x, v[j].y) | ((unsigned long long)pk2(v[j].z, v[j].w) << 32);
#pragma unroll
    for (int q = 0; q < 4; ++q) s[q] = wave_sum(s[q]);
    if (F.lane < 4) rstd_out[F.lane] = 1.f / sqrtf((F.lane == 0 ? s[0] : F.lane == 1 ? s[1] : F.lane == 2 ? s[2] : s[3]) * (1.f / D) + EPS);
}
__device__ __forceinline__ void p0_mkv_tile(Frame& F, int tile, bf16* mkv, const float* xsrc, bf16* xdst, float* rstd_out, int xstep) {
    const int mt = tile >> 4, nt = tile & 15, m0 = 32 * mt, n0 = 32 * nt, r = F.lane & 31, h = F.lane >> 5, kh = F.wave >> 2, tw = F.wave & 3;
    f32x16 acc = {}; float ss = 0.f;
    LAS float* blk = (LAS float*)(F.lds + RING_OFF + F.wave * 12288);
    LAS float* gl = (LAS float*)(F.lds + RING_OFF + 98304);
    for (int i = F.tid; i < D; i += NWAVES * 64) gl[i] = F.g_mem[i];
    __syncthreads();
    const float* msrc = F.mem + (size_t)(m0 + (F.lane >> 4)) * D + kh * 512 + 4 * (F.lane & 15);
    const float* wcol = F.w_mkv + (size_t)(8 * h + kh * 512) * 512 + n0 + r;
    f32x4 ma[8], mb[8]; float wa[32], wb[32];
#define MKV_LD(M, W, kk_) do { _Pragma("unroll") for (int i_ = 0; i_ < 8; ++i_) M[i_] = *(const f32x4*)(msrc + (size_t)(4 * i_) * D + (kk_)); \
        _Pragma("unroll") for (int s_ = 0; s_ < 4; ++s_) _Pragma("unroll") for (int j_ = 0; j_ < 8; ++j_) W[8 * s_ + j_] = wcol[(size_t)((kk_) + 16 * s_ + j_) * 512]; } while (0)
#define MKV_MM(M, W, kk_) do { _Pragma("unroll") for (int i_ = 0; i_ < 8; ++i_) *(LAS f32x4*)(blk + (4 * i_ + (F.lane >> 4)) * 68 + 4 * (F.lane & 15)) = M[i_]; \
        LDS_WAIT(); asm volatile("" ::: "memory"); \
        _Pragma("unroll") for (int s_ = 0; s_ < 4; ++s_) { const LAS float* ap_ = blk + r * 68 + 16 * s_ + 8 * h; const LAS float* gq_ = gl + kh * 512 + (kk_) + 16 * s_ + 8 * h; \
            const f32x4 a0 = *(const LAS f32x4*)ap_, a1 = *(const LAS f32x4*)(ap_ + 4), g0 = *(const LAS f32x4*)gq_, g1 = *(const LAS f32x4*)(gq_ + 4); \
            ss += (a0.x * a0.x + a0.y * a0.y) + (a0.z * a0.z + a0.w * a0.w) + (a1.x * a1.x + a1.y * a1.y) + (a1.z * a1.z + a1.w * a1.w); \
            v4u bw_; bw_.x = pk2(a0.x * g0.x, a0.y * g0.y); bw_.y = pk2(a0.z * g0.z, a0.w * g0.w); bw_.z = pk2(a1.x * g1.x, a1.y * g1.y); bw_.w = pk2(a1.z * g1.z, a1.w * g1.w); \
            v4u aw_; aw_.x = pk2(W[8 * s_], W[8 * s_ + 1]); aw_.y = pk2(W[8 * s_ + 2], W[8 * s_ + 3]); aw_.z = pk2(W[8 * s_ + 4], W[8 * s_ + 5]); aw_.w = pk2(W[8 * s_ + 6], W[8 * s_ + 7]); \
            acc = __builtin_amdgcn_mfma_f32_32x32x16_bf16(__builtin_bit_cast(bf16x8, aw_), __builtin_bit_cast(bf16x8, bw_), acc, 0, 0, 0); } \
        LDS_WAIT(); asm volatile("" ::: "memory"); } while (0)
    f32x4 xv[8];
#define X_LD(m_) do { const GAS f32x4* xr_ = (const GAS f32x4*)(xsrc + (size_t)(m_) * D) + F.lane; _Pragma("unroll") for (int j_ = 0; j_ < 8; ++j_) xv[j_] = xr_[64 * j_]; } while (0)
#define X_PROC(m_) do { float s0_ = 0.f, s1_ = 0.f; \
        _Pragma("unroll") for (int j_ = 0; j_ < 4; ++j_) { s0_ += (xv[j_].x * xv[j_].x + xv[j_].y * xv[j_].y) + (xv[j_].z * xv[j_].z + xv[j_].w * xv[j_].w); \
            s1_ += (xv[4 + j_].x * xv[4 + j_].x + xv[4 + j_].y * xv[4 + j_].y) + (xv[4 + j_].z * xv[4 + j_].z + xv[4 + j_].w * xv[4 + j_].w); } \
        GAS unsigned long long* o8_ = (GAS unsigned long long*)(xdst + (size_t)(m_) * D) + F.lane; \
        _Pragma("unroll") for (int j_ = 0; j_ < 8; ++j_) o8_[64 * j_] = (unsigned long long)pk2(xv[j_].x, xv[j_].y) | ((unsigned long long)pk2(xv[j_].z, xv[j_].w) << 32); \
        s0_ = wave_sum(s0_); s1_ = wave_sum(s1_); \
        if (F.lane < 2) rstd_out[(m_) + F.lane] = 1.f / sqrtf((F.lane == 0 ? s0_ : s1_) * (1.f / D) + EPS); } while (0)
    MKV_LD(ma, wa, 0);
    int xm = 0;
#pragma nounroll
    for (int kk = 0; kk < 512; kk += 128) {
        X_LD(xm); __builtin_amdgcn_sched_barrier(0);
        MKV_LD(mb, wb, kk + 64); MKV_MM(ma, wa, kk); __builtin_amdgcn_sched_barrier(0);
        X_PROC(xm); X_LD(xm + 2); __builtin_amdgcn_sched_barrier(0);
        MKV_LD(ma, wa, min(kk + 128, 448)); MKV_MM(mb, wb, kk + 64); __builtin_amdgcn_sched_barrier(0);
        X_PROC(xm + 2); xm += xstep;
    }
#undef X_LD
#undef X_PROC
#undef MKV_LD
#undef MKV_MM
    LAS float* xc = (LAS float*)(F.lds + RING_OFF + 8 * 16384 - 4 * 64 * 17 * 4) + (tw * 64 + F.lane) * 17;
    if (kh == 1) {
#pragma unroll
        for (int i = 0; i < 16; ++i) xc[i] = acc[i];
        xc[16] = ss; }
    __syncthreads();
    if (kh == 0) {
#pragma unroll
        for (int i = 0; i < 16; ++i) acc[i] += xc[i];
        ss += xc[16]; ss += __shfl_xor(ss, 32);
        const float rstd = 1.f / sqrtf(ss * (1.f / D) + EPS);
        bf16* orow = mkv + (size_t)(m0 + r) * 512 + n0 + 4 * h;
#pragma unroll
        for (int q = 0; q < 4; ++q) { v2u o; o.x = pk2(acc[4 * q] * rstd, acc[4 * q + 1] * rstd); o.y = pk2(acc[4 * q + 2] * rstd, acc[4 * q + 3] * rstd); *(GAS v2u*)(orow + 8 * q) = o; }
    }
    __syncthreads();
}
__device__ __forceinline__ void p0_prologue(Frame& F) {
    LAS float* scr = (LAS float*)(F.lds + RING_OFF + F.wave * 16384);
    const int gw = F.vcu * NWAVES + F.wave, NGW = F.G * NWAVES;
    bf16* win_t = (bf16*)(F.ws + WS_WIN); bf16* wout_t = (bf16*)(F.ws + WS_WOUT);
    bf16* xb = (bf16*)(F.ws + WS_XB); float* rstd1 = (float*)(F.ws + WS_RSTD1);
    p0_mkv_tile(F, (F.wave & 3) * 256 + F.vcu, (bf16*)(F.ws + WS_MKV), F.x + (size_t)(4 * gw) * D, xb + (size_t)(4 * gw) * D, rstd1 + 4 * gw, 4 * NGW);
    bf16* wrt = (bf16*)(F.ws + WS_WRT);
    if (gw < 1280) p0_transpose_all<false, true>(F.w_in, D, DIN, 1, win_t, F.g_attn, 1.f, scr, gw, NGW, F.lane, RowId());
    else if (gw < 1792) p0_transpose_all<true, false>(F.w_out, D, D, 1, (void*)wout_t, nullptr, WSCALE, scr, gw - 1280, NGW, F.lane, RowId());
    else for (int i = (gw - 1792) * 64 + F.lane; i < D * NE; i += 256 * 64) { const int e = i >> 10, k = i & 1023; const float w = F.w_r[k * NE + e] * F.g_ffn[k]; const unsigned hb = f2bf(w); wrt[i] = (bf16)hb; wrt[D * NE + i] = (bf16)f2bf(w - bf2f((bf16)hb)); }
}

constexpr int NCONV = 8, NCONV_ALL = 8 * NCONV;
__device__ __forceinline__ void p0b_unit(Frame& F, int c) {
    LAS float* scr = (LAS float*)(F.lds + RING_OFF + F.wave * 16384);
    p0_transpose_all<true, true>(F.w_gu, D, 2 * DFF, NE, (void*)(F.ws + WS_WGU), F.g_ffn, WSCALE, scr, c * NWAVES + F.wave, NCONV_ALL * NWAVES, F.lane, RowGU());
    p0_transpose_all<true, false>(F.w_dn, DFF, D, NE, (void*)(F.ws + WS_WDN), nullptr, WSCALE, scr, c * NWAVES + F.wave, NCONV_ALL * NWAVES, F.lane, RowId());
    __syncthreads();
}

struct EpiInProj {
    bf16* O; const float* rstd; unsigned* nrm;
    __device__ __forceinline__ void operator()(const pg8::f32x4 (&acc)[2][2][4][2], const pg8::Unit& u, int wr, int wc, int fr, int fq, const LAS unsigned* ids) const {
        asm volatile("" : "+v"(fr), "+v"(fq));
        const int row0 = u.pm * 256 + wr * 64 + fr, col0 = u.pn * 256 + wc * 32 + 8 * fq;
        const float sc = (u.pn <= 1 || u.pn == 6 || u.pn == 9) ? QSCALE : 1.f;
        const LAS float* scl = (const LAS float*)(ids + 256);
        float rsv[2][4];
#pragma unroll
        for (int ai = 0; ai < 2; ++ai)
#pragma unroll
            for (int m = 0; m < 4; ++m) rsv[ai][m] = scl[wr * 64 + fr + ai * 128 + m * 16];
#pragma unroll
        for (int ai = 0; ai < 2; ++ai)
#pragma unroll
            for (int m = 0; m < 4; ++m) { const int row = row0 + ai * 128 + m * 16; const float rs = rsv[ai][m] * sc; bf16* rowp = O + (size_t)row * DIN + col0;
#pragma unroll
                for (int bj = 0; bj < 2; ++bj) { const pg8::f32x4 v0 = acc[ai][bj][m][0] * rs, v1 = acc[ai][bj][m][1] * rs;
                    v4u w; w.x = pg8::cvt_pk_bf16(v0[0], v0[1]); w.y = pg8::cvt_pk_bf16(v0[2], v0[3]); w.z = pg8::cvt_pk_bf16(v1[0], v1[1]); w.w = pg8::cvt_pk_bf16(v1[2], v1[3]);
                    *(v4u*)(rowp + bj * 128) = w; } }
        if (u.pn < 4) {
#pragma unroll
            for (int bj = 0; bj < 2; ++bj) { float mx = 0.f;
#pragma unroll
                for (int ai = 0; ai < 2; ++ai)
#pragma unroll
                    for (int m = 0; m < 4; ++m) { const float rs = rsv[ai][m] * sc; const pg8::f32x4 v0 = acc[ai][bj][m][0] * rs, v1 = acc[ai][bj][m][1] * rs;
                        float s = (v0[0] * v0[0] + v0[1] * v0[1]) + (v0[2] * v0[2] + v0[3] * v0[3]) + (v1[0] * v1[0] + v1[1] * v1[1]) + (v1[2] * v1[2] + v1[3] * v1[3]);
                        s += __shfl_xor(s, 16); s += __shfl_xor(s, 32); mx = fmaxf(mx, s); }
#pragma unroll
                for (int o = 1; o < 16; o <<= 1) mx = fmaxf(mx, __shfl_xor(mx, o));
                if ((fr | fq) == 0) atomicMax(nrm + (((u.pm >> 4) * 4 + u.pn) * 4 + 2 * bj + (wc >> 1)) * 2 + (wc & 1), __builtin_bit_cast(unsigned, mx)); }
        }
    }
};
__device__ __forceinline__ void attn_phase(Frame& F, char* shm, int qoff = 0, int gmask = 7) {
    using namespace attn_body;
    const attn_body::bf16* P = (const attn_body::bf16*)(F.ws + WS_P);
    attn_body::bf16* OD = (attn_body::bf16*)(F.ws + WS_OD);
    attn_body::bf16* omem = (attn_body::bf16*)(F.ws + WS_OMEM);
    attn_body::bf16* ODIL = (attn_body::bf16*)(F.ws + WS_ODIL); float* LSEb = (float*)(F.ws + WS_LSE);
    const attn_body::bf16* MKV = (const attn_body::bf16*)(F.ws + WS_MKV);
    const float* nrm = (const float*)(F.ctl + CW_NRM);
    const int grp = (int)blockIdx.x & 7, b = grp;
    unsigned* qctr = (unsigned*)(F.ctl + CW_Q + qoff) + 64 * grp;
    const attn_body::bf16* Pb = P + (size_t)b * SEQ * DIN;
#define ATTN_LEAD() ({ int t_ = (int)threadIdx.x; asm volatile("" : "+v"(t_)); t_ == 0; })
    unsigned nxt_tok = 0u;
    if (ATTN_LEAD()) nxt_tok = __hip_atomic_fetch_add(qctr, 1u, __ATOMIC_RELAXED, __HIP_MEMORY_SCOPE_AGENT);
    for (;;) {
        if (ATTN_LEAD()) F.MISC[20] = nxt_tok;
        __syncthreads();
        int un = (int)F.MISC[20];
        __syncthreads();
        if (ATTN_LEAD() && un < NCONV + 384) nxt_tok = __hip_atomic_fetch_add(qctr, 1u, __ATOMIC_RELAXED, __HIP_MEMORY_SCOPE_AGENT);
        if (un < NCONV) { if (gmask == 7) p0b_unit(F, grp * NCONV + un); continue; }
        un -= NCONV;
        if (un >= 384) break;
        if (un < 128) {
            if (!(gmask & 1)) continue;
            const int qb = 15 - (un >> 3), h = 3 - ((un >> 1) & 3), j = un & 1;
            const float slope2 = exp2f(-(float)(2 * h + 1)) * LOG2E;
            const int ni = ((b * 4 + (h >> 1)) * 4 + 2 * (h & 1) + j) * 2;
            const float R = sqrtf((nrm[ni] + nrm[ni + 1]) * (nrm[ni + 16] + nrm[ni + 17])) * 1.01f;
            const float kfirst = (float)(qb * 256) - (2.f * R + 160.f) / slope2;
            int t0 = kfirst > 0.f ? (int)(kfirst * (1.f / 64.f)) : 0; t0 = min(t0, 4 * qb); t0 &= ~1;
            UnitP U; U.Q = Pb + C_DQ + h * 128 + j * 64; U.K = Pb + C_DK + h * 128 + j * 64; U.V = Pb + C_DV + h * 128;
            U.O = OD + (size_t)b * SEQ * 1024 + h * 256 + j * 128; U.qp = DIN; U.kp = DIN; U.op = 1024;
            U.q0 = qb * 256; U.t0 = t0; U.NT = 4 * qb + 4 - t0; U.slope2 = slope2; U.lse = nullptr; U.lse_stride = 0;
            attn_unit<32, true, false, true, false, 128>(U, shm);
        } else if (un < 320) {
            if (!(gmask & 2)) continue;
            const int du = un - 128, h = du / 48, idx = du % 48, n = idx >> 4, w = idx & 15;
            const int r = (n == 0) ? 1 : (n == 1 ? 4 : 16), c = (n == 0) ? 0 : (n == 1 ? (w >> 2) : w), blk = (n == 0) ? w : (n == 1 ? (w & 3) : 0);
            const attn_body::bf16* Pc = Pb + (size_t)c * DIN;
            UnitP U; U.Q = Pc + C_LQ + h * 64; U.K = Pc + C_LK + h * 64; U.V = Pc + C_LV + h * 64; U.qp = (long)r * DIN; U.kp = (long)r * DIN;
            U.O = ODIL + (size_t)n * T * 256 + ((size_t)b * SEQ + c) * 256 + h * 64; U.op = (long)r * 256;
            U.q0 = blk * 256; U.t0 = (blk == 0) ? 0 : 4 * blk - 2; U.NT = 4 * blk + 4 - U.t0;
            U.slope2 = exp2f(-(float)(2 * h + 2)) * (float)r * LOG2E;
            U.lse = LSEb + (size_t)n * T * 4 + ((size_t)b * SEQ + c) * 4 + h; U.lse_stride = r * 4;
            attn_unit<32, true, true, true, true>(U, shm);
        } else {
            if (!(gmask & 4)) continue;
            const int mu = un - 320, h = mu >> 4, qb = mu & 15;
            UnitP U; U.Q = Pb + C_MQ + h * 64; U.qp = DIN; U.K = MKV + (size_t)b * NMEM * 512 + h * 64; U.V = U.K + 256; U.kp = 512;
            U.O = omem + (size_t)b * SEQ * 256 + h * 64; U.op = 256; U.q0 = qb * 256; U.t0 = 0; U.NT = 4; U.slope2 = 0.f; U.lse = nullptr; U.lse_stride = 0;
            attn_unit<8, false, false, false, false>(U, shm);
        }
    }
}
#undef ATTN_LEAD
__device__ __forceinline__ void dil_combine_phase(Frame& F) {
    const int gw = F.vcu * NWAVES + F.wave, NGW = F.G * NWAVES;
    const bf16* OD = (const bf16*)(F.ws + WS_OD); const bf16* ODIL = (const bf16*)(F.ws + WS_ODIL); const float* LSEb = (const float*)(F.ws + WS_LSE); unsigned char* mix = (unsigned char*)(F.ws + WS_MIX); const bf16* OMEM = (const bf16*)(F.ws + WS_OMEM);
    const int h = F.lane >> 4, pt = F.lane & 15, d4 = pt * 4;
    float lam;
    { const float a = F.lamqk[F.lane] * F.lamqk[64 + F.lane], c = F.lamqk[128 + F.lane] * F.lamqk[192 + F.lane];
      lam = __expf(wave_sum(a)) - __expf(wave_sum(c)) + 0.2f; }
    float gsub[8];
#pragma unroll
    for (int i = 0; i < 8; ++i) gsub[i] = F.subg[pt * 8 + i] * (0.8f * MSCALE);
    for (int row0 = 4 * gw; row0 < T; row0 += 4 * NGW) {
        float l[4][3]; v2u q[4][3]; v4u o1[4], o2[4]; v2u om[4];
#pragma unroll
        for (int i = 0; i < 4; ++i) {
            om[i] = *(const v2u*)(OMEM + (size_t)(row0 + i) * 256 + 4 * F.lane);
            o1[i] = *(const v4u*)(OD + (size_t)(row0 + i) * 1024 + h * 256 + pt * 8); o2[i] = *(const v4u*)(OD + (size_t)(row0 + i) * 1024 + h * 256 + 128 + pt * 8);
#pragma unroll
            for (int n = 0; n < 3; ++n) { l[i][n] = LSEb[(size_t)n * T * 4 + (size_t)(row0 + i) * 4 + h]; q[i][n] = *(const v2u*)(ODIL + (size_t)n * T * 256 + (size_t)(row0 + i) * 256 + h * 64 + d4); } }
#pragma unroll
        for (int i = 0; i < 4; ++i) {
            const unsigned aw[4] = {o1[i].x, o1[i].y, o1[i].z, o1[i].w}, bw[4] = {o2[i].x, o2[i].y, o2[i].z, o2[i].w};
            float d[8], ss = 0.f;
#pragma unroll
            for (int c = 0; c < 4; ++c) { d[2 * c] = bflo(aw[c]) - lam * bflo(bw[c]); d[2 * c + 1] = bfhi(aw[c]) - lam * bfhi(bw[c]); ss += d[2 * c] * d[2 * c] + d[2 * c + 1] * d[2 * c + 1]; }
#pragma unroll
            for (int o = 1; o < 16; o <<= 1) ss += __shfl_xor(ss, o);
            const float rstd = 1.f / sqrtf(ss * (1.f / 128.f) + EPS);
            v2u od; od.x = fp8x4(d[0] * rstd * gsub[0], d[1] * rstd * gsub[1], d[2] * rstd * gsub[2], d[3] * rstd * gsub[3]); od.y = fp8x4(d[4] * rstd * gsub[4], d[5] * rstd * gsub[5], d[6] * rstd * gsub[6], d[7] * rstd * gsub[7]);
            *(v2u*)(mix + (size_t)(row0 + i) * 1024 + h * 128 + pt * 8) = od;
            const float m = fmaxf(fmaxf(l[i][0], l[i][1]), l[i][2]);
            float wn[3], den = 0.f;
#pragma unroll
            for (int n = 0; n < 3; ++n) { wn[n] = exp2f(l[i][n] - m); den += wn[n]; }
            const float inv = MSCALE / den; float o[4] = {0.f, 0.f, 0.f, 0.f};
#pragma unroll
            for (int n = 0; n < 3; ++n) { const float wq = wn[n] * inv; o[0] += wq * bflo(q[i][n].x); o[1] += wq * bfhi(q[i][n].x); o[2] += wq * bflo(q[i][n].y); o[3] += wq * bfhi(q[i][n].y); }
            *(unsigned*)(mix + (size_t)(row0 + i) * 1024 + 512 + h * 64 + d4) = fp8x4(o[0], o[1], o[2], o[3]);
            *(unsigned*)(mix + (size_t)(row0 + i) * 1024 + 768 + 4 * F.lane) = fp8x4(bflo(om[i].x) * MSCALE, bfhi(om[i].x) * MSCALE, bflo(om[i].y) * MSCALE, bfhi(om[i].y) * MSCALE);
        }
    }
}
struct EpiY {
    bf16* Y;
    __device__ __forceinline__ void operator()(const pg8::f32x4 (&acc)[2][2][4][2], const pg8::Unit& u, int wr, int wc, int fr, int fq, const LAS unsigned*) const {
        asm volatile("" : "+v"(fr), "+v"(fq));
        const int row0 = u.pm * 256 + wr * 64 + fr, col0 = u.pn * 256 + wc * 32 + 8 * fq;
#pragma unroll
        for (int ai = 0; ai < 2; ++ai)
#pragma unroll
            for (int m = 0; m < 4; ++m) { bf16* rowp = Y + (size_t)(row0 + ai * 128 + m * 16) * D + col0;
#pragma unroll
                for (int bj = 0; bj < 2; ++bj) { const pg8::f32x4 v0 = acc[ai][bj][m][0] * (1.f / (WSCALE * MSCALE)), v1 = acc[ai][bj][m][1] * (1.f / (WSCALE * MSCALE));
                    v4u w; w.x = pg8::cvt_pk_bf16(v0[0], v0[1]); w.y = pg8::cvt_pk_bf16(v0[2], v0[3]); w.z = pg8::cvt_pk_bf16(v1[0], v1[1]); w.w = pg8::cvt_pk_bf16(v1[2], v1[3]);
                    *(v4u*)(rowp + bj * 128) = w; } }
    }
};

__device__ __forceinline__ void route_phase(Frame& F) {
    LAS char* XH = (LAS char*)(F.lds + RING_OFF); LAS char* XL = XH + 32768; LAS char* WH = XH + 65536; LAS char* WL = XH + 73728;
    LAS float* xch = (LAS float*)(XH + 81920);
    LAS float* ssl = (LAS float*)(XH + 81920 + 17408);
    LAS unsigned* lcnt = (LAS unsigned*)(F.lds + LCNT_OFF);
    LAS unsigned* stg = (LAS unsigned*)(F.lds + STG_OFF);
    if (F.tid < 64) lcnt[F.tid] = 0u;
    const int lane = F.lane, tl = lane & 31, h = lane >> 5, tg = F.wave & 3, kh = F.wave >> 2;
    const int srow = F.tid >> 5, k4 = (F.tid & 31) * 4, T0 = F.vcu * 128;
    const bf16* xg = (const bf16*)(F.ws + WS_XB) + (size_t)(T0 + srow) * D + k4;
    const bf16* yg = (const bf16*)(F.ws + WS_Y) + (size_t)(T0 + srow) * D + k4;
    unsigned char* x1q = (unsigned char*)(F.ws + WS_X1B) + (size_t)(T0 + srow) * D + k4;
    bf16* x1h = (bf16*)(F.ws + WS_X1H) + (size_t)(T0 + srow) * D + k4;
    const bf16* wsrc = (const bf16*)(F.ws + WS_WRT);
    v2u xv[8]; v2u yv[8]; v4u wv[2]; float ssr[8];
#pragma unroll
    for (int i = 0; i < 8; ++i) ssr[i] = 0.f;
#define RT_LOAD(kc) do { _Pragma("unroll") for (int i_ = 0; i_ < 8; ++i_) { xv[i_] = *(const v2u*)(xg + (size_t)(16 * i_) * D + 128 * (kc)); yv[i_] = *(const v2u*)(yg + (size_t)(16 * i_) * D + 128 * (kc)); } \
        _Pragma("unroll") for (int j_ = 0; j_ < 2; ++j_) { const int idx_ = F.tid + 512 * j_; wv[j_] = *(const v4u*)(wsrc + (idx_ >> 9) * 32768 + ((idx_ >> 4) & 31) * 1024 + 128 * (kc) + (idx_ & 15) * 8); } } while (0)
    f32x16 acc = {};
    RT_LOAD(0);
    for (int kc = 0; kc < 8; ++kc) {
#pragma unroll
        for (int i = 0; i < 8; ++i) {
            const float x0 = bflo(xv[i].x) + bflo(yv[i].x), x1 = bfhi(xv[i].x) + bfhi(yv[i].x), x2 = bflo(xv[i].y) + bflo(yv[i].y), x3 = bfhi(xv[i].y) + bfhi(yv[i].y);
            ssr[i] += (x0 * x0 + x1 * x1) + (x2 * x2 + x3 * x3);
            const unsigned h0 = pk2(x0, x1), h1 = pk2(x2, x3), l0 = pk2(x0 - bflo(h0), x1 - bfhi(h0)), l1 = pk2(x2 - bflo(h1), x3 - bfhi(h1));
            *(unsigned*)(x1q + (size_t)(16 * i) * D + 128 * kc) = fp8x4(x0, x1, x2, x3);
            *(v2u*)(x1h + (size_t)(16 * i) * D + 128 * kc) = (v2u){h0, h1};
            const int row = srow + 16 * i, off = row * 256 + (((k4 >> 3) ^ (row & 15)) << 4) + (k4 & 4) * 2;
            *(LAS v2u*)(XH + off) = (v2u){h0, h1}; *(LAS v2u*)(XL + off) = (v2u){l0, l1};
        }
#pragma unroll
        for (int j = 0; j < 2; ++j) { const int idx = F.tid + 512 * j, e = (idx >> 4) & 31, c = idx & 15; *(LAS v4u*)(((idx >> 9) ? WL : WH) + e * 256 + ((c ^ (e & 15)) << 4)) = wv[j]; }
        __syncthreads();
        if (kc < 7) RT_LOAD(kc + 1);
#pragma unroll
        for (int s = 0; s < 4; ++s) { const int c16 = 2 * (4 * kh + s) + h, tr = tg * 32 + tl;
            const v4u xh = *(const LAS v4u*)(XH + tr * 256 + ((c16 ^ (tr & 15)) << 4)), xl = *(const LAS v4u*)(XL + tr * 256 + ((c16 ^ (tr & 15)) << 4));
            const v4u wh = *(const LAS v4u*)(WH + tl * 256 + ((c16 ^ (tl & 15)) << 4)), wl2 = *(const LAS v4u*)(WL + tl * 256 + ((c16 ^ (tl & 15)) << 4));
            acc = __builtin_amdgcn_mfma_f32_32x32x16_bf16(__builtin_bit_cast(bf16x8, wh), __builtin_bit_cast(bf16x8, xh), acc, 0, 0, 0);
            acc = __builtin_amdgcn_mfma_f32_32x32x16_bf16(__builtin_bit_cast(bf16x8, wh), __builtin_bit_cast(bf16x8, xl), acc, 0, 0, 0);
            acc = __builtin_amdgcn_mfma_f32_32x32x16_bf16(__builtin_bit_cast(bf16x8, wl2), __builtin_bit_cast(bf16x8, xh), acc, 0, 0, 0); }
        __syncthreads();
    }
#undef RT_LOAD
#pragma unroll
    for (int i = 0; i < 8; ++i) { float s = ssr[i];
#pragma unroll
        for (int o = 1; o < 32; o <<= 1) s += __shfl_xor(s, o);
        if ((F.tid & 31) == 0) ssl[srow + 16 * i] = s; }
    const int tok = T0 + tg * 32 + tl; float ss = 0.f;
    if (kh == 1) { LAS float* d = xch + (tg * 64 + lane) * 17;
#pragma unroll
        for (int i = 0; i < 16; ++i) d[i] = acc[i];
        d[16] = ss; }
    __syncthreads();
    if (kh == 0) {
        const LAS float* d = xch + (tg * 64 + lane) * 17;
#pragma unroll
        for (int i = 0; i < 16; ++i) acc[i] += d[i];
        ss = ssl[tg * 32 + tl];
        const float rstd = 1.f / sqrtf(ss * (1.f / D) + EPS);
        float lg[16];
#pragma unroll
        for (int i = 0; i < 16; ++i) lg[i] = acc[i] * rstd + F.b_r[4 * h + (i & 3) + 8 * (i >> 2)];
        float cv[8]; int ce[8];
#pragma unroll
        for (int k = 0; k < 4; ++k) { float bv = -INFINITY; int bi = 0;
#pragma unroll
            for (int i = 0; i < 16; ++i) { if (lg[i] > bv) { bv = lg[i]; bi = i; } }
            cv[k] = bv; ce[k] = 4 * h + (bi & 3) + 8 * (bi >> 2);
#pragma unroll
            for (int i = 0; i < 16; ++i) if (i == bi) lg[i] = -INFINITY; }
#pragma unroll
        for (int k = 0; k < 4; ++k) { cv[4 + k] = __shfl_xor(cv[k], 32); ce[4 + k] = __shfl_xor(ce[k], 32); }
        float tv[4]; int te[4];
#pragma unroll
        for (int k = 0; k < 4; ++k) { float bv = -INFINITY; int be = 64, bi = 0;
#pragma unroll
            for (int i = 0; i < 8; ++i) { if (cv[i] > bv || (cv[i] == bv && ce[i] < be)) { bv = cv[i]; be = ce[i]; bi = i; } }
            tv[k] = bv; te[k] = be;
#pragma unroll
            for (int i = 0; i < 8; ++i) if (i == bi) cv[i] = -INFINITY; }
        float gk[4], den = 0.f;
#pragma unroll
        for (int k = 0; k < 4; ++k) { gk[k] = __expf(tv[k] - tv[0]); den += gk[k]; }
        const float inv = 1.f / den;
        if (h == 0) {
#pragma unroll
            for (int k = 0; k < 4; ++k) {
                const unsigned rank = __hip_atomic_fetch_add(lcnt + te[k], 1u, __ATOMIC_RELAXED, __HIP_MEMORY_SCOPE_WORKGROUP);
                const int slot = (tg * 32 + tl) * 4 + k;
                stg[slot * 4] = (unsigned)(tok * 4 + k); stg[slot * 4 + 1] = ((unsigned)te[k] << 16) | rank; stg[slot * 4 + 2] = __builtin_bit_cast(unsigned, gk[k] * inv); stg[slot * 4 + 3] = __builtin_bit_cast(unsigned, rstd);
            }
        }
    }
    __syncthreads();
    if (F.tid < 32) { const unsigned n = lcnt[F.tid]; lcnt[32 + F.tid] = n ? __hip_atomic_fetch_add((unsigned*)(F.ctl + CW_CNT) + F.tid, n, __ATOMIC_RELAXED, __HIP_MEMORY_SCOPE_AGENT) : 0u; }
    __syncthreads();
    { unsigned* list = (unsigned*)(F.ws + WS_LIST); unsigned* lgate = (unsigned*)(F.ws + WS_LGATE); unsigned* lrstd = (unsigned*)(F.ws + WS_LRSTD);
      const unsigned ent = stg[F.tid * 4], er = stg[F.tid * 4 + 1], gb = stg[F.tid * 4 + 2], rb = stg[F.tid * 4 + 3]; const unsigned e = er >> 16, rank = er & 0xffffu;
      const size_t at = (size_t)e * LCAP + lcnt[32 + e] + rank; list[at] = ent; lgate[at] = gb; lrstd[at] = rb; }
    __syncthreads();
}

__device__ __forceinline__ int moe_build_table(Frame& F) {
    LAS unsigned* tbl = (LAS unsigned*)(F.lds + TBL_OFF); LAS unsigned* lcnt = (LAS unsigned*)(F.lds + LCNT_OFF);
    if (F.wave == 0) {
        const int e = F.lane & 31;
        const unsigned cnt = __hip_atomic_load((unsigned*)(F.ctl + CW_CNT) + e, __ATOMIC_RELAXED, __HIP_MEMORY_SCOPE_AGENT);
        const unsigned nt = (cnt + 255u) >> 8; unsigned incl = nt;
#pragma unroll
        for (int o = 1; o < 32; o <<= 1) { const unsigned t = __shfl_up(incl, o); if ((F.lane & 31) >= o) incl += t; }
        if (F.lane < 32) { lcnt[e] = cnt; const unsigned start = incl - nt; for (unsigned j = 0; j < nt; ++j) tbl[start + j] = ((unsigned)e << 16) | j; if (F.lane == 31) F.MISC[16] = incl; }
    }
    __syncthreads();
    return (int)F.MISC[16];
}
struct MoeOrder {
    const LAS unsigned* tbl; const LAS unsigned* lcnt; const unsigned* list; int NMT, G, c, NPN, MPER, RB; size_t bexp; bool a_tiles; const unsigned* lsc; const unsigned* bias; int bexp_f;
    __device__ __forceinline__ bool next(int i, pg8::Unit& u) const {
        const int L = i * G + c, blk = L >> 5, w = L & 31, g = (NPN == 8) ? blk * 4 + (w >> 3) : blk * 8 + (w >> 2), pn = (NPN == 8) ? (w & 7) : (w & 3);
        if (g >= NMT) return false;
        const unsigned t = tbl[g]; const int e = (int)(t >> 16), mt = (int)(t & 0xffffu); const int cnt = (int)lcnt[e];
        u.pm = g; u.pn = pn; u.e = e; u.mt = mt; u.valid = min(256, cnt - mt * 256);
        u.aoff = a_tiles ? (size_t)g * (size_t)(256 * RB) : (size_t)0; u.boff = (size_t)e * bexp + (size_t)pn * (size_t)(256 * RB);
        return true;
    }
    __device__ __forceinline__ const unsigned* id_src(const pg8::Unit& u, int row) const { return list + (size_t)u.e * LCAP + u.mt * 256 + min(row, u.valid - 1); }
    __device__ __forceinline__ const unsigned* sc_src(const pg8::Unit& u, int row) const { return lsc + (size_t)u.e * LCAP + u.mt * 256 + min(row, u.valid - 1); }
    __device__ __forceinline__ const unsigned* bias_src(const pg8::Unit& u, int col) const { return bias + (size_t)u.e * bexp_f + u.pn * 256 + col; }
};
struct EpiGU {
    unsigned char* ACT;
    __device__ __forceinline__ void operator()(const pg8::f32x4 (&acc)[2][2][4][2], const pg8::Unit& u, int wr, int wc, int fr, int fq, const LAS unsigned* ids) const {
        asm volatile("" : "+v"(fr), "+v"(fq));
        typedef float f2 __attribute__((ext_vector_type(2)));
        constexpr float CG = 1.702f * LOG2E, KA = ASCALE / CG;
        const int r0 = wr * 64 + fr, f0 = u.pn * 128 + wc * 32 + 8 * fq;
        const LAS float* scl = (const LAS float*)(ids + 256); const LAS float* bl = (const LAS float*)(ids + 512) + 2 * (wc * 32 + 8 * fq);
        float rs[2][4];
#pragma unroll
        for (int ai = 0; ai < 2; ++ai)
#pragma unroll
            for (int m = 0; m < 4; ++m) rs[ai][m] = scl[r0 + ai * 128 + m * 16] * (1.f / WSCALE);
        const pg8::f32x4 b0 = *(const LAS pg8::f32x4*)bl, b1 = *(const LAS pg8::f32x4*)(bl + 4), b2 = *(const LAS pg8::f32x4*)(bl + 8), b3 = *(const LAS pg8::f32x4*)(bl + 12);
        const f2 gb[4] = {f2{b0[0], b0[2]} * CG, f2{b1[0], b1[2]} * CG, f2{b2[0], b2[2]} * CG, f2{b3[0], b3[2]} * CG}, ub[4] = {f2{b0[1], b0[3]}, f2{b1[1], b1[3]}, f2{b2[1], b2[3]}, f2{b3[1], b3[3]}};
#pragma unroll
        for (int ai = 0; ai < 2; ++ai)
#pragma unroll
            for (int m = 0; m < 4; ++m) { const int r = r0 + ai * 128 + m * 16; const float s = rs[ai][m], sg = s * CG; f2 a[4];
#pragma unroll
                for (int q = 0; q < 4; ++q) { const int n = q >> 1, j = 2 * (q & 1);
                    f2 g = f2{acc[ai][0][m][n][j], acc[ai][0][m][n][j + 1]} * sg + gb[q], up = f2{acc[ai][1][m][n][j], acc[ai][1][m][n][j + 1]} * s + ub[q];
                    g.x = fminf(g.x, 7.f * CG); g.y = fminf(g.y, 7.f * CG); up.x = __builtin_amdgcn_fmed3f(up.x, -7.f, 7.f); up.y = __builtin_amdgcn_fmed3f(up.y, -7.f, 7.f);
                    f2 d = f2{__builtin_amdgcn_exp2f(-g.x), __builtin_amdgcn_exp2f(-g.y)} + 1.f;
                    const f2 rc = f2{__builtin_amdgcn_rcpf(d.x), __builtin_amdgcn_rcpf(d.y)};
                    a[q] = ((up * KA + KA) * g) * rc; }
                v2u w; w.x = (unsigned)__builtin_amdgcn_cvt_pk_fp8_f32(a[1].x, a[1].y, __builtin_amdgcn_cvt_pk_fp8_f32(a[0].x, a[0].y, 0, false), true);
                w.y = (unsigned)__builtin_amdgcn_cvt_pk_fp8_f32(a[3].x, a[3].y, __builtin_amdgcn_cvt_pk_fp8_f32(a[2].x, a[2].y, 0, false), true);
                *(v2u*)(ACT + (size_t)(u.pm * 256 + r) * DFF + f0) = w; }
    }
};
struct EpiDown {
    unsigned char* YB;
    __device__ __forceinline__ void operator()(const pg8::f32x4 (&acc)[2][2][4][2], const pg8::Unit& u, int wr, int wc, int fr, int fq, const LAS unsigned* ids) const {
        asm volatile("" : "+v"(fr), "+v"(fq));
        const int r0 = wr * 64 + fr, cl = wc * 32 + 8 * fq, col0 = u.pn * 256 + cl;
        const LAS float* scl = (const LAS float*)(ids + 256); const LAS float* bl = (const LAS float*)(ids + 512) + cl;
        pg8::f32x4 bv[2][2];
#pragma unroll
        for (int bj = 0; bj < 2; ++bj)
#pragma unroll
            for (int n = 0; n < 2; ++n) bv[bj][n] = *(const LAS pg8::f32x4*)(bl + bj * 128 + 4 * n);
#pragma unroll
        for (int ai = 0; ai < 2; ++ai)
#pragma unroll
            for (int m = 0; m < 4; ++m) { const int r = r0 + ai * 128 + m * 16; if (r < u.valid) { const float g = scl[r] * YSCALE; unsigned char* yp = YB + (size_t)ids[r] * D + col0;
#pragma unroll
                for (int bj = 0; bj < 2; ++bj) { const pg8::f32x4 v0 = (acc[ai][bj][m][0] * (1.f / (WSCALE * ASCALE)) + bv[bj][0]) * g, v1 = (acc[ai][bj][m][1] * (1.f / (WSCALE * ASCALE)) + bv[bj][1]) * g;
                    v2u w; w.x = fp8x4(v0[0], v0[1], v0[2], v0[3]); w.y = fp8x4(v1[0], v1[1], v1[2], v1[3]);
                    *(v2u*)(yp + bj * 128) = w; } } }
    }
};
__device__ __forceinline__ void final_phase(Frame& F) {
    const int gw = F.vcu * NWAVES + F.wave, NGW = F.G * NWAVES;
    const unsigned char* YB = (const unsigned char*)(F.ws + WS_YB); const bf16* X1 = (const bf16*)(F.ws + WS_X1H);
    const int c = 4 * F.lane;
    f32x4 gf[4];
#pragma unroll
    for (int q = 0; q < 4; ++q) gf[q] = *(const f32x4*)(F.g_fin + c + 256 * q);
    for (int t0 = 2 * gw; t0 < T; t0 += 2 * NGW) {
        v2u xa[2][4]; unsigned y[2][4][4];
#pragma unroll
        for (int u = 0; u < 2; ++u) {
#pragma unroll
            for (int q = 0; q < 4; ++q) xa[u][q] = *(const v2u*)(X1 + (size_t)(t0 + u) * D + c + 256 * q);
#pragma unroll
            for (int k = 0; k < 4; ++k)
#pragma unroll
                for (int q = 0; q < 4; ++q) y[u][k][q] = *(const unsigned*)(YB + ((size_t)(t0 + u) * 4 + k) * D + c + 256 * q); }
#pragma unroll
        for (int u = 0; u < 2; ++u) {
            float v[16];
#pragma unroll
            for (int q = 0; q < 4; ++q) { v[4 * q] = bflo(xa[u][q].x); v[4 * q + 1] = bfhi(xa[u][q].x); v[4 * q + 2] = bflo(xa[u][q].y); v[4 * q + 3] = bfhi(xa[u][q].y); }
#pragma unroll
            for (int k = 0; k < 4; ++k)
#pragma unroll
                for (int q = 0; q < 4; ++q) { const auto lo = __builtin_amdgcn_cvt_pk_f32_fp8((int)y[u][k][q], false), hi = __builtin_amdgcn_cvt_pk_f32_fp8((int)y[u][k][q], true);
                    v[4 * q] += lo[0] * (1.f / YSCALE); v[4 * q + 1] += lo[1] * (1.f / YSCALE); v[4 * q + 2] += hi[0] * (1.f / YSCALE); v[4 * q + 3] += hi[1] * (1.f / YSCALE); }
            float ss = 0.f;
#pragma unroll
            for (int i = 0; i < 16; ++i) ss += v[i] * v[i];
            const float rstd = 1.f / sqrtf(wave_sum(ss) * (1.f / D) + EPS);
#pragma unroll
            for (int q = 0; q < 4; ++q) { f32x4 o; o.x = v[4 * q] * rstd * gf[q].x; o.y = v[4 * q + 1] * rstd * gf[q].y; o.z = v[4 * q + 2] * rstd * gf[q].z; o.w = v[4 * q + 3] * rstd * gf[q].w;
                *(f32x4*)(F.out + (size_t)(t0 + u) * D + c + 256 * q) = o; }
        }
    }
}
struct Args { const float* in[17]; float* out; unsigned char* ws; int ph_lo, ph_hi, use_bar, pad; };
__global__ void __launch_bounds__(NWAVES * 64, 2) mk_fwd(Args args) {
    extern __shared__ __attribute__((aligned(16))) unsigned char lds[];
    Frame F;
    F.lds = (LAS unsigned char*)lds;
    F.MISC = (volatile LAS unsigned*)(F.lds + MISC_OFF);
    F.tid = threadIdx.x; F.lane = F.tid & 63; F.wave = __builtin_amdgcn_readfirstlane(F.tid >> 6);
    const bool lead = F.tid == 0;
#define FRESH() do { F.lane = mk_lane(); F.tid = F.wave * 64 + F.lane; } while (0)
    F.G = gridDim.x; { const int bx = blockIdx.x; F.vcu = (F.G % 8 == 0) ? (bx % 8) * (F.G / 8) + bx / 8 : bx; }
    F.ws = args.ws; F.out = args.out; F.ctl = (gu32*)(args.ws + WS_CTL);
    F.x = args.in[0]; F.mem = args.in[1]; F.g_attn = args.in[2]; F.g_mem = args.in[3]; F.w_in = args.in[4]; F.lamqk = args.in[5]; F.subg = args.in[6]; F.w_mkv = args.in[7];
    F.w_out = args.in[8]; F.g_ffn = args.in[9]; F.w_r = args.in[10]; F.b_r = args.in[11]; F.w_gu = args.in[12]; F.b_gu = args.in[13]; F.w_dn = args.in[14]; F.b_dn = args.in[15]; F.g_fin = args.in[16];
    for (int u = F.tid; u < (LDS_BYTES - LDSCTL_OFF) / 4; u += NWAVES * 64) ((LAS unsigned*)(F.lds + LDSCTL_OFF))[u] = 0u;
    __syncthreads();
    XcdBarrier bar; bar.bar = (unsigned*)(F.ctl + CW_BAR); bar.x = 0; bar.st = nullptr;
    if (args.use_bar) bar = xcd_barrier_post((unsigned*)(F.ctl + CW_BAR), F.MISC + 8, lead);
    const int lo = args.ph_lo, hi = args.ph_hi;
#define IN(k) (lo <= (k) && (k) < hi)
#define SEAM(k) do { if (IN(k) && IN((k) + 1)) xcd_barrier(bar, lead); } while (0)
    if (IN(0)) { p0_prologue(F); } SEAM(0);
    if (IN(1)) {
        pg8::Gemm g{(const void*)(F.ws + WS_XB), (const void*)(F.ws + WS_WIN), 2 * D, 128}; pg8::StaticOrder S; S.init(T, DIN, 2 * D, F.G, (int)blockIdx.x, (const unsigned*)(F.ws + WS_RSTD1));
        EpiInProj E{(bf16*)(F.ws + WS_P), (const float*)(F.ws + WS_RSTD1), (unsigned*)(F.ctl + CW_NRM)};
        pg8::gemm_phase<EpiInProj, pg8::StaticOrder, true, false, true>(F.lds + RING_OFF, (LAS unsigned*)(F.lds + IDB_OFF), g, S, E, F.tid);
    } SEAM(1);
    if (IN(2)) { attn_phase(F, (char*)lds + RING_OFF); } SEAM(2);
    if (IN(3)) { FRESH(); dil_combine_phase(F); } SEAM(3);
    if (IN(4)) { FRESH();
        pg8::Gemm g{(const void*)(F.ws + WS_MIX), (const void*)(F.ws + WS_WOUT), D, 128}; pg8::StaticOrder S; S.init(T, D, D, F.G, (int)blockIdx.x);
        EpiY E{(bf16*)(F.ws + WS_Y)};
        pg8::gemm_phase<EpiY, pg8::StaticOrder, true, true, false, true, true>(F.lds + RING_OFF, (LAS unsigned*)(F.lds + IDB_OFF), g, S, E, F.tid);
    } SEAM(4);
    if (IN(5)) { FRESH(); route_phase(F); } SEAM(5);
    if (IN(6)) { FRESH();
        const int nmt = moe_build_table(F);
        pg8::Gemm g{(const void*)(F.ws + WS_X1B), (const void*)(F.ws + WS_WGU), D, 128};
        MoeOrder S{(const LAS unsigned*)(F.lds + TBL_OFF), (const LAS unsigned*)(F.lds + LCNT_OFF), (const unsigned*)(F.ws + WS_LIST), nmt, F.G, F.vcu, 8, 4, D, (size_t)2 * DFF * D, false, (const unsigned*)(F.ws + WS_LRSTD), (const unsigned*)F.b_gu, 2 * DFF};
        EpiGU E{(unsigned char*)(F.ws + WS_ACT)};
        pg8::gemm_phase<EpiGU, MoeOrder, true, true, true, true>(F.lds + RING_OFF, (LAS unsigned*)(F.lds + IDB_OFF), g, S, E, F.tid);
    } SEAM(6);
    if (IN(7)) { FRESH();
        const int nmt = moe_build_table(F);
        pg8::Gemm g{(const void*)(F.ws + WS_ACT), (const void*)(F.ws + WS_WDN), DFF, 128};
        MoeOrder S{(const LAS unsigned*)(F.lds + TBL_OFF), (const LAS unsigned*)(F.lds + LCNT_OFF), (const unsigned*)(F.ws + WS_LIST), nmt, F.G, F.vcu, 4, 8, DFF, (size_t)D * DFF, true, (const unsigned*)(F.ws + WS_LGATE), (const unsigned*)F.b_dn, D};
        EpiDown E{(unsigned char*)(F.ws + WS_YB)};
        pg8::gemm_phase<EpiDown, MoeOrder, true, true, true, true, true>(F.lds + RING_OFF, (LAS unsigned*)(F.lds + IDB_OFF), g, S, E, F.tid);
    } SEAM(7);
    if (IN(8)) { FRESH(); final_phase(F); }
#undef IN
#undef FRESH
#undef SEAM
}

static void launch_phases(const Args& base, int lo, int hi, int use_bar, int grid, hipStream_t stream) {
    Args a = base; a.ph_lo = lo; a.ph_hi = hi; a.use_bar = use_bar;
    hipLaunchKernelGGL(mk_fwd, dim3(grid), dim3(NWAVES * 64), LDS_BYTES, stream, a);
}
extern "C" void kernel_launch(void* const* d_in, const int* in_sizes, int n_in, void* d_out, int out_size, void* d_ws, size_t ws_size, hipStream_t stream) {
    static int grid = 0;
    if (grid == 0) {
        if (n_in != 17 || in_sizes[0] != T * D || out_size != T * D || ws_size < (size_t)1000 * MiB) { fprintf(stderr, "kernel_launch: unexpected shapes / workspace (%d inputs, ws %zu)\n", n_in, ws_size); grid = -1; return; }
        int dev = 0, cus = 0, per_cu = 0;
        if (hipGetDevice(&dev) != hipSuccess || hipDeviceGetAttribute(&cus, hipDeviceAttributeMultiprocessorCount, dev) != hipSuccess) { grid = -1; return; }
        if (hipFuncSetAttribute((const void*)mk_fwd, hipFuncAttributeMaxDynamicSharedMemorySize, LDS_BYTES) != hipSuccess) { fprintf(stderr, "kernel_launch: hipFuncSetAttribute failed\n"); grid = -1; return; }
        if (hipOccupancyMaxActiveBlocksPerMultiprocessor(&per_cu, (const void*)mk_fwd, NWAVES * 64, LDS_BYTES) != hipSuccess || per_cu < 1) { fprintf(stderr, "kernel_launch: occupancy query says %d blocks per CU\n", per_cu); per_cu = 1; }
        (void)hipGetLastError();
        grid = cus;
        if (grid != 256) { fprintf(stderr, "kernel_launch: built for a 256-CU device (got %d)\n", cus); grid = -1; return; }
    }
    if (grid < 0) return;
    (void)hipMemsetAsync((char*)d_ws + WS_CTL, 0, CTL_ZERO_BYTES, stream);
    Args a{};
    for (int i = 0; i < 17; ++i) a.in[i] = (const float*)d_in[i];
    a.out = (float*)d_out; a.ws = (unsigned char*)d_ws;
    launch_phases(a, 0, 9, 1, grid, stream);
}
```

```cpp
#include <hip/hip_runtime.h>
#include <hip/hip_bf16.h>
#include <cstdint>
#include <cstdio>
#include <cmath>

constexpr int D = 1024, BATCH = 8, SEQ = 4096, T = BATCH * SEQ, DIN = 2560, NMEM = 256, NE = 32, DFF = 1024;
constexpr int C_DQ = 0, C_DK = 512, C_DV = 1024, C_LQ = 1536, C_LK = 1792, C_LV = 2048, C_MQ = 2304;
constexpr float EPS = 1e-5f;
constexpr int LCAP = T;
constexpr float QSCALE = 0.125f * 1.4426950408889634f;
constexpr float LOG2E = 1.4426950408889634f;
__device__ __forceinline__ int mk_lane() { int l = (int)__builtin_amdgcn_mbcnt_hi(~0u, __builtin_amdgcn_mbcnt_lo(~0u, 0u)); asm volatile("" : "+v"(l)); return l; }

namespace pg8 {
#define PG8_LAS __attribute__((address_space(3)))
typedef unsigned short bf16_t;
typedef short bf16x8 __attribute__((ext_vector_type(8)));
typedef float f32x4 __attribute__((ext_vector_type(4)));
typedef unsigned u32x4 __attribute__((ext_vector_type(4)));
typedef unsigned u32x2 __attribute__((ext_vector_type(2)));
constexpr int BM = 256, BK = 64, HALF = 128, HTB = HALF * BK * 2  , STAGE_BYTES = 8 * HTB, NXCD = 8, WGM = 8;

__host__ __device__ __forceinline__ int lds_byte(int r, int c) { const int st = (r >> 4) * 2 + (c >> 5), rr = r & 15, cc = c & 31, ob = rr * 64 + cc * 2; return st * 1024 + (ob ^ (((ob >> 9) & 1) << 5)); }
__host__ __device__ __forceinline__ void stage_rc(int b, int& R, int& C) { const int st = b / 1024, sb = b % 1024, swz = sb ^ (((sb >> 9) & 1) << 5); R = (st >> 1) * 16 + swz / 64; C = (st & 1) * 32 + (swz % 64) / 2; }
__host__ __device__ __forceinline__ int perm32(int rho) { const int n = rho >> 4, i = rho & 15; return 8 * (i >> 2) + 4 * n + (i & 3); }

struct Unit { size_t aoff, boff; int pm, pn, e, valid, mt; };
struct Gemm { const void* A; const void* Bt; int RB; int akstep; };
typedef int v8i __attribute__((ext_vector_type(8)));

struct StaticOrder {
    int nM, nN, nwg, G, c, RB; const unsigned* sc;
    __device__ void init(int M, int N, int RB_, int G_, int c_, const unsigned* sc_ = nullptr) { nM = M / BM; nN = N / BM; nwg = nM * nN; G = G_; c = c_; RB = RB_; sc = sc_; }
    __device__ bool next(int i, Unit& u) const {
        const long L = (long)i * G + c; if (L >= nwg) return false;
        int wgid = (int)L; { const int q = nwg / NXCD, r = nwg % NXCD, xcd = wgid % NXCD, off = wgid / NXCD; wgid = (xcd < r ? xcd * (q + 1) : r * (q + 1) + (xcd - r) * q) + off; }
        const int nig = WGM * nN, gid = wgid / nig, fm = gid * WGM, gsz = (nM - fm) < WGM ? (nM - fm) : WGM;
        u.pm = fm + ((wgid % nig) % gsz); u.pn = (wgid % nig) / gsz; u.e = 0; u.valid = 256; u.mt = 0;
        u.aoff = (size_t)u.pm * (size_t)(BM * RB); u.boff = (size_t)u.pn * (size_t)(BM * RB); return true;
    }
    __device__ __forceinline__ const unsigned* id_src(const Unit& u, int row) const { return sc + u.pm * 256 + row; }
    __device__ __forceinline__ const unsigned* sc_src(const Unit& u, int row) const { return sc + u.pm * 256 + row; }
    __device__ __forceinline__ const unsigned* bias_src(const Unit& u, int row) const { return sc + u.pm * 256 + row; }
};

__device__ __forceinline__ unsigned cvt_pk_bf16(float lo, float hi) { typedef float f2_ __attribute__((ext_vector_type(2))); typedef __bf16 b2_ __attribute__((ext_vector_type(2))); f2_ v = {lo, hi}; b2_ b = __builtin_convertvector(v, b2_); return __builtin_bit_cast(unsigned, b); }

template <class Epi, class Sched, bool ALIGN_EPI, bool GATHER, bool IDS, bool FP8 = false, bool LINEAR = false>
__device__ __forceinline__ void gemm_phase(PG8_LAS unsigned char* lds, PG8_LAS unsigned* idb, const Gemm g, const Sched& S, const Epi& E, const int tid) {
    const int wid = __builtin_amdgcn_readfirstlane(tid >> 6), lane = tid & 63, wr = wid >> 2, wc = wid & 3, fr = lane & 15, fq = lane >> 4;
    const int RB = g.RB; int nt = RB / (BK * 2); asm volatile("" : "+s"(nt));
    unsigned voffA[2], voffB[2]; int RA[2], CA[2];
#pragma unroll
    for (int i = 0; i < 2; ++i) { int R, C; stage_rc(tid * 16 + i * 8192, R, C); const int Rb = (R & ~31) + perm32(R & 31); RA[i] = R; CA[i] = C;
        voffA[i] = (unsigned)(R * RB + C * 2); voffB[i] = (unsigned)(Rb * RB + C * 2); }
    const size_t kstep = (size_t)(BK * 2), akstep = (size_t)g.akstep;
    const size_t hstep = (size_t)HALF * RB;
    const unsigned ldsw = (unsigned)wid * 1024u;
    const int aoff = lds_byte(wr * 64 + fr, fq * 8), boff = lds_byte(wc * 32 + fr, fq * 8);
#define PG8_SA(b, h) (((b) * 2 + (h)) * HTB)
#define PG8_SB(b, h) ((4 + (b) * 2 + (h)) * HTB)
#define PG8_STAGE(bufoff, gbase, voff) do { _Pragma("unroll") for (int _i = 0; _i < 2; ++_i) \
        __builtin_amdgcn_global_load_lds((const unsigned*)((const char*)(gbase) + (voff)[_i]), (PG8_LAS unsigned*)(lds + (bufoff) + ldsw + _i * 8192), 16, 0, 0); } while (0)
#define PG8_STAGE_A(bufoff, pbase, gbase, h, gv) do { if constexpr (GATHER) { PG8_STAGE(bufoff, gbase, gv[h]); } else { PG8_STAGE(bufoff, (pbase) + (h) * hstep, voffA); } } while (0)
#define PG8_LD32(p0_, p1_) __builtin_bit_cast(v8i, __builtin_shufflevector(*(const PG8_LAS u32x4*)(p0_), *(const PG8_LAS u32x4*)(p1_), 0, 1, 2, 3, 4, 5, 6, 7))
#define PG8_LDA(dst, b, h) do { if constexpr (FP8) { _Pragma("unroll") for (int m = 0; m < 4; ++m) dst##8[m] = PG8_LD32(lds + PG8_SA(b, h) + aoff + m * 2048, lds + PG8_SA(b, h) + aoff + m * 2048 + 1024); } \
        else { _Pragma("unroll") for (int m = 0; m < 4; ++m) _Pragma("unroll") for (int k = 0; k < 2; ++k) dst[m][k] = *(const PG8_LAS bf16x8*)(lds + PG8_SA(b, h) + aoff + m * 2048 + k * 1024); } } while (0)
#define PG8_LDB(dst, b, h) do { if constexpr (FP8) { _Pragma("unroll") for (int n = 0; n < 2; ++n) dst##8[n] = PG8_LD32(lds + PG8_SB(b, h) + boff + n * 2048, lds + PG8_SB(b, h) + boff + n * 2048 + 1024); } \
        else { _Pragma("unroll") for (int n = 0; n < 2; ++n) _Pragma("unroll") for (int k = 0; k < 2; ++k) dst[n][k] = *(const PG8_LAS bf16x8*)(lds + PG8_SB(b, h) + boff + n * 2048 + k * 1024); } } while (0)
#define PG8_MMA(ai, bj, At, Bt) do { __builtin_amdgcn_s_setprio(1); if constexpr (FP8) { _Pragma("unroll") for (int m = 0; m < 4; ++m) _Pragma("unroll") for (int n = 0; n < 2; ++n) \
        acc[ai][bj][m][n] = __builtin_amdgcn_mfma_scale_f32_16x16x128_f8f6f4(Bt##8[n], At##8[m], acc[ai][bj][m][n], 0, 0, 0, sca_, 0, 0x7f7f7f7f); } \
        else { _Pragma("unroll") for (int m = 0; m < 4; ++m) _Pragma("unroll") for (int n = 0; n < 2; ++n) _Pragma("unroll") for (int k = 0; k < 2; ++k) \
        acc[ai][bj][m][n] = __builtin_amdgcn_mfma_f32_16x16x32_bf16(Bt[n][k], At[m][k], acc[ai][bj][m][n], 0, 0, 0); } __builtin_amdgcn_s_setprio(0); } while (0)
#define PG8_WAIT_V(n) asm volatile("s_waitcnt vmcnt(" #n ")" ::: "memory")
#define PG8_WAIT_L(n) asm volatile("s_waitcnt lgkmcnt(" #n ")" ::: "memory")
#define PG8_BAR __builtin_amdgcn_s_barrier()
#define PG8_SCHED __builtin_amdgcn_sched_barrier(0)
#define PG8_IDS_DMA(u, s) do { if (wid < 4) { __builtin_amdgcn_global_load_lds(S.id_src(u, tid), (PG8_LAS unsigned*)(idb + (s) * 768 + wid * 64), 4, 0, 0); \
        __builtin_amdgcn_global_load_lds(S.sc_src(u, tid), (PG8_LAS unsigned*)(idb + (s) * 768 + 256 + wid * 64), 4, 0, 0); \
        __builtin_amdgcn_global_load_lds(S.bias_src(u, tid), (PG8_LAS unsigned*)(idb + (s) * 768 + 512 + wid * 64), 4, 0, 0); } } while (0)
#define PG8_GV(dst, s, un) do { _Pragma("unroll") for (int _h = 0; _h < 2; ++_h) _Pragma("unroll") for (int _i = 0; _i < 2; ++_i) \
        dst[_h][_i] = (LINEAR ? (unsigned)((un).pm * 256 + _h * 128 + RA[_i]) : (idb[(s) * 768 + _h * 128 + RA[_i]] >> 2)) * (unsigned)RB + (unsigned)(CA[_i] * 2); } while (0)
    Unit cur, nxt; int ui = 0, us = 0;
    if (!S.next(0, cur)) return;
    f32x4 acc[2][2][4][2];
#pragma unroll
    for (int a = 0; a < 2; ++a)
#pragma unroll
        for (int b = 0; b < 2; ++b)
#pragma unroll
            for (int m = 0; m < 4; ++m)
#pragma unroll
                for (int n = 0; n < 2; ++n) acc[a][b][m][n] = (f32x4){0.f, 0.f, 0.f, 0.f};
    bf16x8 At[4][2], B0[2][2], B1[2][2]; v8i At8[4], B08[2], B18[2];
    unsigned cv[2][2] = {{0u, 0u}, {0u, 0u}};
    const char* A0 = (const char*)g.A;
    const char* cA = A0 + (GATHER ? (size_t)0 : cur.aoff); const char* cB = (const char*)g.Bt + cur.boff;
    if constexpr (IDS) {
        PG8_IDS_DMA(cur, 0); PG8_WAIT_V(0); PG8_BAR;
    }
    if constexpr (GATHER) { PG8_GV(cv, 0, cur); }
    PG8_STAGE(PG8_SB(0, 0), cB, voffB); PG8_STAGE(PG8_SB(0, 1), cB + hstep, voffB); PG8_STAGE_A(PG8_SA(0, 0), cA, A0, 0, cv); PG8_STAGE_A(PG8_SA(0, 1), cA, A0, 1, cv);
    if (wr == 1) PG8_BAR;
    PG8_WAIT_V(2); PG8_BAR;
    PG8_STAGE(PG8_SB(1, 0), cB + kstep, voffB); PG8_STAGE_A(PG8_SA(1, 0), cA + akstep, A0 + akstep, 0, cv); PG8_STAGE(PG8_SB(1, 1), cB + hstep + kstep, voffB);
    PG8_WAIT_V(6); PG8_BAR;
    for (;;) {
        const bool has_next = S.next(ui + 1, nxt);
        const int ns = (us == 2) ? 0 : us + 1;
        if constexpr (IDS) { if (has_next) PG8_IDS_DMA(nxt, ns); }
        const char* nA = has_next ? A0 + (GATHER ? (size_t)0 : nxt.aoff) : cA; const char* nB = has_next ? (const char*)g.Bt + nxt.boff : cB;
#ifdef PROBE_KTWICE
        for (int rep_ = 0; rep_ < (FP8 ? 2 : 1); ++rep_) { const int sca_ = rep_ ? 0 : 0x7f7f7f7f;
#else
        { const int sca_ = 0x7f7f7f7f;
#endif
#pragma nounroll
        for (int t = 0; t < nt; t += 2) {
            int lastv = (t == nt - 2) ? 1 : 0; asm volatile("" : "+v"(lastv)); const bool last = __builtin_amdgcn_readfirstlane(lastv) != 0;
            const char* a1 = cA + (size_t)(t + 1) * akstep;
            const char* a2 = last ? nA : cA + (size_t)(t + 2) * akstep; const char* b2 = last ? nB : cB + (size_t)(t + 2) * kstep;
            const char* a3 = a2 + akstep; const char* b3 = b2 + kstep;
            PG8_LDB(B0, 0, 0); PG8_LDB(B1, 0, 1); PG8_SCHED; PG8_LDA(At, 0, 0); PG8_STAGE_A(PG8_SA(1, 1), a1, a1, 1, cv);
            if constexpr (GATHER) { if (last && has_next) { PG8_GV(cv, ns, nxt); } }
            PG8_WAIT_V(8); PG8_WAIT_L(0); PG8_BAR; PG8_MMA(0, 0, At, B0); PG8_MMA(0, 1, At, B1); PG8_BAR; PG8_SCHED;
            PG8_LDA(At, 0, 1); PG8_STAGE(PG8_SB(0, 0), b2, voffB); PG8_STAGE(PG8_SB(0, 1), b2 + hstep, voffB); PG8_STAGE_A(PG8_SA(0, 0), a2, a2, 0, cv);
            PG8_WAIT_V(8); PG8_WAIT_L(0); PG8_BAR; PG8_MMA(1, 0, At, B0); PG8_MMA(1, 1, At, B1); PG8_BAR; PG8_SCHED;
            PG8_LDB(B0, 1, 0); PG8_LDB(B1, 1, 1); PG8_SCHED; PG8_LDA(At, 1, 0); PG8_STAGE_A(PG8_SA(0, 1), a2, a2, 1, cv);
            PG8_WAIT_V(8); PG8_WAIT_L(0); PG8_BAR; PG8_MMA(0, 0, At, B0); PG8_MMA(0, 1, At, B1); PG8_BAR; PG8_SCHED;
            PG8_LDA(At, 1, 1); PG8_STAGE(PG8_SB(1, 0), b3, voffB); PG8_STAGE(PG8_SB(1, 1), b3 + hstep, voffB); PG8_STAGE_A(PG8_SA(1, 0), a3, a3, 0, cv);
            PG8_WAIT_V(8); PG8_WAIT_L(0); PG8_BAR; PG8_MMA(1, 0, At, B0); PG8_MMA(1, 1, At, B1); PG8_BAR; PG8_SCHED;
        }
        }
        if constexpr (ALIGN_EPI) { if (wr == 0) PG8_BAR; }
        PG8_SCHED;
        E(acc, cur, wr, wc, fr, fq, (const PG8_LAS unsigned*)(idb + us * 768));
        PG8_SCHED;
#ifdef PROBE_EPI2
        if constexpr (FP8) { E(acc, cur, wr, wc, fr, fq, (const PG8_LAS unsigned*)(idb + us * 768)); PG8_SCHED; }
#endif
        if (!has_next) break;
#pragma unroll
        for (int a = 0; a < 2; ++a)
#pragma unroll
            for (int b = 0; b < 2; ++b)
#pragma unroll
                for (int m = 0; m < 4; ++m)
#pragma unroll
                    for (int n = 0; n < 2; ++n) acc[a][b][m][n] = (f32x4){0.f, 0.f, 0.f, 0.f};
        cur = nxt; cA = nA; cB = nB; ++ui; us = ns;
        if constexpr (ALIGN_EPI) { if (wr == 1) PG8_BAR; }
    }
    PG8_WAIT_V(0);
    if constexpr (!ALIGN_EPI) { if (wr == 0) PG8_BAR; }
    PG8_BAR;
#undef PG8_SA
#undef PG8_SB
#undef PG8_STAGE
#undef PG8_STAGE_A
#undef PG8_LDA
#undef PG8_LDB
#undef PG8_MMA
#undef PG8_LD32
#undef PG8_WAIT_V
#undef PG8_WAIT_L
#undef PG8_BAR
#undef PG8_SCHED
#undef PG8_IDS_DMA
#undef PG8_GV
}
}
namespace attn_body {
using bf16=__hip_bfloat16;
using bf16x8=__attribute__((ext_vector_type(8)))short;
using s16x4=__attribute__((ext_vector_type(4)))short;
using f32x16=__attribute__((ext_vector_type(16)))float;
using u32x4=__attribute__((ext_vector_type(4)))unsigned;
constexpr int D=64;
constexpr int NW=8,QBLK=32,QB=QBLK*NW,KVBLK=64;
struct UnitP { const bf16* Q; const bf16* K; const bf16* V; bf16* O; long qp, kp, op; int q0, t0, NT; float slope2; float* lse; int lse_stride; };
__device__ __forceinline__ int crow(int r,int hi){return (r&3)+8*(r>>2)+4*hi;}
#define SBAR() __builtin_amdgcn_sched_barrier(0)
template<bool CAUSAL,bool WINDOW> __device__ __forceinline__ void cmask(f32x16&p0,f32x16&p1,int jb,int qrel,int hi){
  const float NEG=-INFINITY; int kb=64*jb+4*hi;
  #pragma unroll
  for(int r=0;r<16;++r){int kv=kb+(r&3)+8*(r>>2);
    if(CAUSAL){ if(kv>qrel)p0[r]=NEG; if(kv+32>qrel)p1[r]=NEG; }
    if(WINDOW){ if(kv<qrel-128)p0[r]=NEG; if(kv+32<qrel-128)p1[r]=NEG; } }
}
__device__ __forceinline__ unsigned bfr(float x){ typedef float f2_ __attribute__((ext_vector_type(2))); typedef __bf16 b2_ __attribute__((ext_vector_type(2))); f2_ v={x,0.f}; b2_ b=__builtin_convertvector(v,b2_); return __builtin_bit_cast(unsigned,b)&0xffffu; }
__device__ __forceinline__ float bfv(unsigned b){ return __builtin_bit_cast(float,b<<16); }

constexpr int NSLOT=3, SLOTB=8192;
constexpr int LDS_K=0, LDS_V=NSLOT*SLOTB;
template<int DV> struct Lds { static constexpr int SLOTV=SLOTB*(DV/64), WS=LDS_V+NSLOT*SLOTV, OST=WS+NW*64*4, OSTW=4096*(DV/64), BYTES=OST+NW*OSTW; };
__device__ __forceinline__ void glds16(const void*gsrc,unsigned lds_dst){unsigned keep;
  asm volatile("s_mov_b32 %0, m0\n\ts_mov_b32 m0, %2\n\ts_nop 0\n\tglobal_load_lds_dwordx4 %1, off\n\ts_mov_b32 m0, %0":"=&s"(keep):"v"(gsrc),"s"(lds_dst):"memory");}
__device__ __forceinline__ float max3f(float a,float b,float c){float r;asm("v_max3_f32 %0, %1, %2, %3":"=v"(r):"v"(a),"v"(b),"v"(c));return r;}
__device__ __forceinline__ float max2f(float a,float b){float r;asm("v_max_f32_e32 %0, %1, %2":"=v"(r):"v"(a),"v"(b));return r;}
__device__ __forceinline__ float fadd_s(float a,float b){float r;asm("v_add_f32_e32 %0, %1, %2":"=v"(r):"v"(a),"v"(b));return r;}
__device__ __forceinline__ float fsub_s(float a,float b){float r;asm("v_sub_f32_e32 %0, %1, %2":"=v"(r):"v"(a),"v"(b));return r;}
typedef float f32x2_t __attribute__((ext_vector_type(2))); typedef __bf16 bf16x2_t __attribute__((ext_vector_type(2)));
__device__ __forceinline__ unsigned cvtpk_s(float lo,float hi){f32x2_t v={lo,hi};bf16x2_t b=__builtin_convertvector(v,bf16x2_t);return __builtin_bit_cast(unsigned,b);}
#define WAIT_BAR(N) asm volatile("s_waitcnt vmcnt(" #N ") lgkmcnt(0)\n\ts_barrier":::"memory")

__device__ __forceinline__ void qkt(f32x16&p0,f32x16&p1,const char*Kslot,const bf16x8*qr,bf16x8 kx0,bf16x8 kx1,bf16x8 qx,int r32,int hi){
  const char*kb=Kslot+hi*1024+r32*16;
  #pragma unroll
  for(int d0=0;d0<4;++d0){
    const bf16x8 b0=*reinterpret_cast<const bf16x8*>(kb+d0*2048);
    const bf16x8 b1=*reinterpret_cast<const bf16x8*>(kb+d0*2048+512);
    if(d0==0){p0=__builtin_amdgcn_mfma_f32_32x32x16_bf16(b0,qr[0],f32x16{},0,0,0);p1=__builtin_amdgcn_mfma_f32_32x32x16_bf16(b1,qr[0],f32x16{},0,0,0);}
    else{p0=__builtin_amdgcn_mfma_f32_32x32x16_bf16(b0,qr[d0],p0,0,0,0);p1=__builtin_amdgcn_mfma_f32_32x32x16_bf16(b1,qr[d0],p1,0,0,0);}}
  p0=__builtin_amdgcn_mfma_f32_32x32x16_bf16(kx0,qx,p0,0,0,0);p1=__builtin_amdgcn_mfma_f32_32x32x16_bf16(kx1,qx,p1,0,0,0);
}
typedef __attribute__((address_space(3))) const char* lds_cptr;
typedef short v4i16_t __attribute__((ext_vector_type(4)));
__device__ __forceinline__ void kload8(bf16x8*kf,lds_cptr kp){
  kf[0]=*(const __attribute__((address_space(3))) bf16x8*)(kp);      kf[1]=*(const __attribute__((address_space(3))) bf16x8*)(kp+512);
  kf[2]=*(const __attribute__((address_space(3))) bf16x8*)(kp+2048); kf[3]=*(const __attribute__((address_space(3))) bf16x8*)(kp+2560);
  kf[4]=*(const __attribute__((address_space(3))) bf16x8*)(kp+4096); kf[5]=*(const __attribute__((address_space(3))) bf16x8*)(kp+4608);
  kf[6]=*(const __attribute__((address_space(3))) bf16x8*)(kp+6144); kf[7]=*(const __attribute__((address_space(3))) bf16x8*)(kp+6656);
}
__device__ __forceinline__ void kload2(bf16x8*kf,lds_cptr kp,int j){ kf[2*j]=*(const __attribute__((address_space(3))) bf16x8*)(kp+j*2048); kf[2*j+1]=*(const __attribute__((address_space(3))) bf16x8*)(kp+j*2048+512); }
__device__ __forceinline__ s16x4 vtr(lds_cptr p){ return __builtin_bit_cast(s16x4,__builtin_amdgcn_ds_read_tr16_b64_v4i16((__attribute__((address_space(3))) v4i16_t*)p)); }
__device__ __forceinline__ float rowmax(const f32x16&p0,const f32x16&p1){
  float a=max3f(p0[0],p0[1],p1[0]),b=max3f(p0[2],p0[3],p1[1]);a=max3f(a,p1[2],p1[3]);
  #pragma unroll
  for(int r=4;r<16;r+=4){a=max3f(a,p0[r],p0[r+1]);b=max3f(b,p0[r+2],p0[r+3]);a=max3f(a,p1[r],p1[r+1]);b=max3f(b,p1[r+2],p1[r+3]);}
  const float m=max2f(a,b);
  auto rr=__builtin_amdgcn_permlane32_swap(__float_as_uint(m),__float_as_uint(m),false,false);
  return max2f(__uint_as_float(rr[0]),__uint_as_float(rr[1]));
}
__device__ __forceinline__ void pv(f32x16*o,int vb,bf16x8 pa0,bf16x8 pa1,bf16x8 pa2,bf16x8 pa3){
  #pragma unroll
  for(int d0=0;d0<2;++d0){s16x4 lo[4],hi[4];
    #pragma unroll
    for(int ks=0;ks<4;++ks){
      asm volatile("ds_read_b64_tr_b16 %0,%1 offset:%c2":"=&v"(lo[ks]):"v"(vb),"i"(d0*4096+ks*1024):"memory");
      asm volatile("ds_read_b64_tr_b16 %0,%1 offset:%c2":"=&v"(hi[ks]):"v"(vb),"i"(d0*4096+ks*1024+512):"memory");}
    asm volatile("s_waitcnt lgkmcnt(0)":::"memory");SBAR();
    #define PK(k) (bf16x8){lo[k][0],lo[k][1],lo[k][2],lo[k][3],hi[k][0],hi[k][1],hi[k][2],hi[k][3]}
    o[d0]=__builtin_amdgcn_mfma_f32_32x32x16_bf16(pa0,PK(0),o[d0],0,0,0);
    o[d0]=__builtin_amdgcn_mfma_f32_32x32x16_bf16(pa1,PK(1),o[d0],0,0,0);
    o[d0]=__builtin_amdgcn_mfma_f32_32x32x16_bf16(pa2,PK(2),o[d0],0,0,0);
    o[d0]=__builtin_amdgcn_mfma_f32_32x32x16_bf16(pa3,PK(3),o[d0],0,0,0);
    #undef PK
  }
}

__device__ __forceinline__ void pv128(f32x16*o,int vb,bf16x8 pa0,bf16x8 pa1,bf16x8 pa2,bf16x8 pa3){
  #pragma unroll
  for(int d0=0;d0<4;++d0){s16x4 lo[4],hi[4];
    #pragma unroll
    for(int ks=0;ks<4;++ks){
      asm volatile("ds_read_b64_tr_b16 %0,%1 offset:%c2":"=&v"(lo[ks]):"v"(vb),"i"(d0*4096+ks*1024):"memory");
      asm volatile("ds_read_b64_tr_b16 %0,%1 offset:%c2":"=&v"(hi[ks]):"v"(vb),"i"(d0*4096+ks*1024+512):"memory");}
    asm volatile("s_waitcnt lgkmcnt(0)":::"memory");SBAR();
    #define PK(k) (bf16x8){lo[k][0],lo[k][1],lo[k][2],lo[k][3],hi[k][0],hi[k][1],hi[k][2],hi[k][3]}
    o[d0]=__builtin_amdgcn_mfma_f32_32x32x16_bf16(pa0,PK(0),o[d0],0,0,0);
    o[d0]=__builtin_amdgcn_mfma_f32_32x32x16_bf16(pa1,PK(1),o[d0],0,0,0);
    o[d0]=__builtin_amdgcn_mfma_f32_32x32x16_bf16(pa2,PK(2),o[d0],0,0,0);
    o[d0]=__builtin_amdgcn_mfma_f32_32x32x16_bf16(pa3,PK(3),o[d0],0,0,0);
    #undef PK
  }
}
#ifndef ATTN_STORE16
#define ATTN_STORE16(p,v) (*(u32x4*)(p)=(v))
#endif
template<int THRL,bool CAUSAL,bool WINDOW,bool ALIBI,bool LSE,int DV=64> __device__ __forceinline__ void attn_unit(const UnitP&U,char*shm){
  constexpr int LDS_WS=Lds<DV>::WS, LDS_OST=Lds<DV>::OST, VMUL=DV/64;
  int tid=threadIdx.x; asm volatile("":"+v"(tid));
  const int lane=tid&63,r32=lane&31,hi=lane>>5; const int wid=__builtin_amdgcn_readfirstlane(tid>>6);
  const int q0=U.q0; const long qp=U.qp,kp=U.kp,op=U.op; const float slope2=U.slope2;
  const bf16*Qw=U.Q+(long)(q0+wid*QBLK)*qp;
  const bf16*Kh=U.K+(long)U.t0*KVBLK*kp,*Vh=U.V+(long)U.t0*KVBLK*kp;
  const unsigned lds0=(unsigned)(uintptr_t)shm;
  float*wsf=(float*)(shm+LDS_WS)+wid*64;
  const bf16*ksrc=Kh+(long)lane*kp+wid*8;
  const bf16*vsrc=Vh+(long)(16*(wid&3)+(lane>>2))*kp+(wid>>2)*32+(lane&3)*8;
  const unsigned kdst=lds0+LDS_K+wid*1024, vdst=lds0+LDS_V+wid*1024;
  #define DMA_K(t,slot) glds16(ksrc+(long)(t)*KVBLK*kp,(unsigned)__builtin_amdgcn_readfirstlane(kdst+(slot)))
  #define DMA_V(t,slot) do{ glds16(vsrc+(long)(t)*KVBLK*kp,(unsigned)__builtin_amdgcn_readfirstlane(vdst+VMUL*(slot))); if constexpr(DV==128) glds16(vsrc+64+(long)(t)*KVBLK*kp,(unsigned)__builtin_amdgcn_readfirstlane(vdst+VMUL*(slot)+8192)); }while(0)
  const int vb0=(int)(lds0+LDS_V)+((lane>>4)&1)*32+(lane&3)*8+(4*hi+((lane&15)>>2))*64;
  const char*Kbase=shm+LDS_K; bf16x8 kf[8];
  const lds_cptr shm3=(lds_cptr)shm; const lds_cptr kp0=shm3+LDS_K+hi*1024+r32*16; const lds_cptr vp0=shm3+LDS_V+((lane>>4)&1)*32+(lane&3)*8+(4*hi+((lane&15)>>2))*64;
  const int NT=U.NT;
  DMA_K(0,0);DMA_V(0,0);DMA_K(1,SLOTB);
  bf16x8 qr[4];
  #pragma unroll
  for(int d0=0;d0<4;++d0)qr[d0]=*reinterpret_cast<const bf16x8*>(&Qw[(long)r32*qp+d0*16+hi*8]);
  float mhat=0.f,l_reg=0.f;f32x16 o[4];o[0]=f32x16{};o[1]=f32x16{};o[2]=f32x16{};o[3]=f32x16{};
  const int qrel=wid*QBLK+r32;
  #define CMASK(P0,P1,t) do{int jb_=(t)-(NT-4); if(WINDOW||(CAUSAL&&jb_>=0))cmask<CAUSAL,WINDOW>(P0,P1,jb_,qrel,hi);}while(0)
  bf16x8 kx0,kx1,qx;
  { const float k0_=ALIBI?slope2*(float)r32:0.f, k1_=ALIBI?slope2*(float)(r32+32):0.f; const unsigned h0=bfr(k0_),l0=bfr(k0_-bfv(h0)),h1=bfr(k1_),l1=bfr(k1_-bfv(h1));
    u32x4 a={0x3f803f80u,0x3f80u|(h0<<16),l0,0u}, b={0x3f803f80u,0x3f80u|(h1<<16),l1,0u}; if(hi){a=u32x4{0u,0u,0u,0u};b=a;} kx0=__builtin_bit_cast(bf16x8,a); kx1=__builtin_bit_cast(bf16x8,b); }
  #define QX_SET(t) do{ const float nb_=ALIBI?__builtin_fmaf(slope2,(float)(64*((t)-(NT-4))-qrel),-mhat):-mhat; const unsigned a_=bfr(nb_); const float r1_=nb_-bfv(a_); const unsigned b_=bfr(r1_); const unsigned c_=bfr(r1_-bfv(b_)); \
    u32x4 q_={a_|(b_<<16),c_|0x3f800000u,0x3f80u,0u}; if(hi)q_=u32x4{0u,0u,0u,0u}; qx=__builtin_bit_cast(bf16x8,q_); asm volatile("":"+v"(qx)); }while(0)
  bool resc=false;
  #define START(P0,P1) do{ const float rm=rowmax(P0,P1); resc=false; \
    { const float dl=(rm==-INFINITY)?0.f:rm; mhat=fadd_s(mhat,dl); \
      _Pragma("unroll") for(int r=0;r<16;++r){P0[r]=fsub_s(P0[r],dl);P1[r]=fsub_s(P1[r],dl);} } \
    _Pragma("unroll") for(int r=0;r<16;++r)P0[r]=__builtin_amdgcn_exp2f(P0[r]); }while(0)
  #define RESC() do{ if(resc){ asm volatile("s_waitcnt lgkmcnt(0)":::"memory"); \
      _Pragma("unroll") for(int d_=0;d_<2*VMUL;++d_) _Pragma("unroll") for(int r=0;r<16;++r)o[d_][r]*=wsf[crow(r,hi)]; } }while(0)
  f32x16 pA0,pA1,pB0,pB1;
  int sl_prev=0,sl_cur=0,sl_next=SLOTB;
  #define ROT() do{sl_prev=sl_cur;sl_cur=sl_next;sl_next=(sl_next==(NSLOT-1)*SLOTB)?0:sl_next+SLOTB;}while(0)
  DMA_K(2,2*SLOTB);
  if constexpr(DV==128){WAIT_BAR(4);}else{WAIT_BAR(3);}
  QX_SET(0);
  qkt(pA0,pA1,Kbase,qr,kx0,kx1,qx,r32,hi);asm volatile("s_nop 15\n\ts_nop 7":"+v"(pA0),"+v"(pA1));CMASK(pA0,pA1,0);
  START(pA0,pA1);
  _Pragma("unroll") for(int r=0;r<16;++r)pA1[r]=__builtin_amdgcn_exp2f(pA1[r]);
  WAIT_BAR(0);
  DMA_K(3,0);DMA_V(1,SLOTB);
  ROT();
  kload8(kf,kp0+sl_cur);
  if constexpr(DV==128){WAIT_BAR(3);}else{WAIT_BAR(2);}
  s16x4 vlo[8],vhi[8]; s16x4 vfl[4],vfh[4]; u32x4 pw0,pw1,pw2,pw3;
  #define PKW(P,B) cvtpk_s(P[B],P[B+1])
  #define PAF(k) __builtin_bit_cast(bf16x8,pw##k)
  #define VFR(i) (bf16x8){vlo[i][0],vlo[i][1],vlo[i][2],vlo[i][3],vhi[i][0],vhi[i][1],vhi[i][2],vhi[i][3]}
  #define PIN(x) asm volatile("":"+v"(x))
  #define MX3(a,b,c) __builtin_fmaxf(__builtin_fmaxf((a),(b)),(c))
  #define GAPA(MF,A0,A1,A2,A3,W0,W1,PW) do{ MF; sacc+=A0; sacc+=A1; sacc+=A2; sacc+=A3; PIN(sacc); W0; W1; PIN(PW); SBAR(); }while(0)
  #define EX(v) __builtin_amdgcn_exp2f(v)
  #define GAPB(MF,X,B) do{ MF; X[B]=EX(X[B]); X[B+1]=EX(X[B+1]); X[B+2]=EX(X[B+2]); X[B+3]=EX(X[B+3]); PIN(X); SBAR(); }while(0)
  #define VRD(i) do{ if constexpr(DV==64){ vlo[i]=vtr(vp_+(((i)>>2)*4096+((i)&3)*1024)); vhi[i]=vtr(vp_+(((i)>>2)*4096+((i)&3)*1024+512)); } }while(0)
  #define VRJ(f) do{ vfl[(f)&3]=vtr(vp_+(((f)&3)*4096+((f)>>2)*1024)); vfh[(f)&3]=vtr(vp_+(((f)&3)*4096+((f)>>2)*1024+512)); }while(0)
  #define VFJ(f) (bf16x8){vfl[(f)&3][0],vfl[(f)&3][1],vfl[(f)&3][2],vfl[(f)&3][3],vfh[(f)&3][0],vfh[(f)&3][1],vfh[(f)&3][2],vfh[(f)&3][3]}
  #define GAPJ(f,PA,X,B) do{ if((f)+3<16){VRJ((f)+3);} o[(f)&3]=__builtin_amdgcn_mfma_f32_32x32x16_bf16(PA,VFJ(f),o[(f)&3],0,0,0); X[B]=EX(X[B]); X[B+1]=EX(X[B+1]); PIN(X); SBAR(); }while(0)
  #define KRD(G,j) do{ if(G){ kload2(kf,kp0+sl_next,j); SBAR(); } }while(0)
  #define STEP(C0,C1,P0,P1,t,GK,GV,GL) do{ SBAR(); QX_SET(t); SBAR(); \
    const lds_cptr vp_=vp0+VMUL*sl_prev; \
    VRD(0); SBAR(); float sacc=(P0[0]+P0[1]); \
    GAPA(C0=__builtin_amdgcn_mfma_f32_32x32x16_bf16(kf[0],qr[0],f32x16{},0,0,0), P0[2],P0[3],P0[4],P0[5],     pw0[0]=PKW(P0,0), pw0[1]=PKW(P0,2), pw0); \
    VRD(4); SBAR(); GAPA(C1=__builtin_amdgcn_mfma_f32_32x32x16_bf16(kf[1],qr[0],f32x16{},0,0,0), P0[6],P0[7],P0[8],P0[9],     pw0[2]=PKW(P0,4), pw0[3]=PKW(P0,6), pw0); \
    VRD(1); SBAR(); GAPA(C0=__builtin_amdgcn_mfma_f32_32x32x16_bf16(kf[2],qr[1],C0,0,0,0),   P0[10],P0[11],P0[12],P0[13], pw1[0]=PKW(P0,8), pw1[1]=PKW(P0,10), pw1); \
    VRD(5); SBAR(); GAPA(C1=__builtin_amdgcn_mfma_f32_32x32x16_bf16(kf[3],qr[1],C1,0,0,0),   P0[14],P0[15],P1[0],P1[1],   pw1[2]=PKW(P0,12),pw1[3]=PKW(P0,14), pw1); \
    VRD(2); SBAR(); GAPA(C0=__builtin_amdgcn_mfma_f32_32x32x16_bf16(kf[4],qr[2],C0,0,0,0),   P1[2],P1[3],P1[4],P1[5],     pw2[0]=PKW(P1,0), pw2[1]=PKW(P1,2), pw2); \
    VRD(6); SBAR(); GAPA(C1=__builtin_amdgcn_mfma_f32_32x32x16_bf16(kf[5],qr[2],C1,0,0,0),   P1[6],P1[7],P1[8],P1[9],     pw2[2]=PKW(P1,4), pw2[3]=PKW(P1,6), pw2); \
    VRD(3); SBAR(); GAPA(C0=__builtin_amdgcn_mfma_f32_32x32x16_bf16(kf[6],qr[3],C0,0,0,0),   P1[10],P1[11],P1[12],P1[13], pw3[0]=PKW(P1,8), pw3[1]=PKW(P1,10), pw3); \
    VRD(7); SBAR(); GAPA(C1=__builtin_amdgcn_mfma_f32_32x32x16_bf16(kf[7],qr[3],C1,0,0,0),   P1[14],P1[15],0.f,0.f,       pw3[2]=PKW(P1,12),pw3[3]=PKW(P1,14), pw3); \
    C0=__builtin_amdgcn_mfma_f32_32x32x16_bf16(kx0,qx,C0,0,0,0); C1=__builtin_amdgcn_mfma_f32_32x32x16_bf16(kx1,qx,C1,0,0,0); if constexpr(DV==128){VRJ(0);VRJ(1);VRJ(2);} SBAR(); \
    l_reg+=sacc; \
    if(GK){DMA_K((t)+3,sl_cur);} if(GV){DMA_V((t)+1,sl_next);} \
    CMASK(C0,C1,t); \
    { float a=MX3(C0[0],C0[1],C1[0]),b=MX3(C0[2],C0[3],C1[1]); a=MX3(a,C1[2],C1[3]); \
      _Pragma("unroll") for(int r=4;r<16;r+=4){a=MX3(a,C0[r],C0[r+1]);b=MX3(b,C0[r+2],C0[r+3]);a=MX3(a,C1[r],C1[r+1]);b=MX3(b,C1[r+2],C1[r+3]);} \
      float rm=__builtin_fmaxf(a,b); { auto rr=__builtin_amdgcn_permlane32_swap(__float_as_uint(rm),__float_as_uint(rm),false,false); rm=__builtin_fmaxf(__uint_as_float(rr[0]),__uint_as_float(rr[1])); } \
      resc=false; \
      if(__builtin_expect(__any(rm>(float)THRL),0)){ const float dl=__builtin_fmaxf(rm,0.f); mhat+=dl; \
        _Pragma("unroll") for(int r=0;r<16;++r){C0[r]-=dl;C1[r]-=dl;} \
        const float f=__builtin_amdgcn_exp2f(-dl); l_reg*=f; if(hi==0)wsf[r32]=f; resc=true; } } \
    SBAR(); \
    if constexpr(DV==64){ \
    GAPB(o[0]=__builtin_amdgcn_mfma_f32_32x32x16_bf16(PAF(0),VFR(0),o[0],0,0,0), C0,0); \
    GAPB(o[1]=__builtin_amdgcn_mfma_f32_32x32x16_bf16(PAF(0),VFR(4),o[1],0,0,0), C0,4); \
    KRD(GL,0); GAPB(o[0]=__builtin_amdgcn_mfma_f32_32x32x16_bf16(PAF(1),VFR(1),o[0],0,0,0), C0,8); \
    KRD(GL,1); GAPB(o[1]=__builtin_amdgcn_mfma_f32_32x32x16_bf16(PAF(1),VFR(5),o[1],0,0,0), C0,12); \
    KRD(GL,2); GAPB(o[0]=__builtin_amdgcn_mfma_f32_32x32x16_bf16(PAF(2),VFR(2),o[0],0,0,0), C1,0); \
    KRD(GL,3); GAPB(o[1]=__builtin_amdgcn_mfma_f32_32x32x16_bf16(PAF(2),VFR(6),o[1],0,0,0), C1,4); \
    GAPB(o[0]=__builtin_amdgcn_mfma_f32_32x32x16_bf16(PAF(3),VFR(3),o[0],0,0,0), C1,8); \
    GAPB(o[1]=__builtin_amdgcn_mfma_f32_32x32x16_bf16(PAF(3),VFR(7),o[1],0,0,0), C1,12); \
    } else { \
    GAPJ(0,PAF(0),C0,0); GAPJ(1,PAF(0),C0,2); GAPJ(2,PAF(0),C0,4); GAPJ(3,PAF(0),C0,6); \
    KRD(GL,0); GAPJ(4,PAF(1),C0,8); GAPJ(5,PAF(1),C0,10); KRD(GL,1); GAPJ(6,PAF(1),C0,12); GAPJ(7,PAF(1),C0,14); \
    KRD(GL,2); GAPJ(8,PAF(2),C1,0); GAPJ(9,PAF(2),C1,2); KRD(GL,3); GAPJ(10,PAF(2),C1,4); GAPJ(11,PAF(2),C1,6); \
    GAPJ(12,PAF(3),C1,8); GAPJ(13,PAF(3),C1,10); GAPJ(14,PAF(3),C1,12); GAPJ(15,PAF(3),C1,14); \
    } \
    }while(0)
  int t=1;
  #undef CMASK
  #define CMASK(P0,P1,t) do{}while(0)
  for(;t+5<NT;t+=2){
    STEP(pB0,pB1,pA0,pA1,t,true,true,true);     if constexpr(DV==128){WAIT_BAR(3);}else{WAIT_BAR(2);} RESC(); ROT();
    STEP(pA0,pA1,pB0,pB1,t+1,true,true,true);   if constexpr(DV==128){WAIT_BAR(3);}else{WAIT_BAR(2);} RESC(); ROT();
  }
  #undef CMASK
  #define CMASK(P0,P1,t) do{int jb_=(t)-(NT-4); if(WINDOW||(CAUSAL&&jb_>=0))cmask<CAUSAL,WINDOW>(P0,P1,jb_,qrel,hi);}while(0)
  #define ENDW(tt) do{ if((tt)+3<NT){ if constexpr(DV==128){WAIT_BAR(3);}else{WAIT_BAR(2);} } else if((tt)+2<NT){ if constexpr(DV==128){WAIT_BAR(2);}else{WAIT_BAR(1);} } else {WAIT_BAR(0);} }while(0)
  for(;t+1<NT;t+=2){
    STEP(pB0,pB1,pA0,pA1,t,(t+3<NT),(t+1<NT),(t+1<NT));       ENDW(t);   RESC(); ROT();
    STEP(pA0,pA1,pB0,pB1,t+1,(t+4<NT),(t+2<NT),(t+2<NT));     ENDW(t+1); RESC(); ROT();
  }
  STEP(pB0,pB1,pA0,pA1,NT-1,false,false,false); RESC();
  { float sacc=pB0[0]+pB0[1]; _Pragma("unroll") for(int r=2;r<16;++r)sacc+=pB0[r]; _Pragma("unroll") for(int r=0;r<16;++r)sacc+=pB1[r]; l_reg+=sacc;
    pw0=(u32x4){PKW(pB0,0),PKW(pB0,2),PKW(pB0,4),PKW(pB0,6)};pw1=(u32x4){PKW(pB0,8),PKW(pB0,10),PKW(pB0,12),PKW(pB0,14)};pw2=(u32x4){PKW(pB1,0),PKW(pB1,2),PKW(pB1,4),PKW(pB1,6)};pw3=(u32x4){PKW(pB1,8),PKW(pB1,10),PKW(pB1,12),PKW(pB1,14)};
    SBAR(); if constexpr(DV==128){pv128(o,vb0+VMUL*sl_cur,PAF(0),PAF(1),PAF(2),PAF(3));}else{pv(o,vb0+sl_cur,PAF(0),PAF(1),PAF(2),PAF(3));} }
  #undef PKW
  #undef PAF
  #undef VFR
  #undef PIN
  #undef MX3
  #undef GAPA
  #undef GAPB
  #undef EX
  #undef VRD
  #undef VRJ
  #undef VFJ
  #undef GAPJ
  #undef KRD
  #undef STEP
  #undef ENDW
  {auto rr=__builtin_amdgcn_permlane32_swap(__float_as_uint(l_reg),__float_as_uint(l_reg),false,false);l_reg=__uint_as_float(rr[0])+__uint_as_float(rr[1]);}
  if(LSE){ if(hi==0)U.lse[(long)(q0+wid*QBLK+r32)*U.lse_stride]=mhat+__builtin_amdgcn_logf(l_reg); }
  if(hi==0)wsf[32+r32]=l_reg;asm volatile("s_waitcnt lgkmcnt(0)":::"memory");
  float rli[16];
  #pragma unroll
  for(int r=0;r<16;++r)rli[r]=__builtin_amdgcn_rcpf(wsf[32+crow(r,hi)]);
  bf16*Ow=U.O+(long)(q0+wid*QBLK)*op;
  { bf16*stg=(bf16*)(shm+LDS_OST)+wid*(2048*VMUL);
    #pragma unroll
    for(int r=0;r<16;++r){const int orow=crow(r,hi);
      #pragma unroll
      for(int d0=0;d0<2*VMUL;++d0)stg[orow*DV+d0*32+r32]=__float2bfloat16(o[d0][r]*rli[r]);}
    asm volatile("s_waitcnt lgkmcnt(0)":::"memory");
    if constexpr(DV==128){
      #pragma unroll
      for(int i=0;i<8;++i){const int row=i*4+(lane>>4),ch=lane&15; const u32x4 v=*(const u32x4*)(stg+row*128+ch*8); ATTN_STORE16(Ow+(long)row*op+ch*8,v);}
    } else {
      #pragma unroll
      for(int i=0;i<4;++i){const int row=i*8+(lane>>3),ch=lane&7; const u32x4 v=*(const u32x4*)(stg+row*64+ch*8); ATTN_STORE16(Ow+(long)row*op+ch*8,v);} } }
  asm volatile("s_waitcnt lgkmcnt(0)\n\ts_barrier":::"memory");
  #undef DMA_K
  #undef DMA_V
  #undef CMASK
  #undef START
  #undef RESC
  #undef ROT
  #undef QX_SET
}
constexpr int ATTN_LDS_BYTES=Lds<128>::BYTES;
#undef SBAR
#undef WAIT_BAR
}
constexpr size_t MiB = 1u << 20;
constexpr size_t WS_CTL = 0, CTL_ZERO_BYTES = 1 * MiB;
constexpr size_t WS_LIST = 1 * MiB;
constexpr size_t WS_RGATE = 5 * MiB;
constexpr size_t WS_RSTD1 = 5 * MiB + 512 * 1024, WS_RSTD2 = WS_RSTD1 + 128 * 1024, WS_WRG = WS_RSTD2 + 128 * 1024;
constexpr size_t WS_WRT = 7 * MiB + 512 * 1024;
constexpr size_t WS_LSE = 6 * MiB;
constexpr size_t WS_MKV = 8 * MiB;
constexpr size_t WS_WIN = 10 * MiB, WS_WOUT = 15 * MiB, WS_WGU = 17 * MiB, WS_WDN = 145 * MiB;
constexpr size_t WS_XB = 209 * MiB;
constexpr size_t WS_LRSTD = 865 * MiB, WS_LGATE = 869 * MiB;
constexpr size_t WS_P = 273 * MiB, WS_OD = 433 * MiB, WS_ODIL = 497 * MiB;
constexpr size_t WS_ACT = 273 * MiB;
constexpr size_t WS_MIX = 545 * MiB, WS_X1B = 609 * MiB, WS_YB = 673 * MiB, WS_X1H = 801 * MiB, WS_Y = 929 * MiB, WS_END = 993 * MiB;
constexpr int CW_TMO = 0, CW_CODE = 1;
constexpr int CW_CNT = 64;
constexpr int CW_NRM = 256;
constexpr int CW_Q = 1024;
constexpr int CW_BAR = 4096;

constexpr int RING_OFF = 0, RING_BYTES = 131072;
constexpr int LDSCTL_OFF = RING_BYTES;
constexpr int IDB_OFF = LDSCTL_OFF;
constexpr int TBL_OFF = IDB_OFF + 9216;
constexpr int LCNT_OFF = TBL_OFF + 2304;
constexpr int MISC_OFF = LCNT_OFF + 256;
constexpr int STG_OFF = IDB_OFF;
constexpr int LDS_BYTES = 147456;
static_assert(MISC_OFF + 128 <= LDS_BYTES && 512 * 16 <= 9216, "LDS map");
constexpr int NWAVES = 8;

#define GAS __attribute__((address_space(1)))
#define LAS __attribute__((address_space(3)))
typedef unsigned short bf16;
typedef unsigned v4u __attribute__((ext_vector_type(4)));
typedef unsigned v2u __attribute__((ext_vector_type(2)));
typedef float f32x4 __attribute__((ext_vector_type(4)));
typedef float f32x16 __attribute__((ext_vector_type(16)));
typedef short bf16x8 __attribute__((ext_vector_type(8)));
typedef GAS unsigned gu32;
#define RLX_AGENT __ATOMIC_RELAXED, __HIP_MEMORY_SCOPE_AGENT
#define LDS_WAIT() asm volatile("s_waitcnt lgkmcnt(0)" ::: "memory")
#define VM_WAIT() asm volatile("s_waitcnt vmcnt(0)" ::: "memory")
__device__ __forceinline__ unsigned f2bf(float f) { unsigned u = __builtin_bit_cast(unsigned, f); return (u + 0x7fffu + ((u >> 16) & 1u)) >> 16; }
__device__ __forceinline__ unsigned pk2(float lo, float hi) { return f2bf(lo) | (f2bf(hi) << 16); }
__device__ __forceinline__ float sat8(float v) { return __builtin_amdgcn_fmed3f(v, -448.f, 448.f); }
__device__ __forceinline__ unsigned fp8x4(float a, float b, float c, float d) { int w = __builtin_amdgcn_cvt_pk_fp8_f32(sat8(a), sat8(b), 0, false); w = __builtin_amdgcn_cvt_pk_fp8_f32(sat8(c), sat8(d), w, true); return (unsigned)w; }
constexpr float WSCALE = 64.f, ASCALE = 8.f, YSCALE = 64.f;
__device__ __forceinline__ float bf2f(unsigned short b) { return __builtin_bit_cast(float, (unsigned)b << 16); }
__device__ __forceinline__ float bflo(unsigned w) { return __builtin_bit_cast(float, w << 16); }
__device__ __forceinline__ float bfhi(unsigned w) { return __builtin_bit_cast(float, w & 0xffff0000u); }
__device__ __forceinline__ float wave_sum(float v) {
#pragma unroll
    for (int o = 1; o < 64; o <<= 1) v += __shfl_xor(v, o);
    return v;
}

#define XB_TMO      128
#define XB_XCNT(j)  (256  + 64 * (j))
#define XB_XSUB(j)  (1280 + 64 * (j))
#define XB_XGEN(j)  (2304 + 64 * (j))
#define XB_TOP      3328
#define XB_TOPGEN   3392
#define XCD_BAR_WORDS 3456
#define XB_SPIN_CAP (1u << 20)
__device__ __forceinline__ unsigned xb_ld(unsigned* p)              { return __hip_atomic_load(p, __ATOMIC_RELAXED, __HIP_MEMORY_SCOPE_AGENT); }
__device__ __forceinline__ unsigned xb_add(unsigned* p, unsigned v) { return __hip_atomic_fetch_add(p, v, __ATOMIC_RELAXED, __HIP_MEMORY_SCOPE_AGENT); }
__device__ __forceinline__ unsigned xb_xcc_id() { return (unsigned)__builtin_amdgcn_s_getreg((3 << 11) | 20) & 0xFu; }
#define XB_SPIN(cond, bar) do { unsigned _sp = 0; while (cond) { __builtin_amdgcn_s_sleep(1); \
    if ((++_sp & 255u) == 0u) { if (xb_ld(&(bar)[XB_TMO])) break; if (_sp > XB_SPIN_CAP) { atomicAdd(&(bar)[XB_TMO], 1u); break; } } } } while (0)
struct XcdBarrier { unsigned* bar; unsigned x; volatile LAS unsigned* st; };
__device__ __forceinline__ XcdBarrier xcd_barrier_post(unsigned* bar, volatile LAS unsigned* st, const bool lead) {
    XcdBarrier b; b.bar = bar; b.x = xb_xcc_id(); b.st = st;
    if (lead) (void)xb_add(&bar[XB_XCNT(b.x)], 1u);
    return b;
}
__device__ __forceinline__ void xcd_barrier_complete(unsigned* bar, unsigned x, unsigned& nloc, unsigned& nx) {
    const unsigned G = gridDim.x * gridDim.y * gridDim.z;
    unsigned sum, cnt, mine, sp = 0u;
    for (;;) {
        sum = 0u; cnt = 0u; mine = 0u;
#pragma unroll
        for (unsigned j = 0; j < 16; ++j) { const unsigned c = xb_ld(&bar[XB_XCNT(j)]); sum += c; cnt += (c > 0u) ? 1u : 0u; mine = (j == x) ? c : mine; }
        if (sum == G) break;
        __builtin_amdgcn_s_sleep(1);
        if ((++sp & 255u) == 0u) { if (xb_ld(&bar[XB_TMO])) break; if (sp > XB_SPIN_CAP) { atomicAdd(&bar[XB_TMO], 1u); break; } }
    }
    nloc = mine > 0u ? mine : 1u; nx = cnt > 0u ? cnt : 1u;
}
__device__ __forceinline__ void xcd_barrier(const XcdBarrier& b, const bool lead) {
    asm volatile("s_waitcnt vmcnt(0)" ::: "memory");
    __syncthreads();
    if (lead) {
        unsigned* bar = b.bar;
        __builtin_amdgcn_s_waitcnt(0);
        unsigned nloc = b.st[0], nx = b.st[1];
        if (nloc == 0u) { xcd_barrier_complete(bar, b.x, nloc, nx); b.st[0] = nloc; b.st[1] = nx; }
        const unsigned old = xb_add(&bar[XB_XSUB(b.x)], 1u);
        const unsigned gen = old / nloc;
        if (old + 1u == (gen + 1u) * nloc) {
            __builtin_amdgcn_fence(__ATOMIC_RELEASE, "agent");
            asm volatile("s_waitcnt vmcnt(0)" ::: "memory");
            const unsigned og = xb_add(&bar[XB_TOP], 1u);
            const unsigned tg = og / nx;
            if (og + 1u == (tg + 1u) * nx) xb_add(&bar[XB_TOPGEN], 1u);
            else XB_SPIN(xb_ld(&bar[XB_TOPGEN]) == tg, bar);
            __builtin_amdgcn_fence(__ATOMIC_ACQUIRE, "agent");
            xb_add(&bar[XB_XGEN(b.x)], 1u);
            asm volatile("s_waitcnt vmcnt(0)" ::: "memory");
        } else {
            XB_SPIN(xb_ld(&bar[XB_XGEN(b.x)]) == gen, bar);
            __builtin_amdgcn_fence(__ATOMIC_ACQUIRE, "agent");
            asm volatile("s_waitcnt vmcnt(0)" ::: "memory");
        }
    }
    __syncthreads();
}

struct Frame {
    LAS unsigned char* lds;
    volatile LAS unsigned* MISC;
    gu32* ctl;
    int tid, lane, wave;
    int vcu, G;
    const float *x, *mem, *g_attn, *g_mem, *w_in, *lamqk, *subg, *w_mkv, *w_out, *g_ffn, *w_r, *b_r, *w_gu, *b_gu, *w_dn, *b_dn, *g_fin;
    float* out; unsigned char* ws;
};

#define P0_LOAD(dst, itm) do { const int m_ = (itm) / ipm, r_ = (itm) % ipm, kb_ = r_ / nblk, nb_ = r_ % nblk; \
        const float* src_ = W + (size_t)m_ * K * N + (size_t)(64 * kb_ + (lane >> 5)) * N + 32 * nb_ + (lane & 31); \
        _Pragma("unroll") for (int i_ = 0; i_ < 32; ++i_) dst[i_] = __builtin_nontemporal_load(src_ + (size_t)(2 * i_) * N); } while (0)
template <bool F8, bool GAIN, class RowMap>
__device__ __forceinline__ void p0_transpose_all(const float* W, int K, int N, int nmat, void* WTv, const float* gk, float wscale, LAS float* scr, int gw, int NGW, int lane, RowMap rowmap) {
    asm volatile("" : "+v"(lane));
    const int nblk = N / 32, ipm = (K / 64) * nblk, total = nmat * ipm;
    if (gw >= total) return;
    LAS float* gl = scr + 64 * 33;
    if constexpr (GAIN) { for (int i = lane; i < K; i += 64) gl[i] = gk[i] * wscale; LDS_WAIT(); asm volatile("" ::: "memory"); }
#define P0_PROC(v, itm) do { const int m = (itm) / ipm, r = (itm) % ipm, k0 = 64 * (r / nblk), n0 = 32 * (r % nblk); \
        if constexpr (GAIN) { _Pragma("unroll") for (int i = 0; i < 32; ++i) v[i] *= gl[k0 + 2 * i + (lane >> 5)]; } \
        else if (F8) { _Pragma("unroll") for (int i = 0; i < 32; ++i) v[i] *= wscale; } \
        _Pragma("unroll") for (int i = 0; i < 32; ++i) scr[(2 * i + (lane >> 5)) * 33 + (lane & 31)] = v[i]; \
        LDS_WAIT(); asm volatile("" ::: "memory"); \
        const int c = lane & 7; \
        _Pragma("unroll") for (int j = 0; j < 4; ++j) { const int n = (lane >> 3) + 8 * j; const LAS float* s = scr + (8 * c) * 33 + n; \
            if constexpr (F8) { unsigned char* wt = (unsigned char*)WTv + (size_t)m * N * K; \
                v2u o; o.x = fp8x4(s[0 * 33], s[1 * 33], s[2 * 33], s[3 * 33]); o.y = fp8x4(s[4 * 33], s[5 * 33], s[6 * 33], s[7 * 33]); \
                *(GAS v2u*)(wt + (size_t)rowmap(n0 + n) * K + k0 + 8 * c) = o; } \
            else { bf16* wt = (bf16*)WTv + (size_t)m * N * K; \
                v4u o; o.x = pk2(s[0 * 33], s[1 * 33]); o.y = pk2(s[2 * 33], s[3 * 33]); o.z = pk2(s[4 * 33], s[5 * 33]); o.w = pk2(s[6 * 33], s[7 * 33]); \
                *(GAS v4u*)(wt + (size_t)rowmap(n0 + n) * K + k0 + 8 * c) = o; } } \
        LDS_WAIT(); asm volatile("" ::: "memory"); } while (0)
    float va[32], vb[32], vc[32];
    int it = gw;
    P0_LOAD(va, it); if (it + NGW < total) P0_LOAD(vb, it + NGW);
    for (;;) {
        if (it + 2 * NGW < total) P0_LOAD(vc, it + 2 * NGW);
        P0_PROC(va, it); it += NGW; if (it >= total) break;
        if (it + 2 * NGW < total) P0_LOAD(va, it + 2 * NGW);
        P0_PROC(vb, it); it += NGW; if (it >= total) break;
        if (it + 2 * NGW < total) P0_LOAD(vb, it + 2 * NGW);
        P0_PROC(vc, it); it += NGW; if (it >= total) break;
    }
#undef P0_PROC
}
#undef P0_LOAD
struct RowId { __device__ __forceinline__ int operator()(int n) const { return n; } };
struct RowGU { __device__ __forceinline__ int operator()(int n) const { const int f = n >> 1, u = n & 1; return ((f >> 7) << 8) + (u << 7) + (f & 127); } };

__device__ __forceinline__ void p0_x_rows4(Frame& F, const float* xrow, bf16* orow, float* rstd_out) {
    const GAS f32x4* xr = (const GAS f32x4*)xrow + F.lane;
    f32x4 v[16]; float s[4] = {0.f, 0.f, 0.f, 0.f};
#pragma unroll
    for (int j = 0; j < 16; ++j) v[j] = xr[64 * j];
#pragma unroll
    for (int j = 0; j < 16; ++j) s[j >> 2] += (v[j].x * v[j].x + v[j].y * v[j].y) + (v[j].z * v[j].z + v[j].w * v[j].w);
    GAS unsigned long long* o8 = (GAS unsigned long long*)orow + F.lane;
#pragma unroll
    for (int j = 0; j < 16; ++j) o8[64 * j] = (unsigned long long)pk2(v[j].x, v[j].y) | ((unsigned long long)pk2(v[j].z, v[j].w) << 32);
#pragma unroll
    for (int q = 0; q < 4; ++q) s[q] = wave_sum(s[q]);
    if (F.lane < 4) rstd_out[F.lane] = 1.f / sqrtf((F.lane == 0 ? s[0] : F.lane == 1 ? s[1] : F.lane == 2 ? s[2] : s[3]) * (1.f / D) + EPS);
}
__device__ __forceinline__ void p0_mkv_tile(Frame& F, int tile, bf16* mkv, const float* xsrc, bf16* xdst, float* rstd_out, int xstep) {
    const int mt = tile >> 4, nt = tile & 15, m0 = 32 * mt, n0 = 32 * nt, r = F.lane & 31, h = F.lane >> 5, kh = F.wave >> 2, tw = F.wave & 3;
    f32x16 acc = {}; float ss = 0.f;
    LAS float* blk = (LAS float*)(F.lds + RING_OFF + F.wave * 12288);
    LAS float* gl = (LAS float*)(F.lds + RING_OFF + 98304);
    for (int i = F.tid; i < D; i += NWAVES * 64) gl[i] = F.g_mem[i];
    __syncthreads();
    const float* msrc = F.mem + (size_t)(m0 + (F.lane >> 4)) * D + kh * 512 + 4 * (F.lane & 15);
    const float* wcol = F.w_mkv + (size_t)(8 * h + kh * 512) * 512 + n0 + r;
    f32x4 ma[8], mb[8]; float wa[32], wb[32];
#define MKV_LD(M, W, kk_) do { _Pragma("unroll") for (int i_ = 0; i_ < 8; ++i_) M[i_] = *(const f32x4*)(msrc + (size_t)(4 * i_) * D + (kk_)); \
        _Pragma("unroll") for (int s_ = 0; s_ < 4; ++s_) _Pragma("unroll") for (int j_ = 0; j_ < 8; ++j_) W[8 * s_ + j_] = wcol[(size_t)((kk_) + 16 * s_ + j_) * 512]; } while (0)
#define MKV_MM(M, W, kk_) do { _Pragma("unroll") for (int i_ = 0; i_ < 8; ++i_) *(LAS f32x4*)(blk + (4 * i_ + (F.lane >> 4)) * 68 + 4 * (F.lane & 15)) = M[i_]; \
        LDS_WAIT(); asm volatile("" ::: "memory"); \
        _Pragma("unroll") for (int s_ = 0; s_ < 4; ++s_) { const LAS float* ap_ = blk + r * 68 + 16 * s_ + 8 * h; const LAS float* gq_ = gl + kh * 512 + (kk_) + 16 * s_ + 8 * h; \
            const f32x4 a0 = *(const LAS f32x4*)ap_, a1 = *(const LAS f32x4*)(ap_ + 4), g0 = *(const LAS f32x4*)gq_, g1 = *(const LAS f32x4*)(gq_ + 4); \
            ss += (a0.x * a0.x + a0.y * a0.y) + (a0.z * a0.z + a0.w * a0.w) + (a1.x * a1.x + a1.y * a1.y) + (a1.z * a1.z + a1.w * a1.w); \
            v4u bw_; bw_.x = pk2(a0.x * g0.x, a0.y * g0.y); bw_.y = pk2(a0.z * g0.z, a0.w * g0.w); bw_.z = pk2(a1.x * g1.x, a1.y * g1.y); bw_.w = pk2(a1.z * g1.z, a1.w * g1.w); \
            v4u aw_; aw_.x = pk2(W[8 * s_], W[8 * s_ + 1]); aw_.y = pk2(W[8 * s_ + 2], W[8 * s_ + 3]); aw_.z = pk2(W[8 * s_ + 4], W[8 * s_ + 5]); aw_.w = pk2(W[8 * s_ + 6], W[8 * s_ + 7]); \
            acc = __builtin_amdgcn_mfma_f32_32x32x16_bf16(__builtin_bit_cast(bf16x8, aw_), __builtin_bit_cast(bf16x8, bw_), acc, 0, 0, 0); } \
        LDS_WAIT(); asm volatile("" ::: "memory"); } while (0)
    f32x4 xv[8];
#define X_LD(m_) do { const GAS f32x4* xr_ = (const GAS f32x4*)(xsrc + (size_t)(m_) * D) + F.lane; _Pragma("unroll") for (int j_ = 0; j_ < 8; ++j_) xv[j_] = __builtin_nontemporal_load(xr_ + 64 * j_); } while (0)
#define X_PROC(m_) do { float s0_ = 0.f, s1_ = 0.f; \
        _Pragma("unroll") for (int j_ = 0; j_ < 4; ++j_) { s0_ += (xv[j_].x * xv[j_].x + xv[j_].y * xv[j_].y) + (xv[j_].z * xv[j_].z + xv[j_].w * xv[j_].w); \
            s1_ += (xv[4 + j_].x * xv[4 + j_].x + xv[4 + j_].y * xv[4 + j_].y) + (xv[4 + j_].z * xv[4 + j_].z + xv[4 + j_].w * xv[4 + j_].w); } \
        GAS unsigned long long* o8_ = (GAS unsigned long long*)(xdst + (size_t)(m_) * D) + F.lane; \
        _Pragma("unroll") for (int j_ = 0; j_ < 8; ++j_) o8_[64 * j_] = (unsigned long long)pk2(xv[j_].x, xv[j_].y) | ((unsigned long long)pk2(xv[j_].z, xv[j_].w) << 32); \
        s0_ = wave_sum(s0_); s1_ = wave_sum(s1_); \
        if (F.lane < 2) rstd_out[(m_) + F.lane] = 1.f / sqrtf((F.lane == 0 ? s0_ : s1_) * (1.f / D) + EPS); } while (0)
    MKV_LD(ma, wa, 0);
    int xm = 0;
#pragma nounroll
    for (int kk = 0; kk < 512; kk += 128) {
        X_LD(xm); __builtin_amdgcn_sched_barrier(0);
        MKV_LD(mb, wb, kk + 64); MKV_MM(ma, wa, kk); __builtin_amdgcn_sched_barrier(0);
        X_PROC(xm); X_LD(xm + 2); __builtin_amdgcn_sched_barrier(0);
        MKV_LD(ma, wa, min(kk + 128, 448)); MKV_MM(mb, wb, kk + 64); __builtin_amdgcn_sched_barrier(0);
        X_PROC(xm + 2); xm += xstep;
    }
#undef X_LD
#undef X_PROC
#undef MKV_LD
#undef MKV_MM
    LAS float* xc = (LAS float*)(F.lds + RING_OFF + 8 * 16384 - 4 * 64 * 17 * 4) + (tw * 64 + F.lane) * 17;
    if (kh == 1) {
#pragma unroll
        for (int i = 0; i < 16; ++i) xc[i] = acc[i];
        xc[16] = ss; }
    __syncthreads();
    if (kh == 0) {
#pragma unroll
        for (int i = 0; i < 16; ++i) acc[i] += xc[i];
        ss += xc[16]; ss += __shfl_xor(ss, 32);
        const float rstd = 1.f / sqrtf(ss * (1.f / D) + EPS);
        bf16* orow = mkv + (size_t)(m0 + r) * 512 + n0 + 4 * h;
#pragma unroll
        for (int q = 0; q < 4; ++q) { v2u o; o.x = pk2(acc[4 * q] * rstd, acc[4 * q + 1] * rstd); o.y = pk2(acc[4 * q + 2] * rstd, acc[4 * q + 3] * rstd); *(GAS v2u*)(orow + 8 * q) = o; }
    }
    __syncthreads();
}
__device__ __forceinline__ void p0_prologue(Frame& F) {
    LAS float* scr = (LAS float*)(F.lds + RING_OFF + F.wave * 16384);
    const int gw = F.vcu * NWAVES + F.wave, NGW = F.G * NWAVES;
    bf16* win_t = (bf16*)(F.ws + WS_WIN); bf16* wout_t = (bf16*)(F.ws + WS_WOUT);
    bf16* xb = (bf16*)(F.ws + WS_XB); float* rstd1 = (float*)(F.ws + WS_RSTD1);
    p0_mkv_tile(F, (F.wave & 3) * 256 + F.vcu, (bf16*)(F.ws + WS_MKV), F.x + (size_t)(4 * gw) * D, xb + (size_t)(4 * gw) * D, rstd1 + 4 * gw, 4 * NGW);
    bf16* wrt = (bf16*)(F.ws + WS_WRT);
    if (gw < 1280) p0_transpose_all<false, true>(F.w_in, D, DIN, 1, win_t, F.g_attn, 1.f, scr, gw, NGW, F.lane, RowId());
    else if (gw < 1792) p0_transpose_all<false, false>(F.w_out, D, D, 1, wout_t, nullptr, 1.f, scr, gw - 1280, NGW, F.lane, RowId());
    else for (int i = (gw - 1792) * 64 + F.lane; i < D * NE; i += 256 * 64) { const int e = i >> 10, k = i & 1023; const float w = F.w_r[k * NE + e] * F.g_ffn[k]; const unsigned hb = f2bf(w); wrt[i] = (bf16)hb; wrt[D * NE + i] = (bf16)f2bf(w - bf2f((bf16)hb)); }
}

constexpr int NCONV = 8, NCONV_ALL = 8 * NCONV;
__device__ __forceinline__ void p0b_unit(Frame& F, int c) {
    LAS float* scr = (LAS float*)(F.lds + RING_OFF + F.wave * 16384);
    p0_transpose_all<true, true>(F.w_gu, D, 2 * DFF, NE, (void*)(F.ws + WS_WGU), F.g_ffn, WSCALE, scr, c * NWAVES + F.wave, NCONV_ALL * NWAVES, F.lane, RowGU());
    p0_transpose_all<true, false>(F.w_dn, DFF, D, NE, (void*)(F.ws + WS_WDN), nullptr, WSCALE, scr, c * NWAVES + F.wave, NCONV_ALL * NWAVES, F.lane, RowId());
    __syncthreads();
}

struct EpiInProj {
    bf16* O; const float* rstd; unsigned* nrm;
    __device__ __forceinline__ void operator()(const pg8::f32x4 (&acc)[2][2][4][2], const pg8::Unit& u, int wr, int wc, int fr, int fq, const LAS unsigned* ids) const {
        asm volatile("" : "+v"(fr), "+v"(fq));
        const int row0 = u.pm * 256 + wr * 64 + fr, col0 = u.pn * 256 + wc * 32 + 8 * fq;
        const float sc = (u.pn <= 1 || u.pn == 6 || u.pn == 9) ? QSCALE : 1.f;
        const LAS float* scl = (const LAS float*)(ids + 256);
        float rsv[2][4];
#pragma unroll
        for (int ai = 0; ai < 2; ++ai)
#pragma unroll
            for (int m = 0; m < 4; ++m) rsv[ai][m] = scl[wr * 64 + fr + ai * 128 + m * 16];
#pragma unroll
        for (int ai = 0; ai < 2; ++ai)
#pragma unroll
            for (int m = 0; m < 4; ++m) { const int row = row0 + ai * 128 + m * 16; const float rs = rsv[ai][m] * sc; bf16* rowp = O + (size_t)row * DIN + col0;
#pragma unroll
                for (int bj = 0; bj < 2; ++bj) { const pg8::f32x4 v0 = acc[ai][bj][m][0] * rs, v1 = acc[ai][bj][m][1] * rs;
                    v4u w; w.x = pg8::cvt_pk_bf16(v0[0], v0[1]); w.y = pg8::cvt_pk_bf16(v0[2], v0[3]); w.z = pg8::cvt_pk_bf16(v1[0], v1[1]); w.w = pg8::cvt_pk_bf16(v1[2], v1[3]);
                    *(v4u*)(rowp + bj * 128) = w; } }
        if (u.pn < 4) {
#pragma unroll
            for (int bj = 0; bj < 2; ++bj) { float mx = 0.f;
#pragma unroll
                for (int ai = 0; ai < 2; ++ai)
#pragma unroll
                    for (int m = 0; m < 4; ++m) { const float rs = rsv[ai][m] * sc; const pg8::f32x4 v0 = acc[ai][bj][m][0] * rs, v1 = acc[ai][bj][m][1] * rs;
                        float s = (v0[0] * v0[0] + v0[1] * v0[1]) + (v0[2] * v0[2] + v0[3] * v0[3]) + (v1[0] * v1[0] + v1[1] * v1[1]) + (v1[2] * v1[2] + v1[3] * v1[3]);
                        s += __shfl_xor(s, 16); s += __shfl_xor(s, 32); mx = fmaxf(mx, s); }
#pragma unroll
                for (int o = 1; o < 16; o <<= 1) mx = fmaxf(mx, __shfl_xor(mx, o));
                if ((fr | fq) == 0) atomicMax(nrm + (((u.pm >> 4) * 4 + u.pn) * 4 + 2 * bj + (wc >> 1)) * 2 + (wc & 1), __builtin_bit_cast(unsigned, mx)); }
        }
    }
};
__device__ __forceinline__ void attn_phase(Frame& F, char* shm, int qoff = 0, int gmask = 7) {
    using namespace attn_body;
    const attn_body::bf16* P = (const attn_body::bf16*)(F.ws + WS_P);
    attn_body::bf16* OD = (attn_body::bf16*)(F.ws + WS_OD);
    attn_body::bf16* mix = (attn_body::bf16*)(F.ws + WS_MIX);
    attn_body::bf16* ODIL = (attn_body::bf16*)(F.ws + WS_ODIL); float* LSEb = (float*)(F.ws + WS_LSE);
    const attn_body::bf16* MKV = (const attn_body::bf16*)(F.ws + WS_MKV);
    const float* nrm = (const float*)(F.ctl + CW_NRM);
    const int grp = (int)blockIdx.x & 7, b = grp;
    unsigned* qctr = (unsigned*)(F.ctl + CW_Q + qoff) + 64 * grp;
    const attn_body::bf16* Pb = P + (size_t)b * SEQ * DIN;
#define ATTN_LEAD() ({ int t_ = (int)threadIdx.x; asm volatile("" : "+v"(t_)); t_ == 0; })
    unsigned nxt_tok = 0u;
    if (ATTN_LEAD()) nxt_tok = __hip_atomic_fetch_add(qctr, 1u, __ATOMIC_RELAXED, __HIP_MEMORY_SCOPE_AGENT);
    for (;;) {
        if (ATTN_LEAD()) F.MISC[20] = nxt_tok;
        __syncthreads();
        int un = (int)F.MISC[20];
        __syncthreads();
        if (ATTN_LEAD() && un < NCONV + 384) nxt_tok = __hip_atomic_fetch_add(qctr, 1u, __ATOMIC_RELAXED, __HIP_MEMORY_SCOPE_AGENT);
        if (un < NCONV) { if (gmask == 7) p0b_unit(F, grp * NCONV + un); continue; }
        un -= NCONV;
        if (un >= 384) break;
        if (un < 128) {
            if (!(gmask & 1)) continue;
            const int qb = 15 - (un >> 3), h = 3 - ((un >> 1) & 3), j = un & 1;
            const float slope2 = exp2f(-(float)(2 * h + 1)) * LOG2E;
            const int ni = ((b * 4 + (h >> 1)) * 4 + 2 * (h & 1) + j) * 2;
            const float R = sqrtf((nrm[ni] + nrm[ni + 1]) * (nrm[ni + 16] + nrm[ni + 17])) * 1.01f;
            const float kfirst = (float)(qb * 256) - (2.f * R + 160.f) / slope2;
            int t0 = kfirst > 0.f ? (int)(kfirst * (1.f / 64.f)) : 0; t0 = min(t0, 4 * qb); t0 &= ~1;
            UnitP U; U.Q = Pb + C_DQ + h * 128 + j * 64; U.K = Pb + C_DK + h * 128 + j * 64; U.V = Pb + C_DV + h * 128;
            U.O = OD + (size_t)b * SEQ * 1024 + h * 256 + j * 128; U.qp = DIN; U.kp = DIN; U.op = 1024;
            U.q0 = qb * 256; U.t0 = t0; U.NT = 4 * qb + 4 - t0; U.slope2 = slope2; U.lse = nullptr; U.lse_stride = 0;
            attn_unit<32, true, false, true, false, 128>(U, shm);
        } else if (un < 320) {
            if (!(gmask & 2)) continue;
            const int du = un - 128, h = du / 48, idx = du % 48, n = idx >> 4, w = idx & 15;
            const int r = (n == 0) ? 1 : (n == 1 ? 4 : 16), c = (n == 0) ? 0 : (n == 1 ? (w >> 2) : w), blk = (n == 0) ? w : (n == 1 ? (w & 3) : 0);
            const attn_body::bf16* Pc = Pb + (size_t)c * DIN;
            UnitP U; U.Q = Pc + C_LQ + h * 64; U.K = Pc + C_LK + h * 64; U.V = Pc + C_LV + h * 64; U.qp = (long)r * DIN; U.kp = (long)r * DIN;
            U.O = ODIL + (size_t)n * T * 256 + ((size_t)b * SEQ + c) * 256 + h * 64; U.op = (long)r * 256;
            U.q0 = blk * 256; U.t0 = (blk == 0) ? 0 : 4 * blk - 2; U.NT = 4 * blk + 4 - U.t0;
            U.slope2 = exp2f(-(float)(2 * h + 2)) * (float)r * LOG2E;
            U.lse = LSEb + (size_t)n * T * 4 + ((size_t)b * SEQ + c) * 4 + h; U.lse_stride = r * 4;
            attn_unit<32, true, true, true, true>(U, shm);
        } else {
            if (!(gmask & 4)) continue;
            const int mu = un - 320, h = mu >> 4, qb = mu & 15;
            UnitP U; U.Q = Pb + C_MQ + h * 64; U.qp = DIN; U.K = MKV + (size_t)b * NMEM * 512 + h * 64; U.V = U.K + 256; U.kp = 512;
            U.O = mix + (size_t)b * SEQ * 1024 + 768 + h * 64; U.op = 1024; U.q0 = qb * 256; U.t0 = 0; U.NT = 4; U.slope2 = 0.f; U.lse = nullptr; U.lse_stride = 0;
            attn_unit<8, false, false, false, false>(U, shm);
        }
    }
}
#undef ATTN_LEAD
__device__ __forceinline__ void dil_combine_phase(Frame& F) {
    const int gw = F.vcu * NWAVES + F.wave, NGW = F.G * NWAVES;
    const bf16* OD = (const bf16*)(F.ws + WS_OD); const bf16* ODIL = (const bf16*)(F.ws + WS_ODIL); const float* LSEb = (const float*)(F.ws + WS_LSE); bf16* mix = (bf16*)(F.ws + WS_MIX);
    const int h = F.lane >> 4, pt = F.lane & 15, d4 = pt * 4;
    float lam;
    { const float a = F.lamqk[F.lane] * F.lamqk[64 + F.lane], c = F.lamqk[128 + F.lane] * F.lamqk[192 + F.lane];
      lam = __expf(wave_sum(a)) - __expf(wave_sum(c)) + 0.2f; }
    float gsub[8];
#pragma unroll
    for (int i = 0; i < 8; ++i) gsub[i] = F.subg[pt * 8 + i] * 0.8f;
    for (int row0 = 4 * gw; row0 < T; row0 += 4 * NGW) {
        float l[4][3]; v2u q[4][3]; v4u o1[4], o2[4];
#pragma unroll
        for (int i = 0; i < 4; ++i) {
            o1[i] = __builtin_nontemporal_load((const v4u*)(OD + (size_t)(row0 + i) * 1024 + h * 256 + pt * 8)); o2[i] = __builtin_nontemporal_load((const v4u*)(OD + (size_t)(row0 + i) * 1024 + h * 256 + 128 + pt * 8));
#pragma unroll
            for (int n = 0; n < 3; ++n) { l[i][n] = LSEb[(size_t)n * T * 4 + (size_t)(row0 + i) * 4 + h]; q[i][n] = __builtin_nontemporal_load((const v2u*)(ODIL + (size_t)n * T * 256 + (size_t)(row0 + i) * 256 + h * 64 + d4)); } }
#pragma unroll
        for (int i = 0; i < 4; ++i) {
            const unsigned aw[4] = {o1[i].x, o1[i].y, o1[i].z, o1[i].w}, bw[4] = {o2[i].x, o2[i].y, o2[i].z, o2[i].w};
            float d[8], ss = 0.f;
#pragma unroll
            for (int c = 0; c < 4; ++c) { d[2 * c] = bflo(aw[c]) - lam * bflo(bw[c]); d[2 * c + 1] = bfhi(aw[c]) - lam * bfhi(bw[c]); ss += d[2 * c] * d[2 * c] + d[2 * c + 1] * d[2 * c + 1]; }
#pragma unroll
            for (int o = 1; o < 16; o <<= 1) ss += __shfl_xor(ss, o);
            const float rstd = 1.f / sqrtf(ss * (1.f / 128.f) + EPS);
            v4u od; od.x = pk2(d[0] * rstd * gsub[0], d[1] * rstd * gsub[1]); od.y = pk2(d[2] * rstd * gsub[2], d[3] * rstd * gsub[3]); od.z = pk2(d[4] * rstd * gsub[4], d[5] * rstd * gsub[5]); od.w = pk2(d[6] * rstd * gsub[6], d[7] * rstd * gsub[7]);
            *(v4u*)(mix + (size_t)(row0 + i) * 1024 + h * 128 + pt * 8) = od;
            const float m = fmaxf(fmaxf(l[i][0], l[i][1]), l[i][2]);
            float wn[3], den = 0.f;
#pragma unroll
            for (int n = 0; n < 3; ++n) { wn[n] = exp2f(l[i][n] - m); den += wn[n]; }
            const float inv = 1.f / den; float o[4] = {0.f, 0.f, 0.f, 0.f};
#pragma unroll
            for (int n = 0; n < 3; ++n) { const float wq = wn[n] * inv; o[0] += wq * bflo(q[i][n].x); o[1] += wq * bfhi(q[i][n].x); o[2] += wq * bflo(q[i][n].y); o[3] += wq * bfhi(q[i][n].y); }
            v2u ov; ov.x = pk2(o[0], o[1]); ov.y = pk2(o[2], o[3]);
            *(v2u*)(mix + (size_t)(row0 + i) * 1024 + 512 + h * 64 + d4) = ov;
        }
    }
}
struct EpiY {
    bf16* Y;
    __device__ __forceinline__ void operator()(const pg8::f32x4 (&acc)[2][2][4][2], const pg8::Unit& u, int wr, int wc, int fr, int fq, const LAS unsigned*) const {
        asm volatile("" : "+v"(fr), "+v"(fq));
        const int row0 = u.pm * 256 + wr * 64 + fr, col0 = u.pn * 256 + wc * 32 + 8 * fq;
#pragma unroll
        for (int ai = 0; ai < 2; ++ai)
#pragma unroll
            for (int m = 0; m < 4; ++m) { bf16* rowp = Y + (size_t)(row0 + ai * 128 + m * 16) * D + col0;
#pragma unroll
                for (int bj = 0; bj < 2; ++bj) { const pg8::f32x4 v0 = acc[ai][bj][m][0], v1 = acc[ai][bj][m][1];
                    v4u w; w.x = pg8::cvt_pk_bf16(v0[0], v0[1]); w.y = pg8::cvt_pk_bf16(v0[2], v0[3]); w.z = pg8::cvt_pk_bf16(v1[0], v1[1]); w.w = pg8::cvt_pk_bf16(v1[2], v1[3]);
                    *(v4u*)(rowp + bj * 128) = w; } }
    }
};

__device__ __forceinline__ void route_phase(Frame& F) {
    LAS char* XH = (LAS char*)(F.lds + RING_OFF); LAS char* XL = XH + 32768; LAS char* WH = XH + 65536; LAS char* WL = XH + 73728;
    LAS float* xch = (LAS float*)(XH + 81920);
    LAS float* ssl = (LAS float*)(XH + 81920 + 17408);
    LAS unsigned* lcnt = (LAS unsigned*)(F.lds + LCNT_OFF);
    LAS unsigned* stg = (LAS unsigned*)(F.lds + STG_OFF);
    if (F.tid < 64) lcnt[F.tid] = 0u;
    const int lane = F.lane, tl = lane & 31, h = lane >> 5, tg = F.wave & 3, kh = F.wave >> 2;
    const int srow = F.tid >> 5, k4 = (F.tid & 31) * 4, T0 = F.vcu * 128;
    const bf16* xg = (const bf16*)(F.ws + WS_XB) + (size_t)(T0 + srow) * D + k4;
    const bf16* yg = (const bf16*)(F.ws + WS_Y) + (size_t)(T0 + srow) * D + k4;
    unsigned char* x1q = (unsigned char*)(F.ws + WS_X1B) + (size_t)(T0 + srow) * D + k4;
    bf16* x1h = (bf16*)(F.ws + WS_X1H) + (size_t)(T0 + srow) * D + k4;
    const bf16* wsrc = (const bf16*)(F.ws + WS_WRT);
    v2u xv[8]; v2u yv[8]; v4u wv[2]; float ssr[8];
#pragma unroll
    for (int i = 0; i < 8; ++i) ssr[i] = 0.f;
#define RT_LOAD(kc) do { _Pragma("unroll") for (int i_ = 0; i_ < 8; ++i_) { xv[i_] = __builtin_nontemporal_load((const v2u*)(xg + (size_t)(16 * i_) * D + 128 * (kc))); yv[i_] = __builtin_nontemporal_load((const v2u*)(yg + (size_t)(16 * i_) * D + 128 * (kc))); } \
        _Pragma("unroll") for (int j_ = 0; j_ < 2; ++j_) { const int idx_ = F.tid + 512 * j_; wv[j_] = *(const v4u*)(wsrc + (idx_ >> 9) * 32768 + ((idx_ >> 4) & 31) * 1024 + 128 * (kc) + (idx_ & 15) * 8); } } while (0)
    f32x16 acc = {};
    RT_LOAD(0);
    for (int kc = 0; kc < 8; ++kc) {
#pragma unroll
        for (int i = 0; i < 8; ++i) {
            const float x0 = bflo(xv[i].x) + bflo(yv[i].x), x1 = bfhi(xv[i].x) + bfhi(yv[i].x), x2 = bflo(xv[i].y) + bflo(yv[i].y), x3 = bfhi(xv[i].y) + bfhi(yv[i].y);
            ssr[i] += (x0 * x0 + x1 * x1) + (x2 * x2 + x3 * x3);
            const unsigned h0 = pk2(x0, x1), h1 = pk2(x2, x3), l0 = pk2(x0 - bflo(h0), x1 - bfhi(h0)), l1 = pk2(x2 - bflo(h1), x3 - bfhi(h1));
            *(unsigned*)(x1q + (size_t)(16 * i) * D + 128 * kc) = fp8x4(x0, x1, x2, x3);
            *(v2u*)(x1h + (size_t)(16 * i) * D + 128 * kc) = (v2u){h0, h1};
            const int row = srow + 16 * i, off = row * 256 + (((k4 >> 3) ^ (row & 15)) << 4) + (k4 & 4) * 2;
            *(LAS v2u*)(XH + off) = (v2u){h0, h1}; *(LAS v2u*)(XL + off) = (v2u){l0, l1};
        }
#pragma unroll
        for (int j = 0; j < 2; ++j) { const int idx = F.tid + 512 * j, e = (idx >> 4) & 31, c = idx & 15; *(LAS v4u*)(((idx >> 9) ? WL : WH) + e * 256 + ((c ^ (e & 15)) << 4)) = wv[j]; }
        __syncthreads();
        if (kc < 7) RT_LOAD(kc + 1);
#pragma unroll
        for (int s = 0; s < 4; ++s) { const int c16 = 2 * (4 * kh + s) + h, tr = tg * 32 + tl;
            const v4u xh = *(const LAS v4u*)(XH + tr * 256 + ((c16 ^ (tr & 15)) << 4)), xl = *(const LAS v4u*)(XL + tr * 256 + ((c16 ^ (tr & 15)) << 4));
            const v4u wh = *(const LAS v4u*)(WH + tl * 256 + ((c16 ^ (tl & 15)) << 4)), wl2 = *(const LAS v4u*)(WL + tl * 256 + ((c16 ^ (tl & 15)) << 4));
            acc = __builtin_amdgcn_mfma_f32_32x32x16_bf16(__builtin_bit_cast(bf16x8, wh), __builtin_bit_cast(bf16x8, xh), acc, 0, 0, 0);
            acc = __builtin_amdgcn_mfma_f32_32x32x16_bf16(__builtin_bit_cast(bf16x8, wh), __builtin_bit_cast(bf16x8, xl), acc, 0, 0, 0);
            acc = __builtin_amdgcn_mfma_f32_32x32x16_bf16(__builtin_bit_cast(bf16x8, wl2), __builtin_bit_cast(bf16x8, xh), acc, 0, 0, 0); }
        __syncthreads();
    }
#undef RT_LOAD
#pragma unroll
    for (int i = 0; i < 8; ++i) { float s = ssr[i];
#pragma unroll
        for (int o = 1; o < 32; o <<= 1) s += __shfl_xor(s, o);
        if ((F.tid & 31) == 0) ssl[srow + 16 * i] = s; }
    const int tok = T0 + tg * 32 + tl; float ss = 0.f;
    if (kh == 1) { LAS float* d = xch + (tg * 64 + lane) * 17;
#pragma unroll
        for (int i = 0; i < 16; ++i) d[i] = acc[i];
        d[16] = ss; }
    __syncthreads();
    if (kh == 0) {
        const LAS float* d = xch + (tg * 64 + lane) * 17;
#pragma unroll
        for (int i = 0; i < 16; ++i) acc[i] += d[i];
        ss = ssl[tg * 32 + tl];
        const float rstd = 1.f / sqrtf(ss * (1.f / D) + EPS);
        float lg[16];
#pragma unroll
        for (int i = 0; i < 16; ++i) lg[i] = acc[i] * rstd + F.b_r[4 * h + (i & 3) + 8 * (i >> 2)];
        float cv[8]; int ce[8];
#pragma unroll
        for (int k = 0; k < 4; ++k) { float bv = -INFINITY; int bi = 0;
#pragma unroll
            for (int i = 0; i < 16; ++i) { if (lg[i] > bv) { bv = lg[i]; bi = i; } }
            cv[k] = bv; ce[k] = 4 * h + (bi & 3) + 8 * (bi >> 2);
#pragma unroll
            for (int i = 0; i < 16; ++i) if (i == bi) lg[i] = -INFINITY; }
#pragma unroll
        for (int k = 0; k < 4; ++k) { cv[4 + k] = __shfl_xor(cv[k], 32); ce[4 + k] = __shfl_xor(ce[k], 32); }
        float tv[4]; int te[4];
#pragma unroll
        for (int k = 0; k < 4; ++k) { float bv = -INFINITY; int be = 64, bi = 0;
#pragma unroll
            for (int i = 0; i < 8; ++i) { if (cv[i] > bv || (cv[i] == bv && ce[i] < be)) { bv = cv[i]; be = ce[i]; bi = i; } }
            tv[k] = bv; te[k] = be;
#pragma unroll
            for (int i = 0; i < 8; ++i) if (i == bi) cv[i] = -INFINITY; }
        float gk[4], den = 0.f;
#pragma unroll
        for (int k = 0; k < 4; ++k) { gk[k] = __expf(tv[k] - tv[0]); den += gk[k]; }
        const float inv = 1.f / den;
        if (h == 0) {
#pragma unroll
            for (int k = 0; k < 4; ++k) {
                const unsigned rank = __hip_atomic_fetch_add(lcnt + te[k], 1u, __ATOMIC_RELAXED, __HIP_MEMORY_SCOPE_WORKGROUP);
                const int slot = (tg * 32 + tl) * 4 + k;
                stg[slot * 4] = (unsigned)(tok * 4 + k); stg[slot * 4 + 1] = ((unsigned)te[k] << 16) | rank; stg[slot * 4 + 2] = __builtin_bit_cast(unsigned, gk[k] * inv); stg[slot * 4 + 3] = __builtin_bit_cast(unsigned, rstd);
            }
        }
    }
    __syncthreads();
    if (F.tid < 32) { const unsigned n = lcnt[F.tid]; lcnt[32 + F.tid] = n ? __hip_atomic_fetch_add((unsigned*)(F.ctl + CW_CNT) + F.tid, n, __ATOMIC_RELAXED, __HIP_MEMORY_SCOPE_AGENT) : 0u; }
    __syncthreads();
    { unsigned* list = (unsigned*)(F.ws + WS_LIST); unsigned* lgate = (unsigned*)(F.ws + WS_LGATE); unsigned* lrstd = (unsigned*)(F.ws + WS_LRSTD);
      const unsigned ent = stg[F.tid * 4], er = stg[F.tid * 4 + 1], gb = stg[F.tid * 4 + 2], rb = stg[F.tid * 4 + 3]; const unsigned e = er >> 16, rank = er & 0xffffu;
      const size_t at = (size_t)e * LCAP + lcnt[32 + e] + rank; list[at] = ent; lgate[at] = gb; lrstd[at] = rb; }
    __syncthreads();
}

__device__ __forceinline__ int moe_build_table(Frame& F) {
    LAS unsigned* tbl = (LAS unsigned*)(F.lds + TBL_OFF); LAS unsigned* lcnt = (LAS unsigned*)(F.lds + LCNT_OFF);
    if (F.wave == 0) {
        const int e = F.lane & 31;
        const unsigned cnt = __hip_atomic_load((unsigned*)(F.ctl + CW_CNT) + e, __ATOMIC_RELAXED, __HIP_MEMORY_SCOPE_AGENT);
        const unsigned nt = (cnt + 255u) >> 8; unsigned incl = nt;
#pragma unroll
        for (int o = 1; o < 32; o <<= 1) { const unsigned t = __shfl_up(incl, o); if ((F.lane & 31) >= o) incl += t; }
        if (F.lane < 32) { lcnt[e] = cnt; const unsigned start = incl - nt; for (unsigned j = 0; j < nt; ++j) tbl[start + j] = ((unsigned)e << 16) | j; if (F.lane == 31) F.MISC[16] = incl; }
    }
    __syncthreads();
    return (int)F.MISC[16];
}
struct MoeOrder {
    const LAS unsigned* tbl; const LAS unsigned* lcnt; const unsigned* list; int NMT, G, c, NPN, MPER, RB; size_t bexp; bool a_tiles; const unsigned* lsc; const unsigned* bias; int bexp_f;
    __device__ __forceinline__ bool next(int i, pg8::Unit& u) const {
        const int L = i * G + c, blk = L >> 5, w = L & 31, g = (NPN == 8) ? blk * 4 + (w >> 3) : blk * 8 + (w >> 2), pn = (NPN == 8) ? (w & 7) : (w & 3);
        if (g >= NMT) return false;
        const unsigned t = tbl[g]; const int e = (int)(t >> 16), mt = (int)(t & 0xffffu); const int cnt = (int)lcnt[e];
        u.pm = g; u.pn = pn; u.e = e; u.mt = mt; u.valid = min(256, cnt - mt * 256);
        u.aoff = a_tiles ? (size_t)g * (size_t)(256 * RB) : (size_t)0; u.boff = (size_t)e * bexp + (size_t)pn * (size_t)(256 * RB);
        return true;
    }
    __device__ __forceinline__ const unsigned* id_src(const pg8::Unit& u, int row) const { return list + (size_t)u.e * LCAP + u.mt * 256 + min(row, u.valid - 1); }
    __device__ __forceinline__ const unsigned* sc_src(const pg8::Unit& u, int row) const { return lsc + (size_t)u.e * LCAP + u.mt * 256 + min(row, u.valid - 1); }
    __device__ __forceinline__ const unsigned* bias_src(const pg8::Unit& u, int col) const { return bias + (size_t)u.e * bexp_f + u.pn * 256 + col; }
};
struct EpiGU {
    unsigned char* ACT;
    __device__ __forceinline__ void operator()(const pg8::f32x4 (&acc)[2][2][4][2], const pg8::Unit& u, int wr, int wc, int fr, int fq, const LAS unsigned* ids) const {
        asm volatile("" : "+v"(fr), "+v"(fq));
        typedef float f2 __attribute__((ext_vector_type(2)));
        constexpr float CG = 1.702f * LOG2E, KA = ASCALE / CG;
        const int r0 = wr * 64 + fr, f0 = u.pn * 128 + wc * 32 + 8 * fq;
        const LAS float* scl = (const LAS float*)(ids + 256); const LAS float* bl = (const LAS float*)(ids + 512) + 2 * (wc * 32 + 8 * fq);
        float rs[2][4];
#pragma unroll
        for (int ai = 0; ai < 2; ++ai)
#pragma unroll
            for (int m = 0; m < 4; ++m) rs[ai][m] = scl[r0 + ai * 128 + m * 16] * (1.f / WSCALE);
        const pg8::f32x4 b0 = *(const LAS pg8::f32x4*)bl, b1 = *(const LAS pg8::f32x4*)(bl + 4), b2 = *(const LAS pg8::f32x4*)(bl + 8), b3 = *(const LAS pg8::f32x4*)(bl + 12);
        const f2 gb[4] = {f2{b0[0], b0[2]} * CG, f2{b1[0], b1[2]} * CG, f2{b2[0], b2[2]} * CG, f2{b3[0], b3[2]} * CG}, ub[4] = {f2{b0[1], b0[3]}, f2{b1[1], b1[3]}, f2{b2[1], b2[3]}, f2{b3[1], b3[3]}};
#pragma unroll
        for (int ai = 0; ai < 2; ++ai)
#pragma unroll
            for (int m = 0; m < 4; ++m) { const int r = r0 + ai * 128 + m * 16; const float s = rs[ai][m], sg = s * CG; f2 a[4];
#pragma unroll
                for (int q = 0; q < 4; ++q) { const int n = q >> 1, j = 2 * (q & 1);
                    f2 g = f2{acc[ai][0][m][n][j], acc[ai][0][m][n][j + 1]} * sg + gb[q], up = f2{acc[ai][1][m][n][j], acc[ai][1][m][n][j + 1]} * s + ub[q];
                    g.x = fminf(g.x, 7.f * CG); g.y = fminf(g.y, 7.f * CG); up.x = __builtin_amdgcn_fmed3f(up.x, -7.f, 7.f); up.y = __builtin_amdgcn_fmed3f(up.y, -7.f, 7.f);
                    f2 d = f2{__builtin_amdgcn_exp2f(-g.x), __builtin_amdgcn_exp2f(-g.y)} + 1.f;
                    const f2 rc = f2{__builtin_amdgcn_rcpf(d.x), __builtin_amdgcn_rcpf(d.y)};
                    a[q] = ((up * KA + KA) * g) * rc; }
                v2u w; w.x = (unsigned)__builtin_amdgcn_cvt_pk_fp8_f32(a[1].x, a[1].y, __builtin_amdgcn_cvt_pk_fp8_f32(a[0].x, a[0].y, 0, false), true);
                w.y = (unsigned)__builtin_amdgcn_cvt_pk_fp8_f32(a[3].x, a[3].y, __builtin_amdgcn_cvt_pk_fp8_f32(a[2].x, a[2].y, 0, false), true);
                *(v2u*)(ACT + (size_t)(u.pm * 256 + r) * DFF + f0) = w; }
    }
};
struct EpiDown {
    unsigned char* YB;
    __device__ __forceinline__ void operator()(const pg8::f32x4 (&acc)[2][2][4][2], const pg8::Unit& u, int wr, int wc, int fr, int fq, const LAS unsigned* ids) const {
        asm volatile("" : "+v"(fr), "+v"(fq));
        const int r0 = wr * 64 + fr, cl = wc * 32 + 8 * fq, col0 = u.pn * 256 + cl;
        const LAS float* scl = (const LAS float*)(ids + 256); const LAS float* bl = (const LAS float*)(ids + 512) + cl;
        pg8::f32x4 bv[2][2];
#pragma unroll
        for (int bj = 0; bj < 2; ++bj)
#pragma unroll
            for (int n = 0; n < 2; ++n) bv[bj][n] = *(const LAS pg8::f32x4*)(bl + bj * 128 + 4 * n);
#pragma unroll
        for (int ai = 0; ai < 2; ++ai)
#pragma unroll
            for (int m = 0; m < 4; ++m) { const int r = r0 + ai * 128 + m * 16; if (r < u.valid) { const float g = scl[r] * YSCALE; unsigned char* yp = YB + (size_t)ids[r] * D + col0;
#pragma unroll
                for (int bj = 0; bj < 2; ++bj) { const pg8::f32x4 v0 = (acc[ai][bj][m][0] * (1.f / (WSCALE * ASCALE)) + bv[bj][0]) * g, v1 = (acc[ai][bj][m][1] * (1.f / (WSCALE * ASCALE)) + bv[bj][1]) * g;
                    v2u w; w.x = fp8x4(v0[0], v0[1], v0[2], v0[3]); w.y = fp8x4(v1[0], v1[1], v1[2], v1[3]);
                    *(v2u*)(yp + bj * 128) = w; } } }
    }
};
__device__ __forceinline__ void final_phase(Frame& F) {
    const int gw = F.vcu * NWAVES + F.wave, NGW = F.G * NWAVES;
    const unsigned char* YB = (const unsigned char*)(F.ws + WS_YB); const bf16* X1 = (const bf16*)(F.ws + WS_X1H);
    const int c = 4 * F.lane;
    f32x4 gf[4];
#pragma unroll
    for (int q = 0; q < 4; ++q) gf[q] = *(const f32x4*)(F.g_fin + c + 256 * q);
    for (int t0 = 2 * gw; t0 < T; t0 += 2 * NGW) {
        v2u xa[2][4]; unsigned y[2][4][4];
#pragma unroll
        for (int u = 0; u < 2; ++u) {
#pragma unroll
            for (int q = 0; q < 4; ++q) xa[u][q] = __builtin_nontemporal_load((const v2u*)(X1 + (size_t)(t0 + u) * D + c + 256 * q));
#pragma unroll
            for (int k = 0; k < 4; ++k)
#pragma unroll
                for (int q = 0; q < 4; ++q) y[u][k][q] = __builtin_nontemporal_load((const unsigned*)(YB + ((size_t)(t0 + u) * 4 + k) * D + c + 256 * q)); }
#pragma unroll
        for (int u = 0; u < 2; ++u) {
            float v[16];
#pragma unroll
            for (int q = 0; q < 4; ++q) { v[4 * q] = bflo(xa[u][q].x); v[4 * q + 1] = bfhi(xa[u][q].x); v[4 * q + 2] = bflo(xa[u][q].y); v[4 * q + 3] = bfhi(xa[u][q].y); }
#pragma unroll
            for (int k = 0; k < 4; ++k)
#pragma unroll
                for (int q = 0; q < 4; ++q) { const auto lo = __builtin_amdgcn_cvt_pk_f32_fp8((int)y[u][k][q], false), hi = __builtin_amdgcn_cvt_pk_f32_fp8((int)y[u][k][q], true);
                    v[4 * q] += lo[0] * (1.f / YSCALE); v[4 * q + 1] += lo[1] * (1.f / YSCALE); v[4 * q + 2] += hi[0] * (1.f / YSCALE); v[4 * q + 3] += hi[1] * (1.f / YSCALE); }
            float ss = 0.f;
#pragma unroll
            for (int i = 0; i < 16; ++i) ss += v[i] * v[i];
            const float rstd = 1.f / sqrtf(wave_sum(ss) * (1.f / D) + EPS);
#pragma unroll
            for (int q = 0; q < 4; ++q) { f32x4 o; o.x = v[4 * q] * rstd * gf[q].x; o.y = v[4 * q + 1] * rstd * gf[q].y; o.z = v[4 * q + 2] * rstd * gf[q].z; o.w = v[4 * q + 3] * rstd * gf[q].w;
                __builtin_nontemporal_store(o, (f32x4*)(F.out + (size_t)(t0 + u) * D + c + 256 * q)); }
        }
    }
}
struct Args { const float* in[17]; float* out; unsigned char* ws; int ph_lo, ph_hi, use_bar, pad; };
__global__ void __launch_bounds__(NWAVES * 64, 2) mk_fwd(Args args) {
    extern __shared__ __attribute__((aligned(16))) unsigned char lds[];
    Frame F;
    F.lds = (LAS unsigned char*)lds;
    F.MISC = (volatile LAS unsigned*)(F.lds + MISC_OFF);
    F.tid = threadIdx.x; F.lane = F.tid & 63; F.wave = __builtin_amdgcn_readfirstlane(F.tid >> 6);
    const bool lead = F.tid == 0;
#define FRESH() do { F.lane = mk_lane(); F.tid = F.wave * 64 + F.lane; } while (0)
    F.G = gridDim.x; { const int bx = blockIdx.x; F.vcu = (F.G % 8 == 0) ? (bx % 8) * (F.G / 8) + bx / 8 : bx; }
    F.ws = args.ws; F.out = args.out; F.ctl = (gu32*)(args.ws + WS_CTL);
    F.x = args.in[0]; F.mem = args.in[1]; F.g_attn = args.in[2]; F.g_mem = args.in[3]; F.w_in = args.in[4]; F.lamqk = args.in[5]; F.subg = args.in[6]; F.w_mkv = args.in[7];
    F.w_out = args.in[8]; F.g_ffn = args.in[9]; F.w_r = args.in[10]; F.b_r = args.in[11]; F.w_gu = args.in[12]; F.b_gu = args.in[13]; F.w_dn = args.in[14]; F.b_dn = args.in[15]; F.g_fin = args.in[16];
    for (int u = F.tid; u < (LDS_BYTES - LDSCTL_OFF) / 4; u += NWAVES * 64) ((LAS unsigned*)(F.lds + LDSCTL_OFF))[u] = 0u;
    __syncthreads();
    XcdBarrier bar; bar.bar = (unsigned*)(F.ctl + CW_BAR); bar.x = 0; bar.st = nullptr;
    if (args.use_bar) bar = xcd_barrier_post((unsigned*)(F.ctl + CW_BAR), F.MISC + 8, lead);
    const int lo = args.ph_lo, hi = args.ph_hi;
#define IN(k) (lo <= (k) && (k) < hi)
#define SEAM(k) do { if (IN(k) && IN((k) + 1)) xcd_barrier(bar, lead); } while (0)
    if (IN(0)) { p0_prologue(F); } SEAM(0);
    if (IN(1)) {
        pg8::Gemm g{(const void*)(F.ws + WS_XB), (const void*)(F.ws + WS_WIN), 2 * D, 128}; pg8::StaticOrder S; S.init(T, DIN, 2 * D, F.G, (int)blockIdx.x, (const unsigned*)(F.ws + WS_RSTD1));
        EpiInProj E{(bf16*)(F.ws + WS_P), (const float*)(F.ws + WS_RSTD1), (unsigned*)(F.ctl + CW_NRM)};
        pg8::gemm_phase<EpiInProj, pg8::StaticOrder, true, false, true>(F.lds + RING_OFF, (LAS unsigned*)(F.lds + IDB_OFF), g, S, E, F.tid);
    } SEAM(1);
    if (IN(2)) { attn_phase(F, (char*)lds + RING_OFF); } SEAM(2);
    if (IN(3)) { FRESH(); dil_combine_phase(F); } SEAM(3);
    if (IN(4)) { FRESH();
        pg8::Gemm g{(const void*)(F.ws + WS_MIX), (const void*)(F.ws + WS_WOUT), 2 * D, 128}; pg8::StaticOrder S; S.init(T, D, 2 * D, F.G, (int)blockIdx.x);
        EpiY E{(bf16*)(F.ws + WS_Y)};
        pg8::gemm_phase<EpiY, pg8::StaticOrder, true, false, false>(F.lds + RING_OFF, (LAS unsigned*)(F.lds + IDB_OFF), g, S, E, F.tid);
    } SEAM(4);
    if (IN(5)) { FRESH(); route_phase(F); } SEAM(5);
    if (IN(6)) { FRESH();
        const int nmt = moe_build_table(F);
        pg8::Gemm g{(const void*)(F.ws + WS_X1B), (const void*)(F.ws + WS_WGU), D, 128};
        MoeOrder S{(const LAS unsigned*)(F.lds + TBL_OFF), (const LAS unsigned*)(F.lds + LCNT_OFF), (const unsigned*)(F.ws + WS_LIST), nmt, F.G, F.vcu, 8, 4, D, (size_t)2 * DFF * D, false, (const unsigned*)(F.ws + WS_LRSTD), (const unsigned*)F.b_gu, 2 * DFF};
        EpiGU E{(unsigned char*)(F.ws + WS_ACT)};
        pg8::gemm_phase<EpiGU, MoeOrder, true, true, true, true>(F.lds + RING_OFF, (LAS unsigned*)(F.lds + IDB_OFF), g, S, E, F.tid);
    } SEAM(6);
    if (IN(7)) { FRESH();
        const int nmt = moe_build_table(F);
        pg8::Gemm g{(const void*)(F.ws + WS_ACT), (const void*)(F.ws + WS_WDN), DFF, 128};
        MoeOrder S{(const LAS unsigned*)(F.lds + TBL_OFF), (const LAS unsigned*)(F.lds + LCNT_OFF), (const unsigned*)(F.ws + WS_LIST), nmt, F.G, F.vcu, 4, 8, DFF, (size_t)D * DFF, true, (const unsigned*)(F.ws + WS_LGATE), (const unsigned*)F.b_dn, D};
        EpiDown E{(unsigned char*)(F.ws + WS_YB)};
        pg8::gemm_phase<EpiDown, MoeOrder, true, true, true, true, true>(F.lds + RING_OFF, (LAS unsigned*)(F.lds + IDB_OFF), g, S, E, F.tid);
    } SEAM(7);
    if (IN(8)) { FRESH(); final_phase(F); }
#undef IN
#undef FRESH
#undef SEAM
}

static void launch_phases(const Args& base, int lo, int hi, int use_bar, int grid, hipStream_t stream) {
    Args a = base; a.ph_lo = lo; a.ph_hi = hi; a.use_bar = use_bar;
    hipLaunchKernelGGL(mk_fwd, dim3(grid), dim3(NWAVES * 64), LDS_BYTES, stream, a);
}
extern "C" void kernel_launch(void* const* d_in, const int* in_sizes, int n_in, void* d_out, int out_size, void* d_ws, size_t ws_size, hipStream_t stream) {
    static int grid = 0;
    if (grid == 0) {
        if (n_in != 17 || in_sizes[0] != T * D || out_size != T * D || ws_size < (size_t)1000 * MiB) { fprintf(stderr, "kernel_launch: unexpected shapes / workspace (%d inputs, ws %zu)\n", n_in, ws_size); grid = -1; return; }
        int dev = 0, cus = 0, per_cu = 0;
        if (hipGetDevice(&dev) != hipSuccess || hipDeviceGetAttribute(&cus, hipDeviceAttributeMultiprocessorCount, dev) != hipSuccess) { grid = -1; return; }
        if (hipFuncSetAttribute((const void*)mk_fwd, hipFuncAttributeMaxDynamicSharedMemorySize, LDS_BYTES) != hipSuccess) { fprintf(stderr, "kernel_launch: hipFuncSetAttribute failed\n"); grid = -1; return; }
        if (hipOccupancyMaxActiveBlocksPerMultiprocessor(&per_cu, (const void*)mk_fwd, NWAVES * 64, LDS_BYTES) != hipSuccess || per_cu < 1) { fprintf(stderr, "kernel_launch: occupancy query says %d blocks per CU\n", per_cu); per_cu = 1; }
        (void)hipGetLastError();
        grid = cus;
        if (grid != 256) { fprintf(stderr, "kernel_launch: built for a 256-CU device (got %d)\n", cus); grid = -1; return; }
    }
    if (grid < 0) return;
    (void)hipMemsetAsync((char*)d_ws + WS_CTL, 0, CTL_ZERO_BYTES, stream);
    Args a{};
    for (int i = 0; i < 17; ++i) a.in[i] = (const float*)d_in[i];
    a.out = (float*)d_out; a.ws = (unsigned char*)d_ws;
    launch_phases(a, 0, 9, 1, grid, stream);
}
```

```cpp
#include <hip/hip_runtime.h>
#include <hip/hip_bf16.h>
#include <cstdint>
#include <cstdio>
#include <cmath>

constexpr int D = 1024, BATCH = 8, SEQ = 4096, T = BATCH * SEQ, DIN = 2560, NMEM = 256, NE = 32, DFF = 1024;
constexpr int C_DQ = 0, C_DK = 512, C_DV = 1024, C_LQ = 1536, C_LK = 1792, C_LV = 2048, C_MQ = 2304;
constexpr float EPS = 1e-5f;
constexpr int LCAP = T;
constexpr float QSCALE = 0.125f * 1.4426950408889634f;
constexpr float LOG2E = 1.4426950408889634f;
__device__ __forceinline__ int mk_lane() { int l = (int)__builtin_amdgcn_mbcnt_hi(~0u, __builtin_amdgcn_mbcnt_lo(~0u, 0u)); asm volatile("" : "+v"(l)); return l; }

namespace pg8 {
#define PG8_LAS __attribute__((address_space(3)))
typedef unsigned short bf16_t;
typedef short bf16x8 __attribute__((ext_vector_type(8)));
typedef float f32x4 __attribute__((ext_vector_type(4)));
typedef unsigned u32x4 __attribute__((ext_vector_type(4)));
typedef unsigned u32x2 __attribute__((ext_vector_type(2)));
constexpr int BM = 256, BK = 64, HALF = 128, HTB = HALF * BK * 2  , STAGE_BYTES = 8 * HTB, NXCD = 8, WGM = 8;

__host__ __device__ __forceinline__ int lds_byte(int r, int c) { const int st = (r >> 4) * 2 + (c >> 5), rr = r & 15, cc = c & 31, ob = rr * 64 + cc * 2; return st * 1024 + (ob ^ (((ob >> 9) & 1) << 5)); }
__host__ __device__ __forceinline__ void stage_rc(int b, int& R, int& C) { const int st = b / 1024, sb = b % 1024, swz = sb ^ (((sb >> 9) & 1) << 5); R = (st >> 1) * 16 + swz / 64; C = (st & 1) * 32 + (swz % 64) / 2; }
__host__ __device__ __forceinline__ int perm32(int rho) { const int n = rho >> 4, i = rho & 15; return 8 * (i >> 2) + 4 * n + (i & 3); }

struct Unit { size_t aoff, boff; int pm, pn, e, valid, mt; };
struct Gemm { const void* A; const void* Bt; int RB; int akstep; };
typedef int v8i __attribute__((ext_vector_type(8)));

struct StaticOrder {
    int nM, nN, nwg, G, c, RB; const unsigned* sc;
    __device__ void init(int M, int N, int RB_, int G_, int c_, const unsigned* sc_ = nullptr) { nM = M / BM; nN = N / BM; nwg = nM * nN; G = G_; c = c_; RB = RB_; sc = sc_; }
    __device__ bool next(int i, Unit& u) const {
        const long L = (long)i * G + c; if (L >= nwg) return false;
        int wgid = (int)L; { const int q = nwg / NXCD, r = nwg % NXCD, xcd = wgid % NXCD, off = wgid / NXCD; wgid = (xcd < r ? xcd * (q + 1) : r * (q + 1) + (xcd - r) * q) + off; }
        const int nig = WGM * nN, gid = wgid / nig, fm = gid * WGM, gsz = (nM - fm) < WGM ? (nM - fm) : WGM;
        u.pm = fm + ((wgid % nig) % gsz); u.pn = (wgid % nig) / gsz; u.e = 0; u.valid = 256; u.mt = 0;
        u.aoff = (size_t)u.pm * (size_t)(BM * RB); u.boff = (size_t)u.pn * (size_t)(BM * RB); return true;
    }
    __device__ __forceinline__ const unsigned* id_src(const Unit& u, int row) const { return sc + u.pm * 256 + row; }
    __device__ __forceinline__ const unsigned* sc_src(const Unit& u, int row) const { return sc + u.pm * 256 + row; }
    __device__ __forceinline__ const unsigned* bias_src(const Unit& u, int row) const { return sc + u.pm * 256 + row; }
};

__device__ __forceinline__ unsigned cvt_pk_bf16(float lo, float hi) { typedef float f2_ __attribute__((ext_vector_type(2))); typedef __bf16 b2_ __attribute__((ext_vector_type(2))); f2_ v = {lo, hi}; b2_ b = __builtin_convertvector(v, b2_); return __builtin_bit_cast(unsigned, b); }

template <class Epi, class Sched, bool ALIGN_EPI, bool GATHER, bool IDS, bool FP8 = false, bool LINEAR = false>
__device__ __forceinline__ void gemm_phase(PG8_LAS unsigned char* lds, PG8_LAS unsigned* idb, const Gemm g, const Sched& S, const Epi& E, const int tid) {
    const int wid = __builtin_amdgcn_readfirstlane(tid >> 6), lane = tid & 63, wr = wid >> 2, wc = wid & 3, fr = lane & 15, fq = lane >> 4;
    const int RB = g.RB; int nt = RB / (BK * 2); asm volatile("" : "+s"(nt));
    unsigned voffA[2], voffB[2]; int RA[2], CA[2];
#pragma unroll
    for (int i = 0; i < 2; ++i) { int R, C; stage_rc(tid * 16 + i * 8192, R, C); const int Rb = (R & ~31) + perm32(R & 31); RA[i] = R; CA[i] = C;
        voffA[i] = (unsigned)(R * RB + C * 2); voffB[i] = (unsigned)(Rb * RB + C * 2); }
    const size_t kstep = (size_t)(BK * 2), akstep = (size_t)g.akstep;
    const size_t hstep = (size_t)HALF * RB;
    const unsigned ldsw = (unsigned)wid * 1024u;
    const int aoff = lds_byte(wr * 64 + fr, fq * 8), boff = lds_byte(wc * 32 + fr, fq * 8);
#define PG8_SA(b, h) (((b) * 2 + (h)) * HTB)
#define PG8_SB(b, h) ((4 + (b) * 2 + (h)) * HTB)
#define PG8_STAGE(bufoff, gbase, voff) do { _Pragma("unroll") for (int _i = 0; _i < 2; ++_i) \
        __builtin_amdgcn_global_load_lds((const unsigned*)((const char*)(gbase) + (voff)[_i]), (PG8_LAS unsigned*)(lds + (bufoff) + ldsw + _i * 8192), 16, 0, 0); } while (0)
#define PG8_STAGE_A(bufoff, pbase, gbase, h, gv) do { if constexpr (GATHER) { PG8_STAGE(bufoff, gbase, gv[h]); } else { PG8_STAGE(bufoff, (pbase) + (h) * hstep, voffA); } } while (0)
#define PG8_LD32(p0_, p1_) __builtin_bit_cast(v8i, __builtin_shufflevector(*(const PG8_LAS u32x4*)(p0_), *(const PG8_LAS u32x4*)(p1_), 0, 1, 2, 3, 4, 5, 6, 7))
#define PG8_LDA(dst, b, h) do { if constexpr (FP8) { _Pragma("unroll") for (int m = 0; m < 4; ++m) dst##8[m] = PG8_LD32(lds + PG8_SA(b, h) + aoff + m * 2048, lds + PG8_SA(b, h) + aoff + m * 2048 + 1024); } \
        else { _Pragma("unroll") for (int m = 0; m < 4; ++m) _Pragma("unroll") for (int k = 0; k < 2; ++k) dst[m][k] = *(const PG8_LAS bf16x8*)(lds + PG8_SA(b, h) + aoff + m * 2048 + k * 1024); } } while (0)
#define PG8_LDB(dst, b, h) do { if constexpr (FP8) { _Pragma("unroll") for (int n = 0; n < 2; ++n) dst##8[n] = PG8_LD32(lds + PG8_SB(b, h) + boff + n * 2048, lds + PG8_SB(b, h) + boff + n * 2048 + 1024); } \
        else { _Pragma("unroll") for (int n = 0; n < 2; ++n) _Pragma("unroll") for (int k = 0; k < 2; ++k) dst[n][k] = *(const PG8_LAS bf16x8*)(lds + PG8_SB(b, h) + boff + n * 2048 + k * 1024); } } while (0)
#define PG8_MMA(ai, bj, At, Bt) do { __builtin_amdgcn_s_setprio(1); if constexpr (FP8) { _Pragma("unroll") for (int m = 0; m < 4; ++m) _Pragma("unroll") for (int n = 0; n < 2; ++n) \
        acc[ai][bj][m][n] = __builtin_amdgcn_mfma_scale_f32_16x16x128_f8f6f4(Bt##8[n], At##8[m], acc[ai][bj][m][n], 0, 0, 0, sca_, 0, 0x7f7f7f7f); } \
        else { _Pragma("unroll") for (int m = 0; m < 4; ++m) _Pragma("unroll") for (int n = 0; n < 2; ++n) _Pragma("unroll") for (int k = 0; k < 2; ++k) \
        acc[ai][bj][m][n] = __builtin_amdgcn_mfma_f32_16x16x32_bf16(Bt[n][k], At[m][k], acc[ai][bj][m][n], 0, 0, 0); } __builtin_amdgcn_s_setprio(0); } while (0)
#define PG8_WAIT_V(n) asm volatile("s_waitcnt vmcnt(" #n ")" ::: "memory")
#define PG8_WAIT_L(n) asm volatile("s_waitcnt lgkmcnt(" #n ")" ::: "memory")
#define PG8_BAR __builtin_amdgcn_s_barrier()
#define PG8_SCHED __builtin_amdgcn_sched_barrier(0)
#define PG8_IDS_DMA(u, s) do { if (wid < 4) { __builtin_amdgcn_global_load_lds(S.id_src(u, tid), (PG8_LAS unsigned*)(idb + (s) * 768 + wid * 64), 4, 0, 0); \
        __builtin_amdgcn_global_load_lds(S.sc_src(u, tid), (PG8_LAS unsigned*)(idb + (s) * 768 + 256 + wid * 64), 4, 0, 0); \
        __builtin_amdgcn_global_load_lds(S.bias_src(u, tid), (PG8_LAS unsigned*)(idb + (s) * 768 + 512 + wid * 64), 4, 0, 0); } } while (0)
#define PG8_GV(dst, s, un) do { _Pragma("unroll") for (int _h = 0; _h < 2; ++_h) _Pragma("unroll") for (int _i = 0; _i < 2; ++_i) \
        dst[_h][_i] = (LINEAR ? (unsigned)((un).pm * 256 + _h * 128 + RA[_i]) : (idb[(s) * 768 + _h * 128 + RA[_i]] >> 2)) * (unsigned)RB + (unsigned)(CA[_i] * 2); } while (0)
    Unit cur, nxt; int ui = 0, us = 0;
    if (!S.next(0, cur)) return;
    f32x4 acc[2][2][4][2];
#pragma unroll
    for (int a = 0; a < 2; ++a)
#pragma unroll
        for (int b = 0; b < 2; ++b)
#pragma unroll
            for (int m = 0; m < 4; ++m)
#pragma unroll
                for (int n = 0; n < 2; ++n) acc[a][b][m][n] = (f32x4){0.f, 0.f, 0.f, 0.f};
    bf16x8 At[4][2], B0[2][2], B1[2][2]; v8i At8[4], B08[2], B18[2];
    unsigned cv[2][2] = {{0u, 0u}, {0u, 0u}};
    const char* A0 = (const char*)g.A;
    const char* cA = A0 + (GATHER ? (size_t)0 : cur.aoff); const char* cB = (const char*)g.Bt + cur.boff;
    if constexpr (IDS) {
        PG8_IDS_DMA(cur, 0); PG8_WAIT_V(0); PG8_BAR;
    }
    if constexpr (GATHER) { PG8_GV(cv, 0, cur); }
    PG8_STAGE(PG8_SB(0, 0), cB, voffB); PG8_STAGE(PG8_SB(0, 1), cB + hstep, voffB); PG8_STAGE_A(PG8_SA(0, 0), cA, A0, 0, cv); PG8_STAGE_A(PG8_SA(0, 1), cA, A0, 1, cv);
    if (wr == 1) PG8_BAR;
    PG8_WAIT_V(2); PG8_BAR;
    PG8_STAGE(PG8_SB(1, 0), cB + kstep, voffB); PG8_STAGE_A(PG8_SA(1, 0), cA + akstep, A0 + akstep, 0, cv); PG8_STAGE(PG8_SB(1, 1), cB + hstep + kstep, voffB);
    PG8_WAIT_V(6); PG8_BAR;
    for (;;) {
        const bool has_next = S.next(ui + 1, nxt);
        const int ns = (us == 2) ? 0 : us + 1;
        if constexpr (IDS) { if (has_next) PG8_IDS_DMA(nxt, ns); }
        const char* nA = has_next ? A0 + (GATHER ? (size_t)0 : nxt.aoff) : cA; const char* nB = has_next ? (const char*)g.Bt + nxt.boff : cB;
#ifdef PROBE_KTWICE
        for (int rep_ = 0; rep_ < (FP8 ? 2 : 1); ++rep_) { const int sca_ = rep_ ? 0 : 0x7f7f7f7f;
#else
        { const int sca_ = 0x7f7f7f7f;
#endif
#pragma nounroll
        for (int t = 0; t < nt; t += 2) {
            int lastv = (t == nt - 2) ? 1 : 0; asm volatile("" : "+v"(lastv)); const bool last = __builtin_amdgcn_readfirstlane(lastv) != 0;
            const char* a1 = cA + (size_t)(t + 1) * akstep;
            const char* a2 = last ? nA : cA + (size_t)(t + 2) * akstep; const char* b2 = last ? nB : cB + (size_t)(t + 2) * kstep;
            const char* a3 = a2 + akstep; const char* b3 = b2 + kstep;
            PG8_LDB(B0, 0, 0); PG8_LDB(B1, 0, 1); PG8_SCHED; PG8_LDA(At, 0, 0); PG8_STAGE_A(PG8_SA(1, 1), a1, a1, 1, cv);
            if constexpr (GATHER) { if (last && has_next) { PG8_GV(cv, ns, nxt); } }
            PG8_WAIT_V(8); PG8_WAIT_L(0); PG8_BAR; PG8_MMA(0, 0, At, B0); PG8_MMA(0, 1, At, B1); PG8_BAR; PG8_SCHED;
            PG8_LDA(At, 0, 1); PG8_STAGE(PG8_SB(0, 0), b2, voffB); PG8_STAGE(PG8_SB(0, 1), b2 + hstep, voffB); PG8_STAGE_A(PG8_SA(0, 0), a2, a2, 0, cv);
            PG8_WAIT_V(8); PG8_WAIT_L(0); PG8_BAR; PG8_MMA(1, 0, At, B0); PG8_MMA(1, 1, At, B1); PG8_BAR; PG8_SCHED;
            PG8_LDB(B0, 1, 0); PG8_LDB(B1, 1, 1); PG8_SCHED; PG8_LDA(At, 1, 0); PG8_STAGE_A(PG8_SA(0, 1), a2, a2, 1, cv);
            PG8_WAIT_V(8); PG8_WAIT_L(0); PG8_BAR; PG8_MMA(0, 0, At, B0); PG8_MMA(0, 1, At, B1); PG8_BAR; PG8_SCHED;
            PG8_LDA(At, 1, 1); PG8_STAGE(PG8_SB(1, 0), b3, voffB); PG8_STAGE(PG8_SB(1, 1), b3 + hstep, voffB); PG8_STAGE_A(PG8_SA(1, 0), a3, a3, 0, cv);
            PG8_WAIT_V(8); PG8_WAIT_L(0); PG8_BAR; PG8_MMA(1, 0, At, B0); PG8_MMA(1, 1, At, B1); PG8_BAR; PG8_SCHED;
        }
        }
        if constexpr (ALIGN_EPI) { if (wr == 0) PG8_BAR; }
        PG8_SCHED;
        E(acc, cur, wr, wc, fr, fq, (const PG8_LAS unsigned*)(idb + us * 768));
        PG8_SCHED;
#ifdef PROBE_EPI2
        if constexpr (FP8) { E(acc, cur, wr, wc, fr, fq, (const PG8_LAS unsigned*)(idb + us * 768)); PG8_SCHED; }
#endif
        if (!has_next) break;
#pragma unroll
        for (int a = 0; a < 2; ++a)
#pragma unroll
            for (int b = 0; b < 2; ++b)
#pragma unroll
                for (int m = 0; m < 4; ++m)
#pragma unroll
                    for (int n = 0; n < 2; ++n) acc[a][b][m][n] = (f32x4){0.f, 0.f, 0.f, 0.f};
        cur = nxt; cA = nA; cB = nB; ++ui; us = ns;
        if constexpr (ALIGN_EPI) { if (wr == 1) PG8_BAR; }
    }
    PG8_WAIT_V(0);
    if constexpr (!ALIGN_EPI) { if (wr == 0) PG8_BAR; }
    PG8_BAR;
#undef PG8_SA
#undef PG8_SB
#undef PG8_STAGE
#undef PG8_STAGE_A
#undef PG8_LDA
#undef PG8_LDB
#undef PG8_MMA
#undef PG8_LD32
#undef PG8_WAIT_V
#undef PG8_WAIT_L
#undef PG8_BAR
#undef PG8_SCHED
#undef PG8_IDS_DMA
#undef PG8_GV
}
}
namespace attn_body {
using bf16=__hip_bfloat16;
using bf16x8=__attribute__((ext_vector_type(8)))short;
using s16x4=__attribute__((ext_vector_type(4)))short;
using f32x16=__attribute__((ext_vector_type(16)))float;
using u32x4=__attribute__((ext_vector_type(4)))unsigned;
constexpr int D=64;
constexpr int NW=8,QBLK=32,QB=QBLK*NW,KVBLK=64;
struct UnitP { const bf16* Q; const bf16* K; const bf16* V; bf16* O; long qp, kp, op; int q0, t0, NT; float slope2; float* lse; int lse_stride; };
__device__ __forceinline__ int crow(int r,int hi){return (r&3)+8*(r>>2)+4*hi;}
#define SBAR() __builtin_amdgcn_sched_barrier(0)
template<bool CAUSAL,bool WINDOW> __device__ __forceinline__ void cmask(f32x16&p0,f32x16&p1,int jb,int qrel,int hi){
  const float NEG=-INFINITY; int kb=64*jb+4*hi;
  #pragma unroll
  for(int r=0;r<16;++r){int kv=kb+(r&3)+8*(r>>2);
    if(CAUSAL){ if(kv>qrel)p0[r]=NEG; if(kv+32>qrel)p1[r]=NEG; }
    if(WINDOW){ if(kv<qrel-128)p0[r]=NEG; if(kv+32<qrel-128)p1[r]=NEG; } }
}
__device__ __forceinline__ unsigned bfr(float x){ typedef float f2_ __attribute__((ext_vector_type(2))); typedef __bf16 b2_ __attribute__((ext_vector_type(2))); f2_ v={x,0.f}; b2_ b=__builtin_convertvector(v,b2_); return __builtin_bit_cast(unsigned,b)&0xffffu; }
__device__ __forceinline__ float bfv(unsigned b){ return __builtin_bit_cast(float,b<<16); }

constexpr int NSLOT=3, SLOTB=8192;
constexpr int LDS_K=0, LDS_V=NSLOT*SLOTB;
template<int DV> struct Lds { static constexpr int SLOTV=SLOTB*(DV/64), WS=LDS_V+NSLOT*SLOTV, OST=WS+NW*64*4, OSTW=4096*(DV/64), BYTES=OST+NW*OSTW; };
__device__ __forceinline__ void glds16(const void*gsrc,unsigned lds_dst){unsigned keep;
  asm volatile("s_mov_b32 %0, m0\n\ts_mov_b32 m0, %2\n\ts_nop 0\n\tglobal_load_lds_dwordx4 %1, off\n\ts_mov_b32 m0, %0":"=&s"(keep):"v"(gsrc),"s"(lds_dst):"memory");}
__device__ __forceinline__ float max3f(float a,float b,float c){float r;asm("v_max3_f32 %0, %1, %2, %3":"=v"(r):"v"(a),"v"(b),"v"(c));return r;}
__device__ __forceinline__ float max2f(float a,float b){float r;asm("v_max_f32_e32 %0, %1, %2":"=v"(r):"v"(a),"v"(b));return r;}
__device__ __forceinline__ float fadd_s(float a,float b){float r;asm("v_add_f32_e32 %0, %1, %2":"=v"(r):"v"(a),"v"(b));return r;}
__device__ __forceinline__ float fsub_s(float a,float b){float r;asm("v_sub_f32_e32 %0, %1, %2":"=v"(r):"v"(a),"v"(b));return r;}
typedef float f32x2_t __attribute__((ext_vector_type(2))); typedef __bf16 bf16x2_t __attribute__((ext_vector_type(2)));
__device__ __forceinline__ unsigned cvtpk_s(float lo,float hi){f32x2_t v={lo,hi};bf16x2_t b=__builtin_convertvector(v,bf16x2_t);return __builtin_bit_cast(unsigned,b);}
#define WAIT_BAR(N) asm volatile("s_waitcnt vmcnt(" #N ") lgkmcnt(0)\n\ts_barrier":::"memory")

__device__ __forceinline__ void qkt(f32x16&p0,f32x16&p1,const char*Kslot,const bf16x8*qr,bf16x8 kx0,bf16x8 kx1,bf16x8 qx,int r32,int hi){
  const char*kb=Kslot+hi*1024+r32*16;
  #pragma unroll
  for(int d0=0;d0<4;++d0){
    const bf16x8 b0=*reinterpret_cast<const bf16x8*>(kb+d0*2048);
    const bf16x8 b1=*reinterpret_cast<const bf16x8*>(kb+d0*2048+512);
    if(d0==0){p0=__builtin_amdgcn_mfma_f32_32x32x16_bf16(b0,qr[0],f32x16{},0,0,0);p1=__builtin_amdgcn_mfma_f32_32x32x16_bf16(b1,qr[0],f32x16{},0,0,0);}
    else{p0=__builtin_amdgcn_mfma_f32_32x32x16_bf16(b0,qr[d0],p0,0,0,0);p1=__builtin_amdgcn_mfma_f32_32x32x16_bf16(b1,qr[d0],p1,0,0,0);}}
  p0=__builtin_amdgcn_mfma_f32_32x32x16_bf16(kx0,qx,p0,0,0,0);p1=__builtin_amdgcn_mfma_f32_32x32x16_bf16(kx1,qx,p1,0,0,0);
}
typedef __attribute__((address_space(3))) const char* lds_cptr;
typedef short v4i16_t __attribute__((ext_vector_type(4)));
__device__ __forceinline__ void kload8(bf16x8*kf,lds_cptr kp){
  kf[0]=*(const __attribute__((address_space(3))) bf16x8*)(kp);      kf[1]=*(const __attribute__((address_space(3))) bf16x8*)(kp+512);
  kf[2]=*(const __attribute__((address_space(3))) bf16x8*)(kp+2048); kf[3]=*(const __attribute__((address_space(3))) bf16x8*)(kp+2560);
  kf[4]=*(const __attribute__((address_space(3))) bf16x8*)(kp+4096); kf[5]=*(const __attribute__((address_space(3))) bf16x8*)(kp+4608);
  kf[6]=*(const __attribute__((address_space(3))) bf16x8*)(kp+6144); kf[7]=*(const __attribute__((address_space(3))) bf16x8*)(kp+6656);
}
__device__ __forceinline__ void kload2(bf16x8*kf,lds_cptr kp,int j){ kf[2*j]=*(const __attribute__((address_space(3))) bf16x8*)(kp+j*2048); kf[2*j+1]=*(const __attribute__((address_space(3))) bf16x8*)(kp+j*2048+512); }
__device__ __forceinline__ s16x4 vtr(lds_cptr p){ return __builtin_bit_cast(s16x4,__builtin_amdgcn_ds_read_tr16_b64_v4i16((__attribute__((address_space(3))) v4i16_t*)p)); }
__device__ __forceinline__ float rowmax(const f32x16&p0,const f32x16&p1){
  float a=max3f(p0[0],p0[1],p1[0]),b=max3f(p0[2],p0[3],p1[1]);a=max3f(a,p1[2],p1[3]);
  #pragma unroll
  for(int r=4;r<16;r+=4){a=max3f(a,p0[r],p0[r+1]);b=max3f(b,p0[r+2],p0[r+3]);a=max3f(a,p1[r],p1[r+1]);b=max3f(b,p1[r+2],p1[r+3]);}
  const float m=max2f(a,b);
  auto rr=__builtin_amdgcn_permlane32_swap(__float_as_uint(m),__float_as_uint(m),false,false);
  return max2f(__uint_as_float(rr[0]),__uint_as_float(rr[1]));
}
__device__ __forceinline__ void pv(f32x16*o,int vb,bf16x8 pa0,bf16x8 pa1,bf16x8 pa2,bf16x8 pa3){
  #pragma unroll
  for(int d0=0;d0<2;++d0){s16x4 lo[4],hi[4];
    #pragma unroll
    for(int ks=0;ks<4;++ks){
      asm volatile("ds_read_b64_tr_b16 %0,%1 offset:%c2":"=&v"(lo[ks]):"v"(vb),"i"(d0*4096+ks*1024):"memory");
      asm volatile("ds_read_b64_tr_b16 %0,%1 offset:%c2":"=&v"(hi[ks]):"v"(vb),"i"(d0*4096+ks*1024+512):"memory");}
    asm volatile("s_waitcnt lgkmcnt(0)":::"memory");SBAR();
    #define PK(k) (bf16x8){lo[k][0],lo[k][1],lo[k][2],lo[k][3],hi[k][0],hi[k][1],hi[k][2],hi[k][3]}
    o[d0]=__builtin_amdgcn_mfma_f32_32x32x16_bf16(pa0,PK(0),o[d0],0,0,0);
    o[d0]=__builtin_amdgcn_mfma_f32_32x32x16_bf16(pa1,PK(1),o[d0],0,0,0);
    o[d0]=__builtin_amdgcn_mfma_f32_32x32x16_bf16(pa2,PK(2),o[d0],0,0,0);
    o[d0]=__builtin_amdgcn_mfma_f32_32x32x16_bf16(pa3,PK(3),o[d0],0,0,0);
    #undef PK
  }
}

__device__ __forceinline__ void pv128(f32x16*o,int vb,bf16x8 pa0,bf16x8 pa1,bf16x8 pa2,bf16x8 pa3){
  #pragma unroll
  for(int d0=0;d0<4;++d0){s16x4 lo[4],hi[4];
    #pragma unroll
    for(int ks=0;ks<4;++ks){
      asm volatile("ds_read_b64_tr_b16 %0,%1 offset:%c2":"=&v"(lo[ks]):"v"(vb),"i"(d0*4096+ks*1024):"memory");
      asm volatile("ds_read_b64_tr_b16 %0,%1 offset:%c2":"=&v"(hi[ks]):"v"(vb),"i"(d0*4096+ks*1024+512):"memory");}
    asm volatile("s_waitcnt lgkmcnt(0)":::"memory");SBAR();
    #define PK(k) (bf16x8){lo[k][0],lo[k][1],lo[k][2],lo[k][3],hi[k][0],hi[k][1],hi[k][2],hi[k][3]}
    o[d0]=__builtin_amdgcn_mfma_f32_32x32x16_bf16(pa0,PK(0),o[d0],0,0,0);
    o[d0]=__builtin_amdgcn_mfma_f32_32x32x16_bf16(pa1,PK(1),o[d0],0,0,0);
    o[d0]=__builtin_amdgcn_mfma_f32_32x32x16_bf16(pa2,PK(2),o[d0],0,0,0);
    o[d0]=__builtin_amdgcn_mfma_f32_32x32x16_bf16(pa3,PK(3),o[d0],0,0,0);
    #undef PK
  }
}
#ifndef ATTN_STORE16
#define ATTN_STORE16(p,v) (*(u32x4*)(p)=(v))
#endif
template<int THRL,bool CAUSAL,bool WINDOW,bool ALIBI,bool LSE,int DV=64> __device__ __forceinline__ void attn_unit(const UnitP&U,char*shm){
  constexpr int LDS_WS=Lds<DV>::WS, LDS_OST=Lds<DV>::OST, VMUL=DV/64;
  int tid=threadIdx.x; asm volatile("":"+v"(tid));
  const int lane=tid&63,r32=lane&31,hi=lane>>5; const int wid=__builtin_amdgcn_readfirstlane(tid>>6);
  const int q0=U.q0; const long qp=U.qp,kp=U.kp,op=U.op; const float slope2=U.slope2;
  const bf16*Qw=U.Q+(long)(q0+wid*QBLK)*qp;
  const bf16*Kh=U.K+(long)U.t0*KVBLK*kp,*Vh=U.V+(long)U.t0*KVBLK*kp;
  const unsigned lds0=(unsigned)(uintptr_t)shm;
  float*wsf=(float*)(shm+LDS_WS)+wid*64;
  const bf16*ksrc=Kh+(long)lane*kp+wid*8;
  const bf16*vsrc=Vh+(long)(16*(wid&3)+(lane>>2))*kp+(wid>>2)*32+(lane&3)*8;
  const unsigned kdst=lds0+LDS_K+wid*1024, vdst=lds0+LDS_V+wid*1024;
  #define DMA_K(t,slot) glds16(ksrc+(long)(t)*KVBLK*kp,(unsigned)__builtin_amdgcn_readfirstlane(kdst+(slot)))
  #define DMA_V(t,slot) do{ glds16(vsrc+(long)(t)*KVBLK*kp,(unsigned)__builtin_amdgcn_readfirstlane(vdst+VMUL*(slot))); if constexpr(DV==128) glds16(vsrc+64+(long)(t)*KVBLK*kp,(unsigned)__builtin_amdgcn_readfirstlane(vdst+VMUL*(slot)+8192)); }while(0)
  const int vb0=(int)(lds0+LDS_V)+((lane>>4)&1)*32+(lane&3)*8+(4*hi+((lane&15)>>2))*64;
  const char*Kbase=shm+LDS_K; bf16x8 kf[8];
  const lds_cptr shm3=(lds_cptr)shm; const lds_cptr kp0=shm3+LDS_K+hi*1024+r32*16; const lds_cptr vp0=shm3+LDS_V+((lane>>4)&1)*32+(lane&3)*8+(4*hi+((lane&15)>>2))*64;
  const int NT=U.NT;
  DMA_K(0,0);DMA_V(0,0);DMA_K(1,SLOTB);
  bf16x8 qr[4];
  #pragma unroll
  for(int d0=0;d0<4;++d0)qr[d0]=*reinterpret_cast<const bf16x8*>(&Qw[(long)r32*qp+d0*16+hi*8]);
  float mhat=0.f,l_reg=0.f;f32x16 o[4];o[0]=f32x16{};o[1]=f32x16{};o[2]=f32x16{};o[3]=f32x16{};
  const int qrel=wid*QBLK+r32;
  #define CMASK(P0,P1,t) do{int jb_=(t)-(NT-4); if(WINDOW||(CAUSAL&&jb_>=0))cmask<CAUSAL,WINDOW>(P0,P1,jb_,qrel,hi);}while(0)
  bf16x8 kx0,kx1,qx;
  { const float k0_=ALIBI?slope2*(float)r32:0.f, k1_=ALIBI?slope2*(float)(r32+32):0.f; const unsigned h0=bfr(k0_),l0=bfr(k0_-bfv(h0)),h1=bfr(k1_),l1=bfr(k1_-bfv(h1));
    u32x4 a={0x3f803f80u,0x3f80u|(h0<<16),l0,0u}, b={0x3f803f80u,0x3f80u|(h1<<16),l1,0u}; if(hi){a=u32x4{0u,0u,0u,0u};b=a;} kx0=__builtin_bit_cast(bf16x8,a); kx1=__builtin_bit_cast(bf16x8,b); }
  #define QX_SET(t) do{ const float nb_=ALIBI?__builtin_fmaf(slope2,(float)(64*((t)-(NT-4))-qrel),-mhat):-mhat; const unsigned a_=bfr(nb_); const float r1_=nb_-bfv(a_); const unsigned b_=bfr(r1_); const unsigned c_=bfr(r1_-bfv(b_)); \
    u32x4 q_={a_|(b_<<16),c_|0x3f800000u,0x3f80u,0u}; if(hi)q_=u32x4{0u,0u,0u,0u}; qx=__builtin_bit_cast(bf16x8,q_); asm volatile("":"+v"(qx)); }while(0)
  bool resc=false;
  #define START(P0,P1) do{ const float rm=rowmax(P0,P1); resc=false; \
    { const float dl=(rm==-INFINITY)?0.f:rm; mhat=fadd_s(mhat,dl); \
      _Pragma("unroll") for(int r=0;r<16;++r){P0[r]=fsub_s(P0[r],dl);P1[r]=fsub_s(P1[r],dl);} } \
    _Pragma("unroll") for(int r=0;r<16;++r)P0[r]=__builtin_amdgcn_exp2f(P0[r]); }while(0)
  #define RESC() do{ if(resc){ asm volatile("s_waitcnt lgkmcnt(0)":::"memory"); \
      _Pragma("unroll") for(int d_=0;d_<2*VMUL;++d_) _Pragma("unroll") for(int r=0;r<16;++r)o[d_][r]*=wsf[crow(r,hi)]; } }while(0)
  f32x16 pA0,pA1,pB0,pB1;
  int sl_prev=0,sl_cur=0,sl_next=SLOTB;
  #define ROT() do{sl_prev=sl_cur;sl_cur=sl_next;sl_next=(sl_next==(NSLOT-1)*SLOTB)?0:sl_next+SLOTB;}while(0)
  DMA_K(2,2*SLOTB);
  if constexpr(DV==128){WAIT_BAR(4);}else{WAIT_BAR(3);}
  QX_SET(0);
  qkt(pA0,pA1,Kbase,qr,kx0,kx1,qx,r32,hi);asm volatile("s_nop 15\n\ts_nop 7":"+v"(pA0),"+v"(pA1));CMASK(pA0,pA1,0);
  START(pA0,pA1);
  _Pragma("unroll") for(int r=0;r<16;++r)pA1[r]=__builtin_amdgcn_exp2f(pA1[r]);
  WAIT_BAR(0);
  DMA_K(3,0);DMA_V(1,SLOTB);
  ROT();
  kload8(kf,kp0+sl_cur);
  if constexpr(DV==128){WAIT_BAR(3);}else{WAIT_BAR(2);}
  s16x4 vlo[8],vhi[8]; s16x4 vfl[4],vfh[4]; u32x4 pw0,pw1,pw2,pw3;
  #define PKW(P,B) cvtpk_s(P[B],P[B+1])
  #define PAF(k) __builtin_bit_cast(bf16x8,pw##k)
  #define VFR(i) (bf16x8){vlo[i][0],vlo[i][1],vlo[i][2],vlo[i][3],vhi[i][0],vhi[i][1],vhi[i][2],vhi[i][3]}
  #define PIN(x) asm volatile("":"+v"(x))
  #define MX3(a,b,c) __builtin_fmaxf(__builtin_fmaxf((a),(b)),(c))
  #define GAPA(MF,A0,A1,A2,A3,W0,W1,PW) do{ MF; sacc+=A0; sacc+=A1; sacc+=A2; sacc+=A3; PIN(sacc); W0; W1; PIN(PW); SBAR(); }while(0)
  #define EX(v) __builtin_amdgcn_exp2f(v)
  #define GAPB(MF,X,B) do{ MF; X[B]=EX(X[B]); X[B+1]=EX(X[B+1]); X[B+2]=EX(X[B+2]); X[B+3]=EX(X[B+3]); PIN(X); SBAR(); }while(0)
  #define VRD(i) do{ if constexpr(DV==64){ vlo[i]=vtr(vp_+(((i)>>2)*4096+((i)&3)*1024)); vhi[i]=vtr(vp_+(((i)>>2)*4096+((i)&3)*1024+512)); } }while(0)
  #define VRJ(f) do{ vfl[(f)&3]=vtr(vp_+(((f)&3)*4096+((f)>>2)*1024)); vfh[(f)&3]=vtr(vp_+(((f)&3)*4096+((f)>>2)*1024+512)); }while(0)
  #define VFJ(f) (bf16x8){vfl[(f)&3][0],vfl[(f)&3][1],vfl[(f)&3][2],vfl[(f)&3][3],vfh[(f)&3][0],vfh[(f)&3][1],vfh[(f)&3][2],vfh[(f)&3][3]}
  #define GAPJ(f,PA,X,B) do{ if((f)+3<16){VRJ((f)+3);} o[(f)&3]=__builtin_amdgcn_mfma_f32_32x32x16_bf16(PA,VFJ(f),o[(f)&3],0,0,0); X[B]=EX(X[B]); X[B+1]=EX(X[B+1]); PIN(X); SBAR(); }while(0)
  #define KRD(G,j) do{ if(G){ kload2(kf,kp0+sl_next,j); SBAR(); } }while(0)
  #define STEP(C0,C1,P0,P1,t,GK,GV,GL) do{ SBAR(); QX_SET(t); SBAR(); \
    const lds_cptr vp_=vp0+VMUL*sl_prev; \
    VRD(0); SBAR(); float sacc=(P0[0]+P0[1]); \
    GAPA(C0=__builtin_amdgcn_mfma_f32_32x32x16_bf16(kf[0],qr[0],f32x16{},0,0,0), P0[2],P0[3],P0[4],P0[5],     pw0[0]=PKW(P0,0), pw0[1]=PKW(P0,2), pw0); \
    VRD(4); SBAR(); GAPA(C1=__builtin_amdgcn_mfma_f32_32x32x16_bf16(kf[1],qr[0],f32x16{},0,0,0), P0[6],P0[7],P0[8],P0[9],     pw0[2]=PKW(P0,4), pw0[3]=PKW(P0,6), pw0); \
    VRD(1); SBAR(); GAPA(C0=__builtin_amdgcn_mfma_f32_32x32x16_bf16(kf[2],qr[1],C0,0,0,0),   P0[10],P0[11],P0[12],P0[13], pw1[0]=PKW(P0,8), pw1[1]=PKW(P0,10), pw1); \
    VRD(5); SBAR(); GAPA(C1=__builtin_amdgcn_mfma_f32_32x32x16_bf16(kf[3],qr[1],C1,0,0,0),   P0[14],P0[15],P1[0],P1[1],   pw1[2]=PKW(P0,12),pw1[3]=PKW(P0,14), pw1); \
    VRD(2); SBAR(); GAPA(C0=__builtin_amdgcn_mfma_f32_32x32x16_bf16(kf[4],qr[2],C0,0,0,0),   P1[2],P1[3],P1[4],P1[5],     pw2[0]=PKW(P1,0), pw2[1]=PKW(P1,2), pw2); \
    VRD(6); SBAR(); GAPA(C1=__builtin_amdgcn_mfma_f32_32x32x16_bf16(kf[5],qr[2],C1,0,0,0),   P1[6],P1[7],P1[8],P1[9],     pw2[2]=PKW(P1,4), pw2[3]=PKW(P1,6), pw2); \
    VRD(3); SBAR(); GAPA(C0=__builtin_amdgcn_mfma_f32_32x32x16_bf16(kf[6],qr[3],C0,0,0,0),   P1[10],P1[11],P1[12],P1[13], pw3[0]=PKW(P1,8), pw3[1]=PKW(P1,10), pw3); \
    VRD(7); SBAR(); GAPA(C1=__builtin_amdgcn_mfma_f32_32x32x16_bf16(kf[7],qr[3],C1,0,0,0),   P1[14],P1[15],0.f,0.f,       pw3[2]=PKW(P1,12),pw3[3]=PKW(P1,14), pw3); \
    C0=__builtin_amdgcn_mfma_f32_32x32x16_bf16(kx0,qx,C0,0,0,0); C1=__builtin_amdgcn_mfma_f32_32x32x16_bf16(kx1,qx,C1,0,0,0); if constexpr(DV==128){VRJ(0);VRJ(1);VRJ(2);} SBAR(); \
    l_reg+=sacc; \
    if(GK){DMA_K((t)+3,sl_cur);} if(GV){DMA_V((t)+1,sl_next);} \
    CMASK(C0,C1,t); \
    { float a=MX3(C0[0],C0[1],C1[0]),b=MX3(C0[2],C0[3],C1[1]); a=MX3(a,C1[2],C1[3]); \
      _Pragma("unroll") for(int r=4;r<16;r+=4){a=MX3(a,C0[r],C0[r+1]);b=MX3(b,C0[r+2],C0[r+3]);a=MX3(a,C1[r],C1[r+1]);b=MX3(b,C1[r+2],C1[r+3]);} \
      float rm=__builtin_fmaxf(a,b); { auto rr=__builtin_amdgcn_permlane32_swap(__float_as_uint(rm),__float_as_uint(rm),false,false); rm=__builtin_fmaxf(__uint_as_float(rr[0]),__uint_as_float(rr[1])); } \
      resc=false; \
      if(__builtin_expect(__any(rm>(float)THRL),0)){ const float dl=__builtin_fmaxf(rm,0.f); mhat+=dl; \
        _Pragma("unroll") for(int r=0;r<16;++r){C0[r]-=dl;C1[r]-=dl;} \
        const float f=__builtin_amdgcn_exp2f(-dl); l_reg*=f; if(hi==0)wsf[r32]=f; resc=true; } } \
    SBAR(); \
    if constexpr(DV==64){ \
    GAPB(o[0]=__builtin_amdgcn_mfma_f32_32x32x16_bf16(PAF(0),VFR(0),o[0],0,0,0), C0,0); \
    GAPB(o[1]=__builtin_amdgcn_mfma_f32_32x32x16_bf16(PAF(0),VFR(4),o[1],0,0,0), C0,4); \
    KRD(GL,0); GAPB(o[0]=__builtin_amdgcn_mfma_f32_32x32x16_bf16(PAF(1),VFR(1),o[0],0,0,0), C0,8); \
    KRD(GL,1); GAPB(o[1]=__builtin_amdgcn_mfma_f32_32x32x16_bf16(PAF(1),VFR(5),o[1],0,0,0), C0,12); \
    KRD(GL,2); GAPB(o[0]=__builtin_amdgcn_mfma_f32_32x32x16_bf16(PAF(2),VFR(2),o[0],0,0,0), C1,0); \
    KRD(GL,3); GAPB(o[1]=__builtin_amdgcn_mfma_f32_32x32x16_bf16(PAF(2),VFR(6),o[1],0,0,0), C1,4); \
    GAPB(o[0]=__builtin_amdgcn_mfma_f32_32x32x16_bf16(PAF(3),VFR(3),o[0],0,0,0), C1,8); \
    GAPB(o[1]=__builtin_amdgcn_mfma_f32_32x32x16_bf16(PAF(3),VFR(7),o[1],0,0,0), C1,12); \
    } else { \
    GAPJ(0,PAF(0),C0,0); GAPJ(1,PAF(0),C0,2); GAPJ(2,PAF(0),C0,4); GAPJ(3,PAF(0),C0,6); \
    KRD(GL,0); GAPJ(4,PAF(1),C0,8); GAPJ(5,PAF(1),C0,10); KRD(GL,1); GAPJ(6,PAF(1),C0,12); GAPJ(7,PAF(1),C0,14); \
    KRD(GL,2); GAPJ(8,PAF(2),C1,0); GAPJ(9,PAF(2),C1,2); KRD(GL,3); GAPJ(10,PAF(2),C1,4); GAPJ(11,PAF(2),C1,6); \
    GAPJ(12,PAF(3),C1,8); GAPJ(13,PAF(3),C1,10); GAPJ(14,PAF(3),C1,12); GAPJ(15,PAF(3),C1,14); \
    } \
    }while(0)
  int t=1;
  #undef CMASK
  #define CMASK(P0,P1,t) do{}while(0)
  for(;t+5<NT;t+=2){
    STEP(pB0,pB1,pA0,pA1,t,true,true,true);     if constexpr(DV==128){WAIT_BAR(3);}else{WAIT_BAR(2);} RESC(); ROT();
    STEP(pA0,pA1,pB0,pB1,t+1,true,true,true);   if constexpr(DV==128){WAIT_BAR(3);}else{WAIT_BAR(2);} RESC(); ROT();
  }
  #undef CMASK
  #define CMASK(P0,P1,t) do{int jb_=(t)-(NT-4); if(WINDOW||(CAUSAL&&jb_>=0))cmask<CAUSAL,WINDOW>(P0,P1,jb_,qrel,hi);}while(0)
  #define ENDW(tt) do{ if((tt)+3<NT){ if constexpr(DV==128){WAIT_BAR(3);}else{WAIT_BAR(2);} } else if((tt)+2<NT){ if constexpr(DV==128){WAIT_BAR(2);}else{WAIT_BAR(1);} } else {WAIT_BAR(0);} }while(0)
  for(;t+1<NT;t+=2){
    STEP(pB0,pB1,pA0,pA1,t,(t+3<NT),(t+1<NT),(t+1<NT));       ENDW(t);   RESC(); ROT();
    STEP(pA0,pA1,pB0,pB1,t+1,(t+4<NT),(t+2<NT),(t+2<NT));     ENDW(t+1); RESC(); ROT();
  }
  STEP(pB0,pB1,pA0,pA1,NT-1,false,false,false); RESC();
  { float sacc=pB0[0]+pB0[1]; _Pragma("unroll") for(int r=2;r<16;++r)sacc+=pB0[r]; _Pragma("unroll") for(int r=0;r<16;++r)sacc+=pB1[r]; l_reg+=sacc;
    pw0=(u32x4){PKW(pB0,0),PKW(pB0,2),PKW(pB0,4),PKW(pB0,6)};pw1=(u32x4){PKW(pB0,8),PKW(pB0,10),PKW(pB0,12),PKW(pB0,14)};pw2=(u32x4){PKW(pB1,0),PKW(pB1,2),PKW(pB1,4),PKW(pB1,6)};pw3=(u32x4){PKW(pB1,8),PKW(pB1,10),PKW(pB1,12),PKW(pB1,14)};
    SBAR(); if constexpr(DV==128){pv128(o,vb0+VMUL*sl_cur,PAF(0),PAF(1),PAF(2),PAF(3));}else{pv(o,vb0+sl_cur,PAF(0),PAF(1),PAF(2),PAF(3));} }
  #undef PKW
  #undef PAF
  #undef VFR
  #undef PIN
  #undef MX3
  #undef GAPA
  #undef GAPB
  #undef EX
  #undef VRD
  #undef VRJ
  #undef VFJ
  #undef GAPJ
  #undef KRD
  #undef STEP
  #undef ENDW
  {auto rr=__builtin_amdgcn_permlane32_swap(__float_as_uint(l_reg),__float_as_uint(l_reg),false,false);l_reg=__uint_as_float(rr[0])+__uint_as_float(rr[1]);}
  if(LSE){ if(hi==0)U.lse[(long)(q0+wid*QBLK+r32)*U.lse_stride]=mhat+__builtin_amdgcn_logf(l_reg); }
  if(hi==0)wsf[32+r32]=l_reg;asm volatile("s_waitcnt lgkmcnt(0)":::"memory");
  float rli[16];
  #pragma unroll
  for(int r=0;r<16;++r)rli[r]=__builtin_amdgcn_rcpf(wsf[32+crow(r,hi)]);
  bf16*Ow=U.O+(long)(q0+wid*QBLK)*op;
  { bf16*stg=(bf16*)(shm+LDS_OST)+wid*(2048*VMUL);
    #pragma unroll
    for(int r=0;r<16;++r){const int orow=crow(r,hi);
      #pragma unroll
      for(int d0=0;d0<2*VMUL;++d0)stg[orow*DV+d0*32+r32]=__float2bfloat16(o[d0][r]*rli[r]);}
    asm volatile("s_waitcnt lgkmcnt(0)":::"memory");
    if constexpr(DV==128){
      #pragma unroll
      for(int i=0;i<8;++i){const int row=i*4+(lane>>4),ch=lane&15; const u32x4 v=*(const u32x4*)(stg+row*128+ch*8); ATTN_STORE16(Ow+(long)row*op+ch*8,v);}
    } else {
      #pragma unroll
      for(int i=0;i<4;++i){const int row=i*8+(lane>>3),ch=lane&7; const u32x4 v=*(const u32x4*)(stg+row*64+ch*8); ATTN_STORE16(Ow+(long)row*op+ch*8,v);} } }
  asm volatile("s_waitcnt lgkmcnt(0)\n\ts_barrier":::"memory");
  #undef DMA_K
  #undef DMA_V
  #undef CMASK
  #undef START
  #undef RESC
  #undef ROT
  #undef QX_SET
}
constexpr int ATTN_LDS_BYTES=Lds<128>::BYTES;
#undef SBAR
#undef WAIT_BAR
}
constexpr size_t MiB = 1u << 20;
constexpr size_t WS_CTL = 0, CTL_ZERO_BYTES = 1 * MiB;
constexpr size_t WS_LIST = 1 * MiB;
constexpr size_t WS_RGATE = 5 * MiB;
constexpr size_t WS_RSTD1 = 5 * MiB + 512 * 1024, WS_RSTD2 = WS_RSTD1 + 128 * 1024, WS_WRG = WS_RSTD2 + 128 * 1024;
constexpr size_t WS_WRT = 7 * MiB + 512 * 1024;
constexpr size_t WS_LSE = 6 * MiB;
constexpr size_t WS_MKV = 8 * MiB;
constexpr size_t WS_WIN = 10 * MiB, WS_WOUT = 15 * MiB, WS_WGU = 17 * MiB, WS_WDN = 145 * MiB;
constexpr size_t WS_XB = 209 * MiB;
constexpr size_t WS_LRSTD = 865 * MiB, WS_LGATE = 869 * MiB;
constexpr size_t WS_P = 273 * MiB, WS_OD = 433 * MiB, WS_ODIL = 497 * MiB;
constexpr size_t WS_ACT = 273 * MiB;
constexpr size_t WS_MIX = 545 * MiB, WS_X1B = 609 * MiB, WS_YB = 673 * MiB, WS_X1H = 801 * MiB, WS_Y = 929 * MiB, WS_END = 993 * MiB;
constexpr int CW_TMO = 0, CW_CODE = 1;
constexpr int CW_CNT = 64;
constexpr int CW_NRM = 256;
constexpr int CW_Q = 1024;
constexpr int CW_BAR = 4096;

constexpr int RING_OFF = 0, RING_BYTES = 131072;
constexpr int LDSCTL_OFF = RING_BYTES;
constexpr int IDB_OFF = LDSCTL_OFF;
constexpr int TBL_OFF = IDB_OFF + 9216;
constexpr int LCNT_OFF = TBL_OFF + 2304;
constexpr int MISC_OFF = LCNT_OFF + 256;
constexpr int STG_OFF = IDB_OFF;
constexpr int LDS_BYTES = 147456;
static_assert(MISC_OFF + 128 <= LDS_BYTES && 512 * 16 <= 9216, "LDS map");
constexpr int NWAVES = 8;

#define GAS __attribute__((address_space(1)))
#define LAS __attribute__((address_space(3)))
typedef unsigned short bf16;
typedef unsigned v4u __attribute__((ext_vector_type(4)));
typedef unsigned v2u __attribute__((ext_vector_type(2)));
typedef float f32x4 __attribute__((ext_vector_type(4)));
typedef float f32x16 __attribute__((ext_vector_type(16)));
typedef short bf16x8 __attribute__((ext_vector_type(8)));
typedef GAS unsigned gu32;
#define RLX_AGENT __ATOMIC_RELAXED, __HIP_MEMORY_SCOPE_AGENT
#define LDS_WAIT() asm volatile("s_waitcnt lgkmcnt(0)" ::: "memory")
#define VM_WAIT() asm volatile("s_waitcnt vmcnt(0)" ::: "memory")
__device__ __forceinline__ unsigned f2bf(float f) { unsigned u = __builtin_bit_cast(unsigned, f); return (u + 0x7fffu + ((u >> 16) & 1u)) >> 16; }
__device__ __forceinline__ unsigned pk2(float lo, float hi) { return f2bf(lo) | (f2bf(hi) << 16); }
__device__ __forceinline__ float sat8(float v) { return __builtin_amdgcn_fmed3f(v, -448.f, 448.f); }
__device__ __forceinline__ unsigned fp8x4(float a, float b, float c, float d) { int w = __builtin_amdgcn_cvt_pk_fp8_f32(sat8(a), sat8(b), 0, false); w = __builtin_amdgcn_cvt_pk_fp8_f32(sat8(c), sat8(d), w, true); return (unsigned)w; }
constexpr float WSCALE = 64.f, ASCALE = 8.f, YSCALE = 64.f;
__device__ __forceinline__ float bf2f(unsigned short b) { return __builtin_bit_cast(float, (unsigned)b << 16); }
__device__ __forceinline__ float bflo(unsigned w) { return __builtin_bit_cast(float, w << 16); }
__device__ __forceinline__ float bfhi(unsigned w) { return __builtin_bit_cast(float, w & 0xffff0000u); }
__device__ __forceinline__ float wave_sum(float v) {
#pragma unroll
    for (int o = 1; o < 64; o <<= 1) v += __shfl_xor(v, o);
    return v;
}

#define XB_TMO      128
#define XB_XCNT(j)  (256  + 64 * (j))
#define XB_XSUB(j)  (1280 + 64 * (j))
#define XB_XGEN(j)  (2304 + 64 * (j))
#define XB_TOP      3328
#define XB_TOPGEN   3392
#define XCD_BAR_WORDS 3456
#define XB_SPIN_CAP (1u << 20)
__device__ __forceinline__ unsigned xb_ld(unsigned* p)              { return __hip_atomic_load(p, __ATOMIC_RELAXED, __HIP_MEMORY_SCOPE_AGENT); }
__device__ __forceinline__ unsigned xb_add(unsigned* p, unsigned v) { return __hip_atomic_fetch_add(p, v, __ATOMIC_RELAXED, __HIP_MEMORY_SCOPE_AGENT); }
__device__ __forceinline__ unsigned xb_xcc_id() { return (unsigned)__builtin_amdgcn_s_getreg((3 << 11) | 20) & 0xFu; }
#define XB_SPIN(cond, bar) do { unsigned _sp = 0; while (cond) { __builtin_amdgcn_s_sleep(1); \
    if ((++_sp & 255u) == 0u) { if (xb_ld(&(bar)[XB_TMO])) break; if (_sp > XB_SPIN_CAP) { atomicAdd(&(bar)[XB_TMO], 1u); break; } } } } while (0)
struct XcdBarrier { unsigned* bar; unsigned x; volatile LAS unsigned* st; };
__device__ __forceinline__ XcdBarrier xcd_barrier_post(unsigned* bar, volatile LAS unsigned* st, const bool lead) {
    XcdBarrier b; b.bar = bar; b.x = xb_xcc_id(); b.st = st;
    if (lead) (void)xb_add(&bar[XB_XCNT(b.x)], 1u);
    return b;
}
__device__ __forceinline__ void xcd_barrier_complete(unsigned* bar, unsigned x, unsigned& nloc, unsigned& nx) {
    const unsigned G = gridDim.x * gridDim.y * gridDim.z;
    unsigned sum, cnt, mine, sp = 0u;
    for (;;) {
        sum = 0u; cnt = 0u; mine = 0u;
#pragma unroll
        for (unsigned j = 0; j < 16; ++j) { const unsigned c = xb_ld(&bar[XB_XCNT(j)]); sum += c; cnt += (c > 0u) ? 1u : 0u; mine = (j == x) ? c : mine; }
        if (sum == G) break;
        __builtin_amdgcn_s_sleep(1);
        if ((++sp & 255u) == 0u) { if (xb_ld(&bar[XB_TMO])) break; if (sp > XB_SPIN_CAP) { atomicAdd(&bar[XB_TMO], 1u); break; } }
    }
    nloc = mine > 0u ? mine : 1u; nx = cnt > 0u ? cnt : 1u;
}
__device__ __forceinline__ void xcd_barrier(const XcdBarrier& b, const bool lead) {
    asm volatile("s_waitcnt vmcnt(0)" ::: "memory");
    __syncthreads();
    if (lead) {
        unsigned* bar = b.bar;
        __builtin_amdgcn_s_waitcnt(0);
        unsigned nloc = b.st[0], nx = b.st[1];
        if (nloc == 0u) { xcd_barrier_complete(bar, b.x, nloc, nx); b.st[0] = nloc; b.st[1] = nx; }
        const unsigned old = xb_add(&bar[XB_XSUB(b.x)], 1u);
        const unsigned gen = old / nloc;
        if (old + 1u == (gen + 1u) * nloc) {
            __builtin_amdgcn_fence(__ATOMIC_RELEASE, "agent");
            asm volatile("s_waitcnt vmcnt(0)" ::: "memory");
            const unsigned og = xb_add(&bar[XB_TOP], 1u);
            const unsigned tg = og / nx;
            if (og + 1u == (tg + 1u) * nx) xb_add(&bar[XB_TOPGEN], 1u);
            else XB_SPIN(xb_ld(&bar[XB_TOPGEN]) == tg, bar);
            __builtin_amdgcn_fence(__ATOMIC_ACQUIRE, "agent");
            xb_add(&bar[XB_XGEN(b.x)], 1u);
            asm volatile("s_waitcnt vmcnt(0)" ::: "memory");
        } else {
            XB_SPIN(xb_ld(&bar[XB_XGEN(b.x)]) == gen, bar);
            __builtin_amdgcn_fence(__ATOMIC_ACQUIRE, "agent");
            asm volatile("s_waitcnt vmcnt(0)" ::: "memory");
        }
    }
    __syncthreads();
}

struct Frame {
    LAS unsigned char* lds;
    volatile LAS unsigned* MISC;
    gu32* ctl;
    int tid, lane, wave;
    int vcu, G;
    const float *x, *mem, *g_attn, *g_mem, *w_in, *lamqk, *subg, *w_mkv, *w_out, *g_ffn, *w_r, *b_r, *w_gu, *b_gu, *w_dn, *b_dn, *g_fin;
    float* out; unsigned char* ws;
};

#define P0_LOAD(dst, itm) do { const int m_ = (itm) / ipm, r_ = (itm) % ipm, kb_ = r_ / nblk, nb_ = r_ % nblk; \
        const float* src_ = W + (size_t)m_ * K * N + (size_t)(64 * kb_ + (lane >> 5)) * N + 32 * nb_ + (lane & 31); \
        _Pragma("unroll") for (int i_ = 0; i_ < 32; ++i_) dst[i_] = __builtin_nontemporal_load(src_ + (size_t)(2 * i_) * N); } while (0)
template <bool F8, bool GAIN, class RowMap>
__device__ __forceinline__ void p0_transpose_all(const float* W, int K, int N, int nmat, void* WTv, const float* gk, float wscale, LAS float* scr, int gw, int NGW, int lane, RowMap rowmap) {
    asm volatile("" : "+v"(lane));
    const int nblk = N / 32, ipm = (K / 64) * nblk, total = nmat * ipm;
    if (gw >= total) return;
    LAS float* gl = scr + 64 * 33;
    if constexpr (GAIN) { for (int i = lane; i < K; i += 64) gl[i] = gk[i] * wscale; LDS_WAIT(); asm volatile("" ::: "memory"); }
#define P0_PROC(v, itm) do { const int m = (itm) / ipm, r = (itm) % ipm, k0 = 64 * (r / nblk), n0 = 32 * (r % nblk); \
        if constexpr (GAIN) { _Pragma("unroll") for (int i = 0; i < 32; ++i) v[i] *= gl[k0 + 2 * i + (lane >> 5)]; } \
        else if (F8) { _Pragma("unroll") for (int i = 0; i < 32; ++i) v[i] *= wscale; } \
        _Pragma("unroll") for (int i = 0; i < 32; ++i) scr[(2 * i + (lane >> 5)) * 33 + (lane & 31)] = v[i]; \
        LDS_WAIT(); asm volatile("" ::: "memory"); \
        const int c = lane & 7; \
        _Pragma("unroll") for (int j = 0; j < 4; ++j) { const int n = (lane >> 3) + 8 * j; const LAS float* s = scr + (8 * c) * 33 + n; \
            if constexpr (F8) { unsigned char* wt = (unsigned char*)WTv + (size_t)m * N * K; \
                v2u o; o.x = fp8x4(s[0 * 33], s[1 * 33], s[2 * 33], s[3 * 33]); o.y = fp8x4(s[4 * 33], s[5 * 33], s[6 * 33], s[7 * 33]); \
                __builtin_nontemporal_store(o, (GAS v2u*)(wt + (size_t)rowmap(n0 + n) * K + k0 + 8 * c)); } \
            else { bf16* wt = (bf16*)WTv + (size_t)m * N * K; \
                v4u o; o.x = pk2(s[0 * 33], s[1 * 33]); o.y = pk2(s[2 * 33], s[3 * 33]); o.z = pk2(s[4 * 33], s[5 * 33]); o.w = pk2(s[6 * 33], s[7 * 33]); \
                *(GAS v4u*)(wt + (size_t)rowmap(n0 + n) * K + k0 + 8 * c) = o; } } \
        LDS_WAIT(); asm volatile("" ::: "memory"); } while (0)
    float va[32], vb[32], vc[32];
    int it = gw;
    P0_LOAD(va, it); if (it + NGW < total) P0_LOAD(vb, it + NGW);
    for (;;) {
        if (it + 2 * NGW < total) P0_LOAD(vc, it + 2 * NGW);
        P0_PROC(va, it); it += NGW; if (it >= total) break;
        if (it + 2 * NGW < total) P0_LOAD(va, it + 2 * NGW);
        P0_PROC(vb, it); it += NGW; if (it >= total) break;
        if (it + 2 * NGW < total) P0_LOAD(vb, it + 2 * NGW);
        P0_PROC(vc, it); it += NGW; if (it >= total) break;
    }
#undef P0_PROC
}
#undef P0_LOAD
struct RowId { __device__ __forceinline__ int operator()(int n) const { return n; } };
struct RowGU { __device__ __forceinline__ int operator()(int n) const { const int f = n >> 1, u = n & 1; return ((f >> 7) << 8) + (u << 7) + (f & 127); } };

__device__ __forceinline__ void p0_x_rows4(Frame& F, const float* xrow, bf16* orow, float* rstd_out) {
    const GAS f32x4* xr = (const GAS f32x4*)xrow + F.lane;
    f32x4 v[16]; float s[4] = {0.f, 0.f, 0.f, 0.f};
#pragma unroll
    for (int j = 0; j < 16; ++j) v[j] = xr[64 * j];
#pragma unroll
    for (int j = 0; j < 16; ++j) s[j >> 2] += (v[j].x * v[j].x + v[j].y * v[j].y) + (v[j].z * v[j].z + v[j].w * v[j].w);
    GAS unsigned long long* o8 = (GAS unsigned long long*)orow + F.lane;
#pragma unroll
    for (int j = 0; j < 16; ++j) o8[64 * j] = (unsigned long long)pk2(v[j].x, v[j].y) | ((unsigned long long)pk2(v[j].z, v[j].w) << 32);
#pragma unroll
    for (int q = 0; q < 4; ++q) s[q] = wave_sum(s[q]);
    if (F.lane < 4) rstd_out[F.lane] = 1.f / sqrtf((F.lane == 0 ? s[0] : F.lane == 1 ? s[1] : F.lane == 2 ? s[2] : s[3]) * (1.f / D) + EPS);
}
__device__ __forceinline__ void p0_mkv_tile(Frame& F, int tile, bf16* mkv, const float* xsrc, bf16* xdst, float* rstd_out, int xstep) {
    const int mt = tile >> 4, nt = tile & 15, m0 = 32 * mt, n0 = 32 * nt, r = F.lane & 31, h = F.lane >> 5, kh = F.wave >> 2, tw = F.wave & 3;
    f32x16 acc = {}; float ss = 0.f;
    LAS float* blk = (LAS float*)(F.lds + RING_OFF + F.wave * 12288);
    LAS float* gl = (LAS float*)(F.lds + RING_OFF + 98304);
    for (int i = F.tid; i < D; i += NWAVES * 64) gl[i] = F.g_mem[i];
    __syncthreads();
    const float* msrc = F.mem + (size_t)(m0 + (F.lane >> 4)) * D + kh * 512 + 4 * (F.lane & 15);
    const float* wcol = F.w_mkv + (size_t)(8 * h + kh * 512) * 512 + n0 + r;
    f32x4 ma[8], mb[8]; float wa[32], wb[32];
#define MKV_LD(M, W, kk_) do { _Pragma("unroll") for (int i_ = 0; i_ < 8; ++i_) M[i_] = *(const f32x4*)(msrc + (size_t)(4 * i_) * D + (kk_)); \
        _Pragma("unroll") for (int s_ = 0; s_ < 4; ++s_) _Pragma("unroll") for (int j_ = 0; j_ < 8; ++j_) W[8 * s_ + j_] = wcol[(size_t)((kk_) + 16 * s_ + j_) * 512]; } while (0)
#define MKV_MM(M, W, kk_) do { _Pragma("unroll") for (int i_ = 0; i_ < 8; ++i_) *(LAS f32x4*)(blk + (4 * i_ + (F.lane >> 4)) * 68 + 4 * (F.lane & 15)) = M[i_]; \
        LDS_WAIT(); asm volatile("" ::: "memory"); \
        _Pragma("unroll") for (int s_ = 0; s_ < 4; ++s_) { const LAS float* ap_ = blk + r * 68 + 16 * s_ + 8 * h; const LAS float* gq_ = gl + kh * 512 + (kk_) + 16 * s_ + 8 * h; \
            const f32x4 a0 = *(const LAS f32x4*)ap_, a1 = *(const LAS f32x4*)(ap_ + 4), g0 = *(const LAS f32x4*)gq_, g1 = *(const LAS f32x4*)(gq_ + 4); \
            ss += (a0.x * a0.x + a0.y * a0.y) + (a0.z * a0.z + a0.w * a0.w) + (a1.x * a1.x + a1.y * a1.y) + (a1.z * a1.z + a1.w * a1.w); \
            v4u bw_; bw_.x = pk2(a0.x * g0.x, a0.y * g0.y); bw_.y = pk2(a0.z * g0.z, a0.w * g0.w); bw_.z = pk2(a1.x * g1.x, a1.y * g1.y); bw_.w = pk2(a1.z * g1.z, a1.w * g1.w); \
            v4u aw_; aw_.x = pk2(W[8 * s_], W[8 * s_ + 1]); aw_.y = pk2(W[8 * s_ + 2], W[8 * s_ + 3]); aw_.z = pk2(W[8 * s_ + 4], W[8 * s_ + 5]); aw_.w = pk2(W[8 * s_ + 6], W[8 * s_ + 7]); \
            acc = __builtin_amdgcn_mfma_f32_32x32x16_bf16(__builtin_bit_cast(bf16x8, aw_), __builtin_bit_cast(bf16x8, bw_), acc, 0, 0, 0); } \
        LDS_WAIT(); asm volatile("" ::: "memory"); } while (0)
    f32x4 xv[8];
#define X_LD(m_) do { const GAS f32x4* xr_ = (const GAS f32x4*)(xsrc + (size_t)(m_) * D) + F.lane; _Pragma("unroll") for (int j_ = 0; j_ < 8; ++j_) xv[j_] = __builtin_nontemporal_load(xr_ + 64 * j_); } while (0)
#define X_PROC(m_) do { float s0_ = 0.f, s1_ = 0.f; \
        _Pragma("unroll") for (int j_ = 0; j_ < 4; ++j_) { s0_ += (xv[j_].x * xv[j_].x + xv[j_].y * xv[j_].y) + (xv[j_].z * xv[j_].z + xv[j_].w * xv[j_].w); \
            s1_ += (xv[4 + j_].x * xv[4 + j_].x + xv[4 + j_].y * xv[4 + j_].y) + (xv[4 + j_].z * xv[4 + j_].z + xv[4 + j_].w * xv[4 + j_].w); } \
        GAS unsigned long long* o8_ = (GAS unsigned long long*)(xdst + (size_t)(m_) * D) + F.lane; \
        _Pragma("unroll") for (int j_ = 0; j_ < 8; ++j_) o8_[64 * j_] = (unsigned long long)pk2(xv[j_].x, xv[j_].y) | ((unsigned long long)pk2(xv[j_].z, xv[j_].w) << 32); \
        s0_ = wave_sum(s0_); s1_ = wave_sum(s1_); \
        if (F.lane < 2) rstd_out[(m_) + F.lane] = 1.f / sqrtf((F.lane == 0 ? s0_ : s1_) * (1.f / D) + EPS); } while (0)
    MKV_LD(ma, wa, 0);
    int xm = 0;
#pragma nounroll
    for (int kk = 0; kk < 512; kk += 128) {
        X_LD(xm); __builtin_amdgcn_sched_barrier(0);
        MKV_LD(mb, wb, kk + 64); MKV_MM(ma, wa, kk); __builtin_amdgcn_sched_barrier(0);
        X_PROC(xm); X_LD(xm + 2); __builtin_amdgcn_sched_barrier(0);
        MKV_LD(ma, wa, min(kk + 128, 448)); MKV_MM(mb, wb, kk + 64); __builtin_amdgcn_sched_barrier(0);
        X_PROC(xm + 2); xm += xstep;
    }
#undef X_LD
#undef X_PROC
#undef MKV_LD
#undef MKV_MM
    LAS float* xc = (LAS float*)(F.lds + RING_OFF + 8 * 16384 - 4 * 64 * 17 * 4) + (tw * 64 + F.lane) * 17;
    if (kh == 1) {
#pragma unroll
        for (int i = 0; i < 16; ++i) xc[i] = acc[i];
        xc[16] = ss; }
    __syncthreads();
    if (kh == 0) {
#pragma unroll
        for (int i = 0; i < 16; ++i) acc[i] += xc[i];
        ss += xc[16]; ss += __shfl_xor(ss, 32);
        const float rstd = 1.f / sqrtf(ss * (1.f / D) + EPS);
        bf16* orow = mkv + (size_t)(m0 + r) * 512 + n0 + 4 * h;
#pragma unroll
        for (int q = 0; q < 4; ++q) { v2u o; o.x = pk2(acc[4 * q] * rstd, acc[4 * q + 1] * rstd); o.y = pk2(acc[4 * q + 2] * rstd, acc[4 * q + 3] * rstd); *(GAS v2u*)(orow + 8 * q) = o; }
    }
    __syncthreads();
}
__device__ __forceinline__ void p0_prologue(Frame& F) {
    LAS float* scr = (LAS float*)(F.lds + RING_OFF + F.wave * 16384);
    const int gw = F.vcu * NWAVES + F.wave, NGW = F.G * NWAVES;
    bf16* win_t = (bf16*)(F.ws + WS_WIN); bf16* wout_t = (bf16*)(F.ws + WS_WOUT);
    bf16* xb = (bf16*)(F.ws + WS_XB); float* rstd1 = (float*)(F.ws + WS_RSTD1);
    p0_mkv_tile(F, (F.wave & 3) * 256 + F.vcu, (bf16*)(F.ws + WS_MKV), F.x + (size_t)(4 * gw) * D, xb + (size_t)(4 * gw) * D, rstd1 + 4 * gw, 4 * NGW);
    bf16* wrt = (bf16*)(F.ws + WS_WRT);
    if (gw < 1280) p0_transpose_all<false, true>(F.w_in, D, DIN, 1, win_t, F.g_attn, 1.f, scr, gw, NGW, F.lane, RowId());
    else if (gw < 1792) p0_transpose_all<false, false>(F.w_out, D, D, 1, wout_t, nullptr, 1.f, scr, gw - 1280, NGW, F.lane, RowId());
    else for (int i = (gw - 1792) * 64 + F.lane; i < D * NE; i += 256 * 64) { const int e = i >> 10, k = i & 1023; const float w = F.w_r[k * NE + e] * F.g_ffn[k]; const unsigned hb = f2bf(w); wrt[i] = (bf16)hb; wrt[D * NE + i] = (bf16)f2bf(w - bf2f((bf16)hb)); }
}

constexpr int NCONV = 8, NCONV_ALL = 8 * NCONV;
__device__ __forceinline__ void p0b_unit(Frame& F, int c) {
    LAS float* scr = (LAS float*)(F.lds + RING_OFF + F.wave * 16384);
    p0_transpose_all<true, true>(F.w_gu, D, 2 * DFF, NE, (void*)(F.ws + WS_WGU), F.g_ffn, WSCALE, scr, c * NWAVES + F.wave, NCONV_ALL * NWAVES, F.lane, RowGU());
    p0_transpose_all<true, false>(F.w_dn, DFF, D, NE, (void*)(F.ws + WS_WDN), nullptr, WSCALE, scr, c * NWAVES + F.wave, NCONV_ALL * NWAVES, F.lane, RowId());
    __syncthreads();
}

struct EpiInProj {
    bf16* O; const float* rstd; unsigned* nrm;
    __device__ __forceinline__ void operator()(const pg8::f32x4 (&acc)[2][2][4][2], const pg8::Unit& u, int wr, int wc, int fr, int fq, const LAS unsigned* ids) const {
        asm volatile("" : "+v"(fr), "+v"(fq));
        const int row0 = u.pm * 256 + wr * 64 + fr, col0 = u.pn * 256 + wc * 32 + 8 * fq;
        const float sc = (u.pn <= 1 || u.pn == 6 || u.pn == 9) ? QSCALE : 1.f;
        const LAS float* scl = (const LAS float*)(ids + 256);
        float rsv[2][4];
#pragma unroll
        for (int ai = 0; ai < 2; ++ai)
#pragma unroll
            for (int m = 0; m < 4; ++m) rsv[ai][m] = scl[wr * 64 + fr + ai * 128 + m * 16];
#pragma unroll
        for (int ai = 0; ai < 2; ++ai)
#pragma unroll
            for (int m = 0; m < 4; ++m) { const int row = row0 + ai * 128 + m * 16; const float rs = rsv[ai][m] * sc; bf16* rowp = O + (size_t)row * DIN + col0;
#pragma unroll
                for (int bj = 0; bj < 2; ++bj) { const pg8::f32x4 v0 = acc[ai][bj][m][0] * rs, v1 = acc[ai][bj][m][1] * rs;
                    v4u w; w.x = pg8::cvt_pk_bf16(v0[0], v0[1]); w.y = pg8::cvt_pk_bf16(v0[2], v0[3]); w.z = pg8::cvt_pk_bf16(v1[0], v1[1]); w.w = pg8::cvt_pk_bf16(v1[2], v1[3]);
                    *(v4u*)(rowp + bj * 128) = w; } }
        if (u.pn < 4) {
#pragma unroll
            for (int bj = 0; bj < 2; ++bj) { float mx = 0.f;
#pragma unroll
                for (int ai = 0; ai < 2; ++ai)
#pragma unroll
                    for (int m = 0; m < 4; ++m) { const float rs = rsv[ai][m] * sc; const pg8::f32x4 v0 = acc[ai][bj][m][0] * rs, v1 = acc[ai][bj][m][1] * rs;
                        float s = (v0[0] * v0[0] + v0[1] * v0[1]) + (v0[2] * v0[2] + v0[3] * v0[3]) + (v1[0] * v1[0] + v1[1] * v1[1]) + (v1[2] * v1[2] + v1[3] * v1[3]);
                        s += __shfl_xor(s, 16); s += __shfl_xor(s, 32); mx = fmaxf(mx, s); }
#pragma unroll
                for (int o = 1; o < 16; o <<= 1) mx = fmaxf(mx, __shfl_xor(mx, o));
                if ((fr | fq) == 0) atomicMax(nrm + (((u.pm >> 4) * 4 + u.pn) * 4 + 2 * bj + (wc >> 1)) * 2 + (wc & 1), __builtin_bit_cast(unsigned, mx)); }
        }
    }
};
__device__ __forceinline__ void attn_phase(Frame& F, char* shm, int qoff = 0, int gmask = 7) {
    using namespace attn_body;
    const attn_body::bf16* P = (const attn_body::bf16*)(F.ws + WS_P);
    attn_body::bf16* OD = (attn_body::bf16*)(F.ws + WS_OD);
    attn_body::bf16* mix = (attn_body::bf16*)(F.ws + WS_MIX);
    attn_body::bf16* ODIL = (attn_body::bf16*)(F.ws + WS_ODIL); float* LSEb = (float*)(F.ws + WS_LSE);
    const attn_body::bf16* MKV = (const attn_body::bf16*)(F.ws + WS_MKV);
    const float* nrm = (const float*)(F.ctl + CW_NRM);
    const int grp = (int)blockIdx.x & 7, b = grp;
    unsigned* qctr = (unsigned*)(F.ctl + CW_Q + qoff) + 64 * grp;
    const attn_body::bf16* Pb = P + (size_t)b * SEQ * DIN;
#define ATTN_LEAD() ({ int t_ = (int)threadIdx.x; asm volatile("" : "+v"(t_)); t_ == 0; })
    unsigned nxt_tok = 0u;
    if (ATTN_LEAD()) nxt_tok = __hip_atomic_fetch_add(qctr, 1u, __ATOMIC_RELAXED, __HIP_MEMORY_SCOPE_AGENT);
    for (;;) {
        if (ATTN_LEAD()) F.MISC[20] = nxt_tok;
        __syncthreads();
        int un = (int)F.MISC[20];
        __syncthreads();
        if (ATTN_LEAD() && un < NCONV + 384) nxt_tok = __hip_atomic_fetch_add(qctr, 1u, __ATOMIC_RELAXED, __HIP_MEMORY_SCOPE_AGENT);
        if (un < NCONV) { if (gmask == 7) p0b_unit(F, grp * NCONV + un); continue; }
        un -= NCONV;
        if (un >= 384) break;
        if (un < 128) {
            if (!(gmask & 1)) continue;
            const int qb = 15 - (un >> 3), h = 3 - ((un >> 1) & 3), j = un & 1;
            const float slope2 = exp2f(-(float)(2 * h + 1)) * LOG2E;
            const int ni = ((b * 4 + (h >> 1)) * 4 + 2 * (h & 1) + j) * 2;
            const float R = sqrtf((nrm[ni] + nrm[ni + 1]) * (nrm[ni + 16] + nrm[ni + 17])) * 1.01f;
            const float kfirst = (float)(qb * 256) - (2.f * R + 160.f) / slope2;
            int t0 = kfirst > 0.f ? (int)(kfirst * (1.f / 64.f)) : 0; t0 = min(t0, 4 * qb); t0 &= ~1;
            UnitP U; U.Q = Pb + C_DQ + h * 128 + j * 64; U.K = Pb + C_DK + h * 128 + j * 64; U.V = Pb + C_DV + h * 128;
            U.O = OD + (size_t)b * SEQ * 1024 + h * 256 + j * 128; U.qp = DIN; U.kp = DIN; U.op = 1024;
            U.q0 = qb * 256; U.t0 = t0; U.NT = 4 * qb + 4 - t0; U.slope2 = slope2; U.lse = nullptr; U.lse_stride = 0;
            attn_unit<32, true, false, true, false, 128>(U, shm);
        } else if (un < 320) {
            if (!(gmask & 2)) continue;
            const int du = un - 128, h = du / 48, idx = du % 48, n = idx >> 4, w = idx & 15;
            const int r = (n == 0) ? 1 : (n == 1 ? 4 : 16), c = (n == 0) ? 0 : (n == 1 ? (w >> 2) : w), blk = (n == 0) ? w : (n == 1 ? (w & 3) : 0);
            const attn_body::bf16* Pc = Pb + (size_t)c * DIN;
            UnitP U; U.Q = Pc + C_LQ + h * 64; U.K = Pc + C_LK + h * 64; U.V = Pc + C_LV + h * 64; U.qp = (long)r * DIN; U.kp = (long)r * DIN;
            U.O = ODIL + (size_t)n * T * 256 + ((size_t)b * SEQ + c) * 256 + h * 64; U.op = (long)r * 256;
            U.q0 = blk * 256; U.t0 = (blk == 0) ? 0 : 4 * blk - 2; U.NT = 4 * blk + 4 - U.t0;
            U.slope2 = exp2f(-(float)(2 * h + 2)) * (float)r * LOG2E;
            U.lse = LSEb + (size_t)n * T * 4 + ((size_t)b * SEQ + c) * 4 + h; U.lse_stride = r * 4;
            attn_unit<32, true, true, true, true>(U, shm);
        } else {
            if (!(gmask & 4)) continue;
            const int mu = un - 320, h = mu >> 4, qb = mu & 15;
            UnitP U; U.Q = Pb + C_MQ + h * 64; U.qp = DIN; U.K = MKV + (size_t)b * NMEM * 512 + h * 64; U.V = U.K + 256; U.kp = 512;
            U.O = mix + (size_t)b * SEQ * 1024 + 768 + h * 64; U.op = 1024; U.q0 = qb * 256; U.t0 = 0; U.NT = 4; U.slope2 = 0.f; U.lse = nullptr; U.lse_stride = 0;
            attn_unit<8, false, false, false, false>(U, shm);
        }
    }
}
#undef ATTN_LEAD
__device__ __forceinline__ void dil_combine_phase(Frame& F) {
    const int gw = F.vcu * NWAVES + F.wave, NGW = F.G * NWAVES;
    const bf16* OD = (const bf16*)(F.ws + WS_OD); const bf16* ODIL = (const bf16*)(F.ws + WS_ODIL); const float* LSEb = (const float*)(F.ws + WS_LSE); bf16* mix = (bf16*)(F.ws + WS_MIX);
    const int h = F.lane >> 4, pt = F.lane & 15, d4 = pt * 4;
    float lam;
    { const float a = F.lamqk[F.lane] * F.lamqk[64 + F.lane], c = F.lamqk[128 + F.lane] * F.lamqk[192 + F.lane];
      lam = __expf(wave_sum(a)) - __expf(wave_sum(c)) + 0.2f; }
    float gsub[8];
#pragma unroll
    for (int i = 0; i < 8; ++i) gsub[i] = F.subg[pt * 8 + i] * 0.8f;
    for (int row0 = 4 * gw; row0 < T; row0 += 4 * NGW) {
        float l[4][3]; v2u q[4][3]; v4u o1[4], o2[4];
#pragma unroll
        for (int i = 0; i < 4; ++i) {
            o1[i] = __builtin_nontemporal_load((const v4u*)(OD + (size_t)(row0 + i) * 1024 + h * 256 + pt * 8)); o2[i] = __builtin_nontemporal_load((const v4u*)(OD + (size_t)(row0 + i) * 1024 + h * 256 + 128 + pt * 8));
#pragma unroll
            for (int n = 0; n < 3; ++n) { l[i][n] = LSEb[(size_t)n * T * 4 + (size_t)(row0 + i) * 4 + h]; q[i][n] = __builtin_nontemporal_load((const v2u*)(ODIL + (size_t)n * T * 256 + (size_t)(row0 + i) * 256 + h * 64 + d4)); } }
#pragma unroll
        for (int i = 0; i < 4; ++i) {
            const unsigned aw[4] = {o1[i].x, o1[i].y, o1[i].z, o1[i].w}, bw[4] = {o2[i].x, o2[i].y, o2[i].z, o2[i].w};
            float d[8], ss = 0.f;
#pragma unroll
            for (int c = 0; c < 4; ++c) { d[2 * c] = bflo(aw[c]) - lam * bflo(bw[c]); d[2 * c + 1] = bfhi(aw[c]) - lam * bfhi(bw[c]); ss += d[2 * c] * d[2 * c] + d[2 * c + 1] * d[2 * c + 1]; }
#pragma unroll
            for (int o = 1; o < 16; o <<= 1) ss += __shfl_xor(ss, o);
            const float rstd = 1.f / sqrtf(ss * (1.f / 128.f) + EPS);
            v4u od; od.x = pk2(d[0] * rstd * gsub[0], d[1] * rstd * gsub[1]); od.y = pk2(d[2] * rstd * gsub[2], d[3] * rstd * gsub[3]); od.z = pk2(d[4] * rstd * gsub[4], d[5] * rstd * gsub[5]); od.w = pk2(d[6] * rstd * gsub[6], d[7] * rstd * gsub[7]);
            *(v4u*)(mix + (size_t)(row0 + i) * 1024 + h * 128 + pt * 8) = od;
            const float m = fmaxf(fmaxf(l[i][0], l[i][1]), l[i][2]);
            float wn[3], den = 0.f;
#pragma unroll
            for (int n = 0; n < 3; ++n) { wn[n] = exp2f(l[i][n] - m); den += wn[n]; }
            const float inv = 1.f / den; float o[4] = {0.f, 0.f, 0.f, 0.f};
#pragma unroll
            for (int n = 0; n < 3; ++n) { const float wq = wn[n] * inv; o[0] += wq * bflo(q[i][n].x); o[1] += wq * bfhi(q[i][n].x); o[2] += wq * bflo(q[i][n].y); o[3] += wq * bfhi(q[i][n].y); }
            v2u ov; ov.x = pk2(o[0], o[1]); ov.y = pk2(o[2], o[3]);
            *(v2u*)(mix + (size_t)(row0 + i) * 1024 + 512 + h * 64 + d4) = ov;
        }
    }
}
struct EpiY {
    bf16* Y;
    __device__ __forceinline__ void operator()(const pg8::f32x4 (&acc)[2][2][4][2], const pg8::Unit& u, int wr, int wc, int fr, int fq, const LAS unsigned*) const {
        asm volatile("" : "+v"(fr), "+v"(fq));
        const int row0 = u.pm * 256 + wr * 64 + fr, col0 = u.pn * 256 + wc * 32 + 8 * fq;
#pragma unroll
        for (int ai = 0; ai < 2; ++ai)
#pragma unroll
            for (int m = 0; m < 4; ++m) { bf16* rowp = Y + (size_t)(row0 + ai * 128 + m * 16) * D + col0;
#pragma unroll
                for (int bj = 0; bj < 2; ++bj) { const pg8::f32x4 v0 = acc[ai][bj][m][0], v1 = acc[ai][bj][m][1];
                    v4u w; w.x = pg8::cvt_pk_bf16(v0[0], v0[1]); w.y = pg8::cvt_pk_bf16(v0[2], v0[3]); w.z = pg8::cvt_pk_bf16(v1[0], v1[1]); w.w = pg8::cvt_pk_bf16(v1[2], v1[3]);
                    *(v4u*)(rowp + bj * 128) = w; } }
    }
};

__device__ __forceinline__ void route_phase(Frame& F) {
    LAS char* XH = (LAS char*)(F.lds + RING_OFF); LAS char* XL = XH + 32768; LAS char* WH = XH + 65536; LAS char* WL = XH + 73728;
    LAS float* xch = (LAS float*)(XH + 81920);
    LAS float* ssl = (LAS float*)(XH + 81920 + 17408);
    LAS unsigned* lcnt = (LAS unsigned*)(F.lds + LCNT_OFF);
    LAS unsigned* stg = (LAS unsigned*)(F.lds + STG_OFF);
    if (F.tid < 64) lcnt[F.tid] = 0u;
    const int lane = F.lane, tl = lane & 31, h = lane >> 5, tg = F.wave & 3, kh = F.wave >> 2;
    const int srow = F.tid >> 5, k4 = (F.tid & 31) * 4, T0 = F.vcu * 128;
    const bf16* xg = (const bf16*)(F.ws + WS_XB) + (size_t)(T0 + srow) * D + k4;
    const bf16* yg = (const bf16*)(F.ws + WS_Y) + (size_t)(T0 + srow) * D + k4;
    unsigned char* x1q = (unsigned char*)(F.ws + WS_X1B) + (size_t)(T0 + srow) * D + k4;
    bf16* x1h = (bf16*)(F.ws + WS_X1H) + (size_t)(T0 + srow) * D + k4;
    const bf16* wsrc = (const bf16*)(F.ws + WS_WRT);
    v2u xv[8]; v2u yv[8]; v4u wv[2]; float ssr[8];
#pragma unroll
    for (int i = 0; i < 8; ++i) ssr[i] = 0.f;
#define RT_LOAD(kc) do { _Pragma("unroll") for (int i_ = 0; i_ < 8; ++i_) { xv[i_] = __builtin_nontemporal_load((const v2u*)(xg + (size_t)(16 * i_) * D + 128 * (kc))); yv[i_] = __builtin_nontemporal_load((const v2u*)(yg + (size_t)(16 * i_) * D + 128 * (kc))); } \
        _Pragma("unroll") for (int j_ = 0; j_ < 2; ++j_) { const int idx_ = F.tid + 512 * j_; wv[j_] = *(const v4u*)(wsrc + (idx_ >> 9) * 32768 + ((idx_ >> 4) & 31) * 1024 + 128 * (kc) + (idx_ & 15) * 8); } } while (0)
    f32x16 acc = {};
    RT_LOAD(0);
    for (int kc = 0; kc < 8; ++kc) {
#pragma unroll
        for (int i = 0; i < 8; ++i) {
            const float x0 = bflo(xv[i].x) + bflo(yv[i].x), x1 = bfhi(xv[i].x) + bfhi(yv[i].x), x2 = bflo(xv[i].y) + bflo(yv[i].y), x3 = bfhi(xv[i].y) + bfhi(yv[i].y);
            ssr[i] += (x0 * x0 + x1 * x1) + (x2 * x2 + x3 * x3);
            const unsigned h0 = pk2(x0, x1), h1 = pk2(x2, x3), l0 = pk2(x0 - bflo(h0), x1 - bfhi(h0)), l1 = pk2(x2 - bflo(h1), x3 - bfhi(h1));
            *(unsigned*)(x1q + (size_t)(16 * i) * D + 128 * kc) = fp8x4(x0, x1, x2, x3);
            __builtin_nontemporal_store((v2u){h0, h1}, (v2u*)(x1h + (size_t)(16 * i) * D + 128 * kc));
            const int row = srow + 16 * i, off = row * 256 + (((k4 >> 3) ^ (row & 15)) << 4) + (k4 & 4) * 2;
            *(LAS v2u*)(XH + off) = (v2u){h0, h1}; *(LAS v2u*)(XL + off) = (v2u){l0, l1};
        }
#pragma unroll
        for (int j = 0; j < 2; ++j) { const int idx = F.tid + 512 * j, e = (idx >> 4) & 31, c = idx & 15; *(LAS v4u*)(((idx >> 9) ? WL : WH) + e * 256 + ((c ^ (e & 15)) << 4)) = wv[j]; }
        __syncthreads();
        if (kc < 7) RT_LOAD(kc + 1);
#pragma unroll
        for (int s = 0; s < 4; ++s) { const int c16 = 2 * (4 * kh + s) + h, tr = tg * 32 + tl;
            const v4u xh = *(const LAS v4u*)(XH + tr * 256 + ((c16 ^ (tr & 15)) << 4)), xl = *(const LAS v4u*)(XL + tr * 256 + ((c16 ^ (tr & 15)) << 4));
            const v4u wh = *(const LAS v4u*)(WH + tl * 256 + ((c16 ^ (tl & 15)) << 4)), wl2 = *(const LAS v4u*)(WL + tl * 256 + ((c16 ^ (tl & 15)) << 4));
            acc = __builtin_amdgcn_mfma_f32_32x32x16_bf16(__builtin_bit_cast(bf16x8, wh), __builtin_bit_cast(bf16x8, xh), acc, 0, 0, 0);
            acc = __builtin_amdgcn_mfma_f32_32x32x16_bf16(__builtin_bit_cast(bf16x8, wh), __builtin_bit_cast(bf16x8, xl), acc, 0, 0, 0);
            acc = __builtin_amdgcn_mfma_f32_32x32x16_bf16(__builtin_bit_cast(bf16x8, wl2), __builtin_bit_cast(bf16x8, xh), acc, 0, 0, 0); }
        __syncthreads();
    }
#undef RT_LOAD
#pragma unroll
    for (int i = 0; i < 8; ++i) { float s = ssr[i];
#pragma unroll
        for (int o = 1; o < 32; o <<= 1) s += __shfl_xor(s, o);
        if ((F.tid & 31) == 0) ssl[srow + 16 * i] = s; }
    const int tok = T0 + tg * 32 + tl; float ss = 0.f;
    if (kh == 1) { LAS float* d = xch + (tg * 64 + lane) * 17;
#pragma unroll
        for (int i = 0; i < 16; ++i) d[i] = acc[i];
        d[16] = ss; }
    __syncthreads();
    if (kh == 0) {
        const LAS float* d = xch + (tg * 64 + lane) * 17;
#pragma unroll
        for (int i = 0; i < 16; ++i) acc[i] += d[i];
        ss = ssl[tg * 32 + tl];
        const float rstd = 1.f / sqrtf(ss * (1.f / D) + EPS);
        float lg[16];
#pragma unroll
        for (int i = 0; i < 16; ++i) lg[i] = acc[i] * rstd + F.b_r[4 * h + (i & 3) + 8 * (i >> 2)];
        float cv[8]; int ce[8];
#pragma unroll
        for (int k = 0; k < 4; ++k) { float bv = -INFINITY; int bi = 0;
#pragma unroll
            for (int i = 0; i < 16; ++i) { if (lg[i] > bv) { bv = lg[i]; bi = i; } }
            cv[k] = bv; ce[k] = 4 * h + (bi & 3) + 8 * (bi >> 2);
#pragma unroll
            for (int i = 0; i < 16; ++i) if (i == bi) lg[i] = -INFINITY; }
#pragma unroll
        for (int k = 0; k < 4; ++k) { cv[4 + k] = __shfl_xor(cv[k], 32); ce[4 + k] = __shfl_xor(ce[k], 32); }
        float tv[4]; int te[4];
#pragma unroll
        for (int k = 0; k < 4; ++k) { float bv = -INFINITY; int be = 64, bi = 0;
#pragma unroll
            for (int i = 0; i < 8; ++i) { if (cv[i] > bv || (cv[i] == bv && ce[i] < be)) { bv = cv[i]; be = ce[i]; bi = i; } }
            tv[k] = bv; te[k] = be;
#pragma unroll
            for (int i = 0; i < 8; ++i) if (i == bi) cv[i] = -INFINITY; }
        float gk[4], den = 0.f;
#pragma unroll
        for (int k = 0; k < 4; ++k) { gk[k] = __expf(tv[k] - tv[0]); den += gk[k]; }
        const float inv = 1.f / den;
        if (h == 0) {
#pragma unroll
            for (int k = 0; k < 4; ++k) {
                const unsigned rank = __hip_atomic_fetch_add(lcnt + te[k], 1u, __ATOMIC_RELAXED, __HIP_MEMORY_SCOPE_WORKGROUP);
                const int slot = (tg * 32 + tl) * 4 + k;
                stg[slot * 4] = (unsigned)(tok * 4 + k); stg[slot * 4 + 1] = ((unsigned)te[k] << 16) | rank; stg[slot * 4 + 2] = __builtin_bit_cast(unsigned, gk[k] * inv); stg[slot * 4 + 3] = __builtin_bit_cast(unsigned, rstd);
            }
        }
    }
    __syncthreads();
    if (F.tid < 32) { const unsigned n = lcnt[F.tid]; lcnt[32 + F.tid] = n ? __hip_atomic_fetch_add((unsigned*)(F.ctl + CW_CNT) + F.tid, n, __ATOMIC_RELAXED, __HIP_MEMORY_SCOPE_AGENT) : 0u; }
    __syncthreads();
    { unsigned* list = (unsigned*)(F.ws + WS_LIST); unsigned* lgate = (unsigned*)(F.ws + WS_LGATE); unsigned* lrstd = (unsigned*)(F.ws + WS_LRSTD);
      const unsigned ent = stg[F.tid * 4], er = stg[F.tid * 4 + 1], gb = stg[F.tid * 4 + 2], rb = stg[F.tid * 4 + 3]; const unsigned e = er >> 16, rank = er & 0xffffu;
      const size_t at = (size_t)e * LCAP + lcnt[32 + e] + rank; list[at] = ent; lgate[at] = gb; lrstd[at] = rb; }
    __syncthreads();
}

__device__ __forceinline__ int moe_build_table(Frame& F) {
    LAS unsigned* tbl = (LAS unsigned*)(F.lds + TBL_OFF); LAS unsigned* lcnt = (LAS unsigned*)(F.lds + LCNT_OFF);
    if (F.wave == 0) {
        const int e = F.lane & 31;
        const unsigned cnt = __hip_atomic_load((unsigned*)(F.ctl + CW_CNT) + e, __ATOMIC_RELAXED, __HIP_MEMORY_SCOPE_AGENT);
        const unsigned nt = (cnt + 255u) >> 8; unsigned incl = nt;
#pragma unroll
        for (int o = 1; o < 32; o <<= 1) { const unsigned t = __shfl_up(incl, o); if ((F.lane & 31) >= o) incl += t; }
        if (F.lane < 32) { lcnt[e] = cnt; const unsigned start = incl - nt; for (unsigned j = 0; j < nt; ++j) tbl[start + j] = ((unsigned)e << 16) | j; if (F.lane == 31) F.MISC[16] = incl; }
    }
    __syncthreads();
    return (int)F.MISC[16];
}
struct MoeOrder {
    const LAS unsigned* tbl; const LAS unsigned* lcnt; const unsigned* list; int NMT, G, c, NPN, MPER, RB; size_t bexp; bool a_tiles; const unsigned* lsc; const unsigned* bias; int bexp_f;
    __device__ __forceinline__ bool next(int i, pg8::Unit& u) const {
        const int L = i * G + c, blk = L >> 5, w = L & 31, g = (NPN == 8) ? blk * 4 + (w >> 3) : blk * 8 + (w >> 2), pn = (NPN == 8) ? (w & 7) : (w & 3);
        if (g >= NMT) return false;
        const unsigned t = tbl[g]; const int e = (int)(t >> 16), mt = (int)(t & 0xffffu); const int cnt = (int)lcnt[e];
        u.pm = g; u.pn = pn; u.e = e; u.mt = mt; u.valid = min(256, cnt - mt * 256);
        u.aoff = a_tiles ? (size_t)g * (size_t)(256 * RB) : (size_t)0; u.boff = (size_t)e * bexp + (size_t)pn * (size_t)(256 * RB);
        return true;
    }
    __device__ __forceinline__ const unsigned* id_src(const pg8::Unit& u, int row) const { return list + (size_t)u.e * LCAP + u.mt * 256 + min(row, u.valid - 1); }
    __device__ __forceinline__ const unsigned* sc_src(const pg8::Unit& u, int row) const { return lsc + (size_t)u.e * LCAP + u.mt * 256 + min(row, u.valid - 1); }
    __device__ __forceinline__ const unsigned* bias_src(const pg8::Unit& u, int col) const { return bias + (size_t)u.e * bexp_f + u.pn * 256 + col; }
};
struct EpiGU {
    unsigned char* ACT;
    __device__ __forceinline__ void operator()(const pg8::f32x4 (&acc)[2][2][4][2], const pg8::Unit& u, int wr, int wc, int fr, int fq, const LAS unsigned* ids) const {
        asm volatile("" : "+v"(fr), "+v"(fq));
        typedef float f2 __attribute__((ext_vector_type(2)));
        constexpr float CG = 1.702f * LOG2E, KA = ASCALE / CG;
        const int r0 = wr * 64 + fr, f0 = u.pn * 128 + wc * 32 + 8 * fq;
        const LAS float* scl = (const LAS float*)(ids + 256); const LAS float* bl = (const LAS float*)(ids + 512) + 2 * (wc * 32 + 8 * fq);
        float rs[2][4];
#pragma unroll
        for (int ai = 0; ai < 2; ++ai)
#pragma unroll
            for (int m = 0; m < 4; ++m) rs[ai][m] = scl[r0 + ai * 128 + m * 16] * (1.f / WSCALE);
        const pg8::f32x4 b0 = *(const LAS pg8::f32x4*)bl, b1 = *(const LAS pg8::f32x4*)(bl + 4), b2 = *(const LAS pg8::f32x4*)(bl + 8), b3 = *(const LAS pg8::f32x4*)(bl + 12);
        const f2 gb[4] = {f2{b0[0], b0[2]} * CG, f2{b1[0], b1[2]} * CG, f2{b2[0], b2[2]} * CG, f2{b3[0], b3[2]} * CG}, ub[4] = {f2{b0[1], b0[3]}, f2{b1[1], b1[3]}, f2{b2[1], b2[3]}, f2{b3[1], b3[3]}};
#pragma unroll
        for (int ai = 0; ai < 2; ++ai)
#pragma unroll
            for (int m = 0; m < 4; ++m) { const int r = r0 + ai * 128 + m * 16; const float s = rs[ai][m], sg = s * CG; f2 a[4];
#pragma unroll
                for (int q = 0; q < 4; ++q) { const int n = q >> 1, j = 2 * (q & 1);
                    f2 g = f2{acc[ai][0][m][n][j], acc[ai][0][m][n][j + 1]} * sg + gb[q], up = f2{acc[ai][1][m][n][j], acc[ai][1][m][n][j + 1]} * s + ub[q];
                    g.x = fminf(g.x, 7.f * CG); g.y = fminf(g.y, 7.f * CG); up.x = __builtin_amdgcn_fmed3f(up.x, -7.f, 7.f); up.y = __builtin_amdgcn_fmed3f(up.y, -7.f, 7.f);
                    f2 d = f2{__builtin_amdgcn_exp2f(-g.x), __builtin_amdgcn_exp2f(-g.y)} + 1.f;
                    const f2 rc = f2{__builtin_amdgcn_rcpf(d.x), __builtin_amdgcn_rcpf(d.y)};
                    a[q] = ((up * KA + KA) * g) * rc; }
                v2u w; w.x = (unsigned)__builtin_amdgcn_cvt_pk_fp8_f32(a[1].x, a[1].y, __builtin_amdgcn_cvt_pk_fp8_f32(a[0].x, a[0].y, 0, false), true);
                w.y = (unsigned)__builtin_amdgcn_cvt_pk_fp8_f32(a[3].x, a[3].y, __builtin_amdgcn_cvt_pk_fp8_f32(a[2].x, a[2].y, 0, false), true);
                *(v2u*)(ACT + (size_t)(u.pm * 256 + r) * DFF + f0) = w; }
    }
};
struct EpiDown {
    unsigned char* YB;
    __device__ __forceinline__ void operator()(const pg8::f32x4 (&acc)[2][2][4][2], const pg8::Unit& u, int wr, int wc, int fr, int fq, const LAS unsigned* ids) const {
        asm volatile("" : "+v"(fr), "+v"(fq));
        const int r0 = wr * 64 + fr, cl = wc * 32 + 8 * fq, col0 = u.pn * 256 + cl;
        const LAS float* scl = (const LAS float*)(ids + 256); const LAS float* bl = (const LAS float*)(ids + 512) + cl;
        pg8::f32x4 bv[2][2];
#pragma unroll
        for (int bj = 0; bj < 2; ++bj)
#pragma unroll
            for (int n = 0; n < 2; ++n) bv[bj][n] = *(const LAS pg8::f32x4*)(bl + bj * 128 + 4 * n);
#pragma unroll
        for (int ai = 0; ai < 2; ++ai)
#pragma unroll
            for (int m = 0; m < 4; ++m) { const int r = r0 + ai * 128 + m * 16; if (r < u.valid) { const float g = scl[r] * YSCALE; unsigned char* yp = YB + (size_t)ids[r] * D + col0;
#pragma unroll
                for (int bj = 0; bj < 2; ++bj) { const pg8::f32x4 v0 = (acc[ai][bj][m][0] * (1.f / (WSCALE * ASCALE)) + bv[bj][0]) * g, v1 = (acc[ai][bj][m][1] * (1.f / (WSCALE * ASCALE)) + bv[bj][1]) * g;
                    v2u w; w.x = fp8x4(v0[0], v0[1], v0[2], v0[3]); w.y = fp8x4(v1[0], v1[1], v1[2], v1[3]);
                    *(v2u*)(yp + bj * 128) = w; } } }
    }
};
__device__ __forceinline__ void final_phase(Frame& F) {
    const int gw = F.vcu * NWAVES + F.wave, NGW = F.G * NWAVES;
    const unsigned char* YB = (const unsigned char*)(F.ws + WS_YB); const bf16* X1 = (const bf16*)(F.ws + WS_X1H);
    const int c = 4 * F.lane;
    f32x4 gf[4];
#pragma unroll
    for (int q = 0; q < 4; ++q) gf[q] = *(const f32x4*)(F.g_fin + c + 256 * q);
    for (int t0 = 2 * gw; t0 < T; t0 += 2 * NGW) {
        v2u xa[2][4]; unsigned y[2][4][4];
#pragma unroll
        for (int u = 0; u < 2; ++u) {
#pragma unroll
            for (int q = 0; q < 4; ++q) xa[u][q] = __builtin_nontemporal_load((const v2u*)(X1 + (size_t)(t0 + u) * D + c + 256 * q));
#pragma unroll
            for (int k = 0; k < 4; ++k)
#pragma unroll
                for (int q = 0; q < 4; ++q) y[u][k][q] = __builtin_nontemporal_load((const unsigned*)(YB + ((size_t)(t0 + u) * 4 + k) * D + c + 256 * q)); }
#pragma unroll
        for (int u = 0; u < 2; ++u) {
            float v[16];
#pragma unroll
            for (int q = 0; q < 4; ++q) { v[4 * q] = bflo(xa[u][q].x); v[4 * q + 1] = bfhi(xa[u][q].x); v[4 * q + 2] = bflo(xa[u][q].y); v[4 * q + 3] = bfhi(xa[u][q].y); }
#pragma unroll
            for (int k = 0; k < 4; ++k)
#pragma unroll
                for (int q = 0; q < 4; ++q) { const auto lo = __builtin_amdgcn_cvt_pk_f32_fp8((int)y[u][k][q], false), hi = __builtin_amdgcn_cvt_pk_f32_fp8((int)y[u][k][q], true);
                    v[4 * q] += lo[0] * (1.f / YSCALE); v[4 * q + 1] += lo[1] * (1.f / YSCALE); v[4 * q + 2] += hi[0] * (1.f / YSCALE); v[4 * q + 3] += hi[1] * (1.f / YSCALE); }
            float ss = 0.f;
#pragma unroll
            for (int i = 0; i < 16; ++i) ss += v[i] * v[i];
            const float rstd = 1.f / sqrtf(wave_sum(ss) * (1.f / D) + EPS);
#pragma unroll
            for (int q = 0; q < 4; ++q) { f32x4 o; o.x = v[4 * q] * rstd * gf[q].x; o.y = v[4 * q + 1] * rstd * gf[q].y; o.z = v[4 * q + 2] * rstd * gf[q].z; o.w = v[4 * q + 3] * rstd * gf[q].w;
                __builtin_nontemporal_store(o, (f32x4*)(F.out + (size_t)(t0 + u) * D + c + 256 * q)); }
        }
    }
}
struct Args { const float* in[17]; float* out; unsigned char* ws; int ph_lo, ph_hi, use_bar, pad; };
__global__ void __launch_bounds__(NWAVES * 64, 2) mk_fwd(Args args) {
    extern __shared__ __attribute__((aligned(16))) unsigned char lds[];
    Frame F;
    F.lds = (LAS unsigned char*)lds;
    F.MISC = (volatile LAS unsigned*)(F.lds + MISC_OFF);
    F.tid = threadIdx.x; F.lane = F.tid & 63; F.wave = __builtin_amdgcn_readfirstlane(F.tid >> 6);
    const bool lead = F.tid == 0;
#define FRESH() do { F.lane = mk_lane(); F.tid = F.wave * 64 + F.lane; } while (0)
    F.G = gridDim.x; { const int bx = blockIdx.x; F.vcu = (F.G % 8 == 0) ? (bx % 8) * (F.G / 8) + bx / 8 : bx; }
    F.ws = args.ws; F.out = args.out; F.ctl = (gu32*)(args.ws + WS_CTL);
    F.x = args.in[0]; F.mem = args.in[1]; F.g_attn = args.in[2]; F.g_mem = args.in[3]; F.w_in = args.in[4]; F.lamqk = args.in[5]; F.subg = args.in[6]; F.w_mkv = args.in[7];
    F.w_out = args.in[8]; F.g_ffn = args.in[9]; F.w_r = args.in[10]; F.b_r = args.in[11]; F.w_gu = args.in[12]; F.b_gu = args.in[13]; F.w_dn = args.in[14]; F.b_dn = args.in[15]; F.g_fin = args.in[16];
    for (int u = F.tid; u < (LDS_BYTES - LDSCTL_OFF) / 4; u += NWAVES * 64) ((LAS unsigned*)(F.lds + LDSCTL_OFF))[u] = 0u;
    __syncthreads();
    XcdBarrier bar; bar.bar = (unsigned*)(F.ctl + CW_BAR); bar.x = 0; bar.st = nullptr;
    if (args.use_bar) bar = xcd_barrier_post((unsigned*)(F.ctl + CW_BAR), F.MISC + 8, lead);
    const int lo = args.ph_lo, hi = args.ph_hi;
#define IN(k) (lo <= (k) && (k) < hi)
#define SEAM(k) do { if (IN(k) && IN((k) + 1)) xcd_barrier(bar, lead); } while (0)
    if (IN(0)) { p0_prologue(F); } SEAM(0);
    if (IN(1)) {
        pg8::Gemm g{(const void*)(F.ws + WS_XB), (const void*)(F.ws + WS_WIN), 2 * D, 128}; pg8::StaticOrder S; S.init(T, DIN, 2 * D, F.G, (int)blockIdx.x, (const unsigned*)(F.ws + WS_RSTD1));
        EpiInProj E{(bf16*)(F.ws + WS_P), (const float*)(F.ws + WS_RSTD1), (unsigned*)(F.ctl + CW_NRM)};
        pg8::gemm_phase<EpiInProj, pg8::StaticOrder, true, false, true>(F.lds + RING_OFF, (LAS unsigned*)(F.lds + IDB_OFF), g, S, E, F.tid);
    } SEAM(1);
    if (IN(2)) { attn_phase(F, (char*)lds + RING_OFF); } SEAM(2);
    if (IN(3)) { FRESH(); dil_combine_phase(F); } SEAM(3);
    if (IN(4)) { FRESH();
        pg8::Gemm g{(const void*)(F.ws + WS_MIX), (const void*)(F.ws + WS_WOUT), 2 * D, 128}; pg8::StaticOrder S; S.init(T, D, 2 * D, F.G, (int)blockIdx.x);
        EpiY E{(bf16*)(F.ws + WS_Y)};
        pg8::gemm_phase<EpiY, pg8::StaticOrder, true, false, false>(F.lds + RING_OFF, (LAS unsigned*)(F.lds + IDB_OFF), g, S, E, F.tid);
    } SEAM(4);
    if (IN(5)) { FRESH(); route_phase(F); } SEAM(5);
    if (IN(6)) { FRESH();
        const int nmt = moe_build_table(F);
        pg8::Gemm g{(const void*)(F.ws + WS_X1B), (const void*)(F.ws + WS_WGU), D, 128};
        MoeOrder S{(const LAS unsigned*)(F.lds + TBL_OFF), (const LAS unsigned*)(F.lds + LCNT_OFF), (const unsigned*)(F.ws + WS_LIST), nmt, F.G, F.vcu, 8, 4, D, (size_t)2 * DFF * D, false, (const unsigned*)(F.ws + WS_LRSTD), (const unsigned*)F.b_gu, 2 * DFF};
        EpiGU E{(unsigned char*)(F.ws + WS_ACT)};
        pg8::gemm_phase<EpiGU, MoeOrder, true, true, true, true>(F.lds + RING_OFF, (LAS unsigned*)(F.lds + IDB_OFF), g, S, E, F.tid);
    } SEAM(6);
    if (IN(7)) { FRESH();
        const int nmt = moe_build_table(F);
        pg8::Gemm g{(const void*)(F.ws + WS_ACT), (const void*)(F.ws + WS_WDN), DFF, 128};
        MoeOrder S{(const LAS unsigned*)(F.lds + TBL_OFF), (const LAS unsigned*)(F.lds + LCNT_OFF), (const unsigned*)(F.ws + WS_LIST), nmt, F.G, F.vcu, 4, 8, DFF, (size_t)D * DFF, true, (const unsigned*)(F.ws + WS_LGATE), (const unsigned*)F.b_dn, D};
        EpiDown E{(unsigned char*)(F.ws + WS_YB)};
        pg8::gemm_phase<EpiDown, MoeOrder, true, true, true, true, true>(F.lds + RING_OFF, (LAS unsigned*)(F.lds + IDB_OFF), g, S, E, F.tid);
    } SEAM(7);
    if (IN(8)) { FRESH(); final_phase(F); }
#undef IN
#undef FRESH
#undef SEAM
}

static void launch_phases(const Args& base, int lo, int hi, int use_bar, int grid, hipStream_t stream) {
    Args a = base; a.ph_lo = lo; a.ph_hi = hi; a.use_bar = use_bar;
    hipLaunchKernelGGL(mk_fwd, dim3(grid), dim3(NWAVES * 64), LDS_BYTES, stream, a);
}
extern "C" void kernel_launch(void* const* d_in, const int* in_sizes, int n_in, void* d_out, int out_size, void* d_ws, size_t ws_size, hipStream_t stream) {
    static int grid = 0;
    if (grid == 0) {
        if (n_in != 17 || in_sizes[0] != T * D || out_size != T * D || ws_size < (size_t)1000 * MiB) { fprintf(stderr, "kernel_launch: unexpected shapes / workspace (%d inputs, ws %zu)\n", n_in, ws_size); grid = -1; return; }
        int dev = 0, cus = 0, per_cu = 0;
        if (hipGetDevice(&dev) != hipSuccess || hipDeviceGetAttribute(&cus, hipDeviceAttributeMultiprocessorCount, dev) != hipSuccess) { grid = -1; return; }
        if (hipFuncSetAttribute((const void*)mk_fwd, hipFuncAttributeMaxDynamicSharedMemorySize, LDS_BYTES) != hipSuccess) { fprintf(stderr, "kernel_launch: hipFuncSetAttribute failed\n"); grid = -1; return; }
        if (hipOccupancyMaxActiveBlocksPerMultiprocessor(&per_cu, (const void*)mk_fwd, NWAVES * 64, LDS_BYTES) != hipSuccess || per_cu < 1) { fprintf(stderr, "kernel_launch: occupancy query says %d blocks per CU\n", per_cu); per_cu = 1; }
        (void)hipGetLastError();
        grid = cus;
        if (grid != 256) { fprintf(stderr, "kernel_launch: built for a 256-CU device (got %d)\n", cus); grid = -1; return; }
    }
    if (grid < 0) return;
    (void)hipMemsetAsync((char*)d_ws + WS_CTL, 0, CTL_ZERO_BYTES, stream);
    Args a{};
    for (int i = 0; i < 17; ++i) a.in[i] = (const float*)d_in[i];
    a.out = (float*)d_out; a.ws = (unsigned char*)d_ws;
    launch_phases(a, 0, 9, 1, grid, stream);
}
```

```cpp
#include <hip/hip_runtime.h>
#include <hip/hip_bf16.h>
#include <cstdint>
#include <cstdio>
#include <cmath>

constexpr int D = 1024, BATCH = 8, SEQ = 4096, T = BATCH * SEQ, DIN = 2560, NMEM = 256, NE = 32, DFF = 1024;
constexpr int C_DQ = 0, C_DK = 512, C_DV = 1024, C_LQ = 1536, C_LK = 1792, C_LV = 2048, C_MQ = 2304;
constexpr float EPS = 1e-5f;
constexpr int LCAP = T;
constexpr float QSCALE = 0.125f * 1.4426950408889634f;
constexpr float LOG2E = 1.4426950408889634f;
__device__ __forceinline__ int mk_lane() { int l = (int)__builtin_amdgcn_mbcnt_hi(~0u, __builtin_amdgcn_mbcnt_lo(~0u, 0u)); asm volatile("" : "+v"(l)); return l; }

namespace pg8 {
#define PG8_LAS __attribute__((address_space(3)))
typedef unsigned short bf16_t;
typedef short bf16x8 __attribute__((ext_vector_type(8)));
typedef float f32x4 __attribute__((ext_vector_type(4)));
typedef unsigned u32x4 __attribute__((ext_vector_type(4)));
typedef unsigned u32x2 __attribute__((ext_vector_type(2)));
constexpr int BM = 256, BK = 64, HALF = 128, HTB = HALF * BK * 2  , STAGE_BYTES = 8 * HTB, NXCD = 8, WGM = 8;

__host__ __device__ __forceinline__ int lds_byte(int r, int c) { const int st = (r >> 4) * 2 + (c >> 5), rr = r & 15, cc = c & 31, ob = rr * 64 + cc * 2; return st * 1024 + (ob ^ (((ob >> 9) & 1) << 5)); }
__host__ __device__ __forceinline__ void stage_rc(int b, int& R, int& C) { const int st = b / 1024, sb = b % 1024, swz = sb ^ (((sb >> 9) & 1) << 5); R = (st >> 1) * 16 + swz / 64; C = (st & 1) * 32 + (swz % 64) / 2; }
__host__ __device__ __forceinline__ int perm32(int rho) { const int n = rho >> 4, i = rho & 15; return 8 * (i >> 2) + 4 * n + (i & 3); }

struct Unit { size_t aoff, boff; int pm, pn, e, valid, mt; };
struct Gemm { const void* A; const void* Bt; int RB; int akstep; };
typedef int v8i __attribute__((ext_vector_type(8)));

struct StaticOrder {
    int nM, nN, nwg, G, c, RB; const unsigned* sc;
    __device__ void init(int M, int N, int RB_, int G_, int c_, const unsigned* sc_ = nullptr) { nM = M / BM; nN = N / BM; nwg = nM * nN; G = G_; c = c_; RB = RB_; sc = sc_; }
    __device__ bool next(int i, Unit& u) const {
        const long L = (long)i * G + c; if (L >= nwg) return false;
        int wgid = (int)L; { const int q = nwg / NXCD, r = nwg % NXCD, xcd = wgid % NXCD, off = wgid / NXCD; wgid = (xcd < r ? xcd * (q + 1) : r * (q + 1) + (xcd - r) * q) + off; }
        const int nig = WGM * nN, gid = wgid / nig, fm = gid * WGM, gsz = (nM - fm) < WGM ? (nM - fm) : WGM;
        u.pm = fm + ((wgid % nig) % gsz); u.pn = (wgid % nig) / gsz; u.e = 0; u.valid = 256; u.mt = 0;
        u.aoff = (size_t)u.pm * (size_t)(BM * RB); u.boff = (size_t)u.pn * (size_t)(BM * RB); return true;
    }
    __device__ __forceinline__ const unsigned* id_src(const Unit& u, int row) const { return sc + u.pm * 256 + row; }
    __device__ __forceinline__ const unsigned* sc_src(const Unit& u, int row) const { return sc + u.pm * 256 + row; }
    __device__ __forceinline__ const unsigned* bias_src(const Unit& u, int row) const { return sc + u.pm * 256 + row; }
};

__device__ __forceinline__ unsigned cvt_pk_bf16(float lo, float hi) { typedef float f2_ __attribute__((ext_vector_type(2))); typedef __bf16 b2_ __attribute__((ext_vector_type(2))); f2_ v = {lo, hi}; b2_ b = __builtin_convertvector(v, b2_); return __builtin_bit_cast(unsigned, b); }

template <class Epi, class Sched, bool ALIGN_EPI, bool GATHER, bool IDS, bool FP8 = false, bool LINEAR = false>
__device__ __forceinline__ void gemm_phase(PG8_LAS unsigned char* lds, PG8_LAS unsigned* idb, const Gemm g, const Sched& S, const Epi& E, const int tid) {
    const int wid = __builtin_amdgcn_readfirstlane(tid >> 6), lane = tid & 63, wr = wid >> 2, wc = wid & 3, fr = lane & 15, fq = lane >> 4;
    const int RB = g.RB; int nt = RB / (BK * 2); asm volatile("" : "+s"(nt));
    unsigned voffA[2], voffB[2]; int RA[2], CA[2];
#pragma unroll
    for (int i = 0; i < 2; ++i) { int R, C; stage_rc(tid * 16 + i * 8192, R, C); const int Rb = (R & ~31) + perm32(R & 31); RA[i] = R; CA[i] = C;
        voffA[i] = (unsigned)(R * RB + C * 2); voffB[i] = (unsigned)(Rb * RB + C * 2); }
    const size_t kstep = (size_t)(BK * 2), akstep = (size_t)g.akstep;
    const size_t hstep = (size_t)HALF * RB;
    const unsigned ldsw = (unsigned)wid * 1024u;
    const int aoff = lds_byte(wr * 64 + fr, fq * 8), boff = lds_byte(wc * 32 + fr, fq * 8);
#define PG8_SA(b, h) (((b) * 2 + (h)) * HTB)
#define PG8_SB(b, h) ((4 + (b) * 2 + (h)) * HTB)
#define PG8_STAGE(bufoff, gbase, voff) do { _Pragma("unroll") for (int _i = 0; _i < 2; ++_i) \
        __builtin_amdgcn_global_load_lds((const unsigned*)((const char*)(gbase) + (voff)[_i]), (PG8_LAS unsigned*)(lds + (bufoff) + ldsw + _i * 8192), 16, 0, 0); } while (0)
#define PG8_STAGE_A(bufoff, pbase, gbase, h, gv) do { if constexpr (GATHER) { PG8_STAGE(bufoff, gbase, gv[h]); } else { PG8_STAGE(bufoff, (pbase) + (h) * hstep, voffA); } } while (0)
#define PG8_LD32(p0_, p1_) __builtin_bit_cast(v8i, __builtin_shufflevector(*(const PG8_LAS u32x4*)(p0_), *(const PG8_LAS u32x4*)(p1_), 0, 1, 2, 3, 4, 5, 6, 7))
#define PG8_LDA(dst, b, h) do { if constexpr (FP8) { _Pragma("unroll") for (int m = 0; m < 4; ++m) dst##8[m] = PG8_LD32(lds + PG8_SA(b, h) + aoff + m * 2048, lds + PG8_SA(b, h) + aoff + m * 2048 + 1024); } \
        else { _Pragma("unroll") for (int m = 0; m < 4; ++m) _Pragma("unroll") for (int k = 0; k < 2; ++k) dst[m][k] = *(const PG8_LAS bf16x8*)(lds + PG8_SA(b, h) + aoff + m * 2048 + k * 1024); } } while (0)
#define PG8_LDB(dst, b, h) do { if constexpr (FP8) { _Pragma("unroll") for (int n = 0; n < 2; ++n) dst##8[n] = PG8_LD32(lds + PG8_SB(b, h) + boff + n * 2048, lds + PG8_SB(b, h) + boff + n * 2048 + 1024); } \
        else { _Pragma("unroll") for (int n = 0; n < 2; ++n) _Pragma("unroll") for (int k = 0; k < 2; ++k) dst[n][k] = *(const PG8_LAS bf16x8*)(lds + PG8_SB(b, h) + boff + n * 2048 + k * 1024); } } while (0)
#define PG8_MMA(ai, bj, At, Bt) do { __builtin_amdgcn_s_setprio(1); if constexpr (FP8) { _Pragma("unroll") for (int m = 0; m < 4; ++m) _Pragma("unroll") for (int n = 0; n < 2; ++n) \
        acc[ai][bj][m][n] = __builtin_amdgcn_mfma_scale_f32_16x16x128_f8f6f4(Bt##8[n], At##8[m], acc[ai][bj][m][n], 0, 0, 0, sca_, 0, 0x7f7f7f7f); } \
        else { _Pragma("unroll") for (int m = 0; m < 4; ++m) _Pragma("unroll") for (int n = 0; n < 2; ++n) _Pragma("unroll") for (int k = 0; k < 2; ++k) \
        acc[ai][bj][m][n] = __builtin_amdgcn_mfma_f32_16x16x32_bf16(Bt[n][k], At[m][k], acc[ai][bj][m][n], 0, 0, 0); } __builtin_amdgcn_s_setprio(0); } while (0)
#define PG8_WAIT_V(n) asm volatile("s_waitcnt vmcnt(" #n ")" ::: "memory")
#define PG8_WAIT_L(n) asm volatile("s_waitcnt lgkmcnt(" #n ")" ::: "memory")
#define PG8_BAR __builtin_amdgcn_s_barrier()
#define PG8_SCHED __builtin_amdgcn_sched_barrier(0)
#define PG8_IDS_DMA(u, s) do { if (wid < 4) { __builtin_amdgcn_global_load_lds(S.id_src(u, tid), (PG8_LAS unsigned*)(idb + (s) * 768 + wid * 64), 4, 0, 0); \
        __builtin_amdgcn_global_load_lds(S.sc_src(u, tid), (PG8_LAS unsigned*)(idb + (s) * 768 + 256 + wid * 64), 4, 0, 0); \
        __builtin_amdgcn_global_load_lds(S.bias_src(u, tid), (PG8_LAS unsigned*)(idb + (s) * 768 + 512 + wid * 64), 4, 0, 0); } } while (0)
#define PG8_GV(dst, s, un) do { _Pragma("unroll") for (int _h = 0; _h < 2; ++_h) _Pragma("unroll") for (int _i = 0; _i < 2; ++_i) \
        dst[_h][_i] = (LINEAR ? (unsigned)((un).pm * 256 + _h * 128 + RA[_i]) : (idb[(s) * 768 + _h * 128 + RA[_i]] >> 2)) * (unsigned)RB + (unsigned)(CA[_i] * 2); } while (0)
    Unit cur, nxt; int ui = 0, us = 0;
    if (!S.next(0, cur)) return;
    f32x4 acc[2][2][4][2];
#pragma unroll
    for (int a = 0; a < 2; ++a)
#pragma unroll
        for (int b = 0; b < 2; ++b)
#pragma unroll
            for (int m = 0; m < 4; ++m)
#pragma unroll
                for (int n = 0; n < 2; ++n) acc[a][b][m][n] = (f32x4){0.f, 0.f, 0.f, 0.f};
    bf16x8 At[4][2], B0[2][2], B1[2][2]; v8i At8[4], B08[2], B18[2];
    unsigned cv[2][2] = {{0u, 0u}, {0u, 0u}};
    const char* A0 = (const char*)g.A;
    const char* cA = A0 + (GATHER ? (size_t)0 : cur.aoff); const char* cB = (const char*)g.Bt + cur.boff;
    if constexpr (IDS) {
        PG8_IDS_DMA(cur, 0); PG8_WAIT_V(0); PG8_BAR;
    }
    if constexpr (GATHER) { PG8_GV(cv, 0, cur); }
    PG8_STAGE(PG8_SB(0, 0), cB, voffB); PG8_STAGE(PG8_SB(0, 1), cB + hstep, voffB); PG8_STAGE_A(PG8_SA(0, 0), cA, A0, 0, cv); PG8_STAGE_A(PG8_SA(0, 1), cA, A0, 1, cv);
    if (wr == 1) PG8_BAR;
    PG8_WAIT_V(2); PG8_BAR;
    PG8_STAGE(PG8_SB(1, 0), cB + kstep, voffB); PG8_STAGE_A(PG8_SA(1, 0), cA + akstep, A0 + akstep, 0, cv); PG8_STAGE(PG8_SB(1, 1), cB + hstep + kstep, voffB);
    PG8_WAIT_V(6); PG8_BAR;
    for (;;) {
        const bool has_next = S.next(ui + 1, nxt);
        const int ns = (us == 2) ? 0 : us + 1;
        if constexpr (IDS) { if (has_next) PG8_IDS_DMA(nxt, ns); }
        const char* nA = has_next ? A0 + (GATHER ? (size_t)0 : nxt.aoff) : cA; const char* nB = has_next ? (const char*)g.Bt + nxt.boff : cB;
#ifdef PROBE_KTWICE
        for (int rep_ = 0; rep_ < (FP8 ? 2 : 1); ++rep_) { const int sca_ = rep_ ? 0 : 0x7f7f7f7f;
#else
        { const int sca_ = 0x7f7f7f7f;
#endif
#pragma nounroll
        for (int t = 0; t < nt; t += 2) {
            int lastv = (t == nt - 2) ? 1 : 0; asm volatile("" : "+v"(lastv)); const bool last = __builtin_amdgcn_readfirstlane(lastv) != 0;
            const char* a1 = cA + (size_t)(t + 1) * akstep;
            const char* a2 = last ? nA : cA + (size_t)(t + 2) * akstep; const char* b2 = last ? nB : cB + (size_t)(t + 2) * kstep;
            const char* a3 = a2 + akstep; const char* b3 = b2 + kstep;
            PG8_LDB(B0, 0, 0); PG8_LDB(B1, 0, 1); PG8_SCHED; PG8_LDA(At, 0, 0); PG8_STAGE_A(PG8_SA(1, 1), a1, a1, 1, cv);
            if constexpr (GATHER) { if (last && has_next) { PG8_GV(cv, ns, nxt); } }
            PG8_WAIT_V(8); PG8_WAIT_L(0); PG8_BAR; PG8_MMA(0, 0, At, B0); PG8_MMA(0, 1, At, B1); PG8_BAR; PG8_SCHED;
            PG8_LDA(At, 0, 1); PG8_STAGE(PG8_SB(0, 0), b2, voffB); PG8_STAGE(PG8_SB(0, 1), b2 + hstep, voffB); PG8_STAGE_A(PG8_SA(0, 0), a2, a2, 0, cv);
            PG8_WAIT_V(8); PG8_WAIT_L(0); PG8_BAR; PG8_MMA(1, 0, At, B0); PG8_MMA(1, 1, At, B1); PG8_BAR; PG8_SCHED;
            PG8_LDB(B0, 1, 0); PG8_LDB(B1, 1, 1); PG8_SCHED; PG8_LDA(At, 1, 0); PG8_STAGE_A(PG8_SA(0, 1), a2, a2, 1, cv);
            PG8_WAIT_V(8); PG8_WAIT_L(0); PG8_BAR; PG8_MMA(0, 0, At, B0); PG8_MMA(0, 1, At, B1); PG8_BAR; PG8_SCHED;
            PG8_LDA(At, 1, 1); PG8_STAGE(PG8_SB(1, 0), b3, voffB); PG8_STAGE(PG8_SB(1, 1), b3 + hstep, voffB); PG8_STAGE_A(PG8_SA(1, 0), a3, a3, 0, cv);
            PG8_WAIT_V(8); PG8_WAIT_L(0); PG8_BAR; PG8_MMA(1, 0, At, B0); PG8_MMA(1, 1, At, B1); PG8_BAR; PG8_SCHED;
        }
        }
        if constexpr (ALIGN_EPI) { if (wr == 0) PG8_BAR; }
        PG8_SCHED;
        E(acc, cur, wr, wc, fr, fq, (const PG8_LAS unsigned*)(idb + us * 768));
        PG8_SCHED;
#ifdef PROBE_EPI2
        if constexpr (FP8) { E(acc, cur, wr, wc, fr, fq, (const PG8_LAS unsigned*)(idb + us * 768)); PG8_SCHED; }
#endif
        if (!has_next) break;
#pragma unroll
        for (int a = 0; a < 2; ++a)
#pragma unroll
            for (int b = 0; b < 2; ++b)
#pragma unroll
                for (int m = 0; m < 4; ++m)
#pragma unroll
                    for (int n = 0; n < 2; ++n) acc[a][b][m][n] = (f32x4){0.f, 0.f, 0.f, 0.f};
        cur = nxt; cA = nA; cB = nB; ++ui; us = ns;
        if constexpr (ALIGN_EPI) { if (wr == 1) PG8_BAR; }
    }
    PG8_WAIT_V(0);
    if constexpr (!ALIGN_EPI) { if (wr == 0) PG8_BAR; }
    PG8_BAR;
#undef PG8_SA
#undef PG8_SB
#undef PG8_STAGE
#undef PG8_STAGE_A
#undef PG8_LDA
#undef PG8_LDB
#undef PG8_MMA
#undef PG8_LD32
#undef PG8_WAIT_V
#undef PG8_WAIT_L
#undef PG8_BAR
#undef PG8_SCHED
#undef PG8_IDS_DMA
#undef PG8_GV
}
}
namespace attn_body {
using bf16=__hip_bfloat16;
using bf16x8=__attribute__((ext_vector_type(8)))short;
using s16x4=__attribute__((ext_vector_type(4)))short;
using f32x16=__attribute__((ext_vector_type(16)))float;
using u32x4=__attribute__((ext_vector_type(4)))unsigned;
constexpr int D=64;
constexpr int NW=8,QBLK=32,QB=QBLK*NW,KVBLK=64;
struct UnitP { const bf16* Q; const bf16* K; const bf16* V; bf16* O; long qp, kp, op; int q0, t0, NT; float slope2; float* lse; int lse_stride; };
__device__ __forceinline__ int crow(int r,int hi){return (r&3)+8*(r>>2)+4*hi;}
#define SBAR() __builtin_amdgcn_sched_barrier(0)
template<bool CAUSAL,bool WINDOW> __device__ __forceinline__ void cmask(f32x16&p0,f32x16&p1,int jb,int qrel,int hi){
  const float NEG=-INFINITY; int kb=64*jb+4*hi;
  #pragma unroll
  for(int r=0;r<16;++r){int kv=kb+(r&3)+8*(r>>2);
    if(CAUSAL){ if(kv>qrel)p0[r]=NEG; if(kv+32>qrel)p1[r]=NEG; }
    if(WINDOW){ if(kv<qrel-128)p0[r]=NEG; if(kv+32<qrel-128)p1[r]=NEG; } }
}
__device__ __forceinline__ unsigned bfr(float x){ typedef float f2_ __attribute__((ext_vector_type(2))); typedef __bf16 b2_ __attribute__((ext_vector_type(2))); f2_ v={x,0.f}; b2_ b=__builtin_convertvector(v,b2_); return __builtin_bit_cast(unsigned,b)&0xffffu; }
__device__ __forceinline__ float bfv(unsigned b){ return __builtin_bit_cast(float,b<<16); }

constexpr int NSLOT=3, SLOTB=8192;
constexpr int LDS_K=0, LDS_V=NSLOT*SLOTB;
template<int DV> struct Lds { static constexpr int SLOTV=SLOTB*(DV/64), WS=LDS_V+NSLOT*SLOTV, OST=WS+NW*64*4, OSTW=4096*(DV/64), BYTES=OST+NW*OSTW; };
__device__ __forceinline__ void glds16(const void*gsrc,unsigned lds_dst){unsigned keep;
  asm volatile("s_mov_b32 %0, m0\n\ts_mov_b32 m0, %2\n\ts_nop 0\n\tglobal_load_lds_dwordx4 %1, off\n\ts_mov_b32 m0, %0":"=&s"(keep):"v"(gsrc),"s"(lds_dst):"memory");}
__device__ __forceinline__ float max3f(float a,float b,float c){float r;asm("v_max3_f32 %0, %1, %2, %3":"=v"(r):"v"(a),"v"(b),"v"(c));return r;}
__device__ __forceinline__ float max2f(float a,float b){float r;asm("v_max_f32_e32 %0, %1, %2":"=v"(r):"v"(a),"v"(b));return r;}
__device__ __forceinline__ float fadd_s(float a,float b){float r;asm("v_add_f32_e32 %0, %1, %2":"=v"(r):"v"(a),"v"(b));return r;}
__device__ __forceinline__ float fsub_s(float a,float b){float r;asm("v_sub_f32_e32 %0, %1, %2":"=v"(r):"v"(a),"v"(b));return r;}
typedef float f32x2_t __attribute__((ext_vector_type(2))); typedef __bf16 bf16x2_t __attribute__((ext_vector_type(2)));
__device__ __forceinline__ unsigned cvtpk_s(float lo,float hi){f32x2_t v={lo,hi};bf16x2_t b=__builtin_convertvector(v,bf16x2_t);return __builtin_bit_cast(unsigned,b);}
#define WAIT_BAR(N) asm volatile("s_waitcnt vmcnt(" #N ") lgkmcnt(0)\n\ts_barrier":::"memory")

__device__ __forceinline__ void qkt(f32x16&p0,f32x16&p1,const char*Kslot,const bf16x8*qr,bf16x8 kx0,bf16x8 kx1,bf16x8 qx,int r32,int hi){
  const char*kb=Kslot+hi*1024+r32*16;
  #pragma unroll
  for(int d0=0;d0<4;++d0){
    const bf16x8 b0=*reinterpret_cast<const bf16x8*>(kb+d0*2048);
    const bf16x8 b1=*reinterpret_cast<const bf16x8*>(kb+d0*2048+512);
    if(d0==0){p0=__builtin_amdgcn_mfma_f32_32x32x16_bf16(b0,qr[0],f32x16{},0,0,0);p1=__builtin_amdgcn_mfma_f32_32x32x16_bf16(b1,qr[0],f32x16{},0,0,0);}
    else{p0=__builtin_amdgcn_mfma_f32_32x32x16_bf16(b0,qr[d0],p0,0,0,0);p1=__builtin_amdgcn_mfma_f32_32x32x16_bf16(b1,qr[d0],p1,0,0,0);}}
  p0=__builtin_amdgcn_mfma_f32_32x32x16_bf16(kx0,qx,p0,0,0,0);p1=__builtin_amdgcn_mfma_f32_32x32x16_bf16(kx1,qx,p1,0,0,0);
}
typedef __attribute__((address_space(3))) const char* lds_cptr;
typedef short v4i16_t __attribute__((ext_vector_type(4)));
__device__ __forceinline__ void kload8(bf16x8*kf,lds_cptr kp){
  kf[0]=*(const __attribute__((address_space(3))) bf16x8*)(kp);      kf[1]=*(const __attribute__((address_space(3))) bf16x8*)(kp+512);
  kf[2]=*(const __attribute__((address_space(3))) bf16x8*)(kp+2048); kf[3]=*(const __attribute__((address_space(3))) bf16x8*)(kp+2560);
  kf[4]=*(const __attribute__((address_space(3))) bf16x8*)(kp+4096); kf[5]=*(const __attribute__((address_space(3))) bf16x8*)(kp+4608);
  kf[6]=*(const __attribute__((address_space(3))) bf16x8*)(kp+6144); kf[7]=*(const __attribute__((address_space(3))) bf16x8*)(kp+6656);
}
__device__ __forceinline__ void kload2(bf16x8*kf,lds_cptr kp,int j){ kf[2*j]=*(const __attribute__((address_space(3))) bf16x8*)(kp+j*2048); kf[2*j+1]=*(const __attribute__((address_space(3))) bf16x8*)(kp+j*2048+512); }
__device__ __forceinline__ s16x4 vtr(lds_cptr p){ return __builtin_bit_cast(s16x4,__builtin_amdgcn_ds_read_tr16_b64_v4i16((__attribute__((address_space(3))) v4i16_t*)p)); }
__device__ __forceinline__ float rowmax(const f32x16&p0,const f32x16&p1){
  float a=max3f(p0[0],p0[1],p1[0]),b=max3f(p0[2],p0[3],p1[1]);a=max3f(a,p1[2],p1[3]);
  #pragma unroll
  for(int r=4;r<16;r+=4){a=max3f(a,p0[r],p0[r+1]);b=max3f(b,p0[r+2],p0[r+3]);a=max3f(a,p1[r],p1[r+1]);b=max3f(b,p1[r+2],p1[r+3]);}
  const float m=max2f(a,b);
  auto rr=__builtin_amdgcn_permlane32_swap(__float_as_uint(m),__float_as_uint(m),false,false);
  return max2f(__uint_as_float(rr[0]),__uint_as_float(rr[1]));
}
__device__ __forceinline__ void pv(f32x16*o,int vb,bf16x8 pa0,bf16x8 pa1,bf16x8 pa2,bf16x8 pa3){
  #pragma unroll
  for(int d0=0;d0<2;++d0){s16x4 lo[4],hi[4];
    #pragma unroll
    for(int ks=0;ks<4;++ks){
      asm volatile("ds_read_b64_tr_b16 %0,%1 offset:%c2":"=&v"(lo[ks]):"v"(vb),"i"(d0*4096+ks*1024):"memory");
      asm volatile("ds_read_b64_tr_b16 %0,%1 offset:%c2":"=&v"(hi[ks]):"v"(vb),"i"(d0*4096+ks*1024+512):"memory");}
    asm volatile("s_waitcnt lgkmcnt(0)":::"memory");SBAR();
    #define PK(k) (bf16x8){lo[k][0],lo[k][1],lo[k][2],lo[k][3],hi[k][0],hi[k][1],hi[k][2],hi[k][3]}
    o[d0]=__builtin_amdgcn_mfma_f32_32x32x16_bf16(pa0,PK(0),o[d0],0,0,0);
    o[d0]=__builtin_amdgcn_mfma_f32_32x32x16_bf16(pa1,PK(1),o[d0],0,0,0);
    o[d0]=__builtin_amdgcn_mfma_f32_32x32x16_bf16(pa2,PK(2),o[d0],0,0,0);
    o[d0]=__builtin_amdgcn_mfma_f32_32x32x16_bf16(pa3,PK(3),o[d0],0,0,0);
    #undef PK
  }
}

__device__ __forceinline__ void pv128(f32x16*o,int vb,bf16x8 pa0,bf16x8 pa1,bf16x8 pa2,bf16x8 pa3){
  #pragma unroll
  for(int d0=0;d0<4;++d0){s16x4 lo[4],hi[4];
    #pragma unroll
    for(int ks=0;ks<4;++ks){
      asm volatile("ds_read_b64_tr_b16 %0,%1 offset:%c2":"=&v"(lo[ks]):"v"(vb),"i"(d0*4096+ks*1024):"memory");
      asm volatile("ds_read_b64_tr_b16 %0,%1 offset:%c2":"=&v"(hi[ks]):"v"(vb),"i"(d0*4096+ks*1024+512):"memory");}
    asm volatile("s_waitcnt lgkmcnt(0)":::"memory");SBAR();
    #define PK(k) (bf16x8){lo[k][0],lo[k][1],lo[k][2],lo[k][3],hi[k][0],hi[k][1],hi[k][2],hi[k][3]}
    o[d0]=__builtin_amdgcn_mfma_f32_32x32x16_bf16(pa0,PK(0),o[d0],0,0,0);
    o[d0]=__builtin_amdgcn_mfma_f32_32x32x16_bf16(pa1,PK(1),o[d0],0,0,0);
    o[d0]=__builtin_amdgcn_mfma_f32_32x32x16_bf16(pa2,PK(2),o[d0],0,0,0);
    o[d0]=__builtin_amdgcn_mfma_f32_32x32x16_bf16(pa3,PK(3),o[d0],0,0,0);
    #undef PK
  }
}
#ifndef ATTN_STORE16
#define ATTN_STORE16(p,v) (*(u32x4*)(p)=(v))
#endif
template<int THRL,bool CAUSAL,bool WINDOW,bool ALIBI,bool LSE,int DV=64> __device__ __forceinline__ void attn_unit(const UnitP&U,char*shm){
  constexpr int LDS_WS=Lds<DV>::WS, LDS_OST=Lds<DV>::OST, VMUL=DV/64;
  int tid=threadIdx.x; asm volatile("":"+v"(tid));
  const int lane=tid&63,r32=lane&31,hi=lane>>5; const int wid=__builtin_amdgcn_readfirstlane(tid>>6);
  const int q0=U.q0; const long qp=U.qp,kp=U.kp,op=U.op; const float slope2=U.slope2;
  const bf16*Qw=U.Q+(long)(q0+wid*QBLK)*qp;
  const bf16*Kh=U.K+(long)U.t0*KVBLK*kp,*Vh=U.V+(long)U.t0*KVBLK*kp;
  const unsigned lds0=(unsigned)(uintptr_t)shm;
  float*wsf=(float*)(shm+LDS_WS)+wid*64;
  const bf16*ksrc=Kh+(long)lane*kp+wid*8;
  const bf16*vsrc=Vh+(long)(16*(wid&3)+(lane>>2))*kp+(wid>>2)*32+(lane&3)*8;
  const unsigned kdst=lds0+LDS_K+wid*1024, vdst=lds0+LDS_V+wid*1024;
  #define DMA_K(t,slot) glds16(ksrc+(long)(t)*KVBLK*kp,(unsigned)__builtin_amdgcn_readfirstlane(kdst+(slot)))
  #define DMA_V(t,slot) do{ glds16(vsrc+(long)(t)*KVBLK*kp,(unsigned)__builtin_amdgcn_readfirstlane(vdst+VMUL*(slot))); if constexpr(DV==128) glds16(vsrc+64+(long)(t)*KVBLK*kp,(unsigned)__builtin_amdgcn_readfirstlane(vdst+VMUL*(slot)+8192)); }while(0)
  const int vb0=(int)(lds0+LDS_V)+((lane>>4)&1)*32+(lane&3)*8+(4*hi+((lane&15)>>2))*64;
  const char*Kbase=shm+LDS_K; bf16x8 kf[8];
  const lds_cptr shm3=(lds_cptr)shm; const lds_cptr kp0=shm3+LDS_K+hi*1024+r32*16; const lds_cptr vp0=shm3+LDS_V+((lane>>4)&1)*32+(lane&3)*8+(4*hi+((lane&15)>>2))*64;
  const int NT=U.NT;
  DMA_K(0,0);DMA_V(0,0);DMA_K(1,SLOTB);
  bf16x8 qr[4];
  #pragma unroll
  for(int d0=0;d0<4;++d0)qr[d0]=*reinterpret_cast<const bf16x8*>(&Qw[(long)r32*qp+d0*16+hi*8]);
  float mhat=0.f,l_reg=0.f;f32x16 o[4];o[0]=f32x16{};o[1]=f32x16{};o[2]=f32x16{};o[3]=f32x16{};
  const int qrel=wid*QBLK+r32;
  #define CMASK(P0,P1,t) do{int jb_=(t)-(NT-4); if(WINDOW||(CAUSAL&&jb_>=0))cmask<CAUSAL,WINDOW>(P0,P1,jb_,qrel,hi);}while(0)
  bf16x8 kx0,kx1,qx;
  { const float k0_=ALIBI?slope2*(float)r32:0.f, k1_=ALIBI?slope2*(float)(r32+32):0.f; const unsigned h0=bfr(k0_),l0=bfr(k0_-bfv(h0)),h1=bfr(k1_),l1=bfr(k1_-bfv(h1));
    u32x4 a={0x3f803f80u,0x3f80u|(h0<<16),l0,0u}, b={0x3f803f80u,0x3f80u|(h1<<16),l1,0u}; if(hi){a=u32x4{0u,0u,0u,0u};b=a;} kx0=__builtin_bit_cast(bf16x8,a); kx1=__builtin_bit_cast(bf16x8,b); }
  #define QX_SET(t) do{ const float nb_=ALIBI?__builtin_fmaf(slope2,(float)(64*((t)-(NT-4))-qrel),-mhat):-mhat; const unsigned a_=bfr(nb_); const float r1_=nb_-bfv(a_); const unsigned b_=bfr(r1_); const unsigned c_=bfr(r1_-bfv(b_)); \
    u32x4 q_={a_|(b_<<16),c_|0x3f800000u,0x3f80u,0u}; if(hi)q_=u32x4{0u,0u,0u,0u}; qx=__builtin_bit_cast(bf16x8,q_); asm volatile("":"+v"(qx)); }while(0)
  bool resc=false;
  #define START(P0,P1) do{ const float rm=rowmax(P0,P1); resc=false; \
    { const float dl=(rm==-INFINITY)?0.f:rm; mhat=fadd_s(mhat,dl); \
      _Pragma("unroll") for(int r=0;r<16;++r){P0[r]=fsub_s(P0[r],dl);P1[r]=fsub_s(P1[r],dl);} } \
    _Pragma("unroll") for(int r=0;r<16;++r)P0[r]=__builtin_amdgcn_exp2f(P0[r]); }while(0)
  #define RESC() do{ if(resc){ asm volatile("s_waitcnt lgkmcnt(0)":::"memory"); \
      _Pragma("unroll") for(int d_=0;d_<2*VMUL;++d_) _Pragma("unroll") for(int r=0;r<16;++r)o[d_][r]*=wsf[crow(r,hi)]; } }while(0)
  f32x16 pA0,pA1,pB0,pB1;
  int sl_prev=0,sl_cur=0,sl_next=SLOTB;
  #define ROT() do{sl_prev=sl_cur;sl_cur=sl_next;sl_next=(sl_next==(NSLOT-1)*SLOTB)?0:sl_next+SLOTB;}while(0)
  DMA_K(2,2*SLOTB);
  if constexpr(DV==128){WAIT_BAR(4);}else{WAIT_BAR(3);}
  QX_SET(0);
  qkt(pA0,pA1,Kbase,qr,kx0,kx1,qx,r32,hi);asm volatile("s_nop 15\n\ts_nop 7":"+v"(pA0),"+v"(pA1));CMASK(pA0,pA1,0);
  START(pA0,pA1);
  _Pragma("unroll") for(int r=0;r<16;++r)pA1[r]=__builtin_amdgcn_exp2f(pA1[r]);
  WAIT_BAR(0);
  DMA_K(3,0);DMA_V(1,SLOTB);
  ROT();
  kload8(kf,kp0+sl_cur);
  if constexpr(DV==128){WAIT_BAR(3);}else{WAIT_BAR(2);}
  s16x4 vlo[8],vhi[8]; s16x4 vfl[4],vfh[4]; u32x4 pw0,pw1,pw2,pw3;
  #define PKW(P,B) cvtpk_s(P[B],P[B+1])
  #define PAF(k) __builtin_bit_cast(bf16x8,pw##k)
  #define VFR(i) (bf16x8){vlo[i][0],vlo[i][1],vlo[i][2],vlo[i][3],vhi[i][0],vhi[i][1],vhi[i][2],vhi[i][3]}
  #define PIN(x) asm volatile("":"+v"(x))
  #define MX3(a,b,c) __builtin_fmaxf(__builtin_fmaxf((a),(b)),(c))
  #define GAPA(MF,A0,A1,A2,A3,W0,W1,PW) do{ MF; sacc+=A0; sacc+=A1; sacc+=A2; sacc+=A3; PIN(sacc); W0; W1; PIN(PW); SBAR(); }while(0)
  #define EX(v) __builtin_amdgcn_exp2f(v)
  #define GAPB(MF,X,B) do{ MF; X[B]=EX(X[B]); X[B+1]=EX(X[B+1]); X[B+2]=EX(X[B+2]); X[B+3]=EX(X[B+3]); PIN(X); SBAR(); }while(0)
  #define VRD(i) do{ if constexpr(DV==64){ vlo[i]=vtr(vp_+(((i)>>2)*4096+((i)&3)*1024)); vhi[i]=vtr(vp_+(((i)>>2)*4096+((i)&3)*1024+512)); } }while(0)
  #define VRJ(f) do{ vfl[(f)&3]=vtr(vp_+(((f)&3)*4096+((f)>>2)*1024)); vfh[(f)&3]=vtr(vp_+(((f)&3)*4096+((f)>>2)*1024+512)); }while(0)
  #define VFJ(f) (bf16x8){vfl[(f)&3][0],vfl[(f)&3][1],vfl[(f)&3][2],vfl[(f)&3][3],vfh[(f)&3][0],vfh[(f)&3][1],vfh[(f)&3][2],vfh[(f)&3][3]}
  #define GAPJ(f,PA,X,B) do{ if((f)+3<16){VRJ((f)+3);} o[(f)&3]=__builtin_amdgcn_mfma_f32_32x32x16_bf16(PA,VFJ(f),o[(f)&3],0,0,0); X[B]=EX(X[B]); X[B+1]=EX(X[B+1]); PIN(X); SBAR(); }while(0)
  #define KRD(G,j) do{ if(G){ kload2(kf,kp0+sl_next,j); SBAR(); } }while(0)
  #define STEP(C0,C1,P0,P1,t,GK,GV,GL) do{ SBAR(); QX_SET(t); SBAR(); \
    const lds_cptr vp_=vp0+VMUL*sl_prev; \
    VRD(0); SBAR(); float sacc=(P0[0]+P0[1]); \
    GAPA(C0=__builtin_amdgcn_mfma_f32_32x32x16_bf16(kf[0],qr[0],f32x16{},0,0,0), P0[2],P0[3],P0[4],P0[5],     pw0[0]=PKW(P0,0), pw0[1]=PKW(P0,2), pw0); \
    VRD(4); SBAR(); GAPA(C1=__builtin_amdgcn_mfma_f32_32x32x16_bf16(kf[1],qr[0],f32x16{},0,0,0), P0[6],P0[7],P0[8],P0[9],     pw0[2]=PKW(P0,4), pw0[3]=PKW(P0,6), pw0); \
    VRD(1); SBAR(); GAPA(C0=__builtin_amdgcn_mfma_f32_32x32x16_bf16(kf[2],qr[1],C0,0,0,0),   P0[10],P0[11],P0[12],P0[13], pw1[0]=PKW(P0,8), pw1[1]=PKW(P0,10), pw1); \
    VRD(5); SBAR(); GAPA(C1=__builtin_amdgcn_mfma_f32_32x32x16_bf16(kf[3],qr[1],C1,0,0,0),   P0[14],P0[15],P1[0],P1[1],   pw1[2]=PKW(P0,12),pw1[3]=PKW(P0,14), pw1); \
    VRD(2); SBAR(); GAPA(C0=__builtin_amdgcn_mfma_f32_32x32x16_bf16(kf[4],qr[2],C0,0,0,0),   P1[2],P1[3],P1[4],P1[5],     pw2[0]=PKW(P1,0), pw2[1]=PKW(P1,2), pw2); \
    VRD(6); SBAR(); GAPA(C1=__builtin_amdgcn_mfma_f32_32x32x16_bf16(kf[5],qr[2],C1,0,0,0),   P1[6],P1[7],P1[8],P1[9],     pw2[2]=PKW(P1,4), pw2[3]=PKW(P1,6), pw2); \
    VRD(3); SBAR(); GAPA(C0=__builtin_amdgcn_mfma_f32_32x32x16_bf16(kf[6],qr[3],C0,0,0,0),   P1[10],P1[11],P1[12],P1[13], pw3[0]=PKW(P1,8), pw3[1]=PKW(P1,10), pw3); \
    VRD(7); SBAR(); GAPA(C1=__builtin_amdgcn_mfma_f32_32x32x16_bf16(kf[7],qr[3],C1,0,0,0),   P1[14],P1[15],0.f,0.f,       pw3[2]=PKW(P1,12),pw3[3]=PKW(P1,14), pw3); \
    C0=__builtin_amdgcn_mfma_f32_32x32x16_bf16(kx0,qx,C0,0,0,0); C1=__builtin_amdgcn_mfma_f32_32x32x16_bf16(kx1,qx,C1,0,0,0); if constexpr(DV==128){VRJ(0);VRJ(1);VRJ(2);} SBAR(); \
    l_reg+=sacc; \
    if(GK){DMA_K((t)+3,sl_cur);} if(GV){DMA_V((t)+1,sl_next);} \
    CMASK(C0,C1,t); \
    { float a=MX3(C0[0],C0[1],C1[0]),b=MX3(C0[2],C0[3],C1[1]); a=MX3(a,C1[2],C1[3]); \
      _Pragma("unroll") for(int r=4;r<16;r+=4){a=MX3(a,C0[r],C0[r+1]);b=MX3(b,C0[r+2],C0[r+3]);a=MX3(a,C1[r],C1[r+1]);b=MX3(b,C1[r+2],C1[r+3]);} \
      float rm=__builtin_fmaxf(a,b); { auto rr=__builtin_amdgcn_permlane32_swap(__float_as_uint(rm),__float_as_uint(rm),false,false); rm=__builtin_fmaxf(__uint_as_float(rr[0]),__uint_as_float(rr[1])); } \
      resc=false; \
      if(__builtin_expect(__any(rm>(float)THRL),0)){ const float dl=__builtin_fmaxf(rm,0.f); mhat+=dl; \
        _Pragma("unroll") for(int r=0;r<16;++r){C0[r]-=dl;C1[r]-=dl;} \
        const float f=__builtin_amdgcn_exp2f(-dl); l_reg*=f; if(hi==0)wsf[r32]=f; resc=true; } } \
    SBAR(); \
    if constexpr(DV==64){ \
    GAPB(o[0]=__builtin_amdgcn_mfma_f32_32x32x16_bf16(PAF(0),VFR(0),o[0],0,0,0), C0,0); \
    GAPB(o[1]=__builtin_amdgcn_mfma_f32_32x32x16_bf16(PAF(0),VFR(4),o[1],0,0,0), C0,4); \
    KRD(GL,0); GAPB(o[0]=__builtin_amdgcn_mfma_f32_32x32x16_bf16(PAF(1),VFR(1),o[0],0,0,0), C0,8); \
    KRD(GL,1); GAPB(o[1]=__builtin_amdgcn_mfma_f32_32x32x16_bf16(PAF(1),VFR(5),o[1],0,0,0), C0,12); \
    KRD(GL,2); GAPB(o[0]=__builtin_amdgcn_mfma_f32_32x32x16_bf16(PAF(2),VFR(2),o[0],0,0,0), C1,0); \
    KRD(GL,3); GAPB(o[1]=__builtin_amdgcn_mfma_f32_32x32x16_bf16(PAF(2),VFR(6),o[1],0,0,0), C1,4); \
    GAPB(o[0]=__builtin_amdgcn_mfma_f32_32x32x16_bf16(PAF(3),VFR(3),o[0],0,0,0), C1,8); \
    GAPB(o[1]=__builtin_amdgcn_mfma_f32_32x32x16_bf16(PAF(3),VFR(7),o[1],0,0,0), C1,12); \
    } else { \
    GAPJ(0,PAF(0),C0,0); GAPJ(1,PAF(0),C0,2); GAPJ(2,PAF(0),C0,4); GAPJ(3,PAF(0),C0,6); \
    KRD(GL,0); GAPJ(4,PAF(1),C0,8); GAPJ(5,PAF(1),C0,10); KRD(GL,1); GAPJ(6,PAF(1),C0,12); GAPJ(7,PAF(1),C0,14); \
    KRD(GL,2); GAPJ(8,PAF(2),C1,0); GAPJ(9,PAF(2),C1,2); KRD(GL,3); GAPJ(10,PAF(2),C1,4); GAPJ(11,PAF(2),C1,6); \
    GAPJ(12,PAF(3),C1,8); GAPJ(13,PAF(3),C1,10); GAPJ(14,PAF(3),C1,12); GAPJ(15,PAF(3),C1,14); \
    } \
    }while(0)
  int t=1;
  #undef CMASK
  #define CMASK(P0,P1,t) do{}while(0)
  for(;t+5<NT;t+=2){
    STEP(pB0,pB1,pA0,pA1,t,true,true,true);     if constexpr(DV==128){WAIT_BAR(3);}else{WAIT_BAR(2);} RESC(); ROT();
    STEP(pA0,pA1,pB0,pB1,t+1,true,true,true);   if constexpr(DV==128){WAIT_BAR(3);}else{WAIT_BAR(2);} RESC(); ROT();
  }
  #undef CMASK
  #define CMASK(P0,P1,t) do{int jb_=(t)-(NT-4); if(WINDOW||(CAUSAL&&jb_>=0))cmask<CAUSAL,WINDOW>(P0,P1,jb_,qrel,hi);}while(0)
  #define ENDW(tt) do{ if((tt)+3<NT){ if constexpr(DV==128){WAIT_BAR(3);}else{WAIT_BAR(2);} } else if((tt)+2<NT){ if constexpr(DV==128){WAIT_BAR(2);}else{WAIT_BAR(1);} } else {WAIT_BAR(0);} }while(0)
  for(;t+1<NT;t+=2){
    STEP(pB0,pB1,pA0,pA1,t,(t+3<NT),(t+1<NT),(t+1<NT));       ENDW(t);   RESC(); ROT();
    STEP(pA0,pA1,pB0,pB1,t+1,(t+4<NT),(t+2<NT),(t+2<NT));     ENDW(t+1); RESC(); ROT();
  }
  STEP(pB0,pB1,pA0,pA1,NT-1,false,false,false); RESC();
  { float sacc=pB0[0]+pB0[1]; _Pragma("unroll") for(int r=2;r<16;++r)sacc+=pB0[r]; _Pragma("unroll") for(int r=0;r<16;++r)sacc+=pB1[r]; l_reg+=sacc;
    pw0=(u32x4){PKW(pB0,0),PKW(pB0,2),PKW(pB0,4),PKW(pB0,6)};pw1=(u32x4){PKW(pB0,8),PKW(pB0,10),PKW(pB0,12),PKW(pB0,14)};pw2=(u32x4){PKW(pB1,0),PKW(pB1,2),PKW(pB1,4),PKW(pB1,6)};pw3=(u32x4){PKW(pB1,8),PKW(pB1,10),PKW(pB1,12),PKW(pB1,14)};
    SBAR(); if constexpr(DV==128){pv128(o,vb0+VMUL*sl_cur,PAF(0),PAF(1),PAF(2),PAF(3));}else{pv(o,vb0+sl_cur,PAF(0),PAF(1),PAF(2),PAF(3));} }
  #undef PKW
  #undef PAF
  #undef VFR
  #undef PIN
  #undef MX3
  #undef GAPA
  #undef GAPB
  #undef EX
  #undef VRD
  #undef VRJ
  #undef VFJ
  #undef GAPJ
  #undef KRD
  #undef STEP
  #undef ENDW
  {auto rr=__builtin_amdgcn_permlane32_swap(__float_as_uint(l_reg),__float_as_uint(l_reg),false,false);l_reg=__uint_as_float(rr[0])+__uint_as_float(rr[1]);}
  if(LSE){ if(hi==0)U.lse[(long)(q0+wid*QBLK+r32)*U.lse_stride]=mhat+__builtin_amdgcn_logf(l_reg); }
  if(hi==0)wsf[32+r32]=l_reg;asm volatile("s_waitcnt lgkmcnt(0)":::"memory");
  float rli[16];
  #pragma unroll
  for(int r=0;r<16;++r)rli[r]=__builtin_amdgcn_rcpf(wsf[32+crow(r,hi)]);
  bf16*Ow=U.O+(long)(q0+wid*QBLK)*op;
  { bf16*stg=(bf16*)(shm+LDS_OST)+wid*(2048*VMUL);
    #pragma unroll
    for(int r=0;r<16;++r){const int orow=crow(r,hi);
      #pragma unroll
      for(int d0=0;d0<2*VMUL;++d0)stg[orow*DV+d0*32+r32]=__float2bfloat16(o[d0][r]*rli[r]);}
    asm volatile("s_waitcnt lgkmcnt(0)":::"memory");
    if constexpr(DV==128){
      #pragma unroll
      for(int i=0;i<8;++i){const int row=i*4+(lane>>4),ch=lane&15; const u32x4 v=*(const u32x4*)(stg+row*128+ch*8); ATTN_STORE16(Ow+(long)row*op+ch*8,v);}
    } else {
      #pragma unroll
      for(int i=0;i<4;++i){const int row=i*8+(lane>>3),ch=lane&7; const u32x4 v=*(const u32x4*)(stg+row*64+ch*8); ATTN_STORE16(Ow+(long)row*op+ch*8,v);} } }
  asm volatile("s_waitcnt lgkmcnt(0)\n\ts_barrier":::"memory");
  #undef DMA_K
  #undef DMA_V
  #undef CMASK
  #undef START
  #undef RESC
  #undef ROT
  #undef QX_SET
}
constexpr int ATTN_LDS_BYTES=Lds<128>::BYTES;
#undef SBAR
#undef WAIT_BAR
}
constexpr size_t MiB = 1u << 20;
constexpr size_t WS_CTL = 0, CTL_ZERO_BYTES = 1 * MiB;
constexpr size_t WS_LIST = 1 * MiB;
constexpr size_t WS_RGATE = 5 * MiB;
constexpr size_t WS_RSTD1 = 5 * MiB + 512 * 1024, WS_RSTD2 = WS_RSTD1 + 128 * 1024, WS_WRG = WS_RSTD2 + 128 * 1024;
constexpr size_t WS_WRT = 7 * MiB + 512 * 1024;
constexpr size_t WS_LSE = 6 * MiB;
constexpr size_t WS_MKV = 8 * MiB;
constexpr size_t WS_WIN = 10 * MiB, WS_WOUT = 15 * MiB, WS_WGU = 17 * MiB, WS_WDN = 145 * MiB;
constexpr size_t WS_XB = 209 * MiB;
constexpr size_t WS_LRSTD = 865 * MiB, WS_LGATE = 869 * MiB;
constexpr size_t WS_P = 273 * MiB, WS_OD = 433 * MiB, WS_ODIL = 497 * MiB;
constexpr size_t WS_ACT = 273 * MiB;
constexpr size_t WS_YLOG = 889 * MiB, WS_MT = 893 * MiB;
constexpr size_t WS_OMEM = 873 * MiB;
constexpr size_t WS_MIX = 545 * MiB, WS_X1B = 609 * MiB, WS_YB = 673 * MiB, WS_X1H = 801 * MiB, WS_Y = 929 * MiB, WS_END = 993 * MiB;
constexpr int CW_TMO = 0, CW_CODE = 1;
constexpr int CW_CNT = 64;
constexpr int CW_NRM = 256;
constexpr int CW_Q = 1024;
constexpr int CW_BAR = 4096;

constexpr int RING_OFF = 0, RING_BYTES = 131072;
constexpr int LDSCTL_OFF = RING_BYTES;
constexpr int IDB_OFF = LDSCTL_OFF;
constexpr int TBL_OFF = IDB_OFF + 9216;
constexpr int LCNT_OFF = TBL_OFF + 2304;
constexpr int MISC_OFF = LCNT_OFF + 256;
constexpr int STG_OFF = IDB_OFF;
constexpr int LDS_BYTES = 147456;
static_assert(MISC_OFF + 128 <= LDS_BYTES && 512 * 16 <= 9216, "LDS map");
constexpr int NWAVES = 8;

#define GAS __attribute__((address_space(1)))
#define LAS __attribute__((address_space(3)))
typedef unsigned short bf16;
typedef unsigned v4u __attribute__((ext_vector_type(4)));
typedef unsigned v2u __attribute__((ext_vector_type(2)));
typedef float f32x4 __attribute__((ext_vector_type(4)));
typedef float f32x16 __attribute__((ext_vector_type(16)));
typedef short bf16x8 __attribute__((ext_vector_type(8)));
typedef GAS unsigned gu32;
#define RLX_AGENT __ATOMIC_RELAXED, __HIP_MEMORY_SCOPE_AGENT
#define LDS_WAIT() asm volatile("s_waitcnt lgkmcnt(0)" ::: "memory")
#define VM_WAIT() asm volatile("s_waitcnt vmcnt(0)" ::: "memory")
__device__ __forceinline__ unsigned f2bf(float f) { unsigned u = __builtin_bit_cast(unsigned, f); return (u + 0x7fffu + ((u >> 16) & 1u)) >> 16; }
__device__ __forceinline__ unsigned pk2(float lo, float hi) { return f2bf(lo) | (f2bf(hi) << 16); }
__device__ __forceinline__ float sat8(float v) { return __builtin_amdgcn_fmed3f(v, -448.f, 448.f); }
__device__ __forceinline__ unsigned fp8x4(float a, float b, float c, float d) { int w = __builtin_amdgcn_cvt_pk_fp8_f32(sat8(a), sat8(b), 0, false); w = __builtin_amdgcn_cvt_pk_fp8_f32(sat8(c), sat8(d), w, true); return (unsigned)w; }
constexpr float MSCALE = 16.f;
constexpr float WSCALE = 64.f, ASCALE = 8.f, YSCALE = 64.f;
__device__ __forceinline__ float bf2f(unsigned short b) { return __builtin_bit_cast(float, (unsigned)b << 16); }
__device__ __forceinline__ float bflo(unsigned w) { return __builtin_bit_cast(float, w << 16); }
__device__ __forceinline__ float bfhi(unsigned w) { return __builtin_bit_cast(float, w & 0xffff0000u); }
__device__ __forceinline__ float wave_sum(float v) {
#pragma unroll
    for (int o = 1; o < 64; o <<= 1) v += __shfl_xor(v, o);
    return v;
}

#define XB_TMO      128
#define XB_XCNT(j)  (256  + 64 * (j))
#define XB_XSUB(j)  (1280 + 64 * (j))
#define XB_XGEN(j)  (2304 + 64 * (j))
#define XB_TOP      3328
#define XB_TOPGEN   3392
#define XCD_BAR_WORDS 3456
#define XB_SPIN_CAP (1u << 20)
__device__ __forceinline__ unsigned xb_ld(unsigned* p)              { return __hip_atomic_load(p, __ATOMIC_RELAXED, __HIP_MEMORY_SCOPE_AGENT); }
__device__ __forceinline__ unsigned xb_add(unsigned* p, unsigned v) { return __hip_atomic_fetch_add(p, v, __ATOMIC_RELAXED, __HIP_MEMORY_SCOPE_AGENT); }
__device__ __forceinline__ unsigned xb_xcc_id() { return (unsigned)__builtin_amdgcn_s_getreg((3 << 11) | 20) & 0xFu; }
#define XB_SPIN(cond, bar) do { unsigned _sp = 0; while (cond) { __builtin_amdgcn_s_sleep(1); \
    if ((++_sp & 255u) == 0u) { if (xb_ld(&(bar)[XB_TMO])) break; if (_sp > XB_SPIN_CAP) { atomicAdd(&(bar)[XB_TMO], 1u); break; } } } } while (0)
struct XcdBarrier { unsigned* bar; unsigned x; volatile LAS unsigned* st; };
__device__ __forceinline__ XcdBarrier xcd_barrier_post(unsigned* bar, volatile LAS unsigned* st, const bool lead) {
    XcdBarrier b; b.bar = bar; b.x = xb_xcc_id(); b.st = st;
    if (lead) (void)xb_add(&bar[XB_XCNT(b.x)], 1u);
    return b;
}
__device__ __forceinline__ void xcd_barrier_complete(unsigned* bar, unsigned x, unsigned& nloc, unsigned& nx) {
    const unsigned G = gridDim.x * gridDim.y * gridDim.z;
    unsigned sum, cnt, mine, sp = 0u;
    for (;;) {
        sum = 0u; cnt = 0u; mine = 0u;
#pragma unroll
        for (unsigned j = 0; j < 16; ++j) { const unsigned c = xb_ld(&bar[XB_XCNT(j)]); sum += c; cnt += (c > 0u) ? 1u : 0u; mine = (j == x) ? c : mine; }
        if (sum == G) break;
        __builtin_amdgcn_s_sleep(1);
        if ((++sp & 255u) == 0u) { if (xb_ld(&bar[XB_TMO])) break; if (sp > XB_SPIN_CAP) { atomicAdd(&bar[XB_TMO], 1u); break; } }
    }
    nloc = mine > 0u ? mine : 1u; nx = cnt > 0u ? cnt : 1u;
}
__device__ __forceinline__ void xcd_barrier(const XcdBarrier& b, const bool lead) {
    asm volatile("s_waitcnt vmcnt(0)" ::: "memory");
    __syncthreads();
    if (lead) {
        unsigned* bar = b.bar;
        __builtin_amdgcn_s_waitcnt(0);
        unsigned nloc = b.st[0], nx = b.st[1];
        if (nloc == 0u) { xcd_barrier_complete(bar, b.x, nloc, nx); b.st[0] = nloc; b.st[1] = nx; }
        const unsigned old = xb_add(&bar[XB_XSUB(b.x)], 1u);
        const unsigned gen = old / nloc;
        if (old + 1u == (gen + 1u) * nloc) {
            __builtin_amdgcn_fence(__ATOMIC_RELEASE, "agent");
            asm volatile("s_waitcnt vmcnt(0)" ::: "memory");
            const unsigned og = xb_add(&bar[XB_TOP], 1u);
            const unsigned tg = og / nx;
            if (og + 1u == (tg + 1u) * nx) xb_add(&bar[XB_TOPGEN], 1u);
            else XB_SPIN(xb_ld(&bar[XB_TOPGEN]) == tg, bar);
            __builtin_amdgcn_fence(__ATOMIC_ACQUIRE, "agent");
            xb_add(&bar[XB_XGEN(b.x)], 1u);
            asm volatile("s_waitcnt vmcnt(0)" ::: "memory");
        } else {
            XB_SPIN(xb_ld(&bar[XB_XGEN(b.x)]) == gen, bar);
            __builtin_amdgcn_fence(__ATOMIC_ACQUIRE, "agent");
            asm volatile("s_waitcnt vmcnt(0)" ::: "memory");
        }
    }
    __syncthreads();
}

struct Frame {
    LAS unsigned char* lds;
    volatile LAS unsigned* MISC;
    gu32* ctl;
    int tid, lane, wave;
    int vcu, G;
    const float *x, *mem, *g_attn, *g_mem, *w_in, *lamqk, *subg, *w_mkv, *w_out, *g_ffn, *w_r, *b_r, *w_gu, *b_gu, *w_dn, *b_dn, *g_fin;
    float* out; unsigned char* ws;
};

#define P0_LOAD(dst, itm) do { const int m_ = (itm) / ipm, r_ = (itm) % ipm, kb_ = r_ / nblk, nb_ = r_ % nblk; \
        const float* src_ = W + (size_t)m_ * K * N + (size_t)(64 * kb_ + (lane >> 5)) * N + 32 * nb_ + (lane & 31); \
        _Pragma("unroll") for (int i_ = 0; i_ < 32; ++i_) dst[i_] = __builtin_nontemporal_load(src_ + (size_t)(2 * i_) * N); } while (0)
template <bool F8, bool GAIN, class RowMap>
__device__ __forceinline__ void p0_transpose_all(const float* W, int K, int N, int nmat, void* WTv, const float* gk, float wscale, LAS float* scr, int gw, int NGW, int lane, RowMap rowmap) {
    asm volatile("" : "+v"(lane));
    const int nblk = N / 32, ipm = (K / 64) * nblk, total = nmat * ipm;
    if (gw >= total) return;
    LAS float* gl = scr + 64 * 33;
    if constexpr (GAIN) { for (int i = lane; i < K; i += 64) gl[i] = gk[i] * wscale; LDS_WAIT(); asm volatile("" ::: "memory"); }
#define P0_PROC(v, itm) do { const int m = (itm) / ipm, r = (itm) % ipm, k0 = 64 * (r / nblk), n0 = 32 * (r % nblk); \
        if constexpr (GAIN) { _Pragma("unroll") for (int i = 0; i < 32; ++i) v[i] *= gl[k0 + 2 * i + (lane >> 5)]; } \
        else if (F8) { _Pragma("unroll") for (int i = 0; i < 32; ++i) v[i] *= wscale; } \
        _Pragma("unroll") for (int i = 0; i < 32; ++i) scr[(2 * i + (lane >> 5)) * 33 + (lane & 31)] = v[i]; \
        LDS_WAIT(); asm volatile("" ::: "memory"); \
        const int c = lane & 7; \
        _Pragma("unroll") for (int j = 0; j < 4; ++j) { const int n = (lane >> 3) + 8 * j; const LAS float* s = scr + (8 * c) * 33 + n; \
            if constexpr (F8) { unsigned char* wt = (unsigned char*)WTv + (size_t)m * N * K; \
                v2u o; o.x = fp8x4(s[0 * 33], s[1 * 33], s[2 * 33], s[3 * 33]); o.y = fp8x4(s[4 * 33], s[5 * 33], s[6 * 33], s[7 * 33]); \
                __builtin_nontemporal_store(o, (GAS v2u*)(wt + (size_t)rowmap(n0 + n) * K + k0 + 8 * c)); } \
            else { bf16* wt = (bf16*)WTv + (size_t)m * N * K; \
                v4u o; o.x = pk2(s[0 * 33], s[1 * 33]); o.y = pk2(s[2 * 33], s[3 * 33]); o.z = pk2(s[4 * 33], s[5 * 33]); o.w = pk2(s[6 * 33], s[7 * 33]); \
                *(GAS v4u*)(wt + (size_t)rowmap(n0 + n) * K + k0 + 8 * c) = o; } } \
        LDS_WAIT(); asm volatile("" ::: "memory"); } while (0)
    float va[32], vb[32], vc[32];
    int it = gw;
    P0_LOAD(va, it); if (it + NGW < total) P0_LOAD(vb, it + NGW);
    for (;;) {
        if (it + 2 * NGW < total) P0_LOAD(vc, it + 2 * NGW);
        P0_PROC(va, it); it += NGW; if (it >= total) break;
        if (it + 2 * NGW < total) P0_LOAD(va, it + 2 * NGW);
        P0_PROC(vb, it); it += NGW; if (it >= total) break;
        if (it + 2 * NGW < total) P0_LOAD(vb, it + 2 * NGW);
        P0_PROC(vc, it); it += NGW; if (it >= total) break;
    }
#undef P0_PROC
}
#undef P0_LOAD
struct RowId { __device__ __forceinline__ int operator()(int n) const { return n; } };
struct RowGU { __device__ __forceinline__ int operator()(int n) const { const int f = n >> 1, u = n & 1; return ((f >> 7) << 8) + (u << 7) + (f & 127); } };

__device__ __forceinline__ void p0_x_rows4(Frame& F, const float* xrow, bf16* orow, float* rstd_out) {
    const GAS f32x4* xr = (const GAS f32x4*)xrow + F.lane;
    f32x4 v[16]; float s[4] = {0.f, 0.f, 0.f, 0.f};
#pragma unroll
    for (int j = 0; j < 16; ++j) v[j] = xr[64 * j];
#pragma unroll
    for (int j = 0; j < 16; ++j) s[j >> 2] += (v[j].x * v[j].x + v[j].y * v[j].y) + (v[j].z * v[j].z + v[j].w * v[j].w);
    GAS unsigned long long* o8 = (GAS unsigned long long*)orow + F.lane;
#pragma unroll
    for (int j = 0; j < 16; ++j) o8[64 * j] = (unsigned long long)pk2(v[j].x, v[j].y) | ((unsigned long long)pk2(v[j].z, v[j].w) << 32);
#pragma unroll
    for (int q = 0; q < 4; ++q) s[q] = wave_sum(s[q]);
    if (F.lane < 4) rstd_out[F.lane] = 1.f / sqrtf((F.lane == 0 ? s[0] : F.lane == 1 ? s[1] : F.lane == 2 ? s[2] : s[3]) * (1.f / D) + EPS);
}
__device__ __forceinline__ void p0_mkv_tile(Frame& F, int tile, bf16* mkv, const float* xsrc, bf16* xdst, float* rstd_out, int xstep) {
    const int mt = tile >> 4, nt = tile & 15, m0 = 32 * mt, n0 = 32 * nt, r = F.lane & 31, h = F.lane >> 5, kh = F.wave >> 2, tw = F.wave & 3;
    f32x16 acc = {}; float ss = 0.f;
    LAS float* blk = (LAS float*)(F.lds + RING_OFF + F.wave * 12288);
    LAS float* gl = (LAS float*)(F.lds + RING_OFF + 98304);
    for (int i = F.tid; i < D; i += NWAVES * 64) gl[i] = F.g_mem[i];
    __syncthreads();
    const float* msrc = F.mem + (size_t)(m0 + (F.lane >> 4)) * D + kh * 512 + 4 * (F.lane & 15);
    const float* wcol = F.w_mkv + (size_t)(8 * h + kh * 512) * 512 + n0 + r;
    f32x4 ma[8], mb[8]; float wa[32], wb[32];
#define MKV_LD(M, W, kk_) do { _Pragma("unroll") for (int i_ = 0; i_ < 8; ++i_) M[i_] = *(const f32x4*)(msrc + (size_t)(4 * i_) * D + (kk_)); \
        _Pragma("unroll") for (int s_ = 0; s_ < 4; ++s_) _Pragma("unroll") for (int j_ = 0; j_ < 8; ++j_) W[8 * s_ + j_] = wcol[(size_t)((kk_) + 16 * s_ + j_) * 512]; } while (0)
#define MKV_MM(M, W, kk_) do { _Pragma("unroll") for (int i_ = 0; i_ < 8; ++i_) *(LAS f32x4*)(blk + (4 * i_ + (F.lane >> 4)) * 68 + 4 * (F.lane & 15)) = M[i_]; \
        LDS_WAIT(); asm volatile("" ::: "memory"); \
        _Pragma("unroll") for (int s_ = 0; s_ < 4; ++s_) { const LAS float* ap_ = blk + r * 68 + 16 * s_ + 8 * h; const LAS float* gq_ = gl + kh * 512 + (kk_) + 16 * s_ + 8 * h; \
            const f32x4 a0 = *(const LAS f32x4*)ap_, a1 = *(const LAS f32x4*)(ap_ + 4), g0 = *(const LAS f32x4*)gq_, g1 = *(const LAS f32x4*)(gq_ + 4); \
            ss += (a0.x * a0.x + a0.y * a0.y) + (a0.z * a0.z + a0.w * a0.w) + (a1.x * a1.x + a1.y * a1.y) + (a1.z * a1.z + a1.w * a1.w); \
            v4u bw_; bw_.x = pk2(a0.x * g0.x, a0.y * g0.y); bw_.y = pk2(a0.z * g0.z, a0.w * g0.w); bw_.z = pk2(a1.x * g1.x, a1.y * g1.y); bw_.w = pk2(a1.z * g1.z, a1.w * g1.w); \
            v4u aw_; aw_.x = pk2(W[8 * s_], W[8 * s_ + 1]); aw_.y = pk2(W[8 * s_ + 2], W[8 * s_ + 3]); aw_.z = pk2(W[8 * s_ + 4], W[8 * s_ + 5]); aw_.w = pk2(W[8 * s_ + 6], W[8 * s_ + 7]); \
            acc = __builtin_amdgcn_mfma_f32_32x32x16_bf16(__builtin_bit_cast(bf16x8, aw_), __builtin_bit_cast(bf16x8, bw_), acc, 0, 0, 0); } \
        LDS_WAIT(); asm volatile("" ::: "memory"); } while (0)
    f32x4 xv[8];
#define X_LD(m_) do { const GAS f32x4* xr_ = (const GAS f32x4*)(xsrc + (size_t)(m_) * D) + F.lane; _Pragma("unroll") for (int j_ = 0; j_ < 8; ++j_) xv[j_] = __builtin_nontemporal_load(xr_ + 64 * j_); } while (0)
#define X_PROC(m_) do { float s0_ = 0.f, s1_ = 0.f; \
        _Pragma("unroll") for (int j_ = 0; j_ < 4; ++j_) { s0_ += (xv[j_].x * xv[j_].x + xv[j_].y * xv[j_].y) + (xv[j_].z * xv[j_].z + xv[j_].w * xv[j_].w); \
            s1_ += (xv[4 + j_].x * xv[4 + j_].x + xv[4 + j_].y * xv[4 + j_].y) + (xv[4 + j_].z * xv[4 + j_].z + xv[4 + j_].w * xv[4 + j_].w); } \
        GAS unsigned long long* o8_ = (GAS unsigned long long*)(xdst + (size_t)(m_) * D) + F.lane; \
        _Pragma("unroll") for (int j_ = 0; j_ < 8; ++j_) o8_[64 * j_] = (unsigned long long)pk2(xv[j_].x, xv[j_].y) | ((unsigned long long)pk2(xv[j_].z, xv[j_].w) << 32); \
        s0_ = wave_sum(s0_); s1_ = wave_sum(s1_); \
        if (F.lane < 2) rstd_out[(m_) + F.lane] = 1.f / sqrtf((F.lane == 0 ? s0_ : s1_) * (1.f / D) + EPS); } while (0)
    MKV_LD(ma, wa, 0);
    int xm = 0;
#pragma nounroll
    for (int kk = 0; kk < 512; kk += 128) {
        X_LD(xm); __builtin_amdgcn_sched_barrier(0);
        MKV_LD(mb, wb, kk + 64); MKV_MM(ma, wa, kk); __builtin_amdgcn_sched_barrier(0);
        X_PROC(xm); X_LD(xm + 2); __builtin_amdgcn_sched_barrier(0);
        MKV_LD(ma, wa, min(kk + 128, 448)); MKV_MM(mb, wb, kk + 64); __builtin_amdgcn_sched_barrier(0);
        X_PROC(xm + 2); xm += xstep;
    }
#undef X_LD
#undef X_PROC
#undef MKV_LD
#undef MKV_MM
    LAS float* xc = (LAS float*)(F.lds + RING_OFF + 8 * 16384 - 4 * 64 * 17 * 4) + (tw * 64 + F.lane) * 17;
    if (kh == 1) {
#pragma unroll
        for (int i = 0; i < 16; ++i) xc[i] = acc[i];
        xc[16] = ss; }
    __syncthreads();
    if (kh == 0) {
#pragma unroll
        for (int i = 0; i < 16; ++i) acc[i] += xc[i];
        ss += xc[16]; ss += __shfl_xor(ss, 32);
        const float rstd = 1.f / sqrtf(ss * (1.f / D) + EPS);
        bf16* orow = mkv + (size_t)(m0 + r) * 512 + n0 + 4 * h;
#pragma unroll
        for (int q = 0; q < 4; ++q) { v2u o; o.x = pk2(acc[4 * q] * rstd, acc[4 * q + 1] * rstd); o.y = pk2(acc[4 * q + 2] * rstd, acc[4 * q + 3] * rstd); *(GAS v2u*)(orow + 8 * q) = o; }
    }
    __syncthreads();
}
__device__ __forceinline__ void p0_mrows(Frame& F) {
    const int k = 4 * F.vcu + (F.wave & 3), half = F.wave >> 2, e4 = F.lane & 7, ng = F.lane >> 3;
    LAS float* scr = (LAS float*)(F.lds + RING_OFF + F.wave * 16384);
    LAS float* xc = (LAS float*)(F.lds + RING_OFF + 8 * 16384 - 4096) + (F.wave & 3) * 32;
    __syncthreads();
#pragma unroll
    for (int j = 0; j < 8; ++j) { const int n = half * 512 + F.lane + 64 * j; scr[F.lane + 64 * j] = F.w_out[(size_t)k * D + n] * F.g_ffn[n]; }
    LDS_WAIT(); asm volatile("" ::: "memory");
    const float* wr = F.w_r + (size_t)(half * 512 + ng) * NE + 4 * e4;
    f32x4 acc = {0.f, 0.f, 0.f, 0.f};
#pragma unroll 16
    for (int it = 0; it < 64; ++it) { const float a = scr[8 * it + ng]; const f32x4 w4 = *(const f32x4*)(wr + (size_t)(8 * it) * NE); acc.x += a * w4.x; acc.y += a * w4.y; acc.z += a * w4.z; acc.w += a * w4.w; }
#pragma unroll
    for (int o = 8; o < 64; o <<= 1) { acc.x += __shfl_xor(acc.x, o); acc.y += __shfl_xor(acc.y, o); acc.z += __shfl_xor(acc.z, o); acc.w += __shfl_xor(acc.w, o); }
    if (half == 1 && F.lane < 8) *(LAS f32x4*)(xc + 4 * e4) = acc;
    __syncthreads();
    if (half == 0 && F.lane < 8) { const f32x4 o4 = *(const LAS f32x4*)(xc + 4 * e4); bf16* mt = (bf16*)(F.ws + WS_MT);
        mt[(4 * e4) * D + k] = (bf16)f2bf((acc.x + o4.x) * (1.f / MSCALE)); mt[(4 * e4 + 1) * D + k] = (bf16)f2bf((acc.y + o4.y) * (1.f / MSCALE));
        mt[(4 * e4 + 2) * D + k] = (bf16)f2bf((acc.z + o4.z) * (1.f / MSCALE)); mt[(4 * e4 + 3) * D + k] = (bf16)f2bf((acc.w + o4.w) * (1.f / MSCALE)); }
}
__device__ __forceinline__ void p0_prologue(Frame& F) {
    LAS float* scr = (LAS float*)(F.lds + RING_OFF + F.wave * 16384);
    const int gw = F.vcu * NWAVES + F.wave, NGW = F.G * NWAVES;
    bf16* win_t = (bf16*)(F.ws + WS_WIN); bf16* wout_t = (bf16*)(F.ws + WS_WOUT);
    bf16* xb = (bf16*)(F.ws + WS_XB); float* rstd1 = (float*)(F.ws + WS_RSTD1);
    p0_mkv_tile(F, (F.wave & 3) * 256 + F.vcu, (bf16*)(F.ws + WS_MKV), F.x + (size_t)(4 * gw) * D, xb + (size_t)(4 * gw) * D, rstd1 + 4 * gw, 4 * NGW);
    bf16* wrt = (bf16*)(F.ws + WS_WRT);
    if (gw < 1280) p0_transpose_all<false, true>(F.w_in, D, DIN, 1, win_t, F.g_attn, 1.f, scr, gw, NGW, F.lane, RowId());
    else if (gw < 1792) p0_transpose_all<true, false>(F.w_out, D, D, 1, (void*)wout_t, nullptr, WSCALE, scr, gw - 1280, NGW, F.lane, RowId());
    else for (int i = (gw - 1792) * 64 + F.lane; i < D * NE; i += 256 * 64) { const int e = i >> 10, k = i & 1023; const float w = F.w_r[k * NE + e] * F.g_ffn[k]; const unsigned hb = f2bf(w); wrt[i] = (bf16)hb; wrt[D * NE + i] = (bf16)f2bf(w - bf2f((bf16)hb)); }
    p0_mrows(F);
}

constexpr int NCONV = 8, NCONV_ALL = 8 * NCONV;
__device__ __forceinline__ void p0b_unit(Frame& F, int c) {
    LAS float* scr = (LAS float*)(F.lds + RING_OFF + F.wave * 16384);
    p0_transpose_all<true, true>(F.w_gu, D, 2 * DFF, NE, (void*)(F.ws + WS_WGU), F.g_ffn, WSCALE, scr, c * NWAVES + F.wave, NCONV_ALL * NWAVES, F.lane, RowGU());
    p0_transpose_all<true, false>(F.w_dn, DFF, D, NE, (void*)(F.ws + WS_WDN), nullptr, WSCALE, scr, c * NWAVES + F.wave, NCONV_ALL * NWAVES, F.lane, RowId());
    __syncthreads();
}

struct EpiInProj {
    bf16* O; const float* rstd; unsigned* nrm;
    __device__ __forceinline__ void operator()(const pg8::f32x4 (&acc)[2][2][4][2], const pg8::Unit& u, int wr, int wc, int fr, int fq, const LAS unsigned* ids) const {
        asm volatile("" : "+v"(fr), "+v"(fq));
        const int row0 = u.pm * 256 + wr * 64 + fr, col0 = u.pn * 256 + wc * 32 + 8 * fq;
        const float sc = (u.pn <= 1 || u.pn == 6 || u.pn == 9) ? QSCALE : 1.f;
        const LAS float* scl = (const LAS float*)(ids + 256);
        float rsv[2][4];
#pragma unroll
        for (int ai = 0; ai < 2; ++ai)
#pragma unroll
            for (int m = 0; m < 4; ++m) rsv[ai][m] = scl[wr * 64 + fr + ai * 128 + m * 16];
#pragma unroll
        for (int ai = 0; ai < 2; ++ai)
#pragma unroll
            for (int m = 0; m < 4; ++m) { const int row = row0 + ai * 128 + m * 16; const float rs = rsv[ai][m] * sc; bf16* rowp = O + (size_t)row * DIN + col0;
#pragma unroll
                for (int bj = 0; bj < 2; ++bj) { const pg8::f32x4 v0 = acc[ai][bj][m][0] * rs, v1 = acc[ai][bj][m][1] * rs;
                    v4u w; w.x = pg8::cvt_pk_bf16(v0[0], v0[1]); w.y = pg8::cvt_pk_bf16(v0[2], v0[3]); w.z = pg8::cvt_pk_bf16(v1[0], v1[1]); w.w = pg8::cvt_pk_bf16(v1[2], v1[3]);
                    *(v4u*)(rowp + bj * 128) = w; } }
        if (u.pn < 4) {
#pragma unroll
            for (int bj = 0; bj < 2; ++bj) { float mx = 0.f;
#pragma unroll
                for (int ai = 0; ai < 2; ++ai)
#pragma unroll
                    for (int m = 0; m < 4; ++m) { const float rs = rsv[ai][m] * sc; const pg8::f32x4 v0 = acc[ai][bj][m][0] * rs, v1 = acc[ai][bj][m][1] * rs;
                        float s = (v0[0] * v0[0] + v0[1] * v0[1]) + (v0[2] * v0[2] + v0[3] * v0[3]) + (v1[0] * v1[0] + v1[1] * v1[1]) + (v1[2] * v1[2] + v1[3] * v1[3]);
                        s += __shfl_xor(s, 16); s += __shfl_xor(s, 32); mx = fmaxf(mx, s); }
#pragma unroll
                for (int o = 1; o < 16; o <<= 1) mx = fmaxf(mx, __shfl_xor(mx, o));
                if ((fr | fq) == 0) atomicMax(nrm + (((u.pm >> 4) * 4 + u.pn) * 4 + 2 * bj + (wc >> 1)) * 2 + (wc & 1), __builtin_bit_cast(unsigned, mx)); }
        }
    }
};
__device__ __forceinline__ void attn_phase(Frame& F, char* shm, int qoff = 0, int gmask = 7) {
    using namespace attn_body;
    const attn_body::bf16* P = (const attn_body::bf16*)(F.ws + WS_P);
    attn_body::bf16* OD = (attn_body::bf16*)(F.ws + WS_OD);
    attn_body::bf16* omem = (attn_body::bf16*)(F.ws + WS_OMEM);
    attn_body::bf16* ODIL = (attn_body::bf16*)(F.ws + WS_ODIL); float* LSEb = (float*)(F.ws + WS_LSE);
    const attn_body::bf16* MKV = (const attn_body::bf16*)(F.ws + WS_MKV);
    const float* nrm = (const float*)(F.ctl + CW_NRM);
    const int grp = (int)blockIdx.x & 7, b = grp;
    unsigned* qctr = (unsigned*)(F.ctl + CW_Q + qoff) + 64 * grp;
    const attn_body::bf16* Pb = P + (size_t)b * SEQ * DIN;
#define ATTN_LEAD() ({ int t_ = (int)threadIdx.x; asm volatile("" : "+v"(t_)); t_ == 0; })
    unsigned nxt_tok = 0u;
    if (ATTN_LEAD()) nxt_tok = __hip_atomic_fetch_add(qctr, 1u, __ATOMIC_RELAXED, __HIP_MEMORY_SCOPE_AGENT);
    for (;;) {
        if (ATTN_LEAD()) F.MISC[20] = nxt_tok;
        __syncthreads();
        int un = (int)F.MISC[20];
        __syncthreads();
        if (ATTN_LEAD() && un < NCONV + 384) nxt_tok = __hip_atomic_fetch_add(qctr, 1u, __ATOMIC_RELAXED, __HIP_MEMORY_SCOPE_AGENT);
        if (un < NCONV) { if (gmask == 7) p0b_unit(F, grp * NCONV + un); continue; }
        un -= NCONV;
        if (un >= 384) break;
        if (un < 128) {
            if (!(gmask & 1)) continue;
            const int qb = 15 - (un >> 3), h = 3 - ((un >> 1) & 3), j = un & 1;
            const float slope2 = exp2f(-(float)(2 * h + 1)) * LOG2E;
            const int ni = ((b * 4 + (h >> 1)) * 4 + 2 * (h & 1) + j) * 2;
            const float R = sqrtf((nrm[ni] + nrm[ni + 1]) * (nrm[ni + 16] + nrm[ni + 17])) * 1.01f;
            const float kfirst = (float)(qb * 256) - (2.f * R + 160.f) / slope2;
            int t0 = kfirst > 0.f ? (int)(kfirst * (1.f / 64.f)) : 0; t0 = min(t0, 4 * qb); t0 &= ~1;
            UnitP U; U.Q = Pb + C_DQ + h * 128 + j * 64; U.K = Pb + C_DK + h * 128 + j * 64; U.V = Pb + C_DV + h * 128;
            U.O = OD + (size_t)b * SEQ * 1024 + h * 256 + j * 128; U.qp = DIN; U.kp = DIN; U.op = 1024;
            U.q0 = qb * 256; U.t0 = t0; U.NT = 4 * qb + 4 - t0; U.slope2 = slope2; U.lse = nullptr; U.lse_stride = 0;
            attn_unit<32, true, false, true, false, 128>(U, shm);
        } else if (un < 320) {
            if (!(gmask & 2)) continue;
            const int du = un - 128, h = du / 48, idx = du % 48, n = idx >> 4, w = idx & 15;
            const int r = (n == 0) ? 1 : (n == 1 ? 4 : 16), c = (n == 0) ? 0 : (n == 1 ? (w >> 2) : w), blk = (n == 0) ? w : (n == 1 ? (w & 3) : 0);
            const attn_body::bf16* Pc = Pb + (size_t)c * DIN;
            UnitP U; U.Q = Pc + C_LQ + h * 64; U.K = Pc + C_LK + h * 64; U.V = Pc + C_LV + h * 64; U.qp = (long)r * DIN; U.kp = (long)r * DIN;
            U.O = ODIL + (size_t)n * T * 256 + ((size_t)b * SEQ + c) * 256 + h * 64; U.op = (long)r * 256;
            U.q0 = blk * 256; U.t0 = (blk == 0) ? 0 : 4 * blk - 2; U.NT = 4 * blk + 4 - U.t0;
            U.slope2 = exp2f(-(float)(2 * h + 2)) * (float)r * LOG2E;
            U.lse = LSEb + (size_t)n * T * 4 + ((size_t)b * SEQ + c) * 4 + h; U.lse_stride = r * 4;
            attn_unit<32, true, true, true, true>(U, shm);
        } else {
            if (!(gmask & 4)) continue;
            const int mu = un - 320, h = mu >> 4, qb = mu & 15;
            UnitP U; U.Q = Pb + C_MQ + h * 64; U.qp = DIN; U.K = MKV + (size_t)b * NMEM * 512 + h * 64; U.V = U.K + 256; U.kp = 512;
            U.O = omem + (size_t)b * SEQ * 256 + h * 64; U.op = 256; U.q0 = qb * 256; U.t0 = 0; U.NT = 4; U.slope2 = 0.f; U.lse = nullptr; U.lse_stride = 0;
            attn_unit<8, false, false, false, false>(U, shm);
        }
    }
}
#undef ATTN_LEAD
__device__ __forceinline__ void dil_combine_phase(Frame& F) {
    const int gw = F.vcu * NWAVES + F.wave, NGW = F.G * NWAVES;
    const bf16* OD = (const bf16*)(F.ws + WS_OD); const bf16* ODIL = (const bf16*)(F.ws + WS_ODIL); const float* LSEb = (const float*)(F.ws + WS_LSE); unsigned char* mix = (unsigned char*)(F.ws + WS_MIX); const bf16* OMEM = (const bf16*)(F.ws + WS_OMEM);
    const int h = F.lane >> 4, pt = F.lane & 15, d4 = pt * 4;
    float lam;
    { const float a = F.lamqk[F.lane] * F.lamqk[64 + F.lane], c = F.lamqk[128 + F.lane] * F.lamqk[192 + F.lane];
      lam = __expf(wave_sum(a)) - __expf(wave_sum(c)) + 0.2f; }
    float gsub[8];
#pragma unroll
    for (int i = 0; i < 8; ++i) gsub[i] = F.subg[pt * 8 + i] * (0.8f * MSCALE);
    LAS char* MTl = (LAS char*)(F.lds + RING_OFF + 65536); LAS char* tile = (LAS char*)(F.lds + RING_OFF + F.wave * 8192);
    { const bf16* MTg = (const bf16*)(F.ws + WS_MT);
      for (int idx = F.tid; idx < 4096; idx += NWAVES * 64) { const int e = idx >> 7, c = idx & 127; *(LAS v4u*)(MTl + e * 2048 + ((c ^ (e & 15)) << 4)) = *(const v4u*)(MTg + e * D + c * 8); } }
    __syncthreads();
    float* YLOG = (float*)(F.ws + WS_YLOG);
    for (int row0 = 4 * gw; row0 < T; row0 += 4 * NGW) {
        float l[4][3]; v2u q[4][3]; v4u o1[4], o2[4]; v2u om[4];
#pragma unroll
        for (int i = 0; i < 4; ++i) {
            om[i] = __builtin_nontemporal_load((const v2u*)(OMEM + (size_t)(row0 + i) * 256 + 4 * F.lane));
            o1[i] = __builtin_nontemporal_load((const v4u*)(OD + (size_t)(row0 + i) * 1024 + h * 256 + pt * 8)); o2[i] = __builtin_nontemporal_load((const v4u*)(OD + (size_t)(row0 + i) * 1024 + h * 256 + 128 + pt * 8));
#pragma unroll
            for (int n = 0; n < 3; ++n) { l[i][n] = LSEb[(size_t)n * T * 4 + (size_t)(row0 + i) * 4 + h]; q[i][n] = __builtin_nontemporal_load((const v2u*)(ODIL + (size_t)n * T * 256 + (size_t)(row0 + i) * 256 + h * 64 + d4)); } }
#pragma unroll
        for (int i = 0; i < 4; ++i) {
            const unsigned aw[4] = {o1[i].x, o1[i].y, o1[i].z, o1[i].w}, bw[4] = {o2[i].x, o2[i].y, o2[i].z, o2[i].w};
            float d[8], ss = 0.f;
#pragma unroll
            for (int c = 0; c < 4; ++c) { d[2 * c] = bflo(aw[c]) - lam * bflo(bw[c]); d[2 * c + 1] = bfhi(aw[c]) - lam * bfhi(bw[c]); ss += d[2 * c] * d[2 * c] + d[2 * c + 1] * d[2 * c + 1]; }
#pragma unroll
            for (int o = 1; o < 16; o <<= 1) ss += __shfl_xor(ss, o);
            const float rstd = 1.f / sqrtf(ss * (1.f / 128.f) + EPS);
            v2u od; od.x = fp8x4(d[0] * rstd * gsub[0], d[1] * rstd * gsub[1], d[2] * rstd * gsub[2], d[3] * rstd * gsub[3]); od.y = fp8x4(d[4] * rstd * gsub[4], d[5] * rstd * gsub[5], d[6] * rstd * gsub[6], d[7] * rstd * gsub[7]);
            *(v2u*)(mix + (size_t)(row0 + i) * 1024 + h * 128 + pt * 8) = od;
            { v4u sd; sd.x = pk2(d[0] * rstd * gsub[0], d[1] * rstd * gsub[1]); sd.y = pk2(d[2] * rstd * gsub[2], d[3] * rstd * gsub[3]); sd.z = pk2(d[4] * rstd * gsub[4], d[5] * rstd * gsub[5]); sd.w = pk2(d[6] * rstd * gsub[6], d[7] * rstd * gsub[7]);
              *(LAS v4u*)(tile + i * 2048 + (((h * 16 + pt) ^ i) << 4)) = sd; }
            const float m = fmaxf(fmaxf(l[i][0], l[i][1]), l[i][2]);
            float wn[3], den = 0.f;
#pragma unroll
            for (int n = 0; n < 3; ++n) { wn[n] = exp2f(l[i][n] - m); den += wn[n]; }
            const float inv = MSCALE / den; float o[4] = {0.f, 0.f, 0.f, 0.f};
#pragma unroll
            for (int n = 0; n < 3; ++n) { const float wq = wn[n] * inv; o[0] += wq * bflo(q[i][n].x); o[1] += wq * bfhi(q[i][n].x); o[2] += wq * bflo(q[i][n].y); o[3] += wq * bfhi(q[i][n].y); }
            *(unsigned*)(mix + (size_t)(row0 + i) * 1024 + 512 + h * 64 + d4) = fp8x4(o[0], o[1], o[2], o[3]);
            *(LAS v2u*)(tile + i * 2048 + (((64 + 8 * h + (pt >> 1)) ^ i) << 4) + (pt & 1) * 8) = (v2u){pk2(o[0], o[1]), pk2(o[2], o[3])};
            *(unsigned*)(mix + (size_t)(row0 + i) * 1024 + 768 + 4 * F.lane) = fp8x4(bflo(om[i].x) * MSCALE, bfhi(om[i].x) * MSCALE, bflo(om[i].y) * MSCALE, bfhi(om[i].y) * MSCALE);
            *(LAS v2u*)(tile + i * 2048 + (((96 + (F.lane >> 1)) ^ i) << 4) + (F.lane & 1) * 8) = (v2u){pk2(bflo(om[i].x) * MSCALE, bfhi(om[i].x) * MSCALE), pk2(bflo(om[i].y) * MSCALE, bfhi(om[i].y) * MSCALE)};
        }
        LDS_WAIT(); asm volatile("" ::: "memory");
        { const int n = F.lane & 15, kq = F.lane >> 4, r = n & 3; f32x4 y0 = {0.f, 0.f, 0.f, 0.f}, y1 = {0.f, 0.f, 0.f, 0.f};
#pragma unroll 8
          for (int st = 0; st < 32; ++st) { const int c = 4 * st + kq;
              const v4u a0 = *(const LAS v4u*)(MTl + n * 2048 + ((c ^ n) << 4)), a1 = *(const LAS v4u*)(MTl + (16 + n) * 2048 + ((c ^ n) << 4)), bq = *(const LAS v4u*)(tile + r * 2048 + ((c ^ r) << 4));
              y0 = __builtin_amdgcn_mfma_f32_16x16x32_bf16(__builtin_bit_cast(bf16x8, a0), __builtin_bit_cast(bf16x8, bq), y0, 0, 0, 0);
              y1 = __builtin_amdgcn_mfma_f32_16x16x32_bf16(__builtin_bit_cast(bf16x8, a1), __builtin_bit_cast(bf16x8, bq), y1, 0, 0, 0); }
          if (n < 4) { float* yl = YLOG + (size_t)(row0 + n) * NE + 4 * kq; *(f32x4*)yl = y0; *(f32x4*)(yl + 16) = y1; }
          LDS_WAIT(); asm volatile("" ::: "memory"); }
    }
}
struct EpiY {
    bf16* Y;
    __device__ __forceinline__ void operator()(const pg8::f32x4 (&acc)[2][2][4][2], const pg8::Unit& u, int wr, int wc, int fr, int fq, const LAS unsigned*) const {
        asm volatile("" : "+v"(fr), "+v"(fq));
        const int row0 = u.pm * 256 + wr * 64 + fr, col0 = u.pn * 256 + wc * 32 + 8 * fq;
#pragma unroll
        for (int ai = 0; ai < 2; ++ai)
#pragma unroll
            for (int m = 0; m < 4; ++m) { bf16* rowp = Y + (size_t)(row0 + ai * 128 + m * 16) * D + col0;
#pragma unroll
                for (int bj = 0; bj < 2; ++bj) { const pg8::f32x4 v0 = acc[ai][bj][m][0] * (1.f / (WSCALE * MSCALE)), v1 = acc[ai][bj][m][1] * (1.f / (WSCALE * MSCALE));
                    v4u w; w.x = pg8::cvt_pk_bf16(v0[0], v0[1]); w.y = pg8::cvt_pk_bf16(v0[2], v0[3]); w.z = pg8::cvt_pk_bf16(v1[0], v1[1]); w.w = pg8::cvt_pk_bf16(v1[2], v1[3]);
                    *(v4u*)(rowp + bj * 128) = w; } }
    }
};

__device__ __forceinline__ void route_phase(Frame& F) {
    LAS char* XH = (LAS char*)(F.lds + RING_OFF); LAS char* WH = XH + 65536; LAS char* WL = XH + 73728;
    LAS float* xch = (LAS float*)(XH + 81920);
    LAS float* ssl = (LAS float*)(XH + 81920 + 17408);
    LAS unsigned* lcnt = (LAS unsigned*)(F.lds + LCNT_OFF);
    LAS unsigned* stg = (LAS unsigned*)(F.lds + STG_OFF);
    if (F.tid < 64) lcnt[F.tid] = 0u;
    const int lane = F.lane, tl = lane & 31, h = lane >> 5, tg = F.wave & 3, kh = F.wave >> 2;
    const int srow = F.tid >> 5, k4 = (F.tid & 31) * 4, T0 = F.vcu * 128;
    const bf16* xg = (const bf16*)(F.ws + WS_XB) + (size_t)(T0 + srow) * D + k4;
    const bf16* yg = (const bf16*)(F.ws + WS_Y) + (size_t)(T0 + srow) * D + k4;
    unsigned char* x1q = (unsigned char*)(F.ws + WS_X1B) + (size_t)(T0 + srow) * D + k4;
    bf16* x1h = (bf16*)(F.ws + WS_X1H) + (size_t)(T0 + srow) * D + k4;
    const bf16* wsrc = (const bf16*)(F.ws + WS_WRT);
    v2u xv[8]; v2u yv[8]; v4u wv[2]; float ssr[8];
#pragma unroll
    for (int i = 0; i < 8; ++i) ssr[i] = 0.f;
#define RT_LOAD(kc) do { _Pragma("unroll") for (int i_ = 0; i_ < 8; ++i_) { xv[i_] = __builtin_nontemporal_load((const v2u*)(xg + (size_t)(16 * i_) * D + 128 * (kc))); yv[i_] = __builtin_nontemporal_load((const v2u*)(yg + (size_t)(16 * i_) * D + 128 * (kc))); } \
        _Pragma("unroll") for (int j_ = 0; j_ < 2; ++j_) { const int idx_ = F.tid + 512 * j_; wv[j_] = *(const v4u*)(wsrc + (idx_ >> 9) * 32768 + ((idx_ >> 4) & 31) * 1024 + 128 * (kc) + (idx_ & 15) * 8); } } while (0)
    f32x16 acc = {};
    RT_LOAD(0);
    for (int kc = 0; kc < 8; ++kc) {
#pragma unroll
        for (int i = 0; i < 8; ++i) {
            const float x0 = bflo(xv[i].x) + bflo(yv[i].x), x1 = bfhi(xv[i].x) + bfhi(yv[i].x), x2 = bflo(xv[i].y) + bflo(yv[i].y), x3 = bfhi(xv[i].y) + bfhi(yv[i].y);
            ssr[i] += (x0 * x0 + x1 * x1) + (x2 * x2 + x3 * x3);
            const unsigned h0 = pk2(x0, x1), h1 = pk2(x2, x3);
            *(unsigned*)(x1q + (size_t)(16 * i) * D + 128 * kc) = fp8x4(x0, x1, x2, x3);
            __builtin_nontemporal_store((v2u){h0, h1}, (v2u*)(x1h + (size_t)(16 * i) * D + 128 * kc));
            const int row = srow + 16 * i, off = row * 256 + (((k4 >> 3) ^ (row & 15)) << 4) + (k4 & 4) * 2;
            *(LAS v2u*)(XH + off) = xv[i];
        }
#pragma unroll
        for (int j = 0; j < 2; ++j) { const int idx = F.tid + 512 * j, e = (idx >> 4) & 31, c = idx & 15; *(LAS v4u*)(((idx >> 9) ? WL : WH) + e * 256 + ((c ^ (e & 15)) << 4)) = wv[j]; }
        __syncthreads();
        if (kc < 7) RT_LOAD(kc + 1);
#pragma unroll
        for (int s = 0; s < 4; ++s) { const int c16 = 2 * (4 * kh + s) + h, tr = tg * 32 + tl;
            const v4u xh = *(const LAS v4u*)(XH + tr * 256 + ((c16 ^ (tr & 15)) << 4));
            const v4u wh = *(const LAS v4u*)(WH + tl * 256 + ((c16 ^ (tl & 15)) << 4)), wl2 = *(const LAS v4u*)(WL + tl * 256 + ((c16 ^ (tl & 15)) << 4));
            acc = __builtin_amdgcn_mfma_f32_32x32x16_bf16(__builtin_bit_cast(bf16x8, wh), __builtin_bit_cast(bf16x8, xh), acc, 0, 0, 0);
            acc = __builtin_amdgcn_mfma_f32_32x32x16_bf16(__builtin_bit_cast(bf16x8, wl2), __builtin_bit_cast(bf16x8, xh), acc, 0, 0, 0); }
        __syncthreads();
    }
#undef RT_LOAD
#pragma unroll
    for (int i = 0; i < 8; ++i) { float s = ssr[i];
#pragma unroll
        for (int o = 1; o < 32; o <<= 1) s += __shfl_xor(s, o);
        if ((F.tid & 31) == 0) ssl[srow + 16 * i] = s; }
    const int tok = T0 + tg * 32 + tl; float ss = 0.f;
    if (kh == 1) { LAS float* d = xch + (tg * 64 + lane) * 17;
#pragma unroll
        for (int i = 0; i < 16; ++i) d[i] = acc[i];
        d[16] = ss; }
    __syncthreads();
    if (kh == 0) {
        const LAS float* d = xch + (tg * 64 + lane) * 17;
#pragma unroll
        for (int i = 0; i < 16; ++i) acc[i] += d[i];
        ss = ssl[tg * 32 + tl];
        const float rstd = 1.f / sqrtf(ss * (1.f / D) + EPS);
        float lg[16];
        const float* yl = (const float*)(F.ws + WS_YLOG) + (size_t)tok * NE + 4 * h;
#pragma unroll
        for (int i = 0; i < 16; ++i) lg[i] = (acc[i] + yl[8 * (i >> 2) + (i & 3)]) * rstd + F.b_r[4 * h + (i & 3) + 8 * (i >> 2)];
        float cv[8]; int ce[8];
#pragma unroll
        for (int k = 0; k < 4; ++k) { float bv = -INFINITY; int bi = 0;
#pragma unroll
            for (int i = 0; i < 16; ++i) { if (lg[i] > bv) { bv = lg[i]; bi = i; } }
            cv[k] = bv; ce[k] = 4 * h + (bi & 3) + 8 * (bi >> 2);
#pragma unroll
            for (int i = 0; i < 16; ++i) if (i == bi) lg[i] = -INFINITY; }
#pragma unroll
        for (int k = 0; k < 4; ++k) { cv[4 + k] = __shfl_xor(cv[k], 32); ce[4 + k] = __shfl_xor(ce[k], 32); }
        float tv[4]; int te[4];
#pragma unroll
        for (int k = 0; k < 4; ++k) { float bv = -INFINITY; int be = 64, bi = 0;
#pragma unroll
            for (int i = 0; i < 8; ++i) { if (cv[i] > bv || (cv[i] == bv && ce[i] < be)) { bv = cv[i]; be = ce[i]; bi = i; } }
            tv[k] = bv; te[k] = be;
#pragma unroll
            for (int i = 0; i < 8; ++i) if (i == bi) cv[i] = -INFINITY; }
        float gk[4], den = 0.f;
#pragma unroll
        for (int k = 0; k < 4; ++k) { gk[k] = __expf(tv[k] - tv[0]); den += gk[k]; }
        const float inv = 1.f / den;
        if (h == 0) {
#pragma unroll
            for (int k = 0; k < 4; ++k) {
                const unsigned rank = __hip_atomic_fetch_add(lcnt + te[k], 1u, __ATOMIC_RELAXED, __HIP_MEMORY_SCOPE_WORKGROUP);
                const int slot = (tg * 32 + tl) * 4 + k;
                stg[slot * 4] = (unsigned)(tok * 4 + k); stg[slot * 4 + 1] = ((unsigned)te[k] << 16) | rank; stg[slot * 4 + 2] = __builtin_bit_cast(unsigned, gk[k] * inv); stg[slot * 4 + 3] = __builtin_bit_cast(unsigned, rstd);
            }
        }
    }
    __syncthreads();
    if (F.tid < 32) { const unsigned n = lcnt[F.tid]; lcnt[32 + F.tid] = n ? __hip_atomic_fetch_add((unsigned*)(F.ctl + CW_CNT) + F.tid, n, __ATOMIC_RELAXED, __HIP_MEMORY_SCOPE_AGENT) : 0u; }
    __syncthreads();
    { unsigned* list = (unsigned*)(F.ws + WS_LIST); unsigned* lgate = (unsigned*)(F.ws + WS_LGATE); unsigned* lrstd = (unsigned*)(F.ws + WS_LRSTD);
      const unsigned ent = stg[F.tid * 4], er = stg[F.tid * 4 + 1], gb = stg[F.tid * 4 + 2], rb = stg[F.tid * 4 + 3]; const unsigned e = er >> 16, rank = er & 0xffffu;
      const size_t at = (size_t)e * LCAP + lcnt[32 + e] + rank; list[at] = ent; lgate[at] = gb; lrstd[at] = rb; }
    __syncthreads();
}

__device__ __forceinline__ int moe_build_table(Frame& F) {
    LAS unsigned* tbl = (LAS unsigned*)(F.lds + TBL_OFF); LAS unsigned* lcnt = (LAS unsigned*)(F.lds + LCNT_OFF);
    if (F.wave == 0) {
        const int e = F.lane & 31;
        const unsigned cnt = __hip_atomic_load((unsigned*)(F.ctl + CW_CNT) + e, __ATOMIC_RELAXED, __HIP_MEMORY_SCOPE_AGENT);
        const unsigned nt = (cnt + 255u) >> 8; unsigned incl = nt;
#pragma unroll
        for (int o = 1; o < 32; o <<= 1) { const unsigned t = __shfl_up(incl, o); if ((F.lane & 31) >= o) incl += t; }
        if (F.lane < 32) { lcnt[e] = cnt; const unsigned start = incl - nt; for (unsigned j = 0; j < nt; ++j) tbl[start + j] = ((unsigned)e << 16) | j; if (F.lane == 31) F.MISC[16] = incl; }
    }
    __syncthreads();
    return (int)F.MISC[16];
}
struct MoeOrder {
    const LAS unsigned* tbl; const LAS unsigned* lcnt; const unsigned* list; int NMT, G, c, NPN, MPER, RB; size_t bexp; bool a_tiles; const unsigned* lsc; const unsigned* bias; int bexp_f;
    __device__ __forceinline__ bool next(int i, pg8::Unit& u) const {
        const int L = i * G + c, blk = L >> 5, w = L & 31, g = (NPN == 8) ? blk * 4 + (w >> 3) : blk * 8 + (w >> 2), pn = (NPN == 8) ? (w & 7) : (w & 3);
        if (g >= NMT) return false;
        const unsigned t = tbl[g]; const int e = (int)(t >> 16), mt = (int)(t & 0xffffu); const int cnt = (int)lcnt[e];
        u.pm = g; u.pn = pn; u.e = e; u.mt = mt; u.valid = min(256, cnt - mt * 256);
        u.aoff = a_tiles ? (size_t)g * (size_t)(256 * RB) : (size_t)0; u.boff = (size_t)e * bexp + (size_t)pn * (size_t)(256 * RB);
        return true;
    }
    __device__ __forceinline__ const unsigned* id_src(const pg8::Unit& u, int row) const { return list + (size_t)u.e * LCAP + u.mt * 256 + min(row, u.valid - 1); }
    __device__ __forceinline__ const unsigned* sc_src(const pg8::Unit& u, int row) const { return lsc + (size_t)u.e * LCAP + u.mt * 256 + min(row, u.valid - 1); }
    __device__ __forceinline__ const unsigned* bias_src(const pg8::Unit& u, int col) const { return bias + (size_t)u.e * bexp_f + u.pn * 256 + col; }
};
struct EpiGU {
    unsigned char* ACT;
    __device__ __forceinline__ void operator()(const pg8::f32x4 (&acc)[2][2][4][2], const pg8::Unit& u, int wr, int wc, int fr, int fq, const LAS unsigned* ids) const {
        asm volatile("" : "+v"(fr), "+v"(fq));
        typedef float f2 __attribute__((ext_vector_type(2)));
        constexpr float CG = 1.702f * LOG2E, KA = ASCALE / CG;
        const int r0 = wr * 64 + fr, f0 = u.pn * 128 + wc * 32 + 8 * fq;
        const LAS float* scl = (const LAS float*)(ids + 256); const LAS float* bl = (const LAS float*)(ids + 512) + 2 * (wc * 32 + 8 * fq);
        float rs[2][4];
#pragma unroll
        for (int ai = 0; ai < 2; ++ai)
#pragma unroll
            for (int m = 0; m < 4; ++m) rs[ai][m] = scl[r0 + ai * 128 + m * 16] * (1.f / WSCALE);
        const pg8::f32x4 b0 = *(const LAS pg8::f32x4*)bl, b1 = *(const LAS pg8::f32x4*)(bl + 4), b2 = *(const LAS pg8::f32x4*)(bl + 8), b3 = *(const LAS pg8::f32x4*)(bl + 12);
        const f2 gb[4] = {f2{b0[0], b0[2]} * CG, f2{b1[0], b1[2]} * CG, f2{b2[0], b2[2]} * CG, f2{b3[0], b3[2]} * CG}, ub[4] = {f2{b0[1], b0[3]}, f2{b1[1], b1[3]}, f2{b2[1], b2[3]}, f2{b3[1], b3[3]}};
#pragma unroll
        for (int ai = 0; ai < 2; ++ai)
#pragma unroll
            for (int m = 0; m < 4; ++m) { const int r = r0 + ai * 128 + m * 16; const float s = rs[ai][m], sg = s * CG; f2 a[4];
#pragma unroll
                for (int q = 0; q < 4; ++q) { const int n = q >> 1, j = 2 * (q & 1);
                    f2 g = f2{acc[ai][0][m][n][j], acc[ai][0][m][n][j + 1]} * sg + gb[q], up = f2{acc[ai][1][m][n][j], acc[ai][1][m][n][j + 1]} * s + ub[q];
                    g.x = fminf(g.x, 7.f * CG); g.y = fminf(g.y, 7.f * CG); up.x = __builtin_amdgcn_fmed3f(up.x, -7.f, 7.f); up.y = __builtin_amdgcn_fmed3f(up.y, -7.f, 7.f);
                    f2 d = f2{__builtin_amdgcn_exp2f(-g.x), __builtin_amdgcn_exp2f(-g.y)} + 1.f;
                    const f2 rc = f2{__builtin_amdgcn_rcpf(d.x), __builtin_amdgcn_rcpf(d.y)};
                    a[q] = ((up * KA + KA) * g) * rc; }
                v2u w; w.x = (unsigned)__builtin_amdgcn_cvt_pk_fp8_f32(a[1].x, a[1].y, __builtin_amdgcn_cvt_pk_fp8_f32(a[0].x, a[0].y, 0, false), true);
                w.y = (unsigned)__builtin_amdgcn_cvt_pk_fp8_f32(a[3].x, a[3].y, __builtin_amdgcn_cvt_pk_fp8_f32(a[2].x, a[2].y, 0, false), true);
                *(v2u*)(ACT + (size_t)(u.pm * 256 + r) * DFF + f0) = w; }
    }
};
struct EpiDown {
    unsigned char* YB;
    __device__ __forceinline__ void operator()(const pg8::f32x4 (&acc)[2][2][4][2], const pg8::Unit& u, int wr, int wc, int fr, int fq, const LAS unsigned* ids) const {
        asm volatile("" : "+v"(fr), "+v"(fq));
        const int r0 = wr * 64 + fr, cl = wc * 32 + 8 * fq, col0 = u.pn * 256 + cl;
        const LAS float* scl = (const LAS float*)(ids + 256); const LAS float* bl = (const LAS float*)(ids + 512) + cl;
        pg8::f32x4 bv[2][2];
#pragma unroll
        for (int bj = 0; bj < 2; ++bj)
#pragma unroll
            for (int n = 0; n < 2; ++n) bv[bj][n] = *(const LAS pg8::f32x4*)(bl + bj * 128 + 4 * n);
#pragma unroll
        for (int ai = 0; ai < 2; ++ai)
#pragma unroll
            for (int m = 0; m < 4; ++m) { const int r = r0 + ai * 128 + m * 16; if (r < u.valid) { const float g = scl[r] * YSCALE; unsigned char* yp = YB + (size_t)ids[r] * D + col0;
#pragma unroll
                for (int bj = 0; bj < 2; ++bj) { const pg8::f32x4 v0 = (acc[ai][bj][m][0] * (1.f / (WSCALE * ASCALE)) + bv[bj][0]) * g, v1 = (acc[ai][bj][m][1] * (1.f / (WSCALE * ASCALE)) + bv[bj][1]) * g;
                    v2u w; w.x = fp8x4(v0[0], v0[1], v0[2], v0[3]); w.y = fp8x4(v1[0], v1[1], v1[2], v1[3]);
                    *(v2u*)(yp + bj * 128) = w; } } }
    }
};
__device__ __forceinline__ void final_phase(Frame& F) {
    const int gw = F.vcu * NWAVES + F.wave, NGW = F.G * NWAVES;
    const unsigned char* YB = (const unsigned char*)(F.ws + WS_YB); const bf16* X1 = (const bf16*)(F.ws + WS_X1H);
    const int c = 4 * F.lane;
    f32x4 gf[4];
#pragma unroll
    for (int q = 0; q < 4; ++q) gf[q] = *(const f32x4*)(F.g_fin + c + 256 * q);
    for (int t0 = 2 * gw; t0 < T; t0 += 2 * NGW) {
        v2u xa[2][4]; unsigned y[2][4][4];
#pragma unroll
        for (int u = 0; u < 2; ++u) {
#pragma unroll
            for (int q = 0; q < 4; ++q) xa[u][q] = __builtin_nontemporal_load((const v2u*)(X1 + (size_t)(t0 + u) * D + c + 256 * q));
#pragma unroll
            for (int k = 0; k < 4; ++k)
#pragma unroll
                for (int q = 0; q < 4; ++q) y[u][k][q] = __builtin_nontemporal_load((const unsigned*)(YB + ((size_t)(t0 + u) * 4 + k) * D + c + 256 * q)); }
#pragma unroll
        for (int u = 0; u < 2; ++u) {
            float v[16];
#pragma unroll
            for (int q = 0; q < 4; ++q) { v[4 * q] = bflo(xa[u][q].x); v[4 * q + 1] = bfhi(xa[u][q].x); v[4 * q + 2] = bflo(xa[u][q].y); v[4 * q + 3] = bfhi(xa[u][q].y); }
#pragma unroll
            for (int k = 0; k < 4; ++k)
#pragma unroll
                for (int q = 0; q < 4; ++q) { const auto lo = __builtin_amdgcn_cvt_pk_f32_fp8((int)y[u][k][q], false), hi = __builtin_amdgcn_cvt_pk_f32_fp8((int)y[u][k][q], true);
                    v[4 * q] += lo[0] * (1.f / YSCALE); v[4 * q + 1] += lo[1] * (1.f / YSCALE); v[4 * q + 2] += hi[0] * (1.f / YSCALE); v[4 * q + 3] += hi[1] * (1.f / YSCALE); }
            float ss = 0.f;
#pragma unroll
            for (int i = 0; i < 16; ++i) ss += v[i] * v[i];
            const float rstd = 1.f / sqrtf(wave_sum(ss) * (1.f / D) + EPS);
#pragma unroll
            for (int q = 0; q < 4; ++q) { f32x4 o; o.x = v[4 * q] * rstd * gf[q].x; o.y = v[4 * q + 1] * rstd * gf[q].y; o.z = v[4 * q + 2] * rstd * gf[q].z; o.w = v[4 * q + 3] * rstd * gf[q].w;
                __builtin_nontemporal_store(o, (f32x4*)(F.out + (size_t)(t0 + u) * D + c + 256 * q)); }
        }
    }
}
struct Args { const float* in[17]; float* out; unsigned char* ws; int ph_lo, ph_hi, use_bar, pad; };
__global__ void __launch_bounds__(NWAVES * 64, 2) mk_fwd(Args args) {
    extern __shared__ __attribute__((aligned(16))) unsigned char lds[];
    Frame F;
    F.lds = (LAS unsigned char*)lds;
    F.MISC = (volatile LAS unsigned*)(F.lds + MISC_OFF);
    F.tid = threadIdx.x; F.lane = F.tid & 63; F.wave = __builtin_amdgcn_readfirstlane(F.tid >> 6);
    const bool lead = F.tid == 0;
#define FRESH() do { F.lane = mk_lane(); F.tid = F.wave * 64 + F.lane; } while (0)
    F.G = gridDim.x; { const int bx = blockIdx.x; F.vcu = (F.G % 8 == 0) ? (bx % 8) * (F.G / 8) + bx / 8 : bx; }
    F.ws = args.ws; F.out = args.out; F.ctl = (gu32*)(args.ws + WS_CTL);
    F.x = args.in[0]; F.mem = args.in[1]; F.g_attn = args.in[2]; F.g_mem = args.in[3]; F.w_in = args.in[4]; F.lamqk = args.in[5]; F.subg = args.in[6]; F.w_mkv = args.in[7];
    F.w_out = args.in[8]; F.g_ffn = args.in[9]; F.w_r = args.in[10]; F.b_r = args.in[11]; F.w_gu = args.in[12]; F.b_gu = args.in[13]; F.w_dn = args.in[14]; F.b_dn = args.in[15]; F.g_fin = args.in[16];
    for (int u = F.tid; u < (LDS_BYTES - LDSCTL_OFF) / 4; u += NWAVES * 64) ((LAS unsigned*)(F.lds + LDSCTL_OFF))[u] = 0u;
    __syncthreads();
    XcdBarrier bar; bar.bar = (unsigned*)(F.ctl + CW_BAR); bar.x = 0; bar.st = nullptr;
    if (args.use_bar) bar = xcd_barrier_post((unsigned*)(F.ctl + CW_BAR), F.MISC + 8, lead);
    const int lo = args.ph_lo, hi = args.ph_hi;
#define IN(k) (lo <= (k) && (k) < hi)
#define SEAM(k) do { if (IN(k) && IN((k) + 1)) xcd_barrier(bar, lead); } while (0)
    if (IN(0)) { p0_prologue(F); } SEAM(0);
    if (IN(1)) {
        pg8::Gemm g{(const void*)(F.ws + WS_XB), (const void*)(F.ws + WS_WIN), 2 * D, 128}; pg8::StaticOrder S; S.init(T, DIN, 2 * D, F.G, (int)blockIdx.x, (const unsigned*)(F.ws + WS_RSTD1));
        EpiInProj E{(bf16*)(F.ws + WS_P), (const float*)(F.ws + WS_RSTD1), (unsigned*)(F.ctl + CW_NRM)};
        pg8::gemm_phase<EpiInProj, pg8::StaticOrder, true, false, true>(F.lds + RING_OFF, (LAS unsigned*)(F.lds + IDB_OFF), g, S, E, F.tid);
    } SEAM(1);
    if (IN(2)) { attn_phase(F, (char*)lds + RING_OFF); } SEAM(2);
    if (IN(3)) { FRESH(); dil_combine_phase(F); } SEAM(3);
    if (IN(4)) { FRESH();
        pg8::Gemm g{(const void*)(F.ws + WS_MIX), (const void*)(F.ws + WS_WOUT), D, 128}; pg8::StaticOrder S; S.init(T, D, D, F.G, (int)blockIdx.x);
        EpiY E{(bf16*)(F.ws + WS_Y)};
        pg8::gemm_phase<EpiY, pg8::StaticOrder, true, true, false, true, true>(F.lds + RING_OFF, (LAS unsigned*)(F.lds + IDB_OFF), g, S, E, F.tid);
    } SEAM(4);
    if (IN(5)) { FRESH(); route_phase(F); } SEAM(5);
    if (IN(6)) { FRESH();
        const int nmt = moe_build_table(F);
        pg8::Gemm g{(const void*)(F.ws + WS_X1B), (const void*)(F.ws + WS_WGU), D, 128};
        MoeOrder S{(const LAS unsigned*)(F.lds + TBL_OFF), (const LAS unsigned*)(F.lds + LCNT_OFF), (const unsigned*)(F.ws + WS_LIST), nmt, F.G, F.vcu, 8, 4, D, (size_t)2 * DFF * D, false, (const unsigned*)(F.ws + WS_LRSTD), (const unsigned*)F.b_gu, 2 * DFF};
        EpiGU E{(unsigned char*)(F.ws + WS_ACT)};
        pg8::gemm_phase<EpiGU, MoeOrder, true, true, true, true>(F.lds + RING_OFF, (LAS unsigned*)(F.lds + IDB_OFF), g, S, E, F.tid);
    } SEAM(6);
    if (IN(7)) { FRESH();
        const int nmt = moe_build_table(F);
        pg8::Gemm g{(const void*)(F.ws + WS_ACT), (const void*)(F.ws + WS_WDN), DFF, 128};
        MoeOrder S{(const LAS unsigned*)(F.lds + TBL_OFF), (const LAS unsigned*)(F.lds + LCNT_OFF), (const unsigned*)(F.ws + WS_LIST), nmt, F.G, F.vcu, 4, 8, DFF, (size_t)D * DFF, true, (const unsigned*)(F.ws + WS_LGATE), (const unsigned*)F.b_dn, D};
        EpiDown E{(unsigned char*)(F.ws + WS_YB)};
        pg8::gemm_phase<EpiDown, MoeOrder, true, true, true, true, true>(F.lds + RING_OFF, (LAS unsigned*)(F.lds + IDB_OFF), g, S, E, F.tid);
    } SEAM(7);
    if (IN(8)) { FRESH(); final_phase(F); }
#undef IN
#undef FRESH
#undef SEAM
}

static void launch_phases(const Args& base, int lo, int hi, int use_bar, int grid, hipStream_t stream) {
    Args a = base; a.ph_lo = lo; a.ph_hi = hi; a.use_bar = use_bar;
    hipLaunchKernelGGL(mk_fwd, dim3(grid), dim3(NWAVES * 64), LDS_BYTES, stream, a);
}
extern "C" void kernel_launch(void* const* d_in, const int* in_sizes, int n_in, void* d_out, int out_size, void* d_ws, size_t ws_size, hipStream_t stream) {
    static int grid = 0;
    if (grid == 0) {
        if (n_in != 17 || in_sizes[0] != T * D || out_size != T * D || ws_size < (size_t)1000 * MiB) { fprintf(stderr, "kernel_launch: unexpected shapes / workspace (%d inputs, ws %zu)\n", n_in, ws_size); grid = -1; return; }
        int dev = 0, cus = 0, per_cu = 0;
        if (hipGetDevice(&dev) != hipSuccess || hipDeviceGetAttribute(&cus, hipDeviceAttributeMultiprocessorCount, dev) != hipSuccess) { grid = -1; return; }
        if (hipFuncSetAttribute((const void*)mk_fwd, hipFuncAttributeMaxDynamicSharedMemorySize, LDS_BYTES) != hipSuccess) { fprintf(stderr, "kernel_launch: hipFuncSetAttribute failed\n"); grid = -1; return; }
        if (hipOccupancyMaxActiveBlocksPerMultiprocessor(&per_cu, (const void*)mk_fwd, NWAVES * 64, LDS_BYTES) != hipSuccess || per_cu < 1) { fprintf(stderr, "kernel_launch: occupancy query says %d blocks per CU\n", per_cu); per_cu = 1; }
        (void)hipGetLastError();
        grid = cus;
        if (grid != 256) { fprintf(stderr, "kernel_launch: built for a 256-CU device (got %d)\n", cus); grid = -1; return; }
    }
    if (grid < 0) return;
    (void)hipMemsetAsync((char*)d_ws + WS_CTL, 0, CTL_ZERO_BYTES, stream);
    Args a{};
    for (int i = 0; i < 17; ++i) a.in[i] = (const float*)d_in[i];
    a.out = (float*)d_out; a.ws = (unsigned char*)d_ws;
    launch_phases(a, 0, 9, 1, grid, stream);
}
```
